# Optimizing an MI355X kernel written in HIP

```python
import math
import jax, jax.numpy as jnp
from jax import lax
import numpy as np

D_MODEL = 2048
BATCH = 4
SEQ = 2048
DEPTH = 2
DEC_BATCH = 128
DEC_SEQ = 4
PAST_LEN = 16384
PAGE_SIZE = 128

N_META = 16
CHUNK = 64
N_EVEN = (DEPTH + 1) // 2
N_ODD = DEPTH // 2

H_A = 8
DK_A = 128
DV_A = 128
H_B = 4
DK_B = 128
DV_B = 256
EVEN_SIZES = (H_A * DK_A, H_A * DK_A, H_A * DV_A, H_A * DV_A, H_B * DK_B, H_B * DK_B, H_B * DV_B, H_B * DV_B)
EVEN_IN = sum(EVEN_SIZES)
EVEN_MIX = H_A * DV_A + H_B * DV_B

H_C = 16
P_C = 64
N_C = 128
G_C = 2
CONV_W = 4
DI_C = H_C * P_C
CONV_DIM = DI_C + 2 * G_C * N_C
H_D = 16
P_D = 64
DI_D = H_D * P_D
R_W = 64
R_A = 64
R_G = 160
RWKV_SIZES = (DI_D, DI_D, DI_D, R_W, R_A, R_G)
SHIFT_DIM = sum(RWKV_SIZES)
ODD_SIZES = (DI_C, CONV_DIM, H_C, SHIFT_DIM)
ODD_IN = sum(ODD_SIZES)
ODD_MIX = DI_C + DI_D

PEER_KEYS = 128
PEER_EXPERTS = PEER_KEYS * PEER_KEYS
PEER_HEADS = 8
PEER_TOPK = 16
PEER_QDIM = 256
PEER_BLOCK = 128

ALPHA = (2.0 * DEPTH) ** 0.25
BETA = (8.0 * DEPTH) ** -0.25
LN_EPS = 1e-5
RMS_EPS = 1e-6
RWKV_GN_EPS = 64e-5
ROPE_BASE = 10000.0
F32 = jnp.float32

kernel_name = 'hybrid_hgrn2_retnet_mamba2_rwkv7_peer_step'


def split_cols(a, sizes):
    out, start = [], 0
    for s in sizes:
        out.append(a[..., start:start + s])
        start += s
    return out


def layer_norm(x, g=None, b=None, eps=LN_EPS):
    xf = x.astype(F32)
    mu = jnp.mean(xf, -1, keepdims=True)
    var = jnp.mean(jnp.square(xf - mu), -1, keepdims=True)
    y = (xf - mu) * lax.rsqrt(var + eps)
    if g is not None:
        y = y * g + b
    return y.astype(x.dtype)


def rms_norm(x, g, eps=RMS_EPS):
    xf = x.astype(F32)
    return (xf * lax.rsqrt(jnp.mean(xf * xf, -1, keepdims=True) + eps) * g).astype(x.dtype)


def to_heads(a, h):
    bn, t, _ = a.shape
    return a.reshape(bn, t, h, -1).transpose(0, 2, 1, 3)


def rotary(x, pos):
    half = x.shape[-1] // 2
    inv = ROPE_BASE ** (-jnp.arange(half, dtype=F32) / half)
    ang = pos.astype(F32)[:, None] * inv
    cos, sin = jnp.cos(ang)[:, None, :], jnp.sin(ang)[:, None, :]
    x1, x2 = x[..., :half], x[..., half:]
    return jnp.concatenate([x1 * cos - x2 * sin, x1 * sin + x2 * cos], -1).astype(x.dtype)


def scalar_decay_chunk(q, k, v, logf, s0):
    L = q.shape[2]
    causal = jnp.tril(jnp.ones((L, L), dtype=bool))
    b = jnp.cumsum(logf.astype(F32), axis=-1)
    seg = jnp.exp(jnp.where(causal, b[..., :, None] - b[..., None, :], -jnp.inf))
    scores = jnp.einsum('bhtk,bhsk->bhts', q, k) * seg
    o = jnp.einsum('bhts,bhsv->bhtv', scores, v) + jnp.einsum('bhtk,bhkv->bhtv', q * jnp.exp(b)[..., None], s0)
    b_end = b[..., -1:]
    s = jnp.exp(b_end)[..., None] * s0 + jnp.einsum('bhsk,bhsv->bhkv', k * jnp.exp(b_end - b)[..., None], v)
    return o, s


def vector_decay_chunk(q, k, v, logf, s0):
    L = q.shape[2]
    causal = jnp.tril(jnp.ones((L, L), dtype=bool))
    b = jnp.cumsum(logf.astype(F32), axis=2)
    diff = b[:, :, :, None, :] - b[:, :, None, :, :]
    seg = jnp.exp(jnp.where(causal[:, :, None], diff, -jnp.inf))
    scores = jnp.einsum('bhtk,bhtsk,bhsk->bhts', q, seg, k)
    o = jnp.einsum('bhts,bhsv->bhtv', scores, v) + jnp.einsum('bhtk,bhkv->bhtv', q * jnp.exp(b), s0)
    b_end = b[:, :, -1:, :]
    s = jnp.exp(b_end[:, :, 0, :])[..., None] * s0 + jnp.einsum('bhsk,bhsv->bhkv', k * jnp.exp(b_end - b), v)
    return o, s


def run_chunks(chunk_fn, q, k, v, logf, s0, lead):
    T = q.shape[2]
    s = s0.astype(F32)
    parts = []
    if lead > 0:
        o_head, s = chunk_fn(q[:, :, :lead], k[:, :, :lead], v[:, :, :lead], logf[:, :, :lead], s)
        parts.append(o_head)
    rest = T - lead
    if rest > 0:
        n = rest // CHUNK

        def split(a):
            a = a[:, :, lead:]
            a = a.reshape(a.shape[:2] + (n, CHUNK) + a.shape[3:])
            return jnp.moveaxis(a, 2, 0)

        def step(carry, xs):
            o_c, carry = chunk_fn(xs[0], xs[1], xs[2], xs[3], carry)
            return carry, o_c

        s, o_rest = lax.scan(step, s, (split(q), split(k), split(v), split(logf)))
        o_rest = jnp.moveaxis(o_rest, 0, 2)
        parts.append(o_rest.reshape(o_rest.shape[:2] + (rest,) + o_rest.shape[4:]))
    return jnp.concatenate(parts, axis=2), s


def rwkv7_scan(r, decay, k, v, kk, a, s0):
    def step(s, inp):
        r_t, w_t, k_t, v_t, kk_t, a_t = inp
        sa = jnp.einsum('bhij,bhj->bhi', s, -kk_t)
        s = s * w_t[:, :, None, :] + sa[..., None] * (kk_t * a_t)[:, :, None, :] + v_t[..., None] * k_t[:, :, None, :]
        return s, jnp.einsum('bhij,bhj->bhi', s, r_t)

    xs = tuple(jnp.moveaxis(t.astype(F32), 1, 0) for t in (r, decay, k, v, kk, a))
    s, ys = lax.scan(step, s0.astype(F32), xs)
    return jnp.moveaxis(ys, 0, 1), s


def even_mixer(x, pos, lead, s_hgrn, s_ret, lb, w_in, norm_g, w_out):
    bn, T, _ = x.shape
    aq, af, ai, ag, bq, bk, bv, bg = split_cols(x @ w_in, EVEN_SIZES)
    af32 = af.astype(F32)
    log_f = jnp.log(lb + (1.0 - lb) * jax.nn.sigmoid(af32))
    k_a = (1.0 - lb) * jax.nn.sigmoid(-af32)
    o_a, s_hgrn_new = run_chunks(vector_decay_chunk, to_heads(jax.nn.silu(aq), H_A), to_heads(k_a, H_A),
                                 to_heads(ai, H_A), to_heads(log_f, H_A), s_hgrn, lead)
    o_a = rms_norm(o_a.transpose(0, 2, 1, 3), norm_g).reshape(bn, T, -1) * jax.nn.silu(ag)
    qb = rotary(bq.reshape(bn, T, H_B, DK_B), pos)
    kb = rotary(bk.reshape(bn, T, H_B, DK_B), pos) * DK_B ** -0.5
    log_gamma = jnp.log(1.0 - 2.0 ** (-5.0 - jnp.arange(H_B, dtype=F32)))
    log_f_b = jnp.broadcast_to(log_gamma[None, :, None], (bn, H_B, T))
    o_b, s_ret_new = run_chunks(scalar_decay_chunk, qb.transpose(0, 2, 1, 3), kb.transpose(0, 2, 1, 3),
                                to_heads(bv, H_B), log_f_b, s_ret, lead)
    o_b = layer_norm(o_b.transpose(0, 2, 1, 3)).reshape(bn, T, -1) * jax.nn.silu(bg)
    y = jnp.concatenate([o_a, o_b], -1) @ w_out
    return y, s_hgrn_new.astype(s_hgrn.dtype), s_ret_new.astype(s_ret.dtype)


def odd_mixer(x, lead, s_ssm, s_conv, s_wkv, s_shift, w, i):
    bn, T, _ = x.shape
    z, xbc, dt_raw, rw = split_cols(x @ w['odd_w_in'][i], ODD_SIZES)
    xpad = jnp.concatenate([s_conv.astype(xbc.dtype), xbc], axis=1)
    new_conv = xpad[:, -(CONV_W - 1):]
    cw = w['conv_w'][i]
    conv = w['conv_b'][i] + xpad[:, 0:T] * cw[0]
    for j in range(1, CONV_W):
        conv = conv + xpad[:, j:j + T] * cw[j]
    xc, bm, cm = split_cols(jax.nn.silu(conv), (DI_C, G_C * N_C, G_C * N_C))
    dt = jax.nn.softplus(dt_raw.astype(F32) + w['dt_bias'][i])
    log_f = jnp.transpose(dt * -jnp.exp(w['a_log'][i].astype(F32)), (0, 2, 1))
    xh = xc.reshape(bn, T, H_C, P_C)
    rep = H_C // G_C
    bh = jnp.repeat(bm.reshape(bn, T, G_C, N_C), rep, axis=2)
    ch = jnp.repeat(cm.reshape(bn, T, G_C, N_C), rep, axis=2)
    o_c, s_ssm_new = run_chunks(scalar_decay_chunk, ch.transpose(0, 2, 1, 3), bh.transpose(0, 2, 1, 3),
                                (xh * dt[..., None]).transpose(0, 2, 1, 3), log_f, s_ssm, lead)
    y_c = o_c.transpose(0, 2, 1, 3) + xh * w['d_skip'][i][:, None]
    y_c = (y_c.reshape(bn, T, DI_C) * jax.nn.silu(z)).reshape(bn, T, G_C, DI_C // G_C)
    y_c = rms_norm(y_c, w['ssm_norm_g'][i].reshape(G_C, DI_C // G_C)).reshape(bn, T, DI_C)
    prev = jnp.concatenate([s_shift[:, None].astype(rw.dtype), rw[:, :-1]], axis=1)
    new_shift = rw[:, -1]
    rw = rw + (prev - rw) * w['shift_mu'][i]
    r, k, v, dw, da, dg = split_cols(rw, RWKV_SIZES)
    w_log = -jax.nn.softplus(-(w['rwkv_w0'][i] + jnp.tanh(dw) @ w['rwkv_w2'][i]).astype(F32)) - 0.5
    decay = jnp.exp(-jnp.exp(w_log))
    a = jax.nn.sigmoid(w['rwkv_a0'][i] + da @ w['rwkv_a2'][i])
    g = jax.nn.sigmoid(dg) @ w['rwkv_g2'][i]

    def hd(t):
        return t.reshape(bn, T, H_D, P_D)

    kk = hd(k * w['rwkv_k_k'][i]).astype(F32)
    kk = kk / jnp.maximum(jnp.linalg.norm(kk, axis=-1, keepdims=True), 1e-12)
    k = k * (1.0 + (a - 1.0) * w['rwkv_k_a'][i])
    y_d, s_wkv_new = rwkv7_scan(hd(r), hd(decay), hd(k), hd(v), kk, hd(a), s_wkv)
    y_d = layer_norm(y_d, w['lnx_g'][i].reshape(H_D, P_D), w['lnx_b'][i].reshape(H_D, P_D), RWKV_GN_EPS)
    y_d = y_d + jnp.sum(hd(r) * hd(k) * w['rwkv_r_k'][i], -1, keepdims=True) * hd(v)
    y_d = y_d.reshape(bn, T, DI_D) * g
    y = jnp.concatenate([y_c, y_d], -1) @ w['odd_w_out'][i]
    return (y, s_ssm_new.astype(s_ssm.dtype), new_conv.astype(s_conv.dtype),
            s_wkv_new.astype(s_wkv.dtype), new_shift.astype(s_shift.dtype))


def peer(x, w_query, sub_keys, u_tab, v_tab):
    bn, T, _ = x.shape
    xt = x.reshape(-1, D_MODEL)
    M = xt.shape[0]
    q = (xt @ w_query).reshape(M, PEER_HEADS, 2, PEER_QDIM // 2)
    s = jnp.einsum('mhcd,hcnd->mhcn', q, sub_keys).astype(F32)
    top_s, top_i = lax.top_k(s, PEER_TOPK)
    cand = top_s[:, :, 0, :, None] + top_s[:, :, 1, None, :]
    cand_i = top_i[:, :, 0, :, None] * PEER_KEYS + top_i[:, :, 1, None, :]
    best_s, best_j = lax.top_k(cand.reshape(M, PEER_HEADS, PEER_TOPK * PEER_TOPK), PEER_TOPK)
    idx = jnp.take_along_axis(cand_i.reshape(M, PEER_HEADS, PEER_TOPK * PEER_TOPK), best_j, axis=-1)
    gate = jax.nn.softmax(best_s, axis=-1)
    pad = (-M) % PEER_BLOCK
    nb = (M + pad) // PEER_BLOCK
    xb = jnp.pad(xt, ((0, pad), (0, 0))).reshape(nb, PEER_BLOCK, D_MODEL)
    ib = jnp.pad(idx.reshape(M, -1), ((0, pad), (0, 0))).reshape(nb, PEER_BLOCK, PEER_HEADS * PEER_TOPK)
    gb = jnp.pad(gate.reshape(M, -1), ((0, pad), (0, 0))).reshape(nb, PEER_BLOCK, PEER_HEADS * PEER_TOPK)

    def block(args):
        x_blk, i_blk, g_blk = args
        act = jax.nn.gelu(jnp.einsum('md,mkd->mk', x_blk, u_tab[i_blk]).astype(F32), approximate=False)
        return jnp.einsum('mk,mkd->md', g_blk * act, v_tab[i_blk])

    out = lax.map(block, (xb, ib, gb)).reshape(-1, D_MODEL)[:M]
    return out.reshape(bn, T, D_MODEL)


def run_trunk(x, pos, lead, st_hgrn, st_ret, st_ssm, st_conv, st_wkv, st_shift, w):
    hg, rt, ssm, cv, wkv, sh = [], [], [], [], [], []
    lb_table = jnp.cumsum(jax.nn.softmax(w['hgrn_lb_logits'].astype(F32), axis=0), axis=0)
    for l in range(DEPTH):
        i = l // 2
        if l % 2 == 0:
            mix, s_h, s_r = even_mixer(x, pos, lead, st_hgrn[i], st_ret[i], lb_table[l], w['even_w_in'][i],
                                       w['hgrn_norm_g'][i], w['even_w_out'][i])
            hg.append(s_h)
            rt.append(s_r)
        else:
            mix, s_s, s_c, s_w, s_sh = odd_mixer(x, lead, st_ssm[i], st_conv[i], st_wkv[i], st_shift[i], w, i)
            ssm.append(s_s)
            cv.append(s_c)
            wkv.append(s_w)
            sh.append(s_sh)
        x = layer_norm(ALPHA * x + mix, w['ln_g'][l, 0], w['ln_b'][l, 0])
        ffn = peer(x, w['peer_w_query'][l], w['peer_sub_keys'][l], w['peer_u'][l], w['peer_v'][l])
        x = layer_norm(ALPHA * x + ffn, w['ln_g'][l, 1], w['ln_b'][l, 1])
    return x, jnp.stack(hg), jnp.stack(rt), jnp.stack(ssm), jnp.stack(cv), jnp.stack(wkv), jnp.stack(sh)


def setup_inputs(seed: int = 0) -> dict:
    key = jax.random.key(seed)
    keys = list(jax.random.split(key, 48))

    def nrm(shape, scale):
        return jax.random.normal(keys.pop(), shape, F32) * scale

    def unif(shape, lo, hi):
        return jax.random.uniform(keys.pop(), shape, F32, lo, hi)

    dt0 = jnp.exp(unif((N_ODD, H_C), math.log(1e-3), math.log(1e-1)))
    return {
        'x_prompt': nrm((BATCH, SEQ, D_MODEL), 1.0),
        'x_sample': nrm((DEC_BATCH, DEC_SEQ, D_MODEL), 1.0),
        'state_hgrn': nrm((N_EVEN, DEC_BATCH, H_A, DK_A, DV_A), 0.5),
        'state_ret': nrm((N_EVEN, DEC_BATCH, H_B, DK_B, DV_B), 1.0),
        'state_ssm': nrm((N_ODD, DEC_BATCH, H_C, N_C, P_C), 0.5),
        'state_conv': nrm((N_ODD, DEC_BATCH, CONV_W - 1, CONV_DIM), 1.0),
        'state_wkv': nrm((N_ODD, DEC_BATCH, H_D, P_D, P_D), 0.3),
        'state_shift': nrm((N_ODD, DEC_BATCH, SHIFT_DIM), 1.0),
        'meta_tokens': nrm((N_META, D_MODEL), 1.0),
        'ln_g': 1.0 + nrm((DEPTH, 2, D_MODEL), 0.02),
        'ln_b': nrm((DEPTH, 2, D_MODEL), 0.02),
        'even_w_in': nrm((N_EVEN, D_MODEL, EVEN_IN), D_MODEL ** -0.5),
        'hgrn_lb_logits': nrm((DEPTH + 1, H_A * DK_A), 0.5),
        'hgrn_norm_g': 1.0 + nrm((N_EVEN, DV_A), 0.02),
        'even_w_out': nrm((N_EVEN, EVEN_MIX, D_MODEL), EVEN_MIX ** -0.5 * BETA),
        'odd_w_in': nrm((N_ODD, D_MODEL, ODD_IN), D_MODEL ** -0.5),
        'conv_w': nrm((N_ODD, CONV_W, CONV_DIM), CONV_W ** -0.5),
        'conv_b': nrm((N_ODD, CONV_DIM), 0.02),
        'dt_bias': dt0 + jnp.log(-jnp.expm1(-dt0)),
        'a_log': jnp.log(unif((N_ODD, H_C), 1.0, 16.0)),
        'd_skip': 1.0 + nrm((N_ODD, H_C), 0.1),
        'ssm_norm_g': 1.0 + nrm((N_ODD, DI_C), 0.02),
        'shift_mu': unif((N_ODD, SHIFT_DIM), 0.0, 1.0),
        'rwkv_w0': -1.0 + nrm((N_ODD, DI_D), 0.5),
        'rwkv_w2': nrm((N_ODD, R_W, DI_D), 0.1),
        'rwkv_a0': nrm((N_ODD, DI_D), 0.1),
        'rwkv_a2': nrm((N_ODD, R_A, DI_D), 0.1),
        'rwkv_g2': nrm((N_ODD, R_G, DI_D), R_G ** -0.5),
        'rwkv_k_k': 0.85 + nrm((N_ODD, DI_D), 0.05),
        'rwkv_k_a': 1.0 + nrm((N_ODD, DI_D), 0.05),
        'rwkv_r_k': nrm((N_ODD, H_D, P_D), 0.1),
        'lnx_g': 1.0 + nrm((N_ODD, DI_D), 0.02),
        'lnx_b': nrm((N_ODD, DI_D), 0.02),
        'odd_w_out': nrm((N_ODD, ODD_MIX, D_MODEL), ODD_MIX ** -0.5 * BETA),
        'peer_w_query': nrm((DEPTH, D_MODEL, PEER_HEADS * PEER_QDIM), D_MODEL ** -0.5),
        'peer_sub_keys': nrm((DEPTH, PEER_HEADS, 2, PEER_KEYS, PEER_QDIM // 2), (PEER_QDIM // 2) ** -0.5),
        'peer_u': nrm((DEPTH, PEER_EXPERTS, D_MODEL), D_MODEL ** -0.5),
        'peer_v': nrm((DEPTH, PEER_EXPERTS, D_MODEL), BETA * PEER_HEADS ** -0.5),
    }


def reference(x_prompt, x_sample, state_hgrn, state_ret, state_ssm, state_conv, state_wkv, state_shift,
              meta_tokens, ln_g, ln_b, even_w_in, hgrn_lb_logits, hgrn_norm_g, even_w_out, odd_w_in, conv_w,
              conv_b, dt_bias, a_log, d_skip, ssm_norm_g, shift_mu, rwkv_w0, rwkv_w2, rwkv_a0, rwkv_a2, rwkv_g2,
              rwkv_k_k, rwkv_k_a, rwkv_r_k, lnx_g, lnx_b, odd_w_out, peer_w_query, peer_sub_keys, peer_u, peer_v):
    w = dict(ln_g=ln_g, ln_b=ln_b, even_w_in=even_w_in, hgrn_lb_logits=hgrn_lb_logits, hgrn_norm_g=hgrn_norm_g,
             even_w_out=even_w_out, odd_w_in=odd_w_in, conv_w=conv_w, conv_b=conv_b, dt_bias=dt_bias,
             a_log=a_log, d_skip=d_skip, ssm_norm_g=ssm_norm_g, shift_mu=shift_mu, rwkv_w0=rwkv_w0,
             rwkv_w2=rwkv_w2, rwkv_a0=rwkv_a0, rwkv_a2=rwkv_a2, rwkv_g2=rwkv_g2, rwkv_k_k=rwkv_k_k,
             rwkv_k_a=rwkv_k_a, rwkv_r_k=rwkv_r_k, lnx_g=lnx_g, lnx_b=lnx_b, odd_w_out=odd_w_out,
             peer_w_query=peer_w_query, peer_sub_keys=peer_sub_keys, peer_u=peer_u, peer_v=peer_v)
    bp, sp = x_prompt.shape[0], x_prompt.shape[1]
    dt = x_prompt.dtype
    xp = jnp.concatenate([jnp.broadcast_to(meta_tokens.astype(dt)[None], (bp, N_META, D_MODEL)), x_prompt], axis=1)
    pos_p = jnp.arange(N_META + sp)
    yp, hgrn_p, ret_p, ssm_p, conv_p, wkv_p, shift_p = run_trunk(
        xp, pos_p, N_META,
        jnp.zeros((N_EVEN, bp, H_A, DK_A, DV_A), dt), jnp.zeros((N_EVEN, bp, H_B, DK_B, DV_B), dt),
        jnp.zeros((N_ODD, bp, H_C, N_C, P_C), dt), jnp.zeros((N_ODD, bp, CONV_W - 1, CONV_DIM), dt),
        jnp.zeros((N_ODD, bp, H_D, P_D, P_D), dt), jnp.zeros((N_ODD, bp, SHIFT_DIM), dt), w)
    y_prompt = yp[:, N_META:]
    ds = x_sample.shape[1]
    pos_s = PAST_LEN + jnp.arange(ds)
    y_sample, hgrn_s, ret_s, ssm_s, conv_s, wkv_s, shift_s = run_trunk(
        x_sample, pos_s, ds % CHUNK, state_hgrn, state_ret, state_ssm, state_conv, state_wkv, state_shift, w)
    return (y_prompt, y_sample, hgrn_p, hgrn_s, ret_p, ret_s, ssm_p, ssm_s, conv_p, conv_s, wkv_p, wkv_s, shift_p, shift_s)
```

```cpp
#include <hip/hip_runtime.h>
#include <hip/hip_bf16.h>
#include <hip/hip_cooperative_groups.h>
#include <cstdio>
#include <cmath>
namespace cg = cooperative_groups;

#define DEVI __device__ __forceinline__
typedef unsigned short u16;
using bf16x8 = __attribute__((ext_vector_type(8))) short;
using f32x4 = __attribute__((ext_vector_type(4))) float;
using u32x4 = __attribute__((ext_vector_type(4))) unsigned int;

constexpr int D = 2048;
constexpr int TP = 2064;
constexpr int MPR = 8256;
constexpr int M = 8768;
constexpr int MP = 8832;
constexpr int N0 = 7168;
constexpr int N1 = 6016;
constexpr float ALPHA = 1.41421356237f;

constexpr size_t SZ_TAB = (size_t)16384 * 2048 * 2;
constexpr size_t OFF_UB = 0;
constexpr size_t OFF_VB = OFF_UB + SZ_TAB;
constexpr size_t OFF_WIN0 = OFF_VB + SZ_TAB;
constexpr size_t OFF_WOUT0 = OFF_WIN0 + (size_t)N0 * 2048 * 2;
constexpr size_t OFF_WQ0 = OFF_WOUT0 + (size_t)2048 * 2048 * 2;
constexpr size_t OFF_KEY0 = OFF_WQ0 + (size_t)2048 * 2048 * 2;
constexpr size_t OFF_WIN1 = OFF_KEY0 + (size_t)16 * 128 * 128 * 2;
constexpr size_t OFF_WOUT1 = OFF_WIN1 + (size_t)N1 * 2048 * 2;
constexpr size_t OFF_WQ1 = OFF_WOUT1 + (size_t)2048 * 2048 * 2;
constexpr size_t OFF_KEY1 = OFF_WQ1 + (size_t)2048 * 2048 * 2;
constexpr size_t OFF_W2T = OFF_KEY1 + (size_t)16 * 128 * 128 * 2;
constexpr size_t OFF_A2T = OFF_W2T + (size_t)1024 * 64 * 2;
constexpr size_t OFF_G2T = OFF_A2T + (size_t)1024 * 64 * 2;
constexpr size_t OFF_LB = OFF_G2T + (size_t)1024 * 192 * 2;
constexpr size_t OFF_INVREV = OFF_LB + 1024 * 4;
constexpr size_t OFF_XF = OFF_INVREV + 64 * 8;
constexpr size_t OFF_XB = OFF_XF + (size_t)MP * 2048 * 4;
constexpr size_t OFF_PROJ = OFF_XB + (size_t)MP * 2048 * 2;
constexpr size_t OFF_GOUT = OFF_PROJ + (size_t)MP * N0 * 4;
constexpr size_t OFF_OMIX = OFF_GOUT + (size_t)MP * 2048 * 4;
constexpr size_t OFF_MIXB = OFF_OMIX + (size_t)MP * 2048 * 4;
constexpr size_t OFF_QB = OFF_MIXB + (size_t)MP * 2048 * 2;
constexpr size_t OFF_RKV = OFF_QB + (size_t)MP * 2048 * 2;
constexpr size_t OFF_DEC = OFF_RKV + (size_t)MP * 3072 * 4;
constexpr size_t OFF_AA = OFF_DEC + (size_t)MP * 1024 * 4;
constexpr size_t OFF_GG = OFF_AA + (size_t)MP * 1024 * 4;
constexpr size_t OFF_LRA = OFF_GG + (size_t)MP * 1024 * 4;
constexpr size_t OFF_LRB = OFF_LRA + (size_t)MP * 64 * 2;
constexpr size_t OFF_LRG = OFF_LRB + (size_t)MP * 64 * 2;
constexpr size_t OFF_DTA = OFF_LRG + (size_t)MP * 192 * 2;
constexpr size_t OFF_BON = OFF_DTA + (size_t)MP * 64 * 4;
constexpr size_t WS_TOTAL = OFF_BON + (size_t)MP * 16 * 4;
static_assert(WS_TOTAL <= (size_t)1 << 30, "workspace too large");

constexpr size_t O_YP = 0;
constexpr size_t O_YS = O_YP + (size_t)4 * 2048 * 2048;
constexpr size_t O_HGP = O_YS + (size_t)128 * 4 * 2048;
constexpr size_t O_HGS = O_HGP + (size_t)4 * 8 * 128 * 128;
constexpr size_t O_RTP = O_HGS + (size_t)128 * 8 * 128 * 128;
constexpr size_t O_RTS = O_RTP + (size_t)4 * 4 * 128 * 256;
constexpr size_t O_SSP = O_RTS + (size_t)128 * 4 * 128 * 256;
constexpr size_t O_SSS = O_SSP + (size_t)4 * 16 * 128 * 64;
constexpr size_t O_CVP = O_SSS + (size_t)128 * 16 * 128 * 64;
constexpr size_t O_CVS = O_CVP + (size_t)4 * 3 * 1536;
constexpr size_t O_WKP = O_CVS + (size_t)128 * 3 * 1536;
constexpr size_t O_WKS = O_WKP + (size_t)4 * 16 * 64 * 64;
constexpr size_t O_SHP = O_WKS + (size_t)128 * 16 * 64 * 64;
constexpr size_t O_SHS = O_SHP + (size_t)4 * 3360;

struct Params {
  const float* in[38];
  float* out;
  char* ws;
};
enum { I_XP = 0, I_XS, I_SHG, I_SRT, I_SSM, I_SCV, I_SWK, I_SSH, I_META, I_LNG, I_LNB, I_EWIN, I_LBL, I_HNG, I_EWOUT,
       I_OWIN, I_CVW, I_CVB, I_DTB, I_ALOG, I_DSK, I_SNG, I_MU, I_W0, I_W2, I_A0, I_A2, I_G2, I_KK, I_KA, I_RK,
       I_LXG, I_LXB, I_OWOUT, I_WQ, I_KEYS, I_PU, I_PV };

constexpr int SMEM_BYTES = 2 * 16 * 336 * 4 + 2 * 16 * 32 * 4;

DEVI u16 f2bf(float f) {
  unsigned u = __float_as_uint(f);
  u += 0x7fffu + ((u >> 16) & 1u);
  return (u16)(u >> 16);
}
DEVI unsigned pack2(float a, float b) { return (unsigned)f2bf(a) | ((unsigned)f2bf(b) << 16); }
DEVI float bflo(unsigned u) { return __uint_as_float(u << 16); }
DEVI float bfhi(unsigned u) { return __uint_as_float(u & 0xffff0000u); }
DEVI float sigmoidf_(float x) { return 1.0f / (1.0f + expf(-x)); }
DEVI float siluf_(float x) { return x / (1.0f + expf(-x)); }
DEVI float softplusf_(float x) { return fmaxf(x, 0.0f) + log1pf(expf(-fabsf(x))); }
DEVI float wsum(float v) {
#pragma unroll
  for (int o = 32; o > 0; o >>= 1) v += __shfl_xor(v, o, 64);
  return v;
}
DEVI float wmaxf_(float v) {
#pragma unroll
  for (int o = 32; o > 0; o >>= 1) v = fmaxf(v, __shfl_xor(v, o, 64));
  return v;
}
DEVI int wmini_(int v) {
#pragma unroll
  for (int o = 32; o > 0; o >>= 1) v = min(v, __shfl_xor(v, o, 64));
  return v;
}
template <int CTRL>
DEVI float dppf(float v) {
  return __int_as_float(__builtin_amdgcn_update_dpp(0, __float_as_int(v), CTRL, 0xF, 0xF, true));
}
DEVI float red8(float v) {
  v += dppf<0xB1>(v);
  v += dppf<0x4E>(v);
  v += dppf<0x141>(v);
  return v;
}
DEVI float red16(float v) {
  v = red8(v);
  v += dppf<0x140>(v);
  return v;
}
DEVI int row_pos(int row) { return row < MPR ? (row % TP) : (16384 + ((row - MPR) & 3)); }

DEVI void conv_bf16_flat(const float* __restrict__ src, u16* __restrict__ dst, size_t n4) {
  size_t stride = (size_t)gridDim.x * blockDim.x;
  for (size_t i = (size_t)blockIdx.x * blockDim.x + threadIdx.x; i < n4; i += stride) {
    float4 v = ((const float4*)src)[i];
    uint2 o;
    o.x = pack2(v.x, v.y);
    o.y = pack2(v.z, v.w);
    ((uint2*)dst)[i] = o;
  }
}

template <int MODE>
DEVI int colmap(int j) {
  if (MODE == 0) return j;
  if (MODE == 1) {
    if (j < 4096 || j >= 5120) return j;
    int hb = j & ~127, c = j & 127, span = c >> 6, p = c & 63;
    int d = (p < 32) ? (span * 32 + p) : (64 + span * 32 + (p - 32));
    return hb + d;
  }
  if (j < 2560) return j;
  if (j < 5920) return j + 16;
  if (j < 5936) return 2560 + (j - 5920);
  return -1;
}

template <int MODE>
DEVI void transpose_job(const float* __restrict__ src, int ldsrc, int Ksrc, u16* __restrict__ dst, int Kdst, int ndst,
                        float* smem) {
  int ktiles = Kdst / 64, ntiles = ndst / 64;
  int tid = threadIdx.x;
  for (int tile = blockIdx.x; tile < ktiles * ntiles; tile += gridDim.x) {
    int tn = tile / ktiles, tk = tile % ktiles;
    int j0 = tn * 64, k0 = tk * 64;
    int jj = tid & 63;
    int sc = colmap<MODE>(j0 + jj);
#pragma unroll
    for (int i = 0; i < 16; ++i) {
      int kk = i * 4 + (tid >> 6);
      float v = 0.f;
      if (sc >= 0 && (k0 + kk) < Ksrc) v = src[(size_t)(k0 + kk) * ldsrc + sc];
      smem[kk * 65 + jj] = v;
    }
    __syncthreads();
    int jr = tid >> 2, kq = (tid & 3) * 16;
    unsigned pk[8];
#pragma unroll
    for (int e = 0; e < 8; ++e) pk[e] = pack2(smem[(kq + 2 * e) * 65 + jr], smem[(kq + 2 * e + 1) * 65 + jr]);
    uint4* dp = (uint4*)(dst + (size_t)(j0 + jr) * Kdst + k0 + kq);
    dp[0] = make_uint4(pk[0], pk[1], pk[2], pk[3]);
    dp[1] = make_uint4(pk[4], pk[5], pk[6], pk[7]);
    __syncthreads();
  }
}

DEVI void phase0(const Params& p, float* smem) {
  char* ws = p.ws;
  conv_bf16_flat(p.in[I_PU], (u16*)(ws + OFF_UB), (size_t)16384 * 2048 / 4);
  conv_bf16_flat(p.in[I_PV], (u16*)(ws + OFF_VB), (size_t)16384 * 2048 / 4);
  conv_bf16_flat(p.in[I_KEYS], (u16*)(ws + OFF_KEY0), (size_t)16 * 128 * 128 / 4);
  conv_bf16_flat(p.in[I_KEYS] + (size_t)16 * 128 * 128, (u16*)(ws + OFF_KEY1), (size_t)16 * 128 * 128 / 4);
  transpose_job<1>(p.in[I_EWIN], N0, 2048, (u16*)(ws + OFF_WIN0), 2048, N0, smem);
  transpose_job<0>(p.in[I_EWOUT], 2048, 2048, (u16*)(ws + OFF_WOUT0), 2048, 2048, smem);
  transpose_job<0>(p.in[I_WQ], 2048, 2048, (u16*)(ws + OFF_WQ0), 2048, 2048, smem);
  transpose_job<0>(p.in[I_WQ] + (size_t)2048 * 2048, 2048, 2048, (u16*)(ws + OFF_WQ1), 2048, 2048, smem);
  transpose_job<2>(p.in[I_OWIN], 5936, 2048, (u16*)(ws + OFF_WIN1), 2048, N1, smem);
  transpose_job<0>(p.in[I_OWOUT], 2048, 2048, (u16*)(ws + OFF_WOUT1), 2048, 2048, smem);
  transpose_job<0>(p.in[I_W2], 1024, 64, (u16*)(ws + OFF_W2T), 64, 1024, smem);
  transpose_job<0>(p.in[I_A2], 1024, 64, (u16*)(ws + OFF_A2T), 64, 1024, smem);
  transpose_job<0>(p.in[I_G2], 1024, 160, (u16*)(ws + OFF_G2T), 192, 1024, smem);
  {
    float* XF = (float*)(ws + OFF_XF);
    u16* XB = (u16*)(ws + OFF_XB);
    size_t n4 = (size_t)MP * 512;
    size_t stride = (size_t)gridDim.x * blockDim.x;
    for (size_t i = (size_t)blockIdx.x * blockDim.x + threadIdx.x; i < n4; i += stride) {
      int row = (int)(i >> 9), c4 = (int)(i & 511);
      float4 v = make_float4(0.f, 0.f, 0.f, 0.f);
      if (row < MPR) {
        int b = row / TP, t = row % TP;
        const float* s = (t < 16) ? (p.in[I_META] + (size_t)t * D) : (p.in[I_XP] + ((size_t)b * 2048 + (t - 16)) * D);
        v = ((const float4*)s)[c4];
      } else if (row < M) {
        v = ((const float4*)(p.in[I_XS] + (size_t)(row - MPR) * D))[c4];
      }
      ((float4*)XF)[i] = v;
      uint2 o;
      o.x = pack2(v.x, v.y);
      o.y = pack2(v.z, v.w);
      ((uint2*)XB)[i] = o;
    }
  }
  if (blockIdx.x == 0) {
    float* LB = (float*)(ws + OFF_LB);
    const float* lg = p.in[I_LBL];
    for (int c = threadIdx.x; c < 1024; c += blockDim.x) {
      float a = lg[c], b = lg[1024 + c], d = lg[2048 + c];
      float m = fmaxf(a, fmaxf(b, d));
      float ea = expf(a - m), eb = expf(b - m), ed = expf(d - m);
      LB[c] = ea / (ea + eb + ed);
    }
    double* IR = (double*)(ws + OFF_INVREV);
    if (threadIdx.x < 64) {
      double d = (double)threadIdx.x;
      IR[threadIdx.x] = exp(-d * (9.210340371976184 / 64.0)) * 0.15915494309189535;
    }
  }
}

constexpr int G_LDS_STRIDE = 72;
template <class Epi>
DEVI void gemm_phase(const u16* __restrict__ A, int lda, int a_ntile_off, const u16* __restrict__ Bt, int K, int mtiles,
                     int ntiles, char* smem, Epi epi) {
  u16* SA = (u16*)smem;
  u16* SB = SA + 128 * G_LDS_STRIDE;
  const int tid = threadIdx.x, wid = tid >> 6, lane = tid & 63, wr = wid >> 1, wc = wid & 1, fr = lane & 15, fq = lane >> 4;
  const int ntot = mtiles * ntiles;
  const int nk = K / 64;
  for (int tile = blockIdx.x; tile < ntot; tile += gridDim.x) {
    int tm = tile / ntiles, tn = tile % ntiles;
    int brow = tm * 128, bcol = tn * 128;
    const u16* Ag = A + (size_t)brow * lda + (size_t)tn * a_ntile_off;
    const u16* Bg = Bt + (size_t)bcol * K;
    f32x4 acc[4][4];
#pragma unroll
    for (int m = 0; m < 4; ++m)
#pragma unroll
      for (int n = 0; n < 4; ++n) acc[m][n] = f32x4{0.f, 0.f, 0.f, 0.f};
    u32x4 ra[4], rb[4];
#pragma unroll
    for (int i = 0; i < 4; ++i) {
      int ch = tid + i * 256, r = ch >> 3, kc = ch & 7;
      ra[i] = *(const u32x4*)(Ag + (size_t)r * lda + kc * 8);
      rb[i] = *(const u32x4*)(Bg + (size_t)r * K + kc * 8);
    }
    for (int t = 0; t < nk; ++t) {
#pragma unroll
      for (int i = 0; i < 4; ++i) {
        int ch = tid + i * 256, r = ch >> 3, kc = ch & 7;
        *(u32x4*)(SA + r * G_LDS_STRIDE + kc * 8) = ra[i];
        *(u32x4*)(SB + r * G_LDS_STRIDE + kc * 8) = rb[i];
      }
      __syncthreads();
      if (t + 1 < nk) {
#pragma unroll
        for (int i = 0; i < 4; ++i) {
          int ch = tid + i * 256, r = ch >> 3, kc = ch & 7;
          ra[i] = *(const u32x4*)(Ag + (size_t)r * lda + (t + 1) * 64 + kc * 8);
          rb[i] = *(const u32x4*)(Bg + (size_t)r * K + (t + 1) * 64 + kc * 8);
        }
      }
#pragma unroll
      for (int kh = 0; kh < 2; ++kh) {
        bf16x8 At[4], Bl[4];
#pragma unroll
        for (int m = 0; m < 4; ++m)
          At[m] = *(const bf16x8*)(SA + (wr * 64 + m * 16 + fr) * G_LDS_STRIDE + kh * 32 + fq * 8);
#pragma unroll
        for (int n = 0; n < 4; ++n)
          Bl[n] = *(const bf16x8*)(SB + (wc * 64 + n * 16 + fr) * G_LDS_STRIDE + kh * 32 + fq * 8);
#pragma unroll
        for (int m = 0; m < 4; ++m)
#pragma unroll
          for (int n = 0; n < 4; ++n) acc[m][n] = __builtin_amdgcn_mfma_f32_16x16x32_bf16(At[m], Bl[n], acc[m][n], 0, 0, 0);
      }
      __syncthreads();
    }
#pragma unroll
    for (int m = 0; m < 4; ++m)
#pragma unroll
      for (int n = 0; n < 2; ++n)
#pragma unroll
        for (int j = 0; j < 4; ++j) {
          int row = brow + wr * 64 + m * 16 + fq * 4 + j;
          int col = bcol + wc * 64 + n * 16 + fr;
          epi(row, col, acc[m][n][j], acc[m][n + 2][j]);
        }
  }
}

struct Seg {
  int off;
  int ld;
  int n4;
};

template <int NS, int NF4, int RG>
DEVI void stage_init(const float* wsf, const Seg (&sg)[NS], int row0, int tid, const float* (&ptr)[RG], int (&ldv)[RG]) {
  asm volatile("" : "+v"(tid));
#pragma unroll
  for (int q = 0; q < RG; ++q) {
    int flat = tid + q * 256;
    int t = flat / NF4, f = flat % NF4;
    if (flat >= 16 * NF4) { t = 0; f = 0; }
    int off = 0, ld = 0, ff = f;
    bool done = false;
#pragma unroll
    for (int s = 0; s < NS; ++s) {
      bool here = (!done) && (ff < sg[s].n4);
      off = here ? (sg[s].off + (row0 + t) * sg[s].ld + ff * 4) : off;
      ld = here ? sg[s].ld : ld;
      ff = (done || here) ? ff : (ff - sg[s].n4);
      done = done || here;
    }
    ptr[q] = wsf + off;
    ldv[q] = ld;
  }
}
template <int NF4, int RG>
DEVI void stage_issue(const float* const (&ptr)[RG], const int (&ldv)[RG], int st, int nsteps, int tid, f32x4 (&rg)[RG]) {
#pragma unroll
  for (int q = 0; q < RG; ++q) {
    int flat = tid + q * 256;
    if (flat < nsteps * NF4) rg[q] = *(const f32x4*)(ptr[q] + (st * 16) * ldv[q]);
  }
}
template <int NF4, int RG>
DEVI void stage_commit(float* buf, int nsteps, int tid, const f32x4 (&rg)[RG]) {
#pragma unroll
  for (int q = 0; q < RG; ++q) {
    int flat = tid + q * 256;
    if (flat < nsteps * NF4) ((f32x4*)buf)[flat] = rg[q];
  }
}

template <int MODE>
DEVI void colrec_long(const float* wsf, const Seg (&sg)[4], int row0, int T, float gamma, float* outp, int ldo, float* stout, int st_ld,
                      float* smem) {
  constexpr int NF4 = 73, W = 292, RG = 5;
  const int tid = threadIdx.x, w = tid >> 6, lane = tid & 63, c = lane >> 3, s = lane & 7;
  float S[16];
#pragma unroll
  for (int i = 0; i < 16; ++i) S[i] = 0.f;
  float* buf0 = smem;
  float* buf1 = smem + 16 * 336;
  float* obuf = smem + 2 * 16 * 336;
  const int nst = (T + 15) / 16;
  f32x4 rg[RG];
  const float* sptr[RG];
  int sld[RG];
  stage_init<4, NF4, RG>(wsf, sg, row0, tid, sptr, sld);
  stage_issue<NF4, RG>(sptr, sld, 0, min(16, T), tid, rg);
  stage_commit<NF4, RG>(buf0, min(16, T), tid, rg);
  __syncthreads();
#pragma unroll 1
  for (int st = 0; st < nst; ++st) {
    const int nthis = min(16, T - st * 16);
    const int nnext = min(16, T - (st + 1) * 16);
    if (st + 1 < nst) stage_issue<NF4, RG>(sptr, sld, st + 1, nnext, tid, rg);
    const float* b = (st & 1) ? buf1 : buf0;
    float* ob = obuf + (st & 1) * 512;
#pragma unroll 1
    for (int tt = 0; tt < nthis; ++tt) {
      const float* sp = b + tt * W;
      float a[16], q[16];
#pragma unroll
      for (int i = 0; i < 4; ++i) {
        float4 av = *(const float4*)(sp + s * 16 + i * 4);
        float4 qv = *(const float4*)(sp + 128 + s * 16 + i * 4);
        a[i * 4 + 0] = av.x; a[i * 4 + 1] = av.y; a[i * 4 + 2] = av.z; a[i * 4 + 3] = av.w;
        q[i * 4 + 0] = qv.x; q[i * 4 + 1] = qv.y; q[i * 4 + 2] = qv.z; q[i * 4 + 3] = qv.w;
      }
      float val = sp[256 + w * 8 + c];
      float dA = gamma;
      if (MODE == 2) {
        val *= sp[288];
        dA = sp[289];
      }
      float o = 0.f;
#pragma unroll
      for (int i = 0; i < 16; ++i) {
        if (MODE == 0) S[i] = val + a[i] * (S[i] - val);
        else S[i] = dA * S[i] + a[i] * val;
        o += q[i] * S[i];
      }
      o = red8(o);
      if (s == 0) ob[tt * 32 + w * 8 + c] = o;
    }
    if (st + 1 < nst) stage_commit<NF4, RG>((st & 1) ? buf0 : buf1, nnext, tid, rg);
    __syncthreads();
    if (tid < nthis * 8) {
      int t = tid >> 3, c4 = tid & 7;
      *(float4*)(outp + (size_t)(st * 16 + t) * ldo + c4 * 4) = *(const float4*)(ob + t * 32 + c4 * 4);
    }
  }
#pragma unroll
  for (int i = 0; i < 16; ++i) stout[(size_t)(s * 16 + i) * st_ld + w * 8 + c] = S[i];
  __syncthreads();
}

template <int MODE>
DEVI void colrec_short(const float* pa, int lda_, const float* pq, int ldq, const float* pc, int ldc, const float* pdt,
                       long row0, float gamma, const float* stin, float* stout, int st_ld, float* outp, int ldo,
                       float* smem) {
  const int tid = threadIdx.x, lane = tid & 63;
  const int wid = __builtin_amdgcn_readfirstlane(tid >> 6);
  const int k0 = wid * 32;
  float S[32];
#pragma unroll
  for (int i = 0; i < 32; ++i) S[i] = stin[(size_t)(k0 + i) * st_ld + lane];
#pragma unroll 1
  for (int t = 0; t < 4; ++t) {
    long row = row0 + t;
    float val = pc[(size_t)row * ldc + lane];
    float dA = gamma;
    if (MODE == 2) {
      val *= pdt[(size_t)row * 64];
      dA = pdt[(size_t)row * 64 + 1];
    }
    const float4* ap = (const float4*)(pa + (size_t)row * lda_ + k0);
    const float4* qp = (const float4*)(pq + (size_t)row * ldq + k0);
    float o = 0.f;
#pragma unroll
    for (int i4 = 0; i4 < 8; ++i4) {
      float4 av = ap[i4], qv = qp[i4];
      float a[4] = {av.x, av.y, av.z, av.w};
      float q[4] = {qv.x, qv.y, qv.z, qv.w};
#pragma unroll
      for (int e = 0; e < 4; ++e) {
        int i = i4 * 4 + e;
        if (MODE == 0) S[i] = val + a[e] * (S[i] - val);
        else S[i] = dA * S[i] + a[e] * val;
        o += q[e] * S[i];
      }
    }
    smem[(wid * 4 + t) * 64 + lane] = o;
  }
#pragma unroll
  for (int i = 0; i < 32; ++i) stout[(size_t)(k0 + i) * st_ld + lane] = S[i];
  __syncthreads();
  {
    int t = tid >> 6;
    float sum = smem[(0 * 4 + t) * 64 + lane] + smem[(1 * 4 + t) * 64 + lane] + smem[(2 * 4 + t) * 64 + lane] +
                smem[(3 * 4 + t) * 64 + lane];
    outp[(size_t)(row0 + t) * ldo + lane] = sum;
  }
  __syncthreads();
}

DEVI void rwkv_item(const float* wsf, const Seg (&sg)[6], int row0, int T, const float* stin, float* stout, float* outp, int ldo,
                    float* smem) {
  constexpr int NF4 = 84, W = 336, RG = 6;
  const int tid = threadIdx.x, w = tid >> 6, lane = tid & 63, rl = lane >> 4, sl = lane & 15;
  const int il = w * 4 + rl;
  float S[4];
  if (stin) {
    float4 v = *(const float4*)(stin + il * 64 + sl * 4);
    S[0] = v.x; S[1] = v.y; S[2] = v.z; S[3] = v.w;
  } else {
    S[0] = S[1] = S[2] = S[3] = 0.f;
  }
  float* buf0 = smem;
  float* buf1 = smem + 16 * 336;
  float* obuf = smem + 2 * 16 * 336;
  const int nst = (T + 15) / 16;
  f32x4 rg[RG];
  const float* sptr[RG];
  int sld[RG];
  stage_init<6, NF4, RG>(wsf, sg, row0, tid, sptr, sld);
  stage_issue<NF4, RG>(sptr, sld, 0, min(16, T), tid, rg);
  stage_commit<NF4, RG>(buf0, min(16, T), tid, rg);
  __syncthreads();
#pragma unroll 1
  for (int st = 0; st < nst; ++st) {
    const int nthis = min(16, T - st * 16);
    const int nnext = min(16, T - (st + 1) * 16);
    if (st + 1 < nst) stage_issue<NF4, RG>(sptr, sld, st + 1, nnext, tid, rg);
    const float* b = (st & 1) ? buf1 : buf0;
    float* ob = obuf + (st & 1) * 512;
#pragma unroll 1
    for (int tt = 0; tt < nthis; ++tt) {
      const float* sp = b + tt * W;
      float4 r4 = *(const float4*)(sp + sl * 4);
      float4 w4 = *(const float4*)(sp + 64 + sl * 4);
      float4 k4 = *(const float4*)(sp + 128 + sl * 4);
      float4 n4 = *(const float4*)(sp + 192 + sl * 4);
      float4 m4 = *(const float4*)(sp + 256 + sl * 4);
      float vi = sp[320 + il];
      float sa = S[0] * n4.x + S[1] * n4.y + S[2] * n4.z + S[3] * n4.w;
      sa = -red16(sa);
      S[0] = S[0] * w4.x + sa * m4.x + vi * k4.x;
      S[1] = S[1] * w4.y + sa * m4.y + vi * k4.y;
      S[2] = S[2] * w4.z + sa * m4.z + vi * k4.z;
      S[3] = S[3] * w4.w + sa * m4.w + vi * k4.w;
      float y = S[0] * r4.x + S[1] * r4.y + S[2] * r4.z + S[3] * r4.w;
      y = red16(y);
      if (sl == 0) ob[tt * 16 + il] = y;
    }
    if (st + 1 < nst) stage_commit<NF4, RG>((st & 1) ? buf0 : buf1, nnext, tid, rg);
    __syncthreads();
    if (tid < nthis * 4) {
      int t = tid >> 2, c4 = tid & 3;
      *(float4*)(outp + (size_t)(st * 16 + t) * ldo + c4 * 4) = *(const float4*)(ob + t * 16 + c4 * 4);
    }
  }
  *(float4*)(stout + il * 64 + sl * 4) = make_float4(S[0], S[1], S[2], S[3]);
  __syncthreads();
}

DEVI void phase_rec0(const Params& p, float* smem) {
  char* ws = p.ws;
  const float* PROJ = (const float*)(ws + OFF_PROJ);
  float* OMIX = (float*)(ws + OFF_OMIX);
  const float* wsf = (const float*)ws;
  constexpr int PO = (int)(OFF_PROJ / 4);
  for (int item = blockIdx.x; item < 4352; item += gridDim.x) {
    if (item < 128) {
      int b = item >> 5, h = (item >> 2) & 7, cb = item & 3;
      Seg sg[4] = {{PO + 1024 + h * 128, N0, 32}, {PO + h * 128, N0, 32}, {PO + 2048 + h * 128 + cb * 32, N0, 8},
                   {PO, N0, 1}};
      int row0 = b * TP;
      colrec_long<0>(wsf, sg, row0, TP, 0.f, OMIX + (size_t)row0 * 2048 + h * 128 + cb * 32, 2048,
                     p.out + O_HGP + (size_t)(b * 8 + h) * 128 * 128 + cb * 32, 128, smem);
    } else if (item < 256) {
      int it = item - 128;
      int b = it >> 5, h = (it >> 3) & 3, cb = it & 7;
      Seg sg[4] = {{PO + 4608 + h * 128, N0, 32}, {PO + 4096 + h * 128, N0, 32},
                   {PO + 5120 + h * 256 + cb * 32, N0, 8}, {PO, N0, 1}};
      int row0 = b * TP;
      float gamma = 1.0f - exp2f(-5.0f - (float)h);
      colrec_long<1>(wsf, sg, row0, TP, gamma, OMIX + (size_t)row0 * 2048 + 1024 + h * 256 + cb * 32, 2048,
                     p.out + O_RTP + (size_t)(b * 4 + h) * 128 * 256 + cb * 32, 256, smem);
    } else if (item < 2304) {
      int it = item - 256;
      int b = it >> 4, h = (it >> 1) & 7, cb = it & 1;
      long row0 = MPR + (long)b * 4;
      size_t so = (size_t)(b * 8 + h) * 128 * 128 + cb * 64;
      colrec_short<0>(PROJ + 1024 + h * 128, N0, PROJ + h * 128, N0, PROJ + 2048 + h * 128 + cb * 64, N0, nullptr, row0,
                      0.f, p.in[I_SHG] + so, p.out + O_HGS + so, 128, OMIX + h * 128 + cb * 64, 2048, smem);
    } else {
      int it = item - 2304;
      int b = it >> 4, h = (it >> 2) & 3, cb = it & 3;
      long row0 = MPR + (long)b * 4;
      size_t so = (size_t)(b * 4 + h) * 128 * 256 + cb * 64;
      float gamma = 1.0f - exp2f(-5.0f - (float)h);
      colrec_short<1>(PROJ + 4608 + h * 128, N0, PROJ + 4096 + h * 128, N0, PROJ + 5120 + h * 256 + cb * 64, N0, nullptr,
                      row0, gamma, p.in[I_SRT] + so, p.out + O_RTS + so, 256, OMIX + 1024 + h * 256 + cb * 64, 2048,
                      smem);
    }
  }
}

DEVI void phase_post0(const Params& p) {
  char* ws = p.ws;
  const float* PROJ = (const float*)(ws + OFF_PROJ);
  const float* OMIX = (const float*)(ws + OFF_OMIX);
  u16* MIXB = (u16*)(ws + OFF_MIXB);
  const float* ng = p.in[I_HNG];
  const int lane = threadIdx.x & 63;
  const int gw = blockIdx.x * 4 + (threadIdx.x >> 6), nw = gridDim.x * 4;
  for (int row = gw; row < M; row += nw) {
    const float* o = OMIX + (size_t)row * 2048;
    const float* pr = PROJ + (size_t)row * N0;
    u16* mo = MIXB + (size_t)row * 2048;
#pragma unroll 2
    for (int h = 0; h < 8; ++h) {
      float a0 = o[h * 128 + lane], a1 = o[h * 128 + 64 + lane];
      float ss = wsum(a0 * a0 + a1 * a1);
      float inv = rsqrtf(ss * (1.0f / 128.0f) + 1e-6f);
      mo[h * 128 + lane] = f2bf(a0 * inv * ng[lane] * pr[3072 + h * 128 + lane]);
      mo[h * 128 + 64 + lane] = f2bf(a1 * inv * ng[64 + lane] * pr[3072 + h * 128 + 64 + lane]);
    }
#pragma unroll 2
    for (int h = 0; h < 4; ++h) {
      float a[4];
      float s = 0.f;
#pragma unroll
      for (int i = 0; i < 4; ++i) {
        a[i] = o[1024 + h * 256 + i * 64 + lane];
        s += a[i];
      }
      float mu = wsum(s) * (1.0f / 256.0f);
      float v = 0.f;
#pragma unroll
      for (int i = 0; i < 4; ++i) {
        a[i] -= mu;
        v += a[i] * a[i];
      }
      float inv = rsqrtf(wsum(v) * (1.0f / 256.0f) + 1e-5f);
#pragma unroll
      for (int i = 0; i < 4; ++i)
        mo[1024 + h * 256 + i * 64 + lane] = f2bf(a[i] * inv * pr[6144 + h * 256 + i * 64 + lane]);
    }
  }
}

DEVI void phase_ln(const Params& p, const float* addsrc, const float* g, const float* bta) {
  char* ws = p.ws;
  float* XF = (float*)(ws + OFF_XF);
  u16* XB = (u16*)(ws + OFF_XB);
  const int lane = threadIdx.x & 63;
  const int gw = blockIdx.x * 4 + (threadIdx.x >> 6), nw = gridDim.x * 4;
  for (int row = gw; row < M; row += nw) {
    float4* xr = (float4*)(XF + (size_t)row * 2048);
    const float4* ar = (const float4*)(addsrc + (size_t)row * 2048);
    float v[32];
    float s = 0.f;
#pragma unroll
    for (int i = 0; i < 8; ++i) {
      float4 x = xr[i * 64 + lane], a = ar[i * 64 + lane];
      v[i * 4 + 0] = ALPHA * x.x + a.x;
      v[i * 4 + 1] = ALPHA * x.y + a.y;
      v[i * 4 + 2] = ALPHA * x.z + a.z;
      v[i * 4 + 3] = ALPHA * x.w + a.w;
      s += v[i * 4 + 0] + v[i * 4 + 1] + v[i * 4 + 2] + v[i * 4 + 3];
    }
    float mu = wsum(s) * (1.0f / 2048.0f);
    float q = 0.f;
#pragma unroll
    for (int i = 0; i < 32; ++i) {
      v[i] -= mu;
      q += v[i] * v[i];
    }
    float inv = rsqrtf(wsum(q) * (1.0f / 2048.0f) + 1e-5f);
#pragma unroll
    for (int i = 0; i < 8; ++i) {
      float4 gg = ((const float4*)g)[i * 64 + lane], bb = ((const float4*)bta)[i * 64 + lane];
      float4 y;
      y.x = v[i * 4 + 0] * inv * gg.x + bb.x;
      y.y = v[i * 4 + 1] * inv * gg.y + bb.y;
      y.z = v[i * 4 + 2] * inv * gg.z + bb.z;
      y.w = v[i * 4 + 3] * inv * gg.w + bb.w;
      xr[i * 64 + lane] = y;
      uint2 o;
      o.x = pack2(y.x, y.y);
      o.y = pack2(y.z, y.w);
      ((uint2*)(XB + (size_t)row * 2048))[i * 64 + lane] = o;
    }
  }
}

DEVI float dot8(uint4 w, const float* x) {
  float d = bflo(w.x) * x[0];
  d += bfhi(w.x) * x[1];
  d += bflo(w.y) * x[2];
  d += bfhi(w.y) * x[3];
  d += bflo(w.z) * x[4];
  d += bfhi(w.z) * x[5];
  d += bflo(w.w) * x[6];
  d += bfhi(w.w) * x[7];
  return d;
}
DEVI void fma8(uint4 w, float c, float* o) {
  o[0] += c * bflo(w.x);
  o[1] += c * bfhi(w.x);
  o[2] += c * bflo(w.y);
  o[3] += c * bfhi(w.y);
  o[4] += c * bflo(w.z);
  o[5] += c * bfhi(w.z);
  o[6] += c * bflo(w.w);
  o[7] += c * bfhi(w.w);
}

DEVI void phase_peer(const Params& p, int layer, bool final_out) {
  char* ws = p.ws;
  const float* SC = (const float*)(ws + OFF_GOUT);
  float* XF = (float*)(ws + OFF_XF);
  u16* XB = (u16*)(ws + OFF_XB);
  const u16* UB = (const u16*)(ws + OFF_UB);
  const u16* VB = (const u16*)(ws + OFF_VB);
  const float* g = p.in[I_LNG] + (size_t)(layer * 2 + 1) * D;
  const float* bta = p.in[I_LNB] + (size_t)(layer * 2 + 1) * D;
  const int lane = threadIdx.x & 63;
  const int gw = blockIdx.x * 4 + (threadIdx.x >> 6), nw = gridDim.x * 4;
  for (int row = gw; row < M; row += nw) {
    const float* sr = SC + (size_t)row * 2048;
    int eidx0 = 0, eidx1 = 0;
    float gate0 = 0.f, gate1 = 0.f;
    for (int h = 0; h < 8; ++h) {
      float ts0 = 0.f, ts1 = 0.f;
      int ti0 = 0, ti1 = 0;
#pragma unroll
      for (int c = 0; c < 2; ++c) {
        const float* sp = sr + (h * 2 + c) * 128;
        float a = sp[lane], b2 = sp[lane + 64];
        float myts = 0.f;
        int myti = 0;
        for (int r = 0; r < 16; ++r) {
          float m = fmaxf(a, b2);
          float wm = wmaxf_(m);
          int cand = (a == wm) ? lane : ((b2 == wm) ? (lane + 64) : (1 << 20));
          int wi = wmini_(cand);
          if (lane == r) {
            myts = wm;
            myti = wi;
          }
          if (wi == lane) a = -INFINITY;
          else if (wi == lane + 64) b2 = -INFINITY;
        }
        if (c == 0) {
          ts0 = myts;
          ti0 = myti;
        } else {
          ts1 = myts;
          ti1 = myti;
        }
      }
      float s0 = __shfl(ts0, lane >> 2, 64);
      int jb = (lane & 3) * 4;
      float c0 = s0 + __shfl(ts1, jb + 0, 64);
      float c1 = s0 + __shfl(ts1, jb + 1, 64);
      float c2 = s0 + __shfl(ts1, jb + 2, 64);
      float c3 = s0 + __shfl(ts1, jb + 3, 64);
      float bs = 0.f;
      int bf = 0;
      for (int r = 0; r < 16; ++r) {
        float m = c0;
        int mq = 0;
        if (c1 > m) { m = c1; mq = 1; }
        if (c2 > m) { m = c2; mq = 2; }
        if (c3 > m) { m = c3; mq = 3; }
        float wm = wmaxf_(m);
        int cand = (m == wm) ? (lane * 4 + mq) : (1 << 20);
        int wf = wmini_(cand);
        if (lane == r) {
          bs = wm;
          bf = wf;
        }
        if ((wf >> 2) == lane) {
          int q = wf & 3;
          if (q == 0) c0 = -INFINITY;
          else if (q == 1) c1 = -INFINITY;
          else if (q == 2) c2 = -INFINITY;
          else c3 = -INFINITY;
        }
      }
      int e = __shfl(ti0, (bf >> 4) & 15, 64) * 128 + __shfl(ti1, bf & 15, 64);
      float mx = __shfl(bs, 0, 64);
      float ev = (lane < 16) ? expf(bs - mx) : 0.f;
      float sm = wsum(ev);
      float gt = ev / sm;
      int e_b = __shfl(e, lane & 15, 64);
      float g_b = __shfl(gt, lane & 15, 64);
      if ((lane >> 4) == (h & 3)) {
        if (h < 4) {
          eidx0 = e_b;
          gate0 = g_b;
        } else {
          eidx1 = e_b;
          gate1 = g_b;
        }
      }
    }
    float xf[32];
    {
      const uint4* xr = (const uint4*)(XB + (size_t)row * 2048);
#pragma unroll
      for (int j = 0; j < 4; ++j) {
        uint4 w = xr[j * 64 + lane];
        xf[j * 8 + 0] = bflo(w.x); xf[j * 8 + 1] = bfhi(w.x);
        xf[j * 8 + 2] = bflo(w.y); xf[j * 8 + 3] = bfhi(w.y);
        xf[j * 8 + 4] = bflo(w.z); xf[j * 8 + 5] = bfhi(w.z);
        xf[j * 8 + 6] = bflo(w.w); xf[j * 8 + 7] = bfhi(w.w);
      }
    }
    float coef0 = 0.f, coef1 = 0.f;
#pragma unroll 1
    for (int half = 0; half < 2; ++half) {
      int eid = half ? eidx1 : eidx0;
      float gat = half ? gate1 : gate0;
      float coef = 0.f;
#pragma unroll 1
      for (int p0 = 0; p0 < 64; p0 += 4) {
        uint4 w[4][4];
#pragma unroll
        for (int u = 0; u < 4; ++u) {
          int e = __builtin_amdgcn_readlane(eid, p0 + u);
          const uint4* ur = (const uint4*)(UB + (size_t)e * 2048);
#pragma unroll
          for (int j = 0; j < 4; ++j) w[u][j] = ur[j * 64 + lane];
        }
        float d[4];
#pragma unroll
        for (int u = 0; u < 4; ++u) {
          d[u] = dot8(w[u][0], xf) + dot8(w[u][1], xf + 8) + dot8(w[u][2], xf + 16) + dot8(w[u][3], xf + 24);
        }
#pragma unroll
        for (int o = 32; o > 0; o >>= 1) {
#pragma unroll
          for (int u = 0; u < 4; ++u) d[u] += __shfl_xor(d[u], o, 64);
        }
#pragma unroll
        for (int u = 0; u < 4; ++u) {
          float gt = __int_as_float(__builtin_amdgcn_readlane(__float_as_int(gat), p0 + u));
          float act = 0.5f * d[u] * (1.0f + erff(d[u] * 0.70710678118f)) * gt;
          if (lane == p0 + u) coef = act;
        }
      }
      if (half) coef1 = coef;
      else coef0 = coef;
    }
    float o[32];
#pragma unroll
    for (int i = 0; i < 32; ++i) o[i] = 0.f;
#pragma unroll 1
    for (int half = 0; half < 2; ++half) {
      int eid = half ? eidx1 : eidx0;
      float cf = half ? coef1 : coef0;
#pragma unroll 1
      for (int p0 = 0; p0 < 64; p0 += 4) {
        uint4 w[4][4];
#pragma unroll
        for (int u = 0; u < 4; ++u) {
          int e = __builtin_amdgcn_readlane(eid, p0 + u);
          const uint4* vr = (const uint4*)(VB + (size_t)e * 2048);
#pragma unroll
          for (int j = 0; j < 4; ++j) w[u][j] = vr[j * 64 + lane];
        }
#pragma unroll
        for (int u = 0; u < 4; ++u) {
          float c = __int_as_float(__builtin_amdgcn_readlane(__float_as_int(cf), p0 + u));
#pragma unroll
          for (int j = 0; j < 4; ++j) fma8(w[u][j], c, o + j * 8);
        }
      }
    }
    float s = 0.f;
    {
      const float4* xr = (const float4*)(XF + (size_t)row * 2048);
#pragma unroll
      for (int j = 0; j < 4; ++j) {
        float4 x0 = xr[j * 128 + lane * 2], x1 = xr[j * 128 + lane * 2 + 1];
        o[j * 8 + 0] += ALPHA * x0.x; o[j * 8 + 1] += ALPHA * x0.y; o[j * 8 + 2] += ALPHA * x0.z; o[j * 8 + 3] += ALPHA * x0.w;
        o[j * 8 + 4] += ALPHA * x1.x; o[j * 8 + 5] += ALPHA * x1.y; o[j * 8 + 6] += ALPHA * x1.z; o[j * 8 + 7] += ALPHA * x1.w;
      }
#pragma unroll
      for (int i = 0; i < 32; ++i) s += o[i];
    }
    float mu = wsum(s) * (1.0f / 2048.0f);
    float q = 0.f;
#pragma unroll
    for (int i = 0; i < 32; ++i) {
      o[i] -= mu;
      q += o[i] * o[i];
    }
    float inv = rsqrtf(wsum(q) * (1.0f / 2048.0f) + 1e-5f);
    float* dstf;
    if (final_out) {
      if (row < MPR) {
        int b = row / TP, t = row % TP;
        dstf = (t >= 16) ? (p.out + O_YP + ((size_t)b * 2048 + (t - 16)) * D) : nullptr;
      } else {
        dstf = p.out + O_YS + (size_t)(row - MPR) * D;
      }
    } else {
      dstf = XF + (size_t)row * 2048;
    }
#pragma unroll
    for (int j = 0; j < 4; ++j) {
      const float4* gp = (const float4*)(g + j * 512 + lane * 8);
      const float4* bp = (const float4*)(bta + j * 512 + lane * 8);
      float4 g0 = gp[0], g1 = gp[1], b0 = bp[0], b1 = bp[1];
      float4 y0, y1;
      y0.x = o[j * 8 + 0] * inv * g0.x + b0.x; y0.y = o[j * 8 + 1] * inv * g0.y + b0.y;
      y0.z = o[j * 8 + 2] * inv * g0.z + b0.z; y0.w = o[j * 8 + 3] * inv * g0.w + b0.w;
      y1.x = o[j * 8 + 4] * inv * g1.x + b1.x; y1.y = o[j * 8 + 5] * inv * g1.y + b1.y;
      y1.z = o[j * 8 + 6] * inv * g1.z + b1.z; y1.w = o[j * 8 + 7] * inv * g1.w + b1.w;
      if (dstf) {
        ((float4*)(dstf + j * 512 + lane * 8))[0] = y0;
        ((float4*)(dstf + j * 512 + lane * 8))[1] = y1;
      }
      if (!final_out) {
        uint4 pk = make_uint4(pack2(y0.x, y0.y), pack2(y0.z, y0.w), pack2(y1.x, y1.y), pack2(y1.z, y1.w));
        ((uint4*)(XB + (size_t)row * 2048))[j * 64 + lane] = pk;
      }
    }
  }
}

DEVI void phase_pre1(const Params& p) {
  char* ws = p.ws;
  const float* PROJ = (const float*)(ws + OFF_PROJ);
  float* XC = (float*)(ws + OFF_GOUT);
  float* RKV = (float*)(ws + OFF_RKV);
  u16* LRA = (u16*)(ws + OFF_LRA);
  u16* LRB = (u16*)(ws + OFF_LRB);
  u16* LRG = (u16*)(ws + OFF_LRG);
  const float* cw = p.in[I_CVW];
  const float* cbias = p.in[I_CVB];
  const float* mu = p.in[I_MU];
  const int lane = threadIdx.x & 63;
  const int gw = blockIdx.x * 4 + (threadIdx.x >> 6), nw = gridDim.x * 4;
  for (int row = gw; row < M; row += nw) {
    const bool prompt = row < MPR;
    int b, t, T;
    if (prompt) { b = row / TP; t = row % TP; T = TP; }
    else { b = (row - MPR) >> 2; t = (row - MPR) & 3; T = 4; }
    const float* pr = PROJ + (size_t)row * N1;
    for (int c = lane; c < 1536; c += 64) {
      float acc = cbias[c];
#pragma unroll
      for (int jj = 0; jj < 4; ++jj) {
        int tt = t - 3 + jj;
        float xv;
        if (tt >= 0) xv = PROJ[(size_t)(row - 3 + jj) * N1 + 1024 + c];
        else xv = prompt ? 0.f : p.in[I_SCV][(size_t)(b * 3 + (tt + 3)) * 1536 + c];
        acc += xv * cw[jj * 1536 + c];
      }
      XC[(size_t)row * 1536 + c] = siluf_(acc);
      if (t >= T - 3) {
        int j = t - (T - 3);
        float* co = prompt ? (p.out + O_CVP) : (p.out + O_CVS);
        co[(size_t)(b * 3 + j) * 1536 + c] = pr[1024 + c];
      }
    }
    for (int c = lane; c < 3360; c += 64) {
      float cur = pr[2560 + c];
      float prev;
      if (t > 0) prev = PROJ[(size_t)(row - 1) * N1 + 2560 + c];
      else prev = prompt ? 0.f : p.in[I_SSH][(size_t)b * 3360 + c];
      float mixed = cur + (prev - cur) * mu[c];
      if (c < 3072) RKV[(size_t)row * 3072 + c] = mixed;
      else if (c < 3136) LRA[(size_t)row * 64 + (c - 3072)] = f2bf(tanhf(mixed));
      else if (c < 3200) LRB[(size_t)row * 64 + (c - 3136)] = f2bf(mixed);
      else LRG[(size_t)row * 192 + (c - 3200)] = f2bf(sigmoidf_(mixed));
      if (t == T - 1) {
        float* so = prompt ? (p.out + O_SHP) : (p.out + O_SHS);
        so[(size_t)b * 3360 + c] = cur;
      }
    }
    if (lane < 32) LRG[(size_t)row * 192 + 160 + lane] = 0;
  }
}

DEVI void phase_pre1c(const Params& p) {
  char* ws = p.ws;
  float* RKV = (float*)(ws + OFF_RKV);
  const float* AA = (const float*)(ws + OFF_AA);
  float* KK = (float*)(ws + OFF_QB);
  float* KKA = (float*)(ws + OFF_MIXB);
  float* BON = (float*)(ws + OFF_BON);
  const float* k_k = p.in[I_KK];
  const float* k_a = p.in[I_KA];
  const float* r_k = p.in[I_RK];
  const int lane = threadIdx.x & 63;
  const int gw = blockIdx.x * 4 + (threadIdx.x >> 6), nw = gridDim.x * 4;
  for (int row = gw; row < M; row += nw) {
#pragma unroll 4
    for (int h = 0; h < 16; ++h) {
      int c = h * 64 + lane;
      float k = RKV[(size_t)row * 3072 + 1024 + c];
      float r = RKV[(size_t)row * 3072 + c];
      float a = AA[(size_t)row * 1024 + c];
      float kkr = k * k_k[c];
      float ss = wsum(kkr * kkr);
      float kk = kkr / fmaxf(sqrtf(ss), 1e-12f);
      float kp = k * (1.0f + (a - 1.0f) * k_a[c]);
      float bon = wsum(r * kp * r_k[c]);
      KK[(size_t)row * 1024 + c] = kk;
      KKA[(size_t)row * 1024 + c] = kk * a;
      RKV[(size_t)row * 3072 + 1024 + c] = kp;
      if (lane == 0) BON[(size_t)row * 16 + h] = bon;
    }
  }
}

DEVI void phase_rec1(const Params& p, float* smem) {
  char* ws = p.ws;
  const float* XC = (const float*)(ws + OFF_GOUT);
  const float* RKV = (const float*)(ws + OFF_RKV);
  const float* DEC = (const float*)(ws + OFF_DEC);
  const float* KK = (const float*)(ws + OFF_QB);
  const float* KKA = (const float*)(ws + OFF_MIXB);
  const float* DTA = (const float*)(ws + OFF_DTA);
  float* OMIX = (float*)(ws + OFF_OMIX);
  const float* wsf = (const float*)ws;
  constexpr int XO = (int)(OFF_GOUT / 4), DO = (int)(OFF_DTA / 4), RO = (int)(OFF_RKV / 4), CO = (int)(OFF_DEC / 4),
                KO = (int)(OFF_QB / 4), AO = (int)(OFF_MIXB / 4);
  for (int item = blockIdx.x; item < 10624; item += gridDim.x) {
    if (item < 128) {
      int b = item >> 5, h = (item >> 1) & 15, cb = item & 1;
      int g = h >> 3;
      Seg sg[4] = {{XO + 1024 + g * 128, 1536, 32}, {XO + 1280 + g * 128, 1536, 32}, {XO + h * 64 + cb * 32, 1536, 8},
                   {DO + h * 4, 64, 1}};
      int row0 = b * TP;
#ifndef NO_LONG
      colrec_long<2>(wsf, sg, row0, TP, 0.f, OMIX + (size_t)row0 * 2048 + h * 64 + cb * 32, 2048,
                     p.out + O_SSP + (size_t)(b * 16 + h) * 128 * 64 + cb * 32, 64, smem);
#endif
    } else if (item < 384 || item >= 2432) {
      bool prompt = item < 384;
      int it = prompt ? (item - 128) : (item - 2432);
      int b = it >> 6, h = (it >> 2) & 15, rb = it & 3;
      int row0 = prompt ? b * TP : (MPR + b * 4);
      int T = prompt ? TP : 4;
      Seg sg[6] = {{RO + h * 64, 3072, 16}, {CO + h * 64, 1024, 16}, {RO + 1024 + h * 64, 3072, 16},
                   {KO + h * 64, 1024, 16}, {AO + h * 64, 1024, 16}, {RO + 2048 + h * 64 + rb * 16, 3072, 4}};
      size_t so = ((size_t)(b * 16 + h) * 64 + rb * 16) * 64;
      const float* stin = prompt ? nullptr : (p.in[I_SWK] + so);
      float* stout = (prompt ? (p.out + O_WKP) : (p.out + O_WKS)) + so;
#ifndef NO_RWKV
      rwkv_item(wsf, sg, row0, T, stin, stout, OMIX + (size_t)row0 * 2048 + 1024 + h * 64 + rb * 16, 2048, smem);
#endif
    } else {
      int it = item - 384;
      int b = it >> 4, h = it & 15;
      int g = h >> 3;
      long row0 = MPR + (long)b * 4;
      size_t so = (size_t)(b * 16 + h) * 128 * 64;
#ifndef NO_SHORT
      colrec_short<2>(XC + 1024 + g * 128, 1536, XC + 1280 + g * 128, 1536, XC + h * 64, 1536, DTA + h * 4, row0, 0.f,
                      p.in[I_SSM] + so, p.out + O_SSS + so, 64, OMIX + h * 64, 2048, smem);
#endif
    }
  }
}

DEVI void phase_post1(const Params& p) {
  char* ws = p.ws;
  const float* PROJ = (const float*)(ws + OFF_PROJ);
  const float* OMIX = (const float*)(ws + OFF_OMIX);
  const float* XC = (const float*)(ws + OFF_GOUT);
  const float* RKV = (const float*)(ws + OFF_RKV);
  const float* GG = (const float*)(ws + OFF_GG);
  const float* BON = (const float*)(ws + OFF_BON);
  u16* MIXB = (u16*)(ws + OFF_MIXB);
  const float* dsk = p.in[I_DSK];
  const float* sng = p.in[I_SNG];
  const float* lxg = p.in[I_LXG];
  const float* lxb = p.in[I_LXB];
  const int lane = threadIdx.x & 63;
  const int gw = blockIdx.x * 4 + (threadIdx.x >> 6), nw = gridDim.x * 4;
  for (int row = gw; row < M; row += nw) {
    const float* o = OMIX + (size_t)row * 2048;
    u16* mo = MIXB + (size_t)row * 2048;
#pragma unroll 1
    for (int grp = 0; grp < 2; ++grp) {
      float v[8];
      float ss = 0.f;
#pragma unroll
      for (int i = 0; i < 8; ++i) {
        int c = grp * 512 + i * 64 + lane;
        v[i] = (o[c] + XC[(size_t)row * 1536 + c] * dsk[c >> 6]) * PROJ[(size_t)row * N1 + c];
        ss += v[i] * v[i];
      }
      float inv = rsqrtf(wsum(ss) * (1.0f / 512.0f) + 1e-6f);
#pragma unroll
      for (int i = 0; i < 8; ++i) {
        int c = grp * 512 + i * 64 + lane;
        mo[c] = f2bf(v[i] * inv * sng[c]);
      }
    }
#pragma unroll 4
    for (int h = 0; h < 16; ++h) {
      int c = h * 64 + lane;
      float y = o[1024 + c];
      float mu = wsum(y) * (1.0f / 64.0f);
      float d = y - mu;
      float var = wsum(d * d) * (1.0f / 64.0f);
      float yn = d * rsqrtf(var + 64e-5f) * lxg[c] + lxb[c];
      yn += BON[(size_t)row * 16 + h] * RKV[(size_t)row * 3072 + 2048 + c];
      yn *= GG[(size_t)row * 1024 + c];
      mo[1024 + c] = f2bf(yn);
    }
  }
}

template <int ph>
DEVI void run_phase(const Params& p, char* smem_raw) {
  float* smem = (float*)smem_raw;
  char* ws = p.ws;
  {
    switch (ph) {
      case 0: phase0(p, smem); break;
      case 1: {
        float* PROJ = (float*)(ws + OFF_PROJ);
        const float* LB = (const float*)(ws + OFF_LB);
        const double* IR = (const double*)(ws + OFF_INVREV);
        gemm_phase((const u16*)(ws + OFF_XB), 2048, 0, (const u16*)(ws + OFF_WIN0), 2048, MP / 128, N0 / 128, smem_raw,
                   [=](int row, int col, float v0, float v1) {
                     float* pr = PROJ + (size_t)row * N0;
                     if (col < 1024 || (col >= 3072 && col < 4096) || col >= 6144) {
                       pr[col] = siluf_(v0);
                       pr[col + 32] = siluf_(v1);
                     } else if (col < 2048) {
                       float l0 = LB[col - 1024], l1 = LB[col - 1024 + 32];
                       pr[col] = l0 + (1.0f - l0) * sigmoidf_(v0);
                       pr[col + 32] = l1 + (1.0f - l1) * sigmoidf_(v1);
                     } else if (col >= 4096 && col < 5120) {
                       int hb = col & ~127, c = col & 127, span = c >> 6, pp = c & 63;
                       int d = span * 32 + pp;
                       double rev = (double)row_pos(row) * IR[d];
                       float fr = (float)(rev - floor(rev));
                       float sn = __builtin_amdgcn_sinf(fr), cs = __builtin_amdgcn_cosf(fr);
                       float sc = (col >= 4608) ? 0.08838834764831845f : 1.0f;
                       pr[hb + d] = (v0 * cs - v1 * sn) * sc;
                       pr[hb + 64 + d] = (v0 * sn + v1 * cs) * sc;
                     } else {
                       pr[col] = v0;
                       pr[col + 32] = v1;
                     }
                   });
      } break;
      case 2: phase_rec0(p, smem); break;
      case 3: phase_post0(p); break;
      case 4: case 15: {
        float* GO = (float*)(ws + OFF_GOUT);
        gemm_phase((const u16*)(ws + OFF_MIXB), 2048, 0, (const u16*)(ws + (ph == 4 ? OFF_WOUT0 : OFF_WOUT1)), 2048,
                   MP / 128, 16, smem_raw, [=](int row, int col, float v0, float v1) {
                     GO[(size_t)row * 2048 + col] = v0;
                     GO[(size_t)row * 2048 + col + 32] = v1;
                   });
      } break;
      case 5: case 16: {
        int l = (ph == 5) ? 0 : 1;
        phase_ln(p, (const float*)(ws + OFF_GOUT), p.in[I_LNG] + (size_t)(l * 2) * D, p.in[I_LNB] + (size_t)(l * 2) * D);
      } break;
      case 6: case 17: {
        u16* QB = (u16*)(ws + OFF_QB);
        gemm_phase((const u16*)(ws + OFF_XB), 2048, 0, (const u16*)(ws + (ph == 6 ? OFF_WQ0 : OFF_WQ1)), 2048, MP / 128,
                   16, smem_raw, [=](int row, int col, float v0, float v1) {
                     QB[(size_t)row * 2048 + col] = f2bf(v0);
                     QB[(size_t)row * 2048 + col + 32] = f2bf(v1);
                   });
      } break;
      case 7: case 18: {
        float* SC = (float*)(ws + OFF_GOUT);
        gemm_phase((const u16*)(ws + OFF_QB), 2048, 128, (const u16*)(ws + (ph == 7 ? OFF_KEY0 : OFF_KEY1)), 128,
                   MP / 128, 16, smem_raw, [=](int row, int col, float v0, float v1) {
                     SC[(size_t)row * 2048 + col] = v0;
                     SC[(size_t)row * 2048 + col + 32] = v1;
                   });
      } break;
      case 8: phase_peer(p, 0, false); break;
      case 9: {
        conv_bf16_flat(p.in[I_PU] + (size_t)16384 * 2048, (u16*)(ws + OFF_UB), (size_t)16384 * 2048 / 4);
        conv_bf16_flat(p.in[I_PV] + (size_t)16384 * 2048, (u16*)(ws + OFF_VB), (size_t)16384 * 2048 / 4);
        float* PROJ = (float*)(ws + OFF_PROJ);
        float* DTA = (float*)(ws + OFF_DTA);
        const float* dtb = p.in[I_DTB];
        const float* alog = p.in[I_ALOG];
        gemm_phase((const u16*)(ws + OFF_XB), 2048, 0, (const u16*)(ws + OFF_WIN1), 2048, MP / 128, N1 / 128, smem_raw,
                   [=](int row, int col, float v0, float v1) {
                     float* pr = PROJ + (size_t)row * N1;
                     if (col < 1024) {
                       pr[col] = siluf_(v0);
                       pr[col + 32] = siluf_(v1);
                     } else if (col < 5888) {
                       pr[col] = v0;
                       pr[col + 32] = v1;
                     } else {
#pragma unroll
                       for (int e = 0; e < 2; ++e) {
                         int cc = col + e * 32;
                         float v = e ? v1 : v0;
                         if (cc < 5920) pr[cc] = v;
                         else if (cc < 5936) {
                           int h = cc - 5920;
                           float dt = softplusf_(v + dtb[h]);
                           DTA[(size_t)row * 64 + h * 4] = dt;
                           DTA[(size_t)row * 64 + h * 4 + 1] = expf(-dt * expf(alog[h]));
                         }
                       }
                     }
                   });
      } break;
      case 10: phase_pre1(p); break;
      case 11: {
        float* DEC = (float*)(ws + OFF_DEC);
        float* AA = (float*)(ws + OFF_AA);
        float* GG = (float*)(ws + OFF_GG);
        const float* w0 = p.in[I_W0];
        const float* a0 = p.in[I_A0];
        gemm_phase((const u16*)(ws + OFF_LRA), 64, 0, (const u16*)(ws + OFF_W2T), 64, MP / 128, 8, smem_raw,
                   [=](int row, int col, float v0, float v1) {
#pragma unroll
                     for (int e = 0; e < 2; ++e) {
                       int cc = col + e * 32;
                       float v = (e ? v1 : v0) + w0[cc];
                       float wl = -softplusf_(-v) - 0.5f;
                       DEC[(size_t)row * 1024 + cc] = expf(-expf(wl));
                     }
                   });
        gemm_phase((const u16*)(ws + OFF_LRB), 64, 0, (const u16*)(ws + OFF_A2T), 64, MP / 128, 8, smem_raw,
                   [=](int row, int col, float v0, float v1) {
                     AA[(size_t)row * 1024 + col] = sigmoidf_(v0 + a0[col]);
                     AA[(size_t)row * 1024 + col + 32] = sigmoidf_(v1 + a0[col + 32]);
                   });
        gemm_phase((const u16*)(ws + OFF_LRG), 192, 0, (const u16*)(ws + OFF_G2T), 192, MP / 128, 8, smem_raw,
                   [=](int row, int col, float v0, float v1) {
                     GG[(size_t)row * 1024 + col] = v0;
                     GG[(size_t)row * 1024 + col + 32] = v1;
                   });
      } break;
      case 12: phase_pre1c(p); break;
      case 13: phase_rec1(p, smem); break;
      case 14: phase_post1(p); break;
      case 19: phase_peer(p, 1, true); break;
      default: break;
    }
  }
}

__global__ void __launch_bounds__(256, 2) mega(Params p, int ph_lo, int ph_hi) {
  __shared__ __attribute__((aligned(16))) char smem_raw[SMEM_BYTES];
  cg::grid_group grid = cg::this_grid();
#define PHASE(K)                                          \
  if (ph_lo <= K && K < ph_hi) run_phase<K>(p, smem_raw); \
  if (ph_lo <= K && K + 1 < ph_hi) grid.sync();
  PHASE(0) PHASE(1) PHASE(2) PHASE(3) PHASE(4) PHASE(5) PHASE(6) PHASE(7) PHASE(8) PHASE(9)
  PHASE(10) PHASE(11) PHASE(12) PHASE(13) PHASE(14) PHASE(15) PHASE(16) PHASE(17) PHASE(18) PHASE(19)
}
#ifdef PHASE_TEST
template <int PH>
__global__ void __launch_bounds__(256, 2) phk(Params p) {
  __shared__ __attribute__((aligned(16))) char smem_raw[SMEM_BYTES];
  run_phase<PH>(p, smem_raw);
}
#define INST(N) template __global__ void phk<N>(Params);
INST(0) INST(1) INST(2) INST(3) INST(4) INST(5) INST(6) INST(7) INST(8) INST(9) INST(10) INST(11) INST(12) INST(13) INST(14) INST(19)
#endif

constexpr int NPHASE = 20;

extern "C" void kernel_launch(void* const* d_in, const int* in_sizes, int n_in, void* d_out, int out_size, void* d_ws,
                              size_t ws_size, hipStream_t stream) {
  static int grid_blocks = 0;
  if (!grid_blocks) {
    int dev = 0, cus = 0, per_cu = 0;
    hipGetDevice(&dev);
    hipDeviceGetAttribute(&cus, hipDeviceAttributeMultiprocessorCount, dev);
    hipOccupancyMaxActiveBlocksPerMultiprocessor(&per_cu, mega, 256, 0);
    if (per_cu > 2) per_cu = 2;
    if (per_cu < 1) per_cu = 1;
    grid_blocks = cus * per_cu;
  }
  Params p{};
  for (int i = 0; i < 38; ++i) p.in[i] = (const float*)d_in[i];
  p.out = (float*)d_out;
  p.ws = (char*)d_ws;
  int lo = 0, hi = NPHASE;
  void* args[] = {&p, &lo, &hi};
  hipError_t e = hipLaunchCooperativeKernel((void*)mega, dim3(grid_blocks), dim3(256), args, 0, stream);
  if (e != hipSuccess) fprintf(stderr, "cooperative launch failed: %s (grid %d)\n", hipGetErrorString(e), grid_blocks);
}
```

```cpp
#include <hip/hip_runtime.h>
#include <hip/hip_bf16.h>
#include <hip/hip_cooperative_groups.h>
#include <cstdio>
#include <cmath>
namespace cg = cooperative_groups;

#define DEVI __device__ __forceinline__
typedef unsigned short u16;
using bf16x8 = __attribute__((ext_vector_type(8))) short;
using f32x4 = __attribute__((ext_vector_type(4))) float;
using u32x4 = __attribute__((ext_vector_type(4))) unsigned int;

constexpr int D = 2048;
constexpr int TP = 2064;
constexpr int MPR = 8256;
constexpr int M = 8768;
constexpr int MP = 8832;
constexpr int N0 = 7168;
constexpr int N1 = 6016;
constexpr float ALPHA = 1.41421356237f;

constexpr size_t SZ_TAB = (size_t)16384 * 2048 * 2;
constexpr size_t OFF_UB = 0;
constexpr size_t OFF_VB = OFF_UB + SZ_TAB;
constexpr size_t OFF_WIN0 = OFF_VB + SZ_TAB;
constexpr size_t OFF_WOUT0 = OFF_WIN0 + (size_t)N0 * 2048 * 2;
constexpr size_t OFF_WQ0 = OFF_WOUT0 + (size_t)2048 * 2048 * 2;
constexpr size_t OFF_KEY0 = OFF_WQ0 + (size_t)2048 * 2048 * 2;
constexpr size_t OFF_WIN1 = OFF_KEY0 + (size_t)16 * 128 * 128 * 2;
constexpr size_t OFF_WOUT1 = OFF_WIN1 + (size_t)N1 * 2048 * 2;
constexpr size_t OFF_WQ1 = OFF_WOUT1 + (size_t)2048 * 2048 * 2;
constexpr size_t OFF_KEY1 = OFF_WQ1 + (size_t)2048 * 2048 * 2;
constexpr size_t OFF_W2T = OFF_KEY1 + (size_t)16 * 128 * 128 * 2;
constexpr size_t OFF_A2T = OFF_W2T + (size_t)1024 * 64 * 2;
constexpr size_t OFF_G2T = OFF_A2T + (size_t)1024 * 64 * 2;
constexpr size_t OFF_LB = OFF_G2T + (size_t)1024 * 192 * 2;
constexpr size_t OFF_INVREV = OFF_LB + 1024 * 4;
constexpr size_t OFF_XF = OFF_INVREV + 64 * 8;
constexpr size_t OFF_XB = OFF_XF + (size_t)MP * 2048 * 4;
constexpr size_t OFF_PROJ = OFF_XB + (size_t)MP * 2048 * 2;
constexpr size_t OFF_GOUT = OFF_PROJ + (size_t)MP * N0 * 4;
constexpr size_t OFF_OMIX = OFF_GOUT + (size_t)MP * 2048 * 4;
constexpr size_t OFF_MIXB = OFF_OMIX + (size_t)MP * 2048 * 4;
constexpr size_t OFF_QB = OFF_MIXB + (size_t)MP * 2048 * 2;
constexpr size_t OFF_RKV = OFF_QB + (size_t)MP * 2048 * 2;
constexpr size_t OFF_DEC = OFF_RKV + (size_t)MP * 3072 * 4;
constexpr size_t OFF_AA = OFF_DEC + (size_t)MP * 1024 * 4;
constexpr size_t OFF_GG = OFF_AA + (size_t)MP * 1024 * 4;
constexpr size_t OFF_LRA = OFF_GG + (size_t)MP * 1024 * 4;
constexpr size_t OFF_LRB = OFF_LRA + (size_t)MP * 64 * 2;
constexpr size_t OFF_LRG = OFF_LRB + (size_t)MP * 64 * 2;
constexpr size_t OFF_DTA = OFF_LRG + (size_t)MP * 192 * 2;
constexpr size_t OFF_BON = OFF_DTA + (size_t)MP * 64 * 4;
constexpr size_t WS_TOTAL = OFF_BON + (size_t)MP * 16 * 4;
static_assert(WS_TOTAL <= (size_t)1 << 30, "workspace too large");

constexpr size_t O_YP = 0;
constexpr size_t O_YS = O_YP + (size_t)4 * 2048 * 2048;
constexpr size_t O_HGP = O_YS + (size_t)128 * 4 * 2048;
constexpr size_t O_HGS = O_HGP + (size_t)4 * 8 * 128 * 128;
constexpr size_t O_RTP = O_HGS + (size_t)128 * 8 * 128 * 128;
constexpr size_t O_RTS = O_RTP + (size_t)4 * 4 * 128 * 256;
constexpr size_t O_SSP = O_RTS + (size_t)128 * 4 * 128 * 256;
constexpr size_t O_SSS = O_SSP + (size_t)4 * 16 * 128 * 64;
constexpr size_t O_CVP = O_SSS + (size_t)128 * 16 * 128 * 64;
constexpr size_t O_CVS = O_CVP + (size_t)4 * 3 * 1536;
constexpr size_t O_WKP = O_CVS + (size_t)128 * 3 * 1536;
constexpr size_t O_WKS = O_WKP + (size_t)4 * 16 * 64 * 64;
constexpr size_t O_SHP = O_WKS + (size_t)128 * 16 * 64 * 64;
constexpr size_t O_SHS = O_SHP + (size_t)4 * 3360;

struct Params {
  const float* in[38];
  float* out;
  char* ws;
};
enum { I_XP = 0, I_XS, I_SHG, I_SRT, I_SSM, I_SCV, I_SWK, I_SSH, I_META, I_LNG, I_LNB, I_EWIN, I_LBL, I_HNG, I_EWOUT,
       I_OWIN, I_CVW, I_CVB, I_DTB, I_ALOG, I_DSK, I_SNG, I_MU, I_W0, I_W2, I_A0, I_A2, I_G2, I_KK, I_KA, I_RK,
       I_LXG, I_LXB, I_OWOUT, I_WQ, I_KEYS, I_PU, I_PV };

constexpr int SMEM_BYTES = 2 * 16 * 336 * 4 + 2 * 16 * 32 * 4;

DEVI u16 f2bf(float f) {
  unsigned u = __float_as_uint(f);
  u += 0x7fffu + ((u >> 16) & 1u);
  return (u16)(u >> 16);
}
DEVI unsigned pack2(float a, float b) { return (unsigned)f2bf(a) | ((unsigned)f2bf(b) << 16); }
DEVI float bflo(unsigned u) { return __uint_as_float(u << 16); }
DEVI float bfhi(unsigned u) { return __uint_as_float(u & 0xffff0000u); }
DEVI float sigmoidf_(float x) { return 1.0f / (1.0f + expf(-x)); }
DEVI float siluf_(float x) { return x / (1.0f + expf(-x)); }
DEVI float softplusf_(float x) { return fmaxf(x, 0.0f) + log1pf(expf(-fabsf(x))); }
DEVI float wsum(float v) {
#pragma unroll
  for (int o = 32; o > 0; o >>= 1) v += __shfl_xor(v, o, 64);
  return v;
}
DEVI float wmaxf_(float v) {
#pragma unroll
  for (int o = 32; o > 0; o >>= 1) v = fmaxf(v, __shfl_xor(v, o, 64));
  return v;
}
DEVI int wmini_(int v) {
#pragma unroll
  for (int o = 32; o > 0; o >>= 1) v = min(v, __shfl_xor(v, o, 64));
  return v;
}
template <int CTRL>
DEVI float dppf(float v) {
  return __int_as_float(__builtin_amdgcn_update_dpp(0, __float_as_int(v), CTRL, 0xF, 0xF, true));
}
DEVI float red8(float v) {
  v += dppf<0xB1>(v);
  v += dppf<0x4E>(v);
  v += dppf<0x141>(v);
  return v;
}
DEVI float red16(float v) {
  v = red8(v);
  v += dppf<0x140>(v);
  return v;
}
DEVI int row_pos(int row) { return row < MPR ? (row % TP) : (16384 + ((row - MPR) & 3)); }

DEVI void conv_bf16_flat(const float* __restrict__ src, u16* __restrict__ dst, size_t n4) {
  size_t stride = (size_t)gridDim.x * blockDim.x;
  for (size_t i = (size_t)blockIdx.x * blockDim.x + threadIdx.x; i < n4; i += stride) {
    float4 v = ((const float4*)src)[i];
    uint2 o;
    o.x = pack2(v.x, v.y);
    o.y = pack2(v.z, v.w);
    ((uint2*)dst)[i] = o;
  }
}

template <int MODE>
DEVI int colmap(int j) {
  if (MODE == 0) return j;
  if (MODE == 1) {
    if (j < 4096 || j >= 5120) return j;
    int hb = j & ~127, c = j & 127, span = c >> 6, p = c & 63;
    int d = (p < 32) ? (span * 32 + p) : (64 + span * 32 + (p - 32));
    return hb + d;
  }
  if (j < 2560) return j;
  if (j < 5920) return j + 16;
  if (j < 5936) return 2560 + (j - 5920);
  return -1;
}

template <int MODE>
DEVI void transpose_job(const float* __restrict__ src, int ldsrc, int Ksrc, u16* __restrict__ dst, int Kdst, int ndst,
                        float* smem) {
  int ktiles = Kdst / 64, ntiles = ndst / 64;
  int tid = threadIdx.x;
  for (int tile = blockIdx.x; tile < ktiles * ntiles; tile += gridDim.x) {
    int tn = tile / ktiles, tk = tile % ktiles;
    int j0 = tn * 64, k0 = tk * 64;
    int jj = tid & 63;
    int sc = colmap<MODE>(j0 + jj);
#pragma unroll
    for (int i = 0; i < 16; ++i) {
      int kk = i * 4 + (tid >> 6);
      float v = 0.f;
      if (sc >= 0 && (k0 + kk) < Ksrc) v = src[(size_t)(k0 + kk) * ldsrc + sc];
      smem[kk * 65 + jj] = v;
    }
    __syncthreads();
    int jr = tid >> 2, kq = (tid & 3) * 16;
    unsigned pk[8];
#pragma unroll
    for (int e = 0; e < 8; ++e) pk[e] = pack2(smem[(kq + 2 * e) * 65 + jr], smem[(kq + 2 * e + 1) * 65 + jr]);
    uint4* dp = (uint4*)(dst + (size_t)(j0 + jr) * Kdst + k0 + kq);
    dp[0] = make_uint4(pk[0], pk[1], pk[2], pk[3]);
    dp[1] = make_uint4(pk[4], pk[5], pk[6], pk[7]);
    __syncthreads();
  }
}

DEVI void phase0(const Params& p, float* smem) {
  char* ws = p.ws;
  conv_bf16_flat(p.in[I_PU], (u16*)(ws + OFF_UB), (size_t)16384 * 2048 / 4);
  conv_bf16_flat(p.in[I_PV], (u16*)(ws + OFF_VB), (size_t)16384 * 2048 / 4);
  conv_bf16_flat(p.in[I_KEYS], (u16*)(ws + OFF_KEY0), (size_t)16 * 128 * 128 / 4);
  conv_bf16_flat(p.in[I_KEYS] + (size_t)16 * 128 * 128, (u16*)(ws + OFF_KEY1), (size_t)16 * 128 * 128 / 4);
  transpose_job<1>(p.in[I_EWIN], N0, 2048, (u16*)(ws + OFF_WIN0), 2048, N0, smem);
  transpose_job<0>(p.in[I_EWOUT], 2048, 2048, (u16*)(ws + OFF_WOUT0), 2048, 2048, smem);
  transpose_job<0>(p.in[I_WQ], 2048, 2048, (u16*)(ws + OFF_WQ0), 2048, 2048, smem);
  transpose_job<0>(p.in[I_WQ] + (size_t)2048 * 2048, 2048, 2048, (u16*)(ws + OFF_WQ1), 2048, 2048, smem);
  transpose_job<2>(p.in[I_OWIN], 5936, 2048, (u16*)(ws + OFF_WIN1), 2048, N1, smem);
  transpose_job<0>(p.in[I_OWOUT], 2048, 2048, (u16*)(ws + OFF_WOUT1), 2048, 2048, smem);
  transpose_job<0>(p.in[I_W2], 1024, 64, (u16*)(ws + OFF_W2T), 64, 1024, smem);
  transpose_job<0>(p.in[I_A2], 1024, 64, (u16*)(ws + OFF_A2T), 64, 1024, smem);
  transpose_job<0>(p.in[I_G2], 1024, 160, (u16*)(ws + OFF_G2T), 192, 1024, smem);
  {
    float* XF = (float*)(ws + OFF_XF);
    u16* XB = (u16*)(ws + OFF_XB);
    size_t n4 = (size_t)MP * 512;
    size_t stride = (size_t)gridDim.x * blockDim.x;
    for (size_t i = (size_t)blockIdx.x * blockDim.x + threadIdx.x; i < n4; i += stride) {
      int row = (int)(i >> 9), c4 = (int)(i & 511);
      float4 v = make_float4(0.f, 0.f, 0.f, 0.f);
      if (row < MPR) {
        int b = row / TP, t = row % TP;
        const float* s = (t < 16) ? (p.in[I_META] + (size_t)t * D) : (p.in[I_XP] + ((size_t)b * 2048 + (t - 16)) * D);
        v = ((const float4*)s)[c4];
      } else if (row < M) {
        v = ((const float4*)(p.in[I_XS] + (size_t)(row - MPR) * D))[c4];
      }
      ((float4*)XF)[i] = v;
      uint2 o;
      o.x = pack2(v.x, v.y);
      o.y = pack2(v.z, v.w);
      ((uint2*)XB)[i] = o;
    }
  }
  if (blockIdx.x == 0) {
    float* LB = (float*)(ws + OFF_LB);
    const float* lg = p.in[I_LBL];
    for (int c = threadIdx.x; c < 1024; c += blockDim.x) {
      float a = lg[c], b = lg[1024 + c], d = lg[2048 + c];
      float m = fmaxf(a, fmaxf(b, d));
      float ea = expf(a - m), eb = expf(b - m), ed = expf(d - m);
      LB[c] = ea / (ea + eb + ed);
    }
    double* IR = (double*)(ws + OFF_INVREV);
    if (threadIdx.x < 64) {
      double d = (double)threadIdx.x;
      IR[threadIdx.x] = exp(-d * (9.210340371976184 / 64.0)) * 0.15915494309189535;
    }
  }
}

constexpr int G_LDS_STRIDE = 72;
template <class Epi>
DEVI void gemm_phase(const u16* __restrict__ A, int lda, int a_ntile_off, const u16* __restrict__ Bt, int K, int mtiles,
                     int ntiles, char* smem, Epi epi) {
  u16* SA = (u16*)smem;
  u16* SB = SA + 128 * G_LDS_STRIDE;
  const int tid = threadIdx.x, wid = tid >> 6, lane = tid & 63, wr = wid >> 1, wc = wid & 1, fr = lane & 15, fq = lane >> 4;
  const int ntot = mtiles * ntiles;
  const int nk = K / 64;
  for (int tile = blockIdx.x; tile < ntot; tile += gridDim.x) {
    int tm = tile / ntiles, tn = tile % ntiles;
    int brow = tm * 128, bcol = tn * 128;
    const u16* Ag = A + (size_t)brow * lda + (size_t)tn * a_ntile_off;
    const u16* Bg = Bt + (size_t)bcol * K;
    f32x4 acc[4][4];
#pragma unroll
    for (int m = 0; m < 4; ++m)
#pragma unroll
      for (int n = 0; n < 4; ++n) acc[m][n] = f32x4{0.f, 0.f, 0.f, 0.f};
    u32x4 ra[4], rb[4];
#pragma unroll
    for (int i = 0; i < 4; ++i) {
      int ch = tid + i * 256, r = ch >> 3, kc = ch & 7;
      ra[i] = *(const u32x4*)(Ag + (size_t)r * lda + kc * 8);
      rb[i] = *(const u32x4*)(Bg + (size_t)r * K + kc * 8);
    }
    for (int t = 0; t < nk; ++t) {
#pragma unroll
      for (int i = 0; i < 4; ++i) {
        int ch = tid + i * 256, r = ch >> 3, kc = ch & 7;
        *(u32x4*)(SA + r * G_LDS_STRIDE + kc * 8) = ra[i];
        *(u32x4*)(SB + r * G_LDS_STRIDE + kc * 8) = rb[i];
      }
      __syncthreads();
      if (t + 1 < nk) {
#pragma unroll
        for (int i = 0; i < 4; ++i) {
          int ch = tid + i * 256, r = ch >> 3, kc = ch & 7;
          ra[i] = *(const u32x4*)(Ag + (size_t)r * lda + (t + 1) * 64 + kc * 8);
          rb[i] = *(const u32x4*)(Bg + (size_t)r * K + (t + 1) * 64 + kc * 8);
        }
      }
#pragma unroll
      for (int kh = 0; kh < 2; ++kh) {
        bf16x8 At[4], Bl[4];
#pragma unroll
        for (int m = 0; m < 4; ++m)
          At[m] = *(const bf16x8*)(SA + (wr * 64 + m * 16 + fr) * G_LDS_STRIDE + kh * 32 + fq * 8);
#pragma unroll
        for (int n = 0; n < 4; ++n)
          Bl[n] = *(const bf16x8*)(SB + (wc * 64 + n * 16 + fr) * G_LDS_STRIDE + kh * 32 + fq * 8);
#pragma unroll
        for (int m = 0; m < 4; ++m)
#pragma unroll
          for (int n = 0; n < 4; ++n) acc[m][n] = __builtin_amdgcn_mfma_f32_16x16x32_bf16(At[m], Bl[n], acc[m][n], 0, 0, 0);
      }
      __syncthreads();
    }
#pragma unroll
    for (int m = 0; m < 4; ++m)
#pragma unroll
      for (int n = 0; n < 2; ++n)
#pragma unroll
        for (int j = 0; j < 4; ++j) {
          int row = brow + wr * 64 + m * 16 + fq * 4 + j;
          int col = bcol + wc * 64 + n * 16 + fr;
          epi(row, col, acc[m][n][j], acc[m][n + 2][j]);
        }
  }
}

struct Seg {
  int off;
  int ld;
  int n4;
};

template <int NS, int NF4, int RG>
DEVI void stage_init(const float* wsf, const Seg (&sg)[NS], int row0, int tid, const float* (&ptr)[RG], int (&ldv)[RG]) {
  asm volatile("" : "+v"(tid));
#pragma unroll
  for (int q = 0; q < RG; ++q) {
    int flat = tid + q * 256;
    int t = flat / NF4, f = flat % NF4;
    if (flat >= 16 * NF4) { t = 0; f = 0; }
    int off = 0, ld = 0, ff = f;
    bool done = false;
#pragma unroll
    for (int s = 0; s < NS; ++s) {
      bool here = (!done) && (ff < sg[s].n4);
      off = here ? (sg[s].off + (row0 + t) * sg[s].ld + ff * 4) : off;
      ld = here ? sg[s].ld : ld;
      ff = (done || here) ? ff : (ff - sg[s].n4);
      done = done || here;
    }
    ptr[q] = wsf + off;
    ldv[q] = ld;
  }
}
template <int NF4, int RG>
DEVI void stage_issue(const float* const (&ptr)[RG], const int (&ldv)[RG], int st, int nsteps, int tid, f32x4 (&rg)[RG]) {
#pragma unroll
  for (int q = 0; q < RG; ++q) {
    int flat = tid + q * 256;
    if (flat < nsteps * NF4) rg[q] = *(const f32x4*)(ptr[q] + (st * 16) * ldv[q]);
  }
}
template <int NF4, int RG>
DEVI void stage_commit(float* buf, int nsteps, int tid, const f32x4 (&rg)[RG]) {
#pragma unroll
  for (int q = 0; q < RG; ++q) {
    int flat = tid + q * 256;
    if (flat < nsteps * NF4) ((f32x4*)buf)[flat] = rg[q];
  }
}

template <int MODE>
DEVI void colrec_long(const float* wsf, const Seg (&sg)[4], int row0, int T, float gamma, float* outp, int ldo, float* stout, int st_ld,
                      float* smem) {
  constexpr int NF4 = 73, W = 292, RG = 5;
  const int tid = threadIdx.x, w = tid >> 6, lane = tid & 63, c = lane >> 3, s = lane & 7;
  float S[16];
#pragma unroll
  for (int i = 0; i < 16; ++i) S[i] = 0.f;
  float* buf0 = smem;
  float* buf1 = smem + 16 * 336;
  float* obuf = smem + 2 * 16 * 336;
  const int nst = (T + 15) / 16;
  f32x4 rg[RG];
  const float* sptr[RG];
  int sld[RG];
  stage_init<4, NF4, RG>(wsf, sg, row0, tid, sptr, sld);
  stage_issue<NF4, RG>(sptr, sld, 0, min(16, T), tid, rg);
  stage_commit<NF4, RG>(buf0, min(16, T), tid, rg);
  __syncthreads();
#pragma unroll 1
  for (int st = 0; st < nst; ++st) {
    const int nthis = min(16, T - st * 16);
    const int nnext = min(16, T - (st + 1) * 16);
    if (st + 1 < nst) stage_issue<NF4, RG>(sptr, sld, st + 1, nnext, tid, rg);
    const float* b = (st & 1) ? buf1 : buf0;
    float* ob = obuf + (st & 1) * 512;
#pragma unroll 1
    for (int tt = 0; tt < nthis; ++tt) {
      const float* sp = b + tt * W;
      float a[16], q[16];
#pragma unroll
      for (int i = 0; i < 4; ++i) {
        float4 av = *(const float4*)(sp + s * 16 + i * 4);
        float4 qv = *(const float4*)(sp + 128 + s * 16 + i * 4);
        a[i * 4 + 0] = av.x; a[i * 4 + 1] = av.y; a[i * 4 + 2] = av.z; a[i * 4 + 3] = av.w;
        q[i * 4 + 0] = qv.x; q[i * 4 + 1] = qv.y; q[i * 4 + 2] = qv.z; q[i * 4 + 3] = qv.w;
      }
      float val = sp[256 + w * 8 + c];
      float dA = gamma;
      if (MODE == 2) {
        val *= sp[288];
        dA = sp[289];
      }
      float o = 0.f;
#pragma unroll
      for (int i = 0; i < 16; ++i) {
        if (MODE == 0) S[i] = val + a[i] * (S[i] - val);
        else S[i] = dA * S[i] + a[i] * val;
        o += q[i] * S[i];
      }
      o = red8(o);
      if (s == 0) ob[tt * 32 + w * 8 + c] = o;
    }
    if (st + 1 < nst) stage_commit<NF4, RG>((st & 1) ? buf0 : buf1, nnext, tid, rg);
    __syncthreads();
    if (tid < nthis * 8) {
      int t = tid >> 3, c4 = tid & 7;
      *(float4*)(outp + (size_t)(st * 16 + t) * ldo + c4 * 4) = *(const float4*)(ob + t * 32 + c4 * 4);
    }
  }
#pragma unroll
  for (int i = 0; i < 16; ++i) stout[(size_t)(s * 16 + i) * st_ld + w * 8 + c] = S[i];
  __syncthreads();
}

template <int MODE>
DEVI void colrec_short(const float* pa, int lda_, const float* pq, int ldq, const float* pc, int ldc, const float* pdt,
                       long row0, float gamma, const float* stin, float* stout, int st_ld, float* outp, int ldo,
                       float* smem) {
  const int tid = threadIdx.x, lane = tid & 63;
  const int wid = __builtin_amdgcn_readfirstlane(tid >> 6);
  const int k0 = wid * 32;
  float S[32];
#pragma unroll
  for (int i = 0; i < 32; ++i) S[i] = stin[(size_t)(k0 + i) * st_ld + lane];
#pragma unroll 1
  for (int t = 0; t < 4; ++t) {
    long row = row0 + t;
    float val = pc[(size_t)row * ldc + lane];
    float dA = gamma;
    if (MODE == 2) {
      val *= pdt[(size_t)row * 64];
      dA = pdt[(size_t)row * 64 + 1];
    }
    const float4* ap = (const float4*)(pa + (size_t)row * lda_ + k0);
    const float4* qp = (const float4*)(pq + (size_t)row * ldq + k0);
    float o = 0.f;
#pragma unroll
    for (int i4 = 0; i4 < 8; ++i4) {
      float4 av = ap[i4], qv = qp[i4];
      float a[4] = {av.x, av.y, av.z, av.w};
      float q[4] = {qv.x, qv.y, qv.z, qv.w};
#pragma unroll
      for (int e = 0; e < 4; ++e) {
        int i = i4 * 4 + e;
        if (MODE == 0) S[i] = val + a[e] * (S[i] - val);
        else S[i] = dA * S[i] + a[e] * val;
        o += q[e] * S[i];
      }
    }
    smem[(wid * 4 + t) * 64 + lane] = o;
  }
#pragma unroll
  for (int i = 0; i < 32; ++i) stout[(size_t)(k0 + i) * st_ld + lane] = S[i];
  __syncthreads();
  {
    int t = tid >> 6;
    float sum = smem[(0 * 4 + t) * 64 + lane] + smem[(1 * 4 + t) * 64 + lane] + smem[(2 * 4 + t) * 64 + lane] +
                smem[(3 * 4 + t) * 64 + lane];
    outp[(size_t)(row0 + t) * ldo + lane] = sum;
  }
  __syncthreads();
}

DEVI void rwkv_item(const float* wsf, const Seg (&sg)[6], int row0, int T, const float* stin, float* stout, float* outp, int ldo,
                    float* smem) {
  constexpr int NF4 = 84, W = 336, RG = 6;
  const int tid = threadIdx.x, w = tid >> 6, lane = tid & 63, rl = lane >> 4, sl = lane & 15;
  const int il = w * 4 + rl;
  float S[4];
  if (stin) {
    float4 v = *(const float4*)(stin + il * 64 + sl * 4);
    S[0] = v.x; S[1] = v.y; S[2] = v.z; S[3] = v.w;
  } else {
    S[0] = S[1] = S[2] = S[3] = 0.f;
  }
  float* buf0 = smem;
  float* buf1 = smem + 16 * 336;
  float* obuf = smem + 2 * 16 * 336;
  const int nst = (T + 15) / 16;
  f32x4 rg[RG];
  const float* sptr[RG];
  int sld[RG];
  stage_init<6, NF4, RG>(wsf, sg, row0, tid, sptr, sld);
  stage_issue<NF4, RG>(sptr, sld, 0, min(16, T), tid, rg);
  stage_commit<NF4, RG>(buf0, min(16, T), tid, rg);
  __syncthreads();
#pragma unroll 1
  for (int st = 0; st < nst; ++st) {
    const int nthis = min(16, T - st * 16);
    const int nnext = min(16, T - (st + 1) * 16);
    if (st + 1 < nst) stage_issue<NF4, RG>(sptr, sld, st + 1, nnext, tid, rg);
    const float* b = (st & 1) ? buf1 : buf0;
    float* ob = obuf + (st & 1) * 512;
#pragma unroll 1
    for (int tt = 0; tt < nthis; ++tt) {
      const float* sp = b + tt * W;
      float4 r4 = *(const float4*)(sp + sl * 4);
      float4 w4 = *(const float4*)(sp + 64 + sl * 4);
      float4 k4 = *(const float4*)(sp + 128 + sl * 4);
      float4 n4 = *(const float4*)(sp + 192 + sl * 4);
      float4 m4 = *(const float4*)(sp + 256 + sl * 4);
      float vi = sp[320 + il];
      float sa = S[0] * n4.x + S[1] * n4.y + S[2] * n4.z + S[3] * n4.w;
      sa = -red16(sa);
      S[0] = S[0] * w4.x + sa * m4.x + vi * k4.x;
      S[1] = S[1] * w4.y + sa * m4.y + vi * k4.y;
      S[2] = S[2] * w4.z + sa * m4.z + vi * k4.z;
      S[3] = S[3] * w4.w + sa * m4.w + vi * k4.w;
      float y = S[0] * r4.x + S[1] * r4.y + S[2] * r4.z + S[3] * r4.w;
      y = red16(y);
      if (sl == 0) ob[tt * 16 + il] = y;
    }
    if (st + 1 < nst) stage_commit<NF4, RG>((st & 1) ? buf0 : buf1, nnext, tid, rg);
    __syncthreads();
    if (tid < nthis * 4) {
      int t = tid >> 2, c4 = tid & 3;
      *(float4*)(outp + (size_t)(st * 16 + t) * ldo + c4 * 4) = *(const float4*)(ob + t * 16 + c4 * 4);
    }
  }
  *(float4*)(stout + il * 64 + sl * 4) = make_float4(S[0], S[1], S[2], S[3]);
  __syncthreads();
}

DEVI void phase_rec0(const Params& p, float* smem) {
  char* ws = p.ws;
  const float* PROJ = (const float*)(ws + OFF_PROJ);
  float* OMIX = (float*)(ws + OFF_OMIX);
  const float* wsf = (const float*)ws;
  constexpr int PO = (int)(OFF_PROJ / 4);
  for (int item = blockIdx.x; item < 4352; item += gridDim.x) {
    if (item < 128) {
      int b = item >> 5, h = (item >> 2) & 7, cb = item & 3;
      Seg sg[4] = {{PO + 1024 + h * 128, N0, 32}, {PO + h * 128, N0, 32}, {PO + 2048 + h * 128 + cb * 32, N0, 8},
                   {PO, N0, 1}};
      int row0 = b * TP;
      colrec_long<0>(wsf, sg, row0, TP, 0.f, OMIX + (size_t)row0 * 2048 + h * 128 + cb * 32, 2048,
                     p.out + O_HGP + (size_t)(b * 8 + h) * 128 * 128 + cb * 32, 128, smem);
    } else if (item < 256) {
      int it = item - 128;
      int b = it >> 5, h = (it >> 3) & 3, cb = it & 7;
      Seg sg[4] = {{PO + 4608 + h * 128, N0, 32}, {PO + 4096 + h * 128, N0, 32},
                   {PO + 5120 + h * 256 + cb * 32, N0, 8}, {PO, N0, 1}};
      int row0 = b * TP;
      float gamma = 1.0f - exp2f(-5.0f - (float)h);
      colrec_long<1>(wsf, sg, row0, TP, gamma, OMIX + (size_t)row0 * 2048 + 1024 + h * 256 + cb * 32, 2048,
                     p.out + O_RTP + (size_t)(b * 4 + h) * 128 * 256 + cb * 32, 256, smem);
    } else if (item < 2304) {
      int it = item - 256;
      int b = it >> 4, h = (it >> 1) & 7, cb = it & 1;
      long row0 = MPR + (long)b * 4;
      size_t so = (size_t)(b * 8 + h) * 128 * 128 + cb * 64;
      colrec_short<0>(PROJ + 1024 + h * 128, N0, PROJ + h * 128, N0, PROJ + 2048 + h * 128 + cb * 64, N0, nullptr, row0,
                      0.f, p.in[I_SHG] + so, p.out + O_HGS + so, 128, OMIX + h * 128 + cb * 64, 2048, smem);
    } else {
      int it = item - 2304;
      int b = it >> 4, h = (it >> 2) & 3, cb = it & 3;
      long row0 = MPR + (long)b * 4;
      size_t so = (size_t)(b * 4 + h) * 128 * 256 + cb * 64;
      float gamma = 1.0f - exp2f(-5.0f - (float)h);
      colrec_short<1>(PROJ + 4608 + h * 128, N0, PROJ + 4096 + h * 128, N0, PROJ + 5120 + h * 256 + cb * 64, N0, nullptr,
                      row0, gamma, p.in[I_SRT] + so, p.out + O_RTS + so, 256, OMIX + 1024 + h * 256 + cb * 64, 2048,
                      smem);
    }
  }
}

DEVI void phase_post0(const Params& p) {
  char* ws = p.ws;
  const float* PROJ = (const float*)(ws + OFF_PROJ);
  const float* OMIX = (const float*)(ws + OFF_OMIX);
  u16* MIXB = (u16*)(ws + OFF_MIXB);
  const float* ng = p.in[I_HNG];
  const int lane = threadIdx.x & 63;
  const int gw = blockIdx.x * 4 + (threadIdx.x >> 6), nw = gridDim.x * 4;
  for (int row = gw; row < M; row += nw) {
    const float* o = OMIX + (size_t)row * 2048;
    const float* pr = PROJ + (size_t)row * N0;
    u16* mo = MIXB + (size_t)row * 2048;
#pragma unroll 2
    for (int h = 0; h < 8; ++h) {
      float a0 = o[h * 128 + lane], a1 = o[h * 128 + 64 + lane];
      float ss = wsum(a0 * a0 + a1 * a1);
      float inv = rsqrtf(ss * (1.0f / 128.0f) + 1e-6f);
      mo[h * 128 + lane] = f2bf(a0 * inv * ng[lane] * pr[3072 + h * 128 + lane]);
      mo[h * 128 + 64 + lane] = f2bf(a1 * inv * ng[64 + lane] * pr[3072 + h * 128 + 64 + lane]);
    }
#pragma unroll 2
    for (int h = 0; h < 4; ++h) {
      float a[4];
      float s = 0.f;
#pragma unroll
      for (int i = 0; i < 4; ++i) {
        a[i] = o[1024 + h * 256 + i * 64 + lane];
        s += a[i];
      }
      float mu = wsum(s) * (1.0f / 256.0f);
      float v = 0.f;
#pragma unroll
      for (int i = 0; i < 4; ++i) {
        a[i] -= mu;
        v += a[i] * a[i];
      }
      float inv = rsqrtf(wsum(v) * (1.0f / 256.0f) + 1e-5f);
#pragma unroll
      for (int i = 0; i < 4; ++i)
        mo[1024 + h * 256 + i * 64 + lane] = f2bf(a[i] * inv * pr[6144 + h * 256 + i * 64 + lane]);
    }
  }
}

DEVI void phase_ln(const Params& p, const float* addsrc, const float* g, const float* bta) {
  char* ws = p.ws;
  float* XF = (float*)(ws + OFF_XF);
  u16* XB = (u16*)(ws + OFF_XB);
  const int lane = threadIdx.x & 63;
  const int gw = blockIdx.x * 4 + (threadIdx.x >> 6), nw = gridDim.x * 4;
  for (int row = gw; row < M; row += nw) {
    float4* xr = (float4*)(XF + (size_t)row * 2048);
    const float4* ar = (const float4*)(addsrc + (size_t)row * 2048);
    float v[32];
    float s = 0.f;
#pragma unroll
    for (int i = 0; i < 8; ++i) {
      float4 x = xr[i * 64 + lane], a = ar[i * 64 + lane];
      v[i * 4 + 0] = ALPHA * x.x + a.x;
      v[i * 4 + 1] = ALPHA * x.y + a.y;
      v[i * 4 + 2] = ALPHA * x.z + a.z;
      v[i * 4 + 3] = ALPHA * x.w + a.w;
      s += v[i * 4 + 0] + v[i * 4 + 1] + v[i * 4 + 2] + v[i * 4 + 3];
    }
    float mu = wsum(s) * (1.0f / 2048.0f);
    float q = 0.f;
#pragma unroll
    for (int i = 0; i < 32; ++i) {
      v[i] -= mu;
      q += v[i] * v[i];
    }
    float inv = rsqrtf(wsum(q) * (1.0f / 2048.0f) + 1e-5f);
#pragma unroll
    for (int i = 0; i < 8; ++i) {
      float4 gg = ((const float4*)g)[i * 64 + lane], bb = ((const float4*)bta)[i * 64 + lane];
      float4 y;
      y.x = v[i * 4 + 0] * inv * gg.x + bb.x;
      y.y = v[i * 4 + 1] * inv * gg.y + bb.y;
      y.z = v[i * 4 + 2] * inv * gg.z + bb.z;
      y.w = v[i * 4 + 3] * inv * gg.w + bb.w;
      xr[i * 64 + lane] = y;
      uint2 o;
      o.x = pack2(y.x, y.y);
      o.y = pack2(y.z, y.w);
      ((uint2*)(XB + (size_t)row * 2048))[i * 64 + lane] = o;
    }
  }
}

typedef __attribute__((ext_vector_type(2))) __bf16 bf2_t;
typedef __attribute__((ext_vector_type(2))) float f32x2;
DEVI float dot2bf(unsigned a, unsigned b, float acc) {
  return __builtin_amdgcn_fdot2_f32_bf16(__builtin_bit_cast(bf2_t, a), __builtin_bit_cast(bf2_t, b), acc, false);
}
template <int CTRL>
DEVI int dppi(int v) {
  return __builtin_amdgcn_update_dpp(v, v, CTRL, 0xF, 0xF, false);
}
DEVI int wmax_i(int v) {
  v = max(v, dppi<0xB1>(v));
  v = max(v, dppi<0x4E>(v));
  v = max(v, dppi<0x141>(v));
  v = max(v, dppi<0x140>(v));
  int a = __builtin_amdgcn_readlane(v, 0), b = __builtin_amdgcn_readlane(v, 16);
  int c = __builtin_amdgcn_readlane(v, 32), d = __builtin_amdgcn_readlane(v, 48);
  return max(max(a, b), max(c, d));
}
DEVI float rlf(float v, int l) { return __int_as_float(__builtin_amdgcn_readlane(__float_as_int(v), l)); }
DEVI float wsum_u(float v) {
  v = red16(v);
  return (rlf(v, 0) + rlf(v, 16)) + (rlf(v, 32) + rlf(v, 48));
}
DEVI int fkey(float f) {
  int u = __float_as_int(f);
  return u ^ ((u >> 31) & 0x7fffffff);
}
DEVI float keyf(int k) { return __int_as_float(k ^ ((k >> 31) & 0x7fffffff)); }

DEVI void phase_peer(const Params& p, int layer, bool final_out) {
  char* ws = p.ws;
  const float* SC = (const float*)(ws + OFF_GOUT);
  float* XF = (float*)(ws + OFF_XF);
  u16* XB = (u16*)(ws + OFF_XB);
  const u16* UB = (const u16*)(ws + OFF_UB);
  const u16* VB = (const u16*)(ws + OFF_VB);
  const float* g = p.in[I_LNG] + (size_t)(layer * 2 + 1) * D;
  const float* bta = p.in[I_LNB] + (size_t)(layer * 2 + 1) * D;
  const int lane = threadIdx.x & 63;
  const int gw = blockIdx.x * 4 + (threadIdx.x >> 6), nw = gridDim.x * 4;
  constexpr int KMIN = (int)0x80000000;
  for (int row = gw; row < M; row += nw) {
    const float* sr = SC + (size_t)row * 2048;
    int eidx0 = 0, eidx1 = 0;
    float gate0 = 0.f, gate1 = 0.f;
#pragma unroll 1
    for (int h = 0; h < 8; ++h) {
      const float* sp = sr + h * 256;
      int ka0 = (fkey(sp[lane]) & ~127) | (127 - lane);
      int kb0 = (fkey(sp[lane + 64]) & ~127) | (63 - lane);
      int ka1 = (fkey(sp[128 + lane]) & ~127) | (127 - lane);
      int kb1 = (fkey(sp[192 + lane]) & ~127) | (63 - lane);
      int my0 = KMIN, my1 = KMIN;
#pragma unroll 1
      for (int r = 0; r < 16; ++r) {
        int K0 = wmax_i(max(ka0, kb0));
        int K1 = wmax_i(max(ka1, kb1));
        my0 = (lane == r) ? K0 : my0;
        my1 = (lane == r) ? K1 : my1;
        ka0 = (ka0 == K0) ? KMIN : ka0;
        kb0 = (kb0 == K0) ? KMIN : kb0;
        ka1 = (ka1 == K1) ? KMIN : ka1;
        kb1 = (kb1 == K1) ? KMIN : kb1;
      }
      float ts0 = keyf(my0 & ~127), ts1 = keyf(my1 & ~127);
      int ti0 = 127 - (my0 & 127), ti1 = 127 - (my1 & 127);
      float s0 = __shfl(ts0, lane >> 2, 64);
      int jb = (lane & 3) * 4;
      int c0 = (fkey(s0 + __shfl(ts1, jb + 0, 64)) & ~255) | (255 - (lane * 4 + 0));
      int c1 = (fkey(s0 + __shfl(ts1, jb + 1, 64)) & ~255) | (255 - (lane * 4 + 1));
      int c2 = (fkey(s0 + __shfl(ts1, jb + 2, 64)) & ~255) | (255 - (lane * 4 + 2));
      int c3 = (fkey(s0 + __shfl(ts1, jb + 3, 64)) & ~255) | (255 - (lane * 4 + 3));
      int myk = KMIN;
#pragma unroll 1
      for (int r = 0; r < 16; ++r) {
        int K = wmax_i(max(max(c0, c1), max(c2, c3)));
        myk = (lane == r) ? K : myk;
        c0 = (c0 == K) ? KMIN : c0;
        c1 = (c1 == K) ? KMIN : c1;
        c2 = (c2 == K) ? KMIN : c2;
        c3 = (c3 == K) ? KMIN : c3;
      }
      float bs = keyf(myk & ~255);
      int bf = 255 - (myk & 255);
      int e = __shfl(ti0, (bf >> 4) & 15, 64) * 128 + __shfl(ti1, bf & 15, 64);
      float mx = rlf(bs, 0);
      float ev = (lane < 16) ? expf(bs - mx) : 0.f;
      float sm = wsum_u(ev);
      float gt = ev / sm;
      int e_b = __shfl(e, lane & 15, 64);
      float g_b = __shfl(gt, lane & 15, 64);
      if ((lane >> 4) == (h & 3)) {
        if (h < 4) {
          eidx0 = e_b;
          gate0 = g_b;
        } else {
          eidx1 = e_b;
          gate1 = g_b;
        }
      }
    }
    u32x4 xp[4];
    {
      const u32x4* xr = (const u32x4*)(XB + (size_t)row * 2048);
#pragma unroll
      for (int j = 0; j < 4; ++j) xp[j] = xr[j * 64 + lane];
    }
    float dv0 = 0.f, dv1 = 0.f;
    {
      constexpr int R = 8;
      u32x4 w[R][4];
      auto load_row = [&](int pidx, u32x4(&wr)[4]) {
        int src = (pidx < 64) ? eidx0 : eidx1;
        int e = __builtin_amdgcn_readlane(src, pidx & 63);
        const u32x4* ur = (const u32x4*)(UB + (size_t)e * 2048);
#pragma unroll
        for (int j = 0; j < 4; ++j) wr[j] = ur[j * 64 + lane];
      };
#pragma unroll
      for (int u = 0; u < R; ++u) load_row(u, w[u]);
#pragma unroll 1
      for (int p0 = 0; p0 < 128; p0 += R) {
#pragma unroll
        for (int u = 0; u < R; ++u) {
          float d = 0.f;
#pragma unroll
          for (int j = 0; j < 4; ++j) {
            d = dot2bf(w[u][j].x, xp[j].x, d);
            d = dot2bf(w[u][j].y, xp[j].y, d);
            d = dot2bf(w[u][j].z, xp[j].z, d);
            d = dot2bf(w[u][j].w, xp[j].w, d);
          }
          if (p0 + R < 128) load_row(p0 + R + u, w[u]);
          d = wsum_u(d);
          int pl = (p0 + u) & 63;
          if (p0 < 64) dv0 = (lane == pl) ? d : dv0;
          else dv1 = (lane == pl) ? d : dv1;
        }
      }
    }
    float coef0 = 0.5f * dv0 * (1.0f + erff(dv0 * 0.70710678118f)) * gate0;
    float coef1 = 0.5f * dv1 * (1.0f + erff(dv1 * 0.70710678118f)) * gate1;
    f32x2 o2[16];
#pragma unroll
    for (int i = 0; i < 16; ++i) o2[i] = f32x2{0.f, 0.f};
    {
      constexpr int R = 4;
      u32x4 w[R][4];
      auto load_row = [&](int pidx, u32x4(&wr)[4]) {
        int src = (pidx < 64) ? eidx0 : eidx1;
        int e = __builtin_amdgcn_readlane(src, pidx & 63);
        const u32x4* vr = (const u32x4*)(VB + (size_t)e * 2048);
#pragma unroll
        for (int j = 0; j < 4; ++j) wr[j] = vr[j * 64 + lane];
      };
#pragma unroll
      for (int u = 0; u < R; ++u) load_row(u, w[u]);
#pragma unroll 1
      for (int p0 = 0; p0 < 128; p0 += R) {
        float cfs = (p0 < 64) ? coef0 : coef1;
#pragma unroll
        for (int u = 0; u < R; ++u) {
          float c = rlf(cfs, (p0 + u) & 63);
          f32x2 cc = f32x2{c, c};
#pragma unroll
          for (int j = 0; j < 4; ++j) {
            unsigned wx = w[u][j].x, wy = w[u][j].y, wz = w[u][j].z, ww = w[u][j].w;
            o2[j * 4 + 0] += cc * f32x2{bflo(wx), bfhi(wx)};
            o2[j * 4 + 1] += cc * f32x2{bflo(wy), bfhi(wy)};
            o2[j * 4 + 2] += cc * f32x2{bflo(wz), bfhi(wz)};
            o2[j * 4 + 3] += cc * f32x2{bflo(ww), bfhi(ww)};
          }
          if (p0 + R < 128) load_row(p0 + R + u, w[u]);
        }
      }
    }
    float o[32];
#pragma unroll
    for (int i = 0; i < 16; ++i) {
      o[2 * i] = o2[i].x;
      o[2 * i + 1] = o2[i].y;
    }
    float s = 0.f;
    {
      const float4* xr = (const float4*)(XF + (size_t)row * 2048);
#pragma unroll
      for (int j = 0; j < 4; ++j) {
        float4 x0 = xr[j * 128 + lane * 2], x1 = xr[j * 128 + lane * 2 + 1];
        o[j * 8 + 0] += ALPHA * x0.x; o[j * 8 + 1] += ALPHA * x0.y; o[j * 8 + 2] += ALPHA * x0.z; o[j * 8 + 3] += ALPHA * x0.w;
        o[j * 8 + 4] += ALPHA * x1.x; o[j * 8 + 5] += ALPHA * x1.y; o[j * 8 + 6] += ALPHA * x1.z; o[j * 8 + 7] += ALPHA * x1.w;
      }
#pragma unroll
      for (int i = 0; i < 32; ++i) s += o[i];
    }
    float mu = wsum_u(s) * (1.0f / 2048.0f);
    float q = 0.f;
#pragma unroll
    for (int i = 0; i < 32; ++i) {
      o[i] -= mu;
      q += o[i] * o[i];
    }
    float inv = rsqrtf(wsum_u(q) * (1.0f / 2048.0f) + 1e-5f);
    float* dstf;
    if (final_out) {
      if (row < MPR) {
        int b = row / TP, t = row % TP;
        dstf = (t >= 16) ? (p.out + O_YP + ((size_t)b * 2048 + (t - 16)) * D) : nullptr;
      } else {
        dstf = p.out + O_YS + (size_t)(row - MPR) * D;
      }
    } else {
      dstf = XF + (size_t)row * 2048;
    }
#pragma unroll
    for (int j = 0; j < 4; ++j) {
      const float4* gp = (const float4*)(g + j * 512 + lane * 8);
      const float4* bp = (const float4*)(bta + j * 512 + lane * 8);
      float4 g0 = gp[0], g1 = gp[1], b0 = bp[0], b1 = bp[1];
      float4 y0, y1;
      y0.x = o[j * 8 + 0] * inv * g0.x + b0.x; y0.y = o[j * 8 + 1] * inv * g0.y + b0.y;
      y0.z = o[j * 8 + 2] * inv * g0.z + b0.z; y0.w = o[j * 8 + 3] * inv * g0.w + b0.w;
      y1.x = o[j * 8 + 4] * inv * g1.x + b1.x; y1.y = o[j * 8 + 5] * inv * g1.y + b1.y;
      y1.z = o[j * 8 + 6] * inv * g1.z + b1.z; y1.w = o[j * 8 + 7] * inv * g1.w + b1.w;
      if (dstf) {
        ((float4*)(dstf + j * 512 + lane * 8))[0] = y0;
        ((float4*)(dstf + j * 512 + lane * 8))[1] = y1;
      }
      if (!final_out) {
        uint4 pk = make_uint4(pack2(y0.x, y0.y), pack2(y0.z, y0.w), pack2(y1.x, y1.y), pack2(y1.z, y1.w));
        ((uint4*)(XB + (size_t)row * 2048))[j * 64 + lane] = pk;
      }
    }
  }
}

DEVI void phase_pre1(const Params& p) {
  char* ws = p.ws;
  const float* PROJ = (const float*)(ws + OFF_PROJ);
  float* XC = (float*)(ws + OFF_GOUT);
  float* RKV = (float*)(ws + OFF_RKV);
  u16* LRA = (u16*)(ws + OFF_LRA);
  u16* LRB = (u16*)(ws + OFF_LRB);
  u16* LRG = (u16*)(ws + OFF_LRG);
  const float* cw = p.in[I_CVW];
  const float* cbias = p.in[I_CVB];
  const float* mu = p.in[I_MU];
  const int lane = threadIdx.x & 63;
  const int gw = blockIdx.x * 4 + (threadIdx.x >> 6), nw = gridDim.x * 4;
  for (int row = gw; row < M; row += nw) {
    const bool prompt = row < MPR;
    int b, t, T;
    if (prompt) { b = row / TP; t = row % TP; T = TP; }
    else { b = (row - MPR) >> 2; t = (row - MPR) & 3; T = 4; }
    const float* pr = PROJ + (size_t)row * N1;
    for (int c = lane; c < 1536; c += 64) {
      float acc = cbias[c];
#pragma unroll
      for (int jj = 0; jj < 4; ++jj) {
        int tt = t - 3 + jj;
        float xv;
        if (tt >= 0) xv = PROJ[(size_t)(row - 3 + jj) * N1 + 1024 + c];
        else xv = prompt ? 0.f : p.in[I_SCV][(size_t)(b * 3 + (tt + 3)) * 1536 + c];
        acc += xv * cw[jj * 1536 + c];
      }
      XC[(size_t)row * 1536 + c] = siluf_(acc);
      if (t >= T - 3) {
        int j = t - (T - 3);
        float* co = prompt ? (p.out + O_CVP) : (p.out + O_CVS);
        co[(size_t)(b * 3 + j) * 1536 + c] = pr[1024 + c];
      }
    }
    for (int c = lane; c < 3360; c += 64) {
      float cur = pr[2560 + c];
      float prev;
      if (t > 0) prev = PROJ[(size_t)(row - 1) * N1 + 2560 + c];
      else prev = prompt ? 0.f : p.in[I_SSH][(size_t)b * 3360 + c];
      float mixed = cur + (prev - cur) * mu[c];
      if (c < 3072) RKV[(size_t)row * 3072 + c] = mixed;
      else if (c < 3136) LRA[(size_t)row * 64 + (c - 3072)] = f2bf(tanhf(mixed));
      else if (c < 3200) LRB[(size_t)row * 64 + (c - 3136)] = f2bf(mixed);
      else LRG[(size_t)row * 192 + (c - 3200)] = f2bf(sigmoidf_(mixed));
      if (t == T - 1) {
        float* so = prompt ? (p.out + O_SHP) : (p.out + O_SHS);
        so[(size_t)b * 3360 + c] = cur;
      }
    }
    if (lane < 32) LRG[(size_t)row * 192 + 160 + lane] = 0;
  }
}

DEVI void phase_pre1c(const Params& p) {
  char* ws = p.ws;
  float* RKV = (float*)(ws + OFF_RKV);
  const float* AA = (const float*)(ws + OFF_AA);
  float* KK = (float*)(ws + OFF_QB);
  float* KKA = (float*)(ws + OFF_MIXB);
  float* BON = (float*)(ws + OFF_BON);
  const float* k_k = p.in[I_KK];
  const float* k_a = p.in[I_KA];
  const float* r_k = p.in[I_RK];
  const int lane = threadIdx.x & 63;
  const int gw = blockIdx.x * 4 + (threadIdx.x >> 6), nw = gridDim.x * 4;
  for (int row = gw; row < M; row += nw) {
#pragma unroll 4
    for (int h = 0; h < 16; ++h) {
      int c = h * 64 + lane;
      float k = RKV[(size_t)row * 3072 + 1024 + c];
      float r = RKV[(size_t)row * 3072 + c];
      float a = AA[(size_t)row * 1024 + c];
      float kkr = k * k_k[c];
      float ss = wsum(kkr * kkr);
      float kk = kkr / fmaxf(sqrtf(ss), 1e-12f);
      float kp = k * (1.0f + (a - 1.0f) * k_a[c]);
      float bon = wsum(r * kp * r_k[c]);
      KK[(size_t)row * 1024 + c] = kk;
      KKA[(size_t)row * 1024 + c] = kk * a;
      RKV[(size_t)row * 3072 + 1024 + c] = kp;
      if (lane == 0) BON[(size_t)row * 16 + h] = bon;
    }
  }
}

DEVI void phase_rec1(const Params& p, float* smem) {
  char* ws = p.ws;
  const float* XC = (const float*)(ws + OFF_GOUT);
  const float* RKV = (const float*)(ws + OFF_RKV);
  const float* DEC = (const float*)(ws + OFF_DEC);
  const float* KK = (const float*)(ws + OFF_QB);
  const float* KKA = (const float*)(ws + OFF_MIXB);
  const float* DTA = (const float*)(ws + OFF_DTA);
  float* OMIX = (float*)(ws + OFF_OMIX);
  const float* wsf = (const float*)ws;
  constexpr int XO = (int)(OFF_GOUT / 4), DO = (int)(OFF_DTA / 4), RO = (int)(OFF_RKV / 4), CO = (int)(OFF_DEC / 4),
                KO = (int)(OFF_QB / 4), AO = (int)(OFF_MIXB / 4);
  for (int item = blockIdx.x; item < 10624; item += gridDim.x) {
    if (item < 128) {
      int b = item >> 5, h = (item >> 1) & 15, cb = item & 1;
      int g = h >> 3;
      Seg sg[4] = {{XO + 1024 + g * 128, 1536, 32}, {XO + 1280 + g * 128, 1536, 32}, {XO + h * 64 + cb * 32, 1536, 8},
                   {DO + h * 4, 64, 1}};
      int row0 = b * TP;
#ifndef NO_LONG
      colrec_long<2>(wsf, sg, row0, TP, 0.f, OMIX + (size_t)row0 * 2048 + h * 64 + cb * 32, 2048,
                     p.out + O_SSP + (size_t)(b * 16 + h) * 128 * 64 + cb * 32, 64, smem);
#endif
    } else if (item < 384 || item >= 2432) {
      bool prompt = item < 384;
      int it = prompt ? (item - 128) : (item - 2432);
      int b = it >> 6, h = (it >> 2) & 15, rb = it & 3;
      int row0 = prompt ? b * TP : (MPR + b * 4);
      int T = prompt ? TP : 4;
      Seg sg[6] = {{RO + h * 64, 3072, 16}, {CO + h * 64, 1024, 16}, {RO + 1024 + h * 64, 3072, 16},
                   {KO + h * 64, 1024, 16}, {AO + h * 64, 1024, 16}, {RO + 2048 + h * 64 + rb * 16, 3072, 4}};
      size_t so = ((size_t)(b * 16 + h) * 64 + rb * 16) * 64;
      const float* stin = prompt ? nullptr : (p.in[I_SWK] + so);
      float* stout = (prompt ? (p.out + O_WKP) : (p.out + O_WKS)) + so;
#ifndef NO_RWKV
      rwkv_item(wsf, sg, row0, T, stin, stout, OMIX + (size_t)row0 * 2048 + 1024 + h * 64 + rb * 16, 2048, smem);
#endif
    } else {
      int it = item - 384;
      int b = it >> 4, h = it & 15;
      int g = h >> 3;
      long row0 = MPR + (long)b * 4;
      size_t so = (size_t)(b * 16 + h) * 128 * 64;
#ifndef NO_SHORT
      colrec_short<2>(XC + 1024 + g * 128, 1536, XC + 1280 + g * 128, 1536, XC + h * 64, 1536, DTA + h * 4, row0, 0.f,
                      p.in[I_SSM] + so, p.out + O_SSS + so, 64, OMIX + h * 64, 2048, smem);
#endif
    }
  }
}

DEVI void phase_post1(const Params& p) {
  char* ws = p.ws;
  const float* PROJ = (const float*)(ws + OFF_PROJ);
  const float* OMIX = (const float*)(ws + OFF_OMIX);
  const float* XC = (const float*)(ws + OFF_GOUT);
  const float* RKV = (const float*)(ws + OFF_RKV);
  const float* GG = (const float*)(ws + OFF_GG);
  const float* BON = (const float*)(ws + OFF_BON);
  u16* MIXB = (u16*)(ws + OFF_MIXB);
  const float* dsk = p.in[I_DSK];
  const float* sng = p.in[I_SNG];
  const float* lxg = p.in[I_LXG];
  const float* lxb = p.in[I_LXB];
  const int lane = threadIdx.x & 63;
  const int gw = blockIdx.x * 4 + (threadIdx.x >> 6), nw = gridDim.x * 4;
  for (int row = gw; row < M; row += nw) {
    const float* o = OMIX + (size_t)row * 2048;
    u16* mo = MIXB + (size_t)row * 2048;
#pragma unroll 1
    for (int grp = 0; grp < 2; ++grp) {
      float v[8];
      float ss = 0.f;
#pragma unroll
      for (int i = 0; i < 8; ++i) {
        int c = grp * 512 + i * 64 + lane;
        v[i] = (o[c] + XC[(size_t)row * 1536 + c] * dsk[c >> 6]) * PROJ[(size_t)row * N1 + c];
        ss += v[i] * v[i];
      }
      float inv = rsqrtf(wsum(ss) * (1.0f / 512.0f) + 1e-6f);
#pragma unroll
      for (int i = 0; i < 8; ++i) {
        int c = grp * 512 + i * 64 + lane;
        mo[c] = f2bf(v[i] * inv * sng[c]);
      }
    }
#pragma unroll 4
    for (int h = 0; h < 16; ++h) {
      int c = h * 64 + lane;
      float y = o[1024 + c];
      float mu = wsum(y) * (1.0f / 64.0f);
      float d = y - mu;
      float var = wsum(d * d) * (1.0f / 64.0f);
      float yn = d * rsqrtf(var + 64e-5f) * lxg[c] + lxb[c];
      yn += BON[(size_t)row * 16 + h] * RKV[(size_t)row * 3072 + 2048 + c];
      yn *= GG[(size_t)row * 1024 + c];
      mo[1024 + c] = f2bf(yn);
    }
  }
}

template <int ph>
DEVI void run_phase(const Params& p, char* smem_raw) {
  float* smem = (float*)smem_raw;
  char* ws = p.ws;
  {
    switch (ph) {
      case 0: phase0(p, smem); break;
      case 1: {
        float* PROJ = (float*)(ws + OFF_PROJ);
        const float* LB = (const float*)(ws + OFF_LB);
        const double* IR = (const double*)(ws + OFF_INVREV);
        gemm_phase((const u16*)(ws + OFF_XB), 2048, 0, (const u16*)(ws + OFF_WIN0), 2048, MP / 128, N0 / 128, smem_raw,
                   [=](int row, int col, float v0, float v1) {
                     float* pr = PROJ + (size_t)row * N0;
                     if (col < 1024 || (col >= 3072 && col < 4096) || col >= 6144) {
                       pr[col] = siluf_(v0);
                       pr[col + 32] = siluf_(v1);
                     } else if (col < 2048) {
                       float l0 = LB[col - 1024], l1 = LB[col - 1024 + 32];
                       pr[col] = l0 + (1.0f - l0) * sigmoidf_(v0);
                       pr[col + 32] = l1 + (1.0f - l1) * sigmoidf_(v1);
                     } else if (col >= 4096 && col < 5120) {
                       int hb = col & ~127, c = col & 127, span = c >> 6, pp = c & 63;
                       int d = span * 32 + pp;
                       double rev = (double)row_pos(row) * IR[d];
                       float fr = (float)(rev - floor(rev));
                       float sn = __builtin_amdgcn_sinf(fr), cs = __builtin_amdgcn_cosf(fr);
                       float sc = (col >= 4608) ? 0.08838834764831845f : 1.0f;
                       pr[hb + d] = (v0 * cs - v1 * sn) * sc;
                       pr[hb + 64 + d] = (v0 * sn + v1 * cs) * sc;
                     } else {
                       pr[col] = v0;
                       pr[col + 32] = v1;
                     }
                   });
      } break;
      case 2: phase_rec0(p, smem); break;
      case 3: phase_post0(p); break;
      case 4: case 15: {
        float* GO = (float*)(ws + OFF_GOUT);
        gemm_phase((const u16*)(ws + OFF_MIXB), 2048, 0, (const u16*)(ws + (ph == 4 ? OFF_WOUT0 : OFF_WOUT1)), 2048,
                   MP / 128, 16, smem_raw, [=](int row, int col, float v0, float v1) {
                     GO[(size_t)row * 2048 + col] = v0;
                     GO[(size_t)row * 2048 + col + 32] = v1;
                   });
      } break;
      case 5: case 16: {
        int l = (ph == 5) ? 0 : 1;
        phase_ln(p, (const float*)(ws + OFF_GOUT), p.in[I_LNG] + (size_t)(l * 2) * D, p.in[I_LNB] + (size_t)(l * 2) * D);
      } break;
      case 6: case 17: {
        u16* QB = (u16*)(ws + OFF_QB);
        gemm_phase((const u16*)(ws + OFF_XB), 2048, 0, (const u16*)(ws + (ph == 6 ? OFF_WQ0 : OFF_WQ1)), 2048, MP / 128,
                   16, smem_raw, [=](int row, int col, float v0, float v1) {
                     QB[(size_t)row * 2048 + col] = f2bf(v0);
                     QB[(size_t)row * 2048 + col + 32] = f2bf(v1);
                   });
      } break;
      case 7: case 18: {
        float* SC = (float*)(ws + OFF_GOUT);
        gemm_phase((const u16*)(ws + OFF_QB), 2048, 128, (const u16*)(ws + (ph == 7 ? OFF_KEY0 : OFF_KEY1)), 128,
                   MP / 128, 16, smem_raw, [=](int row, int col, float v0, float v1) {
                     SC[(size_t)row * 2048 + col] = v0;
                     SC[(size_t)row * 2048 + col + 32] = v1;
                   });
      } break;
      case 8: phase_peer(p, 0, false); break;
      case 9: {
        conv_bf16_flat(p.in[I_PU] + (size_t)16384 * 2048, (u16*)(ws + OFF_UB), (size_t)16384 * 2048 / 4);
        conv_bf16_flat(p.in[I_PV] + (size_t)16384 * 2048, (u16*)(ws + OFF_VB), (size_t)16384 * 2048 / 4);
        float* PROJ = (float*)(ws + OFF_PROJ);
        float* DTA = (float*)(ws + OFF_DTA);
        const float* dtb = p.in[I_DTB];
        const float* alog = p.in[I_ALOG];
        gemm_phase((const u16*)(ws + OFF_XB), 2048, 0, (const u16*)(ws + OFF_WIN1), 2048, MP / 128, N1 / 128, smem_raw,
                   [=](int row, int col, float v0, float v1) {
                     float* pr = PROJ + (size_t)row * N1;
                     if (col < 1024) {
                       pr[col] = siluf_(v0);
                       pr[col + 32] = siluf_(v1);
                     } else if (col < 5888) {
                       pr[col] = v0;
                       pr[col + 32] = v1;
                     } else {
#pragma unroll
                       for (int e = 0; e < 2; ++e) {
                         int cc = col + e * 32;
                         float v = e ? v1 : v0;
                         if (cc < 5920) pr[cc] = v;
                         else if (cc < 5936) {
                           int h = cc - 5920;
                           float dt = softplusf_(v + dtb[h]);
                           DTA[(size_t)row * 64 + h * 4] = dt;
                           DTA[(size_t)row * 64 + h * 4 + 1] = expf(-dt * expf(alog[h]));
                         }
                       }
                     }
                   });
      } break;
      case 10: phase_pre1(p); break;
      case 11: {
        float* DEC = (float*)(ws + OFF_DEC);
        float* AA = (float*)(ws + OFF_AA);
        float* GG = (float*)(ws + OFF_GG);
        const float* w0 = p.in[I_W0];
        const float* a0 = p.in[I_A0];
        gemm_phase((const u16*)(ws + OFF_LRA), 64, 0, (const u16*)(ws + OFF_W2T), 64, MP / 128, 8, smem_raw,
                   [=](int row, int col, float v0, float v1) {
#pragma unroll
                     for (int e = 0; e < 2; ++e) {
                       int cc = col + e * 32;
                       float v = (e ? v1 : v0) + w0[cc];
                       float wl = -softplusf_(-v) - 0.5f;
                       DEC[(size_t)row * 1024 + cc] = expf(-expf(wl));
                     }
                   });
        gemm_phase((const u16*)(ws + OFF_LRB), 64, 0, (const u16*)(ws + OFF_A2T), 64, MP / 128, 8, smem_raw,
                   [=](int row, int col, float v0, float v1) {
                     AA[(size_t)row * 1024 + col] = sigmoidf_(v0 + a0[col]);
                     AA[(size_t)row * 1024 + col + 32] = sigmoidf_(v1 + a0[col + 32]);
                   });
        gemm_phase((const u16*)(ws + OFF_LRG), 192, 0, (const u16*)(ws + OFF_G2T), 192, MP / 128, 8, smem_raw,
                   [=](int row, int col, float v0, float v1) {
                     GG[(size_t)row * 1024 + col] = v0;
                     GG[(size_t)row * 1024 + col + 32] = v1;
                   });
      } break;
      case 12: phase_pre1c(p); break;
      case 13: phase_rec1(p, smem); break;
      case 14: phase_post1(p); break;
      case 19: phase_peer(p, 1, true); break;
      default: break;
    }
  }
}

__global__ void __launch_bounds__(256, 2) mega(Params p, int ph_lo, int ph_hi) {
  __shared__ __attribute__((aligned(16))) char smem_raw[SMEM_BYTES];
  cg::grid_group grid = cg::this_grid();
#ifndef REPEAT_MASK
#define REPEAT_MASK 0
#endif
#define PHASE(K)                                          \
  if (ph_lo <= K && K < ph_hi) run_phase<K>(p, smem_raw); \
  if ((REPEAT_MASK >> K) & 1) { grid.sync(); run_phase<K>(p, smem_raw); } \
  if (ph_lo <= K && K + 1 < ph_hi) grid.sync();
  PHASE(0) PHASE(1) PHASE(2) PHASE(3) PHASE(4) PHASE(5) PHASE(6) PHASE(7) PHASE(8) PHASE(9)
  PHASE(10) PHASE(11) PHASE(12) PHASE(13) PHASE(14) PHASE(15) PHASE(16) PHASE(17) PHASE(18) PHASE(19)
}
#ifdef PHASE_TEST
template <int PH>
__global__ void __launch_bounds__(256, 2) phk(Params p) {
  __shared__ __attribute__((aligned(16))) char smem_raw[SMEM_BYTES];
  run_phase<PH>(p, smem_raw);
}
#define INST(N) template __global__ void phk<N>(Params);
INST(0) INST(1) INST(2) INST(3) INST(4) INST(5) INST(6) INST(7) INST(8) INST(9) INST(10) INST(11) INST(12) INST(13) INST(14) INST(19)
#endif

constexpr int NPHASE = 20;

extern "C" void kernel_launch(void* const* d_in, const int* in_sizes, int n_in, void* d_out, int out_size, void* d_ws,
                              size_t ws_size, hipStream_t stream) {
  static int grid_blocks = 0;
  if (!grid_blocks) {
    int dev = 0, cus = 0, per_cu = 0;
    hipGetDevice(&dev);
    hipDeviceGetAttribute(&cus, hipDeviceAttributeMultiprocessorCount, dev);
    hipOccupancyMaxActiveBlocksPerMultiprocessor(&per_cu, mega, 256, 0);
    if (per_cu > 2) per_cu = 2;
    if (per_cu < 1) per_cu = 1;
    grid_blocks = cus * per_cu;
  }
  Params p{};
  for (int i = 0; i < 38; ++i) p.in[i] = (const float*)d_in[i];
  p.out = (float*)d_out;
  p.ws = (char*)d_ws;
  int lo = 0, hi = NPHASE;
  void* args[] = {&p, &lo, &hi};
  hipError_t e = hipLaunchCooperativeKernel((void*)mega, dim3(grid_blocks), dim3(256), args, 0, stream);
  if (e != hipSuccess) fprintf(stderr, "cooperative launch failed: %s (grid %d)\n", hipGetErrorString(e), grid_blocks);
}
```

```cpp
#include <hip/hip_runtime.h>
#include <hip/hip_bf16.h>
#include <hip/hip_cooperative_groups.h>
#include <cstdio>
#include <cmath>
namespace cg = cooperative_groups;

#define DEVI __device__ __forceinline__
typedef unsigned short u16;
using bf16x8 = __attribute__((ext_vector_type(8))) short;
using f32x4 = __attribute__((ext_vector_type(4))) float;
using u32x4 = __attribute__((ext_vector_type(4))) unsigned int;

constexpr int D = 2048;
constexpr int TP = 2064;
constexpr int MPR = 8256;
constexpr int M = 8768;
constexpr int MP = 8832;
constexpr int N0 = 7168;
constexpr int N1 = 6016;
constexpr float ALPHA = 1.41421356237f;

constexpr size_t SZ_TAB = (size_t)16384 * 2048 * 2;
constexpr size_t OFF_UB = 0;
constexpr size_t OFF_VB = OFF_UB + SZ_TAB;
constexpr size_t OFF_WIN0 = OFF_VB + SZ_TAB;
constexpr size_t OFF_WOUT0 = OFF_WIN0 + (size_t)N0 * 2048 * 2;
constexpr size_t OFF_WQ0 = OFF_WOUT0 + (size_t)2048 * 2048 * 2;
constexpr size_t OFF_KEY0 = OFF_WQ0 + (size_t)2048 * 2048 * 2;
constexpr size_t OFF_WIN1 = OFF_KEY0 + (size_t)16 * 128 * 128 * 2;
constexpr size_t OFF_WOUT1 = OFF_WIN1 + (size_t)N1 * 2048 * 2;
constexpr size_t OFF_WQ1 = OFF_WOUT1 + (size_t)2048 * 2048 * 2;
constexpr size_t OFF_KEY1 = OFF_WQ1 + (size_t)2048 * 2048 * 2;
constexpr size_t OFF_W2T = OFF_KEY1 + (size_t)16 * 128 * 128 * 2;
constexpr size_t OFF_A2T = OFF_W2T + (size_t)1024 * 64 * 2;
constexpr size_t OFF_G2T = OFF_A2T + (size_t)1024 * 64 * 2;
constexpr size_t OFF_LB = OFF_G2T + (size_t)1024 * 192 * 2;
constexpr size_t OFF_INVREV = OFF_LB + 1024 * 4;
constexpr size_t OFF_XF = OFF_INVREV + 64 * 8;
constexpr size_t OFF_XB = OFF_XF + (size_t)MP * 2048 * 4;
constexpr size_t OFF_PROJ = OFF_XB + (size_t)MP * 2048 * 2;
constexpr size_t OFF_GOUT = OFF_PROJ + (size_t)MP * N0 * 4;
constexpr size_t OFF_OMIX = OFF_GOUT + (size_t)MP * 2048 * 4;
constexpr size_t OFF_MIXB = OFF_OMIX + (size_t)MP * 2048 * 4;
constexpr size_t OFF_QB = OFF_MIXB + (size_t)MP * 2048 * 2;
constexpr size_t OFF_RKV = OFF_QB + (size_t)MP * 2048 * 2;
constexpr size_t OFF_DEC = OFF_RKV + (size_t)MP * 3072 * 4;
constexpr size_t OFF_AA = OFF_DEC + (size_t)MP * 1024 * 4;
constexpr size_t OFF_GG = OFF_AA + (size_t)MP * 1024 * 4;
constexpr size_t OFF_LRA = OFF_GG + (size_t)MP * 1024 * 4;
constexpr size_t OFF_LRB = OFF_LRA + (size_t)MP * 64 * 2;
constexpr size_t OFF_LRG = OFF_LRB + (size_t)MP * 64 * 2;
constexpr size_t OFF_DTA = OFF_LRG + (size_t)MP * 192 * 2;
constexpr size_t OFF_BON = OFF_DTA + (size_t)MP * 64 * 4;
constexpr size_t OFF_USC = OFF_BON + (size_t)MP * 16 * 4;
constexpr size_t OFF_VSC = OFF_USC + 16384 * 4;
constexpr size_t WS_TOTAL = OFF_VSC + 16384 * 4;
static_assert(WS_TOTAL <= (size_t)1 << 30, "workspace too large");

constexpr size_t O_YP = 0;
constexpr size_t O_YS = O_YP + (size_t)4 * 2048 * 2048;
constexpr size_t O_HGP = O_YS + (size_t)128 * 4 * 2048;
constexpr size_t O_HGS = O_HGP + (size_t)4 * 8 * 128 * 128;
constexpr size_t O_RTP = O_HGS + (size_t)128 * 8 * 128 * 128;
constexpr size_t O_RTS = O_RTP + (size_t)4 * 4 * 128 * 256;
constexpr size_t O_SSP = O_RTS + (size_t)128 * 4 * 128 * 256;
constexpr size_t O_SSS = O_SSP + (size_t)4 * 16 * 128 * 64;
constexpr size_t O_CVP = O_SSS + (size_t)128 * 16 * 128 * 64;
constexpr size_t O_CVS = O_CVP + (size_t)4 * 3 * 1536;
constexpr size_t O_WKP = O_CVS + (size_t)128 * 3 * 1536;
constexpr size_t O_WKS = O_WKP + (size_t)4 * 16 * 64 * 64;
constexpr size_t O_SHP = O_WKS + (size_t)128 * 16 * 64 * 64;
constexpr size_t O_SHS = O_SHP + (size_t)4 * 3360;

struct Params {
  const float* in[38];
  float* out;
  char* ws;
};
enum { I_XP = 0, I_XS, I_SHG, I_SRT, I_SSM, I_SCV, I_SWK, I_SSH, I_META, I_LNG, I_LNB, I_EWIN, I_LBL, I_HNG, I_EWOUT,
       I_OWIN, I_CVW, I_CVB, I_DTB, I_ALOG, I_DSK, I_SNG, I_MU, I_W0, I_W2, I_A0, I_A2, I_G2, I_KK, I_KA, I_RK,
       I_LXG, I_LXB, I_OWOUT, I_WQ, I_KEYS, I_PU, I_PV };

constexpr int SMEM_BYTES = 2 * 16 * 336 * 4 + 2 * 16 * 32 * 4;

DEVI u16 f2bf(float f) {
  unsigned u = __float_as_uint(f);
  u += 0x7fffu + ((u >> 16) & 1u);
  return (u16)(u >> 16);
}
DEVI unsigned pack2(float a, float b) { return (unsigned)f2bf(a) | ((unsigned)f2bf(b) << 16); }
DEVI float bflo(unsigned u) { return __uint_as_float(u << 16); }
DEVI float bfhi(unsigned u) { return __uint_as_float(u & 0xffff0000u); }
DEVI float sigmoidf_(float x) { return 1.0f / (1.0f + expf(-x)); }
DEVI float siluf_(float x) { return x / (1.0f + expf(-x)); }
DEVI float softplusf_(float x) { return fmaxf(x, 0.0f) + log1pf(expf(-fabsf(x))); }
DEVI float wsum(float v) {
#pragma unroll
  for (int o = 32; o > 0; o >>= 1) v += __shfl_xor(v, o, 64);
  return v;
}
DEVI float wmaxf_(float v) {
#pragma unroll
  for (int o = 32; o > 0; o >>= 1) v = fmaxf(v, __shfl_xor(v, o, 64));
  return v;
}
DEVI int wmini_(int v) {
#pragma unroll
  for (int o = 32; o > 0; o >>= 1) v = min(v, __shfl_xor(v, o, 64));
  return v;
}
template <int CTRL>
DEVI float dppf(float v) {
  return __int_as_float(__builtin_amdgcn_update_dpp(0, __float_as_int(v), CTRL, 0xF, 0xF, true));
}
DEVI float red8(float v) {
  v += dppf<0xB1>(v);
  v += dppf<0x4E>(v);
  v += dppf<0x141>(v);
  return v;
}
DEVI float red16(float v) {
  v = red8(v);
  v += dppf<0x140>(v);
  return v;
}
DEVI int row_pos(int row) { return row < MPR ? (row % TP) : (16384 + ((row - MPR) & 3)); }

DEVI void conv_bf16_flat(const float* __restrict__ src, u16* __restrict__ dst, size_t n4) {
  size_t stride = (size_t)gridDim.x * blockDim.x;
  for (size_t i = (size_t)blockIdx.x * blockDim.x + threadIdx.x; i < n4; i += stride) {
    float4 v = ((const float4*)src)[i];
    uint2 o;
    o.x = pack2(v.x, v.y);
    o.y = pack2(v.z, v.w);
    ((uint2*)dst)[i] = o;
  }
}

template <int MODE>
DEVI int colmap(int j) {
  if (MODE == 0) return j;
  if (MODE == 1) {
    if (j < 4096 || j >= 5120) return j;
    int hb = j & ~127, c = j & 127, span = c >> 6, p = c & 63;
    int d = (p < 32) ? (span * 32 + p) : (64 + span * 32 + (p - 32));
    return hb + d;
  }
  if (j < 2560) return j;
  if (j < 5920) return j + 16;
  if (j < 5936) return 2560 + (j - 5920);
  return -1;
}

template <int MODE>
DEVI void transpose_job(const float* __restrict__ src, int ldsrc, int Ksrc, u16* __restrict__ dst, int Kdst, int ndst,
                        float* smem) {
  int ktiles = Kdst / 64, ntiles = ndst / 64;
  int tid = threadIdx.x;
  for (int tile = blockIdx.x; tile < ktiles * ntiles; tile += gridDim.x) {
    int tn = tile / ktiles, tk = tile % ktiles;
    int j0 = tn * 64, k0 = tk * 64;
    int jj = tid & 63;
    int sc = colmap<MODE>(j0 + jj);
#pragma unroll
    for (int i = 0; i < 16; ++i) {
      int kk = i * 4 + (tid >> 6);
      float v = 0.f;
      if (sc >= 0 && (k0 + kk) < Ksrc) v = src[(size_t)(k0 + kk) * ldsrc + sc];
      smem[kk * 65 + jj] = v;
    }
    __syncthreads();
    int jr = tid >> 2, kq = (tid & 3) * 16;
    unsigned pk[8];
#pragma unroll
    for (int e = 0; e < 8; ++e) pk[e] = pack2(smem[(kq + 2 * e) * 65 + jr], smem[(kq + 2 * e + 1) * 65 + jr]);
    uint4* dp = (uint4*)(dst + (size_t)(j0 + jr) * Kdst + k0 + kq);
    dp[0] = make_uint4(pk[0], pk[1], pk[2], pk[3]);
    dp[1] = make_uint4(pk[4], pk[5], pk[6], pk[7]);
    __syncthreads();
  }
}

DEVI void phase0(const Params& p, float* smem) {
  char* ws = p.ws;
  conv_bf16_flat(p.in[I_KEYS], (u16*)(ws + OFF_KEY0), (size_t)16 * 128 * 128 / 4);
  conv_bf16_flat(p.in[I_KEYS] + (size_t)16 * 128 * 128, (u16*)(ws + OFF_KEY1), (size_t)16 * 128 * 128 / 4);
  transpose_job<1>(p.in[I_EWIN], N0, 2048, (u16*)(ws + OFF_WIN0), 2048, N0, smem);
  transpose_job<0>(p.in[I_EWOUT], 2048, 2048, (u16*)(ws + OFF_WOUT0), 2048, 2048, smem);
  transpose_job<0>(p.in[I_WQ], 2048, 2048, (u16*)(ws + OFF_WQ0), 2048, 2048, smem);
  transpose_job<0>(p.in[I_WQ] + (size_t)2048 * 2048, 2048, 2048, (u16*)(ws + OFF_WQ1), 2048, 2048, smem);
  transpose_job<2>(p.in[I_OWIN], 5936, 2048, (u16*)(ws + OFF_WIN1), 2048, N1, smem);
  transpose_job<0>(p.in[I_OWOUT], 2048, 2048, (u16*)(ws + OFF_WOUT1), 2048, 2048, smem);
  transpose_job<0>(p.in[I_W2], 1024, 64, (u16*)(ws + OFF_W2T), 64, 1024, smem);
  transpose_job<0>(p.in[I_A2], 1024, 64, (u16*)(ws + OFF_A2T), 64, 1024, smem);
  transpose_job<0>(p.in[I_G2], 1024, 160, (u16*)(ws + OFF_G2T), 192, 1024, smem);
  {
    float* XF = (float*)(ws + OFF_XF);
    u16* XB = (u16*)(ws + OFF_XB);
    size_t n4 = (size_t)MP * 512;
    size_t stride = (size_t)gridDim.x * blockDim.x;
    for (size_t i = (size_t)blockIdx.x * blockDim.x + threadIdx.x; i < n4; i += stride) {
      int row = (int)(i >> 9), c4 = (int)(i & 511);
      float4 v = make_float4(0.f, 0.f, 0.f, 0.f);
      if (row < MPR) {
        int b = row / TP, t = row % TP;
        const float* s = (t < 16) ? (p.in[I_META] + (size_t)t * D) : (p.in[I_XP] + ((size_t)b * 2048 + (t - 16)) * D);
        v = ((const float4*)s)[c4];
      } else if (row < M) {
        v = ((const float4*)(p.in[I_XS] + (size_t)(row - MPR) * D))[c4];
      }
      ((float4*)XF)[i] = v;
      uint2 o;
      o.x = pack2(v.x, v.y);
      o.y = pack2(v.z, v.w);
      ((uint2*)XB)[i] = o;
    }
  }
  if (blockIdx.x == 0) {
    float* LB = (float*)(ws + OFF_LB);
    const float* lg = p.in[I_LBL];
    for (int c = threadIdx.x; c < 1024; c += blockDim.x) {
      float a = lg[c], b = lg[1024 + c], d = lg[2048 + c];
      float m = fmaxf(a, fmaxf(b, d));
      float ea = expf(a - m), eb = expf(b - m), ed = expf(d - m);
      LB[c] = ea / (ea + eb + ed);
    }
    double* IR = (double*)(ws + OFF_INVREV);
    if (threadIdx.x < 64) {
      double d = (double)threadIdx.x;
      IR[threadIdx.x] = exp(-d * (9.210340371976184 / 64.0)) * 0.15915494309189535;
    }
  }
}

constexpr int G_LDS_STRIDE = 72;
template <class Epi>
DEVI void gemm_phase(const u16* __restrict__ A, int lda, int a_ntile_off, const u16* __restrict__ Bt, int K, int mtiles,
                     int ntiles, char* smem, Epi epi) {
  u16* SA = (u16*)smem;
  u16* SB = SA + 128 * G_LDS_STRIDE;
  const int tid = threadIdx.x, wid = tid >> 6, lane = tid & 63, wr = wid >> 1, wc = wid & 1, fr = lane & 15, fq = lane >> 4;
  const int ntot = mtiles * ntiles;
  const int nk = K / 64;
  for (int tile = blockIdx.x; tile < ntot; tile += gridDim.x) {
    int tm = tile / ntiles, tn = tile % ntiles;
    int brow = tm * 128, bcol = tn * 128;
    const u16* Ag = A + (size_t)brow * lda + (size_t)tn * a_ntile_off;
    const u16* Bg = Bt + (size_t)bcol * K;
    f32x4 acc[4][4];
#pragma unroll
    for (int m = 0; m < 4; ++m)
#pragma unroll
      for (int n = 0; n < 4; ++n) acc[m][n] = f32x4{0.f, 0.f, 0.f, 0.f};
    u32x4 ra[4], rb[4];
#pragma unroll
    for (int i = 0; i < 4; ++i) {
      int ch = tid + i * 256, r = ch >> 3, kc = ch & 7;
      ra[i] = *(const u32x4*)(Ag + (size_t)r * lda + kc * 8);
      rb[i] = *(const u32x4*)(Bg + (size_t)r * K + kc * 8);
    }
    for (int t = 0; t < nk; ++t) {
#pragma unroll
      for (int i = 0; i < 4; ++i) {
        int ch = tid + i * 256, r = ch >> 3, kc = ch & 7;
        *(u32x4*)(SA + r * G_LDS_STRIDE + kc * 8) = ra[i];
        *(u32x4*)(SB + r * G_LDS_STRIDE + kc * 8) = rb[i];
      }
      __syncthreads();
      if (t + 1 < nk) {
#pragma unroll
        for (int i = 0; i < 4; ++i) {
          int ch = tid + i * 256, r = ch >> 3, kc = ch & 7;
          ra[i] = *(const u32x4*)(Ag + (size_t)r * lda + (t + 1) * 64 + kc * 8);
          rb[i] = *(const u32x4*)(Bg + (size_t)r * K + (t + 1) * 64 + kc * 8);
        }
      }
#pragma unroll
      for (int kh = 0; kh < 2; ++kh) {
        bf16x8 At[4], Bl[4];
#pragma unroll
        for (int m = 0; m < 4; ++m)
          At[m] = *(const bf16x8*)(SA + (wr * 64 + m * 16 + fr) * G_LDS_STRIDE + kh * 32 + fq * 8);
#pragma unroll
        for (int n = 0; n < 4; ++n)
          Bl[n] = *(const bf16x8*)(SB + (wc * 64 + n * 16 + fr) * G_LDS_STRIDE + kh * 32 + fq * 8);
#pragma unroll
        for (int m = 0; m < 4; ++m)
#pragma unroll
          for (int n = 0; n < 4; ++n) acc[m][n] = __builtin_amdgcn_mfma_f32_16x16x32_bf16(At[m], Bl[n], acc[m][n], 0, 0, 0);
      }
      __syncthreads();
    }
#pragma unroll
    for (int m = 0; m < 4; ++m)
#pragma unroll
      for (int n = 0; n < 2; ++n)
#pragma unroll
        for (int j = 0; j < 4; ++j) {
          int row = brow + wr * 64 + m * 16 + fq * 4 + j;
          int col = bcol + wc * 64 + n * 16 + fr;
          epi(row, col, acc[m][n][j], acc[m][n + 2][j]);
        }
  }
}

struct Seg {
  int off;
  int ld;
  int n4;
};

template <int NS, int NF4, int RG>
DEVI void stage_init(const float* wsf, const Seg (&sg)[NS], int row0, int tid, const float* (&ptr)[RG], int (&ldv)[RG]) {
  asm volatile("" : "+v"(tid));
#pragma unroll
  for (int q = 0; q < RG; ++q) {
    int flat = tid + q * 256;
    int t = flat / NF4, f = flat % NF4;
    if (flat >= 16 * NF4) { t = 0; f = 0; }
    int off = 0, ld = 0, ff = f;
    bool done = false;
#pragma unroll
    for (int s = 0; s < NS; ++s) {
      bool here = (!done) && (ff < sg[s].n4);
      off = here ? (sg[s].off + (row0 + t) * sg[s].ld + ff * 4) : off;
      ld = here ? sg[s].ld : ld;
      ff = (done || here) ? ff : (ff - sg[s].n4);
      done = done || here;
    }
    ptr[q] = wsf + off;
    ldv[q] = ld;
  }
}
template <int NF4, int RG>
DEVI void stage_issue(const float* const (&ptr)[RG], const int (&ldv)[RG], int st, int nsteps, int tid, f32x4 (&rg)[RG]) {
#pragma unroll
  for (int q = 0; q < RG; ++q) {
    int flat = tid + q * 256;
    if (flat < nsteps * NF4) rg[q] = *(const f32x4*)(ptr[q] + (st * 16) * ldv[q]);
  }
}
template <int NF4, int RG>
DEVI void stage_commit(float* buf, int nsteps, int tid, const f32x4 (&rg)[RG]) {
#pragma unroll
  for (int q = 0; q < RG; ++q) {
    int flat = tid + q * 256;
    if (flat < nsteps * NF4) ((f32x4*)buf)[flat] = rg[q];
  }
}

template <int MODE>
DEVI void colrec_long(const float* wsf, const Seg (&sg)[4], int row0, int T, float gamma, float* outp, int ldo, float* stout, int st_ld,
                      float* smem) {
  constexpr int NF4 = 69, W = 276, RG = 5;
  const int tid = threadIdx.x, w = tid >> 6, lane = tid & 63, c = lane >> 4, s = lane & 15;
  float S[8];
#pragma unroll
  for (int i = 0; i < 8; ++i) S[i] = 0.f;
  float* buf0 = smem;
  float* buf1 = smem + 16 * 336;
  float* obuf = smem + 2 * 16 * 336;
  const int nst = (T + 15) / 16;
  f32x4 rg[RG];
  const float* sptr[RG];
  int sld[RG];
  stage_init<4, NF4, RG>(wsf, sg, row0, tid, sptr, sld);
  stage_issue<NF4, RG>(sptr, sld, 0, min(16, T), tid, rg);
  stage_commit<NF4, RG>(buf0, min(16, T), tid, rg);
  __syncthreads();
  auto step = [&](const float* sp, float* ob, int tt) {
    float4 a0 = *(const float4*)(sp + s * 8), a1 = *(const float4*)(sp + s * 8 + 4);
    float4 q0 = *(const float4*)(sp + 128 + s * 8), q1 = *(const float4*)(sp + 128 + s * 8 + 4);
    float a[8] = {a0.x, a0.y, a0.z, a0.w, a1.x, a1.y, a1.z, a1.w};
    float q[8] = {q0.x, q0.y, q0.z, q0.w, q1.x, q1.y, q1.z, q1.w};
    float val = sp[256 + w * 4 + c];
    float dA = gamma;
    if (MODE == 2) {
      val *= sp[272];
      dA = sp[273];
    }
    float o = 0.f;
#pragma unroll
    for (int i = 0; i < 8; ++i) {
      if (MODE == 0) S[i] = val + a[i] * (S[i] - val);
      else S[i] = dA * S[i] + a[i] * val;
      o += q[i] * S[i];
    }
    o = red16(o);
    if (s == 0) ob[tt * 16 + w * 4 + c] = o;
  };
#pragma unroll 1
  for (int st = 0; st < nst; ++st) {
    const int nthis = min(16, T - st * 16);
    const int nnext = min(16, T - (st + 1) * 16);
    if (st + 1 < nst) stage_issue<NF4, RG>(sptr, sld, st + 1, nnext, tid, rg);
    const float* b = (st & 1) ? buf1 : buf0;
    float* ob = obuf + (st & 1) * 512;
#pragma unroll 1
    for (int tt = 0; tt < nthis; tt += 4) {
      step(b + tt * W, ob, tt);
      step(b + (tt + 1) * W, ob, tt + 1);
      step(b + (tt + 2) * W, ob, tt + 2);
      step(b + (tt + 3) * W, ob, tt + 3);
    }
    if (st + 1 < nst) stage_commit<NF4, RG>((st & 1) ? buf0 : buf1, nnext, tid, rg);
    __syncthreads();
    if (tid < nthis * 4) {
      int t = tid >> 2, c4 = tid & 3;
      *(float4*)(outp + (size_t)(st * 16 + t) * ldo + c4 * 4) = *(const float4*)(ob + t * 16 + c4 * 4);
    }
  }
#pragma unroll
  for (int i = 0; i < 8; ++i) stout[(size_t)(s * 8 + i) * st_ld + w * 4 + c] = S[i];
  __syncthreads();
}

template <int MODE>
DEVI void colrec_short(const float* pa, int lda_, const float* pq, int ldq, const float* pc, int ldc, const float* pdt,
                       long row0, float gamma, const float* stin, float* stout, int st_ld, float* outp, int ldo,
                       float* smem) {
  const int tid = threadIdx.x, lane = tid & 63;
  const int wid = __builtin_amdgcn_readfirstlane(tid >> 6);
  const int k0 = wid * 32;
  float S[32];
#pragma unroll
  for (int i = 0; i < 32; ++i) S[i] = stin[(size_t)(k0 + i) * st_ld + lane];
#pragma unroll 1
  for (int t = 0; t < 4; ++t) {
    long row = row0 + t;
    float val = pc[(size_t)row * ldc + lane];
    float dA = gamma;
    if (MODE == 2) {
      val *= pdt[(size_t)row * 64];
      dA = pdt[(size_t)row * 64 + 1];
    }
    const float4* ap = (const float4*)(pa + (size_t)row * lda_ + k0);
    const float4* qp = (const float4*)(pq + (size_t)row * ldq + k0);
    float o = 0.f;
#pragma unroll
    for (int i4 = 0; i4 < 8; ++i4) {
      float4 av = ap[i4], qv = qp[i4];
      float a[4] = {av.x, av.y, av.z, av.w};
      float q[4] = {qv.x, qv.y, qv.z, qv.w};
#pragma unroll
      for (int e = 0; e < 4; ++e) {
        int i = i4 * 4 + e;
        if (MODE == 0) S[i] = val + a[e] * (S[i] - val);
        else S[i] = dA * S[i] + a[e] * val;
        o += q[e] * S[i];
      }
    }
    smem[(wid * 4 + t) * 64 + lane] = o;
  }
#pragma unroll
  for (int i = 0; i < 32; ++i) stout[(size_t)(k0 + i) * st_ld + lane] = S[i];
  __syncthreads();
  {
    int t = tid >> 6;
    float sum = smem[(0 * 4 + t) * 64 + lane] + smem[(1 * 4 + t) * 64 + lane] + smem[(2 * 4 + t) * 64 + lane] +
                smem[(3 * 4 + t) * 64 + lane];
    outp[(size_t)(row0 + t) * ldo + lane] = sum;
  }
  __syncthreads();
}

DEVI void rwkv_item(const float* wsf, const Seg (&sg)[6], int row0, int T, const float* stin, float* stout, float* outp, int ldo,
                    float* smem) {
  constexpr int NF4 = 84, W = 336, RG = 6;
  const int tid = threadIdx.x, w = tid >> 6, lane = tid & 63, rl = lane >> 4, sl = lane & 15;
  const int il = w * 4 + rl;
  float S[4];
  if (stin) {
    float4 v = *(const float4*)(stin + il * 64 + sl * 4);
    S[0] = v.x; S[1] = v.y; S[2] = v.z; S[3] = v.w;
  } else {
    S[0] = S[1] = S[2] = S[3] = 0.f;
  }
  float* buf0 = smem;
  float* buf1 = smem + 16 * 336;
  float* obuf = smem + 2 * 16 * 336;
  const int nst = (T + 15) / 16;
  f32x4 rg[RG];
  const float* sptr[RG];
  int sld[RG];
  stage_init<6, NF4, RG>(wsf, sg, row0, tid, sptr, sld);
  stage_issue<NF4, RG>(sptr, sld, 0, min(16, T), tid, rg);
  stage_commit<NF4, RG>(buf0, min(16, T), tid, rg);
  __syncthreads();
#pragma unroll 1
  for (int st = 0; st < nst; ++st) {
    const int nthis = min(16, T - st * 16);
    const int nnext = min(16, T - (st + 1) * 16);
    if (st + 1 < nst) stage_issue<NF4, RG>(sptr, sld, st + 1, nnext, tid, rg);
    const float* b = (st & 1) ? buf1 : buf0;
    float* ob = obuf + (st & 1) * 512;
#pragma unroll 4
    for (int tt = 0; tt < nthis; ++tt) {
      const float* sp = b + tt * W;
      float4 r4 = *(const float4*)(sp + sl * 4);
      float4 w4 = *(const float4*)(sp + 64 + sl * 4);
      float4 k4 = *(const float4*)(sp + 128 + sl * 4);
      float4 n4 = *(const float4*)(sp + 192 + sl * 4);
      float4 m4 = *(const float4*)(sp + 256 + sl * 4);
      float vi = sp[320 + il];
      float sa = S[0] * n4.x + S[1] * n4.y + S[2] * n4.z + S[3] * n4.w;
      sa = -red16(sa);
      S[0] = S[0] * w4.x + sa * m4.x + vi * k4.x;
      S[1] = S[1] * w4.y + sa * m4.y + vi * k4.y;
      S[2] = S[2] * w4.z + sa * m4.z + vi * k4.z;
      S[3] = S[3] * w4.w + sa * m4.w + vi * k4.w;
      float y = S[0] * r4.x + S[1] * r4.y + S[2] * r4.z + S[3] * r4.w;
      y = red16(y);
      if (sl == 0) ob[tt * 16 + il] = y;
    }
    if (st + 1 < nst) stage_commit<NF4, RG>((st & 1) ? buf0 : buf1, nnext, tid, rg);
    __syncthreads();
    if (tid < nthis * 4) {
      int t = tid >> 2, c4 = tid & 3;
      *(float4*)(outp + (size_t)(st * 16 + t) * ldo + c4 * 4) = *(const float4*)(ob + t * 16 + c4 * 4);
    }
  }
  *(float4*)(stout + il * 64 + sl * 4) = make_float4(S[0], S[1], S[2], S[3]);
  __syncthreads();
}

DEVI void phase_rec0(const Params& p, float* smem) {
  char* ws = p.ws;
  const float* PROJ = (const float*)(ws + OFF_PROJ);
  float* OMIX = (float*)(ws + OFF_OMIX);
  const float* wsf = (const float*)ws;
  constexpr int PO = (int)(OFF_PROJ / 4);
  for (int item = blockIdx.x; item < 4608; item += gridDim.x) {
    if (item < 256) {
      int b = item >> 6, h = (item >> 3) & 7, cb = item & 7;
      Seg sg[4] = {{PO + 1024 + h * 128, N0, 32}, {PO + h * 128, N0, 32}, {PO + 2048 + h * 128 + cb * 16, N0, 4},
                   {PO, N0, 1}};
      int row0 = b * TP;
      colrec_long<0>(wsf, sg, row0, TP, 0.f, OMIX + (size_t)row0 * 2048 + h * 128 + cb * 16, 2048,
                     p.out + O_HGP + (size_t)(b * 8 + h) * 128 * 128 + cb * 16, 128, smem);
    } else if (item < 512) {
      int it = item - 256;
      int b = it >> 6, h = (it >> 4) & 3, cb = it & 15;
      Seg sg[4] = {{PO + 4608 + h * 128, N0, 32}, {PO + 4096 + h * 128, N0, 32},
                   {PO + 5120 + h * 256 + cb * 16, N0, 4}, {PO, N0, 1}};
      int row0 = b * TP;
      float gamma = 1.0f - exp2f(-5.0f - (float)h);
      colrec_long<1>(wsf, sg, row0, TP, gamma, OMIX + (size_t)row0 * 2048 + 1024 + h * 256 + cb * 16, 2048,
                     p.out + O_RTP + (size_t)(b * 4 + h) * 128 * 256 + cb * 16, 256, smem);
    } else if (item < 2560) {
      int it = item - 512;
      int b = it >> 4, h = (it >> 1) & 7, cb = it & 1;
      long row0 = MPR + (long)b * 4;
      size_t so = (size_t)(b * 8 + h) * 128 * 128 + cb * 64;
      colrec_short<0>(PROJ + 1024 + h * 128, N0, PROJ + h * 128, N0, PROJ + 2048 + h * 128 + cb * 64, N0, nullptr, row0,
                      0.f, p.in[I_SHG] + so, p.out + O_HGS + so, 128, OMIX + h * 128 + cb * 64, 2048, smem);
    } else {
      int it = item - 2560;
      int b = it >> 4, h = (it >> 2) & 3, cb = it & 3;
      long row0 = MPR + (long)b * 4;
      size_t so = (size_t)(b * 4 + h) * 128 * 256 + cb * 64;
      float gamma = 1.0f - exp2f(-5.0f - (float)h);
      colrec_short<1>(PROJ + 4608 + h * 128, N0, PROJ + 4096 + h * 128, N0, PROJ + 5120 + h * 256 + cb * 64, N0, nullptr,
                      row0, gamma, p.in[I_SRT] + so, p.out + O_RTS + so, 256, OMIX + 1024 + h * 256 + cb * 64, 2048,
                      smem);
    }
  }
}

DEVI float4 ld4(const float* p) { return *(const float4*)p; }
DEVI void st_bf4(u16* p, float a, float b, float c, float d) {
  uint2 o;
  o.x = pack2(a, b);
  o.y = pack2(c, d);
  *(uint2*)p = o;
}
DEVI float rlf_(float v, int l) { return __int_as_float(__builtin_amdgcn_readlane(__float_as_int(v), l)); }
DEVI float wsum_u_(float v) {
  v = red16(v);
  return (rlf_(v, 0) + rlf_(v, 16)) + (rlf_(v, 32) + rlf_(v, 48));
}
DEVI float red32(float v) {
  v = red16(v);
  return v + __shfl_xor(v, 16, 64);
}
DEVI void phase_post0(const Params& p) {
  char* ws = p.ws;
  const float* PROJ = (const float*)(ws + OFF_PROJ);
  const float* OMIX = (const float*)(ws + OFF_OMIX);
  u16* MIXB = (u16*)(ws + OFF_MIXB);
  const float* ng = p.in[I_HNG];
  const int lane = threadIdx.x & 63;
  const int gw = blockIdx.x * 4 + (threadIdx.x >> 6), nw = gridDim.x * 4;
  const float4 g4 = ld4(ng + (lane & 31) * 4);
  for (int row = gw; row < M; row += nw) {
    const float* o = OMIX + (size_t)row * 2048;
    const float* pr = PROJ + (size_t)row * N0;
    u16* mo = MIXB + (size_t)row * 2048;
    float4 a[4], ga[4], bq[4], gb[4];
#pragma unroll
    for (int it = 0; it < 4; ++it) {
      int c = it * 256 + lane * 4;
      a[it] = ld4(o + c);
      ga[it] = ld4(pr + 3072 + c);
      bq[it] = ld4(o + 1024 + c);
      gb[it] = ld4(pr + 6144 + c);
    }
#pragma unroll
    for (int it = 0; it < 4; ++it) {
      int c = it * 256 + lane * 4;
      float ss = red32(a[it].x * a[it].x + a[it].y * a[it].y + a[it].z * a[it].z + a[it].w * a[it].w);
      float inv = rsqrtf(ss * (1.0f / 128.0f) + 1e-6f);
      st_bf4(mo + c, a[it].x * inv * g4.x * ga[it].x, a[it].y * inv * g4.y * ga[it].y, a[it].z * inv * g4.z * ga[it].z,
             a[it].w * inv * g4.w * ga[it].w);
      float mu = wsum_u_(bq[it].x + bq[it].y + bq[it].z + bq[it].w) * (1.0f / 256.0f);
      float dx = bq[it].x - mu, dy = bq[it].y - mu, dz = bq[it].z - mu, dw = bq[it].w - mu;
      float var = wsum_u_(dx * dx + dy * dy + dz * dz + dw * dw) * (1.0f / 256.0f);
      float iv = rsqrtf(var + 1e-5f);
      st_bf4(mo + 1024 + c, dx * iv * gb[it].x, dy * iv * gb[it].y, dz * iv * gb[it].z, dw * iv * gb[it].w);
    }
  }
}

DEVI void phase_ln(const Params& p, const float* addsrc, const float* g, const float* bta) {
  char* ws = p.ws;
  float* XF = (float*)(ws + OFF_XF);
  u16* XB = (u16*)(ws + OFF_XB);
  const int lane = threadIdx.x & 63;
  const int gw = blockIdx.x * 4 + (threadIdx.x >> 6), nw = gridDim.x * 4;
  for (int row = gw; row < M; row += nw) {
    float4* xr = (float4*)(XF + (size_t)row * 2048);
    const float4* ar = (const float4*)(addsrc + (size_t)row * 2048);
    float v[32];
    float s = 0.f;
#pragma unroll
    for (int i = 0; i < 8; ++i) {
      float4 x = xr[i * 64 + lane], a = ar[i * 64 + lane];
      v[i * 4 + 0] = ALPHA * x.x + a.x;
      v[i * 4 + 1] = ALPHA * x.y + a.y;
      v[i * 4 + 2] = ALPHA * x.z + a.z;
      v[i * 4 + 3] = ALPHA * x.w + a.w;
      s += v[i * 4 + 0] + v[i * 4 + 1] + v[i * 4 + 2] + v[i * 4 + 3];
    }
    float mu = wsum(s) * (1.0f / 2048.0f);
    float q = 0.f;
#pragma unroll
    for (int i = 0; i < 32; ++i) {
      v[i] -= mu;
      q += v[i] * v[i];
    }
    float inv = rsqrtf(wsum(q) * (1.0f / 2048.0f) + 1e-5f);
#pragma unroll
    for (int i = 0; i < 8; ++i) {
      float4 gg = ((const float4*)g)[i * 64 + lane], bb = ((const float4*)bta)[i * 64 + lane];
      float4 y;
      y.x = v[i * 4 + 0] * inv * gg.x + bb.x;
      y.y = v[i * 4 + 1] * inv * gg.y + bb.y;
      y.z = v[i * 4 + 2] * inv * gg.z + bb.z;
      y.w = v[i * 4 + 3] * inv * gg.w + bb.w;
      xr[i * 64 + lane] = y;
      uint2 o;
      o.x = pack2(y.x, y.y);
      o.y = pack2(y.z, y.w);
      ((uint2*)(XB + (size_t)row * 2048))[i * 64 + lane] = o;
    }
  }
}

typedef __attribute__((ext_vector_type(2))) __bf16 bf2_t;
typedef __attribute__((ext_vector_type(2))) float f32x2;
DEVI float dot2bf(unsigned a, unsigned b, float acc) {
  return __builtin_amdgcn_fdot2_f32_bf16(__builtin_bit_cast(bf2_t, a), __builtin_bit_cast(bf2_t, b), acc, false);
}
template <int CTRL>
DEVI int dppi(int v) {
  return __builtin_amdgcn_update_dpp(v, v, CTRL, 0xF, 0xF, false);
}
DEVI int wmax_i(int v) {
  v = max(v, dppi<0xB1>(v));
  v = max(v, dppi<0x4E>(v));
  v = max(v, dppi<0x141>(v));
  v = max(v, dppi<0x140>(v));
  int a = __builtin_amdgcn_readlane(v, 0), b = __builtin_amdgcn_readlane(v, 16);
  int c = __builtin_amdgcn_readlane(v, 32), d = __builtin_amdgcn_readlane(v, 48);
  return max(max(a, b), max(c, d));
}
DEVI float rlf(float v, int l) { return __int_as_float(__builtin_amdgcn_readlane(__float_as_int(v), l)); }
DEVI float wsum_u(float v) {
  v = red16(v);
  return (rlf(v, 0) + rlf(v, 16)) + (rlf(v, 32) + rlf(v, 48));
}
DEVI int fkey(float f) {
  int u = __float_as_int(f);
  return u ^ ((u >> 31) & 0x7fffffff);
}
DEVI float keyf(int k) { return __int_as_float(k ^ ((k >> 31) & 0x7fffffff)); }

DEVI void conv_fp8_rows(const float* __restrict__ src, unsigned char* __restrict__ dst, float* __restrict__ scales) {
  const int lane = threadIdx.x & 63;
  const int gw = blockIdx.x * 4 + (threadIdx.x >> 6), nw = gridDim.x * 4;
  for (int e = gw; e < 16384; e += nw) {
    const float* r = src + (size_t)e * 2048;
    float4 v[8];
    float am = 0.f;
#pragma unroll
    for (int q = 0; q < 8; ++q) {
      v[q] = *(const float4*)(r + (q >> 2) * 1024 + lane * 16 + (q & 3) * 4);
      am = fmaxf(am, fmaxf(fmaxf(fabsf(v[q].x), fabsf(v[q].y)), fmaxf(fabsf(v[q].z), fabsf(v[q].w))));
    }
    float amax = __int_as_float(wmax_i(__float_as_int(am)));
    float inv = (amax > 0.f) ? (440.0f / amax) : 0.f;
    float scale = (amax > 0.f) ? (amax * (1.0f / 440.0f)) : 1.0f;
#pragma unroll
    for (int j = 0; j < 2; ++j) {
      u32x4 o;
#pragma unroll
      for (int k = 0; k < 4; ++k) {
        float4 t = v[j * 4 + k];
        int pk = 0;
        pk = __builtin_amdgcn_cvt_pk_fp8_f32(t.x * inv, t.y * inv, pk, false);
        pk = __builtin_amdgcn_cvt_pk_fp8_f32(t.z * inv, t.w * inv, pk, true);
        o[k] = (unsigned)pk;
      }
      *(u32x4*)(dst + (size_t)e * 2048 + j * 1024 + lane * 16) = o;
    }
    if (lane == 0) scales[e] = scale;
  }
}

DEVI void phase_peer(const Params& p, int layer, bool final_out) {
  char* ws = p.ws;
  const float* SC = (const float*)(ws + OFF_GOUT);
  float* XF = (float*)(ws + OFF_XF);
  u16* XB = (u16*)(ws + OFF_XB);
  const unsigned char* UB = (const unsigned char*)(ws + OFF_UB);
  const unsigned char* VB = (const unsigned char*)(ws + OFF_VB);
  const float* USC = (const float*)(ws + OFF_USC);
  const float* VSC = (const float*)(ws + OFF_VSC);
  const float* g = p.in[I_LNG] + (size_t)(layer * 2 + 1) * D;
  const float* bta = p.in[I_LNB] + (size_t)(layer * 2 + 1) * D;
  const int lane = threadIdx.x & 63;
  const int gw = blockIdx.x * 4 + (threadIdx.x >> 6), nw = gridDim.x * 4;
  constexpr int KMIN = (int)0x80000000;
  for (int row = gw; row < M; row += nw) {
    const float* sr = SC + (size_t)row * 2048;
    int eidx0 = 0, eidx1 = 0;
    float gate0 = 0.f, gate1 = 0.f;
#pragma unroll 1
    for (int h = 0; h < 8; ++h) {
      const float* sp = sr + h * 256;
      int ka0 = (fkey(sp[lane]) & ~127) | (127 - lane);
      int kb0 = (fkey(sp[lane + 64]) & ~127) | (63 - lane);
      int ka1 = (fkey(sp[128 + lane]) & ~127) | (127 - lane);
      int kb1 = (fkey(sp[192 + lane]) & ~127) | (63 - lane);
      int my0 = KMIN, my1 = KMIN;
#pragma unroll 1
      for (int r = 0; r < 16; ++r) {
        int K0 = wmax_i(max(ka0, kb0));
        int K1 = wmax_i(max(ka1, kb1));
        my0 = (lane == r) ? K0 : my0;
        my1 = (lane == r) ? K1 : my1;
        ka0 = (ka0 == K0) ? KMIN : ka0;
        kb0 = (kb0 == K0) ? KMIN : kb0;
        ka1 = (ka1 == K1) ? KMIN : ka1;
        kb1 = (kb1 == K1) ? KMIN : kb1;
      }
      float ts0 = keyf(my0 & ~127), ts1 = keyf(my1 & ~127);
      int ti0 = 127 - (my0 & 127), ti1 = 127 - (my1 & 127);
      float s0 = __shfl(ts0, lane >> 2, 64);
      int jb = (lane & 3) * 4;
      int c0 = (fkey(s0 + __shfl(ts1, jb + 0, 64)) & ~255) | (255 - (lane * 4 + 0));
      int c1 = (fkey(s0 + __shfl(ts1, jb + 1, 64)) & ~255) | (255 - (lane * 4 + 1));
      int c2 = (fkey(s0 + __shfl(ts1, jb + 2, 64)) & ~255) | (255 - (lane * 4 + 2));
      int c3 = (fkey(s0 + __shfl(ts1, jb + 3, 64)) & ~255) | (255 - (lane * 4 + 3));
      int myk = KMIN;
#pragma unroll 1
      for (int r = 0; r < 16; ++r) {
        int K = wmax_i(max(max(c0, c1), max(c2, c3)));
        myk = (lane == r) ? K : myk;
        c0 = (c0 == K) ? KMIN : c0;
        c1 = (c1 == K) ? KMIN : c1;
        c2 = (c2 == K) ? KMIN : c2;
        c3 = (c3 == K) ? KMIN : c3;
      }
      float bs = keyf(myk & ~255);
      int bf = 255 - (myk & 255);
      int e = __shfl(ti0, (bf >> 4) & 15, 64) * 128 + __shfl(ti1, bf & 15, 64);
      float mx = rlf(bs, 0);
      float ev = (lane < 16) ? expf(bs - mx) : 0.f;
      float sm = wsum_u(ev);
      float gt = ev / sm;
      int e_b = __shfl(e, lane & 15, 64);
      float g_b = __shfl(gt, lane & 15, 64);
      if ((lane >> 4) == (h & 3)) {
        if (h < 4) {
          eidx0 = e_b;
          gate0 = g_b;
        } else {
          eidx1 = e_b;
          gate1 = g_b;
        }
      }
    }
    float dv0 = 0.f, dv1 = 0.f;
    {
      float xf[32];
      {
        const float4* xr = (const float4*)(XF + (size_t)row * 2048);
#pragma unroll
        for (int q = 0; q < 8; ++q) {
          float4 t = xr[(q >> 2) * 256 + lane * 4 + (q & 3)];
          xf[q * 4 + 0] = t.x; xf[q * 4 + 1] = t.y; xf[q * 4 + 2] = t.z; xf[q * 4 + 3] = t.w;
        }
      }
      constexpr int R = 8;
      u32x4 w[R][2];
      float sc[R];
      auto load_row = [&](int pidx, u32x4(&wr)[2], float& scv) {
        int src = (pidx < 64) ? eidx0 : eidx1;
        int e = __builtin_amdgcn_readlane(src, pidx & 63);
        const u32x4* ur = (const u32x4*)(UB + (size_t)e * 2048);
        wr[0] = ur[lane];
        wr[1] = ur[64 + lane];
        scv = USC[e];
      };
#pragma unroll
      for (int u = 0; u < R; ++u) load_row(u, w[u], sc[u]);
#pragma unroll 1
      for (int p0 = 0; p0 < 128; p0 += R) {
#pragma unroll
        for (int u = 0; u < R; ++u) {
          float d = 0.f;
#pragma unroll
          for (int j = 0; j < 2; ++j) {
#pragma unroll
            for (int k = 0; k < 4; ++k) {
              int dw = (int)w[u][j][k];
              f32x2 lo = __builtin_amdgcn_cvt_pk_f32_fp8(dw, false);
              f32x2 hi = __builtin_amdgcn_cvt_pk_f32_fp8(dw, true);
              d += lo.x * xf[j * 16 + k * 4 + 0];
              d += lo.y * xf[j * 16 + k * 4 + 1];
              d += hi.x * xf[j * 16 + k * 4 + 2];
              d += hi.y * xf[j * 16 + k * 4 + 3];
            }
          }
          float scu = sc[u];
          if (p0 + R < 128) load_row(p0 + R + u, w[u], sc[u]);
          d = wsum_u(d) * scu;
          int pl = (p0 + u) & 63;
          if (p0 < 64) dv0 = (lane == pl) ? d : dv0;
          else dv1 = (lane == pl) ? d : dv1;
          __builtin_amdgcn_sched_barrier(0);
        }
      }
    }
    float coef0 = 0.5f * dv0 * (1.0f + erff(dv0 * 0.70710678118f)) * gate0;
    float coef1 = 0.5f * dv1 * (1.0f + erff(dv1 * 0.70710678118f)) * gate1;
    f32x2 o2[16];
#pragma unroll
    for (int i = 0; i < 16; ++i) o2[i] = f32x2{0.f, 0.f};
    {
      constexpr int R = 8;
      u32x4 w[R][2];
      float sc[R];
      auto load_row = [&](int pidx, u32x4(&wr)[2], float& scv) {
        int src = (pidx < 64) ? eidx0 : eidx1;
        int e = __builtin_amdgcn_readlane(src, pidx & 63);
        const u32x4* vr = (const u32x4*)(VB + (size_t)e * 2048);
        wr[0] = vr[lane];
        wr[1] = vr[64 + lane];
        scv = VSC[e];
      };
#pragma unroll
      for (int u = 0; u < R; ++u) load_row(u, w[u], sc[u]);
#pragma unroll 1
      for (int p0 = 0; p0 < 128; p0 += R) {
        float cfs = (p0 < 64) ? coef0 : coef1;
#pragma unroll
        for (int u = 0; u < R; ++u) {
          float c = rlf(cfs, (p0 + u) & 63) * sc[u];
          f32x2 cc = f32x2{c, c};
#pragma unroll
          for (int j = 0; j < 2; ++j) {
#pragma unroll
            for (int k = 0; k < 4; ++k) {
              int dw = (int)w[u][j][k];
              o2[j * 8 + k * 2 + 0] += cc * __builtin_amdgcn_cvt_pk_f32_fp8(dw, false);
              o2[j * 8 + k * 2 + 1] += cc * __builtin_amdgcn_cvt_pk_f32_fp8(dw, true);
            }
          }
          if (p0 + R < 128) load_row(p0 + R + u, w[u], sc[u]);
          __builtin_amdgcn_sched_barrier(0);
        }
      }
    }
    float o[32];
#pragma unroll
    for (int i = 0; i < 16; ++i) {
      o[2 * i] = o2[i].x;
      o[2 * i + 1] = o2[i].y;
    }
    float s = 0.f;
    {
      const float4* xr = (const float4*)(XF + (size_t)row * 2048);
#pragma unroll
      for (int q = 0; q < 8; ++q) {
        float4 t = xr[(q >> 2) * 256 + lane * 4 + (q & 3)];
        o[q * 4 + 0] += ALPHA * t.x; o[q * 4 + 1] += ALPHA * t.y; o[q * 4 + 2] += ALPHA * t.z; o[q * 4 + 3] += ALPHA * t.w;
      }
#pragma unroll
      for (int i = 0; i < 32; ++i) s += o[i];
    }
    float mu = wsum_u(s) * (1.0f / 2048.0f);
    float q = 0.f;
#pragma unroll
    for (int i = 0; i < 32; ++i) {
      o[i] -= mu;
      q += o[i] * o[i];
    }
    float inv = rsqrtf(wsum_u(q) * (1.0f / 2048.0f) + 1e-5f);
    float* dstf;
    if (final_out) {
      if (row < MPR) {
        int b = row / TP, t = row % TP;
        dstf = (t >= 16) ? (p.out + O_YP + ((size_t)b * 2048 + (t - 16)) * D) : nullptr;
      } else {
        dstf = p.out + O_YS + (size_t)(row - MPR) * D;
      }
    } else {
      dstf = XF + (size_t)row * 2048;
    }
#pragma unroll
    for (int j = 0; j < 2; ++j) {
      float yv[16];
#pragma unroll
      for (int k = 0; k < 4; ++k) {
        float4 gv = *(const float4*)(g + j * 1024 + lane * 16 + k * 4);
        float4 bv = *(const float4*)(bta + j * 1024 + lane * 16 + k * 4);
        float4 y;
        y.x = o[j * 16 + k * 4 + 0] * inv * gv.x + bv.x;
        y.y = o[j * 16 + k * 4 + 1] * inv * gv.y + bv.y;
        y.z = o[j * 16 + k * 4 + 2] * inv * gv.z + bv.z;
        y.w = o[j * 16 + k * 4 + 3] * inv * gv.w + bv.w;
        if (dstf) *(float4*)(dstf + j * 1024 + lane * 16 + k * 4) = y;
        yv[k * 4 + 0] = y.x; yv[k * 4 + 1] = y.y; yv[k * 4 + 2] = y.z; yv[k * 4 + 3] = y.w;
      }
      if (!final_out) {
        uint4* xb = (uint4*)(XB + (size_t)row * 2048 + j * 1024 + lane * 16);
        xb[0] = make_uint4(pack2(yv[0], yv[1]), pack2(yv[2], yv[3]), pack2(yv[4], yv[5]), pack2(yv[6], yv[7]));
        xb[1] = make_uint4(pack2(yv[8], yv[9]), pack2(yv[10], yv[11]), pack2(yv[12], yv[13]), pack2(yv[14], yv[15]));
      }
    }
  }
}

DEVI float4 f4mul(float4 a, float4 b) { return make_float4(a.x * b.x, a.y * b.y, a.z * b.z, a.w * b.w); }
DEVI void row_info(int row, bool& prompt, int& b, int& t, int& T) {
  prompt = row < MPR;
  if (prompt) { b = row / TP; t = row - b * TP; T = TP; }
  else { b = (row - MPR) >> 2; t = (row - MPR) & 3; T = 4; }
}
DEVI void phase_pre1(const Params& p) {
  char* ws = p.ws;
  const float* PROJ = (const float*)(ws + OFF_PROJ);
  float* XC = (float*)(ws + OFF_GOUT);
  float* RKV = (float*)(ws + OFF_RKV);
  u16* LRA = (u16*)(ws + OFF_LRA);
  u16* LRB = (u16*)(ws + OFF_LRB);
  u16* LRG = (u16*)(ws + OFF_LRG);
  const float* cw = p.in[I_CVW];
  const float* cbias = p.in[I_CVB];
  const float* mu = p.in[I_MU];
  const int gtid = blockIdx.x * 256 + threadIdx.x, nthr = gridDim.x * 256;
#pragma unroll 2
  for (int idx = gtid; idx < M * 384; idx += nthr) {
    int row = idx / 384, c = (idx - row * 384) * 4;
    bool prompt; int b, t, T;
    row_info(row, prompt, b, t, T);
    float4 xv[4];
#pragma unroll
    for (int jj = 0; jj < 4; ++jj) {
      int tt = t - 3 + jj;
      if (tt >= 0) xv[jj] = ld4(PROJ + (size_t)(row - 3 + jj) * N1 + 1024 + c);
      else if (prompt) xv[jj] = make_float4(0.f, 0.f, 0.f, 0.f);
      else xv[jj] = ld4(p.in[I_SCV] + (size_t)(b * 3 + (tt + 3)) * 1536 + c);
    }
    float4 acc = ld4(cbias + c);
#pragma unroll
    for (int jj = 0; jj < 4; ++jj) {
      float4 w = ld4(cw + jj * 1536 + c);
      acc.x += xv[jj].x * w.x; acc.y += xv[jj].y * w.y; acc.z += xv[jj].z * w.z; acc.w += xv[jj].w * w.w;
    }
    *(float4*)(XC + (size_t)row * 1536 + c) = make_float4(siluf_(acc.x), siluf_(acc.y), siluf_(acc.z), siluf_(acc.w));
    if (t >= T - 3) {
      float* co = prompt ? (p.out + O_CVP) : (p.out + O_CVS);
      *(float4*)(co + (size_t)(b * 3 + (t - (T - 3))) * 1536 + c) = xv[3];
    }
  }
#pragma unroll 2
  for (int idx = gtid; idx < M * 840; idx += nthr) {
    int row = idx / 840, c = (idx - row * 840) * 4;
    bool prompt; int b, t, T;
    row_info(row, prompt, b, t, T);
    float4 cur = ld4(PROJ + (size_t)row * N1 + 2560 + c);
    float4 prev;
    if (t > 0) prev = ld4(PROJ + (size_t)(row - 1) * N1 + 2560 + c);
    else if (prompt) prev = make_float4(0.f, 0.f, 0.f, 0.f);
    else prev = ld4(p.in[I_SSH] + (size_t)b * 3360 + c);
    float4 m4 = ld4(mu + c);
    float4 mx;
    mx.x = cur.x + (prev.x - cur.x) * m4.x; mx.y = cur.y + (prev.y - cur.y) * m4.y;
    mx.z = cur.z + (prev.z - cur.z) * m4.z; mx.w = cur.w + (prev.w - cur.w) * m4.w;
    if (c < 3072) *(float4*)(RKV + (size_t)row * 3072 + c) = mx;
    else if (c < 3136) st_bf4(LRA + (size_t)row * 64 + (c - 3072), tanhf(mx.x), tanhf(mx.y), tanhf(mx.z), tanhf(mx.w));
    else if (c < 3200) st_bf4(LRB + (size_t)row * 64 + (c - 3136), mx.x, mx.y, mx.z, mx.w);
    else st_bf4(LRG + (size_t)row * 192 + (c - 3200), sigmoidf_(mx.x), sigmoidf_(mx.y), sigmoidf_(mx.z), sigmoidf_(mx.w));
    if (t == T - 1) {
      float* so = prompt ? (p.out + O_SHP) : (p.out + O_SHS);
      *(float4*)(so + (size_t)b * 3360 + c) = cur;
    }
  }
  for (int idx = gtid; idx < M * 4; idx += nthr) {
    int row = idx >> 2, k = idx & 3;
    ((uint4*)(LRG + (size_t)row * 192 + 160))[k] = make_uint4(0, 0, 0, 0);
  }
}

DEVI void phase_pre1c(const Params& p) {
  char* ws = p.ws;
  float* RKV = (float*)(ws + OFF_RKV);
  const float* AA = (const float*)(ws + OFF_AA);
  float* KK = (float*)(ws + OFF_QB);
  float* KKA = (float*)(ws + OFF_MIXB);
  float* BON = (float*)(ws + OFF_BON);
  const float* k_k = p.in[I_KK];
  const float* k_a = p.in[I_KA];
  const float* r_k = p.in[I_RK];
  const int lane = threadIdx.x & 63;
  const int gw = blockIdx.x * 4 + (threadIdx.x >> 6), nw = gridDim.x * 4;
  for (int row = gw; row < M; row += nw) {
    float4 k4[4], r4[4], a4[4];
#pragma unroll
    for (int it = 0; it < 4; ++it) {
      int c = it * 256 + lane * 4;
      k4[it] = ld4(RKV + (size_t)row * 3072 + 1024 + c);
      r4[it] = ld4(RKV + (size_t)row * 3072 + c);
      a4[it] = ld4(AA + (size_t)row * 1024 + c);
    }
#pragma unroll
    for (int it = 0; it < 4; ++it) {
      int c = it * 256 + lane * 4;
      float4 kk4 = ld4(k_k + c), ka4 = ld4(k_a + c), rk4 = ld4(r_k + c);
      float4 k = k4[it], r = r4[it], a = a4[it];
      float4 kr = f4mul(k, kk4);
      float ss = red16(kr.x * kr.x + kr.y * kr.y + kr.z * kr.z + kr.w * kr.w);
      float inv = 1.0f / fmaxf(sqrtf(ss), 1e-12f);
      float4 kk = make_float4(kr.x * inv, kr.y * inv, kr.z * inv, kr.w * inv);
      float4 kp;
      kp.x = k.x * (1.0f + (a.x - 1.0f) * ka4.x); kp.y = k.y * (1.0f + (a.y - 1.0f) * ka4.y);
      kp.z = k.z * (1.0f + (a.z - 1.0f) * ka4.z); kp.w = k.w * (1.0f + (a.w - 1.0f) * ka4.w);
      float bon = red16(r.x * kp.x * rk4.x + r.y * kp.y * rk4.y + r.z * kp.z * rk4.z + r.w * kp.w * rk4.w);
      *(float4*)(KK + (size_t)row * 1024 + c) = kk;
      *(float4*)(KKA + (size_t)row * 1024 + c) = f4mul(kk, a);
      *(float4*)(RKV + (size_t)row * 3072 + 1024 + c) = kp;
      if ((lane & 15) == 0) BON[(size_t)row * 16 + it * 4 + (lane >> 4)] = bon;
    }
  }
}

DEVI void phase_rec1(const Params& p, float* smem) {
  char* ws = p.ws;
  const float* XC = (const float*)(ws + OFF_GOUT);
  const float* RKV = (const float*)(ws + OFF_RKV);
  const float* DEC = (const float*)(ws + OFF_DEC);
  const float* KK = (const float*)(ws + OFF_QB);
  const float* KKA = (const float*)(ws + OFF_MIXB);
  const float* DTA = (const float*)(ws + OFF_DTA);
  float* OMIX = (float*)(ws + OFF_OMIX);
  const float* wsf = (const float*)ws;
  constexpr int XO = (int)(OFF_GOUT / 4), DO = (int)(OFF_DTA / 4), RO = (int)(OFF_RKV / 4), CO = (int)(OFF_DEC / 4),
                KO = (int)(OFF_QB / 4), AO = (int)(OFF_MIXB / 4);
  for (int item = blockIdx.x; item < 10752; item += gridDim.x) {
    if (item < 256) {
      int b = item >> 6, h = (item >> 2) & 15, cb = item & 3;
      int g = h >> 3;
      Seg sg[4] = {{XO + 1024 + g * 128, 1536, 32}, {XO + 1280 + g * 128, 1536, 32}, {XO + h * 64 + cb * 16, 1536, 4},
                   {DO + h * 4, 64, 1}};
      int row0 = b * TP;
      colrec_long<2>(wsf, sg, row0, TP, 0.f, OMIX + (size_t)row0 * 2048 + h * 64 + cb * 16, 2048,
                     p.out + O_SSP + (size_t)(b * 16 + h) * 128 * 64 + cb * 16, 64, smem);
    } else if (item < 512 || item >= 2560) {
      bool prompt = item < 512;
      int it = prompt ? (item - 256) : (item - 2560);
      int b = it >> 6, h = (it >> 2) & 15, rb = it & 3;
      int row0 = prompt ? b * TP : (MPR + b * 4);
      int T = prompt ? TP : 4;
      Seg sg[6] = {{RO + h * 64, 3072, 16}, {CO + h * 64, 1024, 16}, {RO + 1024 + h * 64, 3072, 16},
                   {KO + h * 64, 1024, 16}, {AO + h * 64, 1024, 16}, {RO + 2048 + h * 64 + rb * 16, 3072, 4}};
      size_t so = ((size_t)(b * 16 + h) * 64 + rb * 16) * 64;
      const float* stin = prompt ? nullptr : (p.in[I_SWK] + so);
      float* stout = (prompt ? (p.out + O_WKP) : (p.out + O_WKS)) + so;
      rwkv_item(wsf, sg, row0, T, stin, stout, OMIX + (size_t)row0 * 2048 + 1024 + h * 64 + rb * 16, 2048, smem);
    } else {
      int it = item - 512;
      int b = it >> 4, h = it & 15;
      int g = h >> 3;
      long row0 = MPR + (long)b * 4;
      size_t so = (size_t)(b * 16 + h) * 128 * 64;
      colrec_short<2>(XC + 1024 + g * 128, 1536, XC + 1280 + g * 128, 1536, XC + h * 64, 1536, DTA + h * 4, row0, 0.f,
                      p.in[I_SSM] + so, p.out + O_SSS + so, 64, OMIX + h * 64, 2048, smem);
    }
  }
}

DEVI void phase_post1(const Params& p) {
  char* ws = p.ws;
  const float* PROJ = (const float*)(ws + OFF_PROJ);
  const float* OMIX = (const float*)(ws + OFF_OMIX);
  const float* XC = (const float*)(ws + OFF_GOUT);
  const float* RKV = (const float*)(ws + OFF_RKV);
  const float* GG = (const float*)(ws + OFF_GG);
  const float* BON = (const float*)(ws + OFF_BON);
  u16* MIXB = (u16*)(ws + OFF_MIXB);
  const float* dsk = p.in[I_DSK];
  const float* sng = p.in[I_SNG];
  const float* lxg = p.in[I_LXG];
  const float* lxb = p.in[I_LXB];
  const int lane = threadIdx.x & 63;
  const int gw = blockIdx.x * 4 + (threadIdx.x >> 6), nw = gridDim.x * 4;
  for (int row = gw; row < M; row += nw) {
    const float* o = OMIX + (size_t)row * 2048;
    u16* mo = MIXB + (size_t)row * 2048;
    float4 oc[4], xc[4], z[4], y[4], v[4], gg[4];
    float bn[4];
#pragma unroll
    for (int it = 0; it < 4; ++it) {
      int c = it * 256 + lane * 4;
      oc[it] = ld4(o + c);
      xc[it] = ld4(XC + (size_t)row * 1536 + c);
      z[it] = ld4(PROJ + (size_t)row * N1 + c);
      y[it] = ld4(o + 1024 + c);
      v[it] = ld4(RKV + (size_t)row * 3072 + 2048 + c);
      gg[it] = ld4(GG + (size_t)row * 1024 + c);
      bn[it] = BON[(size_t)row * 16 + it * 4 + (lane >> 4)];
    }
    float4 val[4];
    float ssq[4];
#pragma unroll
    for (int it = 0; it < 4; ++it) {
      float ds = dsk[it * 4 + (lane >> 4)];
      val[it].x = (oc[it].x + xc[it].x * ds) * z[it].x;
      val[it].y = (oc[it].y + xc[it].y * ds) * z[it].y;
      val[it].z = (oc[it].z + xc[it].z * ds) * z[it].z;
      val[it].w = (oc[it].w + xc[it].w * ds) * z[it].w;
      ssq[it] = val[it].x * val[it].x + val[it].y * val[it].y + val[it].z * val[it].z + val[it].w * val[it].w;
    }
    float inv0 = rsqrtf(wsum_u_(ssq[0] + ssq[1]) * (1.0f / 512.0f) + 1e-6f);
    float inv1 = rsqrtf(wsum_u_(ssq[2] + ssq[3]) * (1.0f / 512.0f) + 1e-6f);
#pragma unroll
    for (int it = 0; it < 4; ++it) {
      int c = it * 256 + lane * 4;
      float inv = (it < 2) ? inv0 : inv1;
      float4 sg = ld4(sng + c);
      st_bf4(mo + c, val[it].x * inv * sg.x, val[it].y * inv * sg.y, val[it].z * inv * sg.z, val[it].w * inv * sg.w);
      float mu = red16(y[it].x + y[it].y + y[it].z + y[it].w) * (1.0f / 64.0f);
      float dx = y[it].x - mu, dy = y[it].y - mu, dz = y[it].z - mu, dw = y[it].w - mu;
      float var = red16(dx * dx + dy * dy + dz * dz + dw * dw) * (1.0f / 64.0f);
      float iv = rsqrtf(var + 64e-5f);
      float4 lg = ld4(lxg + c), lb = ld4(lxb + c);
      float y0 = (dx * iv * lg.x + lb.x + bn[it] * v[it].x) * gg[it].x;
      float y1 = (dy * iv * lg.y + lb.y + bn[it] * v[it].y) * gg[it].y;
      float y2 = (dz * iv * lg.z + lb.z + bn[it] * v[it].z) * gg[it].z;
      float y3 = (dw * iv * lg.w + lb.w + bn[it] * v[it].w) * gg[it].w;
      st_bf4(mo + 1024 + c, y0, y1, y2, y3);
    }
  }
}

template <int ph>
DEVI void run_phase(const Params& p, char* smem_raw) {
  float* smem = (float*)smem_raw;
  char* ws = p.ws;
  {
    switch (ph) {
      case 0:
        phase0(p, smem);
        conv_fp8_rows(p.in[I_PU], (unsigned char*)(ws + OFF_UB), (float*)(ws + OFF_USC));
        conv_fp8_rows(p.in[I_PV], (unsigned char*)(ws + OFF_VB), (float*)(ws + OFF_VSC));
        break;
      case 1: {
        float* PROJ = (float*)(ws + OFF_PROJ);
        const float* LB = (const float*)(ws + OFF_LB);
        const double* IR = (const double*)(ws + OFF_INVREV);
        gemm_phase((const u16*)(ws + OFF_XB), 2048, 0, (const u16*)(ws + OFF_WIN0), 2048, MP / 128, N0 / 128, smem_raw,
                   [=](int row, int col, float v0, float v1) {
                     float* pr = PROJ + (size_t)row * N0;
                     if (col < 1024 || (col >= 3072 && col < 4096) || col >= 6144) {
                       pr[col] = siluf_(v0);
                       pr[col + 32] = siluf_(v1);
                     } else if (col < 2048) {
                       float l0 = LB[col - 1024], l1 = LB[col - 1024 + 32];
                       pr[col] = l0 + (1.0f - l0) * sigmoidf_(v0);
                       pr[col + 32] = l1 + (1.0f - l1) * sigmoidf_(v1);
                     } else if (col >= 4096 && col < 5120) {
                       int hb = col & ~127, c = col & 127, span = c >> 6, pp = c & 63;
                       int d = span * 32 + pp;
                       double rev = (double)row_pos(row) * IR[d];
                       float fr = (float)(rev - floor(rev));
                       float sn = __builtin_amdgcn_sinf(fr), cs = __builtin_amdgcn_cosf(fr);
                       float sc = (col >= 4608) ? 0.08838834764831845f : 1.0f;
                       pr[hb + d] = (v0 * cs - v1 * sn) * sc;
                       pr[hb + 64 + d] = (v0 * sn + v1 * cs) * sc;
                     } else {
                       pr[col] = v0;
                       pr[col + 32] = v1;
                     }
                   });
      } break;
      case 2: phase_rec0(p, smem); break;
      case 3: phase_post0(p); break;
      case 4: case 15: {
        float* GO = (float*)(ws + OFF_GOUT);
        gemm_phase((const u16*)(ws + OFF_MIXB), 2048, 0, (const u16*)(ws + (ph == 4 ? OFF_WOUT0 : OFF_WOUT1)), 2048,
                   MP / 128, 16, smem_raw, [=](int row, int col, float v0, float v1) {
                     GO[(size_t)row * 2048 + col] = v0;
                     GO[(size_t)row * 2048 + col + 32] = v1;
                   });
      } break;
      case 5: case 16: {
        int l = (ph == 5) ? 0 : 1;
        phase_ln(p, (const float*)(ws + OFF_GOUT), p.in[I_LNG] + (size_t)(l * 2) * D, p.in[I_LNB] + (size_t)(l * 2) * D);
      } break;
      case 6: case 17: {
        u16* QB = (u16*)(ws + OFF_QB);
        gemm_phase((const u16*)(ws + OFF_XB), 2048, 0, (const u16*)(ws + (ph == 6 ? OFF_WQ0 : OFF_WQ1)), 2048, MP / 128,
                   16, smem_raw, [=](int row, int col, float v0, float v1) {
                     QB[(size_t)row * 2048 + col] = f2bf(v0);
                     QB[(size_t)row * 2048 + col + 32] = f2bf(v1);
                   });
      } break;
      case 7: case 18: {
        float* SC = (float*)(ws + OFF_GOUT);
        gemm_phase((const u16*)(ws + OFF_QB), 2048, 128, (const u16*)(ws + (ph == 7 ? OFF_KEY0 : OFF_KEY1)), 128,
                   MP / 128, 16, smem_raw, [=](int row, int col, float v0, float v1) {
                     SC[(size_t)row * 2048 + col] = v0;
                     SC[(size_t)row * 2048 + col + 32] = v1;
                   });
      } break;
      case 8: phase_peer(p, 0, false); break;
      case 9: {
        conv_fp8_rows(p.in[I_PU] + (size_t)16384 * 2048, (unsigned char*)(ws + OFF_UB), (float*)(ws + OFF_USC));
        conv_fp8_rows(p.in[I_PV] + (size_t)16384 * 2048, (unsigned char*)(ws + OFF_VB), (float*)(ws + OFF_VSC));
        float* PROJ = (float*)(ws + OFF_PROJ);
        float* DTA = (float*)(ws + OFF_DTA);
        const float* dtb = p.in[I_DTB];
        const float* alog = p.in[I_ALOG];
        gemm_phase((const u16*)(ws + OFF_XB), 2048, 0, (const u16*)(ws + OFF_WIN1), 2048, MP / 128, N1 / 128, smem_raw,
                   [=](int row, int col, float v0, float v1) {
                     float* pr = PROJ + (size_t)row * N1;
                     if (col < 1024) {
                       pr[col] = siluf_(v0);
                       pr[col + 32] = siluf_(v1);
                     } else if (col < 5888) {
                       pr[col] = v0;
                       pr[col + 32] = v1;
                     } else {
#pragma unroll
                       for (int e = 0; e < 2; ++e) {
                         int cc = col + e * 32;
                         float v = e ? v1 : v0;
                         if (cc < 5920) pr[cc] = v;
                         else if (cc < 5936) {
                           int h = cc - 5920;
                           float dt = softplusf_(v + dtb[h]);
                           DTA[(size_t)row * 64 + h * 4] = dt;
                           DTA[(size_t)row * 64 + h * 4 + 1] = expf(-dt * expf(alog[h]));
                         }
                       }
                     }
                   });
      } break;
      case 10: phase_pre1(p); break;
      case 11: {
        float* DEC = (float*)(ws + OFF_DEC);
        float* AA = (float*)(ws + OFF_AA);
        float* GG = (float*)(ws + OFF_GG);
        const float* w0 = p.in[I_W0];
        const float* a0 = p.in[I_A0];
        gemm_phase((const u16*)(ws + OFF_LRA), 64, 0, (const u16*)(ws + OFF_W2T), 64, MP / 128, 8, smem_raw,
                   [=](int row, int col, float v0, float v1) {
#pragma unroll
                     for (int e = 0; e < 2; ++e) {
                       int cc = col + e * 32;
                       float v = (e ? v1 : v0) + w0[cc];
                       float wl = -softplusf_(-v) - 0.5f;
                       DEC[(size_t)row * 1024 + cc] = expf(-expf(wl));
                     }
                   });
        gemm_phase((const u16*)(ws + OFF_LRB), 64, 0, (const u16*)(ws + OFF_A2T), 64, MP / 128, 8, smem_raw,
                   [=](int row, int col, float v0, float v1) {
                     AA[(size_t)row * 1024 + col] = sigmoidf_(v0 + a0[col]);
                     AA[(size_t)row * 1024 + col + 32] = sigmoidf_(v1 + a0[col + 32]);
                   });
        gemm_phase((const u16*)(ws + OFF_LRG), 192, 0, (const u16*)(ws + OFF_G2T), 192, MP / 128, 8, smem_raw,
                   [=](int row, int col, float v0, float v1) {
                     GG[(size_t)row * 1024 + col] = v0;
                     GG[(size_t)row * 1024 + col + 32] = v1;
                   });
      } break;
      case 12: phase_pre1c(p); break;
      case 13: phase_rec1(p, smem); break;
      case 14: phase_post1(p); break;
      case 19: phase_peer(p, 1, true); break;
      default: break;
    }
  }
}

__global__ void __launch_bounds__(256, 2) mega(Params p, int ph_lo, int ph_hi) {
  __shared__ __attribute__((aligned(16))) char smem_raw[SMEM_BYTES];
  cg::grid_group grid = cg::this_grid();
#ifndef REPEAT_MASK
#define REPEAT_MASK 0
#endif
#define PHASE(K)                                          \
  if (ph_lo <= K && K < ph_hi) run_phase<K>(p, smem_raw); \
  if ((REPEAT_MASK >> K) & 1) { grid.sync(); run_phase<K>(p, smem_raw); } \
  if (ph_lo <= K && K + 1 < ph_hi) grid.sync();
  PHASE(0) PHASE(1) PHASE(2) PHASE(3) PHASE(4) PHASE(5) PHASE(6) PHASE(7) PHASE(8) PHASE(9)
  PHASE(10) PHASE(11) PHASE(12) PHASE(13) PHASE(14) PHASE(15) PHASE(16) PHASE(17) PHASE(18) PHASE(19)
}
#ifdef PHASE_TEST
template <int PH>
__global__ void __launch_bounds__(256, 2) phk(Params p) {
  __shared__ __attribute__((aligned(16))) char smem_raw[SMEM_BYTES];
  run_phase<PH>(p, smem_raw);
}
#define INST(N) template __global__ void phk<N>(Params);
INST(0) INST(1) INST(2) INST(3) INST(4) INST(5) INST(6) INST(7) INST(8) INST(9) INST(10) INST(11) INST(12) INST(13) INST(14) INST(19)
#endif

constexpr int NPHASE = 20;

extern "C" void kernel_launch(void* const* d_in, const int* in_sizes, int n_in, void* d_out, int out_size, void* d_ws,
                              size_t ws_size, hipStream_t stream) {
  static int grid_blocks = 0;
  if (!grid_blocks) {
    int dev = 0, cus = 0, per_cu = 0;
    hipGetDevice(&dev);
    hipDeviceGetAttribute(&cus, hipDeviceAttributeMultiprocessorCount, dev);
    hipOccupancyMaxActiveBlocksPerMultiprocessor(&per_cu, mega, 256, 0);
    if (per_cu > 2) per_cu = 2;
    if (per_cu < 1) per_cu = 1;
    grid_blocks = cus * per_cu;
  }
  Params p{};
  for (int i = 0; i < 38; ++i) p.in[i] = (const float*)d_in[i];
  p.out = (float*)d_out;
  p.ws = (char*)d_ws;
  int lo = 0, hi = NPHASE;
  void* args[] = {&p, &lo, &hi};
  hipError_t e = hipLaunchCooperativeKernel((void*)mega, dim3(grid_blocks), dim3(256), args, 0, stream);
  if (e != hipSuccess) fprintf(stderr, "cooperative launch failed: %s (grid %d)\n", hipGetErrorString(e), grid_blocks);
}
```

```cpp
#include <hip/hip_runtime.h>
#include <hip/hip_bf16.h>
#include <hip/hip_cooperative_groups.h>
#include <cstdio>
#include <cmath>
namespace cg = cooperative_groups;

#define DEVI __device__ __forceinline__
typedef unsigned short u16;
using bf16x8 = __attribute__((ext_vector_type(8))) short;
using f32x4 = __attribute__((ext_vector_type(4))) float;
using u32x4 = __attribute__((ext_vector_type(4))) unsigned int;

constexpr int D = 2048;
constexpr int TP = 2064;
constexpr int MPR = 8256;
constexpr int M = 8768;
constexpr int MP = 8832;
constexpr int N0 = 7168;
constexpr int N1 = 6016;
constexpr float ALPHA = 1.41421356237f;

constexpr size_t SZ_TAB = (size_t)16384 * 2048 * 2;
constexpr size_t OFF_UB = 0;
constexpr size_t OFF_VB = OFF_UB + SZ_TAB;
constexpr size_t OFF_WIN0 = OFF_VB + SZ_TAB;
constexpr size_t OFF_WOUT0 = OFF_WIN0 + (size_t)N0 * 2048 * 2;
constexpr size_t OFF_WQ0 = OFF_WOUT0 + (size_t)2048 * 2048 * 2;
constexpr size_t OFF_KEY0 = OFF_WQ0 + (size_t)2048 * 2048 * 2;
constexpr size_t OFF_WIN1 = OFF_KEY0 + (size_t)16 * 128 * 128 * 2;
constexpr size_t OFF_WOUT1 = OFF_WIN1 + (size_t)N1 * 2048 * 2;
constexpr size_t OFF_WQ1 = OFF_WOUT1 + (size_t)2048 * 2048 * 2;
constexpr size_t OFF_KEY1 = OFF_WQ1 + (size_t)2048 * 2048 * 2;
constexpr size_t OFF_W2T = OFF_KEY1 + (size_t)16 * 128 * 128 * 2;
constexpr size_t OFF_A2T = OFF_W2T + (size_t)1024 * 64 * 2;
constexpr size_t OFF_G2T = OFF_A2T + (size_t)1024 * 64 * 2;
constexpr size_t OFF_LB = OFF_G2T + (size_t)1024 * 192 * 2;
constexpr size_t OFF_INVREV = OFF_LB + 1024 * 4;
constexpr size_t OFF_XF = OFF_INVREV + 64 * 8;
constexpr size_t OFF_XB = OFF_XF + (size_t)MP * 2048 * 4;
constexpr size_t OFF_PROJ = OFF_XB + (size_t)MP * 2048 * 2;
constexpr size_t OFF_GOUT = OFF_PROJ + (size_t)MP * N0 * 4;
constexpr size_t OFF_OMIX = OFF_GOUT + (size_t)MP * 2048 * 4;
constexpr size_t OFF_MIXB = OFF_OMIX + (size_t)MP * 2048 * 4;
constexpr size_t OFF_QB = OFF_MIXB + (size_t)MP * 2048 * 2;
constexpr size_t OFF_RKV = OFF_QB + (size_t)MP * 2048 * 2;
constexpr size_t OFF_DEC = OFF_RKV + (size_t)MP * 3072 * 4;
constexpr size_t OFF_AA = OFF_DEC + (size_t)MP * 1024 * 4;
constexpr size_t OFF_GG = OFF_AA + (size_t)MP * 1024 * 4;
constexpr size_t OFF_LRA = OFF_GG + (size_t)MP * 1024 * 4;
constexpr size_t OFF_LRB = OFF_LRA + (size_t)MP * 64 * 2;
constexpr size_t OFF_LRG = OFF_LRB + (size_t)MP * 64 * 2;
constexpr size_t OFF_DTA = OFF_LRG + (size_t)MP * 192 * 2;
constexpr size_t OFF_BON = OFF_DTA + (size_t)MP * 64 * 4;
constexpr size_t OFF_USC = OFF_BON + (size_t)MP * 16 * 4;
constexpr size_t OFF_VSC = OFF_USC + 16384 * 4;
constexpr size_t OFF_BAR = OFF_VSC + 16384 * 4;
constexpr size_t WS_TOTAL = OFF_BAR + 3456 * 4;
static_assert(WS_TOTAL <= (size_t)1 << 30, "workspace too large");

constexpr size_t O_YP = 0;
constexpr size_t O_YS = O_YP + (size_t)4 * 2048 * 2048;
constexpr size_t O_HGP = O_YS + (size_t)128 * 4 * 2048;
constexpr size_t O_HGS = O_HGP + (size_t)4 * 8 * 128 * 128;
constexpr size_t O_RTP = O_HGS + (size_t)128 * 8 * 128 * 128;
constexpr size_t O_RTS = O_RTP + (size_t)4 * 4 * 128 * 256;
constexpr size_t O_SSP = O_RTS + (size_t)128 * 4 * 128 * 256;
constexpr size_t O_SSS = O_SSP + (size_t)4 * 16 * 128 * 64;
constexpr size_t O_CVP = O_SSS + (size_t)128 * 16 * 128 * 64;
constexpr size_t O_CVS = O_CVP + (size_t)4 * 3 * 1536;
constexpr size_t O_WKP = O_CVS + (size_t)128 * 3 * 1536;
constexpr size_t O_WKS = O_WKP + (size_t)4 * 16 * 64 * 64;
constexpr size_t O_SHP = O_WKS + (size_t)128 * 16 * 64 * 64;
constexpr size_t O_SHS = O_SHP + (size_t)4 * 3360;

struct Params {
  const float* in[38];
  float* out;
  char* ws;
};
enum { I_XP = 0, I_XS, I_SHG, I_SRT, I_SSM, I_SCV, I_SWK, I_SSH, I_META, I_LNG, I_LNB, I_EWIN, I_LBL, I_HNG, I_EWOUT,
       I_OWIN, I_CVW, I_CVB, I_DTB, I_ALOG, I_DSK, I_SNG, I_MU, I_W0, I_W2, I_A0, I_A2, I_G2, I_KK, I_KA, I_RK,
       I_LXG, I_LXB, I_OWOUT, I_WQ, I_KEYS, I_PU, I_PV };

constexpr int SMEM_BYTES = 2 * 16 * 336 * 4 + 2 * 16 * 32 * 4;

DEVI u16 f2bf(float f) {
  unsigned u = __float_as_uint(f);
  u += 0x7fffu + ((u >> 16) & 1u);
  return (u16)(u >> 16);
}
DEVI unsigned pack2(float a, float b) { return (unsigned)f2bf(a) | ((unsigned)f2bf(b) << 16); }
DEVI float bflo(unsigned u) { return __uint_as_float(u << 16); }
DEVI float bfhi(unsigned u) { return __uint_as_float(u & 0xffff0000u); }
DEVI float sigmoidf_(float x) { return 1.0f / (1.0f + expf(-x)); }
DEVI float siluf_(float x) { return x / (1.0f + expf(-x)); }
DEVI float softplusf_(float x) { return fmaxf(x, 0.0f) + log1pf(expf(-fabsf(x))); }
DEVI float wsum(float v) {
#pragma unroll
  for (int o = 32; o > 0; o >>= 1) v += __shfl_xor(v, o, 64);
  return v;
}
DEVI float wmaxf_(float v) {
#pragma unroll
  for (int o = 32; o > 0; o >>= 1) v = fmaxf(v, __shfl_xor(v, o, 64));
  return v;
}
DEVI int wmini_(int v) {
#pragma unroll
  for (int o = 32; o > 0; o >>= 1) v = min(v, __shfl_xor(v, o, 64));
  return v;
}
template <int CTRL>
DEVI float dppf(float v) {
  return __int_as_float(__builtin_amdgcn_update_dpp(0, __float_as_int(v), CTRL, 0xF, 0xF, true));
}
DEVI float red8(float v) {
  v += dppf<0xB1>(v);
  v += dppf<0x4E>(v);
  v += dppf<0x141>(v);
  return v;
}
DEVI float red16(float v) {
  v = red8(v);
  v += dppf<0x140>(v);
  return v;
}
DEVI int row_pos(int row) { return row < MPR ? (row % TP) : (16384 + ((row - MPR) & 3)); }

DEVI void conv_bf16_flat(const float* __restrict__ src, u16* __restrict__ dst, size_t n4) {
  size_t stride = (size_t)gridDim.x * blockDim.x;
  for (size_t i = (size_t)blockIdx.x * blockDim.x + threadIdx.x; i < n4; i += stride) {
    float4 v = ((const float4*)src)[i];
    uint2 o;
    o.x = pack2(v.x, v.y);
    o.y = pack2(v.z, v.w);
    ((uint2*)dst)[i] = o;
  }
}

template <int MODE>
DEVI int colmap(int j) {
  if (MODE == 0) return j;
  if (MODE == 1) {
    if (j < 4096 || j >= 5120) return j;
    int hb = j & ~127, c = j & 127, span = c >> 6, p = c & 63;
    int d = (p < 32) ? (span * 32 + p) : (64 + span * 32 + (p - 32));
    return hb + d;
  }
  if (j < 2560) return j;
  if (j < 5920) return j + 16;
  if (j < 5936) return 2560 + (j - 5920);
  return -1;
}

template <int MODE>
DEVI void transpose_job(const float* __restrict__ src, int ldsrc, int Ksrc, u16* __restrict__ dst, int Kdst, int ndst,
                        float* smem) {
  int ktiles = Kdst / 64, ntiles = ndst / 64;
  int tid = threadIdx.x;
  for (int tile = blockIdx.x; tile < ktiles * ntiles; tile += gridDim.x) {
    int tn = tile / ktiles, tk = tile % ktiles;
    int j0 = tn * 64, k0 = tk * 64;
    int jj = tid & 63;
    int sc = colmap<MODE>(j0 + jj);
#pragma unroll
    for (int i = 0; i < 16; ++i) {
      int kk = i * 4 + (tid >> 6);
      float v = 0.f;
      if (sc >= 0 && (k0 + kk) < Ksrc) v = src[(size_t)(k0 + kk) * ldsrc + sc];
      smem[kk * 65 + jj] = v;
    }
    __syncthreads();
    int jr = tid >> 2, kq = (tid & 3) * 16;
    unsigned pk[8];
#pragma unroll
    for (int e = 0; e < 8; ++e) pk[e] = pack2(smem[(kq + 2 * e) * 65 + jr], smem[(kq + 2 * e + 1) * 65 + jr]);
    uint4* dp = (uint4*)(dst + (size_t)(j0 + jr) * Kdst + k0 + kq);
    dp[0] = make_uint4(pk[0], pk[1], pk[2], pk[3]);
    dp[1] = make_uint4(pk[4], pk[5], pk[6], pk[7]);
    __syncthreads();
  }
}

DEVI void phase0(const Params& p, float* smem) {
  char* ws = p.ws;
  conv_bf16_flat(p.in[I_KEYS], (u16*)(ws + OFF_KEY0), (size_t)16 * 128 * 128 / 4);
  conv_bf16_flat(p.in[I_KEYS] + (size_t)16 * 128 * 128, (u16*)(ws + OFF_KEY1), (size_t)16 * 128 * 128 / 4);
  transpose_job<1>(p.in[I_EWIN], N0, 2048, (u16*)(ws + OFF_WIN0), 2048, N0, smem);
  transpose_job<0>(p.in[I_EWOUT], 2048, 2048, (u16*)(ws + OFF_WOUT0), 2048, 2048, smem);
  transpose_job<0>(p.in[I_WQ], 2048, 2048, (u16*)(ws + OFF_WQ0), 2048, 2048, smem);
  transpose_job<0>(p.in[I_WQ] + (size_t)2048 * 2048, 2048, 2048, (u16*)(ws + OFF_WQ1), 2048, 2048, smem);
  transpose_job<2>(p.in[I_OWIN], 5936, 2048, (u16*)(ws + OFF_WIN1), 2048, N1, smem);
  transpose_job<0>(p.in[I_OWOUT], 2048, 2048, (u16*)(ws + OFF_WOUT1), 2048, 2048, smem);
  transpose_job<0>(p.in[I_W2], 1024, 64, (u16*)(ws + OFF_W2T), 64, 1024, smem);
  transpose_job<0>(p.in[I_A2], 1024, 64, (u16*)(ws + OFF_A2T), 64, 1024, smem);
  transpose_job<0>(p.in[I_G2], 1024, 160, (u16*)(ws + OFF_G2T), 192, 1024, smem);
  {
    float* XF = (float*)(ws + OFF_XF);
    u16* XB = (u16*)(ws + OFF_XB);
    size_t n4 = (size_t)MP * 512;
    size_t stride = (size_t)gridDim.x * blockDim.x;
    for (size_t i = (size_t)blockIdx.x * blockDim.x + threadIdx.x; i < n4; i += stride) {
      int row = (int)(i >> 9), c4 = (int)(i & 511);
      float4 v = make_float4(0.f, 0.f, 0.f, 0.f);
      if (row < MPR) {
        int b = row / TP, t = row % TP;
        const float* s = (t < 16) ? (p.in[I_META] + (size_t)t * D) : (p.in[I_XP] + ((size_t)b * 2048 + (t - 16)) * D);
        v = ((const float4*)s)[c4];
      } else if (row < M) {
        v = ((const float4*)(p.in[I_XS] + (size_t)(row - MPR) * D))[c4];
      }
      ((float4*)XF)[i] = v;
      uint2 o;
      o.x = pack2(v.x, v.y);
      o.y = pack2(v.z, v.w);
      ((uint2*)XB)[i] = o;
    }
  }
  if (blockIdx.x == 0) {
    float* LB = (float*)(ws + OFF_LB);
    const float* lg = p.in[I_LBL];
    for (int c = threadIdx.x; c < 1024; c += blockDim.x) {
      float a = lg[c], b = lg[1024 + c], d = lg[2048 + c];
      float m = fmaxf(a, fmaxf(b, d));
      float ea = expf(a - m), eb = expf(b - m), ed = expf(d - m);
      LB[c] = ea / (ea + eb + ed);
    }
    double* IR = (double*)(ws + OFF_INVREV);
    if (threadIdx.x < 64) {
      double d = (double)threadIdx.x;
      IR[threadIdx.x] = exp(-d * (9.210340371976184 / 64.0)) * 0.15915494309189535;
    }
  }
}

constexpr int G_LDS_STRIDE = 72;
template <class Epi>
DEVI void gemm_phase(const u16* __restrict__ A, int lda, int a_ntile_off, const u16* __restrict__ Bt, int K, int mtiles,
                     int ntiles, char* smem, Epi epi) {
  u16* SA = (u16*)smem;
  u16* SB = SA + 128 * G_LDS_STRIDE;
  const int tid = threadIdx.x, wid = tid >> 6, lane = tid & 63, wr = wid >> 1, wc = wid & 1, fr = lane & 15, fq = lane >> 4;
  const int ntot = mtiles * ntiles;
  const int nk = K / 64;
  for (int tile = blockIdx.x; tile < ntot; tile += gridDim.x) {
    int tm = tile / ntiles, tn = tile % ntiles;
    int brow = tm * 128, bcol = tn * 128;
    const u16* Ag = A + (size_t)brow * lda + (size_t)tn * a_ntile_off;
    const u16* Bg = Bt + (size_t)bcol * K;
    f32x4 acc[4][4];
#pragma unroll
    for (int m = 0; m < 4; ++m)
#pragma unroll
      for (int n = 0; n < 4; ++n) acc[m][n] = f32x4{0.f, 0.f, 0.f, 0.f};
    u32x4 ra[4], rb[4];
#pragma unroll
    for (int i = 0; i < 4; ++i) {
      int ch = tid + i * 256, r = ch >> 3, kc = ch & 7;
      ra[i] = *(const u32x4*)(Ag + (size_t)r * lda + kc * 8);
      rb[i] = *(const u32x4*)(Bg + (size_t)r * K + kc * 8);
    }
    for (int t = 0; t < nk; ++t) {
#pragma unroll
      for (int i = 0; i < 4; ++i) {
        int ch = tid + i * 256, r = ch >> 3, kc = ch & 7;
        *(u32x4*)(SA + r * G_LDS_STRIDE + kc * 8) = ra[i];
        *(u32x4*)(SB + r * G_LDS_STRIDE + kc * 8) = rb[i];
      }
      __syncthreads();
      if (t + 1 < nk) {
#pragma unroll
        for (int i = 0; i < 4; ++i) {
          int ch = tid + i * 256, r = ch >> 3, kc = ch & 7;
          ra[i] = *(const u32x4*)(Ag + (size_t)r * lda + (t + 1) * 64 + kc * 8);
          rb[i] = *(const u32x4*)(Bg + (size_t)r * K + (t + 1) * 64 + kc * 8);
        }
      }
#pragma unroll
      for (int kh = 0; kh < 2; ++kh) {
        bf16x8 At[4], Bl[4];
#pragma unroll
        for (int m = 0; m < 4; ++m)
          At[m] = *(const bf16x8*)(SA + (wr * 64 + m * 16 + fr) * G_LDS_STRIDE + kh * 32 + fq * 8);
#pragma unroll
        for (int n = 0; n < 4; ++n)
          Bl[n] = *(const bf16x8*)(SB + (wc * 64 + n * 16 + fr) * G_LDS_STRIDE + kh * 32 + fq * 8);
#pragma unroll
        for (int m = 0; m < 4; ++m)
#pragma unroll
          for (int n = 0; n < 4; ++n) acc[m][n] = __builtin_amdgcn_mfma_f32_16x16x32_bf16(At[m], Bl[n], acc[m][n], 0, 0, 0);
      }
      __syncthreads();
    }
#pragma unroll
    for (int m = 0; m < 4; ++m)
#pragma unroll
      for (int n = 0; n < 2; ++n)
#pragma unroll
        for (int j = 0; j < 4; ++j) {
          int row = brow + wr * 64 + m * 16 + fq * 4 + j;
          int col = bcol + wc * 64 + n * 16 + fr;
          epi(row, col, acc[m][n][j], acc[m][n + 2][j]);
        }
  }
}

struct Seg {
  int off;
  int ld;
  int n4;
};

template <int NS, int NF4, int RG>
DEVI void stage_init(const float* wsf, const Seg (&sg)[NS], int row0, int tid, const float* (&ptr)[RG], int (&ldv)[RG]) {
  asm volatile("" : "+v"(tid));
#pragma unroll
  for (int q = 0; q < RG; ++q) {
    int flat = tid + q * 256;
    int t = flat / NF4, f = flat % NF4;
    if (flat >= 16 * NF4) { t = 0; f = 0; }
    int off = 0, ld = 0, ff = f;
    bool done = false;
#pragma unroll
    for (int s = 0; s < NS; ++s) {
      bool here = (!done) && (ff < sg[s].n4);
      off = here ? (sg[s].off + (row0 + t) * sg[s].ld + ff * 4) : off;
      ld = here ? sg[s].ld : ld;
      ff = (done || here) ? ff : (ff - sg[s].n4);
      done = done || here;
    }
    ptr[q] = wsf + off;
    ldv[q] = ld;
  }
}
template <int NF4, int RG>
DEVI void stage_issue(const float* const (&ptr)[RG], const int (&ldv)[RG], int st, int nsteps, int tid, f32x4 (&rg)[RG]) {
#pragma unroll
  for (int q = 0; q < RG; ++q) {
    int flat = tid + q * 256;
    if (flat < nsteps * NF4) rg[q] = *(const f32x4*)(ptr[q] + (st * 16) * ldv[q]);
  }
}
template <int NF4, int RG>
DEVI void stage_commit(float* buf, int nsteps, int tid, const f32x4 (&rg)[RG]) {
#pragma unroll
  for (int q = 0; q < RG; ++q) {
    int flat = tid + q * 256;
    if (flat < nsteps * NF4) ((f32x4*)buf)[flat] = rg[q];
  }
}

template <int MODE>
DEVI void colrec_long(const float* wsf, const Seg (&sg)[4], int row0, int T, float gamma, float* outp, int ldo, float* stout, int st_ld,
                      float* smem) {
  constexpr int NF4 = 69, W = 276, RG = 5;
  const int tid = threadIdx.x, w = tid >> 6, lane = tid & 63, c = lane >> 4, s = lane & 15;
  float S[8];
#pragma unroll
  for (int i = 0; i < 8; ++i) S[i] = 0.f;
  float* buf0 = smem;
  float* buf1 = smem + 16 * 336;
  float* obuf = smem + 2 * 16 * 336;
  const int nst = (T + 15) / 16;
  f32x4 rg[RG];
  const float* sptr[RG];
  int sld[RG];
  stage_init<4, NF4, RG>(wsf, sg, row0, tid, sptr, sld);
  stage_issue<NF4, RG>(sptr, sld, 0, min(16, T), tid, rg);
  stage_commit<NF4, RG>(buf0, min(16, T), tid, rg);
  __syncthreads();
  auto step = [&](const float* sp, float* ob, int tt) {
    float4 a0 = *(const float4*)(sp + s * 8), a1 = *(const float4*)(sp + s * 8 + 4);
    float4 q0 = *(const float4*)(sp + 128 + s * 8), q1 = *(const float4*)(sp + 128 + s * 8 + 4);
    float a[8] = {a0.x, a0.y, a0.z, a0.w, a1.x, a1.y, a1.z, a1.w};
    float q[8] = {q0.x, q0.y, q0.z, q0.w, q1.x, q1.y, q1.z, q1.w};
    float val = sp[256 + w * 4 + c];
    float dA = gamma;
    if (MODE == 2) {
      val *= sp[272];
      dA = sp[273];
    }
    float o = 0.f;
#pragma unroll
    for (int i = 0; i < 8; ++i) {
      if (MODE == 0) S[i] = val + a[i] * (S[i] - val);
      else S[i] = dA * S[i] + a[i] * val;
      o += q[i] * S[i];
    }
    o = red16(o);
    if (s == 0) ob[tt * 16 + w * 4 + c] = o;
  };
#pragma unroll 1
  for (int st = 0; st < nst; ++st) {
    const int nthis = min(16, T - st * 16);
    const int nnext = min(16, T - (st + 1) * 16);
    if (st + 1 < nst) stage_issue<NF4, RG>(sptr, sld, st + 1, nnext, tid, rg);
    const float* b = (st & 1) ? buf1 : buf0;
    float* ob = obuf + (st & 1) * 512;
#pragma unroll 1
    for (int tt = 0; tt < nthis; tt += 4) {
      step(b + tt * W, ob, tt);
      step(b + (tt + 1) * W, ob, tt + 1);
      step(b + (tt + 2) * W, ob, tt + 2);
      step(b + (tt + 3) * W, ob, tt + 3);
    }
    if (st + 1 < nst) stage_commit<NF4, RG>((st & 1) ? buf0 : buf1, nnext, tid, rg);
    __syncthreads();
    if (tid < nthis * 4) {
      int t = tid >> 2, c4 = tid & 3;
      *(float4*)(outp + (size_t)(st * 16 + t) * ldo + c4 * 4) = *(const float4*)(ob + t * 16 + c4 * 4);
    }
  }
#pragma unroll
  for (int i = 0; i < 8; ++i) stout[(size_t)(s * 8 + i) * st_ld + w * 4 + c] = S[i];
  __syncthreads();
}

template <int MODE>
DEVI void colrec_short(const float* pa, int lda_, const float* pq, int ldq, const float* pc, int ldc, const float* pdt,
                       long row0, float gamma, const float* stin, float* stout, int st_ld, float* outp, int ldo,
                       float* smem) {
  const int tid = threadIdx.x, lane = tid & 63;
  const int wid = __builtin_amdgcn_readfirstlane(tid >> 6);
  const int k0 = wid * 32;
  float S[32];
#pragma unroll
  for (int i = 0; i < 32; ++i) S[i] = stin[(size_t)(k0 + i) * st_ld + lane];
#pragma unroll 1
  for (int t = 0; t < 4; ++t) {
    long row = row0 + t;
    float val = pc[(size_t)row * ldc + lane];
    float dA = gamma;
    if (MODE == 2) {
      val *= pdt[(size_t)row * 64];
      dA = pdt[(size_t)row * 64 + 1];
    }
    const float4* ap = (const float4*)(pa + (size_t)row * lda_ + k0);
    const float4* qp = (const float4*)(pq + (size_t)row * ldq + k0);
    float o = 0.f;
#pragma unroll
    for (int i4 = 0; i4 < 8; ++i4) {
      float4 av = ap[i4], qv = qp[i4];
      float a[4] = {av.x, av.y, av.z, av.w};
      float q[4] = {qv.x, qv.y, qv.z, qv.w};
#pragma unroll
      for (int e = 0; e < 4; ++e) {
        int i = i4 * 4 + e;
        if (MODE == 0) S[i] = val + a[e] * (S[i] - val);
        else S[i] = dA * S[i] + a[e] * val;
        o += q[e] * S[i];
      }
    }
    smem[(wid * 4 + t) * 64 + lane] = o;
  }
#pragma unroll
  for (int i = 0; i < 32; ++i) stout[(size_t)(k0 + i) * st_ld + lane] = S[i];
  __syncthreads();
  {
    int t = tid >> 6;
    float sum = smem[(0 * 4 + t) * 64 + lane] + smem[(1 * 4 + t) * 64 + lane] + smem[(2 * 4 + t) * 64 + lane] +
                smem[(3 * 4 + t) * 64 + lane];
    outp[(size_t)(row0 + t) * ldo + lane] = sum;
  }
  __syncthreads();
}

DEVI void rwkv_item(const float* wsf, const Seg (&sg)[6], int row0, int T, const float* stin, float* stout, float* outp, int ldo,
                    float* smem) {
  constexpr int NF4 = 84, W = 336, RG = 6;
  const int tid = threadIdx.x, w = tid >> 6, lane = tid & 63, rl = lane >> 4, sl = lane & 15;
  const int il = w * 4 + rl;
  float S[4];
  if (stin) {
    float4 v = *(const float4*)(stin + il * 64 + sl * 4);
    S[0] = v.x; S[1] = v.y; S[2] = v.z; S[3] = v.w;
  } else {
    S[0] = S[1] = S[2] = S[3] = 0.f;
  }
  float* buf0 = smem;
  float* buf1 = smem + 16 * 336;
  float* obuf = smem + 2 * 16 * 336;
  const int nst = (T + 15) / 16;
  f32x4 rg[RG];
  const float* sptr[RG];
  int sld[RG];
  stage_init<6, NF4, RG>(wsf, sg, row0, tid, sptr, sld);
  stage_issue<NF4, RG>(sptr, sld, 0, min(16, T), tid, rg);
  stage_commit<NF4, RG>(buf0, min(16, T), tid, rg);
  __syncthreads();
#pragma unroll 1
  for (int st = 0; st < nst; ++st) {
    const int nthis = min(16, T - st * 16);
    const int nnext = min(16, T - (st + 1) * 16);
    if (st + 1 < nst) stage_issue<NF4, RG>(sptr, sld, st + 1, nnext, tid, rg);
    const float* b = (st & 1) ? buf1 : buf0;
    float* ob = obuf + (st & 1) * 512;
#pragma unroll 4
    for (int tt = 0; tt < nthis; ++tt) {
      const float* sp = b + tt * W;
      float4 r4 = *(const float4*)(sp + sl * 4);
      float4 w4 = *(const float4*)(sp + 64 + sl * 4);
      float4 k4 = *(const float4*)(sp + 128 + sl * 4);
      float4 n4 = *(const float4*)(sp + 192 + sl * 4);
      float4 m4 = *(const float4*)(sp + 256 + sl * 4);
      float vi = sp[320 + il];
      float sa = S[0] * n4.x + S[1] * n4.y + S[2] * n4.z + S[3] * n4.w;
      sa = -red16(sa);
      S[0] = S[0] * w4.x + sa * m4.x + vi * k4.x;
      S[1] = S[1] * w4.y + sa * m4.y + vi * k4.y;
      S[2] = S[2] * w4.z + sa * m4.z + vi * k4.z;
      S[3] = S[3] * w4.w + sa * m4.w + vi * k4.w;
      float y = S[0] * r4.x + S[1] * r4.y + S[2] * r4.z + S[3] * r4.w;
      y = red16(y);
      if (sl == 0) ob[tt * 16 + il] = y;
    }
    if (st + 1 < nst) stage_commit<NF4, RG>((st & 1) ? buf0 : buf1, nnext, tid, rg);
    __syncthreads();
    if (tid < nthis * 4) {
      int t = tid >> 2, c4 = tid & 3;
      *(float4*)(outp + (size_t)(st * 16 + t) * ldo + c4 * 4) = *(const float4*)(ob + t * 16 + c4 * 4);
    }
  }
  *(float4*)(stout + il * 64 + sl * 4) = make_float4(S[0], S[1], S[2], S[3]);
  __syncthreads();
}

DEVI void phase_rec0(const Params& p, float* smem) {
  char* ws = p.ws;
  const float* PROJ = (const float*)(ws + OFF_PROJ);
  float* OMIX = (float*)(ws + OFF_OMIX);
  const float* wsf = (const float*)ws;
  constexpr int PO = (int)(OFF_PROJ / 4);
  for (int item = blockIdx.x; item < 4608; item += gridDim.x) {
    if (item < 256) {
      int b = item >> 6, h = (item >> 3) & 7, cb = item & 7;
      Seg sg[4] = {{PO + 1024 + h * 128, N0, 32}, {PO + h * 128, N0, 32}, {PO + 2048 + h * 128 + cb * 16, N0, 4},
                   {PO, N0, 1}};
      int row0 = b * TP;
      colrec_long<0>(wsf, sg, row0, TP, 0.f, OMIX + (size_t)row0 * 2048 + h * 128 + cb * 16, 2048,
                     p.out + O_HGP + (size_t)(b * 8 + h) * 128 * 128 + cb * 16, 128, smem);
    } else if (item < 512) {
      int it = item - 256;
      int b = it >> 6, h = (it >> 4) & 3, cb = it & 15;
      Seg sg[4] = {{PO + 4608 + h * 128, N0, 32}, {PO + 4096 + h * 128, N0, 32},
                   {PO + 5120 + h * 256 + cb * 16, N0, 4}, {PO, N0, 1}};
      int row0 = b * TP;
      float gamma = 1.0f - exp2f(-5.0f - (float)h);
      colrec_long<1>(wsf, sg, row0, TP, gamma, OMIX + (size_t)row0 * 2048 + 1024 + h * 256 + cb * 16, 2048,
                     p.out + O_RTP + (size_t)(b * 4 + h) * 128 * 256 + cb * 16, 256, smem);
    } else if (item < 2560) {
      int it = item - 512;
      int b = it >> 4, h = (it >> 1) & 7, cb = it & 1;
      long row0 = MPR + (long)b * 4;
      size_t so = (size_t)(b * 8 + h) * 128 * 128 + cb * 64;
      colrec_short<0>(PROJ + 1024 + h * 128, N0, PROJ + h * 128, N0, PROJ + 2048 + h * 128 + cb * 64, N0, nullptr, row0,
                      0.f, p.in[I_SHG] + so, p.out + O_HGS + so, 128, OMIX + h * 128 + cb * 64, 2048, smem);
    } else {
      int it = item - 2560;
      int b = it >> 4, h = (it >> 2) & 3, cb = it & 3;
      long row0 = MPR + (long)b * 4;
      size_t so = (size_t)(b * 4 + h) * 128 * 256 + cb * 64;
      float gamma = 1.0f - exp2f(-5.0f - (float)h);
      colrec_short<1>(PROJ + 4608 + h * 128, N0, PROJ + 4096 + h * 128, N0, PROJ + 5120 + h * 256 + cb * 64, N0, nullptr,
                      row0, gamma, p.in[I_SRT] + so, p.out + O_RTS + so, 256, OMIX + 1024 + h * 256 + cb * 64, 2048,
                      smem);
    }
  }
}

DEVI float4 ld4(const float* p) { return *(const float4*)p; }
DEVI void st_bf4(u16* p, float a, float b, float c, float d) {
  uint2 o;
  o.x = pack2(a, b);
  o.y = pack2(c, d);
  *(uint2*)p = o;
}
DEVI float rlf_(float v, int l) { return __int_as_float(__builtin_amdgcn_readlane(__float_as_int(v), l)); }
DEVI float wsum_u_(float v) {
  v = red16(v);
  return (rlf_(v, 0) + rlf_(v, 16)) + (rlf_(v, 32) + rlf_(v, 48));
}
DEVI float red32(float v) {
  v = red16(v);
  return v + __shfl_xor(v, 16, 64);
}
DEVI void phase_post0(const Params& p) {
  char* ws = p.ws;
  const float* PROJ = (const float*)(ws + OFF_PROJ);
  const float* OMIX = (const float*)(ws + OFF_OMIX);
  u16* MIXB = (u16*)(ws + OFF_MIXB);
  const float* ng = p.in[I_HNG];
  const int lane = threadIdx.x & 63;
  const int gw = blockIdx.x * 4 + (threadIdx.x >> 6), nw = gridDim.x * 4;
  const float4 g4 = ld4(ng + (lane & 31) * 4);
  for (int row = gw; row < M; row += nw) {
    const float* o = OMIX + (size_t)row * 2048;
    const float* pr = PROJ + (size_t)row * N0;
    u16* mo = MIXB + (size_t)row * 2048;
    float4 a[4], ga[4], bq[4], gb[4];
#pragma unroll
    for (int it = 0; it < 4; ++it) {
      int c = it * 256 + lane * 4;
      a[it] = ld4(o + c);
      ga[it] = ld4(pr + 3072 + c);
      bq[it] = ld4(o + 1024 + c);
      gb[it] = ld4(pr + 6144 + c);
    }
#pragma unroll
    for (int it = 0; it < 4; ++it) {
      int c = it * 256 + lane * 4;
      float ss = red32(a[it].x * a[it].x + a[it].y * a[it].y + a[it].z * a[it].z + a[it].w * a[it].w);
      float inv = rsqrtf(ss * (1.0f / 128.0f) + 1e-6f);
      st_bf4(mo + c, a[it].x * inv * g4.x * ga[it].x, a[it].y * inv * g4.y * ga[it].y, a[it].z * inv * g4.z * ga[it].z,
             a[it].w * inv * g4.w * ga[it].w);
      float mu = wsum_u_(bq[it].x + bq[it].y + bq[it].z + bq[it].w) * (1.0f / 256.0f);
      float dx = bq[it].x - mu, dy = bq[it].y - mu, dz = bq[it].z - mu, dw = bq[it].w - mu;
      float var = wsum_u_(dx * dx + dy * dy + dz * dz + dw * dw) * (1.0f / 256.0f);
      float iv = rsqrtf(var + 1e-5f);
      st_bf4(mo + 1024 + c, dx * iv * gb[it].x, dy * iv * gb[it].y, dz * iv * gb[it].z, dw * iv * gb[it].w);
    }
  }
}

DEVI void phase_ln(const Params& p, const float* addsrc, const float* g, const float* bta) {
  char* ws = p.ws;
  float* XF = (float*)(ws + OFF_XF);
  u16* XB = (u16*)(ws + OFF_XB);
  const int lane = threadIdx.x & 63;
  const int gw = blockIdx.x * 4 + (threadIdx.x >> 6), nw = gridDim.x * 4;
  for (int row = gw; row < M; row += nw) {
    float4* xr = (float4*)(XF + (size_t)row * 2048);
    const float4* ar = (const float4*)(addsrc + (size_t)row * 2048);
    float v[32];
    float s = 0.f;
#pragma unroll
    for (int i = 0; i < 8; ++i) {
      float4 x = xr[i * 64 + lane], a = ar[i * 64 + lane];
      v[i * 4 + 0] = ALPHA * x.x + a.x;
      v[i * 4 + 1] = ALPHA * x.y + a.y;
      v[i * 4 + 2] = ALPHA * x.z + a.z;
      v[i * 4 + 3] = ALPHA * x.w + a.w;
      s += v[i * 4 + 0] + v[i * 4 + 1] + v[i * 4 + 2] + v[i * 4 + 3];
    }
    float mu = wsum(s) * (1.0f / 2048.0f);
    float q = 0.f;
#pragma unroll
    for (int i = 0; i < 32; ++i) {
      v[i] -= mu;
      q += v[i] * v[i];
    }
    float inv = rsqrtf(wsum(q) * (1.0f / 2048.0f) + 1e-5f);
#pragma unroll
    for (int i = 0; i < 8; ++i) {
      float4 gg = ((const float4*)g)[i * 64 + lane], bb = ((const float4*)bta)[i * 64 + lane];
      float4 y;
      y.x = v[i * 4 + 0] * inv * gg.x + bb.x;
      y.y = v[i * 4 + 1] * inv * gg.y + bb.y;
      y.z = v[i * 4 + 2] * inv * gg.z + bb.z;
      y.w = v[i * 4 + 3] * inv * gg.w + bb.w;
      xr[i * 64 + lane] = y;
      uint2 o;
      o.x = pack2(y.x, y.y);
      o.y = pack2(y.z, y.w);
      ((uint2*)(XB + (size_t)row * 2048))[i * 64 + lane] = o;
    }
  }
}

typedef __attribute__((ext_vector_type(2))) __bf16 bf2_t;
typedef __attribute__((ext_vector_type(2))) float f32x2;
DEVI float dot2bf(unsigned a, unsigned b, float acc) {
  return __builtin_amdgcn_fdot2_f32_bf16(__builtin_bit_cast(bf2_t, a), __builtin_bit_cast(bf2_t, b), acc, false);
}
template <int CTRL>
DEVI int dppi(int v) {
  return __builtin_amdgcn_update_dpp(v, v, CTRL, 0xF, 0xF, false);
}
DEVI int wmax_i(int v) {
  v = max(v, dppi<0xB1>(v));
  v = max(v, dppi<0x4E>(v));
  v = max(v, dppi<0x141>(v));
  v = max(v, dppi<0x140>(v));
  int a = __builtin_amdgcn_readlane(v, 0), b = __builtin_amdgcn_readlane(v, 16);
  int c = __builtin_amdgcn_readlane(v, 32), d = __builtin_amdgcn_readlane(v, 48);
  return max(max(a, b), max(c, d));
}
DEVI float rlf(float v, int l) { return __int_as_float(__builtin_amdgcn_readlane(__float_as_int(v), l)); }
DEVI float wsum_u(float v) {
  v = red16(v);
  return (rlf(v, 0) + rlf(v, 16)) + (rlf(v, 32) + rlf(v, 48));
}
DEVI int fkey(float f) {
  int u = __float_as_int(f);
  return u ^ ((u >> 31) & 0x7fffffff);
}
DEVI float keyf(int k) { return __int_as_float(k ^ ((k >> 31) & 0x7fffffff)); }

DEVI void conv_fp8_rows(const float* __restrict__ src, unsigned char* __restrict__ dst, float* __restrict__ scales) {
  const int lane = threadIdx.x & 63;
  const int gw = blockIdx.x * 4 + (threadIdx.x >> 6), nw = gridDim.x * 4;
  for (int e = gw; e < 16384; e += nw) {
    const float* r = src + (size_t)e * 2048;
    float4 v[8];
    float am = 0.f;
#pragma unroll
    for (int q = 0; q < 8; ++q) {
      v[q] = *(const float4*)(r + (q >> 2) * 1024 + lane * 16 + (q & 3) * 4);
      am = fmaxf(am, fmaxf(fmaxf(fabsf(v[q].x), fabsf(v[q].y)), fmaxf(fabsf(v[q].z), fabsf(v[q].w))));
    }
    float amax = __int_as_float(wmax_i(__float_as_int(am)));
    float inv = (amax > 0.f) ? (440.0f / amax) : 0.f;
    float scale = (amax > 0.f) ? (amax * (1.0f / 440.0f)) : 1.0f;
#pragma unroll
    for (int j = 0; j < 2; ++j) {
      u32x4 o;
#pragma unroll
      for (int k = 0; k < 4; ++k) {
        float4 t = v[j * 4 + k];
        int pk = 0;
        pk = __builtin_amdgcn_cvt_pk_fp8_f32(t.x * inv, t.y * inv, pk, false);
        pk = __builtin_amdgcn_cvt_pk_fp8_f32(t.z * inv, t.w * inv, pk, true);
        o[k] = (unsigned)pk;
      }
      *(u32x4*)(dst + (size_t)e * 2048 + j * 1024 + lane * 16) = o;
    }
    if (lane == 0) scales[e] = scale;
  }
}

DEVI void phase_peer(const Params& p, int layer, bool final_out) {
  char* ws = p.ws;
  const float* SC = (const float*)(ws + OFF_GOUT);
  float* XF = (float*)(ws + OFF_XF);
  u16* XB = (u16*)(ws + OFF_XB);
  const unsigned char* UB = (const unsigned char*)(ws + OFF_UB);
  const unsigned char* VB = (const unsigned char*)(ws + OFF_VB);
  const float* USC = (const float*)(ws + OFF_USC);
  const float* VSC = (const float*)(ws + OFF_VSC);
  const float* g = p.in[I_LNG] + (size_t)(layer * 2 + 1) * D;
  const float* bta = p.in[I_LNB] + (size_t)(layer * 2 + 1) * D;
  const int lane = threadIdx.x & 63;
  const int gw = blockIdx.x * 4 + (threadIdx.x >> 6), nw = gridDim.x * 4;
  constexpr int KMIN = (int)0x80000000;
  for (int row = gw; row < M; row += nw) {
    const float* sr = SC + (size_t)row * 2048;
    int eidx0 = 0, eidx1 = 0;
    float gate0 = 0.f, gate1 = 0.f;
#pragma unroll 1
    for (int h = 0; h < 8; ++h) {
      const float* sp = sr + h * 256;
      int ka0 = (fkey(sp[lane]) & ~127) | (127 - lane);
      int kb0 = (fkey(sp[lane + 64]) & ~127) | (63 - lane);
      int ka1 = (fkey(sp[128 + lane]) & ~127) | (127 - lane);
      int kb1 = (fkey(sp[192 + lane]) & ~127) | (63 - lane);
      int my0 = KMIN, my1 = KMIN;
#pragma unroll 1
      for (int r = 0; r < 16; ++r) {
        int K0 = wmax_i(max(ka0, kb0));
        int K1 = wmax_i(max(ka1, kb1));
        my0 = (lane == r) ? K0 : my0;
        my1 = (lane == r) ? K1 : my1;
        ka0 = (ka0 == K0) ? KMIN : ka0;
        kb0 = (kb0 == K0) ? KMIN : kb0;
        ka1 = (ka1 == K1) ? KMIN : ka1;
        kb1 = (kb1 == K1) ? KMIN : kb1;
      }
      float ts0 = keyf(my0 & ~127), ts1 = keyf(my1 & ~127);
      int ti0 = 127 - (my0 & 127), ti1 = 127 - (my1 & 127);
      float s0 = __shfl(ts0, lane >> 2, 64);
      int jb = (lane & 3) * 4;
      int c0 = (fkey(s0 + __shfl(ts1, jb + 0, 64)) & ~255) | (255 - (lane * 4 + 0));
      int c1 = (fkey(s0 + __shfl(ts1, jb + 1, 64)) & ~255) | (255 - (lane * 4 + 1));
      int c2 = (fkey(s0 + __shfl(ts1, jb + 2, 64)) & ~255) | (255 - (lane * 4 + 2));
      int c3 = (fkey(s0 + __shfl(ts1, jb + 3, 64)) & ~255) | (255 - (lane * 4 + 3));
      int myk = KMIN;
#pragma unroll 1
      for (int r = 0; r < 16; ++r) {
        int K = wmax_i(max(max(c0, c1), max(c2, c3)));
        myk = (lane == r) ? K : myk;
        c0 = (c0 == K) ? KMIN : c0;
        c1 = (c1 == K) ? KMIN : c1;
        c2 = (c2 == K) ? KMIN : c2;
        c3 = (c3 == K) ? KMIN : c3;
      }
      float bs = keyf(myk & ~255);
      int bf = 255 - (myk & 255);
      int e = __shfl(ti0, (bf >> 4) & 15, 64) * 128 + __shfl(ti1, bf & 15, 64);
      float mx = rlf(bs, 0);
      float ev = (lane < 16) ? expf(bs - mx) : 0.f;
      float sm = wsum_u(ev);
      float gt = ev / sm;
      int e_b = __shfl(e, lane & 15, 64);
      float g_b = __shfl(gt, lane & 15, 64);
      if ((lane >> 4) == (h & 3)) {
        if (h < 4) {
          eidx0 = e_b;
          gate0 = g_b;
        } else {
          eidx1 = e_b;
          gate1 = g_b;
        }
      }
    }
    float dv0 = 0.f, dv1 = 0.f;
    {
      float xf[32];
      {
        const float4* xr = (const float4*)(XF + (size_t)row * 2048);
#pragma unroll
        for (int q = 0; q < 8; ++q) {
          float4 t = xr[(q >> 2) * 256 + lane * 4 + (q & 3)];
          xf[q * 4 + 0] = t.x; xf[q * 4 + 1] = t.y; xf[q * 4 + 2] = t.z; xf[q * 4 + 3] = t.w;
        }
      }
      constexpr int R = 8;
      u32x4 w[R][2];
      float sc[R];
      auto load_row = [&](int pidx, u32x4(&wr)[2], float& scv) {
        int src = (pidx < 64) ? eidx0 : eidx1;
        int e = __builtin_amdgcn_readlane(src, pidx & 63);
        const u32x4* ur = (const u32x4*)(UB + (size_t)e * 2048);
        wr[0] = ur[lane];
        wr[1] = ur[64 + lane];
        scv = USC[e];
      };
#pragma unroll
      for (int u = 0; u < R; ++u) load_row(u, w[u], sc[u]);
#pragma unroll 1
      for (int p0 = 0; p0 < 128; p0 += R) {
#pragma unroll
        for (int u = 0; u < R; ++u) {
          float d = 0.f;
#pragma unroll
          for (int j = 0; j < 2; ++j) {
#pragma unroll
            for (int k = 0; k < 4; ++k) {
              int dw = (int)w[u][j][k];
              f32x2 lo = __builtin_amdgcn_cvt_pk_f32_fp8(dw, false);
              f32x2 hi = __builtin_amdgcn_cvt_pk_f32_fp8(dw, true);
              d += lo.x * xf[j * 16 + k * 4 + 0];
              d += lo.y * xf[j * 16 + k * 4 + 1];
              d += hi.x * xf[j * 16 + k * 4 + 2];
              d += hi.y * xf[j * 16 + k * 4 + 3];
            }
          }
          float scu = sc[u];
          if (p0 + R < 128) load_row(p0 + R + u, w[u], sc[u]);
          d = wsum_u(d) * scu;
          int pl = (p0 + u) & 63;
          if (p0 < 64) dv0 = (lane == pl) ? d : dv0;
          else dv1 = (lane == pl) ? d : dv1;
          __builtin_amdgcn_sched_barrier(0);
        }
      }
    }
    float coef0 = 0.5f * dv0 * (1.0f + erff(dv0 * 0.70710678118f)) * gate0;
    float coef1 = 0.5f * dv1 * (1.0f + erff(dv1 * 0.70710678118f)) * gate1;
    f32x2 o2[16];
#pragma unroll
    for (int i = 0; i < 16; ++i) o2[i] = f32x2{0.f, 0.f};
    {
      constexpr int R = 8;
      u32x4 w[R][2];
      float sc[R];
      auto load_row = [&](int pidx, u32x4(&wr)[2], float& scv) {
        int src = (pidx < 64) ? eidx0 : eidx1;
        int e = __builtin_amdgcn_readlane(src, pidx & 63);
        const u32x4* vr = (const u32x4*)(VB + (size_t)e * 2048);
        wr[0] = vr[lane];
        wr[1] = vr[64 + lane];
        scv = VSC[e];
      };
#pragma unroll
      for (int u = 0; u < R; ++u) load_row(u, w[u], sc[u]);
#pragma unroll 1
      for (int p0 = 0; p0 < 128; p0 += R) {
        float cfs = (p0 < 64) ? coef0 : coef1;
#pragma unroll
        for (int u = 0; u < R; ++u) {
          float c = rlf(cfs, (p0 + u) & 63) * sc[u];
          f32x2 cc = f32x2{c, c};
#pragma unroll
          for (int j = 0; j < 2; ++j) {
#pragma unroll
            for (int k = 0; k < 4; ++k) {
              int dw = (int)w[u][j][k];
              o2[j * 8 + k * 2 + 0] += cc * __builtin_amdgcn_cvt_pk_f32_fp8(dw, false);
              o2[j * 8 + k * 2 + 1] += cc * __builtin_amdgcn_cvt_pk_f32_fp8(dw, true);
            }
          }
          if (p0 + R < 128) load_row(p0 + R + u, w[u], sc[u]);
          __builtin_amdgcn_sched_barrier(0);
        }
      }
    }
    float o[32];
#pragma unroll
    for (int i = 0; i < 16; ++i) {
      o[2 * i] = o2[i].x;
      o[2 * i + 1] = o2[i].y;
    }
    float s = 0.f;
    {
      const float4* xr = (const float4*)(XF + (size_t)row * 2048);
#pragma unroll
      for (int q = 0; q < 8; ++q) {
        float4 t = xr[(q >> 2) * 256 + lane * 4 + (q & 3)];
        o[q * 4 + 0] += ALPHA * t.x; o[q * 4 + 1] += ALPHA * t.y; o[q * 4 + 2] += ALPHA * t.z; o[q * 4 + 3] += ALPHA * t.w;
      }
#pragma unroll
      for (int i = 0; i < 32; ++i) s += o[i];
    }
    float mu = wsum_u(s) * (1.0f / 2048.0f);
    float q = 0.f;
#pragma unroll
    for (int i = 0; i < 32; ++i) {
      o[i] -= mu;
      q += o[i] * o[i];
    }
    float inv = rsqrtf(wsum_u(q) * (1.0f / 2048.0f) + 1e-5f);
    float* dstf;
    if (final_out) {
      if (row < MPR) {
        int b = row / TP, t = row % TP;
        dstf = (t >= 16) ? (p.out + O_YP + ((size_t)b * 2048 + (t - 16)) * D) : nullptr;
      } else {
        dstf = p.out + O_YS + (size_t)(row - MPR) * D;
      }
    } else {
      dstf = XF + (size_t)row * 2048;
    }
#pragma unroll
    for (int j = 0; j < 2; ++j) {
      float yv[16];
#pragma unroll
      for (int k = 0; k < 4; ++k) {
        float4 gv = *(const float4*)(g + j * 1024 + lane * 16 + k * 4);
        float4 bv = *(const float4*)(bta + j * 1024 + lane * 16 + k * 4);
        float4 y;
        y.x = o[j * 16 + k * 4 + 0] * inv * gv.x + bv.x;
        y.y = o[j * 16 + k * 4 + 1] * inv * gv.y + bv.y;
        y.z = o[j * 16 + k * 4 + 2] * inv * gv.z + bv.z;
        y.w = o[j * 16 + k * 4 + 3] * inv * gv.w + bv.w;
        if (dstf) *(float4*)(dstf + j * 1024 + lane * 16 + k * 4) = y;
        yv[k * 4 + 0] = y.x; yv[k * 4 + 1] = y.y; yv[k * 4 + 2] = y.z; yv[k * 4 + 3] = y.w;
      }
      if (!final_out) {
        uint4* xb = (uint4*)(XB + (size_t)row * 2048 + j * 1024 + lane * 16);
        xb[0] = make_uint4(pack2(yv[0], yv[1]), pack2(yv[2], yv[3]), pack2(yv[4], yv[5]), pack2(yv[6], yv[7]));
        xb[1] = make_uint4(pack2(yv[8], yv[9]), pack2(yv[10], yv[11]), pack2(yv[12], yv[13]), pack2(yv[14], yv[15]));
      }
    }
  }
}

DEVI float4 f4mul(float4 a, float4 b) { return make_float4(a.x * b.x, a.y * b.y, a.z * b.z, a.w * b.w); }
DEVI void row_info(int row, bool& prompt, int& b, int& t, int& T) {
  prompt = row < MPR;
  if (prompt) { b = row / TP; t = row - b * TP; T = TP; }
  else { b = (row - MPR) >> 2; t = (row - MPR) & 3; T = 4; }
}
DEVI void phase_pre1(const Params& p) {
  char* ws = p.ws;
  const float* PROJ = (const float*)(ws + OFF_PROJ);
  float* XC = (float*)(ws + OFF_GOUT);
  float* RKV = (float*)(ws + OFF_RKV);
  u16* LRA = (u16*)(ws + OFF_LRA);
  u16* LRB = (u16*)(ws + OFF_LRB);
  u16* LRG = (u16*)(ws + OFF_LRG);
  const float* cw = p.in[I_CVW];
  const float* cbias = p.in[I_CVB];
  const float* mu = p.in[I_MU];
  const int gtid = blockIdx.x * 256 + threadIdx.x, nthr = gridDim.x * 256;
#pragma unroll 2
  for (int idx = gtid; idx < M * 384; idx += nthr) {
    int row = idx / 384, c = (idx - row * 384) * 4;
    bool prompt; int b, t, T;
    row_info(row, prompt, b, t, T);
    float4 xv[4];
#pragma unroll
    for (int jj = 0; jj < 4; ++jj) {
      int tt = t - 3 + jj;
      if (tt >= 0) xv[jj] = ld4(PROJ + (size_t)(row - 3 + jj) * N1 + 1024 + c);
      else if (prompt) xv[jj] = make_float4(0.f, 0.f, 0.f, 0.f);
      else xv[jj] = ld4(p.in[I_SCV] + (size_t)(b * 3 + (tt + 3)) * 1536 + c);
    }
    float4 acc = ld4(cbias + c);
#pragma unroll
    for (int jj = 0; jj < 4; ++jj) {
      float4 w = ld4(cw + jj * 1536 + c);
      acc.x += xv[jj].x * w.x; acc.y += xv[jj].y * w.y; acc.z += xv[jj].z * w.z; acc.w += xv[jj].w * w.w;
    }
    *(float4*)(XC + (size_t)row * 1536 + c) = make_float4(siluf_(acc.x), siluf_(acc.y), siluf_(acc.z), siluf_(acc.w));
    if (t >= T - 3) {
      float* co = prompt ? (p.out + O_CVP) : (p.out + O_CVS);
      *(float4*)(co + (size_t)(b * 3 + (t - (T - 3))) * 1536 + c) = xv[3];
    }
  }
#pragma unroll 2
  for (int idx = gtid; idx < M * 840; idx += nthr) {
    int row = idx / 840, c = (idx - row * 840) * 4;
    bool prompt; int b, t, T;
    row_info(row, prompt, b, t, T);
    float4 cur = ld4(PROJ + (size_t)row * N1 + 2560 + c);
    float4 prev;
    if (t > 0) prev = ld4(PROJ + (size_t)(row - 1) * N1 + 2560 + c);
    else if (prompt) prev = make_float4(0.f, 0.f, 0.f, 0.f);
    else prev = ld4(p.in[I_SSH] + (size_t)b * 3360 + c);
    float4 m4 = ld4(mu + c);
    float4 mx;
    mx.x = cur.x + (prev.x - cur.x) * m4.x; mx.y = cur.y + (prev.y - cur.y) * m4.y;
    mx.z = cur.z + (prev.z - cur.z) * m4.z; mx.w = cur.w + (prev.w - cur.w) * m4.w;
    if (c < 3072) *(float4*)(RKV + (size_t)row * 3072 + c) = mx;
    else if (c < 3136) st_bf4(LRA + (size_t)row * 64 + (c - 3072), tanhf(mx.x), tanhf(mx.y), tanhf(mx.z), tanhf(mx.w));
    else if (c < 3200) st_bf4(LRB + (size_t)row * 64 + (c - 3136), mx.x, mx.y, mx.z, mx.w);
    else st_bf4(LRG + (size_t)row * 192 + (c - 3200), sigmoidf_(mx.x), sigmoidf_(mx.y), sigmoidf_(mx.z), sigmoidf_(mx.w));
    if (t == T - 1) {
      float* so = prompt ? (p.out + O_SHP) : (p.out + O_SHS);
      *(float4*)(so + (size_t)b * 3360 + c) = cur;
    }
  }
  for (int idx = gtid; idx < M * 4; idx += nthr) {
    int row = idx >> 2, k = idx & 3;
    ((uint4*)(LRG + (size_t)row * 192 + 160))[k] = make_uint4(0, 0, 0, 0);
  }
}

DEVI void phase_pre1c(const Params& p) {
  char* ws = p.ws;
  float* RKV = (float*)(ws + OFF_RKV);
  const float* AA = (const float*)(ws + OFF_AA);
  float* KK = (float*)(ws + OFF_QB);
  float* KKA = (float*)(ws + OFF_MIXB);
  float* BON = (float*)(ws + OFF_BON);
  const float* k_k = p.in[I_KK];
  const float* k_a = p.in[I_KA];
  const float* r_k = p.in[I_RK];
  const int lane = threadIdx.x & 63;
  const int gw = blockIdx.x * 4 + (threadIdx.x >> 6), nw = gridDim.x * 4;
  for (int row = gw; row < M; row += nw) {
    float4 k4[4], r4[4], a4[4];
#pragma unroll
    for (int it = 0; it < 4; ++it) {
      int c = it * 256 + lane * 4;
      k4[it] = ld4(RKV + (size_t)row * 3072 + 1024 + c);
      r4[it] = ld4(RKV + (size_t)row * 3072 + c);
      a4[it] = ld4(AA + (size_t)row * 1024 + c);
    }
#pragma unroll
    for (int it = 0; it < 4; ++it) {
      int c = it * 256 + lane * 4;
      float4 kk4 = ld4(k_k + c), ka4 = ld4(k_a + c), rk4 = ld4(r_k + c);
      float4 k = k4[it], r = r4[it], a = a4[it];
      float4 kr = f4mul(k, kk4);
      float ss = red16(kr.x * kr.x + kr.y * kr.y + kr.z * kr.z + kr.w * kr.w);
      float inv = 1.0f / fmaxf(sqrtf(ss), 1e-12f);
      float4 kk = make_float4(kr.x * inv, kr.y * inv, kr.z * inv, kr.w * inv);
      float4 kp;
      kp.x = k.x * (1.0f + (a.x - 1.0f) * ka4.x); kp.y = k.y * (1.0f + (a.y - 1.0f) * ka4.y);
      kp.z = k.z * (1.0f + (a.z - 1.0f) * ka4.z); kp.w = k.w * (1.0f + (a.w - 1.0f) * ka4.w);
      float bon = red16(r.x * kp.x * rk4.x + r.y * kp.y * rk4.y + r.z * kp.z * rk4.z + r.w * kp.w * rk4.w);
      *(float4*)(KK + (size_t)row * 1024 + c) = kk;
      *(float4*)(KKA + (size_t)row * 1024 + c) = f4mul(kk, a);
      *(float4*)(RKV + (size_t)row * 3072 + 1024 + c) = kp;
      if ((lane & 15) == 0) BON[(size_t)row * 16 + it * 4 + (lane >> 4)] = bon;
    }
  }
}

DEVI void phase_rec1(const Params& p, float* smem) {
  char* ws = p.ws;
  const float* XC = (const float*)(ws + OFF_GOUT);
  const float* RKV = (const float*)(ws + OFF_RKV);
  const float* DEC = (const float*)(ws + OFF_DEC);
  const float* KK = (const float*)(ws + OFF_QB);
  const float* KKA = (const float*)(ws + OFF_MIXB);
  const float* DTA = (const float*)(ws + OFF_DTA);
  float* OMIX = (float*)(ws + OFF_OMIX);
  const float* wsf = (const float*)ws;
  constexpr int XO = (int)(OFF_GOUT / 4), DO = (int)(OFF_DTA / 4), RO = (int)(OFF_RKV / 4), CO = (int)(OFF_DEC / 4),
                KO = (int)(OFF_QB / 4), AO = (int)(OFF_MIXB / 4);
  for (int item = blockIdx.x; item < 10752; item += gridDim.x) {
    if (item < 256) {
      int b = item >> 6, h = (item >> 2) & 15, cb = item & 3;
      int g = h >> 3;
      Seg sg[4] = {{XO + 1024 + g * 128, 1536, 32}, {XO + 1280 + g * 128, 1536, 32}, {XO + h * 64 + cb * 16, 1536, 4},
                   {DO + h * 4, 64, 1}};
      int row0 = b * TP;
      colrec_long<2>(wsf, sg, row0, TP, 0.f, OMIX + (size_t)row0 * 2048 + h * 64 + cb * 16, 2048,
                     p.out + O_SSP + (size_t)(b * 16 + h) * 128 * 64 + cb * 16, 64, smem);
    } else if (item < 512 || item >= 2560) {
      bool prompt = item < 512;
      int it = prompt ? (item - 256) : (item - 2560);
      int b = it >> 6, h = (it >> 2) & 15, rb = it & 3;
      int row0 = prompt ? b * TP : (MPR + b * 4);
      int T = prompt ? TP : 4;
      Seg sg[6] = {{RO + h * 64, 3072, 16}, {CO + h * 64, 1024, 16}, {RO + 1024 + h * 64, 3072, 16},
                   {KO + h * 64, 1024, 16}, {AO + h * 64, 1024, 16}, {RO + 2048 + h * 64 + rb * 16, 3072, 4}};
      size_t so = ((size_t)(b * 16 + h) * 64 + rb * 16) * 64;
      const float* stin = prompt ? nullptr : (p.in[I_SWK] + so);
      float* stout = (prompt ? (p.out + O_WKP) : (p.out + O_WKS)) + so;
      rwkv_item(wsf, sg, row0, T, stin, stout, OMIX + (size_t)row0 * 2048 + 1024 + h * 64 + rb * 16, 2048, smem);
    } else {
      int it = item - 512;
      int b = it >> 4, h = it & 15;
      int g = h >> 3;
      long row0 = MPR + (long)b * 4;
      size_t so = (size_t)(b * 16 + h) * 128 * 64;
      colrec_short<2>(XC + 1024 + g * 128, 1536, XC + 1280 + g * 128, 1536, XC + h * 64, 1536, DTA + h * 4, row0, 0.f,
                      p.in[I_SSM] + so, p.out + O_SSS + so, 64, OMIX + h * 64, 2048, smem);
    }
  }
}

DEVI void phase_post1(const Params& p) {
  char* ws = p.ws;
  const float* PROJ = (const float*)(ws + OFF_PROJ);
  const float* OMIX = (const float*)(ws + OFF_OMIX);
  const float* XC = (const float*)(ws + OFF_GOUT);
  const float* RKV = (const float*)(ws + OFF_RKV);
  const float* GG = (const float*)(ws + OFF_GG);
  const float* BON = (const float*)(ws + OFF_BON);
  u16* MIXB = (u16*)(ws + OFF_MIXB);
  const float* dsk = p.in[I_DSK];
  const float* sng = p.in[I_SNG];
  const float* lxg = p.in[I_LXG];
  const float* lxb = p.in[I_LXB];
  const int lane = threadIdx.x & 63;
  const int gw = blockIdx.x * 4 + (threadIdx.x >> 6), nw = gridDim.x * 4;
  for (int row = gw; row < M; row += nw) {
    const float* o = OMIX + (size_t)row * 2048;
    u16* mo = MIXB + (size_t)row * 2048;
    float4 oc[4], xc[4], z[4], y[4], v[4], gg[4];
    float bn[4];
#pragma unroll
    for (int it = 0; it < 4; ++it) {
      int c = it * 256 + lane * 4;
      oc[it] = ld4(o + c);
      xc[it] = ld4(XC + (size_t)row * 1536 + c);
      z[it] = ld4(PROJ + (size_t)row * N1 + c);
      y[it] = ld4(o + 1024 + c);
      v[it] = ld4(RKV + (size_t)row * 3072 + 2048 + c);
      gg[it] = ld4(GG + (size_t)row * 1024 + c);
      bn[it] = BON[(size_t)row * 16 + it * 4 + (lane >> 4)];
    }
    float4 val[4];
    float ssq[4];
#pragma unroll
    for (int it = 0; it < 4; ++it) {
      float ds = dsk[it * 4 + (lane >> 4)];
      val[it].x = (oc[it].x + xc[it].x * ds) * z[it].x;
      val[it].y = (oc[it].y + xc[it].y * ds) * z[it].y;
      val[it].z = (oc[it].z + xc[it].z * ds) * z[it].z;
      val[it].w = (oc[it].w + xc[it].w * ds) * z[it].w;
      ssq[it] = val[it].x * val[it].x + val[it].y * val[it].y + val[it].z * val[it].z + val[it].w * val[it].w;
    }
    float inv0 = rsqrtf(wsum_u_(ssq[0] + ssq[1]) * (1.0f / 512.0f) + 1e-6f);
    float inv1 = rsqrtf(wsum_u_(ssq[2] + ssq[3]) * (1.0f / 512.0f) + 1e-6f);
#pragma unroll
    for (int it = 0; it < 4; ++it) {
      int c = it * 256 + lane * 4;
      float inv = (it < 2) ? inv0 : inv1;
      float4 sg = ld4(sng + c);
      st_bf4(mo + c, val[it].x * inv * sg.x, val[it].y * inv * sg.y, val[it].z * inv * sg.z, val[it].w * inv * sg.w);
      float mu = red16(y[it].x + y[it].y + y[it].z + y[it].w) * (1.0f / 64.0f);
      float dx = y[it].x - mu, dy = y[it].y - mu, dz = y[it].z - mu, dw = y[it].w - mu;
      float var = red16(dx * dx + dy * dy + dz * dz + dw * dw) * (1.0f / 64.0f);
      float iv = rsqrtf(var + 64e-5f);
      float4 lg = ld4(lxg + c), lb = ld4(lxb + c);
      float y0 = (dx * iv * lg.x + lb.x + bn[it] * v[it].x) * gg[it].x;
      float y1 = (dy * iv * lg.y + lb.y + bn[it] * v[it].y) * gg[it].y;
      float y2 = (dz * iv * lg.z + lb.z + bn[it] * v[it].z) * gg[it].z;
      float y3 = (dw * iv * lg.w + lb.w + bn[it] * v[it].w) * gg[it].w;
      st_bf4(mo + 1024 + c, y0, y1, y2, y3);
    }
  }
}

#define XB_TMO      128
#define XB_XCNT(j)  (256  + 64 * (j))
#define XB_XSUB(j)  (1280 + 64 * (j))
#define XB_XGEN(j)  (2304 + 64 * (j))
#define XB_TOP      3328
#define XB_TOPGEN   3392
#define XCD_BAR_WORDS 3456
#define XB_SPIN_CAP (1u << 18)
#define LAS __attribute__((address_space(3)))

__device__ __forceinline__ unsigned xb_ld(unsigned* p)              { return __hip_atomic_load(p, __ATOMIC_RELAXED, __HIP_MEMORY_SCOPE_AGENT); }
__device__ __forceinline__ unsigned xb_add(unsigned* p, unsigned v) { return __hip_atomic_fetch_add(p, v, __ATOMIC_RELAXED, __HIP_MEMORY_SCOPE_AGENT); }
__device__ __forceinline__ unsigned xb_xcc_id() { return (unsigned)__builtin_amdgcn_s_getreg((3 << 11) | 20) & 0xFu; }
#define XB_SPIN(cond, bar) do { unsigned _sp = 0; while (cond) { __builtin_amdgcn_s_sleep(1); \
    if ((++_sp & 255u) == 0u) { if (xb_ld(&(bar)[XB_TMO])) break; if (_sp > XB_SPIN_CAP) { atomicAdd(&(bar)[XB_TMO], 1u); break; } } } } while (0)

struct XcdBarrier {
    unsigned* bar; unsigned x;
    volatile LAS unsigned* st;
};

__device__ __forceinline__ XcdBarrier xcd_barrier_post(unsigned* bar, volatile LAS unsigned* st) {
    XcdBarrier b; b.bar = bar; b.x = xb_xcc_id(); b.st = st;
    if (threadIdx.x == 0) (void)xb_add(&bar[XB_XCNT(b.x)], 1u);
    return b;
}
__device__ __forceinline__ void xcd_barrier_complete(unsigned* bar, unsigned x, unsigned& nloc, unsigned& nx) {
    const unsigned G = gridDim.x * gridDim.y * gridDim.z;
    unsigned sum, cnt, mine, sp = 0u;
    for (;;) {
        sum = 0u; cnt = 0u; mine = 0u;
#pragma unroll
        for (unsigned j = 0; j < 16; ++j) { const unsigned c = xb_ld(&bar[XB_XCNT(j)]); sum += c; cnt += (c > 0u) ? 1u : 0u; mine = (j == x) ? c : mine; }
        if (sum == G) break;
        __builtin_amdgcn_s_sleep(1);
        if ((++sp & 255u) == 0u) { if (xb_ld(&bar[XB_TMO])) break; if (sp > XB_SPIN_CAP) { atomicAdd(&bar[XB_TMO], 1u); break; } }
    }
    nloc = mine > 0u ? mine : 1u; nx = cnt > 0u ? cnt : 1u;
}

__device__ __forceinline__ void xcd_barrier(const XcdBarrier& b) {
    asm volatile("s_waitcnt vmcnt(0)" ::: "memory");
    __syncthreads();
    if (threadIdx.x == 0) {
        unsigned* bar = b.bar;
        __builtin_amdgcn_s_waitcnt(0);
        unsigned nloc = b.st[0], nx = b.st[1];
        if (nloc == 0u) { xcd_barrier_complete(bar, b.x, nloc, nx); b.st[0] = nloc; b.st[1] = nx; }
        const unsigned old = xb_add(&bar[XB_XSUB(b.x)], 1u);
        const unsigned gen = old / nloc;
        if (old + 1u == (gen + 1u) * nloc) {
            __builtin_amdgcn_fence(__ATOMIC_RELEASE, "agent");
            asm volatile("s_waitcnt vmcnt(0)" ::: "memory");
            const unsigned og = xb_add(&bar[XB_TOP], 1u);
            const unsigned tg = og / nx;
            if (og + 1u == (tg + 1u) * nx) xb_add(&bar[XB_TOPGEN], 1u);
            else XB_SPIN(xb_ld(&bar[XB_TOPGEN]) == tg, bar);
            __builtin_amdgcn_fence(__ATOMIC_ACQUIRE, "agent");
            xb_add(&bar[XB_XGEN(b.x)], 1u);
            asm volatile("s_waitcnt vmcnt(0)" ::: "memory");
        } else {
            XB_SPIN(xb_ld(&bar[XB_XGEN(b.x)]) == gen, bar);
            __builtin_amdgcn_fence(__ATOMIC_ACQUIRE, "agent");
            asm volatile("s_waitcnt vmcnt(0)" ::: "memory");
        }
    }
    __syncthreads();
}


template <int ph>
DEVI void run_phase(const Params& p, char* smem_raw) {
  float* smem = (float*)smem_raw;
  char* ws = p.ws;
  {
    switch (ph) {
      case 0:
        phase0(p, smem);
        conv_fp8_rows(p.in[I_PU], (unsigned char*)(ws + OFF_UB), (float*)(ws + OFF_USC));
        conv_fp8_rows(p.in[I_PV], (unsigned char*)(ws + OFF_VB), (float*)(ws + OFF_VSC));
        break;
      case 1: {
        float* PROJ = (float*)(ws + OFF_PROJ);
        const float* LB = (const float*)(ws + OFF_LB);
        const double* IR = (const double*)(ws + OFF_INVREV);
        gemm_phase((const u16*)(ws + OFF_XB), 2048, 0, (const u16*)(ws + OFF_WIN0), 2048, MP / 128, N0 / 128, smem_raw,
                   [=](int row, int col, float v0, float v1) {
                     float* pr = PROJ + (size_t)row * N0;
                     if (col < 1024 || (col >= 3072 && col < 4096) || col >= 6144) {
                       pr[col] = siluf_(v0);
                       pr[col + 32] = siluf_(v1);
                     } else if (col < 2048) {
                       float l0 = LB[col - 1024], l1 = LB[col - 1024 + 32];
                       pr[col] = l0 + (1.0f - l0) * sigmoidf_(v0);
                       pr[col + 32] = l1 + (1.0f - l1) * sigmoidf_(v1);
                     } else if (col >= 4096 && col < 5120) {
                       int hb = col & ~127, c = col & 127, span = c >> 6, pp = c & 63;
                       int d = span * 32 + pp;
                       double rev = (double)row_pos(row) * IR[d];
                       float fr = (float)(rev - floor(rev));
                       float sn = __builtin_amdgcn_sinf(fr), cs = __builtin_amdgcn_cosf(fr);
                       float sc = (col >= 4608) ? 0.08838834764831845f : 1.0f;
                       pr[hb + d] = (v0 * cs - v1 * sn) * sc;
                       pr[hb + 64 + d] = (v0 * sn + v1 * cs) * sc;
                     } else {
                       pr[col] = v0;
                       pr[col + 32] = v1;
                     }
                   });
      } break;
      case 2: phase_rec0(p, smem); break;
      case 3: phase_post0(p); break;
      case 4: case 15: {
        float* GO = (float*)(ws + OFF_GOUT);
        gemm_phase((const u16*)(ws + OFF_MIXB), 2048, 0, (const u16*)(ws + (ph == 4 ? OFF_WOUT0 : OFF_WOUT1)), 2048,
                   MP / 128, 16, smem_raw, [=](int row, int col, float v0, float v1) {
                     GO[(size_t)row * 2048 + col] = v0;
                     GO[(size_t)row * 2048 + col + 32] = v1;
                   });
      } break;
      case 5: case 16: {
        int l = (ph == 5) ? 0 : 1;
        phase_ln(p, (const float*)(ws + OFF_GOUT), p.in[I_LNG] + (size_t)(l * 2) * D, p.in[I_LNB] + (size_t)(l * 2) * D);
      } break;
      case 6: case 17: {
        u16* QB = (u16*)(ws + OFF_QB);
        gemm_phase((const u16*)(ws + OFF_XB), 2048, 0, (const u16*)(ws + (ph == 6 ? OFF_WQ0 : OFF_WQ1)), 2048, MP / 128,
                   16, smem_raw, [=](int row, int col, float v0, float v1) {
                     QB[(size_t)row * 2048 + col] = f2bf(v0);
                     QB[(size_t)row * 2048 + col + 32] = f2bf(v1);
                   });
      } break;
      case 7: case 18: {
        float* SC = (float*)(ws + OFF_GOUT);
        gemm_phase((const u16*)(ws + OFF_QB), 2048, 128, (const u16*)(ws + (ph == 7 ? OFF_KEY0 : OFF_KEY1)), 128,
                   MP / 128, 16, smem_raw, [=](int row, int col, float v0, float v1) {
                     SC[(size_t)row * 2048 + col] = v0;
                     SC[(size_t)row * 2048 + col + 32] = v1;
                   });
      } break;
      case 8: phase_peer(p, 0, false); break;
      case 9: {
        conv_fp8_rows(p.in[I_PU] + (size_t)16384 * 2048, (unsigned char*)(ws + OFF_UB), (float*)(ws + OFF_USC));
        conv_fp8_rows(p.in[I_PV] + (size_t)16384 * 2048, (unsigned char*)(ws + OFF_VB), (float*)(ws + OFF_VSC));
        float* PROJ = (float*)(ws + OFF_PROJ);
        float* DTA = (float*)(ws + OFF_DTA);
        const float* dtb = p.in[I_DTB];
        const float* alog = p.in[I_ALOG];
        gemm_phase((const u16*)(ws + OFF_XB), 2048, 0, (const u16*)(ws + OFF_WIN1), 2048, MP / 128, N1 / 128, smem_raw,
                   [=](int row, int col, float v0, float v1) {
                     float* pr = PROJ + (size_t)row * N1;
                     if (col < 1024) {
                       pr[col] = siluf_(v0);
                       pr[col + 32] = siluf_(v1);
                     } else if (col < 5888) {
                       pr[col] = v0;
                       pr[col + 32] = v1;
                     } else {
#pragma unroll
                       for (int e = 0; e < 2; ++e) {
                         int cc = col + e * 32;
                         float v = e ? v1 : v0;
                         if (cc < 5920) pr[cc] = v;
                         else if (cc < 5936) {
                           int h = cc - 5920;
                           float dt = softplusf_(v + dtb[h]);
                           DTA[(size_t)row * 64 + h * 4] = dt;
                           DTA[(size_t)row * 64 + h * 4 + 1] = expf(-dt * expf(alog[h]));
                         }
                       }
                     }
                   });
      } break;
      case 10: phase_pre1(p); break;
      case 11: {
        float* DEC = (float*)(ws + OFF_DEC);
        float* AA = (float*)(ws + OFF_AA);
        float* GG = (float*)(ws + OFF_GG);
        const float* w0 = p.in[I_W0];
        const float* a0 = p.in[I_A0];
        gemm_phase((const u16*)(ws + OFF_LRA), 64, 0, (const u16*)(ws + OFF_W2T), 64, MP / 128, 8, smem_raw,
                   [=](int row, int col, float v0, float v1) {
#pragma unroll
                     for (int e = 0; e < 2; ++e) {
                       int cc = col + e * 32;
                       float v = (e ? v1 : v0) + w0[cc];
                       float wl = -softplusf_(-v) - 0.5f;
                       DEC[(size_t)row * 1024 + cc] = expf(-expf(wl));
                     }
                   });
        gemm_phase((const u16*)(ws + OFF_LRB), 64, 0, (const u16*)(ws + OFF_A2T), 64, MP / 128, 8, smem_raw,
                   [=](int row, int col, float v0, float v1) {
                     AA[(size_t)row * 1024 + col] = sigmoidf_(v0 + a0[col]);
                     AA[(size_t)row * 1024 + col + 32] = sigmoidf_(v1 + a0[col + 32]);
                   });
        gemm_phase((const u16*)(ws + OFF_LRG), 192, 0, (const u16*)(ws + OFF_G2T), 192, MP / 128, 8, smem_raw,
                   [=](int row, int col, float v0, float v1) {
                     GG[(size_t)row * 1024 + col] = v0;
                     GG[(size_t)row * 1024 + col + 32] = v1;
                   });
      } break;
      case 12: phase_pre1c(p); break;
      case 13: phase_rec1(p, smem); break;
      case 14: phase_post1(p); break;
      case 19: phase_peer(p, 1, true); break;
      default: break;
    }
  }
}

__global__ void __launch_bounds__(256, 2) mega(Params p, int ph_lo, int ph_hi) {
  __shared__ __attribute__((aligned(16))) char smem_raw[SMEM_BYTES];
  __shared__ uint4 xb_words;
  cg::grid_group grid = cg::this_grid();
  if (threadIdx.x == 0) xb_words = make_uint4(0u, 0u, 0u, 0u);
  __syncthreads();
  XcdBarrier xb = xcd_barrier_post((unsigned*)(p.ws + OFF_BAR), (volatile LAS unsigned*)&xb_words);
  if (ph_hi > 1000) grid.sync();
#ifndef REPEAT_MASK
#define REPEAT_MASK 0
#endif
#define PHASE(K)                                          \
  if (ph_lo <= K && K < ph_hi) run_phase<K>(p, smem_raw); \
  if ((REPEAT_MASK >> K) & 1) { xcd_barrier(xb); run_phase<K>(p, smem_raw); } \
  if (ph_lo <= K && K + 1 < ph_hi) xcd_barrier(xb);
  PHASE(0) PHASE(1) PHASE(2) PHASE(3) PHASE(4) PHASE(5) PHASE(6) PHASE(7) PHASE(8) PHASE(9)
  PHASE(10) PHASE(11) PHASE(12) PHASE(13) PHASE(14) PHASE(15) PHASE(16) PHASE(17) PHASE(18) PHASE(19)
}
#ifdef PHASE_TEST
template <int PH>
__global__ void __launch_bounds__(256, 2) phk(Params p) {
  __shared__ __attribute__((aligned(16))) char smem_raw[SMEM_BYTES];
  run_phase<PH>(p, smem_raw);
}
#define INST(N) template __global__ void phk<N>(Params);
INST(0) INST(1) INST(2) INST(3) INST(4) INST(5) INST(6) INST(7) INST(8) INST(9) INST(10) INST(11) INST(12) INST(13) INST(14) INST(19)
#endif

constexpr int NPHASE = 20;

extern "C" void kernel_launch(void* const* d_in, const int* in_sizes, int n_in, void* d_out, int out_size, void* d_ws,
                              size_t ws_size, hipStream_t stream) {
  static int grid_blocks = 0;
  if (!grid_blocks) {
    int dev = 0, cus = 0, per_cu = 0;
    hipGetDevice(&dev);
    hipDeviceGetAttribute(&cus, hipDeviceAttributeMultiprocessorCount, dev);
    hipOccupancyMaxActiveBlocksPerMultiprocessor(&per_cu, mega, 256, 0);
    if (per_cu > 2) per_cu = 2;
    if (per_cu < 1) per_cu = 1;
    grid_blocks = cus * per_cu;
  }
  Params p{};
  for (int i = 0; i < 38; ++i) p.in[i] = (const float*)d_in[i];
  p.out = (float*)d_out;
  p.ws = (char*)d_ws;
  (void)hipMemsetAsync((char*)d_ws + OFF_BAR, 0, 3456 * 4, stream);
  int lo = 0, hi = NPHASE;
  void* args[] = {&p, &lo, &hi};
  hipError_t e = hipLaunchCooperativeKernel((void*)mega, dim3(grid_blocks), dim3(256), args, 0, stream);
  if (e != hipSuccess) fprintf(stderr, "cooperative launch failed: %s (grid %d)\n", hipGetErrorString(e), grid_blocks);
}
```

```cpp
#include <hip/hip_runtime.h>
#include <hip/hip_bf16.h>
#include <hip/hip_cooperative_groups.h>
#include <cstdio>
#include <cmath>
namespace cg = cooperative_groups;

#define DEVI __device__ __forceinline__
typedef unsigned short u16;
using bf16x8 = __attribute__((ext_vector_type(8))) short;
using f32x4 = __attribute__((ext_vector_type(4))) float;
using u32x4 = __attribute__((ext_vector_type(4))) unsigned int;

constexpr int D = 2048;
constexpr int TP = 2064;
constexpr int MPR = 8256;
constexpr int M = 8768;
constexpr int MP = 8832;
constexpr int N0 = 7168;
constexpr int N1 = 6016;
constexpr float ALPHA = 1.41421356237f;

constexpr size_t SZ_TAB = (size_t)16384 * 2048 * 2;
constexpr size_t OFF_UB = 0;
constexpr size_t OFF_VB = OFF_UB + SZ_TAB;
constexpr size_t OFF_WIN0 = OFF_VB + SZ_TAB;
constexpr size_t OFF_WOUT0 = OFF_WIN0 + (size_t)N0 * 2048 * 2;
constexpr size_t OFF_WQ0 = OFF_WOUT0 + (size_t)2048 * 2048 * 2;
constexpr size_t OFF_KEY0 = OFF_WQ0 + (size_t)2048 * 2048 * 2;
constexpr size_t OFF_WIN1 = OFF_KEY0 + (size_t)16 * 128 * 128 * 2;
constexpr size_t OFF_WOUT1 = OFF_WIN1 + (size_t)N1 * 2048 * 2;
constexpr size_t OFF_WQ1 = OFF_WOUT1 + (size_t)2048 * 2048 * 2;
constexpr size_t OFF_KEY1 = OFF_WQ1 + (size_t)2048 * 2048 * 2;
constexpr size_t OFF_W2T = OFF_KEY1 + (size_t)16 * 128 * 128 * 2;
constexpr size_t OFF_A2T = OFF_W2T + (size_t)1024 * 64 * 2;
constexpr size_t OFF_G2T = OFF_A2T + (size_t)1024 * 64 * 2;
constexpr size_t OFF_LB = OFF_G2T + (size_t)1024 * 192 * 2;
constexpr size_t OFF_INVREV = OFF_LB + 1024 * 4;
constexpr size_t OFF_XF = OFF_INVREV + 64 * 8;
constexpr size_t OFF_XB = OFF_XF + (size_t)MP * 2048 * 4;
constexpr size_t OFF_PROJ = OFF_XB + (size_t)MP * 2048 * 2;
constexpr size_t OFF_GOUT = OFF_PROJ + (size_t)MP * N0 * 4;
constexpr size_t OFF_OMIX = OFF_GOUT + (size_t)MP * 2048 * 4;
constexpr size_t OFF_MIXB = OFF_OMIX + (size_t)MP * 2048 * 4;
constexpr size_t OFF_QB = OFF_MIXB + (size_t)MP * 2048 * 2;
constexpr size_t OFF_RKV = OFF_QB + (size_t)MP * 2048 * 2;
constexpr size_t OFF_DEC = OFF_RKV + (size_t)MP * 3072 * 4;
constexpr size_t OFF_AA = OFF_DEC + (size_t)MP * 1024 * 4;
constexpr size_t OFF_GG = OFF_AA + (size_t)MP * 1024 * 4;
constexpr size_t OFF_LRA = OFF_GG + (size_t)MP * 1024 * 4;
constexpr size_t OFF_LRB = OFF_LRA + (size_t)MP * 64 * 2;
constexpr size_t OFF_LRG = OFF_LRB + (size_t)MP * 64 * 2;
constexpr size_t OFF_DTA = OFF_LRG + (size_t)MP * 192 * 2;
constexpr size_t OFF_BON = OFF_DTA + (size_t)MP * 64 * 4;
constexpr size_t OFF_USC = OFF_BON + (size_t)MP * 16 * 4;
constexpr size_t OFF_VSC = OFF_USC + 16384 * 4;
constexpr size_t OFF_BAR = OFF_VSC + 16384 * 4;
constexpr size_t WS_TOTAL = OFF_BAR + 3456 * 4;
static_assert(WS_TOTAL <= (size_t)1 << 30, "workspace too large");

constexpr size_t O_YP = 0;
constexpr size_t O_YS = O_YP + (size_t)4 * 2048 * 2048;
constexpr size_t O_HGP = O_YS + (size_t)128 * 4 * 2048;
constexpr size_t O_HGS = O_HGP + (size_t)4 * 8 * 128 * 128;
constexpr size_t O_RTP = O_HGS + (size_t)128 * 8 * 128 * 128;
constexpr size_t O_RTS = O_RTP + (size_t)4 * 4 * 128 * 256;
constexpr size_t O_SSP = O_RTS + (size_t)128 * 4 * 128 * 256;
constexpr size_t O_SSS = O_SSP + (size_t)4 * 16 * 128 * 64;
constexpr size_t O_CVP = O_SSS + (size_t)128 * 16 * 128 * 64;
constexpr size_t O_CVS = O_CVP + (size_t)4 * 3 * 1536;
constexpr size_t O_WKP = O_CVS + (size_t)128 * 3 * 1536;
constexpr size_t O_WKS = O_WKP + (size_t)4 * 16 * 64 * 64;
constexpr size_t O_SHP = O_WKS + (size_t)128 * 16 * 64 * 64;
constexpr size_t O_SHS = O_SHP + (size_t)4 * 3360;

struct Params {
  const float* in[38];
  float* out;
  char* ws;
};
enum { I_XP = 0, I_XS, I_SHG, I_SRT, I_SSM, I_SCV, I_SWK, I_SSH, I_META, I_LNG, I_LNB, I_EWIN, I_LBL, I_HNG, I_EWOUT,
       I_OWIN, I_CVW, I_CVB, I_DTB, I_ALOG, I_DSK, I_SNG, I_MU, I_W0, I_W2, I_A0, I_A2, I_G2, I_KK, I_KA, I_RK,
       I_LXG, I_LXB, I_OWOUT, I_WQ, I_KEYS, I_PU, I_PV };

constexpr int SMEM_BYTES = 2 * 2 * 128 * 72 * 2;

DEVI u16 f2bf(float f) {
  unsigned u = __float_as_uint(f);
  u += 0x7fffu + ((u >> 16) & 1u);
  return (u16)(u >> 16);
}
DEVI unsigned pack2(float a, float b) { return (unsigned)f2bf(a) | ((unsigned)f2bf(b) << 16); }
DEVI float bflo(unsigned u) { return __uint_as_float(u << 16); }
DEVI float bfhi(unsigned u) { return __uint_as_float(u & 0xffff0000u); }
DEVI float sigmoidf_(float x) { return 1.0f / (1.0f + expf(-x)); }
DEVI float siluf_(float x) { return x / (1.0f + expf(-x)); }
DEVI float softplusf_(float x) { return fmaxf(x, 0.0f) + log1pf(expf(-fabsf(x))); }
DEVI float wsum(float v) {
#pragma unroll
  for (int o = 32; o > 0; o >>= 1) v += __shfl_xor(v, o, 64);
  return v;
}
DEVI float wmaxf_(float v) {
#pragma unroll
  for (int o = 32; o > 0; o >>= 1) v = fmaxf(v, __shfl_xor(v, o, 64));
  return v;
}
DEVI int wmini_(int v) {
#pragma unroll
  for (int o = 32; o > 0; o >>= 1) v = min(v, __shfl_xor(v, o, 64));
  return v;
}
template <int CTRL>
DEVI float dppf(float v) {
  return __int_as_float(__builtin_amdgcn_update_dpp(0, __float_as_int(v), CTRL, 0xF, 0xF, true));
}
DEVI float red8(float v) {
  v += dppf<0xB1>(v);
  v += dppf<0x4E>(v);
  v += dppf<0x141>(v);
  return v;
}
DEVI float red16(float v) {
  v = red8(v);
  v += dppf<0x140>(v);
  return v;
}
DEVI int row_pos(int row) { return row < MPR ? (row % TP) : (16384 + ((row - MPR) & 3)); }

DEVI void conv_bf16_flat(const float* __restrict__ src, u16* __restrict__ dst, size_t n4) {
  size_t stride = (size_t)gridDim.x * blockDim.x;
  for (size_t i = (size_t)blockIdx.x * blockDim.x + threadIdx.x; i < n4; i += stride) {
    float4 v = ((const float4*)src)[i];
    uint2 o;
    o.x = pack2(v.x, v.y);
    o.y = pack2(v.z, v.w);
    ((uint2*)dst)[i] = o;
  }
}

template <int MODE>
DEVI int colmap(int j) {
  if (MODE == 0) return j;
  if (MODE == 1) {
    if (j < 4096 || j >= 5120) return j;
    int hb = j & ~127, c = j & 127, span = c >> 6, p = c & 63;
    int d = (p < 32) ? (span * 32 + p) : (64 + span * 32 + (p - 32));
    return hb + d;
  }
  if (j < 2560) return j;
  if (j < 5920) return j + 16;
  if (j < 5936) return 2560 + (j - 5920);
  return -1;
}

template <int MODE>
DEVI void transpose_job(const float* __restrict__ src, int ldsrc, int Ksrc, u16* __restrict__ dst, int Kdst, int ndst,
                        float* smem) {
  int ktiles = Kdst / 64, ntiles = ndst / 64;
  int tid = threadIdx.x;
  for (int tile = blockIdx.x; tile < ktiles * ntiles; tile += gridDim.x) {
    int tn = tile / ktiles, tk = tile % ktiles;
    int j0 = tn * 64, k0 = tk * 64;
    int jj = tid & 63;
    int sc = colmap<MODE>(j0 + jj);
#pragma unroll
    for (int i = 0; i < 16; ++i) {
      int kk = i * 4 + (tid >> 6);
      float v = 0.f;
      if (sc >= 0 && (k0 + kk) < Ksrc) v = src[(size_t)(k0 + kk) * ldsrc + sc];
      smem[kk * 65 + jj] = v;
    }
    __syncthreads();
    int jr = tid >> 2, kq = (tid & 3) * 16;
    unsigned pk[8];
#pragma unroll
    for (int e = 0; e < 8; ++e) pk[e] = pack2(smem[(kq + 2 * e) * 65 + jr], smem[(kq + 2 * e + 1) * 65 + jr]);
    uint4* dp = (uint4*)(dst + (size_t)(j0 + jr) * Kdst + k0 + kq);
    dp[0] = make_uint4(pk[0], pk[1], pk[2], pk[3]);
    dp[1] = make_uint4(pk[4], pk[5], pk[6], pk[7]);
    __syncthreads();
  }
}

DEVI void phase0(const Params& p, float* smem) {
  char* ws = p.ws;
  conv_bf16_flat(p.in[I_KEYS], (u16*)(ws + OFF_KEY0), (size_t)16 * 128 * 128 / 4);
  conv_bf16_flat(p.in[I_KEYS] + (size_t)16 * 128 * 128, (u16*)(ws + OFF_KEY1), (size_t)16 * 128 * 128 / 4);
  transpose_job<1>(p.in[I_EWIN], N0, 2048, (u16*)(ws + OFF_WIN0), 2048, N0, smem);
  transpose_job<0>(p.in[I_EWOUT], 2048, 2048, (u16*)(ws + OFF_WOUT0), 2048, 2048, smem);
  transpose_job<0>(p.in[I_WQ], 2048, 2048, (u16*)(ws + OFF_WQ0), 2048, 2048, smem);
  transpose_job<0>(p.in[I_WQ] + (size_t)2048 * 2048, 2048, 2048, (u16*)(ws + OFF_WQ1), 2048, 2048, smem);
  transpose_job<2>(p.in[I_OWIN], 5936, 2048, (u16*)(ws + OFF_WIN1), 2048, N1, smem);
  transpose_job<0>(p.in[I_OWOUT], 2048, 2048, (u16*)(ws + OFF_WOUT1), 2048, 2048, smem);
  transpose_job<0>(p.in[I_W2], 1024, 64, (u16*)(ws + OFF_W2T), 64, 1024, smem);
  transpose_job<0>(p.in[I_A2], 1024, 64, (u16*)(ws + OFF_A2T), 64, 1024, smem);
  transpose_job<0>(p.in[I_G2], 1024, 160, (u16*)(ws + OFF_G2T), 192, 1024, smem);
  {
    float* XF = (float*)(ws + OFF_XF);
    u16* XB = (u16*)(ws + OFF_XB);
    size_t n4 = (size_t)MP * 512;
    size_t stride = (size_t)gridDim.x * blockDim.x;
    for (size_t i = (size_t)blockIdx.x * blockDim.x + threadIdx.x; i < n4; i += stride) {
      int row = (int)(i >> 9), c4 = (int)(i & 511);
      float4 v = make_float4(0.f, 0.f, 0.f, 0.f);
      if (row < MPR) {
        int b = row / TP, t = row % TP;
        const float* s = (t < 16) ? (p.in[I_META] + (size_t)t * D) : (p.in[I_XP] + ((size_t)b * 2048 + (t - 16)) * D);
        v = ((const float4*)s)[c4];
      } else if (row < M) {
        v = ((const float4*)(p.in[I_XS] + (size_t)(row - MPR) * D))[c4];
      }
      ((float4*)XF)[i] = v;
      uint2 o;
      o.x = pack2(v.x, v.y);
      o.y = pack2(v.z, v.w);
      ((uint2*)XB)[i] = o;
    }
  }
  if (blockIdx.x == 0) {
    float* LB = (float*)(ws + OFF_LB);
    const float* lg = p.in[I_LBL];
    for (int c = threadIdx.x; c < 1024; c += blockDim.x) {
      float a = lg[c], b = lg[1024 + c], d = lg[2048 + c];
      float m = fmaxf(a, fmaxf(b, d));
      float ea = expf(a - m), eb = expf(b - m), ed = expf(d - m);
      LB[c] = ea / (ea + eb + ed);
    }
    double* IR = (double*)(ws + OFF_INVREV);
    if (threadIdx.x < 64) {
      double d = (double)threadIdx.x;
      IR[threadIdx.x] = exp(-d * (9.210340371976184 / 64.0)) * 0.15915494309189535;
    }
  }
}

constexpr int G_LDS_STRIDE = 72;
constexpr int G_LDS_BUF = 2 * 128 * G_LDS_STRIDE;
template <class Epi>
DEVI void gemm_phase(const u16* __restrict__ A, int lda, int a_ntile_off, const u16* __restrict__ Bt, int K, int mtiles,
                     int ntiles, char* smem, Epi epi) {
  u16* S0 = (u16*)smem;
  const int tid = threadIdx.x, wid = tid >> 6, lane = tid & 63, wr = wid >> 1, wc = wid & 1, fr = lane & 15, fq = lane >> 4;
  const int nk = K / 64;
  const int xcd = blockIdx.x & 7, slot = blockIdx.x >> 3;
  const int cw = (gridDim.x >> 3) >> 3;
  const int lm = slot / cw, ln = slot - lm * cw;
  const int ncn = (ntiles + cw - 1) / cw, ncm = (mtiles + 7) >> 3;
  for (int ch = xcd; ch < ncn * ncm; ch += 8) {
    const int cm = ch / ncn, cn = ch - cm * ncn;
    const int tm = cm * 8 + lm, tn = cn * cw + ln;
    if (tm >= mtiles || tn >= ntiles) continue;
    const int brow = tm * 128, bcol = tn * 128;
    const u16* Ag = A + (size_t)brow * lda + (size_t)tn * a_ntile_off;
    const u16* Bg = Bt + (size_t)bcol * K;
    f32x4 acc[4][4];
#pragma unroll
    for (int m = 0; m < 4; ++m)
#pragma unroll
      for (int n = 0; n < 4; ++n) acc[m][n] = f32x4{0.f, 0.f, 0.f, 0.f};
    u32x4 ra0[4], rb0[4], ra1[4], rb1[4];
    auto gload = [&](int t, u32x4(&ra)[4], u32x4(&rb)[4]) {
#pragma unroll
      for (int i = 0; i < 4; ++i) {
        int c = tid + i * 256, r = c >> 3, kc = c & 7;
        ra[i] = *(const u32x4*)(Ag + (size_t)r * lda + t * 64 + kc * 8);
        rb[i] = *(const u32x4*)(Bg + (size_t)r * K + t * 64 + kc * 8);
      }
    };
    auto lwrite = [&](int buf, const u32x4(&ra)[4], const u32x4(&rb)[4]) {
      u16* SA = S0 + buf * G_LDS_BUF;
      u16* SB = SA + 128 * G_LDS_STRIDE;
#pragma unroll
      for (int i = 0; i < 4; ++i) {
        int c = tid + i * 256, r = c >> 3, kc = c & 7;
        *(u32x4*)(SA + r * G_LDS_STRIDE + kc * 8) = ra[i];
        *(u32x4*)(SB + r * G_LDS_STRIDE + kc * 8) = rb[i];
      }
    };
    auto compute = [&](int buf) {
      const u16* SA = S0 + buf * G_LDS_BUF;
      const u16* SB = SA + 128 * G_LDS_STRIDE;
#pragma unroll
      for (int kh = 0; kh < 2; ++kh) {
        bf16x8 At[4], Bl[4];
#pragma unroll
        for (int m = 0; m < 4; ++m)
          At[m] = *(const bf16x8*)(SA + (wr * 64 + m * 16 + fr) * G_LDS_STRIDE + kh * 32 + fq * 8);
#pragma unroll
        for (int n = 0; n < 4; ++n)
          Bl[n] = *(const bf16x8*)(SB + (wc * 64 + n * 16 + fr) * G_LDS_STRIDE + kh * 32 + fq * 8);
#pragma unroll
        for (int m = 0; m < 4; ++m)
#pragma unroll
          for (int n = 0; n < 4; ++n) acc[m][n] = __builtin_amdgcn_mfma_f32_16x16x32_bf16(At[m], Bl[n], acc[m][n], 0, 0, 0);
        __builtin_amdgcn_sched_barrier(0);
      }
    };
    gload(0, ra0, rb0);
    if (nk > 1) gload(1, ra1, rb1);
    lwrite(0, ra0, rb0);
    __syncthreads();
#pragma unroll 1
    for (int t = 0; t < nk; t += 2) {
      if (t + 2 < nk) gload(t + 2, ra0, rb0);
      compute(0);
      if (t + 1 < nk) lwrite(1, ra1, rb1);
      __syncthreads();
      if (t + 1 < nk) {
        if (t + 3 < nk) gload(t + 3, ra1, rb1);
        compute(1);
        if (t + 2 < nk) lwrite(0, ra0, rb0);
        __syncthreads();
      }
    }
#pragma unroll
    for (int m = 0; m < 4; ++m)
#pragma unroll
      for (int n = 0; n < 2; ++n)
#pragma unroll
        for (int j = 0; j < 4; ++j) {
          int row = brow + wr * 64 + m * 16 + fq * 4 + j;
          int col = bcol + wc * 64 + n * 16 + fr;
          epi(row, col, acc[m][n][j], acc[m][n + 2][j]);
        }
  }
}

struct Seg {
  int off;
  int ld;
  int n4;
};

template <int NS, int NF4, int RG>
DEVI void stage_init(const float* wsf, const Seg (&sg)[NS], int row0, int tid, const float* (&ptr)[RG], int (&ldv)[RG]) {
  asm volatile("" : "+v"(tid));
#pragma unroll
  for (int q = 0; q < RG; ++q) {
    int flat = tid + q * 256;
    int t = flat / NF4, f = flat % NF4;
    if (flat >= 16 * NF4) { t = 0; f = 0; }
    int off = 0, ld = 0, ff = f;
    bool done = false;
#pragma unroll
    for (int s = 0; s < NS; ++s) {
      bool here = (!done) && (ff < sg[s].n4);
      off = here ? (sg[s].off + (row0 + t) * sg[s].ld + ff * 4) : off;
      ld = here ? sg[s].ld : ld;
      ff = (done || here) ? ff : (ff - sg[s].n4);
      done = done || here;
    }
    ptr[q] = wsf + off;
    ldv[q] = ld;
  }
}
template <int NF4, int RG>
DEVI void stage_issue(const float* const (&ptr)[RG], const int (&ldv)[RG], int st, int nsteps, int tid, f32x4 (&rg)[RG]) {
#pragma unroll
  for (int q = 0; q < RG; ++q) {
    int flat = tid + q * 256;
    if (flat < nsteps * NF4) rg[q] = *(const f32x4*)(ptr[q] + (st * 16) * ldv[q]);
  }
}
template <int NF4, int RG>
DEVI void stage_commit(float* buf, int nsteps, int tid, const f32x4 (&rg)[RG]) {
#pragma unroll
  for (int q = 0; q < RG; ++q) {
    int flat = tid + q * 256;
    if (flat < nsteps * NF4) ((f32x4*)buf)[flat] = rg[q];
  }
}

template <int MODE>
DEVI void colrec_long(const float* wsf, const Seg (&sg)[4], int row0, int T, float gamma, float* outp, int ldo, float* stout, int st_ld,
                      float* smem) {
  constexpr int NF4 = 69, W = 276, RG = 5;
  const int tid = threadIdx.x, w = tid >> 6, lane = tid & 63, c = lane >> 4, s = lane & 15;
  float S[8];
#pragma unroll
  for (int i = 0; i < 8; ++i) S[i] = 0.f;
  float* buf0 = smem;
  float* buf1 = smem + 16 * 336;
  float* obuf = smem + 2 * 16 * 336;
  const int nst = (T + 15) / 16;
  f32x4 rgA[RG], rgB[RG];
  const float* sptr[RG];
  int sld[RG];
  stage_init<4, NF4, RG>(wsf, sg, row0, tid, sptr, sld);
  auto step = [&](const float* sp, float* ob, int tt) {
    float4 a0 = *(const float4*)(sp + s * 8), a1 = *(const float4*)(sp + s * 8 + 4);
    float4 q0 = *(const float4*)(sp + 128 + s * 8), q1 = *(const float4*)(sp + 128 + s * 8 + 4);
    float a[8] = {a0.x, a0.y, a0.z, a0.w, a1.x, a1.y, a1.z, a1.w};
    float q[8] = {q0.x, q0.y, q0.z, q0.w, q1.x, q1.y, q1.z, q1.w};
    float val = sp[256 + w * 4 + c];
    float dA = gamma;
    if (MODE == 2) {
      val *= sp[272];
      dA = sp[273];
    }
    float o = 0.f;
#pragma unroll
    for (int i = 0; i < 8; ++i) {
      if (MODE == 0) S[i] = val + a[i] * (S[i] - val);
      else S[i] = dA * S[i] + a[i] * val;
      o += q[i] * S[i];
    }
    o = red16(o);
    if (s == 0) ob[tt * 16 + w * 4 + c] = o;
  };
  auto run_stage = [&](const float* b, float* ob, int nthis) {
#pragma unroll 1
    for (int tt = 0; tt < nthis; tt += 4) {
      step(b + tt * W, ob, tt);
      step(b + (tt + 1) * W, ob, tt + 1);
      step(b + (tt + 2) * W, ob, tt + 2);
      step(b + (tt + 3) * W, ob, tt + 3);
    }
  };
  auto write_out = [&](const float* ob, int st, int nthis) {
    if (tid < nthis * 4) {
      int t = tid >> 2, c4 = tid & 3;
      *(float4*)(outp + (size_t)(st * 16 + t) * ldo + c4 * 4) = *(const float4*)(ob + t * 16 + c4 * 4);
    }
  };
  auto nsteps = [&](int st) { return min(16, T - st * 16); };
  stage_issue<NF4, RG>(sptr, sld, 0, nsteps(0), tid, rgA);
  stage_commit<NF4, RG>(buf0, nsteps(0), tid, rgA);
  if (nst > 1) stage_issue<NF4, RG>(sptr, sld, 1, nsteps(1), tid, rgB);
  __syncthreads();
#pragma unroll 1
  for (int st = 0; st < nst; st += 2) {
    if (st + 2 < nst) stage_issue<NF4, RG>(sptr, sld, st + 2, nsteps(st + 2), tid, rgA);
    run_stage(buf0, obuf, nsteps(st));
    if (st + 1 < nst) stage_commit<NF4, RG>(buf1, nsteps(st + 1), tid, rgB);
    __syncthreads();
    write_out(obuf, st, nsteps(st));
    if (st + 1 < nst) {
      if (st + 3 < nst) stage_issue<NF4, RG>(sptr, sld, st + 3, nsteps(st + 3), tid, rgB);
      run_stage(buf1, obuf + 512, nsteps(st + 1));
      if (st + 2 < nst) stage_commit<NF4, RG>(buf0, nsteps(st + 2), tid, rgA);
      __syncthreads();
      write_out(obuf + 512, st + 1, nsteps(st + 1));
    }
  }
#pragma unroll
  for (int i = 0; i < 8; ++i) stout[(size_t)(s * 8 + i) * st_ld + w * 4 + c] = S[i];
  __syncthreads();
}

template <int MODE>
DEVI void colrec_short(const float* pa, int lda_, const float* pq, int ldq, const float* pc, int ldc, const float* pdt,
                       long row0, float gamma, const float* stin, float* stout, int st_ld, float* outp, int ldo,
                       float* smem) {
  const int tid = threadIdx.x, lane = tid & 63;
  const int wid = __builtin_amdgcn_readfirstlane(tid >> 6);
  const int k0 = wid * 32;
  float S[32];
#pragma unroll
  for (int i = 0; i < 32; ++i) S[i] = stin[(size_t)(k0 + i) * st_ld + lane];
#pragma unroll 1
  for (int t = 0; t < 4; ++t) {
    long row = row0 + t;
    float val = pc[(size_t)row * ldc + lane];
    float dA = gamma;
    if (MODE == 2) {
      val *= pdt[(size_t)row * 64];
      dA = pdt[(size_t)row * 64 + 1];
    }
    const float4* ap = (const float4*)(pa + (size_t)row * lda_ + k0);
    const float4* qp = (const float4*)(pq + (size_t)row * ldq + k0);
    float o = 0.f;
#pragma unroll
    for (int i4 = 0; i4 < 8; ++i4) {
      float4 av = ap[i4], qv = qp[i4];
      float a[4] = {av.x, av.y, av.z, av.w};
      float q[4] = {qv.x, qv.y, qv.z, qv.w};
#pragma unroll
      for (int e = 0; e < 4; ++e) {
        int i = i4 * 4 + e;
        if (MODE == 0) S[i] = val + a[e] * (S[i] - val);
        else S[i] = dA * S[i] + a[e] * val;
        o += q[e] * S[i];
      }
    }
    smem[(wid * 4 + t) * 64 + lane] = o;
  }
#pragma unroll
  for (int i = 0; i < 32; ++i) stout[(size_t)(k0 + i) * st_ld + lane] = S[i];
  __syncthreads();
  {
    int t = tid >> 6;
    float sum = smem[(0 * 4 + t) * 64 + lane] + smem[(1 * 4 + t) * 64 + lane] + smem[(2 * 4 + t) * 64 + lane] +
                smem[(3 * 4 + t) * 64 + lane];
    outp[(size_t)(row0 + t) * ldo + lane] = sum;
  }
  __syncthreads();
}

DEVI void rwkv_item(const float* wsf, const Seg (&sg)[6], int row0, int T, const float* stin, float* stout, float* outp, int ldo,
                    float* smem) {
  constexpr int NF4 = 84, W = 336, RG = 6;
  const int tid = threadIdx.x, w = tid >> 6, lane = tid & 63, rl = lane >> 4, sl = lane & 15;
  const int il = w * 4 + rl;
  float S[4];
  if (stin) {
    float4 v = *(const float4*)(stin + il * 64 + sl * 4);
    S[0] = v.x; S[1] = v.y; S[2] = v.z; S[3] = v.w;
  } else {
    S[0] = S[1] = S[2] = S[3] = 0.f;
  }
  float* buf0 = smem;
  float* buf1 = smem + 16 * 336;
  float* obuf = smem + 2 * 16 * 336;
  const int nst = (T + 15) / 16;
  f32x4 rgA[RG], rgB[RG];
  const float* sptr[RG];
  int sld[RG];
  stage_init<6, NF4, RG>(wsf, sg, row0, tid, sptr, sld);
  auto run_stage = [&](const float* b, float* ob, int nthis) {
#pragma unroll 4
    for (int tt = 0; tt < nthis; ++tt) {
      const float* sp = b + tt * W;
      float4 r4 = *(const float4*)(sp + sl * 4);
      float4 w4 = *(const float4*)(sp + 64 + sl * 4);
      float4 k4 = *(const float4*)(sp + 128 + sl * 4);
      float4 n4 = *(const float4*)(sp + 192 + sl * 4);
      float4 m4 = *(const float4*)(sp + 256 + sl * 4);
      float vi = sp[320 + il];
      float sa = S[0] * n4.x + S[1] * n4.y + S[2] * n4.z + S[3] * n4.w;
      sa = -red16(sa);
      S[0] = S[0] * w4.x + sa * m4.x + vi * k4.x;
      S[1] = S[1] * w4.y + sa * m4.y + vi * k4.y;
      S[2] = S[2] * w4.z + sa * m4.z + vi * k4.z;
      S[3] = S[3] * w4.w + sa * m4.w + vi * k4.w;
      float y = S[0] * r4.x + S[1] * r4.y + S[2] * r4.z + S[3] * r4.w;
      y = red16(y);
      if (sl == 0) ob[tt * 16 + il] = y;
    }
  };
  auto write_out = [&](const float* ob, int st, int nthis) {
    if (tid < nthis * 4) {
      int t = tid >> 2, c4 = tid & 3;
      *(float4*)(outp + (size_t)(st * 16 + t) * ldo + c4 * 4) = *(const float4*)(ob + t * 16 + c4 * 4);
    }
  };
  auto nsteps = [&](int st) { return min(16, T - st * 16); };
  stage_issue<NF4, RG>(sptr, sld, 0, nsteps(0), tid, rgA);
  stage_commit<NF4, RG>(buf0, nsteps(0), tid, rgA);
  if (nst > 1) stage_issue<NF4, RG>(sptr, sld, 1, nsteps(1), tid, rgB);
  __syncthreads();
#pragma unroll 1
  for (int st = 0; st < nst; st += 2) {
    if (st + 2 < nst) stage_issue<NF4, RG>(sptr, sld, st + 2, nsteps(st + 2), tid, rgA);
    run_stage(buf0, obuf, nsteps(st));
    if (st + 1 < nst) stage_commit<NF4, RG>(buf1, nsteps(st + 1), tid, rgB);
    __syncthreads();
    write_out(obuf, st, nsteps(st));
    if (st + 1 < nst) {
      if (st + 3 < nst) stage_issue<NF4, RG>(sptr, sld, st + 3, nsteps(st + 3), tid, rgB);
      run_stage(buf1, obuf + 512, nsteps(st + 1));
      if (st + 2 < nst) stage_commit<NF4, RG>(buf0, nsteps(st + 2), tid, rgA);
      __syncthreads();
      write_out(obuf + 512, st + 1, nsteps(st + 1));
    }
  }
  *(float4*)(stout + il * 64 + sl * 4) = make_float4(S[0], S[1], S[2], S[3]);
  __syncthreads();
}

DEVI void phase_rec0(const Params& p, float* smem) {
  char* ws = p.ws;
  const float* PROJ = (const float*)(ws + OFF_PROJ);
  float* OMIX = (float*)(ws + OFF_OMIX);
  const float* wsf = (const float*)ws;
  constexpr int PO = (int)(OFF_PROJ / 4);
  for (int item = blockIdx.x; item < 4608; item += gridDim.x) {
    if (item < 256) {
      int b = item >> 6, h = (item >> 3) & 7, cb = item & 7;
      Seg sg[4] = {{PO + 1024 + h * 128, N0, 32}, {PO + h * 128, N0, 32}, {PO + 2048 + h * 128 + cb * 16, N0, 4},
                   {PO, N0, 1}};
      int row0 = b * TP;
      colrec_long<0>(wsf, sg, row0, TP, 0.f, OMIX + (size_t)row0 * 2048 + h * 128 + cb * 16, 2048,
                     p.out + O_HGP + (size_t)(b * 8 + h) * 128 * 128 + cb * 16, 128, smem);
    } else if (item < 512) {
      int it = item - 256;
      int b = it >> 6, h = (it >> 4) & 3, cb = it & 15;
      Seg sg[4] = {{PO + 4608 + h * 128, N0, 32}, {PO + 4096 + h * 128, N0, 32},
                   {PO + 5120 + h * 256 + cb * 16, N0, 4}, {PO, N0, 1}};
      int row0 = b * TP;
      float gamma = 1.0f - exp2f(-5.0f - (float)h);
      colrec_long<1>(wsf, sg, row0, TP, gamma, OMIX + (size_t)row0 * 2048 + 1024 + h * 256 + cb * 16, 2048,
                     p.out + O_RTP + (size_t)(b * 4 + h) * 128 * 256 + cb * 16, 256, smem);
    } else if (item < 2560) {
      int it = item - 512;
      int b = it >> 4, h = (it >> 1) & 7, cb = it & 1;
      long row0 = MPR + (long)b * 4;
      size_t so = (size_t)(b * 8 + h) * 128 * 128 + cb * 64;
      colrec_short<0>(PROJ + 1024 + h * 128, N0, PROJ + h * 128, N0, PROJ + 2048 + h * 128 + cb * 64, N0, nullptr, row0,
                      0.f, p.in[I_SHG] + so, p.out + O_HGS + so, 128, OMIX + h * 128 + cb * 64, 2048, smem);
    } else {
      int it = item - 2560;
      int b = it >> 4, h = (it >> 2) & 3, cb = it & 3;
      long row0 = MPR + (long)b * 4;
      size_t so = (size_t)(b * 4 + h) * 128 * 256 + cb * 64;
      float gamma = 1.0f - exp2f(-5.0f - (float)h);
      colrec_short<1>(PROJ + 4608 + h * 128, N0, PROJ + 4096 + h * 128, N0, PROJ + 5120 + h * 256 + cb * 64, N0, nullptr,
                      row0, gamma, p.in[I_SRT] + so, p.out + O_RTS + so, 256, OMIX + 1024 + h * 256 + cb * 64, 2048,
                      smem);
    }
  }
}

DEVI float4 ld4(const float* p) { return *(const float4*)p; }
DEVI void st_bf4(u16* p, float a, float b, float c, float d) {
  uint2 o;
  o.x = pack2(a, b);
  o.y = pack2(c, d);
  *(uint2*)p = o;
}
DEVI float rlf_(float v, int l) { return __int_as_float(__builtin_amdgcn_readlane(__float_as_int(v), l)); }
DEVI float wsum_u_(float v) {
  v = red16(v);
  return (rlf_(v, 0) + rlf_(v, 16)) + (rlf_(v, 32) + rlf_(v, 48));
}
DEVI float red32(float v) {
  v = red16(v);
  return v + __shfl_xor(v, 16, 64);
}
DEVI void phase_post0(const Params& p) {
  char* ws = p.ws;
  const float* PROJ = (const float*)(ws + OFF_PROJ);
  const float* OMIX = (const float*)(ws + OFF_OMIX);
  u16* MIXB = (u16*)(ws + OFF_MIXB);
  const float* ng = p.in[I_HNG];
  const int lane = threadIdx.x & 63;
  const int gw = blockIdx.x * 4 + (threadIdx.x >> 6), nw = gridDim.x * 4;
  const float4 g4 = ld4(ng + (lane & 31) * 4);
  for (int row = gw; row < M; row += nw) {
    const float* o = OMIX + (size_t)row * 2048;
    const float* pr = PROJ + (size_t)row * N0;
    u16* mo = MIXB + (size_t)row * 2048;
    float4 a[4], ga[4], bq[4], gb[4];
#pragma unroll
    for (int it = 0; it < 4; ++it) {
      int c = it * 256 + lane * 4;
      a[it] = ld4(o + c);
      ga[it] = ld4(pr + 3072 + c);
      bq[it] = ld4(o + 1024 + c);
      gb[it] = ld4(pr + 6144 + c);
    }
#pragma unroll
    for (int it = 0; it < 4; ++it) {
      int c = it * 256 + lane * 4;
      float ss = red32(a[it].x * a[it].x + a[it].y * a[it].y + a[it].z * a[it].z + a[it].w * a[it].w);
      float inv = rsqrtf(ss * (1.0f / 128.0f) + 1e-6f);
      st_bf4(mo + c, a[it].x * inv * g4.x * ga[it].x, a[it].y * inv * g4.y * ga[it].y, a[it].z * inv * g4.z * ga[it].z,
             a[it].w * inv * g4.w * ga[it].w);
      float mu = wsum_u_(bq[it].x + bq[it].y + bq[it].z + bq[it].w) * (1.0f / 256.0f);
      float dx = bq[it].x - mu, dy = bq[it].y - mu, dz = bq[it].z - mu, dw = bq[it].w - mu;
      float var = wsum_u_(dx * dx + dy * dy + dz * dz + dw * dw) * (1.0f / 256.0f);
      float iv = rsqrtf(var + 1e-5f);
      st_bf4(mo + 1024 + c, dx * iv * gb[it].x, dy * iv * gb[it].y, dz * iv * gb[it].z, dw * iv * gb[it].w);
    }
  }
}

DEVI void phase_ln(const Params& p, const float* addsrc, const float* g, const float* bta) {
  char* ws = p.ws;
  float* XF = (float*)(ws + OFF_XF);
  u16* XB = (u16*)(ws + OFF_XB);
  const int lane = threadIdx.x & 63;
  const int gw = blockIdx.x * 4 + (threadIdx.x >> 6), nw = gridDim.x * 4;
  for (int row = gw; row < M; row += nw) {
    float4* xr = (float4*)(XF + (size_t)row * 2048);
    const float4* ar = (const float4*)(addsrc + (size_t)row * 2048);
    float v[32];
    float s = 0.f;
#pragma unroll
    for (int i = 0; i < 8; ++i) {
      float4 x = xr[i * 64 + lane], a = ar[i * 64 + lane];
      v[i * 4 + 0] = ALPHA * x.x + a.x;
      v[i * 4 + 1] = ALPHA * x.y + a.y;
      v[i * 4 + 2] = ALPHA * x.z + a.z;
      v[i * 4 + 3] = ALPHA * x.w + a.w;
      s += v[i * 4 + 0] + v[i * 4 + 1] + v[i * 4 + 2] + v[i * 4 + 3];
    }
    float mu = wsum(s) * (1.0f / 2048.0f);
    float q = 0.f;
#pragma unroll
    for (int i = 0; i < 32; ++i) {
      v[i] -= mu;
      q += v[i] * v[i];
    }
    float inv = rsqrtf(wsum(q) * (1.0f / 2048.0f) + 1e-5f);
#pragma unroll
    for (int i = 0; i < 8; ++i) {
      float4 gg = ((const float4*)g)[i * 64 + lane], bb = ((const float4*)bta)[i * 64 + lane];
      float4 y;
      y.x = v[i * 4 + 0] * inv * gg.x + bb.x;
      y.y = v[i * 4 + 1] * inv * gg.y + bb.y;
      y.z = v[i * 4 + 2] * inv * gg.z + bb.z;
      y.w = v[i * 4 + 3] * inv * gg.w + bb.w;
      xr[i * 64 + lane] = y;
      uint2 o;
      o.x = pack2(y.x, y.y);
      o.y = pack2(y.z, y.w);
      ((uint2*)(XB + (size_t)row * 2048))[i * 64 + lane] = o;
    }
  }
}

typedef __attribute__((ext_vector_type(2))) __bf16 bf2_t;
typedef __attribute__((ext_vector_type(2))) float f32x2;
DEVI float dot2bf(unsigned a, unsigned b, float acc) {
  return __builtin_amdgcn_fdot2_f32_bf16(__builtin_bit_cast(bf2_t, a), __builtin_bit_cast(bf2_t, b), acc, false);
}
template <int CTRL>
DEVI int dppi(int v) {
  return __builtin_amdgcn_update_dpp(v, v, CTRL, 0xF, 0xF, false);
}
DEVI int wmax_i(int v) {
  v = max(v, dppi<0xB1>(v));
  v = max(v, dppi<0x4E>(v));
  v = max(v, dppi<0x141>(v));
  v = max(v, dppi<0x140>(v));
  int a = __builtin_amdgcn_readlane(v, 0), b = __builtin_amdgcn_readlane(v, 16);
  int c = __builtin_amdgcn_readlane(v, 32), d = __builtin_amdgcn_readlane(v, 48);
  return max(max(a, b), max(c, d));
}
DEVI float rlf(float v, int l) { return __int_as_float(__builtin_amdgcn_readlane(__float_as_int(v), l)); }
DEVI float wsum_u(float v) {
  v = red16(v);
  return (rlf(v, 0) + rlf(v, 16)) + (rlf(v, 32) + rlf(v, 48));
}
DEVI int fkey(float f) {
  int u = __float_as_int(f);
  return u ^ ((u >> 31) & 0x7fffffff);
}
DEVI float keyf(int k) { return __int_as_float(k ^ ((k >> 31) & 0x7fffffff)); }

DEVI void conv_fp8_rows(const float* __restrict__ src, unsigned char* __restrict__ dst, float* __restrict__ scales) {
  const int lane = threadIdx.x & 63;
  const int gw = blockIdx.x * 4 + (threadIdx.x >> 6), nw = gridDim.x * 4;
  for (int e = gw; e < 16384; e += nw) {
    const float* r = src + (size_t)e * 2048;
    float4 v[8];
    float am = 0.f;
#pragma unroll
    for (int q = 0; q < 8; ++q) {
      v[q] = *(const float4*)(r + (q >> 2) * 1024 + lane * 16 + (q & 3) * 4);
      am = fmaxf(am, fmaxf(fmaxf(fabsf(v[q].x), fabsf(v[q].y)), fmaxf(fabsf(v[q].z), fabsf(v[q].w))));
    }
    float amax = __int_as_float(wmax_i(__float_as_int(am)));
    float inv = (amax > 0.f) ? (440.0f / amax) : 0.f;
    float scale = (amax > 0.f) ? (amax * (1.0f / 440.0f)) : 1.0f;
#pragma unroll
    for (int j = 0; j < 2; ++j) {
      u32x4 o;
#pragma unroll
      for (int k = 0; k < 4; ++k) {
        float4 t = v[j * 4 + k];
        int pk = 0;
        pk = __builtin_amdgcn_cvt_pk_fp8_f32(t.x * inv, t.y * inv, pk, false);
        pk = __builtin_amdgcn_cvt_pk_fp8_f32(t.z * inv, t.w * inv, pk, true);
        o[k] = (unsigned)pk;
      }
      *(u32x4*)(dst + (size_t)e * 2048 + j * 1024 + lane * 16) = o;
    }
    if (lane == 0) scales[e] = scale;
  }
}

DEVI void phase_peer(const Params& p, int layer, bool final_out) {
  char* ws = p.ws;
  const float* SC = (const float*)(ws + OFF_GOUT);
  float* XF = (float*)(ws + OFF_XF);
  u16* XB = (u16*)(ws + OFF_XB);
  const unsigned char* UB = (const unsigned char*)(ws + OFF_UB);
  const unsigned char* VB = (const unsigned char*)(ws + OFF_VB);
  const float* USC = (const float*)(ws + OFF_USC);
  const float* VSC = (const float*)(ws + OFF_VSC);
  const float* g = p.in[I_LNG] + (size_t)(layer * 2 + 1) * D;
  const float* bta = p.in[I_LNB] + (size_t)(layer * 2 + 1) * D;
  const int lane = threadIdx.x & 63;
  const int gw = blockIdx.x * 4 + (threadIdx.x >> 6), nw = gridDim.x * 4;
  constexpr int KMIN = (int)0x80000000;
  for (int row = gw; row < M; row += nw) {
    const float* sr = SC + (size_t)row * 2048;
    int eidx0 = 0, eidx1 = 0;
    float gate0 = 0.f, gate1 = 0.f;
#pragma unroll 1
    for (int h = 0; h < 8; ++h) {
      const float* sp = sr + h * 256;
      int ka0 = (fkey(sp[lane]) & ~127) | (127 - lane);
      int kb0 = (fkey(sp[lane + 64]) & ~127) | (63 - lane);
      int ka1 = (fkey(sp[128 + lane]) & ~127) | (127 - lane);
      int kb1 = (fkey(sp[192 + lane]) & ~127) | (63 - lane);
      int my0 = KMIN, my1 = KMIN;
#pragma unroll 1
      for (int r = 0; r < 16; ++r) {
        int K0 = wmax_i(max(ka0, kb0));
        int K1 = wmax_i(max(ka1, kb1));
        my0 = (lane == r) ? K0 : my0;
        my1 = (lane == r) ? K1 : my1;
        ka0 = (ka0 == K0) ? KMIN : ka0;
        kb0 = (kb0 == K0) ? KMIN : kb0;
        ka1 = (ka1 == K1) ? KMIN : ka1;
        kb1 = (kb1 == K1) ? KMIN : kb1;
      }
      float ts0 = keyf(my0 & ~127), ts1 = keyf(my1 & ~127);
      int ti0 = 127 - (my0 & 127), ti1 = 127 - (my1 & 127);
      float s0 = __shfl(ts0, lane >> 2, 64);
      int jb = (lane & 3) * 4;
      int c0 = (fkey(s0 + __shfl(ts1, jb + 0, 64)) & ~255) | (255 - (lane * 4 + 0));
      int c1 = (fkey(s0 + __shfl(ts1, jb + 1, 64)) & ~255) | (255 - (lane * 4 + 1));
      int c2 = (fkey(s0 + __shfl(ts1, jb + 2, 64)) & ~255) | (255 - (lane * 4 + 2));
      int c3 = (fkey(s0 + __shfl(ts1, jb + 3, 64)) & ~255) | (255 - (lane * 4 + 3));
      int myk = KMIN;
#pragma unroll 1
      for (int r = 0; r < 16; ++r) {
        int K = wmax_i(max(max(c0, c1), max(c2, c3)));
        myk = (lane == r) ? K : myk;
        c0 = (c0 == K) ? KMIN : c0;
        c1 = (c1 == K) ? KMIN : c1;
        c2 = (c2 == K) ? KMIN : c2;
        c3 = (c3 == K) ? KMIN : c3;
      }
      float bs = keyf(myk & ~255);
      int bf = 255 - (myk & 255);
      int e = __shfl(ti0, (bf >> 4) & 15, 64) * 128 + __shfl(ti1, bf & 15, 64);
      float mx = rlf(bs, 0);
      float ev = (lane < 16) ? expf(bs - mx) : 0.f;
      float sm = wsum_u(ev);
      float gt = ev / sm;
      int e_b = __shfl(e, lane & 15, 64);
      float g_b = __shfl(gt, lane & 15, 64);
      if ((lane >> 4) == (h & 3)) {
        if (h < 4) {
          eidx0 = e_b;
          gate0 = g_b;
        } else {
          eidx1 = e_b;
          gate1 = g_b;
        }
      }
    }
    float dv0 = 0.f, dv1 = 0.f;
    {
      float xf[32];
      {
        const float4* xr = (const float4*)(XF + (size_t)row * 2048);
#pragma unroll
        for (int q = 0; q < 8; ++q) {
          float4 t = xr[(q >> 2) * 256 + lane * 4 + (q & 3)];
          xf[q * 4 + 0] = t.x; xf[q * 4 + 1] = t.y; xf[q * 4 + 2] = t.z; xf[q * 4 + 3] = t.w;
        }
      }
      constexpr int R = 8;
      u32x4 w[R][2];
      float sc[R];
      auto load_row = [&](int pidx, u32x4(&wr)[2], float& scv) {
        int src = (pidx < 64) ? eidx0 : eidx1;
        int e = __builtin_amdgcn_readlane(src, pidx & 63);
        const u32x4* ur = (const u32x4*)(UB + (size_t)e * 2048);
        wr[0] = ur[lane];
        wr[1] = ur[64 + lane];
        scv = USC[e];
      };
#pragma unroll
      for (int u = 0; u < R; ++u) load_row(u, w[u], sc[u]);
#pragma unroll 1
      for (int p0 = 0; p0 < 128; p0 += R) {
#pragma unroll
        for (int u = 0; u < R; ++u) {
          float d = 0.f;
#pragma unroll
          for (int j = 0; j < 2; ++j) {
#pragma unroll
            for (int k = 0; k < 4; ++k) {
              int dw = (int)w[u][j][k];
              f32x2 lo = __builtin_amdgcn_cvt_pk_f32_fp8(dw, false);
              f32x2 hi = __builtin_amdgcn_cvt_pk_f32_fp8(dw, true);
              d += lo.x * xf[j * 16 + k * 4 + 0];
              d += lo.y * xf[j * 16 + k * 4 + 1];
              d += hi.x * xf[j * 16 + k * 4 + 2];
              d += hi.y * xf[j * 16 + k * 4 + 3];
            }
          }
          float scu = sc[u];
          if (p0 + R < 128) load_row(p0 + R + u, w[u], sc[u]);
          d = wsum_u(d) * scu;
          int pl = (p0 + u) & 63;
          if (p0 < 64) dv0 = (lane == pl) ? d : dv0;
          else dv1 = (lane == pl) ? d : dv1;
          __builtin_amdgcn_sched_barrier(0);
        }
      }
    }
    float coef0 = 0.5f * dv0 * (1.0f + erff(dv0 * 0.70710678118f)) * gate0;
    float coef1 = 0.5f * dv1 * (1.0f + erff(dv1 * 0.70710678118f)) * gate1;
    f32x2 o2[16];
#pragma unroll
    for (int i = 0; i < 16; ++i) o2[i] = f32x2{0.f, 0.f};
    {
      constexpr int R = 8;
      u32x4 w[R][2];
      float sc[R];
      auto load_row = [&](int pidx, u32x4(&wr)[2], float& scv) {
        int src = (pidx < 64) ? eidx0 : eidx1;
        int e = __builtin_amdgcn_readlane(src, pidx & 63);
        const u32x4* vr = (const u32x4*)(VB + (size_t)e * 2048);
        wr[0] = vr[lane];
        wr[1] = vr[64 + lane];
        scv = VSC[e];
      };
#pragma unroll
      for (int u = 0; u < R; ++u) load_row(u, w[u], sc[u]);
#pragma unroll 1
      for (int p0 = 0; p0 < 128; p0 += R) {
        float cfs = (p0 < 64) ? coef0 : coef1;
#pragma unroll
        for (int u = 0; u < R; ++u) {
          float c = rlf(cfs, (p0 + u) & 63) * sc[u];
          f32x2 cc = f32x2{c, c};
#pragma unroll
          for (int j = 0; j < 2; ++j) {
#pragma unroll
            for (int k = 0; k < 4; ++k) {
              int dw = (int)w[u][j][k];
              o2[j * 8 + k * 2 + 0] += cc * __builtin_amdgcn_cvt_pk_f32_fp8(dw, false);
              o2[j * 8 + k * 2 + 1] += cc * __builtin_amdgcn_cvt_pk_f32_fp8(dw, true);
            }
          }
          if (p0 + R < 128) load_row(p0 + R + u, w[u], sc[u]);
          __builtin_amdgcn_sched_barrier(0);
        }
      }
    }
    float o[32];
#pragma unroll
    for (int i = 0; i < 16; ++i) {
      o[2 * i] = o2[i].x;
      o[2 * i + 1] = o2[i].y;
    }
    float s = 0.f;
    {
      const float4* xr = (const float4*)(XF + (size_t)row * 2048);
#pragma unroll
      for (int q = 0; q < 8; ++q) {
        float4 t = xr[(q >> 2) * 256 + lane * 4 + (q & 3)];
        o[q * 4 + 0] += ALPHA * t.x; o[q * 4 + 1] += ALPHA * t.y; o[q * 4 + 2] += ALPHA * t.z; o[q * 4 + 3] += ALPHA * t.w;
      }
#pragma unroll
      for (int i = 0; i < 32; ++i) s += o[i];
    }
    float mu = wsum_u(s) * (1.0f / 2048.0f);
    float q = 0.f;
#pragma unroll
    for (int i = 0; i < 32; ++i) {
      o[i] -= mu;
      q += o[i] * o[i];
    }
    float inv = rsqrtf(wsum_u(q) * (1.0f / 2048.0f) + 1e-5f);
    float* dstf;
    if (final_out) {
      if (row < MPR) {
        int b = row / TP, t = row % TP;
        dstf = (t >= 16) ? (p.out + O_YP + ((size_t)b * 2048 + (t - 16)) * D) : nullptr;
      } else {
        dstf = p.out + O_YS + (size_t)(row - MPR) * D;
      }
    } else {
      dstf = XF + (size_t)row * 2048;
    }
#pragma unroll
    for (int j = 0; j < 2; ++j) {
      float yv[16];
#pragma unroll
      for (int k = 0; k < 4; ++k) {
        float4 gv = *(const float4*)(g + j * 1024 + lane * 16 + k * 4);
        float4 bv = *(const float4*)(bta + j * 1024 + lane * 16 + k * 4);
        float4 y;
        y.x = o[j * 16 + k * 4 + 0] * inv * gv.x + bv.x;
        y.y = o[j * 16 + k * 4 + 1] * inv * gv.y + bv.y;
        y.z = o[j * 16 + k * 4 + 2] * inv * gv.z + bv.z;
        y.w = o[j * 16 + k * 4 + 3] * inv * gv.w + bv.w;
        if (dstf) *(float4*)(dstf + j * 1024 + lane * 16 + k * 4) = y;
        yv[k * 4 + 0] = y.x; yv[k * 4 + 1] = y.y; yv[k * 4 + 2] = y.z; yv[k * 4 + 3] = y.w;
      }
      if (!final_out) {
        uint4* xb = (uint4*)(XB + (size_t)row * 2048 + j * 1024 + lane * 16);
        xb[0] = make_uint4(pack2(yv[0], yv[1]), pack2(yv[2], yv[3]), pack2(yv[4], yv[5]), pack2(yv[6], yv[7]));
        xb[1] = make_uint4(pack2(yv[8], yv[9]), pack2(yv[10], yv[11]), pack2(yv[12], yv[13]), pack2(yv[14], yv[15]));
      }
    }
  }
}

DEVI float4 f4mul(float4 a, float4 b) { return make_float4(a.x * b.x, a.y * b.y, a.z * b.z, a.w * b.w); }
DEVI void row_info(int row, bool& prompt, int& b, int& t, int& T) {
  prompt = row < MPR;
  if (prompt) { b = row / TP; t = row - b * TP; T = TP; }
  else { b = (row - MPR) >> 2; t = (row - MPR) & 3; T = 4; }
}
DEVI void phase_pre1(const Params& p) {
  char* ws = p.ws;
  const float* PROJ = (const float*)(ws + OFF_PROJ);
  float* XC = (float*)(ws + OFF_GOUT);
  float* RKV = (float*)(ws + OFF_RKV);
  u16* LRA = (u16*)(ws + OFF_LRA);
  u16* LRB = (u16*)(ws + OFF_LRB);
  u16* LRG = (u16*)(ws + OFF_LRG);
  const float* cw = p.in[I_CVW];
  const float* cbias = p.in[I_CVB];
  const float* mu = p.in[I_MU];
  const int gtid = blockIdx.x * 256 + threadIdx.x, nthr = gridDim.x * 256;
#pragma unroll 2
  for (int idx = gtid; idx < M * 384; idx += nthr) {
    int row = idx / 384, c = (idx - row * 384) * 4;
    bool prompt; int b, t, T;
    row_info(row, prompt, b, t, T);
    float4 xv[4];
#pragma unroll
    for (int jj = 0; jj < 4; ++jj) {
      int tt = t - 3 + jj;
      if (tt >= 0) xv[jj] = ld4(PROJ + (size_t)(row - 3 + jj) * N1 + 1024 + c);
      else if (prompt) xv[jj] = make_float4(0.f, 0.f, 0.f, 0.f);
      else xv[jj] = ld4(p.in[I_SCV] + (size_t)(b * 3 + (tt + 3)) * 1536 + c);
    }
    float4 acc = ld4(cbias + c);
#pragma unroll
    for (int jj = 0; jj < 4; ++jj) {
      float4 w = ld4(cw + jj * 1536 + c);
      acc.x += xv[jj].x * w.x; acc.y += xv[jj].y * w.y; acc.z += xv[jj].z * w.z; acc.w += xv[jj].w * w.w;
    }
    *(float4*)(XC + (size_t)row * 1536 + c) = make_float4(siluf_(acc.x), siluf_(acc.y), siluf_(acc.z), siluf_(acc.w));
    if (t >= T - 3) {
      float* co = prompt ? (p.out + O_CVP) : (p.out + O_CVS);
      *(float4*)(co + (size_t)(b * 3 + (t - (T - 3))) * 1536 + c) = xv[3];
    }
  }
#pragma unroll 2
  for (int idx = gtid; idx < M * 840; idx += nthr) {
    int row = idx / 840, c = (idx - row * 840) * 4;
    bool prompt; int b, t, T;
    row_info(row, prompt, b, t, T);
    float4 cur = ld4(PROJ + (size_t)row * N1 + 2560 + c);
    float4 prev;
    if (t > 0) prev = ld4(PROJ + (size_t)(row - 1) * N1 + 2560 + c);
    else if (prompt) prev = make_float4(0.f, 0.f, 0.f, 0.f);
    else prev = ld4(p.in[I_SSH] + (size_t)b * 3360 + c);
    float4 m4 = ld4(mu + c);
    float4 mx;
    mx.x = cur.x + (prev.x - cur.x) * m4.x; mx.y = cur.y + (prev.y - cur.y) * m4.y;
    mx.z = cur.z + (prev.z - cur.z) * m4.z; mx.w = cur.w + (prev.w - cur.w) * m4.w;
    if (c < 3072) *(float4*)(RKV + (size_t)row * 3072 + c) = mx;
    else if (c < 3136) st_bf4(LRA + (size_t)row * 64 + (c - 3072), tanhf(mx.x), tanhf(mx.y), tanhf(mx.z), tanhf(mx.w));
    else if (c < 3200) st_bf4(LRB + (size_t)row * 64 + (c - 3136), mx.x, mx.y, mx.z, mx.w);
    else st_bf4(LRG + (size_t)row * 192 + (c - 3200), sigmoidf_(mx.x), sigmoidf_(mx.y), sigmoidf_(mx.z), sigmoidf_(mx.w));
    if (t == T - 1) {
      float* so = prompt ? (p.out + O_SHP) : (p.out + O_SHS);
      *(float4*)(so + (size_t)b * 3360 + c) = cur;
    }
  }
  for (int idx = gtid; idx < M * 4; idx += nthr) {
    int row = idx >> 2, k = idx & 3;
    ((uint4*)(LRG + (size_t)row * 192 + 160))[k] = make_uint4(0, 0, 0, 0);
  }
}

DEVI void phase_pre1c(const Params& p) {
  char* ws = p.ws;
  float* RKV = (float*)(ws + OFF_RKV);
  const float* AA = (const float*)(ws + OFF_AA);
  float* KK = (float*)(ws + OFF_QB);
  float* KKA = (float*)(ws + OFF_MIXB);
  float* BON = (float*)(ws + OFF_BON);
  const float* k_k = p.in[I_KK];
  const float* k_a = p.in[I_KA];
  const float* r_k = p.in[I_RK];
  const int lane = threadIdx.x & 63;
  const int gw = blockIdx.x * 4 + (threadIdx.x >> 6), nw = gridDim.x * 4;
  for (int row = gw; row < M; row += nw) {
    float4 k4[4], r4[4], a4[4];
#pragma unroll
    for (int it = 0; it < 4; ++it) {
      int c = it * 256 + lane * 4;
      k4[it] = ld4(RKV + (size_t)row * 3072 + 1024 + c);
      r4[it] = ld4(RKV + (size_t)row * 3072 + c);
      a4[it] = ld4(AA + (size_t)row * 1024 + c);
    }
#pragma unroll
    for (int it = 0; it < 4; ++it) {
      int c = it * 256 + lane * 4;
      float4 kk4 = ld4(k_k + c), ka4 = ld4(k_a + c), rk4 = ld4(r_k + c);
      float4 k = k4[it], r = r4[it], a = a4[it];
      float4 kr = f4mul(k, kk4);
      float ss = red16(kr.x * kr.x + kr.y * kr.y + kr.z * kr.z + kr.w * kr.w);
      float inv = 1.0f / fmaxf(sqrtf(ss), 1e-12f);
      float4 kk = make_float4(kr.x * inv, kr.y * inv, kr.z * inv, kr.w * inv);
      float4 kp;
      kp.x = k.x * (1.0f + (a.x - 1.0f) * ka4.x); kp.y = k.y * (1.0f + (a.y - 1.0f) * ka4.y);
      kp.z = k.z * (1.0f + (a.z - 1.0f) * ka4.z); kp.w = k.w * (1.0f + (a.w - 1.0f) * ka4.w);
      float bon = red16(r.x * kp.x * rk4.x + r.y * kp.y * rk4.y + r.z * kp.z * rk4.z + r.w * kp.w * rk4.w);
      *(float4*)(KK + (size_t)row * 1024 + c) = kk;
      *(float4*)(KKA + (size_t)row * 1024 + c) = f4mul(kk, a);
      *(float4*)(RKV + (size_t)row * 3072 + 1024 + c) = kp;
      if ((lane & 15) == 0) BON[(size_t)row * 16 + it * 4 + (lane >> 4)] = bon;
    }
  }
}

DEVI void phase_rec1(const Params& p, float* smem) {
  char* ws = p.ws;
  const float* XC = (const float*)(ws + OFF_GOUT);
  const float* RKV = (const float*)(ws + OFF_RKV);
  const float* DEC = (const float*)(ws + OFF_DEC);
  const float* KK = (const float*)(ws + OFF_QB);
  const float* KKA = (const float*)(ws + OFF_MIXB);
  const float* DTA = (const float*)(ws + OFF_DTA);
  float* OMIX = (float*)(ws + OFF_OMIX);
  const float* wsf = (const float*)ws;
  constexpr int XO = (int)(OFF_GOUT / 4), DO = (int)(OFF_DTA / 4), RO = (int)(OFF_RKV / 4), CO = (int)(OFF_DEC / 4),
                KO = (int)(OFF_QB / 4), AO = (int)(OFF_MIXB / 4);
  for (int item = blockIdx.x; item < 10752; item += gridDim.x) {
    if (item < 256) {
      int b = item >> 6, h = (item >> 2) & 15, cb = item & 3;
      int g = h >> 3;
      Seg sg[4] = {{XO + 1024 + g * 128, 1536, 32}, {XO + 1280 + g * 128, 1536, 32}, {XO + h * 64 + cb * 16, 1536, 4},
                   {DO + h * 4, 64, 1}};
      int row0 = b * TP;
      colrec_long<2>(wsf, sg, row0, TP, 0.f, OMIX + (size_t)row0 * 2048 + h * 64 + cb * 16, 2048,
                     p.out + O_SSP + (size_t)(b * 16 + h) * 128 * 64 + cb * 16, 64, smem);
    } else if (item < 512 || item >= 2560) {
      bool prompt = item < 512;
      int it = prompt ? (item - 256) : (item - 2560);
      int b = it >> 6, h = (it >> 2) & 15, rb = it & 3;
      int row0 = prompt ? b * TP : (MPR + b * 4);
      int T = prompt ? TP : 4;
      Seg sg[6] = {{RO + h * 64, 3072, 16}, {CO + h * 64, 1024, 16}, {RO + 1024 + h * 64, 3072, 16},
                   {KO + h * 64, 1024, 16}, {AO + h * 64, 1024, 16}, {RO + 2048 + h * 64 + rb * 16, 3072, 4}};
      size_t so = ((size_t)(b * 16 + h) * 64 + rb * 16) * 64;
      const float* stin = prompt ? nullptr : (p.in[I_SWK] + so);
      float* stout = (prompt ? (p.out + O_WKP) : (p.out + O_WKS)) + so;
      rwkv_item(wsf, sg, row0, T, stin, stout, OMIX + (size_t)row0 * 2048 + 1024 + h * 64 + rb * 16, 2048, smem);
    } else {
      int it = item - 512;
      int b = it >> 4, h = it & 15;
      int g = h >> 3;
      long row0 = MPR + (long)b * 4;
      size_t so = (size_t)(b * 16 + h) * 128 * 64;
      colrec_short<2>(XC + 1024 + g * 128, 1536, XC + 1280 + g * 128, 1536, XC + h * 64, 1536, DTA + h * 4, row0, 0.f,
                      p.in[I_SSM] + so, p.out + O_SSS + so, 64, OMIX + h * 64, 2048, smem);
    }
  }
}

DEVI void phase_post1(const Params& p) {
  char* ws = p.ws;
  const float* PROJ = (const float*)(ws + OFF_PROJ);
  const float* OMIX = (const float*)(ws + OFF_OMIX);
  const float* XC = (const float*)(ws + OFF_GOUT);
  const float* RKV = (const float*)(ws + OFF_RKV);
  const float* GG = (const float*)(ws + OFF_GG);
  const float* BON = (const float*)(ws + OFF_BON);
  u16* MIXB = (u16*)(ws + OFF_MIXB);
  const float* dsk = p.in[I_DSK];
  const float* sng = p.in[I_SNG];
  const float* lxg = p.in[I_LXG];
  const float* lxb = p.in[I_LXB];
  const int lane = threadIdx.x & 63;
  const int gw = blockIdx.x * 4 + (threadIdx.x >> 6), nw = gridDim.x * 4;
  for (int row = gw; row < M; row += nw) {
    const float* o = OMIX + (size_t)row * 2048;
    u16* mo = MIXB + (size_t)row * 2048;
    float4 oc[4], xc[4], z[4], y[4], v[4], gg[4];
    float bn[4];
#pragma unroll
    for (int it = 0; it < 4; ++it) {
      int c = it * 256 + lane * 4;
      oc[it] = ld4(o + c);
      xc[it] = ld4(XC + (size_t)row * 1536 + c);
      z[it] = ld4(PROJ + (size_t)row * N1 + c);
      y[it] = ld4(o + 1024 + c);
      v[it] = ld4(RKV + (size_t)row * 3072 + 2048 + c);
      gg[it] = ld4(GG + (size_t)row * 1024 + c);
      bn[it] = BON[(size_t)row * 16 + it * 4 + (lane >> 4)];
    }
    float4 val[4];
    float ssq[4];
#pragma unroll
    for (int it = 0; it < 4; ++it) {
      float ds = dsk[it * 4 + (lane >> 4)];
      val[it].x = (oc[it].x + xc[it].x * ds) * z[it].x;
      val[it].y = (oc[it].y + xc[it].y * ds) * z[it].y;
      val[it].z = (oc[it].z + xc[it].z * ds) * z[it].z;
      val[it].w = (oc[it].w + xc[it].w * ds) * z[it].w;
      ssq[it] = val[it].x * val[it].x + val[it].y * val[it].y + val[it].z * val[it].z + val[it].w * val[it].w;
    }
    float inv0 = rsqrtf(wsum_u_(ssq[0] + ssq[1]) * (1.0f / 512.0f) + 1e-6f);
    float inv1 = rsqrtf(wsum_u_(ssq[2] + ssq[3]) * (1.0f / 512.0f) + 1e-6f);
#pragma unroll
    for (int it = 0; it < 4; ++it) {
      int c = it * 256 + lane * 4;
      float inv = (it < 2) ? inv0 : inv1;
      float4 sg = ld4(sng + c);
      st_bf4(mo + c, val[it].x * inv * sg.x, val[it].y * inv * sg.y, val[it].z * inv * sg.z, val[it].w * inv * sg.w);
      float mu = red16(y[it].x + y[it].y + y[it].z + y[it].w) * (1.0f / 64.0f);
      float dx = y[it].x - mu, dy = y[it].y - mu, dz = y[it].z - mu, dw = y[it].w - mu;
      float var = red16(dx * dx + dy * dy + dz * dz + dw * dw) * (1.0f / 64.0f);
      float iv = rsqrtf(var + 64e-5f);
      float4 lg = ld4(lxg + c), lb = ld4(lxb + c);
      float y0 = (dx * iv * lg.x + lb.x + bn[it] * v[it].x) * gg[it].x;
      float y1 = (dy * iv * lg.y + lb.y + bn[it] * v[it].y) * gg[it].y;
      float y2 = (dz * iv * lg.z + lb.z + bn[it] * v[it].z) * gg[it].z;
      float y3 = (dw * iv * lg.w + lb.w + bn[it] * v[it].w) * gg[it].w;
      st_bf4(mo + 1024 + c, y0, y1, y2, y3);
    }
  }
}

#define XB_TMO      128
#define XB_XCNT(j)  (256  + 64 * (j))
#define XB_XSUB(j)  (1280 + 64 * (j))
#define XB_XGEN(j)  (2304 + 64 * (j))
#define XB_TOP      3328
#define XB_TOPGEN   3392
#define XCD_BAR_WORDS 3456
#define XB_SPIN_CAP (1u << 18)
#define LAS __attribute__((address_space(3)))

__device__ __forceinline__ unsigned xb_ld(unsigned* p)              { return __hip_atomic_load(p, __ATOMIC_RELAXED, __HIP_MEMORY_SCOPE_AGENT); }
__device__ __forceinline__ unsigned xb_add(unsigned* p, unsigned v) { return __hip_atomic_fetch_add(p, v, __ATOMIC_RELAXED, __HIP_MEMORY_SCOPE_AGENT); }
__device__ __forceinline__ unsigned xb_xcc_id() { return (unsigned)__builtin_amdgcn_s_getreg((3 << 11) | 20) & 0xFu; }
#define XB_SPIN(cond, bar) do { unsigned _sp = 0; while (cond) { __builtin_amdgcn_s_sleep(1); \
    if ((++_sp & 255u) == 0u) { if (xb_ld(&(bar)[XB_TMO])) break; if (_sp > XB_SPIN_CAP) { atomicAdd(&(bar)[XB_TMO], 1u); break; } } } } while (0)

struct XcdBarrier {
    unsigned* bar; unsigned x;
    volatile LAS unsigned* st;
};

__device__ __forceinline__ XcdBarrier xcd_barrier_post(unsigned* bar, volatile LAS unsigned* st) {
    XcdBarrier b; b.bar = bar; b.x = xb_xcc_id(); b.st = st;
    if (threadIdx.x == 0) (void)xb_add(&bar[XB_XCNT(b.x)], 1u);
    return b;
}
__device__ __forceinline__ void xcd_barrier_complete(unsigned* bar, unsigned x, unsigned& nloc, unsigned& nx) {
    const unsigned G = gridDim.x * gridDim.y * gridDim.z;
    unsigned sum, cnt, mine, sp = 0u;
    for (;;) {
        sum = 0u; cnt = 0u; mine = 0u;
#pragma unroll
        for (unsigned j = 0; j < 16; ++j) { const unsigned c = xb_ld(&bar[XB_XCNT(j)]); sum += c; cnt += (c > 0u) ? 1u : 0u; mine = (j == x) ? c : mine; }
        if (sum == G) break;
        __builtin_amdgcn_s_sleep(1);
        if ((++sp & 255u) == 0u) { if (xb_ld(&bar[XB_TMO])) break; if (sp > XB_SPIN_CAP) { atomicAdd(&bar[XB_TMO], 1u); break; } }
    }
    nloc = mine > 0u ? mine : 1u; nx = cnt > 0u ? cnt : 1u;
}

__device__ __forceinline__ void xcd_barrier(const XcdBarrier& b) {
    asm volatile("s_waitcnt vmcnt(0)" ::: "memory");
    __syncthreads();
    if (threadIdx.x == 0) {
        unsigned* bar = b.bar;
        __builtin_amdgcn_s_waitcnt(0);
        unsigned nloc = b.st[0], nx = b.st[1];
        if (nloc == 0u) { xcd_barrier_complete(bar, b.x, nloc, nx); b.st[0] = nloc; b.st[1] = nx; }
        const unsigned old = xb_add(&bar[XB_XSUB(b.x)], 1u);
        const unsigned gen = old / nloc;
        if (old + 1u == (gen + 1u) * nloc) {
            __builtin_amdgcn_fence(__ATOMIC_RELEASE, "agent");
            asm volatile("s_waitcnt vmcnt(0)" ::: "memory");
            const unsigned og = xb_add(&bar[XB_TOP], 1u);
            const unsigned tg = og / nx;
            if (og + 1u == (tg + 1u) * nx) xb_add(&bar[XB_TOPGEN], 1u);
            else XB_SPIN(xb_ld(&bar[XB_TOPGEN]) == tg, bar);
            __builtin_amdgcn_fence(__ATOMIC_ACQUIRE, "agent");
            xb_add(&bar[XB_XGEN(b.x)], 1u);
            asm volatile("s_waitcnt vmcnt(0)" ::: "memory");
        } else {
            XB_SPIN(xb_ld(&bar[XB_XGEN(b.x)]) == gen, bar);
            __builtin_amdgcn_fence(__ATOMIC_ACQUIRE, "agent");
            asm volatile("s_waitcnt vmcnt(0)" ::: "memory");
        }
    }
    __syncthreads();
}


template <int ph>
DEVI void run_phase(const Params& p, char* smem_raw) {
  float* smem = (float*)smem_raw;
  char* ws = p.ws;
  {
    switch (ph) {
      case 0:
        phase0(p, smem);
        conv_fp8_rows(p.in[I_PU], (unsigned char*)(ws + OFF_UB), (float*)(ws + OFF_USC));
        conv_fp8_rows(p.in[I_PV], (unsigned char*)(ws + OFF_VB), (float*)(ws + OFF_VSC));
        break;
      case 1: {
        float* PROJ = (float*)(ws + OFF_PROJ);
        const float* LB = (const float*)(ws + OFF_LB);
        const double* IR = (const double*)(ws + OFF_INVREV);
        gemm_phase((const u16*)(ws + OFF_XB), 2048, 0, (const u16*)(ws + OFF_WIN0), 2048, MP / 128, N0 / 128, smem_raw,
                   [=](int row, int col, float v0, float v1) {
                     float* pr = PROJ + (size_t)row * N0;
                     if (col < 1024 || (col >= 3072 && col < 4096) || col >= 6144) {
                       pr[col] = siluf_(v0);
                       pr[col + 32] = siluf_(v1);
                     } else if (col < 2048) {
                       float l0 = LB[col - 1024], l1 = LB[col - 1024 + 32];
                       pr[col] = l0 + (1.0f - l0) * sigmoidf_(v0);
                       pr[col + 32] = l1 + (1.0f - l1) * sigmoidf_(v1);
                     } else if (col >= 4096 && col < 5120) {
                       int hb = col & ~127, c = col & 127, span = c >> 6, pp = c & 63;
                       int d = span * 32 + pp;
                       double rev = (double)row_pos(row) * IR[d];
                       float fr = (float)(rev - floor(rev));
                       float sn = __builtin_amdgcn_sinf(fr), cs = __builtin_amdgcn_cosf(fr);
                       float sc = (col >= 4608) ? 0.08838834764831845f : 1.0f;
                       pr[hb + d] = (v0 * cs - v1 * sn) * sc;
                       pr[hb + 64 + d] = (v0 * sn + v1 * cs) * sc;
                     } else {
                       pr[col] = v0;
                       pr[col + 32] = v1;
                     }
                   });
      } break;
      case 2: phase_rec0(p, smem); break;
      case 3: phase_post0(p); break;
      case 4: case 15: {
        float* GO = (float*)(ws + OFF_GOUT);
        gemm_phase((const u16*)(ws + OFF_MIXB), 2048, 0, (const u16*)(ws + (ph == 4 ? OFF_WOUT0 : OFF_WOUT1)), 2048,
                   MP / 128, 16, smem_raw, [=](int row, int col, float v0, float v1) {
                     GO[(size_t)row * 2048 + col] = v0;
                     GO[(size_t)row * 2048 + col + 32] = v1;
                   });
      } break;
      case 5: case 16: {
        int l = (ph == 5) ? 0 : 1;
        phase_ln(p, (const float*)(ws + OFF_GOUT), p.in[I_LNG] + (size_t)(l * 2) * D, p.in[I_LNB] + (size_t)(l * 2) * D);
      } break;
      case 6: case 17: {
        u16* QB = (u16*)(ws + OFF_QB);
        gemm_phase((const u16*)(ws + OFF_XB), 2048, 0, (const u16*)(ws + (ph == 6 ? OFF_WQ0 : OFF_WQ1)), 2048, MP / 128,
                   16, smem_raw, [=](int row, int col, float v0, float v1) {
                     QB[(size_t)row * 2048 + col] = f2bf(v0);
                     QB[(size_t)row * 2048 + col + 32] = f2bf(v1);
                   });
      } break;
      case 7: case 18: {
        float* SC = (float*)(ws + OFF_GOUT);
        gemm_phase((const u16*)(ws + OFF_QB), 2048, 128, (const u16*)(ws + (ph == 7 ? OFF_KEY0 : OFF_KEY1)), 128,
                   MP / 128, 16, smem_raw, [=](int row, int col, float v0, float v1) {
                     SC[(size_t)row * 2048 + col] = v0;
                     SC[(size_t)row * 2048 + col + 32] = v1;
                   });
      } break;
      case 8: phase_peer(p, 0, false); break;
      case 9: {
        conv_fp8_rows(p.in[I_PU] + (size_t)16384 * 2048, (unsigned char*)(ws + OFF_UB), (float*)(ws + OFF_USC));
        conv_fp8_rows(p.in[I_PV] + (size_t)16384 * 2048, (unsigned char*)(ws + OFF_VB), (float*)(ws + OFF_VSC));
        float* PROJ = (float*)(ws + OFF_PROJ);
        float* DTA = (float*)(ws + OFF_DTA);
        const float* dtb = p.in[I_DTB];
        const float* alog = p.in[I_ALOG];
        gemm_phase((const u16*)(ws + OFF_XB), 2048, 0, (const u16*)(ws + OFF_WIN1), 2048, MP / 128, N1 / 128, smem_raw,
                   [=](int row, int col, float v0, float v1) {
                     float* pr = PROJ + (size_t)row * N1;
                     if (col < 1024) {
                       pr[col] = siluf_(v0);
                       pr[col + 32] = siluf_(v1);
                     } else if (col < 5888) {
                       pr[col] = v0;
                       pr[col + 32] = v1;
                     } else {
#pragma unroll
                       for (int e = 0; e < 2; ++e) {
                         int cc = col + e * 32;
                         float v = e ? v1 : v0;
                         if (cc < 5920) pr[cc] = v;
                         else if (cc < 5936) {
                           int h = cc - 5920;
                           float dt = softplusf_(v + dtb[h]);
                           DTA[(size_t)row * 64 + h * 4] = dt;
                           DTA[(size_t)row * 64 + h * 4 + 1] = expf(-dt * expf(alog[h]));
                         }
                       }
                     }
                   });
      } break;
      case 10: phase_pre1(p); break;
      case 11: {
        float* DEC = (float*)(ws + OFF_DEC);
        float* AA = (float*)(ws + OFF_AA);
        float* GG = (float*)(ws + OFF_GG);
        const float* w0 = p.in[I_W0];
        const float* a0 = p.in[I_A0];
        gemm_phase((const u16*)(ws + OFF_LRA), 64, 0, (const u16*)(ws + OFF_W2T), 64, MP / 128, 8, smem_raw,
                   [=](int row, int col, float v0, float v1) {
#pragma unroll
                     for (int e = 0; e < 2; ++e) {
                       int cc = col + e * 32;
                       float v = (e ? v1 : v0) + w0[cc];
                       float wl = -softplusf_(-v) - 0.5f;
                       DEC[(size_t)row * 1024 + cc] = expf(-expf(wl));
                     }
                   });
        gemm_phase((const u16*)(ws + OFF_LRB), 64, 0, (const u16*)(ws + OFF_A2T), 64, MP / 128, 8, smem_raw,
                   [=](int row, int col, float v0, float v1) {
                     AA[(size_t)row * 1024 + col] = sigmoidf_(v0 + a0[col]);
                     AA[(size_t)row * 1024 + col + 32] = sigmoidf_(v1 + a0[col + 32]);
                   });
        gemm_phase((const u16*)(ws + OFF_LRG), 192, 0, (const u16*)(ws + OFF_G2T), 192, MP / 128, 8, smem_raw,
                   [=](int row, int col, float v0, float v1) {
                     GG[(size_t)row * 1024 + col] = v0;
                     GG[(size_t)row * 1024 + col + 32] = v1;
                   });
      } break;
      case 12: phase_pre1c(p); break;
      case 13: phase_rec1(p, smem); break;
      case 14: phase_post1(p); break;
      case 19: phase_peer(p, 1, true); break;
      default: break;
    }
  }
}

__global__ void __launch_bounds__(256, 2) mega(Params p, int ph_lo, int ph_hi) {
  __shared__ __attribute__((aligned(16))) char smem_raw[SMEM_BYTES];
  __shared__ uint4 xb_words;
  cg::grid_group grid = cg::this_grid();
  if (threadIdx.x == 0) xb_words = make_uint4(0u, 0u, 0u, 0u);
  __syncthreads();
  XcdBarrier xb = xcd_barrier_post((unsigned*)(p.ws + OFF_BAR), (volatile LAS unsigned*)&xb_words);
  if (ph_hi > 1000) grid.sync();
#ifndef REPEAT_MASK
#define REPEAT_MASK 0
#endif
#define PHASE(K)                                          \
  if (ph_lo <= K && K < ph_hi) run_phase<K>(p, smem_raw); \
  if ((REPEAT_MASK >> K) & 1) { xcd_barrier(xb); run_phase<K>(p, smem_raw); } \
  if (ph_lo <= K && K + 1 < ph_hi) xcd_barrier(xb);
  PHASE(0) PHASE(1) PHASE(2) PHASE(3) PHASE(4) PHASE(5) PHASE(6) PHASE(7) PHASE(8) PHASE(9)
  PHASE(10) PHASE(11) PHASE(12) PHASE(13) PHASE(14) PHASE(15) PHASE(16) PHASE(17) PHASE(18) PHASE(19)
}
#ifdef PHASE_TEST
template <int PH>
__global__ void __launch_bounds__(256, 2) phk(Params p) {
  __shared__ __attribute__((aligned(16))) char smem_raw[SMEM_BYTES];
  run_phase<PH>(p, smem_raw);
}
#define INST(N) template __global__ void phk<N>(Params);
INST(0) INST(1) INST(2) INST(3) INST(4) INST(5) INST(6) INST(7) INST(8) INST(9) INST(10) INST(11) INST(12) INST(13) INST(14) INST(19)
#endif

constexpr int NPHASE = 20;

extern "C" void kernel_launch(void* const* d_in, const int* in_sizes, int n_in, void* d_out, int out_size, void* d_ws,
                              size_t ws_size, hipStream_t stream) {
  static int grid_blocks = 0;
  if (!grid_blocks) {
    int dev = 0, cus = 0, per_cu = 0;
    hipGetDevice(&dev);
    hipDeviceGetAttribute(&cus, hipDeviceAttributeMultiprocessorCount, dev);
    hipOccupancyMaxActiveBlocksPerMultiprocessor(&per_cu, mega, 256, 0);
    if (per_cu > 2) per_cu = 2;
    if (per_cu < 1) per_cu = 1;
    grid_blocks = cus * per_cu;
  }
  Params p{};
  for (int i = 0; i < 38; ++i) p.in[i] = (const float*)d_in[i];
  p.out = (float*)d_out;
  p.ws = (char*)d_ws;
  (void)hipMemsetAsync((char*)d_ws + OFF_BAR, 0, 3456 * 4, stream);
  int lo = 0, hi = NPHASE;
  void* args[] = {&p, &lo, &hi};
  hipError_t e = hipLaunchCooperativeKernel((void*)mega, dim3(grid_blocks), dim3(256), args, 0, stream);
  if (e != hipSuccess) fprintf(stderr, "cooperative launch failed: %s (grid %d)\n", hipGetErrorString(e), grid_blocks);
}
```

```cpp
#include <hip/hip_runtime.h>
#include <hip/hip_bf16.h>
#include <hip/hip_cooperative_groups.h>
#include <cstdio>
#include <cmath>
namespace cg = cooperative_groups;

#define DEVI __device__ __forceinline__
typedef unsigned short u16;
using bf16x8 = __attribute__((ext_vector_type(8))) short;
using f32x4 = __attribute__((ext_vector_type(4))) float;
using u32x4 = __attribute__((ext_vector_type(4))) unsigned int;

constexpr int D = 2048;
constexpr int TP = 2064;
constexpr int MPR = 8256;
constexpr int M = 8768;
constexpr int MP = 8960;
constexpr int N0 = 7168;
constexpr int N1 = 6144;
constexpr float ALPHA = 1.41421356237f;

constexpr size_t SZ_TAB = (size_t)16384 * 2048 * 2;
constexpr size_t OFF_UB = 0;
constexpr size_t OFF_VB = OFF_UB + SZ_TAB;
constexpr size_t OFF_WIN0 = OFF_VB + SZ_TAB;
constexpr size_t OFF_WOUT0 = OFF_WIN0 + (size_t)N0 * 2048 * 2;
constexpr size_t OFF_WQ0 = OFF_WOUT0 + (size_t)2048 * 2048 * 2;
constexpr size_t OFF_KEY0 = OFF_WQ0 + (size_t)2048 * 2048 * 2;
constexpr size_t OFF_WIN1 = OFF_KEY0 + (size_t)16 * 128 * 128 * 2;
constexpr size_t OFF_WOUT1 = OFF_WIN1 + (size_t)N1 * 2048 * 2;
constexpr size_t OFF_WQ1 = OFF_WOUT1 + (size_t)2048 * 2048 * 2;
constexpr size_t OFF_KEY1 = OFF_WQ1 + (size_t)2048 * 2048 * 2;
constexpr size_t OFF_W2T = OFF_KEY1 + (size_t)16 * 128 * 128 * 2;
constexpr size_t OFF_A2T = OFF_W2T + (size_t)1024 * 64 * 2;
constexpr size_t OFF_G2T = OFF_A2T + (size_t)1024 * 64 * 2;
constexpr size_t OFF_LB = OFF_G2T + (size_t)1024 * 192 * 2;
constexpr size_t OFF_INVREV = OFF_LB + 1024 * 4;
constexpr size_t OFF_XF = OFF_INVREV + 64 * 8;
constexpr size_t OFF_XB = OFF_XF + (size_t)MP * 2048 * 4;
constexpr size_t OFF_PROJ = OFF_XB + (size_t)MP * 2048 * 2;
constexpr size_t OFF_GOUT = OFF_PROJ + (size_t)MP * N0 * 4;
constexpr size_t OFF_OMIX = OFF_GOUT + (size_t)MP * 2048 * 4;
constexpr size_t OFF_MIXB = OFF_OMIX + (size_t)MP * 2048 * 4;
constexpr size_t OFF_QB = OFF_MIXB + (size_t)MP * 2048 * 2;
constexpr size_t OFF_RKV = OFF_QB + (size_t)MP * 2048 * 2;
constexpr size_t OFF_DEC = OFF_RKV + (size_t)MP * 3072 * 4;
constexpr size_t OFF_AA = OFF_DEC + (size_t)MP * 1024 * 4;
constexpr size_t OFF_GG = OFF_AA + (size_t)MP * 1024 * 4;
constexpr size_t OFF_LRA = OFF_GG + (size_t)MP * 1024 * 4;
constexpr size_t OFF_LRB = OFF_LRA + (size_t)MP * 64 * 2;
constexpr size_t OFF_LRG = OFF_LRB + (size_t)MP * 64 * 2;
constexpr size_t OFF_DTA = OFF_LRG + (size_t)MP * 192 * 2;
constexpr size_t OFF_BON = OFF_DTA + (size_t)MP * 64 * 4;
constexpr size_t OFF_USC = OFF_BON + (size_t)MP * 16 * 4;
constexpr size_t OFF_VSC = OFF_USC + 16384 * 4;
constexpr size_t OFF_BAR = OFF_VSC + 16384 * 4;
constexpr size_t WS_TOTAL = OFF_BAR + 3456 * 4;
static_assert(WS_TOTAL <= (size_t)1 << 30, "workspace too large");

constexpr size_t O_YP = 0;
constexpr size_t O_YS = O_YP + (size_t)4 * 2048 * 2048;
constexpr size_t O_HGP = O_YS + (size_t)128 * 4 * 2048;
constexpr size_t O_HGS = O_HGP + (size_t)4 * 8 * 128 * 128;
constexpr size_t O_RTP = O_HGS + (size_t)128 * 8 * 128 * 128;
constexpr size_t O_RTS = O_RTP + (size_t)4 * 4 * 128 * 256;
constexpr size_t O_SSP = O_RTS + (size_t)128 * 4 * 128 * 256;
constexpr size_t O_SSS = O_SSP + (size_t)4 * 16 * 128 * 64;
constexpr size_t O_CVP = O_SSS + (size_t)128 * 16 * 128 * 64;
constexpr size_t O_CVS = O_CVP + (size_t)4 * 3 * 1536;
constexpr size_t O_WKP = O_CVS + (size_t)128 * 3 * 1536;
constexpr size_t O_WKS = O_WKP + (size_t)4 * 16 * 64 * 64;
constexpr size_t O_SHP = O_WKS + (size_t)128 * 16 * 64 * 64;
constexpr size_t O_SHS = O_SHP + (size_t)4 * 3360;

struct Params {
  const float* in[38];
  float* out;
  char* ws;
};
enum { I_XP = 0, I_XS, I_SHG, I_SRT, I_SSM, I_SCV, I_SWK, I_SSH, I_META, I_LNG, I_LNB, I_EWIN, I_LBL, I_HNG, I_EWOUT,
       I_OWIN, I_CVW, I_CVB, I_DTB, I_ALOG, I_DSK, I_SNG, I_MU, I_W0, I_W2, I_A0, I_A2, I_G2, I_KK, I_KA, I_RK,
       I_LXG, I_LXB, I_OWOUT, I_WQ, I_KEYS, I_PU, I_PV };

constexpr int VB_BYTES = 2 * 2 * 128 * 72 * 2;
constexpr int SMEM_BYTES = 2 * VB_BYTES;

DEVI u16 f2bf(float f) {
  unsigned u = __float_as_uint(f);
  u += 0x7fffu + ((u >> 16) & 1u);
  return (u16)(u >> 16);
}
DEVI unsigned pack2(float a, float b) { return (unsigned)f2bf(a) | ((unsigned)f2bf(b) << 16); }
DEVI float bflo(unsigned u) { return __uint_as_float(u << 16); }
DEVI float bfhi(unsigned u) { return __uint_as_float(u & 0xffff0000u); }
DEVI float sigmoidf_(float x) { return __builtin_amdgcn_rcpf(1.0f + __builtin_amdgcn_exp2f(-1.44269504089f * x)); }
DEVI float siluf_(float x) { return x * __builtin_amdgcn_rcpf(1.0f + __builtin_amdgcn_exp2f(-1.44269504089f * x)); }
DEVI float sigmoid_acc(float x) { return 1.0f / (1.0f + expf(-x)); }
DEVI float silu_acc(float x) { return x / (1.0f + expf(-x)); }
DEVI float softplusf_(float x) { return fmaxf(x, 0.0f) + log1pf(expf(-fabsf(x))); }
DEVI float wsum(float v) {
#pragma unroll
  for (int o = 32; o > 0; o >>= 1) v += __shfl_xor(v, o, 64);
  return v;
}
DEVI float wmaxf_(float v) {
#pragma unroll
  for (int o = 32; o > 0; o >>= 1) v = fmaxf(v, __shfl_xor(v, o, 64));
  return v;
}
DEVI int wmini_(int v) {
#pragma unroll
  for (int o = 32; o > 0; o >>= 1) v = min(v, __shfl_xor(v, o, 64));
  return v;
}
template <int CTRL>
DEVI float dppf(float v) {
  return __int_as_float(__builtin_amdgcn_update_dpp(0, __float_as_int(v), CTRL, 0xF, 0xF, true));
}
DEVI float red8(float v) {
  v += dppf<0xB1>(v);
  v += dppf<0x4E>(v);
  v += dppf<0x141>(v);
  return v;
}
DEVI float red16(float v) {
  v = red8(v);
  v += dppf<0x140>(v);
  return v;
}
DEVI float rlf_(float v, int l) { return __int_as_float(__builtin_amdgcn_readlane(__float_as_int(v), l)); }
DEVI int row_pos(int row) { return row < MPR ? (row % TP) : (16384 + ((row - MPR) & 3)); }

DEVI void conv_bf16_flat(const float* __restrict__ src, u16* __restrict__ dst, size_t n4) {
  size_t stride = (size_t)gridDim.x * blockDim.x;
  for (size_t i = (size_t)blockIdx.x * blockDim.x + threadIdx.x; i < n4; i += stride) {
    float4 v = ((const float4*)src)[i];
    uint2 o;
    o.x = pack2(v.x, v.y);
    o.y = pack2(v.z, v.w);
    ((uint2*)dst)[i] = o;
  }
}

template <int MODE>
DEVI int colmap(int j) {
  if (MODE == 0) return j;
  if (MODE == 1) {
    if (j < 4096 || j >= 5120) return j;
    int hb = j & ~127, c = j & 127, wc = c >> 5, n = (c >> 4) & 1, r = c & 15;
    int d = n ? (64 + wc * 16 + r) : (wc * 16 + r);
    return hb + d;
  }
  if (j < 2560) return j;
  if (j < 5920) return j + 16;
  if (j < 5936) return 2560 + (j - 5920);
  return -1;
}

template <int MODE>
DEVI void transpose_job(const float* __restrict__ src, int ldsrc, int Ksrc, u16* __restrict__ dst, int Kdst, int ndst,
                        float* smem) {
  int ktiles = Kdst / 64, ntiles = ndst / 64;
  int tid = threadIdx.x & 255;
  const int half = threadIdx.x >> 8;
  smem += half * (64 * 65);
  for (int base = blockIdx.x * 2; base < ktiles * ntiles; base += gridDim.x * 2) {
    int tile = base + half;
    const bool valid = tile < ktiles * ntiles;
    if (!valid) tile = ktiles * ntiles - 1;
    int tn = tile / ktiles, tk = tile % ktiles;
    int j0 = tn * 64, k0 = tk * 64;
    int jj = tid & 63;
    int sc = colmap<MODE>(j0 + jj);
#pragma unroll
    for (int i = 0; i < 16; ++i) {
      int kk = i * 4 + (tid >> 6);
      float v = 0.f;
      if (sc >= 0 && (k0 + kk) < Ksrc) v = src[(size_t)(k0 + kk) * ldsrc + sc];
      smem[kk * 65 + jj] = v;
    }
    __syncthreads();
    int jr = tid >> 2, kq = (tid & 3) * 16;
    unsigned pk[8];
#pragma unroll
    for (int e = 0; e < 8; ++e) pk[e] = pack2(smem[(kq + 2 * e) * 65 + jr], smem[(kq + 2 * e + 1) * 65 + jr]);
    uint4* dp = (uint4*)(dst + (size_t)(j0 + jr) * Kdst + k0 + kq);
    if (valid) {
      dp[0] = make_uint4(pk[0], pk[1], pk[2], pk[3]);
      dp[1] = make_uint4(pk[4], pk[5], pk[6], pk[7]);
    }
    __syncthreads();
  }
}

DEVI void phase0(const Params& p, float* smem) {
  char* ws = p.ws;
  conv_bf16_flat(p.in[I_KEYS], (u16*)(ws + OFF_KEY0), (size_t)16 * 128 * 128 / 4);
  conv_bf16_flat(p.in[I_KEYS] + (size_t)16 * 128 * 128, (u16*)(ws + OFF_KEY1), (size_t)16 * 128 * 128 / 4);
  transpose_job<1>(p.in[I_EWIN], N0, 2048, (u16*)(ws + OFF_WIN0), 2048, N0, smem);
  transpose_job<0>(p.in[I_EWOUT], 2048, 2048, (u16*)(ws + OFF_WOUT0), 2048, 2048, smem);
  transpose_job<0>(p.in[I_WQ], 2048, 2048, (u16*)(ws + OFF_WQ0), 2048, 2048, smem);
  transpose_job<0>(p.in[I_WQ] + (size_t)2048 * 2048, 2048, 2048, (u16*)(ws + OFF_WQ1), 2048, 2048, smem);
  transpose_job<2>(p.in[I_OWIN], 5936, 2048, (u16*)(ws + OFF_WIN1), 2048, N1, smem);
  transpose_job<0>(p.in[I_OWOUT], 2048, 2048, (u16*)(ws + OFF_WOUT1), 2048, 2048, smem);
  transpose_job<0>(p.in[I_W2], 1024, 64, (u16*)(ws + OFF_W2T), 64, 1024, smem);
  transpose_job<0>(p.in[I_A2], 1024, 64, (u16*)(ws + OFF_A2T), 64, 1024, smem);
  transpose_job<0>(p.in[I_G2], 1024, 160, (u16*)(ws + OFF_G2T), 192, 1024, smem);
  {
    float* XF = (float*)(ws + OFF_XF);
    u16* XB = (u16*)(ws + OFF_XB);
    size_t n4 = (size_t)MP * 512;
    size_t stride = (size_t)gridDim.x * blockDim.x;
    for (size_t i = (size_t)blockIdx.x * blockDim.x + threadIdx.x; i < n4; i += stride) {
      int row = (int)(i >> 9), c4 = (int)(i & 511);
      float4 v = make_float4(0.f, 0.f, 0.f, 0.f);
      if (row < MPR) {
        int b = row / TP, t = row % TP;
        const float* s = (t < 16) ? (p.in[I_META] + (size_t)t * D) : (p.in[I_XP] + ((size_t)b * 2048 + (t - 16)) * D);
        v = ((const float4*)s)[c4];
      } else if (row < M) {
        v = ((const float4*)(p.in[I_XS] + (size_t)(row - MPR) * D))[c4];
      }
      ((float4*)XF)[i] = v;
      uint2 o;
      o.x = pack2(v.x, v.y);
      o.y = pack2(v.z, v.w);
      ((uint2*)XB)[i] = o;
    }
  }
  if (blockIdx.x == 0) {
    float* LB = (float*)(ws + OFF_LB);
    const float* lg = p.in[I_LBL];
    for (int c = threadIdx.x; c < 1024; c += blockDim.x) {
      float a = lg[c], b = lg[1024 + c], d = lg[2048 + c];
      float m = fmaxf(a, fmaxf(b, d));
      float ea = expf(a - m), eb = expf(b - m), ed = expf(d - m);
      LB[c] = ea / (ea + eb + ed);
    }
    float* IR = (float*)(ws + OFF_INVREV);
    if (threadIdx.x < 64) {
      double d = (double)threadIdx.x;
      double v = exp(-d * (9.210340371976184 / 64.0)) * 0.15915494309189535;
      float h = (float)v;
      IR[threadIdx.x * 2] = h;
      IR[threadIdx.x * 2 + 1] = (float)(v - (double)h);
    }
  }
}

constexpr int G_LDS_STRIDE = 72;
constexpr int G_LDS_BUF = 2 * 128 * G_LDS_STRIDE;
template <class Epi>
DEVI void gemm_phase(const u16* __restrict__ A, int lda, int a_ntile_off, const u16* __restrict__ Bt, int K, int mtiles,
                     int ntiles, char* smem, Epi epi, const float* __restrict__ colc = nullptr) {
  const int half = threadIdx.x >> 8;
  u16* S0 = (u16*)(smem + half * VB_BYTES);
  const int tid = threadIdx.x & 255, wid = tid >> 6, lane = tid & 63, wr = wid >> 1, wc = wid & 1, fr = lane & 15, fq = lane >> 4;
  const int nk = K / 64;
  const int ntot = mtiles * ntiles;
  for (int base = blockIdx.x * 2; base < ntot; base += gridDim.x * 2) {
    int tile = base + half;
    const bool valid = tile < ntot;
    if (!valid) tile = ntot - 1;
    const int tm = tile / ntiles, tn = tile - tm * ntiles;
    const int brow = tm * 128, bcol = tn * 128;
    const u16* Ag = A + (size_t)brow * lda + (size_t)tn * a_ntile_off;
    const u16* Bg = Bt + (size_t)bcol * K;
    f32x4 acc[4][4];
#pragma unroll
    for (int m = 0; m < 4; ++m)
#pragma unroll
      for (int n = 0; n < 4; ++n) acc[m][n] = f32x4{0.f, 0.f, 0.f, 0.f};
    u32x4 ra0[4], rb0[4], ra1[4], rb1[4];
    auto gload = [&](int t, u32x4(&ra)[4], u32x4(&rb)[4]) {
#pragma unroll
      for (int i = 0; i < 4; ++i) {
        int c = tid + i * 256, r = c >> 3, kc = c & 7;
        ra[i] = *(const u32x4*)(Ag + (size_t)r * lda + t * 64 + kc * 8);
        rb[i] = *(const u32x4*)(Bg + (size_t)r * K + t * 64 + kc * 8);
      }
    };
    auto lwrite = [&](int buf, const u32x4(&ra)[4], const u32x4(&rb)[4]) {
      u16* SA = S0 + buf * G_LDS_BUF;
      u16* SB = SA + 128 * G_LDS_STRIDE;
#pragma unroll
      for (int i = 0; i < 4; ++i) {
        int c = tid + i * 256, r = c >> 3, kc = c & 7;
        *(u32x4*)(SA + r * G_LDS_STRIDE + kc * 8) = ra[i];
        *(u32x4*)(SB + r * G_LDS_STRIDE + kc * 8) = rb[i];
      }
    };
    auto compute = [&](int buf) {
      const u16* SA = S0 + buf * G_LDS_BUF;
      const u16* SB = SA + 128 * G_LDS_STRIDE;
#pragma unroll
      for (int kh = 0; kh < 2; ++kh) {
        bf16x8 At[4], Bl[4];
#pragma unroll
        for (int m = 0; m < 4; ++m)
          At[m] = *(const bf16x8*)(SA + (wr * 64 + m * 16 + fr) * G_LDS_STRIDE + kh * 32 + fq * 8);
#pragma unroll
        for (int n = 0; n < 4; ++n)
          Bl[n] = *(const bf16x8*)(SB + (wc * 64 + n * 16 + fr) * G_LDS_STRIDE + kh * 32 + fq * 8);
#pragma unroll
        for (int m = 0; m < 4; ++m)
#pragma unroll
          for (int n = 0; n < 4; ++n) acc[m][n] = __builtin_amdgcn_mfma_f32_16x16x32_bf16(At[m], Bl[n], acc[m][n], 0, 0, 0);
        __builtin_amdgcn_sched_barrier(0);
      }
    };
    gload(0, ra0, rb0);
    if (nk > 1) gload(1, ra1, rb1);
    lwrite(0, ra0, rb0);
    __syncthreads();
#pragma unroll 1
    for (int t = 0; t < nk; t += 2) {
      if (t + 2 < nk) gload(t + 2, ra0, rb0);
      compute(0);
      if (t + 1 < nk) lwrite(1, ra1, rb1);
      __syncthreads();
      if (t + 1 < nk) {
        if (t + 3 < nk) gload(t + 3, ra1, rb1);
        compute(1);
        if (t + 2 < nk) lwrite(0, ra0, rb0);
        __syncthreads();
      }
    }
    if (valid) {
      float cc[4] = {0.f, 0.f, 0.f, 0.f};
      if (colc) {
#pragma unroll
        for (int n = 0; n < 4; ++n) cc[n] = colc[bcol + wc * 64 + n * 16 + fr];
      }
#pragma unroll
      for (int m = 0; m < 4; ++m)
#pragma unroll
        for (int n = 0; n < 2; ++n)
#pragma unroll
          for (int j = 0; j < 4; ++j) {
            int row = brow + wr * 64 + m * 16 + fq * 4 + j;
            int col = bcol + wc * 64 + n * 16 + fr;
            epi(row, col, acc[m][n][j] + cc[n], acc[m][n + 2][j] + cc[n + 2]);
          }
    }
  }
}


namespace pg8 {
#define PG8_LAS __attribute__((address_space(3)))
typedef unsigned short bf16_t;
typedef short bf16x8 __attribute__((ext_vector_type(8)));
typedef float f32x4 __attribute__((ext_vector_type(4)));
typedef unsigned u32x4 __attribute__((ext_vector_type(4)));
constexpr int BM = 256, BK = 64, HALF = 128, HTB = HALF * BK * 2  , STAGE_BYTES = 8 * HTB, NXCD = 8, WGM = 8;

__host__ __device__ __forceinline__ int lds_byte(int r, int c) { const int st = (r >> 4) * 2 + (c >> 5), rr = r & 15, cc = c & 31, ob = rr * 64 + cc * 2; return st * 1024 + (ob ^ (((ob >> 9) & 1) << 5)); }
__host__ __device__ __forceinline__ void stage_rc(int b, int& R, int& C) { const int st = b / 1024, sb = b % 1024, swz = sb ^ (((sb >> 9) & 1) << 5); R = (st >> 1) * 16 + swz / 64; C = (st & 1) * 32 + (swz % 64) / 2; }
__host__ __device__ __forceinline__ int perm32(int rho) { const int n = rho >> 4, i = rho & 15; return 8 * (i >> 2) + 4 * n + (i & 3); }

struct Unit { int pm, pn; };
struct Gemm { const bf16_t* A; const bf16_t* Bt; int M, N, K; };

struct StaticOrder {
    int nM, nN, nwg, G, c;
    __host__ __device__ void init(int M, int N, int G_, int c_) { nM = M / BM; nN = N / BM; nwg = nM * nN; G = G_; c = c_; }
    __host__ __device__ bool next(int i, Unit& u) const {
        const long L = (long)i * G + c; if (L >= nwg) return false;
        int wgid = (int)L; { const int q = nwg / NXCD, r = nwg % NXCD, xcd = wgid % NXCD, off = wgid / NXCD; wgid = (xcd < r ? xcd * (q + 1) : r * (q + 1) + (xcd - r) * q) + off; }
        const int nig = WGM * nN, gid = wgid / nig, fm = gid * WGM, gsz = (nM - fm) < WGM ? (nM - fm) : WGM;
        u.pm = fm + ((wgid % nig) % gsz); u.pn = (wgid % nig) / gsz; return true;
    }
    __device__ __forceinline__ void a_ready(const Unit&) const {}
    __device__ __forceinline__ void done(const Unit&) const {}
};
template <class Epi, class Sched, bool STAMP = false>
__device__ __forceinline__ void gemm_phase(PG8_LAS unsigned char* lds, const Gemm g, const Sched& S, const Epi& E, unsigned long long* stamps) {
    const int tid = threadIdx.x, wid = __builtin_amdgcn_readfirstlane(tid >> 6), lane = tid & 63, wr = wid >> 2, wc = wid & 3, fr = lane & 15, fq = lane >> 4;
    const int K = g.K, nt = K / BK;
    int ts_lo = 0, ts_hi = 0, nts = 0; const unsigned long long rt_entry = STAMP ? (unsigned long long)wall_clock64() : 0ull;
#define PG8_STAMP() do { if (STAMP && wid == 0 && nts < 64) { const unsigned long long _c = (unsigned long long)clock64(); \
        ts_lo = (lane == nts) ? (int)(unsigned)_c : ts_lo; ts_hi = (lane == nts) ? (int)(unsigned)(_c >> 32) : ts_hi; ++nts; } } while (0)
    PG8_STAMP();
    unsigned voffA[2], voffB[2];
#pragma unroll
    for (int i = 0; i < 2; ++i) { int R, C; stage_rc(tid * 16 + i * 8192, R, C); const int Rb = Epi::PERM ? ((R & ~31) + perm32(R & 31)) : R;
        voffA[i] = (unsigned)(R * K + C) * 2u; voffB[i] = (unsigned)(Rb * K + C) * 2u; }
    const size_t kstep = (size_t)(BK * 2);
    const size_t hstep = (size_t)HALF * K * 2;
    const size_t tstep = 2 * hstep;
    const unsigned ldsw = (unsigned)wid * 1024u;
    const int aoff = lds_byte(wr * 64 + fr, fq * 8), boff = lds_byte(wc * 32 + fr, fq * 8);
#define PG8_SA(b, h) (((b) * 2 + (h)) * HTB)
#define PG8_SB(b, h) ((4 + (b) * 2 + (h)) * HTB)
#define PG8_STAGE(bufoff, gbase, voff) do { _Pragma("unroll") for (int _i = 0; _i < 2; ++_i) \
        __builtin_amdgcn_global_load_lds((const unsigned*)((const char*)(gbase) + (voff)[_i]), (PG8_LAS unsigned*)(lds + (bufoff) + ldsw + _i * 8192), 16, 0, 0); } while (0)
#define PG8_LDA(dst, b, h) do { _Pragma("unroll") for (int m = 0; m < 4; ++m) _Pragma("unroll") for (int k = 0; k < 2; ++k) dst[m][k] = *(const PG8_LAS bf16x8*)(lds + PG8_SA(b, h) + aoff + m * 2048 + k * 1024); } while (0)
#define PG8_LDB(dst, b, h) do { _Pragma("unroll") for (int n = 0; n < 2; ++n) _Pragma("unroll") for (int k = 0; k < 2; ++k) dst[n][k] = *(const PG8_LAS bf16x8*)(lds + PG8_SB(b, h) + boff + n * 2048 + k * 1024); } while (0)
#define PG8_MMA(ai, bj, At, Bt) do { __builtin_amdgcn_s_setprio(1); _Pragma("unroll") for (int m = 0; m < 4; ++m) _Pragma("unroll") for (int n = 0; n < 2; ++n) _Pragma("unroll") for (int k = 0; k < 2; ++k) \
        acc[ai][bj][m][n] = __builtin_amdgcn_mfma_f32_16x16x32_bf16(Bt[n][k], At[m][k], acc[ai][bj][m][n], 0, 0, 0); __builtin_amdgcn_s_setprio(0); } while (0)
#define PG8_WAIT_V(n) asm volatile("s_waitcnt vmcnt(" #n ")" ::: "memory")
#define PG8_WAIT_L(n) asm volatile("s_waitcnt lgkmcnt(" #n ")" ::: "memory")
#define PG8_BAR __builtin_amdgcn_s_barrier()
#define PG8_SCHED __builtin_amdgcn_sched_barrier(0)
    Unit cur, nxt; int ui = 0;
    if (!S.next(0, cur)) return;
    f32x4 acc[2][2][4][2];
#pragma unroll
    for (int a = 0; a < 2; ++a)
#pragma unroll
        for (int b = 0; b < 2; ++b)
#pragma unroll
            for (int m = 0; m < 4; ++m)
#pragma unroll
                for (int n = 0; n < 2; ++n) acc[a][b][m][n] = (f32x4){0.f, 0.f, 0.f, 0.f};
    bf16x8 At[4][2], B0[2][2], B1[2][2];
    const char* cA = (const char*)g.A + (size_t)cur.pm * tstep; const char* cB = (const char*)g.Bt + (size_t)cur.pn * tstep;
    S.a_ready(cur);
    PG8_STAGE(PG8_SB(0, 0), cB, voffB); PG8_STAGE(PG8_SA(0, 0), cA, voffA); PG8_STAGE(PG8_SB(0, 1), cB + hstep, voffB); PG8_STAGE(PG8_SA(0, 1), cA + hstep, voffA);
    if (wr == 1) PG8_BAR;
    PG8_WAIT_V(4); PG8_BAR;
    PG8_STAGE(PG8_SB(1, 0), cB + kstep, voffB); PG8_STAGE(PG8_SA(1, 0), cA + kstep, voffA); PG8_STAGE(PG8_SB(1, 1), cB + hstep + kstep, voffB);
    PG8_WAIT_V(6); PG8_BAR;
    PG8_STAMP();
    for (;;) {
        const bool has_next = S.next(ui + 1, nxt);
        const char* nA = has_next ? (const char*)g.A + (size_t)nxt.pm * tstep : cA; const char* nB = has_next ? (const char*)g.Bt + (size_t)nxt.pn * tstep : cB;
        for (int t = 0; t < nt; t += 2) {
            const bool last = (t == nt - 2);
            const char* a1 = cA + (size_t)(t + 1) * kstep;
            const char* a2 = last ? nA : cA + (size_t)(t + 2) * kstep; const char* b2 = last ? nB : cB + (size_t)(t + 2) * kstep;
            const char* a3 = a2 + kstep; const char* b3 = b2 + kstep;
            if (last && has_next) S.a_ready(nxt);
            PG8_LDB(B0, 0, 0); PG8_SCHED; PG8_LDA(At, 0, 0); PG8_STAGE(PG8_SA(1, 1), a1 + hstep, voffA);
            PG8_WAIT_L(8); PG8_BAR; PG8_WAIT_L(0); PG8_MMA(0, 0, At, B0); PG8_BAR; PG8_SCHED;
            PG8_LDB(B1, 0, 1); PG8_STAGE(PG8_SB(0, 0), b2, voffB);
            PG8_BAR; PG8_WAIT_L(0); PG8_MMA(0, 1, At, B1); PG8_BAR;
            PG8_LDA(At, 0, 1); PG8_STAGE(PG8_SA(0, 0), a2, voffA);
            PG8_BAR; PG8_WAIT_L(0); PG8_MMA(1, 0, At, B0); PG8_BAR; PG8_SCHED;
            PG8_STAGE(PG8_SB(0, 1), b2 + hstep, voffB);
            PG8_WAIT_V(6); PG8_BAR; PG8_MMA(1, 1, At, B1); PG8_BAR;
            PG8_LDB(B0, 1, 0); PG8_SCHED; PG8_LDA(At, 1, 0); PG8_STAGE(PG8_SA(0, 1), a2 + hstep, voffA);
            PG8_WAIT_L(8); PG8_BAR; PG8_WAIT_L(0); PG8_MMA(0, 0, At, B0); PG8_BAR; PG8_SCHED;
            PG8_LDB(B1, 1, 1); PG8_STAGE(PG8_SB(1, 0), b3, voffB);
            PG8_BAR; PG8_WAIT_L(0); PG8_MMA(0, 1, At, B1); PG8_BAR;
            PG8_LDA(At, 1, 1); PG8_STAGE(PG8_SA(1, 0), a3, voffA);
            PG8_BAR; PG8_WAIT_L(0); PG8_MMA(1, 0, At, B0); PG8_BAR; PG8_SCHED;
            PG8_STAGE(PG8_SB(1, 1), b3 + hstep, voffB);
            PG8_WAIT_V(6); PG8_BAR; PG8_MMA(1, 1, At, B1); PG8_BAR;
        }
        PG8_STAMP();
        if constexpr (!Epi::AFTER_DRAIN) { E(acc, cur, wr, wc, fr, fq); S.done(cur); }
        PG8_STAMP();
        if (!has_next) break;
#pragma unroll
        for (int a = 0; a < 2; ++a)
#pragma unroll
            for (int b = 0; b < 2; ++b)
#pragma unroll
                for (int m = 0; m < 4; ++m)
#pragma unroll
                    for (int n = 0; n < 2; ++n) acc[a][b][m][n] = (f32x4){0.f, 0.f, 0.f, 0.f};
        cur = nxt; cA = nA; cB = nB; ++ui;
    }
    PG8_WAIT_V(0);
    if (wr == 0) PG8_BAR;
    PG8_BAR;
    if constexpr (Epi::AFTER_DRAIN) { E.fused(acc, cur, wr, wc, fr, fq, lds, wid, lane); S.done(cur); }
    PG8_STAMP();
    if (STAMP && wid == 0) { stamps[lane] = lane < nts ? (((unsigned long long)(unsigned)ts_hi << 32) | (unsigned)ts_lo) : 0ull;
        if (lane == 62) stamps[62] = rt_entry; if (lane == 63) stamps[63] = (unsigned long long)wall_clock64(); }
#undef PG8_STAMP
#undef PG8_SA
#undef PG8_SB
#undef PG8_STAGE
#undef PG8_LDA
#undef PG8_LDB
#undef PG8_MMA
#undef PG8_WAIT_V
#undef PG8_WAIT_L
#undef PG8_BAR
#undef PG8_SCHED
}
}

struct EpiIn0 {
  static constexpr bool PERM = false, AFTER_DRAIN = false;
  float* PROJ;
  const float* LB;
  const float* IR;
  __device__ __forceinline__ void operator()(const pg8::f32x4 (&acc)[2][2][4][2], const pg8::Unit& u, int wr, int wc, int fr, int fq) const {
#pragma unroll
    for (int bj = 0; bj < 2; ++bj) {
      const int cb = u.pn * 256 + bj * 128;
      if (cb >= 4096 && cb < 5120) {
        const int d0 = wc * 16 + 4 * fq;
        const pg8::f32x4 irA = *(const pg8::f32x4*)(IR + 2 * d0), irB = *(const pg8::f32x4*)(IR + 2 * d0 + 4);
        const float irh[4] = {irA[0], irA[2], irB[0], irB[2]}, irl[4] = {irA[1], irA[3], irB[1], irB[3]};
        const float sc = (cb >= 4608) ? 0.08838834764831845f : 1.0f;
#pragma unroll
        for (int ai = 0; ai < 2; ++ai)
#pragma unroll
          for (int m = 0; m < 4; ++m) {
            const int row = u.pm * 256 + ai * 128 + wr * 64 + m * 16 + fr;
            float* pr = PROJ + (size_t)row * N0;
            const pg8::f32x4 v0 = acc[ai][bj][m][0], v1 = acc[ai][bj][m][1];
            const float pos = (float)row_pos(row);
            pg8::f32x4 o1, o2;
#pragma unroll
            for (int j = 0; j < 4; ++j) {
              float ph = pos * irh[j];
              float pe = __builtin_fmaf(pos, irh[j], -ph) + pos * irl[j];
              float frc = __builtin_amdgcn_fractf(ph) + pe;
              float sn = __builtin_amdgcn_sinf(frc), cs = __builtin_amdgcn_cosf(frc);
              o1[j] = (v0[j] * cs - v1[j] * sn) * sc;
              o2[j] = (v0[j] * sn + v1[j] * cs) * sc;
            }
            *(pg8::f32x4*)(pr + cb + d0) = o1;
            *(pg8::f32x4*)(pr + cb + 64 + d0) = o2;
            __builtin_amdgcn_sched_barrier(0);
          }
      } else if (cb >= 1024 && cb < 2048) {
        const int c0 = cb + 32 * wc + 4 * fq;
        const pg8::f32x4 l0 = *(const pg8::f32x4*)(LB + c0 - 1024), l1 = *(const pg8::f32x4*)(LB + c0 + 16 - 1024);
#pragma unroll
        for (int ai = 0; ai < 2; ++ai)
#pragma unroll
          for (int m = 0; m < 4; ++m) {
            const int row = u.pm * 256 + ai * 128 + wr * 64 + m * 16 + fr;
            float* pr = PROJ + (size_t)row * N0;
#pragma unroll
            for (int n = 0; n < 2; ++n) {
              const pg8::f32x4 l = n ? l1 : l0;
              pg8::f32x4 v = acc[ai][bj][m][n], o;
#pragma unroll
              for (int j = 0; j < 4; ++j) o[j] = l[j] + (1.0f - l[j]) * sigmoid_acc(v[j]);
              *(pg8::f32x4*)(pr + c0 + 16 * n) = o;
            }
            __builtin_amdgcn_sched_barrier(0);
          }
      } else {
        const bool act = (cb < 1024 || (cb >= 3072 && cb < 4096) || cb >= 6144);
        const int c0 = cb + 32 * wc + 4 * fq;
#pragma unroll
        for (int ai = 0; ai < 2; ++ai)
#pragma unroll
          for (int m = 0; m < 4; ++m) {
            const int row = u.pm * 256 + ai * 128 + wr * 64 + m * 16 + fr;
            float* pr = PROJ + (size_t)row * N0;
#pragma unroll
            for (int n = 0; n < 2; ++n) {
              pg8::f32x4 v = acc[ai][bj][m][n], o;
#pragma unroll
              for (int j = 0; j < 4; ++j) o[j] = act ? silu_acc(v[j]) : v[j];
              *(pg8::f32x4*)(pr + c0 + 16 * n) = o;
            }
            __builtin_amdgcn_sched_barrier(0);
          }
      }
    }
  }
};
struct EpiIn1 {
  static constexpr bool PERM = false, AFTER_DRAIN = false;
  float* PROJ;
  float* DTA;
  const float* dtb;
  const float* alog;
  __device__ __forceinline__ void operator()(const pg8::f32x4 (&acc)[2][2][4][2], const pg8::Unit& u, int wr, int wc, int fr, int fq) const {
    float dtbv[4] = {0.f, 0.f, 0.f, 0.f}, aev[4] = {0.f, 0.f, 0.f, 0.f};
    if (u.pn == 23) {
      const int cc = 23 * 256 + 32 * wc + 4 * fq;
      const int hb = (cc >= 5920 && cc < 5936) ? (cc - 5920) : ((cc + 16 >= 5920 && cc + 16 < 5936) ? (cc + 16 - 5920) : -1);
      if (hb >= 0) {
#pragma unroll
        for (int j = 0; j < 4; ++j) { dtbv[j] = dtb[hb + j]; aev[j] = expf(alog[hb + j]); }
      }
    }
#pragma unroll
    for (int ai = 0; ai < 2; ++ai)
#pragma unroll
      for (int m = 0; m < 4; ++m) {
        const int row = u.pm * 256 + ai * 128 + wr * 64 + m * 16 + fr;
        float* pr = PROJ + (size_t)row * N1;
#pragma unroll
        for (int bj = 0; bj < 2; ++bj)
#pragma unroll
          for (int n = 0; n < 2; ++n) {
            const int col0 = u.pn * 256 + bj * 128 + 32 * wc + 16 * n + 4 * fq;
            pg8::f32x4 v = acc[ai][bj][m][n];
            if (col0 < 1024) {
              pg8::f32x4 o;
#pragma unroll
              for (int j = 0; j < 4; ++j) o[j] = siluf_(v[j]);
              *(pg8::f32x4*)(pr + col0) = o;
            } else if (col0 < 5920) {
              *(pg8::f32x4*)(pr + col0) = v;
            } else if (col0 < 5936) {
#pragma unroll
              for (int j = 0; j < 4; ++j) {
                int h = col0 + j - 5920;
                float dt = softplusf_(v[j] + dtbv[j]);
                DTA[(size_t)row * 64 + h * 4] = dt;
                DTA[(size_t)row * 64 + h * 4 + 1] = expf(-dt * aev[j]);
              }
            }
          }
      }
  }
};

struct Seg {
  int off;
  int ld;
  int n4;
};

template <int NS, int NF4, int RG>
DEVI void stage_init(const float* wsf, const Seg (&sg)[NS], int row0, int tid, const float* (&ptr)[RG], int (&ldv)[RG]) {
  asm volatile("" : "+v"(tid));
#pragma unroll
  for (int q = 0; q < RG; ++q) {
    int flat = tid + q * 256;
    int t = flat / NF4, f = flat % NF4;
    if (flat >= 16 * NF4) { t = 0; f = 0; }
    int off = 0, ld = 0, ff = f;
    bool done = false;
#pragma unroll
    for (int s = 0; s < NS; ++s) {
      bool here = (!done) && (ff < sg[s].n4);
      off = here ? (sg[s].off + (row0 + t) * sg[s].ld + ff * 4) : off;
      ld = here ? sg[s].ld : ld;
      ff = (done || here) ? ff : (ff - sg[s].n4);
      done = done || here;
    }
    ptr[q] = wsf + off;
    ldv[q] = ld;
  }
}
template <int NF4, int RG>
DEVI void stage_issue(const float* const (&ptr)[RG], const int (&ldv)[RG], int st, int nsteps, int tid, f32x4 (&rg)[RG]) {
#pragma unroll
  for (int q = 0; q < RG; ++q) {
    int flat = tid + q * 256;
    if (flat < nsteps * NF4) rg[q] = *(const f32x4*)(ptr[q] + (st * 16) * ldv[q]);
  }
}
template <int NF4, int RG>
DEVI void stage_commit(float* buf, int nsteps, int tid, const f32x4 (&rg)[RG]) {
#pragma unroll
  for (int q = 0; q < RG; ++q) {
    int flat = tid + q * 256;
    if (flat < nsteps * NF4) ((f32x4*)buf)[flat] = rg[q];
  }
}

template <int MODE>
DEVI void colrec_long(const float* wsf, const Seg (&sg)[4], int row0, int T, float gamma, float* outp, int ldo, float* stout, int st_ld,
                      float* smem) {
  constexpr int NF4 = 69, W = 276, RG = 5;
  const int tid = threadIdx.x & 255, w = tid >> 6, lane = tid & 63, c = lane >> 4, s = lane & 15;
  smem += (threadIdx.x >> 8) * (VB_BYTES / 4);
  float S[8];
#pragma unroll
  for (int i = 0; i < 8; ++i) S[i] = 0.f;
  float* buf0 = smem;
  float* buf1 = smem + 16 * 336;
  float* obuf = smem + 2 * 16 * 336;
  const int nst = (T + 15) / 16;
  f32x4 rgA[RG], rgB[RG];
  const float* sptr[RG];
  int sld[RG];
  stage_init<4, NF4, RG>(wsf, sg, row0, tid, sptr, sld);
  auto step = [&](const float* sp, float* ob, int tt) -> float {
    float4 a0 = *(const float4*)(sp + s * 8), a1 = *(const float4*)(sp + s * 8 + 4);
    float4 q0 = *(const float4*)(sp + 128 + s * 8), q1 = *(const float4*)(sp + 128 + s * 8 + 4);
    float a[8] = {a0.x, a0.y, a0.z, a0.w, a1.x, a1.y, a1.z, a1.w};
    float q[8] = {q0.x, q0.y, q0.z, q0.w, q1.x, q1.y, q1.z, q1.w};
    float val = sp[256 + w * 4 + c];
    float dA = gamma;
    if (MODE == 2) {
      val *= sp[272];
      dA = sp[273];
    }
    float o = 0.f;
#pragma unroll
    for (int i = 0; i < 8; ++i) {
      if (MODE == 0) S[i] = val + a[i] * (S[i] - val);
      else S[i] = dA * S[i] + a[i] * val;
      o += q[i] * S[i];
    }
    return red16(o);
  };
  auto run_stage = [&](const float* b, float* ob, int nthis) {
#pragma unroll 1
    for (int tt = 0; tt < nthis; tt += 4) {
      float o0 = step(b + tt * W, ob, tt);
      float o1 = step(b + (tt + 1) * W, ob, tt + 1);
      float o2 = step(b + (tt + 2) * W, ob, tt + 2);
      float o3 = step(b + (tt + 3) * W, ob, tt + 3);
      const int base = (s == 0) ? (tt * 16 + w * 4 + c) : (1024 + (tid & 255));
      const int st16 = (s == 0) ? 16 : 0;
      ob[base] = o0;
      ob[base + st16] = o1;
      ob[base + 2 * st16] = o2;
      ob[base + 3 * st16] = o3;
    }
  };
  auto write_out = [&](const float* ob, int st, int nthis) {
    if (tid < nthis * 4) {
      int t = tid >> 2, c4 = tid & 3;
      *(float4*)(outp + (size_t)(st * 16 + t) * ldo + c4 * 4) = *(const float4*)(ob + t * 16 + c4 * 4);
    }
  };
  auto nsteps = [&](int st) { return min(16, T - st * 16); };
  stage_issue<NF4, RG>(sptr, sld, 0, nsteps(0), tid, rgA);
  stage_commit<NF4, RG>(buf0, nsteps(0), tid, rgA);
  if (nst > 1) stage_issue<NF4, RG>(sptr, sld, 1, nsteps(1), tid, rgB);
  __syncthreads();
#pragma unroll 1
  for (int st = 0; st < nst; st += 2) {
    if (st + 2 < nst) stage_issue<NF4, RG>(sptr, sld, st + 2, nsteps(st + 2), tid, rgA);
    run_stage(buf0, obuf, nsteps(st));
    if (st + 1 < nst) stage_commit<NF4, RG>(buf1, nsteps(st + 1), tid, rgB);
    __syncthreads();
    write_out(obuf, st, nsteps(st));
    if (st + 1 < nst) {
      if (st + 3 < nst) stage_issue<NF4, RG>(sptr, sld, st + 3, nsteps(st + 3), tid, rgB);
      run_stage(buf1, obuf + 512, nsteps(st + 1));
      if (st + 2 < nst) stage_commit<NF4, RG>(buf0, nsteps(st + 2), tid, rgA);
      __syncthreads();
      write_out(obuf + 512, st + 1, nsteps(st + 1));
    }
  }
#pragma unroll
  for (int i = 0; i < 8; ++i) stout[(size_t)(s * 8 + i) * st_ld + w * 4 + c] = S[i];
  __syncthreads();
}

template <int MODE>
DEVI void colrec_short(const float* pa, int lda_, const float* pq, int ldq, const float* pc, int ldc, const float* pdt,
                       long row0, float gamma, const float* stin, float* stout, int st_ld, float* outp, int ldo,
                       float* smem) {
  const int tid = threadIdx.x & 255, lane = tid & 63;
  const int wid = __builtin_amdgcn_readfirstlane(tid >> 6);
  const int k0 = wid * 32;
  smem += (threadIdx.x >> 8) * (VB_BYTES / 4);
  float S[32];
#pragma unroll
  for (int i = 0; i < 32; ++i) S[i] = stin[(size_t)(k0 + i) * st_ld + lane];
  float aq[4], vv[4], dAv[4];
#pragma unroll
  for (int t = 0; t < 4; ++t) {
    long row = row0 + t;
    aq[t] = (lane < 32) ? pa[(size_t)row * lda_ + k0 + lane] : pq[(size_t)row * ldq + k0 + (lane - 32)];
    vv[t] = pc[(size_t)row * ldc + lane];
    dAv[t] = gamma;
    if (MODE == 2) {
      vv[t] *= pdt[(size_t)row * 64];
      dAv[t] = pdt[(size_t)row * 64 + 1];
    }
  }
#pragma unroll
  for (int t = 0; t < 4; ++t) {
    const float val = vv[t], dA = dAv[t];
    float o = 0.f;
#pragma unroll
    for (int i = 0; i < 32; ++i) {
      const float a = rlf_(aq[t], i), q = rlf_(aq[t], 32 + i);
      if (MODE == 0) S[i] = val + a * (S[i] - val);
      else S[i] = dA * S[i] + a * val;
      o += q * S[i];
    }
    smem[(wid * 4 + t) * 64 + lane] = o;
  }
#pragma unroll
  for (int i = 0; i < 32; ++i) stout[(size_t)(k0 + i) * st_ld + lane] = S[i];
  __syncthreads();
  {
    int t = tid >> 6;
    float sum = smem[(0 * 4 + t) * 64 + lane] + smem[(1 * 4 + t) * 64 + lane] + smem[(2 * 4 + t) * 64 + lane] +
                smem[(3 * 4 + t) * 64 + lane];
    outp[(size_t)(row0 + t) * ldo + lane] = sum;
  }
  __syncthreads();
}

DEVI void rwkv_item(const float* wsf, const Seg (&sg)[6], int row0, int T, const float* stin, float* stout, float* outp, int ldo,
                    float* smem) {
  constexpr int NF4 = 84, W = 336, RG = 6;
  const int tid = threadIdx.x & 255, w = tid >> 6, lane = tid & 63, rl = lane >> 4, sl = lane & 15;
  smem += (threadIdx.x >> 8) * (VB_BYTES / 4);
  const int il = w * 4 + rl;
  float S[4];
  if (stin) {
    float4 v = *(const float4*)(stin + il * 64 + sl * 4);
    S[0] = v.x; S[1] = v.y; S[2] = v.z; S[3] = v.w;
  } else {
    S[0] = S[1] = S[2] = S[3] = 0.f;
  }
  float* buf0 = smem;
  float* buf1 = smem + 16 * 336;
  float* obuf = smem + 2 * 16 * 336;
  const int nst = (T + 15) / 16;
  f32x4 rgA[RG], rgB[RG];
  const float* sptr[RG];
  int sld[RG];
  stage_init<6, NF4, RG>(wsf, sg, row0, tid, sptr, sld);
  auto run_stage = [&](const float* b, float* ob, int nthis) {
#pragma unroll 4
    for (int tt = 0; tt < nthis; ++tt) {
      const float* sp = b + tt * W;
      float4 r4 = *(const float4*)(sp + sl * 4);
      float4 w4 = *(const float4*)(sp + 64 + sl * 4);
      float4 k4 = *(const float4*)(sp + 128 + sl * 4);
      float4 n4 = *(const float4*)(sp + 192 + sl * 4);
      float4 m4 = *(const float4*)(sp + 256 + sl * 4);
      float vi = sp[320 + il];
      float sa = S[0] * n4.x + S[1] * n4.y + S[2] * n4.z + S[3] * n4.w;
      sa = -red16(sa);
      S[0] = S[0] * w4.x + sa * m4.x + vi * k4.x;
      S[1] = S[1] * w4.y + sa * m4.y + vi * k4.y;
      S[2] = S[2] * w4.z + sa * m4.z + vi * k4.z;
      S[3] = S[3] * w4.w + sa * m4.w + vi * k4.w;
      float y = S[0] * r4.x + S[1] * r4.y + S[2] * r4.z + S[3] * r4.w;
      y = red16(y);
      ob[(sl == 0) ? (tt * 16 + il) : (1024 + (tid & 255))] = y;
    }
  };
  auto write_out = [&](const float* ob, int st, int nthis) {
    if (tid < nthis * 4) {
      int t = tid >> 2, c4 = tid & 3;
      *(float4*)(outp + (size_t)(st * 16 + t) * ldo + c4 * 4) = *(const float4*)(ob + t * 16 + c4 * 4);
    }
  };
  auto nsteps = [&](int st) { return min(16, T - st * 16); };
  stage_issue<NF4, RG>(sptr, sld, 0, nsteps(0), tid, rgA);
  stage_commit<NF4, RG>(buf0, nsteps(0), tid, rgA);
  if (nst > 1) stage_issue<NF4, RG>(sptr, sld, 1, nsteps(1), tid, rgB);
  __syncthreads();
#pragma unroll 1
  for (int st = 0; st < nst; st += 2) {
    if (st + 2 < nst) stage_issue<NF4, RG>(sptr, sld, st + 2, nsteps(st + 2), tid, rgA);
    run_stage(buf0, obuf, nsteps(st));
    if (st + 1 < nst) stage_commit<NF4, RG>(buf1, nsteps(st + 1), tid, rgB);
    __syncthreads();
    write_out(obuf, st, nsteps(st));
    if (st + 1 < nst) {
      if (st + 3 < nst) stage_issue<NF4, RG>(sptr, sld, st + 3, nsteps(st + 3), tid, rgB);
      run_stage(buf1, obuf + 512, nsteps(st + 1));
      if (st + 2 < nst) stage_commit<NF4, RG>(buf0, nsteps(st + 2), tid, rgA);
      __syncthreads();
      write_out(obuf + 512, st + 1, nsteps(st + 1));
    }
  }
  *(float4*)(stout + il * 64 + sl * 4) = make_float4(S[0], S[1], S[2], S[3]);
  __syncthreads();
}

DEVI void phase_rec0(const Params& p, float* smem) {
  char* ws = p.ws;
  const float* PROJ = (const float*)(ws + OFF_PROJ);
  float* OMIX = (float*)(ws + OFF_OMIX);
  const float* wsf = (const float*)ws;
  constexpr int PO = (int)(OFF_PROJ / 4);
  for (int item = blockIdx.x * 2 + (threadIdx.x >> 8); item < 4608; item += gridDim.x * 2) {
    if (item < 256) {
      int b = item >> 6, h = (item >> 3) & 7, cb = item & 7;
      Seg sg[4] = {{PO + 1024 + h * 128, N0, 32}, {PO + h * 128, N0, 32}, {PO + 2048 + h * 128 + cb * 16, N0, 4},
                   {PO, N0, 1}};
      int row0 = b * TP;
      colrec_long<0>(wsf, sg, row0, TP, 0.f, OMIX + (size_t)row0 * 2048 + h * 128 + cb * 16, 2048,
                     p.out + O_HGP + (size_t)(b * 8 + h) * 128 * 128 + cb * 16, 128, smem);
    } else if (item < 512) {
      int it = item - 256;
      int b = it >> 6, h = (it >> 4) & 3, cb = it & 15;
      Seg sg[4] = {{PO + 4608 + h * 128, N0, 32}, {PO + 4096 + h * 128, N0, 32},
                   {PO + 5120 + h * 256 + cb * 16, N0, 4}, {PO, N0, 1}};
      int row0 = b * TP;
      float gamma = 1.0f - exp2f(-5.0f - (float)h);
      colrec_long<1>(wsf, sg, row0, TP, gamma, OMIX + (size_t)row0 * 2048 + 1024 + h * 256 + cb * 16, 2048,
                     p.out + O_RTP + (size_t)(b * 4 + h) * 128 * 256 + cb * 16, 256, smem);
    } else if (item < 2560) {
      int it = item - 512;
      int b = it >> 4, h = (it >> 1) & 7, cb = it & 1;
      long row0 = MPR + (long)b * 4;
      size_t so = (size_t)(b * 8 + h) * 128 * 128 + cb * 64;
      colrec_short<0>(PROJ + 1024 + h * 128, N0, PROJ + h * 128, N0, PROJ + 2048 + h * 128 + cb * 64, N0, nullptr, row0,
                      0.f, p.in[I_SHG] + so, p.out + O_HGS + so, 128, OMIX + h * 128 + cb * 64, 2048, smem);
    } else {
      int it = item - 2560;
      int b = it >> 4, h = (it >> 2) & 3, cb = it & 3;
      long row0 = MPR + (long)b * 4;
      size_t so = (size_t)(b * 4 + h) * 128 * 256 + cb * 64;
      float gamma = 1.0f - exp2f(-5.0f - (float)h);
      colrec_short<1>(PROJ + 4608 + h * 128, N0, PROJ + 4096 + h * 128, N0, PROJ + 5120 + h * 256 + cb * 64, N0, nullptr,
                      row0, gamma, p.in[I_SRT] + so, p.out + O_RTS + so, 256, OMIX + 1024 + h * 256 + cb * 64, 2048,
                      smem);
    }
  }
}

DEVI float4 ld4(const float* p) { return *(const float4*)p; }
DEVI void st_bf4(u16* p, float a, float b, float c, float d) {
  uint2 o;
  o.x = pack2(a, b);
  o.y = pack2(c, d);
  *(uint2*)p = o;
}
DEVI float wsum_u_(float v) {
  v = red16(v);
  return (rlf_(v, 0) + rlf_(v, 16)) + (rlf_(v, 32) + rlf_(v, 48));
}
DEVI float red32(float v) {
  v = red16(v);
  return v + __shfl_xor(v, 16, 64);
}
DEVI void phase_post0(const Params& p) {
  char* ws = p.ws;
  const float* PROJ = (const float*)(ws + OFF_PROJ);
  const float* OMIX = (const float*)(ws + OFF_OMIX);
  u16* MIXB = (u16*)(ws + OFF_MIXB);
  const float* ng = p.in[I_HNG];
  const int lane = threadIdx.x & 63;
  const int gw = blockIdx.x * 8 + (threadIdx.x >> 6), nw = gridDim.x * 8;
  const float4 g4 = ld4(ng + (lane & 31) * 4);
  for (int row = gw; row < M; row += nw) {
    const float* o = OMIX + (size_t)row * 2048;
    const float* pr = PROJ + (size_t)row * N0;
    u16* mo = MIXB + (size_t)row * 2048;
    float4 a[4], ga[4], bq[4], gb[4];
#pragma unroll
    for (int it = 0; it < 4; ++it) {
      int c = it * 256 + lane * 4;
      a[it] = ld4(o + c);
      ga[it] = ld4(pr + 3072 + c);
      bq[it] = ld4(o + 1024 + c);
      gb[it] = ld4(pr + 6144 + c);
    }
#pragma unroll
    for (int it = 0; it < 4; ++it) {
      int c = it * 256 + lane * 4;
      float ss = red32(a[it].x * a[it].x + a[it].y * a[it].y + a[it].z * a[it].z + a[it].w * a[it].w);
      float inv = rsqrtf(ss * (1.0f / 128.0f) + 1e-6f);
      st_bf4(mo + c, a[it].x * inv * g4.x * ga[it].x, a[it].y * inv * g4.y * ga[it].y, a[it].z * inv * g4.z * ga[it].z,
             a[it].w * inv * g4.w * ga[it].w);
      float mu = wsum_u_(bq[it].x + bq[it].y + bq[it].z + bq[it].w) * (1.0f / 256.0f);
      float dx = bq[it].x - mu, dy = bq[it].y - mu, dz = bq[it].z - mu, dw = bq[it].w - mu;
      float var = wsum_u_(dx * dx + dy * dy + dz * dz + dw * dw) * (1.0f / 256.0f);
      float iv = rsqrtf(var + 1e-5f);
      st_bf4(mo + 1024 + c, dx * iv * gb[it].x, dy * iv * gb[it].y, dz * iv * gb[it].z, dw * iv * gb[it].w);
    }
  }
}

DEVI void phase_ln(const Params& p, const float* addsrc, const float* g, const float* bta) {
  char* ws = p.ws;
  float* XF = (float*)(ws + OFF_XF);
  u16* XB = (u16*)(ws + OFF_XB);
  const int lane = threadIdx.x & 63;
  const int gw = blockIdx.x * 8 + (threadIdx.x >> 6), nw = gridDim.x * 8;
  for (int row = gw; row < M; row += nw) {
    float4* xr = (float4*)(XF + (size_t)row * 2048);
    const float4* ar = (const float4*)(addsrc + (size_t)row * 2048);
    float v[32];
    float s = 0.f;
#pragma unroll
    for (int i = 0; i < 8; ++i) {
      float4 x = xr[i * 64 + lane], a = ar[i * 64 + lane];
      v[i * 4 + 0] = ALPHA * x.x + a.x;
      v[i * 4 + 1] = ALPHA * x.y + a.y;
      v[i * 4 + 2] = ALPHA * x.z + a.z;
      v[i * 4 + 3] = ALPHA * x.w + a.w;
      s += v[i * 4 + 0] + v[i * 4 + 1] + v[i * 4 + 2] + v[i * 4 + 3];
    }
    float mu = wsum(s) * (1.0f / 2048.0f);
    float q = 0.f;
#pragma unroll
    for (int i = 0; i < 32; ++i) {
      v[i] -= mu;
      q += v[i] * v[i];
    }
    float inv = rsqrtf(wsum(q) * (1.0f / 2048.0f) + 1e-5f);
#pragma unroll
    for (int i = 0; i < 8; ++i) {
      float4 gg = ((const float4*)g)[i * 64 + lane], bb = ((const float4*)bta)[i * 64 + lane];
      float4 y;
      y.x = v[i * 4 + 0] * inv * gg.x + bb.x;
      y.y = v[i * 4 + 1] * inv * gg.y + bb.y;
      y.z = v[i * 4 + 2] * inv * gg.z + bb.z;
      y.w = v[i * 4 + 3] * inv * gg.w + bb.w;
      xr[i * 64 + lane] = y;
      uint2 o;
      o.x = pack2(y.x, y.y);
      o.y = pack2(y.z, y.w);
      ((uint2*)(XB + (size_t)row * 2048))[i * 64 + lane] = o;
    }
  }
}

typedef __attribute__((ext_vector_type(2))) __bf16 bf2_t;
typedef __attribute__((ext_vector_type(2))) float f32x2;
DEVI float dot2bf(unsigned a, unsigned b, float acc) {
  return __builtin_amdgcn_fdot2_f32_bf16(__builtin_bit_cast(bf2_t, a), __builtin_bit_cast(bf2_t, b), acc, false);
}
template <int CTRL>
DEVI int dppi(int v) {
  return __builtin_amdgcn_update_dpp(v, v, CTRL, 0xF, 0xF, false);
}
DEVI int wmax_i(int v) {
  v = max(v, dppi<0xB1>(v));
  v = max(v, dppi<0x4E>(v));
  v = max(v, dppi<0x141>(v));
  v = max(v, dppi<0x140>(v));
  int a = __builtin_amdgcn_readlane(v, 0), b = __builtin_amdgcn_readlane(v, 16);
  int c = __builtin_amdgcn_readlane(v, 32), d = __builtin_amdgcn_readlane(v, 48);
  return max(max(a, b), max(c, d));
}
DEVI float rlf(float v, int l) { return __int_as_float(__builtin_amdgcn_readlane(__float_as_int(v), l)); }
DEVI float wsum_u(float v) {
  v = red16(v);
  return (rlf(v, 0) + rlf(v, 16)) + (rlf(v, 32) + rlf(v, 48));
}
DEVI int fkey(float f) {
  int u = __float_as_int(f);
  return u ^ ((u >> 31) & 0x7fffffff);
}
DEVI float keyf(int k) { return __int_as_float(k ^ ((k >> 31) & 0x7fffffff)); }

DEVI void conv_fp8_rows(const float* __restrict__ src, unsigned char* __restrict__ dst, float* __restrict__ scales) {
  const int lane = threadIdx.x & 63;
  const int gw = blockIdx.x * 8 + (threadIdx.x >> 6), nw = gridDim.x * 8;
  for (int e = gw; e < 16384; e += nw) {
    const float* r = src + (size_t)e * 2048;
    float4 v[8];
    float am = 0.f;
#pragma unroll
    for (int q = 0; q < 8; ++q) {
      v[q] = *(const float4*)(r + (q >> 2) * 1024 + lane * 16 + (q & 3) * 4);
      am = fmaxf(am, fmaxf(fmaxf(fabsf(v[q].x), fabsf(v[q].y)), fmaxf(fabsf(v[q].z), fabsf(v[q].w))));
    }
    float amax = __int_as_float(wmax_i(__float_as_int(am)));
    float inv = (amax > 0.f) ? (440.0f / amax) : 0.f;
    float scale = (amax > 0.f) ? (amax * (1.0f / 440.0f)) : 1.0f;
#pragma unroll
    for (int j = 0; j < 2; ++j) {
      u32x4 o;
#pragma unroll
      for (int k = 0; k < 4; ++k) {
        float4 t = v[j * 4 + k];
        int pk = 0;
        pk = __builtin_amdgcn_cvt_pk_fp8_f32(t.x * inv, t.y * inv, pk, false);
        pk = __builtin_amdgcn_cvt_pk_fp8_f32(t.z * inv, t.w * inv, pk, true);
        o[k] = (unsigned)pk;
      }
      *(u32x4*)(dst + (size_t)e * 2048 + j * 1024 + lane * 16) = o;
    }
    if (lane == 0) scales[e] = scale;
  }
}

DEVI void phase_peer(const Params& p, int layer, bool final_out) {
  char* ws = p.ws;
  const float* SC = (const float*)(ws + OFF_GOUT);
  float* XF = (float*)(ws + OFF_XF);
  u16* XB = (u16*)(ws + OFF_XB);
  const unsigned char* UB = (const unsigned char*)(ws + OFF_UB);
  const unsigned char* VB = (const unsigned char*)(ws + OFF_VB);
  const float* USC = (const float*)(ws + OFF_USC);
  const float* VSC = (const float*)(ws + OFF_VSC);
  const float* g = p.in[I_LNG] + (size_t)(layer * 2 + 1) * D;
  const float* bta = p.in[I_LNB] + (size_t)(layer * 2 + 1) * D;
  const int lane = threadIdx.x & 63;
  const int gw = blockIdx.x * 8 + (threadIdx.x >> 6), nw = gridDim.x * 8;
  constexpr int KMIN = (int)0x80000000;
  for (int row = gw; row < M; row += nw) {
    const float* sr = SC + (size_t)row * 2048;
    int eidx0 = 0, eidx1 = 0;
    float gate0 = 0.f, gate1 = 0.f;
#pragma unroll 1
    for (int h = 0; h < 8; ++h) {
      const float* sp = sr + h * 256;
      int ka0 = (fkey(sp[lane]) & ~127) | (127 - lane);
      int kb0 = (fkey(sp[lane + 64]) & ~127) | (63 - lane);
      int ka1 = (fkey(sp[128 + lane]) & ~127) | (127 - lane);
      int kb1 = (fkey(sp[192 + lane]) & ~127) | (63 - lane);
      int my0 = KMIN, my1 = KMIN;
#pragma unroll 1
      for (int r = 0; r < 16; ++r) {
        int K0 = wmax_i(max(ka0, kb0));
        int K1 = wmax_i(max(ka1, kb1));
        my0 = (lane == r) ? K0 : my0;
        my1 = (lane == r) ? K1 : my1;
        ka0 = (ka0 == K0) ? KMIN : ka0;
        kb0 = (kb0 == K0) ? KMIN : kb0;
        ka1 = (ka1 == K1) ? KMIN : ka1;
        kb1 = (kb1 == K1) ? KMIN : kb1;
      }
      float ts0 = keyf(my0 & ~127), ts1 = keyf(my1 & ~127);
      int ti0 = 127 - (my0 & 127), ti1 = 127 - (my1 & 127);
      float s0 = __shfl(ts0, lane >> 2, 64);
      int jb = (lane & 3) * 4;
      int c0 = (fkey(s0 + __shfl(ts1, jb + 0, 64)) & ~255) | (255 - (lane * 4 + 0));
      int c1 = (fkey(s0 + __shfl(ts1, jb + 1, 64)) & ~255) | (255 - (lane * 4 + 1));
      int c2 = (fkey(s0 + __shfl(ts1, jb + 2, 64)) & ~255) | (255 - (lane * 4 + 2));
      int c3 = (fkey(s0 + __shfl(ts1, jb + 3, 64)) & ~255) | (255 - (lane * 4 + 3));
      int myk = KMIN;
#pragma unroll 1
      for (int r = 0; r < 16; ++r) {
        int K = wmax_i(max(max(c0, c1), max(c2, c3)));
        myk = (lane == r) ? K : myk;
        c0 = (c0 == K) ? KMIN : c0;
        c1 = (c1 == K) ? KMIN : c1;
        c2 = (c2 == K) ? KMIN : c2;
        c3 = (c3 == K) ? KMIN : c3;
      }
      float bs = keyf(myk & ~255);
      int bf = 255 - (myk & 255);
      int e = __shfl(ti0, (bf >> 4) & 15, 64) * 128 + __shfl(ti1, bf & 15, 64);
      float mx = rlf(bs, 0);
      float ev = (lane < 16) ? expf(bs - mx) : 0.f;
      float sm = wsum_u(ev);
      float gt = ev / sm;
      int e_b = __shfl(e, lane & 15, 64);
      float g_b = __shfl(gt, lane & 15, 64);
      if ((lane >> 4) == (h & 3)) {
        if (h < 4) {
          eidx0 = e_b;
          gate0 = g_b;
        } else {
          eidx1 = e_b;
          gate1 = g_b;
        }
      }
    }
    float dv0 = 0.f, dv1 = 0.f;
    {
      float xf[32];
      {
        const float4* xr = (const float4*)(XF + (size_t)row * 2048);
#pragma unroll
        for (int q = 0; q < 8; ++q) {
          float4 t = xr[(q >> 2) * 256 + lane * 4 + (q & 3)];
          xf[q * 4 + 0] = t.x; xf[q * 4 + 1] = t.y; xf[q * 4 + 2] = t.z; xf[q * 4 + 3] = t.w;
        }
      }
      constexpr int R = 8;
      u32x4 w[R][2];
      float sc[R];
      auto load_row = [&](int pidx, u32x4(&wr)[2], float& scv) {
        int src = (pidx < 64) ? eidx0 : eidx1;
        int e = __builtin_amdgcn_readlane(src, pidx & 63);
        const u32x4* ur = (const u32x4*)(UB + (size_t)e * 2048);
        wr[0] = ur[lane];
        wr[1] = ur[64 + lane];
        scv = USC[e];
      };
#pragma unroll
      for (int u = 0; u < R; ++u) load_row(u, w[u], sc[u]);
#pragma unroll 1
      for (int p0 = 0; p0 < 128; p0 += R) {
#pragma unroll
        for (int u = 0; u < R; ++u) {
          float d = 0.f;
#pragma unroll
          for (int j = 0; j < 2; ++j) {
#pragma unroll
            for (int k = 0; k < 4; ++k) {
              int dw = (int)w[u][j][k];
              f32x2 lo = __builtin_amdgcn_cvt_pk_f32_fp8(dw, false);
              f32x2 hi = __builtin_amdgcn_cvt_pk_f32_fp8(dw, true);
              d += lo.x * xf[j * 16 + k * 4 + 0];
              d += lo.y * xf[j * 16 + k * 4 + 1];
              d += hi.x * xf[j * 16 + k * 4 + 2];
              d += hi.y * xf[j * 16 + k * 4 + 3];
            }
          }
          float scu = sc[u];
          if (p0 + R < 128) load_row(p0 + R + u, w[u], sc[u]);
          d = wsum_u(d) * scu;
          int pl = (p0 + u) & 63;
          if (p0 < 64) dv0 = (lane == pl) ? d : dv0;
          else dv1 = (lane == pl) ? d : dv1;
          __builtin_amdgcn_sched_barrier(0);
        }
      }
    }
    float coef0 = 0.5f * dv0 * (1.0f + erff(dv0 * 0.70710678118f)) * gate0;
    float coef1 = 0.5f * dv1 * (1.0f + erff(dv1 * 0.70710678118f)) * gate1;
    f32x2 o2[16];
#pragma unroll
    for (int i = 0; i < 16; ++i) o2[i] = f32x2{0.f, 0.f};
    {
      constexpr int R = 8;
      u32x4 w[R][2];
      float sc[R];
      auto load_row = [&](int pidx, u32x4(&wr)[2], float& scv) {
        int src = (pidx < 64) ? eidx0 : eidx1;
        int e = __builtin_amdgcn_readlane(src, pidx & 63);
        const u32x4* vr = (const u32x4*)(VB + (size_t)e * 2048);
        wr[0] = vr[lane];
        wr[1] = vr[64 + lane];
        scv = VSC[e];
      };
#pragma unroll
      for (int u = 0; u < R; ++u) load_row(u, w[u], sc[u]);
#pragma unroll 1
      for (int p0 = 0; p0 < 128; p0 += R) {
        float cfs = (p0 < 64) ? coef0 : coef1;
#pragma unroll
        for (int u = 0; u < R; ++u) {
          float c = rlf(cfs, (p0 + u) & 63) * sc[u];
          f32x2 cc = f32x2{c, c};
#pragma unroll
          for (int j = 0; j < 2; ++j) {
#pragma unroll
            for (int k = 0; k < 4; ++k) {
              int dw = (int)w[u][j][k];
              o2[j * 8 + k * 2 + 0] += cc * __builtin_amdgcn_cvt_pk_f32_fp8(dw, false);
              o2[j * 8 + k * 2 + 1] += cc * __builtin_amdgcn_cvt_pk_f32_fp8(dw, true);
            }
          }
          if (p0 + R < 128) load_row(p0 + R + u, w[u], sc[u]);
          __builtin_amdgcn_sched_barrier(0);
        }
      }
    }
    float o[32];
#pragma unroll
    for (int i = 0; i < 16; ++i) {
      o[2 * i] = o2[i].x;
      o[2 * i + 1] = o2[i].y;
    }
    float s = 0.f;
    {
      const float4* xr = (const float4*)(XF + (size_t)row * 2048);
#pragma unroll
      for (int q = 0; q < 8; ++q) {
        float4 t = xr[(q >> 2) * 256 + lane * 4 + (q & 3)];
        o[q * 4 + 0] += ALPHA * t.x; o[q * 4 + 1] += ALPHA * t.y; o[q * 4 + 2] += ALPHA * t.z; o[q * 4 + 3] += ALPHA * t.w;
      }
#pragma unroll
      for (int i = 0; i < 32; ++i) s += o[i];
    }
    float mu = wsum_u(s) * (1.0f / 2048.0f);
    float q = 0.f;
#pragma unroll
    for (int i = 0; i < 32; ++i) {
      o[i] -= mu;
      q += o[i] * o[i];
    }
    float inv = rsqrtf(wsum_u(q) * (1.0f / 2048.0f) + 1e-5f);
    float* dstf;
    if (final_out) {
      if (row < MPR) {
        int b = row / TP, t = row % TP;
        dstf = (t >= 16) ? (p.out + O_YP + ((size_t)b * 2048 + (t - 16)) * D) : nullptr;
      } else {
        dstf = p.out + O_YS + (size_t)(row - MPR) * D;
      }
    } else {
      dstf = XF + (size_t)row * 2048;
    }
#pragma unroll
    for (int j = 0; j < 2; ++j) {
      float yv[16];
#pragma unroll
      for (int k = 0; k < 4; ++k) {
        float4 gv = *(const float4*)(g + j * 1024 + lane * 16 + k * 4);
        float4 bv = *(const float4*)(bta + j * 1024 + lane * 16 + k * 4);
        float4 y;
        y.x = o[j * 16 + k * 4 + 0] * inv * gv.x + bv.x;
        y.y = o[j * 16 + k * 4 + 1] * inv * gv.y + bv.y;
        y.z = o[j * 16 + k * 4 + 2] * inv * gv.z + bv.z;
        y.w = o[j * 16 + k * 4 + 3] * inv * gv.w + bv.w;
        if (dstf) *(float4*)(dstf + j * 1024 + lane * 16 + k * 4) = y;
        yv[k * 4 + 0] = y.x; yv[k * 4 + 1] = y.y; yv[k * 4 + 2] = y.z; yv[k * 4 + 3] = y.w;
      }
      if (!final_out) {
        uint4* xb = (uint4*)(XB + (size_t)row * 2048 + j * 1024 + lane * 16);
        xb[0] = make_uint4(pack2(yv[0], yv[1]), pack2(yv[2], yv[3]), pack2(yv[4], yv[5]), pack2(yv[6], yv[7]));
        xb[1] = make_uint4(pack2(yv[8], yv[9]), pack2(yv[10], yv[11]), pack2(yv[12], yv[13]), pack2(yv[14], yv[15]));
      }
    }
  }
}

DEVI float4 f4mul(float4 a, float4 b) { return make_float4(a.x * b.x, a.y * b.y, a.z * b.z, a.w * b.w); }
DEVI void row_info(int row, bool& prompt, int& b, int& t, int& T) {
  prompt = row < MPR;
  if (prompt) { b = row / TP; t = row - b * TP; T = TP; }
  else { b = (row - MPR) >> 2; t = (row - MPR) & 3; T = 4; }
}
DEVI void phase_pre1(const Params& p) {
  char* ws = p.ws;
  const float* PROJ = (const float*)(ws + OFF_PROJ);
  float* XC = (float*)(ws + OFF_GOUT);
  float* RKV = (float*)(ws + OFF_RKV);
  u16* LRA = (u16*)(ws + OFF_LRA);
  u16* LRB = (u16*)(ws + OFF_LRB);
  u16* LRG = (u16*)(ws + OFF_LRG);
  const float* cw = p.in[I_CVW];
  const float* cbias = p.in[I_CVB];
  const float* mu = p.in[I_MU];
  const int gtid = blockIdx.x * 512 + threadIdx.x, nthr = gridDim.x * 512;
#pragma unroll 2
  for (int idx = gtid; idx < M * 384; idx += nthr) {
    int row = idx / 384, c = (idx - row * 384) * 4;
    bool prompt; int b, t, T;
    row_info(row, prompt, b, t, T);
    float4 xv[4];
#pragma unroll
    for (int jj = 0; jj < 4; ++jj) {
      int tt = t - 3 + jj;
      if (tt >= 0) xv[jj] = ld4(PROJ + (size_t)(row - 3 + jj) * N1 + 1024 + c);
      else if (prompt) xv[jj] = make_float4(0.f, 0.f, 0.f, 0.f);
      else xv[jj] = ld4(p.in[I_SCV] + (size_t)(b * 3 + (tt + 3)) * 1536 + c);
    }
    float4 acc = ld4(cbias + c);
#pragma unroll
    for (int jj = 0; jj < 4; ++jj) {
      float4 w = ld4(cw + jj * 1536 + c);
      acc.x += xv[jj].x * w.x; acc.y += xv[jj].y * w.y; acc.z += xv[jj].z * w.z; acc.w += xv[jj].w * w.w;
    }
    *(float4*)(XC + (size_t)row * 1536 + c) = make_float4(siluf_(acc.x), siluf_(acc.y), siluf_(acc.z), siluf_(acc.w));
    if (t >= T - 3) {
      float* co = prompt ? (p.out + O_CVP) : (p.out + O_CVS);
      *(float4*)(co + (size_t)(b * 3 + (t - (T - 3))) * 1536 + c) = xv[3];
    }
  }
#pragma unroll 2
  for (int idx = gtid; idx < M * 840; idx += nthr) {
    int row = idx / 840, c = (idx - row * 840) * 4;
    bool prompt; int b, t, T;
    row_info(row, prompt, b, t, T);
    float4 cur = ld4(PROJ + (size_t)row * N1 + 2560 + c);
    float4 prev;
    if (t > 0) prev = ld4(PROJ + (size_t)(row - 1) * N1 + 2560 + c);
    else if (prompt) prev = make_float4(0.f, 0.f, 0.f, 0.f);
    else prev = ld4(p.in[I_SSH] + (size_t)b * 3360 + c);
    float4 m4 = ld4(mu + c);
    float4 mx;
    mx.x = cur.x + (prev.x - cur.x) * m4.x; mx.y = cur.y + (prev.y - cur.y) * m4.y;
    mx.z = cur.z + (prev.z - cur.z) * m4.z; mx.w = cur.w + (prev.w - cur.w) * m4.w;
    if (c < 3072) *(float4*)(RKV + (size_t)row * 3072 + c) = mx;
    else if (c < 3136) st_bf4(LRA + (size_t)row * 64 + (c - 3072), tanhf(mx.x), tanhf(mx.y), tanhf(mx.z), tanhf(mx.w));
    else if (c < 3200) st_bf4(LRB + (size_t)row * 64 + (c - 3136), mx.x, mx.y, mx.z, mx.w);
    else st_bf4(LRG + (size_t)row * 192 + (c - 3200), sigmoidf_(mx.x), sigmoidf_(mx.y), sigmoidf_(mx.z), sigmoidf_(mx.w));
    if (t == T - 1) {
      float* so = prompt ? (p.out + O_SHP) : (p.out + O_SHS);
      *(float4*)(so + (size_t)b * 3360 + c) = cur;
    }
  }
  for (int idx = gtid; idx < M * 4; idx += nthr) {
    int row = idx >> 2, k = idx & 3;
    ((uint4*)(LRG + (size_t)row * 192 + 160))[k] = make_uint4(0, 0, 0, 0);
  }
}

DEVI void phase_pre1c(const Params& p) {
  char* ws = p.ws;
  float* RKV = (float*)(ws + OFF_RKV);
  const float* AA = (const float*)(ws + OFF_AA);
  float* KK = (float*)(ws + OFF_QB);
  float* KKA = (float*)(ws + OFF_MIXB);
  float* BON = (float*)(ws + OFF_BON);
  const float* k_k = p.in[I_KK];
  const float* k_a = p.in[I_KA];
  const float* r_k = p.in[I_RK];
  const int lane = threadIdx.x & 63;
  const int gw = blockIdx.x * 8 + (threadIdx.x >> 6), nw = gridDim.x * 8;
  for (int row = gw; row < M; row += nw) {
    float4 k4[4], r4[4], a4[4];
#pragma unroll
    for (int it = 0; it < 4; ++it) {
      int c = it * 256 + lane * 4;
      k4[it] = ld4(RKV + (size_t)row * 3072 + 1024 + c);
      r4[it] = ld4(RKV + (size_t)row * 3072 + c);
      a4[it] = ld4(AA + (size_t)row * 1024 + c);
    }
#pragma unroll
    for (int it = 0; it < 4; ++it) {
      int c = it * 256 + lane * 4;
      float4 kk4 = ld4(k_k + c), ka4 = ld4(k_a + c), rk4 = ld4(r_k + c);
      float4 k = k4[it], r = r4[it], a = a4[it];
      float4 kr = f4mul(k, kk4);
      float ss = red16(kr.x * kr.x + kr.y * kr.y + kr.z * kr.z + kr.w * kr.w);
      float inv = 1.0f / fmaxf(sqrtf(ss), 1e-12f);
      float4 kk = make_float4(kr.x * inv, kr.y * inv, kr.z * inv, kr.w * inv);
      float4 kp;
      kp.x = k.x * (1.0f + (a.x - 1.0f) * ka4.x); kp.y = k.y * (1.0f + (a.y - 1.0f) * ka4.y);
      kp.z = k.z * (1.0f + (a.z - 1.0f) * ka4.z); kp.w = k.w * (1.0f + (a.w - 1.0f) * ka4.w);
      float bon = red16(r.x * kp.x * rk4.x + r.y * kp.y * rk4.y + r.z * kp.z * rk4.z + r.w * kp.w * rk4.w);
      *(float4*)(KK + (size_t)row * 1024 + c) = kk;
      *(float4*)(KKA + (size_t)row * 1024 + c) = f4mul(kk, a);
      *(float4*)(RKV + (size_t)row * 3072 + 1024 + c) = kp;
      if ((lane & 15) == 0) BON[(size_t)row * 16 + it * 4 + (lane >> 4)] = bon;
    }
  }
}

DEVI void phase_rec1(const Params& p, float* smem) {
  char* ws = p.ws;
  const float* XC = (const float*)(ws + OFF_GOUT);
  const float* RKV = (const float*)(ws + OFF_RKV);
  const float* DEC = (const float*)(ws + OFF_DEC);
  const float* KK = (const float*)(ws + OFF_QB);
  const float* KKA = (const float*)(ws + OFF_MIXB);
  const float* DTA = (const float*)(ws + OFF_DTA);
  float* OMIX = (float*)(ws + OFF_OMIX);
  const float* wsf = (const float*)ws;
  constexpr int XO = (int)(OFF_GOUT / 4), DO = (int)(OFF_DTA / 4), RO = (int)(OFF_RKV / 4), CO = (int)(OFF_DEC / 4),
                KO = (int)(OFF_QB / 4), AO = (int)(OFF_MIXB / 4);
  for (int item = blockIdx.x * 2 + (threadIdx.x >> 8); item < 10752; item += gridDim.x * 2) {
    if (item < 256) {
      int b = item >> 6, h = (item >> 2) & 15, cb = item & 3;
      int g = h >> 3;
      Seg sg[4] = {{XO + 1024 + g * 128, 1536, 32}, {XO + 1280 + g * 128, 1536, 32}, {XO + h * 64 + cb * 16, 1536, 4},
                   {DO + h * 4, 64, 1}};
      int row0 = b * TP;
      colrec_long<2>(wsf, sg, row0, TP, 0.f, OMIX + (size_t)row0 * 2048 + h * 64 + cb * 16, 2048,
                     p.out + O_SSP + (size_t)(b * 16 + h) * 128 * 64 + cb * 16, 64, smem);
    } else if (item < 512 || item >= 2560) {
      bool prompt = item < 512;
      int it = prompt ? (item - 256) : (item - 2560);
      int b = it >> 6, h = (it >> 2) & 15, rb = it & 3;
      int row0 = prompt ? b * TP : (MPR + b * 4);
      int T = prompt ? TP : 4;
      Seg sg[6] = {{RO + h * 64, 3072, 16}, {CO + h * 64, 1024, 16}, {RO + 1024 + h * 64, 3072, 16},
                   {KO + h * 64, 1024, 16}, {AO + h * 64, 1024, 16}, {RO + 2048 + h * 64 + rb * 16, 3072, 4}};
      size_t so = ((size_t)(b * 16 + h) * 64 + rb * 16) * 64;
      const float* stin = prompt ? nullptr : (p.in[I_SWK] + so);
      float* stout = (prompt ? (p.out + O_WKP) : (p.out + O_WKS)) + so;
      rwkv_item(wsf, sg, row0, T, stin, stout, OMIX + (size_t)row0 * 2048 + 1024 + h * 64 + rb * 16, 2048, smem);
    } else {
      int it = item - 512;
      int b = it >> 4, h = it & 15;
      int g = h >> 3;
      long row0 = MPR + (long)b * 4;
      size_t so = (size_t)(b * 16 + h) * 128 * 64;
      colrec_short<2>(XC + 1024 + g * 128, 1536, XC + 1280 + g * 128, 1536, XC + h * 64, 1536, DTA + h * 4, row0, 0.f,
                      p.in[I_SSM] + so, p.out + O_SSS + so, 64, OMIX + h * 64, 2048, smem);
    }
  }
}

DEVI void phase_post1(const Params& p) {
  char* ws = p.ws;
  const float* PROJ = (const float*)(ws + OFF_PROJ);
  const float* OMIX = (const float*)(ws + OFF_OMIX);
  const float* XC = (const float*)(ws + OFF_GOUT);
  const float* RKV = (const float*)(ws + OFF_RKV);
  const float* GG = (const float*)(ws + OFF_GG);
  const float* BON = (const float*)(ws + OFF_BON);
  u16* MIXB = (u16*)(ws + OFF_MIXB);
  const float* dsk = p.in[I_DSK];
  const float* sng = p.in[I_SNG];
  const float* lxg = p.in[I_LXG];
  const float* lxb = p.in[I_LXB];
  const int lane = threadIdx.x & 63;
  const int gw = blockIdx.x * 8 + (threadIdx.x >> 6), nw = gridDim.x * 8;
  for (int row = gw; row < M; row += nw) {
    const float* o = OMIX + (size_t)row * 2048;
    u16* mo = MIXB + (size_t)row * 2048;
    float4 oc[4], xc[4], z[4], y[4], v[4], gg[4];
    float bn[4];
#pragma unroll
    for (int it = 0; it < 4; ++it) {
      int c = it * 256 + lane * 4;
      oc[it] = ld4(o + c);
      xc[it] = ld4(XC + (size_t)row * 1536 + c);
      z[it] = ld4(PROJ + (size_t)row * N1 + c);
      y[it] = ld4(o + 1024 + c);
      v[it] = ld4(RKV + (size_t)row * 3072 + 2048 + c);
      gg[it] = ld4(GG + (size_t)row * 1024 + c);
      bn[it] = BON[(size_t)row * 16 + it * 4 + (lane >> 4)];
    }
    float4 val[4];
    float ssq[4];
#pragma unroll
    for (int it = 0; it < 4; ++it) {
      float ds = dsk[it * 4 + (lane >> 4)];
      val[it].x = (oc[it].x + xc[it].x * ds) * z[it].x;
      val[it].y = (oc[it].y + xc[it].y * ds) * z[it].y;
      val[it].z = (oc[it].z + xc[it].z * ds) * z[it].z;
      val[it].w = (oc[it].w + xc[it].w * ds) * z[it].w;
      ssq[it] = val[it].x * val[it].x + val[it].y * val[it].y + val[it].z * val[it].z + val[it].w * val[it].w;
    }
    float inv0 = rsqrtf(wsum_u_(ssq[0] + ssq[1]) * (1.0f / 512.0f) + 1e-6f);
    float inv1 = rsqrtf(wsum_u_(ssq[2] + ssq[3]) * (1.0f / 512.0f) + 1e-6f);
#pragma unroll
    for (int it = 0; it < 4; ++it) {
      int c = it * 256 + lane * 4;
      float inv = (it < 2) ? inv0 : inv1;
      float4 sg = ld4(sng + c);
      st_bf4(mo + c, val[it].x * inv * sg.x, val[it].y * inv * sg.y, val[it].z * inv * sg.z, val[it].w * inv * sg.w);
      float mu = red16(y[it].x + y[it].y + y[it].z + y[it].w) * (1.0f / 64.0f);
      float dx = y[it].x - mu, dy = y[it].y - mu, dz = y[it].z - mu, dw = y[it].w - mu;
      float var = red16(dx * dx + dy * dy + dz * dz + dw * dw) * (1.0f / 64.0f);
      float iv = rsqrtf(var + 64e-5f);
      float4 lg = ld4(lxg + c), lb = ld4(lxb + c);
      float y0 = (dx * iv * lg.x + lb.x + bn[it] * v[it].x) * gg[it].x;
      float y1 = (dy * iv * lg.y + lb.y + bn[it] * v[it].y) * gg[it].y;
      float y2 = (dz * iv * lg.z + lb.z + bn[it] * v[it].z) * gg[it].z;
      float y3 = (dw * iv * lg.w + lb.w + bn[it] * v[it].w) * gg[it].w;
      st_bf4(mo + 1024 + c, y0, y1, y2, y3);
    }
  }
}

#define XB_TMO      128
#define XB_XCNT(j)  (256  + 64 * (j))
#define XB_XSUB(j)  (1280 + 64 * (j))
#define XB_XGEN(j)  (2304 + 64 * (j))
#define XB_TOP      3328
#define XB_TOPGEN   3392
#define XCD_BAR_WORDS 3456
#define XB_SPIN_CAP (1u << 18)
#define LAS __attribute__((address_space(3)))

__device__ __forceinline__ unsigned xb_ld(unsigned* p)              { return __hip_atomic_load(p, __ATOMIC_RELAXED, __HIP_MEMORY_SCOPE_AGENT); }
__device__ __forceinline__ unsigned xb_add(unsigned* p, unsigned v) { return __hip_atomic_fetch_add(p, v, __ATOMIC_RELAXED, __HIP_MEMORY_SCOPE_AGENT); }
__device__ __forceinline__ unsigned xb_xcc_id() { return (unsigned)__builtin_amdgcn_s_getreg((3 << 11) | 20) & 0xFu; }
#define XB_SPIN(cond, bar) do { unsigned _sp = 0; while (cond) { __builtin_amdgcn_s_sleep(1); \
    if ((++_sp & 255u) == 0u) { if (xb_ld(&(bar)[XB_TMO])) break; if (_sp > XB_SPIN_CAP) { atomicAdd(&(bar)[XB_TMO], 1u); break; } } } } while (0)

struct XcdBarrier {
    unsigned* bar; unsigned x;
    volatile LAS unsigned* st;
};

__device__ __forceinline__ XcdBarrier xcd_barrier_post(unsigned* bar, volatile LAS unsigned* st) {
    XcdBarrier b; b.bar = bar; b.x = xb_xcc_id(); b.st = st;
    if (threadIdx.x == 0) (void)xb_add(&bar[XB_XCNT(b.x)], 1u);
    return b;
}
__device__ __forceinline__ void xcd_barrier_complete(unsigned* bar, unsigned x, unsigned& nloc, unsigned& nx) {
    const unsigned G = gridDim.x * gridDim.y * gridDim.z;
    unsigned sum, cnt, mine, sp = 0u;
    for (;;) {
        sum = 0u; cnt = 0u; mine = 0u;
#pragma unroll
        for (unsigned j = 0; j < 16; ++j) { const unsigned c = xb_ld(&bar[XB_XCNT(j)]); sum += c; cnt += (c > 0u) ? 1u : 0u; mine = (j == x) ? c : mine; }
        if (sum == G) break;
        __builtin_amdgcn_s_sleep(1);
        if ((++sp & 255u) == 0u) { if (xb_ld(&bar[XB_TMO])) break; if (sp > XB_SPIN_CAP) { atomicAdd(&bar[XB_TMO], 1u); break; } }
    }
    nloc = mine > 0u ? mine : 1u; nx = cnt > 0u ? cnt : 1u;
}

__device__ __forceinline__ void xcd_barrier(const XcdBarrier& b) {
    asm volatile("s_waitcnt vmcnt(0)" ::: "memory");
    __syncthreads();
    if (threadIdx.x == 0) {
        unsigned* bar = b.bar;
        __builtin_amdgcn_s_waitcnt(0);
        unsigned nloc = b.st[0], nx = b.st[1];
        if (nloc == 0u) { xcd_barrier_complete(bar, b.x, nloc, nx); b.st[0] = nloc; b.st[1] = nx; }
        const unsigned old = xb_add(&bar[XB_XSUB(b.x)], 1u);
        const unsigned gen = old / nloc;
        if (old + 1u == (gen + 1u) * nloc) {
            __builtin_amdgcn_fence(__ATOMIC_RELEASE, "agent");
            asm volatile("s_waitcnt vmcnt(0)" ::: "memory");
            const unsigned og = xb_add(&bar[XB_TOP], 1u);
            const unsigned tg = og / nx;
            if (og + 1u == (tg + 1u) * nx) xb_add(&bar[XB_TOPGEN], 1u);
            else XB_SPIN(xb_ld(&bar[XB_TOPGEN]) == tg, bar);
            __builtin_amdgcn_fence(__ATOMIC_ACQUIRE, "agent");
            xb_add(&bar[XB_XGEN(b.x)], 1u);
            asm volatile("s_waitcnt vmcnt(0)" ::: "memory");
        } else {
            XB_SPIN(xb_ld(&bar[XB_XGEN(b.x)]) == gen, bar);
            __builtin_amdgcn_fence(__ATOMIC_ACQUIRE, "agent");
            asm volatile("s_waitcnt vmcnt(0)" ::: "memory");
        }
    }
    __syncthreads();
}


template <int ph>
DEVI void run_phase(const Params& p, char* smem_raw) {
  float* smem = (float*)smem_raw;
  char* ws = p.ws;
  {
    switch (ph) {
      case 0:
        phase0(p, smem);
        conv_fp8_rows(p.in[I_PU], (unsigned char*)(ws + OFF_UB), (float*)(ws + OFF_USC));
        conv_fp8_rows(p.in[I_PV], (unsigned char*)(ws + OFF_VB), (float*)(ws + OFF_VSC));
        break;
      case 1: {
        EpiIn0 E{(float*)(ws + OFF_PROJ), (const float*)(ws + OFF_LB), (const float*)(ws + OFF_INVREV)};
        pg8::Gemm g{(const pg8::bf16_t*)(ws + OFF_XB), (const pg8::bf16_t*)(ws + OFF_WIN0), MP, N0, 2048};
        pg8::StaticOrder S;
        S.init(MP, N0, (int)gridDim.x, (int)blockIdx.x);
        pg8::gemm_phase<EpiIn0, pg8::StaticOrder, false>((PG8_LAS unsigned char*)smem_raw, g, S, E, nullptr);
      } break;
      case 2: phase_rec0(p, smem); break;
      case 3: phase_post0(p); break;
      case 4: case 15: {
        float* GO = (float*)(ws + OFF_GOUT);
        gemm_phase((const u16*)(ws + OFF_MIXB), 2048, 0, (const u16*)(ws + (ph == 4 ? OFF_WOUT0 : OFF_WOUT1)), 2048,
                   69, 16, smem_raw, [=](int row, int col, float v0, float v1) {
                     GO[(size_t)row * 2048 + col] = v0;
                     GO[(size_t)row * 2048 + col + 32] = v1;
                   });
      } break;
      case 5: case 16: {
        int l = (ph == 5) ? 0 : 1;
        phase_ln(p, (const float*)(ws + OFF_GOUT), p.in[I_LNG] + (size_t)(l * 2) * D, p.in[I_LNB] + (size_t)(l * 2) * D);
      } break;
      case 6: case 17: {
        u16* QB = (u16*)(ws + OFF_QB);
        gemm_phase((const u16*)(ws + OFF_XB), 2048, 0, (const u16*)(ws + (ph == 6 ? OFF_WQ0 : OFF_WQ1)), 2048, 69,
                   16, smem_raw, [=](int row, int col, float v0, float v1) {
                     QB[(size_t)row * 2048 + col] = f2bf(v0);
                     QB[(size_t)row * 2048 + col + 32] = f2bf(v1);
                   });
      } break;
      case 7: case 18: {
        float* SC = (float*)(ws + OFF_GOUT);
        gemm_phase((const u16*)(ws + OFF_QB), 2048, 128, (const u16*)(ws + (ph == 7 ? OFF_KEY0 : OFF_KEY1)), 128,
                   69, 16, smem_raw, [=](int row, int col, float v0, float v1) {
                     SC[(size_t)row * 2048 + col] = v0;
                     SC[(size_t)row * 2048 + col + 32] = v1;
                   });
      } break;
      case 8: phase_peer(p, 0, false); break;
      case 9: {
        conv_fp8_rows(p.in[I_PU] + (size_t)16384 * 2048, (unsigned char*)(ws + OFF_UB), (float*)(ws + OFF_USC));
        conv_fp8_rows(p.in[I_PV] + (size_t)16384 * 2048, (unsigned char*)(ws + OFF_VB), (float*)(ws + OFF_VSC));
        EpiIn1 E{(float*)(ws + OFF_PROJ), (float*)(ws + OFF_DTA), p.in[I_DTB], p.in[I_ALOG]};
        pg8::Gemm g{(const pg8::bf16_t*)(ws + OFF_XB), (const pg8::bf16_t*)(ws + OFF_WIN1), MP, N1, 2048};
        pg8::StaticOrder S;
        S.init(MP, N1, (int)gridDim.x, (int)blockIdx.x);
        pg8::gemm_phase<EpiIn1, pg8::StaticOrder, false>((PG8_LAS unsigned char*)smem_raw, g, S, E, nullptr);
      } break;
      case 10: phase_pre1(p); break;
      case 11: {
        float* DEC = (float*)(ws + OFF_DEC);
        float* AA = (float*)(ws + OFF_AA);
        float* GG = (float*)(ws + OFF_GG);
        const float* w0 = p.in[I_W0];
        const float* a0 = p.in[I_A0];
        gemm_phase((const u16*)(ws + OFF_LRA), 64, 0, (const u16*)(ws + OFF_W2T), 64, 69, 8, smem_raw,
                   [=](int row, int col, float v0, float v1) {
#pragma unroll
                     for (int e = 0; e < 2; ++e) {
                       int cc = col + e * 32;
                       float v = (e ? v1 : v0);
                       float wl = -softplusf_(-v) - 0.5f;
                       DEC[(size_t)row * 1024 + cc] = expf(-expf(wl));
                     }
                   }, w0);
        gemm_phase((const u16*)(ws + OFF_LRB), 64, 0, (const u16*)(ws + OFF_A2T), 64, 69, 8, smem_raw,
                   [=](int row, int col, float v0, float v1) {
                     AA[(size_t)row * 1024 + col] = sigmoidf_(v0);
                     AA[(size_t)row * 1024 + col + 32] = sigmoidf_(v1);
                   }, a0);
        gemm_phase((const u16*)(ws + OFF_LRG), 192, 0, (const u16*)(ws + OFF_G2T), 192, 69, 8, smem_raw,
                   [=](int row, int col, float v0, float v1) {
                     GG[(size_t)row * 1024 + col] = v0;
                     GG[(size_t)row * 1024 + col + 32] = v1;
                   });
      } break;
      case 12: phase_pre1c(p); break;
      case 13: phase_rec1(p, smem); break;
      case 14: phase_post1(p); break;
      case 19: phase_peer(p, 1, true); break;
      default: break;
    }
  }
}

__global__ void __launch_bounds__(512, 2) mega(Params p, int ph_lo, int ph_hi) {
  __shared__ __attribute__((aligned(16))) char smem_raw[SMEM_BYTES];
  __shared__ uint4 xb_words;
  cg::grid_group grid = cg::this_grid();
  if (threadIdx.x == 0) xb_words = make_uint4(0u, 0u, 0u, 0u);
  __syncthreads();
  XcdBarrier xb = xcd_barrier_post((unsigned*)(p.ws + OFF_BAR), (volatile LAS unsigned*)&xb_words);
  if (ph_hi > 1000) grid.sync();
#ifndef REPEAT_MASK
#define REPEAT_MASK 0
#endif
#define PHASE(K)                                          \
  if (ph_lo <= K && K < ph_hi) run_phase<K>(p, smem_raw); \
  if ((REPEAT_MASK >> K) & 1) { xcd_barrier(xb); run_phase<K>(p, smem_raw); } \
  if (ph_lo <= K && K + 1 < ph_hi) xcd_barrier(xb);
  PHASE(0) PHASE(1) PHASE(2) PHASE(3) PHASE(4) PHASE(5) PHASE(6) PHASE(7) PHASE(8) PHASE(9)
  PHASE(10) PHASE(11) PHASE(12) PHASE(13) PHASE(14) PHASE(15) PHASE(16) PHASE(17) PHASE(18) PHASE(19)
}
#ifdef PHASE_TEST
template <int PH>
__global__ void __launch_bounds__(512, 2) phk(Params p) {
  __shared__ __attribute__((aligned(16))) char smem_raw[SMEM_BYTES];
  run_phase<PH>(p, smem_raw);
}
#define INST(N) template __global__ void phk<N>(Params);
INST(0) INST(1) INST(2) INST(3) INST(4) INST(5) INST(6) INST(7) INST(8) INST(9) INST(10) INST(11) INST(12) INST(13) INST(14) INST(19)
#endif

constexpr int NPHASE = 20;

extern "C" void kernel_launch(void* const* d_in, const int* in_sizes, int n_in, void* d_out, int out_size, void* d_ws,
                              size_t ws_size, hipStream_t stream) {
  static int grid_blocks = 0;
  if (!grid_blocks) {
    int dev = 0, cus = 0, per_cu = 0;
    hipGetDevice(&dev);
    hipDeviceGetAttribute(&cus, hipDeviceAttributeMultiprocessorCount, dev);
    hipOccupancyMaxActiveBlocksPerMultiprocessor(&per_cu, mega, 512, 0);
    if (per_cu > 1) per_cu = 1;
    if (per_cu < 1) per_cu = 1;
    grid_blocks = cus * per_cu;
  }
  Params p{};
  for (int i = 0; i < 38; ++i) p.in[i] = (const float*)d_in[i];
  p.out = (float*)d_out;
  p.ws = (char*)d_ws;
  (void)hipMemsetAsync((char*)d_ws + OFF_BAR, 0, 3456 * 4, stream);
  int lo = 0, hi = NPHASE;
  void* args[] = {&p, &lo, &hi};
  hipError_t e = hipLaunchCooperativeKernel((void*)mega, dim3(grid_blocks), dim3(512), args, 0, stream);
  if (e != hipSuccess) fprintf(stderr, "cooperative launch failed: %s (grid %d)\n", hipGetErrorString(e), grid_blocks);
}
```

```cpp
#include <hip/hip_runtime.h>
#include <hip/hip_bf16.h>
#include <hip/hip_cooperative_groups.h>
#include <cstdio>
#include <cmath>
namespace cg = cooperative_groups;

#define DEVI __device__ __forceinline__
typedef unsigned short u16;
using bf16x8 = __attribute__((ext_vector_type(8))) short;
using f32x4 = __attribute__((ext_vector_type(4))) float;
using u32x4 = __attribute__((ext_vector_type(4))) unsigned int;

constexpr int D = 2048;
constexpr int TP = 2064;
constexpr int MPR = 8256;
constexpr int M = 8768;
constexpr int MP = 8960;
constexpr int N0 = 7168;
constexpr int N1 = 6144;
constexpr float ALPHA = 1.41421356237f;

constexpr size_t SZ_TAB = (size_t)16384 * 2048 * 2;
constexpr size_t OFF_UB = 0;
constexpr size_t OFF_VB = OFF_UB + SZ_TAB;
constexpr size_t OFF_WIN0 = OFF_VB + SZ_TAB;
constexpr size_t OFF_WOUT0 = OFF_WIN0 + (size_t)N0 * 2048 * 2;
constexpr size_t OFF_WQ0 = OFF_WOUT0 + (size_t)2048 * 2048 * 2;
constexpr size_t OFF_KEY0 = OFF_WQ0 + (size_t)2048 * 2048 * 2;
constexpr size_t OFF_WIN1 = OFF_KEY0 + (size_t)16 * 128 * 128 * 2;
constexpr size_t OFF_WOUT1 = OFF_WIN1 + (size_t)N1 * 2048 * 2;
constexpr size_t OFF_WQ1 = OFF_WOUT1 + (size_t)2048 * 2048 * 2;
constexpr size_t OFF_KEY1 = OFF_WQ1 + (size_t)2048 * 2048 * 2;
constexpr size_t OFF_W2T = OFF_KEY1 + (size_t)16 * 128 * 128 * 2;
constexpr size_t OFF_A2T = OFF_W2T + (size_t)1024 * 64 * 2;
constexpr size_t OFF_G2T = OFF_A2T + (size_t)1024 * 64 * 2;
constexpr size_t OFF_LB = OFF_G2T + (size_t)1024 * 192 * 2;
constexpr size_t OFF_INVREV = OFF_LB + 1024 * 4;
constexpr size_t OFF_XF = OFF_INVREV + 64 * 8;
constexpr size_t OFF_XB = OFF_XF + (size_t)MP * 2048 * 4;
constexpr size_t OFF_PROJ = OFF_XB + (size_t)MP * 2048 * 2;
constexpr size_t OFF_GOUT = OFF_PROJ + (size_t)MP * N0 * 4;
constexpr size_t OFF_OMIX = OFF_GOUT + (size_t)MP * 2048 * 4;
constexpr size_t OFF_MIXB = OFF_OMIX + (size_t)MP * 2048 * 4;
constexpr size_t OFF_QB = OFF_MIXB + (size_t)MP * 2048 * 2;
constexpr size_t OFF_RKV = OFF_QB + (size_t)MP * 2048 * 2;
constexpr size_t OFF_DEC = OFF_RKV + (size_t)MP * 3072 * 4;
constexpr size_t OFF_AA = OFF_DEC + (size_t)MP * 1024 * 4;
constexpr size_t OFF_GG = OFF_AA + (size_t)MP * 1024 * 4;
constexpr size_t OFF_LRA = OFF_GG + (size_t)MP * 1024 * 4;
constexpr size_t OFF_LRB = OFF_LRA + (size_t)MP * 64 * 2;
constexpr size_t OFF_LRG = OFF_LRB + (size_t)MP * 64 * 2;
constexpr size_t OFF_DTA = OFF_LRG + (size_t)MP * 192 * 2;
constexpr size_t OFF_BON = OFF_DTA + (size_t)MP * 64 * 4;
constexpr size_t OFF_USC = OFF_BON + (size_t)MP * 16 * 4;
constexpr size_t OFF_VSC = OFF_USC + 16384 * 4;
constexpr size_t OFF_BAR = OFF_VSC + 16384 * 4;
constexpr size_t WS_TOTAL = OFF_BAR + 3456 * 4;
static_assert(WS_TOTAL <= (size_t)1 << 30, "workspace too large");

constexpr size_t O_YP = 0;
constexpr size_t O_YS = O_YP + (size_t)4 * 2048 * 2048;
constexpr size_t O_HGP = O_YS + (size_t)128 * 4 * 2048;
constexpr size_t O_HGS = O_HGP + (size_t)4 * 8 * 128 * 128;
constexpr size_t O_RTP = O_HGS + (size_t)128 * 8 * 128 * 128;
constexpr size_t O_RTS = O_RTP + (size_t)4 * 4 * 128 * 256;
constexpr size_t O_SSP = O_RTS + (size_t)128 * 4 * 128 * 256;
constexpr size_t O_SSS = O_SSP + (size_t)4 * 16 * 128 * 64;
constexpr size_t O_CVP = O_SSS + (size_t)128 * 16 * 128 * 64;
constexpr size_t O_CVS = O_CVP + (size_t)4 * 3 * 1536;
constexpr size_t O_WKP = O_CVS + (size_t)128 * 3 * 1536;
constexpr size_t O_WKS = O_WKP + (size_t)4 * 16 * 64 * 64;
constexpr size_t O_SHP = O_WKS + (size_t)128 * 16 * 64 * 64;
constexpr size_t O_SHS = O_SHP + (size_t)4 * 3360;

struct Params {
  const float* in[38];
  float* out;
  char* ws;
};
enum { I_XP = 0, I_XS, I_SHG, I_SRT, I_SSM, I_SCV, I_SWK, I_SSH, I_META, I_LNG, I_LNB, I_EWIN, I_LBL, I_HNG, I_EWOUT,
       I_OWIN, I_CVW, I_CVB, I_DTB, I_ALOG, I_DSK, I_SNG, I_MU, I_W0, I_W2, I_A0, I_A2, I_G2, I_KK, I_KA, I_RK,
       I_LXG, I_LXB, I_OWOUT, I_WQ, I_KEYS, I_PU, I_PV };

constexpr int VB_BYTES = 2 * 2 * 128 * 72 * 2;
constexpr int SMEM_BYTES = 2 * VB_BYTES;

DEVI u16 f2bf(float f) {
  unsigned u = __float_as_uint(f);
  u += 0x7fffu + ((u >> 16) & 1u);
  return (u16)(u >> 16);
}
DEVI unsigned pack2(float a, float b) { return (unsigned)f2bf(a) | ((unsigned)f2bf(b) << 16); }
DEVI float bflo(unsigned u) { return __uint_as_float(u << 16); }
DEVI float bfhi(unsigned u) { return __uint_as_float(u & 0xffff0000u); }
DEVI float sigmoidf_(float x) { return __builtin_amdgcn_rcpf(1.0f + __builtin_amdgcn_exp2f(-1.44269504089f * x)); }
DEVI float siluf_(float x) { return x * __builtin_amdgcn_rcpf(1.0f + __builtin_amdgcn_exp2f(-1.44269504089f * x)); }
DEVI float sigmoid_acc(float x) { return 1.0f / (1.0f + expf(-x)); }
DEVI float silu_acc(float x) { return x / (1.0f + expf(-x)); }
DEVI float softplusf_(float x) { return fmaxf(x, 0.0f) + log1pf(expf(-fabsf(x))); }
DEVI float wsum(float v) {
#pragma unroll
  for (int o = 32; o > 0; o >>= 1) v += __shfl_xor(v, o, 64);
  return v;
}
DEVI float wmaxf_(float v) {
#pragma unroll
  for (int o = 32; o > 0; o >>= 1) v = fmaxf(v, __shfl_xor(v, o, 64));
  return v;
}
DEVI int wmini_(int v) {
#pragma unroll
  for (int o = 32; o > 0; o >>= 1) v = min(v, __shfl_xor(v, o, 64));
  return v;
}
template <int CTRL>
DEVI float dppf(float v) {
  return __int_as_float(__builtin_amdgcn_update_dpp(0, __float_as_int(v), CTRL, 0xF, 0xF, true));
}
DEVI float red8(float v) {
  v += dppf<0xB1>(v);
  v += dppf<0x4E>(v);
  v += dppf<0x141>(v);
  return v;
}
DEVI float red16(float v) {
  v = red8(v);
  v += dppf<0x140>(v);
  return v;
}
DEVI float rlf_(float v, int l) { return __int_as_float(__builtin_amdgcn_readlane(__float_as_int(v), l)); }
DEVI int row_pos(int row) { return row < MPR ? (row % TP) : (16384 + ((row - MPR) & 3)); }

DEVI void conv_bf16_flat(const float* __restrict__ src, u16* __restrict__ dst, size_t n4) {
  size_t stride = (size_t)gridDim.x * blockDim.x;
  for (size_t i = (size_t)blockIdx.x * blockDim.x + threadIdx.x; i < n4; i += stride) {
    float4 v = ((const float4*)src)[i];
    uint2 o;
    o.x = pack2(v.x, v.y);
    o.y = pack2(v.z, v.w);
    ((uint2*)dst)[i] = o;
  }
}

template <int MODE>
DEVI int colmap(int j) {
  if (MODE == 0) return j;
  if (MODE == 1) {
    if (j < 4096 || j >= 5120) return j;
    int hb = j & ~127, c = j & 127, wc = c >> 5, n = (c >> 4) & 1, r = c & 15;
    int d = n ? (64 + wc * 16 + r) : (wc * 16 + r);
    return hb + d;
  }
  if (j < 2560) return j;
  if (j < 5920) return j + 16;
  if (j < 5936) return 2560 + (j - 5920);
  return -1;
}

template <int MODE>
DEVI void transpose_job(const float* __restrict__ src, int ldsrc, int Ksrc, u16* __restrict__ dst, int Kdst, int ndst,
                        float* smem) {
  int ktiles = Kdst / 64, ntiles = ndst / 64;
  int tid = threadIdx.x & 255;
  const int half = threadIdx.x >> 8;
  smem += half * (64 * 65);
  for (int base = blockIdx.x * 2; base < ktiles * ntiles; base += gridDim.x * 2) {
    int tile = base + half;
    const bool valid = tile < ktiles * ntiles;
    if (!valid) tile = ktiles * ntiles - 1;
    int tn = tile / ktiles, tk = tile % ktiles;
    int j0 = tn * 64, k0 = tk * 64;
    int jj = tid & 63;
    int sc = colmap<MODE>(j0 + jj);
#pragma unroll
    for (int i = 0; i < 16; ++i) {
      int kk = i * 4 + (tid >> 6);
      float v = 0.f;
      if (sc >= 0 && (k0 + kk) < Ksrc) v = src[(size_t)(k0 + kk) * ldsrc + sc];
      smem[kk * 65 + jj] = v;
    }
    __syncthreads();
    int jr = tid >> 2, kq = (tid & 3) * 16;
    unsigned pk[8];
#pragma unroll
    for (int e = 0; e < 8; ++e) pk[e] = pack2(smem[(kq + 2 * e) * 65 + jr], smem[(kq + 2 * e + 1) * 65 + jr]);
    uint4* dp = (uint4*)(dst + (size_t)(j0 + jr) * Kdst + k0 + kq);
    if (valid) {
      dp[0] = make_uint4(pk[0], pk[1], pk[2], pk[3]);
      dp[1] = make_uint4(pk[4], pk[5], pk[6], pk[7]);
    }
    __syncthreads();
  }
}

DEVI void phase0(const Params& p, float* smem) {
  char* ws = p.ws;
  conv_bf16_flat(p.in[I_KEYS], (u16*)(ws + OFF_KEY0), (size_t)16 * 128 * 128 / 4);
  conv_bf16_flat(p.in[I_KEYS] + (size_t)16 * 128 * 128, (u16*)(ws + OFF_KEY1), (size_t)16 * 128 * 128 / 4);
  transpose_job<1>(p.in[I_EWIN], N0, 2048, (u16*)(ws + OFF_WIN0), 2048, N0, smem);
  transpose_job<0>(p.in[I_EWOUT], 2048, 2048, (u16*)(ws + OFF_WOUT0), 2048, 2048, smem);
  transpose_job<0>(p.in[I_WQ], 2048, 2048, (u16*)(ws + OFF_WQ0), 2048, 2048, smem);
  transpose_job<0>(p.in[I_WQ] + (size_t)2048 * 2048, 2048, 2048, (u16*)(ws + OFF_WQ1), 2048, 2048, smem);
  transpose_job<2>(p.in[I_OWIN], 5936, 2048, (u16*)(ws + OFF_WIN1), 2048, N1, smem);
  transpose_job<0>(p.in[I_OWOUT], 2048, 2048, (u16*)(ws + OFF_WOUT1), 2048, 2048, smem);
  transpose_job<0>(p.in[I_W2], 1024, 64, (u16*)(ws + OFF_W2T), 64, 1024, smem);
  transpose_job<0>(p.in[I_A2], 1024, 64, (u16*)(ws + OFF_A2T), 64, 1024, smem);
  transpose_job<0>(p.in[I_G2], 1024, 160, (u16*)(ws + OFF_G2T), 192, 1024, smem);
  {
    float* XF = (float*)(ws + OFF_XF);
    u16* XB = (u16*)(ws + OFF_XB);
    size_t n4 = (size_t)MP * 512;
    size_t stride = (size_t)gridDim.x * blockDim.x;
    for (size_t i = (size_t)blockIdx.x * blockDim.x + threadIdx.x; i < n4; i += stride) {
      int row = (int)(i >> 9), c4 = (int)(i & 511);
      float4 v = make_float4(0.f, 0.f, 0.f, 0.f);
      if (row < MPR) {
        int b = row / TP, t = row % TP;
        const float* s = (t < 16) ? (p.in[I_META] + (size_t)t * D) : (p.in[I_XP] + ((size_t)b * 2048 + (t - 16)) * D);
        v = ((const float4*)s)[c4];
      } else if (row < M) {
        v = ((const float4*)(p.in[I_XS] + (size_t)(row - MPR) * D))[c4];
      }
      ((float4*)XF)[i] = v;
      uint2 o;
      o.x = pack2(v.x, v.y);
      o.y = pack2(v.z, v.w);
      ((uint2*)XB)[i] = o;
    }
  }
  if (blockIdx.x == 0) {
    float* LB = (float*)(ws + OFF_LB);
    const float* lg = p.in[I_LBL];
    for (int c = threadIdx.x; c < 1024; c += blockDim.x) {
      float a = lg[c], b = lg[1024 + c], d = lg[2048 + c];
      float m = fmaxf(a, fmaxf(b, d));
      float ea = expf(a - m), eb = expf(b - m), ed = expf(d - m);
      LB[c] = ea / (ea + eb + ed);
    }
    float* IR = (float*)(ws + OFF_INVREV);
    if (threadIdx.x < 64) {
      double d = (double)threadIdx.x;
      double v = exp(-d * (9.210340371976184 / 64.0)) * 0.15915494309189535;
      float h = (float)v;
      IR[threadIdx.x * 2] = h;
      IR[threadIdx.x * 2 + 1] = (float)(v - (double)h);
    }
  }
}

constexpr int G_LDS_STRIDE = 72;
constexpr int G_LDS_BUF = 2 * 128 * G_LDS_STRIDE;
template <class Epi>
DEVI void gemm_phase(const u16* __restrict__ A, int lda, int a_ntile_off, const u16* __restrict__ Bt, int K, int mtiles,
                     int ntiles, char* smem, Epi epi, const float* __restrict__ colc = nullptr) {
  const int half = threadIdx.x >> 8;
  u16* S0 = (u16*)(smem + half * VB_BYTES);
  const int tid = threadIdx.x & 255, wid = tid >> 6, lane = tid & 63, wr = wid >> 1, wc = wid & 1, fr = lane & 15, fq = lane >> 4;
  const int nk = K / 64;
  const int ntot = mtiles * ntiles;
  for (int base = blockIdx.x * 2; base < ntot; base += gridDim.x * 2) {
    int tile = base + half;
    const bool valid = tile < ntot;
    if (!valid) tile = ntot - 1;
    const int tm = tile / ntiles, tn = tile - tm * ntiles;
    const int brow = tm * 128, bcol = tn * 128;
    const u16* Ag = A + (size_t)brow * lda + (size_t)tn * a_ntile_off;
    const u16* Bg = Bt + (size_t)bcol * K;
    f32x4 acc[4][4];
#pragma unroll
    for (int m = 0; m < 4; ++m)
#pragma unroll
      for (int n = 0; n < 4; ++n) acc[m][n] = f32x4{0.f, 0.f, 0.f, 0.f};
    u32x4 ra0[4], rb0[4], ra1[4], rb1[4];
    auto gload = [&](int t, u32x4(&ra)[4], u32x4(&rb)[4]) {
#pragma unroll
      for (int i = 0; i < 4; ++i) {
        int c = tid + i * 256, r = c >> 3, kc = c & 7;
        ra[i] = *(const u32x4*)(Ag + (size_t)r * lda + t * 64 + kc * 8);
        rb[i] = *(const u32x4*)(Bg + (size_t)r * K + t * 64 + kc * 8);
      }
    };
    auto lwrite = [&](int buf, const u32x4(&ra)[4], const u32x4(&rb)[4]) {
      u16* SA = S0 + buf * G_LDS_BUF;
      u16* SB = SA + 128 * G_LDS_STRIDE;
#pragma unroll
      for (int i = 0; i < 4; ++i) {
        int c = tid + i * 256, r = c >> 3, kc = c & 7;
        *(u32x4*)(SA + r * G_LDS_STRIDE + kc * 8) = ra[i];
        *(u32x4*)(SB + r * G_LDS_STRIDE + kc * 8) = rb[i];
      }
    };
    auto compute = [&](int buf) {
      const u16* SA = S0 + buf * G_LDS_BUF;
      const u16* SB = SA + 128 * G_LDS_STRIDE;
#pragma unroll
      for (int kh = 0; kh < 2; ++kh) {
        bf16x8 At[4], Bl[4];
#pragma unroll
        for (int m = 0; m < 4; ++m)
          At[m] = *(const bf16x8*)(SA + (wr * 64 + m * 16 + fr) * G_LDS_STRIDE + kh * 32 + fq * 8);
#pragma unroll
        for (int n = 0; n < 4; ++n)
          Bl[n] = *(const bf16x8*)(SB + (wc * 64 + n * 16 + fr) * G_LDS_STRIDE + kh * 32 + fq * 8);
#pragma unroll
        for (int m = 0; m < 4; ++m)
#pragma unroll
          for (int n = 0; n < 4; ++n) acc[m][n] = __builtin_amdgcn_mfma_f32_16x16x32_bf16(At[m], Bl[n], acc[m][n], 0, 0, 0);
        __builtin_amdgcn_sched_barrier(0);
      }
    };
    gload(0, ra0, rb0);
    if (nk > 1) gload(1, ra1, rb1);
    lwrite(0, ra0, rb0);
    __syncthreads();
#pragma unroll 1
    for (int t = 0; t < nk; t += 2) {
      if (t + 2 < nk) gload(t + 2, ra0, rb0);
      compute(0);
      if (t + 1 < nk) lwrite(1, ra1, rb1);
      __syncthreads();
      if (t + 1 < nk) {
        if (t + 3 < nk) gload(t + 3, ra1, rb1);
        compute(1);
        if (t + 2 < nk) lwrite(0, ra0, rb0);
        __syncthreads();
      }
    }
    if (valid) {
      float cc[4] = {0.f, 0.f, 0.f, 0.f};
      if (colc) {
#pragma unroll
        for (int n = 0; n < 4; ++n) cc[n] = colc[bcol + wc * 64 + n * 16 + fr];
      }
#pragma unroll
      for (int m = 0; m < 4; ++m)
#pragma unroll
        for (int n = 0; n < 2; ++n)
#pragma unroll
          for (int j = 0; j < 4; ++j) {
            int row = brow + wr * 64 + m * 16 + fq * 4 + j;
            int col = bcol + wc * 64 + n * 16 + fr;
            epi(row, col, acc[m][n][j] + cc[n], acc[m][n + 2][j] + cc[n + 2]);
          }
    }
  }
}


namespace pg8 {
#define PG8_LAS __attribute__((address_space(3)))
typedef unsigned short bf16_t;
typedef short bf16x8 __attribute__((ext_vector_type(8)));
typedef float f32x4 __attribute__((ext_vector_type(4)));
typedef unsigned u32x4 __attribute__((ext_vector_type(4)));
constexpr int BM = 256, BK = 64, HALF = 128, HTB = HALF * BK * 2  , STAGE_BYTES = 8 * HTB, NXCD = 8, WGM = 8;

__host__ __device__ __forceinline__ int lds_byte(int r, int c) { const int st = (r >> 4) * 2 + (c >> 5), rr = r & 15, cc = c & 31, ob = rr * 64 + cc * 2; return st * 1024 + (ob ^ (((ob >> 9) & 1) << 5)); }
__host__ __device__ __forceinline__ void stage_rc(int b, int& R, int& C) { const int st = b / 1024, sb = b % 1024, swz = sb ^ (((sb >> 9) & 1) << 5); R = (st >> 1) * 16 + swz / 64; C = (st & 1) * 32 + (swz % 64) / 2; }
__host__ __device__ __forceinline__ int perm32(int rho) { const int n = rho >> 4, i = rho & 15; return 8 * (i >> 2) + 4 * n + (i & 3); }

struct Unit { int pm, pn; };
struct Gemm { const bf16_t* A; const bf16_t* Bt; int M, N, K; };

struct StaticOrder {
    int nM, nN, nwg, G, c;
    __host__ __device__ void init(int M, int N, int G_, int c_) { nM = M / BM; nN = N / BM; nwg = nM * nN; G = G_; c = c_; }
    __host__ __device__ bool next(int i, Unit& u) const {
        const long L = (long)i * G + c; if (L >= nwg) return false;
        int wgid = (int)L; { const int q = nwg / NXCD, r = nwg % NXCD, xcd = wgid % NXCD, off = wgid / NXCD; wgid = (xcd < r ? xcd * (q + 1) : r * (q + 1) + (xcd - r) * q) + off; }
        const int nig = WGM * nN, gid = wgid / nig, fm = gid * WGM, gsz = (nM - fm) < WGM ? (nM - fm) : WGM;
        u.pm = fm + ((wgid % nig) % gsz); u.pn = (wgid % nig) / gsz; return true;
    }
    __device__ __forceinline__ void a_ready(const Unit&) const {}
    __device__ __forceinline__ void done(const Unit&) const {}
};
template <class Epi, class Sched, bool STAMP = false>
__device__ __forceinline__ void gemm_phase(PG8_LAS unsigned char* lds, const Gemm g, const Sched& S, const Epi& E, unsigned long long* stamps) {
    const int tid = threadIdx.x, wid = __builtin_amdgcn_readfirstlane(tid >> 6), lane = tid & 63, wr = wid >> 2, wc = wid & 3, fr = lane & 15, fq = lane >> 4;
    const int K = g.K, nt = K / BK;
    int ts_lo = 0, ts_hi = 0, nts = 0; const unsigned long long rt_entry = STAMP ? (unsigned long long)wall_clock64() : 0ull;
#define PG8_STAMP() do { if (STAMP && wid == 0 && nts < 64) { const unsigned long long _c = (unsigned long long)clock64(); \
        ts_lo = (lane == nts) ? (int)(unsigned)_c : ts_lo; ts_hi = (lane == nts) ? (int)(unsigned)(_c >> 32) : ts_hi; ++nts; } } while (0)
    PG8_STAMP();
    unsigned voffA[2], voffB[2];
#pragma unroll
    for (int i = 0; i < 2; ++i) { int R, C; stage_rc(tid * 16 + i * 8192, R, C); const int Rb = Epi::PERM ? ((R & ~31) + perm32(R & 31)) : R;
        voffA[i] = (unsigned)(R * K + C) * 2u; voffB[i] = (unsigned)(Rb * K + C) * 2u; }
    const size_t kstep = (size_t)(BK * 2);
    const size_t hstep = (size_t)HALF * K * 2;
    const size_t tstep = 2 * hstep;
    const unsigned ldsw = (unsigned)wid * 1024u;
    const int aoff = lds_byte(wr * 64 + fr, fq * 8), boff = lds_byte(wc * 32 + fr, fq * 8);
#define PG8_SA(b, h) (((b) * 2 + (h)) * HTB)
#define PG8_SB(b, h) ((4 + (b) * 2 + (h)) * HTB)
#define PG8_STAGE(bufoff, gbase, voff) do { _Pragma("unroll") for (int _i = 0; _i < 2; ++_i) \
        __builtin_amdgcn_global_load_lds((const unsigned*)((const char*)(gbase) + (voff)[_i]), (PG8_LAS unsigned*)(lds + (bufoff) + ldsw + _i * 8192), 16, 0, 0); } while (0)
#define PG8_LDA(dst, b, h) do { _Pragma("unroll") for (int m = 0; m < 4; ++m) _Pragma("unroll") for (int k = 0; k < 2; ++k) dst[m][k] = *(const PG8_LAS bf16x8*)(lds + PG8_SA(b, h) + aoff + m * 2048 + k * 1024); } while (0)
#define PG8_LDB(dst, b, h) do { _Pragma("unroll") for (int n = 0; n < 2; ++n) _Pragma("unroll") for (int k = 0; k < 2; ++k) dst[n][k] = *(const PG8_LAS bf16x8*)(lds + PG8_SB(b, h) + boff + n * 2048 + k * 1024); } while (0)
#define PG8_MMA(ai, bj, At, Bt) do { __builtin_amdgcn_s_setprio(1); _Pragma("unroll") for (int m = 0; m < 4; ++m) _Pragma("unroll") for (int n = 0; n < 2; ++n) _Pragma("unroll") for (int k = 0; k < 2; ++k) \
        acc[ai][bj][m][n] = __builtin_amdgcn_mfma_f32_16x16x32_bf16(Bt[n][k], At[m][k], acc[ai][bj][m][n], 0, 0, 0); __builtin_amdgcn_s_setprio(0); } while (0)
#define PG8_WAIT_V(n) asm volatile("s_waitcnt vmcnt(" #n ")" ::: "memory")
#define PG8_WAIT_L(n) asm volatile("s_waitcnt lgkmcnt(" #n ")" ::: "memory")
#define PG8_BAR __builtin_amdgcn_s_barrier()
#define PG8_SCHED __builtin_amdgcn_sched_barrier(0)
    Unit cur, nxt; int ui = 0;
    if (!S.next(0, cur)) return;
    f32x4 acc[2][2][4][2];
#pragma unroll
    for (int a = 0; a < 2; ++a)
#pragma unroll
        for (int b = 0; b < 2; ++b)
#pragma unroll
            for (int m = 0; m < 4; ++m)
#pragma unroll
                for (int n = 0; n < 2; ++n) acc[a][b][m][n] = (f32x4){0.f, 0.f, 0.f, 0.f};
    bf16x8 At[4][2], B0[2][2], B1[2][2];
    const char* cA = (const char*)g.A + (size_t)cur.pm * tstep; const char* cB = (const char*)g.Bt + (size_t)cur.pn * tstep;
    S.a_ready(cur);
    PG8_STAGE(PG8_SB(0, 0), cB, voffB); PG8_STAGE(PG8_SA(0, 0), cA, voffA); PG8_STAGE(PG8_SB(0, 1), cB + hstep, voffB); PG8_STAGE(PG8_SA(0, 1), cA + hstep, voffA);
    if (wr == 1) PG8_BAR;
    PG8_WAIT_V(4); PG8_BAR;
    PG8_STAGE(PG8_SB(1, 0), cB + kstep, voffB); PG8_STAGE(PG8_SA(1, 0), cA + kstep, voffA); PG8_STAGE(PG8_SB(1, 1), cB + hstep + kstep, voffB);
    PG8_WAIT_V(6); PG8_BAR;
    PG8_STAMP();
    for (;;) {
        const bool has_next = S.next(ui + 1, nxt);
        const char* nA = has_next ? (const char*)g.A + (size_t)nxt.pm * tstep : cA; const char* nB = has_next ? (const char*)g.Bt + (size_t)nxt.pn * tstep : cB;
        for (int t = 0; t < nt; t += 2) {
            const bool last = (t == nt - 2);
            const char* a1 = cA + (size_t)(t + 1) * kstep;
            const char* a2 = last ? nA : cA + (size_t)(t + 2) * kstep; const char* b2 = last ? nB : cB + (size_t)(t + 2) * kstep;
            const char* a3 = a2 + kstep; const char* b3 = b2 + kstep;
            if (last && has_next) S.a_ready(nxt);
            PG8_LDB(B0, 0, 0); PG8_SCHED; PG8_LDA(At, 0, 0); PG8_STAGE(PG8_SA(1, 1), a1 + hstep, voffA);
            PG8_WAIT_L(8); PG8_BAR; PG8_WAIT_L(0); PG8_MMA(0, 0, At, B0); PG8_BAR; PG8_SCHED;
            PG8_LDB(B1, 0, 1); PG8_STAGE(PG8_SB(0, 0), b2, voffB);
            PG8_BAR; PG8_WAIT_L(0); PG8_MMA(0, 1, At, B1); PG8_BAR;
            PG8_LDA(At, 0, 1); PG8_STAGE(PG8_SA(0, 0), a2, voffA);
            PG8_BAR; PG8_WAIT_L(0); PG8_MMA(1, 0, At, B0); PG8_BAR; PG8_SCHED;
            PG8_STAGE(PG8_SB(0, 1), b2 + hstep, voffB);
            PG8_WAIT_V(6); PG8_BAR; PG8_MMA(1, 1, At, B1); PG8_BAR;
            PG8_LDB(B0, 1, 0); PG8_SCHED; PG8_LDA(At, 1, 0); PG8_STAGE(PG8_SA(0, 1), a2 + hstep, voffA);
            PG8_WAIT_L(8); PG8_BAR; PG8_WAIT_L(0); PG8_MMA(0, 0, At, B0); PG8_BAR; PG8_SCHED;
            PG8_LDB(B1, 1, 1); PG8_STAGE(PG8_SB(1, 0), b3, voffB);
            PG8_BAR; PG8_WAIT_L(0); PG8_MMA(0, 1, At, B1); PG8_BAR;
            PG8_LDA(At, 1, 1); PG8_STAGE(PG8_SA(1, 0), a3, voffA);
            PG8_BAR; PG8_WAIT_L(0); PG8_MMA(1, 0, At, B0); PG8_BAR; PG8_SCHED;
            PG8_STAGE(PG8_SB(1, 1), b3 + hstep, voffB);
            PG8_WAIT_V(6); PG8_BAR; PG8_MMA(1, 1, At, B1); PG8_BAR;
        }
        PG8_STAMP();
        if constexpr (!Epi::AFTER_DRAIN) { E(acc, cur, wr, wc, fr, fq); S.done(cur); }
        PG8_STAMP();
        if (!has_next) break;
#pragma unroll
        for (int a = 0; a < 2; ++a)
#pragma unroll
            for (int b = 0; b < 2; ++b)
#pragma unroll
                for (int m = 0; m < 4; ++m)
#pragma unroll
                    for (int n = 0; n < 2; ++n) acc[a][b][m][n] = (f32x4){0.f, 0.f, 0.f, 0.f};
        cur = nxt; cA = nA; cB = nB; ++ui;
    }
    PG8_WAIT_V(0);
    if (wr == 0) PG8_BAR;
    PG8_BAR;
    if constexpr (Epi::AFTER_DRAIN) { E.fused(acc, cur, wr, wc, fr, fq, lds, wid, lane); S.done(cur); }
    PG8_STAMP();
    if (STAMP && wid == 0) { stamps[lane] = lane < nts ? (((unsigned long long)(unsigned)ts_hi << 32) | (unsigned)ts_lo) : 0ull;
        if (lane == 62) stamps[62] = rt_entry; if (lane == 63) stamps[63] = (unsigned long long)wall_clock64(); }
#undef PG8_STAMP
#undef PG8_SA
#undef PG8_SB
#undef PG8_STAGE
#undef PG8_LDA
#undef PG8_LDB
#undef PG8_MMA
#undef PG8_WAIT_V
#undef PG8_WAIT_L
#undef PG8_BAR
#undef PG8_SCHED
}
}

struct EpiIn0 {
  static constexpr bool PERM = false, AFTER_DRAIN = false;
  float* PROJ;
  const float* LB;
  const float* IR;
  __device__ __forceinline__ void operator()(const pg8::f32x4 (&acc)[2][2][4][2], const pg8::Unit& u, int wr, int wc, int fr, int fq) const {
#pragma unroll
    for (int bj = 0; bj < 2; ++bj) {
      const int cb = u.pn * 256 + bj * 128;
      if (cb >= 4096 && cb < 5120) {
        const int d0 = wc * 16 + 4 * fq;
        const pg8::f32x4 irA = *(const pg8::f32x4*)(IR + 2 * d0), irB = *(const pg8::f32x4*)(IR + 2 * d0 + 4);
        const float irh[4] = {irA[0], irA[2], irB[0], irB[2]}, irl[4] = {irA[1], irA[3], irB[1], irB[3]};
        const float sc = (cb >= 4608) ? 0.08838834764831845f : 1.0f;
#pragma unroll
        for (int ai = 0; ai < 2; ++ai)
#pragma unroll
          for (int m = 0; m < 4; ++m) {
            const int row = u.pm * 256 + ai * 128 + wr * 64 + m * 16 + fr;
            float* pr = PROJ + (size_t)row * N0;
            const pg8::f32x4 v0 = acc[ai][bj][m][0], v1 = acc[ai][bj][m][1];
            const float pos = (float)row_pos(row);
            pg8::f32x4 o1, o2;
#pragma unroll
            for (int j = 0; j < 4; ++j) {
              float ph = pos * irh[j];
              float pe = __builtin_fmaf(pos, irh[j], -ph) + pos * irl[j];
              float frc = __builtin_amdgcn_fractf(ph) + pe;
              float sn = __builtin_amdgcn_sinf(frc), cs = __builtin_amdgcn_cosf(frc);
              o1[j] = (v0[j] * cs - v1[j] * sn) * sc;
              o2[j] = (v0[j] * sn + v1[j] * cs) * sc;
            }
            *(pg8::f32x4*)(pr + cb + d0) = o1;
            *(pg8::f32x4*)(pr + cb + 64 + d0) = o2;
            __builtin_amdgcn_sched_barrier(0);
          }
      } else if (cb >= 1024 && cb < 2048) {
        const int c0 = cb + 32 * wc + 4 * fq;
        const pg8::f32x4 l0 = *(const pg8::f32x4*)(LB + c0 - 1024), l1 = *(const pg8::f32x4*)(LB + c0 + 16 - 1024);
#pragma unroll
        for (int ai = 0; ai < 2; ++ai)
#pragma unroll
          for (int m = 0; m < 4; ++m) {
            const int row = u.pm * 256 + ai * 128 + wr * 64 + m * 16 + fr;
            float* pr = PROJ + (size_t)row * N0;
#pragma unroll
            for (int n = 0; n < 2; ++n) {
              const pg8::f32x4 l = n ? l1 : l0;
              pg8::f32x4 v = acc[ai][bj][m][n], o;
#pragma unroll
              for (int j = 0; j < 4; ++j) o[j] = l[j] + (1.0f - l[j]) * sigmoid_acc(v[j]);
              *(pg8::f32x4*)(pr + c0 + 16 * n) = o;
            }
            __builtin_amdgcn_sched_barrier(0);
          }
      } else {
        const bool act = (cb < 1024 || (cb >= 3072 && cb < 4096) || cb >= 6144);
        const int c0 = cb + 32 * wc + 4 * fq;
#pragma unroll
        for (int ai = 0; ai < 2; ++ai)
#pragma unroll
          for (int m = 0; m < 4; ++m) {
            const int row = u.pm * 256 + ai * 128 + wr * 64 + m * 16 + fr;
            float* pr = PROJ + (size_t)row * N0;
#pragma unroll
            for (int n = 0; n < 2; ++n) {
              pg8::f32x4 v = acc[ai][bj][m][n], o;
#pragma unroll
              for (int j = 0; j < 4; ++j) o[j] = act ? silu_acc(v[j]) : v[j];
              *(pg8::f32x4*)(pr + c0 + 16 * n) = o;
            }
            __builtin_amdgcn_sched_barrier(0);
          }
      }
    }
  }
};
struct EpiIn1 {
  static constexpr bool PERM = false, AFTER_DRAIN = false;
  float* PROJ;
  float* DTA;
  const float* dtb;
  const float* alog;
  __device__ __forceinline__ void operator()(const pg8::f32x4 (&acc)[2][2][4][2], const pg8::Unit& u, int wr, int wc, int fr, int fq) const {
    float dtbv[4] = {0.f, 0.f, 0.f, 0.f}, aev[4] = {0.f, 0.f, 0.f, 0.f};
    if (u.pn == 23) {
      const int cc = 23 * 256 + 32 * wc + 4 * fq;
      const int hb = (cc >= 5920 && cc < 5936) ? (cc - 5920) : ((cc + 16 >= 5920 && cc + 16 < 5936) ? (cc + 16 - 5920) : -1);
      if (hb >= 0) {
#pragma unroll
        for (int j = 0; j < 4; ++j) { dtbv[j] = dtb[hb + j]; aev[j] = expf(alog[hb + j]); }
      }
    }
#pragma unroll
    for (int ai = 0; ai < 2; ++ai)
#pragma unroll
      for (int m = 0; m < 4; ++m) {
        const int row = u.pm * 256 + ai * 128 + wr * 64 + m * 16 + fr;
        float* pr = PROJ + (size_t)row * N1;
#pragma unroll
        for (int bj = 0; bj < 2; ++bj)
#pragma unroll
          for (int n = 0; n < 2; ++n) {
            const int col0 = u.pn * 256 + bj * 128 + 32 * wc + 16 * n + 4 * fq;
            pg8::f32x4 v = acc[ai][bj][m][n];
            if (col0 < 1024) {
              pg8::f32x4 o;
#pragma unroll
              for (int j = 0; j < 4; ++j) o[j] = siluf_(v[j]);
              *(pg8::f32x4*)(pr + col0) = o;
            } else if (col0 < 5920) {
              *(pg8::f32x4*)(pr + col0) = v;
            } else if (col0 < 5936) {
#pragma unroll
              for (int j = 0; j < 4; ++j) {
                int h = col0 + j - 5920;
                float dt = softplusf_(v[j] + dtbv[j]);
                DTA[(size_t)row * 64 + h * 4] = dt;
                DTA[(size_t)row * 64 + h * 4 + 1] = expf(-dt * aev[j]);
              }
            }
          }
      }
  }
};

struct Seg {
  int off;
  int ld;
  int n4;
};

template <int NS, int NF4, int RG>
DEVI void stage_init(const float* wsf, const Seg (&sg)[NS], int row0, int tid, const float* (&ptr)[RG], int (&ldv)[RG]) {
  asm volatile("" : "+v"(tid));
#pragma unroll
  for (int q = 0; q < RG; ++q) {
    int flat = tid + q * 256;
    int t = flat / NF4, f = flat % NF4;
    if (flat >= 16 * NF4) { t = 0; f = 0; }
    int off = 0, ld = 0, ff = f;
    bool done = false;
#pragma unroll
    for (int s = 0; s < NS; ++s) {
      bool here = (!done) && (ff < sg[s].n4);
      off = here ? (sg[s].off + (row0 + t) * sg[s].ld + ff * 4) : off;
      ld = here ? sg[s].ld : ld;
      ff = (done || here) ? ff : (ff - sg[s].n4);
      done = done || here;
    }
    ptr[q] = wsf + off;
    ldv[q] = ld;
  }
}
template <int NF4, int RG>
DEVI void stage_issue(const float* const (&ptr)[RG], const int (&ldv)[RG], int st, int nsteps, int tid, f32x4 (&rg)[RG]) {
#pragma unroll
  for (int q = 0; q < RG; ++q) {
    int flat = tid + q * 256;
    if (flat < nsteps * NF4) rg[q] = *(const f32x4*)(ptr[q] + (st * 16) * ldv[q]);
  }
}
template <int NF4, int RG>
DEVI void stage_commit(float* buf, int nsteps, int tid, const f32x4 (&rg)[RG]) {
#pragma unroll
  for (int q = 0; q < RG; ++q) {
    int flat = tid + q * 256;
    if (flat < nsteps * NF4) ((f32x4*)buf)[flat] = rg[q];
  }
}

template <int MODE>
DEVI void colrec_long(const float* wsf, const Seg (&sg)[4], int row0, int T, float gamma, float* outp, int ldo, float* stout, int st_ld,
                      float* smem) {
  constexpr int NF4 = 69, W = 276, RG = 5;
  const int tid = threadIdx.x & 255, w = tid >> 6, lane = tid & 63, c = lane >> 4, s = lane & 15;
  smem += (threadIdx.x >> 8) * (VB_BYTES / 4);
  float S[8];
#pragma unroll
  for (int i = 0; i < 8; ++i) S[i] = 0.f;
  float* buf0 = smem;
  float* buf1 = smem + 16 * 336;
  float* obuf = smem + 2 * 16 * 336;
  const int nst = (T + 15) / 16;
  f32x4 rgA[RG], rgB[RG];
  const float* sptr[RG];
  int sld[RG];
  stage_init<4, NF4, RG>(wsf, sg, row0, tid, sptr, sld);
  auto step = [&](const float* sp, float* ob, int tt) -> float {
    float4 a0 = *(const float4*)(sp + s * 8), a1 = *(const float4*)(sp + s * 8 + 4);
    float4 q0 = *(const float4*)(sp + 128 + s * 8), q1 = *(const float4*)(sp + 128 + s * 8 + 4);
    float a[8] = {a0.x, a0.y, a0.z, a0.w, a1.x, a1.y, a1.z, a1.w};
    float q[8] = {q0.x, q0.y, q0.z, q0.w, q1.x, q1.y, q1.z, q1.w};
    float val = sp[256 + w * 4 + c];
    float dA = gamma;
    if (MODE == 2) {
      val *= sp[272];
      dA = sp[273];
    }
    float o = 0.f;
#pragma unroll
    for (int i = 0; i < 8; ++i) {
      if (MODE == 0) S[i] = val + a[i] * (S[i] - val);
      else S[i] = dA * S[i] + a[i] * val;
      o += q[i] * S[i];
    }
    return red16(o);
  };
  auto run_stage = [&](const float* b, float* ob, int nthis) {
#pragma unroll 1
    for (int tt = 0; tt < nthis; tt += 4) {
      float o0 = step(b + tt * W, ob, tt);
      float o1 = step(b + (tt + 1) * W, ob, tt + 1);
      float o2 = step(b + (tt + 2) * W, ob, tt + 2);
      float o3 = step(b + (tt + 3) * W, ob, tt + 3);
      const int base = (s == 0) ? (tt * 16 + w * 4 + c) : (1024 + (tid & 255));
      const int st16 = (s == 0) ? 16 : 0;
      ob[base] = o0;
      ob[base + st16] = o1;
      ob[base + 2 * st16] = o2;
      ob[base + 3 * st16] = o3;
    }
  };
  auto write_out = [&](const float* ob, int st, int nthis) {
    if (tid < nthis * 4) {
      int t = tid >> 2, c4 = tid & 3;
      *(float4*)(outp + (size_t)(st * 16 + t) * ldo + c4 * 4) = *(const float4*)(ob + t * 16 + c4 * 4);
    }
  };
  auto nsteps = [&](int st) { return min(16, T - st * 16); };
  stage_issue<NF4, RG>(sptr, sld, 0, nsteps(0), tid, rgA);
  stage_commit<NF4, RG>(buf0, nsteps(0), tid, rgA);
  if (nst > 1) stage_issue<NF4, RG>(sptr, sld, 1, nsteps(1), tid, rgB);
  __syncthreads();
#pragma unroll 1
  for (int st = 0; st < nst; st += 2) {
    if (st + 2 < nst) stage_issue<NF4, RG>(sptr, sld, st + 2, nsteps(st + 2), tid, rgA);
    run_stage(buf0, obuf, nsteps(st));
    if (st + 1 < nst) stage_commit<NF4, RG>(buf1, nsteps(st + 1), tid, rgB);
    __syncthreads();
    write_out(obuf, st, nsteps(st));
    if (st + 1 < nst) {
      if (st + 3 < nst) stage_issue<NF4, RG>(sptr, sld, st + 3, nsteps(st + 3), tid, rgB);
      run_stage(buf1, obuf + 512, nsteps(st + 1));
      if (st + 2 < nst) stage_commit<NF4, RG>(buf0, nsteps(st + 2), tid, rgA);
      __syncthreads();
      write_out(obuf + 512, st + 1, nsteps(st + 1));
    }
  }
#pragma unroll
  for (int i = 0; i < 8; ++i) stout[(size_t)(s * 8 + i) * st_ld + w * 4 + c] = S[i];
  __syncthreads();
}

template <int MODE>
DEVI void colrec_short(const float* pa, int lda_, const float* pq, int ldq, const float* pc, int ldc, const float* pdt,
                       long row0, float gamma, const float* stin, float* stout, int st_ld, float* outp, int ldo,
                       float* smem) {
  const int tid = threadIdx.x & 255, lane = tid & 63;
  const int wid = __builtin_amdgcn_readfirstlane(tid >> 6);
  const int k0 = wid * 32;
  smem += (threadIdx.x >> 8) * (VB_BYTES / 4);
  float S[32];
#pragma unroll
  for (int i = 0; i < 32; ++i) S[i] = stin[(size_t)(k0 + i) * st_ld + lane];
  float aq[4], vv[4], dAv[4];
#pragma unroll
  for (int t = 0; t < 4; ++t) {
    long row = row0 + t;
    aq[t] = (lane < 32) ? pa[(size_t)row * lda_ + k0 + lane] : pq[(size_t)row * ldq + k0 + (lane - 32)];
    vv[t] = pc[(size_t)row * ldc + lane];
    dAv[t] = gamma;
    if (MODE == 2) {
      vv[t] *= pdt[(size_t)row * 64];
      dAv[t] = pdt[(size_t)row * 64 + 1];
    }
  }
#pragma unroll
  for (int t = 0; t < 4; ++t) {
    const float val = vv[t], dA = dAv[t];
    float o = 0.f;
#pragma unroll
    for (int i = 0; i < 32; ++i) {
      const float a = rlf_(aq[t], i), q = rlf_(aq[t], 32 + i);
      if (MODE == 0) S[i] = val + a * (S[i] - val);
      else S[i] = dA * S[i] + a * val;
      o += q * S[i];
    }
    smem[(wid * 4 + t) * 64 + lane] = o;
  }
#pragma unroll
  for (int i = 0; i < 32; ++i) stout[(size_t)(k0 + i) * st_ld + lane] = S[i];
  __syncthreads();
  {
    int t = tid >> 6;
    float sum = smem[(0 * 4 + t) * 64 + lane] + smem[(1 * 4 + t) * 64 + lane] + smem[(2 * 4 + t) * 64 + lane] +
                smem[(3 * 4 + t) * 64 + lane];
    outp[(size_t)(row0 + t) * ldo + lane] = sum;
  }
  __syncthreads();
}

DEVI void rwkv_item(const float* wsf, const Seg (&sg)[6], int row0, int T, const float* stin, float* stout, float* outp, int ldo,
                    float* smem) {
  constexpr int NF4 = 84, W = 336, RG = 6;
  const int tid = threadIdx.x & 255, w = tid >> 6, lane = tid & 63, rl = lane >> 4, sl = lane & 15;
  smem += (threadIdx.x >> 8) * (VB_BYTES / 4);
  const int il = w * 4 + rl;
  float S[4];
  if (stin) {
    float4 v = *(const float4*)(stin + il * 64 + sl * 4);
    S[0] = v.x; S[1] = v.y; S[2] = v.z; S[3] = v.w;
  } else {
    S[0] = S[1] = S[2] = S[3] = 0.f;
  }
  float* buf0 = smem;
  float* buf1 = smem + 16 * 336;
  float* obuf = smem + 2 * 16 * 336;
  const int nst = (T + 15) / 16;
  f32x4 rgA[RG], rgB[RG];
  const float* sptr[RG];
  int sld[RG];
  stage_init<6, NF4, RG>(wsf, sg, row0, tid, sptr, sld);
  auto run_stage = [&](const float* b, float* ob, int nthis) {
#pragma unroll 4
    for (int tt = 0; tt < nthis; ++tt) {
      const float* sp = b + tt * W;
      float4 r4 = *(const float4*)(sp + sl * 4);
      float4 w4 = *(const float4*)(sp + 64 + sl * 4);
      float4 k4 = *(const float4*)(sp + 128 + sl * 4);
      float4 n4 = *(const float4*)(sp + 192 + sl * 4);
      float4 m4 = *(const float4*)(sp + 256 + sl * 4);
      float vi = sp[320 + il];
      float sa = S[0] * n4.x + S[1] * n4.y + S[2] * n4.z + S[3] * n4.w;
      sa = -red16(sa);
      S[0] = S[0] * w4.x + sa * m4.x + vi * k4.x;
      S[1] = S[1] * w4.y + sa * m4.y + vi * k4.y;
      S[2] = S[2] * w4.z + sa * m4.z + vi * k4.z;
      S[3] = S[3] * w4.w + sa * m4.w + vi * k4.w;
      float y = S[0] * r4.x + S[1] * r4.y + S[2] * r4.z + S[3] * r4.w;
      y = red16(y);
      ob[(sl == 0) ? (tt * 16 + il) : (1024 + (tid & 255))] = y;
    }
  };
  auto write_out = [&](const float* ob, int st, int nthis) {
    if (tid < nthis * 4) {
      int t = tid >> 2, c4 = tid & 3;
      *(float4*)(outp + (size_t)(st * 16 + t) * ldo + c4 * 4) = *(const float4*)(ob + t * 16 + c4 * 4);
    }
  };
  auto nsteps = [&](int st) { return min(16, T - st * 16); };
  stage_issue<NF4, RG>(sptr, sld, 0, nsteps(0), tid, rgA);
  stage_commit<NF4, RG>(buf0, nsteps(0), tid, rgA);
  if (nst > 1) stage_issue<NF4, RG>(sptr, sld, 1, nsteps(1), tid, rgB);
  __syncthreads();
#pragma unroll 1
  for (int st = 0; st < nst; st += 2) {
    if (st + 2 < nst) stage_issue<NF4, RG>(sptr, sld, st + 2, nsteps(st + 2), tid, rgA);
    run_stage(buf0, obuf, nsteps(st));
    if (st + 1 < nst) stage_commit<NF4, RG>(buf1, nsteps(st + 1), tid, rgB);
    __syncthreads();
    write_out(obuf, st, nsteps(st));
    if (st + 1 < nst) {
      if (st + 3 < nst) stage_issue<NF4, RG>(sptr, sld, st + 3, nsteps(st + 3), tid, rgB);
      run_stage(buf1, obuf + 512, nsteps(st + 1));
      if (st + 2 < nst) stage_commit<NF4, RG>(buf0, nsteps(st + 2), tid, rgA);
      __syncthreads();
      write_out(obuf + 512, st + 1, nsteps(st + 1));
    }
  }
  *(float4*)(stout + il * 64 + sl * 4) = make_float4(S[0], S[1], S[2], S[3]);
  __syncthreads();
}

DEVI void phase_rec0(const Params& p, float* smem) {
  char* ws = p.ws;
  const float* PROJ = (const float*)(ws + OFF_PROJ);
  float* OMIX = (float*)(ws + OFF_OMIX);
  const float* wsf = (const float*)ws;
  constexpr int PO = (int)(OFF_PROJ / 4);
  for (int item = blockIdx.x * 2 + (threadIdx.x >> 8); item < 4608; item += gridDim.x * 2) {
    if (item < 256) {
      int b = item >> 6, h = (item >> 3) & 7, cb = item & 7;
      Seg sg[4] = {{PO + 1024 + h * 128, N0, 32}, {PO + h * 128, N0, 32}, {PO + 2048 + h * 128 + cb * 16, N0, 4},
                   {PO, N0, 1}};
      int row0 = b * TP;
      colrec_long<0>(wsf, sg, row0, TP, 0.f, OMIX + (size_t)row0 * 2048 + h * 128 + cb * 16, 2048,
                     p.out + O_HGP + (size_t)(b * 8 + h) * 128 * 128 + cb * 16, 128, smem);
    } else if (item < 512) {
      int it = item - 256;
      int b = it >> 6, h = (it >> 4) & 3, cb = it & 15;
      Seg sg[4] = {{PO + 4608 + h * 128, N0, 32}, {PO + 4096 + h * 128, N0, 32},
                   {PO + 5120 + h * 256 + cb * 16, N0, 4}, {PO, N0, 1}};
      int row0 = b * TP;
      float gamma = 1.0f - exp2f(-5.0f - (float)h);
      colrec_long<1>(wsf, sg, row0, TP, gamma, OMIX + (size_t)row0 * 2048 + 1024 + h * 256 + cb * 16, 2048,
                     p.out + O_RTP + (size_t)(b * 4 + h) * 128 * 256 + cb * 16, 256, smem);
    } else if (item < 2560) {
      int it = item - 512;
      int b = it >> 4, h = (it >> 1) & 7, cb = it & 1;
      long row0 = MPR + (long)b * 4;
      size_t so = (size_t)(b * 8 + h) * 128 * 128 + cb * 64;
      colrec_short<0>(PROJ + 1024 + h * 128, N0, PROJ + h * 128, N0, PROJ + 2048 + h * 128 + cb * 64, N0, nullptr, row0,
                      0.f, p.in[I_SHG] + so, p.out + O_HGS + so, 128, OMIX + h * 128 + cb * 64, 2048, smem);
    } else {
      int it = item - 2560;
      int b = it >> 4, h = (it >> 2) & 3, cb = it & 3;
      long row0 = MPR + (long)b * 4;
      size_t so = (size_t)(b * 4 + h) * 128 * 256 + cb * 64;
      float gamma = 1.0f - exp2f(-5.0f - (float)h);
      colrec_short<1>(PROJ + 4608 + h * 128, N0, PROJ + 4096 + h * 128, N0, PROJ + 5120 + h * 256 + cb * 64, N0, nullptr,
                      row0, gamma, p.in[I_SRT] + so, p.out + O_RTS + so, 256, OMIX + 1024 + h * 256 + cb * 64, 2048,
                      smem);
    }
  }
}

DEVI float4 ld4(const float* p) { return *(const float4*)p; }
DEVI void st_bf4(u16* p, float a, float b, float c, float d) {
  uint2 o;
  o.x = pack2(a, b);
  o.y = pack2(c, d);
  *(uint2*)p = o;
}
DEVI float wsum_u_(float v) {
  v = red16(v);
  return (rlf_(v, 0) + rlf_(v, 16)) + (rlf_(v, 32) + rlf_(v, 48));
}
DEVI float red32(float v) {
  v = red16(v);
  return v + __shfl_xor(v, 16, 64);
}
DEVI void phase_post0(const Params& p) {
  char* ws = p.ws;
  const float* PROJ = (const float*)(ws + OFF_PROJ);
  const float* OMIX = (const float*)(ws + OFF_OMIX);
  u16* MIXB = (u16*)(ws + OFF_MIXB);
  const float* ng = p.in[I_HNG];
  const int lane = threadIdx.x & 63;
  const int gw = blockIdx.x * 8 + (threadIdx.x >> 6), nw = gridDim.x * 8;
  const float4 g4 = ld4(ng + (lane & 31) * 4);
  for (int row = gw; row < M; row += nw) {
    const float* o = OMIX + (size_t)row * 2048;
    const float* pr = PROJ + (size_t)row * N0;
    u16* mo = MIXB + (size_t)row * 2048;
    float4 a[4], ga[4], bq[4], gb[4];
#pragma unroll
    for (int it = 0; it < 4; ++it) {
      int c = it * 256 + lane * 4;
      a[it] = ld4(o + c);
      ga[it] = ld4(pr + 3072 + c);
      bq[it] = ld4(o + 1024 + c);
      gb[it] = ld4(pr + 6144 + c);
    }
#pragma unroll
    for (int it = 0; it < 4; ++it) {
      int c = it * 256 + lane * 4;
      float ss = red32(a[it].x * a[it].x + a[it].y * a[it].y + a[it].z * a[it].z + a[it].w * a[it].w);
      float inv = rsqrtf(ss * (1.0f / 128.0f) + 1e-6f);
      st_bf4(mo + c, a[it].x * inv * g4.x * ga[it].x, a[it].y * inv * g4.y * ga[it].y, a[it].z * inv * g4.z * ga[it].z,
             a[it].w * inv * g4.w * ga[it].w);
      float mu = wsum_u_(bq[it].x + bq[it].y + bq[it].z + bq[it].w) * (1.0f / 256.0f);
      float dx = bq[it].x - mu, dy = bq[it].y - mu, dz = bq[it].z - mu, dw = bq[it].w - mu;
      float var = wsum_u_(dx * dx + dy * dy + dz * dz + dw * dw) * (1.0f / 256.0f);
      float iv = rsqrtf(var + 1e-5f);
      st_bf4(mo + 1024 + c, dx * iv * gb[it].x, dy * iv * gb[it].y, dz * iv * gb[it].z, dw * iv * gb[it].w);
    }
  }
}

DEVI void phase_ln(const Params& p, const float* addsrc, const float* g, const float* bta) {
  char* ws = p.ws;
  float* XF = (float*)(ws + OFF_XF);
  u16* XB = (u16*)(ws + OFF_XB);
  const int lane = threadIdx.x & 63;
  const int gw = blockIdx.x * 8 + (threadIdx.x >> 6), nw = gridDim.x * 8;
  for (int row = gw; row < M; row += nw) {
    float4* xr = (float4*)(XF + (size_t)row * 2048);
    const float4* ar = (const float4*)(addsrc + (size_t)row * 2048);
    float v[32];
    float s = 0.f;
#pragma unroll
    for (int i = 0; i < 8; ++i) {
      float4 x = xr[i * 64 + lane], a = ar[i * 64 + lane];
      v[i * 4 + 0] = ALPHA * x.x + a.x;
      v[i * 4 + 1] = ALPHA * x.y + a.y;
      v[i * 4 + 2] = ALPHA * x.z + a.z;
      v[i * 4 + 3] = ALPHA * x.w + a.w;
      s += v[i * 4 + 0] + v[i * 4 + 1] + v[i * 4 + 2] + v[i * 4 + 3];
    }
    float mu = wsum(s) * (1.0f / 2048.0f);
    float q = 0.f;
#pragma unroll
    for (int i = 0; i < 32; ++i) {
      v[i] -= mu;
      q += v[i] * v[i];
    }
    float inv = rsqrtf(wsum(q) * (1.0f / 2048.0f) + 1e-5f);
#pragma unroll
    for (int i = 0; i < 8; ++i) {
      float4 gg = ((const float4*)g)[i * 64 + lane], bb = ((const float4*)bta)[i * 64 + lane];
      float4 y;
      y.x = v[i * 4 + 0] * inv * gg.x + bb.x;
      y.y = v[i * 4 + 1] * inv * gg.y + bb.y;
      y.z = v[i * 4 + 2] * inv * gg.z + bb.z;
      y.w = v[i * 4 + 3] * inv * gg.w + bb.w;
      xr[i * 64 + lane] = y;
      uint2 o;
      o.x = pack2(y.x, y.y);
      o.y = pack2(y.z, y.w);
      ((uint2*)(XB + (size_t)row * 2048))[i * 64 + lane] = o;
    }
  }
}

typedef __attribute__((ext_vector_type(2))) __bf16 bf2_t;
typedef __attribute__((ext_vector_type(2))) float f32x2;
DEVI float dot2bf(unsigned a, unsigned b, float acc) {
  return __builtin_amdgcn_fdot2_f32_bf16(__builtin_bit_cast(bf2_t, a), __builtin_bit_cast(bf2_t, b), acc, false);
}
template <int CTRL>
DEVI int dppi(int v) {
  return __builtin_amdgcn_update_dpp(v, v, CTRL, 0xF, 0xF, false);
}
DEVI int wmax_i(int v) {
  v = max(v, dppi<0xB1>(v));
  v = max(v, dppi<0x4E>(v));
  v = max(v, dppi<0x141>(v));
  v = max(v, dppi<0x140>(v));
  int a = __builtin_amdgcn_readlane(v, 0), b = __builtin_amdgcn_readlane(v, 16);
  int c = __builtin_amdgcn_readlane(v, 32), d = __builtin_amdgcn_readlane(v, 48);
  return max(max(a, b), max(c, d));
}
DEVI float rlf(float v, int l) { return __int_as_float(__builtin_amdgcn_readlane(__float_as_int(v), l)); }
DEVI float wsum_u(float v) {
  v = red16(v);
  return (rlf(v, 0) + rlf(v, 16)) + (rlf(v, 32) + rlf(v, 48));
}
DEVI int fkey(float f) {
  int u = __float_as_int(f);
  return u ^ ((u >> 31) & 0x7fffffff);
}
DEVI float keyf(int k) { return __int_as_float(k ^ ((k >> 31) & 0x7fffffff)); }

DEVI void conv_fp8_rows(const float* __restrict__ src, unsigned char* __restrict__ dst, float* __restrict__ scales) {
  const int lane = threadIdx.x & 63;
  const int gw = blockIdx.x * 8 + (threadIdx.x >> 6), nw = gridDim.x * 8;
  for (int e = gw; e < 16384; e += nw) {
    const float* r = src + (size_t)e * 2048;
    float4 v[8];
    float am = 0.f;
#pragma unroll
    for (int q = 0; q < 8; ++q) {
      v[q] = *(const float4*)(r + (q >> 2) * 1024 + lane * 16 + (q & 3) * 4);
      am = fmaxf(am, fmaxf(fmaxf(fabsf(v[q].x), fabsf(v[q].y)), fmaxf(fabsf(v[q].z), fabsf(v[q].w))));
    }
    float amax = __int_as_float(wmax_i(__float_as_int(am)));
    float inv = (amax > 0.f) ? (440.0f / amax) : 0.f;
    float scale = (amax > 0.f) ? (amax * (1.0f / 440.0f)) : 1.0f;
#pragma unroll
    for (int j = 0; j < 2; ++j) {
      u32x4 o;
#pragma unroll
      for (int k = 0; k < 4; ++k) {
        float4 t = v[j * 4 + k];
        int pk = 0;
        pk = __builtin_amdgcn_cvt_pk_fp8_f32(t.x * inv, t.y * inv, pk, false);
        pk = __builtin_amdgcn_cvt_pk_fp8_f32(t.z * inv, t.w * inv, pk, true);
        o[k] = (unsigned)pk;
      }
      *(u32x4*)(dst + (size_t)e * 2048 + j * 1024 + lane * 16) = o;
    }
    if (lane == 0) scales[e] = scale;
  }
}

DEVI void phase_peer(const Params& p, int layer, bool final_out) {
  char* ws = p.ws;
  const float* SC = (const float*)(ws + OFF_GOUT);
  float* XF = (float*)(ws + OFF_XF);
  u16* XB = (u16*)(ws + OFF_XB);
  const unsigned char* UB = (const unsigned char*)(ws + OFF_UB);
  const unsigned char* VB = (const unsigned char*)(ws + OFF_VB);
  const float* USC = (const float*)(ws + OFF_USC);
  const float* VSC = (const float*)(ws + OFF_VSC);
  const float* g = p.in[I_LNG] + (size_t)(layer * 2 + 1) * D;
  const float* bta = p.in[I_LNB] + (size_t)(layer * 2 + 1) * D;
  const int lane = threadIdx.x & 63;
  const int gw = blockIdx.x * 8 + (threadIdx.x >> 6), nw = gridDim.x * 8;
  constexpr int KMIN = (int)0x80000000;
  for (int row = gw; row < M; row += nw) {
    const float* sr = SC + (size_t)row * 2048;
    int eidx0 = 0, eidx1 = 0;
    float gate0 = 0.f, gate1 = 0.f;
#pragma unroll 1
    for (int h = 0; h < 8; ++h) {
      const float* sp = sr + h * 256;
      int ka0 = (fkey(sp[lane]) & ~127) | (127 - lane);
      int kb0 = (fkey(sp[lane + 64]) & ~127) | (63 - lane);
      int ka1 = (fkey(sp[128 + lane]) & ~127) | (127 - lane);
      int kb1 = (fkey(sp[192 + lane]) & ~127) | (63 - lane);
      int my0 = KMIN, my1 = KMIN;
#pragma unroll 1
      for (int r = 0; r < 16; ++r) {
        int K0 = wmax_i(max(ka0, kb0));
        int K1 = wmax_i(max(ka1, kb1));
        my0 = (lane == r) ? K0 : my0;
        my1 = (lane == r) ? K1 : my1;
        ka0 = (ka0 == K0) ? KMIN : ka0;
        kb0 = (kb0 == K0) ? KMIN : kb0;
        ka1 = (ka1 == K1) ? KMIN : ka1;
        kb1 = (kb1 == K1) ? KMIN : kb1;
      }
      float ts0 = keyf(my0 & ~127), ts1 = keyf(my1 & ~127);
      int ti0 = 127 - (my0 & 127), ti1 = 127 - (my1 & 127);
      float s0 = __shfl(ts0, lane >> 2, 64);
      int jb = (lane & 3) * 4;
      int c0 = (fkey(s0 + __shfl(ts1, jb + 0, 64)) & ~255) | (255 - (lane * 4 + 0));
      int c1 = (fkey(s0 + __shfl(ts1, jb + 1, 64)) & ~255) | (255 - (lane * 4 + 1));
      int c2 = (fkey(s0 + __shfl(ts1, jb + 2, 64)) & ~255) | (255 - (lane * 4 + 2));
      int c3 = (fkey(s0 + __shfl(ts1, jb + 3, 64)) & ~255) | (255 - (lane * 4 + 3));
      int myk = KMIN;
#pragma unroll 1
      for (int r = 0; r < 16; ++r) {
        int K = wmax_i(max(max(c0, c1), max(c2, c3)));
        myk = (lane == r) ? K : myk;
        c0 = (c0 == K) ? KMIN : c0;
        c1 = (c1 == K) ? KMIN : c1;
        c2 = (c2 == K) ? KMIN : c2;
        c3 = (c3 == K) ? KMIN : c3;
      }
      float bs = keyf(myk & ~255);
      int bf = 255 - (myk & 255);
      int e = __shfl(ti0, (bf >> 4) & 15, 64) * 128 + __shfl(ti1, bf & 15, 64);
      float mx = rlf(bs, 0);
      float ev = (lane < 16) ? expf(bs - mx) : 0.f;
      float sm = wsum_u(ev);
      float gt = ev / sm;
      int e_b = __shfl(e, lane & 15, 64);
      float g_b = __shfl(gt, lane & 15, 64);
      if ((lane >> 4) == (h & 3)) {
        if (h < 4) {
          eidx0 = e_b;
          gate0 = g_b;
        } else {
          eidx1 = e_b;
          gate1 = g_b;
        }
      }
    }
    float dv0 = 0.f, dv1 = 0.f;
    {
      float xf[32];
      {
        const float4* xr = (const float4*)(XF + (size_t)row * 2048);
#pragma unroll
        for (int q = 0; q < 8; ++q) {
          float4 t = xr[(q >> 2) * 256 + lane * 4 + (q & 3)];
          xf[q * 4 + 0] = t.x; xf[q * 4 + 1] = t.y; xf[q * 4 + 2] = t.z; xf[q * 4 + 3] = t.w;
        }
      }
      constexpr int R = 8;
      u32x4 w[R][2];
      float sc[R];
      auto load_row = [&](int pidx, u32x4(&wr)[2], float& scv) {
        int src = (pidx < 64) ? eidx0 : eidx1;
        int e = __builtin_amdgcn_readlane(src, pidx & 63);
        const u32x4* ur = (const u32x4*)(UB + (size_t)e * 2048);
        wr[0] = ur[lane];
        wr[1] = ur[64 + lane];
        scv = USC[e];
      };
#pragma unroll
      for (int u = 0; u < R; ++u) load_row(u, w[u], sc[u]);
#pragma unroll 1
      for (int p0 = 0; p0 < 128; p0 += R) {
#pragma unroll
        for (int u = 0; u < R; ++u) {
          float d = 0.f;
#pragma unroll
          for (int j = 0; j < 2; ++j) {
#pragma unroll
            for (int k = 0; k < 4; ++k) {
              int dw = (int)w[u][j][k];
              f32x2 lo = __builtin_amdgcn_cvt_pk_f32_fp8(dw, false);
              f32x2 hi = __builtin_amdgcn_cvt_pk_f32_fp8(dw, true);
              d += lo.x * xf[j * 16 + k * 4 + 0];
              d += lo.y * xf[j * 16 + k * 4 + 1];
              d += hi.x * xf[j * 16 + k * 4 + 2];
              d += hi.y * xf[j * 16 + k * 4 + 3];
            }
          }
          float scu = sc[u];
          if (p0 + R < 128) load_row(p0 + R + u, w[u], sc[u]);
          d = wsum_u(d) * scu;
          int pl = (p0 + u) & 63;
          if (p0 < 64) dv0 = (lane == pl) ? d : dv0;
          else dv1 = (lane == pl) ? d : dv1;
          __builtin_amdgcn_sched_barrier(0);
        }
      }
    }
    float coef0 = 0.5f * dv0 * (1.0f + erff(dv0 * 0.70710678118f)) * gate0;
    float coef1 = 0.5f * dv1 * (1.0f + erff(dv1 * 0.70710678118f)) * gate1;
    f32x2 o2[16];
#pragma unroll
    for (int i = 0; i < 16; ++i) o2[i] = f32x2{0.f, 0.f};
    {
      constexpr int R = 8;
      u32x4 w[R][2];
      float sc[R];
      auto load_row = [&](int pidx, u32x4(&wr)[2], float& scv) {
        int src = (pidx < 64) ? eidx0 : eidx1;
        int e = __builtin_amdgcn_readlane(src, pidx & 63);
        const u32x4* vr = (const u32x4*)(VB + (size_t)e * 2048);
        wr[0] = vr[lane];
        wr[1] = vr[64 + lane];
        scv = VSC[e];
      };
#pragma unroll
      for (int u = 0; u < R; ++u) load_row(u, w[u], sc[u]);
#pragma unroll 1
      for (int p0 = 0; p0 < 128; p0 += R) {
        float cfs = (p0 < 64) ? coef0 : coef1;
#pragma unroll
        for (int u = 0; u < R; ++u) {
          float c = rlf(cfs, (p0 + u) & 63) * sc[u];
          f32x2 cc = f32x2{c, c};
#pragma unroll
          for (int j = 0; j < 2; ++j) {
#pragma unroll
            for (int k = 0; k < 4; ++k) {
              int dw = (int)w[u][j][k];
              o2[j * 8 + k * 2 + 0] += cc * __builtin_amdgcn_cvt_pk_f32_fp8(dw, false);
              o2[j * 8 + k * 2 + 1] += cc * __builtin_amdgcn_cvt_pk_f32_fp8(dw, true);
            }
          }
          if (p0 + R < 128) load_row(p0 + R + u, w[u], sc[u]);
          __builtin_amdgcn_sched_barrier(0);
        }
      }
    }
    float o[32];
#pragma unroll
    for (int i = 0; i < 16; ++i) {
      o[2 * i] = o2[i].x;
      o[2 * i + 1] = o2[i].y;
    }
    float s = 0.f;
    {
      const float4* xr = (const float4*)(XF + (size_t)row * 2048);
#pragma unroll
      for (int q = 0; q < 8; ++q) {
        float4 t = xr[(q >> 2) * 256 + lane * 4 + (q & 3)];
        o[q * 4 + 0] += ALPHA * t.x; o[q * 4 + 1] += ALPHA * t.y; o[q * 4 + 2] += ALPHA * t.z; o[q * 4 + 3] += ALPHA * t.w;
      }
#pragma unroll
      for (int i = 0; i < 32; ++i) s += o[i];
    }
    float mu = wsum_u(s) * (1.0f / 2048.0f);
    float q = 0.f;
#pragma unroll
    for (int i = 0; i < 32; ++i) {
      o[i] -= mu;
      q += o[i] * o[i];
    }
    float inv = rsqrtf(wsum_u(q) * (1.0f / 2048.0f) + 1e-5f);
    float* dstf;
    if (final_out) {
      if (row < MPR) {
        int b = row / TP, t = row % TP;
        dstf = (t >= 16) ? (p.out + O_YP + ((size_t)b * 2048 + (t - 16)) * D) : nullptr;
      } else {
        dstf = p.out + O_YS + (size_t)(row - MPR) * D;
      }
    } else {
      dstf = XF + (size_t)row * 2048;
    }
#pragma unroll
    for (int j = 0; j < 2; ++j) {
      float yv[16];
#pragma unroll
      for (int k = 0; k < 4; ++k) {
        float4 gv = *(const float4*)(g + j * 1024 + lane * 16 + k * 4);
        float4 bv = *(const float4*)(bta + j * 1024 + lane * 16 + k * 4);
        float4 y;
        y.x = o[j * 16 + k * 4 + 0] * inv * gv.x + bv.x;
        y.y = o[j * 16 + k * 4 + 1] * inv * gv.y + bv.y;
        y.z = o[j * 16 + k * 4 + 2] * inv * gv.z + bv.z;
        y.w = o[j * 16 + k * 4 + 3] * inv * gv.w + bv.w;
        if (dstf) *(float4*)(dstf + j * 1024 + lane * 16 + k * 4) = y;
        yv[k * 4 + 0] = y.x; yv[k * 4 + 1] = y.y; yv[k * 4 + 2] = y.z; yv[k * 4 + 3] = y.w;
      }
      if (!final_out) {
        uint4* xb = (uint4*)(XB + (size_t)row * 2048 + j * 1024 + lane * 16);
        xb[0] = make_uint4(pack2(yv[0], yv[1]), pack2(yv[2], yv[3]), pack2(yv[4], yv[5]), pack2(yv[6], yv[7]));
        xb[1] = make_uint4(pack2(yv[8], yv[9]), pack2(yv[10], yv[11]), pack2(yv[12], yv[13]), pack2(yv[14], yv[15]));
      }
    }
  }
}

DEVI float4 f4mul(float4 a, float4 b) { return make_float4(a.x * b.x, a.y * b.y, a.z * b.z, a.w * b.w); }
DEVI void row_info(int row, bool& prompt, int& b, int& t, int& T) {
  prompt = row < MPR;
  if (prompt) { b = row / TP; t = row - b * TP; T = TP; }
  else { b = (row - MPR) >> 2; t = (row - MPR) & 3; T = 4; }
}
DEVI void phase_pre1(const Params& p) {
  char* ws = p.ws;
  const float* PROJ = (const float*)(ws + OFF_PROJ);
  float* XC = (float*)(ws + OFF_GOUT);
  float* RKV = (float*)(ws + OFF_RKV);
  u16* LRA = (u16*)(ws + OFF_LRA);
  u16* LRB = (u16*)(ws + OFF_LRB);
  u16* LRG = (u16*)(ws + OFF_LRG);
  const float* cw = p.in[I_CVW];
  const float* cbias = p.in[I_CVB];
  const float* mu = p.in[I_MU];
  const int gtid = blockIdx.x * 512 + threadIdx.x, nthr = gridDim.x * 512;
#pragma unroll 2
  for (int idx = gtid; idx < M * 384; idx += nthr) {
    int row = idx / 384, c = (idx - row * 384) * 4;
    bool prompt; int b, t, T;
    row_info(row, prompt, b, t, T);
    float4 xv[4];
#pragma unroll
    for (int jj = 0; jj < 4; ++jj) {
      int tt = t - 3 + jj;
      if (tt >= 0) xv[jj] = ld4(PROJ + (size_t)(row - 3 + jj) * N1 + 1024 + c);
      else if (prompt) xv[jj] = make_float4(0.f, 0.f, 0.f, 0.f);
      else xv[jj] = ld4(p.in[I_SCV] + (size_t)(b * 3 + (tt + 3)) * 1536 + c);
    }
    float4 acc = ld4(cbias + c);
#pragma unroll
    for (int jj = 0; jj < 4; ++jj) {
      float4 w = ld4(cw + jj * 1536 + c);
      acc.x += xv[jj].x * w.x; acc.y += xv[jj].y * w.y; acc.z += xv[jj].z * w.z; acc.w += xv[jj].w * w.w;
    }
    *(float4*)(XC + (size_t)row * 1536 + c) = make_float4(siluf_(acc.x), siluf_(acc.y), siluf_(acc.z), siluf_(acc.w));
    if (t >= T - 3) {
      float* co = prompt ? (p.out + O_CVP) : (p.out + O_CVS);
      *(float4*)(co + (size_t)(b * 3 + (t - (T - 3))) * 1536 + c) = xv[3];
    }
  }
#pragma unroll 2
  for (int idx = gtid; idx < M * 840; idx += nthr) {
    int row = idx / 840, c = (idx - row * 840) * 4;
    bool prompt; int b, t, T;
    row_info(row, prompt, b, t, T);
    float4 cur = ld4(PROJ + (size_t)row * N1 + 2560 + c);
    float4 prev;
    if (t > 0) prev = ld4(PROJ + (size_t)(row - 1) * N1 + 2560 + c);
    else if (prompt) prev = make_float4(0.f, 0.f, 0.f, 0.f);
    else prev = ld4(p.in[I_SSH] + (size_t)b * 3360 + c);
    float4 m4 = ld4(mu + c);
    float4 mx;
    mx.x = cur.x + (prev.x - cur.x) * m4.x; mx.y = cur.y + (prev.y - cur.y) * m4.y;
    mx.z = cur.z + (prev.z - cur.z) * m4.z; mx.w = cur.w + (prev.w - cur.w) * m4.w;
    if (c < 3072) *(float4*)(RKV + (size_t)row * 3072 + c) = mx;
    else if (c < 3136) st_bf4(LRA + (size_t)row * 64 + (c - 3072), tanhf(mx.x), tanhf(mx.y), tanhf(mx.z), tanhf(mx.w));
    else if (c < 3200) st_bf4(LRB + (size_t)row * 64 + (c - 3136), mx.x, mx.y, mx.z, mx.w);
    else st_bf4(LRG + (size_t)row * 192 + (c - 3200), sigmoidf_(mx.x), sigmoidf_(mx.y), sigmoidf_(mx.z), sigmoidf_(mx.w));
    if (t == T - 1) {
      float* so = prompt ? (p.out + O_SHP) : (p.out + O_SHS);
      *(float4*)(so + (size_t)b * 3360 + c) = cur;
    }
  }
  for (int idx = gtid; idx < M * 4; idx += nthr) {
    int row = idx >> 2, k = idx & 3;
    ((uint4*)(LRG + (size_t)row * 192 + 160))[k] = make_uint4(0, 0, 0, 0);
  }
}

DEVI void phase_pre1c(const Params& p) {
  char* ws = p.ws;
  float* RKV = (float*)(ws + OFF_RKV);
  const float* AA = (const float*)(ws + OFF_AA);
  float* KK = (float*)(ws + OFF_QB);
  float* KKA = (float*)(ws + OFF_MIXB);
  float* BON = (float*)(ws + OFF_BON);
  const float* k_k = p.in[I_KK];
  const float* k_a = p.in[I_KA];
  const float* r_k = p.in[I_RK];
  const int lane = threadIdx.x & 63;
  const int gw = blockIdx.x * 8 + (threadIdx.x >> 6), nw = gridDim.x * 8;
  for (int row = gw; row < M; row += nw) {
    float4 k4[4], r4[4], a4[4];
#pragma unroll
    for (int it = 0; it < 4; ++it) {
      int c = it * 256 + lane * 4;
      k4[it] = ld4(RKV + (size_t)row * 3072 + 1024 + c);
      r4[it] = ld4(RKV + (size_t)row * 3072 + c);
      a4[it] = ld4(AA + (size_t)row * 1024 + c);
    }
#pragma unroll
    for (int it = 0; it < 4; ++it) {
      int c = it * 256 + lane * 4;
      float4 kk4 = ld4(k_k + c), ka4 = ld4(k_a + c), rk4 = ld4(r_k + c);
      float4 k = k4[it], r = r4[it], a = a4[it];
      float4 kr = f4mul(k, kk4);
      float ss = red16(kr.x * kr.x + kr.y * kr.y + kr.z * kr.z + kr.w * kr.w);
      float inv = 1.0f / fmaxf(sqrtf(ss), 1e-12f);
      float4 kk = make_float4(kr.x * inv, kr.y * inv, kr.z * inv, kr.w * inv);
      float4 kp;
      kp.x = k.x * (1.0f + (a.x - 1.0f) * ka4.x); kp.y = k.y * (1.0f + (a.y - 1.0f) * ka4.y);
      kp.z = k.z * (1.0f + (a.z - 1.0f) * ka4.z); kp.w = k.w * (1.0f + (a.w - 1.0f) * ka4.w);
      float bon = red16(r.x * kp.x * rk4.x + r.y * kp.y * rk4.y + r.z * kp.z * rk4.z + r.w * kp.w * rk4.w);
      *(float4*)(KK + (size_t)row * 1024 + c) = kk;
      *(float4*)(KKA + (size_t)row * 1024 + c) = f4mul(kk, a);
      *(float4*)(RKV + (size_t)row * 3072 + 1024 + c) = kp;
      if ((lane & 15) == 0) BON[(size_t)row * 16 + it * 4 + (lane >> 4)] = bon;
    }
  }
}

DEVI void rwkv_short(const float* __restrict__ RKV, const float* __restrict__ DEC, const float* __restrict__ KK,
                     const float* __restrict__ KKA, int h, int rb, int row0, const float* __restrict__ stin,
                     float* __restrict__ stout, float* __restrict__ outp) {
  const int tid = threadIdx.x & 255, w = tid >> 6, lane = tid & 63, rl = lane >> 4, sl = lane & 15;
  const int il = w * 4 + rl;
  float4 sv = *(const float4*)(stin + il * 64 + sl * 4);
  float S[4] = {sv.x, sv.y, sv.z, sv.w};
  float4 r4[4], w4[4], k4[4], n4[4], m4[4];
  float vi[4];
#pragma unroll
  for (int t = 0; t < 4; ++t) {
    const size_t row = (size_t)(row0 + t);
    r4[t] = *(const float4*)(RKV + row * 3072 + h * 64 + sl * 4);
    w4[t] = *(const float4*)(DEC + row * 1024 + h * 64 + sl * 4);
    k4[t] = *(const float4*)(RKV + row * 3072 + 1024 + h * 64 + sl * 4);
    n4[t] = *(const float4*)(KK + row * 1024 + h * 64 + sl * 4);
    m4[t] = *(const float4*)(KKA + row * 1024 + h * 64 + sl * 4);
    vi[t] = RKV[row * 3072 + 2048 + h * 64 + rb * 16 + il];
  }
#pragma unroll
  for (int t = 0; t < 4; ++t) {
    float sa = S[0] * n4[t].x + S[1] * n4[t].y + S[2] * n4[t].z + S[3] * n4[t].w;
    sa = -red16(sa);
    S[0] = S[0] * w4[t].x + sa * m4[t].x + vi[t] * k4[t].x;
    S[1] = S[1] * w4[t].y + sa * m4[t].y + vi[t] * k4[t].y;
    S[2] = S[2] * w4[t].z + sa * m4[t].z + vi[t] * k4[t].z;
    S[3] = S[3] * w4[t].w + sa * m4[t].w + vi[t] * k4[t].w;
    float y = S[0] * r4[t].x + S[1] * r4[t].y + S[2] * r4[t].z + S[3] * r4[t].w;
    y = red16(y);
    if (sl == 0) outp[(size_t)t * 2048 + il] = y;
  }
  *(float4*)(stout + il * 64 + sl * 4) = make_float4(S[0], S[1], S[2], S[3]);
}

DEVI void phase_rec1(const Params& p, float* smem) {
  char* ws = p.ws;
  const float* XC = (const float*)(ws + OFF_GOUT);
  const float* RKV = (const float*)(ws + OFF_RKV);
  const float* DEC = (const float*)(ws + OFF_DEC);
  const float* KK = (const float*)(ws + OFF_QB);
  const float* KKA = (const float*)(ws + OFF_MIXB);
  const float* DTA = (const float*)(ws + OFF_DTA);
  float* OMIX = (float*)(ws + OFF_OMIX);
  const float* wsf = (const float*)ws;
  constexpr int XO = (int)(OFF_GOUT / 4), DO = (int)(OFF_DTA / 4), RO = (int)(OFF_RKV / 4), CO = (int)(OFF_DEC / 4),
                KO = (int)(OFF_QB / 4), AO = (int)(OFF_MIXB / 4);
  const int half = threadIdx.x >> 8;
  for (int li = blockIdx.x; li < 256; li += gridDim.x) {
    if (half == 0) {
      int b = li >> 6, h = (li >> 2) & 15, cb = li & 3;
      int g = h >> 3;
      Seg sg[4] = {{XO + 1024 + g * 128, 1536, 32}, {XO + 1280 + g * 128, 1536, 32}, {XO + h * 64 + cb * 16, 1536, 4},
                   {DO + h * 4, 64, 1}};
      int row0 = b * TP;
      colrec_long<2>(wsf, sg, row0, TP, 0.f, OMIX + (size_t)row0 * 2048 + h * 64 + cb * 16, 2048,
                     p.out + O_SSP + (size_t)(b * 16 + h) * 128 * 64 + cb * 16, 64, smem);
    } else {
      int b = li >> 6, h = (li >> 2) & 15, rb = li & 3;
      int row0 = b * TP;
      Seg sg[6] = {{RO + h * 64, 3072, 16}, {CO + h * 64, 1024, 16}, {RO + 1024 + h * 64, 3072, 16},
                   {KO + h * 64, 1024, 16}, {AO + h * 64, 1024, 16}, {RO + 2048 + h * 64 + rb * 16, 3072, 4}};
      size_t so = ((size_t)(b * 16 + h) * 64 + rb * 16) * 64;
      rwkv_item(wsf, sg, row0, TP, nullptr, p.out + O_WKP + so, OMIX + (size_t)row0 * 2048 + 1024 + h * 64 + rb * 16, 2048, smem);
    }
  }
  for (int it = blockIdx.x * 2 + half; it < 2048; it += gridDim.x * 2) {
    int b = it >> 4, h = it & 15;
    int g = h >> 3;
    long row0 = MPR + (long)b * 4;
    size_t so = (size_t)(b * 16 + h) * 128 * 64;
    colrec_short<2>(XC + 1024 + g * 128, 1536, XC + 1280 + g * 128, 1536, XC + h * 64, 1536, DTA + h * 4, row0, 0.f,
                    p.in[I_SSM] + so, p.out + O_SSS + so, 64, OMIX + h * 64, 2048, smem);
  }
  for (int it = blockIdx.x * 2 + half; it < 8192; it += gridDim.x * 2) {
    int b = it >> 6, h = (it >> 2) & 15, rb = it & 3;
    int row0 = MPR + b * 4;
    size_t so = ((size_t)(b * 16 + h) * 64 + rb * 16) * 64;
    rwkv_short(RKV, DEC, KK, KKA, h, rb, row0, p.in[I_SWK] + so, p.out + O_WKS + so,
               OMIX + (size_t)row0 * 2048 + 1024 + h * 64 + rb * 16);
  }
}

DEVI void phase_post1(const Params& p) {
  char* ws = p.ws;
  const float* PROJ = (const float*)(ws + OFF_PROJ);
  const float* OMIX = (const float*)(ws + OFF_OMIX);
  const float* XC = (const float*)(ws + OFF_GOUT);
  const float* RKV = (const float*)(ws + OFF_RKV);
  const float* GG = (const float*)(ws + OFF_GG);
  const float* BON = (const float*)(ws + OFF_BON);
  u16* MIXB = (u16*)(ws + OFF_MIXB);
  const float* dsk = p.in[I_DSK];
  const float* sng = p.in[I_SNG];
  const float* lxg = p.in[I_LXG];
  const float* lxb = p.in[I_LXB];
  const int lane = threadIdx.x & 63;
  const int gw = blockIdx.x * 8 + (threadIdx.x >> 6), nw = gridDim.x * 8;
  for (int row = gw; row < M; row += nw) {
    const float* o = OMIX + (size_t)row * 2048;
    u16* mo = MIXB + (size_t)row * 2048;
    float4 oc[4], xc[4], z[4], y[4], v[4], gg[4];
    float bn[4];
#pragma unroll
    for (int it = 0; it < 4; ++it) {
      int c = it * 256 + lane * 4;
      oc[it] = ld4(o + c);
      xc[it] = ld4(XC + (size_t)row * 1536 + c);
      z[it] = ld4(PROJ + (size_t)row * N1 + c);
      y[it] = ld4(o + 1024 + c);
      v[it] = ld4(RKV + (size_t)row * 3072 + 2048 + c);
      gg[it] = ld4(GG + (size_t)row * 1024 + c);
      bn[it] = BON[(size_t)row * 16 + it * 4 + (lane >> 4)];
    }
    float4 val[4];
    float ssq[4];
#pragma unroll
    for (int it = 0; it < 4; ++it) {
      float ds = dsk[it * 4 + (lane >> 4)];
      val[it].x = (oc[it].x + xc[it].x * ds) * z[it].x;
      val[it].y = (oc[it].y + xc[it].y * ds) * z[it].y;
      val[it].z = (oc[it].z + xc[it].z * ds) * z[it].z;
      val[it].w = (oc[it].w + xc[it].w * ds) * z[it].w;
      ssq[it] = val[it].x * val[it].x + val[it].y * val[it].y + val[it].z * val[it].z + val[it].w * val[it].w;
    }
    float inv0 = rsqrtf(wsum_u_(ssq[0] + ssq[1]) * (1.0f / 512.0f) + 1e-6f);
    float inv1 = rsqrtf(wsum_u_(ssq[2] + ssq[3]) * (1.0f / 512.0f) + 1e-6f);
#pragma unroll
    for (int it = 0; it < 4; ++it) {
      int c = it * 256 + lane * 4;
      float inv = (it < 2) ? inv0 : inv1;
      float4 sg = ld4(sng + c);
      st_bf4(mo + c, val[it].x * inv * sg.x, val[it].y * inv * sg.y, val[it].z * inv * sg.z, val[it].w * inv * sg.w);
      float mu = red16(y[it].x + y[it].y + y[it].z + y[it].w) * (1.0f / 64.0f);
      float dx = y[it].x - mu, dy = y[it].y - mu, dz = y[it].z - mu, dw = y[it].w - mu;
      float var = red16(dx * dx + dy * dy + dz * dz + dw * dw) * (1.0f / 64.0f);
      float iv = rsqrtf(var + 64e-5f);
      float4 lg = ld4(lxg + c), lb = ld4(lxb + c);
      float y0 = (dx * iv * lg.x + lb.x + bn[it] * v[it].x) * gg[it].x;
      float y1 = (dy * iv * lg.y + lb.y + bn[it] * v[it].y) * gg[it].y;
      float y2 = (dz * iv * lg.z + lb.z + bn[it] * v[it].z) * gg[it].z;
      float y3 = (dw * iv * lg.w + lb.w + bn[it] * v[it].w) * gg[it].w;
      st_bf4(mo + 1024 + c, y0, y1, y2, y3);
    }
  }
}

#define XB_TMO      128
#define XB_XCNT(j)  (256  + 64 * (j))
#define XB_XSUB(j)  (1280 + 64 * (j))
#define XB_XGEN(j)  (2304 + 64 * (j))
#define XB_TOP      3328
#define XB_TOPGEN   3392
#define XCD_BAR_WORDS 3456
#define XB_SPIN_CAP (1u << 18)
#define LAS __attribute__((address_space(3)))

__device__ __forceinline__ unsigned xb_ld(unsigned* p)              { return __hip_atomic_load(p, __ATOMIC_RELAXED, __HIP_MEMORY_SCOPE_AGENT); }
__device__ __forceinline__ unsigned xb_add(unsigned* p, unsigned v) { return __hip_atomic_fetch_add(p, v, __ATOMIC_RELAXED, __HIP_MEMORY_SCOPE_AGENT); }
__device__ __forceinline__ unsigned xb_xcc_id() { return (unsigned)__builtin_amdgcn_s_getreg((3 << 11) | 20) & 0xFu; }
#define XB_SPIN(cond, bar) do { unsigned _sp = 0; while (cond) { __builtin_amdgcn_s_sleep(1); \
    if ((++_sp & 255u) == 0u) { if (xb_ld(&(bar)[XB_TMO])) break; if (_sp > XB_SPIN_CAP) { atomicAdd(&(bar)[XB_TMO], 1u); break; } } } } while (0)

struct XcdBarrier {
    unsigned* bar; unsigned x;
    volatile LAS unsigned* st;
};

__device__ __forceinline__ XcdBarrier xcd_barrier_post(unsigned* bar, volatile LAS unsigned* st) {
    XcdBarrier b; b.bar = bar; b.x = xb_xcc_id(); b.st = st;
    if (threadIdx.x == 0) (void)xb_add(&bar[XB_XCNT(b.x)], 1u);
    return b;
}
__device__ __forceinline__ void xcd_barrier_complete(unsigned* bar, unsigned x, unsigned& nloc, unsigned& nx) {
    const unsigned G = gridDim.x * gridDim.y * gridDim.z;
    unsigned sum, cnt, mine, sp = 0u;
    for (;;) {
        sum = 0u; cnt = 0u; mine = 0u;
#pragma unroll
        for (unsigned j = 0; j < 16; ++j) { const unsigned c = xb_ld(&bar[XB_XCNT(j)]); sum += c; cnt += (c > 0u) ? 1u : 0u; mine = (j == x) ? c : mine; }
        if (sum == G) break;
        __builtin_amdgcn_s_sleep(1);
        if ((++sp & 255u) == 0u) { if (xb_ld(&bar[XB_TMO])) break; if (sp > XB_SPIN_CAP) { atomicAdd(&bar[XB_TMO], 1u); break; } }
    }
    nloc = mine > 0u ? mine : 1u; nx = cnt > 0u ? cnt : 1u;
}

__device__ __forceinline__ void xcd_barrier(const XcdBarrier& b) {
    asm volatile("s_waitcnt vmcnt(0)" ::: "memory");
    __syncthreads();
    if (threadIdx.x == 0) {
        unsigned* bar = b.bar;
        __builtin_amdgcn_s_waitcnt(0);
        unsigned nloc = b.st[0], nx = b.st[1];
        if (nloc == 0u) { xcd_barrier_complete(bar, b.x, nloc, nx); b.st[0] = nloc; b.st[1] = nx; }
        const unsigned old = xb_add(&bar[XB_XSUB(b.x)], 1u);
        const unsigned gen = old / nloc;
        if (old + 1u == (gen + 1u) * nloc) {
            __builtin_amdgcn_fence(__ATOMIC_RELEASE, "agent");
            asm volatile("s_waitcnt vmcnt(0)" ::: "memory");
            const unsigned og = xb_add(&bar[XB_TOP], 1u);
            const unsigned tg = og / nx;
            if (og + 1u == (tg + 1u) * nx) xb_add(&bar[XB_TOPGEN], 1u);
            else XB_SPIN(xb_ld(&bar[XB_TOPGEN]) == tg, bar);
            __builtin_amdgcn_fence(__ATOMIC_ACQUIRE, "agent");
            xb_add(&bar[XB_XGEN(b.x)], 1u);
            asm volatile("s_waitcnt vmcnt(0)" ::: "memory");
        } else {
            XB_SPIN(xb_ld(&bar[XB_XGEN(b.x)]) == gen, bar);
            __builtin_amdgcn_fence(__ATOMIC_ACQUIRE, "agent");
            asm volatile("s_waitcnt vmcnt(0)" ::: "memory");
        }
    }
    __syncthreads();
}


template <int ph>
DEVI void run_phase(const Params& p, char* smem_raw) {
  float* smem = (float*)smem_raw;
  char* ws = p.ws;
  {
    switch (ph) {
      case 0:
        phase0(p, smem);
        conv_fp8_rows(p.in[I_PU], (unsigned char*)(ws + OFF_UB), (float*)(ws + OFF_USC));
        conv_fp8_rows(p.in[I_PV], (unsigned char*)(ws + OFF_VB), (float*)(ws + OFF_VSC));
        break;
      case 1: {
        EpiIn0 E{(float*)(ws + OFF_PROJ), (const float*)(ws + OFF_LB), (const float*)(ws + OFF_INVREV)};
        pg8::Gemm g{(const pg8::bf16_t*)(ws + OFF_XB), (const pg8::bf16_t*)(ws + OFF_WIN0), MP, N0, 2048};
        pg8::StaticOrder S;
        S.init(MP, N0, (int)gridDim.x, (int)blockIdx.x);
        pg8::gemm_phase<EpiIn0, pg8::StaticOrder, false>((PG8_LAS unsigned char*)smem_raw, g, S, E, nullptr);
      } break;
      case 2: phase_rec0(p, smem); break;
      case 3: phase_post0(p); break;
      case 4: case 15: {
        float* GO = (float*)(ws + OFF_GOUT);
        gemm_phase((const u16*)(ws + OFF_MIXB), 2048, 0, (const u16*)(ws + (ph == 4 ? OFF_WOUT0 : OFF_WOUT1)), 2048,
                   69, 16, smem_raw, [=](int row, int col, float v0, float v1) {
                     GO[(size_t)row * 2048 + col] = v0;
                     GO[(size_t)row * 2048 + col + 32] = v1;
                   });
      } break;
      case 5: case 16: {
        int l = (ph == 5) ? 0 : 1;
        phase_ln(p, (const float*)(ws + OFF_GOUT), p.in[I_LNG] + (size_t)(l * 2) * D, p.in[I_LNB] + (size_t)(l * 2) * D);
      } break;
      case 6: case 17: {
        u16* QB = (u16*)(ws + OFF_QB);
        gemm_phase((const u16*)(ws + OFF_XB), 2048, 0, (const u16*)(ws + (ph == 6 ? OFF_WQ0 : OFF_WQ1)), 2048, 69,
                   16, smem_raw, [=](int row, int col, float v0, float v1) {
                     QB[(size_t)row * 2048 + col] = f2bf(v0);
                     QB[(size_t)row * 2048 + col + 32] = f2bf(v1);
                   });
      } break;
      case 7: case 18: {
        float* SC = (float*)(ws + OFF_GOUT);
        gemm_phase((const u16*)(ws + OFF_QB), 2048, 128, (const u16*)(ws + (ph == 7 ? OFF_KEY0 : OFF_KEY1)), 128,
                   69, 16, smem_raw, [=](int row, int col, float v0, float v1) {
                     SC[(size_t)row * 2048 + col] = v0;
                     SC[(size_t)row * 2048 + col + 32] = v1;
                   });
      } break;
      case 8: phase_peer(p, 0, false); break;
      case 9: {
        conv_fp8_rows(p.in[I_PU] + (size_t)16384 * 2048, (unsigned char*)(ws + OFF_UB), (float*)(ws + OFF_USC));
        conv_fp8_rows(p.in[I_PV] + (size_t)16384 * 2048, (unsigned char*)(ws + OFF_VB), (float*)(ws + OFF_VSC));
        EpiIn1 E{(float*)(ws + OFF_PROJ), (float*)(ws + OFF_DTA), p.in[I_DTB], p.in[I_ALOG]};
        pg8::Gemm g{(const pg8::bf16_t*)(ws + OFF_XB), (const pg8::bf16_t*)(ws + OFF_WIN1), MP, N1, 2048};
        pg8::StaticOrder S;
        S.init(MP, N1, (int)gridDim.x, (int)blockIdx.x);
        pg8::gemm_phase<EpiIn1, pg8::StaticOrder, false>((PG8_LAS unsigned char*)smem_raw, g, S, E, nullptr);
      } break;
      case 10: phase_pre1(p); break;
      case 11: {
        float* DEC = (float*)(ws + OFF_DEC);
        float* AA = (float*)(ws + OFF_AA);
        float* GG = (float*)(ws + OFF_GG);
        const float* w0 = p.in[I_W0];
        const float* a0 = p.in[I_A0];
        gemm_phase((const u16*)(ws + OFF_LRA), 64, 0, (const u16*)(ws + OFF_W2T), 64, 69, 8, smem_raw,
                   [=](int row, int col, float v0, float v1) {
#pragma unroll
                     for (int e = 0; e < 2; ++e) {
                       int cc = col + e * 32;
                       float v = (e ? v1 : v0);
                       float wl = -softplusf_(-v) - 0.5f;
                       DEC[(size_t)row * 1024 + cc] = expf(-expf(wl));
                     }
                   }, w0);
        gemm_phase((const u16*)(ws + OFF_LRB), 64, 0, (const u16*)(ws + OFF_A2T), 64, 69, 8, smem_raw,
                   [=](int row, int col, float v0, float v1) {
                     AA[(size_t)row * 1024 + col] = sigmoidf_(v0);
                     AA[(size_t)row * 1024 + col + 32] = sigmoidf_(v1);
                   }, a0);
        gemm_phase((const u16*)(ws + OFF_LRG), 192, 0, (const u16*)(ws + OFF_G2T), 192, 69, 8, smem_raw,
                   [=](int row, int col, float v0, float v1) {
                     GG[(size_t)row * 1024 + col] = v0;
                     GG[(size_t)row * 1024 + col + 32] = v1;
                   });
      } break;
      case 12: phase_pre1c(p); break;
      case 13: phase_rec1(p, smem); break;
      case 14: phase_post1(p); break;
      case 19: phase_peer(p, 1, true); break;
      default: break;
    }
  }
}

__global__ void __launch_bounds__(512, 2) mega(Params p, int ph_lo, int ph_hi) {
  __shared__ __attribute__((aligned(16))) char smem_raw[SMEM_BYTES];
  __shared__ uint4 xb_words;
  cg::grid_group grid = cg::this_grid();
  if (threadIdx.x == 0) xb_words = make_uint4(0u, 0u, 0u, 0u);
  __syncthreads();
  XcdBarrier xb = xcd_barrier_post((unsigned*)(p.ws + OFF_BAR), (volatile LAS unsigned*)&xb_words);
  if (ph_hi > 1000) grid.sync();
#ifndef REPEAT_MASK
#define REPEAT_MASK 0
#endif
#define PHASE(K)                                          \
  if (ph_lo <= K && K < ph_hi) run_phase<K>(p, smem_raw); \
  if ((REPEAT_MASK >> K) & 1) { xcd_barrier(xb); run_phase<K>(p, smem_raw); } \
  if (ph_lo <= K && K + 1 < ph_hi) xcd_barrier(xb);
  PHASE(0) PHASE(1) PHASE(2) PHASE(3) PHASE(4) PHASE(5) PHASE(6) PHASE(7) PHASE(8) PHASE(9)
  PHASE(10) PHASE(11) PHASE(12) PHASE(13) PHASE(14) PHASE(15) PHASE(16) PHASE(17) PHASE(18) PHASE(19)
}
#ifdef PHASE_TEST
template <int PH>
__global__ void __launch_bounds__(512, 2) phk(Params p) {
  __shared__ __attribute__((aligned(16))) char smem_raw[SMEM_BYTES];
  run_phase<PH>(p, smem_raw);
}
#define INST(N) template __global__ void phk<N>(Params);
INST(0) INST(1) INST(2) INST(3) INST(4) INST(5) INST(6) INST(7) INST(8) INST(9) INST(10) INST(11) INST(12) INST(13) INST(14) INST(19)
#endif

constexpr int NPHASE = 20;

extern "C" void kernel_launch(void* const* d_in, const int* in_sizes, int n_in, void* d_out, int out_size, void* d_ws,
                              size_t ws_size, hipStream_t stream) {
  static int grid_blocks = 0;
  if (!grid_blocks) {
    int dev = 0, cus = 0, per_cu = 0;
    hipGetDevice(&dev);
    hipDeviceGetAttribute(&cus, hipDeviceAttributeMultiprocessorCount, dev);
    hipOccupancyMaxActiveBlocksPerMultiprocessor(&per_cu, mega, 512, 0);
    if (per_cu > 1) per_cu = 1;
    if (per_cu < 1) per_cu = 1;
    grid_blocks = cus * per_cu;
  }
  Params p{};
  for (int i = 0; i < 38; ++i) p.in[i] = (const float*)d_in[i];
  p.out = (float*)d_out;
  p.ws = (char*)d_ws;
  (void)hipMemsetAsync((char*)d_ws + OFF_BAR, 0, 3456 * 4, stream);
  int lo = 0, hi = NPHASE;
  void* args[] = {&p, &lo, &hi};
  hipError_t e = hipLaunchCooperativeKernel((void*)mega, dim3(grid_blocks), dim3(512), args, 0, stream);
  if (e != hipSuccess) fprintf(stderr, "cooperative launch failed: %s (grid %d)\n", hipGetErrorString(e), grid_blocks);
}
```

```cpp
#include <hip/hip_runtime.h>
#include <hip/hip_bf16.h>
#include <hip/hip_cooperative_groups.h>
#include <cstdio>
#include <cmath>
namespace cg = cooperative_groups;

#define DEVI __device__ __forceinline__
typedef unsigned short u16;
using bf16x8 = __attribute__((ext_vector_type(8))) short;
using f32x4 = __attribute__((ext_vector_type(4))) float;
using u32x4 = __attribute__((ext_vector_type(4))) unsigned int;

constexpr int D = 2048;
constexpr int TP = 2064;
constexpr int MPR = 8256;
constexpr int M = 8768;
constexpr int MP = 8960;
constexpr int N0 = 7168;
constexpr int N1 = 6144;
constexpr float ALPHA = 1.41421356237f;

constexpr size_t SZ_TAB = (size_t)16384 * 2048 * 2;
constexpr size_t OFF_UB = 0;
constexpr size_t OFF_VB = OFF_UB + SZ_TAB;
constexpr size_t OFF_WIN0 = OFF_VB + SZ_TAB;
constexpr size_t OFF_WOUT0 = OFF_WIN0 + (size_t)N0 * 2048 * 2;
constexpr size_t OFF_WQ0 = OFF_WOUT0 + (size_t)2048 * 2048 * 2;
constexpr size_t OFF_KEY0 = OFF_WQ0 + (size_t)2048 * 2048 * 2;
constexpr size_t OFF_WIN1 = OFF_KEY0 + (size_t)16 * 128 * 128 * 2;
constexpr size_t OFF_WOUT1 = OFF_WIN1 + (size_t)N1 * 2048 * 2;
constexpr size_t OFF_WQ1 = OFF_WOUT1 + (size_t)2048 * 2048 * 2;
constexpr size_t OFF_KEY1 = OFF_WQ1 + (size_t)2048 * 2048 * 2;
constexpr size_t OFF_W2T = OFF_KEY1 + (size_t)16 * 128 * 128 * 2;
constexpr size_t OFF_A2T = OFF_W2T + (size_t)1024 * 64 * 2;
constexpr size_t OFF_G2T = OFF_A2T + (size_t)1024 * 64 * 2;
constexpr size_t OFF_LB = OFF_G2T + (size_t)1024 * 192 * 2;
constexpr size_t OFF_INVREV = OFF_LB + 1024 * 4;
constexpr size_t OFF_XF = OFF_INVREV + 64 * 8;
constexpr size_t OFF_XB = OFF_XF + (size_t)MP * 2048 * 4;
constexpr size_t OFF_PROJ = OFF_XB + (size_t)MP * 2048 * 2;
constexpr size_t OFF_GOUT = OFF_PROJ + (size_t)MP * N0 * 4;
constexpr size_t OFF_OMIX = OFF_GOUT + (size_t)MP * 2048 * 4;
constexpr size_t OFF_MIXB = OFF_OMIX + (size_t)MP * 2048 * 4;
constexpr size_t OFF_QB = OFF_MIXB + (size_t)MP * 2048 * 2;
constexpr size_t OFF_RKV = OFF_QB + (size_t)MP * 2048 * 2;
constexpr size_t OFF_DEC = OFF_RKV + (size_t)MP * 3072 * 4;
constexpr size_t OFF_AA = OFF_DEC + (size_t)MP * 1024 * 4;
constexpr size_t OFF_GG = OFF_AA + (size_t)MP * 1024 * 4;
constexpr size_t OFF_LRA = OFF_GG + (size_t)MP * 1024 * 4;
constexpr size_t OFF_LRB = OFF_LRA + (size_t)MP * 64 * 2;
constexpr size_t OFF_LRG = OFF_LRB + (size_t)MP * 64 * 2;
constexpr size_t OFF_DTA = OFF_LRG + (size_t)MP * 192 * 2;
constexpr size_t OFF_BON = OFF_DTA + (size_t)MP * 64 * 4;
constexpr size_t OFF_USC = OFF_BON + (size_t)MP * 16 * 4;
constexpr size_t OFF_VSC = OFF_USC + 16384 * 4;
constexpr size_t OFF_BAR = OFF_VSC + 16384 * 4;
constexpr size_t WS_TOTAL = OFF_BAR + 3456 * 4;
static_assert(WS_TOTAL <= (size_t)1 << 30, "workspace too large");

constexpr size_t O_YP = 0;
constexpr size_t O_YS = O_YP + (size_t)4 * 2048 * 2048;
constexpr size_t O_HGP = O_YS + (size_t)128 * 4 * 2048;
constexpr size_t O_HGS = O_HGP + (size_t)4 * 8 * 128 * 128;
constexpr size_t O_RTP = O_HGS + (size_t)128 * 8 * 128 * 128;
constexpr size_t O_RTS = O_RTP + (size_t)4 * 4 * 128 * 256;
constexpr size_t O_SSP = O_RTS + (size_t)128 * 4 * 128 * 256;
constexpr size_t O_SSS = O_SSP + (size_t)4 * 16 * 128 * 64;
constexpr size_t O_CVP = O_SSS + (size_t)128 * 16 * 128 * 64;
constexpr size_t O_CVS = O_CVP + (size_t)4 * 3 * 1536;
constexpr size_t O_WKP = O_CVS + (size_t)128 * 3 * 1536;
constexpr size_t O_WKS = O_WKP + (size_t)4 * 16 * 64 * 64;
constexpr size_t O_SHP = O_WKS + (size_t)128 * 16 * 64 * 64;
constexpr size_t O_SHS = O_SHP + (size_t)4 * 3360;

struct Params {
  const float* in[38];
  float* out;
  char* ws;
};
enum { I_XP = 0, I_XS, I_SHG, I_SRT, I_SSM, I_SCV, I_SWK, I_SSH, I_META, I_LNG, I_LNB, I_EWIN, I_LBL, I_HNG, I_EWOUT,
       I_OWIN, I_CVW, I_CVB, I_DTB, I_ALOG, I_DSK, I_SNG, I_MU, I_W0, I_W2, I_A0, I_A2, I_G2, I_KK, I_KA, I_RK,
       I_LXG, I_LXB, I_OWOUT, I_WQ, I_KEYS, I_PU, I_PV };

constexpr int VB_BYTES = 2 * 2 * 128 * 72 * 2;
constexpr int SMEM_BYTES = 2 * VB_BYTES;

DEVI u16 f2bf(float f) {
  unsigned u = __float_as_uint(f);
  u += 0x7fffu + ((u >> 16) & 1u);
  return (u16)(u >> 16);
}
DEVI unsigned pack2(float a, float b) { return (unsigned)f2bf(a) | ((unsigned)f2bf(b) << 16); }
DEVI float bflo(unsigned u) { return __uint_as_float(u << 16); }
DEVI float bfhi(unsigned u) { return __uint_as_float(u & 0xffff0000u); }
DEVI float sigmoidf_(float x) { return __builtin_amdgcn_rcpf(1.0f + __builtin_amdgcn_exp2f(-1.44269504089f * x)); }
DEVI float siluf_(float x) { return x * __builtin_amdgcn_rcpf(1.0f + __builtin_amdgcn_exp2f(-1.44269504089f * x)); }
DEVI float sigmoid_acc(float x) { return 1.0f / (1.0f + expf(-x)); }
DEVI float silu_acc(float x) { return x / (1.0f + expf(-x)); }
DEVI float softplusf_(float x) { return fmaxf(x, 0.0f) + log1pf(expf(-fabsf(x))); }
DEVI float wsum(float v) {
#pragma unroll
  for (int o = 32; o > 0; o >>= 1) v += __shfl_xor(v, o, 64);
  return v;
}
DEVI float wmaxf_(float v) {
#pragma unroll
  for (int o = 32; o > 0; o >>= 1) v = fmaxf(v, __shfl_xor(v, o, 64));
  return v;
}
DEVI int wmini_(int v) {
#pragma unroll
  for (int o = 32; o > 0; o >>= 1) v = min(v, __shfl_xor(v, o, 64));
  return v;
}
template <int CTRL>
DEVI float dppf(float v) {
  return __int_as_float(__builtin_amdgcn_update_dpp(0, __float_as_int(v), CTRL, 0xF, 0xF, true));
}
DEVI float red8(float v) {
  v += dppf<0xB1>(v);
  v += dppf<0x4E>(v);
  v += dppf<0x141>(v);
  return v;
}
DEVI float red16(float v) {
  v = red8(v);
  v += dppf<0x140>(v);
  return v;
}
DEVI float rlf_(float v, int l) { return __int_as_float(__builtin_amdgcn_readlane(__float_as_int(v), l)); }
DEVI int row_pos(int row) { return row < MPR ? (row % TP) : (16384 + ((row - MPR) & 3)); }

DEVI void conv_bf16_flat(const float* __restrict__ src, u16* __restrict__ dst, size_t n4) {
  size_t stride = (size_t)gridDim.x * blockDim.x;
  for (size_t i = (size_t)blockIdx.x * blockDim.x + threadIdx.x; i < n4; i += stride) {
    float4 v = ((const float4*)src)[i];
    uint2 o;
    o.x = pack2(v.x, v.y);
    o.y = pack2(v.z, v.w);
    ((uint2*)dst)[i] = o;
  }
}

template <int MODE>
DEVI int colmap(int j) {
  if (MODE == 0) return j;
  if (MODE == 1) {
    if (j < 4096 || j >= 5120) return j;
    int hb = j & ~127, c = j & 127, wc = c >> 5, n = (c >> 4) & 1, r = c & 15;
    int d = n ? (64 + wc * 16 + r) : (wc * 16 + r);
    return hb + d;
  }
  if (j < 2560) return j;
  if (j < 5920) return j + 16;
  if (j < 5936) return 2560 + (j - 5920);
  return -1;
}

template <int MODE>
DEVI void transpose_job(const float* __restrict__ src, int ldsrc, int Ksrc, u16* __restrict__ dst, int Kdst, int ndst,
                        float* smem) {
  int ktiles = Kdst / 64, ntiles = ndst / 64;
  int tid = threadIdx.x & 255;
  const int half = threadIdx.x >> 8;
  smem += half * (64 * 65);
  for (int base = blockIdx.x * 2; base < ktiles * ntiles; base += gridDim.x * 2) {
    int tile = base + half;
    const bool valid = tile < ktiles * ntiles;
    if (!valid) tile = ktiles * ntiles - 1;
    int tn = tile / ktiles, tk = tile % ktiles;
    int j0 = tn * 64, k0 = tk * 64;
    int jj = (tid & 15) * 4;
    int sc = colmap<MODE>(j0 + jj);
#pragma unroll
    for (int i = 0; i < 4; ++i) {
      int kk = i * 16 + (tid >> 4);
      float4 v = make_float4(0.f, 0.f, 0.f, 0.f);
      if (sc >= 0 && (k0 + kk) < Ksrc) v = *(const float4*)(src + (size_t)(k0 + kk) * ldsrc + sc);
      smem[kk * 65 + jj] = v.x;
      smem[kk * 65 + jj + 1] = v.y;
      smem[kk * 65 + jj + 2] = v.z;
      smem[kk * 65 + jj + 3] = v.w;
    }
    __syncthreads();
    int jr = tid >> 2, kq = (tid & 3) * 16;
    unsigned pk[8];
#pragma unroll
    for (int e = 0; e < 8; ++e) pk[e] = pack2(smem[(kq + 2 * e) * 65 + jr], smem[(kq + 2 * e + 1) * 65 + jr]);
    uint4* dp = (uint4*)(dst + (size_t)(j0 + jr) * Kdst + k0 + kq);
    if (valid) {
      dp[0] = make_uint4(pk[0], pk[1], pk[2], pk[3]);
      dp[1] = make_uint4(pk[4], pk[5], pk[6], pk[7]);
    }
    __syncthreads();
  }
}

DEVI void phase0(const Params& p, float* smem) {
  char* ws = p.ws;
  conv_bf16_flat(p.in[I_KEYS], (u16*)(ws + OFF_KEY0), (size_t)16 * 128 * 128 / 4);
  conv_bf16_flat(p.in[I_KEYS] + (size_t)16 * 128 * 128, (u16*)(ws + OFF_KEY1), (size_t)16 * 128 * 128 / 4);
  transpose_job<1>(p.in[I_EWIN], N0, 2048, (u16*)(ws + OFF_WIN0), 2048, N0, smem);
  transpose_job<0>(p.in[I_EWOUT], 2048, 2048, (u16*)(ws + OFF_WOUT0), 2048, 2048, smem);
  transpose_job<0>(p.in[I_WQ], 2048, 2048, (u16*)(ws + OFF_WQ0), 2048, 2048, smem);
  transpose_job<0>(p.in[I_WQ] + (size_t)2048 * 2048, 2048, 2048, (u16*)(ws + OFF_WQ1), 2048, 2048, smem);
  transpose_job<2>(p.in[I_OWIN], 5936, 2048, (u16*)(ws + OFF_WIN1), 2048, N1, smem);
  transpose_job<0>(p.in[I_OWOUT], 2048, 2048, (u16*)(ws + OFF_WOUT1), 2048, 2048, smem);
  transpose_job<0>(p.in[I_W2], 1024, 64, (u16*)(ws + OFF_W2T), 64, 1024, smem);
  transpose_job<0>(p.in[I_A2], 1024, 64, (u16*)(ws + OFF_A2T), 64, 1024, smem);
  transpose_job<0>(p.in[I_G2], 1024, 160, (u16*)(ws + OFF_G2T), 192, 1024, smem);
  {
    float* XF = (float*)(ws + OFF_XF);
    u16* XB = (u16*)(ws + OFF_XB);
    size_t n4 = (size_t)MP * 512;
    size_t stride = (size_t)gridDim.x * blockDim.x;
    for (size_t i = (size_t)blockIdx.x * blockDim.x + threadIdx.x; i < n4; i += stride) {
      int row = (int)(i >> 9), c4 = (int)(i & 511);
      float4 v = make_float4(0.f, 0.f, 0.f, 0.f);
      if (row < MPR) {
        int b = row / TP, t = row % TP;
        const float* s = (t < 16) ? (p.in[I_META] + (size_t)t * D) : (p.in[I_XP] + ((size_t)b * 2048 + (t - 16)) * D);
        v = ((const float4*)s)[c4];
      } else if (row < M) {
        v = ((const float4*)(p.in[I_XS] + (size_t)(row - MPR) * D))[c4];
      }
      ((float4*)XF)[i] = v;
      uint2 o;
      o.x = pack2(v.x, v.y);
      o.y = pack2(v.z, v.w);
      ((uint2*)XB)[i] = o;
    }
  }
  if (blockIdx.x == 0) {
    float* LB = (float*)(ws + OFF_LB);
    const float* lg = p.in[I_LBL];
    for (int c = threadIdx.x; c < 1024; c += blockDim.x) {
      float a = lg[c], b = lg[1024 + c], d = lg[2048 + c];
      float m = fmaxf(a, fmaxf(b, d));
      float ea = expf(a - m), eb = expf(b - m), ed = expf(d - m);
      LB[c] = ea / (ea + eb + ed);
    }
    float* IR = (float*)(ws + OFF_INVREV);
    if (threadIdx.x < 64) {
      double d = (double)threadIdx.x;
      double v = exp(-d * (9.210340371976184 / 64.0)) * 0.15915494309189535;
      float h = (float)v;
      IR[threadIdx.x * 2] = h;
      IR[threadIdx.x * 2 + 1] = (float)(v - (double)h);
    }
  }
}

constexpr int G_LDS_STRIDE = 72;
constexpr int G_LDS_BUF = 2 * 128 * G_LDS_STRIDE;
template <class Epi>
DEVI void gemm_phase(const u16* __restrict__ A, int lda, int a_ntile_off, const u16* __restrict__ Bt, int K, int mtiles,
                     int ntiles, char* smem, Epi epi, const float* __restrict__ colc = nullptr) {
  const int half = threadIdx.x >> 8;
  u16* S0 = (u16*)(smem + half * VB_BYTES);
  const int tid = threadIdx.x & 255, wid = tid >> 6, lane = tid & 63, wr = wid >> 1, wc = wid & 1, fr = lane & 15, fq = lane >> 4;
  const int nk = K / 64;
  const int ntot = mtiles * ntiles;
  for (int base = blockIdx.x * 2; base < ntot; base += gridDim.x * 2) {
    int tile = base + half;
    const bool valid = tile < ntot;
    if (!valid) tile = ntot - 1;
    const int tm = tile / ntiles, tn = tile - tm * ntiles;
    const int brow = tm * 128, bcol = tn * 128;
    const u16* Ag = A + (size_t)brow * lda + (size_t)tn * a_ntile_off;
    const u16* Bg = Bt + (size_t)bcol * K;
    f32x4 acc[4][4];
#pragma unroll
    for (int m = 0; m < 4; ++m)
#pragma unroll
      for (int n = 0; n < 4; ++n) acc[m][n] = f32x4{0.f, 0.f, 0.f, 0.f};
    u32x4 ra0[4], rb0[4], ra1[4], rb1[4];
    auto gload = [&](int t, u32x4(&ra)[4], u32x4(&rb)[4]) {
#pragma unroll
      for (int i = 0; i < 4; ++i) {
        int c = tid + i * 256, r = c >> 3, kc = c & 7;
        ra[i] = *(const u32x4*)(Ag + (size_t)r * lda + t * 64 + kc * 8);
        rb[i] = *(const u32x4*)(Bg + (size_t)r * K + t * 64 + kc * 8);
      }
    };
    auto lwrite = [&](int buf, const u32x4(&ra)[4], const u32x4(&rb)[4]) {
      u16* SA = S0 + buf * G_LDS_BUF;
      u16* SB = SA + 128 * G_LDS_STRIDE;
#pragma unroll
      for (int i = 0; i < 4; ++i) {
        int c = tid + i * 256, r = c >> 3, kc = c & 7;
        *(u32x4*)(SA + r * G_LDS_STRIDE + kc * 8) = ra[i];
        *(u32x4*)(SB + r * G_LDS_STRIDE + kc * 8) = rb[i];
      }
    };
    auto compute = [&](int buf) {
      const u16* SA = S0 + buf * G_LDS_BUF;
      const u16* SB = SA + 128 * G_LDS_STRIDE;
#pragma unroll
      for (int kh = 0; kh < 2; ++kh) {
        bf16x8 At[4], Bl[4];
#pragma unroll
        for (int m = 0; m < 4; ++m)
          At[m] = *(const bf16x8*)(SA + (wr * 64 + m * 16 + fr) * G_LDS_STRIDE + kh * 32 + fq * 8);
#pragma unroll
        for (int n = 0; n < 4; ++n)
          Bl[n] = *(const bf16x8*)(SB + (wc * 64 + n * 16 + fr) * G_LDS_STRIDE + kh * 32 + fq * 8);
#pragma unroll
        for (int m = 0; m < 4; ++m)
#pragma unroll
          for (int n = 0; n < 4; ++n) acc[m][n] = __builtin_amdgcn_mfma_f32_16x16x32_bf16(At[m], Bl[n], acc[m][n], 0, 0, 0);
        __builtin_amdgcn_sched_barrier(0);
      }
    };
    gload(0, ra0, rb0);
    if (nk > 1) gload(1, ra1, rb1);
    lwrite(0, ra0, rb0);
    __syncthreads();
#pragma unroll 1
    for (int t = 0; t < nk; t += 2) {
      if (t + 2 < nk) gload(t + 2, ra0, rb0);
      compute(0);
      if (t + 1 < nk) lwrite(1, ra1, rb1);
      __syncthreads();
      if (t + 1 < nk) {
        if (t + 3 < nk) gload(t + 3, ra1, rb1);
        compute(1);
        if (t + 2 < nk) lwrite(0, ra0, rb0);
        __syncthreads();
      }
    }
    if (valid) {
      float cc[4] = {0.f, 0.f, 0.f, 0.f};
      if (colc) {
#pragma unroll
        for (int n = 0; n < 4; ++n) cc[n] = colc[bcol + wc * 64 + n * 16 + fr];
      }
#pragma unroll
      for (int m = 0; m < 4; ++m)
#pragma unroll
        for (int n = 0; n < 2; ++n)
#pragma unroll
          for (int j = 0; j < 4; ++j) {
            int row = brow + wr * 64 + m * 16 + fq * 4 + j;
            int col = bcol + wc * 64 + n * 16 + fr;
            epi(row, col, acc[m][n][j] + cc[n], acc[m][n + 2][j] + cc[n + 2]);
          }
    }
  }
}


namespace pg8 {
#define PG8_LAS __attribute__((address_space(3)))
typedef unsigned short bf16_t;
typedef short bf16x8 __attribute__((ext_vector_type(8)));
typedef float f32x4 __attribute__((ext_vector_type(4)));
typedef unsigned u32x4 __attribute__((ext_vector_type(4)));
constexpr int BM = 256, BK = 64, HALF = 128, HTB = HALF * BK * 2  , STAGE_BYTES = 8 * HTB, NXCD = 8, WGM = 8;

__host__ __device__ __forceinline__ int lds_byte(int r, int c) { const int st = (r >> 4) * 2 + (c >> 5), rr = r & 15, cc = c & 31, ob = rr * 64 + cc * 2; return st * 1024 + (ob ^ (((ob >> 9) & 1) << 5)); }
__host__ __device__ __forceinline__ void stage_rc(int b, int& R, int& C) { const int st = b / 1024, sb = b % 1024, swz = sb ^ (((sb >> 9) & 1) << 5); R = (st >> 1) * 16 + swz / 64; C = (st & 1) * 32 + (swz % 64) / 2; }
__host__ __device__ __forceinline__ int perm32(int rho) { const int n = rho >> 4, i = rho & 15; return 8 * (i >> 2) + 4 * n + (i & 3); }

struct Unit { int pm, pn; };
struct Gemm { const bf16_t* A; const bf16_t* Bt; int M, N, K; };

struct StaticOrder {
    int nM, nN, nwg, G, c;
    __host__ __device__ void init(int M, int N, int G_, int c_) { nM = M / BM; nN = N / BM; nwg = nM * nN; G = G_; c = c_; }
    __host__ __device__ bool next(int i, Unit& u) const {
        const long L = (long)i * G + c; if (L >= nwg) return false;
        int wgid = (int)L; { const int q = nwg / NXCD, r = nwg % NXCD, xcd = wgid % NXCD, off = wgid / NXCD; wgid = (xcd < r ? xcd * (q + 1) : r * (q + 1) + (xcd - r) * q) + off; }
        const int nig = WGM * nN, gid = wgid / nig, fm = gid * WGM, gsz = (nM - fm) < WGM ? (nM - fm) : WGM;
        u.pm = fm + ((wgid % nig) % gsz); u.pn = (wgid % nig) / gsz; return true;
    }
    __device__ __forceinline__ void a_ready(const Unit&) const {}
    __device__ __forceinline__ void done(const Unit&) const {}
};
template <class Epi, class Sched, bool STAMP = false>
__device__ __forceinline__ void gemm_phase(PG8_LAS unsigned char* lds, const Gemm g, const Sched& S, const Epi& E, unsigned long long* stamps) {
    const int tid = threadIdx.x, wid = __builtin_amdgcn_readfirstlane(tid >> 6), lane = tid & 63, wr = wid >> 2, wc = wid & 3, fr = lane & 15, fq = lane >> 4;
    const int K = g.K, nt = K / BK;
    int ts_lo = 0, ts_hi = 0, nts = 0; const unsigned long long rt_entry = STAMP ? (unsigned long long)wall_clock64() : 0ull;
#define PG8_STAMP() do { if (STAMP && wid == 0 && nts < 64) { const unsigned long long _c = (unsigned long long)clock64(); \
        ts_lo = (lane == nts) ? (int)(unsigned)_c : ts_lo; ts_hi = (lane == nts) ? (int)(unsigned)(_c >> 32) : ts_hi; ++nts; } } while (0)
    PG8_STAMP();
    unsigned voffA[2], voffB[2];
#pragma unroll
    for (int i = 0; i < 2; ++i) { int R, C; stage_rc(tid * 16 + i * 8192, R, C); const int Rb = Epi::PERM ? ((R & ~31) + perm32(R & 31)) : R;
        voffA[i] = (unsigned)(R * K + C) * 2u; voffB[i] = (unsigned)(Rb * K + C) * 2u; }
    const size_t kstep = (size_t)(BK * 2);
    const size_t hstep = (size_t)HALF * K * 2;
    const size_t tstep = 2 * hstep;
    const unsigned ldsw = (unsigned)wid * 1024u;
    const int aoff = lds_byte(wr * 64 + fr, fq * 8), boff = lds_byte(wc * 32 + fr, fq * 8);
#define PG8_SA(b, h) (((b) * 2 + (h)) * HTB)
#define PG8_SB(b, h) ((4 + (b) * 2 + (h)) * HTB)
#define PG8_STAGE(bufoff, gbase, voff) do { _Pragma("unroll") for (int _i = 0; _i < 2; ++_i) \
        __builtin_amdgcn_global_load_lds((const unsigned*)((const char*)(gbase) + (voff)[_i]), (PG8_LAS unsigned*)(lds + (bufoff) + ldsw + _i * 8192), 16, 0, 0); } while (0)
#define PG8_LDA(dst, b, h) do { _Pragma("unroll") for (int m = 0; m < 4; ++m) _Pragma("unroll") for (int k = 0; k < 2; ++k) dst[m][k] = *(const PG8_LAS bf16x8*)(lds + PG8_SA(b, h) + aoff + m * 2048 + k * 1024); } while (0)
#define PG8_LDB(dst, b, h) do { _Pragma("unroll") for (int n = 0; n < 2; ++n) _Pragma("unroll") for (int k = 0; k < 2; ++k) dst[n][k] = *(const PG8_LAS bf16x8*)(lds + PG8_SB(b, h) + boff + n * 2048 + k * 1024); } while (0)
#define PG8_MMA(ai, bj, At, Bt) do { __builtin_amdgcn_s_setprio(1); _Pragma("unroll") for (int m = 0; m < 4; ++m) _Pragma("unroll") for (int n = 0; n < 2; ++n) _Pragma("unroll") for (int k = 0; k < 2; ++k) \
        acc[ai][bj][m][n] = __builtin_amdgcn_mfma_f32_16x16x32_bf16(Bt[n][k], At[m][k], acc[ai][bj][m][n], 0, 0, 0); __builtin_amdgcn_s_setprio(0); } while (0)
#define PG8_WAIT_V(n) asm volatile("s_waitcnt vmcnt(" #n ")" ::: "memory")
#define PG8_WAIT_L(n) asm volatile("s_waitcnt lgkmcnt(" #n ")" ::: "memory")
#define PG8_BAR __builtin_amdgcn_s_barrier()
#define PG8_SCHED __builtin_amdgcn_sched_barrier(0)
    Unit cur, nxt; int ui = 0;
    if (!S.next(0, cur)) return;
    f32x4 acc[2][2][4][2];
#pragma unroll
    for (int a = 0; a < 2; ++a)
#pragma unroll
        for (int b = 0; b < 2; ++b)
#pragma unroll
            for (int m = 0; m < 4; ++m)
#pragma unroll
                for (int n = 0; n < 2; ++n) acc[a][b][m][n] = (f32x4){0.f, 0.f, 0.f, 0.f};
    bf16x8 At[4][2], B0[2][2], B1[2][2];
    const char* cA = (const char*)g.A + (size_t)cur.pm * tstep; const char* cB = (const char*)g.Bt + (size_t)cur.pn * tstep;
    S.a_ready(cur);
    PG8_STAGE(PG8_SB(0, 0), cB, voffB); PG8_STAGE(PG8_SA(0, 0), cA, voffA); PG8_STAGE(PG8_SB(0, 1), cB + hstep, voffB); PG8_STAGE(PG8_SA(0, 1), cA + hstep, voffA);
    if (wr == 1) PG8_BAR;
    PG8_WAIT_V(4); PG8_BAR;
    PG8_STAGE(PG8_SB(1, 0), cB + kstep, voffB); PG8_STAGE(PG8_SA(1, 0), cA + kstep, voffA); PG8_STAGE(PG8_SB(1, 1), cB + hstep + kstep, voffB);
    PG8_WAIT_V(6); PG8_BAR;
    PG8_STAMP();
    for (;;) {
        const bool has_next = S.next(ui + 1, nxt);
        const char* nA = has_next ? (const char*)g.A + (size_t)nxt.pm * tstep : cA; const char* nB = has_next ? (const char*)g.Bt + (size_t)nxt.pn * tstep : cB;
        for (int t = 0; t < nt; t += 2) {
            const bool last = (t == nt - 2);
            const char* a1 = cA + (size_t)(t + 1) * kstep;
            const char* a2 = last ? nA : cA + (size_t)(t + 2) * kstep; const char* b2 = last ? nB : cB + (size_t)(t + 2) * kstep;
            const char* a3 = a2 + kstep; const char* b3 = b2 + kstep;
            if (last && has_next) S.a_ready(nxt);
            PG8_LDB(B0, 0, 0); PG8_SCHED; PG8_LDA(At, 0, 0); PG8_STAGE(PG8_SA(1, 1), a1 + hstep, voffA);
            PG8_WAIT_L(8); PG8_BAR; PG8_WAIT_L(0); PG8_MMA(0, 0, At, B0); PG8_BAR; PG8_SCHED;
            PG8_LDB(B1, 0, 1); PG8_STAGE(PG8_SB(0, 0), b2, voffB);
            PG8_BAR; PG8_WAIT_L(0); PG8_MMA(0, 1, At, B1); PG8_BAR;
            PG8_LDA(At, 0, 1); PG8_STAGE(PG8_SA(0, 0), a2, voffA);
            PG8_BAR; PG8_WAIT_L(0); PG8_MMA(1, 0, At, B0); PG8_BAR; PG8_SCHED;
            PG8_STAGE(PG8_SB(0, 1), b2 + hstep, voffB);
            PG8_WAIT_V(6); PG8_BAR; PG8_MMA(1, 1, At, B1); PG8_BAR;
            PG8_LDB(B0, 1, 0); PG8_SCHED; PG8_LDA(At, 1, 0); PG8_STAGE(PG8_SA(0, 1), a2 + hstep, voffA);
            PG8_WAIT_L(8); PG8_BAR; PG8_WAIT_L(0); PG8_MMA(0, 0, At, B0); PG8_BAR; PG8_SCHED;
            PG8_LDB(B1, 1, 1); PG8_STAGE(PG8_SB(1, 0), b3, voffB);
            PG8_BAR; PG8_WAIT_L(0); PG8_MMA(0, 1, At, B1); PG8_BAR;
            PG8_LDA(At, 1, 1); PG8_STAGE(PG8_SA(1, 0), a3, voffA);
            PG8_BAR; PG8_WAIT_L(0); PG8_MMA(1, 0, At, B0); PG8_BAR; PG8_SCHED;
            PG8_STAGE(PG8_SB(1, 1), b3 + hstep, voffB);
            PG8_WAIT_V(6); PG8_BAR; PG8_MMA(1, 1, At, B1); PG8_BAR;
        }
        PG8_STAMP();
        if constexpr (!Epi::AFTER_DRAIN) { E(acc, cur, wr, wc, fr, fq); S.done(cur); }
        PG8_STAMP();
        if (!has_next) break;
#pragma unroll
        for (int a = 0; a < 2; ++a)
#pragma unroll
            for (int b = 0; b < 2; ++b)
#pragma unroll
                for (int m = 0; m < 4; ++m)
#pragma unroll
                    for (int n = 0; n < 2; ++n) acc[a][b][m][n] = (f32x4){0.f, 0.f, 0.f, 0.f};
        cur = nxt; cA = nA; cB = nB; ++ui;
    }
    PG8_WAIT_V(0);
    if (wr == 0) PG8_BAR;
    PG8_BAR;
    if constexpr (Epi::AFTER_DRAIN) { E.fused(acc, cur, wr, wc, fr, fq, lds, wid, lane); S.done(cur); }
    PG8_STAMP();
    if (STAMP && wid == 0) { stamps[lane] = lane < nts ? (((unsigned long long)(unsigned)ts_hi << 32) | (unsigned)ts_lo) : 0ull;
        if (lane == 62) stamps[62] = rt_entry; if (lane == 63) stamps[63] = (unsigned long long)wall_clock64(); }
#undef PG8_STAMP
#undef PG8_SA
#undef PG8_SB
#undef PG8_STAGE
#undef PG8_LDA
#undef PG8_LDB
#undef PG8_MMA
#undef PG8_WAIT_V
#undef PG8_WAIT_L
#undef PG8_BAR
#undef PG8_SCHED
}
}

struct EpiIn0 {
  static constexpr bool PERM = false, AFTER_DRAIN = false;
  float* PROJ;
  const float* LB;
  const float* IR;
  __device__ __forceinline__ void operator()(const pg8::f32x4 (&acc)[2][2][4][2], const pg8::Unit& u, int wr, int wc, int fr, int fq) const {
#pragma unroll
    for (int bj = 0; bj < 2; ++bj) {
      const int cb = u.pn * 256 + bj * 128;
      if (cb >= 4096 && cb < 5120) {
        const int d0 = wc * 16 + 4 * fq;
        const pg8::f32x4 irA = *(const pg8::f32x4*)(IR + 2 * d0), irB = *(const pg8::f32x4*)(IR + 2 * d0 + 4);
        const float irh[4] = {irA[0], irA[2], irB[0], irB[2]}, irl[4] = {irA[1], irA[3], irB[1], irB[3]};
        const float sc = (cb >= 4608) ? 0.08838834764831845f : 1.0f;
#pragma unroll
        for (int ai = 0; ai < 2; ++ai)
#pragma unroll
          for (int m = 0; m < 4; ++m) {
            const int row = u.pm * 256 + ai * 128 + wr * 64 + m * 16 + fr;
            float* pr = PROJ + (size_t)row * N0;
            const pg8::f32x4 v0 = acc[ai][bj][m][0], v1 = acc[ai][bj][m][1];
            const float pos = (float)row_pos(row);
            pg8::f32x4 o1, o2;
#pragma unroll
            for (int j = 0; j < 4; ++j) {
              float ph = pos * irh[j];
              float pe = __builtin_fmaf(pos, irh[j], -ph) + pos * irl[j];
              float frc = __builtin_amdgcn_fractf(ph) + pe;
              float sn = __builtin_amdgcn_sinf(frc), cs = __builtin_amdgcn_cosf(frc);
              o1[j] = (v0[j] * cs - v1[j] * sn) * sc;
              o2[j] = (v0[j] * sn + v1[j] * cs) * sc;
            }
            *(pg8::f32x4*)(pr + cb + d0) = o1;
            *(pg8::f32x4*)(pr + cb + 64 + d0) = o2;
            __builtin_amdgcn_sched_barrier(0);
          }
      } else if (cb >= 1024 && cb < 2048) {
        const int c0 = cb + 32 * wc + 4 * fq;
        const pg8::f32x4 l0 = *(const pg8::f32x4*)(LB + c0 - 1024), l1 = *(const pg8::f32x4*)(LB + c0 + 16 - 1024);
#pragma unroll
        for (int ai = 0; ai < 2; ++ai)
#pragma unroll
          for (int m = 0; m < 4; ++m) {
            const int row = u.pm * 256 + ai * 128 + wr * 64 + m * 16 + fr;
            float* pr = PROJ + (size_t)row * N0;
#pragma unroll
            for (int n = 0; n < 2; ++n) {
              const pg8::f32x4 l = n ? l1 : l0;
              pg8::f32x4 v = acc[ai][bj][m][n], o;
#pragma unroll
              for (int j = 0; j < 4; ++j) o[j] = l[j] + (1.0f - l[j]) * sigmoid_acc(v[j]);
              *(pg8::f32x4*)(pr + c0 + 16 * n) = o;
            }
            __builtin_amdgcn_sched_barrier(0);
          }
      } else {
        const bool act = (cb < 1024 || (cb >= 3072 && cb < 4096) || cb >= 6144);
        const int c0 = cb + 32 * wc + 4 * fq;
#pragma unroll
        for (int ai = 0; ai < 2; ++ai)
#pragma unroll
          for (int m = 0; m < 4; ++m) {
            const int row = u.pm * 256 + ai * 128 + wr * 64 + m * 16 + fr;
            float* pr = PROJ + (size_t)row * N0;
#pragma unroll
            for (int n = 0; n < 2; ++n) {
              pg8::f32x4 v = acc[ai][bj][m][n], o;
#pragma unroll
              for (int j = 0; j < 4; ++j) o[j] = act ? silu_acc(v[j]) : v[j];
              *(pg8::f32x4*)(pr + c0 + 16 * n) = o;
            }
            __builtin_amdgcn_sched_barrier(0);
          }
      }
    }
  }
};
struct EpiIn1 {
  static constexpr bool PERM = false, AFTER_DRAIN = false;
  float* PROJ;
  float* DTA;
  const float* dtb;
  const float* alog;
  __device__ __forceinline__ void operator()(const pg8::f32x4 (&acc)[2][2][4][2], const pg8::Unit& u, int wr, int wc, int fr, int fq) const {
    float dtbv[4] = {0.f, 0.f, 0.f, 0.f}, aev[4] = {0.f, 0.f, 0.f, 0.f};
    if (u.pn == 23) {
      const int cc = 23 * 256 + 32 * wc + 4 * fq;
      const int hb = (cc >= 5920 && cc < 5936) ? (cc - 5920) : ((cc + 16 >= 5920 && cc + 16 < 5936) ? (cc + 16 - 5920) : -1);
      if (hb >= 0) {
#pragma unroll
        for (int j = 0; j < 4; ++j) { dtbv[j] = dtb[hb + j]; aev[j] = expf(alog[hb + j]); }
      }
    }
#pragma unroll
    for (int ai = 0; ai < 2; ++ai)
#pragma unroll
      for (int m = 0; m < 4; ++m) {
        const int row = u.pm * 256 + ai * 128 + wr * 64 + m * 16 + fr;
        float* pr = PROJ + (size_t)row * N1;
#pragma unroll
        for (int bj = 0; bj < 2; ++bj)
#pragma unroll
          for (int n = 0; n < 2; ++n) {
            const int col0 = u.pn * 256 + bj * 128 + 32 * wc + 16 * n + 4 * fq;
            pg8::f32x4 v = acc[ai][bj][m][n];
            if (col0 < 1024) {
              pg8::f32x4 o;
#pragma unroll
              for (int j = 0; j < 4; ++j) o[j] = siluf_(v[j]);
              *(pg8::f32x4*)(pr + col0) = o;
            } else if (col0 < 5920) {
              *(pg8::f32x4*)(pr + col0) = v;
            } else if (col0 < 5936) {
#pragma unroll
              for (int j = 0; j < 4; ++j) {
                int h = col0 + j - 5920;
                float dt = softplusf_(v[j] + dtbv[j]);
                DTA[(size_t)row * 64 + h * 4] = dt;
                DTA[(size_t)row * 64 + h * 4 + 1] = expf(-dt * aev[j]);
              }
            }
          }
      }
  }
};

struct Seg {
  int off;
  int ld;
  int n4;
};

template <int NS, int NF4, int RG>
DEVI void stage_init(const float* wsf, const Seg (&sg)[NS], int row0, int tid, const float* (&ptr)[RG], int (&ldv)[RG]) {
  asm volatile("" : "+v"(tid));
#pragma unroll
  for (int q = 0; q < RG; ++q) {
    int flat = tid + q * 256;
    int t = flat / NF4, f = flat % NF4;
    if (flat >= 16 * NF4) { t = 0; f = 0; }
    int off = 0, ld = 0, ff = f;
    bool done = false;
#pragma unroll
    for (int s = 0; s < NS; ++s) {
      bool here = (!done) && (ff < sg[s].n4);
      off = here ? (sg[s].off + (row0 + t) * sg[s].ld + ff * 4) : off;
      ld = here ? sg[s].ld : ld;
      ff = (done || here) ? ff : (ff - sg[s].n4);
      done = done || here;
    }
    ptr[q] = wsf + off;
    ldv[q] = ld;
  }
}
template <int NF4, int RG>
DEVI void stage_issue(const float* const (&ptr)[RG], const int (&ldv)[RG], int st, int nsteps, int tid, f32x4 (&rg)[RG]) {
#pragma unroll
  for (int q = 0; q < RG; ++q) {
    int flat = tid + q * 256;
    if (flat < nsteps * NF4) rg[q] = *(const f32x4*)(ptr[q] + (st * 16) * ldv[q]);
  }
}
template <int NF4, int RG>
DEVI void stage_commit(float* buf, int nsteps, int tid, const f32x4 (&rg)[RG]) {
#pragma unroll
  for (int q = 0; q < RG; ++q) {
    int flat = tid + q * 256;
    if (flat < nsteps * NF4) ((f32x4*)buf)[flat] = rg[q];
  }
}

template <int MODE>
DEVI void colrec_long(const float* wsf, const Seg (&sg)[4], int row0, int T, float gamma, float* outp, int ldo, float* stout, int st_ld,
                      float* smem) {
  constexpr int NF4 = 69, W = 276, RG = 5;
  const int tid = threadIdx.x & 255, w = tid >> 6, lane = tid & 63, c = lane >> 4, s = lane & 15;
  smem += (threadIdx.x >> 8) * (VB_BYTES / 4);
  float S[8];
#pragma unroll
  for (int i = 0; i < 8; ++i) S[i] = 0.f;
  float* buf0 = smem;
  float* buf1 = smem + 16 * 336;
  float* obuf = smem + 2 * 16 * 336;
  const int nst = (T + 15) / 16;
  f32x4 rgA[RG], rgB[RG];
  const float* sptr[RG];
  int sld[RG];
  stage_init<4, NF4, RG>(wsf, sg, row0, tid, sptr, sld);
  auto step = [&](const float* sp, float* ob, int tt) -> float {
    float4 a0 = *(const float4*)(sp + s * 8), a1 = *(const float4*)(sp + s * 8 + 4);
    float4 q0 = *(const float4*)(sp + 128 + s * 8), q1 = *(const float4*)(sp + 128 + s * 8 + 4);
    float a[8] = {a0.x, a0.y, a0.z, a0.w, a1.x, a1.y, a1.z, a1.w};
    float q[8] = {q0.x, q0.y, q0.z, q0.w, q1.x, q1.y, q1.z, q1.w};
    float val = sp[256 + w * 4 + c];
    float dA = gamma;
    if (MODE == 2) {
      val *= sp[272];
      dA = sp[273];
    }
    float o = 0.f;
#pragma unroll
    for (int i = 0; i < 8; ++i) {
      if (MODE == 0) S[i] = val + a[i] * (S[i] - val);
      else S[i] = dA * S[i] + a[i] * val;
      o += q[i] * S[i];
    }
    return red16(o);
  };
  auto run_stage = [&](const float* b, float* ob, int nthis) {
#pragma unroll 1
    for (int tt = 0; tt < nthis; tt += 4) {
      float o0 = step(b + tt * W, ob, tt);
      float o1 = step(b + (tt + 1) * W, ob, tt + 1);
      float o2 = step(b + (tt + 2) * W, ob, tt + 2);
      float o3 = step(b + (tt + 3) * W, ob, tt + 3);
      const int base = (s == 0) ? (tt * 16 + w * 4 + c) : (1024 + (tid & 255));
      const int st16 = (s == 0) ? 16 : 0;
      ob[base] = o0;
      ob[base + st16] = o1;
      ob[base + 2 * st16] = o2;
      ob[base + 3 * st16] = o3;
    }
  };
  auto write_out = [&](const float* ob, int st, int nthis) {
    if (tid < nthis * 4) {
      int t = tid >> 2, c4 = tid & 3;
      *(float4*)(outp + (size_t)(st * 16 + t) * ldo + c4 * 4) = *(const float4*)(ob + t * 16 + c4 * 4);
    }
  };
  auto nsteps = [&](int st) { return min(16, T - st * 16); };
  stage_issue<NF4, RG>(sptr, sld, 0, nsteps(0), tid, rgA);
  stage_commit<NF4, RG>(buf0, nsteps(0), tid, rgA);
  if (nst > 1) stage_issue<NF4, RG>(sptr, sld, 1, nsteps(1), tid, rgB);
  __syncthreads();
#pragma unroll 1
  for (int st = 0; st < nst; st += 2) {
    if (st + 2 < nst) stage_issue<NF4, RG>(sptr, sld, st + 2, nsteps(st + 2), tid, rgA);
    run_stage(buf0, obuf, nsteps(st));
    if (st + 1 < nst) stage_commit<NF4, RG>(buf1, nsteps(st + 1), tid, rgB);
    __syncthreads();
    write_out(obuf, st, nsteps(st));
    if (st + 1 < nst) {
      if (st + 3 < nst) stage_issue<NF4, RG>(sptr, sld, st + 3, nsteps(st + 3), tid, rgB);
      run_stage(buf1, obuf + 512, nsteps(st + 1));
      if (st + 2 < nst) stage_commit<NF4, RG>(buf0, nsteps(st + 2), tid, rgA);
      __syncthreads();
      write_out(obuf + 512, st + 1, nsteps(st + 1));
    }
  }
#pragma unroll
  for (int i = 0; i < 8; ++i) stout[(size_t)(s * 8 + i) * st_ld + w * 4 + c] = S[i];
  __syncthreads();
}

template <int MODE>
DEVI void colrec_short(const float* pa, int lda_, const float* pq, int ldq, const float* pc, int ldc, const float* pdt,
                       long row0, float gamma, const float* stin, float* stout, int st_ld, float* outp, int ldo,
                       float* smem) {
  const int tid = threadIdx.x & 255, lane = tid & 63;
  const int wid = __builtin_amdgcn_readfirstlane(tid >> 6);
  const int k0 = wid * 32;
  smem += (threadIdx.x >> 8) * (VB_BYTES / 4);
  float S[32];
#pragma unroll
  for (int i = 0; i < 32; ++i) S[i] = stin[(size_t)(k0 + i) * st_ld + lane];
  float aq[4], vv[4], dAv[4];
#pragma unroll
  for (int t = 0; t < 4; ++t) {
    long row = row0 + t;
    aq[t] = (lane < 32) ? pa[(size_t)row * lda_ + k0 + lane] : pq[(size_t)row * ldq + k0 + (lane - 32)];
    vv[t] = pc[(size_t)row * ldc + lane];
    dAv[t] = gamma;
    if (MODE == 2) {
      vv[t] *= pdt[(size_t)row * 64];
      dAv[t] = pdt[(size_t)row * 64 + 1];
    }
  }
#pragma unroll
  for (int t = 0; t < 4; ++t) {
    const float val = vv[t], dA = dAv[t];
    float o = 0.f;
#pragma unroll
    for (int i = 0; i < 32; ++i) {
      const float a = rlf_(aq[t], i), q = rlf_(aq[t], 32 + i);
      if (MODE == 0) S[i] = val + a * (S[i] - val);
      else S[i] = dA * S[i] + a * val;
      o += q * S[i];
    }
    smem[(wid * 4 + t) * 64 + lane] = o;
  }
#pragma unroll
  for (int i = 0; i < 32; ++i) stout[(size_t)(k0 + i) * st_ld + lane] = S[i];
  __syncthreads();
  {
    int t = tid >> 6;
    float sum = smem[(0 * 4 + t) * 64 + lane] + smem[(1 * 4 + t) * 64 + lane] + smem[(2 * 4 + t) * 64 + lane] +
                smem[(3 * 4 + t) * 64 + lane];
    outp[(size_t)(row0 + t) * ldo + lane] = sum;
  }
  __syncthreads();
}

DEVI void rwkv_item(const float* wsf, const Seg (&sg)[6], int row0, int T, const float* stin, float* stout, float* outp, int ldo,
                    float* smem) {
  constexpr int NF4 = 84, W = 336, RG = 6;
  const int tid = threadIdx.x & 255, w = tid >> 6, lane = tid & 63, rl = lane >> 4, sl = lane & 15;
  smem += (threadIdx.x >> 8) * (VB_BYTES / 4);
  const int il = w * 4 + rl;
  float S[4];
  if (stin) {
    float4 v = *(const float4*)(stin + il * 64 + sl * 4);
    S[0] = v.x; S[1] = v.y; S[2] = v.z; S[3] = v.w;
  } else {
    S[0] = S[1] = S[2] = S[3] = 0.f;
  }
  float* buf0 = smem;
  float* buf1 = smem + 16 * 336;
  float* obuf = smem + 2 * 16 * 336;
  const int nst = (T + 15) / 16;
  f32x4 rgA[RG], rgB[RG];
  const float* sptr[RG];
  int sld[RG];
  stage_init<6, NF4, RG>(wsf, sg, row0, tid, sptr, sld);
  auto run_stage = [&](const float* b, float* ob, int nthis) {
#pragma unroll 4
    for (int tt = 0; tt < nthis; ++tt) {
      const float* sp = b + tt * W;
      float4 r4 = *(const float4*)(sp + sl * 4);
      float4 w4 = *(const float4*)(sp + 64 + sl * 4);
      float4 k4 = *(const float4*)(sp + 128 + sl * 4);
      float4 n4 = *(const float4*)(sp + 192 + sl * 4);
      float4 m4 = *(const float4*)(sp + 256 + sl * 4);
      float vi = sp[320 + il];
      float sa = S[0] * n4.x + S[1] * n4.y + S[2] * n4.z + S[3] * n4.w;
      sa = -red16(sa);
      S[0] = S[0] * w4.x + sa * m4.x + vi * k4.x;
      S[1] = S[1] * w4.y + sa * m4.y + vi * k4.y;
      S[2] = S[2] * w4.z + sa * m4.z + vi * k4.z;
      S[3] = S[3] * w4.w + sa * m4.w + vi * k4.w;
      float y = S[0] * r4.x + S[1] * r4.y + S[2] * r4.z + S[3] * r4.w;
      y = red16(y);
      ob[(sl == 0) ? (tt * 16 + il) : (1024 + (tid & 255))] = y;
    }
  };
  auto write_out = [&](const float* ob, int st, int nthis) {
    if (tid < nthis * 4) {
      int t = tid >> 2, c4 = tid & 3;
      *(float4*)(outp + (size_t)(st * 16 + t) * ldo + c4 * 4) = *(const float4*)(ob + t * 16 + c4 * 4);
    }
  };
  auto nsteps = [&](int st) { return min(16, T - st * 16); };
  stage_issue<NF4, RG>(sptr, sld, 0, nsteps(0), tid, rgA);
  stage_commit<NF4, RG>(buf0, nsteps(0), tid, rgA);
  if (nst > 1) stage_issue<NF4, RG>(sptr, sld, 1, nsteps(1), tid, rgB);
  __syncthreads();
#pragma unroll 1
  for (int st = 0; st < nst; st += 2) {
    if (st + 2 < nst) stage_issue<NF4, RG>(sptr, sld, st + 2, nsteps(st + 2), tid, rgA);
    run_stage(buf0, obuf, nsteps(st));
    if (st + 1 < nst) stage_commit<NF4, RG>(buf1, nsteps(st + 1), tid, rgB);
    __syncthreads();
    write_out(obuf, st, nsteps(st));
    if (st + 1 < nst) {
      if (st + 3 < nst) stage_issue<NF4, RG>(sptr, sld, st + 3, nsteps(st + 3), tid, rgB);
      run_stage(buf1, obuf + 512, nsteps(st + 1));
      if (st + 2 < nst) stage_commit<NF4, RG>(buf0, nsteps(st + 2), tid, rgA);
      __syncthreads();
      write_out(obuf + 512, st + 1, nsteps(st + 1));
    }
  }
  *(float4*)(stout + il * 64 + sl * 4) = make_float4(S[0], S[1], S[2], S[3]);
  __syncthreads();
}

DEVI void phase_rec0(const Params& p, float* smem) {
  char* ws = p.ws;
  const float* PROJ = (const float*)(ws + OFF_PROJ);
  float* OMIX = (float*)(ws + OFF_OMIX);
  const float* wsf = (const float*)ws;
  constexpr int PO = (int)(OFF_PROJ / 4);
  for (int item = blockIdx.x * 2 + (threadIdx.x >> 8); item < 4608; item += gridDim.x * 2) {
    if (item < 256) {
      int b = item >> 6, h = (item >> 3) & 7, cb = item & 7;
      Seg sg[4] = {{PO + 1024 + h * 128, N0, 32}, {PO + h * 128, N0, 32}, {PO + 2048 + h * 128 + cb * 16, N0, 4},
                   {PO, N0, 1}};
      int row0 = b * TP;
      colrec_long<0>(wsf, sg, row0, TP, 0.f, OMIX + (size_t)row0 * 2048 + h * 128 + cb * 16, 2048,
                     p.out + O_HGP + (size_t)(b * 8 + h) * 128 * 128 + cb * 16, 128, smem);
    } else if (item < 512) {
      int it = item - 256;
      int b = it >> 6, h = (it >> 4) & 3, cb = it & 15;
      Seg sg[4] = {{PO + 4608 + h * 128, N0, 32}, {PO + 4096 + h * 128, N0, 32},
                   {PO + 5120 + h * 256 + cb * 16, N0, 4}, {PO, N0, 1}};
      int row0 = b * TP;
      float gamma = 1.0f - exp2f(-5.0f - (float)h);
      colrec_long<1>(wsf, sg, row0, TP, gamma, OMIX + (size_t)row0 * 2048 + 1024 + h * 256 + cb * 16, 2048,
                     p.out + O_RTP + (size_t)(b * 4 + h) * 128 * 256 + cb * 16, 256, smem);
    } else if (item < 2560) {
      int it = item - 512;
      int b = it >> 4, h = (it >> 1) & 7, cb = it & 1;
      long row0 = MPR + (long)b * 4;
      size_t so = (size_t)(b * 8 + h) * 128 * 128 + cb * 64;
      colrec_short<0>(PROJ + 1024 + h * 128, N0, PROJ + h * 128, N0, PROJ + 2048 + h * 128 + cb * 64, N0, nullptr, row0,
                      0.f, p.in[I_SHG] + so, p.out + O_HGS + so, 128, OMIX + h * 128 + cb * 64, 2048, smem);
    } else {
      int it = item - 2560;
      int b = it >> 4, h = (it >> 2) & 3, cb = it & 3;
      long row0 = MPR + (long)b * 4;
      size_t so = (size_t)(b * 4 + h) * 128 * 256 + cb * 64;
      float gamma = 1.0f - exp2f(-5.0f - (float)h);
      colrec_short<1>(PROJ + 4608 + h * 128, N0, PROJ + 4096 + h * 128, N0, PROJ + 5120 + h * 256 + cb * 64, N0, nullptr,
                      row0, gamma, p.in[I_SRT] + so, p.out + O_RTS + so, 256, OMIX + 1024 + h * 256 + cb * 64, 2048,
                      smem);
    }
  }
}

DEVI float4 ld4(const float* p) { return *(const float4*)p; }
DEVI void st_bf4(u16* p, float a, float b, float c, float d) {
  uint2 o;
  o.x = pack2(a, b);
  o.y = pack2(c, d);
  *(uint2*)p = o;
}
DEVI float wsum_u_(float v) {
  v = red16(v);
  return (rlf_(v, 0) + rlf_(v, 16)) + (rlf_(v, 32) + rlf_(v, 48));
}
DEVI float red32(float v) {
  v = red16(v);
  return v + __shfl_xor(v, 16, 64);
}
DEVI void phase_post0(const Params& p) {
  char* ws = p.ws;
  const float* PROJ = (const float*)(ws + OFF_PROJ);
  const float* OMIX = (const float*)(ws + OFF_OMIX);
  u16* MIXB = (u16*)(ws + OFF_MIXB);
  const float* ng = p.in[I_HNG];
  const int lane = threadIdx.x & 63;
  const int gw = blockIdx.x * 8 + (threadIdx.x >> 6), nw = gridDim.x * 8;
  const float4 g4 = ld4(ng + (lane & 31) * 4);
  for (int row = gw; row < M; row += nw) {
    const float* o = OMIX + (size_t)row * 2048;
    const float* pr = PROJ + (size_t)row * N0;
    u16* mo = MIXB + (size_t)row * 2048;
    float4 a[4], ga[4], bq[4], gb[4];
#pragma unroll
    for (int it = 0; it < 4; ++it) {
      int c = it * 256 + lane * 4;
      a[it] = ld4(o + c);
      ga[it] = ld4(pr + 3072 + c);
      bq[it] = ld4(o + 1024 + c);
      gb[it] = ld4(pr + 6144 + c);
    }
#pragma unroll
    for (int it = 0; it < 4; ++it) {
      int c = it * 256 + lane * 4;
      float ss = red32(a[it].x * a[it].x + a[it].y * a[it].y + a[it].z * a[it].z + a[it].w * a[it].w);
      float inv = rsqrtf(ss * (1.0f / 128.0f) + 1e-6f);
      st_bf4(mo + c, a[it].x * inv * g4.x * ga[it].x, a[it].y * inv * g4.y * ga[it].y, a[it].z * inv * g4.z * ga[it].z,
             a[it].w * inv * g4.w * ga[it].w);
      float mu = wsum_u_(bq[it].x + bq[it].y + bq[it].z + bq[it].w) * (1.0f / 256.0f);
      float dx = bq[it].x - mu, dy = bq[it].y - mu, dz = bq[it].z - mu, dw = bq[it].w - mu;
      float var = wsum_u_(dx * dx + dy * dy + dz * dz + dw * dw) * (1.0f / 256.0f);
      float iv = rsqrtf(var + 1e-5f);
      st_bf4(mo + 1024 + c, dx * iv * gb[it].x, dy * iv * gb[it].y, dz * iv * gb[it].z, dw * iv * gb[it].w);
    }
  }
}

DEVI void phase_ln(const Params& p, const float* addsrc, const float* g, const float* bta) {
  char* ws = p.ws;
  float* XF = (float*)(ws + OFF_XF);
  u16* XB = (u16*)(ws + OFF_XB);
  const int lane = threadIdx.x & 63;
  const int gw = blockIdx.x * 8 + (threadIdx.x >> 6), nw = gridDim.x * 8;
  for (int row = gw; row < M; row += nw) {
    float4* xr = (float4*)(XF + (size_t)row * 2048);
    const float4* ar = (const float4*)(addsrc + (size_t)row * 2048);
    float v[32];
    float s = 0.f;
#pragma unroll
    for (int i = 0; i < 8; ++i) {
      float4 x = xr[i * 64 + lane], a = ar[i * 64 + lane];
      v[i * 4 + 0] = ALPHA * x.x + a.x;
      v[i * 4 + 1] = ALPHA * x.y + a.y;
      v[i * 4 + 2] = ALPHA * x.z + a.z;
      v[i * 4 + 3] = ALPHA * x.w + a.w;
      s += v[i * 4 + 0] + v[i * 4 + 1] + v[i * 4 + 2] + v[i * 4 + 3];
    }
    float mu = wsum(s) * (1.0f / 2048.0f);
    float q = 0.f;
#pragma unroll
    for (int i = 0; i < 32; ++i) {
      v[i] -= mu;
      q += v[i] * v[i];
    }
    float inv = rsqrtf(wsum(q) * (1.0f / 2048.0f) + 1e-5f);
#pragma unroll
    for (int i = 0; i < 8; ++i) {
      float4 gg = ((const float4*)g)[i * 64 + lane], bb = ((const float4*)bta)[i * 64 + lane];
      float4 y;
      y.x = v[i * 4 + 0] * inv * gg.x + bb.x;
      y.y = v[i * 4 + 1] * inv * gg.y + bb.y;
      y.z = v[i * 4 + 2] * inv * gg.z + bb.z;
      y.w = v[i * 4 + 3] * inv * gg.w + bb.w;
      xr[i * 64 + lane] = y;
      uint2 o;
      o.x = pack2(y.x, y.y);
      o.y = pack2(y.z, y.w);
      ((uint2*)(XB + (size_t)row * 2048))[i * 64 + lane] = o;
    }
  }
}

typedef __attribute__((ext_vector_type(2))) __bf16 bf2_t;
typedef __attribute__((ext_vector_type(2))) float f32x2;
DEVI float dot2bf(unsigned a, unsigned b, float acc) {
  return __builtin_amdgcn_fdot2_f32_bf16(__builtin_bit_cast(bf2_t, a), __builtin_bit_cast(bf2_t, b), acc, false);
}
template <int CTRL>
DEVI int dppi(int v) {
  return __builtin_amdgcn_update_dpp(v, v, CTRL, 0xF, 0xF, false);
}
DEVI int wmax_i(int v) {
  v = max(v, dppi<0xB1>(v));
  v = max(v, dppi<0x4E>(v));
  v = max(v, dppi<0x141>(v));
  v = max(v, dppi<0x140>(v));
  int a = __builtin_amdgcn_readlane(v, 0), b = __builtin_amdgcn_readlane(v, 16);
  int c = __builtin_amdgcn_readlane(v, 32), d = __builtin_amdgcn_readlane(v, 48);
  return max(max(a, b), max(c, d));
}
DEVI float rlf(float v, int l) { return __int_as_float(__builtin_amdgcn_readlane(__float_as_int(v), l)); }
DEVI float wsum_u(float v) {
  v = red16(v);
  return (rlf(v, 0) + rlf(v, 16)) + (rlf(v, 32) + rlf(v, 48));
}
DEVI int fkey(float f) {
  int u = __float_as_int(f);
  return u ^ ((u >> 31) & 0x7fffffff);
}
DEVI float keyf(int k) { return __int_as_float(k ^ ((k >> 31) & 0x7fffffff)); }

DEVI void conv_fp8_rows(const float* __restrict__ src, unsigned char* __restrict__ dst, float* __restrict__ scales) {
  const int lane = threadIdx.x & 63;
  const int gw = blockIdx.x * 8 + (threadIdx.x >> 6), nw = gridDim.x * 8;
  for (int e = gw; e < 16384; e += nw) {
    const float* r = src + (size_t)e * 2048;
    float4 v[8];
    float am = 0.f;
#pragma unroll
    for (int q = 0; q < 8; ++q) {
      v[q] = *(const float4*)(r + (q >> 2) * 1024 + lane * 16 + (q & 3) * 4);
      am = fmaxf(am, fmaxf(fmaxf(fabsf(v[q].x), fabsf(v[q].y)), fmaxf(fabsf(v[q].z), fabsf(v[q].w))));
    }
    float amax = __int_as_float(wmax_i(__float_as_int(am)));
    float inv = (amax > 0.f) ? (440.0f / amax) : 0.f;
    float scale = (amax > 0.f) ? (amax * (1.0f / 440.0f)) : 1.0f;
#pragma unroll
    for (int j = 0; j < 2; ++j) {
      u32x4 o;
#pragma unroll
      for (int k = 0; k < 4; ++k) {
        float4 t = v[j * 4 + k];
        int pk = 0;
        pk = __builtin_amdgcn_cvt_pk_fp8_f32(t.x * inv, t.y * inv, pk, false);
        pk = __builtin_amdgcn_cvt_pk_fp8_f32(t.z * inv, t.w * inv, pk, true);
        o[k] = (unsigned)pk;
      }
      *(u32x4*)(dst + (size_t)e * 2048 + j * 1024 + lane * 16) = o;
    }
    if (lane == 0) scales[e] = scale;
  }
}

DEVI void phase_peer(const Params& p, int layer, bool final_out) {
  char* ws = p.ws;
  const float* SC = (const float*)(ws + OFF_GOUT);
  float* XF = (float*)(ws + OFF_XF);
  u16* XB = (u16*)(ws + OFF_XB);
  const unsigned char* UB = (const unsigned char*)(ws + OFF_UB);
  const unsigned char* VB = (const unsigned char*)(ws + OFF_VB);
  const float* USC = (const float*)(ws + OFF_USC);
  const float* VSC = (const float*)(ws + OFF_VSC);
  const float* g = p.in[I_LNG] + (size_t)(layer * 2 + 1) * D;
  const float* bta = p.in[I_LNB] + (size_t)(layer * 2 + 1) * D;
  const int lane = threadIdx.x & 63;
  const int gw = blockIdx.x * 8 + (threadIdx.x >> 6), nw = gridDim.x * 8;
  constexpr int KMIN = (int)0x80000000;
  for (int row = gw; row < M; row += nw) {
    const float* sr = SC + (size_t)row * 2048;
    int eidx0 = 0, eidx1 = 0;
    float gate0 = 0.f, gate1 = 0.f;
#pragma unroll 1
    for (int h = 0; h < 8; ++h) {
      const float* sp = sr + h * 256;
      int ka0 = (fkey(sp[lane]) & ~127) | (127 - lane);
      int kb0 = (fkey(sp[lane + 64]) & ~127) | (63 - lane);
      int ka1 = (fkey(sp[128 + lane]) & ~127) | (127 - lane);
      int kb1 = (fkey(sp[192 + lane]) & ~127) | (63 - lane);
      int my0 = KMIN, my1 = KMIN;
#pragma unroll 1
      for (int r = 0; r < 16; ++r) {
        int K0 = wmax_i(max(ka0, kb0));
        int K1 = wmax_i(max(ka1, kb1));
        my0 = (lane == r) ? K0 : my0;
        my1 = (lane == r) ? K1 : my1;
        ka0 = (ka0 == K0) ? KMIN : ka0;
        kb0 = (kb0 == K0) ? KMIN : kb0;
        ka1 = (ka1 == K1) ? KMIN : ka1;
        kb1 = (kb1 == K1) ? KMIN : kb1;
      }
      float ts0 = keyf(my0 & ~127), ts1 = keyf(my1 & ~127);
      int ti0 = 127 - (my0 & 127), ti1 = 127 - (my1 & 127);
      float s0 = __shfl(ts0, lane >> 2, 64);
      int jb = (lane & 3) * 4;
      int c0 = (fkey(s0 + __shfl(ts1, jb + 0, 64)) & ~255) | (255 - (lane * 4 + 0));
      int c1 = (fkey(s0 + __shfl(ts1, jb + 1, 64)) & ~255) | (255 - (lane * 4 + 1));
      int c2 = (fkey(s0 + __shfl(ts1, jb + 2, 64)) & ~255) | (255 - (lane * 4 + 2));
      int c3 = (fkey(s0 + __shfl(ts1, jb + 3, 64)) & ~255) | (255 - (lane * 4 + 3));
      int myk = KMIN;
#pragma unroll 1
      for (int r = 0; r < 16; ++r) {
        int K = wmax_i(max(max(c0, c1), max(c2, c3)));
        myk = (lane == r) ? K : myk;
        c0 = (c0 == K) ? KMIN : c0;
        c1 = (c1 == K) ? KMIN : c1;
        c2 = (c2 == K) ? KMIN : c2;
        c3 = (c3 == K) ? KMIN : c3;
      }
      float bs = keyf(myk & ~255);
      int bf = 255 - (myk & 255);
      int e = __shfl(ti0, (bf >> 4) & 15, 64) * 128 + __shfl(ti1, bf & 15, 64);
      float mx = rlf(bs, 0);
      float ev = (lane < 16) ? expf(bs - mx) : 0.f;
      float sm = wsum_u(ev);
      float gt = ev / sm;
      int e_b = __shfl(e, lane & 15, 64);
      float g_b = __shfl(gt, lane & 15, 64);
      if ((lane >> 4) == (h & 3)) {
        if (h < 4) {
          eidx0 = e_b;
          gate0 = g_b;
        } else {
          eidx1 = e_b;
          gate1 = g_b;
        }
      }
    }
    float dv0 = 0.f, dv1 = 0.f;
    {
      float xf[32];
      {
        const float4* xr = (const float4*)(XF + (size_t)row * 2048);
#pragma unroll
        for (int q = 0; q < 8; ++q) {
          float4 t = xr[(q >> 2) * 256 + lane * 4 + (q & 3)];
          xf[q * 4 + 0] = t.x; xf[q * 4 + 1] = t.y; xf[q * 4 + 2] = t.z; xf[q * 4 + 3] = t.w;
        }
      }
      constexpr int R = 8;
      u32x4 w[R][2];
      float sc[R];
      auto load_row = [&](int pidx, u32x4(&wr)[2], float& scv) {
        int src = (pidx < 64) ? eidx0 : eidx1;
        int e = __builtin_amdgcn_readlane(src, pidx & 63);
        const u32x4* ur = (const u32x4*)(UB + (size_t)e * 2048);
        wr[0] = ur[lane];
        wr[1] = ur[64 + lane];
        scv = USC[e];
      };
#pragma unroll
      for (int u = 0; u < R; ++u) load_row(u, w[u], sc[u]);
#pragma unroll 1
      for (int p0 = 0; p0 < 128; p0 += R) {
#pragma unroll
        for (int u = 0; u < R; ++u) {
          float d = 0.f;
#pragma unroll
          for (int j = 0; j < 2; ++j) {
#pragma unroll
            for (int k = 0; k < 4; ++k) {
              int dw = (int)w[u][j][k];
              f32x2 lo = __builtin_amdgcn_cvt_pk_f32_fp8(dw, false);
              f32x2 hi = __builtin_amdgcn_cvt_pk_f32_fp8(dw, true);
              d += lo.x * xf[j * 16 + k * 4 + 0];
              d += lo.y * xf[j * 16 + k * 4 + 1];
              d += hi.x * xf[j * 16 + k * 4 + 2];
              d += hi.y * xf[j * 16 + k * 4 + 3];
            }
          }
          float scu = sc[u];
          if (p0 + R < 128) load_row(p0 + R + u, w[u], sc[u]);
          d = wsum_u(d) * scu;
          int pl = (p0 + u) & 63;
          if (p0 < 64) dv0 = (lane == pl) ? d : dv0;
          else dv1 = (lane == pl) ? d : dv1;
          __builtin_amdgcn_sched_barrier(0);
        }
      }
    }
    float coef0 = 0.5f * dv0 * (1.0f + erff(dv0 * 0.70710678118f)) * gate0;
    float coef1 = 0.5f * dv1 * (1.0f + erff(dv1 * 0.70710678118f)) * gate1;
    f32x2 o2[16];
#pragma unroll
    for (int i = 0; i < 16; ++i) o2[i] = f32x2{0.f, 0.f};
    {
      constexpr int R = 8;
      u32x4 w[R][2];
      float sc[R];
      auto load_row = [&](int pidx, u32x4(&wr)[2], float& scv) {
        int src = (pidx < 64) ? eidx0 : eidx1;
        int e = __builtin_amdgcn_readlane(src, pidx & 63);
        const u32x4* vr = (const u32x4*)(VB + (size_t)e * 2048);
        wr[0] = vr[lane];
        wr[1] = vr[64 + lane];
        scv = VSC[e];
      };
#pragma unroll
      for (int u = 0; u < R; ++u) load_row(u, w[u], sc[u]);
#pragma unroll 1
      for (int p0 = 0; p0 < 128; p0 += R) {
        float cfs = (p0 < 64) ? coef0 : coef1;
#pragma unroll
        for (int u = 0; u < R; ++u) {
          float c = rlf(cfs, (p0 + u) & 63) * sc[u];
          f32x2 cc = f32x2{c, c};
#pragma unroll
          for (int j = 0; j < 2; ++j) {
#pragma unroll
            for (int k = 0; k < 4; ++k) {
              int dw = (int)w[u][j][k];
              o2[j * 8 + k * 2 + 0] += cc * __builtin_amdgcn_cvt_pk_f32_fp8(dw, false);
              o2[j * 8 + k * 2 + 1] += cc * __builtin_amdgcn_cvt_pk_f32_fp8(dw, true);
            }
          }
          if (p0 + R < 128) load_row(p0 + R + u, w[u], sc[u]);
          __builtin_amdgcn_sched_barrier(0);
        }
      }
    }
    float o[32];
#pragma unroll
    for (int i = 0; i < 16; ++i) {
      o[2 * i] = o2[i].x;
      o[2 * i + 1] = o2[i].y;
    }
    float s = 0.f;
    {
      const float4* xr = (const float4*)(XF + (size_t)row * 2048);
#pragma unroll
      for (int q = 0; q < 8; ++q) {
        float4 t = xr[(q >> 2) * 256 + lane * 4 + (q & 3)];
        o[q * 4 + 0] += ALPHA * t.x; o[q * 4 + 1] += ALPHA * t.y; o[q * 4 + 2] += ALPHA * t.z; o[q * 4 + 3] += ALPHA * t.w;
      }
#pragma unroll
      for (int i = 0; i < 32; ++i) s += o[i];
    }
    float mu = wsum_u(s) * (1.0f / 2048.0f);
    float q = 0.f;
#pragma unroll
    for (int i = 0; i < 32; ++i) {
      o[i] -= mu;
      q += o[i] * o[i];
    }
    float inv = rsqrtf(wsum_u(q) * (1.0f / 2048.0f) + 1e-5f);
    float* dstf;
    if (final_out) {
      if (row < MPR) {
        int b = row / TP, t = row % TP;
        dstf = (t >= 16) ? (p.out + O_YP + ((size_t)b * 2048 + (t - 16)) * D) : nullptr;
      } else {
        dstf = p.out + O_YS + (size_t)(row - MPR) * D;
      }
    } else {
      dstf = XF + (size_t)row * 2048;
    }
#pragma unroll
    for (int j = 0; j < 2; ++j) {
      float yv[16];
#pragma unroll
      for (int k = 0; k < 4; ++k) {
        float4 gv = *(const float4*)(g + j * 1024 + lane * 16 + k * 4);
        float4 bv = *(const float4*)(bta + j * 1024 + lane * 16 + k * 4);
        float4 y;
        y.x = o[j * 16 + k * 4 + 0] * inv * gv.x + bv.x;
        y.y = o[j * 16 + k * 4 + 1] * inv * gv.y + bv.y;
        y.z = o[j * 16 + k * 4 + 2] * inv * gv.z + bv.z;
        y.w = o[j * 16 + k * 4 + 3] * inv * gv.w + bv.w;
        if (dstf) *(float4*)(dstf + j * 1024 + lane * 16 + k * 4) = y;
        yv[k * 4 + 0] = y.x; yv[k * 4 + 1] = y.y; yv[k * 4 + 2] = y.z; yv[k * 4 + 3] = y.w;
      }
      if (!final_out) {
        uint4* xb = (uint4*)(XB + (size_t)row * 2048 + j * 1024 + lane * 16);
        xb[0] = make_uint4(pack2(yv[0], yv[1]), pack2(yv[2], yv[3]), pack2(yv[4], yv[5]), pack2(yv[6], yv[7]));
        xb[1] = make_uint4(pack2(yv[8], yv[9]), pack2(yv[10], yv[11]), pack2(yv[12], yv[13]), pack2(yv[14], yv[15]));
      }
    }
  }
}

DEVI float4 f4mul(float4 a, float4 b) { return make_float4(a.x * b.x, a.y * b.y, a.z * b.z, a.w * b.w); }
DEVI void row_info(int row, bool& prompt, int& b, int& t, int& T) {
  prompt = row < MPR;
  if (prompt) { b = row / TP; t = row - b * TP; T = TP; }
  else { b = (row - MPR) >> 2; t = (row - MPR) & 3; T = 4; }
}
DEVI void phase_pre1(const Params& p) {
  char* ws = p.ws;
  const float* PROJ = (const float*)(ws + OFF_PROJ);
  float* XC = (float*)(ws + OFF_GOUT);
  float* RKV = (float*)(ws + OFF_RKV);
  u16* LRA = (u16*)(ws + OFF_LRA);
  u16* LRB = (u16*)(ws + OFF_LRB);
  u16* LRG = (u16*)(ws + OFF_LRG);
  const float* cw = p.in[I_CVW];
  const float* cbias = p.in[I_CVB];
  const float* mu = p.in[I_MU];
  const int gtid = blockIdx.x * 512 + threadIdx.x, nthr = gridDim.x * 512;
#pragma unroll 2
  for (int idx = gtid; idx < M * 384; idx += nthr) {
    int row = idx / 384, c = (idx - row * 384) * 4;
    bool prompt; int b, t, T;
    row_info(row, prompt, b, t, T);
    float4 xv[4];
#pragma unroll
    for (int jj = 0; jj < 4; ++jj) {
      int tt = t - 3 + jj;
      if (tt >= 0) xv[jj] = ld4(PROJ + (size_t)(row - 3 + jj) * N1 + 1024 + c);
      else if (prompt) xv[jj] = make_float4(0.f, 0.f, 0.f, 0.f);
      else xv[jj] = ld4(p.in[I_SCV] + (size_t)(b * 3 + (tt + 3)) * 1536 + c);
    }
    float4 acc = ld4(cbias + c);
#pragma unroll
    for (int jj = 0; jj < 4; ++jj) {
      float4 w = ld4(cw + jj * 1536 + c);
      acc.x += xv[jj].x * w.x; acc.y += xv[jj].y * w.y; acc.z += xv[jj].z * w.z; acc.w += xv[jj].w * w.w;
    }
    *(float4*)(XC + (size_t)row * 1536 + c) = make_float4(siluf_(acc.x), siluf_(acc.y), siluf_(acc.z), siluf_(acc.w));
    if (t >= T - 3) {
      float* co = prompt ? (p.out + O_CVP) : (p.out + O_CVS);
      *(float4*)(co + (size_t)(b * 3 + (t - (T - 3))) * 1536 + c) = xv[3];
    }
  }
#pragma unroll 2
  for (int idx = gtid; idx < M * 840; idx += nthr) {
    int row = idx / 840, c = (idx - row * 840) * 4;
    bool prompt; int b, t, T;
    row_info(row, prompt, b, t, T);
    float4 cur = ld4(PROJ + (size_t)row * N1 + 2560 + c);
    float4 prev;
    if (t > 0) prev = ld4(PROJ + (size_t)(row - 1) * N1 + 2560 + c);
    else if (prompt) prev = make_float4(0.f, 0.f, 0.f, 0.f);
    else prev = ld4(p.in[I_SSH] + (size_t)b * 3360 + c);
    float4 m4 = ld4(mu + c);
    float4 mx;
    mx.x = cur.x + (prev.x - cur.x) * m4.x; mx.y = cur.y + (prev.y - cur.y) * m4.y;
    mx.z = cur.z + (prev.z - cur.z) * m4.z; mx.w = cur.w + (prev.w - cur.w) * m4.w;
    if (c < 3072) *(float4*)(RKV + (size_t)row * 3072 + c) = mx;
    else if (c < 3136) st_bf4(LRA + (size_t)row * 64 + (c - 3072), tanhf(mx.x), tanhf(mx.y), tanhf(mx.z), tanhf(mx.w));
    else if (c < 3200) st_bf4(LRB + (size_t)row * 64 + (c - 3136), mx.x, mx.y, mx.z, mx.w);
    else st_bf4(LRG + (size_t)row * 192 + (c - 3200), sigmoidf_(mx.x), sigmoidf_(mx.y), sigmoidf_(mx.z), sigmoidf_(mx.w));
    if (t == T - 1) {
      float* so = prompt ? (p.out + O_SHP) : (p.out + O_SHS);
      *(float4*)(so + (size_t)b * 3360 + c) = cur;
    }
  }
  for (int idx = gtid; idx < M * 4; idx += nthr) {
    int row = idx >> 2, k = idx & 3;
    ((uint4*)(LRG + (size_t)row * 192 + 160))[k] = make_uint4(0, 0, 0, 0);
  }
}

DEVI void phase_pre1c(const Params& p) {
  char* ws = p.ws;
  float* RKV = (float*)(ws + OFF_RKV);
  const float* AA = (const float*)(ws + OFF_AA);
  float* KK = (float*)(ws + OFF_QB);
  float* KKA = (float*)(ws + OFF_MIXB);
  float* BON = (float*)(ws + OFF_BON);
  const float* k_k = p.in[I_KK];
  const float* k_a = p.in[I_KA];
  const float* r_k = p.in[I_RK];
  const int lane = threadIdx.x & 63;
  const int gw = blockIdx.x * 8 + (threadIdx.x >> 6), nw = gridDim.x * 8;
  for (int row = gw; row < M; row += nw) {
    float4 k4[4], r4[4], a4[4];
#pragma unroll
    for (int it = 0; it < 4; ++it) {
      int c = it * 256 + lane * 4;
      k4[it] = ld4(RKV + (size_t)row * 3072 + 1024 + c);
      r4[it] = ld4(RKV + (size_t)row * 3072 + c);
      a4[it] = ld4(AA + (size_t)row * 1024 + c);
    }
#pragma unroll
    for (int it = 0; it < 4; ++it) {
      int c = it * 256 + lane * 4;
      float4 kk4 = ld4(k_k + c), ka4 = ld4(k_a + c), rk4 = ld4(r_k + c);
      float4 k = k4[it], r = r4[it], a = a4[it];
      float4 kr = f4mul(k, kk4);
      float ss = red16(kr.x * kr.x + kr.y * kr.y + kr.z * kr.z + kr.w * kr.w);
      float inv = 1.0f / fmaxf(sqrtf(ss), 1e-12f);
      float4 kk = make_float4(kr.x * inv, kr.y * inv, kr.z * inv, kr.w * inv);
      float4 kp;
      kp.x = k.x * (1.0f + (a.x - 1.0f) * ka4.x); kp.y = k.y * (1.0f + (a.y - 1.0f) * ka4.y);
      kp.z = k.z * (1.0f + (a.z - 1.0f) * ka4.z); kp.w = k.w * (1.0f + (a.w - 1.0f) * ka4.w);
      float bon = red16(r.x * kp.x * rk4.x + r.y * kp.y * rk4.y + r.z * kp.z * rk4.z + r.w * kp.w * rk4.w);
      *(float4*)(KK + (size_t)row * 1024 + c) = kk;
      *(float4*)(KKA + (size_t)row * 1024 + c) = f4mul(kk, a);
      *(float4*)(RKV + (size_t)row * 3072 + 1024 + c) = kp;
      if ((lane & 15) == 0) BON[(size_t)row * 16 + it * 4 + (lane >> 4)] = bon;
    }
  }
}

DEVI void rwkv_short(const float* __restrict__ RKV, const float* __restrict__ DEC, const float* __restrict__ KK,
                     const float* __restrict__ KKA, int h, int rb, int row0, const float* __restrict__ stin,
                     float* __restrict__ stout, float* __restrict__ outp) {
  const int tid = threadIdx.x & 255, w = tid >> 6, lane = tid & 63, rl = lane >> 4, sl = lane & 15;
  const int il = w * 4 + rl;
  float4 sv = *(const float4*)(stin + il * 64 + sl * 4);
  float S[4] = {sv.x, sv.y, sv.z, sv.w};
  float4 r4[4], w4[4], k4[4], n4[4], m4[4];
  float vi[4];
#pragma unroll
  for (int t = 0; t < 4; ++t) {
    const size_t row = (size_t)(row0 + t);
    r4[t] = *(const float4*)(RKV + row * 3072 + h * 64 + sl * 4);
    w4[t] = *(const float4*)(DEC + row * 1024 + h * 64 + sl * 4);
    k4[t] = *(const float4*)(RKV + row * 3072 + 1024 + h * 64 + sl * 4);
    n4[t] = *(const float4*)(KK + row * 1024 + h * 64 + sl * 4);
    m4[t] = *(const float4*)(KKA + row * 1024 + h * 64 + sl * 4);
    vi[t] = RKV[row * 3072 + 2048 + h * 64 + rb * 16 + il];
  }
#pragma unroll
  for (int t = 0; t < 4; ++t) {
    float sa = S[0] * n4[t].x + S[1] * n4[t].y + S[2] * n4[t].z + S[3] * n4[t].w;
    sa = -red16(sa);
    S[0] = S[0] * w4[t].x + sa * m4[t].x + vi[t] * k4[t].x;
    S[1] = S[1] * w4[t].y + sa * m4[t].y + vi[t] * k4[t].y;
    S[2] = S[2] * w4[t].z + sa * m4[t].z + vi[t] * k4[t].z;
    S[3] = S[3] * w4[t].w + sa * m4[t].w + vi[t] * k4[t].w;
    float y = S[0] * r4[t].x + S[1] * r4[t].y + S[2] * r4[t].z + S[3] * r4[t].w;
    y = red16(y);
    if (sl == 0) outp[(size_t)t * 2048 + il] = y;
  }
  *(float4*)(stout + il * 64 + sl * 4) = make_float4(S[0], S[1], S[2], S[3]);
}

DEVI void phase_rec1(const Params& p, float* smem) {
  char* ws = p.ws;
  const float* XC = (const float*)(ws + OFF_GOUT);
  const float* RKV = (const float*)(ws + OFF_RKV);
  const float* DEC = (const float*)(ws + OFF_DEC);
  const float* KK = (const float*)(ws + OFF_QB);
  const float* KKA = (const float*)(ws + OFF_MIXB);
  const float* DTA = (const float*)(ws + OFF_DTA);
  float* OMIX = (float*)(ws + OFF_OMIX);
  const float* wsf = (const float*)ws;
  constexpr int XO = (int)(OFF_GOUT / 4), DO = (int)(OFF_DTA / 4), RO = (int)(OFF_RKV / 4), CO = (int)(OFF_DEC / 4),
                KO = (int)(OFF_QB / 4), AO = (int)(OFF_MIXB / 4);
  const int half = threadIdx.x >> 8;
  for (int li = blockIdx.x; li < 256; li += gridDim.x) {
    if (half == 0) {
      int b = li >> 6, h = (li >> 2) & 15, cb = li & 3;
      int g = h >> 3;
      Seg sg[4] = {{XO + 1024 + g * 128, 1536, 32}, {XO + 1280 + g * 128, 1536, 32}, {XO + h * 64 + cb * 16, 1536, 4},
                   {DO + h * 4, 64, 1}};
      int row0 = b * TP;
      colrec_long<2>(wsf, sg, row0, TP, 0.f, OMIX + (size_t)row0 * 2048 + h * 64 + cb * 16, 2048,
                     p.out + O_SSP + (size_t)(b * 16 + h) * 128 * 64 + cb * 16, 64, smem);
    } else {
      int b = li >> 6, h = (li >> 2) & 15, rb = li & 3;
      int row0 = b * TP;
      Seg sg[6] = {{RO + h * 64, 3072, 16}, {CO + h * 64, 1024, 16}, {RO + 1024 + h * 64, 3072, 16},
                   {KO + h * 64, 1024, 16}, {AO + h * 64, 1024, 16}, {RO + 2048 + h * 64 + rb * 16, 3072, 4}};
      size_t so = ((size_t)(b * 16 + h) * 64 + rb * 16) * 64;
      rwkv_item(wsf, sg, row0, TP, nullptr, p.out + O_WKP + so, OMIX + (size_t)row0 * 2048 + 1024 + h * 64 + rb * 16, 2048, smem);
    }
  }
  for (int it = blockIdx.x * 2 + half; it < 2048; it += gridDim.x * 2) {
    int b = it >> 4, h = it & 15;
    int g = h >> 3;
    long row0 = MPR + (long)b * 4;
    size_t so = (size_t)(b * 16 + h) * 128 * 64;
    colrec_short<2>(XC + 1024 + g * 128, 1536, XC + 1280 + g * 128, 1536, XC + h * 64, 1536, DTA + h * 4, row0, 0.f,
                    p.in[I_SSM] + so, p.out + O_SSS + so, 64, OMIX + h * 64, 2048, smem);
  }
  for (int it = blockIdx.x * 2 + half; it < 8192; it += gridDim.x * 2) {
    int b = it >> 6, h = (it >> 2) & 15, rb = it & 3;
    int row0 = MPR + b * 4;
    size_t so = ((size_t)(b * 16 + h) * 64 + rb * 16) * 64;
    rwkv_short(RKV, DEC, KK, KKA, h, rb, row0, p.in[I_SWK] + so, p.out + O_WKS + so,
               OMIX + (size_t)row0 * 2048 + 1024 + h * 64 + rb * 16);
  }
}

DEVI void phase_post1(const Params& p) {
  char* ws = p.ws;
  const float* PROJ = (const float*)(ws + OFF_PROJ);
  const float* OMIX = (const float*)(ws + OFF_OMIX);
  const float* XC = (const float*)(ws + OFF_GOUT);
  const float* RKV = (const float*)(ws + OFF_RKV);
  const float* GG = (const float*)(ws + OFF_GG);
  const float* BON = (const float*)(ws + OFF_BON);
  u16* MIXB = (u16*)(ws + OFF_MIXB);
  const float* dsk = p.in[I_DSK];
  const float* sng = p.in[I_SNG];
  const float* lxg = p.in[I_LXG];
  const float* lxb = p.in[I_LXB];
  const int lane = threadIdx.x & 63;
  const int gw = blockIdx.x * 8 + (threadIdx.x >> 6), nw = gridDim.x * 8;
  for (int row = gw; row < M; row += nw) {
    const float* o = OMIX + (size_t)row * 2048;
    u16* mo = MIXB + (size_t)row * 2048;
    float4 oc[4], xc[4], z[4], y[4], v[4], gg[4];
    float bn[4];
#pragma unroll
    for (int it = 0; it < 4; ++it) {
      int c = it * 256 + lane * 4;
      oc[it] = ld4(o + c);
      xc[it] = ld4(XC + (size_t)row * 1536 + c);
      z[it] = ld4(PROJ + (size_t)row * N1 + c);
      y[it] = ld4(o + 1024 + c);
      v[it] = ld4(RKV + (size_t)row * 3072 + 2048 + c);
      gg[it] = ld4(GG + (size_t)row * 1024 + c);
      bn[it] = BON[(size_t)row * 16 + it * 4 + (lane >> 4)];
    }
    float4 val[4];
    float ssq[4];
#pragma unroll
    for (int it = 0; it < 4; ++it) {
      float ds = dsk[it * 4 + (lane >> 4)];
      val[it].x = (oc[it].x + xc[it].x * ds) * z[it].x;
      val[it].y = (oc[it].y + xc[it].y * ds) * z[it].y;
      val[it].z = (oc[it].z + xc[it].z * ds) * z[it].z;
      val[it].w = (oc[it].w + xc[it].w * ds) * z[it].w;
      ssq[it] = val[it].x * val[it].x + val[it].y * val[it].y + val[it].z * val[it].z + val[it].w * val[it].w;
    }
    float inv0 = rsqrtf(wsum_u_(ssq[0] + ssq[1]) * (1.0f / 512.0f) + 1e-6f);
    float inv1 = rsqrtf(wsum_u_(ssq[2] + ssq[3]) * (1.0f / 512.0f) + 1e-6f);
#pragma unroll
    for (int it = 0; it < 4; ++it) {
      int c = it * 256 + lane * 4;
      float inv = (it < 2) ? inv0 : inv1;
      float4 sg = ld4(sng + c);
      st_bf4(mo + c, val[it].x * inv * sg.x, val[it].y * inv * sg.y, val[it].z * inv * sg.z, val[it].w * inv * sg.w);
      float mu = red16(y[it].x + y[it].y + y[it].z + y[it].w) * (1.0f / 64.0f);
      float dx = y[it].x - mu, dy = y[it].y - mu, dz = y[it].z - mu, dw = y[it].w - mu;
      float var = red16(dx * dx + dy * dy + dz * dz + dw * dw) * (1.0f / 64.0f);
      float iv = rsqrtf(var + 64e-5f);
      float4 lg = ld4(lxg + c), lb = ld4(lxb + c);
      float y0 = (dx * iv * lg.x + lb.x + bn[it] * v[it].x) * gg[it].x;
      float y1 = (dy * iv * lg.y + lb.y + bn[it] * v[it].y) * gg[it].y;
      float y2 = (dz * iv * lg.z + lb.z + bn[it] * v[it].z) * gg[it].z;
      float y3 = (dw * iv * lg.w + lb.w + bn[it] * v[it].w) * gg[it].w;
      st_bf4(mo + 1024 + c, y0, y1, y2, y3);
    }
  }
}

#define XB_TMO      128
#define XB_XCNT(j)  (256  + 64 * (j))
#define XB_XSUB(j)  (1280 + 64 * (j))
#define XB_XGEN(j)  (2304 + 64 * (j))
#define XB_TOP      3328
#define XB_TOPGEN   3392
#define XCD_BAR_WORDS 3456
#define XB_SPIN_CAP (1u << 18)
#define LAS __attribute__((address_space(3)))

__device__ __forceinline__ unsigned xb_ld(unsigned* p)              { return __hip_atomic_load(p, __ATOMIC_RELAXED, __HIP_MEMORY_SCOPE_AGENT); }
__device__ __forceinline__ unsigned xb_add(unsigned* p, unsigned v) { return __hip_atomic_fetch_add(p, v, __ATOMIC_RELAXED, __HIP_MEMORY_SCOPE_AGENT); }
__device__ __forceinline__ unsigned xb_xcc_id() { return (unsigned)__builtin_amdgcn_s_getreg((3 << 11) | 20) & 0xFu; }
#define XB_SPIN(cond, bar) do { unsigned _sp = 0; while (cond) { __builtin_amdgcn_s_sleep(1); \
    if ((++_sp & 255u) == 0u) { if (xb_ld(&(bar)[XB_TMO])) break; if (_sp > XB_SPIN_CAP) { atomicAdd(&(bar)[XB_TMO], 1u); break; } } } } while (0)

struct XcdBarrier {
    unsigned* bar; unsigned x;
    volatile LAS unsigned* st;
};

__device__ __forceinline__ XcdBarrier xcd_barrier_post(unsigned* bar, volatile LAS unsigned* st) {
    XcdBarrier b; b.bar = bar; b.x = xb_xcc_id(); b.st = st;
    if (threadIdx.x == 0) (void)xb_add(&bar[XB_XCNT(b.x)], 1u);
    return b;
}
__device__ __forceinline__ void xcd_barrier_complete(unsigned* bar, unsigned x, unsigned& nloc, unsigned& nx) {
    const unsigned G = gridDim.x * gridDim.y * gridDim.z;
    unsigned sum, cnt, mine, sp = 0u;
    for (;;) {
        sum = 0u; cnt = 0u; mine = 0u;
#pragma unroll
        for (unsigned j = 0; j < 16; ++j) { const unsigned c = xb_ld(&bar[XB_XCNT(j)]); sum += c; cnt += (c > 0u) ? 1u : 0u; mine = (j == x) ? c : mine; }
        if (sum == G) break;
        __builtin_amdgcn_s_sleep(1);
        if ((++sp & 255u) == 0u) { if (xb_ld(&bar[XB_TMO])) break; if (sp > XB_SPIN_CAP) { atomicAdd(&bar[XB_TMO], 1u); break; } }
    }
    nloc = mine > 0u ? mine : 1u; nx = cnt > 0u ? cnt : 1u;
}

__device__ __forceinline__ void xcd_barrier(const XcdBarrier& b) {
    asm volatile("s_waitcnt vmcnt(0)" ::: "memory");
    __syncthreads();
    if (threadIdx.x == 0) {
        unsigned* bar = b.bar;
        __builtin_amdgcn_s_waitcnt(0);
        unsigned nloc = b.st[0], nx = b.st[1];
        if (nloc == 0u) { xcd_barrier_complete(bar, b.x, nloc, nx); b.st[0] = nloc; b.st[1] = nx; }
        const unsigned old = xb_add(&bar[XB_XSUB(b.x)], 1u);
        const unsigned gen = old / nloc;
        if (old + 1u == (gen + 1u) * nloc) {
            __builtin_amdgcn_fence(__ATOMIC_RELEASE, "agent");
            asm volatile("s_waitcnt vmcnt(0)" ::: "memory");
            const unsigned og = xb_add(&bar[XB_TOP], 1u);
            const unsigned tg = og / nx;
            if (og + 1u == (tg + 1u) * nx) xb_add(&bar[XB_TOPGEN], 1u);
            else XB_SPIN(xb_ld(&bar[XB_TOPGEN]) == tg, bar);
            __builtin_amdgcn_fence(__ATOMIC_ACQUIRE, "agent");
            xb_add(&bar[XB_XGEN(b.x)], 1u);
            asm volatile("s_waitcnt vmcnt(0)" ::: "memory");
        } else {
            XB_SPIN(xb_ld(&bar[XB_XGEN(b.x)]) == gen, bar);
            __builtin_amdgcn_fence(__ATOMIC_ACQUIRE, "agent");
            asm volatile("s_waitcnt vmcnt(0)" ::: "memory");
        }
    }
    __syncthreads();
}


template <int ph>
DEVI void run_phase(const Params& p, char* smem_raw) {
  float* smem = (float*)smem_raw;
  char* ws = p.ws;
  {
    switch (ph) {
      case 0:
        phase0(p, smem);
        conv_fp8_rows(p.in[I_PU], (unsigned char*)(ws + OFF_UB), (float*)(ws + OFF_USC));
        conv_fp8_rows(p.in[I_PV], (unsigned char*)(ws + OFF_VB), (float*)(ws + OFF_VSC));
        break;
      case 1: {
        EpiIn0 E{(float*)(ws + OFF_PROJ), (const float*)(ws + OFF_LB), (const float*)(ws + OFF_INVREV)};
        pg8::Gemm g{(const pg8::bf16_t*)(ws + OFF_XB), (const pg8::bf16_t*)(ws + OFF_WIN0), MP, N0, 2048};
        pg8::StaticOrder S;
        S.init(MP, N0, (int)gridDim.x, (int)blockIdx.x);
        pg8::gemm_phase<EpiIn0, pg8::StaticOrder, false>((PG8_LAS unsigned char*)smem_raw, g, S, E, nullptr);
      } break;
      case 2: phase_rec0(p, smem); break;
      case 3: phase_post0(p); break;
      case 4: case 15: {
        float* GO = (float*)(ws + OFF_GOUT);
        gemm_phase((const u16*)(ws + OFF_MIXB), 2048, 0, (const u16*)(ws + (ph == 4 ? OFF_WOUT0 : OFF_WOUT1)), 2048,
                   69, 16, smem_raw, [=](int row, int col, float v0, float v1) {
                     GO[(size_t)row * 2048 + col] = v0;
                     GO[(size_t)row * 2048 + col + 32] = v1;
                   });
      } break;
      case 5: case 16: {
        int l = (ph == 5) ? 0 : 1;
        phase_ln(p, (const float*)(ws + OFF_GOUT), p.in[I_LNG] + (size_t)(l * 2) * D, p.in[I_LNB] + (size_t)(l * 2) * D);
      } break;
      case 6: case 17: {
        u16* QB = (u16*)(ws + OFF_QB);
        gemm_phase((const u16*)(ws + OFF_XB), 2048, 0, (const u16*)(ws + (ph == 6 ? OFF_WQ0 : OFF_WQ1)), 2048, 69,
                   16, smem_raw, [=](int row, int col, float v0, float v1) {
                     QB[(size_t)row * 2048 + col] = f2bf(v0);
                     QB[(size_t)row * 2048 + col + 32] = f2bf(v1);
                   });
      } break;
      case 7: case 18: {
        float* SC = (float*)(ws + OFF_GOUT);
        gemm_phase((const u16*)(ws + OFF_QB), 2048, 128, (const u16*)(ws + (ph == 7 ? OFF_KEY0 : OFF_KEY1)), 128,
                   69, 16, smem_raw, [=](int row, int col, float v0, float v1) {
                     SC[(size_t)row * 2048 + col] = v0;
                     SC[(size_t)row * 2048 + col + 32] = v1;
                   });
      } break;
      case 8: phase_peer(p, 0, false); break;
      case 9: {
        conv_fp8_rows(p.in[I_PU] + (size_t)16384 * 2048, (unsigned char*)(ws + OFF_UB), (float*)(ws + OFF_USC));
        conv_fp8_rows(p.in[I_PV] + (size_t)16384 * 2048, (unsigned char*)(ws + OFF_VB), (float*)(ws + OFF_VSC));
        EpiIn1 E{(float*)(ws + OFF_PROJ), (float*)(ws + OFF_DTA), p.in[I_DTB], p.in[I_ALOG]};
        pg8::Gemm g{(const pg8::bf16_t*)(ws + OFF_XB), (const pg8::bf16_t*)(ws + OFF_WIN1), MP, N1, 2048};
        pg8::StaticOrder S;
        S.init(MP, N1, (int)gridDim.x, (int)blockIdx.x);
        pg8::gemm_phase<EpiIn1, pg8::StaticOrder, false>((PG8_LAS unsigned char*)smem_raw, g, S, E, nullptr);
      } break;
      case 10: phase_pre1(p); break;
      case 11: {
        float* DEC = (float*)(ws + OFF_DEC);
        float* AA = (float*)(ws + OFF_AA);
        float* GG = (float*)(ws + OFF_GG);
        const float* w0 = p.in[I_W0];
        const float* a0 = p.in[I_A0];
        gemm_phase((const u16*)(ws + OFF_LRA), 64, 0, (const u16*)(ws + OFF_W2T), 64, 69, 8, smem_raw,
                   [=](int row, int col, float v0, float v1) {
#pragma unroll
                     for (int e = 0; e < 2; ++e) {
                       int cc = col + e * 32;
                       float v = (e ? v1 : v0);
                       float wl = -softplusf_(-v) - 0.5f;
                       DEC[(size_t)row * 1024 + cc] = expf(-expf(wl));
                     }
                   }, w0);
        gemm_phase((const u16*)(ws + OFF_LRB), 64, 0, (const u16*)(ws + OFF_A2T), 64, 69, 8, smem_raw,
                   [=](int row, int col, float v0, float v1) {
                     AA[(size_t)row * 1024 + col] = sigmoidf_(v0);
                     AA[(size_t)row * 1024 + col + 32] = sigmoidf_(v1);
                   }, a0);
        gemm_phase((const u16*)(ws + OFF_LRG), 192, 0, (const u16*)(ws + OFF_G2T), 192, 69, 8, smem_raw,
                   [=](int row, int col, float v0, float v1) {
                     GG[(size_t)row * 1024 + col] = v0;
                     GG[(size_t)row * 1024 + col + 32] = v1;
                   });
      } break;
      case 12: phase_pre1c(p); break;
      case 13: phase_rec1(p, smem); break;
      case 14: phase_post1(p); break;
      case 19: phase_peer(p, 1, true); break;
      default: break;
    }
  }
}

__global__ void __launch_bounds__(512, 2) mega(Params p, int ph_lo, int ph_hi) {
  __shared__ __attribute__((aligned(16))) char smem_raw[SMEM_BYTES];
  __shared__ uint4 xb_words;
  cg::grid_group grid = cg::this_grid();
  if (threadIdx.x == 0) xb_words = make_uint4(0u, 0u, 0u, 0u);
  __syncthreads();
  XcdBarrier xb = xcd_barrier_post((unsigned*)(p.ws + OFF_BAR), (volatile LAS unsigned*)&xb_words);
  if (ph_hi > 1000) grid.sync();
#ifndef REPEAT_MASK
#define REPEAT_MASK 0
#endif
#define PHASE(K)                                          \
  if (ph_lo <= K && K < ph_hi) run_phase<K>(p, smem_raw); \
  if ((REPEAT_MASK >> K) & 1) { xcd_barrier(xb); run_phase<K>(p, smem_raw); } \
  if (ph_lo <= K && K + 1 < ph_hi) xcd_barrier(xb);
  PHASE(0) PHASE(1) PHASE(2) PHASE(3) PHASE(4) PHASE(5) PHASE(6) PHASE(7) PHASE(8) PHASE(9)
  PHASE(10) PHASE(11) PHASE(12) PHASE(13) PHASE(14) PHASE(15) PHASE(16) PHASE(17) PHASE(18) PHASE(19)
}
#ifdef PHASE_TEST
template <int PH>
__global__ void __launch_bounds__(512, 2) phk(Params p) {
  __shared__ __attribute__((aligned(16))) char smem_raw[SMEM_BYTES];
  run_phase<PH>(p, smem_raw);
}
#define INST(N) template __global__ void phk<N>(Params);
INST(0) INST(1) INST(2) INST(3) INST(4) INST(5) INST(6) INST(7) INST(8) INST(9) INST(10) INST(11) INST(12) INST(13) INST(14) INST(19)
#endif

constexpr int NPHASE = 20;

extern "C" void kernel_launch(void* const* d_in, const int* in_sizes, int n_in, void* d_out, int out_size, void* d_ws,
                              size_t ws_size, hipStream_t stream) {
  static int grid_blocks = 0;
  if (!grid_blocks) {
    int dev = 0, cus = 0, per_cu = 0;
    hipGetDevice(&dev);
    hipDeviceGetAttribute(&cus, hipDeviceAttributeMultiprocessorCount, dev);
    hipOccupancyMaxActiveBlocksPerMultiprocessor(&per_cu, mega, 512, 0);
    if (per_cu > 1) per_cu = 1;
    if (per_cu < 1) per_cu = 1;
    grid_blocks = cus * per_cu;
  }
  Params p{};
  for (int i = 0; i < 38; ++i) p.in[i] = (const float*)d_in[i];
  p.out = (float*)d_out;
  p.ws = (char*)d_ws;
  (void)hipMemsetAsync((char*)d_ws + OFF_BAR, 0, 3456 * 4, stream);
  int lo = 0, hi = NPHASE;
  void* args[] = {&p, &lo, &hi};
  hipError_t e = hipLaunchCooperativeKernel((void*)mega, dim3(grid_blocks), dim3(512), args, 0, stream);
  if (e != hipSuccess) fprintf(stderr, "cooperative launch failed: %s (grid %d)\n", hipGetErrorString(e), grid_blocks);
}
```

```cpp
#include <hip/hip_runtime.h>
#include <hip/hip_bf16.h>
#include <hip/hip_cooperative_groups.h>
#include <cstdio>
#include <cmath>
namespace cg = cooperative_groups;

#define DEVI __device__ __forceinline__
typedef unsigned short u16;
using bf16x8 = __attribute__((ext_vector_type(8))) short;
using f32x4 = __attribute__((ext_vector_type(4))) float;
using u32x4 = __attribute__((ext_vector_type(4))) unsigned int;

constexpr int D = 2048;
constexpr int TP = 2064;
constexpr int MPR = 8256;
constexpr int M = 8768;
constexpr int MP = 8960;
constexpr int N0 = 7168;
constexpr int N1 = 6144;
constexpr float ALPHA = 1.41421356237f;

constexpr size_t SZ_TAB = (size_t)16384 * 2048 * 2;
constexpr size_t OFF_UB = 0;
constexpr size_t OFF_VB = OFF_UB + SZ_TAB;
constexpr size_t OFF_WIN0 = OFF_VB + SZ_TAB;
constexpr size_t OFF_WOUT0 = OFF_WIN0 + (size_t)N0 * 2048 * 2;
constexpr size_t OFF_WQ0 = OFF_WOUT0 + (size_t)2048 * 2048 * 2;
constexpr size_t OFF_KEY0 = OFF_WQ0 + (size_t)2048 * 2048 * 2;
constexpr size_t OFF_WIN1 = OFF_KEY0 + (size_t)16 * 128 * 128 * 2;
constexpr size_t OFF_WOUT1 = OFF_WIN1 + (size_t)N1 * 2048 * 2;
constexpr size_t OFF_WQ1 = OFF_WOUT1 + (size_t)2048 * 2048 * 2;
constexpr size_t OFF_KEY1 = OFF_WQ1 + (size_t)2048 * 2048 * 2;
constexpr size_t OFF_W2T = OFF_KEY1 + (size_t)16 * 128 * 128 * 2;
constexpr size_t OFF_A2T = OFF_W2T + (size_t)1024 * 64 * 2;
constexpr size_t OFF_G2T = OFF_A2T + (size_t)1024 * 64 * 2;
constexpr size_t OFF_LB = OFF_G2T + (size_t)1024 * 192 * 2;
constexpr size_t OFF_INVREV = OFF_LB + 1024 * 4;
constexpr size_t OFF_XF = OFF_INVREV + 64 * 8;
constexpr size_t OFF_XB = OFF_XF + (size_t)MP * 2048 * 4;
constexpr size_t OFF_PROJ = OFF_XB + (size_t)MP * 2048 * 2;
constexpr size_t OFF_GOUT = OFF_PROJ + (size_t)MP * N0 * 4;
constexpr size_t OFF_OMIX = OFF_GOUT + (size_t)MP * 2048 * 4;
constexpr size_t OFF_MIXB = OFF_OMIX + (size_t)MP * 2048 * 4;
constexpr size_t OFF_QB = OFF_MIXB + (size_t)MP * 2048 * 2;
constexpr size_t OFF_RKV = OFF_QB + (size_t)MP * 2048 * 2;
constexpr size_t OFF_DEC = OFF_RKV + (size_t)MP * 3072 * 4;
constexpr size_t OFF_AA = OFF_DEC + (size_t)MP * 1024 * 4;
constexpr size_t OFF_GG = OFF_AA + (size_t)MP * 1024 * 4;
constexpr size_t OFF_LRA = OFF_GG + (size_t)MP * 1024 * 4;
constexpr size_t OFF_LRB = OFF_LRA + (size_t)MP * 64 * 2;
constexpr size_t OFF_LRG = OFF_LRB + (size_t)MP * 64 * 2;
constexpr size_t OFF_DTA = OFF_LRG + (size_t)MP * 192 * 2;
constexpr size_t OFF_BON = OFF_DTA + (size_t)MP * 64 * 4;
constexpr size_t OFF_USC = OFF_BON + (size_t)MP * 16 * 4;
constexpr size_t OFF_VSC = OFF_USC + 16384 * 4;
constexpr size_t OFF_BAR = OFF_VSC + 16384 * 4;
constexpr size_t WS_TOTAL = OFF_BAR + 3456 * 4;
static_assert(WS_TOTAL <= (size_t)1 << 30, "workspace too large");

constexpr size_t O_YP = 0;
constexpr size_t O_YS = O_YP + (size_t)4 * 2048 * 2048;
constexpr size_t O_HGP = O_YS + (size_t)128 * 4 * 2048;
constexpr size_t O_HGS = O_HGP + (size_t)4 * 8 * 128 * 128;
constexpr size_t O_RTP = O_HGS + (size_t)128 * 8 * 128 * 128;
constexpr size_t O_RTS = O_RTP + (size_t)4 * 4 * 128 * 256;
constexpr size_t O_SSP = O_RTS + (size_t)128 * 4 * 128 * 256;
constexpr size_t O_SSS = O_SSP + (size_t)4 * 16 * 128 * 64;
constexpr size_t O_CVP = O_SSS + (size_t)128 * 16 * 128 * 64;
constexpr size_t O_CVS = O_CVP + (size_t)4 * 3 * 1536;
constexpr size_t O_WKP = O_CVS + (size_t)128 * 3 * 1536;
constexpr size_t O_WKS = O_WKP + (size_t)4 * 16 * 64 * 64;
constexpr size_t O_SHP = O_WKS + (size_t)128 * 16 * 64 * 64;
constexpr size_t O_SHS = O_SHP + (size_t)4 * 3360;

struct Params {
  const float* in[38];
  float* out;
  char* ws;
};
enum { I_XP = 0, I_XS, I_SHG, I_SRT, I_SSM, I_SCV, I_SWK, I_SSH, I_META, I_LNG, I_LNB, I_EWIN, I_LBL, I_HNG, I_EWOUT,
       I_OWIN, I_CVW, I_CVB, I_DTB, I_ALOG, I_DSK, I_SNG, I_MU, I_W0, I_W2, I_A0, I_A2, I_G2, I_KK, I_KA, I_RK,
       I_LXG, I_LXB, I_OWOUT, I_WQ, I_KEYS, I_PU, I_PV };

constexpr int VB_BYTES = 2 * 2 * 128 * 72 * 2;
constexpr int SMEM_BYTES = 2 * VB_BYTES;

DEVI u16 f2bf(float f) {
  unsigned u = __float_as_uint(f);
  u += 0x7fffu + ((u >> 16) & 1u);
  return (u16)(u >> 16);
}
DEVI unsigned pack2(float a, float b) { return (unsigned)f2bf(a) | ((unsigned)f2bf(b) << 16); }
DEVI float bflo(unsigned u) { return __uint_as_float(u << 16); }
DEVI float bfhi(unsigned u) { return __uint_as_float(u & 0xffff0000u); }
DEVI float sigmoidf_(float x) { return __builtin_amdgcn_rcpf(1.0f + __builtin_amdgcn_exp2f(-1.44269504089f * x)); }
DEVI float siluf_(float x) { return x * __builtin_amdgcn_rcpf(1.0f + __builtin_amdgcn_exp2f(-1.44269504089f * x)); }
DEVI float sigmoid_acc(float x) { return 1.0f / (1.0f + expf(-x)); }
DEVI float silu_acc(float x) { return x / (1.0f + expf(-x)); }
DEVI float softplusf_(float x) { return fmaxf(x, 0.0f) + log1pf(expf(-fabsf(x))); }
DEVI float wsum(float v) {
#pragma unroll
  for (int o = 32; o > 0; o >>= 1) v += __shfl_xor(v, o, 64);
  return v;
}
DEVI float wmaxf_(float v) {
#pragma unroll
  for (int o = 32; o > 0; o >>= 1) v = fmaxf(v, __shfl_xor(v, o, 64));
  return v;
}
DEVI int wmini_(int v) {
#pragma unroll
  for (int o = 32; o > 0; o >>= 1) v = min(v, __shfl_xor(v, o, 64));
  return v;
}
template <int CTRL>
DEVI float dppf(float v) {
  return __int_as_float(__builtin_amdgcn_update_dpp(0, __float_as_int(v), CTRL, 0xF, 0xF, true));
}
DEVI float red8(float v) {
  v += dppf<0xB1>(v);
  v += dppf<0x4E>(v);
  v += dppf<0x141>(v);
  return v;
}
DEVI float red16(float v) {
  v = red8(v);
  v += dppf<0x140>(v);
  return v;
}
DEVI float rlf_(float v, int l) { return __int_as_float(__builtin_amdgcn_readlane(__float_as_int(v), l)); }
DEVI int row_pos(int row) { return row < MPR ? (row % TP) : (16384 + ((row - MPR) & 3)); }

DEVI void conv_bf16_flat(const float* __restrict__ src, u16* __restrict__ dst, size_t n4) {
  size_t stride = (size_t)gridDim.x * blockDim.x;
  for (size_t i = (size_t)blockIdx.x * blockDim.x + threadIdx.x; i < n4; i += stride) {
    float4 v = ((const float4*)src)[i];
    uint2 o;
    o.x = pack2(v.x, v.y);
    o.y = pack2(v.z, v.w);
    ((uint2*)dst)[i] = o;
  }
}

template <int MODE>
DEVI int colmap(int j) {
  if (MODE == 0) return j;
  if (MODE == 1) {
    if (j < 4096 || j >= 5120) return j;
    int hb = j & ~127, c = j & 127, wc = c >> 5, n = (c >> 4) & 1, r = c & 15;
    int d = n ? (64 + wc * 16 + r) : (wc * 16 + r);
    return hb + d;
  }
  if (j < 2560) return j;
  if (j < 5920) return j + 16;
  if (j < 5936) return 2560 + (j - 5920);
  return -1;
}

template <int MODE>
DEVI void transpose_job(const float* __restrict__ src, int ldsrc, int Ksrc, u16* __restrict__ dst, int Kdst, int ndst,
                        float* smem) {
  int ktiles = Kdst / 64, ntiles = ndst / 64;
  int tid = threadIdx.x & 255;
  const int half = threadIdx.x >> 8;
  smem += half * (64 * 65);
  for (int base = blockIdx.x * 2; base < ktiles * ntiles; base += gridDim.x * 2) {
    int tile = base + half;
    const bool valid = tile < ktiles * ntiles;
    if (!valid) tile = ktiles * ntiles - 1;
    int tn = tile / ktiles, tk = tile % ktiles;
    int j0 = tn * 64, k0 = tk * 64;
    int jj = (tid & 15) * 4;
    int sc = colmap<MODE>(j0 + jj);
#pragma unroll
    for (int i = 0; i < 4; ++i) {
      int kk = i * 16 + (tid >> 4);
      float4 v = make_float4(0.f, 0.f, 0.f, 0.f);
      if (sc >= 0 && (k0 + kk) < Ksrc) v = *(const float4*)(src + (size_t)(k0 + kk) * ldsrc + sc);
      smem[kk * 65 + jj] = v.x;
      smem[kk * 65 + jj + 1] = v.y;
      smem[kk * 65 + jj + 2] = v.z;
      smem[kk * 65 + jj + 3] = v.w;
    }
    __syncthreads();
    int jr = tid >> 2, kq = (tid & 3) * 16;
    unsigned pk[8];
#pragma unroll
    for (int e = 0; e < 8; ++e) pk[e] = pack2(smem[(kq + 2 * e) * 65 + jr], smem[(kq + 2 * e + 1) * 65 + jr]);
    uint4* dp = (uint4*)(dst + (size_t)(j0 + jr) * Kdst + k0 + kq);
    if (valid) {
      dp[0] = make_uint4(pk[0], pk[1], pk[2], pk[3]);
      dp[1] = make_uint4(pk[4], pk[5], pk[6], pk[7]);
    }
    __syncthreads();
  }
}

DEVI void phase0(const Params& p, float* smem) {
  char* ws = p.ws;
  conv_bf16_flat(p.in[I_KEYS], (u16*)(ws + OFF_KEY0), (size_t)16 * 128 * 128 / 4);
  conv_bf16_flat(p.in[I_KEYS] + (size_t)16 * 128 * 128, (u16*)(ws + OFF_KEY1), (size_t)16 * 128 * 128 / 4);
  transpose_job<1>(p.in[I_EWIN], N0, 2048, (u16*)(ws + OFF_WIN0), 2048, N0, smem);
  transpose_job<0>(p.in[I_EWOUT], 2048, 2048, (u16*)(ws + OFF_WOUT0), 2048, 2048, smem);
  transpose_job<0>(p.in[I_WQ], 2048, 2048, (u16*)(ws + OFF_WQ0), 2048, 2048, smem);
  transpose_job<0>(p.in[I_WQ] + (size_t)2048 * 2048, 2048, 2048, (u16*)(ws + OFF_WQ1), 2048, 2048, smem);
  transpose_job<2>(p.in[I_OWIN], 5936, 2048, (u16*)(ws + OFF_WIN1), 2048, N1, smem);
  transpose_job<0>(p.in[I_OWOUT], 2048, 2048, (u16*)(ws + OFF_WOUT1), 2048, 2048, smem);
  transpose_job<0>(p.in[I_W2], 1024, 64, (u16*)(ws + OFF_W2T), 64, 1024, smem);
  transpose_job<0>(p.in[I_A2], 1024, 64, (u16*)(ws + OFF_A2T), 64, 1024, smem);
  transpose_job<0>(p.in[I_G2], 1024, 160, (u16*)(ws + OFF_G2T), 192, 1024, smem);
  {
    float* XF = (float*)(ws + OFF_XF);
    u16* XB = (u16*)(ws + OFF_XB);
    size_t n4 = (size_t)MP * 512;
    size_t stride = (size_t)gridDim.x * blockDim.x;
    for (size_t i = (size_t)blockIdx.x * blockDim.x + threadIdx.x; i < n4; i += stride) {
      int row = (int)(i >> 9), c4 = (int)(i & 511);
      float4 v = make_float4(0.f, 0.f, 0.f, 0.f);
      if (row < MPR) {
        int b = row / TP, t = row % TP;
        const float* s = (t < 16) ? (p.in[I_META] + (size_t)t * D) : (p.in[I_XP] + ((size_t)b * 2048 + (t - 16)) * D);
        v = ((const float4*)s)[c4];
      } else if (row < M) {
        v = ((const float4*)(p.in[I_XS] + (size_t)(row - MPR) * D))[c4];
      }
      ((float4*)XF)[i] = v;
      uint2 o;
      o.x = pack2(v.x, v.y);
      o.y = pack2(v.z, v.w);
      ((uint2*)XB)[i] = o;
    }
  }
  if (blockIdx.x == 0) {
    float* LB = (float*)(ws + OFF_LB);
    const float* lg = p.in[I_LBL];
    for (int c = threadIdx.x; c < 1024; c += blockDim.x) {
      float a = lg[c], b = lg[1024 + c], d = lg[2048 + c];
      float m = fmaxf(a, fmaxf(b, d));
      float ea = expf(a - m), eb = expf(b - m), ed = expf(d - m);
      LB[c] = ea / (ea + eb + ed);
    }
    float* IR = (float*)(ws + OFF_INVREV);
    if (threadIdx.x < 64) {
      double d = (double)threadIdx.x;
      double v = exp(-d * (9.210340371976184 / 64.0)) * 0.15915494309189535;
      float h = (float)v;
      IR[threadIdx.x * 2] = h;
      IR[threadIdx.x * 2 + 1] = (float)(v - (double)h);
    }
  }
}

constexpr int G_LDS_STRIDE = 72;
constexpr int G_LDS_BUF = 2 * 128 * G_LDS_STRIDE;
template <class Epi>
DEVI void gemm_phase(const u16* __restrict__ A, int lda, int a_ntile_off, const u16* __restrict__ Bt, int K, int mtiles,
                     int ntiles, char* smem, Epi epi, const float* __restrict__ colc = nullptr) {
  const int half = threadIdx.x >> 8;
  u16* S0 = (u16*)(smem + half * VB_BYTES);
  const int tid = threadIdx.x & 255, wid = tid >> 6, lane = tid & 63, wr = wid >> 1, wc = wid & 1, fr = lane & 15, fq = lane >> 4;
  const int nk = K / 64;
  const int ntot = mtiles * ntiles;
  for (int base = blockIdx.x * 2; base < ntot; base += gridDim.x * 2) {
    int tile = base + half;
    const bool valid = tile < ntot;
    if (!valid) tile = ntot - 1;
    const int tm = tile / ntiles, tn = tile - tm * ntiles;
    const int brow = tm * 128, bcol = tn * 128;
    const u16* Ag = A + (size_t)brow * lda + (size_t)tn * a_ntile_off;
    const u16* Bg = Bt + (size_t)bcol * K;
    f32x4 acc[4][4];
#pragma unroll
    for (int m = 0; m < 4; ++m)
#pragma unroll
      for (int n = 0; n < 4; ++n) acc[m][n] = f32x4{0.f, 0.f, 0.f, 0.f};
    u32x4 ra0[4], rb0[4], ra1[4], rb1[4];
    auto gload = [&](int t, u32x4(&ra)[4], u32x4(&rb)[4]) {
#pragma unroll
      for (int i = 0; i < 4; ++i) {
        int c = tid + i * 256, r = c >> 3, kc = c & 7;
        ra[i] = *(const u32x4*)(Ag + (size_t)r * lda + t * 64 + kc * 8);
        rb[i] = *(const u32x4*)(Bg + (size_t)r * K + t * 64 + kc * 8);
      }
    };
    auto lwrite = [&](int buf, const u32x4(&ra)[4], const u32x4(&rb)[4]) {
      u16* SA = S0 + buf * G_LDS_BUF;
      u16* SB = SA + 128 * G_LDS_STRIDE;
#pragma unroll
      for (int i = 0; i < 4; ++i) {
        int c = tid + i * 256, r = c >> 3, kc = c & 7;
        *(u32x4*)(SA + r * G_LDS_STRIDE + kc * 8) = ra[i];
        *(u32x4*)(SB + r * G_LDS_STRIDE + kc * 8) = rb[i];
      }
    };
    auto compute = [&](int buf) {
      const u16* SA = S0 + buf * G_LDS_BUF;
      const u16* SB = SA + 128 * G_LDS_STRIDE;
#pragma unroll
      for (int kh = 0; kh < 2; ++kh) {
        bf16x8 At[4], Bl[4];
#pragma unroll
        for (int m = 0; m < 4; ++m)
          At[m] = *(const bf16x8*)(SA + (wr * 64 + m * 16 + fr) * G_LDS_STRIDE + kh * 32 + fq * 8);
#pragma unroll
        for (int n = 0; n < 4; ++n)
          Bl[n] = *(const bf16x8*)(SB + (wc * 64 + n * 16 + fr) * G_LDS_STRIDE + kh * 32 + fq * 8);
#pragma unroll
        for (int m = 0; m < 4; ++m)
#pragma unroll
          for (int n = 0; n < 4; ++n) acc[m][n] = __builtin_amdgcn_mfma_f32_16x16x32_bf16(At[m], Bl[n], acc[m][n], 0, 0, 0);
        __builtin_amdgcn_sched_barrier(0);
      }
    };
    gload(0, ra0, rb0);
    if (nk > 1) gload(1, ra1, rb1);
    lwrite(0, ra0, rb0);
    __syncthreads();
#pragma unroll 1
    for (int t = 0; t < nk; t += 2) {
      if (t + 2 < nk) gload(t + 2, ra0, rb0);
      compute(0);
      if (t + 1 < nk) lwrite(1, ra1, rb1);
      __syncthreads();
      if (t + 1 < nk) {
        if (t + 3 < nk) gload(t + 3, ra1, rb1);
        compute(1);
        if (t + 2 < nk) lwrite(0, ra0, rb0);
        __syncthreads();
      }
    }
    if (valid) {
      float cc[4] = {0.f, 0.f, 0.f, 0.f};
      if (colc) {
#pragma unroll
        for (int n = 0; n < 4; ++n) cc[n] = colc[bcol + wc * 64 + n * 16 + fr];
      }
#pragma unroll
      for (int m = 0; m < 4; ++m)
#pragma unroll
        for (int n = 0; n < 2; ++n)
#pragma unroll
          for (int j = 0; j < 4; ++j) {
            int row = brow + wr * 64 + m * 16 + fq * 4 + j;
            int col = bcol + wc * 64 + n * 16 + fr;
            epi(row, col, acc[m][n][j] + cc[n], acc[m][n + 2][j] + cc[n + 2]);
          }
    }
  }
}


namespace pg8 {
#define PG8_LAS __attribute__((address_space(3)))
typedef unsigned short bf16_t;
typedef short bf16x8 __attribute__((ext_vector_type(8)));
typedef float f32x4 __attribute__((ext_vector_type(4)));
typedef unsigned u32x4 __attribute__((ext_vector_type(4)));
constexpr int BM = 256, BK = 64, HALF = 128, HTB = HALF * BK * 2  , STAGE_BYTES = 8 * HTB, NXCD = 8, WGM = 8;

__host__ __device__ __forceinline__ int lds_byte(int r, int c) { const int st = (r >> 4) * 2 + (c >> 5), rr = r & 15, cc = c & 31, ob = rr * 64 + cc * 2; return st * 1024 + (ob ^ (((ob >> 9) & 1) << 5)); }
__host__ __device__ __forceinline__ void stage_rc(int b, int& R, int& C) { const int st = b / 1024, sb = b % 1024, swz = sb ^ (((sb >> 9) & 1) << 5); R = (st >> 1) * 16 + swz / 64; C = (st & 1) * 32 + (swz % 64) / 2; }
__host__ __device__ __forceinline__ int perm32(int rho) { const int n = rho >> 4, i = rho & 15; return 8 * (i >> 2) + 4 * n + (i & 3); }

struct Unit { int pm, pn; };
struct Gemm { const bf16_t* A; const bf16_t* Bt; int M, N, K; };

struct StaticOrder {
    int nM, nN, nwg, G, c;
    __host__ __device__ void init(int M, int N, int G_, int c_) { nM = M / BM; nN = N / BM; nwg = nM * nN; G = G_; c = c_; }
    __host__ __device__ bool next(int i, Unit& u) const {
        const long L = (long)i * G + c; if (L >= nwg) return false;
        int wgid = (int)L; { const int q = nwg / NXCD, r = nwg % NXCD, xcd = wgid % NXCD, off = wgid / NXCD; wgid = (xcd < r ? xcd * (q + 1) : r * (q + 1) + (xcd - r) * q) + off; }
        const int nig = WGM * nN, gid = wgid / nig, fm = gid * WGM, gsz = (nM - fm) < WGM ? (nM - fm) : WGM;
        u.pm = fm + ((wgid % nig) % gsz); u.pn = (wgid % nig) / gsz; return true;
    }
    __device__ __forceinline__ void a_ready(const Unit&) const {}
    __device__ __forceinline__ void done(const Unit&) const {}
};
template <class Epi, class Sched, bool STAMP = false>
__device__ __forceinline__ void gemm_phase(PG8_LAS unsigned char* lds, const Gemm g, const Sched& S, const Epi& E, unsigned long long* stamps) {
    const int tid = threadIdx.x, wid = __builtin_amdgcn_readfirstlane(tid >> 6), lane = tid & 63, wr = wid >> 2, wc = wid & 3, fr = lane & 15, fq = lane >> 4;
    const int K = g.K, nt = K / BK;
    int ts_lo = 0, ts_hi = 0, nts = 0; const unsigned long long rt_entry = STAMP ? (unsigned long long)wall_clock64() : 0ull;
#define PG8_STAMP() do { if (STAMP && wid == 0 && nts < 64) { const unsigned long long _c = (unsigned long long)clock64(); \
        ts_lo = (lane == nts) ? (int)(unsigned)_c : ts_lo; ts_hi = (lane == nts) ? (int)(unsigned)(_c >> 32) : ts_hi; ++nts; } } while (0)
    PG8_STAMP();
    unsigned voffA[2], voffB[2];
#pragma unroll
    for (int i = 0; i < 2; ++i) { int R, C; stage_rc(tid * 16 + i * 8192, R, C); const int Rb = Epi::PERM ? ((R & ~31) + perm32(R & 31)) : R;
        voffA[i] = (unsigned)(R * K + C) * 2u; voffB[i] = (unsigned)(Rb * K + C) * 2u; }
    const size_t kstep = (size_t)(BK * 2);
    const size_t hstep = (size_t)HALF * K * 2;
    const size_t tstep = 2 * hstep;
    const unsigned ldsw = (unsigned)wid * 1024u;
    const int aoff = lds_byte(wr * 64 + fr, fq * 8), boff = lds_byte(wc * 32 + fr, fq * 8);
#define PG8_SA(b, h) (((b) * 2 + (h)) * HTB)
#define PG8_SB(b, h) ((4 + (b) * 2 + (h)) * HTB)
#define PG8_STAGE(bufoff, gbase, voff) do { _Pragma("unroll") for (int _i = 0; _i < 2; ++_i) \
        __builtin_amdgcn_global_load_lds((const unsigned*)((const char*)(gbase) + (voff)[_i]), (PG8_LAS unsigned*)(lds + (bufoff) + ldsw + _i * 8192), 16, 0, 0); } while (0)
#define PG8_LDA(dst, b, h) do { _Pragma("unroll") for (int m = 0; m < 4; ++m) _Pragma("unroll") for (int k = 0; k < 2; ++k) dst[m][k] = *(const PG8_LAS bf16x8*)(lds + PG8_SA(b, h) + aoff + m * 2048 + k * 1024); } while (0)
#define PG8_LDB(dst, b, h) do { _Pragma("unroll") for (int n = 0; n < 2; ++n) _Pragma("unroll") for (int k = 0; k < 2; ++k) dst[n][k] = *(const PG8_LAS bf16x8*)(lds + PG8_SB(b, h) + boff + n * 2048 + k * 1024); } while (0)
#define PG8_MMA(ai, bj, At, Bt) do { __builtin_amdgcn_s_setprio(1); _Pragma("unroll") for (int m = 0; m < 4; ++m) _Pragma("unroll") for (int n = 0; n < 2; ++n) _Pragma("unroll") for (int k = 0; k < 2; ++k) \
        acc[ai][bj][m][n] = __builtin_amdgcn_mfma_f32_16x16x32_bf16(Bt[n][k], At[m][k], acc[ai][bj][m][n], 0, 0, 0); __builtin_amdgcn_s_setprio(0); } while (0)
#define PG8_WAIT_V(n) asm volatile("s_waitcnt vmcnt(" #n ")" ::: "memory")
#define PG8_WAIT_L(n) asm volatile("s_waitcnt lgkmcnt(" #n ")" ::: "memory")
#define PG8_BAR __builtin_amdgcn_s_barrier()
#define PG8_SCHED __builtin_amdgcn_sched_barrier(0)
    Unit cur, nxt; int ui = 0;
    if (!S.next(0, cur)) return;
    f32x4 acc[2][2][4][2];
#pragma unroll
    for (int a = 0; a < 2; ++a)
#pragma unroll
        for (int b = 0; b < 2; ++b)
#pragma unroll
            for (int m = 0; m < 4; ++m)
#pragma unroll
                for (int n = 0; n < 2; ++n) acc[a][b][m][n] = (f32x4){0.f, 0.f, 0.f, 0.f};
    bf16x8 At[4][2], B0[2][2], B1[2][2];
    const char* cA = (const char*)g.A + (size_t)cur.pm * tstep; const char* cB = (const char*)g.Bt + (size_t)cur.pn * tstep;
    S.a_ready(cur);
    PG8_STAGE(PG8_SB(0, 0), cB, voffB); PG8_STAGE(PG8_SA(0, 0), cA, voffA); PG8_STAGE(PG8_SB(0, 1), cB + hstep, voffB); PG8_STAGE(PG8_SA(0, 1), cA + hstep, voffA);
    if (wr == 1) PG8_BAR;
    PG8_WAIT_V(4); PG8_BAR;
    PG8_STAGE(PG8_SB(1, 0), cB + kstep, voffB); PG8_STAGE(PG8_SA(1, 0), cA + kstep, voffA); PG8_STAGE(PG8_SB(1, 1), cB + hstep + kstep, voffB);
    PG8_WAIT_V(6); PG8_BAR;
    PG8_STAMP();
    for (;;) {
        const bool has_next = S.next(ui + 1, nxt);
        const char* nA = has_next ? (const char*)g.A + (size_t)nxt.pm * tstep : cA; const char* nB = has_next ? (const char*)g.Bt + (size_t)nxt.pn * tstep : cB;
        for (int t = 0; t < nt; t += 2) {
            const bool last = (t == nt - 2);
            const char* a1 = cA + (size_t)(t + 1) * kstep;
            const char* a2 = last ? nA : cA + (size_t)(t + 2) * kstep; const char* b2 = last ? nB : cB + (size_t)(t + 2) * kstep;
            const char* a3 = a2 + kstep; const char* b3 = b2 + kstep;
            if (last && has_next) S.a_ready(nxt);
            PG8_LDB(B0, 0, 0); PG8_SCHED; PG8_LDA(At, 0, 0); PG8_STAGE(PG8_SA(1, 1), a1 + hstep, voffA);
            PG8_WAIT_L(8); PG8_BAR; PG8_WAIT_L(0); PG8_MMA(0, 0, At, B0); PG8_BAR; PG8_SCHED;
            PG8_LDB(B1, 0, 1); PG8_STAGE(PG8_SB(0, 0), b2, voffB);
            PG8_BAR; PG8_WAIT_L(0); PG8_MMA(0, 1, At, B1); PG8_BAR;
            PG8_LDA(At, 0, 1); PG8_STAGE(PG8_SA(0, 0), a2, voffA);
            PG8_BAR; PG8_WAIT_L(0); PG8_MMA(1, 0, At, B0); PG8_BAR; PG8_SCHED;
            PG8_STAGE(PG8_SB(0, 1), b2 + hstep, voffB);
            PG8_WAIT_V(6); PG8_BAR; PG8_MMA(1, 1, At, B1); PG8_BAR;
            PG8_LDB(B0, 1, 0); PG8_SCHED; PG8_LDA(At, 1, 0); PG8_STAGE(PG8_SA(0, 1), a2 + hstep, voffA);
            PG8_WAIT_L(8); PG8_BAR; PG8_WAIT_L(0); PG8_MMA(0, 0, At, B0); PG8_BAR; PG8_SCHED;
            PG8_LDB(B1, 1, 1); PG8_STAGE(PG8_SB(1, 0), b3, voffB);
            PG8_BAR; PG8_WAIT_L(0); PG8_MMA(0, 1, At, B1); PG8_BAR;
            PG8_LDA(At, 1, 1); PG8_STAGE(PG8_SA(1, 0), a3, voffA);
            PG8_BAR; PG8_WAIT_L(0); PG8_MMA(1, 0, At, B0); PG8_BAR; PG8_SCHED;
            PG8_STAGE(PG8_SB(1, 1), b3 + hstep, voffB);
            PG8_WAIT_V(6); PG8_BAR; PG8_MMA(1, 1, At, B1); PG8_BAR;
        }
        PG8_STAMP();
        if constexpr (!Epi::AFTER_DRAIN) { E(acc, cur, wr, wc, fr, fq); S.done(cur); }
        PG8_STAMP();
        if (!has_next) break;
#pragma unroll
        for (int a = 0; a < 2; ++a)
#pragma unroll
            for (int b = 0; b < 2; ++b)
#pragma unroll
                for (int m = 0; m < 4; ++m)
#pragma unroll
                    for (int n = 0; n < 2; ++n) acc[a][b][m][n] = (f32x4){0.f, 0.f, 0.f, 0.f};
        cur = nxt; cA = nA; cB = nB; ++ui;
    }
    PG8_WAIT_V(0);
    if (wr == 0) PG8_BAR;
    PG8_BAR;
    if constexpr (Epi::AFTER_DRAIN) { E.fused(acc, cur, wr, wc, fr, fq, lds, wid, lane); S.done(cur); }
    PG8_STAMP();
    if (STAMP && wid == 0) { stamps[lane] = lane < nts ? (((unsigned long long)(unsigned)ts_hi << 32) | (unsigned)ts_lo) : 0ull;
        if (lane == 62) stamps[62] = rt_entry; if (lane == 63) stamps[63] = (unsigned long long)wall_clock64(); }
#undef PG8_STAMP
#undef PG8_SA
#undef PG8_SB
#undef PG8_STAGE
#undef PG8_LDA
#undef PG8_LDB
#undef PG8_MMA
#undef PG8_WAIT_V
#undef PG8_WAIT_L
#undef PG8_BAR
#undef PG8_SCHED
}
}

struct EpiIn0 {
  static constexpr bool PERM = false, AFTER_DRAIN = false;
  float* PROJ;
  const float* LB;
  const float* IR;
  __device__ __forceinline__ void operator()(const pg8::f32x4 (&acc)[2][2][4][2], const pg8::Unit& u, int wr, int wc, int fr, int fq) const {
#pragma unroll
    for (int bj = 0; bj < 2; ++bj) {
      const int cb = u.pn * 256 + bj * 128;
      if (cb >= 4096 && cb < 5120) {
        const int d0 = wc * 16 + 4 * fq;
        const pg8::f32x4 irA = *(const pg8::f32x4*)(IR + 2 * d0), irB = *(const pg8::f32x4*)(IR + 2 * d0 + 4);
        const float irh[4] = {irA[0], irA[2], irB[0], irB[2]}, irl[4] = {irA[1], irA[3], irB[1], irB[3]};
        const float sc = (cb >= 4608) ? 0.08838834764831845f : 1.0f;
#pragma unroll
        for (int ai = 0; ai < 2; ++ai)
#pragma unroll
          for (int m = 0; m < 4; ++m) {
            const int row = u.pm * 256 + ai * 128 + wr * 64 + m * 16 + fr;
            float* pr = PROJ + (size_t)row * N0;
            const pg8::f32x4 v0 = acc[ai][bj][m][0], v1 = acc[ai][bj][m][1];
            const float pos = (float)row_pos(row);
            pg8::f32x4 o1, o2;
#pragma unroll
            for (int j = 0; j < 4; ++j) {
              float ph = pos * irh[j];
              float pe = __builtin_fmaf(pos, irh[j], -ph) + pos * irl[j];
              float frc = __builtin_amdgcn_fractf(ph) + pe;
              float sn = __builtin_amdgcn_sinf(frc), cs = __builtin_amdgcn_cosf(frc);
              o1[j] = (v0[j] * cs - v1[j] * sn) * sc;
              o2[j] = (v0[j] * sn + v1[j] * cs) * sc;
            }
            *(pg8::f32x4*)(pr + cb + d0) = o1;
            *(pg8::f32x4*)(pr + cb + 64 + d0) = o2;
            __builtin_amdgcn_sched_barrier(0);
          }
      } else if (cb >= 1024 && cb < 2048) {
        const int c0 = cb + 32 * wc + 4 * fq;
        const pg8::f32x4 l0 = *(const pg8::f32x4*)(LB + c0 - 1024), l1 = *(const pg8::f32x4*)(LB + c0 + 16 - 1024);
#pragma unroll
        for (int ai = 0; ai < 2; ++ai)
#pragma unroll
          for (int m = 0; m < 4; ++m) {
            const int row = u.pm * 256 + ai * 128 + wr * 64 + m * 16 + fr;
            float* pr = PROJ + (size_t)row * N0;
#pragma unroll
            for (int n = 0; n < 2; ++n) {
              const pg8::f32x4 l = n ? l1 : l0;
              pg8::f32x4 v = acc[ai][bj][m][n], o;
#pragma unroll
              for (int j = 0; j < 4; ++j) o[j] = l[j] + (1.0f - l[j]) * sigmoid_acc(v[j]);
              *(pg8::f32x4*)(pr + c0 + 16 * n) = o;
            }
            __builtin_amdgcn_sched_barrier(0);
          }
      } else {
        const bool act = (cb < 1024 || (cb >= 3072 && cb < 4096) || cb >= 6144);
        const int c0 = cb + 32 * wc + 4 * fq;
#pragma unroll
        for (int ai = 0; ai < 2; ++ai)
#pragma unroll
          for (int m = 0; m < 4; ++m) {
            const int row = u.pm * 256 + ai * 128 + wr * 64 + m * 16 + fr;
            float* pr = PROJ + (size_t)row * N0;
#pragma unroll
            for (int n = 0; n < 2; ++n) {
              pg8::f32x4 v = acc[ai][bj][m][n], o;
#pragma unroll
              for (int j = 0; j < 4; ++j) o[j] = act ? silu_acc(v[j]) : v[j];
              *(pg8::f32x4*)(pr + c0 + 16 * n) = o;
            }
            __builtin_amdgcn_sched_barrier(0);
          }
      }
    }
  }
};
struct EpiIn1 {
  static constexpr bool PERM = false, AFTER_DRAIN = false;
  float* PROJ;
  float* DTA;
  const float* dtb;
  const float* alog;
  __device__ __forceinline__ void operator()(const pg8::f32x4 (&acc)[2][2][4][2], const pg8::Unit& u, int wr, int wc, int fr, int fq) const {
    float dtbv[4] = {0.f, 0.f, 0.f, 0.f}, aev[4] = {0.f, 0.f, 0.f, 0.f};
    if (u.pn == 23) {
      const int cc = 23 * 256 + 32 * wc + 4 * fq;
      const int hb = (cc >= 5920 && cc < 5936) ? (cc - 5920) : ((cc + 16 >= 5920 && cc + 16 < 5936) ? (cc + 16 - 5920) : -1);
      if (hb >= 0) {
#pragma unroll
        for (int j = 0; j < 4; ++j) { dtbv[j] = dtb[hb + j]; aev[j] = expf(alog[hb + j]); }
      }
    }
#pragma unroll
    for (int ai = 0; ai < 2; ++ai)
#pragma unroll
      for (int m = 0; m < 4; ++m) {
        const int row = u.pm * 256 + ai * 128 + wr * 64 + m * 16 + fr;
        float* pr = PROJ + (size_t)row * N1;
#pragma unroll
        for (int bj = 0; bj < 2; ++bj)
#pragma unroll
          for (int n = 0; n < 2; ++n) {
            const int col0 = u.pn * 256 + bj * 128 + 32 * wc + 16 * n + 4 * fq;
            pg8::f32x4 v = acc[ai][bj][m][n];
            if (col0 < 1024) {
              pg8::f32x4 o;
#pragma unroll
              for (int j = 0; j < 4; ++j) o[j] = siluf_(v[j]);
              *(pg8::f32x4*)(pr + col0) = o;
            } else if (col0 < 5920) {
              *(pg8::f32x4*)(pr + col0) = v;
            } else if (col0 < 5936) {
#pragma unroll
              for (int j = 0; j < 4; ++j) {
                int h = col0 + j - 5920;
                float dt = softplusf_(v[j] + dtbv[j]);
                DTA[(size_t)row * 64 + h * 4] = dt;
                DTA[(size_t)row * 64 + h * 4 + 1] = expf(-dt * aev[j]);
              }
            }
          }
      }
  }
};

struct Seg {
  int off;
  int ld;
  int n4;
};

template <int NS, int NF4, int RG>
DEVI void stage_init(const float* wsf, const Seg (&sg)[NS], int row0, int tid, const float* (&ptr)[RG], int (&ldv)[RG]) {
  asm volatile("" : "+v"(tid));
#pragma unroll
  for (int q = 0; q < RG; ++q) {
    int flat = tid + q * 256;
    int t = flat / NF4, f = flat % NF4;
    if (flat >= 16 * NF4) { t = 0; f = 0; }
    int off = 0, ld = 0, ff = f;
    bool done = false;
#pragma unroll
    for (int s = 0; s < NS; ++s) {
      bool here = (!done) && (ff < sg[s].n4);
      off = here ? (sg[s].off + (row0 + t) * sg[s].ld + ff * 4) : off;
      ld = here ? sg[s].ld : ld;
      ff = (done || here) ? ff : (ff - sg[s].n4);
      done = done || here;
    }
    ptr[q] = wsf + off;
    ldv[q] = ld;
  }
}
template <int NF4, int RG>
DEVI void stage_issue(const float* const (&ptr)[RG], const int (&ldv)[RG], int st, int nsteps, int tid, f32x4 (&rg)[RG]) {
#pragma unroll
  for (int q = 0; q < RG; ++q) {
    int flat = tid + q * 256;
    if (flat < nsteps * NF4) rg[q] = *(const f32x4*)(ptr[q] + (st * 16) * ldv[q]);
  }
}
template <int NF4, int RG>
DEVI void stage_commit(float* buf, int nsteps, int tid, const f32x4 (&rg)[RG]) {
#pragma unroll
  for (int q = 0; q < RG; ++q) {
    int flat = tid + q * 256;
    if (flat < nsteps * NF4) ((f32x4*)buf)[flat] = rg[q];
  }
}

template <int MODE>
DEVI void colrec_long(const float* wsf, const Seg (&sg)[4], int row0, int T, float gamma, float* outp, int ldo, float* stout, int st_ld,
                      float* smem) {
  constexpr int NF4 = 69, W = 276, RG = 5;
  const int tid = threadIdx.x & 255, w = tid >> 6, lane = tid & 63, c = lane >> 4, s = lane & 15;
  smem += (threadIdx.x >> 8) * (VB_BYTES / 4);
  float S[8];
#pragma unroll
  for (int i = 0; i < 8; ++i) S[i] = 0.f;
  float* buf0 = smem;
  float* buf1 = smem + 16 * 336;
  float* obuf = smem + 2 * 16 * 336;
  const int nst = (T + 15) / 16;
  f32x4 rgA[RG], rgB[RG];
  const float* sptr[RG];
  int sld[RG];
  stage_init<4, NF4, RG>(wsf, sg, row0, tid, sptr, sld);
  auto step = [&](const float* sp, float* ob, int tt) -> float {
    float4 a0 = *(const float4*)(sp + s * 8), a1 = *(const float4*)(sp + s * 8 + 4);
    float4 q0 = *(const float4*)(sp + 128 + s * 8), q1 = *(const float4*)(sp + 128 + s * 8 + 4);
    float a[8] = {a0.x, a0.y, a0.z, a0.w, a1.x, a1.y, a1.z, a1.w};
    float q[8] = {q0.x, q0.y, q0.z, q0.w, q1.x, q1.y, q1.z, q1.w};
    float val = sp[256 + w * 4 + c];
    float dA = gamma;
    if (MODE == 2) {
      val *= sp[272];
      dA = sp[273];
    }
    float o = 0.f;
#pragma unroll
    for (int i = 0; i < 8; ++i) {
      if (MODE == 0) S[i] = val + a[i] * (S[i] - val);
      else S[i] = dA * S[i] + a[i] * val;
      o += q[i] * S[i];
    }
    return red16(o);
  };
  auto run_stage = [&](const float* b, float* ob, int nthis) {
#pragma unroll 1
    for (int tt = 0; tt < nthis; tt += 4) {
      float o0 = step(b + tt * W, ob, tt);
      float o1 = step(b + (tt + 1) * W, ob, tt + 1);
      float o2 = step(b + (tt + 2) * W, ob, tt + 2);
      float o3 = step(b + (tt + 3) * W, ob, tt + 3);
      const int base = (s == 0) ? (tt * 16 + w * 4 + c) : (1024 + (tid & 255));
      const int st16 = (s == 0) ? 16 : 0;
      ob[base] = o0;
      ob[base + st16] = o1;
      ob[base + 2 * st16] = o2;
      ob[base + 3 * st16] = o3;
    }
  };
  auto write_out = [&](const float* ob, int st, int nthis) {
    if (tid < nthis * 4) {
      int t = tid >> 2, c4 = tid & 3;
      *(float4*)(outp + (size_t)(st * 16 + t) * ldo + c4 * 4) = *(const float4*)(ob + t * 16 + c4 * 4);
    }
  };
  auto nsteps = [&](int st) { return min(16, T - st * 16); };
  stage_issue<NF4, RG>(sptr, sld, 0, nsteps(0), tid, rgA);
  stage_commit<NF4, RG>(buf0, nsteps(0), tid, rgA);
  if (nst > 1) stage_issue<NF4, RG>(sptr, sld, 1, nsteps(1), tid, rgB);
  __syncthreads();
#pragma unroll 1
  for (int st = 0; st < nst; st += 2) {
    if (st + 2 < nst) stage_issue<NF4, RG>(sptr, sld, st + 2, nsteps(st + 2), tid, rgA);
    run_stage(buf0, obuf, nsteps(st));
    if (st + 1 < nst) stage_commit<NF4, RG>(buf1, nsteps(st + 1), tid, rgB);
    __syncthreads();
    write_out(obuf, st, nsteps(st));
    if (st + 1 < nst) {
      if (st + 3 < nst) stage_issue<NF4, RG>(sptr, sld, st + 3, nsteps(st + 3), tid, rgB);
      run_stage(buf1, obuf + 512, nsteps(st + 1));
      if (st + 2 < nst) stage_commit<NF4, RG>(buf0, nsteps(st + 2), tid, rgA);
      __syncthreads();
      write_out(obuf + 512, st + 1, nsteps(st + 1));
    }
  }
#pragma unroll
  for (int i = 0; i < 8; ++i) stout[(size_t)(s * 8 + i) * st_ld + w * 4 + c] = S[i];
  __syncthreads();
}

template <int MODE>
DEVI void colrec_short(const float* pa, int lda_, const float* pq, int ldq, const float* pc, int ldc, const float* pdt,
                       long row0, float gamma, const float* stin, float* stout, int st_ld, float* outp, int ldo,
                       float* smem) {
  const int tid = threadIdx.x & 255, lane = tid & 63;
  const int wid = __builtin_amdgcn_readfirstlane(tid >> 6);
  const int k0 = wid * 32;
  smem += (threadIdx.x >> 8) * (VB_BYTES / 4);
  float S[32];
#pragma unroll
  for (int i = 0; i < 32; ++i) S[i] = stin[(size_t)(k0 + i) * st_ld + lane];
  float aq[4], vv[4], dAv[4];
#pragma unroll
  for (int t = 0; t < 4; ++t) {
    long row = row0 + t;
    aq[t] = (lane < 32) ? pa[(size_t)row * lda_ + k0 + lane] : pq[(size_t)row * ldq + k0 + (lane - 32)];
    vv[t] = pc[(size_t)row * ldc + lane];
    dAv[t] = gamma;
    if (MODE == 2) {
      vv[t] *= pdt[(size_t)row * 64];
      dAv[t] = pdt[(size_t)row * 64 + 1];
    }
  }
#pragma unroll
  for (int t = 0; t < 4; ++t) {
    const float val = vv[t], dA = dAv[t];
    float o = 0.f;
#pragma unroll
    for (int i = 0; i < 32; ++i) {
      const float a = rlf_(aq[t], i), q = rlf_(aq[t], 32 + i);
      if (MODE == 0) S[i] = val + a * (S[i] - val);
      else S[i] = dA * S[i] + a * val;
      o += q * S[i];
    }
    smem[(wid * 4 + t) * 64 + lane] = o;
  }
#pragma unroll
  for (int i = 0; i < 32; ++i) stout[(size_t)(k0 + i) * st_ld + lane] = S[i];
  __syncthreads();
  {
    int t = tid >> 6;
    float sum = smem[(0 * 4 + t) * 64 + lane] + smem[(1 * 4 + t) * 64 + lane] + smem[(2 * 4 + t) * 64 + lane] +
                smem[(3 * 4 + t) * 64 + lane];
    outp[(size_t)(row0 + t) * ldo + lane] = sum;
  }
  __syncthreads();
}

DEVI void rwkv_item(const float* wsf, const Seg (&sg)[6], int row0, int T, const float* stin, float* stout, float* outp, int ldo,
                    float* smem) {
  constexpr int NF4 = 84, W = 336, RG = 6;
  const int tid = threadIdx.x & 255, w = tid >> 6, lane = tid & 63, rl = lane >> 4, sl = lane & 15;
  smem += (threadIdx.x >> 8) * (VB_BYTES / 4);
  const int il = w * 4 + rl;
  float S[4];
  if (stin) {
    float4 v = *(const float4*)(stin + il * 64 + sl * 4);
    S[0] = v.x; S[1] = v.y; S[2] = v.z; S[3] = v.w;
  } else {
    S[0] = S[1] = S[2] = S[3] = 0.f;
  }
  float* buf0 = smem;
  float* buf1 = smem + 16 * 336;
  float* obuf = smem + 2 * 16 * 336;
  const int nst = (T + 15) / 16;
  f32x4 rgA[RG], rgB[RG];
  const float* sptr[RG];
  int sld[RG];
  stage_init<6, NF4, RG>(wsf, sg, row0, tid, sptr, sld);
  auto run_stage = [&](const float* b, float* ob, int nthis) {
#pragma unroll 4
    for (int tt = 0; tt < nthis; ++tt) {
      const float* sp = b + tt * W;
      float4 r4 = *(const float4*)(sp + sl * 4);
      float4 w4 = *(const float4*)(sp + 64 + sl * 4);
      float4 k4 = *(const float4*)(sp + 128 + sl * 4);
      float4 n4 = *(const float4*)(sp + 192 + sl * 4);
      float4 m4 = *(const float4*)(sp + 256 + sl * 4);
      float vi = sp[320 + il];
      float sa = S[0] * n4.x + S[1] * n4.y + S[2] * n4.z + S[3] * n4.w;
      sa = -red16(sa);
      S[0] = S[0] * w4.x + sa * m4.x + vi * k4.x;
      S[1] = S[1] * w4.y + sa * m4.y + vi * k4.y;
      S[2] = S[2] * w4.z + sa * m4.z + vi * k4.z;
      S[3] = S[3] * w4.w + sa * m4.w + vi * k4.w;
      float y = S[0] * r4.x + S[1] * r4.y + S[2] * r4.z + S[3] * r4.w;
      y = red16(y);
      ob[(sl == 0) ? (tt * 16 + il) : (1024 + (tid & 255))] = y;
    }
  };
  auto write_out = [&](const float* ob, int st, int nthis) {
    if (tid < nthis * 4) {
      int t = tid >> 2, c4 = tid & 3;
      *(float4*)(outp + (size_t)(st * 16 + t) * ldo + c4 * 4) = *(const float4*)(ob + t * 16 + c4 * 4);
    }
  };
  auto nsteps = [&](int st) { return min(16, T - st * 16); };
  stage_issue<NF4, RG>(sptr, sld, 0, nsteps(0), tid, rgA);
  stage_commit<NF4, RG>(buf0, nsteps(0), tid, rgA);
  if (nst > 1) stage_issue<NF4, RG>(sptr, sld, 1, nsteps(1), tid, rgB);
  __syncthreads();
  __builtin_amdgcn_s_setprio(3);
#pragma unroll 1
  for (int st = 0; st < nst; st += 2) {
    if (st + 2 < nst) stage_issue<NF4, RG>(sptr, sld, st + 2, nsteps(st + 2), tid, rgA);
    run_stage(buf0, obuf, nsteps(st));
    if (st + 1 < nst) stage_commit<NF4, RG>(buf1, nsteps(st + 1), tid, rgB);
    __syncthreads();
    write_out(obuf, st, nsteps(st));
    if (st + 1 < nst) {
      if (st + 3 < nst) stage_issue<NF4, RG>(sptr, sld, st + 3, nsteps(st + 3), tid, rgB);
      run_stage(buf1, obuf + 512, nsteps(st + 1));
      if (st + 2 < nst) stage_commit<NF4, RG>(buf0, nsteps(st + 2), tid, rgA);
      __syncthreads();
      write_out(obuf + 512, st + 1, nsteps(st + 1));
    }
  }
  __builtin_amdgcn_s_setprio(0);
  *(float4*)(stout + il * 64 + sl * 4) = make_float4(S[0], S[1], S[2], S[3]);
  __syncthreads();
}

DEVI void phase_rec0(const Params& p, float* smem) {
  char* ws = p.ws;
  const float* PROJ = (const float*)(ws + OFF_PROJ);
  float* OMIX = (float*)(ws + OFF_OMIX);
  const float* wsf = (const float*)ws;
  constexpr int PO = (int)(OFF_PROJ / 4);
  for (int item = blockIdx.x * 2 + (threadIdx.x >> 8); item < 4608; item += gridDim.x * 2) {
    if (item < 256) {
      int b = item >> 6, h = (item >> 3) & 7, cb = item & 7;
      Seg sg[4] = {{PO + 1024 + h * 128, N0, 32}, {PO + h * 128, N0, 32}, {PO + 2048 + h * 128 + cb * 16, N0, 4},
                   {PO, N0, 1}};
      int row0 = b * TP;
      colrec_long<0>(wsf, sg, row0, TP, 0.f, OMIX + (size_t)row0 * 2048 + h * 128 + cb * 16, 2048,
                     p.out + O_HGP + (size_t)(b * 8 + h) * 128 * 128 + cb * 16, 128, smem);
    } else if (item < 512) {
      int it = item - 256;
      int b = it >> 6, h = (it >> 4) & 3, cb = it & 15;
      Seg sg[4] = {{PO + 4608 + h * 128, N0, 32}, {PO + 4096 + h * 128, N0, 32},
                   {PO + 5120 + h * 256 + cb * 16, N0, 4}, {PO, N0, 1}};
      int row0 = b * TP;
      float gamma = 1.0f - exp2f(-5.0f - (float)h);
      colrec_long<1>(wsf, sg, row0, TP, gamma, OMIX + (size_t)row0 * 2048 + 1024 + h * 256 + cb * 16, 2048,
                     p.out + O_RTP + (size_t)(b * 4 + h) * 128 * 256 + cb * 16, 256, smem);
    } else if (item < 2560) {
      int it = item - 512;
      int b = it >> 4, h = (it >> 1) & 7, cb = it & 1;
      long row0 = MPR + (long)b * 4;
      size_t so = (size_t)(b * 8 + h) * 128 * 128 + cb * 64;
      colrec_short<0>(PROJ + 1024 + h * 128, N0, PROJ + h * 128, N0, PROJ + 2048 + h * 128 + cb * 64, N0, nullptr, row0,
                      0.f, p.in[I_SHG] + so, p.out + O_HGS + so, 128, OMIX + h * 128 + cb * 64, 2048, smem);
    } else {
      int it = item - 2560;
      int b = it >> 4, h = (it >> 2) & 3, cb = it & 3;
      long row0 = MPR + (long)b * 4;
      size_t so = (size_t)(b * 4 + h) * 128 * 256 + cb * 64;
      float gamma = 1.0f - exp2f(-5.0f - (float)h);
      colrec_short<1>(PROJ + 4608 + h * 128, N0, PROJ + 4096 + h * 128, N0, PROJ + 5120 + h * 256 + cb * 64, N0, nullptr,
                      row0, gamma, p.in[I_SRT] + so, p.out + O_RTS + so, 256, OMIX + 1024 + h * 256 + cb * 64, 2048,
                      smem);
    }
  }
}

DEVI float4 ld4(const float* p) { return *(const float4*)p; }
DEVI void st_bf4(u16* p, float a, float b, float c, float d) {
  uint2 o;
  o.x = pack2(a, b);
  o.y = pack2(c, d);
  *(uint2*)p = o;
}
DEVI float wsum_u_(float v) {
  v = red16(v);
  return (rlf_(v, 0) + rlf_(v, 16)) + (rlf_(v, 32) + rlf_(v, 48));
}
DEVI float red32(float v) {
  v = red16(v);
  return v + __shfl_xor(v, 16, 64);
}
DEVI void phase_post0(const Params& p) {
  char* ws = p.ws;
  const float* PROJ = (const float*)(ws + OFF_PROJ);
  const float* OMIX = (const float*)(ws + OFF_OMIX);
  u16* MIXB = (u16*)(ws + OFF_MIXB);
  const float* ng = p.in[I_HNG];
  const int lane = threadIdx.x & 63;
  const int gw = blockIdx.x * 8 + (threadIdx.x >> 6), nw = gridDim.x * 8;
  const float4 g4 = ld4(ng + (lane & 31) * 4);
  for (int row = gw; row < M; row += nw) {
    const float* o = OMIX + (size_t)row * 2048;
    const float* pr = PROJ + (size_t)row * N0;
    u16* mo = MIXB + (size_t)row * 2048;
    float4 a[4], ga[4], bq[4], gb[4];
#pragma unroll
    for (int it = 0; it < 4; ++it) {
      int c = it * 256 + lane * 4;
      a[it] = ld4(o + c);
      ga[it] = ld4(pr + 3072 + c);
      bq[it] = ld4(o + 1024 + c);
      gb[it] = ld4(pr + 6144 + c);
    }
#pragma unroll
    for (int it = 0; it < 4; ++it) {
      int c = it * 256 + lane * 4;
      float ss = red32(a[it].x * a[it].x + a[it].y * a[it].y + a[it].z * a[it].z + a[it].w * a[it].w);
      float inv = rsqrtf(ss * (1.0f / 128.0f) + 1e-6f);
      st_bf4(mo + c, a[it].x * inv * g4.x * ga[it].x, a[it].y * inv * g4.y * ga[it].y, a[it].z * inv * g4.z * ga[it].z,
             a[it].w * inv * g4.w * ga[it].w);
      float mu = wsum_u_(bq[it].x + bq[it].y + bq[it].z + bq[it].w) * (1.0f / 256.0f);
      float dx = bq[it].x - mu, dy = bq[it].y - mu, dz = bq[it].z - mu, dw = bq[it].w - mu;
      float var = wsum_u_(dx * dx + dy * dy + dz * dz + dw * dw) * (1.0f / 256.0f);
      float iv = rsqrtf(var + 1e-5f);
      st_bf4(mo + 1024 + c, dx * iv * gb[it].x, dy * iv * gb[it].y, dz * iv * gb[it].z, dw * iv * gb[it].w);
    }
  }
}

DEVI void phase_ln(const Params& p, const float* addsrc, const float* g, const float* bta) {
  char* ws = p.ws;
  float* XF = (float*)(ws + OFF_XF);
  u16* XB = (u16*)(ws + OFF_XB);
  const int lane = threadIdx.x & 63;
  const int gw = blockIdx.x * 8 + (threadIdx.x >> 6), nw = gridDim.x * 8;
  for (int row = gw; row < M; row += nw) {
    float4* xr = (float4*)(XF + (size_t)row * 2048);
    const float4* ar = (const float4*)(addsrc + (size_t)row * 2048);
    float v[32];
    float s = 0.f;
#pragma unroll
    for (int i = 0; i < 8; ++i) {
      float4 x = xr[i * 64 + lane], a = ar[i * 64 + lane];
      v[i * 4 + 0] = ALPHA * x.x + a.x;
      v[i * 4 + 1] = ALPHA * x.y + a.y;
      v[i * 4 + 2] = ALPHA * x.z + a.z;
      v[i * 4 + 3] = ALPHA * x.w + a.w;
      s += v[i * 4 + 0] + v[i * 4 + 1] + v[i * 4 + 2] + v[i * 4 + 3];
    }
    float mu = wsum(s) * (1.0f / 2048.0f);
    float q = 0.f;
#pragma unroll
    for (int i = 0; i < 32; ++i) {
      v[i] -= mu;
      q += v[i] * v[i];
    }
    float inv = rsqrtf(wsum(q) * (1.0f / 2048.0f) + 1e-5f);
#pragma unroll
    for (int i = 0; i < 8; ++i) {
      float4 gg = ((const float4*)g)[i * 64 + lane], bb = ((const float4*)bta)[i * 64 + lane];
      float4 y;
      y.x = v[i * 4 + 0] * inv * gg.x + bb.x;
      y.y = v[i * 4 + 1] * inv * gg.y + bb.y;
      y.z = v[i * 4 + 2] * inv * gg.z + bb.z;
      y.w = v[i * 4 + 3] * inv * gg.w + bb.w;
      xr[i * 64 + lane] = y;
      uint2 o;
      o.x = pack2(y.x, y.y);
      o.y = pack2(y.z, y.w);
      ((uint2*)(XB + (size_t)row * 2048))[i * 64 + lane] = o;
    }
  }
}

typedef __attribute__((ext_vector_type(2))) __bf16 bf2_t;
typedef __attribute__((ext_vector_type(2))) float f32x2;
DEVI float dot2bf(unsigned a, unsigned b, float acc) {
  return __builtin_amdgcn_fdot2_f32_bf16(__builtin_bit_cast(bf2_t, a), __builtin_bit_cast(bf2_t, b), acc, false);
}
template <int CTRL>
DEVI int dppi(int v) {
  return __builtin_amdgcn_update_dpp(v, v, CTRL, 0xF, 0xF, false);
}
DEVI int wmax_i(int v) {
  v = max(v, dppi<0xB1>(v));
  v = max(v, dppi<0x4E>(v));
  v = max(v, dppi<0x141>(v));
  v = max(v, dppi<0x140>(v));
  int a = __builtin_amdgcn_readlane(v, 0), b = __builtin_amdgcn_readlane(v, 16);
  int c = __builtin_amdgcn_readlane(v, 32), d = __builtin_amdgcn_readlane(v, 48);
  return max(max(a, b), max(c, d));
}
DEVI float rlf(float v, int l) { return __int_as_float(__builtin_amdgcn_readlane(__float_as_int(v), l)); }
DEVI float wsum_u(float v) {
  v = red16(v);
  return (rlf(v, 0) + rlf(v, 16)) + (rlf(v, 32) + rlf(v, 48));
}
DEVI int fkey(float f) {
  int u = __float_as_int(f);
  return u ^ ((u >> 31) & 0x7fffffff);
}
DEVI float keyf(int k) { return __int_as_float(k ^ ((k >> 31) & 0x7fffffff)); }

DEVI void conv_fp8_rows(const float* __restrict__ src, unsigned char* __restrict__ dst, float* __restrict__ scales) {
  const int lane = threadIdx.x & 63;
  const int gw = blockIdx.x * 8 + (threadIdx.x >> 6), nw = gridDim.x * 8;
  for (int e = gw; e < 16384; e += nw) {
    const float* r = src + (size_t)e * 2048;
    float4 v[8];
    float am = 0.f;
#pragma unroll
    for (int q = 0; q < 8; ++q) {
      v[q] = *(const float4*)(r + (q >> 2) * 1024 + lane * 16 + (q & 3) * 4);
      am = fmaxf(am, fmaxf(fmaxf(fabsf(v[q].x), fabsf(v[q].y)), fmaxf(fabsf(v[q].z), fabsf(v[q].w))));
    }
    float amax = __int_as_float(wmax_i(__float_as_int(am)));
    float inv = (amax > 0.f) ? (440.0f / amax) : 0.f;
    float scale = (amax > 0.f) ? (amax * (1.0f / 440.0f)) : 1.0f;
#pragma unroll
    for (int j = 0; j < 2; ++j) {
      u32x4 o;
#pragma unroll
      for (int k = 0; k < 4; ++k) {
        float4 t = v[j * 4 + k];
        int pk = 0;
        pk = __builtin_amdgcn_cvt_pk_fp8_f32(t.x * inv, t.y * inv, pk, false);
        pk = __builtin_amdgcn_cvt_pk_fp8_f32(t.z * inv, t.w * inv, pk, true);
        o[k] = (unsigned)pk;
      }
      *(u32x4*)(dst + (size_t)e * 2048 + j * 1024 + lane * 16) = o;
    }
    if (lane == 0) scales[e] = scale;
  }
}

DEVI void phase_peer(const Params& p, int layer, bool final_out) {
  char* ws = p.ws;
  const float* SC = (const float*)(ws + OFF_GOUT);
  float* XF = (float*)(ws + OFF_XF);
  u16* XB = (u16*)(ws + OFF_XB);
  const unsigned char* UB = (const unsigned char*)(ws + OFF_UB);
  const unsigned char* VB = (const unsigned char*)(ws + OFF_VB);
  const float* USC = (const float*)(ws + OFF_USC);
  const float* VSC = (const float*)(ws + OFF_VSC);
  const float* g = p.in[I_LNG] + (size_t)(layer * 2 + 1) * D;
  const float* bta = p.in[I_LNB] + (size_t)(layer * 2 + 1) * D;
  const int lane = threadIdx.x & 63;
  const int gw = blockIdx.x * 8 + (threadIdx.x >> 6), nw = gridDim.x * 8;
  constexpr int KMIN = (int)0x80000000;
  for (int row = gw; row < M; row += nw) {
    const float* sr = SC + (size_t)row * 2048;
    int eidx0 = 0, eidx1 = 0;
    float gate0 = 0.f, gate1 = 0.f;
#pragma unroll 1
    for (int h = 0; h < 8; ++h) {
      const float* sp = sr + h * 256;
      int ka0 = (fkey(sp[lane]) & ~127) | (127 - lane);
      int kb0 = (fkey(sp[lane + 64]) & ~127) | (63 - lane);
      int ka1 = (fkey(sp[128 + lane]) & ~127) | (127 - lane);
      int kb1 = (fkey(sp[192 + lane]) & ~127) | (63 - lane);
      int my0 = KMIN, my1 = KMIN;
#pragma unroll 1
      for (int r = 0; r < 16; ++r) {
        int K0 = wmax_i(max(ka0, kb0));
        int K1 = wmax_i(max(ka1, kb1));
        my0 = (lane == r) ? K0 : my0;
        my1 = (lane == r) ? K1 : my1;
        ka0 = (ka0 == K0) ? KMIN : ka0;
        kb0 = (kb0 == K0) ? KMIN : kb0;
        ka1 = (ka1 == K1) ? KMIN : ka1;
        kb1 = (kb1 == K1) ? KMIN : kb1;
      }
      float ts0 = keyf(my0 & ~127), ts1 = keyf(my1 & ~127);
      int ti0 = 127 - (my0 & 127), ti1 = 127 - (my1 & 127);
      float s0 = __shfl(ts0, lane >> 2, 64);
      int jb = (lane & 3) * 4;
      int c0 = (fkey(s0 + __shfl(ts1, jb + 0, 64)) & ~255) | (255 - (lane * 4 + 0));
      int c1 = (fkey(s0 + __shfl(ts1, jb + 1, 64)) & ~255) | (255 - (lane * 4 + 1));
      int c2 = (fkey(s0 + __shfl(ts1, jb + 2, 64)) & ~255) | (255 - (lane * 4 + 2));
      int c3 = (fkey(s0 + __shfl(ts1, jb + 3, 64)) & ~255) | (255 - (lane * 4 + 3));
      int myk = KMIN;
#pragma unroll 1
      for (int r = 0; r < 16; ++r) {
        int K = wmax_i(max(max(c0, c1), max(c2, c3)));
        myk = (lane == r) ? K : myk;
        c0 = (c0 == K) ? KMIN : c0;
        c1 = (c1 == K) ? KMIN : c1;
        c2 = (c2 == K) ? KMIN : c2;
        c3 = (c3 == K) ? KMIN : c3;
      }
      float bs = keyf(myk & ~255);
      int bf = 255 - (myk & 255);
      int e = __shfl(ti0, (bf >> 4) & 15, 64) * 128 + __shfl(ti1, bf & 15, 64);
      float mx = rlf(bs, 0);
      float ev = (lane < 16) ? expf(bs - mx) : 0.f;
      float sm = wsum_u(ev);
      float gt = ev / sm;
      int e_b = __shfl(e, lane & 15, 64);
      float g_b = __shfl(gt, lane & 15, 64);
      if ((lane >> 4) == (h & 3)) {
        if (h < 4) {
          eidx0 = e_b;
          gate0 = g_b;
        } else {
          eidx1 = e_b;
          gate1 = g_b;
        }
      }
    }
    float dv0 = 0.f, dv1 = 0.f;
    {
      float xf[32];
      {
        const float4* xr = (const float4*)(XF + (size_t)row * 2048);
#pragma unroll
        for (int q = 0; q < 8; ++q) {
          float4 t = xr[(q >> 2) * 256 + lane * 4 + (q & 3)];
          xf[q * 4 + 0] = t.x; xf[q * 4 + 1] = t.y; xf[q * 4 + 2] = t.z; xf[q * 4 + 3] = t.w;
        }
      }
      constexpr int R = 8;
      u32x4 w[R][2];
      float sc[R];
      auto load_row = [&](int pidx, u32x4(&wr)[2], float& scv) {
        int src = (pidx < 64) ? eidx0 : eidx1;
        int e = __builtin_amdgcn_readlane(src, pidx & 63);
        const u32x4* ur = (const u32x4*)(UB + (size_t)e * 2048);
        wr[0] = ur[lane];
        wr[1] = ur[64 + lane];
        scv = USC[e];
      };
#pragma unroll
      for (int u = 0; u < R; ++u) load_row(u, w[u], sc[u]);
#pragma unroll 1
      for (int p0 = 0; p0 < 128; p0 += R) {
#pragma unroll
        for (int u = 0; u < R; ++u) {
          float d = 0.f;
#pragma unroll
          for (int j = 0; j < 2; ++j) {
#pragma unroll
            for (int k = 0; k < 4; ++k) {
              int dw = (int)w[u][j][k];
              f32x2 lo = __builtin_amdgcn_cvt_pk_f32_fp8(dw, false);
              f32x2 hi = __builtin_amdgcn_cvt_pk_f32_fp8(dw, true);
              d += lo.x * xf[j * 16 + k * 4 + 0];
              d += lo.y * xf[j * 16 + k * 4 + 1];
              d += hi.x * xf[j * 16 + k * 4 + 2];
              d += hi.y * xf[j * 16 + k * 4 + 3];
            }
          }
          float scu = sc[u];
          if (p0 + R < 128) load_row(p0 + R + u, w[u], sc[u]);
          d = wsum_u(d) * scu;
          int pl = (p0 + u) & 63;
          if (p0 < 64) dv0 = (lane == pl) ? d : dv0;
          else dv1 = (lane == pl) ? d : dv1;
          __builtin_amdgcn_sched_barrier(0);
        }
      }
    }
    float coef0 = 0.5f * dv0 * (1.0f + erff(dv0 * 0.70710678118f)) * gate0;
    float coef1 = 0.5f * dv1 * (1.0f + erff(dv1 * 0.70710678118f)) * gate1;
    f32x2 o2[16];
#pragma unroll
    for (int i = 0; i < 16; ++i) o2[i] = f32x2{0.f, 0.f};
    {
      constexpr int R = 8;
      u32x4 w[R][2];
      float sc[R];
      auto load_row = [&](int pidx, u32x4(&wr)[2], float& scv) {
        int src = (pidx < 64) ? eidx0 : eidx1;
        int e = __builtin_amdgcn_readlane(src, pidx & 63);
        const u32x4* vr = (const u32x4*)(VB + (size_t)e * 2048);
        wr[0] = vr[lane];
        wr[1] = vr[64 + lane];
        scv = VSC[e];
      };
#pragma unroll
      for (int u = 0; u < R; ++u) load_row(u, w[u], sc[u]);
#pragma unroll 1
      for (int p0 = 0; p0 < 128; p0 += R) {
        float cfs = (p0 < 64) ? coef0 : coef1;
#pragma unroll
        for (int u = 0; u < R; ++u) {
          float c = rlf(cfs, (p0 + u) & 63) * sc[u];
          f32x2 cc = f32x2{c, c};
#pragma unroll
          for (int j = 0; j < 2; ++j) {
#pragma unroll
            for (int k = 0; k < 4; ++k) {
              int dw = (int)w[u][j][k];
              o2[j * 8 + k * 2 + 0] += cc * __builtin_amdgcn_cvt_pk_f32_fp8(dw, false);
              o2[j * 8 + k * 2 + 1] += cc * __builtin_amdgcn_cvt_pk_f32_fp8(dw, true);
            }
          }
          if (p0 + R < 128) load_row(p0 + R + u, w[u], sc[u]);
          __builtin_amdgcn_sched_barrier(0);
        }
      }
    }
    float o[32];
#pragma unroll
    for (int i = 0; i < 16; ++i) {
      o[2 * i] = o2[i].x;
      o[2 * i + 1] = o2[i].y;
    }
    float s = 0.f;
    {
      const float4* xr = (const float4*)(XF + (size_t)row * 2048);
#pragma unroll
      for (int q = 0; q < 8; ++q) {
        float4 t = xr[(q >> 2) * 256 + lane * 4 + (q & 3)];
        o[q * 4 + 0] += ALPHA * t.x; o[q * 4 + 1] += ALPHA * t.y; o[q * 4 + 2] += ALPHA * t.z; o[q * 4 + 3] += ALPHA * t.w;
      }
#pragma unroll
      for (int i = 0; i < 32; ++i) s += o[i];
    }
    float mu = wsum_u(s) * (1.0f / 2048.0f);
    float q = 0.f;
#pragma unroll
    for (int i = 0; i < 32; ++i) {
      o[i] -= mu;
      q += o[i] * o[i];
    }
    float inv = rsqrtf(wsum_u(q) * (1.0f / 2048.0f) + 1e-5f);
    float* dstf;
    if (final_out) {
      if (row < MPR) {
        int b = row / TP, t = row % TP;
        dstf = (t >= 16) ? (p.out + O_YP + ((size_t)b * 2048 + (t - 16)) * D) : nullptr;
      } else {
        dstf = p.out + O_YS + (size_t)(row - MPR) * D;
      }
    } else {
      dstf = XF + (size_t)row * 2048;
    }
#pragma unroll
    for (int j = 0; j < 2; ++j) {
      float yv[16];
#pragma unroll
      for (int k = 0; k < 4; ++k) {
        float4 gv = *(const float4*)(g + j * 1024 + lane * 16 + k * 4);
        float4 bv = *(const float4*)(bta + j * 1024 + lane * 16 + k * 4);
        float4 y;
        y.x = o[j * 16 + k * 4 + 0] * inv * gv.x + bv.x;
        y.y = o[j * 16 + k * 4 + 1] * inv * gv.y + bv.y;
        y.z = o[j * 16 + k * 4 + 2] * inv * gv.z + bv.z;
        y.w = o[j * 16 + k * 4 + 3] * inv * gv.w + bv.w;
        if (dstf) *(float4*)(dstf + j * 1024 + lane * 16 + k * 4) = y;
        yv[k * 4 + 0] = y.x; yv[k * 4 + 1] = y.y; yv[k * 4 + 2] = y.z; yv[k * 4 + 3] = y.w;
      }
      if (!final_out) {
        uint4* xb = (uint4*)(XB + (size_t)row * 2048 + j * 1024 + lane * 16);
        xb[0] = make_uint4(pack2(yv[0], yv[1]), pack2(yv[2], yv[3]), pack2(yv[4], yv[5]), pack2(yv[6], yv[7]));
        xb[1] = make_uint4(pack2(yv[8], yv[9]), pack2(yv[10], yv[11]), pack2(yv[12], yv[13]), pack2(yv[14], yv[15]));
      }
    }
  }
}

DEVI float4 f4mul(float4 a, float4 b) { return make_float4(a.x * b.x, a.y * b.y, a.z * b.z, a.w * b.w); }
DEVI void row_info(int row, bool& prompt, int& b, int& t, int& T) {
  prompt = row < MPR;
  if (prompt) { b = row / TP; t = row - b * TP; T = TP; }
  else { b = (row - MPR) >> 2; t = (row - MPR) & 3; T = 4; }
}
DEVI void phase_pre1(const Params& p) {
  char* ws = p.ws;
  const float* PROJ = (const float*)(ws + OFF_PROJ);
  float* XC = (float*)(ws + OFF_GOUT);
  float* RKV = (float*)(ws + OFF_RKV);
  u16* LRA = (u16*)(ws + OFF_LRA);
  u16* LRB = (u16*)(ws + OFF_LRB);
  u16* LRG = (u16*)(ws + OFF_LRG);
  const float* cw = p.in[I_CVW];
  const float* cbias = p.in[I_CVB];
  const float* mu = p.in[I_MU];
  const int gtid = blockIdx.x * 512 + threadIdx.x, nthr = gridDim.x * 512;
#pragma unroll 2
  for (int idx = gtid; idx < M * 384; idx += nthr) {
    int row = idx / 384, c = (idx - row * 384) * 4;
    bool prompt; int b, t, T;
    row_info(row, prompt, b, t, T);
    float4 xv[4];
#pragma unroll
    for (int jj = 0; jj < 4; ++jj) {
      int tt = t - 3 + jj;
      if (tt >= 0) xv[jj] = ld4(PROJ + (size_t)(row - 3 + jj) * N1 + 1024 + c);
      else if (prompt) xv[jj] = make_float4(0.f, 0.f, 0.f, 0.f);
      else xv[jj] = ld4(p.in[I_SCV] + (size_t)(b * 3 + (tt + 3)) * 1536 + c);
    }
    float4 acc = ld4(cbias + c);
#pragma unroll
    for (int jj = 0; jj < 4; ++jj) {
      float4 w = ld4(cw + jj * 1536 + c);
      acc.x += xv[jj].x * w.x; acc.y += xv[jj].y * w.y; acc.z += xv[jj].z * w.z; acc.w += xv[jj].w * w.w;
    }
    *(float4*)(XC + (size_t)row * 1536 + c) = make_float4(siluf_(acc.x), siluf_(acc.y), siluf_(acc.z), siluf_(acc.w));
    if (t >= T - 3) {
      float* co = prompt ? (p.out + O_CVP) : (p.out + O_CVS);
      *(float4*)(co + (size_t)(b * 3 + (t - (T - 3))) * 1536 + c) = xv[3];
    }
  }
#pragma unroll 2
  for (int idx = gtid; idx < M * 840; idx += nthr) {
    int row = idx / 840, c = (idx - row * 840) * 4;
    bool prompt; int b, t, T;
    row_info(row, prompt, b, t, T);
    float4 cur = ld4(PROJ + (size_t)row * N1 + 2560 + c);
    float4 prev;
    if (t > 0) prev = ld4(PROJ + (size_t)(row - 1) * N1 + 2560 + c);
    else if (prompt) prev = make_float4(0.f, 0.f, 0.f, 0.f);
    else prev = ld4(p.in[I_SSH] + (size_t)b * 3360 + c);
    float4 m4 = ld4(mu + c);
    float4 mx;
    mx.x = cur.x + (prev.x - cur.x) * m4.x; mx.y = cur.y + (prev.y - cur.y) * m4.y;
    mx.z = cur.z + (prev.z - cur.z) * m4.z; mx.w = cur.w + (prev.w - cur.w) * m4.w;
    if (c < 3072) *(float4*)(RKV + (size_t)row * 3072 + c) = mx;
    else if (c < 3136) st_bf4(LRA + (size_t)row * 64 + (c - 3072), tanhf(mx.x), tanhf(mx.y), tanhf(mx.z), tanhf(mx.w));
    else if (c < 3200) st_bf4(LRB + (size_t)row * 64 + (c - 3136), mx.x, mx.y, mx.z, mx.w);
    else st_bf4(LRG + (size_t)row * 192 + (c - 3200), sigmoidf_(mx.x), sigmoidf_(mx.y), sigmoidf_(mx.z), sigmoidf_(mx.w));
    if (t == T - 1) {
      float* so = prompt ? (p.out + O_SHP) : (p.out + O_SHS);
      *(float4*)(so + (size_t)b * 3360 + c) = cur;
    }
  }
  for (int idx = gtid; idx < M * 4; idx += nthr) {
    int row = idx >> 2, k = idx & 3;
    ((uint4*)(LRG + (size_t)row * 192 + 160))[k] = make_uint4(0, 0, 0, 0);
  }
}

DEVI void phase_pre1c(const Params& p) {
  char* ws = p.ws;
  float* RKV = (float*)(ws + OFF_RKV);
  const float* AA = (const float*)(ws + OFF_AA);
  float* KK = (float*)(ws + OFF_QB);
  float* KKA = (float*)(ws + OFF_MIXB);
  float* BON = (float*)(ws + OFF_BON);
  const float* k_k = p.in[I_KK];
  const float* k_a = p.in[I_KA];
  const float* r_k = p.in[I_RK];
  const int lane = threadIdx.x & 63;
  const int gw = blockIdx.x * 8 + (threadIdx.x >> 6), nw = gridDim.x * 8;
  for (int row = gw; row < M; row += nw) {
    float4 k4[4], r4[4], a4[4];
#pragma unroll
    for (int it = 0; it < 4; ++it) {
      int c = it * 256 + lane * 4;
      k4[it] = ld4(RKV + (size_t)row * 3072 + 1024 + c);
      r4[it] = ld4(RKV + (size_t)row * 3072 + c);
      a4[it] = ld4(AA + (size_t)row * 1024 + c);
    }
#pragma unroll
    for (int it = 0; it < 4; ++it) {
      int c = it * 256 + lane * 4;
      float4 kk4 = ld4(k_k + c), ka4 = ld4(k_a + c), rk4 = ld4(r_k + c);
      float4 k = k4[it], r = r4[it], a = a4[it];
      float4 kr = f4mul(k, kk4);
      float ss = red16(kr.x * kr.x + kr.y * kr.y + kr.z * kr.z + kr.w * kr.w);
      float inv = 1.0f / fmaxf(sqrtf(ss), 1e-12f);
      float4 kk = make_float4(kr.x * inv, kr.y * inv, kr.z * inv, kr.w * inv);
      float4 kp;
      kp.x = k.x * (1.0f + (a.x - 1.0f) * ka4.x); kp.y = k.y * (1.0f + (a.y - 1.0f) * ka4.y);
      kp.z = k.z * (1.0f + (a.z - 1.0f) * ka4.z); kp.w = k.w * (1.0f + (a.w - 1.0f) * ka4.w);
      float bon = red16(r.x * kp.x * rk4.x + r.y * kp.y * rk4.y + r.z * kp.z * rk4.z + r.w * kp.w * rk4.w);
      *(float4*)(KK + (size_t)row * 1024 + c) = kk;
      *(float4*)(KKA + (size_t)row * 1024 + c) = f4mul(kk, a);
      *(float4*)(RKV + (size_t)row * 3072 + 1024 + c) = kp;
      if ((lane & 15) == 0) BON[(size_t)row * 16 + it * 4 + (lane >> 4)] = bon;
    }
  }
}

DEVI void rwkv_short(const float* __restrict__ RKV, const float* __restrict__ DEC, const float* __restrict__ KK,
                     const float* __restrict__ KKA, int h, int rb, int row0, const float* __restrict__ stin,
                     float* __restrict__ stout, float* __restrict__ outp) {
  const int tid = threadIdx.x & 255, w = tid >> 6, lane = tid & 63, rl = lane >> 4, sl = lane & 15;
  const int il = w * 4 + rl;
  float4 sv = *(const float4*)(stin + il * 64 + sl * 4);
  float S[4] = {sv.x, sv.y, sv.z, sv.w};
  float4 r4[4], w4[4], k4[4], n4[4], m4[4];
  float vi[4];
#pragma unroll
  for (int t = 0; t < 4; ++t) {
    const size_t row = (size_t)(row0 + t);
    r4[t] = *(const float4*)(RKV + row * 3072 + h * 64 + sl * 4);
    w4[t] = *(const float4*)(DEC + row * 1024 + h * 64 + sl * 4);
    k4[t] = *(const float4*)(RKV + row * 3072 + 1024 + h * 64 + sl * 4);
    n4[t] = *(const float4*)(KK + row * 1024 + h * 64 + sl * 4);
    m4[t] = *(const float4*)(KKA + row * 1024 + h * 64 + sl * 4);
    vi[t] = RKV[row * 3072 + 2048 + h * 64 + rb * 16 + il];
  }
#pragma unroll
  for (int t = 0; t < 4; ++t) {
    float sa = S[0] * n4[t].x + S[1] * n4[t].y + S[2] * n4[t].z + S[3] * n4[t].w;
    sa = -red16(sa);
    S[0] = S[0] * w4[t].x + sa * m4[t].x + vi[t] * k4[t].x;
    S[1] = S[1] * w4[t].y + sa * m4[t].y + vi[t] * k4[t].y;
    S[2] = S[2] * w4[t].z + sa * m4[t].z + vi[t] * k4[t].z;
    S[3] = S[3] * w4[t].w + sa * m4[t].w + vi[t] * k4[t].w;
    float y = S[0] * r4[t].x + S[1] * r4[t].y + S[2] * r4[t].z + S[3] * r4[t].w;
    y = red16(y);
    if (sl == 0) outp[(size_t)t * 2048 + il] = y;
  }
  *(float4*)(stout + il * 64 + sl * 4) = make_float4(S[0], S[1], S[2], S[3]);
}

DEVI void phase_rec1(const Params& p, float* smem) {
  char* ws = p.ws;
  const float* XC = (const float*)(ws + OFF_GOUT);
  const float* RKV = (const float*)(ws + OFF_RKV);
  const float* DEC = (const float*)(ws + OFF_DEC);
  const float* KK = (const float*)(ws + OFF_QB);
  const float* KKA = (const float*)(ws + OFF_MIXB);
  const float* DTA = (const float*)(ws + OFF_DTA);
  float* OMIX = (float*)(ws + OFF_OMIX);
  const float* wsf = (const float*)ws;
  constexpr int XO = (int)(OFF_GOUT / 4), DO = (int)(OFF_DTA / 4), RO = (int)(OFF_RKV / 4), CO = (int)(OFF_DEC / 4),
                KO = (int)(OFF_QB / 4), AO = (int)(OFF_MIXB / 4);
  const int half = threadIdx.x >> 8;
  for (int li = blockIdx.x; li < 256; li += gridDim.x) {
    if (half == 0) {
      int b = li >> 6, h = (li >> 2) & 15, cb = li & 3;
      int g = h >> 3;
      Seg sg[4] = {{XO + 1024 + g * 128, 1536, 32}, {XO + 1280 + g * 128, 1536, 32}, {XO + h * 64 + cb * 16, 1536, 4},
                   {DO + h * 4, 64, 1}};
      int row0 = b * TP;
      colrec_long<2>(wsf, sg, row0, TP, 0.f, OMIX + (size_t)row0 * 2048 + h * 64 + cb * 16, 2048,
                     p.out + O_SSP + (size_t)(b * 16 + h) * 128 * 64 + cb * 16, 64, smem);
    } else {
      int b = li >> 6, h = (li >> 2) & 15, rb = li & 3;
      int row0 = b * TP;
      Seg sg[6] = {{RO + h * 64, 3072, 16}, {CO + h * 64, 1024, 16}, {RO + 1024 + h * 64, 3072, 16},
                   {KO + h * 64, 1024, 16}, {AO + h * 64, 1024, 16}, {RO + 2048 + h * 64 + rb * 16, 3072, 4}};
      size_t so = ((size_t)(b * 16 + h) * 64 + rb * 16) * 64;
      rwkv_item(wsf, sg, row0, TP, nullptr, p.out + O_WKP + so, OMIX + (size_t)row0 * 2048 + 1024 + h * 64 + rb * 16, 2048, smem);
    }
  }
  for (int it = blockIdx.x * 2 + half; it < 2048; it += gridDim.x * 2) {
    int b = it >> 4, h = it & 15;
    int g = h >> 3;
    long row0 = MPR + (long)b * 4;
    size_t so = (size_t)(b * 16 + h) * 128 * 64;
    colrec_short<2>(XC + 1024 + g * 128, 1536, XC + 1280 + g * 128, 1536, XC + h * 64, 1536, DTA + h * 4, row0, 0.f,
                    p.in[I_SSM] + so, p.out + O_SSS + so, 64, OMIX + h * 64, 2048, smem);
  }
  for (int it = blockIdx.x * 2 + half; it < 8192; it += gridDim.x * 2) {
    int b = it >> 6, h = (it >> 2) & 15, rb = it & 3;
    int row0 = MPR + b * 4;
    size_t so = ((size_t)(b * 16 + h) * 64 + rb * 16) * 64;
    rwkv_short(RKV, DEC, KK, KKA, h, rb, row0, p.in[I_SWK] + so, p.out + O_WKS + so,
               OMIX + (size_t)row0 * 2048 + 1024 + h * 64 + rb * 16);
  }
}

DEVI void phase_post1(const Params& p) {
  char* ws = p.ws;
  const float* PROJ = (const float*)(ws + OFF_PROJ);
  const float* OMIX = (const float*)(ws + OFF_OMIX);
  const float* XC = (const float*)(ws + OFF_GOUT);
  const float* RKV = (const float*)(ws + OFF_RKV);
  const float* GG = (const float*)(ws + OFF_GG);
  const float* BON = (const float*)(ws + OFF_BON);
  u16* MIXB = (u16*)(ws + OFF_MIXB);
  const float* dsk = p.in[I_DSK];
  const float* sng = p.in[I_SNG];
  const float* lxg = p.in[I_LXG];
  const float* lxb = p.in[I_LXB];
  const int lane = threadIdx.x & 63;
  const int gw = blockIdx.x * 8 + (threadIdx.x >> 6), nw = gridDim.x * 8;
  for (int row = gw; row < M; row += nw) {
    const float* o = OMIX + (size_t)row * 2048;
    u16* mo = MIXB + (size_t)row * 2048;
    float4 oc[4], xc[4], z[4], y[4], v[4], gg[4];
    float bn[4];
#pragma unroll
    for (int it = 0; it < 4; ++it) {
      int c = it * 256 + lane * 4;
      oc[it] = ld4(o + c);
      xc[it] = ld4(XC + (size_t)row * 1536 + c);
      z[it] = ld4(PROJ + (size_t)row * N1 + c);
      y[it] = ld4(o + 1024 + c);
      v[it] = ld4(RKV + (size_t)row * 3072 + 2048 + c);
      gg[it] = ld4(GG + (size_t)row * 1024 + c);
      bn[it] = BON[(size_t)row * 16 + it * 4 + (lane >> 4)];
    }
    float4 val[4];
    float ssq[4];
#pragma unroll
    for (int it = 0; it < 4; ++it) {
      float ds = dsk[it * 4 + (lane >> 4)];
      val[it].x = (oc[it].x + xc[it].x * ds) * z[it].x;
      val[it].y = (oc[it].y + xc[it].y * ds) * z[it].y;
      val[it].z = (oc[it].z + xc[it].z * ds) * z[it].z;
      val[it].w = (oc[it].w + xc[it].w * ds) * z[it].w;
      ssq[it] = val[it].x * val[it].x + val[it].y * val[it].y + val[it].z * val[it].z + val[it].w * val[it].w;
    }
    float inv0 = rsqrtf(wsum_u_(ssq[0] + ssq[1]) * (1.0f / 512.0f) + 1e-6f);
    float inv1 = rsqrtf(wsum_u_(ssq[2] + ssq[3]) * (1.0f / 512.0f) + 1e-6f);
#pragma unroll
    for (int it = 0; it < 4; ++it) {
      int c = it * 256 + lane * 4;
      float inv = (it < 2) ? inv0 : inv1;
      float4 sg = ld4(sng + c);
      st_bf4(mo + c, val[it].x * inv * sg.x, val[it].y * inv * sg.y, val[it].z * inv * sg.z, val[it].w * inv * sg.w);
      float mu = red16(y[it].x + y[it].y + y[it].z + y[it].w) * (1.0f / 64.0f);
      float dx = y[it].x - mu, dy = y[it].y - mu, dz = y[it].z - mu, dw = y[it].w - mu;
      float var = red16(dx * dx + dy * dy + dz * dz + dw * dw) * (1.0f / 64.0f);
      float iv = rsqrtf(var + 64e-5f);
      float4 lg = ld4(lxg + c), lb = ld4(lxb + c);
      float y0 = (dx * iv * lg.x + lb.x + bn[it] * v[it].x) * gg[it].x;
      float y1 = (dy * iv * lg.y + lb.y + bn[it] * v[it].y) * gg[it].y;
      float y2 = (dz * iv * lg.z + lb.z + bn[it] * v[it].z) * gg[it].z;
      float y3 = (dw * iv * lg.w + lb.w + bn[it] * v[it].w) * gg[it].w;
      st_bf4(mo + 1024 + c, y0, y1, y2, y3);
    }
  }
}

#define XB_TMO      128
#define XB_XCNT(j)  (256  + 64 * (j))
#define XB_XSUB(j)  (1280 + 64 * (j))
#define XB_XGEN(j)  (2304 + 64 * (j))
#define XB_TOP      3328
#define XB_TOPGEN   3392
#define XCD_BAR_WORDS 3456
#define XB_SPIN_CAP (1u << 18)
#define LAS __attribute__((address_space(3)))

__device__ __forceinline__ unsigned xb_ld(unsigned* p)              { return __hip_atomic_load(p, __ATOMIC_RELAXED, __HIP_MEMORY_SCOPE_AGENT); }
__device__ __forceinline__ unsigned xb_add(unsigned* p, unsigned v) { return __hip_atomic_fetch_add(p, v, __ATOMIC_RELAXED, __HIP_MEMORY_SCOPE_AGENT); }
__device__ __forceinline__ unsigned xb_xcc_id() { return (unsigned)__builtin_amdgcn_s_getreg((3 << 11) | 20) & 0xFu; }
#define XB_SPIN(cond, bar) do { unsigned _sp = 0; while (cond) { __builtin_amdgcn_s_sleep(1); \
    if ((++_sp & 255u) == 0u) { if (xb_ld(&(bar)[XB_TMO])) break; if (_sp > XB_SPIN_CAP) { atomicAdd(&(bar)[XB_TMO], 1u); break; } } } } while (0)

struct XcdBarrier {
    unsigned* bar; unsigned x;
    volatile LAS unsigned* st;
};

__device__ __forceinline__ XcdBarrier xcd_barrier_post(unsigned* bar, volatile LAS unsigned* st) {
    XcdBarrier b; b.bar = bar; b.x = xb_xcc_id(); b.st = st;
    if (threadIdx.x == 0) (void)xb_add(&bar[XB_XCNT(b.x)], 1u);
    return b;
}
__device__ __forceinline__ void xcd_barrier_complete(unsigned* bar, unsigned x, unsigned& nloc, unsigned& nx) {
    const unsigned G = gridDim.x * gridDim.y * gridDim.z;
    unsigned sum, cnt, mine, sp = 0u;
    for (;;) {
        sum = 0u; cnt = 0u; mine = 0u;
#pragma unroll
        for (unsigned j = 0; j < 16; ++j) { const unsigned c = xb_ld(&bar[XB_XCNT(j)]); sum += c; cnt += (c > 0u) ? 1u : 0u; mine = (j == x) ? c : mine; }
        if (sum == G) break;
        __builtin_amdgcn_s_sleep(1);
        if ((++sp & 255u) == 0u) { if (xb_ld(&bar[XB_TMO])) break; if (sp > XB_SPIN_CAP) { atomicAdd(&bar[XB_TMO], 1u); break; } }
    }
    nloc = mine > 0u ? mine : 1u; nx = cnt > 0u ? cnt : 1u;
}

__device__ __forceinline__ void xcd_barrier(const XcdBarrier& b) {
    asm volatile("s_waitcnt vmcnt(0)" ::: "memory");
    __syncthreads();
    if (threadIdx.x == 0) {
        unsigned* bar = b.bar;
        __builtin_amdgcn_s_waitcnt(0);
        unsigned nloc = b.st[0], nx = b.st[1];
        if (nloc == 0u) { xcd_barrier_complete(bar, b.x, nloc, nx); b.st[0] = nloc; b.st[1] = nx; }
        const unsigned old = xb_add(&bar[XB_XSUB(b.x)], 1u);
        const unsigned gen = old / nloc;
        if (old + 1u == (gen + 1u) * nloc) {
            __builtin_amdgcn_fence(__ATOMIC_RELEASE, "agent");
            asm volatile("s_waitcnt vmcnt(0)" ::: "memory");
            const unsigned og = xb_add(&bar[XB_TOP], 1u);
            const unsigned tg = og / nx;
            if (og + 1u == (tg + 1u) * nx) xb_add(&bar[XB_TOPGEN], 1u);
            else XB_SPIN(xb_ld(&bar[XB_TOPGEN]) == tg, bar);
            __builtin_amdgcn_fence(__ATOMIC_ACQUIRE, "agent");
            xb_add(&bar[XB_XGEN(b.x)], 1u);
            asm volatile("s_waitcnt vmcnt(0)" ::: "memory");
        } else {
            XB_SPIN(xb_ld(&bar[XB_XGEN(b.x)]) == gen, bar);
            __builtin_amdgcn_fence(__ATOMIC_ACQUIRE, "agent");
            asm volatile("s_waitcnt vmcnt(0)" ::: "memory");
        }
    }
    __syncthreads();
}


template <int ph>
DEVI void run_phase(const Params& p, char* smem_raw) {
  float* smem = (float*)smem_raw;
  char* ws = p.ws;
  {
    switch (ph) {
      case 0:
        phase0(p, smem);
        conv_fp8_rows(p.in[I_PU], (unsigned char*)(ws + OFF_UB), (float*)(ws + OFF_USC));
        conv_fp8_rows(p.in[I_PV], (unsigned char*)(ws + OFF_VB), (float*)(ws + OFF_VSC));
        break;
      case 1: {
        EpiIn0 E{(float*)(ws + OFF_PROJ), (const float*)(ws + OFF_LB), (const float*)(ws + OFF_INVREV)};
        pg8::Gemm g{(const pg8::bf16_t*)(ws + OFF_XB), (const pg8::bf16_t*)(ws + OFF_WIN0), MP, N0, 2048};
        pg8::StaticOrder S;
        S.init(MP, N0, (int)gridDim.x, (int)blockIdx.x);
        pg8::gemm_phase<EpiIn0, pg8::StaticOrder, false>((PG8_LAS unsigned char*)smem_raw, g, S, E, nullptr);
      } break;
      case 2: phase_rec0(p, smem); break;
      case 3: phase_post0(p); break;
      case 4: case 15: {
        float* GO = (float*)(ws + OFF_GOUT);
        gemm_phase((const u16*)(ws + OFF_MIXB), 2048, 0, (const u16*)(ws + (ph == 4 ? OFF_WOUT0 : OFF_WOUT1)), 2048,
                   69, 16, smem_raw, [=](int row, int col, float v0, float v1) {
                     GO[(size_t)row * 2048 + col] = v0;
                     GO[(size_t)row * 2048 + col + 32] = v1;
                   });
      } break;
      case 5: case 16: {
        int l = (ph == 5) ? 0 : 1;
        phase_ln(p, (const float*)(ws + OFF_GOUT), p.in[I_LNG] + (size_t)(l * 2) * D, p.in[I_LNB] + (size_t)(l * 2) * D);
      } break;
      case 6: case 17: {
        u16* QB = (u16*)(ws + OFF_QB);
        gemm_phase((const u16*)(ws + OFF_XB), 2048, 0, (const u16*)(ws + (ph == 6 ? OFF_WQ0 : OFF_WQ1)), 2048, 69,
                   16, smem_raw, [=](int row, int col, float v0, float v1) {
                     QB[(size_t)row * 2048 + col] = f2bf(v0);
                     QB[(size_t)row * 2048 + col + 32] = f2bf(v1);
                   });
      } break;
      case 7: case 18: {
        float* SC = (float*)(ws + OFF_GOUT);
        gemm_phase((const u16*)(ws + OFF_QB), 2048, 128, (const u16*)(ws + (ph == 7 ? OFF_KEY0 : OFF_KEY1)), 128,
                   69, 16, smem_raw, [=](int row, int col, float v0, float v1) {
                     SC[(size_t)row * 2048 + col] = v0;
                     SC[(size_t)row * 2048 + col + 32] = v1;
                   });
      } break;
      case 8: phase_peer(p, 0, false); break;
      case 9: {
        conv_fp8_rows(p.in[I_PU] + (size_t)16384 * 2048, (unsigned char*)(ws + OFF_UB), (float*)(ws + OFF_USC));
        conv_fp8_rows(p.in[I_PV] + (size_t)16384 * 2048, (unsigned char*)(ws + OFF_VB), (float*)(ws + OFF_VSC));
        EpiIn1 E{(float*)(ws + OFF_PROJ), (float*)(ws + OFF_DTA), p.in[I_DTB], p.in[I_ALOG]};
        pg8::Gemm g{(const pg8::bf16_t*)(ws + OFF_XB), (const pg8::bf16_t*)(ws + OFF_WIN1), MP, N1, 2048};
        pg8::StaticOrder S;
        S.init(MP, N1, (int)gridDim.x, (int)blockIdx.x);
        pg8::gemm_phase<EpiIn1, pg8::StaticOrder, false>((PG8_LAS unsigned char*)smem_raw, g, S, E, nullptr);
      } break;
      case 10: phase_pre1(p); break;
      case 11: {
        float* DEC = (float*)(ws + OFF_DEC);
        float* AA = (float*)(ws + OFF_AA);
        float* GG = (float*)(ws + OFF_GG);
        const float* w0 = p.in[I_W0];
        const float* a0 = p.in[I_A0];
        gemm_phase((const u16*)(ws + OFF_LRA), 64, 0, (const u16*)(ws + OFF_W2T), 64, 69, 8, smem_raw,
                   [=](int row, int col, float v0, float v1) {
#pragma unroll
                     for (int e = 0; e < 2; ++e) {
                       int cc = col + e * 32;
                       float v = (e ? v1 : v0);
                       float wl = -softplusf_(-v) - 0.5f;
                       DEC[(size_t)row * 1024 + cc] = expf(-expf(wl));
                     }
                   }, w0);
        gemm_phase((const u16*)(ws + OFF_LRB), 64, 0, (const u16*)(ws + OFF_A2T), 64, 69, 8, smem_raw,
                   [=](int row, int col, float v0, float v1) {
                     AA[(size_t)row * 1024 + col] = sigmoidf_(v0);
                     AA[(size_t)row * 1024 + col + 32] = sigmoidf_(v1);
                   }, a0);
        gemm_phase((const u16*)(ws + OFF_LRG), 192, 0, (const u16*)(ws + OFF_G2T), 192, 69, 8, smem_raw,
                   [=](int row, int col, float v0, float v1) {
                     GG[(size_t)row * 1024 + col] = v0;
                     GG[(size_t)row * 1024 + col + 32] = v1;
                   });
      } break;
      case 12: phase_pre1c(p); break;
      case 13: phase_rec1(p, smem); break;
      case 14: phase_post1(p); break;
      case 19: phase_peer(p, 1, true); break;
      default: break;
    }
  }
}

__global__ void __launch_bounds__(512, 2) mega(Params p, int ph_lo, int ph_hi) {
  __shared__ __attribute__((aligned(16))) char smem_raw[SMEM_BYTES];
  __shared__ uint4 xb_words;
  cg::grid_group grid = cg::this_grid();
  if (threadIdx.x == 0) xb_words = make_uint4(0u, 0u, 0u, 0u);
  __syncthreads();
  XcdBarrier xb = xcd_barrier_post((unsigned*)(p.ws + OFF_BAR), (volatile LAS unsigned*)&xb_words);
  if (ph_hi > 1000) grid.sync();
#ifndef REPEAT_MASK
#define REPEAT_MASK 0
#endif
#define PHASE(K)                                          \
  if (ph_lo <= K && K < ph_hi) run_phase<K>(p, smem_raw); \
  if ((REPEAT_MASK >> K) & 1) { xcd_barrier(xb); run_phase<K>(p, smem_raw); } \
  if (ph_lo <= K && K + 1 < ph_hi) xcd_barrier(xb);
  PHASE(0) PHASE(1) PHASE(2) PHASE(3) PHASE(4) PHASE(5) PHASE(6) PHASE(7) PHASE(8) PHASE(9)
  PHASE(10) PHASE(11) PHASE(12) PHASE(13) PHASE(14) PHASE(15) PHASE(16) PHASE(17) PHASE(18) PHASE(19)
}
#ifdef PHASE_TEST
template <int PH>
__global__ void __launch_bounds__(512, 2) phk(Params p) {
  __shared__ __attribute__((aligned(16))) char smem_raw[SMEM_BYTES];
  run_phase<PH>(p, smem_raw);
}
#define INST(N) template __global__ void phk<N>(Params);
INST(0) INST(1) INST(2) INST(3) INST(4) INST(5) INST(6) INST(7) INST(8) INST(9) INST(10) INST(11) INST(12) INST(13) INST(14) INST(19)
#endif

constexpr int NPHASE = 20;

extern "C" void kernel_launch(void* const* d_in, const int* in_sizes, int n_in, void* d_out, int out_size, void* d_ws,
                              size_t ws_size, hipStream_t stream) {
  static int grid_blocks = 0;
  if (!grid_blocks) {
    int dev = 0, cus = 0, per_cu = 0;
    hipGetDevice(&dev);
    hipDeviceGetAttribute(&cus, hipDeviceAttributeMultiprocessorCount, dev);
    hipOccupancyMaxActiveBlocksPerMultiprocessor(&per_cu, mega, 512, 0);
    if (per_cu > 1) per_cu = 1;
    if (per_cu < 1) per_cu = 1;
    grid_blocks = cus * per_cu;
  }
  Params p{};
  for (int i = 0; i < 38; ++i) p.in[i] = (const float*)d_in[i];
  p.out = (float*)d_out;
  p.ws = (char*)d_ws;
  (void)hipMemsetAsync((char*)d_ws + OFF_BAR, 0, 3456 * 4, stream);
  int lo = 0, hi = NPHASE;
  void* args[] = {&p, &lo, &hi};
  hipError_t e = hipLaunchCooperativeKernel((void*)mega, dim3(grid_blocks), dim3(512), args, 0, stream);
  if (e != hipSuccess) fprintf(stderr, "cooperative launch failed: %s (grid %d)\n", hipGetErrorString(e), grid_blocks);
}
```

```cpp
#include <hip/hip_runtime.h>
#include <hip/hip_bf16.h>
#include <hip/hip_cooperative_groups.h>
#include <cstdio>
#include <cmath>
namespace cg = cooperative_groups;

#define DEVI __device__ __forceinline__
typedef unsigned short u16;
using bf16x8 = __attribute__((ext_vector_type(8))) short;
using f32x4 = __attribute__((ext_vector_type(4))) float;
using u32x4 = __attribute__((ext_vector_type(4))) unsigned int;

constexpr int D = 2048;
constexpr int TP = 2064;
constexpr int MPR = 8256;
constexpr int M = 8768;
constexpr int MP = 8960;
constexpr int N0 = 7168;
constexpr int N1 = 6144;
constexpr float ALPHA = 1.41421356237f;

constexpr size_t SZ_TAB = (size_t)16384 * 2048 * 2;
constexpr size_t OFF_UB = 0;
constexpr size_t OFF_VB = OFF_UB + SZ_TAB;
constexpr size_t OFF_WIN0 = OFF_VB + SZ_TAB;
constexpr size_t OFF_WOUT0 = OFF_WIN0 + (size_t)N0 * 2048 * 2;
constexpr size_t OFF_WQ0 = OFF_WOUT0 + (size_t)2048 * 2048 * 2;
constexpr size_t OFF_KEY0 = OFF_WQ0 + (size_t)2048 * 2048 * 2;
constexpr size_t OFF_WIN1 = OFF_KEY0 + (size_t)16 * 128 * 128 * 2;
constexpr size_t OFF_WOUT1 = OFF_WIN1 + (size_t)N1 * 2048 * 2;
constexpr size_t OFF_WQ1 = OFF_WOUT1 + (size_t)2048 * 2048 * 2;
constexpr size_t OFF_KEY1 = OFF_WQ1 + (size_t)2048 * 2048 * 2;
constexpr size_t OFF_W2T = OFF_KEY1 + (size_t)16 * 128 * 128 * 2;
constexpr size_t OFF_A2T = OFF_W2T + (size_t)1024 * 64 * 2;
constexpr size_t OFF_G2T = OFF_A2T + (size_t)1024 * 64 * 2;
constexpr size_t OFF_LB = OFF_G2T + (size_t)1024 * 192 * 2;
constexpr size_t OFF_INVREV = OFF_LB + 1024 * 4;
constexpr size_t OFF_XF = OFF_INVREV + 64 * 8;
constexpr size_t OFF_XB = OFF_XF + (size_t)MP * 2048 * 4;
constexpr size_t OFF_PROJ = OFF_XB + (size_t)MP * 2048 * 2;
constexpr size_t OFF_GOUT = OFF_PROJ + (size_t)MP * N0 * 4;
constexpr size_t OFF_OMIX = OFF_GOUT + (size_t)MP * 2048 * 4;
constexpr size_t OFF_MIXB = OFF_OMIX + (size_t)MP * 2048 * 4;
constexpr size_t OFF_QB = OFF_MIXB + (size_t)MP * 2048 * 2;
constexpr size_t OFF_RKV = OFF_QB + (size_t)MP * 2048 * 2;
constexpr size_t OFF_DEC = OFF_RKV + (size_t)MP * 3072 * 4;
constexpr size_t OFF_AA = OFF_DEC + (size_t)MP * 1024 * 4;
constexpr size_t OFF_GG = OFF_AA + (size_t)MP * 1024 * 4;
constexpr size_t OFF_LRA = OFF_GG + (size_t)MP * 1024 * 4;
constexpr size_t OFF_LRB = OFF_LRA + (size_t)MP * 64 * 2;
constexpr size_t OFF_LRG = OFF_LRB + (size_t)MP * 64 * 2;
constexpr size_t OFF_DTA = OFF_LRG + (size_t)MP * 192 * 2;
constexpr size_t OFF_BON = OFF_DTA + (size_t)MP * 64 * 4;
constexpr size_t OFF_USC = OFF_BON + (size_t)MP * 16 * 4;
constexpr size_t OFF_VSC = OFF_USC + 16384 * 4;
constexpr size_t OFF_BAR = OFF_VSC + 16384 * 4;
constexpr size_t WS_TOTAL = OFF_BAR + 3456 * 4;
static_assert(WS_TOTAL <= (size_t)1 << 30, "workspace too large");

constexpr size_t O_YP = 0;
constexpr size_t O_YS = O_YP + (size_t)4 * 2048 * 2048;
constexpr size_t O_HGP = O_YS + (size_t)128 * 4 * 2048;
constexpr size_t O_HGS = O_HGP + (size_t)4 * 8 * 128 * 128;
constexpr size_t O_RTP = O_HGS + (size_t)128 * 8 * 128 * 128;
constexpr size_t O_RTS = O_RTP + (size_t)4 * 4 * 128 * 256;
constexpr size_t O_SSP = O_RTS + (size_t)128 * 4 * 128 * 256;
constexpr size_t O_SSS = O_SSP + (size_t)4 * 16 * 128 * 64;
constexpr size_t O_CVP = O_SSS + (size_t)128 * 16 * 128 * 64;
constexpr size_t O_CVS = O_CVP + (size_t)4 * 3 * 1536;
constexpr size_t O_WKP = O_CVS + (size_t)128 * 3 * 1536;
constexpr size_t O_WKS = O_WKP + (size_t)4 * 16 * 64 * 64;
constexpr size_t O_SHP = O_WKS + (size_t)128 * 16 * 64 * 64;
constexpr size_t O_SHS = O_SHP + (size_t)4 * 3360;

struct Params {
  const float* in[38];
  float* out;
  char* ws;
};
enum { I_XP = 0, I_XS, I_SHG, I_SRT, I_SSM, I_SCV, I_SWK, I_SSH, I_META, I_LNG, I_LNB, I_EWIN, I_LBL, I_HNG, I_EWOUT,
       I_OWIN, I_CVW, I_CVB, I_DTB, I_ALOG, I_DSK, I_SNG, I_MU, I_W0, I_W2, I_A0, I_A2, I_G2, I_KK, I_KA, I_RK,
       I_LXG, I_LXB, I_OWOUT, I_WQ, I_KEYS, I_PU, I_PV };

constexpr int VB_BYTES = 2 * 2 * 128 * 72 * 2;
constexpr int SMEM_BYTES = 2 * VB_BYTES;

DEVI u16 f2bf(float f) {
  unsigned u = __float_as_uint(f);
  u += 0x7fffu + ((u >> 16) & 1u);
  return (u16)(u >> 16);
}
DEVI unsigned pack2(float a, float b) { return (unsigned)f2bf(a) | ((unsigned)f2bf(b) << 16); }
DEVI float bflo(unsigned u) { return __uint_as_float(u << 16); }
DEVI float bfhi(unsigned u) { return __uint_as_float(u & 0xffff0000u); }
DEVI float sigmoidf_(float x) { return __builtin_amdgcn_rcpf(1.0f + __builtin_amdgcn_exp2f(-1.44269504089f * x)); }
DEVI float siluf_(float x) { return x * __builtin_amdgcn_rcpf(1.0f + __builtin_amdgcn_exp2f(-1.44269504089f * x)); }
DEVI float sigmoid_acc(float x) { return 1.0f / (1.0f + expf(-x)); }
DEVI float silu_acc(float x) { return x / (1.0f + expf(-x)); }
DEVI float softplusf_(float x) { return fmaxf(x, 0.0f) + log1pf(expf(-fabsf(x))); }
DEVI float wsum(float v) {
#pragma unroll
  for (int o = 32; o > 0; o >>= 1) v += __shfl_xor(v, o, 64);
  return v;
}
DEVI float wmaxf_(float v) {
#pragma unroll
  for (int o = 32; o > 0; o >>= 1) v = fmaxf(v, __shfl_xor(v, o, 64));
  return v;
}
DEVI int wmini_(int v) {
#pragma unroll
  for (int o = 32; o > 0; o >>= 1) v = min(v, __shfl_xor(v, o, 64));
  return v;
}
template <int CTRL>
DEVI float dppf(float v) {
  return __int_as_float(__builtin_amdgcn_update_dpp(0, __float_as_int(v), CTRL, 0xF, 0xF, true));
}
DEVI float red8(float v) {
  v += dppf<0xB1>(v);
  v += dppf<0x4E>(v);
  v += dppf<0x141>(v);
  return v;
}
DEVI float red16(float v) {
  v = red8(v);
  v += dppf<0x140>(v);
  return v;
}
DEVI float rlf_(float v, int l) { return __int_as_float(__builtin_amdgcn_readlane(__float_as_int(v), l)); }
DEVI int row_pos(int row) { return row < MPR ? (row % TP) : (16384 + ((row - MPR) & 3)); }

DEVI void conv_bf16_flat(const float* __restrict__ src, u16* __restrict__ dst, size_t n4) {
  size_t stride = (size_t)gridDim.x * blockDim.x;
  for (size_t i = (size_t)blockIdx.x * blockDim.x + threadIdx.x; i < n4; i += stride) {
    float4 v = ((const float4*)src)[i];
    uint2 o;
    o.x = pack2(v.x, v.y);
    o.y = pack2(v.z, v.w);
    ((uint2*)dst)[i] = o;
  }
}

template <int MODE>
DEVI int colmap(int j) {
  if (MODE == 0) return j;
  if (MODE == 1) {
    if (j < 4096 || j >= 5120) return j;
    int hb = j & ~127, c = j & 127, wc = c >> 5, n = (c >> 4) & 1, r = c & 15;
    int d = n ? (64 + wc * 16 + r) : (wc * 16 + r);
    return hb + d;
  }
  if (j < 2560) return j;
  if (j < 5920) return j + 16;
  if (j < 5936) return 2560 + (j - 5920);
  return -1;
}

template <int MODE>
DEVI void transpose_job(const float* __restrict__ src, int ldsrc, int Ksrc, u16* __restrict__ dst, int Kdst, int ndst,
                        float* smem) {
  int ktiles = Kdst / 64, ntiles = ndst / 64;
  int tid = threadIdx.x & 255;
  const int half = threadIdx.x >> 8;
  smem += half * (64 * 65);
  for (int base = blockIdx.x * 2; base < ktiles * ntiles; base += gridDim.x * 2) {
    int tile = base + half;
    const bool valid = tile < ktiles * ntiles;
    if (!valid) tile = ktiles * ntiles - 1;
    int tn = tile / ktiles, tk = tile % ktiles;
    int j0 = tn * 64, k0 = tk * 64;
    int jj = (tid & 15) * 4;
    int sc = colmap<MODE>(j0 + jj);
#pragma unroll
    for (int i = 0; i < 4; ++i) {
      int kk = i * 16 + (tid >> 4);
      float4 v = make_float4(0.f, 0.f, 0.f, 0.f);
      if (sc >= 0 && (k0 + kk) < Ksrc) v = *(const float4*)(src + (size_t)(k0 + kk) * ldsrc + sc);
      smem[kk * 65 + jj] = v.x;
      smem[kk * 65 + jj + 1] = v.y;
      smem[kk * 65 + jj + 2] = v.z;
      smem[kk * 65 + jj + 3] = v.w;
    }
    __syncthreads();
    int jr = tid >> 2, kq = (tid & 3) * 16;
    unsigned pk[8];
#pragma unroll
    for (int e = 0; e < 8; ++e) pk[e] = pack2(smem[(kq + 2 * e) * 65 + jr], smem[(kq + 2 * e + 1) * 65 + jr]);
    uint4* dp = (uint4*)(dst + (size_t)(j0 + jr) * Kdst + k0 + kq);
    if (valid) {
      dp[0] = make_uint4(pk[0], pk[1], pk[2], pk[3]);
      dp[1] = make_uint4(pk[4], pk[5], pk[6], pk[7]);
    }
    __syncthreads();
  }
}

DEVI void phase0(const Params& p, float* smem) {
  char* ws = p.ws;
  conv_bf16_flat(p.in[I_KEYS], (u16*)(ws + OFF_KEY0), (size_t)16 * 128 * 128 / 4);
  conv_bf16_flat(p.in[I_KEYS] + (size_t)16 * 128 * 128, (u16*)(ws + OFF_KEY1), (size_t)16 * 128 * 128 / 4);
  transpose_job<1>(p.in[I_EWIN], N0, 2048, (u16*)(ws + OFF_WIN0), 2048, N0, smem);
  transpose_job<0>(p.in[I_EWOUT], 2048, 2048, (u16*)(ws + OFF_WOUT0), 2048, 2048, smem);
  transpose_job<0>(p.in[I_WQ], 2048, 2048, (u16*)(ws + OFF_WQ0), 2048, 2048, smem);
  transpose_job<0>(p.in[I_WQ] + (size_t)2048 * 2048, 2048, 2048, (u16*)(ws + OFF_WQ1), 2048, 2048, smem);
  transpose_job<2>(p.in[I_OWIN], 5936, 2048, (u16*)(ws + OFF_WIN1), 2048, N1, smem);
  transpose_job<0>(p.in[I_OWOUT], 2048, 2048, (u16*)(ws + OFF_WOUT1), 2048, 2048, smem);
  transpose_job<0>(p.in[I_W2], 1024, 64, (u16*)(ws + OFF_W2T), 64, 1024, smem);
  transpose_job<0>(p.in[I_A2], 1024, 64, (u16*)(ws + OFF_A2T), 64, 1024, smem);
  transpose_job<0>(p.in[I_G2], 1024, 160, (u16*)(ws + OFF_G2T), 192, 1024, smem);
  {
    float* XF = (float*)(ws + OFF_XF);
    u16* XB = (u16*)(ws + OFF_XB);
    size_t n4 = (size_t)MP * 512;
    size_t stride = (size_t)gridDim.x * blockDim.x;
    for (size_t i = (size_t)blockIdx.x * blockDim.x + threadIdx.x; i < n4; i += stride) {
      int row = (int)(i >> 9), c4 = (int)(i & 511);
      float4 v = make_float4(0.f, 0.f, 0.f, 0.f);
      if (row < MPR) {
        int b = row / TP, t = row % TP;
        const float* s = (t < 16) ? (p.in[I_META] + (size_t)t * D) : (p.in[I_XP] + ((size_t)b * 2048 + (t - 16)) * D);
        v = ((const float4*)s)[c4];
      } else if (row < M) {
        v = ((const float4*)(p.in[I_XS] + (size_t)(row - MPR) * D))[c4];
      }
      ((float4*)XF)[i] = v;
      uint2 o;
      o.x = pack2(v.x, v.y);
      o.y = pack2(v.z, v.w);
      ((uint2*)XB)[i] = o;
    }
  }
  if (blockIdx.x == 0) {
    float* LB = (float*)(ws + OFF_LB);
    const float* lg = p.in[I_LBL];
    for (int c = threadIdx.x; c < 1024; c += blockDim.x) {
      float a = lg[c], b = lg[1024 + c], d = lg[2048 + c];
      float m = fmaxf(a, fmaxf(b, d));
      float ea = expf(a - m), eb = expf(b - m), ed = expf(d - m);
      LB[c] = ea / (ea + eb + ed);
    }
    float* IR = (float*)(ws + OFF_INVREV);
    if (threadIdx.x < 64) {
      double d = (double)threadIdx.x;
      double v = exp(-d * (9.210340371976184 / 64.0)) * 0.15915494309189535;
      float h = (float)v;
      IR[threadIdx.x * 2] = h;
      IR[threadIdx.x * 2 + 1] = (float)(v - (double)h);
    }
  }
}

constexpr int G_LDS_STRIDE = 72;
constexpr int G_LDS_BUF = 2 * 128 * G_LDS_STRIDE;
template <class Epi>
DEVI void gemm_phase(const u16* __restrict__ A, int lda, int a_ntile_off, const u16* __restrict__ Bt, int K, int mtiles,
                     int ntiles, char* smem, Epi epi, const float* __restrict__ colc = nullptr) {
  const int half = threadIdx.x >> 8;
  u16* S0 = (u16*)(smem + half * VB_BYTES);
  const int tid = threadIdx.x & 255, wid = tid >> 6, lane = tid & 63, wr = wid >> 1, wc = wid & 1, fr = lane & 15, fq = lane >> 4;
  const int nk = K / 64;
  const int ntot = mtiles * ntiles;
  for (int base = blockIdx.x * 2; base < ntot; base += gridDim.x * 2) {
    int tile = base + half;
    const bool valid = tile < ntot;
    if (!valid) tile = ntot - 1;
    const int tm = tile / ntiles, tn = tile - tm * ntiles;
    const int brow = tm * 128, bcol = tn * 128;
    const u16* Ag = A + (size_t)brow * lda + (size_t)tn * a_ntile_off;
    const u16* Bg = Bt + (size_t)bcol * K;
    f32x4 acc[4][4];
#pragma unroll
    for (int m = 0; m < 4; ++m)
#pragma unroll
      for (int n = 0; n < 4; ++n) acc[m][n] = f32x4{0.f, 0.f, 0.f, 0.f};
    u32x4 ra0[4], rb0[4], ra1[4], rb1[4];
    auto gload = [&](int t, u32x4(&ra)[4], u32x4(&rb)[4]) {
#pragma unroll
      for (int i = 0; i < 4; ++i) {
        int c = tid + i * 256, r = c >> 3, kc = c & 7;
        ra[i] = *(const u32x4*)(Ag + (size_t)r * lda + t * 64 + kc * 8);
        rb[i] = *(const u32x4*)(Bg + (size_t)r * K + t * 64 + kc * 8);
      }
    };
    auto lwrite = [&](int buf, const u32x4(&ra)[4], const u32x4(&rb)[4]) {
      u16* SA = S0 + buf * G_LDS_BUF;
      u16* SB = SA + 128 * G_LDS_STRIDE;
#pragma unroll
      for (int i = 0; i < 4; ++i) {
        int c = tid + i * 256, r = c >> 3, kc = c & 7;
        *(u32x4*)(SA + r * G_LDS_STRIDE + kc * 8) = ra[i];
        *(u32x4*)(SB + r * G_LDS_STRIDE + kc * 8) = rb[i];
      }
    };
    auto compute = [&](int buf) {
      const u16* SA = S0 + buf * G_LDS_BUF;
      const u16* SB = SA + 128 * G_LDS_STRIDE;
#pragma unroll
      for (int kh = 0; kh < 2; ++kh) {
        bf16x8 At[4], Bl[4];
#pragma unroll
        for (int m = 0; m < 4; ++m)
          At[m] = *(const bf16x8*)(SA + (wr * 64 + m * 16 + fr) * G_LDS_STRIDE + kh * 32 + fq * 8);
#pragma unroll
        for (int n = 0; n < 4; ++n)
          Bl[n] = *(const bf16x8*)(SB + (wc * 64 + n * 16 + fr) * G_LDS_STRIDE + kh * 32 + fq * 8);
#pragma unroll
        for (int m = 0; m < 4; ++m)
#pragma unroll
          for (int n = 0; n < 4; ++n) acc[m][n] = __builtin_amdgcn_mfma_f32_16x16x32_bf16(At[m], Bl[n], acc[m][n], 0, 0, 0);
        __builtin_amdgcn_sched_barrier(0);
      }
    };
    gload(0, ra0, rb0);
    if (nk > 1) gload(1, ra1, rb1);
    lwrite(0, ra0, rb0);
    __syncthreads();
#pragma unroll 1
    for (int t = 0; t < nk; t += 2) {
      if (t + 2 < nk) gload(t + 2, ra0, rb0);
      compute(0);
      if (t + 1 < nk) lwrite(1, ra1, rb1);
      __syncthreads();
      if (t + 1 < nk) {
        if (t + 3 < nk) gload(t + 3, ra1, rb1);
        compute(1);
        if (t + 2 < nk) lwrite(0, ra0, rb0);
        __syncthreads();
      }
    }
    if (valid) {
      float cc[4] = {0.f, 0.f, 0.f, 0.f};
      if (colc) {
#pragma unroll
        for (int n = 0; n < 4; ++n) cc[n] = colc[bcol + wc * 64 + n * 16 + fr];
      }
#pragma unroll
      for (int m = 0; m < 4; ++m)
#pragma unroll
        for (int n = 0; n < 2; ++n)
#pragma unroll
          for (int j = 0; j < 4; ++j) {
            int row = brow + wr * 64 + m * 16 + fq * 4 + j;
            int col = bcol + wc * 64 + n * 16 + fr;
            epi(row, col, acc[m][n][j] + cc[n], acc[m][n + 2][j] + cc[n + 2]);
          }
    }
  }
}


namespace pg8 {
#define PG8_LAS __attribute__((address_space(3)))
typedef unsigned short bf16_t;
typedef short bf16x8 __attribute__((ext_vector_type(8)));
typedef float f32x4 __attribute__((ext_vector_type(4)));
typedef unsigned u32x4 __attribute__((ext_vector_type(4)));
constexpr int BM = 256, BK = 64, HALF = 128, HTB = HALF * BK * 2  , STAGE_BYTES = 8 * HTB, NXCD = 8, WGM = 8;

__host__ __device__ __forceinline__ int lds_byte(int r, int c) { const int st = (r >> 4) * 2 + (c >> 5), rr = r & 15, cc = c & 31, ob = rr * 64 + cc * 2; return st * 1024 + (ob ^ (((ob >> 9) & 1) << 5)); }
__host__ __device__ __forceinline__ void stage_rc(int b, int& R, int& C) { const int st = b / 1024, sb = b % 1024, swz = sb ^ (((sb >> 9) & 1) << 5); R = (st >> 1) * 16 + swz / 64; C = (st & 1) * 32 + (swz % 64) / 2; }
__host__ __device__ __forceinline__ int perm32(int rho) { const int n = rho >> 4, i = rho & 15; return 8 * (i >> 2) + 4 * n + (i & 3); }

struct Unit { int pm, pn; };
struct Gemm { const bf16_t* A; const bf16_t* Bt; int M, N, K; };

struct StaticOrder {
    int nM, nN, nwg, G, c;
    __host__ __device__ void init(int M, int N, int G_, int c_) { nM = M / BM; nN = N / BM; nwg = nM * nN; G = G_; c = c_; }
    __host__ __device__ bool next(int i, Unit& u) const {
        const long L = (long)i * G + c; if (L >= nwg) return false;
        int wgid = (int)L; { const int q = nwg / NXCD, r = nwg % NXCD, xcd = wgid % NXCD, off = wgid / NXCD; wgid = (xcd < r ? xcd * (q + 1) : r * (q + 1) + (xcd - r) * q) + off; }
        const int nig = WGM * nN, gid = wgid / nig, fm = gid * WGM, gsz = (nM - fm) < WGM ? (nM - fm) : WGM;
        u.pm = fm + ((wgid % nig) % gsz); u.pn = (wgid % nig) / gsz; return true;
    }
    __device__ __forceinline__ void a_ready(const Unit&) const {}
    __device__ __forceinline__ void done(const Unit&) const {}
};
template <class Epi, class Sched, bool STAMP = false>
__device__ __forceinline__ void gemm_phase(PG8_LAS unsigned char* lds, const Gemm g, const Sched& S, const Epi& E, unsigned long long* stamps) {
    const int tid = threadIdx.x, wid = __builtin_amdgcn_readfirstlane(tid >> 6), lane = tid & 63, wr = wid >> 2, wc = wid & 3, fr = lane & 15, fq = lane >> 4;
    const int K = g.K, nt = K / BK;
    int ts_lo = 0, ts_hi = 0, nts = 0; const unsigned long long rt_entry = STAMP ? (unsigned long long)wall_clock64() : 0ull;
#define PG8_STAMP() do { if (STAMP && wid == 0 && nts < 64) { const unsigned long long _c = (unsigned long long)clock64(); \
        ts_lo = (lane == nts) ? (int)(unsigned)_c : ts_lo; ts_hi = (lane == nts) ? (int)(unsigned)(_c >> 32) : ts_hi; ++nts; } } while (0)
    PG8_STAMP();
    unsigned voffA[2], voffB[2];
#pragma unroll
    for (int i = 0; i < 2; ++i) { int R, C; stage_rc(tid * 16 + i * 8192, R, C); const int Rb = Epi::PERM ? ((R & ~31) + perm32(R & 31)) : R;
        voffA[i] = (unsigned)(R * K + C) * 2u; voffB[i] = (unsigned)(Rb * K + C) * 2u; }
    const size_t kstep = (size_t)(BK * 2);
    const size_t hstep = (size_t)HALF * K * 2;
    const size_t tstep = 2 * hstep;
    const unsigned ldsw = (unsigned)wid * 1024u;
    const int aoff = lds_byte(wr * 64 + fr, fq * 8), boff = lds_byte(wc * 32 + fr, fq * 8);
#define PG8_SA(b, h) (((b) * 2 + (h)) * HTB)
#define PG8_SB(b, h) ((4 + (b) * 2 + (h)) * HTB)
#define PG8_STAGE(bufoff, gbase, voff) do { _Pragma("unroll") for (int _i = 0; _i < 2; ++_i) \
        __builtin_amdgcn_global_load_lds((const unsigned*)((const char*)(gbase) + (voff)[_i]), (PG8_LAS unsigned*)(lds + (bufoff) + ldsw + _i * 8192), 16, 0, 0); } while (0)
#define PG8_LDA(dst, b, h) do { _Pragma("unroll") for (int m = 0; m < 4; ++m) _Pragma("unroll") for (int k = 0; k < 2; ++k) dst[m][k] = *(const PG8_LAS bf16x8*)(lds + PG8_SA(b, h) + aoff + m * 2048 + k * 1024); } while (0)
#define PG8_LDB(dst, b, h) do { _Pragma("unroll") for (int n = 0; n < 2; ++n) _Pragma("unroll") for (int k = 0; k < 2; ++k) dst[n][k] = *(const PG8_LAS bf16x8*)(lds + PG8_SB(b, h) + boff + n * 2048 + k * 1024); } while (0)
#define PG8_MMA(ai, bj, At, Bt) do { __builtin_amdgcn_s_setprio(1); _Pragma("unroll") for (int m = 0; m < 4; ++m) _Pragma("unroll") for (int n = 0; n < 2; ++n) _Pragma("unroll") for (int k = 0; k < 2; ++k) \
        acc[ai][bj][m][n] = __builtin_amdgcn_mfma_f32_16x16x32_bf16(Bt[n][k], At[m][k], acc[ai][bj][m][n], 0, 0, 0); __builtin_amdgcn_s_setprio(0); } while (0)
#define PG8_WAIT_V(n) asm volatile("s_waitcnt vmcnt(" #n ")" ::: "memory")
#define PG8_WAIT_L(n) asm volatile("s_waitcnt lgkmcnt(" #n ")" ::: "memory")
#define PG8_BAR __builtin_amdgcn_s_barrier()
#define PG8_SCHED __builtin_amdgcn_sched_barrier(0)
    Unit cur, nxt; int ui = 0;
    if (!S.next(0, cur)) return;
    f32x4 acc[2][2][4][2];
#pragma unroll
    for (int a = 0; a < 2; ++a)
#pragma unroll
        for (int b = 0; b < 2; ++b)
#pragma unroll
            for (int m = 0; m < 4; ++m)
#pragma unroll
                for (int n = 0; n < 2; ++n) acc[a][b][m][n] = (f32x4){0.f, 0.f, 0.f, 0.f};
    bf16x8 At[4][2], B0[2][2], B1[2][2];
    const char* cA = (const char*)g.A + (size_t)cur.pm * tstep; const char* cB = (const char*)g.Bt + (size_t)cur.pn * tstep;
    S.a_ready(cur);
    PG8_STAGE(PG8_SB(0, 0), cB, voffB); PG8_STAGE(PG8_SA(0, 0), cA, voffA); PG8_STAGE(PG8_SB(0, 1), cB + hstep, voffB); PG8_STAGE(PG8_SA(0, 1), cA + hstep, voffA);
    if (wr == 1) PG8_BAR;
    PG8_WAIT_V(4); PG8_BAR;
    PG8_STAGE(PG8_SB(1, 0), cB + kstep, voffB); PG8_STAGE(PG8_SA(1, 0), cA + kstep, voffA); PG8_STAGE(PG8_SB(1, 1), cB + hstep + kstep, voffB);
    PG8_WAIT_V(6); PG8_BAR;
    PG8_STAMP();
    for (;;) {
        const bool has_next = S.next(ui + 1, nxt);
        const char* nA = has_next ? (const char*)g.A + (size_t)nxt.pm * tstep : cA; const char* nB = has_next ? (const char*)g.Bt + (size_t)nxt.pn * tstep : cB;
        for (int t = 0; t < nt; t += 2) {
            const bool last = (t == nt - 2);
            const char* a1 = cA + (size_t)(t + 1) * kstep;
            const char* a2 = last ? nA : cA + (size_t)(t + 2) * kstep; const char* b2 = last ? nB : cB + (size_t)(t + 2) * kstep;
            const char* a3 = a2 + kstep; const char* b3 = b2 + kstep;
            if (last && has_next) S.a_ready(nxt);
            PG8_LDB(B0, 0, 0); PG8_SCHED; PG8_LDA(At, 0, 0); PG8_STAGE(PG8_SA(1, 1), a1 + hstep, voffA);
            PG8_WAIT_L(8); PG8_BAR; PG8_WAIT_L(0); PG8_MMA(0, 0, At, B0); PG8_BAR; PG8_SCHED;
            PG8_LDB(B1, 0, 1); PG8_STAGE(PG8_SB(0, 0), b2, voffB);
            PG8_BAR; PG8_WAIT_L(0); PG8_MMA(0, 1, At, B1); PG8_BAR;
            PG8_LDA(At, 0, 1); PG8_STAGE(PG8_SA(0, 0), a2, voffA);
            PG8_BAR; PG8_WAIT_L(0); PG8_MMA(1, 0, At, B0); PG8_BAR; PG8_SCHED;
            PG8_STAGE(PG8_SB(0, 1), b2 + hstep, voffB);
            PG8_WAIT_V(6); PG8_BAR; PG8_MMA(1, 1, At, B1); PG8_BAR;
            PG8_LDB(B0, 1, 0); PG8_SCHED; PG8_LDA(At, 1, 0); PG8_STAGE(PG8_SA(0, 1), a2 + hstep, voffA);
            PG8_WAIT_L(8); PG8_BAR; PG8_WAIT_L(0); PG8_MMA(0, 0, At, B0); PG8_BAR; PG8_SCHED;
            PG8_LDB(B1, 1, 1); PG8_STAGE(PG8_SB(1, 0), b3, voffB);
            PG8_BAR; PG8_WAIT_L(0); PG8_MMA(0, 1, At, B1); PG8_BAR;
            PG8_LDA(At, 1, 1); PG8_STAGE(PG8_SA(1, 0), a3, voffA);
            PG8_BAR; PG8_WAIT_L(0); PG8_MMA(1, 0, At, B0); PG8_BAR; PG8_SCHED;
            PG8_STAGE(PG8_SB(1, 1), b3 + hstep, voffB);
            PG8_WAIT_V(6); PG8_BAR; PG8_MMA(1, 1, At, B1); PG8_BAR;
        }
        PG8_STAMP();
        if constexpr (!Epi::AFTER_DRAIN) { E(acc, cur, wr, wc, fr, fq); S.done(cur); }
        PG8_STAMP();
        if (!has_next) break;
#pragma unroll
        for (int a = 0; a < 2; ++a)
#pragma unroll
            for (int b = 0; b < 2; ++b)
#pragma unroll
                for (int m = 0; m < 4; ++m)
#pragma unroll
                    for (int n = 0; n < 2; ++n) acc[a][b][m][n] = (f32x4){0.f, 0.f, 0.f, 0.f};
        cur = nxt; cA = nA; cB = nB; ++ui;
    }
    PG8_WAIT_V(0);
    if (wr == 0) PG8_BAR;
    PG8_BAR;
    if constexpr (Epi::AFTER_DRAIN) { E.fused(acc, cur, wr, wc, fr, fq, lds, wid, lane); S.done(cur); }
    PG8_STAMP();
    if (STAMP && wid == 0) { stamps[lane] = lane < nts ? (((unsigned long long)(unsigned)ts_hi << 32) | (unsigned)ts_lo) : 0ull;
        if (lane == 62) stamps[62] = rt_entry; if (lane == 63) stamps[63] = (unsigned long long)wall_clock64(); }
#undef PG8_STAMP
#undef PG8_SA
#undef PG8_SB
#undef PG8_STAGE
#undef PG8_LDA
#undef PG8_LDB
#undef PG8_MMA
#undef PG8_WAIT_V
#undef PG8_WAIT_L
#undef PG8_BAR
#undef PG8_SCHED
}
}

struct EpiIn0 {
  static constexpr bool PERM = false, AFTER_DRAIN = false;
  float* PROJ;
  const float* LB;
  const float* IR;
  __device__ __forceinline__ void operator()(const pg8::f32x4 (&acc)[2][2][4][2], const pg8::Unit& u, int wr, int wc, int fr, int fq) const {
#pragma unroll
    for (int bj = 0; bj < 2; ++bj) {
      const int cb = u.pn * 256 + bj * 128;
      if (cb >= 4096 && cb < 5120) {
        const int d0 = wc * 16 + 4 * fq;
        const pg8::f32x4 irA = *(const pg8::f32x4*)(IR + 2 * d0), irB = *(const pg8::f32x4*)(IR + 2 * d0 + 4);
        const float irh[4] = {irA[0], irA[2], irB[0], irB[2]}, irl[4] = {irA[1], irA[3], irB[1], irB[3]};
        const float sc = (cb >= 4608) ? 0.08838834764831845f : 1.0f;
#pragma unroll
        for (int ai = 0; ai < 2; ++ai)
#pragma unroll
          for (int m = 0; m < 4; ++m) {
            const int row = u.pm * 256 + ai * 128 + wr * 64 + m * 16 + fr;
            float* pr = PROJ + (size_t)row * N0;
            const pg8::f32x4 v0 = acc[ai][bj][m][0], v1 = acc[ai][bj][m][1];
            const float pos = (float)row_pos(row);
            pg8::f32x4 o1, o2;
#pragma unroll
            for (int j = 0; j < 4; ++j) {
              float ph = pos * irh[j];
              float pe = __builtin_fmaf(pos, irh[j], -ph) + pos * irl[j];
              float frc = __builtin_amdgcn_fractf(ph) + pe;
              float sn = __builtin_amdgcn_sinf(frc), cs = __builtin_amdgcn_cosf(frc);
              o1[j] = (v0[j] * cs - v1[j] * sn) * sc;
              o2[j] = (v0[j] * sn + v1[j] * cs) * sc;
            }
            *(pg8::f32x4*)(pr + cb + d0) = o1;
            *(pg8::f32x4*)(pr + cb + 64 + d0) = o2;
            __builtin_amdgcn_sched_barrier(0);
          }
      } else if (cb >= 1024 && cb < 2048) {
        const int c0 = cb + 32 * wc + 4 * fq;
        const pg8::f32x4 l0 = *(const pg8::f32x4*)(LB + c0 - 1024), l1 = *(const pg8::f32x4*)(LB + c0 + 16 - 1024);
#pragma unroll
        for (int ai = 0; ai < 2; ++ai)
#pragma unroll
          for (int m = 0; m < 4; ++m) {
            const int row = u.pm * 256 + ai * 128 + wr * 64 + m * 16 + fr;
            float* pr = PROJ + (size_t)row * N0;
#pragma unroll
            for (int n = 0; n < 2; ++n) {
              const pg8::f32x4 l = n ? l1 : l0;
              pg8::f32x4 v = acc[ai][bj][m][n], o;
#pragma unroll
              for (int j = 0; j < 4; ++j) o[j] = l[j] + (1.0f - l[j]) * sigmoid_acc(v[j]);
              *(pg8::f32x4*)(pr + c0 + 16 * n) = o;
            }
            __builtin_amdgcn_sched_barrier(0);
          }
      } else {
        const bool act = (cb < 1024 || (cb >= 3072 && cb < 4096) || cb >= 6144);
        const int c0 = cb + 32 * wc + 4 * fq;
#pragma unroll
        for (int ai = 0; ai < 2; ++ai)
#pragma unroll
          for (int m = 0; m < 4; ++m) {
            const int row = u.pm * 256 + ai * 128 + wr * 64 + m * 16 + fr;
            float* pr = PROJ + (size_t)row * N0;
#pragma unroll
            for (int n = 0; n < 2; ++n) {
              pg8::f32x4 v = acc[ai][bj][m][n], o;
#pragma unroll
              for (int j = 0; j < 4; ++j) o[j] = act ? silu_acc(v[j]) : v[j];
              *(pg8::f32x4*)(pr + c0 + 16 * n) = o;
            }
            __builtin_amdgcn_sched_barrier(0);
          }
      }
    }
  }
};
struct EpiIn1 {
  static constexpr bool PERM = false, AFTER_DRAIN = false;
  float* PROJ;
  float* DTA;
  const float* dtb;
  const float* alog;
  __device__ __forceinline__ void operator()(const pg8::f32x4 (&acc)[2][2][4][2], const pg8::Unit& u, int wr, int wc, int fr, int fq) const {
    float dtbv[4] = {0.f, 0.f, 0.f, 0.f}, aev[4] = {0.f, 0.f, 0.f, 0.f};
    if (u.pn == 23) {
      const int cc = 23 * 256 + 32 * wc + 4 * fq;
      const int hb = (cc >= 5920 && cc < 5936) ? (cc - 5920) : ((cc + 16 >= 5920 && cc + 16 < 5936) ? (cc + 16 - 5920) : -1);
      if (hb >= 0) {
#pragma unroll
        for (int j = 0; j < 4; ++j) { dtbv[j] = dtb[hb + j]; aev[j] = expf(alog[hb + j]); }
      }
    }
#pragma unroll
    for (int ai = 0; ai < 2; ++ai)
#pragma unroll
      for (int m = 0; m < 4; ++m) {
        const int row = u.pm * 256 + ai * 128 + wr * 64 + m * 16 + fr;
        float* pr = PROJ + (size_t)row * N1;
#pragma unroll
        for (int bj = 0; bj < 2; ++bj)
#pragma unroll
          for (int n = 0; n < 2; ++n) {
            const int col0 = u.pn * 256 + bj * 128 + 32 * wc + 16 * n + 4 * fq;
            pg8::f32x4 v = acc[ai][bj][m][n];
            if (col0 < 1024) {
              pg8::f32x4 o;
#pragma unroll
              for (int j = 0; j < 4; ++j) o[j] = siluf_(v[j]);
              *(pg8::f32x4*)(pr + col0) = o;
            } else if (col0 < 5920) {
              *(pg8::f32x4*)(pr + col0) = v;
            } else if (col0 < 5936) {
#pragma unroll
              for (int j = 0; j < 4; ++j) {
                int h = col0 + j - 5920;
                float dt = softplusf_(v[j] + dtbv[j]);
                DTA[(size_t)row * 64 + h * 4] = dt;
                DTA[(size_t)row * 64 + h * 4 + 1] = expf(-dt * aev[j]);
              }
            }
          }
      }
  }
};

struct Seg {
  int off;
  int ld;
  int n4;
};

template <int NS, int NF4, int RG>
DEVI void stage_init(const float* wsf, const Seg (&sg)[NS], int row0, int tid, const float* (&ptr)[RG], int (&ldv)[RG]) {
  asm volatile("" : "+v"(tid));
#pragma unroll
  for (int q = 0; q < RG; ++q) {
    int flat = tid + q * 256;
    int t = flat / NF4, f = flat % NF4;
    if (flat >= 16 * NF4) { t = 0; f = 0; }
    int off = 0, ld = 0, ff = f;
    bool done = false;
#pragma unroll
    for (int s = 0; s < NS; ++s) {
      bool here = (!done) && (ff < sg[s].n4);
      off = here ? (sg[s].off + (row0 + t) * sg[s].ld + ff * 4) : off;
      ld = here ? sg[s].ld : ld;
      ff = (done || here) ? ff : (ff - sg[s].n4);
      done = done || here;
    }
    ptr[q] = wsf + off;
    ldv[q] = ld;
  }
}
template <int NF4, int RG>
DEVI void stage_issue(const float* const (&ptr)[RG], const int (&ldv)[RG], int st, int nsteps, int tid, f32x4 (&rg)[RG]) {
#pragma unroll
  for (int q = 0; q < RG; ++q) {
    int flat = tid + q * 256;
    if (flat < nsteps * NF4) rg[q] = *(const f32x4*)(ptr[q] + (st * 16) * ldv[q]);
  }
}
template <int NF4, int RG>
DEVI void stage_commit(float* buf, int nsteps, int tid, const f32x4 (&rg)[RG]) {
#pragma unroll
  for (int q = 0; q < RG; ++q) {
    int flat = tid + q * 256;
    if (flat < nsteps * NF4) ((f32x4*)buf)[flat] = rg[q];
  }
}

template <int MODE>
DEVI void colrec_long(const float* wsf, const Seg (&sg)[4], int row0, int T, float gamma, float* outp, int ldo, float* stout, int st_ld,
                      float* smem) {
  constexpr int NF4 = 69, W = 276, RG = 5;
  const int tid = threadIdx.x & 255, w = tid >> 6, lane = tid & 63, c = lane >> 4, s = lane & 15;
  smem += (threadIdx.x >> 8) * (VB_BYTES / 4);
  float S[8];
#pragma unroll
  for (int i = 0; i < 8; ++i) S[i] = 0.f;
  float* buf0 = smem;
  float* buf1 = smem + 16 * 336;
  float* obuf = smem + 2 * 16 * 336;
  const int nst = (T + 15) / 16;
  f32x4 rgA[RG], rgB[RG];
  const float* sptr[RG];
  int sld[RG];
  stage_init<4, NF4, RG>(wsf, sg, row0, tid, sptr, sld);
  auto step = [&](const float* sp, float* ob, int tt) -> float {
    float4 a0 = *(const float4*)(sp + s * 8), a1 = *(const float4*)(sp + s * 8 + 4);
    float4 q0 = *(const float4*)(sp + 128 + s * 8), q1 = *(const float4*)(sp + 128 + s * 8 + 4);
    float a[8] = {a0.x, a0.y, a0.z, a0.w, a1.x, a1.y, a1.z, a1.w};
    float q[8] = {q0.x, q0.y, q0.z, q0.w, q1.x, q1.y, q1.z, q1.w};
    float val = sp[256 + w * 4 + c];
    float dA = gamma;
    if (MODE == 2) {
      val *= sp[272];
      dA = sp[273];
    }
    float o = 0.f;
#pragma unroll
    for (int i = 0; i < 8; ++i) {
      if (MODE == 0) S[i] = val + a[i] * (S[i] - val);
      else S[i] = dA * S[i] + a[i] * val;
      o += q[i] * S[i];
    }
    return red16(o);
  };
  auto run_stage = [&](const float* b, float* ob, int nthis) {
#pragma unroll 1
    for (int tt = 0; tt < nthis; tt += 4) {
      float o0 = step(b + tt * W, ob, tt);
      float o1 = step(b + (tt + 1) * W, ob, tt + 1);
      float o2 = step(b + (tt + 2) * W, ob, tt + 2);
      float o3 = step(b + (tt + 3) * W, ob, tt + 3);
      const int base = (s == 0) ? (tt * 16 + w * 4 + c) : (1024 + (tid & 255));
      const int st16 = (s == 0) ? 16 : 0;
      ob[base] = o0;
      ob[base + st16] = o1;
      ob[base + 2 * st16] = o2;
      ob[base + 3 * st16] = o3;
    }
  };
  auto write_out = [&](const float* ob, int st, int nthis) {
    if (tid < nthis * 4) {
      int t = tid >> 2, c4 = tid & 3;
      *(float4*)(outp + (size_t)(st * 16 + t) * ldo + c4 * 4) = *(const float4*)(ob + t * 16 + c4 * 4);
    }
  };
  auto nsteps = [&](int st) { return min(16, T - st * 16); };
  stage_issue<NF4, RG>(sptr, sld, 0, nsteps(0), tid, rgA);
  stage_commit<NF4, RG>(buf0, nsteps(0), tid, rgA);
  if (nst > 1) stage_issue<NF4, RG>(sptr, sld, 1, nsteps(1), tid, rgB);
  __syncthreads();
#pragma unroll 1
  for (int st = 0; st < nst; st += 2) {
    if (st + 2 < nst) stage_issue<NF4, RG>(sptr, sld, st + 2, nsteps(st + 2), tid, rgA);
    run_stage(buf0, obuf, nsteps(st));
    if (st + 1 < nst) stage_commit<NF4, RG>(buf1, nsteps(st + 1), tid, rgB);
    __syncthreads();
    write_out(obuf, st, nsteps(st));
    if (st + 1 < nst) {
      if (st + 3 < nst) stage_issue<NF4, RG>(sptr, sld, st + 3, nsteps(st + 3), tid, rgB);
      run_stage(buf1, obuf + 512, nsteps(st + 1));
      if (st + 2 < nst) stage_commit<NF4, RG>(buf0, nsteps(st + 2), tid, rgA);
      __syncthreads();
      write_out(obuf + 512, st + 1, nsteps(st + 1));
    }
  }
#pragma unroll
  for (int i = 0; i < 8; ++i) stout[(size_t)(s * 8 + i) * st_ld + w * 4 + c] = S[i];
  __syncthreads();
}

template <int MODE>
DEVI void colrec_short(const float* pa, int lda_, const float* pq, int ldq, const float* pc, int ldc, const float* pdt,
                       long row0, float gamma, const float* stin, float* stout, int st_ld, float* outp, int ldo,
                       float* smem) {
  const int tid = threadIdx.x & 255, lane = tid & 63;
  const int wid = __builtin_amdgcn_readfirstlane(tid >> 6);
  const int k0 = wid * 32;
  smem += (threadIdx.x >> 8) * (VB_BYTES / 4);
  float S[32];
#pragma unroll
  for (int i = 0; i < 32; ++i) S[i] = stin[(size_t)(k0 + i) * st_ld + lane];
  float aq[4], vv[4], dAv[4];
#pragma unroll
  for (int t = 0; t < 4; ++t) {
    long row = row0 + t;
    aq[t] = (lane < 32) ? pa[(size_t)row * lda_ + k0 + lane] : pq[(size_t)row * ldq + k0 + (lane - 32)];
    vv[t] = pc[(size_t)row * ldc + lane];
    dAv[t] = gamma;
    if (MODE == 2) {
      vv[t] *= pdt[(size_t)row * 64];
      dAv[t] = pdt[(size_t)row * 64 + 1];
    }
  }
#pragma unroll
  for (int t = 0; t < 4; ++t) {
    const float val = vv[t], dA = dAv[t];
    float o = 0.f;
#pragma unroll
    for (int i = 0; i < 32; ++i) {
      const float a = rlf_(aq[t], i), q = rlf_(aq[t], 32 + i);
      if (MODE == 0) S[i] = val + a * (S[i] - val);
      else S[i] = dA * S[i] + a * val;
      o += q * S[i];
    }
    smem[(wid * 4 + t) * 64 + lane] = o;
  }
#pragma unroll
  for (int i = 0; i < 32; ++i) stout[(size_t)(k0 + i) * st_ld + lane] = S[i];
  __syncthreads();
  {
    int t = tid >> 6;
    float sum = smem[(0 * 4 + t) * 64 + lane] + smem[(1 * 4 + t) * 64 + lane] + smem[(2 * 4 + t) * 64 + lane] +
                smem[(3 * 4 + t) * 64 + lane];
    outp[(size_t)(row0 + t) * ldo + lane] = sum;
  }
  __syncthreads();
}

DEVI void rwkv_item(const float* wsf, const Seg (&sg)[6], int row0, int T, const float* stin, float* stout, float* outp, int ldo,
                    float* smem) {
  constexpr int NF4 = 84, W = 336, RG = 6;
  const int tid = threadIdx.x & 255, w = tid >> 6, lane = tid & 63, rl = lane >> 4, sl = lane & 15;
  smem += (threadIdx.x >> 8) * (VB_BYTES / 4);
  const int il = w * 4 + rl;
  float S[4];
  if (stin) {
    float4 v = *(const float4*)(stin + il * 64 + sl * 4);
    S[0] = v.x; S[1] = v.y; S[2] = v.z; S[3] = v.w;
  } else {
    S[0] = S[1] = S[2] = S[3] = 0.f;
  }
  float* buf0 = smem;
  float* buf1 = smem + 16 * 336;
  float* obuf = smem + 2 * 16 * 336;
  const int nst = (T + 15) / 16;
  f32x4 rgA[RG], rgB[RG];
  const float* sptr[RG];
  int sld[RG];
  stage_init<6, NF4, RG>(wsf, sg, row0, tid, sptr, sld);
  auto run_stage = [&](const float* b, float* ob, int nthis) {
#pragma unroll 4
    for (int tt = 0; tt < nthis; ++tt) {
      const float* sp = b + tt * W;
      float4 r4 = *(const float4*)(sp + sl * 4);
      float4 w4 = *(const float4*)(sp + 64 + sl * 4);
      float4 k4 = *(const float4*)(sp + 128 + sl * 4);
      float4 n4 = *(const float4*)(sp + 192 + sl * 4);
      float4 m4 = *(const float4*)(sp + 256 + sl * 4);
      float vi = sp[320 + il];
      float sa = S[0] * n4.x + S[1] * n4.y + S[2] * n4.z + S[3] * n4.w;
      sa = -red16(sa);
      S[0] = S[0] * w4.x + sa * m4.x + vi * k4.x;
      S[1] = S[1] * w4.y + sa * m4.y + vi * k4.y;
      S[2] = S[2] * w4.z + sa * m4.z + vi * k4.z;
      S[3] = S[3] * w4.w + sa * m4.w + vi * k4.w;
      float y = S[0] * r4.x + S[1] * r4.y + S[2] * r4.z + S[3] * r4.w;
      y = red16(y);
      ob[(sl == 0) ? (tt * 16 + il) : (1024 + (tid & 255))] = y;
    }
  };
  auto write_out = [&](const float* ob, int st, int nthis) {
    if (tid < nthis * 4) {
      int t = tid >> 2, c4 = tid & 3;
      *(float4*)(outp + (size_t)(st * 16 + t) * ldo + c4 * 4) = *(const float4*)(ob + t * 16 + c4 * 4);
    }
  };
  auto nsteps = [&](int st) { return min(16, T - st * 16); };
  stage_issue<NF4, RG>(sptr, sld, 0, nsteps(0), tid, rgA);
  stage_commit<NF4, RG>(buf0, nsteps(0), tid, rgA);
  if (nst > 1) stage_issue<NF4, RG>(sptr, sld, 1, nsteps(1), tid, rgB);
  __syncthreads();
  __builtin_amdgcn_s_setprio(3);
#pragma unroll 1
  for (int st = 0; st < nst; st += 2) {
    if (st + 2 < nst) stage_issue<NF4, RG>(sptr, sld, st + 2, nsteps(st + 2), tid, rgA);
    run_stage(buf0, obuf, nsteps(st));
    if (st + 1 < nst) stage_commit<NF4, RG>(buf1, nsteps(st + 1), tid, rgB);
    __syncthreads();
    write_out(obuf, st, nsteps(st));
    if (st + 1 < nst) {
      if (st + 3 < nst) stage_issue<NF4, RG>(sptr, sld, st + 3, nsteps(st + 3), tid, rgB);
      run_stage(buf1, obuf + 512, nsteps(st + 1));
      if (st + 2 < nst) stage_commit<NF4, RG>(buf0, nsteps(st + 2), tid, rgA);
      __syncthreads();
      write_out(obuf + 512, st + 1, nsteps(st + 1));
    }
  }
  __builtin_amdgcn_s_setprio(0);
  *(float4*)(stout + il * 64 + sl * 4) = make_float4(S[0], S[1], S[2], S[3]);
  __syncthreads();
}

DEVI void phase_rec0(const Params& p, float* smem) {
  char* ws = p.ws;
  const float* PROJ = (const float*)(ws + OFF_PROJ);
  float* OMIX = (float*)(ws + OFF_OMIX);
  const float* wsf = (const float*)ws;
  constexpr int PO = (int)(OFF_PROJ / 4);
  for (int item = blockIdx.x * 2 + (threadIdx.x >> 8); item < 4608; item += gridDim.x * 2) {
    if (item < 256) {
      int b = item >> 6, h = (item >> 3) & 7, cb = item & 7;
      Seg sg[4] = {{PO + 1024 + h * 128, N0, 32}, {PO + h * 128, N0, 32}, {PO + 2048 + h * 128 + cb * 16, N0, 4},
                   {PO, N0, 1}};
      int row0 = b * TP;
      colrec_long<0>(wsf, sg, row0, TP, 0.f, OMIX + (size_t)row0 * 2048 + h * 128 + cb * 16, 2048,
                     p.out + O_HGP + (size_t)(b * 8 + h) * 128 * 128 + cb * 16, 128, smem);
    } else if (item < 512) {
      int it = item - 256;
      int b = it >> 6, h = (it >> 4) & 3, cb = it & 15;
      Seg sg[4] = {{PO + 4608 + h * 128, N0, 32}, {PO + 4096 + h * 128, N0, 32},
                   {PO + 5120 + h * 256 + cb * 16, N0, 4}, {PO, N0, 1}};
      int row0 = b * TP;
      float gamma = 1.0f - exp2f(-5.0f - (float)h);
      colrec_long<1>(wsf, sg, row0, TP, gamma, OMIX + (size_t)row0 * 2048 + 1024 + h * 256 + cb * 16, 2048,
                     p.out + O_RTP + (size_t)(b * 4 + h) * 128 * 256 + cb * 16, 256, smem);
    } else if (item < 2560) {
      int it = item - 512;
      int b = it >> 4, h = (it >> 1) & 7, cb = it & 1;
      long row0 = MPR + (long)b * 4;
      size_t so = (size_t)(b * 8 + h) * 128 * 128 + cb * 64;
      colrec_short<0>(PROJ + 1024 + h * 128, N0, PROJ + h * 128, N0, PROJ + 2048 + h * 128 + cb * 64, N0, nullptr, row0,
                      0.f, p.in[I_SHG] + so, p.out + O_HGS + so, 128, OMIX + h * 128 + cb * 64, 2048, smem);
    } else {
      int it = item - 2560;
      int b = it >> 4, h = (it >> 2) & 3, cb = it & 3;
      long row0 = MPR + (long)b * 4;
      size_t so = (size_t)(b * 4 + h) * 128 * 256 + cb * 64;
      float gamma = 1.0f - exp2f(-5.0f - (float)h);
      colrec_short<1>(PROJ + 4608 + h * 128, N0, PROJ + 4096 + h * 128, N0, PROJ + 5120 + h * 256 + cb * 64, N0, nullptr,
                      row0, gamma, p.in[I_SRT] + so, p.out + O_RTS + so, 256, OMIX + 1024 + h * 256 + cb * 64, 2048,
                      smem);
    }
  }
}

DEVI float4 ld4(const float* p) { return *(const float4*)p; }
DEVI void st_bf4(u16* p, float a, float b, float c, float d) {
  uint2 o;
  o.x = pack2(a, b);
  o.y = pack2(c, d);
  *(uint2*)p = o;
}
DEVI float wsum_u_(float v) {
  v = red16(v);
  return (rlf_(v, 0) + rlf_(v, 16)) + (rlf_(v, 32) + rlf_(v, 48));
}
DEVI float red32(float v) {
  v = red16(v);
  return v + __shfl_xor(v, 16, 64);
}
DEVI void phase_post0(const Params& p) {
  char* ws = p.ws;
  const float* PROJ = (const float*)(ws + OFF_PROJ);
  const float* OMIX = (const float*)(ws + OFF_OMIX);
  u16* MIXB = (u16*)(ws + OFF_MIXB);
  const float* ng = p.in[I_HNG];
  const int lane = threadIdx.x & 63;
  const int gw = blockIdx.x * 8 + (threadIdx.x >> 6), nw = gridDim.x * 8;
  const float4 g4 = ld4(ng + (lane & 31) * 4);
  for (int row = gw; row < M; row += nw) {
    const float* o = OMIX + (size_t)row * 2048;
    const float* pr = PROJ + (size_t)row * N0;
    u16* mo = MIXB + (size_t)row * 2048;
    float4 a[4], ga[4], bq[4], gb[4];
#pragma unroll
    for (int it = 0; it < 4; ++it) {
      int c = it * 256 + lane * 4;
      a[it] = ld4(o + c);
      ga[it] = ld4(pr + 3072 + c);
      bq[it] = ld4(o + 1024 + c);
      gb[it] = ld4(pr + 6144 + c);
    }
#pragma unroll
    for (int it = 0; it < 4; ++it) {
      int c = it * 256 + lane * 4;
      float ss = red32(a[it].x * a[it].x + a[it].y * a[it].y + a[it].z * a[it].z + a[it].w * a[it].w);
      float inv = rsqrtf(ss * (1.0f / 128.0f) + 1e-6f);
      st_bf4(mo + c, a[it].x * inv * g4.x * ga[it].x, a[it].y * inv * g4.y * ga[it].y, a[it].z * inv * g4.z * ga[it].z,
             a[it].w * inv * g4.w * ga[it].w);
      float mu = wsum_u_(bq[it].x + bq[it].y + bq[it].z + bq[it].w) * (1.0f / 256.0f);
      float dx = bq[it].x - mu, dy = bq[it].y - mu, dz = bq[it].z - mu, dw = bq[it].w - mu;
      float var = wsum_u_(dx * dx + dy * dy + dz * dz + dw * dw) * (1.0f / 256.0f);
      float iv = rsqrtf(var + 1e-5f);
      st_bf4(mo + 1024 + c, dx * iv * gb[it].x, dy * iv * gb[it].y, dz * iv * gb[it].z, dw * iv * gb[it].w);
    }
  }
}

DEVI void phase_ln(const Params& p, const float* addsrc, const float* g, const float* bta) {
  char* ws = p.ws;
  float* XF = (float*)(ws + OFF_XF);
  u16* XB = (u16*)(ws + OFF_XB);
  const int lane = threadIdx.x & 63;
  const int gw = blockIdx.x * 8 + (threadIdx.x >> 6), nw = gridDim.x * 8;
  for (int row = gw; row < M; row += nw) {
    float4* xr = (float4*)(XF + (size_t)row * 2048);
    const float4* ar = (const float4*)(addsrc + (size_t)row * 2048);
    float v[32];
    float s = 0.f;
#pragma unroll
    for (int i = 0; i < 8; ++i) {
      float4 x = xr[i * 64 + lane], a = ar[i * 64 + lane];
      v[i * 4 + 0] = ALPHA * x.x + a.x;
      v[i * 4 + 1] = ALPHA * x.y + a.y;
      v[i * 4 + 2] = ALPHA * x.z + a.z;
      v[i * 4 + 3] = ALPHA * x.w + a.w;
      s += v[i * 4 + 0] + v[i * 4 + 1] + v[i * 4 + 2] + v[i * 4 + 3];
    }
    float mu = wsum(s) * (1.0f / 2048.0f);
    float q = 0.f;
#pragma unroll
    for (int i = 0; i < 32; ++i) {
      v[i] -= mu;
      q += v[i] * v[i];
    }
    float inv = rsqrtf(wsum(q) * (1.0f / 2048.0f) + 1e-5f);
#pragma unroll
    for (int i = 0; i < 8; ++i) {
      float4 gg = ((const float4*)g)[i * 64 + lane], bb = ((const float4*)bta)[i * 64 + lane];
      float4 y;
      y.x = v[i * 4 + 0] * inv * gg.x + bb.x;
      y.y = v[i * 4 + 1] * inv * gg.y + bb.y;
      y.z = v[i * 4 + 2] * inv * gg.z + bb.z;
      y.w = v[i * 4 + 3] * inv * gg.w + bb.w;
      xr[i * 64 + lane] = y;
      uint2 o;
      o.x = pack2(y.x, y.y);
      o.y = pack2(y.z, y.w);
      ((uint2*)(XB + (size_t)row * 2048))[i * 64 + lane] = o;
    }
  }
}

typedef __attribute__((ext_vector_type(2))) __bf16 bf2_t;
typedef __attribute__((ext_vector_type(2))) float f32x2;
DEVI float dot2bf(unsigned a, unsigned b, float acc) {
  return __builtin_amdgcn_fdot2_f32_bf16(__builtin_bit_cast(bf2_t, a), __builtin_bit_cast(bf2_t, b), acc, false);
}
template <int CTRL>
DEVI int dppi(int v) {
  return __builtin_amdgcn_update_dpp(v, v, CTRL, 0xF, 0xF, false);
}
DEVI int wmax_i(int v) {
  v = max(v, dppi<0xB1>(v));
  v = max(v, dppi<0x4E>(v));
  v = max(v, dppi<0x141>(v));
  v = max(v, dppi<0x140>(v));
  int a = __builtin_amdgcn_readlane(v, 0), b = __builtin_amdgcn_readlane(v, 16);
  int c = __builtin_amdgcn_readlane(v, 32), d = __builtin_amdgcn_readlane(v, 48);
  return max(max(a, b), max(c, d));
}
DEVI float rlf(float v, int l) { return __int_as_float(__builtin_amdgcn_readlane(__float_as_int(v), l)); }
DEVI float wsum_u(float v) {
  v = red16(v);
  return (rlf(v, 0) + rlf(v, 16)) + (rlf(v, 32) + rlf(v, 48));
}
DEVI int fkey(float f) {
  int u = __float_as_int(f);
  return u ^ ((u >> 31) & 0x7fffffff);
}
DEVI float keyf(int k) { return __int_as_float(k ^ ((k >> 31) & 0x7fffffff)); }

DEVI void conv_fp8_rows(const float* __restrict__ src, unsigned char* __restrict__ dst, float* __restrict__ scales) {
  const int lane = threadIdx.x & 63;
  const int gw = blockIdx.x * 8 + (threadIdx.x >> 6), nw = gridDim.x * 8;
  for (int e = gw; e < 16384; e += nw) {
    const float* r = src + (size_t)e * 2048;
    float4 v[8];
    float am = 0.f;
#pragma unroll
    for (int q = 0; q < 8; ++q) {
      v[q] = *(const float4*)(r + (q >> 2) * 1024 + lane * 16 + (q & 3) * 4);
      am = fmaxf(am, fmaxf(fmaxf(fabsf(v[q].x), fabsf(v[q].y)), fmaxf(fabsf(v[q].z), fabsf(v[q].w))));
    }
    float amax = __int_as_float(wmax_i(__float_as_int(am)));
    float inv = (amax > 0.f) ? (440.0f / amax) : 0.f;
    float scale = (amax > 0.f) ? (amax * (1.0f / 440.0f)) : 1.0f;
#pragma unroll
    for (int j = 0; j < 2; ++j) {
      u32x4 o;
#pragma unroll
      for (int k = 0; k < 4; ++k) {
        float4 t = v[j * 4 + k];
        int pk = 0;
        pk = __builtin_amdgcn_cvt_pk_fp8_f32(t.x * inv, t.y * inv, pk, false);
        pk = __builtin_amdgcn_cvt_pk_fp8_f32(t.z * inv, t.w * inv, pk, true);
        o[k] = (unsigned)pk;
      }
      *(u32x4*)(dst + (size_t)e * 2048 + j * 1024 + lane * 16) = o;
    }
    if (lane == 0) scales[e] = scale;
  }
}

DEVI void phase_peer(const Params& p, int layer, bool final_out) {
  char* ws = p.ws;
  const float* SC = (const float*)(ws + OFF_GOUT);
  float* XF = (float*)(ws + OFF_XF);
  u16* XB = (u16*)(ws + OFF_XB);
  const unsigned char* UB = (const unsigned char*)(ws + OFF_UB);
  const unsigned char* VB = (const unsigned char*)(ws + OFF_VB);
  const float* USC = (const float*)(ws + OFF_USC);
  const float* VSC = (const float*)(ws + OFF_VSC);
  const float* g = p.in[I_LNG] + (size_t)(layer * 2 + 1) * D;
  const float* bta = p.in[I_LNB] + (size_t)(layer * 2 + 1) * D;
  const int lane = threadIdx.x & 63;
  const int gw = blockIdx.x * 8 + (threadIdx.x >> 6), nw = gridDim.x * 8;
  constexpr int KMIN = (int)0x80000000;
  for (int row = gw; row < M; row += nw) {
    const float* sr = SC + (size_t)row * 2048;
    int eidx0 = 0, eidx1 = 0;
    float gate0 = 0.f, gate1 = 0.f;
#pragma unroll 1
    for (int hp = 0; hp < 4; ++hp) {
      const float* spA = sr + hp * 256;
      const float* spB = sr + (hp + 4) * 256;
      int kaA0 = (fkey(spA[lane]) & ~127) | (127 - lane);
      int kbA0 = (fkey(spA[lane + 64]) & ~127) | (63 - lane);
      int kaA1 = (fkey(spA[128 + lane]) & ~127) | (127 - lane);
      int kbA1 = (fkey(spA[192 + lane]) & ~127) | (63 - lane);
      int kaB0 = (fkey(spB[lane]) & ~127) | (127 - lane);
      int kbB0 = (fkey(spB[lane + 64]) & ~127) | (63 - lane);
      int kaB1 = (fkey(spB[128 + lane]) & ~127) | (127 - lane);
      int kbB1 = (fkey(spB[192 + lane]) & ~127) | (63 - lane);
      int myA0 = KMIN, myA1 = KMIN, myB0 = KMIN, myB1 = KMIN;
#pragma unroll 1
      for (int r = 0; r < 16; ++r) {
        int KA0 = wmax_i(max(kaA0, kbA0));
        int KA1 = wmax_i(max(kaA1, kbA1));
        int KB0 = wmax_i(max(kaB0, kbB0));
        int KB1 = wmax_i(max(kaB1, kbB1));
        myA0 = (lane == r) ? KA0 : myA0;
        myA1 = (lane == r) ? KA1 : myA1;
        myB0 = (lane == r) ? KB0 : myB0;
        myB1 = (lane == r) ? KB1 : myB1;
        kaA0 = (kaA0 == KA0) ? KMIN : kaA0;
        kbA0 = (kbA0 == KA0) ? KMIN : kbA0;
        kaA1 = (kaA1 == KA1) ? KMIN : kaA1;
        kbA1 = (kbA1 == KA1) ? KMIN : kbA1;
        kaB0 = (kaB0 == KB0) ? KMIN : kaB0;
        kbB0 = (kbB0 == KB0) ? KMIN : kbB0;
        kaB1 = (kaB1 == KB1) ? KMIN : kaB1;
        kbB1 = (kbB1 == KB1) ? KMIN : kbB1;
      }
      const float tsA0 = keyf(myA0 & ~127), tsA1 = keyf(myA1 & ~127);
      const float tsB0 = keyf(myB0 & ~127), tsB1 = keyf(myB1 & ~127);
      const int tiA0 = 127 - (myA0 & 127), tiA1 = 127 - (myA1 & 127);
      const int tiB0 = 127 - (myB0 & 127), tiB1 = 127 - (myB1 & 127);
      const int jb = (lane & 3) * 4;
      const float sA = __shfl(tsA0, lane >> 2, 64), sB = __shfl(tsB0, lane >> 2, 64);
      int cA0 = (fkey(sA + __shfl(tsA1, jb + 0, 64)) & ~255) | (255 - (lane * 4 + 0));
      int cA1 = (fkey(sA + __shfl(tsA1, jb + 1, 64)) & ~255) | (255 - (lane * 4 + 1));
      int cA2 = (fkey(sA + __shfl(tsA1, jb + 2, 64)) & ~255) | (255 - (lane * 4 + 2));
      int cA3 = (fkey(sA + __shfl(tsA1, jb + 3, 64)) & ~255) | (255 - (lane * 4 + 3));
      int cB0 = (fkey(sB + __shfl(tsB1, jb + 0, 64)) & ~255) | (255 - (lane * 4 + 0));
      int cB1 = (fkey(sB + __shfl(tsB1, jb + 1, 64)) & ~255) | (255 - (lane * 4 + 1));
      int cB2 = (fkey(sB + __shfl(tsB1, jb + 2, 64)) & ~255) | (255 - (lane * 4 + 2));
      int cB3 = (fkey(sB + __shfl(tsB1, jb + 3, 64)) & ~255) | (255 - (lane * 4 + 3));
      int mykA = KMIN, mykB = KMIN;
#pragma unroll 1
      for (int r = 0; r < 16; ++r) {
        int KA = wmax_i(max(max(cA0, cA1), max(cA2, cA3)));
        int KB = wmax_i(max(max(cB0, cB1), max(cB2, cB3)));
        mykA = (lane == r) ? KA : mykA;
        mykB = (lane == r) ? KB : mykB;
        cA0 = (cA0 == KA) ? KMIN : cA0;
        cA1 = (cA1 == KA) ? KMIN : cA1;
        cA2 = (cA2 == KA) ? KMIN : cA2;
        cA3 = (cA3 == KA) ? KMIN : cA3;
        cB0 = (cB0 == KB) ? KMIN : cB0;
        cB1 = (cB1 == KB) ? KMIN : cB1;
        cB2 = (cB2 == KB) ? KMIN : cB2;
        cB3 = (cB3 == KB) ? KMIN : cB3;
      }
      const float bsA = keyf(mykA & ~255), bsB = keyf(mykB & ~255);
      const int bfA = 255 - (mykA & 255), bfB = 255 - (mykB & 255);
      const int eA = __shfl(tiA0, (bfA >> 4) & 15, 64) * 128 + __shfl(tiA1, bfA & 15, 64);
      const int eB = __shfl(tiB0, (bfB >> 4) & 15, 64) * 128 + __shfl(tiB1, bfB & 15, 64);
      const float evA = (lane < 16) ? expf(bsA - rlf(bsA, 0)) : 0.f;
      const float evB = (lane < 16) ? expf(bsB - rlf(bsB, 0)) : 0.f;
      const float gtA = evA / wsum_u(evA), gtB = evB / wsum_u(evB);
      const int eA_b = __shfl(eA, lane & 15, 64), eB_b = __shfl(eB, lane & 15, 64);
      const float gA_b = __shfl(gtA, lane & 15, 64), gB_b = __shfl(gtB, lane & 15, 64);
      if ((lane >> 4) == hp) {
        eidx0 = eA_b;
        gate0 = gA_b;
        eidx1 = eB_b;
        gate1 = gB_b;
      }
    }
    float dv0 = 0.f, dv1 = 0.f;
    {
      float xf[32];
      {
        const float4* xr = (const float4*)(XF + (size_t)row * 2048);
#pragma unroll
        for (int q = 0; q < 8; ++q) {
          float4 t = xr[(q >> 2) * 256 + lane * 4 + (q & 3)];
          xf[q * 4 + 0] = t.x; xf[q * 4 + 1] = t.y; xf[q * 4 + 2] = t.z; xf[q * 4 + 3] = t.w;
        }
      }
      constexpr int R = 8;
      u32x4 w[R][2];
      float sc[R];
      auto load_row = [&](int pidx, u32x4(&wr)[2], float& scv) {
        int src = (pidx < 64) ? eidx0 : eidx1;
        int e = __builtin_amdgcn_readlane(src, pidx & 63);
        const u32x4* ur = (const u32x4*)(UB + (size_t)e * 2048);
        wr[0] = ur[lane];
        wr[1] = ur[64 + lane];
        scv = USC[e];
      };
#pragma unroll
      for (int u = 0; u < R; ++u) load_row(u, w[u], sc[u]);
#pragma unroll 1
      for (int p0 = 0; p0 < 128; p0 += R) {
#pragma unroll
        for (int u = 0; u < R; ++u) {
          float d = 0.f;
#pragma unroll
          for (int j = 0; j < 2; ++j) {
#pragma unroll
            for (int k = 0; k < 4; ++k) {
              int dw = (int)w[u][j][k];
              f32x2 lo = __builtin_amdgcn_cvt_pk_f32_fp8(dw, false);
              f32x2 hi = __builtin_amdgcn_cvt_pk_f32_fp8(dw, true);
              d += lo.x * xf[j * 16 + k * 4 + 0];
              d += lo.y * xf[j * 16 + k * 4 + 1];
              d += hi.x * xf[j * 16 + k * 4 + 2];
              d += hi.y * xf[j * 16 + k * 4 + 3];
            }
          }
          float scu = sc[u];
          if (p0 + R < 128) load_row(p0 + R + u, w[u], sc[u]);
          d = wsum_u(d) * scu;
          int pl = (p0 + u) & 63;
          if (p0 < 64) dv0 = (lane == pl) ? d : dv0;
          else dv1 = (lane == pl) ? d : dv1;
          __builtin_amdgcn_sched_barrier(0);
        }
      }
    }
    float coef0 = 0.5f * dv0 * (1.0f + erff(dv0 * 0.70710678118f)) * gate0;
    float coef1 = 0.5f * dv1 * (1.0f + erff(dv1 * 0.70710678118f)) * gate1;
    f32x2 o2[16];
#pragma unroll
    for (int i = 0; i < 16; ++i) o2[i] = f32x2{0.f, 0.f};
    {
      constexpr int R = 8;
      u32x4 w[R][2];
      float sc[R];
      auto load_row = [&](int pidx, u32x4(&wr)[2], float& scv) {
        int src = (pidx < 64) ? eidx0 : eidx1;
        int e = __builtin_amdgcn_readlane(src, pidx & 63);
        const u32x4* vr = (const u32x4*)(VB + (size_t)e * 2048);
        wr[0] = vr[lane];
        wr[1] = vr[64 + lane];
        scv = VSC[e];
      };
#pragma unroll
      for (int u = 0; u < R; ++u) load_row(u, w[u], sc[u]);
#pragma unroll 1
      for (int p0 = 0; p0 < 128; p0 += R) {
        float cfs = (p0 < 64) ? coef0 : coef1;
#pragma unroll
        for (int u = 0; u < R; ++u) {
          float c = rlf(cfs, (p0 + u) & 63) * sc[u];
          f32x2 cc = f32x2{c, c};
#pragma unroll
          for (int j = 0; j < 2; ++j) {
#pragma unroll
            for (int k = 0; k < 4; ++k) {
              int dw = (int)w[u][j][k];
              o2[j * 8 + k * 2 + 0] += cc * __builtin_amdgcn_cvt_pk_f32_fp8(dw, false);
              o2[j * 8 + k * 2 + 1] += cc * __builtin_amdgcn_cvt_pk_f32_fp8(dw, true);
            }
          }
          if (p0 + R < 128) load_row(p0 + R + u, w[u], sc[u]);
          __builtin_amdgcn_sched_barrier(0);
        }
      }
    }
    float o[32];
#pragma unroll
    for (int i = 0; i < 16; ++i) {
      o[2 * i] = o2[i].x;
      o[2 * i + 1] = o2[i].y;
    }
    float s = 0.f;
    {
      const float4* xr = (const float4*)(XF + (size_t)row * 2048);
#pragma unroll
      for (int q = 0; q < 8; ++q) {
        float4 t = xr[(q >> 2) * 256 + lane * 4 + (q & 3)];
        o[q * 4 + 0] += ALPHA * t.x; o[q * 4 + 1] += ALPHA * t.y; o[q * 4 + 2] += ALPHA * t.z; o[q * 4 + 3] += ALPHA * t.w;
      }
#pragma unroll
      for (int i = 0; i < 32; ++i) s += o[i];
    }
    float mu = wsum_u(s) * (1.0f / 2048.0f);
    float q = 0.f;
#pragma unroll
    for (int i = 0; i < 32; ++i) {
      o[i] -= mu;
      q += o[i] * o[i];
    }
    float inv = rsqrtf(wsum_u(q) * (1.0f / 2048.0f) + 1e-5f);
    float* dstf;
    if (final_out) {
      if (row < MPR) {
        int b = row / TP, t = row % TP;
        dstf = (t >= 16) ? (p.out + O_YP + ((size_t)b * 2048 + (t - 16)) * D) : nullptr;
      } else {
        dstf = p.out + O_YS + (size_t)(row - MPR) * D;
      }
    } else {
      dstf = XF + (size_t)row * 2048;
    }
#pragma unroll
    for (int j = 0; j < 2; ++j) {
      float yv[16];
#pragma unroll
      for (int k = 0; k < 4; ++k) {
        float4 gv = *(const float4*)(g + j * 1024 + lane * 16 + k * 4);
        float4 bv = *(const float4*)(bta + j * 1024 + lane * 16 + k * 4);
        float4 y;
        y.x = o[j * 16 + k * 4 + 0] * inv * gv.x + bv.x;
        y.y = o[j * 16 + k * 4 + 1] * inv * gv.y + bv.y;
        y.z = o[j * 16 + k * 4 + 2] * inv * gv.z + bv.z;
        y.w = o[j * 16 + k * 4 + 3] * inv * gv.w + bv.w;
        if (dstf) *(float4*)(dstf + j * 1024 + lane * 16 + k * 4) = y;
        yv[k * 4 + 0] = y.x; yv[k * 4 + 1] = y.y; yv[k * 4 + 2] = y.z; yv[k * 4 + 3] = y.w;
      }
      if (!final_out) {
        uint4* xb = (uint4*)(XB + (size_t)row * 2048 + j * 1024 + lane * 16);
        xb[0] = make_uint4(pack2(yv[0], yv[1]), pack2(yv[2], yv[3]), pack2(yv[4], yv[5]), pack2(yv[6], yv[7]));
        xb[1] = make_uint4(pack2(yv[8], yv[9]), pack2(yv[10], yv[11]), pack2(yv[12], yv[13]), pack2(yv[14], yv[15]));
      }
    }
  }
}

DEVI float4 f4mul(float4 a, float4 b) { return make_float4(a.x * b.x, a.y * b.y, a.z * b.z, a.w * b.w); }
DEVI void row_info(int row, bool& prompt, int& b, int& t, int& T) {
  prompt = row < MPR;
  if (prompt) { b = row / TP; t = row - b * TP; T = TP; }
  else { b = (row - MPR) >> 2; t = (row - MPR) & 3; T = 4; }
}
DEVI void phase_pre1(const Params& p) {
  char* ws = p.ws;
  const float* PROJ = (const float*)(ws + OFF_PROJ);
  float* XC = (float*)(ws + OFF_GOUT);
  float* RKV = (float*)(ws + OFF_RKV);
  u16* LRA = (u16*)(ws + OFF_LRA);
  u16* LRB = (u16*)(ws + OFF_LRB);
  u16* LRG = (u16*)(ws + OFF_LRG);
  const float* cw = p.in[I_CVW];
  const float* cbias = p.in[I_CVB];
  const float* mu = p.in[I_MU];
  const int gtid = blockIdx.x * 512 + threadIdx.x, nthr = gridDim.x * 512;
#pragma unroll 2
  for (int idx = gtid; idx < M * 384; idx += nthr) {
    int row = idx / 384, c = (idx - row * 384) * 4;
    bool prompt; int b, t, T;
    row_info(row, prompt, b, t, T);
    float4 xv[4];
#pragma unroll
    for (int jj = 0; jj < 4; ++jj) {
      int tt = t - 3 + jj;
      if (tt >= 0) xv[jj] = ld4(PROJ + (size_t)(row - 3 + jj) * N1 + 1024 + c);
      else if (prompt) xv[jj] = make_float4(0.f, 0.f, 0.f, 0.f);
      else xv[jj] = ld4(p.in[I_SCV] + (size_t)(b * 3 + (tt + 3)) * 1536 + c);
    }
    float4 acc = ld4(cbias + c);
#pragma unroll
    for (int jj = 0; jj < 4; ++jj) {
      float4 w = ld4(cw + jj * 1536 + c);
      acc.x += xv[jj].x * w.x; acc.y += xv[jj].y * w.y; acc.z += xv[jj].z * w.z; acc.w += xv[jj].w * w.w;
    }
    *(float4*)(XC + (size_t)row * 1536 + c) = make_float4(siluf_(acc.x), siluf_(acc.y), siluf_(acc.z), siluf_(acc.w));
    if (t >= T - 3) {
      float* co = prompt ? (p.out + O_CVP) : (p.out + O_CVS);
      *(float4*)(co + (size_t)(b * 3 + (t - (T - 3))) * 1536 + c) = xv[3];
    }
  }
#pragma unroll 2
  for (int idx = gtid; idx < M * 840; idx += nthr) {
    int row = idx / 840, c = (idx - row * 840) * 4;
    bool prompt; int b, t, T;
    row_info(row, prompt, b, t, T);
    float4 cur = ld4(PROJ + (size_t)row * N1 + 2560 + c);
    float4 prev;
    if (t > 0) prev = ld4(PROJ + (size_t)(row - 1) * N1 + 2560 + c);
    else if (prompt) prev = make_float4(0.f, 0.f, 0.f, 0.f);
    else prev = ld4(p.in[I_SSH] + (size_t)b * 3360 + c);
    float4 m4 = ld4(mu + c);
    float4 mx;
    mx.x = cur.x + (prev.x - cur.x) * m4.x; mx.y = cur.y + (prev.y - cur.y) * m4.y;
    mx.z = cur.z + (prev.z - cur.z) * m4.z; mx.w = cur.w + (prev.w - cur.w) * m4.w;
    if (c < 3072) *(float4*)(RKV + (size_t)row * 3072 + c) = mx;
    else if (c < 3136) st_bf4(LRA + (size_t)row * 64 + (c - 3072), tanhf(mx.x), tanhf(mx.y), tanhf(mx.z), tanhf(mx.w));
    else if (c < 3200) st_bf4(LRB + (size_t)row * 64 + (c - 3136), mx.x, mx.y, mx.z, mx.w);
    else st_bf4(LRG + (size_t)row * 192 + (c - 3200), sigmoidf_(mx.x), sigmoidf_(mx.y), sigmoidf_(mx.z), sigmoidf_(mx.w));
    if (t == T - 1) {
      float* so = prompt ? (p.out + O_SHP) : (p.out + O_SHS);
      *(float4*)(so + (size_t)b * 3360 + c) = cur;
    }
  }
  for (int idx = gtid; idx < M * 4; idx += nthr) {
    int row = idx >> 2, k = idx & 3;
    ((uint4*)(LRG + (size_t)row * 192 + 160))[k] = make_uint4(0, 0, 0, 0);
  }
}

DEVI void phase_pre1c(const Params& p) {
  char* ws = p.ws;
  float* RKV = (float*)(ws + OFF_RKV);
  const float* AA = (const float*)(ws + OFF_AA);
  float* KK = (float*)(ws + OFF_QB);
  float* KKA = (float*)(ws + OFF_MIXB);
  float* BON = (float*)(ws + OFF_BON);
  const float* k_k = p.in[I_KK];
  const float* k_a = p.in[I_KA];
  const float* r_k = p.in[I_RK];
  const int lane = threadIdx.x & 63;
  const int gw = blockIdx.x * 8 + (threadIdx.x >> 6), nw = gridDim.x * 8;
  for (int row = gw; row < M; row += nw) {
    float4 k4[4], r4[4], a4[4];
#pragma unroll
    for (int it = 0; it < 4; ++it) {
      int c = it * 256 + lane * 4;
      k4[it] = ld4(RKV + (size_t)row * 3072 + 1024 + c);
      r4[it] = ld4(RKV + (size_t)row * 3072 + c);
      a4[it] = ld4(AA + (size_t)row * 1024 + c);
    }
#pragma unroll
    for (int it = 0; it < 4; ++it) {
      int c = it * 256 + lane * 4;
      float4 kk4 = ld4(k_k + c), ka4 = ld4(k_a + c), rk4 = ld4(r_k + c);
      float4 k = k4[it], r = r4[it], a = a4[it];
      float4 kr = f4mul(k, kk4);
      float ss = red16(kr.x * kr.x + kr.y * kr.y + kr.z * kr.z + kr.w * kr.w);
      float inv = 1.0f / fmaxf(sqrtf(ss), 1e-12f);
      float4 kk = make_float4(kr.x * inv, kr.y * inv, kr.z * inv, kr.w * inv);
      float4 kp;
      kp.x = k.x * (1.0f + (a.x - 1.0f) * ka4.x); kp.y = k.y * (1.0f + (a.y - 1.0f) * ka4.y);
      kp.z = k.z * (1.0f + (a.z - 1.0f) * ka4.z); kp.w = k.w * (1.0f + (a.w - 1.0f) * ka4.w);
      float bon = red16(r.x * kp.x * rk4.x + r.y * kp.y * rk4.y + r.z * kp.z * rk4.z + r.w * kp.w * rk4.w);
      *(float4*)(KK + (size_t)row * 1024 + c) = kk;
      *(float4*)(KKA + (size_t)row * 1024 + c) = f4mul(kk, a);
      *(float4*)(RKV + (size_t)row * 3072 + 1024 + c) = kp;
      if ((lane & 15) == 0) BON[(size_t)row * 16 + it * 4 + (lane >> 4)] = bon;
    }
  }
}

DEVI void rwkv_short(const float* __restrict__ RKV, const float* __restrict__ DEC, const float* __restrict__ KK,
                     const float* __restrict__ KKA, int h, int rb, int row0, const float* __restrict__ stin,
                     float* __restrict__ stout, float* __restrict__ outp) {
  const int tid = threadIdx.x & 255, w = tid >> 6, lane = tid & 63, rl = lane >> 4, sl = lane & 15;
  const int il = w * 4 + rl;
  float4 sv = *(const float4*)(stin + il * 64 + sl * 4);
  float S[4] = {sv.x, sv.y, sv.z, sv.w};
  float4 r4[4], w4[4], k4[4], n4[4], m4[4];
  float vi[4];
#pragma unroll
  for (int t = 0; t < 4; ++t) {
    const size_t row = (size_t)(row0 + t);
    r4[t] = *(const float4*)(RKV + row * 3072 + h * 64 + sl * 4);
    w4[t] = *(const float4*)(DEC + row * 1024 + h * 64 + sl * 4);
    k4[t] = *(const float4*)(RKV + row * 3072 + 1024 + h * 64 + sl * 4);
    n4[t] = *(const float4*)(KK + row * 1024 + h * 64 + sl * 4);
    m4[t] = *(const float4*)(KKA + row * 1024 + h * 64 + sl * 4);
    vi[t] = RKV[row * 3072 + 2048 + h * 64 + rb * 16 + il];
  }
#pragma unroll
  for (int t = 0; t < 4; ++t) {
    float sa = S[0] * n4[t].x + S[1] * n4[t].y + S[2] * n4[t].z + S[3] * n4[t].w;
    sa = -red16(sa);
    S[0] = S[0] * w4[t].x + sa * m4[t].x + vi[t] * k4[t].x;
    S[1] = S[1] * w4[t].y + sa * m4[t].y + vi[t] * k4[t].y;
    S[2] = S[2] * w4[t].z + sa * m4[t].z + vi[t] * k4[t].z;
    S[3] = S[3] * w4[t].w + sa * m4[t].w + vi[t] * k4[t].w;
    float y = S[0] * r4[t].x + S[1] * r4[t].y + S[2] * r4[t].z + S[3] * r4[t].w;
    y = red16(y);
    if (sl == 0) outp[(size_t)t * 2048 + il] = y;
  }
  *(float4*)(stout + il * 64 + sl * 4) = make_float4(S[0], S[1], S[2], S[3]);
}

DEVI void phase_rec1(const Params& p, float* smem) {
  char* ws = p.ws;
  const float* XC = (const float*)(ws + OFF_GOUT);
  const float* RKV = (const float*)(ws + OFF_RKV);
  const float* DEC = (const float*)(ws + OFF_DEC);
  const float* KK = (const float*)(ws + OFF_QB);
  const float* KKA = (const float*)(ws + OFF_MIXB);
  const float* DTA = (const float*)(ws + OFF_DTA);
  float* OMIX = (float*)(ws + OFF_OMIX);
  const float* wsf = (const float*)ws;
  constexpr int XO = (int)(OFF_GOUT / 4), DO = (int)(OFF_DTA / 4), RO = (int)(OFF_RKV / 4), CO = (int)(OFF_DEC / 4),
                KO = (int)(OFF_QB / 4), AO = (int)(OFF_MIXB / 4);
  const int half = threadIdx.x >> 8;
  for (int li = blockIdx.x; li < 256; li += gridDim.x) {
    if (half == 0) {
      int b = li >> 6, h = (li >> 2) & 15, cb = li & 3;
      int g = h >> 3;
      Seg sg[4] = {{XO + 1024 + g * 128, 1536, 32}, {XO + 1280 + g * 128, 1536, 32}, {XO + h * 64 + cb * 16, 1536, 4},
                   {DO + h * 4, 64, 1}};
      int row0 = b * TP;
      colrec_long<2>(wsf, sg, row0, TP, 0.f, OMIX + (size_t)row0 * 2048 + h * 64 + cb * 16, 2048,
                     p.out + O_SSP + (size_t)(b * 16 + h) * 128 * 64 + cb * 16, 64, smem);
    } else {
      int b = li >> 6, h = (li >> 2) & 15, rb = li & 3;
      int row0 = b * TP;
      Seg sg[6] = {{RO + h * 64, 3072, 16}, {CO + h * 64, 1024, 16}, {RO + 1024 + h * 64, 3072, 16},
                   {KO + h * 64, 1024, 16}, {AO + h * 64, 1024, 16}, {RO + 2048 + h * 64 + rb * 16, 3072, 4}};
      size_t so = ((size_t)(b * 16 + h) * 64 + rb * 16) * 64;
      rwkv_item(wsf, sg, row0, TP, nullptr, p.out + O_WKP + so, OMIX + (size_t)row0 * 2048 + 1024 + h * 64 + rb * 16, 2048, smem);
    }
  }
  for (int it = blockIdx.x * 2 + half; it < 2048; it += gridDim.x * 2) {
    int b = it >> 4, h = it & 15;
    int g = h >> 3;
    long row0 = MPR + (long)b * 4;
    size_t so = (size_t)(b * 16 + h) * 128 * 64;
    colrec_short<2>(XC + 1024 + g * 128, 1536, XC + 1280 + g * 128, 1536, XC + h * 64, 1536, DTA + h * 4, row0, 0.f,
                    p.in[I_SSM] + so, p.out + O_SSS + so, 64, OMIX + h * 64, 2048, smem);
  }
  for (int it = blockIdx.x * 2 + half; it < 8192; it += gridDim.x * 2) {
    int b = it >> 6, h = (it >> 2) & 15, rb = it & 3;
    int row0 = MPR + b * 4;
    size_t so = ((size_t)(b * 16 + h) * 64 + rb * 16) * 64;
    rwkv_short(RKV, DEC, KK, KKA, h, rb, row0, p.in[I_SWK] + so, p.out + O_WKS + so,
               OMIX + (size_t)row0 * 2048 + 1024 + h * 64 + rb * 16);
  }
}

DEVI void phase_post1(const Params& p) {
  char* ws = p.ws;
  const float* PROJ = (const float*)(ws + OFF_PROJ);
  const float* OMIX = (const float*)(ws + OFF_OMIX);
  const float* XC = (const float*)(ws + OFF_GOUT);
  const float* RKV = (const float*)(ws + OFF_RKV);
  const float* GG = (const float*)(ws + OFF_GG);
  const float* BON = (const float*)(ws + OFF_BON);
  u16* MIXB = (u16*)(ws + OFF_MIXB);
  const float* dsk = p.in[I_DSK];
  const float* sng = p.in[I_SNG];
  const float* lxg = p.in[I_LXG];
  const float* lxb = p.in[I_LXB];
  const int lane = threadIdx.x & 63;
  const int gw = blockIdx.x * 8 + (threadIdx.x >> 6), nw = gridDim.x * 8;
  for (int row = gw; row < M; row += nw) {
    const float* o = OMIX + (size_t)row * 2048;
    u16* mo = MIXB + (size_t)row * 2048;
    float4 oc[4], xc[4], z[4], y[4], v[4], gg[4];
    float bn[4];
#pragma unroll
    for (int it = 0; it < 4; ++it) {
      int c = it * 256 + lane * 4;
      oc[it] = ld4(o + c);
      xc[it] = ld4(XC + (size_t)row * 1536 + c);
      z[it] = ld4(PROJ + (size_t)row * N1 + c);
      y[it] = ld4(o + 1024 + c);
      v[it] = ld4(RKV + (size_t)row * 3072 + 2048 + c);
      gg[it] = ld4(GG + (size_t)row * 1024 + c);
      bn[it] = BON[(size_t)row * 16 + it * 4 + (lane >> 4)];
    }
    float4 val[4];
    float ssq[4];
#pragma unroll
    for (int it = 0; it < 4; ++it) {
      float ds = dsk[it * 4 + (lane >> 4)];
      val[it].x = (oc[it].x + xc[it].x * ds) * z[it].x;
      val[it].y = (oc[it].y + xc[it].y * ds) * z[it].y;
      val[it].z = (oc[it].z + xc[it].z * ds) * z[it].z;
      val[it].w = (oc[it].w + xc[it].w * ds) * z[it].w;
      ssq[it] = val[it].x * val[it].x + val[it].y * val[it].y + val[it].z * val[it].z + val[it].w * val[it].w;
    }
    float inv0 = rsqrtf(wsum_u_(ssq[0] + ssq[1]) * (1.0f / 512.0f) + 1e-6f);
    float inv1 = rsqrtf(wsum_u_(ssq[2] + ssq[3]) * (1.0f / 512.0f) + 1e-6f);
#pragma unroll
    for (int it = 0; it < 4; ++it) {
      int c = it * 256 + lane * 4;
      float inv = (it < 2) ? inv0 : inv1;
      float4 sg = ld4(sng + c);
      st_bf4(mo + c, val[it].x * inv * sg.x, val[it].y * inv * sg.y, val[it].z * inv * sg.z, val[it].w * inv * sg.w);
      float mu = red16(y[it].x + y[it].y + y[it].z + y[it].w) * (1.0f / 64.0f);
      float dx = y[it].x - mu, dy = y[it].y - mu, dz = y[it].z - mu, dw = y[it].w - mu;
      float var = red16(dx * dx + dy * dy + dz * dz + dw * dw) * (1.0f / 64.0f);
      float iv = rsqrtf(var + 64e-5f);
      float4 lg = ld4(lxg + c), lb = ld4(lxb + c);
      float y0 = (dx * iv * lg.x + lb.x + bn[it] * v[it].x) * gg[it].x;
      float y1 = (dy * iv * lg.y + lb.y + bn[it] * v[it].y) * gg[it].y;
      float y2 = (dz * iv * lg.z + lb.z + bn[it] * v[it].z) * gg[it].z;
      float y3 = (dw * iv * lg.w + lb.w + bn[it] * v[it].w) * gg[it].w;
      st_bf4(mo + 1024 + c, y0, y1, y2, y3);
    }
  }
}

#define XB_TMO      128
#define XB_XCNT(j)  (256  + 64 * (j))
#define XB_XSUB(j)  (1280 + 64 * (j))
#define XB_XGEN(j)  (2304 + 64 * (j))
#define XB_TOP      3328
#define XB_TOPGEN   3392
#define XCD_BAR_WORDS 3456
#define XB_SPIN_CAP (1u << 18)
#define LAS __attribute__((address_space(3)))

__device__ __forceinline__ unsigned xb_ld(unsigned* p)              { return __hip_atomic_load(p, __ATOMIC_RELAXED, __HIP_MEMORY_SCOPE_AGENT); }
__device__ __forceinline__ unsigned xb_add(unsigned* p, unsigned v) { return __hip_atomic_fetch_add(p, v, __ATOMIC_RELAXED, __HIP_MEMORY_SCOPE_AGENT); }
__device__ __forceinline__ unsigned xb_xcc_id() { return (unsigned)__builtin_amdgcn_s_getreg((3 << 11) | 20) & 0xFu; }
#define XB_SPIN(cond, bar) do { unsigned _sp = 0; while (cond) { __builtin_amdgcn_s_sleep(1); \
    if ((++_sp & 255u) == 0u) { if (xb_ld(&(bar)[XB_TMO])) break; if (_sp > XB_SPIN_CAP) { atomicAdd(&(bar)[XB_TMO], 1u); break; } } } } while (0)

struct XcdBarrier {
    unsigned* bar; unsigned x;
    volatile LAS unsigned* st;
};

__device__ __forceinline__ XcdBarrier xcd_barrier_post(unsigned* bar, volatile LAS unsigned* st) {
    XcdBarrier b; b.bar = bar; b.x = xb_xcc_id(); b.st = st;
    if (threadIdx.x == 0) (void)xb_add(&bar[XB_XCNT(b.x)], 1u);
    return b;
}
__device__ __forceinline__ void xcd_barrier_complete(unsigned* bar, unsigned x, unsigned& nloc, unsigned& nx) {
    const unsigned G = gridDim.x * gridDim.y * gridDim.z;
    unsigned sum, cnt, mine, sp = 0u;
    for (;;) {
        sum = 0u; cnt = 0u; mine = 0u;
#pragma unroll
        for (unsigned j = 0; j < 16; ++j) { const unsigned c = xb_ld(&bar[XB_XCNT(j)]); sum += c; cnt += (c > 0u) ? 1u : 0u; mine = (j == x) ? c : mine; }
        if (sum == G) break;
        __builtin_amdgcn_s_sleep(1);
        if ((++sp & 255u) == 0u) { if (xb_ld(&bar[XB_TMO])) break; if (sp > XB_SPIN_CAP) { atomicAdd(&bar[XB_TMO], 1u); break; } }
    }
    nloc = mine > 0u ? mine : 1u; nx = cnt > 0u ? cnt : 1u;
}

__device__ __forceinline__ void xcd_barrier(const XcdBarrier& b) {
    asm volatile("s_waitcnt vmcnt(0)" ::: "memory");
    __syncthreads();
    if (threadIdx.x == 0) {
        unsigned* bar = b.bar;
        __builtin_amdgcn_s_waitcnt(0);
        unsigned nloc = b.st[0], nx = b.st[1];
        if (nloc == 0u) { xcd_barrier_complete(bar, b.x, nloc, nx); b.st[0] = nloc; b.st[1] = nx; }
        const unsigned old = xb_add(&bar[XB_XSUB(b.x)], 1u);
        const unsigned gen = old / nloc;
        if (old + 1u == (gen + 1u) * nloc) {
            __builtin_amdgcn_fence(__ATOMIC_RELEASE, "agent");
            asm volatile("s_waitcnt vmcnt(0)" ::: "memory");
            const unsigned og = xb_add(&bar[XB_TOP], 1u);
            const unsigned tg = og / nx;
            if (og + 1u == (tg + 1u) * nx) xb_add(&bar[XB_TOPGEN], 1u);
            else XB_SPIN(xb_ld(&bar[XB_TOPGEN]) == tg, bar);
            __builtin_amdgcn_fence(__ATOMIC_ACQUIRE, "agent");
            xb_add(&bar[XB_XGEN(b.x)], 1u);
            asm volatile("s_waitcnt vmcnt(0)" ::: "memory");
        } else {
            XB_SPIN(xb_ld(&bar[XB_XGEN(b.x)]) == gen, bar);
            __builtin_amdgcn_fence(__ATOMIC_ACQUIRE, "agent");
            asm volatile("s_waitcnt vmcnt(0)" ::: "memory");
        }
    }
    __syncthreads();
}


template <int ph>
DEVI void run_phase(const Params& p, char* smem_raw) {
  float* smem = (float*)smem_raw;
  char* ws = p.ws;
  {
    switch (ph) {
      case 0:
        phase0(p, smem);
        conv_fp8_rows(p.in[I_PU], (unsigned char*)(ws + OFF_UB), (float*)(ws + OFF_USC));
        conv_fp8_rows(p.in[I_PV], (unsigned char*)(ws + OFF_VB), (float*)(ws + OFF_VSC));
        break;
      case 1: {
        EpiIn0 E{(float*)(ws + OFF_PROJ), (const float*)(ws + OFF_LB), (const float*)(ws + OFF_INVREV)};
        pg8::Gemm g{(const pg8::bf16_t*)(ws + OFF_XB), (const pg8::bf16_t*)(ws + OFF_WIN0), MP, N0, 2048};
        pg8::StaticOrder S;
        S.init(MP, N0, (int)gridDim.x, (int)blockIdx.x);
        pg8::gemm_phase<EpiIn0, pg8::StaticOrder, false>((PG8_LAS unsigned char*)smem_raw, g, S, E, nullptr);
      } break;
      case 2: phase_rec0(p, smem); break;
      case 3: phase_post0(p); break;
      case 4: case 15: {
        float* GO = (float*)(ws + OFF_GOUT);
        gemm_phase((const u16*)(ws + OFF_MIXB), 2048, 0, (const u16*)(ws + (ph == 4 ? OFF_WOUT0 : OFF_WOUT1)), 2048,
                   69, 16, smem_raw, [=](int row, int col, float v0, float v1) {
                     GO[(size_t)row * 2048 + col] = v0;
                     GO[(size_t)row * 2048 + col + 32] = v1;
                   });
      } break;
      case 5: case 16: {
        int l = (ph == 5) ? 0 : 1;
        phase_ln(p, (const float*)(ws + OFF_GOUT), p.in[I_LNG] + (size_t)(l * 2) * D, p.in[I_LNB] + (size_t)(l * 2) * D);
      } break;
      case 6: case 17: {
        u16* QB = (u16*)(ws + OFF_QB);
        gemm_phase((const u16*)(ws + OFF_XB), 2048, 0, (const u16*)(ws + (ph == 6 ? OFF_WQ0 : OFF_WQ1)), 2048, 69,
                   16, smem_raw, [=](int row, int col, float v0, float v1) {
                     QB[(size_t)row * 2048 + col] = f2bf(v0);
                     QB[(size_t)row * 2048 + col + 32] = f2bf(v1);
                   });
      } break;
      case 7: case 18: {
        float* SC = (float*)(ws + OFF_GOUT);
        gemm_phase((const u16*)(ws + OFF_QB), 2048, 128, (const u16*)(ws + (ph == 7 ? OFF_KEY0 : OFF_KEY1)), 128,
                   69, 16, smem_raw, [=](int row, int col, float v0, float v1) {
                     SC[(size_t)row * 2048 + col] = v0;
                     SC[(size_t)row * 2048 + col + 32] = v1;
                   });
      } break;
      case 8: phase_peer(p, 0, false); break;
      case 9: {
        conv_fp8_rows(p.in[I_PU] + (size_t)16384 * 2048, (unsigned char*)(ws + OFF_UB), (float*)(ws + OFF_USC));
        conv_fp8_rows(p.in[I_PV] + (size_t)16384 * 2048, (unsigned char*)(ws + OFF_VB), (float*)(ws + OFF_VSC));
        EpiIn1 E{(float*)(ws + OFF_PROJ), (float*)(ws + OFF_DTA), p.in[I_DTB], p.in[I_ALOG]};
        pg8::Gemm g{(const pg8::bf16_t*)(ws + OFF_XB), (const pg8::bf16_t*)(ws + OFF_WIN1), MP, N1, 2048};
        pg8::StaticOrder S;
        S.init(MP, N1, (int)gridDim.x, (int)blockIdx.x);
        pg8::gemm_phase<EpiIn1, pg8::StaticOrder, false>((PG8_LAS unsigned char*)smem_raw, g, S, E, nullptr);
      } break;
      case 10: phase_pre1(p); break;
      case 11: {
        float* DEC = (float*)(ws + OFF_DEC);
        float* AA = (float*)(ws + OFF_AA);
        float* GG = (float*)(ws + OFF_GG);
        const float* w0 = p.in[I_W0];
        const float* a0 = p.in[I_A0];
        gemm_phase((const u16*)(ws + OFF_LRA), 64, 0, (const u16*)(ws + OFF_W2T), 64, 69, 8, smem_raw,
                   [=](int row, int col, float v0, float v1) {
#pragma unroll
                     for (int e = 0; e < 2; ++e) {
                       int cc = col + e * 32;
                       float v = (e ? v1 : v0);
                       float wl = -softplusf_(-v) - 0.5f;
                       DEC[(size_t)row * 1024 + cc] = expf(-expf(wl));
                     }
                   }, w0);
        gemm_phase((const u16*)(ws + OFF_LRB), 64, 0, (const u16*)(ws + OFF_A2T), 64, 69, 8, smem_raw,
                   [=](int row, int col, float v0, float v1) {
                     AA[(size_t)row * 1024 + col] = sigmoidf_(v0);
                     AA[(size_t)row * 1024 + col + 32] = sigmoidf_(v1);
                   }, a0);
        gemm_phase((const u16*)(ws + OFF_LRG), 192, 0, (const u16*)(ws + OFF_G2T), 192, 69, 8, smem_raw,
                   [=](int row, int col, float v0, float v1) {
                     GG[(size_t)row * 1024 + col] = v0;
                     GG[(size_t)row * 1024 + col + 32] = v1;
                   });
      } break;
      case 12: phase_pre1c(p); break;
      case 13: phase_rec1(p, smem); break;
      case 14: phase_post1(p); break;
      case 19: phase_peer(p, 1, true); break;
      default: break;
    }
  }
}

__global__ void __launch_bounds__(512, 2) mega(Params p, int ph_lo, int ph_hi) {
  __shared__ __attribute__((aligned(16))) char smem_raw[SMEM_BYTES];
  __shared__ uint4 xb_words;
  cg::grid_group grid = cg::this_grid();
  if (threadIdx.x == 0) xb_words = make_uint4(0u, 0u, 0u, 0u);
  __syncthreads();
  XcdBarrier xb = xcd_barrier_post((unsigned*)(p.ws + OFF_BAR), (volatile LAS unsigned*)&xb_words);
  if (ph_hi > 1000) grid.sync();
#ifndef REPEAT_MASK
#define REPEAT_MASK 0
#endif
#define PHASE(K)                                          \
  if (ph_lo <= K && K < ph_hi) run_phase<K>(p, smem_raw); \
  if ((REPEAT_MASK >> K) & 1) { xcd_barrier(xb); run_phase<K>(p, smem_raw); } \
  if (ph_lo <= K && K + 1 < ph_hi) xcd_barrier(xb);
  PHASE(0) PHASE(1) PHASE(2) PHASE(3) PHASE(4) PHASE(5) PHASE(6) PHASE(7) PHASE(8) PHASE(9)
  PHASE(10) PHASE(11) PHASE(12) PHASE(13) PHASE(14) PHASE(15) PHASE(16) PHASE(17) PHASE(18) PHASE(19)
}
#ifdef PHASE_TEST
template <int PH>
__global__ void __launch_bounds__(512, 2) phk(Params p) {
  __shared__ __attribute__((aligned(16))) char smem_raw[SMEM_BYTES];
  run_phase<PH>(p, smem_raw);
}
#define INST(N) template __global__ void phk<N>(Params);
INST(0) INST(1) INST(2) INST(3) INST(4) INST(5) INST(6) INST(7) INST(8) INST(9) INST(10) INST(11) INST(12) INST(13) INST(14) INST(19)
#endif

constexpr int NPHASE = 20;

extern "C" void kernel_launch(void* const* d_in, const int* in_sizes, int n_in, void* d_out, int out_size, void* d_ws,
                              size_t ws_size, hipStream_t stream) {
  static int grid_blocks = 0;
  if (!grid_blocks) {
    int dev = 0, cus = 0, per_cu = 0;
    hipGetDevice(&dev);
    hipDeviceGetAttribute(&cus, hipDeviceAttributeMultiprocessorCount, dev);
    hipOccupancyMaxActiveBlocksPerMultiprocessor(&per_cu, mega, 512, 0);
    if (per_cu > 1) per_cu = 1;
    if (per_cu < 1) per_cu = 1;
    grid_blocks = cus * per_cu;
  }
  Params p{};
  for (int i = 0; i < 38; ++i) p.in[i] = (const float*)d_in[i];
  p.out = (float*)d_out;
  p.ws = (char*)d_ws;
  (void)hipMemsetAsync((char*)d_ws + OFF_BAR, 0, 3456 * 4, stream);
  int lo = 0, hi = NPHASE;
  void* args[] = {&p, &lo, &hi};
  hipError_t e = hipLaunchCooperativeKernel((void*)mega, dim3(grid_blocks), dim3(512), args, 0, stream);
  if (e != hipSuccess) fprintf(stderr, "cooperative launch failed: %s (grid %d)\n", hipGetErrorString(e), grid_blocks);
}
```

```cpp
#include <hip/hip_runtime.h>
#include <hip/hip_bf16.h>
#include <hip/hip_cooperative_groups.h>
#include <cstdio>
#include <cmath>
namespace cg = cooperative_groups;

#define DEVI __device__ __forceinline__
typedef unsigned short u16;
using bf16x8 = __attribute__((ext_vector_type(8))) short;
using f32x4 = __attribute__((ext_vector_type(4))) float;
using u32x4 = __attribute__((ext_vector_type(4))) unsigned int;

constexpr int D = 2048;
constexpr int TP = 2064;
constexpr int MPR = 8256;
constexpr int M = 8768;
constexpr int MP = 8960;
constexpr int N0 = 7168;
constexpr int N1 = 6144;
constexpr float ALPHA = 1.41421356237f;

constexpr size_t SZ_TAB = (size_t)16384 * 2048 * 2;
constexpr size_t OFF_UB = 0;
constexpr size_t OFF_VB = OFF_UB + SZ_TAB;
constexpr size_t OFF_WIN0 = OFF_VB + SZ_TAB;
constexpr size_t OFF_WOUT0 = OFF_WIN0 + (size_t)N0 * 2048 * 2;
constexpr size_t OFF_WQ0 = OFF_WOUT0 + (size_t)2048 * 2048 * 2;
constexpr size_t OFF_KEY0 = OFF_WQ0 + (size_t)2048 * 2048 * 2;
constexpr size_t OFF_WIN1 = OFF_KEY0 + (size_t)16 * 128 * 128 * 2;
constexpr size_t OFF_WOUT1 = OFF_WIN1 + (size_t)N1 * 2048 * 2;
constexpr size_t OFF_WQ1 = OFF_WOUT1 + (size_t)2048 * 2048 * 2;
constexpr size_t OFF_KEY1 = OFF_WQ1 + (size_t)2048 * 2048 * 2;
constexpr size_t OFF_W2T = OFF_KEY1 + (size_t)16 * 128 * 128 * 2;
constexpr size_t OFF_A2T = OFF_W2T + (size_t)1024 * 64 * 2;
constexpr size_t OFF_G2T = OFF_A2T + (size_t)1024 * 64 * 2;
constexpr size_t OFF_LB = OFF_G2T + (size_t)1024 * 192 * 2;
constexpr size_t OFF_INVREV = OFF_LB + 1024 * 4;
constexpr size_t OFF_XF = OFF_INVREV + 64 * 8;
constexpr size_t OFF_XB = OFF_XF + (size_t)MP * 2048 * 4;
constexpr size_t OFF_PROJ = OFF_XB + (size_t)MP * 2048 * 2;
constexpr size_t OFF_GOUT = OFF_PROJ + (size_t)MP * N0 * 4;
constexpr size_t OFF_OMIX = OFF_GOUT + (size_t)MP * 2048 * 4;
constexpr size_t OFF_MIXB = OFF_OMIX + (size_t)MP * 2048 * 4;
constexpr size_t OFF_QB = OFF_MIXB + (size_t)MP * 2048 * 2;
constexpr size_t OFF_RKV = OFF_QB + (size_t)MP * 2048 * 2;
constexpr size_t OFF_DEC = OFF_RKV + (size_t)MP * 3072 * 4;
constexpr size_t OFF_AA = OFF_DEC + (size_t)MP * 1024 * 4;
constexpr size_t OFF_GG = OFF_AA + (size_t)MP * 1024 * 4;
constexpr size_t OFF_LRA = OFF_GG + (size_t)MP * 1024 * 4;
constexpr size_t OFF_LRB = OFF_LRA + (size_t)MP * 64 * 2;
constexpr size_t OFF_LRG = OFF_LRB + (size_t)MP * 64 * 2;
constexpr size_t OFF_DTA = OFF_LRG + (size_t)MP * 192 * 2;
constexpr size_t OFF_BON = OFF_DTA + (size_t)MP * 64 * 4;
constexpr size_t OFF_USC = OFF_BON + (size_t)MP * 16 * 4;
constexpr size_t OFF_VSC = OFF_USC + 16384 * 4;
constexpr size_t OFF_BAR = OFF_VSC + 16384 * 4;
constexpr size_t WS_TOTAL = OFF_BAR + 3456 * 4;
static_assert(WS_TOTAL <= (size_t)1 << 30, "workspace too large");

constexpr size_t O_YP = 0;
constexpr size_t O_YS = O_YP + (size_t)4 * 2048 * 2048;
constexpr size_t O_HGP = O_YS + (size_t)128 * 4 * 2048;
constexpr size_t O_HGS = O_HGP + (size_t)4 * 8 * 128 * 128;
constexpr size_t O_RTP = O_HGS + (size_t)128 * 8 * 128 * 128;
constexpr size_t O_RTS = O_RTP + (size_t)4 * 4 * 128 * 256;
constexpr size_t O_SSP = O_RTS + (size_t)128 * 4 * 128 * 256;
constexpr size_t O_SSS = O_SSP + (size_t)4 * 16 * 128 * 64;
constexpr size_t O_CVP = O_SSS + (size_t)128 * 16 * 128 * 64;
constexpr size_t O_CVS = O_CVP + (size_t)4 * 3 * 1536;
constexpr size_t O_WKP = O_CVS + (size_t)128 * 3 * 1536;
constexpr size_t O_WKS = O_WKP + (size_t)4 * 16 * 64 * 64;
constexpr size_t O_SHP = O_WKS + (size_t)128 * 16 * 64 * 64;
constexpr size_t O_SHS = O_SHP + (size_t)4 * 3360;

struct Params {
  const float* in[38];
  float* out;
  char* ws;
};
enum { I_XP = 0, I_XS, I_SHG, I_SRT, I_SSM, I_SCV, I_SWK, I_SSH, I_META, I_LNG, I_LNB, I_EWIN, I_LBL, I_HNG, I_EWOUT,
       I_OWIN, I_CVW, I_CVB, I_DTB, I_ALOG, I_DSK, I_SNG, I_MU, I_W0, I_W2, I_A0, I_A2, I_G2, I_KK, I_KA, I_RK,
       I_LXG, I_LXB, I_OWOUT, I_WQ, I_KEYS, I_PU, I_PV };

constexpr int VB_BYTES = 2 * 2 * 128 * 72 * 2;
constexpr int SMEM_BYTES = 2 * VB_BYTES;

DEVI u16 f2bf(float f) {
  unsigned u = __float_as_uint(f);
  u += 0x7fffu + ((u >> 16) & 1u);
  return (u16)(u >> 16);
}
DEVI unsigned pack2(float a, float b) { return (unsigned)f2bf(a) | ((unsigned)f2bf(b) << 16); }
DEVI float bflo(unsigned u) { return __uint_as_float(u << 16); }
DEVI float bfhi(unsigned u) { return __uint_as_float(u & 0xffff0000u); }
DEVI float sigmoidf_(float x) { return __builtin_amdgcn_rcpf(1.0f + __builtin_amdgcn_exp2f(-1.44269504089f * x)); }
DEVI float siluf_(float x) { return x * __builtin_amdgcn_rcpf(1.0f + __builtin_amdgcn_exp2f(-1.44269504089f * x)); }
DEVI float sigmoid_acc(float x) { return 1.0f / (1.0f + expf(-x)); }
DEVI float silu_acc(float x) { return x / (1.0f + expf(-x)); }
DEVI float softplusf_(float x) { return fmaxf(x, 0.0f) + log1pf(expf(-fabsf(x))); }
DEVI float wsum(float v) {
#pragma unroll
  for (int o = 32; o > 0; o >>= 1) v += __shfl_xor(v, o, 64);
  return v;
}
DEVI float wmaxf_(float v) {
#pragma unroll
  for (int o = 32; o > 0; o >>= 1) v = fmaxf(v, __shfl_xor(v, o, 64));
  return v;
}
DEVI int wmini_(int v) {
#pragma unroll
  for (int o = 32; o > 0; o >>= 1) v = min(v, __shfl_xor(v, o, 64));
  return v;
}
template <int CTRL>
DEVI float dppf(float v) {
  return __int_as_float(__builtin_amdgcn_update_dpp(0, __float_as_int(v), CTRL, 0xF, 0xF, true));
}
DEVI float red8(float v) {
  v += dppf<0xB1>(v);
  v += dppf<0x4E>(v);
  v += dppf<0x141>(v);
  return v;
}
DEVI float red16(float v) {
  v = red8(v);
  v += dppf<0x140>(v);
  return v;
}
DEVI float rlf_(float v, int l) { return __int_as_float(__builtin_amdgcn_readlane(__float_as_int(v), l)); }
DEVI int row_pos(int row) { return row < MPR ? (row % TP) : (16384 + ((row - MPR) & 3)); }

DEVI void conv_bf16_flat(const float* __restrict__ src, u16* __restrict__ dst, size_t n4) {
  size_t stride = (size_t)gridDim.x * blockDim.x;
  for (size_t i = (size_t)blockIdx.x * blockDim.x + threadIdx.x; i < n4; i += stride) {
    float4 v = ((const float4*)src)[i];
    uint2 o;
    o.x = pack2(v.x, v.y);
    o.y = pack2(v.z, v.w);
    ((uint2*)dst)[i] = o;
  }
}

template <int MODE>
DEVI int colmap(int j) {
  if (MODE == 0) return j;
  if (MODE == 1) {
    if (j < 4096 || j >= 5120) return j;
    int hb = j & ~127, c = j & 127, wc = c >> 5, n = (c >> 4) & 1, r = c & 15;
    int d = n ? (64 + wc * 16 + r) : (wc * 16 + r);
    return hb + d;
  }
  if (j < 2560) return j;
  if (j < 5920) return j + 16;
  if (j < 5936) return 2560 + (j - 5920);
  return -1;
}

template <int MODE>
DEVI void transpose_job(const float* __restrict__ src, int ldsrc, int Ksrc, u16* __restrict__ dst, int Kdst, int ndst,
                        float* smem) {
  int ktiles = Kdst / 64, ntiles = ndst / 64;
  int tid = threadIdx.x & 255;
  const int half = threadIdx.x >> 8;
  smem += half * (64 * 65);
  for (int base = blockIdx.x * 2; base < ktiles * ntiles; base += gridDim.x * 2) {
    int tile = base + half;
    const bool valid = tile < ktiles * ntiles;
    if (!valid) tile = ktiles * ntiles - 1;
    int tn = tile / ktiles, tk = tile % ktiles;
    int j0 = tn * 64, k0 = tk * 64;
    int jj = (tid & 15) * 4;
    int sc = colmap<MODE>(j0 + jj);
#pragma unroll
    for (int i = 0; i < 4; ++i) {
      int kk = i * 16 + (tid >> 4);
      float4 v = make_float4(0.f, 0.f, 0.f, 0.f);
      if (sc >= 0 && (k0 + kk) < Ksrc) v = *(const float4*)(src + (size_t)(k0 + kk) * ldsrc + sc);
      smem[kk * 65 + jj] = v.x;
      smem[kk * 65 + jj + 1] = v.y;
      smem[kk * 65 + jj + 2] = v.z;
      smem[kk * 65 + jj + 3] = v.w;
    }
    __syncthreads();
    int jr = tid >> 2, kq = (tid & 3) * 16;
    unsigned pk[8];
#pragma unroll
    for (int e = 0; e < 8; ++e) pk[e] = pack2(smem[(kq + 2 * e) * 65 + jr], smem[(kq + 2 * e + 1) * 65 + jr]);
    uint4* dp = (uint4*)(dst + (size_t)(j0 + jr) * Kdst + k0 + kq);
    if (valid) {
      dp[0] = make_uint4(pk[0], pk[1], pk[2], pk[3]);
      dp[1] = make_uint4(pk[4], pk[5], pk[6], pk[7]);
    }
    __syncthreads();
  }
}

DEVI void phase0(const Params& p, float* smem) {
  char* ws = p.ws;
  conv_bf16_flat(p.in[I_KEYS], (u16*)(ws + OFF_KEY0), (size_t)16 * 128 * 128 / 4);
  conv_bf16_flat(p.in[I_KEYS] + (size_t)16 * 128 * 128, (u16*)(ws + OFF_KEY1), (size_t)16 * 128 * 128 / 4);
  transpose_job<1>(p.in[I_EWIN], N0, 2048, (u16*)(ws + OFF_WIN0), 2048, N0, smem);
  transpose_job<0>(p.in[I_EWOUT], 2048, 2048, (u16*)(ws + OFF_WOUT0), 2048, 2048, smem);
  transpose_job<0>(p.in[I_WQ], 2048, 2048, (u16*)(ws + OFF_WQ0), 2048, 2048, smem);
  transpose_job<0>(p.in[I_WQ] + (size_t)2048 * 2048, 2048, 2048, (u16*)(ws + OFF_WQ1), 2048, 2048, smem);
  transpose_job<2>(p.in[I_OWIN], 5936, 2048, (u16*)(ws + OFF_WIN1), 2048, N1, smem);
  transpose_job<0>(p.in[I_OWOUT], 2048, 2048, (u16*)(ws + OFF_WOUT1), 2048, 2048, smem);
  transpose_job<0>(p.in[I_W2], 1024, 64, (u16*)(ws + OFF_W2T), 64, 1024, smem);
  transpose_job<0>(p.in[I_A2], 1024, 64, (u16*)(ws + OFF_A2T), 64, 1024, smem);
  transpose_job<0>(p.in[I_G2], 1024, 160, (u16*)(ws + OFF_G2T), 192, 1024, smem);
  {
    float* XF = (float*)(ws + OFF_XF);
    u16* XB = (u16*)(ws + OFF_XB);
    size_t n4 = (size_t)MP * 512;
    size_t stride = (size_t)gridDim.x * blockDim.x;
    for (size_t i = (size_t)blockIdx.x * blockDim.x + threadIdx.x; i < n4; i += stride) {
      int row = (int)(i >> 9), c4 = (int)(i & 511);
      float4 v = make_float4(0.f, 0.f, 0.f, 0.f);
      if (row < MPR) {
        int b = row / TP, t = row % TP;
        const float* s = (t < 16) ? (p.in[I_META] + (size_t)t * D) : (p.in[I_XP] + ((size_t)b * 2048 + (t - 16)) * D);
        v = ((const float4*)s)[c4];
      } else if (row < M) {
        v = ((const float4*)(p.in[I_XS] + (size_t)(row - MPR) * D))[c4];
      }
      ((float4*)XF)[i] = v;
      uint2 o;
      o.x = pack2(v.x, v.y);
      o.y = pack2(v.z, v.w);
      ((uint2*)XB)[i] = o;
    }
  }
  if (blockIdx.x == 0) {
    float* LB = (float*)(ws + OFF_LB);
    const float* lg = p.in[I_LBL];
    for (int c = threadIdx.x; c < 1024; c += blockDim.x) {
      float a = lg[c], b = lg[1024 + c], d = lg[2048 + c];
      float m = fmaxf(a, fmaxf(b, d));
      float ea = expf(a - m), eb = expf(b - m), ed = expf(d - m);
      LB[c] = ea / (ea + eb + ed);
    }
    float* IR = (float*)(ws + OFF_INVREV);
    if (threadIdx.x < 64) {
      double d = (double)threadIdx.x;
      double v = exp(-d * (9.210340371976184 / 64.0)) * 0.15915494309189535;
      float h = (float)v;
      IR[threadIdx.x * 2] = h;
      IR[threadIdx.x * 2 + 1] = (float)(v - (double)h);
    }
  }
}

constexpr int G_LDS_STRIDE = 72;
constexpr int G_LDS_BUF = 2 * 128 * G_LDS_STRIDE;
template <class Epi>
DEVI void gemm_phase(const u16* __restrict__ A, int lda, int a_ntile_off, const u16* __restrict__ Bt, int K, int mtiles,
                     int ntiles, char* smem, Epi epi, const float* __restrict__ colc = nullptr) {
  const int half = threadIdx.x >> 8;
  u16* S0 = (u16*)(smem + half * VB_BYTES);
  const int tid = threadIdx.x & 255, wid = tid >> 6, lane = tid & 63, wr = wid >> 1, wc = wid & 1, fr = lane & 15, fq = lane >> 4;
  const int nk = K / 64;
  const int ntot = mtiles * ntiles;
  for (int base = blockIdx.x * 2; base < ntot; base += gridDim.x * 2) {
    int tile = base + half;
    const bool valid = tile < ntot;
    if (!valid) tile = ntot - 1;
    const int tm = tile / ntiles, tn = tile - tm * ntiles;
    const int brow = tm * 128, bcol = tn * 128;
    const u16* Ag = A + (size_t)brow * lda + (size_t)tn * a_ntile_off;
    const u16* Bg = Bt + (size_t)bcol * K;
    f32x4 acc[4][4];
#pragma unroll
    for (int m = 0; m < 4; ++m)
#pragma unroll
      for (int n = 0; n < 4; ++n) acc[m][n] = f32x4{0.f, 0.f, 0.f, 0.f};
    u32x4 ra0[4], rb0[4], ra1[4], rb1[4];
    auto gload = [&](int t, u32x4(&ra)[4], u32x4(&rb)[4]) {
#pragma unroll
      for (int i = 0; i < 4; ++i) {
        int c = tid + i * 256, r = c >> 3, kc = c & 7;
        ra[i] = *(const u32x4*)(Ag + (size_t)r * lda + t * 64 + kc * 8);
        rb[i] = *(const u32x4*)(Bg + (size_t)r * K + t * 64 + kc * 8);
      }
    };
    auto lwrite = [&](int buf, const u32x4(&ra)[4], const u32x4(&rb)[4]) {
      u16* SA = S0 + buf * G_LDS_BUF;
      u16* SB = SA + 128 * G_LDS_STRIDE;
#pragma unroll
      for (int i = 0; i < 4; ++i) {
        int c = tid + i * 256, r = c >> 3, kc = c & 7;
        *(u32x4*)(SA + r * G_LDS_STRIDE + kc * 8) = ra[i];
        *(u32x4*)(SB + r * G_LDS_STRIDE + kc * 8) = rb[i];
      }
    };
    auto compute = [&](int buf) {
      const u16* SA = S0 + buf * G_LDS_BUF;
      const u16* SB = SA + 128 * G_LDS_STRIDE;
#pragma unroll
      for (int kh = 0; kh < 2; ++kh) {
        bf16x8 At[4], Bl[4];
#pragma unroll
        for (int m = 0; m < 4; ++m)
          At[m] = *(const bf16x8*)(SA + (wr * 64 + m * 16 + fr) * G_LDS_STRIDE + kh * 32 + fq * 8);
#pragma unroll
        for (int n = 0; n < 4; ++n)
          Bl[n] = *(const bf16x8*)(SB + (wc * 64 + n * 16 + fr) * G_LDS_STRIDE + kh * 32 + fq * 8);
#pragma unroll
        for (int m = 0; m < 4; ++m)
#pragma unroll
          for (int n = 0; n < 4; ++n) acc[m][n] = __builtin_amdgcn_mfma_f32_16x16x32_bf16(At[m], Bl[n], acc[m][n], 0, 0, 0);
        __builtin_amdgcn_sched_barrier(0);
      }
    };
    gload(0, ra0, rb0);
    if (nk > 1) gload(1, ra1, rb1);
    lwrite(0, ra0, rb0);
    __syncthreads();
#pragma unroll 1
    for (int t = 0; t < nk; t += 2) {
      if (t + 2 < nk) gload(t + 2, ra0, rb0);
      compute(0);
      if (t + 1 < nk) lwrite(1, ra1, rb1);
      __syncthreads();
      if (t + 1 < nk) {
        if (t + 3 < nk) gload(t + 3, ra1, rb1);
        compute(1);
        if (t + 2 < nk) lwrite(0, ra0, rb0);
        __syncthreads();
      }
    }
    if (valid) {
      float cc[4] = {0.f, 0.f, 0.f, 0.f};
      if (colc) {
#pragma unroll
        for (int n = 0; n < 4; ++n) cc[n] = colc[bcol + wc * 64 + n * 16 + fr];
      }
#pragma unroll
      for (int m = 0; m < 4; ++m)
#pragma unroll
        for (int n = 0; n < 2; ++n)
#pragma unroll
          for (int j = 0; j < 4; ++j) {
            int row = brow + wr * 64 + m * 16 + fq * 4 + j;
            int col = bcol + wc * 64 + n * 16 + fr;
            epi(row, col, acc[m][n][j] + cc[n], acc[m][n + 2][j] + cc[n + 2]);
          }
    }
  }
}


namespace pg8 {
#define PG8_LAS __attribute__((address_space(3)))
typedef unsigned short bf16_t;
typedef short bf16x8 __attribute__((ext_vector_type(8)));
typedef float f32x4 __attribute__((ext_vector_type(4)));
typedef unsigned u32x4 __attribute__((ext_vector_type(4)));
constexpr int BM = 256, BK = 64, HALF = 128, HTB = HALF * BK * 2  , STAGE_BYTES = 8 * HTB, NXCD = 8, WGM = 8;

__host__ __device__ __forceinline__ int lds_byte(int r, int c) { const int st = (r >> 4) * 2 + (c >> 5), rr = r & 15, cc = c & 31, ob = rr * 64 + cc * 2; return st * 1024 + (ob ^ (((ob >> 9) & 1) << 5)); }
__host__ __device__ __forceinline__ void stage_rc(int b, int& R, int& C) { const int st = b / 1024, sb = b % 1024, swz = sb ^ (((sb >> 9) & 1) << 5); R = (st >> 1) * 16 + swz / 64; C = (st & 1) * 32 + (swz % 64) / 2; }
__host__ __device__ __forceinline__ int perm32(int rho) { const int n = rho >> 4, i = rho & 15; return 8 * (i >> 2) + 4 * n + (i & 3); }

struct Unit { int pm, pn; };
struct Gemm { const bf16_t* A; const bf16_t* Bt; int M, N, K; };

struct StaticOrder {
    int nM, nN, nwg, G, c;
    __host__ __device__ void init(int M, int N, int G_, int c_) { nM = M / BM; nN = N / BM; nwg = nM * nN; G = G_; c = c_; }
    __host__ __device__ bool next(int i, Unit& u) const {
        const long L = (long)i * G + c; if (L >= nwg) return false;
        int wgid = (int)L; { const int q = nwg / NXCD, r = nwg % NXCD, xcd = wgid % NXCD, off = wgid / NXCD; wgid = (xcd < r ? xcd * (q + 1) : r * (q + 1) + (xcd - r) * q) + off; }
        const int nig = WGM * nN, gid = wgid / nig, fm = gid * WGM, gsz = (nM - fm) < WGM ? (nM - fm) : WGM;
        u.pm = fm + ((wgid % nig) % gsz); u.pn = (wgid % nig) / gsz; return true;
    }
    __device__ __forceinline__ void a_ready(const Unit&) const {}
    __device__ __forceinline__ void done(const Unit&) const {}
};
template <class Epi, class Sched, bool STAMP = false>
__device__ __forceinline__ void gemm_phase(PG8_LAS unsigned char* lds, const Gemm g, const Sched& S, const Epi& E, unsigned long long* stamps) {
    const int tid = threadIdx.x, wid = __builtin_amdgcn_readfirstlane(tid >> 6), lane = tid & 63, wr = wid >> 2, wc = wid & 3, fr = lane & 15, fq = lane >> 4;
    const int K = g.K, nt = K / BK;
    int ts_lo = 0, ts_hi = 0, nts = 0; const unsigned long long rt_entry = STAMP ? (unsigned long long)wall_clock64() : 0ull;
#define PG8_STAMP() do { if (STAMP && wid == 0 && nts < 64) { const unsigned long long _c = (unsigned long long)clock64(); \
        ts_lo = (lane == nts) ? (int)(unsigned)_c : ts_lo; ts_hi = (lane == nts) ? (int)(unsigned)(_c >> 32) : ts_hi; ++nts; } } while (0)
    PG8_STAMP();
    unsigned voffA[2], voffB[2];
#pragma unroll
    for (int i = 0; i < 2; ++i) { int R, C; stage_rc(tid * 16 + i * 8192, R, C); const int Rb = Epi::PERM ? ((R & ~31) + perm32(R & 31)) : R;
        voffA[i] = (unsigned)(R * K + C) * 2u; voffB[i] = (unsigned)(Rb * K + C) * 2u; }
    const size_t kstep = (size_t)(BK * 2);
    const size_t hstep = (size_t)HALF * K * 2;
    const size_t tstep = 2 * hstep;
    const unsigned ldsw = (unsigned)wid * 1024u;
    const int aoff = lds_byte(wr * 64 + fr, fq * 8), boff = lds_byte(wc * 32 + fr, fq * 8);
#define PG8_SA(b, h) (((b) * 2 + (h)) * HTB)
#define PG8_SB(b, h) ((4 + (b) * 2 + (h)) * HTB)
#define PG8_STAGE(bufoff, gbase, voff) do { _Pragma("unroll") for (int _i = 0; _i < 2; ++_i) \
        __builtin_amdgcn_global_load_lds((const unsigned*)((const char*)(gbase) + (voff)[_i]), (PG8_LAS unsigned*)(lds + (bufoff) + ldsw + _i * 8192), 16, 0, 0); } while (0)
#define PG8_LDA(dst, b, h) do { _Pragma("unroll") for (int m = 0; m < 4; ++m) _Pragma("unroll") for (int k = 0; k < 2; ++k) dst[m][k] = *(const PG8_LAS bf16x8*)(lds + PG8_SA(b, h) + aoff + m * 2048 + k * 1024); } while (0)
#define PG8_LDB(dst, b, h) do { _Pragma("unroll") for (int n = 0; n < 2; ++n) _Pragma("unroll") for (int k = 0; k < 2; ++k) dst[n][k] = *(const PG8_LAS bf16x8*)(lds + PG8_SB(b, h) + boff + n * 2048 + k * 1024); } while (0)
#define PG8_MMA(ai, bj, At, Bt) do { __builtin_amdgcn_s_setprio(1); _Pragma("unroll") for (int m = 0; m < 4; ++m) _Pragma("unroll") for (int n = 0; n < 2; ++n) _Pragma("unroll") for (int k = 0; k < 2; ++k) \
        acc[ai][bj][m][n] = __builtin_amdgcn_mfma_f32_16x16x32_bf16(Bt[n][k], At[m][k], acc[ai][bj][m][n], 0, 0, 0); __builtin_amdgcn_s_setprio(0); } while (0)
#define PG8_WAIT_V(n) asm volatile("s_waitcnt vmcnt(" #n ")" ::: "memory")
#define PG8_WAIT_L(n) asm volatile("s_waitcnt lgkmcnt(" #n ")" ::: "memory")
#define PG8_BAR __builtin_amdgcn_s_barrier()
#define PG8_SCHED __builtin_amdgcn_sched_barrier(0)
    Unit cur, nxt; int ui = 0;
    if (!S.next(0, cur)) return;
    f32x4 acc[2][2][4][2];
#pragma unroll
    for (int a = 0; a < 2; ++a)
#pragma unroll
        for (int b = 0; b < 2; ++b)
#pragma unroll
            for (int m = 0; m < 4; ++m)
#pragma unroll
                for (int n = 0; n < 2; ++n) acc[a][b][m][n] = (f32x4){0.f, 0.f, 0.f, 0.f};
    bf16x8 At[4][2], B0[2][2], B1[2][2];
    const char* cA = (const char*)g.A + (size_t)cur.pm * tstep; const char* cB = (const char*)g.Bt + (size_t)cur.pn * tstep;
    S.a_ready(cur);
    PG8_STAGE(PG8_SB(0, 0), cB, voffB); PG8_STAGE(PG8_SA(0, 0), cA, voffA); PG8_STAGE(PG8_SB(0, 1), cB + hstep, voffB); PG8_STAGE(PG8_SA(0, 1), cA + hstep, voffA);
    if (wr == 1) PG8_BAR;
    PG8_WAIT_V(4); PG8_BAR;
    PG8_STAGE(PG8_SB(1, 0), cB + kstep, voffB); PG8_STAGE(PG8_SA(1, 0), cA + kstep, voffA); PG8_STAGE(PG8_SB(1, 1), cB + hstep + kstep, voffB);
    PG8_WAIT_V(6); PG8_BAR;
    PG8_STAMP();
    for (;;) {
        const bool has_next = S.next(ui + 1, nxt);
        const char* nA = has_next ? (const char*)g.A + (size_t)nxt.pm * tstep : cA; const char* nB = has_next ? (const char*)g.Bt + (size_t)nxt.pn * tstep : cB;
        for (int t = 0; t < nt; t += 2) {
            const bool last = (t == nt - 2);
            const char* a1 = cA + (size_t)(t + 1) * kstep;
            const char* a2 = last ? nA : cA + (size_t)(t + 2) * kstep; const char* b2 = last ? nB : cB + (size_t)(t + 2) * kstep;
            const char* a3 = a2 + kstep; const char* b3 = b2 + kstep;
            if (last && has_next) S.a_ready(nxt);
            PG8_LDB(B0, 0, 0); PG8_SCHED; PG8_LDA(At, 0, 0); PG8_STAGE(PG8_SA(1, 1), a1 + hstep, voffA);
            PG8_WAIT_L(8); PG8_BAR; PG8_WAIT_L(0); PG8_MMA(0, 0, At, B0); PG8_BAR; PG8_SCHED;
            PG8_LDB(B1, 0, 1); PG8_STAGE(PG8_SB(0, 0), b2, voffB);
            PG8_BAR; PG8_WAIT_L(0); PG8_MMA(0, 1, At, B1); PG8_BAR;
            PG8_LDA(At, 0, 1); PG8_STAGE(PG8_SA(0, 0), a2, voffA);
            PG8_BAR; PG8_WAIT_L(0); PG8_MMA(1, 0, At, B0); PG8_BAR; PG8_SCHED;
            PG8_STAGE(PG8_SB(0, 1), b2 + hstep, voffB);
            PG8_WAIT_V(6); PG8_BAR; PG8_MMA(1, 1, At, B1); PG8_BAR;
            PG8_LDB(B0, 1, 0); PG8_SCHED; PG8_LDA(At, 1, 0); PG8_STAGE(PG8_SA(0, 1), a2 + hstep, voffA);
            PG8_WAIT_L(8); PG8_BAR; PG8_WAIT_L(0); PG8_MMA(0, 0, At, B0); PG8_BAR; PG8_SCHED;
            PG8_LDB(B1, 1, 1); PG8_STAGE(PG8_SB(1, 0), b3, voffB);
            PG8_BAR; PG8_WAIT_L(0); PG8_MMA(0, 1, At, B1); PG8_BAR;
            PG8_LDA(At, 1, 1); PG8_STAGE(PG8_SA(1, 0), a3, voffA);
            PG8_BAR; PG8_WAIT_L(0); PG8_MMA(1, 0, At, B0); PG8_BAR; PG8_SCHED;
            PG8_STAGE(PG8_SB(1, 1), b3 + hstep, voffB);
            PG8_WAIT_V(6); PG8_BAR; PG8_MMA(1, 1, At, B1); PG8_BAR;
        }
        PG8_STAMP();
        if constexpr (!Epi::AFTER_DRAIN) { E(acc, cur, wr, wc, fr, fq); S.done(cur); }
        PG8_STAMP();
        if (!has_next) break;
#pragma unroll
        for (int a = 0; a < 2; ++a)
#pragma unroll
            for (int b = 0; b < 2; ++b)
#pragma unroll
                for (int m = 0; m < 4; ++m)
#pragma unroll
                    for (int n = 0; n < 2; ++n) acc[a][b][m][n] = (f32x4){0.f, 0.f, 0.f, 0.f};
        cur = nxt; cA = nA; cB = nB; ++ui;
    }
    PG8_WAIT_V(0);
    if (wr == 0) PG8_BAR;
    PG8_BAR;
    if constexpr (Epi::AFTER_DRAIN) { E.fused(acc, cur, wr, wc, fr, fq, lds, wid, lane); S.done(cur); }
    PG8_STAMP();
    if (STAMP && wid == 0) { stamps[lane] = lane < nts ? (((unsigned long long)(unsigned)ts_hi << 32) | (unsigned)ts_lo) : 0ull;
        if (lane == 62) stamps[62] = rt_entry; if (lane == 63) stamps[63] = (unsigned long long)wall_clock64(); }
#undef PG8_STAMP
#undef PG8_SA
#undef PG8_SB
#undef PG8_STAGE
#undef PG8_LDA
#undef PG8_LDB
#undef PG8_MMA
#undef PG8_WAIT_V
#undef PG8_WAIT_L
#undef PG8_BAR
#undef PG8_SCHED
}
}

struct EpiIn0 {
  static constexpr bool PERM = false, AFTER_DRAIN = false;
  float* PROJ;
  const float* LB;
  const float* IR;
  __device__ __forceinline__ void operator()(const pg8::f32x4 (&acc)[2][2][4][2], const pg8::Unit& u, int wr, int wc, int fr, int fq) const {
#pragma unroll
    for (int bj = 0; bj < 2; ++bj) {
      const int cb = u.pn * 256 + bj * 128;
      if (cb >= 4096 && cb < 5120) {
        const int d0 = wc * 16 + 4 * fq;
        const pg8::f32x4 irA = *(const pg8::f32x4*)(IR + 2 * d0), irB = *(const pg8::f32x4*)(IR + 2 * d0 + 4);
        const float irh[4] = {irA[0], irA[2], irB[0], irB[2]}, irl[4] = {irA[1], irA[3], irB[1], irB[3]};
        const float sc = (cb >= 4608) ? 0.08838834764831845f : 1.0f;
#pragma unroll
        for (int ai = 0; ai < 2; ++ai)
#pragma unroll
          for (int m = 0; m < 4; ++m) {
            const int row = u.pm * 256 + ai * 128 + wr * 64 + m * 16 + fr;
            float* pr = PROJ + (size_t)row * N0;
            const pg8::f32x4 v0 = acc[ai][bj][m][0], v1 = acc[ai][bj][m][1];
            const float pos = (float)row_pos(row);
            pg8::f32x4 o1, o2;
#pragma unroll
            for (int j = 0; j < 4; ++j) {
              float ph = pos * irh[j];
              float pe = __builtin_fmaf(pos, irh[j], -ph) + pos * irl[j];
              float frc = __builtin_amdgcn_fractf(ph) + pe;
              float sn = __builtin_amdgcn_sinf(frc), cs = __builtin_amdgcn_cosf(frc);
              o1[j] = (v0[j] * cs - v1[j] * sn) * sc;
              o2[j] = (v0[j] * sn + v1[j] * cs) * sc;
            }
            *(pg8::f32x4*)(pr + cb + d0) = o1;
            *(pg8::f32x4*)(pr + cb + 64 + d0) = o2;
            __builtin_amdgcn_sched_barrier(0);
          }
      } else if (cb >= 1024 && cb < 2048) {
        const int c0 = cb + 32 * wc + 4 * fq;
        const pg8::f32x4 l0 = *(const pg8::f32x4*)(LB + c0 - 1024), l1 = *(const pg8::f32x4*)(LB + c0 + 16 - 1024);
#pragma unroll
        for (int ai = 0; ai < 2; ++ai)
#pragma unroll
          for (int m = 0; m < 4; ++m) {
            const int row = u.pm * 256 + ai * 128 + wr * 64 + m * 16 + fr;
            float* pr = PROJ + (size_t)row * N0;
#pragma unroll
            for (int n = 0; n < 2; ++n) {
              const pg8::f32x4 l = n ? l1 : l0;
              pg8::f32x4 v = acc[ai][bj][m][n], o;
#pragma unroll
              for (int j = 0; j < 4; ++j) o[j] = l[j] + (1.0f - l[j]) * sigmoid_acc(v[j]);
              *(pg8::f32x4*)(pr + c0 + 16 * n) = o;
            }
            __builtin_amdgcn_sched_barrier(0);
          }
      } else {
        const bool act = (cb < 1024 || (cb >= 3072 && cb < 4096) || cb >= 6144);
        const int c0 = cb + 32 * wc + 4 * fq;
#pragma unroll
        for (int ai = 0; ai < 2; ++ai)
#pragma unroll
          for (int m = 0; m < 4; ++m) {
            const int row = u.pm * 256 + ai * 128 + wr * 64 + m * 16 + fr;
            float* pr = PROJ + (size_t)row * N0;
#pragma unroll
            for (int n = 0; n < 2; ++n) {
              pg8::f32x4 v = acc[ai][bj][m][n], o;
#pragma unroll
              for (int j = 0; j < 4; ++j) o[j] = act ? silu_acc(v[j]) : v[j];
              *(pg8::f32x4*)(pr + c0 + 16 * n) = o;
            }
            __builtin_amdgcn_sched_barrier(0);
          }
      }
    }
  }
};
struct EpiStoreF32 {
  static constexpr bool PERM = false, AFTER_DRAIN = false;
  float* C;
  __device__ __forceinline__ void operator()(const pg8::f32x4 (&acc)[2][2][4][2], const pg8::Unit& u, int wr, int wc, int fr, int fq) const {
#pragma unroll
    for (int ai = 0; ai < 2; ++ai)
#pragma unroll
      for (int m = 0; m < 4; ++m) {
        const int row = u.pm * 256 + ai * 128 + wr * 64 + m * 16 + fr;
        float* pr = C + (size_t)row * 2048 + u.pn * 256 + 32 * wc + 4 * fq;
#pragma unroll
        for (int bj = 0; bj < 2; ++bj)
#pragma unroll
          for (int n = 0; n < 2; ++n) *(pg8::f32x4*)(pr + bj * 128 + 16 * n) = acc[ai][bj][m][n];
      }
  }
};
struct EpiStoreBf16 {
  static constexpr bool PERM = false, AFTER_DRAIN = false;
  u16* C;
  __device__ __forceinline__ void operator()(const pg8::f32x4 (&acc)[2][2][4][2], const pg8::Unit& u, int wr, int wc, int fr, int fq) const {
#pragma unroll
    for (int ai = 0; ai < 2; ++ai)
#pragma unroll
      for (int m = 0; m < 4; ++m) {
        const int row = u.pm * 256 + ai * 128 + wr * 64 + m * 16 + fr;
        u16* pr = C + (size_t)row * 2048 + u.pn * 256 + 32 * wc + 4 * fq;
#pragma unroll
        for (int bj = 0; bj < 2; ++bj)
#pragma unroll
          for (int n = 0; n < 2; ++n) {
            const pg8::f32x4 v = acc[ai][bj][m][n];
            uint2 o;
            o.x = pack2(v[0], v[1]);
            o.y = pack2(v[2], v[3]);
            *(uint2*)(pr + bj * 128 + 16 * n) = o;
          }
      }
  }
};
struct EpiIn1 {
  static constexpr bool PERM = false, AFTER_DRAIN = false;
  float* PROJ;
  float* DTA;
  const float* dtb;
  const float* alog;
  __device__ __forceinline__ void operator()(const pg8::f32x4 (&acc)[2][2][4][2], const pg8::Unit& u, int wr, int wc, int fr, int fq) const {
    float dtbv[4] = {0.f, 0.f, 0.f, 0.f}, aev[4] = {0.f, 0.f, 0.f, 0.f};
    if (u.pn == 23) {
      const int cc = 23 * 256 + 32 * wc + 4 * fq;
      const int hb = (cc >= 5920 && cc < 5936) ? (cc - 5920) : ((cc + 16 >= 5920 && cc + 16 < 5936) ? (cc + 16 - 5920) : -1);
      if (hb >= 0) {
#pragma unroll
        for (int j = 0; j < 4; ++j) { dtbv[j] = dtb[hb + j]; aev[j] = expf(alog[hb + j]); }
      }
    }
#pragma unroll
    for (int ai = 0; ai < 2; ++ai)
#pragma unroll
      for (int m = 0; m < 4; ++m) {
        const int row = u.pm * 256 + ai * 128 + wr * 64 + m * 16 + fr;
        float* pr = PROJ + (size_t)row * N1;
#pragma unroll
        for (int bj = 0; bj < 2; ++bj)
#pragma unroll
          for (int n = 0; n < 2; ++n) {
            const int col0 = u.pn * 256 + bj * 128 + 32 * wc + 16 * n + 4 * fq;
            pg8::f32x4 v = acc[ai][bj][m][n];
            if (col0 < 1024) {
              pg8::f32x4 o;
#pragma unroll
              for (int j = 0; j < 4; ++j) o[j] = siluf_(v[j]);
              *(pg8::f32x4*)(pr + col0) = o;
            } else if (col0 < 5920) {
              *(pg8::f32x4*)(pr + col0) = v;
            } else if (col0 < 5936) {
#pragma unroll
              for (int j = 0; j < 4; ++j) {
                int h = col0 + j - 5920;
                float dt = softplusf_(v[j] + dtbv[j]);
                DTA[(size_t)row * 64 + h * 4] = dt;
                DTA[(size_t)row * 64 + h * 4 + 1] = expf(-dt * aev[j]);
              }
            }
          }
      }
  }
};

struct Seg {
  int off;
  int ld;
  int n4;
};

template <int NS, int NF4, int RG>
DEVI void stage_init(const float* wsf, const Seg (&sg)[NS], int row0, int tid, const float* (&ptr)[RG], int (&ldv)[RG]) {
  asm volatile("" : "+v"(tid));
#pragma unroll
  for (int q = 0; q < RG; ++q) {
    int flat = tid + q * 256;
    int t = flat / NF4, f = flat % NF4;
    if (flat >= 16 * NF4) { t = 0; f = 0; }
    int off = 0, ld = 0, ff = f;
    bool done = false;
#pragma unroll
    for (int s = 0; s < NS; ++s) {
      bool here = (!done) && (ff < sg[s].n4);
      off = here ? (sg[s].off + (row0 + t) * sg[s].ld + ff * 4) : off;
      ld = here ? sg[s].ld : ld;
      ff = (done || here) ? ff : (ff - sg[s].n4);
      done = done || here;
    }
    ptr[q] = wsf + off;
    ldv[q] = ld;
  }
}
template <int NF4, int RG>
DEVI void stage_issue(const float* const (&ptr)[RG], const int (&ldv)[RG], int st, int nsteps, int tid, f32x4 (&rg)[RG]) {
#pragma unroll
  for (int q = 0; q < RG; ++q) {
    int flat = tid + q * 256;
    if (flat < nsteps * NF4) rg[q] = *(const f32x4*)(ptr[q] + (st * 16) * ldv[q]);
  }
}
template <int NF4, int RG>
DEVI void stage_commit(float* buf, int nsteps, int tid, const f32x4 (&rg)[RG]) {
#pragma unroll
  for (int q = 0; q < RG; ++q) {
    int flat = tid + q * 256;
    if (flat < nsteps * NF4) ((f32x4*)buf)[flat] = rg[q];
  }
}

template <int MODE>
DEVI void colrec_long(const float* wsf, const Seg (&sg)[4], int row0, int T, float gamma, float* outp, int ldo, float* stout, int st_ld,
                      float* smem) {
  constexpr int NF4 = 69, W = 276, RG = 5;
  const int tid = threadIdx.x & 255, w = tid >> 6, lane = tid & 63, c = lane >> 4, s = lane & 15;
  smem += (threadIdx.x >> 8) * (VB_BYTES / 4);
  float S[8];
#pragma unroll
  for (int i = 0; i < 8; ++i) S[i] = 0.f;
  float* buf0 = smem;
  float* buf1 = smem + 16 * 336;
  float* obuf = smem + 2 * 16 * 336;
  const int nst = (T + 15) / 16;
  f32x4 rgA[RG], rgB[RG];
  const float* sptr[RG];
  int sld[RG];
  stage_init<4, NF4, RG>(wsf, sg, row0, tid, sptr, sld);
  auto step = [&](const float* sp, float* ob, int tt) -> float {
    float4 a0 = *(const float4*)(sp + s * 8), a1 = *(const float4*)(sp + s * 8 + 4);
    float4 q0 = *(const float4*)(sp + 128 + s * 8), q1 = *(const float4*)(sp + 128 + s * 8 + 4);
    float a[8] = {a0.x, a0.y, a0.z, a0.w, a1.x, a1.y, a1.z, a1.w};
    float q[8] = {q0.x, q0.y, q0.z, q0.w, q1.x, q1.y, q1.z, q1.w};
    float val = sp[256 + w * 4 + c];
    float dA = gamma;
    if (MODE == 2) {
      val *= sp[272];
      dA = sp[273];
    }
    float o = 0.f;
#pragma unroll
    for (int i = 0; i < 8; ++i) {
      if (MODE == 0) S[i] = val + a[i] * (S[i] - val);
      else S[i] = dA * S[i] + a[i] * val;
      o += q[i] * S[i];
    }
    return red16(o);
  };
  auto run_stage = [&](const float* b, float* ob, int nthis) {
#pragma unroll 1
    for (int tt = 0; tt < nthis; tt += 4) {
      float o0 = step(b + tt * W, ob, tt);
      float o1 = step(b + (tt + 1) * W, ob, tt + 1);
      float o2 = step(b + (tt + 2) * W, ob, tt + 2);
      float o3 = step(b + (tt + 3) * W, ob, tt + 3);
      const int base = (s == 0) ? (tt * 16 + w * 4 + c) : (1024 + (tid & 255));
      const int st16 = (s == 0) ? 16 : 0;
      ob[base] = o0;
      ob[base + st16] = o1;
      ob[base + 2 * st16] = o2;
      ob[base + 3 * st16] = o3;
    }
  };
  auto write_out = [&](const float* ob, int st, int nthis) {
    if (tid < nthis * 4) {
      int t = tid >> 2, c4 = tid & 3;
      *(float4*)(outp + (size_t)(st * 16 + t) * ldo + c4 * 4) = *(const float4*)(ob + t * 16 + c4 * 4);
    }
  };
  auto nsteps = [&](int st) { return min(16, T - st * 16); };
  stage_issue<NF4, RG>(sptr, sld, 0, nsteps(0), tid, rgA);
  stage_commit<NF4, RG>(buf0, nsteps(0), tid, rgA);
  if (nst > 1) stage_issue<NF4, RG>(sptr, sld, 1, nsteps(1), tid, rgB);
  __syncthreads();
#pragma unroll 1
  for (int st = 0; st < nst; st += 2) {
    if (st + 2 < nst) stage_issue<NF4, RG>(sptr, sld, st + 2, nsteps(st + 2), tid, rgA);
    run_stage(buf0, obuf, nsteps(st));
    if (st + 1 < nst) stage_commit<NF4, RG>(buf1, nsteps(st + 1), tid, rgB);
    __syncthreads();
    write_out(obuf, st, nsteps(st));
    if (st + 1 < nst) {
      if (st + 3 < nst) stage_issue<NF4, RG>(sptr, sld, st + 3, nsteps(st + 3), tid, rgB);
      run_stage(buf1, obuf + 512, nsteps(st + 1));
      if (st + 2 < nst) stage_commit<NF4, RG>(buf0, nsteps(st + 2), tid, rgA);
      __syncthreads();
      write_out(obuf + 512, st + 1, nsteps(st + 1));
    }
  }
#pragma unroll
  for (int i = 0; i < 8; ++i) stout[(size_t)(s * 8 + i) * st_ld + w * 4 + c] = S[i];
  __syncthreads();
}

template <int MODE>
DEVI void colrec_short(const float* pa, int lda_, const float* pq, int ldq, const float* pc, int ldc, const float* pdt,
                       long row0, float gamma, const float* stin, float* stout, int st_ld, float* outp, int ldo,
                       float* smem) {
  const int tid = threadIdx.x & 255, lane = tid & 63;
  const int wid = __builtin_amdgcn_readfirstlane(tid >> 6);
  const int k0 = wid * 32;
  smem += (threadIdx.x >> 8) * (VB_BYTES / 4);
  float S[32];
#pragma unroll
  for (int i = 0; i < 32; ++i) S[i] = stin[(size_t)(k0 + i) * st_ld + lane];
  float aq[4], vv[4], dAv[4];
#pragma unroll
  for (int t = 0; t < 4; ++t) {
    long row = row0 + t;
    aq[t] = (lane < 32) ? pa[(size_t)row * lda_ + k0 + lane] : pq[(size_t)row * ldq + k0 + (lane - 32)];
    vv[t] = pc[(size_t)row * ldc + lane];
    dAv[t] = gamma;
    if (MODE == 2) {
      vv[t] *= pdt[(size_t)row * 64];
      dAv[t] = pdt[(size_t)row * 64 + 1];
    }
  }
#pragma unroll
  for (int t = 0; t < 4; ++t) {
    const float val = vv[t], dA = dAv[t];
    float o = 0.f;
#pragma unroll
    for (int i = 0; i < 32; ++i) {
      const float a = rlf_(aq[t], i), q = rlf_(aq[t], 32 + i);
      if (MODE == 0) S[i] = val + a * (S[i] - val);
      else S[i] = dA * S[i] + a * val;
      o += q * S[i];
    }
    smem[(wid * 4 + t) * 64 + lane] = o;
  }
#pragma unroll
  for (int i = 0; i < 32; ++i) stout[(size_t)(k0 + i) * st_ld + lane] = S[i];
  __syncthreads();
  {
    int t = tid >> 6;
    float sum = smem[(0 * 4 + t) * 64 + lane] + smem[(1 * 4 + t) * 64 + lane] + smem[(2 * 4 + t) * 64 + lane] +
                smem[(3 * 4 + t) * 64 + lane];
    outp[(size_t)(row0 + t) * ldo + lane] = sum;
  }
  __syncthreads();
}

DEVI void rwkv_item(const float* wsf, const Seg (&sg)[6], int row0, int T, const float* stin, float* stout, float* outp, int ldo,
                    float* smem) {
  constexpr int NF4 = 84, W = 336, RG = 6;
  const int tid = threadIdx.x & 255, w = tid >> 6, lane = tid & 63, rl = lane >> 4, sl = lane & 15;
  smem += (threadIdx.x >> 8) * (VB_BYTES / 4);
  const int il = w * 4 + rl;
  float S[4];
  if (stin) {
    float4 v = *(const float4*)(stin + il * 64 + sl * 4);
    S[0] = v.x; S[1] = v.y; S[2] = v.z; S[3] = v.w;
  } else {
    S[0] = S[1] = S[2] = S[3] = 0.f;
  }
  float* buf0 = smem;
  float* buf1 = smem + 16 * 336;
  float* obuf = smem + 2 * 16 * 336;
  const int nst = (T + 15) / 16;
  f32x4 rgA[RG], rgB[RG];
  const float* sptr[RG];
  int sld[RG];
  stage_init<6, NF4, RG>(wsf, sg, row0, tid, sptr, sld);
  auto run_stage = [&](const float* b, float* ob, int nthis) {
#pragma unroll 4
    for (int tt = 0; tt < nthis; ++tt) {
      const float* sp = b + tt * W;
      float4 r4 = *(const float4*)(sp + sl * 4);
      float4 w4 = *(const float4*)(sp + 64 + sl * 4);
      float4 k4 = *(const float4*)(sp + 128 + sl * 4);
      float4 n4 = *(const float4*)(sp + 192 + sl * 4);
      float4 m4 = *(const float4*)(sp + 256 + sl * 4);
      float vi = sp[320 + il];
      float sa = S[0] * n4.x + S[1] * n4.y + S[2] * n4.z + S[3] * n4.w;
      sa = -red16(sa);
      S[0] = S[0] * w4.x + sa * m4.x + vi * k4.x;
      S[1] = S[1] * w4.y + sa * m4.y + vi * k4.y;
      S[2] = S[2] * w4.z + sa * m4.z + vi * k4.z;
      S[3] = S[3] * w4.w + sa * m4.w + vi * k4.w;
      float y = S[0] * r4.x + S[1] * r4.y + S[2] * r4.z + S[3] * r4.w;
      y = red16(y);
      ob[(sl == 0) ? (tt * 16 + il) : (1024 + (tid & 255))] = y;
    }
  };
  auto write_out = [&](const float* ob, int st, int nthis) {
    if (tid < nthis * 4) {
      int t = tid >> 2, c4 = tid & 3;
      *(float4*)(outp + (size_t)(st * 16 + t) * ldo + c4 * 4) = *(const float4*)(ob + t * 16 + c4 * 4);
    }
  };
  auto nsteps = [&](int st) { return min(16, T - st * 16); };
  stage_issue<NF4, RG>(sptr, sld, 0, nsteps(0), tid, rgA);
  stage_commit<NF4, RG>(buf0, nsteps(0), tid, rgA);
  if (nst > 1) stage_issue<NF4, RG>(sptr, sld, 1, nsteps(1), tid, rgB);
  __syncthreads();
  __builtin_amdgcn_s_setprio(3);
#pragma unroll 1
  for (int st = 0; st < nst; st += 2) {
    if (st + 2 < nst) stage_issue<NF4, RG>(sptr, sld, st + 2, nsteps(st + 2), tid, rgA);
    run_stage(buf0, obuf, nsteps(st));
    if (st + 1 < nst) stage_commit<NF4, RG>(buf1, nsteps(st + 1), tid, rgB);
    __syncthreads();
    write_out(obuf, st, nsteps(st));
    if (st + 1 < nst) {
      if (st + 3 < nst) stage_issue<NF4, RG>(sptr, sld, st + 3, nsteps(st + 3), tid, rgB);
      run_stage(buf1, obuf + 512, nsteps(st + 1));
      if (st + 2 < nst) stage_commit<NF4, RG>(buf0, nsteps(st + 2), tid, rgA);
      __syncthreads();
      write_out(obuf + 512, st + 1, nsteps(st + 1));
    }
  }
  __builtin_amdgcn_s_setprio(0);
  *(float4*)(stout + il * 64 + sl * 4) = make_float4(S[0], S[1], S[2], S[3]);
  __syncthreads();
}

DEVI void phase_rec0(const Params& p, float* smem) {
  char* ws = p.ws;
  const float* PROJ = (const float*)(ws + OFF_PROJ);
  float* OMIX = (float*)(ws + OFF_OMIX);
  const float* wsf = (const float*)ws;
  constexpr int PO = (int)(OFF_PROJ / 4);
  for (int item = blockIdx.x * 2 + (threadIdx.x >> 8); item < 4608; item += gridDim.x * 2) {
    if (item < 256) {
      int b = item >> 6, h = (item >> 3) & 7, cb = item & 7;
      Seg sg[4] = {{PO + 1024 + h * 128, N0, 32}, {PO + h * 128, N0, 32}, {PO + 2048 + h * 128 + cb * 16, N0, 4},
                   {PO, N0, 1}};
      int row0 = b * TP;
      colrec_long<0>(wsf, sg, row0, TP, 0.f, OMIX + (size_t)row0 * 2048 + h * 128 + cb * 16, 2048,
                     p.out + O_HGP + (size_t)(b * 8 + h) * 128 * 128 + cb * 16, 128, smem);
    } else if (item < 512) {
      int it = item - 256;
      int b = it >> 6, h = (it >> 4) & 3, cb = it & 15;
      Seg sg[4] = {{PO + 4608 + h * 128, N0, 32}, {PO + 4096 + h * 128, N0, 32},
                   {PO + 5120 + h * 256 + cb * 16, N0, 4}, {PO, N0, 1}};
      int row0 = b * TP;
      float gamma = 1.0f - exp2f(-5.0f - (float)h);
      colrec_long<1>(wsf, sg, row0, TP, gamma, OMIX + (size_t)row0 * 2048 + 1024 + h * 256 + cb * 16, 2048,
                     p.out + O_RTP + (size_t)(b * 4 + h) * 128 * 256 + cb * 16, 256, smem);
    } else if (item < 2560) {
      int it = item - 512;
      int b = it >> 4, h = (it >> 1) & 7, cb = it & 1;
      long row0 = MPR + (long)b * 4;
      size_t so = (size_t)(b * 8 + h) * 128 * 128 + cb * 64;
      colrec_short<0>(PROJ + 1024 + h * 128, N0, PROJ + h * 128, N0, PROJ + 2048 + h * 128 + cb * 64, N0, nullptr, row0,
                      0.f, p.in[I_SHG] + so, p.out + O_HGS + so, 128, OMIX + h * 128 + cb * 64, 2048, smem);
    } else {
      int it = item - 2560;
      int b = it >> 4, h = (it >> 2) & 3, cb = it & 3;
      long row0 = MPR + (long)b * 4;
      size_t so = (size_t)(b * 4 + h) * 128 * 256 + cb * 64;
      float gamma = 1.0f - exp2f(-5.0f - (float)h);
      colrec_short<1>(PROJ + 4608 + h * 128, N0, PROJ + 4096 + h * 128, N0, PROJ + 5120 + h * 256 + cb * 64, N0, nullptr,
                      row0, gamma, p.in[I_SRT] + so, p.out + O_RTS + so, 256, OMIX + 1024 + h * 256 + cb * 64, 2048,
                      smem);
    }
  }
}

DEVI float4 ld4(const float* p) { return *(const float4*)p; }
DEVI void st_bf4(u16* p, float a, float b, float c, float d) {
  uint2 o;
  o.x = pack2(a, b);
  o.y = pack2(c, d);
  *(uint2*)p = o;
}
DEVI float wsum_u_(float v) {
  v = red16(v);
  return (rlf_(v, 0) + rlf_(v, 16)) + (rlf_(v, 32) + rlf_(v, 48));
}
DEVI float red32(float v) {
  v = red16(v);
  return v + __shfl_xor(v, 16, 64);
}
DEVI void phase_post0(const Params& p) {
  char* ws = p.ws;
  const float* PROJ = (const float*)(ws + OFF_PROJ);
  const float* OMIX = (const float*)(ws + OFF_OMIX);
  u16* MIXB = (u16*)(ws + OFF_MIXB);
  const float* ng = p.in[I_HNG];
  const int lane = threadIdx.x & 63;
  const int gw = blockIdx.x * 8 + (threadIdx.x >> 6), nw = gridDim.x * 8;
  const float4 g4 = ld4(ng + (lane & 31) * 4);
  for (int row = gw; row < M; row += nw) {
    const float* o = OMIX + (size_t)row * 2048;
    const float* pr = PROJ + (size_t)row * N0;
    u16* mo = MIXB + (size_t)row * 2048;
    float4 a[4], ga[4], bq[4], gb[4];
#pragma unroll
    for (int it = 0; it < 4; ++it) {
      int c = it * 256 + lane * 4;
      a[it] = ld4(o + c);
      ga[it] = ld4(pr + 3072 + c);
      bq[it] = ld4(o + 1024 + c);
      gb[it] = ld4(pr + 6144 + c);
    }
#pragma unroll
    for (int it = 0; it < 4; ++it) {
      int c = it * 256 + lane * 4;
      float ss = red32(a[it].x * a[it].x + a[it].y * a[it].y + a[it].z * a[it].z + a[it].w * a[it].w);
      float inv = rsqrtf(ss * (1.0f / 128.0f) + 1e-6f);
      st_bf4(mo + c, a[it].x * inv * g4.x * ga[it].x, a[it].y * inv * g4.y * ga[it].y, a[it].z * inv * g4.z * ga[it].z,
             a[it].w * inv * g4.w * ga[it].w);
      float mu = wsum_u_(bq[it].x + bq[it].y + bq[it].z + bq[it].w) * (1.0f / 256.0f);
      float dx = bq[it].x - mu, dy = bq[it].y - mu, dz = bq[it].z - mu, dw = bq[it].w - mu;
      float var = wsum_u_(dx * dx + dy * dy + dz * dz + dw * dw) * (1.0f / 256.0f);
      float iv = rsqrtf(var + 1e-5f);
      st_bf4(mo + 1024 + c, dx * iv * gb[it].x, dy * iv * gb[it].y, dz * iv * gb[it].z, dw * iv * gb[it].w);
    }
  }
}

DEVI void phase_ln(const Params& p, const float* addsrc, const float* g, const float* bta) {
  char* ws = p.ws;
  float* XF = (float*)(ws + OFF_XF);
  u16* XB = (u16*)(ws + OFF_XB);
  const int lane = threadIdx.x & 63;
  const int gw = blockIdx.x * 8 + (threadIdx.x >> 6), nw = gridDim.x * 8;
  for (int row = gw; row < M; row += nw) {
    float4* xr = (float4*)(XF + (size_t)row * 2048);
    const float4* ar = (const float4*)(addsrc + (size_t)row * 2048);
    float v[32];
    float s = 0.f;
#pragma unroll
    for (int i = 0; i < 8; ++i) {
      float4 x = xr[i * 64 + lane], a = ar[i * 64 + lane];
      v[i * 4 + 0] = ALPHA * x.x + a.x;
      v[i * 4 + 1] = ALPHA * x.y + a.y;
      v[i * 4 + 2] = ALPHA * x.z + a.z;
      v[i * 4 + 3] = ALPHA * x.w + a.w;
      s += v[i * 4 + 0] + v[i * 4 + 1] + v[i * 4 + 2] + v[i * 4 + 3];
    }
    float mu = wsum(s) * (1.0f / 2048.0f);
    float q = 0.f;
#pragma unroll
    for (int i = 0; i < 32; ++i) {
      v[i] -= mu;
      q += v[i] * v[i];
    }
    float inv = rsqrtf(wsum(q) * (1.0f / 2048.0f) + 1e-5f);
#pragma unroll
    for (int i = 0; i < 8; ++i) {
      float4 gg = ((const float4*)g)[i * 64 + lane], bb = ((const float4*)bta)[i * 64 + lane];
      float4 y;
      y.x = v[i * 4 + 0] * inv * gg.x + bb.x;
      y.y = v[i * 4 + 1] * inv * gg.y + bb.y;
      y.z = v[i * 4 + 2] * inv * gg.z + bb.z;
      y.w = v[i * 4 + 3] * inv * gg.w + bb.w;
      xr[i * 64 + lane] = y;
      uint2 o;
      o.x = pack2(y.x, y.y);
      o.y = pack2(y.z, y.w);
      ((uint2*)(XB + (size_t)row * 2048))[i * 64 + lane] = o;
    }
  }
}

typedef __attribute__((ext_vector_type(2))) __bf16 bf2_t;
typedef __attribute__((ext_vector_type(2))) float f32x2;
DEVI float dot2bf(unsigned a, unsigned b, float acc) {
  return __builtin_amdgcn_fdot2_f32_bf16(__builtin_bit_cast(bf2_t, a), __builtin_bit_cast(bf2_t, b), acc, false);
}
template <int CTRL>
DEVI int dppi(int v) {
  return __builtin_amdgcn_update_dpp(v, v, CTRL, 0xF, 0xF, false);
}
DEVI int wmax_i(int v) {
  v = max(v, dppi<0xB1>(v));
  v = max(v, dppi<0x4E>(v));
  v = max(v, dppi<0x141>(v));
  v = max(v, dppi<0x140>(v));
  int a = __builtin_amdgcn_readlane(v, 0), b = __builtin_amdgcn_readlane(v, 16);
  int c = __builtin_amdgcn_readlane(v, 32), d = __builtin_amdgcn_readlane(v, 48);
  return max(max(a, b), max(c, d));
}
DEVI float rlf(float v, int l) { return __int_as_float(__builtin_amdgcn_readlane(__float_as_int(v), l)); }
DEVI float wsum_u(float v) {
  v = red16(v);
  return (rlf(v, 0) + rlf(v, 16)) + (rlf(v, 32) + rlf(v, 48));
}
DEVI int fkey(float f) {
  int u = __float_as_int(f);
  return u ^ ((u >> 31) & 0x7fffffff);
}
DEVI float keyf(int k) { return __int_as_float(k ^ ((k >> 31) & 0x7fffffff)); }

DEVI void conv_fp8_rows(const float* __restrict__ src, unsigned char* __restrict__ dst, float* __restrict__ scales) {
  const int lane = threadIdx.x & 63;
  const int gw = blockIdx.x * 8 + (threadIdx.x >> 6), nw = gridDim.x * 8;
  for (int e = gw; e < 16384; e += nw) {
    const float* r = src + (size_t)e * 2048;
    float4 v[8];
    float am = 0.f;
#pragma unroll
    for (int q = 0; q < 8; ++q) {
      v[q] = *(const float4*)(r + (q >> 2) * 1024 + lane * 16 + (q & 3) * 4);
      am = fmaxf(am, fmaxf(fmaxf(fabsf(v[q].x), fabsf(v[q].y)), fmaxf(fabsf(v[q].z), fabsf(v[q].w))));
    }
    float amax = __int_as_float(wmax_i(__float_as_int(am)));
    float inv = (amax > 0.f) ? (440.0f / amax) : 0.f;
    float scale = (amax > 0.f) ? (amax * (1.0f / 440.0f)) : 1.0f;
#pragma unroll
    for (int j = 0; j < 2; ++j) {
      u32x4 o;
#pragma unroll
      for (int k = 0; k < 4; ++k) {
        float4 t = v[j * 4 + k];
        int pk = 0;
        pk = __builtin_amdgcn_cvt_pk_fp8_f32(t.x * inv, t.y * inv, pk, false);
        pk = __builtin_amdgcn_cvt_pk_fp8_f32(t.z * inv, t.w * inv, pk, true);
        o[k] = (unsigned)pk;
      }
      *(u32x4*)(dst + (size_t)e * 2048 + j * 1024 + lane * 16) = o;
    }
    if (lane == 0) scales[e] = scale;
  }
}

DEVI void phase_peer(const Params& p, int layer, bool final_out) {
  char* ws = p.ws;
  const float* SC = (const float*)(ws + OFF_GOUT);
  float* XF = (float*)(ws + OFF_XF);
  u16* XB = (u16*)(ws + OFF_XB);
  const unsigned char* UB = (const unsigned char*)(ws + OFF_UB);
  const unsigned char* VB = (const unsigned char*)(ws + OFF_VB);
  const float* USC = (const float*)(ws + OFF_USC);
  const float* VSC = (const float*)(ws + OFF_VSC);
  const float* g = p.in[I_LNG] + (size_t)(layer * 2 + 1) * D;
  const float* bta = p.in[I_LNB] + (size_t)(layer * 2 + 1) * D;
  const int lane = threadIdx.x & 63;
  const int gw = blockIdx.x * 8 + (threadIdx.x >> 6), nw = gridDim.x * 8;
  constexpr int KMIN = (int)0x80000000;
  for (int row = gw; row < M; row += nw) {
    const float* sr = SC + (size_t)row * 2048;
    int eidx0 = 0, eidx1 = 0;
    float gate0 = 0.f, gate1 = 0.f;
#pragma unroll 1
    for (int hp = 0; hp < 4; ++hp) {
      const float* spA = sr + hp * 256;
      const float* spB = sr + (hp + 4) * 256;
      int kaA0 = (fkey(spA[lane]) & ~127) | (127 - lane);
      int kbA0 = (fkey(spA[lane + 64]) & ~127) | (63 - lane);
      int kaA1 = (fkey(spA[128 + lane]) & ~127) | (127 - lane);
      int kbA1 = (fkey(spA[192 + lane]) & ~127) | (63 - lane);
      int kaB0 = (fkey(spB[lane]) & ~127) | (127 - lane);
      int kbB0 = (fkey(spB[lane + 64]) & ~127) | (63 - lane);
      int kaB1 = (fkey(spB[128 + lane]) & ~127) | (127 - lane);
      int kbB1 = (fkey(spB[192 + lane]) & ~127) | (63 - lane);
      int myA0 = KMIN, myA1 = KMIN, myB0 = KMIN, myB1 = KMIN;
#pragma unroll 1
      for (int r = 0; r < 16; ++r) {
        int KA0 = wmax_i(max(kaA0, kbA0));
        int KA1 = wmax_i(max(kaA1, kbA1));
        int KB0 = wmax_i(max(kaB0, kbB0));
        int KB1 = wmax_i(max(kaB1, kbB1));
        myA0 = (lane == r) ? KA0 : myA0;
        myA1 = (lane == r) ? KA1 : myA1;
        myB0 = (lane == r) ? KB0 : myB0;
        myB1 = (lane == r) ? KB1 : myB1;
        kaA0 = (kaA0 == KA0) ? KMIN : kaA0;
        kbA0 = (kbA0 == KA0) ? KMIN : kbA0;
        kaA1 = (kaA1 == KA1) ? KMIN : kaA1;
        kbA1 = (kbA1 == KA1) ? KMIN : kbA1;
        kaB0 = (kaB0 == KB0) ? KMIN : kaB0;
        kbB0 = (kbB0 == KB0) ? KMIN : kbB0;
        kaB1 = (kaB1 == KB1) ? KMIN : kaB1;
        kbB1 = (kbB1 == KB1) ? KMIN : kbB1;
      }
      const float tsA0 = keyf(myA0 & ~127), tsA1 = keyf(myA1 & ~127);
      const float tsB0 = keyf(myB0 & ~127), tsB1 = keyf(myB1 & ~127);
      const int tiA0 = 127 - (myA0 & 127), tiA1 = 127 - (myA1 & 127);
      const int tiB0 = 127 - (myB0 & 127), tiB1 = 127 - (myB1 & 127);
      const int jb = (lane & 3) * 4;
      const float sA = __shfl(tsA0, lane >> 2, 64), sB = __shfl(tsB0, lane >> 2, 64);
      int cA0 = (fkey(sA + __shfl(tsA1, jb + 0, 64)) & ~255) | (255 - (lane * 4 + 0));
      int cA1 = (fkey(sA + __shfl(tsA1, jb + 1, 64)) & ~255) | (255 - (lane * 4 + 1));
      int cA2 = (fkey(sA + __shfl(tsA1, jb + 2, 64)) & ~255) | (255 - (lane * 4 + 2));
      int cA3 = (fkey(sA + __shfl(tsA1, jb + 3, 64)) & ~255) | (255 - (lane * 4 + 3));
      int cB0 = (fkey(sB + __shfl(tsB1, jb + 0, 64)) & ~255) | (255 - (lane * 4 + 0));
      int cB1 = (fkey(sB + __shfl(tsB1, jb + 1, 64)) & ~255) | (255 - (lane * 4 + 1));
      int cB2 = (fkey(sB + __shfl(tsB1, jb + 2, 64)) & ~255) | (255 - (lane * 4 + 2));
      int cB3 = (fkey(sB + __shfl(tsB1, jb + 3, 64)) & ~255) | (255 - (lane * 4 + 3));
      int mykA = KMIN, mykB = KMIN;
#pragma unroll 1
      for (int r = 0; r < 16; ++r) {
        int KA = wmax_i(max(max(cA0, cA1), max(cA2, cA3)));
        int KB = wmax_i(max(max(cB0, cB1), max(cB2, cB3)));
        mykA = (lane == r) ? KA : mykA;
        mykB = (lane == r) ? KB : mykB;
        cA0 = (cA0 == KA) ? KMIN : cA0;
        cA1 = (cA1 == KA) ? KMIN : cA1;
        cA2 = (cA2 == KA) ? KMIN : cA2;
        cA3 = (cA3 == KA) ? KMIN : cA3;
        cB0 = (cB0 == KB) ? KMIN : cB0;
        cB1 = (cB1 == KB) ? KMIN : cB1;
        cB2 = (cB2 == KB) ? KMIN : cB2;
        cB3 = (cB3 == KB) ? KMIN : cB3;
      }
      const float bsA = keyf(mykA & ~255), bsB = keyf(mykB & ~255);
      const int bfA = 255 - (mykA & 255), bfB = 255 - (mykB & 255);
      const int eA = __shfl(tiA0, (bfA >> 4) & 15, 64) * 128 + __shfl(tiA1, bfA & 15, 64);
      const int eB = __shfl(tiB0, (bfB >> 4) & 15, 64) * 128 + __shfl(tiB1, bfB & 15, 64);
      const float evA = (lane < 16) ? expf(bsA - rlf(bsA, 0)) : 0.f;
      const float evB = (lane < 16) ? expf(bsB - rlf(bsB, 0)) : 0.f;
      const float gtA = evA / wsum_u(evA), gtB = evB / wsum_u(evB);
      const int eA_b = __shfl(eA, lane & 15, 64), eB_b = __shfl(eB, lane & 15, 64);
      const float gA_b = __shfl(gtA, lane & 15, 64), gB_b = __shfl(gtB, lane & 15, 64);
      if ((lane >> 4) == hp) {
        eidx0 = eA_b;
        gate0 = gA_b;
        eidx1 = eB_b;
        gate1 = gB_b;
      }
    }
    float dv0 = 0.f, dv1 = 0.f;
    {
      float xf[32];
      {
        const float4* xr = (const float4*)(XF + (size_t)row * 2048);
#pragma unroll
        for (int q = 0; q < 8; ++q) {
          float4 t = xr[(q >> 2) * 256 + lane * 4 + (q & 3)];
          xf[q * 4 + 0] = t.x; xf[q * 4 + 1] = t.y; xf[q * 4 + 2] = t.z; xf[q * 4 + 3] = t.w;
        }
      }
      constexpr int R = 8;
      u32x4 w[R][2];
      float sc[R];
      auto load_row = [&](int pidx, u32x4(&wr)[2], float& scv) {
        int src = (pidx < 64) ? eidx0 : eidx1;
        int e = __builtin_amdgcn_readlane(src, pidx & 63);
        const u32x4* ur = (const u32x4*)(UB + (size_t)e * 2048);
        wr[0] = ur[lane];
        wr[1] = ur[64 + lane];
        scv = USC[e];
      };
#pragma unroll
      for (int u = 0; u < R; ++u) load_row(u, w[u], sc[u]);
#pragma unroll 1
      for (int p0 = 0; p0 < 128; p0 += R) {
#pragma unroll
        for (int u = 0; u < R; ++u) {
          float d = 0.f;
#pragma unroll
          for (int j = 0; j < 2; ++j) {
#pragma unroll
            for (int k = 0; k < 4; ++k) {
              int dw = (int)w[u][j][k];
              f32x2 lo = __builtin_amdgcn_cvt_pk_f32_fp8(dw, false);
              f32x2 hi = __builtin_amdgcn_cvt_pk_f32_fp8(dw, true);
              d += lo.x * xf[j * 16 + k * 4 + 0];
              d += lo.y * xf[j * 16 + k * 4 + 1];
              d += hi.x * xf[j * 16 + k * 4 + 2];
              d += hi.y * xf[j * 16 + k * 4 + 3];
            }
          }
          float scu = sc[u];
          if (p0 + R < 128) load_row(p0 + R + u, w[u], sc[u]);
          d = wsum_u(d) * scu;
          int pl = (p0 + u) & 63;
          if (p0 < 64) dv0 = (lane == pl) ? d : dv0;
          else dv1 = (lane == pl) ? d : dv1;
          __builtin_amdgcn_sched_barrier(0);
        }
      }
    }
    float coef0 = 0.5f * dv0 * (1.0f + erff(dv0 * 0.70710678118f)) * gate0;
    float coef1 = 0.5f * dv1 * (1.0f + erff(dv1 * 0.70710678118f)) * gate1;
    f32x2 o2[16];
#pragma unroll
    for (int i = 0; i < 16; ++i) o2[i] = f32x2{0.f, 0.f};
    {
      constexpr int R = 8;
      u32x4 w[R][2];
      float sc[R];
      auto load_row = [&](int pidx, u32x4(&wr)[2], float& scv) {
        int src = (pidx < 64) ? eidx0 : eidx1;
        int e = __builtin_amdgcn_readlane(src, pidx & 63);
        const u32x4* vr = (const u32x4*)(VB + (size_t)e * 2048);
        wr[0] = vr[lane];
        wr[1] = vr[64 + lane];
        scv = VSC[e];
      };
#pragma unroll
      for (int u = 0; u < R; ++u) load_row(u, w[u], sc[u]);
#pragma unroll 1
      for (int p0 = 0; p0 < 128; p0 += R) {
        float cfs = (p0 < 64) ? coef0 : coef1;
#pragma unroll
        for (int u = 0; u < R; ++u) {
          float c = rlf(cfs, (p0 + u) & 63) * sc[u];
          f32x2 cc = f32x2{c, c};
#pragma unroll
          for (int j = 0; j < 2; ++j) {
#pragma unroll
            for (int k = 0; k < 4; ++k) {
              int dw = (int)w[u][j][k];
              o2[j * 8 + k * 2 + 0] += cc * __builtin_amdgcn_cvt_pk_f32_fp8(dw, false);
              o2[j * 8 + k * 2 + 1] += cc * __builtin_amdgcn_cvt_pk_f32_fp8(dw, true);
            }
          }
          if (p0 + R < 128) load_row(p0 + R + u, w[u], sc[u]);
          __builtin_amdgcn_sched_barrier(0);
        }
      }
    }
    float o[32];
#pragma unroll
    for (int i = 0; i < 16; ++i) {
      o[2 * i] = o2[i].x;
      o[2 * i + 1] = o2[i].y;
    }
    float s = 0.f;
    {
      const float4* xr = (const float4*)(XF + (size_t)row * 2048);
#pragma unroll
      for (int q = 0; q < 8; ++q) {
        float4 t = xr[(q >> 2) * 256 + lane * 4 + (q & 3)];
        o[q * 4 + 0] += ALPHA * t.x; o[q * 4 + 1] += ALPHA * t.y; o[q * 4 + 2] += ALPHA * t.z; o[q * 4 + 3] += ALPHA * t.w;
      }
#pragma unroll
      for (int i = 0; i < 32; ++i) s += o[i];
    }
    float mu = wsum_u(s) * (1.0f / 2048.0f);
    float q = 0.f;
#pragma unroll
    for (int i = 0; i < 32; ++i) {
      o[i] -= mu;
      q += o[i] * o[i];
    }
    float inv = rsqrtf(wsum_u(q) * (1.0f / 2048.0f) + 1e-5f);
    float* dstf;
    if (final_out) {
      if (row < MPR) {
        int b = row / TP, t = row % TP;
        dstf = (t >= 16) ? (p.out + O_YP + ((size_t)b * 2048 + (t - 16)) * D) : nullptr;
      } else {
        dstf = p.out + O_YS + (size_t)(row - MPR) * D;
      }
    } else {
      dstf = XF + (size_t)row * 2048;
    }
#pragma unroll
    for (int j = 0; j < 2; ++j) {
      float yv[16];
#pragma unroll
      for (int k = 0; k < 4; ++k) {
        float4 gv = *(const float4*)(g + j * 1024 + lane * 16 + k * 4);
        float4 bv = *(const float4*)(bta + j * 1024 + lane * 16 + k * 4);
        float4 y;
        y.x = o[j * 16 + k * 4 + 0] * inv * gv.x + bv.x;
        y.y = o[j * 16 + k * 4 + 1] * inv * gv.y + bv.y;
        y.z = o[j * 16 + k * 4 + 2] * inv * gv.z + bv.z;
        y.w = o[j * 16 + k * 4 + 3] * inv * gv.w + bv.w;
        if (dstf) *(float4*)(dstf + j * 1024 + lane * 16 + k * 4) = y;
        yv[k * 4 + 0] = y.x; yv[k * 4 + 1] = y.y; yv[k * 4 + 2] = y.z; yv[k * 4 + 3] = y.w;
      }
      if (!final_out) {
        uint4* xb = (uint4*)(XB + (size_t)row * 2048 + j * 1024 + lane * 16);
        xb[0] = make_uint4(pack2(yv[0], yv[1]), pack2(yv[2], yv[3]), pack2(yv[4], yv[5]), pack2(yv[6], yv[7]));
        xb[1] = make_uint4(pack2(yv[8], yv[9]), pack2(yv[10], yv[11]), pack2(yv[12], yv[13]), pack2(yv[14], yv[15]));
      }
    }
  }
}

DEVI float4 f4mul(float4 a, float4 b) { return make_float4(a.x * b.x, a.y * b.y, a.z * b.z, a.w * b.w); }
DEVI void row_info(int row, bool& prompt, int& b, int& t, int& T) {
  prompt = row < MPR;
  if (prompt) { b = row / TP; t = row - b * TP; T = TP; }
  else { b = (row - MPR) >> 2; t = (row - MPR) & 3; T = 4; }
}
DEVI void phase_pre1(const Params& p) {
  char* ws = p.ws;
  const float* PROJ = (const float*)(ws + OFF_PROJ);
  float* XC = (float*)(ws + OFF_GOUT);
  float* RKV = (float*)(ws + OFF_RKV);
  u16* LRA = (u16*)(ws + OFF_LRA);
  u16* LRB = (u16*)(ws + OFF_LRB);
  u16* LRG = (u16*)(ws + OFF_LRG);
  const float* cw = p.in[I_CVW];
  const float* cbias = p.in[I_CVB];
  const float* mu = p.in[I_MU];
  const int gtid = blockIdx.x * 512 + threadIdx.x, nthr = gridDim.x * 512;
#pragma unroll 2
  for (int idx = gtid; idx < M * 384; idx += nthr) {
    int row = idx / 384, c = (idx - row * 384) * 4;
    bool prompt; int b, t, T;
    row_info(row, prompt, b, t, T);
    float4 xv[4];
#pragma unroll
    for (int jj = 0; jj < 4; ++jj) {
      int tt = t - 3 + jj;
      if (tt >= 0) xv[jj] = ld4(PROJ + (size_t)(row - 3 + jj) * N1 + 1024 + c);
      else if (prompt) xv[jj] = make_float4(0.f, 0.f, 0.f, 0.f);
      else xv[jj] = ld4(p.in[I_SCV] + (size_t)(b * 3 + (tt + 3)) * 1536 + c);
    }
    float4 acc = ld4(cbias + c);
#pragma unroll
    for (int jj = 0; jj < 4; ++jj) {
      float4 w = ld4(cw + jj * 1536 + c);
      acc.x += xv[jj].x * w.x; acc.y += xv[jj].y * w.y; acc.z += xv[jj].z * w.z; acc.w += xv[jj].w * w.w;
    }
    *(float4*)(XC + (size_t)row * 1536 + c) = make_float4(siluf_(acc.x), siluf_(acc.y), siluf_(acc.z), siluf_(acc.w));
    if (t >= T - 3) {
      float* co = prompt ? (p.out + O_CVP) : (p.out + O_CVS);
      *(float4*)(co + (size_t)(b * 3 + (t - (T - 3))) * 1536 + c) = xv[3];
    }
  }
#pragma unroll 2
  for (int idx = gtid; idx < M * 840; idx += nthr) {
    int row = idx / 840, c = (idx - row * 840) * 4;
    bool prompt; int b, t, T;
    row_info(row, prompt, b, t, T);
    float4 cur = ld4(PROJ + (size_t)row * N1 + 2560 + c);
    float4 prev;
    if (t > 0) prev = ld4(PROJ + (size_t)(row - 1) * N1 + 2560 + c);
    else if (prompt) prev = make_float4(0.f, 0.f, 0.f, 0.f);
    else prev = ld4(p.in[I_SSH] + (size_t)b * 3360 + c);
    float4 m4 = ld4(mu + c);
    float4 mx;
    mx.x = cur.x + (prev.x - cur.x) * m4.x; mx.y = cur.y + (prev.y - cur.y) * m4.y;
    mx.z = cur.z + (prev.z - cur.z) * m4.z; mx.w = cur.w + (prev.w - cur.w) * m4.w;
    if (c < 3072) *(float4*)(RKV + (size_t)row * 3072 + c) = mx;
    else if (c < 3136) st_bf4(LRA + (size_t)row * 64 + (c - 3072), tanhf(mx.x), tanhf(mx.y), tanhf(mx.z), tanhf(mx.w));
    else if (c < 3200) st_bf4(LRB + (size_t)row * 64 + (c - 3136), mx.x, mx.y, mx.z, mx.w);
    else st_bf4(LRG + (size_t)row * 192 + (c - 3200), sigmoidf_(mx.x), sigmoidf_(mx.y), sigmoidf_(mx.z), sigmoidf_(mx.w));
    if (t == T - 1) {
      float* so = prompt ? (p.out + O_SHP) : (p.out + O_SHS);
      *(float4*)(so + (size_t)b * 3360 + c) = cur;
    }
  }
  for (int idx = gtid; idx < M * 4; idx += nthr) {
    int row = idx >> 2, k = idx & 3;
    ((uint4*)(LRG + (size_t)row * 192 + 160))[k] = make_uint4(0, 0, 0, 0);
  }
}

DEVI void phase_pre1c(const Params& p) {
  char* ws = p.ws;
  float* RKV = (float*)(ws + OFF_RKV);
  const float* AA = (const float*)(ws + OFF_AA);
  float* KK = (float*)(ws + OFF_QB);
  float* KKA = (float*)(ws + OFF_MIXB);
  float* BON = (float*)(ws + OFF_BON);
  const float* k_k = p.in[I_KK];
  const float* k_a = p.in[I_KA];
  const float* r_k = p.in[I_RK];
  const int lane = threadIdx.x & 63;
  const int gw = blockIdx.x * 8 + (threadIdx.x >> 6), nw = gridDim.x * 8;
  for (int row = gw; row < M; row += nw) {
    float4 k4[4], r4[4], a4[4];
#pragma unroll
    for (int it = 0; it < 4; ++it) {
      int c = it * 256 + lane * 4;
      k4[it] = ld4(RKV + (size_t)row * 3072 + 1024 + c);
      r4[it] = ld4(RKV + (size_t)row * 3072 + c);
      a4[it] = ld4(AA + (size_t)row * 1024 + c);
    }
#pragma unroll
    for (int it = 0; it < 4; ++it) {
      int c = it * 256 + lane * 4;
      float4 kk4 = ld4(k_k + c), ka4 = ld4(k_a + c), rk4 = ld4(r_k + c);
      float4 k = k4[it], r = r4[it], a = a4[it];
      float4 kr = f4mul(k, kk4);
      float ss = red16(kr.x * kr.x + kr.y * kr.y + kr.z * kr.z + kr.w * kr.w);
      float inv = 1.0f / fmaxf(sqrtf(ss), 1e-12f);
      float4 kk = make_float4(kr.x * inv, kr.y * inv, kr.z * inv, kr.w * inv);
      float4 kp;
      kp.x = k.x * (1.0f + (a.x - 1.0f) * ka4.x); kp.y = k.y * (1.0f + (a.y - 1.0f) * ka4.y);
      kp.z = k.z * (1.0f + (a.z - 1.0f) * ka4.z); kp.w = k.w * (1.0f + (a.w - 1.0f) * ka4.w);
      float bon = red16(r.x * kp.x * rk4.x + r.y * kp.y * rk4.y + r.z * kp.z * rk4.z + r.w * kp.w * rk4.w);
      *(float4*)(KK + (size_t)row * 1024 + c) = kk;
      *(float4*)(KKA + (size_t)row * 1024 + c) = f4mul(kk, a);
      *(float4*)(RKV + (size_t)row * 3072 + 1024 + c) = kp;
      if ((lane & 15) == 0) BON[(size_t)row * 16 + it * 4 + (lane >> 4)] = bon;
    }
  }
}

DEVI void rwkv_short(const float* __restrict__ RKV, const float* __restrict__ DEC, const float* __restrict__ KK,
                     const float* __restrict__ KKA, int h, int rb, int row0, const float* __restrict__ stin,
                     float* __restrict__ stout, float* __restrict__ outp) {
  const int tid = threadIdx.x & 255, w = tid >> 6, lane = tid & 63, rl = lane >> 4, sl = lane & 15;
  const int il = w * 4 + rl;
  float4 sv = *(const float4*)(stin + il * 64 + sl * 4);
  float S[4] = {sv.x, sv.y, sv.z, sv.w};
  float4 r4[4], w4[4], k4[4], n4[4], m4[4];
  float vi[4];
#pragma unroll
  for (int t = 0; t < 4; ++t) {
    const size_t row = (size_t)(row0 + t);
    r4[t] = *(const float4*)(RKV + row * 3072 + h * 64 + sl * 4);
    w4[t] = *(const float4*)(DEC + row * 1024 + h * 64 + sl * 4);
    k4[t] = *(const float4*)(RKV + row * 3072 + 1024 + h * 64 + sl * 4);
    n4[t] = *(const float4*)(KK + row * 1024 + h * 64 + sl * 4);
    m4[t] = *(const float4*)(KKA + row * 1024 + h * 64 + sl * 4);
    vi[t] = RKV[row * 3072 + 2048 + h * 64 + rb * 16 + il];
  }
#pragma unroll
  for (int t = 0; t < 4; ++t) {
    float sa = S[0] * n4[t].x + S[1] * n4[t].y + S[2] * n4[t].z + S[3] * n4[t].w;
    sa = -red16(sa);
    S[0] = S[0] * w4[t].x + sa * m4[t].x + vi[t] * k4[t].x;
    S[1] = S[1] * w4[t].y + sa * m4[t].y + vi[t] * k4[t].y;
    S[2] = S[2] * w4[t].z + sa * m4[t].z + vi[t] * k4[t].z;
    S[3] = S[3] * w4[t].w + sa * m4[t].w + vi[t] * k4[t].w;
    float y = S[0] * r4[t].x + S[1] * r4[t].y + S[2] * r4[t].z + S[3] * r4[t].w;
    y = red16(y);
    if (sl == 0) outp[(size_t)t * 2048 + il] = y;
  }
  *(float4*)(stout + il * 64 + sl * 4) = make_float4(S[0], S[1], S[2], S[3]);
}

DEVI void phase_rec1(const Params& p, float* smem) {
  char* ws = p.ws;
  const float* XC = (const float*)(ws + OFF_GOUT);
  const float* RKV = (const float*)(ws + OFF_RKV);
  const float* DEC = (const float*)(ws + OFF_DEC);
  const float* KK = (const float*)(ws + OFF_QB);
  const float* KKA = (const float*)(ws + OFF_MIXB);
  const float* DTA = (const float*)(ws + OFF_DTA);
  float* OMIX = (float*)(ws + OFF_OMIX);
  const float* wsf = (const float*)ws;
  constexpr int XO = (int)(OFF_GOUT / 4), DO = (int)(OFF_DTA / 4), RO = (int)(OFF_RKV / 4), CO = (int)(OFF_DEC / 4),
                KO = (int)(OFF_QB / 4), AO = (int)(OFF_MIXB / 4);
  const int half = threadIdx.x >> 8;
  for (int li = blockIdx.x; li < 256; li += gridDim.x) {
    if (half == 0) {
      int b = li >> 6, h = (li >> 2) & 15, cb = li & 3;
      int g = h >> 3;
      Seg sg[4] = {{XO + 1024 + g * 128, 1536, 32}, {XO + 1280 + g * 128, 1536, 32}, {XO + h * 64 + cb * 16, 1536, 4},
                   {DO + h * 4, 64, 1}};
      int row0 = b * TP;
      colrec_long<2>(wsf, sg, row0, TP, 0.f, OMIX + (size_t)row0 * 2048 + h * 64 + cb * 16, 2048,
                     p.out + O_SSP + (size_t)(b * 16 + h) * 128 * 64 + cb * 16, 64, smem);
    } else {
      int b = li >> 6, h = (li >> 2) & 15, rb = li & 3;
      int row0 = b * TP;
      Seg sg[6] = {{RO + h * 64, 3072, 16}, {CO + h * 64, 1024, 16}, {RO + 1024 + h * 64, 3072, 16},
                   {KO + h * 64, 1024, 16}, {AO + h * 64, 1024, 16}, {RO + 2048 + h * 64 + rb * 16, 3072, 4}};
      size_t so = ((size_t)(b * 16 + h) * 64 + rb * 16) * 64;
      rwkv_item(wsf, sg, row0, TP, nullptr, p.out + O_WKP + so, OMIX + (size_t)row0 * 2048 + 1024 + h * 64 + rb * 16, 2048, smem);
    }
  }
  for (int it = blockIdx.x * 2 + half; it < 2048; it += gridDim.x * 2) {
    int b = it >> 4, h = it & 15;
    int g = h >> 3;
    long row0 = MPR + (long)b * 4;
    size_t so = (size_t)(b * 16 + h) * 128 * 64;
    colrec_short<2>(XC + 1024 + g * 128, 1536, XC + 1280 + g * 128, 1536, XC + h * 64, 1536, DTA + h * 4, row0, 0.f,
                    p.in[I_SSM] + so, p.out + O_SSS + so, 64, OMIX + h * 64, 2048, smem);
  }
  for (int it = blockIdx.x * 2 + half; it < 8192; it += gridDim.x * 2) {
    int b = it >> 6, h = (it >> 2) & 15, rb = it & 3;
    int row0 = MPR + b * 4;
    size_t so = ((size_t)(b * 16 + h) * 64 + rb * 16) * 64;
    rwkv_short(RKV, DEC, KK, KKA, h, rb, row0, p.in[I_SWK] + so, p.out + O_WKS + so,
               OMIX + (size_t)row0 * 2048 + 1024 + h * 64 + rb * 16);
  }
}

DEVI void phase_post1(const Params& p) {
  char* ws = p.ws;
  const float* PROJ = (const float*)(ws + OFF_PROJ);
  const float* OMIX = (const float*)(ws + OFF_OMIX);
  const float* XC = (const float*)(ws + OFF_GOUT);
  const float* RKV = (const float*)(ws + OFF_RKV);
  const float* GG = (const float*)(ws + OFF_GG);
  const float* BON = (const float*)(ws + OFF_BON);
  u16* MIXB = (u16*)(ws + OFF_MIXB);
  const float* dsk = p.in[I_DSK];
  const float* sng = p.in[I_SNG];
  const float* lxg = p.in[I_LXG];
  const float* lxb = p.in[I_LXB];
  const int lane = threadIdx.x & 63;
  const int gw = blockIdx.x * 8 + (threadIdx.x >> 6), nw = gridDim.x * 8;
  for (int row = gw; row < M; row += nw) {
    const float* o = OMIX + (size_t)row * 2048;
    u16* mo = MIXB + (size_t)row * 2048;
    float4 oc[4], xc[4], z[4], y[4], v[4], gg[4];
    float bn[4];
#pragma unroll
    for (int it = 0; it < 4; ++it) {
      int c = it * 256 + lane * 4;
      oc[it] = ld4(o + c);
      xc[it] = ld4(XC + (size_t)row * 1536 + c);
      z[it] = ld4(PROJ + (size_t)row * N1 + c);
      y[it] = ld4(o + 1024 + c);
      v[it] = ld4(RKV + (size_t)row * 3072 + 2048 + c);
      gg[it] = ld4(GG + (size_t)row * 1024 + c);
      bn[it] = BON[(size_t)row * 16 + it * 4 + (lane >> 4)];
    }
    float4 val[4];
    float ssq[4];
#pragma unroll
    for (int it = 0; it < 4; ++it) {
      float ds = dsk[it * 4 + (lane >> 4)];
      val[it].x = (oc[it].x + xc[it].x * ds) * z[it].x;
      val[it].y = (oc[it].y + xc[it].y * ds) * z[it].y;
      val[it].z = (oc[it].z + xc[it].z * ds) * z[it].z;
      val[it].w = (oc[it].w + xc[it].w * ds) * z[it].w;
      ssq[it] = val[it].x * val[it].x + val[it].y * val[it].y + val[it].z * val[it].z + val[it].w * val[it].w;
    }
    float inv0 = rsqrtf(wsum_u_(ssq[0] + ssq[1]) * (1.0f / 512.0f) + 1e-6f);
    float inv1 = rsqrtf(wsum_u_(ssq[2] + ssq[3]) * (1.0f / 512.0f) + 1e-6f);
#pragma unroll
    for (int it = 0; it < 4; ++it) {
      int c = it * 256 + lane * 4;
      float inv = (it < 2) ? inv0 : inv1;
      float4 sg = ld4(sng + c);
      st_bf4(mo + c, val[it].x * inv * sg.x, val[it].y * inv * sg.y, val[it].z * inv * sg.z, val[it].w * inv * sg.w);
      float mu = red16(y[it].x + y[it].y + y[it].z + y[it].w) * (1.0f / 64.0f);
      float dx = y[it].x - mu, dy = y[it].y - mu, dz = y[it].z - mu, dw = y[it].w - mu;
      float var = red16(dx * dx + dy * dy + dz * dz + dw * dw) * (1.0f / 64.0f);
      float iv = rsqrtf(var + 64e-5f);
      float4 lg = ld4(lxg + c), lb = ld4(lxb + c);
      float y0 = (dx * iv * lg.x + lb.x + bn[it] * v[it].x) * gg[it].x;
      float y1 = (dy * iv * lg.y + lb.y + bn[it] * v[it].y) * gg[it].y;
      float y2 = (dz * iv * lg.z + lb.z + bn[it] * v[it].z) * gg[it].z;
      float y3 = (dw * iv * lg.w + lb.w + bn[it] * v[it].w) * gg[it].w;
      st_bf4(mo + 1024 + c, y0, y1, y2, y3);
    }
  }
}

#define XB_TMO      128
#define XB_XCNT(j)  (256  + 64 * (j))
#define XB_XSUB(j)  (1280 + 64 * (j))
#define XB_XGEN(j)  (2304 + 64 * (j))
#define XB_TOP      3328
#define XB_TOPGEN   3392
#define XCD_BAR_WORDS 3456
#define XB_SPIN_CAP (1u << 18)
#define LAS __attribute__((address_space(3)))

__device__ __forceinline__ unsigned xb_ld(unsigned* p)              { return __hip_atomic_load(p, __ATOMIC_RELAXED, __HIP_MEMORY_SCOPE_AGENT); }
__device__ __forceinline__ unsigned xb_add(unsigned* p, unsigned v) { return __hip_atomic_fetch_add(p, v, __ATOMIC_RELAXED, __HIP_MEMORY_SCOPE_AGENT); }
__device__ __forceinline__ unsigned xb_xcc_id() { return (unsigned)__builtin_amdgcn_s_getreg((3 << 11) | 20) & 0xFu; }
#define XB_SPIN(cond, bar) do { unsigned _sp = 0; while (cond) { __builtin_amdgcn_s_sleep(1); \
    if ((++_sp & 255u) == 0u) { if (xb_ld(&(bar)[XB_TMO])) break; if (_sp > XB_SPIN_CAP) { atomicAdd(&(bar)[XB_TMO], 1u); break; } } } } while (0)

struct XcdBarrier {
    unsigned* bar; unsigned x;
    volatile LAS unsigned* st;
};

__device__ __forceinline__ XcdBarrier xcd_barrier_post(unsigned* bar, volatile LAS unsigned* st) {
    XcdBarrier b; b.bar = bar; b.x = xb_xcc_id(); b.st = st;
    if (threadIdx.x == 0) (void)xb_add(&bar[XB_XCNT(b.x)], 1u);
    return b;
}
__device__ __forceinline__ void xcd_barrier_complete(unsigned* bar, unsigned x, unsigned& nloc, unsigned& nx) {
    const unsigned G = gridDim.x * gridDim.y * gridDim.z;
    unsigned sum, cnt, mine, sp = 0u;
    for (;;) {
        sum = 0u; cnt = 0u; mine = 0u;
#pragma unroll
        for (unsigned j = 0; j < 16; ++j) { const unsigned c = xb_ld(&bar[XB_XCNT(j)]); sum += c; cnt += (c > 0u) ? 1u : 0u; mine = (j == x) ? c : mine; }
        if (sum == G) break;
        __builtin_amdgcn_s_sleep(1);
        if ((++sp & 255u) == 0u) { if (xb_ld(&bar[XB_TMO])) break; if (sp > XB_SPIN_CAP) { atomicAdd(&bar[XB_TMO], 1u); break; } }
    }
    nloc = mine > 0u ? mine : 1u; nx = cnt > 0u ? cnt : 1u;
}

__device__ __forceinline__ void xcd_barrier(const XcdBarrier& b) {
    asm volatile("s_waitcnt vmcnt(0)" ::: "memory");
    __syncthreads();
    if (threadIdx.x == 0) {
        unsigned* bar = b.bar;
        __builtin_amdgcn_s_waitcnt(0);
        unsigned nloc = b.st[0], nx = b.st[1];
        if (nloc == 0u) { xcd_barrier_complete(bar, b.x, nloc, nx); b.st[0] = nloc; b.st[1] = nx; }
        const unsigned old = xb_add(&bar[XB_XSUB(b.x)], 1u);
        const unsigned gen = old / nloc;
        if (old + 1u == (gen + 1u) * nloc) {
            __builtin_amdgcn_fence(__ATOMIC_RELEASE, "agent");
            asm volatile("s_waitcnt vmcnt(0)" ::: "memory");
            const unsigned og = xb_add(&bar[XB_TOP], 1u);
            const unsigned tg = og / nx;
            if (og + 1u == (tg + 1u) * nx) xb_add(&bar[XB_TOPGEN], 1u);
            else XB_SPIN(xb_ld(&bar[XB_TOPGEN]) == tg, bar);
            __builtin_amdgcn_fence(__ATOMIC_ACQUIRE, "agent");
            xb_add(&bar[XB_XGEN(b.x)], 1u);
            asm volatile("s_waitcnt vmcnt(0)" ::: "memory");
        } else {
            XB_SPIN(xb_ld(&bar[XB_XGEN(b.x)]) == gen, bar);
            __builtin_amdgcn_fence(__ATOMIC_ACQUIRE, "agent");
            asm volatile("s_waitcnt vmcnt(0)" ::: "memory");
        }
    }
    __syncthreads();
}


template <int ph>
DEVI void run_phase(const Params& p, char* smem_raw) {
  float* smem = (float*)smem_raw;
  char* ws = p.ws;
  {
    switch (ph) {
      case 0:
        phase0(p, smem);
        conv_fp8_rows(p.in[I_PU], (unsigned char*)(ws + OFF_UB), (float*)(ws + OFF_USC));
        conv_fp8_rows(p.in[I_PV], (unsigned char*)(ws + OFF_VB), (float*)(ws + OFF_VSC));
        break;
      case 1: {
        EpiIn0 E{(float*)(ws + OFF_PROJ), (const float*)(ws + OFF_LB), (const float*)(ws + OFF_INVREV)};
        pg8::Gemm g{(const pg8::bf16_t*)(ws + OFF_XB), (const pg8::bf16_t*)(ws + OFF_WIN0), MP, N0, 2048};
        pg8::StaticOrder S;
        S.init(MP, N0, (int)gridDim.x, (int)blockIdx.x);
        pg8::gemm_phase<EpiIn0, pg8::StaticOrder, false>((PG8_LAS unsigned char*)smem_raw, g, S, E, nullptr);
      } break;
      case 2: phase_rec0(p, smem); break;
      case 3: phase_post0(p); break;
      case 4: case 15: {
        EpiStoreF32 E{(float*)(ws + OFF_GOUT)};
        pg8::Gemm g{(const pg8::bf16_t*)(ws + OFF_MIXB), (const pg8::bf16_t*)(ws + (ph == 4 ? OFF_WOUT0 : OFF_WOUT1)), MP, 2048, 2048};
        pg8::StaticOrder S;
        S.init(MP, 2048, (int)gridDim.x, (int)blockIdx.x);
        pg8::gemm_phase<EpiStoreF32, pg8::StaticOrder, false>((PG8_LAS unsigned char*)smem_raw, g, S, E, nullptr);
      } break;
      case 5: case 16: {
        int l = (ph == 5) ? 0 : 1;
        phase_ln(p, (const float*)(ws + OFF_GOUT), p.in[I_LNG] + (size_t)(l * 2) * D, p.in[I_LNB] + (size_t)(l * 2) * D);
      } break;
      case 6: case 17: {
        EpiStoreBf16 E{(u16*)(ws + OFF_QB)};
        pg8::Gemm g{(const pg8::bf16_t*)(ws + OFF_XB), (const pg8::bf16_t*)(ws + (ph == 6 ? OFF_WQ0 : OFF_WQ1)), MP, 2048, 2048};
        pg8::StaticOrder S;
        S.init(MP, 2048, (int)gridDim.x, (int)blockIdx.x);
        pg8::gemm_phase<EpiStoreBf16, pg8::StaticOrder, false>((PG8_LAS unsigned char*)smem_raw, g, S, E, nullptr);
      } break;
      case 7: case 18: {
        float* SC = (float*)(ws + OFF_GOUT);
        gemm_phase((const u16*)(ws + OFF_QB), 2048, 128, (const u16*)(ws + (ph == 7 ? OFF_KEY0 : OFF_KEY1)), 128,
                   69, 16, smem_raw, [=](int row, int col, float v0, float v1) {
                     SC[(size_t)row * 2048 + col] = v0;
                     SC[(size_t)row * 2048 + col + 32] = v1;
                   });
      } break;
      case 8: phase_peer(p, 0, false); break;
      case 9: {
        conv_fp8_rows(p.in[I_PU] + (size_t)16384 * 2048, (unsigned char*)(ws + OFF_UB), (float*)(ws + OFF_USC));
        conv_fp8_rows(p.in[I_PV] + (size_t)16384 * 2048, (unsigned char*)(ws + OFF_VB), (float*)(ws + OFF_VSC));
        EpiIn1 E{(float*)(ws + OFF_PROJ), (float*)(ws + OFF_DTA), p.in[I_DTB], p.in[I_ALOG]};
        pg8::Gemm g{(const pg8::bf16_t*)(ws + OFF_XB), (const pg8::bf16_t*)(ws + OFF_WIN1), MP, N1, 2048};
        pg8::StaticOrder S;
        S.init(MP, N1, (int)gridDim.x, (int)blockIdx.x);
        pg8::gemm_phase<EpiIn1, pg8::StaticOrder, false>((PG8_LAS unsigned char*)smem_raw, g, S, E, nullptr);
      } break;
      case 10: phase_pre1(p); break;
      case 11: {
        float* DEC = (float*)(ws + OFF_DEC);
        float* AA = (float*)(ws + OFF_AA);
        float* GG = (float*)(ws + OFF_GG);
        const float* w0 = p.in[I_W0];
        const float* a0 = p.in[I_A0];
        gemm_phase((const u16*)(ws + OFF_LRA), 64, 0, (const u16*)(ws + OFF_W2T), 64, 69, 8, smem_raw,
                   [=](int row, int col, float v0, float v1) {
#pragma unroll
                     for (int e = 0; e < 2; ++e) {
                       int cc = col + e * 32;
                       float v = (e ? v1 : v0);
                       float wl = -softplusf_(-v) - 0.5f;
                       DEC[(size_t)row * 1024 + cc] = expf(-expf(wl));
                     }
                   }, w0);
        gemm_phase((const u16*)(ws + OFF_LRB), 64, 0, (const u16*)(ws + OFF_A2T), 64, 69, 8, smem_raw,
                   [=](int row, int col, float v0, float v1) {
                     AA[(size_t)row * 1024 + col] = sigmoidf_(v0);
                     AA[(size_t)row * 1024 + col + 32] = sigmoidf_(v1);
                   }, a0);
        gemm_phase((const u16*)(ws + OFF_LRG), 192, 0, (const u16*)(ws + OFF_G2T), 192, 69, 8, smem_raw,
                   [=](int row, int col, float v0, float v1) {
                     GG[(size_t)row * 1024 + col] = v0;
                     GG[(size_t)row * 1024 + col + 32] = v1;
                   });
      } break;
      case 12: phase_pre1c(p); break;
      case 13: phase_rec1(p, smem); break;
      case 14: phase_post1(p); break;
      case 19: phase_peer(p, 1, true); break;
      default: break;
    }
  }
}

__global__ void __launch_bounds__(512, 2) mega(Params p, int ph_lo, int ph_hi) {
  __shared__ __attribute__((aligned(16))) char smem_raw[SMEM_BYTES];
  __shared__ uint4 xb_words;
  cg::grid_group grid = cg::this_grid();
  if (threadIdx.x == 0) xb_words = make_uint4(0u, 0u, 0u, 0u);
  __syncthreads();
  XcdBarrier xb = xcd_barrier_post((unsigned*)(p.ws + OFF_BAR), (volatile LAS unsigned*)&xb_words);
  if (ph_hi > 1000) grid.sync();
#ifndef REPEAT_MASK
#define REPEAT_MASK 0
#endif
#define PHASE(K)                                          \
  if (ph_lo <= K && K < ph_hi) run_phase<K>(p, smem_raw); \
  if ((REPEAT_MASK >> K) & 1) { xcd_barrier(xb); run_phase<K>(p, smem_raw); } \
  if (ph_lo <= K && K + 1 < ph_hi) xcd_barrier(xb);
  PHASE(0) PHASE(1) PHASE(2) PHASE(3) PHASE(4) PHASE(5) PHASE(6) PHASE(7) PHASE(8) PHASE(9)
  PHASE(10) PHASE(11) PHASE(12) PHASE(13) PHASE(14) PHASE(15) PHASE(16) PHASE(17) PHASE(18) PHASE(19)
}
#ifdef PHASE_TEST
template <int PH>
__global__ void __launch_bounds__(512, 2) phk(Params p) {
  __shared__ __attribute__((aligned(16))) char smem_raw[SMEM_BYTES];
  run_phase<PH>(p, smem_raw);
}
#define INST(N) template __global__ void phk<N>(Params);
INST(0) INST(1) INST(2) INST(3) INST(4) INST(5) INST(6) INST(7) INST(8) INST(9) INST(10) INST(11) INST(12) INST(13) INST(14) INST(19)
#endif

constexpr int NPHASE = 20;

extern "C" void kernel_launch(void* const* d_in, const int* in_sizes, int n_in, void* d_out, int out_size, void* d_ws,
                              size_t ws_size, hipStream_t stream) {
  static int grid_blocks = 0;
  if (!grid_blocks) {
    int dev = 0, cus = 0, per_cu = 0;
    hipGetDevice(&dev);
    hipDeviceGetAttribute(&cus, hipDeviceAttributeMultiprocessorCount, dev);
    hipOccupancyMaxActiveBlocksPerMultiprocessor(&per_cu, mega, 512, 0);
    if (per_cu > 1) per_cu = 1;
    if (per_cu < 1) per_cu = 1;
    grid_blocks = cus * per_cu;
  }
  Params p{};
  for (int i = 0; i < 38; ++i) p.in[i] = (const float*)d_in[i];
  p.out = (float*)d_out;
  p.ws = (char*)d_ws;
  (void)hipMemsetAsync((char*)d_ws + OFF_BAR, 0, 3456 * 4, stream);
  int lo = 0, hi = NPHASE;
  void* args[] = {&p, &lo, &hi};
  hipError_t e = hipLaunchCooperativeKernel((void*)mega, dim3(grid_blocks), dim3(512), args, 0, stream);
  if (e != hipSuccess) fprintf(stderr, "cooperative launch failed: %s (grid %d)\n", hipGetErrorString(e), grid_blocks);
}
```

```cpp
#include <hip/hip_runtime.h>
#include <hip/hip_bf16.h>
#include <hip/hip_cooperative_groups.h>
#include <cstdio>
#include <cmath>
namespace cg = cooperative_groups;

#define DEVI __device__ __forceinline__
typedef unsigned short u16;
using bf16x8 = __attribute__((ext_vector_type(8))) short;
using f32x4 = __attribute__((ext_vector_type(4))) float;
using u32x4 = __attribute__((ext_vector_type(4))) unsigned int;

constexpr int D = 2048;
constexpr int TP = 2064;
constexpr int MPR = 8256;
constexpr int M = 8768;
constexpr int MP = 8960;
constexpr int N0 = 7168;
constexpr int N1 = 6144;
constexpr float ALPHA = 1.41421356237f;

constexpr size_t SZ_TAB = (size_t)16384 * 2048 * 2;
constexpr size_t OFF_UB = 0;
constexpr size_t OFF_VB = OFF_UB + SZ_TAB;
constexpr size_t OFF_WIN0 = OFF_VB + SZ_TAB;
constexpr size_t OFF_WOUT0 = OFF_WIN0 + (size_t)N0 * 2048 * 2;
constexpr size_t OFF_WQ0 = OFF_WOUT0 + (size_t)2048 * 2048 * 2;
constexpr size_t OFF_KEY0 = OFF_WQ0 + (size_t)2048 * 2048 * 2;
constexpr size_t OFF_WIN1 = OFF_KEY0 + (size_t)16 * 128 * 128 * 2;
constexpr size_t OFF_WOUT1 = OFF_WIN1 + (size_t)N1 * 2048 * 2;
constexpr size_t OFF_WQ1 = OFF_WOUT1 + (size_t)2048 * 2048 * 2;
constexpr size_t OFF_KEY1 = OFF_WQ1 + (size_t)2048 * 2048 * 2;
constexpr size_t OFF_W2T = OFF_KEY1 + (size_t)16 * 128 * 128 * 2;
constexpr size_t OFF_A2T = OFF_W2T + (size_t)1024 * 64 * 2;
constexpr size_t OFF_G2T = OFF_A2T + (size_t)1024 * 64 * 2;
constexpr size_t OFF_LB = OFF_G2T + (size_t)1024 * 192 * 2;
constexpr size_t OFF_INVREV = OFF_LB + 1024 * 4;
constexpr size_t OFF_XF = OFF_INVREV + 64 * 8;
constexpr size_t OFF_XB = OFF_XF + (size_t)MP * 2048 * 4;
constexpr size_t OFF_PROJ = OFF_XB + (size_t)MP * 2048 * 2;
constexpr size_t OFF_GOUT = OFF_PROJ + (size_t)MP * N0 * 4;
constexpr size_t OFF_OMIX = OFF_GOUT + (size_t)MP * 2048 * 4;
constexpr size_t OFF_MIXB = OFF_OMIX + (size_t)MP * 2048 * 4;
constexpr size_t OFF_QB = OFF_MIXB + (size_t)MP * 2048 * 2;
constexpr size_t OFF_RKV = OFF_QB + (size_t)MP * 2048 * 2;
constexpr size_t OFF_DEC = OFF_RKV + (size_t)MP * 3072 * 4;
constexpr size_t OFF_AA = OFF_DEC + (size_t)MP * 1024 * 4;
constexpr size_t OFF_GG = OFF_AA + (size_t)MP * 1024 * 4;
constexpr size_t OFF_LRA = OFF_GG + (size_t)MP * 1024 * 4;
constexpr size_t OFF_LRB = OFF_LRA + (size_t)MP * 64 * 2;
constexpr size_t OFF_LRG = OFF_LRB + (size_t)MP * 64 * 2;
constexpr size_t OFF_DTA = OFF_LRG + (size_t)MP * 192 * 2;
constexpr size_t OFF_BON = OFF_DTA + (size_t)MP * 64 * 4;
constexpr size_t OFF_USC = OFF_BON + (size_t)MP * 16 * 4;
constexpr size_t OFF_VSC = OFF_USC + 16384 * 4;
constexpr size_t OFF_BAR = OFF_VSC + 16384 * 4;
constexpr size_t WS_TOTAL = OFF_BAR + 3456 * 4;
static_assert(WS_TOTAL <= (size_t)1 << 30, "workspace too large");

constexpr size_t O_YP = 0;
constexpr size_t O_YS = O_YP + (size_t)4 * 2048 * 2048;
constexpr size_t O_HGP = O_YS + (size_t)128 * 4 * 2048;
constexpr size_t O_HGS = O_HGP + (size_t)4 * 8 * 128 * 128;
constexpr size_t O_RTP = O_HGS + (size_t)128 * 8 * 128 * 128;
constexpr size_t O_RTS = O_RTP + (size_t)4 * 4 * 128 * 256;
constexpr size_t O_SSP = O_RTS + (size_t)128 * 4 * 128 * 256;
constexpr size_t O_SSS = O_SSP + (size_t)4 * 16 * 128 * 64;
constexpr size_t O_CVP = O_SSS + (size_t)128 * 16 * 128 * 64;
constexpr size_t O_CVS = O_CVP + (size_t)4 * 3 * 1536;
constexpr size_t O_WKP = O_CVS + (size_t)128 * 3 * 1536;
constexpr size_t O_WKS = O_WKP + (size_t)4 * 16 * 64 * 64;
constexpr size_t O_SHP = O_WKS + (size_t)128 * 16 * 64 * 64;
constexpr size_t O_SHS = O_SHP + (size_t)4 * 3360;

struct Params {
  const float* in[38];
  float* out;
  char* ws;
};
enum { I_XP = 0, I_XS, I_SHG, I_SRT, I_SSM, I_SCV, I_SWK, I_SSH, I_META, I_LNG, I_LNB, I_EWIN, I_LBL, I_HNG, I_EWOUT,
       I_OWIN, I_CVW, I_CVB, I_DTB, I_ALOG, I_DSK, I_SNG, I_MU, I_W0, I_W2, I_A0, I_A2, I_G2, I_KK, I_KA, I_RK,
       I_LXG, I_LXB, I_OWOUT, I_WQ, I_KEYS, I_PU, I_PV };

constexpr int VB_BYTES = 2 * 2 * 128 * 72 * 2;
constexpr int SMEM_BYTES = 2 * VB_BYTES;

DEVI u16 f2bf(float f) {
  unsigned u = __float_as_uint(f);
  u += 0x7fffu + ((u >> 16) & 1u);
  return (u16)(u >> 16);
}
DEVI unsigned pack2(float a, float b) { return (unsigned)f2bf(a) | ((unsigned)f2bf(b) << 16); }
DEVI float bflo(unsigned u) { return __uint_as_float(u << 16); }
DEVI float bfhi(unsigned u) { return __uint_as_float(u & 0xffff0000u); }
DEVI float sigmoidf_(float x) { return __builtin_amdgcn_rcpf(1.0f + __builtin_amdgcn_exp2f(-1.44269504089f * x)); }
DEVI float siluf_(float x) { return x * __builtin_amdgcn_rcpf(1.0f + __builtin_amdgcn_exp2f(-1.44269504089f * x)); }
DEVI float sigmoid_acc(float x) { return 1.0f / (1.0f + expf(-x)); }
DEVI float silu_acc(float x) { return x / (1.0f + expf(-x)); }
DEVI float softplusf_(float x) { return fmaxf(x, 0.0f) + log1pf(expf(-fabsf(x))); }
DEVI float wsum(float v) {
#pragma unroll
  for (int o = 32; o > 0; o >>= 1) v += __shfl_xor(v, o, 64);
  return v;
}
DEVI float wmaxf_(float v) {
#pragma unroll
  for (int o = 32; o > 0; o >>= 1) v = fmaxf(v, __shfl_xor(v, o, 64));
  return v;
}
DEVI int wmini_(int v) {
#pragma unroll
  for (int o = 32; o > 0; o >>= 1) v = min(v, __shfl_xor(v, o, 64));
  return v;
}
template <int CTRL>
DEVI float dppf(float v) {
  return __int_as_float(__builtin_amdgcn_update_dpp(0, __float_as_int(v), CTRL, 0xF, 0xF, true));
}
DEVI float red8(float v) {
  v += dppf<0xB1>(v);
  v += dppf<0x4E>(v);
  v += dppf<0x141>(v);
  return v;
}
DEVI float red16(float v) {
  v = red8(v);
  v += dppf<0x140>(v);
  return v;
}
DEVI float rlf_(float v, int l) { return __int_as_float(__builtin_amdgcn_readlane(__float_as_int(v), l)); }
DEVI int row_pos(int row) { return row < MPR ? (row % TP) : (16384 + ((row - MPR) & 3)); }

DEVI void conv_bf16_flat(const float* __restrict__ src, u16* __restrict__ dst, size_t n4) {
  size_t stride = (size_t)gridDim.x * blockDim.x;
  for (size_t i = (size_t)blockIdx.x * blockDim.x + threadIdx.x; i < n4; i += stride) {
    float4 v = ((const float4*)src)[i];
    uint2 o;
    o.x = pack2(v.x, v.y);
    o.y = pack2(v.z, v.w);
    ((uint2*)dst)[i] = o;
  }
}

template <int MODE>
DEVI int colmap(int j) {
  if (MODE == 0) return j;
  if (MODE == 1) {
    if (j < 4096 || j >= 5120) return j;
    int hb = j & ~127, c = j & 127, wc = c >> 5, n = (c >> 4) & 1, r = c & 15;
    int d = n ? (64 + wc * 16 + r) : (wc * 16 + r);
    return hb + d;
  }
  if (j < 2560) return j;
  if (j < 5920) return j + 16;
  if (j < 5936) return 2560 + (j - 5920);
  return -1;
}

template <int MODE>
DEVI void transpose_job(const float* __restrict__ src, int ldsrc, int Ksrc, u16* __restrict__ dst, int Kdst, int ndst,
                        float* smem) {
  int ktiles = Kdst / 64, ntiles = ndst / 64;
  int tid = threadIdx.x & 255;
  const int half = threadIdx.x >> 8;
  smem += half * (64 * 65);
  for (int base = blockIdx.x * 2; base < ktiles * ntiles; base += gridDim.x * 2) {
    int tile = base + half;
    const bool valid = tile < ktiles * ntiles;
    if (!valid) tile = ktiles * ntiles - 1;
    int tn = tile / ktiles, tk = tile % ktiles;
    int j0 = tn * 64, k0 = tk * 64;
    int jj = (tid & 15) * 4;
    int sc = colmap<MODE>(j0 + jj);
#pragma unroll
    for (int i = 0; i < 4; ++i) {
      int kk = i * 16 + (tid >> 4);
      float4 v = make_float4(0.f, 0.f, 0.f, 0.f);
      if (sc >= 0 && (k0 + kk) < Ksrc) v = *(const float4*)(src + (size_t)(k0 + kk) * ldsrc + sc);
      smem[kk * 65 + jj] = v.x;
      smem[kk * 65 + jj + 1] = v.y;
      smem[kk * 65 + jj + 2] = v.z;
      smem[kk * 65 + jj + 3] = v.w;
    }
    __syncthreads();
    int jr = tid >> 2, kq = (tid & 3) * 16;
    unsigned pk[8];
#pragma unroll
    for (int e = 0; e < 8; ++e) pk[e] = pack2(smem[(kq + 2 * e) * 65 + jr], smem[(kq + 2 * e + 1) * 65 + jr]);
    uint4* dp = (uint4*)(dst + (size_t)(j0 + jr) * Kdst + k0 + kq);
    if (valid) {
      dp[0] = make_uint4(pk[0], pk[1], pk[2], pk[3]);
      dp[1] = make_uint4(pk[4], pk[5], pk[6], pk[7]);
    }
    __syncthreads();
  }
}

DEVI void phase0(const Params& p, float* smem) {
  char* ws = p.ws;
  conv_bf16_flat(p.in[I_KEYS], (u16*)(ws + OFF_KEY0), (size_t)16 * 128 * 128 / 4);
  conv_bf16_flat(p.in[I_KEYS] + (size_t)16 * 128 * 128, (u16*)(ws + OFF_KEY1), (size_t)16 * 128 * 128 / 4);
  transpose_job<1>(p.in[I_EWIN], N0, 2048, (u16*)(ws + OFF_WIN0), 2048, N0, smem);
  transpose_job<0>(p.in[I_EWOUT], 2048, 2048, (u16*)(ws + OFF_WOUT0), 2048, 2048, smem);
  transpose_job<0>(p.in[I_WQ], 2048, 2048, (u16*)(ws + OFF_WQ0), 2048, 2048, smem);
  transpose_job<0>(p.in[I_WQ] + (size_t)2048 * 2048, 2048, 2048, (u16*)(ws + OFF_WQ1), 2048, 2048, smem);
  transpose_job<2>(p.in[I_OWIN], 5936, 2048, (u16*)(ws + OFF_WIN1), 2048, N1, smem);
  transpose_job<0>(p.in[I_OWOUT], 2048, 2048, (u16*)(ws + OFF_WOUT1), 2048, 2048, smem);
  transpose_job<0>(p.in[I_W2], 1024, 64, (u16*)(ws + OFF_W2T), 64, 1024, smem);
  transpose_job<0>(p.in[I_A2], 1024, 64, (u16*)(ws + OFF_A2T), 64, 1024, smem);
  transpose_job<0>(p.in[I_G2], 1024, 160, (u16*)(ws + OFF_G2T), 192, 1024, smem);
  {
    float* XF = (float*)(ws + OFF_XF);
    u16* XB = (u16*)(ws + OFF_XB);
    size_t n4 = (size_t)MP * 512;
    size_t stride = (size_t)gridDim.x * blockDim.x;
    for (size_t i = (size_t)blockIdx.x * blockDim.x + threadIdx.x; i < n4; i += stride) {
      int row = (int)(i >> 9), c4 = (int)(i & 511);
      float4 v = make_float4(0.f, 0.f, 0.f, 0.f);
      if (row < MPR) {
        int b = row / TP, t = row % TP;
        const float* s = (t < 16) ? (p.in[I_META] + (size_t)t * D) : (p.in[I_XP] + ((size_t)b * 2048 + (t - 16)) * D);
        v = ((const float4*)s)[c4];
      } else if (row < M) {
        v = ((const float4*)(p.in[I_XS] + (size_t)(row - MPR) * D))[c4];
      }
      ((float4*)XF)[i] = v;
      uint2 o;
      o.x = pack2(v.x, v.y);
      o.y = pack2(v.z, v.w);
      ((uint2*)XB)[i] = o;
    }
  }
  if (blockIdx.x == 0) {
    float* LB = (float*)(ws + OFF_LB);
    const float* lg = p.in[I_LBL];
    for (int c = threadIdx.x; c < 1024; c += blockDim.x) {
      float a = lg[c], b = lg[1024 + c], d = lg[2048 + c];
      float m = fmaxf(a, fmaxf(b, d));
      float ea = expf(a - m), eb = expf(b - m), ed = expf(d - m);
      LB[c] = ea / (ea + eb + ed);
    }
    float* IR = (float*)(ws + OFF_INVREV);
    if (threadIdx.x < 64) {
      double d = (double)threadIdx.x;
      double v = exp(-d * (9.210340371976184 / 64.0)) * 0.15915494309189535;
      float h = (float)v;
      IR[threadIdx.x * 2] = h;
      IR[threadIdx.x * 2 + 1] = (float)(v - (double)h);
    }
  }
}

constexpr int G_LDS_STRIDE = 72;
constexpr int G_LDS_BUF = 2 * 128 * G_LDS_STRIDE;
template <class Epi>
DEVI void gemm_phase(const u16* __restrict__ A, int lda, int a_ntile_off, const u16* __restrict__ Bt, int K, int mtiles,
                     int ntiles, char* smem, Epi epi, const float* __restrict__ colc = nullptr) {
  const int half = threadIdx.x >> 8;
  u16* S0 = (u16*)(smem + half * VB_BYTES);
  const int tid = threadIdx.x & 255, wid = tid >> 6, lane = tid & 63, wr = wid >> 1, wc = wid & 1, fr = lane & 15, fq = lane >> 4;
  const int nk = K / 64;
  const int ntot = mtiles * ntiles;
  for (int base = blockIdx.x * 2; base < ntot; base += gridDim.x * 2) {
    int tile = base + half;
    const bool valid = tile < ntot;
    if (!valid) tile = ntot - 1;
    const int tm = tile / ntiles, tn = tile - tm * ntiles;
    const int brow = tm * 128, bcol = tn * 128;
    const u16* Ag = A + (size_t)brow * lda + (size_t)tn * a_ntile_off;
    const u16* Bg = Bt + (size_t)bcol * K;
    f32x4 acc[4][4];
#pragma unroll
    for (int m = 0; m < 4; ++m)
#pragma unroll
      for (int n = 0; n < 4; ++n) acc[m][n] = f32x4{0.f, 0.f, 0.f, 0.f};
    u32x4 ra0[4], rb0[4], ra1[4], rb1[4];
    auto gload = [&](int t, u32x4(&ra)[4], u32x4(&rb)[4]) {
#pragma unroll
      for (int i = 0; i < 4; ++i) {
        int c = tid + i * 256, r = c >> 3, kc = c & 7;
        ra[i] = *(const u32x4*)(Ag + (size_t)r * lda + t * 64 + kc * 8);
        rb[i] = *(const u32x4*)(Bg + (size_t)r * K + t * 64 + kc * 8);
      }
    };
    auto lwrite = [&](int buf, const u32x4(&ra)[4], const u32x4(&rb)[4]) {
      u16* SA = S0 + buf * G_LDS_BUF;
      u16* SB = SA + 128 * G_LDS_STRIDE;
#pragma unroll
      for (int i = 0; i < 4; ++i) {
        int c = tid + i * 256, r = c >> 3, kc = c & 7;
        *(u32x4*)(SA + r * G_LDS_STRIDE + kc * 8) = ra[i];
        *(u32x4*)(SB + r * G_LDS_STRIDE + kc * 8) = rb[i];
      }
    };
    auto compute = [&](int buf) {
      const u16* SA = S0 + buf * G_LDS_BUF;
      const u16* SB = SA + 128 * G_LDS_STRIDE;
#pragma unroll
      for (int kh = 0; kh < 2; ++kh) {
        bf16x8 At[4], Bl[4];
#pragma unroll
        for (int m = 0; m < 4; ++m)
          At[m] = *(const bf16x8*)(SA + (wr * 64 + m * 16 + fr) * G_LDS_STRIDE + kh * 32 + fq * 8);
#pragma unroll
        for (int n = 0; n < 4; ++n)
          Bl[n] = *(const bf16x8*)(SB + (wc * 64 + n * 16 + fr) * G_LDS_STRIDE + kh * 32 + fq * 8);
#pragma unroll
        for (int m = 0; m < 4; ++m)
#pragma unroll
          for (int n = 0; n < 4; ++n) acc[m][n] = __builtin_amdgcn_mfma_f32_16x16x32_bf16(At[m], Bl[n], acc[m][n], 0, 0, 0);
        __builtin_amdgcn_sched_barrier(0);
      }
    };
    gload(0, ra0, rb0);
    if (nk > 1) gload(1, ra1, rb1);
    lwrite(0, ra0, rb0);
    __syncthreads();
#pragma unroll 1
    for (int t = 0; t < nk; t += 2) {
      if (t + 2 < nk) gload(t + 2, ra0, rb0);
      compute(0);
      if (t + 1 < nk) lwrite(1, ra1, rb1);
      __syncthreads();
      if (t + 1 < nk) {
        if (t + 3 < nk) gload(t + 3, ra1, rb1);
        compute(1);
        if (t + 2 < nk) lwrite(0, ra0, rb0);
        __syncthreads();
      }
    }
    if (valid) {
      float cc[4] = {0.f, 0.f, 0.f, 0.f};
      if (colc) {
#pragma unroll
        for (int n = 0; n < 4; ++n) cc[n] = colc[bcol + wc * 64 + n * 16 + fr];
      }
#pragma unroll
      for (int m = 0; m < 4; ++m)
#pragma unroll
        for (int n = 0; n < 2; ++n)
#pragma unroll
          for (int j = 0; j < 4; ++j) {
            int row = brow + wr * 64 + m * 16 + fq * 4 + j;
            int col = bcol + wc * 64 + n * 16 + fr;
            epi(row, col, acc[m][n][j] + cc[n], acc[m][n + 2][j] + cc[n + 2]);
          }
    }
  }
}


namespace pg8 {
#define PG8_LAS __attribute__((address_space(3)))
typedef unsigned short bf16_t;
typedef short bf16x8 __attribute__((ext_vector_type(8)));
typedef float f32x4 __attribute__((ext_vector_type(4)));
typedef unsigned u32x4 __attribute__((ext_vector_type(4)));
constexpr int BM = 256, BK = 64, HALF = 128, HTB = HALF * BK * 2  , STAGE_BYTES = 8 * HTB, NXCD = 8, WGM = 8;

__host__ __device__ __forceinline__ int lds_byte(int r, int c) { const int st = (r >> 4) * 2 + (c >> 5), rr = r & 15, cc = c & 31, ob = rr * 64 + cc * 2; return st * 1024 + (ob ^ (((ob >> 9) & 1) << 5)); }
__host__ __device__ __forceinline__ void stage_rc(int b, int& R, int& C) { const int st = b / 1024, sb = b % 1024, swz = sb ^ (((sb >> 9) & 1) << 5); R = (st >> 1) * 16 + swz / 64; C = (st & 1) * 32 + (swz % 64) / 2; }
__host__ __device__ __forceinline__ int perm32(int rho) { const int n = rho >> 4, i = rho & 15; return 8 * (i >> 2) + 4 * n + (i & 3); }

struct Unit { int pm, pn; };
struct Gemm { const bf16_t* A; const bf16_t* Bt; int M, N, K; };

struct StaticOrder {
    int nM, nN, nwg, G, c;
    __host__ __device__ void init(int M, int N, int G_, int c_) { nM = M / BM; nN = N / BM; nwg = nM * nN; G = G_; c = c_; }
    __host__ __device__ bool next(int i, Unit& u) const {
        const long L = (long)i * G + c; if (L >= nwg) return false;
        int wgid = (int)L; { const int q = nwg / NXCD, r = nwg % NXCD, xcd = wgid % NXCD, off = wgid / NXCD; wgid = (xcd < r ? xcd * (q + 1) : r * (q + 1) + (xcd - r) * q) + off; }
        const int nig = WGM * nN, gid = wgid / nig, fm = gid * WGM, gsz = (nM - fm) < WGM ? (nM - fm) : WGM;
        u.pm = fm + ((wgid % nig) % gsz); u.pn = (wgid % nig) / gsz; return true;
    }
    __device__ __forceinline__ void a_ready(const Unit&) const {}
    __device__ __forceinline__ void done(const Unit&) const {}
};
template <class Epi, class Sched, bool STAMP = false>
__device__ __forceinline__ void gemm_phase(PG8_LAS unsigned char* lds, const Gemm g, const Sched& S, const Epi& E, unsigned long long* stamps) {
    const int tid = threadIdx.x, wid = __builtin_amdgcn_readfirstlane(tid >> 6), lane = tid & 63, wr = wid >> 2, wc = wid & 3, fr = lane & 15, fq = lane >> 4;
    const int K = g.K, nt = K / BK;
    int ts_lo = 0, ts_hi = 0, nts = 0; const unsigned long long rt_entry = STAMP ? (unsigned long long)wall_clock64() : 0ull;
#define PG8_STAMP() do { if (STAMP && wid == 0 && nts < 64) { const unsigned long long _c = (unsigned long long)clock64(); \
        ts_lo = (lane == nts) ? (int)(unsigned)_c : ts_lo; ts_hi = (lane == nts) ? (int)(unsigned)(_c >> 32) : ts_hi; ++nts; } } while (0)
    PG8_STAMP();
    unsigned voffA[2], voffB[2];
#pragma unroll
    for (int i = 0; i < 2; ++i) { int R, C; stage_rc(tid * 16 + i * 8192, R, C); const int Rb = Epi::PERM ? ((R & ~31) + perm32(R & 31)) : R;
        voffA[i] = (unsigned)(R * K + C) * 2u; voffB[i] = (unsigned)(Rb * K + C) * 2u; }
    const size_t kstep = (size_t)(BK * 2);
    const size_t hstep = (size_t)HALF * K * 2;
    const size_t tstep = 2 * hstep;
    const unsigned ldsw = (unsigned)wid * 1024u;
    const int aoff = lds_byte(wr * 64 + fr, fq * 8), boff = lds_byte(wc * 32 + fr, fq * 8);
#define PG8_SA(b, h) (((b) * 2 + (h)) * HTB)
#define PG8_SB(b, h) ((4 + (b) * 2 + (h)) * HTB)
#define PG8_STAGE(bufoff, gbase, voff) do { _Pragma("unroll") for (int _i = 0; _i < 2; ++_i) \
        __builtin_amdgcn_global_load_lds((const unsigned*)((const char*)(gbase) + (voff)[_i]), (PG8_LAS unsigned*)(lds + (bufoff) + ldsw + _i * 8192), 16, 0, 0); } while (0)
#define PG8_LDA(dst, b, h) do { _Pragma("unroll") for (int m = 0; m < 4; ++m) _Pragma("unroll") for (int k = 0; k < 2; ++k) dst[m][k] = *(const PG8_LAS bf16x8*)(lds + PG8_SA(b, h) + aoff + m * 2048 + k * 1024); } while (0)
#define PG8_LDB(dst, b, h) do { _Pragma("unroll") for (int n = 0; n < 2; ++n) _Pragma("unroll") for (int k = 0; k < 2; ++k) dst[n][k] = *(const PG8_LAS bf16x8*)(lds + PG8_SB(b, h) + boff + n * 2048 + k * 1024); } while (0)
#define PG8_MMA(ai, bj, At, Bt) do { __builtin_amdgcn_s_setprio(1); _Pragma("unroll") for (int m = 0; m < 4; ++m) _Pragma("unroll") for (int n = 0; n < 2; ++n) _Pragma("unroll") for (int k = 0; k < 2; ++k) \
        acc[ai][bj][m][n] = __builtin_amdgcn_mfma_f32_16x16x32_bf16(Bt[n][k], At[m][k], acc[ai][bj][m][n], 0, 0, 0); __builtin_amdgcn_s_setprio(0); } while (0)
#define PG8_WAIT_V(n) asm volatile("s_waitcnt vmcnt(" #n ")" ::: "memory")
#define PG8_WAIT_L(n) asm volatile("s_waitcnt lgkmcnt(" #n ")" ::: "memory")
#define PG8_BAR __builtin_amdgcn_s_barrier()
#define PG8_SCHED __builtin_amdgcn_sched_barrier(0)
    Unit cur, nxt; int ui = 0;
    if (!S.next(0, cur)) return;
    f32x4 acc[2][2][4][2];
#pragma unroll
    for (int a = 0; a < 2; ++a)
#pragma unroll
        for (int b = 0; b < 2; ++b)
#pragma unroll
            for (int m = 0; m < 4; ++m)
#pragma unroll
                for (int n = 0; n < 2; ++n) acc[a][b][m][n] = (f32x4){0.f, 0.f, 0.f, 0.f};
    bf16x8 At[4][2], B0[2][2], B1[2][2];
    const char* cA = (const char*)g.A + (size_t)cur.pm * tstep; const char* cB = (const char*)g.Bt + (size_t)cur.pn * tstep;
    S.a_ready(cur);
    PG8_STAGE(PG8_SB(0, 0), cB, voffB); PG8_STAGE(PG8_SA(0, 0), cA, voffA); PG8_STAGE(PG8_SB(0, 1), cB + hstep, voffB); PG8_STAGE(PG8_SA(0, 1), cA + hstep, voffA);
    if (wr == 1) PG8_BAR;
    PG8_WAIT_V(4); PG8_BAR;
    PG8_STAGE(PG8_SB(1, 0), cB + kstep, voffB); PG8_STAGE(PG8_SA(1, 0), cA + kstep, voffA); PG8_STAGE(PG8_SB(1, 1), cB + hstep + kstep, voffB);
    PG8_WAIT_V(6); PG8_BAR;
    PG8_STAMP();
    for (;;) {
        const bool has_next = S.next(ui + 1, nxt);
        const char* nA = has_next ? (const char*)g.A + (size_t)nxt.pm * tstep : cA; const char* nB = has_next ? (const char*)g.Bt + (size_t)nxt.pn * tstep : cB;
        for (int t = 0; t < nt; t += 2) {
            const bool last = (t == nt - 2);
            const char* a1 = cA + (size_t)(t + 1) * kstep;
            const char* a2 = last ? nA : cA + (size_t)(t + 2) * kstep; const char* b2 = last ? nB : cB + (size_t)(t + 2) * kstep;
            const char* a3 = a2 + kstep; const char* b3 = b2 + kstep;
            if (last && has_next) S.a_ready(nxt);
            PG8_LDB(B0, 0, 0); PG8_SCHED; PG8_LDA(At, 0, 0); PG8_STAGE(PG8_SA(1, 1), a1 + hstep, voffA);
            PG8_WAIT_L(8); PG8_BAR; PG8_WAIT_L(0); PG8_MMA(0, 0, At, B0); PG8_BAR; PG8_SCHED;
            PG8_LDB(B1, 0, 1); PG8_STAGE(PG8_SB(0, 0), b2, voffB);
            PG8_BAR; PG8_WAIT_L(0); PG8_MMA(0, 1, At, B1); PG8_BAR;
            PG8_LDA(At, 0, 1); PG8_STAGE(PG8_SA(0, 0), a2, voffA);
            PG8_BAR; PG8_WAIT_L(0); PG8_MMA(1, 0, At, B0); PG8_BAR; PG8_SCHED;
            PG8_STAGE(PG8_SB(0, 1), b2 + hstep, voffB);
            PG8_WAIT_V(6); PG8_BAR; PG8_MMA(1, 1, At, B1); PG8_BAR;
            PG8_LDB(B0, 1, 0); PG8_SCHED; PG8_LDA(At, 1, 0); PG8_STAGE(PG8_SA(0, 1), a2 + hstep, voffA);
            PG8_WAIT_L(8); PG8_BAR; PG8_WAIT_L(0); PG8_MMA(0, 0, At, B0); PG8_BAR; PG8_SCHED;
            PG8_LDB(B1, 1, 1); PG8_STAGE(PG8_SB(1, 0), b3, voffB);
            PG8_BAR; PG8_WAIT_L(0); PG8_MMA(0, 1, At, B1); PG8_BAR;
            PG8_LDA(At, 1, 1); PG8_STAGE(PG8_SA(1, 0), a3, voffA);
            PG8_BAR; PG8_WAIT_L(0); PG8_MMA(1, 0, At, B0); PG8_BAR; PG8_SCHED;
            PG8_STAGE(PG8_SB(1, 1), b3 + hstep, voffB);
            PG8_WAIT_V(6); PG8_BAR; PG8_MMA(1, 1, At, B1); PG8_BAR;
        }
        PG8_STAMP();
        if constexpr (!Epi::AFTER_DRAIN) { E(acc, cur, wr, wc, fr, fq); S.done(cur); }
        PG8_STAMP();
        if (!has_next) break;
#pragma unroll
        for (int a = 0; a < 2; ++a)
#pragma unroll
            for (int b = 0; b < 2; ++b)
#pragma unroll
                for (int m = 0; m < 4; ++m)
#pragma unroll
                    for (int n = 0; n < 2; ++n) acc[a][b][m][n] = (f32x4){0.f, 0.f, 0.f, 0.f};
        cur = nxt; cA = nA; cB = nB; ++ui;
    }
    PG8_WAIT_V(0);
    if (wr == 0) PG8_BAR;
    PG8_BAR;
    if constexpr (Epi::AFTER_DRAIN) { E.fused(acc, cur, wr, wc, fr, fq, lds, wid, lane); S.done(cur); }
    PG8_STAMP();
    if (STAMP && wid == 0) { stamps[lane] = lane < nts ? (((unsigned long long)(unsigned)ts_hi << 32) | (unsigned)ts_lo) : 0ull;
        if (lane == 62) stamps[62] = rt_entry; if (lane == 63) stamps[63] = (unsigned long long)wall_clock64(); }
#undef PG8_STAMP
#undef PG8_SA
#undef PG8_SB
#undef PG8_STAGE
#undef PG8_LDA
#undef PG8_LDB
#undef PG8_MMA
#undef PG8_WAIT_V
#undef PG8_WAIT_L
#undef PG8_BAR
#undef PG8_SCHED
}
}

struct EpiIn0 {
  static constexpr bool PERM = false, AFTER_DRAIN = false;
  float* PROJ;
  const float* LB;
  const float* IR;
  __device__ __forceinline__ void operator()(const pg8::f32x4 (&acc)[2][2][4][2], const pg8::Unit& u, int wr, int wc, int fr, int fq) const {
#pragma unroll
    for (int bj = 0; bj < 2; ++bj) {
      const int cb = u.pn * 256 + bj * 128;
      if (cb >= 4096 && cb < 5120) {
        const int d0 = wc * 16 + 4 * fq;
        const pg8::f32x4 irA = *(const pg8::f32x4*)(IR + 2 * d0), irB = *(const pg8::f32x4*)(IR + 2 * d0 + 4);
        const float irh[4] = {irA[0], irA[2], irB[0], irB[2]}, irl[4] = {irA[1], irA[3], irB[1], irB[3]};
        const float sc = (cb >= 4608) ? 0.08838834764831845f : 1.0f;
#pragma unroll
        for (int ai = 0; ai < 2; ++ai)
#pragma unroll
          for (int m = 0; m < 4; ++m) {
            const int row = u.pm * 256 + ai * 128 + wr * 64 + m * 16 + fr;
            float* pr = PROJ + (size_t)row * N0;
            const pg8::f32x4 v0 = acc[ai][bj][m][0], v1 = acc[ai][bj][m][1];
            const float pos = (float)row_pos(row);
            pg8::f32x4 o1, o2;
#pragma unroll
            for (int j = 0; j < 4; ++j) {
              float ph = pos * irh[j];
              float pe = __builtin_fmaf(pos, irh[j], -ph) + pos * irl[j];
              float frc = __builtin_amdgcn_fractf(ph) + pe;
              float sn = __builtin_amdgcn_sinf(frc), cs = __builtin_amdgcn_cosf(frc);
              o1[j] = (v0[j] * cs - v1[j] * sn) * sc;
              o2[j] = (v0[j] * sn + v1[j] * cs) * sc;
            }
            *(pg8::f32x4*)(pr + cb + d0) = o1;
            *(pg8::f32x4*)(pr + cb + 64 + d0) = o2;
            __builtin_amdgcn_sched_barrier(0);
          }
      } else if (cb >= 1024 && cb < 2048) {
        const int c0 = cb + 32 * wc + 4 * fq;
        const pg8::f32x4 l0 = *(const pg8::f32x4*)(LB + c0 - 1024), l1 = *(const pg8::f32x4*)(LB + c0 + 16 - 1024);
#pragma unroll
        for (int ai = 0; ai < 2; ++ai)
#pragma unroll
          for (int m = 0; m < 4; ++m) {
            const int row = u.pm * 256 + ai * 128 + wr * 64 + m * 16 + fr;
            float* pr = PROJ + (size_t)row * N0;
#pragma unroll
            for (int n = 0; n < 2; ++n) {
              const pg8::f32x4 l = n ? l1 : l0;
              pg8::f32x4 v = acc[ai][bj][m][n], o;
#pragma unroll
              for (int j = 0; j < 4; ++j) o[j] = l[j] + (1.0f - l[j]) * sigmoid_acc(v[j]);
              *(pg8::f32x4*)(pr + c0 + 16 * n) = o;
            }
            __builtin_amdgcn_sched_barrier(0);
          }
      } else {
        const bool act = (cb < 1024 || (cb >= 3072 && cb < 4096) || cb >= 6144);
        const int c0 = cb + 32 * wc + 4 * fq;
#pragma unroll
        for (int ai = 0; ai < 2; ++ai)
#pragma unroll
          for (int m = 0; m < 4; ++m) {
            const int row = u.pm * 256 + ai * 128 + wr * 64 + m * 16 + fr;
            float* pr = PROJ + (size_t)row * N0;
#pragma unroll
            for (int n = 0; n < 2; ++n) {
              pg8::f32x4 v = acc[ai][bj][m][n], o;
#pragma unroll
              for (int j = 0; j < 4; ++j) o[j] = act ? silu_acc(v[j]) : v[j];
              *(pg8::f32x4*)(pr + c0 + 16 * n) = o;
            }
            __builtin_amdgcn_sched_barrier(0);
          }
      }
    }
  }
};
struct EpiStoreF32 {
  static constexpr bool PERM = false, AFTER_DRAIN = false;
  float* C;
  __device__ __forceinline__ void operator()(const pg8::f32x4 (&acc)[2][2][4][2], const pg8::Unit& u, int wr, int wc, int fr, int fq) const {
#pragma unroll
    for (int ai = 0; ai < 2; ++ai)
#pragma unroll
      for (int m = 0; m < 4; ++m) {
        const int row = u.pm * 256 + ai * 128 + wr * 64 + m * 16 + fr;
        float* pr = C + (size_t)row * 2048 + u.pn * 256 + 32 * wc + 4 * fq;
#pragma unroll
        for (int bj = 0; bj < 2; ++bj)
#pragma unroll
          for (int n = 0; n < 2; ++n) *(pg8::f32x4*)(pr + bj * 128 + 16 * n) = acc[ai][bj][m][n];
      }
  }
};
struct EpiStoreBf16 {
  static constexpr bool PERM = false, AFTER_DRAIN = false;
  u16* C;
  __device__ __forceinline__ void operator()(const pg8::f32x4 (&acc)[2][2][4][2], const pg8::Unit& u, int wr, int wc, int fr, int fq) const {
#pragma unroll
    for (int ai = 0; ai < 2; ++ai)
#pragma unroll
      for (int m = 0; m < 4; ++m) {
        const int row = u.pm * 256 + ai * 128 + wr * 64 + m * 16 + fr;
        u16* pr = C + (size_t)row * 2048 + u.pn * 256 + 32 * wc + 4 * fq;
#pragma unroll
        for (int bj = 0; bj < 2; ++bj)
#pragma unroll
          for (int n = 0; n < 2; ++n) {
            const pg8::f32x4 v = acc[ai][bj][m][n];
            uint2 o;
            o.x = pack2(v[0], v[1]);
            o.y = pack2(v[2], v[3]);
            *(uint2*)(pr + bj * 128 + 16 * n) = o;
          }
      }
  }
};
struct EpiIn1 {
  static constexpr bool PERM = false, AFTER_DRAIN = false;
  float* PROJ;
  float* DTA;
  const float* dtb;
  const float* alog;
  __device__ __forceinline__ void operator()(const pg8::f32x4 (&acc)[2][2][4][2], const pg8::Unit& u, int wr, int wc, int fr, int fq) const {
    float dtbv[4] = {0.f, 0.f, 0.f, 0.f}, aev[4] = {0.f, 0.f, 0.f, 0.f};
    if (u.pn == 23) {
      const int cc = 23 * 256 + 32 * wc + 4 * fq;
      const int hb = (cc >= 5920 && cc < 5936) ? (cc - 5920) : ((cc + 16 >= 5920 && cc + 16 < 5936) ? (cc + 16 - 5920) : -1);
      if (hb >= 0) {
#pragma unroll
        for (int j = 0; j < 4; ++j) { dtbv[j] = dtb[hb + j]; aev[j] = expf(alog[hb + j]); }
      }
    }
#pragma unroll
    for (int ai = 0; ai < 2; ++ai)
#pragma unroll
      for (int m = 0; m < 4; ++m) {
        const int row = u.pm * 256 + ai * 128 + wr * 64 + m * 16 + fr;
        float* pr = PROJ + (size_t)row * N1;
#pragma unroll
        for (int bj = 0; bj < 2; ++bj)
#pragma unroll
          for (int n = 0; n < 2; ++n) {
            const int col0 = u.pn * 256 + bj * 128 + 32 * wc + 16 * n + 4 * fq;
            pg8::f32x4 v = acc[ai][bj][m][n];
            if (col0 < 1024) {
              pg8::f32x4 o;
#pragma unroll
              for (int j = 0; j < 4; ++j) o[j] = siluf_(v[j]);
              *(pg8::f32x4*)(pr + col0) = o;
            } else if (col0 < 5920) {
              *(pg8::f32x4*)(pr + col0) = v;
            } else if (col0 < 5936) {
#pragma unroll
              for (int j = 0; j < 4; ++j) {
                int h = col0 + j - 5920;
                float dt = softplusf_(v[j] + dtbv[j]);
                DTA[(size_t)row * 64 + h * 4] = dt;
                DTA[(size_t)row * 64 + h * 4 + 1] = expf(-dt * aev[j]);
              }
            }
          }
      }
  }
};

struct Seg {
  int off;
  int ld;
  int n4;
};

template <int NS, int NF4, int RG>
DEVI void stage_init(const float* wsf, const Seg (&sg)[NS], int row0, int tid, const float* (&ptr)[RG], int (&ldv)[RG]) {
  asm volatile("" : "+v"(tid));
#pragma unroll
  for (int q = 0; q < RG; ++q) {
    int flat = tid + q * 256;
    int t = flat / NF4, f = flat % NF4;
    if (flat >= 16 * NF4) { t = 0; f = 0; }
    int off = 0, ld = 0, ff = f;
    bool done = false;
#pragma unroll
    for (int s = 0; s < NS; ++s) {
      bool here = (!done) && (ff < sg[s].n4);
      off = here ? (sg[s].off + (row0 + t) * sg[s].ld + ff * 4) : off;
      ld = here ? sg[s].ld : ld;
      ff = (done || here) ? ff : (ff - sg[s].n4);
      done = done || here;
    }
    ptr[q] = wsf + off;
    ldv[q] = ld;
  }
}
template <int NF4, int RG>
DEVI void stage_issue(const float* const (&ptr)[RG], const int (&ldv)[RG], int st, int nsteps, int tid, f32x4 (&rg)[RG]) {
#pragma unroll
  for (int q = 0; q < RG; ++q) {
    int flat = tid + q * 256;
    if (flat < nsteps * NF4) rg[q] = *(const f32x4*)(ptr[q] + (st * 16) * ldv[q]);
  }
}
template <int NF4, int RG>
DEVI void stage_commit(float* buf, int nsteps, int tid, const f32x4 (&rg)[RG]) {
#pragma unroll
  for (int q = 0; q < RG; ++q) {
    int flat = tid + q * 256;
    if (flat < nsteps * NF4) ((f32x4*)buf)[flat] = rg[q];
  }
}

template <int MODE>
DEVI void colrec_long(const float* wsf, const Seg (&sg)[4], int row0, int T, float gamma, float* outp, int ldo, float* stout, int st_ld,
                      float* smem) {
  constexpr int NF4 = 69, W = 276, RG = 5;
  const int tid = threadIdx.x & 255, w = tid >> 6, lane = tid & 63, c = lane >> 4, s = lane & 15;
  smem += (threadIdx.x >> 8) * (VB_BYTES / 4);
  float S[8];
#pragma unroll
  for (int i = 0; i < 8; ++i) S[i] = 0.f;
  float* buf0 = smem;
  float* buf1 = smem + 16 * 336;
  float* obuf = smem + 2 * 16 * 336;
  const int nst = (T + 15) / 16;
  f32x4 rgA[RG], rgB[RG];
  const float* sptr[RG];
  int sld[RG];
  stage_init<4, NF4, RG>(wsf, sg, row0, tid, sptr, sld);
  auto step = [&](const float* sp, float* ob, int tt) -> float {
    float4 a0 = *(const float4*)(sp + s * 8), a1 = *(const float4*)(sp + s * 8 + 4);
    float4 q0 = *(const float4*)(sp + 128 + s * 8), q1 = *(const float4*)(sp + 128 + s * 8 + 4);
    float a[8] = {a0.x, a0.y, a0.z, a0.w, a1.x, a1.y, a1.z, a1.w};
    float q[8] = {q0.x, q0.y, q0.z, q0.w, q1.x, q1.y, q1.z, q1.w};
    float val = sp[256 + w * 4 + c];
    float dA = gamma;
    if (MODE == 2) {
      val *= sp[272];
      dA = sp[273];
    }
    float o = 0.f;
#pragma unroll
    for (int i = 0; i < 8; ++i) {
      if (MODE == 0) S[i] = val + a[i] * (S[i] - val);
      else S[i] = dA * S[i] + a[i] * val;
      o += q[i] * S[i];
    }
    return red16(o);
  };
  auto run_stage = [&](const float* b, float* ob, int nthis) {
#pragma unroll 1
    for (int tt = 0; tt < nthis; tt += 4) {
      float o0 = step(b + tt * W, ob, tt);
      float o1 = step(b + (tt + 1) * W, ob, tt + 1);
      float o2 = step(b + (tt + 2) * W, ob, tt + 2);
      float o3 = step(b + (tt + 3) * W, ob, tt + 3);
      const int base = (s == 0) ? (tt * 16 + w * 4 + c) : (1024 + (tid & 255));
      const int st16 = (s == 0) ? 16 : 0;
      ob[base] = o0;
      ob[base + st16] = o1;
      ob[base + 2 * st16] = o2;
      ob[base + 3 * st16] = o3;
    }
  };
  auto write_out = [&](const float* ob, int st, int nthis) {
    if (tid < nthis * 4) {
      int t = tid >> 2, c4 = tid & 3;
      *(float4*)(outp + (size_t)(st * 16 + t) * ldo + c4 * 4) = *(const float4*)(ob + t * 16 + c4 * 4);
    }
  };
  auto nsteps = [&](int st) { return min(16, T - st * 16); };
  stage_issue<NF4, RG>(sptr, sld, 0, nsteps(0), tid, rgA);
  stage_commit<NF4, RG>(buf0, nsteps(0), tid, rgA);
  if (nst > 1) stage_issue<NF4, RG>(sptr, sld, 1, nsteps(1), tid, rgB);
  __syncthreads();
#pragma unroll 1
  for (int st = 0; st < nst; st += 2) {
    if (st + 2 < nst) stage_issue<NF4, RG>(sptr, sld, st + 2, nsteps(st + 2), tid, rgA);
    run_stage(buf0, obuf, nsteps(st));
    if (st + 1 < nst) stage_commit<NF4, RG>(buf1, nsteps(st + 1), tid, rgB);
    __syncthreads();
    write_out(obuf, st, nsteps(st));
    if (st + 1 < nst) {
      if (st + 3 < nst) stage_issue<NF4, RG>(sptr, sld, st + 3, nsteps(st + 3), tid, rgB);
      run_stage(buf1, obuf + 512, nsteps(st + 1));
      if (st + 2 < nst) stage_commit<NF4, RG>(buf0, nsteps(st + 2), tid, rgA);
      __syncthreads();
      write_out(obuf + 512, st + 1, nsteps(st + 1));
    }
  }
#pragma unroll
  for (int i = 0; i < 8; ++i) stout[(size_t)(s * 8 + i) * st_ld + w * 4 + c] = S[i];
  __syncthreads();
}

template <int MODE>
DEVI void colrec_short(const float* pa, int lda_, const float* pq, int ldq, const float* pc, int ldc, const float* pdt,
                       long row0, float gamma, const float* stin, float* stout, int st_ld, float* outp, int ldo,
                       float* smem) {
  const int tid = threadIdx.x & 255, lane = tid & 63;
  const int wid = __builtin_amdgcn_readfirstlane(tid >> 6);
  const int k0 = wid * 32;
  smem += (threadIdx.x >> 8) * (VB_BYTES / 4);
  float S[32];
#pragma unroll
  for (int i = 0; i < 32; ++i) S[i] = stin[(size_t)(k0 + i) * st_ld + lane];
  float aq[4], vv[4], dAv[4];
#pragma unroll
  for (int t = 0; t < 4; ++t) {
    long row = row0 + t;
    aq[t] = (lane < 32) ? pa[(size_t)row * lda_ + k0 + lane] : pq[(size_t)row * ldq + k0 + (lane - 32)];
    vv[t] = pc[(size_t)row * ldc + lane];
    dAv[t] = gamma;
    if (MODE == 2) {
      vv[t] *= pdt[(size_t)row * 64];
      dAv[t] = pdt[(size_t)row * 64 + 1];
    }
  }
#pragma unroll
  for (int t = 0; t < 4; ++t) {
    const float val = vv[t], dA = dAv[t];
    float o = 0.f;
#pragma unroll
    for (int i = 0; i < 32; ++i) {
      const float a = rlf_(aq[t], i), q = rlf_(aq[t], 32 + i);
      if (MODE == 0) S[i] = val + a * (S[i] - val);
      else S[i] = dA * S[i] + a * val;
      o += q * S[i];
    }
    smem[(wid * 4 + t) * 64 + lane] = o;
  }
#pragma unroll
  for (int i = 0; i < 32; ++i) stout[(size_t)(k0 + i) * st_ld + lane] = S[i];
  __syncthreads();
  {
    int t = tid >> 6;
    float sum = smem[(0 * 4 + t) * 64 + lane] + smem[(1 * 4 + t) * 64 + lane] + smem[(2 * 4 + t) * 64 + lane] +
                smem[(3 * 4 + t) * 64 + lane];
    outp[(size_t)(row0 + t) * ldo + lane] = sum;
  }
  __syncthreads();
}

DEVI void rwkv_item(const float* wsf, const Seg (&sg)[6], int row0, int T, const float* stin, float* stout, float* outp, int ldo,
                    float* smem) {
  constexpr int NF4 = 84, W = 336, RG = 6;
  const int tid = threadIdx.x & 255, w = tid >> 6, lane = tid & 63, rl = lane >> 4, sl = lane & 15;
  smem += (threadIdx.x >> 8) * (VB_BYTES / 4);
  const int il = w * 4 + rl;
  float S[4];
  if (stin) {
    float4 v = *(const float4*)(stin + il * 64 + sl * 4);
    S[0] = v.x; S[1] = v.y; S[2] = v.z; S[3] = v.w;
  } else {
    S[0] = S[1] = S[2] = S[3] = 0.f;
  }
  float* buf0 = smem;
  float* buf1 = smem + 16 * 336;
  float* obuf = smem + 2 * 16 * 336;
  const int nst = (T + 15) / 16;
  f32x4 rgA[RG], rgB[RG];
  const float* sptr[RG];
  int sld[RG];
  stage_init<6, NF4, RG>(wsf, sg, row0, tid, sptr, sld);
  auto run_stage = [&](const float* b, float* ob, int nthis) {
#pragma unroll 4
    for (int tt = 0; tt < nthis; ++tt) {
      const float* sp = b + tt * W;
      float4 r4 = *(const float4*)(sp + sl * 4);
      float4 w4 = *(const float4*)(sp + 64 + sl * 4);
      float4 k4 = *(const float4*)(sp + 128 + sl * 4);
      float4 n4 = *(const float4*)(sp + 192 + sl * 4);
      float4 m4 = *(const float4*)(sp + 256 + sl * 4);
      float vi = sp[320 + il];
      float sa = S[0] * n4.x + S[1] * n4.y + S[2] * n4.z + S[3] * n4.w;
      sa = -red16(sa);
      S[0] = S[0] * w4.x + sa * m4.x + vi * k4.x;
      S[1] = S[1] * w4.y + sa * m4.y + vi * k4.y;
      S[2] = S[2] * w4.z + sa * m4.z + vi * k4.z;
      S[3] = S[3] * w4.w + sa * m4.w + vi * k4.w;
      float y = S[0] * r4.x + S[1] * r4.y + S[2] * r4.z + S[3] * r4.w;
      y = red16(y);
      ob[(sl == 0) ? (tt * 16 + il) : (1024 + (tid & 255))] = y;
    }
  };
  auto write_out = [&](const float* ob, int st, int nthis) {
    if (tid < nthis * 4) {
      int t = tid >> 2, c4 = tid & 3;
      *(float4*)(outp + (size_t)(st * 16 + t) * ldo + c4 * 4) = *(const float4*)(ob + t * 16 + c4 * 4);
    }
  };
  auto nsteps = [&](int st) { return min(16, T - st * 16); };
  stage_issue<NF4, RG>(sptr, sld, 0, nsteps(0), tid, rgA);
  stage_commit<NF4, RG>(buf0, nsteps(0), tid, rgA);
  if (nst > 1) stage_issue<NF4, RG>(sptr, sld, 1, nsteps(1), tid, rgB);
  __syncthreads();
  __builtin_amdgcn_s_setprio(3);
#pragma unroll 1
  for (int st = 0; st < nst; st += 2) {
    if (st + 2 < nst) stage_issue<NF4, RG>(sptr, sld, st + 2, nsteps(st + 2), tid, rgA);
    run_stage(buf0, obuf, nsteps(st));
    if (st + 1 < nst) stage_commit<NF4, RG>(buf1, nsteps(st + 1), tid, rgB);
    __syncthreads();
    write_out(obuf, st, nsteps(st));
    if (st + 1 < nst) {
      if (st + 3 < nst) stage_issue<NF4, RG>(sptr, sld, st + 3, nsteps(st + 3), tid, rgB);
      run_stage(buf1, obuf + 512, nsteps(st + 1));
      if (st + 2 < nst) stage_commit<NF4, RG>(buf0, nsteps(st + 2), tid, rgA);
      __syncthreads();
      write_out(obuf + 512, st + 1, nsteps(st + 1));
    }
  }
  __builtin_amdgcn_s_setprio(0);
  *(float4*)(stout + il * 64 + sl * 4) = make_float4(S[0], S[1], S[2], S[3]);
  __syncthreads();
}

DEVI void phase_rec0(const Params& p, float* smem) {
  char* ws = p.ws;
  const float* PROJ = (const float*)(ws + OFF_PROJ);
  float* OMIX = (float*)(ws + OFF_OMIX);
  const float* wsf = (const float*)ws;
  constexpr int PO = (int)(OFF_PROJ / 4);
  for (int item = blockIdx.x * 2 + (threadIdx.x >> 8); item < 4608; item += gridDim.x * 2) {
    if (item < 256) {
      int b = item >> 6, h = (item >> 3) & 7, cb = item & 7;
      Seg sg[4] = {{PO + 1024 + h * 128, N0, 32}, {PO + h * 128, N0, 32}, {PO + 2048 + h * 128 + cb * 16, N0, 4},
                   {PO, N0, 1}};
      int row0 = b * TP;
      colrec_long<0>(wsf, sg, row0, TP, 0.f, OMIX + (size_t)row0 * 2048 + h * 128 + cb * 16, 2048,
                     p.out + O_HGP + (size_t)(b * 8 + h) * 128 * 128 + cb * 16, 128, smem);
    } else if (item < 512) {
      int it = item - 256;
      int b = it >> 6, h = (it >> 4) & 3, cb = it & 15;
      Seg sg[4] = {{PO + 4608 + h * 128, N0, 32}, {PO + 4096 + h * 128, N0, 32},
                   {PO + 5120 + h * 256 + cb * 16, N0, 4}, {PO, N0, 1}};
      int row0 = b * TP;
      float gamma = 1.0f - exp2f(-5.0f - (float)h);
      colrec_long<1>(wsf, sg, row0, TP, gamma, OMIX + (size_t)row0 * 2048 + 1024 + h * 256 + cb * 16, 2048,
                     p.out + O_RTP + (size_t)(b * 4 + h) * 128 * 256 + cb * 16, 256, smem);
    } else if (item < 2560) {
      int it = item - 512;
      int b = it >> 4, h = (it >> 1) & 7, cb = it & 1;
      long row0 = MPR + (long)b * 4;
      size_t so = (size_t)(b * 8 + h) * 128 * 128 + cb * 64;
      colrec_short<0>(PROJ + 1024 + h * 128, N0, PROJ + h * 128, N0, PROJ + 2048 + h * 128 + cb * 64, N0, nullptr, row0,
                      0.f, p.in[I_SHG] + so, p.out + O_HGS + so, 128, OMIX + h * 128 + cb * 64, 2048, smem);
    } else {
      int it = item - 2560;
      int b = it >> 4, h = (it >> 2) & 3, cb = it & 3;
      long row0 = MPR + (long)b * 4;
      size_t so = (size_t)(b * 4 + h) * 128 * 256 + cb * 64;
      float gamma = 1.0f - exp2f(-5.0f - (float)h);
      colrec_short<1>(PROJ + 4608 + h * 128, N0, PROJ + 4096 + h * 128, N0, PROJ + 5120 + h * 256 + cb * 64, N0, nullptr,
                      row0, gamma, p.in[I_SRT] + so, p.out + O_RTS + so, 256, OMIX + 1024 + h * 256 + cb * 64, 2048,
                      smem);
    }
  }
}

DEVI float4 ld4(const float* p) { return *(const float4*)p; }
DEVI void st_bf4(u16* p, float a, float b, float c, float d) {
  uint2 o;
  o.x = pack2(a, b);
  o.y = pack2(c, d);
  *(uint2*)p = o;
}
DEVI float wsum_u_(float v) {
  v = red16(v);
  return (rlf_(v, 0) + rlf_(v, 16)) + (rlf_(v, 32) + rlf_(v, 48));
}
DEVI float red32(float v) {
  v = red16(v);
  return v + __shfl_xor(v, 16, 64);
}
DEVI void phase_post0(const Params& p) {
  char* ws = p.ws;
  const float* PROJ = (const float*)(ws + OFF_PROJ);
  const float* OMIX = (const float*)(ws + OFF_OMIX);
  u16* MIXB = (u16*)(ws + OFF_MIXB);
  const float* ng = p.in[I_HNG];
  const int lane = threadIdx.x & 63;
  const int gw = blockIdx.x * 8 + (threadIdx.x >> 6), nw = gridDim.x * 8;
  const float4 g4 = ld4(ng + (lane & 31) * 4);
  for (int row = gw; row < M; row += nw) {
    const float* o = OMIX + (size_t)row * 2048;
    const float* pr = PROJ + (size_t)row * N0;
    u16* mo = MIXB + (size_t)row * 2048;
    float4 a[4], ga[4], bq[4], gb[4];
#pragma unroll
    for (int it = 0; it < 4; ++it) {
      int c = it * 256 + lane * 4;
      a[it] = ld4(o + c);
      ga[it] = ld4(pr + 3072 + c);
      bq[it] = ld4(o + 1024 + c);
      gb[it] = ld4(pr + 6144 + c);
    }
#pragma unroll
    for (int it = 0; it < 4; ++it) {
      int c = it * 256 + lane * 4;
      float ss = red32(a[it].x * a[it].x + a[it].y * a[it].y + a[it].z * a[it].z + a[it].w * a[it].w);
      float inv = rsqrtf(ss * (1.0f / 128.0f) + 1e-6f);
      st_bf4(mo + c, a[it].x * inv * g4.x * ga[it].x, a[it].y * inv * g4.y * ga[it].y, a[it].z * inv * g4.z * ga[it].z,
             a[it].w * inv * g4.w * ga[it].w);
      float mu = wsum_u_(bq[it].x + bq[it].y + bq[it].z + bq[it].w) * (1.0f / 256.0f);
      float dx = bq[it].x - mu, dy = bq[it].y - mu, dz = bq[it].z - mu, dw = bq[it].w - mu;
      float var = wsum_u_(dx * dx + dy * dy + dz * dz + dw * dw) * (1.0f / 256.0f);
      float iv = rsqrtf(var + 1e-5f);
      st_bf4(mo + 1024 + c, dx * iv * gb[it].x, dy * iv * gb[it].y, dz * iv * gb[it].z, dw * iv * gb[it].w);
    }
  }
}

DEVI void phase_ln(const Params& p, const float* addsrc, const float* g, const float* bta) {
  char* ws = p.ws;
  float* XF = (float*)(ws + OFF_XF);
  u16* XB = (u16*)(ws + OFF_XB);
  const int lane = threadIdx.x & 63;
  const int gw = blockIdx.x * 8 + (threadIdx.x >> 6), nw = gridDim.x * 8;
  for (int row = gw; row < M; row += nw) {
    float4* xr = (float4*)(XF + (size_t)row * 2048);
    const float4* ar = (const float4*)(addsrc + (size_t)row * 2048);
    float v[32];
    float s = 0.f;
#pragma unroll
    for (int i = 0; i < 8; ++i) {
      float4 x = xr[i * 64 + lane], a = ar[i * 64 + lane];
      v[i * 4 + 0] = ALPHA * x.x + a.x;
      v[i * 4 + 1] = ALPHA * x.y + a.y;
      v[i * 4 + 2] = ALPHA * x.z + a.z;
      v[i * 4 + 3] = ALPHA * x.w + a.w;
      s += v[i * 4 + 0] + v[i * 4 + 1] + v[i * 4 + 2] + v[i * 4 + 3];
    }
    float mu = wsum(s) * (1.0f / 2048.0f);
    float q = 0.f;
#pragma unroll
    for (int i = 0; i < 32; ++i) {
      v[i] -= mu;
      q += v[i] * v[i];
    }
    float inv = rsqrtf(wsum(q) * (1.0f / 2048.0f) + 1e-5f);
#pragma unroll
    for (int i = 0; i < 8; ++i) {
      float4 gg = ((const float4*)g)[i * 64 + lane], bb = ((const float4*)bta)[i * 64 + lane];
      float4 y;
      y.x = v[i * 4 + 0] * inv * gg.x + bb.x;
      y.y = v[i * 4 + 1] * inv * gg.y + bb.y;
      y.z = v[i * 4 + 2] * inv * gg.z + bb.z;
      y.w = v[i * 4 + 3] * inv * gg.w + bb.w;
      xr[i * 64 + lane] = y;
      uint2 o;
      o.x = pack2(y.x, y.y);
      o.y = pack2(y.z, y.w);
      ((uint2*)(XB + (size_t)row * 2048))[i * 64 + lane] = o;
    }
  }
}

typedef __attribute__((ext_vector_type(2))) __bf16 bf2_t;
typedef __attribute__((ext_vector_type(2))) float f32x2;
DEVI float dot2bf(unsigned a, unsigned b, float acc) {
  return __builtin_amdgcn_fdot2_f32_bf16(__builtin_bit_cast(bf2_t, a), __builtin_bit_cast(bf2_t, b), acc, false);
}
template <int CTRL>
DEVI int dppi(int v) {
  return __builtin_amdgcn_update_dpp(v, v, CTRL, 0xF, 0xF, false);
}
DEVI int wmax_i(int v) {
  v = max(v, dppi<0xB1>(v));
  v = max(v, dppi<0x4E>(v));
  v = max(v, dppi<0x141>(v));
  v = max(v, dppi<0x140>(v));
  int a = __builtin_amdgcn_readlane(v, 0), b = __builtin_amdgcn_readlane(v, 16);
  int c = __builtin_amdgcn_readlane(v, 32), d = __builtin_amdgcn_readlane(v, 48);
  return max(max(a, b), max(c, d));
}
DEVI float rlf(float v, int l) { return __int_as_float(__builtin_amdgcn_readlane(__float_as_int(v), l)); }
DEVI float wsum_u(float v) {
  v = red16(v);
  return (rlf(v, 0) + rlf(v, 16)) + (rlf(v, 32) + rlf(v, 48));
}
DEVI int fkey(float f) {
  int u = __float_as_int(f);
  return u ^ ((u >> 31) & 0x7fffffff);
}
DEVI float keyf(int k) { return __int_as_float(k ^ ((k >> 31) & 0x7fffffff)); }

DEVI void conv_fp8_rows(const float* __restrict__ src, unsigned char* __restrict__ dst, float* __restrict__ scales) {
  const int lane = threadIdx.x & 63;
  const int gw = blockIdx.x * 8 + (threadIdx.x >> 6), nw = gridDim.x * 8;
  for (int e = gw; e < 16384; e += nw) {
    const float* r = src + (size_t)e * 2048;
    float4 v[8];
    float am = 0.f;
#pragma unroll
    for (int q = 0; q < 8; ++q) {
      v[q] = *(const float4*)(r + (q >> 2) * 1024 + lane * 16 + (q & 3) * 4);
      am = fmaxf(am, fmaxf(fmaxf(fabsf(v[q].x), fabsf(v[q].y)), fmaxf(fabsf(v[q].z), fabsf(v[q].w))));
    }
    float amax = __int_as_float(wmax_i(__float_as_int(am)));
    float inv = (amax > 0.f) ? (440.0f / amax) : 0.f;
    float scale = (amax > 0.f) ? (amax * (1.0f / 440.0f)) : 1.0f;
#pragma unroll
    for (int j = 0; j < 2; ++j) {
      u32x4 o;
#pragma unroll
      for (int k = 0; k < 4; ++k) {
        float4 t = v[j * 4 + k];
        int pk = 0;
        pk = __builtin_amdgcn_cvt_pk_fp8_f32(t.x * inv, t.y * inv, pk, false);
        pk = __builtin_amdgcn_cvt_pk_fp8_f32(t.z * inv, t.w * inv, pk, true);
        o[k] = (unsigned)pk;
      }
      *(u32x4*)(dst + (size_t)e * 2048 + j * 1024 + lane * 16) = o;
    }
    if (lane == 0) scales[e] = scale;
  }
}

DEVI void phase_peer(const Params& p, int layer, bool final_out) {
  char* ws = p.ws;
  const float* SC = (const float*)(ws + OFF_GOUT);
  float* XF = (float*)(ws + OFF_XF);
  u16* XB = (u16*)(ws + OFF_XB);
  const unsigned char* UB = (const unsigned char*)(ws + OFF_UB);
  const unsigned char* VB = (const unsigned char*)(ws + OFF_VB);
  const float* USC = (const float*)(ws + OFF_USC);
  const float* VSC = (const float*)(ws + OFF_VSC);
  const float* g = p.in[I_LNG] + (size_t)(layer * 2 + 1) * D;
  const float* bta = p.in[I_LNB] + (size_t)(layer * 2 + 1) * D;
  const int lane = threadIdx.x & 63;
  const int gw = blockIdx.x * 8 + (threadIdx.x >> 6), nw = gridDim.x * 8;
  constexpr int KMIN = (int)0x80000000;
  for (int row = gw; row < M; row += nw) {
    const float* sr = SC + (size_t)row * 2048;
    int eidx0 = 0, eidx1 = 0;
    float gate0 = 0.f, gate1 = 0.f;
#pragma unroll 1
    for (int hp = 0; hp < 2; ++hp) {
      int hd[4] = {hp * 2, hp * 2 + 1, hp * 2 + 4, hp * 2 + 5};
      int ka[4][2], kb[4][2], my[4][2];
#pragma unroll
      for (int n = 0; n < 4; ++n) {
        const float* sp = sr + hd[n] * 256;
#pragma unroll
        for (int c = 0; c < 2; ++c) {
          ka[n][c] = (fkey(sp[c * 128 + lane]) & ~127) | (127 - lane);
          kb[n][c] = (fkey(sp[c * 128 + 64 + lane]) & ~127) | (63 - lane);
          my[n][c] = KMIN;
        }
      }
#pragma unroll 1
      for (int r = 0; r < 16; ++r) {
#pragma unroll
        for (int n = 0; n < 4; ++n)
#pragma unroll
          for (int c = 0; c < 2; ++c) {
            int K = wmax_i(max(ka[n][c], kb[n][c]));
            my[n][c] = (lane == r) ? K : my[n][c];
            ka[n][c] = (ka[n][c] == K) ? KMIN : ka[n][c];
            kb[n][c] = (kb[n][c] == K) ? KMIN : kb[n][c];
          }
      }
      const int jb = (lane & 3) * 4;
      int cc[4][4], myk[4];
      int ti0[4], ti1[4];
#pragma unroll
      for (int n = 0; n < 4; ++n) {
        const float ts0 = keyf(my[n][0] & ~127), ts1 = keyf(my[n][1] & ~127);
        ti0[n] = 127 - (my[n][0] & 127);
        ti1[n] = 127 - (my[n][1] & 127);
        const float s0 = __shfl(ts0, lane >> 2, 64);
#pragma unroll
        for (int q = 0; q < 4; ++q) cc[n][q] = (fkey(s0 + __shfl(ts1, jb + q, 64)) & ~255) | (255 - (lane * 4 + q));
        myk[n] = KMIN;
      }
#pragma unroll 1
      for (int r = 0; r < 16; ++r) {
#pragma unroll
        for (int n = 0; n < 4; ++n) {
          int K = wmax_i(max(max(cc[n][0], cc[n][1]), max(cc[n][2], cc[n][3])));
          myk[n] = (lane == r) ? K : myk[n];
#pragma unroll
          for (int q = 0; q < 4; ++q) cc[n][q] = (cc[n][q] == K) ? KMIN : cc[n][q];
        }
      }
#pragma unroll
      for (int n = 0; n < 4; ++n) {
        const float bs = keyf(myk[n] & ~255);
        const int bf = 255 - (myk[n] & 255);
        const int e = __shfl(ti0[n], (bf >> 4) & 15, 64) * 128 + __shfl(ti1[n], bf & 15, 64);
        const float ev = (lane < 16) ? expf(bs - rlf(bs, 0)) : 0.f;
        const float gt = ev / wsum_u(ev);
        const int e_b = __shfl(e, lane & 15, 64);
        const float g_b = __shfl(gt, lane & 15, 64);
        const int hh = hp * 2 + (n & 1);
        if ((lane >> 4) == hh) {
          if (n < 2) { eidx0 = e_b; gate0 = g_b; }
          else { eidx1 = e_b; gate1 = g_b; }
        }
      }
    }
    float dv0 = 0.f, dv1 = 0.f;
    {
      float xf[32];
      {
        const float4* xr = (const float4*)(XF + (size_t)row * 2048);
#pragma unroll
        for (int q = 0; q < 8; ++q) {
          float4 t = xr[(q >> 2) * 256 + lane * 4 + (q & 3)];
          xf[q * 4 + 0] = t.x; xf[q * 4 + 1] = t.y; xf[q * 4 + 2] = t.z; xf[q * 4 + 3] = t.w;
        }
      }
      constexpr int R = 8;
      u32x4 w[R][2];
      float sc[R];
      auto load_row = [&](int pidx, u32x4(&wr)[2], float& scv) {
        int src = (pidx < 64) ? eidx0 : eidx1;
        int e = __builtin_amdgcn_readlane(src, pidx & 63);
        const u32x4* ur = (const u32x4*)(UB + (size_t)e * 2048);
        wr[0] = ur[lane];
        wr[1] = ur[64 + lane];
        scv = USC[e];
      };
#pragma unroll
      for (int u = 0; u < R; ++u) load_row(u, w[u], sc[u]);
#pragma unroll 1
      for (int p0 = 0; p0 < 128; p0 += R) {
#pragma unroll
        for (int u = 0; u < R; ++u) {
          float d = 0.f;
#pragma unroll
          for (int j = 0; j < 2; ++j) {
#pragma unroll
            for (int k = 0; k < 4; ++k) {
              int dw = (int)w[u][j][k];
              f32x2 lo = __builtin_amdgcn_cvt_pk_f32_fp8(dw, false);
              f32x2 hi = __builtin_amdgcn_cvt_pk_f32_fp8(dw, true);
              d += lo.x * xf[j * 16 + k * 4 + 0];
              d += lo.y * xf[j * 16 + k * 4 + 1];
              d += hi.x * xf[j * 16 + k * 4 + 2];
              d += hi.y * xf[j * 16 + k * 4 + 3];
            }
          }
          float scu = sc[u];
          if (p0 + R < 128) load_row(p0 + R + u, w[u], sc[u]);
          d = wsum_u(d) * scu;
          int pl = (p0 + u) & 63;
          if (p0 < 64) dv0 = (lane == pl) ? d : dv0;
          else dv1 = (lane == pl) ? d : dv1;
          __builtin_amdgcn_sched_barrier(0);
        }
      }
    }
    float coef0 = 0.5f * dv0 * (1.0f + erff(dv0 * 0.70710678118f)) * gate0;
    float coef1 = 0.5f * dv1 * (1.0f + erff(dv1 * 0.70710678118f)) * gate1;
    f32x2 o2[16];
#pragma unroll
    for (int i = 0; i < 16; ++i) o2[i] = f32x2{0.f, 0.f};
    {
      constexpr int R = 8;
      u32x4 w[R][2];
      float sc[R];
      auto load_row = [&](int pidx, u32x4(&wr)[2], float& scv) {
        int src = (pidx < 64) ? eidx0 : eidx1;
        int e = __builtin_amdgcn_readlane(src, pidx & 63);
        const u32x4* vr = (const u32x4*)(VB + (size_t)e * 2048);
        wr[0] = vr[lane];
        wr[1] = vr[64 + lane];
        scv = VSC[e];
      };
#pragma unroll
      for (int u = 0; u < R; ++u) load_row(u, w[u], sc[u]);
#pragma unroll 1
      for (int p0 = 0; p0 < 128; p0 += R) {
        float cfs = (p0 < 64) ? coef0 : coef1;
#pragma unroll
        for (int u = 0; u < R; ++u) {
          float c = rlf(cfs, (p0 + u) & 63) * sc[u];
          f32x2 cc = f32x2{c, c};
#pragma unroll
          for (int j = 0; j < 2; ++j) {
#pragma unroll
            for (int k = 0; k < 4; ++k) {
              int dw = (int)w[u][j][k];
              o2[j * 8 + k * 2 + 0] += cc * __builtin_amdgcn_cvt_pk_f32_fp8(dw, false);
              o2[j * 8 + k * 2 + 1] += cc * __builtin_amdgcn_cvt_pk_f32_fp8(dw, true);
            }
          }
          if (p0 + R < 128) load_row(p0 + R + u, w[u], sc[u]);
          __builtin_amdgcn_sched_barrier(0);
        }
      }
    }
    float o[32];
#pragma unroll
    for (int i = 0; i < 16; ++i) {
      o[2 * i] = o2[i].x;
      o[2 * i + 1] = o2[i].y;
    }
    float s = 0.f;
    {
      const float4* xr = (const float4*)(XF + (size_t)row * 2048);
#pragma unroll
      for (int q = 0; q < 8; ++q) {
        float4 t = xr[(q >> 2) * 256 + lane * 4 + (q & 3)];
        o[q * 4 + 0] += ALPHA * t.x; o[q * 4 + 1] += ALPHA * t.y; o[q * 4 + 2] += ALPHA * t.z; o[q * 4 + 3] += ALPHA * t.w;
      }
#pragma unroll
      for (int i = 0; i < 32; ++i) s += o[i];
    }
    float mu = wsum_u(s) * (1.0f / 2048.0f);
    float q = 0.f;
#pragma unroll
    for (int i = 0; i < 32; ++i) {
      o[i] -= mu;
      q += o[i] * o[i];
    }
    float inv = rsqrtf(wsum_u(q) * (1.0f / 2048.0f) + 1e-5f);
    float* dstf;
    if (final_out) {
      if (row < MPR) {
        int b = row / TP, t = row % TP;
        dstf = (t >= 16) ? (p.out + O_YP + ((size_t)b * 2048 + (t - 16)) * D) : nullptr;
      } else {
        dstf = p.out + O_YS + (size_t)(row - MPR) * D;
      }
    } else {
      dstf = XF + (size_t)row * 2048;
    }
#pragma unroll
    for (int j = 0; j < 2; ++j) {
      float yv[16];
#pragma unroll
      for (int k = 0; k < 4; ++k) {
        float4 gv = *(const float4*)(g + j * 1024 + lane * 16 + k * 4);
        float4 bv = *(const float4*)(bta + j * 1024 + lane * 16 + k * 4);
        float4 y;
        y.x = o[j * 16 + k * 4 + 0] * inv * gv.x + bv.x;
        y.y = o[j * 16 + k * 4 + 1] * inv * gv.y + bv.y;
        y.z = o[j * 16 + k * 4 + 2] * inv * gv.z + bv.z;
        y.w = o[j * 16 + k * 4 + 3] * inv * gv.w + bv.w;
        if (dstf) *(float4*)(dstf + j * 1024 + lane * 16 + k * 4) = y;
        yv[k * 4 + 0] = y.x; yv[k * 4 + 1] = y.y; yv[k * 4 + 2] = y.z; yv[k * 4 + 3] = y.w;
      }
      if (!final_out) {
        uint4* xb = (uint4*)(XB + (size_t)row * 2048 + j * 1024 + lane * 16);
        xb[0] = make_uint4(pack2(yv[0], yv[1]), pack2(yv[2], yv[3]), pack2(yv[4], yv[5]), pack2(yv[6], yv[7]));
        xb[1] = make_uint4(pack2(yv[8], yv[9]), pack2(yv[10], yv[11]), pack2(yv[12], yv[13]), pack2(yv[14], yv[15]));
      }
    }
  }
}

DEVI float4 f4mul(float4 a, float4 b) { return make_float4(a.x * b.x, a.y * b.y, a.z * b.z, a.w * b.w); }
DEVI void row_info(int row, bool& prompt, int& b, int& t, int& T) {
  prompt = row < MPR;
  if (prompt) { b = row / TP; t = row - b * TP; T = TP; }
  else { b = (row - MPR) >> 2; t = (row - MPR) & 3; T = 4; }
}
DEVI void phase_pre1(const Params& p) {
  char* ws = p.ws;
  const float* PROJ = (const float*)(ws + OFF_PROJ);
  float* XC = (float*)(ws + OFF_GOUT);
  float* RKV = (float*)(ws + OFF_RKV);
  u16* LRA = (u16*)(ws + OFF_LRA);
  u16* LRB = (u16*)(ws + OFF_LRB);
  u16* LRG = (u16*)(ws + OFF_LRG);
  const float* cw = p.in[I_CVW];
  const float* cbias = p.in[I_CVB];
  const float* mu = p.in[I_MU];
  const int gtid = blockIdx.x * 512 + threadIdx.x, nthr = gridDim.x * 512;
#pragma unroll 2
  for (int idx = gtid; idx < M * 384; idx += nthr) {
    int row = idx / 384, c = (idx - row * 384) * 4;
    bool prompt; int b, t, T;
    row_info(row, prompt, b, t, T);
    float4 xv[4];
#pragma unroll
    for (int jj = 0; jj < 4; ++jj) {
      int tt = t - 3 + jj;
      if (tt >= 0) xv[jj] = ld4(PROJ + (size_t)(row - 3 + jj) * N1 + 1024 + c);
      else if (prompt) xv[jj] = make_float4(0.f, 0.f, 0.f, 0.f);
      else xv[jj] = ld4(p.in[I_SCV] + (size_t)(b * 3 + (tt + 3)) * 1536 + c);
    }
    float4 acc = ld4(cbias + c);
#pragma unroll
    for (int jj = 0; jj < 4; ++jj) {
      float4 w = ld4(cw + jj * 1536 + c);
      acc.x += xv[jj].x * w.x; acc.y += xv[jj].y * w.y; acc.z += xv[jj].z * w.z; acc.w += xv[jj].w * w.w;
    }
    *(float4*)(XC + (size_t)row * 1536 + c) = make_float4(siluf_(acc.x), siluf_(acc.y), siluf_(acc.z), siluf_(acc.w));
    if (t >= T - 3) {
      float* co = prompt ? (p.out + O_CVP) : (p.out + O_CVS);
      *(float4*)(co + (size_t)(b * 3 + (t - (T - 3))) * 1536 + c) = xv[3];
    }
  }
#pragma unroll 2
  for (int idx = gtid; idx < M * 840; idx += nthr) {
    int row = idx / 840, c = (idx - row * 840) * 4;
    bool prompt; int b, t, T;
    row_info(row, prompt, b, t, T);
    float4 cur = ld4(PROJ + (size_t)row * N1 + 2560 + c);
    float4 prev;
    if (t > 0) prev = ld4(PROJ + (size_t)(row - 1) * N1 + 2560 + c);
    else if (prompt) prev = make_float4(0.f, 0.f, 0.f, 0.f);
    else prev = ld4(p.in[I_SSH] + (size_t)b * 3360 + c);
    float4 m4 = ld4(mu + c);
    float4 mx;
    mx.x = cur.x + (prev.x - cur.x) * m4.x; mx.y = cur.y + (prev.y - cur.y) * m4.y;
    mx.z = cur.z + (prev.z - cur.z) * m4.z; mx.w = cur.w + (prev.w - cur.w) * m4.w;
    if (c < 3072) *(float4*)(RKV + (size_t)row * 3072 + c) = mx;
    else if (c < 3136) st_bf4(LRA + (size_t)row * 64 + (c - 3072), tanhf(mx.x), tanhf(mx.y), tanhf(mx.z), tanhf(mx.w));
    else if (c < 3200) st_bf4(LRB + (size_t)row * 64 + (c - 3136), mx.x, mx.y, mx.z, mx.w);
    else st_bf4(LRG + (size_t)row * 192 + (c - 3200), sigmoidf_(mx.x), sigmoidf_(mx.y), sigmoidf_(mx.z), sigmoidf_(mx.w));
    if (t == T - 1) {
      float* so = prompt ? (p.out + O_SHP) : (p.out + O_SHS);
      *(float4*)(so + (size_t)b * 3360 + c) = cur;
    }
  }
  for (int idx = gtid; idx < M * 4; idx += nthr) {
    int row = idx >> 2, k = idx & 3;
    ((uint4*)(LRG + (size_t)row * 192 + 160))[k] = make_uint4(0, 0, 0, 0);
  }
}

DEVI void phase_pre1c(const Params& p) {
  char* ws = p.ws;
  float* RKV = (float*)(ws + OFF_RKV);
  const float* AA = (const float*)(ws + OFF_AA);
  float* KK = (float*)(ws + OFF_QB);
  float* KKA = (float*)(ws + OFF_MIXB);
  float* BON = (float*)(ws + OFF_BON);
  const float* k_k = p.in[I_KK];
  const float* k_a = p.in[I_KA];
  const float* r_k = p.in[I_RK];
  const int lane = threadIdx.x & 63;
  const int gw = blockIdx.x * 8 + (threadIdx.x >> 6), nw = gridDim.x * 8;
  for (int row = gw; row < M; row += nw) {
    float4 k4[4], r4[4], a4[4];
#pragma unroll
    for (int it = 0; it < 4; ++it) {
      int c = it * 256 + lane * 4;
      k4[it] = ld4(RKV + (size_t)row * 3072 + 1024 + c);
      r4[it] = ld4(RKV + (size_t)row * 3072 + c);
      a4[it] = ld4(AA + (size_t)row * 1024 + c);
    }
#pragma unroll
    for (int it = 0; it < 4; ++it) {
      int c = it * 256 + lane * 4;
      float4 kk4 = ld4(k_k + c), ka4 = ld4(k_a + c), rk4 = ld4(r_k + c);
      float4 k = k4[it], r = r4[it], a = a4[it];
      float4 kr = f4mul(k, kk4);
      float ss = red16(kr.x * kr.x + kr.y * kr.y + kr.z * kr.z + kr.w * kr.w);
      float inv = 1.0f / fmaxf(sqrtf(ss), 1e-12f);
      float4 kk = make_float4(kr.x * inv, kr.y * inv, kr.z * inv, kr.w * inv);
      float4 kp;
      kp.x = k.x * (1.0f + (a.x - 1.0f) * ka4.x); kp.y = k.y * (1.0f + (a.y - 1.0f) * ka4.y);
      kp.z = k.z * (1.0f + (a.z - 1.0f) * ka4.z); kp.w = k.w * (1.0f + (a.w - 1.0f) * ka4.w);
      float bon = red16(r.x * kp.x * rk4.x + r.y * kp.y * rk4.y + r.z * kp.z * rk4.z + r.w * kp.w * rk4.w);
      *(float4*)(KK + (size_t)row * 1024 + c) = kk;
      *(float4*)(KKA + (size_t)row * 1024 + c) = f4mul(kk, a);
      *(float4*)(RKV + (size_t)row * 3072 + 1024 + c) = kp;
      if ((lane & 15) == 0) BON[(size_t)row * 16 + it * 4 + (lane >> 4)] = bon;
    }
  }
}

DEVI void rwkv_short(const float* __restrict__ RKV, const float* __restrict__ DEC, const float* __restrict__ KK,
                     const float* __restrict__ KKA, int h, int rb, int row0, const float* __restrict__ stin,
                     float* __restrict__ stout, float* __restrict__ outp) {
  const int tid = threadIdx.x & 255, w = tid >> 6, lane = tid & 63, rl = lane >> 4, sl = lane & 15;
  const int il = w * 4 + rl;
  float4 sv = *(const float4*)(stin + il * 64 + sl * 4);
  float S[4] = {sv.x, sv.y, sv.z, sv.w};
  float4 r4[4], w4[4], k4[4], n4[4], m4[4];
  float vi[4];
#pragma unroll
  for (int t = 0; t < 4; ++t) {
    const size_t row = (size_t)(row0 + t);
    r4[t] = *(const float4*)(RKV + row * 3072 + h * 64 + sl * 4);
    w4[t] = *(const float4*)(DEC + row * 1024 + h * 64 + sl * 4);
    k4[t] = *(const float4*)(RKV + row * 3072 + 1024 + h * 64 + sl * 4);
    n4[t] = *(const float4*)(KK + row * 1024 + h * 64 + sl * 4);
    m4[t] = *(const float4*)(KKA + row * 1024 + h * 64 + sl * 4);
    vi[t] = RKV[row * 3072 + 2048 + h * 64 + rb * 16 + il];
  }
#pragma unroll
  for (int t = 0; t < 4; ++t) {
    float sa = S[0] * n4[t].x + S[1] * n4[t].y + S[2] * n4[t].z + S[3] * n4[t].w;
    sa = -red16(sa);
    S[0] = S[0] * w4[t].x + sa * m4[t].x + vi[t] * k4[t].x;
    S[1] = S[1] * w4[t].y + sa * m4[t].y + vi[t] * k4[t].y;
    S[2] = S[2] * w4[t].z + sa * m4[t].z + vi[t] * k4[t].z;
    S[3] = S[3] * w4[t].w + sa * m4[t].w + vi[t] * k4[t].w;
    float y = S[0] * r4[t].x + S[1] * r4[t].y + S[2] * r4[t].z + S[3] * r4[t].w;
    y = red16(y);
    if (sl == 0) outp[(size_t)t * 2048 + il] = y;
  }
  *(float4*)(stout + il * 64 + sl * 4) = make_float4(S[0], S[1], S[2], S[3]);
}

DEVI void phase_rec1(const Params& p, float* smem) {
  char* ws = p.ws;
  const float* XC = (const float*)(ws + OFF_GOUT);
  const float* RKV = (const float*)(ws + OFF_RKV);
  const float* DEC = (const float*)(ws + OFF_DEC);
  const float* KK = (const float*)(ws + OFF_QB);
  const float* KKA = (const float*)(ws + OFF_MIXB);
  const float* DTA = (const float*)(ws + OFF_DTA);
  float* OMIX = (float*)(ws + OFF_OMIX);
  const float* wsf = (const float*)ws;
  constexpr int XO = (int)(OFF_GOUT / 4), DO = (int)(OFF_DTA / 4), RO = (int)(OFF_RKV / 4), CO = (int)(OFF_DEC / 4),
                KO = (int)(OFF_QB / 4), AO = (int)(OFF_MIXB / 4);
  const int half = threadIdx.x >> 8;
  for (int li = blockIdx.x; li < 256; li += gridDim.x) {
    if (half == 0) {
      int b = li >> 6, h = (li >> 2) & 15, cb = li & 3;
      int g = h >> 3;
      Seg sg[4] = {{XO + 1024 + g * 128, 1536, 32}, {XO + 1280 + g * 128, 1536, 32}, {XO + h * 64 + cb * 16, 1536, 4},
                   {DO + h * 4, 64, 1}};
      int row0 = b * TP;
      colrec_long<2>(wsf, sg, row0, TP, 0.f, OMIX + (size_t)row0 * 2048 + h * 64 + cb * 16, 2048,
                     p.out + O_SSP + (size_t)(b * 16 + h) * 128 * 64 + cb * 16, 64, smem);
    } else {
      int b = li >> 6, h = (li >> 2) & 15, rb = li & 3;
      int row0 = b * TP;
      Seg sg[6] = {{RO + h * 64, 3072, 16}, {CO + h * 64, 1024, 16}, {RO + 1024 + h * 64, 3072, 16},
                   {KO + h * 64, 1024, 16}, {AO + h * 64, 1024, 16}, {RO + 2048 + h * 64 + rb * 16, 3072, 4}};
      size_t so = ((size_t)(b * 16 + h) * 64 + rb * 16) * 64;
      rwkv_item(wsf, sg, row0, TP, nullptr, p.out + O_WKP + so, OMIX + (size_t)row0 * 2048 + 1024 + h * 64 + rb * 16, 2048, smem);
    }
  }
  for (int it = blockIdx.x * 2 + half; it < 2048; it += gridDim.x * 2) {
    int b = it >> 4, h = it & 15;
    int g = h >> 3;
    long row0 = MPR + (long)b * 4;
    size_t so = (size_t)(b * 16 + h) * 128 * 64;
    colrec_short<2>(XC + 1024 + g * 128, 1536, XC + 1280 + g * 128, 1536, XC + h * 64, 1536, DTA + h * 4, row0, 0.f,
                    p.in[I_SSM] + so, p.out + O_SSS + so, 64, OMIX + h * 64, 2048, smem);
  }
  for (int it = blockIdx.x * 2 + half; it < 8192; it += gridDim.x * 2) {
    int b = it >> 6, h = (it >> 2) & 15, rb = it & 3;
    int row0 = MPR + b * 4;
    size_t so = ((size_t)(b * 16 + h) * 64 + rb * 16) * 64;
    rwkv_short(RKV, DEC, KK, KKA, h, rb, row0, p.in[I_SWK] + so, p.out + O_WKS + so,
               OMIX + (size_t)row0 * 2048 + 1024 + h * 64 + rb * 16);
  }
}

DEVI void phase_post1(const Params& p) {
  char* ws = p.ws;
  const float* PROJ = (const float*)(ws + OFF_PROJ);
  const float* OMIX = (const float*)(ws + OFF_OMIX);
  const float* XC = (const float*)(ws + OFF_GOUT);
  const float* RKV = (const float*)(ws + OFF_RKV);
  const float* GG = (const float*)(ws + OFF_GG);
  const float* BON = (const float*)(ws + OFF_BON);
  u16* MIXB = (u16*)(ws + OFF_MIXB);
  const float* dsk = p.in[I_DSK];
  const float* sng = p.in[I_SNG];
  const float* lxg = p.in[I_LXG];
  const float* lxb = p.in[I_LXB];
  const int lane = threadIdx.x & 63;
  const int gw = blockIdx.x * 8 + (threadIdx.x >> 6), nw = gridDim.x * 8;
  for (int row = gw; row < M; row += nw) {
    const float* o = OMIX + (size_t)row * 2048;
    u16* mo = MIXB + (size_t)row * 2048;
    float4 oc[4], xc[4], z[4], y[4], v[4], gg[4];
    float bn[4];
#pragma unroll
    for (int it = 0; it < 4; ++it) {
      int c = it * 256 + lane * 4;
      oc[it] = ld4(o + c);
      xc[it] = ld4(XC + (size_t)row * 1536 + c);
      z[it] = ld4(PROJ + (size_t)row * N1 + c);
      y[it] = ld4(o + 1024 + c);
      v[it] = ld4(RKV + (size_t)row * 3072 + 2048 + c);
      gg[it] = ld4(GG + (size_t)row * 1024 + c);
      bn[it] = BON[(size_t)row * 16 + it * 4 + (lane >> 4)];
    }
    float4 val[4];
    float ssq[4];
#pragma unroll
    for (int it = 0; it < 4; ++it) {
      float ds = dsk[it * 4 + (lane >> 4)];
      val[it].x = (oc[it].x + xc[it].x * ds) * z[it].x;
      val[it].y = (oc[it].y + xc[it].y * ds) * z[it].y;
      val[it].z = (oc[it].z + xc[it].z * ds) * z[it].z;
      val[it].w = (oc[it].w + xc[it].w * ds) * z[it].w;
      ssq[it] = val[it].x * val[it].x + val[it].y * val[it].y + val[it].z * val[it].z + val[it].w * val[it].w;
    }
    float inv0 = rsqrtf(wsum_u_(ssq[0] + ssq[1]) * (1.0f / 512.0f) + 1e-6f);
    float inv1 = rsqrtf(wsum_u_(ssq[2] + ssq[3]) * (1.0f / 512.0f) + 1e-6f);
#pragma unroll
    for (int it = 0; it < 4; ++it) {
      int c = it * 256 + lane * 4;
      float inv = (it < 2) ? inv0 : inv1;
      float4 sg = ld4(sng + c);
      st_bf4(mo + c, val[it].x * inv * sg.x, val[it].y * inv * sg.y, val[it].z * inv * sg.z, val[it].w * inv * sg.w);
      float mu = red16(y[it].x + y[it].y + y[it].z + y[it].w) * (1.0f / 64.0f);
      float dx = y[it].x - mu, dy = y[it].y - mu, dz = y[it].z - mu, dw = y[it].w - mu;
      float var = red16(dx * dx + dy * dy + dz * dz + dw * dw) * (1.0f / 64.0f);
      float iv = rsqrtf(var + 64e-5f);
      float4 lg = ld4(lxg + c), lb = ld4(lxb + c);
      float y0 = (dx * iv * lg.x + lb.x + bn[it] * v[it].x) * gg[it].x;
      float y1 = (dy * iv * lg.y + lb.y + bn[it] * v[it].y) * gg[it].y;
      float y2 = (dz * iv * lg.z + lb.z + bn[it] * v[it].z) * gg[it].z;
      float y3 = (dw * iv * lg.w + lb.w + bn[it] * v[it].w) * gg[it].w;
      st_bf4(mo + 1024 + c, y0, y1, y2, y3);
    }
  }
}

#define XB_TMO      128
#define XB_XCNT(j)  (256  + 64 * (j))
#define XB_XSUB(j)  (1280 + 64 * (j))
#define XB_XGEN(j)  (2304 + 64 * (j))
#define XB_TOP      3328
#define XB_TOPGEN   3392
#define XCD_BAR_WORDS 3456
#define XB_SPIN_CAP (1u << 18)
#define LAS __attribute__((address_space(3)))

__device__ __forceinline__ unsigned xb_ld(unsigned* p)              { return __hip_atomic_load(p, __ATOMIC_RELAXED, __HIP_MEMORY_SCOPE_AGENT); }
__device__ __forceinline__ unsigned xb_add(unsigned* p, unsigned v) { return __hip_atomic_fetch_add(p, v, __ATOMIC_RELAXED, __HIP_MEMORY_SCOPE_AGENT); }
__device__ __forceinline__ unsigned xb_xcc_id() { return (unsigned)__builtin_amdgcn_s_getreg((3 << 11) | 20) & 0xFu; }
#define XB_SPIN(cond, bar) do { unsigned _sp = 0; while (cond) { __builtin_amdgcn_s_sleep(1); \
    if ((++_sp & 255u) == 0u) { if (xb_ld(&(bar)[XB_TMO])) break; if (_sp > XB_SPIN_CAP) { atomicAdd(&(bar)[XB_TMO], 1u); break; } } } } while (0)

struct XcdBarrier {
    unsigned* bar; unsigned x;
    volatile LAS unsigned* st;
};

__device__ __forceinline__ XcdBarrier xcd_barrier_post(unsigned* bar, volatile LAS unsigned* st) {
    XcdBarrier b; b.bar = bar; b.x = xb_xcc_id(); b.st = st;
    if (threadIdx.x == 0) (void)xb_add(&bar[XB_XCNT(b.x)], 1u);
    return b;
}
__device__ __forceinline__ void xcd_barrier_complete(unsigned* bar, unsigned x, unsigned& nloc, unsigned& nx) {
    const unsigned G = gridDim.x * gridDim.y * gridDim.z;
    unsigned sum, cnt, mine, sp = 0u;
    for (;;) {
        sum = 0u; cnt = 0u; mine = 0u;
#pragma unroll
        for (unsigned j = 0; j < 16; ++j) { const unsigned c = xb_ld(&bar[XB_XCNT(j)]); sum += c; cnt += (c > 0u) ? 1u : 0u; mine = (j == x) ? c : mine; }
        if (sum == G) break;
        __builtin_amdgcn_s_sleep(1);
        if ((++sp & 255u) == 0u) { if (xb_ld(&bar[XB_TMO])) break; if (sp > XB_SPIN_CAP) { atomicAdd(&bar[XB_TMO], 1u); break; } }
    }
    nloc = mine > 0u ? mine : 1u; nx = cnt > 0u ? cnt : 1u;
}

__device__ __forceinline__ void xcd_barrier(const XcdBarrier& b) {
    asm volatile("s_waitcnt vmcnt(0)" ::: "memory");
    __syncthreads();
    if (threadIdx.x == 0) {
        unsigned* bar = b.bar;
        __builtin_amdgcn_s_waitcnt(0);
        unsigned nloc = b.st[0], nx = b.st[1];
        if (nloc == 0u) { xcd_barrier_complete(bar, b.x, nloc, nx); b.st[0] = nloc; b.st[1] = nx; }
        const unsigned old = xb_add(&bar[XB_XSUB(b.x)], 1u);
        const unsigned gen = old / nloc;
        if (old + 1u == (gen + 1u) * nloc) {
            __builtin_amdgcn_fence(__ATOMIC_RELEASE, "agent");
            asm volatile("s_waitcnt vmcnt(0)" ::: "memory");
            const unsigned og = xb_add(&bar[XB_TOP], 1u);
            const unsigned tg = og / nx;
            if (og + 1u == (tg + 1u) * nx) xb_add(&bar[XB_TOPGEN], 1u);
            else XB_SPIN(xb_ld(&bar[XB_TOPGEN]) == tg, bar);
            __builtin_amdgcn_fence(__ATOMIC_ACQUIRE, "agent");
            xb_add(&bar[XB_XGEN(b.x)], 1u);
            asm volatile("s_waitcnt vmcnt(0)" ::: "memory");
        } else {
            XB_SPIN(xb_ld(&bar[XB_XGEN(b.x)]) == gen, bar);
            __builtin_amdgcn_fence(__ATOMIC_ACQUIRE, "agent");
            asm volatile("s_waitcnt vmcnt(0)" ::: "memory");
        }
    }
    __syncthreads();
}


template <int ph>
DEVI void run_phase(const Params& p, char* smem_raw) {
  float* smem = (float*)smem_raw;
  char* ws = p.ws;
  {
    switch (ph) {
      case 0:
        phase0(p, smem);
        conv_fp8_rows(p.in[I_PU], (unsigned char*)(ws + OFF_UB), (float*)(ws + OFF_USC));
        conv_fp8_rows(p.in[I_PV], (unsigned char*)(ws + OFF_VB), (float*)(ws + OFF_VSC));
        break;
      case 1: {
        EpiIn0 E{(float*)(ws + OFF_PROJ), (const float*)(ws + OFF_LB), (const float*)(ws + OFF_INVREV)};
        pg8::Gemm g{(const pg8::bf16_t*)(ws + OFF_XB), (const pg8::bf16_t*)(ws + OFF_WIN0), MP, N0, 2048};
        pg8::StaticOrder S;
        S.init(MP, N0, (int)gridDim.x, (int)blockIdx.x);
        pg8::gemm_phase<EpiIn0, pg8::StaticOrder, false>((PG8_LAS unsigned char*)smem_raw, g, S, E, nullptr);
      } break;
      case 2: phase_rec0(p, smem); break;
      case 3: phase_post0(p); break;
      case 4: case 15: {
        EpiStoreF32 E{(float*)(ws + OFF_GOUT)};
        pg8::Gemm g{(const pg8::bf16_t*)(ws + OFF_MIXB), (const pg8::bf16_t*)(ws + (ph == 4 ? OFF_WOUT0 : OFF_WOUT1)), MP, 2048, 2048};
        pg8::StaticOrder S;
        S.init(MP, 2048, (int)gridDim.x, (int)blockIdx.x);
        pg8::gemm_phase<EpiStoreF32, pg8::StaticOrder, false>((PG8_LAS unsigned char*)smem_raw, g, S, E, nullptr);
      } break;
      case 5: case 16: {
        int l = (ph == 5) ? 0 : 1;
        phase_ln(p, (const float*)(ws + OFF_GOUT), p.in[I_LNG] + (size_t)(l * 2) * D, p.in[I_LNB] + (size_t)(l * 2) * D);
      } break;
      case 6: case 17: {
        EpiStoreBf16 E{(u16*)(ws + OFF_QB)};
        pg8::Gemm g{(const pg8::bf16_t*)(ws + OFF_XB), (const pg8::bf16_t*)(ws + (ph == 6 ? OFF_WQ0 : OFF_WQ1)), MP, 2048, 2048};
        pg8::StaticOrder S;
        S.init(MP, 2048, (int)gridDim.x, (int)blockIdx.x);
        pg8::gemm_phase<EpiStoreBf16, pg8::StaticOrder, false>((PG8_LAS unsigned char*)smem_raw, g, S, E, nullptr);
      } break;
      case 7: case 18: {
        float* SC = (float*)(ws + OFF_GOUT);
        gemm_phase((const u16*)(ws + OFF_QB), 2048, 128, (const u16*)(ws + (ph == 7 ? OFF_KEY0 : OFF_KEY1)), 128,
                   69, 16, smem_raw, [=](int row, int col, float v0, float v1) {
                     SC[(size_t)row * 2048 + col] = v0;
                     SC[(size_t)row * 2048 + col + 32] = v1;
                   });
      } break;
      case 8: phase_peer(p, 0, false); break;
      case 9: {
        conv_fp8_rows(p.in[I_PU] + (size_t)16384 * 2048, (unsigned char*)(ws + OFF_UB), (float*)(ws + OFF_USC));
        conv_fp8_rows(p.in[I_PV] + (size_t)16384 * 2048, (unsigned char*)(ws + OFF_VB), (float*)(ws + OFF_VSC));
        EpiIn1 E{(float*)(ws + OFF_PROJ), (float*)(ws + OFF_DTA), p.in[I_DTB], p.in[I_ALOG]};
        pg8::Gemm g{(const pg8::bf16_t*)(ws + OFF_XB), (const pg8::bf16_t*)(ws + OFF_WIN1), MP, N1, 2048};
        pg8::StaticOrder S;
        S.init(MP, N1, (int)gridDim.x, (int)blockIdx.x);
        pg8::gemm_phase<EpiIn1, pg8::StaticOrder, false>((PG8_LAS unsigned char*)smem_raw, g, S, E, nullptr);
      } break;
      case 10: phase_pre1(p); break;
      case 11: {
        float* DEC = (float*)(ws + OFF_DEC);
        float* AA = (float*)(ws + OFF_AA);
        float* GG = (float*)(ws + OFF_GG);
        const float* w0 = p.in[I_W0];
        const float* a0 = p.in[I_A0];
        gemm_phase((const u16*)(ws + OFF_LRA), 64, 0, (const u16*)(ws + OFF_W2T), 64, 69, 8, smem_raw,
                   [=](int row, int col, float v0, float v1) {
#pragma unroll
                     for (int e = 0; e < 2; ++e) {
                       int cc = col + e * 32;
                       float v = (e ? v1 : v0);
                       float wl = -softplusf_(-v) - 0.5f;
                       DEC[(size_t)row * 1024 + cc] = expf(-expf(wl));
                     }
                   }, w0);
        gemm_phase((const u16*)(ws + OFF_LRB), 64, 0, (const u16*)(ws + OFF_A2T), 64, 69, 8, smem_raw,
                   [=](int row, int col, float v0, float v1) {
                     AA[(size_t)row * 1024 + col] = sigmoidf_(v0);
                     AA[(size_t)row * 1024 + col + 32] = sigmoidf_(v1);
                   }, a0);
        gemm_phase((const u16*)(ws + OFF_LRG), 192, 0, (const u16*)(ws + OFF_G2T), 192, 69, 8, smem_raw,
                   [=](int row, int col, float v0, float v1) {
                     GG[(size_t)row * 1024 + col] = v0;
                     GG[(size_t)row * 1024 + col + 32] = v1;
                   });
      } break;
      case 12: phase_pre1c(p); break;
      case 13: phase_rec1(p, smem); break;
      case 14: phase_post1(p); break;
      case 19: phase_peer(p, 1, true); break;
      default: break;
    }
  }
}

__global__ void __launch_bounds__(512, 2) mega(Params p, int ph_lo, int ph_hi) {
  __shared__ __attribute__((aligned(16))) char smem_raw[SMEM_BYTES];
  __shared__ uint4 xb_words;
  cg::grid_group grid = cg::this_grid();
  if (threadIdx.x == 0) xb_words = make_uint4(0u, 0u, 0u, 0u);
  __syncthreads();
  XcdBarrier xb = xcd_barrier_post((unsigned*)(p.ws + OFF_BAR), (volatile LAS unsigned*)&xb_words);
  if (ph_hi > 1000) grid.sync();
#ifndef REPEAT_MASK
#define REPEAT_MASK 0
#endif
#define PHASE(K)                                          \
  if (ph_lo <= K && K < ph_hi) run_phase<K>(p, smem_raw); \
  if ((REPEAT_MASK >> K) & 1) { xcd_barrier(xb); run_phase<K>(p, smem_raw); } \
  if (ph_lo <= K && K + 1 < ph_hi) xcd_barrier(xb);
  PHASE(0) PHASE(1) PHASE(2) PHASE(3) PHASE(4) PHASE(5) PHASE(6) PHASE(7) PHASE(8) PHASE(9)
  PHASE(10) PHASE(11) PHASE(12) PHASE(13) PHASE(14) PHASE(15) PHASE(16) PHASE(17) PHASE(18) PHASE(19)
}
#ifdef PHASE_TEST
template <int PH>
__global__ void __launch_bounds__(512, 2) phk(Params p) {
  __shared__ __attribute__((aligned(16))) char smem_raw[SMEM_BYTES];
  run_phase<PH>(p, smem_raw);
}
#define INST(N) template __global__ void phk<N>(Params);
INST(0) INST(1) INST(2) INST(3) INST(4) INST(5) INST(6) INST(7) INST(8) INST(9) INST(10) INST(11) INST(12) INST(13) INST(14) INST(19)
#endif

constexpr int NPHASE = 20;

extern "C" void kernel_launch(void* const* d_in, const int* in_sizes, int n_in, void* d_out, int out_size, void* d_ws,
                              size_t ws_size, hipStream_t stream) {
  static int grid_blocks = 0;
  if (!grid_blocks) {
    int dev = 0, cus = 0, per_cu = 0;
    hipGetDevice(&dev);
    hipDeviceGetAttribute(&cus, hipDeviceAttributeMultiprocessorCount, dev);
    hipOccupancyMaxActiveBlocksPerMultiprocessor(&per_cu, mega, 512, 0);
    if (per_cu > 1) per_cu = 1;
    if (per_cu < 1) per_cu = 1;
    grid_blocks = cus * per_cu;
  }
  Params p{};
  for (int i = 0; i < 38; ++i) p.in[i] = (const float*)d_in[i];
  p.out = (float*)d_out;
  p.ws = (char*)d_ws;
  (void)hipMemsetAsync((char*)d_ws + OFF_BAR, 0, 3456 * 4, stream);
  int lo = 0, hi = NPHASE;
  void* args[] = {&p, &lo, &hi};
  hipError_t e = hipLaunchCooperativeKernel((void*)mega, dim3(grid_blocks), dim3(512), args, 0, stream);
  if (e != hipSuccess) fprintf(stderr, "cooperative launch failed: %s (grid %d)\n", hipGetErrorString(e), grid_blocks);
}
```

```cpp
#include <hip/hip_runtime.h>
#include <hip/hip_bf16.h>
#include <hip/hip_cooperative_groups.h>
#include <cstdio>
#include <cmath>
namespace cg = cooperative_groups;

#define DEVI __device__ __forceinline__
typedef unsigned short u16;
using bf16x8 = __attribute__((ext_vector_type(8))) short;
using f32x4 = __attribute__((ext_vector_type(4))) float;
using u32x4 = __attribute__((ext_vector_type(4))) unsigned int;

constexpr int D = 2048;
constexpr int TP = 2064;
constexpr int MPR = 8256;
constexpr int M = 8768;
constexpr int MP = 8960;
constexpr int N0 = 7168;
constexpr int N1 = 6144;
constexpr float ALPHA = 1.41421356237f;

constexpr size_t SZ_TAB = (size_t)16384 * 2048 * 2;
constexpr size_t OFF_UB = 0;
constexpr size_t OFF_VB = OFF_UB + SZ_TAB;
constexpr size_t OFF_WIN0 = OFF_VB + SZ_TAB;
constexpr size_t OFF_WOUT0 = OFF_WIN0 + (size_t)N0 * 2048 * 2;
constexpr size_t OFF_WQ0 = OFF_WOUT0 + (size_t)2048 * 2048 * 2;
constexpr size_t OFF_KEY0 = OFF_WQ0 + (size_t)2048 * 2048 * 2;
constexpr size_t OFF_WIN1 = OFF_KEY0 + (size_t)16 * 128 * 128 * 2;
constexpr size_t OFF_WOUT1 = OFF_WIN1 + (size_t)N1 * 2048 * 2;
constexpr size_t OFF_WQ1 = OFF_WOUT1 + (size_t)2048 * 2048 * 2;
constexpr size_t OFF_KEY1 = OFF_WQ1 + (size_t)2048 * 2048 * 2;
constexpr size_t OFF_W2T = OFF_KEY1 + (size_t)16 * 128 * 128 * 2;
constexpr size_t OFF_A2T = OFF_W2T + (size_t)1024 * 64 * 2;
constexpr size_t OFF_G2T = OFF_A2T + (size_t)1024 * 64 * 2;
constexpr size_t OFF_LB = OFF_G2T + (size_t)1024 * 192 * 2;
constexpr size_t OFF_INVREV = OFF_LB + 1024 * 4;
constexpr size_t OFF_XF = OFF_INVREV + 64 * 8;
constexpr size_t OFF_XB = OFF_XF + (size_t)MP * 2048 * 4;
constexpr size_t OFF_PROJ = OFF_XB + (size_t)MP * 2048 * 2;
constexpr size_t OFF_GOUT = OFF_PROJ + (size_t)MP * N0 * 4;
constexpr size_t OFF_OMIX = OFF_GOUT + (size_t)MP * 2048 * 4;
constexpr size_t OFF_MIXB = OFF_OMIX + (size_t)MP * 2048 * 4;
constexpr size_t OFF_QB = OFF_MIXB + (size_t)MP * 2048 * 2;
constexpr size_t OFF_RKV = OFF_QB + (size_t)MP * 2048 * 2;
constexpr size_t OFF_DEC = OFF_RKV + (size_t)MP * 3072 * 4;
constexpr size_t OFF_AA = OFF_DEC + (size_t)MP * 1024 * 4;
constexpr size_t OFF_GG = OFF_AA + (size_t)MP * 1024 * 4;
constexpr size_t OFF_LRA = OFF_GG + (size_t)MP * 1024 * 4;
constexpr size_t OFF_LRB = OFF_LRA + (size_t)MP * 64 * 2;
constexpr size_t OFF_LRG = OFF_LRB + (size_t)MP * 64 * 2;
constexpr size_t OFF_DTA = OFF_LRG + (size_t)MP * 192 * 2;
constexpr size_t OFF_BON = OFF_DTA + (size_t)MP * 64 * 4;
constexpr size_t OFF_USC = OFF_BON + (size_t)MP * 16 * 4;
constexpr size_t OFF_VSC = OFF_USC + 16384 * 4;
constexpr size_t OFF_BAR = OFF_VSC + 16384 * 4;
constexpr size_t WS_TOTAL = OFF_BAR + 3456 * 4;
static_assert(WS_TOTAL <= (size_t)1 << 30, "workspace too large");

constexpr size_t O_YP = 0;
constexpr size_t O_YS = O_YP + (size_t)4 * 2048 * 2048;
constexpr size_t O_HGP = O_YS + (size_t)128 * 4 * 2048;
constexpr size_t O_HGS = O_HGP + (size_t)4 * 8 * 128 * 128;
constexpr size_t O_RTP = O_HGS + (size_t)128 * 8 * 128 * 128;
constexpr size_t O_RTS = O_RTP + (size_t)4 * 4 * 128 * 256;
constexpr size_t O_SSP = O_RTS + (size_t)128 * 4 * 128 * 256;
constexpr size_t O_SSS = O_SSP + (size_t)4 * 16 * 128 * 64;
constexpr size_t O_CVP = O_SSS + (size_t)128 * 16 * 128 * 64;
constexpr size_t O_CVS = O_CVP + (size_t)4 * 3 * 1536;
constexpr size_t O_WKP = O_CVS + (size_t)128 * 3 * 1536;
constexpr size_t O_WKS = O_WKP + (size_t)4 * 16 * 64 * 64;
constexpr size_t O_SHP = O_WKS + (size_t)128 * 16 * 64 * 64;
constexpr size_t O_SHS = O_SHP + (size_t)4 * 3360;

struct Params {
  const float* in[38];
  float* out;
  char* ws;
};
enum { I_XP = 0, I_XS, I_SHG, I_SRT, I_SSM, I_SCV, I_SWK, I_SSH, I_META, I_LNG, I_LNB, I_EWIN, I_LBL, I_HNG, I_EWOUT,
       I_OWIN, I_CVW, I_CVB, I_DTB, I_ALOG, I_DSK, I_SNG, I_MU, I_W0, I_W2, I_A0, I_A2, I_G2, I_KK, I_KA, I_RK,
       I_LXG, I_LXB, I_OWOUT, I_WQ, I_KEYS, I_PU, I_PV };

constexpr int VB_BYTES = 2 * 2 * 128 * 72 * 2;
constexpr int SMEM_BYTES = 2 * VB_BYTES;

DEVI u16 f2bf(float f) {
  unsigned u = __float_as_uint(f);
  u += 0x7fffu + ((u >> 16) & 1u);
  return (u16)(u >> 16);
}
DEVI unsigned pack2(float a, float b) { return (unsigned)f2bf(a) | ((unsigned)f2bf(b) << 16); }
DEVI float bflo(unsigned u) { return __uint_as_float(u << 16); }
DEVI float bfhi(unsigned u) { return __uint_as_float(u & 0xffff0000u); }
DEVI float sigmoidf_(float x) { return __builtin_amdgcn_rcpf(1.0f + __builtin_amdgcn_exp2f(-1.44269504089f * x)); }
DEVI float siluf_(float x) { return x * __builtin_amdgcn_rcpf(1.0f + __builtin_amdgcn_exp2f(-1.44269504089f * x)); }
DEVI float sigmoid_acc(float x) { return 1.0f / (1.0f + expf(-x)); }
DEVI float silu_acc(float x) { return x / (1.0f + expf(-x)); }
DEVI float softplusf_(float x) { return fmaxf(x, 0.0f) + log1pf(expf(-fabsf(x))); }
DEVI float wsum(float v) {
#pragma unroll
  for (int o = 32; o > 0; o >>= 1) v += __shfl_xor(v, o, 64);
  return v;
}
DEVI float wmaxf_(float v) {
#pragma unroll
  for (int o = 32; o > 0; o >>= 1) v = fmaxf(v, __shfl_xor(v, o, 64));
  return v;
}
DEVI int wmini_(int v) {
#pragma unroll
  for (int o = 32; o > 0; o >>= 1) v = min(v, __shfl_xor(v, o, 64));
  return v;
}
template <int CTRL>
DEVI float dppf(float v) {
  return __int_as_float(__builtin_amdgcn_update_dpp(0, __float_as_int(v), CTRL, 0xF, 0xF, true));
}
DEVI float red8(float v) {
  v += dppf<0xB1>(v);
  v += dppf<0x4E>(v);
  v += dppf<0x141>(v);
  return v;
}
DEVI float red16(float v) {
  v = red8(v);
  v += dppf<0x140>(v);
  return v;
}
DEVI float rlf_(float v, int l) { return __int_as_float(__builtin_amdgcn_readlane(__float_as_int(v), l)); }
DEVI int row_pos(int row) { return row < MPR ? (row % TP) : (16384 + ((row - MPR) & 3)); }

DEVI void conv_bf16_flat(const float* __restrict__ src, u16* __restrict__ dst, size_t n4) {
  size_t stride = (size_t)gridDim.x * blockDim.x;
  for (size_t i = (size_t)blockIdx.x * blockDim.x + threadIdx.x; i < n4; i += stride) {
    float4 v = ((const float4*)src)[i];
    uint2 o;
    o.x = pack2(v.x, v.y);
    o.y = pack2(v.z, v.w);
    ((uint2*)dst)[i] = o;
  }
}

template <int MODE>
DEVI int colmap(int j) {
  if (MODE == 0) return j;
  if (MODE == 1) {
    if (j < 4096 || j >= 5120) return j;
    int hb = j & ~127, c = j & 127, wc = c >> 5, n = (c >> 4) & 1, r = c & 15;
    int d = n ? (64 + wc * 16 + r) : (wc * 16 + r);
    return hb + d;
  }
  if (j < 2560) return j;
  if (j < 5920) return j + 16;
  if (j < 5936) return 2560 + (j - 5920);
  return -1;
}

template <int MODE>
DEVI void transpose_job(const float* __restrict__ src, int ldsrc, int Ksrc, u16* __restrict__ dst, int Kdst, int ndst,
                        float* smem) {
  int ktiles = Kdst / 64, ntiles = ndst / 64;
  int tid = threadIdx.x & 255;
  const int half = threadIdx.x >> 8;
  smem += half * (64 * 65);
  for (int base = blockIdx.x * 2; base < ktiles * ntiles; base += gridDim.x * 2) {
    int tile = base + half;
    const bool valid = tile < ktiles * ntiles;
    if (!valid) tile = ktiles * ntiles - 1;
    int tn = tile / ktiles, tk = tile % ktiles;
    int j0 = tn * 64, k0 = tk * 64;
    int jj = (tid & 15) * 4;
    int sc = colmap<MODE>(j0 + jj);
#pragma unroll
    for (int i = 0; i < 4; ++i) {
      int kk = i * 16 + (tid >> 4);
      float4 v = make_float4(0.f, 0.f, 0.f, 0.f);
      if (sc >= 0 && (k0 + kk) < Ksrc) v = *(const float4*)(src + (size_t)(k0 + kk) * ldsrc + sc);
      smem[kk * 65 + jj] = v.x;
      smem[kk * 65 + jj + 1] = v.y;
      smem[kk * 65 + jj + 2] = v.z;
      smem[kk * 65 + jj + 3] = v.w;
    }
    __syncthreads();
    int jr = tid >> 2, kq = (tid & 3) * 16;
    unsigned pk[8];
#pragma unroll
    for (int e = 0; e < 8; ++e) pk[e] = pack2(smem[(kq + 2 * e) * 65 + jr], smem[(kq + 2 * e + 1) * 65 + jr]);
    uint4* dp = (uint4*)(dst + (size_t)(j0 + jr) * Kdst + k0 + kq);
    if (valid) {
      dp[0] = make_uint4(pk[0], pk[1], pk[2], pk[3]);
      dp[1] = make_uint4(pk[4], pk[5], pk[6], pk[7]);
    }
    __syncthreads();
  }
}

DEVI void phase0(const Params& p, float* smem) {
  char* ws = p.ws;
  conv_bf16_flat(p.in[I_KEYS], (u16*)(ws + OFF_KEY0), (size_t)16 * 128 * 128 / 4);
  conv_bf16_flat(p.in[I_KEYS] + (size_t)16 * 128 * 128, (u16*)(ws + OFF_KEY1), (size_t)16 * 128 * 128 / 4);
  transpose_job<1>(p.in[I_EWIN], N0, 2048, (u16*)(ws + OFF_WIN0), 2048, N0, smem);
  transpose_job<0>(p.in[I_EWOUT], 2048, 2048, (u16*)(ws + OFF_WOUT0), 2048, 2048, smem);
  transpose_job<0>(p.in[I_WQ], 2048, 2048, (u16*)(ws + OFF_WQ0), 2048, 2048, smem);
  transpose_job<0>(p.in[I_WQ] + (size_t)2048 * 2048, 2048, 2048, (u16*)(ws + OFF_WQ1), 2048, 2048, smem);
  transpose_job<2>(p.in[I_OWIN], 5936, 2048, (u16*)(ws + OFF_WIN1), 2048, N1, smem);
  transpose_job<0>(p.in[I_OWOUT], 2048, 2048, (u16*)(ws + OFF_WOUT1), 2048, 2048, smem);
  transpose_job<0>(p.in[I_W2], 1024, 64, (u16*)(ws + OFF_W2T), 64, 1024, smem);
  transpose_job<0>(p.in[I_A2], 1024, 64, (u16*)(ws + OFF_A2T), 64, 1024, smem);
  transpose_job<0>(p.in[I_G2], 1024, 160, (u16*)(ws + OFF_G2T), 192, 1024, smem);
  {
    float* XF = (float*)(ws + OFF_XF);
    u16* XB = (u16*)(ws + OFF_XB);
    size_t n4 = (size_t)MP * 512;
    size_t stride = (size_t)gridDim.x * blockDim.x;
    for (size_t i = (size_t)blockIdx.x * blockDim.x + threadIdx.x; i < n4; i += stride) {
      int row = (int)(i >> 9), c4 = (int)(i & 511);
      float4 v = make_float4(0.f, 0.f, 0.f, 0.f);
      if (row < MPR) {
        int b = row / TP, t = row % TP;
        const float* s = (t < 16) ? (p.in[I_META] + (size_t)t * D) : (p.in[I_XP] + ((size_t)b * 2048 + (t - 16)) * D);
        v = ((const float4*)s)[c4];
      } else if (row < M) {
        v = ((const float4*)(p.in[I_XS] + (size_t)(row - MPR) * D))[c4];
      }
      ((float4*)XF)[i] = v;
      uint2 o;
      o.x = pack2(v.x, v.y);
      o.y = pack2(v.z, v.w);
      ((uint2*)XB)[i] = o;
    }
  }
  if (blockIdx.x == 0) {
    float* LB = (float*)(ws + OFF_LB);
    const float* lg = p.in[I_LBL];
    for (int c = threadIdx.x; c < 1024; c += blockDim.x) {
      float a = lg[c], b = lg[1024 + c], d = lg[2048 + c];
      float m = fmaxf(a, fmaxf(b, d));
      float ea = expf(a - m), eb = expf(b - m), ed = expf(d - m);
      LB[c] = ea / (ea + eb + ed);
    }
    float* IR = (float*)(ws + OFF_INVREV);
    if (threadIdx.x < 64) {
      double d = (double)threadIdx.x;
      double v = exp(-d * (9.210340371976184 / 64.0)) * 0.15915494309189535;
      float h = (float)v;
      IR[threadIdx.x * 2] = h;
      IR[threadIdx.x * 2 + 1] = (float)(v - (double)h);
    }
  }
}

constexpr int G_LDS_STRIDE = 72;
constexpr int G_LDS_BUF = 2 * 128 * G_LDS_STRIDE;
template <class Epi>
DEVI void gemm_phase(const u16* __restrict__ A, int lda, int a_ntile_off, const u16* __restrict__ Bt, int K, int mtiles,
                     int ntiles, char* smem, Epi epi, const float* __restrict__ colc = nullptr) {
  const int half = threadIdx.x >> 8;
  u16* S0 = (u16*)(smem + half * VB_BYTES);
  const int tid = threadIdx.x & 255, wid = tid >> 6, lane = tid & 63, wr = wid >> 1, wc = wid & 1, fr = lane & 15, fq = lane >> 4;
  const int nk = K / 64;
  const int ntot = mtiles * ntiles;
  for (int base = blockIdx.x * 2; base < ntot; base += gridDim.x * 2) {
    int tile = base + half;
    const bool valid = tile < ntot;
    if (!valid) tile = ntot - 1;
    const int tm = tile / ntiles, tn = tile - tm * ntiles;
    const int brow = tm * 128, bcol = tn * 128;
    const u16* Ag = A + (size_t)brow * lda + (size_t)tn * a_ntile_off;
    const u16* Bg = Bt + (size_t)bcol * K;
    f32x4 acc[4][4];
#pragma unroll
    for (int m = 0; m < 4; ++m)
#pragma unroll
      for (int n = 0; n < 4; ++n) acc[m][n] = f32x4{0.f, 0.f, 0.f, 0.f};
    u32x4 ra0[4], rb0[4], ra1[4], rb1[4];
    auto gload = [&](int t, u32x4(&ra)[4], u32x4(&rb)[4]) {
#pragma unroll
      for (int i = 0; i < 4; ++i) {
        int c = tid + i * 256, r = c >> 3, kc = c & 7;
        ra[i] = *(const u32x4*)(Ag + (size_t)r * lda + t * 64 + kc * 8);
        rb[i] = *(const u32x4*)(Bg + (size_t)r * K + t * 64 + kc * 8);
      }
    };
    auto lwrite = [&](int buf, const u32x4(&ra)[4], const u32x4(&rb)[4]) {
      u16* SA = S0 + buf * G_LDS_BUF;
      u16* SB = SA + 128 * G_LDS_STRIDE;
#pragma unroll
      for (int i = 0; i < 4; ++i) {
        int c = tid + i * 256, r = c >> 3, kc = c & 7;
        *(u32x4*)(SA + r * G_LDS_STRIDE + kc * 8) = ra[i];
        *(u32x4*)(SB + r * G_LDS_STRIDE + kc * 8) = rb[i];
      }
    };
    auto compute = [&](int buf) {
      const u16* SA = S0 + buf * G_LDS_BUF;
      const u16* SB = SA + 128 * G_LDS_STRIDE;
#pragma unroll
      for (int kh = 0; kh < 2; ++kh) {
        bf16x8 At[4], Bl[4];
#pragma unroll
        for (int m = 0; m < 4; ++m)
          At[m] = *(const bf16x8*)(SA + (wr * 64 + m * 16 + fr) * G_LDS_STRIDE + kh * 32 + fq * 8);
#pragma unroll
        for (int n = 0; n < 4; ++n)
          Bl[n] = *(const bf16x8*)(SB + (wc * 64 + n * 16 + fr) * G_LDS_STRIDE + kh * 32 + fq * 8);
#pragma unroll
        for (int m = 0; m < 4; ++m)
#pragma unroll
          for (int n = 0; n < 4; ++n) acc[m][n] = __builtin_amdgcn_mfma_f32_16x16x32_bf16(At[m], Bl[n], acc[m][n], 0, 0, 0);
        __builtin_amdgcn_sched_barrier(0);
      }
    };
    gload(0, ra0, rb0);
    if (nk > 1) gload(1, ra1, rb1);
    lwrite(0, ra0, rb0);
    __syncthreads();
#pragma unroll 1
    for (int t = 0; t < nk; t += 2) {
      if (t + 2 < nk) gload(t + 2, ra0, rb0);
      compute(0);
      if (t + 1 < nk) lwrite(1, ra1, rb1);
      __syncthreads();
      if (t + 1 < nk) {
        if (t + 3 < nk) gload(t + 3, ra1, rb1);
        compute(1);
        if (t + 2 < nk) lwrite(0, ra0, rb0);
        __syncthreads();
      }
    }
    if (valid) {
      float cc[4] = {0.f, 0.f, 0.f, 0.f};
      if (colc) {
#pragma unroll
        for (int n = 0; n < 4; ++n) cc[n] = colc[bcol + wc * 64 + n * 16 + fr];
      }
#pragma unroll
      for (int m = 0; m < 4; ++m)
#pragma unroll
        for (int n = 0; n < 2; ++n)
#pragma unroll
          for (int j = 0; j < 4; ++j) {
            int row = brow + wr * 64 + m * 16 + fq * 4 + j;
            int col = bcol + wc * 64 + n * 16 + fr;
            epi(row, col, acc[m][n][j] + cc[n], acc[m][n + 2][j] + cc[n + 2]);
          }
    }
  }
}


namespace pg8 {
#define PG8_LAS __attribute__((address_space(3)))
typedef unsigned short bf16_t;
typedef short bf16x8 __attribute__((ext_vector_type(8)));
typedef float f32x4 __attribute__((ext_vector_type(4)));
typedef unsigned u32x4 __attribute__((ext_vector_type(4)));
constexpr int BM = 256, BK = 64, HALF = 128, HTB = HALF * BK * 2  , STAGE_BYTES = 8 * HTB, NXCD = 8, WGM = 8;

__host__ __device__ __forceinline__ int lds_byte(int r, int c) { const int st = (r >> 4) * 2 + (c >> 5), rr = r & 15, cc = c & 31, ob = rr * 64 + cc * 2; return st * 1024 + (ob ^ (((ob >> 9) & 1) << 5)); }
__host__ __device__ __forceinline__ void stage_rc(int b, int& R, int& C) { const int st = b / 1024, sb = b % 1024, swz = sb ^ (((sb >> 9) & 1) << 5); R = (st >> 1) * 16 + swz / 64; C = (st & 1) * 32 + (swz % 64) / 2; }
__host__ __device__ __forceinline__ int perm32(int rho) { const int n = rho >> 4, i = rho & 15; return 8 * (i >> 2) + 4 * n + (i & 3); }

struct Unit { int pm, pn; };
struct Gemm { const bf16_t* A; const bf16_t* Bt; int M, N, K; };

struct StaticOrder {
    int nM, nN, nwg, G, c;
    __host__ __device__ void init(int M, int N, int G_, int c_) { nM = M / BM; nN = N / BM; nwg = nM * nN; G = G_; c = c_; }
    __host__ __device__ bool next(int i, Unit& u) const {
        const long L = (long)i * G + c; if (L >= nwg) return false;
        int wgid = (int)L; { const int q = nwg / NXCD, r = nwg % NXCD, xcd = wgid % NXCD, off = wgid / NXCD; wgid = (xcd < r ? xcd * (q + 1) : r * (q + 1) + (xcd - r) * q) + off; }
        const int nig = WGM * nN, gid = wgid / nig, fm = gid * WGM, gsz = (nM - fm) < WGM ? (nM - fm) : WGM;
        u.pm = fm + ((wgid % nig) % gsz); u.pn = (wgid % nig) / gsz; return true;
    }
    __device__ __forceinline__ void a_ready(const Unit&) const {}
    __device__ __forceinline__ void done(const Unit&) const {}
};
template <class Epi, class Sched, bool STAMP = false>
__device__ __forceinline__ void gemm_phase(PG8_LAS unsigned char* lds, const Gemm g, const Sched& S, const Epi& E, unsigned long long* stamps) {
    const int tid = threadIdx.x, wid = __builtin_amdgcn_readfirstlane(tid >> 6), lane = tid & 63, wr = wid >> 2, wc = wid & 3, fr = lane & 15, fq = lane >> 4;
    const int K = g.K, nt = K / BK;
    int ts_lo = 0, ts_hi = 0, nts = 0; const unsigned long long rt_entry = STAMP ? (unsigned long long)wall_clock64() : 0ull;
#define PG8_STAMP() do { if (STAMP && wid == 0 && nts < 64) { const unsigned long long _c = (unsigned long long)clock64(); \
        ts_lo = (lane == nts) ? (int)(unsigned)_c : ts_lo; ts_hi = (lane == nts) ? (int)(unsigned)(_c >> 32) : ts_hi; ++nts; } } while (0)
    PG8_STAMP();
    unsigned voffA[2], voffB[2];
#pragma unroll
    for (int i = 0; i < 2; ++i) { int R, C; stage_rc(tid * 16 + i * 8192, R, C); const int Rb = Epi::PERM ? ((R & ~31) + perm32(R & 31)) : R;
        voffA[i] = (unsigned)(R * K + C) * 2u; voffB[i] = (unsigned)(Rb * K + C) * 2u; }
    const size_t kstep = (size_t)(BK * 2);
    const size_t hstep = (size_t)HALF * K * 2;
    const size_t tstep = 2 * hstep;
    const unsigned ldsw = (unsigned)wid * 1024u;
    const int aoff = lds_byte(wr * 64 + fr, fq * 8), boff = lds_byte(wc * 32 + fr, fq * 8);
#define PG8_SA(b, h) (((b) * 2 + (h)) * HTB)
#define PG8_SB(b, h) ((4 + (b) * 2 + (h)) * HTB)
#define PG8_STAGE(bufoff, gbase, voff) do { _Pragma("unroll") for (int _i = 0; _i < 2; ++_i) \
        __builtin_amdgcn_global_load_lds((const unsigned*)((const char*)(gbase) + (voff)[_i]), (PG8_LAS unsigned*)(lds + (bufoff) + ldsw + _i * 8192), 16, 0, 0); } while (0)
#define PG8_LDA(dst, b, h) do { _Pragma("unroll") for (int m = 0; m < 4; ++m) _Pragma("unroll") for (int k = 0; k < 2; ++k) dst[m][k] = *(const PG8_LAS bf16x8*)(lds + PG8_SA(b, h) + aoff + m * 2048 + k * 1024); } while (0)
#define PG8_LDB(dst, b, h) do { _Pragma("unroll") for (int n = 0; n < 2; ++n) _Pragma("unroll") for (int k = 0; k < 2; ++k) dst[n][k] = *(const PG8_LAS bf16x8*)(lds + PG8_SB(b, h) + boff + n * 2048 + k * 1024); } while (0)
#define PG8_MMA(ai, bj, At, Bt) do { __builtin_amdgcn_s_setprio(1); _Pragma("unroll") for (int m = 0; m < 4; ++m) _Pragma("unroll") for (int n = 0; n < 2; ++n) _Pragma("unroll") for (int k = 0; k < 2; ++k) \
        acc[ai][bj][m][n] = __builtin_amdgcn_mfma_f32_16x16x32_bf16(Bt[n][k], At[m][k], acc[ai][bj][m][n], 0, 0, 0); __builtin_amdgcn_s_setprio(0); } while (0)
#define PG8_WAIT_V(n) asm volatile("s_waitcnt vmcnt(" #n ")" ::: "memory")
#define PG8_WAIT_L(n) asm volatile("s_waitcnt lgkmcnt(" #n ")" ::: "memory")
#define PG8_BAR __builtin_amdgcn_s_barrier()
#define PG8_SCHED __builtin_amdgcn_sched_barrier(0)
    Unit cur, nxt; int ui = 0;
    if (!S.next(0, cur)) return;
    f32x4 acc[2][2][4][2];
#pragma unroll
    for (int a = 0; a < 2; ++a)
#pragma unroll
        for (int b = 0; b < 2; ++b)
#pragma unroll
            for (int m = 0; m < 4; ++m)
#pragma unroll
                for (int n = 0; n < 2; ++n) acc[a][b][m][n] = (f32x4){0.f, 0.f, 0.f, 0.f};
    bf16x8 At[4][2], B0[2][2], B1[2][2];
    const char* cA = (const char*)g.A + (size_t)cur.pm * tstep; const char* cB = (const char*)g.Bt + (size_t)cur.pn * tstep;
    S.a_ready(cur);
    PG8_STAGE(PG8_SB(0, 0), cB, voffB); PG8_STAGE(PG8_SA(0, 0), cA, voffA); PG8_STAGE(PG8_SB(0, 1), cB + hstep, voffB); PG8_STAGE(PG8_SA(0, 1), cA + hstep, voffA);
    if (wr == 1) PG8_BAR;
    PG8_WAIT_V(4); PG8_BAR;
    PG8_STAGE(PG8_SB(1, 0), cB + kstep, voffB); PG8_STAGE(PG8_SA(1, 0), cA + kstep, voffA); PG8_STAGE(PG8_SB(1, 1), cB + hstep + kstep, voffB);
    PG8_WAIT_V(6); PG8_BAR;
    PG8_STAMP();
    for (;;) {
        const bool has_next = S.next(ui + 1, nxt);
        const char* nA = has_next ? (const char*)g.A + (size_t)nxt.pm * tstep : cA; const char* nB = has_next ? (const char*)g.Bt + (size_t)nxt.pn * tstep : cB;
        for (int t = 0; t < nt; t += 2) {
            const bool last = (t == nt - 2);
            const char* a1 = cA + (size_t)(t + 1) * kstep;
            const char* a2 = last ? nA : cA + (size_t)(t + 2) * kstep; const char* b2 = last ? nB : cB + (size_t)(t + 2) * kstep;
            const char* a3 = a2 + kstep; const char* b3 = b2 + kstep;
            if (last && has_next) S.a_ready(nxt);
            PG8_LDB(B0, 0, 0); PG8_SCHED; PG8_LDA(At, 0, 0); PG8_STAGE(PG8_SA(1, 1), a1 + hstep, voffA);
            PG8_WAIT_L(8); PG8_BAR; PG8_WAIT_L(0); PG8_MMA(0, 0, At, B0); PG8_BAR; PG8_SCHED;
            PG8_LDB(B1, 0, 1); PG8_STAGE(PG8_SB(0, 0), b2, voffB);
            PG8_BAR; PG8_WAIT_L(0); PG8_MMA(0, 1, At, B1); PG8_BAR;
            PG8_LDA(At, 0, 1); PG8_STAGE(PG8_SA(0, 0), a2, voffA);
            PG8_BAR; PG8_WAIT_L(0); PG8_MMA(1, 0, At, B0); PG8_BAR; PG8_SCHED;
            PG8_STAGE(PG8_SB(0, 1), b2 + hstep, voffB);
            PG8_WAIT_V(6); PG8_BAR; PG8_MMA(1, 1, At, B1); PG8_BAR;
            PG8_LDB(B0, 1, 0); PG8_SCHED; PG8_LDA(At, 1, 0); PG8_STAGE(PG8_SA(0, 1), a2 + hstep, voffA);
            PG8_WAIT_L(8); PG8_BAR; PG8_WAIT_L(0); PG8_MMA(0, 0, At, B0); PG8_BAR; PG8_SCHED;
            PG8_LDB(B1, 1, 1); PG8_STAGE(PG8_SB(1, 0), b3, voffB);
            PG8_BAR; PG8_WAIT_L(0); PG8_MMA(0, 1, At, B1); PG8_BAR;
            PG8_LDA(At, 1, 1); PG8_STAGE(PG8_SA(1, 0), a3, voffA);
            PG8_BAR; PG8_WAIT_L(0); PG8_MMA(1, 0, At, B0); PG8_BAR; PG8_SCHED;
            PG8_STAGE(PG8_SB(1, 1), b3 + hstep, voffB);
            PG8_WAIT_V(6); PG8_BAR; PG8_MMA(1, 1, At, B1); PG8_BAR;
        }
        PG8_STAMP();
        if constexpr (!Epi::AFTER_DRAIN) { E(acc, cur, wr, wc, fr, fq); S.done(cur); }
        PG8_STAMP();
        if (!has_next) break;
#pragma unroll
        for (int a = 0; a < 2; ++a)
#pragma unroll
            for (int b = 0; b < 2; ++b)
#pragma unroll
                for (int m = 0; m < 4; ++m)
#pragma unroll
                    for (int n = 0; n < 2; ++n) acc[a][b][m][n] = (f32x4){0.f, 0.f, 0.f, 0.f};
        cur = nxt; cA = nA; cB = nB; ++ui;
    }
    PG8_WAIT_V(0);
    if (wr == 0) PG8_BAR;
    PG8_BAR;
    if constexpr (Epi::AFTER_DRAIN) { E.fused(acc, cur, wr, wc, fr, fq, lds, wid, lane); S.done(cur); }
    PG8_STAMP();
    if (STAMP && wid == 0) { stamps[lane] = lane < nts ? (((unsigned long long)(unsigned)ts_hi << 32) | (unsigned)ts_lo) : 0ull;
        if (lane == 62) stamps[62] = rt_entry; if (lane == 63) stamps[63] = (unsigned long long)wall_clock64(); }
#undef PG8_STAMP
#undef PG8_SA
#undef PG8_SB
#undef PG8_STAGE
#undef PG8_LDA
#undef PG8_LDB
#undef PG8_MMA
#undef PG8_WAIT_V
#undef PG8_WAIT_L
#undef PG8_BAR
#undef PG8_SCHED
}
}

struct EpiIn0 {
  static constexpr bool PERM = false, AFTER_DRAIN = false;
  float* PROJ;
  const float* LB;
  const float* IR;
  __device__ __forceinline__ void operator()(const pg8::f32x4 (&acc)[2][2][4][2], const pg8::Unit& u, int wr, int wc, int fr, int fq) const {
#pragma unroll
    for (int bj = 0; bj < 2; ++bj) {
      const int cb = u.pn * 256 + bj * 128;
      if (cb >= 4096 && cb < 5120) {
        const int d0 = wc * 16 + 4 * fq;
        const pg8::f32x4 irA = *(const pg8::f32x4*)(IR + 2 * d0), irB = *(const pg8::f32x4*)(IR + 2 * d0 + 4);
        const float irh[4] = {irA[0], irA[2], irB[0], irB[2]}, irl[4] = {irA[1], irA[3], irB[1], irB[3]};
        const float sc = (cb >= 4608) ? 0.08838834764831845f : 1.0f;
#pragma unroll
        for (int ai = 0; ai < 2; ++ai)
#pragma unroll
          for (int m = 0; m < 4; ++m) {
            const int row = u.pm * 256 + ai * 128 + wr * 64 + m * 16 + fr;
            float* pr = PROJ + (size_t)row * N0;
            const pg8::f32x4 v0 = acc[ai][bj][m][0], v1 = acc[ai][bj][m][1];
            const float pos = (float)row_pos(row);
            pg8::f32x4 o1, o2;
#pragma unroll
            for (int j = 0; j < 4; ++j) {
              float ph = pos * irh[j];
              float pe = __builtin_fmaf(pos, irh[j], -ph) + pos * irl[j];
              float frc = __builtin_amdgcn_fractf(ph) + pe;
              float sn = __builtin_amdgcn_sinf(frc), cs = __builtin_amdgcn_cosf(frc);
              o1[j] = (v0[j] * cs - v1[j] * sn) * sc;
              o2[j] = (v0[j] * sn + v1[j] * cs) * sc;
            }
            *(pg8::f32x4*)(pr + cb + d0) = o1;
            *(pg8::f32x4*)(pr + cb + 64 + d0) = o2;
            __builtin_amdgcn_sched_barrier(0);
          }
      } else if (cb >= 1024 && cb < 2048) {
        const int c0 = cb + 32 * wc + 4 * fq;
        const pg8::f32x4 l0 = *(const pg8::f32x4*)(LB + c0 - 1024), l1 = *(const pg8::f32x4*)(LB + c0 + 16 - 1024);
#pragma unroll
        for (int ai = 0; ai < 2; ++ai)
#pragma unroll
          for (int m = 0; m < 4; ++m) {
            const int row = u.pm * 256 + ai * 128 + wr * 64 + m * 16 + fr;
            float* pr = PROJ + (size_t)row * N0;
#pragma unroll
            for (int n = 0; n < 2; ++n) {
              const pg8::f32x4 l = n ? l1 : l0;
              pg8::f32x4 v = acc[ai][bj][m][n], o;
#pragma unroll
              for (int j = 0; j < 4; ++j) o[j] = l[j] + (1.0f - l[j]) * sigmoid_acc(v[j]);
              *(pg8::f32x4*)(pr + c0 + 16 * n) = o;
            }
            __builtin_amdgcn_sched_barrier(0);
          }
      } else if (cb < 1024 || (cb >= 3072 && cb < 4096) || cb >= 6144) {
        const int c0 = cb + 32 * wc + 4 * fq;
#pragma unroll
        for (int ai = 0; ai < 2; ++ai)
#pragma unroll
          for (int m = 0; m < 4; ++m) {
            const int row = u.pm * 256 + ai * 128 + wr * 64 + m * 16 + fr;
            float* pr = PROJ + (size_t)row * N0;
#pragma unroll
            for (int n = 0; n < 2; ++n) {
              pg8::f32x4 v = acc[ai][bj][m][n], o;
#pragma unroll
              for (int j = 0; j < 4; ++j) o[j] = siluf_(v[j]);
              *(pg8::f32x4*)(pr + c0 + 16 * n) = o;
            }
            __builtin_amdgcn_sched_barrier(0);
          }
      } else {
        const int c0 = cb + 32 * wc + 4 * fq;
#pragma unroll
        for (int ai = 0; ai < 2; ++ai)
#pragma unroll
          for (int m = 0; m < 4; ++m) {
            const int row = u.pm * 256 + ai * 128 + wr * 64 + m * 16 + fr;
            float* pr = PROJ + (size_t)row * N0;
#pragma unroll
            for (int n = 0; n < 2; ++n) *(pg8::f32x4*)(pr + c0 + 16 * n) = acc[ai][bj][m][n];
          }
      }
    }
  }
};
struct EpiStoreF32 {
  static constexpr bool PERM = false, AFTER_DRAIN = false;
  float* C;
  __device__ __forceinline__ void operator()(const pg8::f32x4 (&acc)[2][2][4][2], const pg8::Unit& u, int wr, int wc, int fr, int fq) const {
#pragma unroll
    for (int ai = 0; ai < 2; ++ai)
#pragma unroll
      for (int m = 0; m < 4; ++m) {
        const int row = u.pm * 256 + ai * 128 + wr * 64 + m * 16 + fr;
        float* pr = C + (size_t)row * 2048 + u.pn * 256 + 32 * wc + 4 * fq;
#pragma unroll
        for (int bj = 0; bj < 2; ++bj)
#pragma unroll
          for (int n = 0; n < 2; ++n) *(pg8::f32x4*)(pr + bj * 128 + 16 * n) = acc[ai][bj][m][n];
      }
  }
};
struct EpiStoreBf16 {
  static constexpr bool PERM = false, AFTER_DRAIN = false;
  u16* C;
  __device__ __forceinline__ void operator()(const pg8::f32x4 (&acc)[2][2][4][2], const pg8::Unit& u, int wr, int wc, int fr, int fq) const {
#pragma unroll
    for (int ai = 0; ai < 2; ++ai)
#pragma unroll
      for (int m = 0; m < 4; ++m) {
        const int row = u.pm * 256 + ai * 128 + wr * 64 + m * 16 + fr;
        u16* pr = C + (size_t)row * 2048 + u.pn * 256 + 32 * wc + 4 * fq;
#pragma unroll
        for (int bj = 0; bj < 2; ++bj)
#pragma unroll
          for (int n = 0; n < 2; ++n) {
            const pg8::f32x4 v = acc[ai][bj][m][n];
            uint2 o;
            o.x = pack2(v[0], v[1]);
            o.y = pack2(v[2], v[3]);
            *(uint2*)(pr + bj * 128 + 16 * n) = o;
          }
      }
  }
};
struct EpiIn1 {
  static constexpr bool PERM = false, AFTER_DRAIN = false;
  float* PROJ;
  float* DTA;
  const float* dtb;
  const float* alog;
  __device__ __forceinline__ void operator()(const pg8::f32x4 (&acc)[2][2][4][2], const pg8::Unit& u, int wr, int wc, int fr, int fq) const {
    float dtbv[4] = {0.f, 0.f, 0.f, 0.f}, aev[4] = {0.f, 0.f, 0.f, 0.f};
    if (u.pn == 23) {
      const int cc = 23 * 256 + 32 * wc + 4 * fq;
      const int hb = (cc >= 5920 && cc < 5936) ? (cc - 5920) : ((cc + 16 >= 5920 && cc + 16 < 5936) ? (cc + 16 - 5920) : -1);
      if (hb >= 0) {
#pragma unroll
        for (int j = 0; j < 4; ++j) { dtbv[j] = dtb[hb + j]; aev[j] = expf(alog[hb + j]); }
      }
    }
#pragma unroll
    for (int ai = 0; ai < 2; ++ai)
#pragma unroll
      for (int m = 0; m < 4; ++m) {
        const int row = u.pm * 256 + ai * 128 + wr * 64 + m * 16 + fr;
        float* pr = PROJ + (size_t)row * N1;
#pragma unroll
        for (int bj = 0; bj < 2; ++bj)
#pragma unroll
          for (int n = 0; n < 2; ++n) {
            const int col0 = u.pn * 256 + bj * 128 + 32 * wc + 16 * n + 4 * fq;
            pg8::f32x4 v = acc[ai][bj][m][n];
            if (col0 < 1024) {
              pg8::f32x4 o;
#pragma unroll
              for (int j = 0; j < 4; ++j) o[j] = siluf_(v[j]);
              *(pg8::f32x4*)(pr + col0) = o;
            } else if (col0 < 5920) {
              *(pg8::f32x4*)(pr + col0) = v;
            } else if (col0 < 5936) {
#pragma unroll
              for (int j = 0; j < 4; ++j) {
                int h = col0 + j - 5920;
                float dt = softplusf_(v[j] + dtbv[j]);
                DTA[(size_t)row * 64 + h * 4] = dt;
                DTA[(size_t)row * 64 + h * 4 + 1] = expf(-dt * aev[j]);
              }
            }
          }
      }
  }
};

struct Seg {
  int off;
  int ld;
  int n4;
};

template <int NS, int NF4, int RG>
DEVI void stage_init(const float* wsf, const Seg (&sg)[NS], int row0, int tid, const float* (&ptr)[RG], int (&ldv)[RG]) {
  asm volatile("" : "+v"(tid));
#pragma unroll
  for (int q = 0; q < RG; ++q) {
    int flat = tid + q * 256;
    int t = flat / NF4, f = flat % NF4;
    if (flat >= 16 * NF4) { t = 0; f = 0; }
    int off = 0, ld = 0, ff = f;
    bool done = false;
#pragma unroll
    for (int s = 0; s < NS; ++s) {
      bool here = (!done) && (ff < sg[s].n4);
      off = here ? (sg[s].off + (row0 + t) * sg[s].ld + ff * 4) : off;
      ld = here ? sg[s].ld : ld;
      ff = (done || here) ? ff : (ff - sg[s].n4);
      done = done || here;
    }
    ptr[q] = wsf + off;
    ldv[q] = ld;
  }
}
template <int NF4, int RG>
DEVI void stage_issue(const float* const (&ptr)[RG], const int (&ldv)[RG], int st, int nsteps, int tid, f32x4 (&rg)[RG]) {
#pragma unroll
  for (int q = 0; q < RG; ++q) {
    int flat = tid + q * 256;
    if (flat < nsteps * NF4) rg[q] = *(const f32x4*)(ptr[q] + (st * 16) * ldv[q]);
  }
}
template <int NF4, int RG>
DEVI void stage_commit(float* buf, int nsteps, int tid, const f32x4 (&rg)[RG]) {
#pragma unroll
  for (int q = 0; q < RG; ++q) {
    int flat = tid + q * 256;
    if (flat < nsteps * NF4) ((f32x4*)buf)[flat] = rg[q];
  }
}

template <int MODE>
DEVI void colrec_long(const float* wsf, const Seg (&sg)[4], int row0, int T, float gamma, float* outp, int ldo, float* stout, int st_ld,
                      float* smem) {
  constexpr int NF4 = 69, W = 276, RG = 5;
  const int tid = threadIdx.x & 255, w = tid >> 6, lane = tid & 63, c = lane >> 4, s = lane & 15;
  smem += (threadIdx.x >> 8) * (VB_BYTES / 4);
  float S[8];
#pragma unroll
  for (int i = 0; i < 8; ++i) S[i] = 0.f;
  float* buf0 = smem;
  float* buf1 = smem + 16 * 336;
  float* obuf = smem + 2 * 16 * 336;
  const int nst = (T + 15) / 16;
  f32x4 rgA[RG], rgB[RG];
  const float* sptr[RG];
  int sld[RG];
  stage_init<4, NF4, RG>(wsf, sg, row0, tid, sptr, sld);
  auto step = [&](const float* sp, float* ob, int tt) -> float {
    float4 a0 = *(const float4*)(sp + s * 8), a1 = *(const float4*)(sp + s * 8 + 4);
    float4 q0 = *(const float4*)(sp + 128 + s * 8), q1 = *(const float4*)(sp + 128 + s * 8 + 4);
    float a[8] = {a0.x, a0.y, a0.z, a0.w, a1.x, a1.y, a1.z, a1.w};
    float q[8] = {q0.x, q0.y, q0.z, q0.w, q1.x, q1.y, q1.z, q1.w};
    float val = sp[256 + w * 4 + c];
    float dA = gamma;
    if (MODE == 2) {
      val *= sp[272];
      dA = sp[273];
    }
    float o = 0.f;
#pragma unroll
    for (int i = 0; i < 8; ++i) {
      if (MODE == 0) S[i] = val + a[i] * (S[i] - val);
      else S[i] = dA * S[i] + a[i] * val;
      o += q[i] * S[i];
    }
    return red16(o);
  };
  auto run_stage = [&](const float* b, float* ob, int nthis) {
#pragma unroll 1
    for (int tt = 0; tt < nthis; tt += 4) {
      float o0 = step(b + tt * W, ob, tt);
      float o1 = step(b + (tt + 1) * W, ob, tt + 1);
      float o2 = step(b + (tt + 2) * W, ob, tt + 2);
      float o3 = step(b + (tt + 3) * W, ob, tt + 3);
      const int base = (s == 0) ? (tt * 16 + w * 4 + c) : (1024 + (tid & 255));
      const int st16 = (s == 0) ? 16 : 0;
      ob[base] = o0;
      ob[base + st16] = o1;
      ob[base + 2 * st16] = o2;
      ob[base + 3 * st16] = o3;
    }
  };
  auto write_out = [&](const float* ob, int st, int nthis) {
    if (tid < nthis * 4) {
      int t = tid >> 2, c4 = tid & 3;
      *(float4*)(outp + (size_t)(st * 16 + t) * ldo + c4 * 4) = *(const float4*)(ob + t * 16 + c4 * 4);
    }
  };
  auto nsteps = [&](int st) { return min(16, T - st * 16); };
  stage_issue<NF4, RG>(sptr, sld, 0, nsteps(0), tid, rgA);
  stage_commit<NF4, RG>(buf0, nsteps(0), tid, rgA);
  if (nst > 1) stage_issue<NF4, RG>(sptr, sld, 1, nsteps(1), tid, rgB);
  __syncthreads();
#pragma unroll 1
  for (int st = 0; st < nst; st += 2) {
    if (st + 2 < nst) stage_issue<NF4, RG>(sptr, sld, st + 2, nsteps(st + 2), tid, rgA);
    run_stage(buf0, obuf, nsteps(st));
    if (st + 1 < nst) stage_commit<NF4, RG>(buf1, nsteps(st + 1), tid, rgB);
    __syncthreads();
    write_out(obuf, st, nsteps(st));
    if (st + 1 < nst) {
      if (st + 3 < nst) stage_issue<NF4, RG>(sptr, sld, st + 3, nsteps(st + 3), tid, rgB);
      run_stage(buf1, obuf + 512, nsteps(st + 1));
      if (st + 2 < nst) stage_commit<NF4, RG>(buf0, nsteps(st + 2), tid, rgA);
      __syncthreads();
      write_out(obuf + 512, st + 1, nsteps(st + 1));
    }
  }
#pragma unroll
  for (int i = 0; i < 8; ++i) stout[(size_t)(s * 8 + i) * st_ld + w * 4 + c] = S[i];
  __syncthreads();
}

template <int MODE>
DEVI void colrec_short(const float* pa, int lda_, const float* pq, int ldq, const float* pc, int ldc, const float* pdt,
                       long row0, float gamma, const float* stin, float* stout, int st_ld, float* outp, int ldo,
                       float* smem) {
  const int tid = threadIdx.x & 255, lane = tid & 63;
  const int wid = __builtin_amdgcn_readfirstlane(tid >> 6);
  const int k0 = wid * 32;
  smem += (threadIdx.x >> 8) * (VB_BYTES / 4);
  float S[32];
#pragma unroll
  for (int i = 0; i < 32; ++i) S[i] = stin[(size_t)(k0 + i) * st_ld + lane];
  float aq[4], vv[4], dAv[4];
#pragma unroll
  for (int t = 0; t < 4; ++t) {
    long row = row0 + t;
    aq[t] = (lane < 32) ? pa[(size_t)row * lda_ + k0 + lane] : pq[(size_t)row * ldq + k0 + (lane - 32)];
    vv[t] = pc[(size_t)row * ldc + lane];
    dAv[t] = gamma;
    if (MODE == 2) {
      vv[t] *= pdt[(size_t)row * 64];
      dAv[t] = pdt[(size_t)row * 64 + 1];
    }
  }
#pragma unroll
  for (int t = 0; t < 4; ++t) {
    const float val = vv[t], dA = dAv[t];
    float o = 0.f;
#pragma unroll
    for (int i = 0; i < 32; ++i) {
      const float a = rlf_(aq[t], i), q = rlf_(aq[t], 32 + i);
      if (MODE == 0) S[i] = val + a * (S[i] - val);
      else S[i] = dA * S[i] + a * val;
      o += q * S[i];
    }
    smem[(wid * 4 + t) * 64 + lane] = o;
  }
#pragma unroll
  for (int i = 0; i < 32; ++i) stout[(size_t)(k0 + i) * st_ld + lane] = S[i];
  __syncthreads();
  {
    int t = tid >> 6;
    float sum = smem[(0 * 4 + t) * 64 + lane] + smem[(1 * 4 + t) * 64 + lane] + smem[(2 * 4 + t) * 64 + lane] +
                smem[(3 * 4 + t) * 64 + lane];
    outp[(size_t)(row0 + t) * ldo + lane] = sum;
  }
  __syncthreads();
}

DEVI void rwkv_item(const float* wsf, const Seg (&sg)[6], int row0, int T, const float* stin, float* stout, float* outp, int ldo,
                    float* smem) {
  constexpr int NF4 = 84, W = 336, RG = 6;
  const int tid = threadIdx.x & 255, w = tid >> 6, lane = tid & 63, rl = lane >> 4, sl = lane & 15;
  smem += (threadIdx.x >> 8) * (VB_BYTES / 4);
  const int il = w * 4 + rl;
  float S[4];
  if (stin) {
    float4 v = *(const float4*)(stin + il * 64 + sl * 4);
    S[0] = v.x; S[1] = v.y; S[2] = v.z; S[3] = v.w;
  } else {
    S[0] = S[1] = S[2] = S[3] = 0.f;
  }
  float* buf0 = smem;
  float* buf1 = smem + 16 * 336;
  float* obuf = smem + 2 * 16 * 336;
  const int nst = (T + 15) / 16;
  f32x4 rgA[RG], rgB[RG];
  const float* sptr[RG];
  int sld[RG];
  stage_init<6, NF4, RG>(wsf, sg, row0, tid, sptr, sld);
  auto run_stage = [&](const float* b, float* ob, int nthis) {
#pragma unroll 4
    for (int tt = 0; tt < nthis; ++tt) {
      const float* sp = b + tt * W;
      float4 r4 = *(const float4*)(sp + sl * 4);
      float4 w4 = *(const float4*)(sp + 64 + sl * 4);
      float4 k4 = *(const float4*)(sp + 128 + sl * 4);
      float4 n4 = *(const float4*)(sp + 192 + sl * 4);
      float4 m4 = *(const float4*)(sp + 256 + sl * 4);
      float vi = sp[320 + il];
      float sa = S[0] * n4.x + S[1] * n4.y + S[2] * n4.z + S[3] * n4.w;
      sa = -red16(sa);
      S[0] = S[0] * w4.x + sa * m4.x + vi * k4.x;
      S[1] = S[1] * w4.y + sa * m4.y + vi * k4.y;
      S[2] = S[2] * w4.z + sa * m4.z + vi * k4.z;
      S[3] = S[3] * w4.w + sa * m4.w + vi * k4.w;
      float y = S[0] * r4.x + S[1] * r4.y + S[2] * r4.z + S[3] * r4.w;
      y = red16(y);
      ob[(sl == 0) ? (tt * 16 + il) : (1024 + (tid & 255))] = y;
    }
  };
  auto write_out = [&](const float* ob, int st, int nthis) {
    if (tid < nthis * 4) {
      int t = tid >> 2, c4 = tid & 3;
      *(float4*)(outp + (size_t)(st * 16 + t) * ldo + c4 * 4) = *(const float4*)(ob + t * 16 + c4 * 4);
    }
  };
  auto nsteps = [&](int st) { return min(16, T - st * 16); };
  stage_issue<NF4, RG>(sptr, sld, 0, nsteps(0), tid, rgA);
  stage_commit<NF4, RG>(buf0, nsteps(0), tid, rgA);
  if (nst > 1) stage_issue<NF4, RG>(sptr, sld, 1, nsteps(1), tid, rgB);
  __syncthreads();
  __builtin_amdgcn_s_setprio(3);
#pragma unroll 1
  for (int st = 0; st < nst; st += 2) {
    if (st + 2 < nst) stage_issue<NF4, RG>(sptr, sld, st + 2, nsteps(st + 2), tid, rgA);
    run_stage(buf0, obuf, nsteps(st));
    if (st + 1 < nst) stage_commit<NF4, RG>(buf1, nsteps(st + 1), tid, rgB);
    __syncthreads();
    write_out(obuf, st, nsteps(st));
    if (st + 1 < nst) {
      if (st + 3 < nst) stage_issue<NF4, RG>(sptr, sld, st + 3, nsteps(st + 3), tid, rgB);
      run_stage(buf1, obuf + 512, nsteps(st + 1));
      if (st + 2 < nst) stage_commit<NF4, RG>(buf0, nsteps(st + 2), tid, rgA);
      __syncthreads();
      write_out(obuf + 512, st + 1, nsteps(st + 1));
    }
  }
  __builtin_amdgcn_s_setprio(0);
  *(float4*)(stout + il * 64 + sl * 4) = make_float4(S[0], S[1], S[2], S[3]);
  __syncthreads();
}

DEVI void phase_rec0(const Params& p, float* smem) {
  char* ws = p.ws;
  const float* PROJ = (const float*)(ws + OFF_PROJ);
  float* OMIX = (float*)(ws + OFF_OMIX);
  const float* wsf = (const float*)ws;
  constexpr int PO = (int)(OFF_PROJ / 4);
  for (int item = blockIdx.x * 2 + (threadIdx.x >> 8); item < 4608; item += gridDim.x * 2) {
    if (item < 256) {
      int b = item >> 6, h = (item >> 3) & 7, cb = item & 7;
      Seg sg[4] = {{PO + 1024 + h * 128, N0, 32}, {PO + h * 128, N0, 32}, {PO + 2048 + h * 128 + cb * 16, N0, 4},
                   {PO, N0, 1}};
      int row0 = b * TP;
      colrec_long<0>(wsf, sg, row0, TP, 0.f, OMIX + (size_t)row0 * 2048 + h * 128 + cb * 16, 2048,
                     p.out + O_HGP + (size_t)(b * 8 + h) * 128 * 128 + cb * 16, 128, smem);
    } else if (item < 512) {
      int it = item - 256;
      int b = it >> 6, h = (it >> 4) & 3, cb = it & 15;
      Seg sg[4] = {{PO + 4608 + h * 128, N0, 32}, {PO + 4096 + h * 128, N0, 32},
                   {PO + 5120 + h * 256 + cb * 16, N0, 4}, {PO, N0, 1}};
      int row0 = b * TP;
      float gamma = 1.0f - exp2f(-5.0f - (float)h);
      colrec_long<1>(wsf, sg, row0, TP, gamma, OMIX + (size_t)row0 * 2048 + 1024 + h * 256 + cb * 16, 2048,
                     p.out + O_RTP + (size_t)(b * 4 + h) * 128 * 256 + cb * 16, 256, smem);
    } else if (item < 2560) {
      int it = item - 512;
      int b = it >> 4, h = (it >> 1) & 7, cb = it & 1;
      long row0 = MPR + (long)b * 4;
      size_t so = (size_t)(b * 8 + h) * 128 * 128 + cb * 64;
      colrec_short<0>(PROJ + 1024 + h * 128, N0, PROJ + h * 128, N0, PROJ + 2048 + h * 128 + cb * 64, N0, nullptr, row0,
                      0.f, p.in[I_SHG] + so, p.out + O_HGS + so, 128, OMIX + h * 128 + cb * 64, 2048, smem);
    } else {
      int it = item - 2560;
      int b = it >> 4, h = (it >> 2) & 3, cb = it & 3;
      long row0 = MPR + (long)b * 4;
      size_t so = (size_t)(b * 4 + h) * 128 * 256 + cb * 64;
      float gamma = 1.0f - exp2f(-5.0f - (float)h);
      colrec_short<1>(PROJ + 4608 + h * 128, N0, PROJ + 4096 + h * 128, N0, PROJ + 5120 + h * 256 + cb * 64, N0, nullptr,
                      row0, gamma, p.in[I_SRT] + so, p.out + O_RTS + so, 256, OMIX + 1024 + h * 256 + cb * 64, 2048,
                      smem);
    }
  }
}

DEVI float4 ld4(const float* p) { return *(const float4*)p; }
DEVI void st_bf4(u16* p, float a, float b, float c, float d) {
  uint2 o;
  o.x = pack2(a, b);
  o.y = pack2(c, d);
  *(uint2*)p = o;
}
DEVI float wsum_u_(float v) {
  v = red16(v);
  return (rlf_(v, 0) + rlf_(v, 16)) + (rlf_(v, 32) + rlf_(v, 48));
}
DEVI float red32(float v) {
  v = red16(v);
  return v + __shfl_xor(v, 16, 64);
}
DEVI void phase_post0(const Params& p) {
  char* ws = p.ws;
  const float* PROJ = (const float*)(ws + OFF_PROJ);
  const float* OMIX = (const float*)(ws + OFF_OMIX);
  u16* MIXB = (u16*)(ws + OFF_MIXB);
  const float* ng = p.in[I_HNG];
  const int lane = threadIdx.x & 63;
  const int gw = blockIdx.x * 8 + (threadIdx.x >> 6), nw = gridDim.x * 8;
  const float4 g4 = ld4(ng + (lane & 31) * 4);
  for (int row = gw; row < M; row += nw) {
    const float* o = OMIX + (size_t)row * 2048;
    const float* pr = PROJ + (size_t)row * N0;
    u16* mo = MIXB + (size_t)row * 2048;
    float4 a[4], ga[4], bq[4], gb[4];
#pragma unroll
    for (int it = 0; it < 4; ++it) {
      int c = it * 256 + lane * 4;
      a[it] = ld4(o + c);
      ga[it] = ld4(pr + 3072 + c);
      bq[it] = ld4(o + 1024 + c);
      gb[it] = ld4(pr + 6144 + c);
    }
#pragma unroll
    for (int it = 0; it < 4; ++it) {
      int c = it * 256 + lane * 4;
      float ss = red32(a[it].x * a[it].x + a[it].y * a[it].y + a[it].z * a[it].z + a[it].w * a[it].w);
      float inv = rsqrtf(ss * (1.0f / 128.0f) + 1e-6f);
      st_bf4(mo + c, a[it].x * inv * g4.x * ga[it].x, a[it].y * inv * g4.y * ga[it].y, a[it].z * inv * g4.z * ga[it].z,
             a[it].w * inv * g4.w * ga[it].w);
      float mu = wsum_u_(bq[it].x + bq[it].y + bq[it].z + bq[it].w) * (1.0f / 256.0f);
      float dx = bq[it].x - mu, dy = bq[it].y - mu, dz = bq[it].z - mu, dw = bq[it].w - mu;
      float var = wsum_u_(dx * dx + dy * dy + dz * dz + dw * dw) * (1.0f / 256.0f);
      float iv = rsqrtf(var + 1e-5f);
      st_bf4(mo + 1024 + c, dx * iv * gb[it].x, dy * iv * gb[it].y, dz * iv * gb[it].z, dw * iv * gb[it].w);
    }
  }
}

DEVI void phase_ln(const Params& p, const float* addsrc, const float* g, const float* bta) {
  char* ws = p.ws;
  float* XF = (float*)(ws + OFF_XF);
  u16* XB = (u16*)(ws + OFF_XB);
  const int lane = threadIdx.x & 63;
  const int gw = blockIdx.x * 8 + (threadIdx.x >> 6), nw = gridDim.x * 8;
  for (int row = gw; row < M; row += nw) {
    float4* xr = (float4*)(XF + (size_t)row * 2048);
    const float4* ar = (const float4*)(addsrc + (size_t)row * 2048);
    float v[32];
    float s = 0.f;
#pragma unroll
    for (int i = 0; i < 8; ++i) {
      float4 x = xr[i * 64 + lane], a = ar[i * 64 + lane];
      v[i * 4 + 0] = ALPHA * x.x + a.x;
      v[i * 4 + 1] = ALPHA * x.y + a.y;
      v[i * 4 + 2] = ALPHA * x.z + a.z;
      v[i * 4 + 3] = ALPHA * x.w + a.w;
      s += v[i * 4 + 0] + v[i * 4 + 1] + v[i * 4 + 2] + v[i * 4 + 3];
    }
    float mu = wsum(s) * (1.0f / 2048.0f);
    float q = 0.f;
#pragma unroll
    for (int i = 0; i < 32; ++i) {
      v[i] -= mu;
      q += v[i] * v[i];
    }
    float inv = rsqrtf(wsum(q) * (1.0f / 2048.0f) + 1e-5f);
#pragma unroll
    for (int i = 0; i < 8; ++i) {
      float4 gg = ((const float4*)g)[i * 64 + lane], bb = ((const float4*)bta)[i * 64 + lane];
      float4 y;
      y.x = v[i * 4 + 0] * inv * gg.x + bb.x;
      y.y = v[i * 4 + 1] * inv * gg.y + bb.y;
      y.z = v[i * 4 + 2] * inv * gg.z + bb.z;
      y.w = v[i * 4 + 3] * inv * gg.w + bb.w;
      xr[i * 64 + lane] = y;
      uint2 o;
      o.x = pack2(y.x, y.y);
      o.y = pack2(y.z, y.w);
      ((uint2*)(XB + (size_t)row * 2048))[i * 64 + lane] = o;
    }
  }
}

typedef __attribute__((ext_vector_type(2))) __bf16 bf2_t;
typedef __attribute__((ext_vector_type(2))) float f32x2;
DEVI float dot2bf(unsigned a, unsigned b, float acc) {
  return __builtin_amdgcn_fdot2_f32_bf16(__builtin_bit_cast(bf2_t, a), __builtin_bit_cast(bf2_t, b), acc, false);
}
template <int CTRL>
DEVI int dppi(int v) {
  return __builtin_amdgcn_update_dpp(v, v, CTRL, 0xF, 0xF, false);
}
DEVI int wmax_i(int v) {
  v = max(v, dppi<0xB1>(v));
  v = max(v, dppi<0x4E>(v));
  v = max(v, dppi<0x141>(v));
  v = max(v, dppi<0x140>(v));
  int a = __builtin_amdgcn_readlane(v, 0), b = __builtin_amdgcn_readlane(v, 16);
  int c = __builtin_amdgcn_readlane(v, 32), d = __builtin_amdgcn_readlane(v, 48);
  return max(max(a, b), max(c, d));
}
DEVI float rlf(float v, int l) { return __int_as_float(__builtin_amdgcn_readlane(__float_as_int(v), l)); }
DEVI float wsum_u(float v) {
  v = red16(v);
  return (rlf(v, 0) + rlf(v, 16)) + (rlf(v, 32) + rlf(v, 48));
}
DEVI int fkey(float f) {
  int u = __float_as_int(f);
  return u ^ ((u >> 31) & 0x7fffffff);
}
DEVI float keyf(int k) { return __int_as_float(k ^ ((k >> 31) & 0x7fffffff)); }

DEVI void conv_fp8_rows(const float* __restrict__ src, unsigned char* __restrict__ dst, float* __restrict__ scales) {
  const int lane = threadIdx.x & 63;
  const int gw = blockIdx.x * 8 + (threadIdx.x >> 6), nw = gridDim.x * 8;
  for (int e = gw; e < 16384; e += nw) {
    const float* r = src + (size_t)e * 2048;
    float4 v[8];
    float am = 0.f;
#pragma unroll
    for (int q = 0; q < 8; ++q) {
      v[q] = *(const float4*)(r + (q >> 2) * 1024 + lane * 16 + (q & 3) * 4);
      am = fmaxf(am, fmaxf(fmaxf(fabsf(v[q].x), fabsf(v[q].y)), fmaxf(fabsf(v[q].z), fabsf(v[q].w))));
    }
    float amax = __int_as_float(wmax_i(__float_as_int(am)));
    float inv = (amax > 0.f) ? (440.0f / amax) : 0.f;
    float scale = (amax > 0.f) ? (amax * (1.0f / 440.0f)) : 1.0f;
#pragma unroll
    for (int j = 0; j < 2; ++j) {
      u32x4 o;
#pragma unroll
      for (int k = 0; k < 4; ++k) {
        float4 t = v[j * 4 + k];
        int pk = 0;
        pk = __builtin_amdgcn_cvt_pk_fp8_f32(t.x * inv, t.y * inv, pk, false);
        pk = __builtin_amdgcn_cvt_pk_fp8_f32(t.z * inv, t.w * inv, pk, true);
        o[k] = (unsigned)pk;
      }
      *(u32x4*)(dst + (size_t)e * 2048 + j * 1024 + lane * 16) = o;
    }
    if (lane == 0) scales[e] = scale;
  }
}

DEVI void phase_peer(const Params& p, int layer, bool final_out) {
  char* ws = p.ws;
  const float* SC = (const float*)(ws + OFF_GOUT);
  float* XF = (float*)(ws + OFF_XF);
  u16* XB = (u16*)(ws + OFF_XB);
  const unsigned char* UB = (const unsigned char*)(ws + OFF_UB);
  const unsigned char* VB = (const unsigned char*)(ws + OFF_VB);
  const float* USC = (const float*)(ws + OFF_USC);
  const float* VSC = (const float*)(ws + OFF_VSC);
  const float* g = p.in[I_LNG] + (size_t)(layer * 2 + 1) * D;
  const float* bta = p.in[I_LNB] + (size_t)(layer * 2 + 1) * D;
  const int lane = threadIdx.x & 63;
  const int gw = blockIdx.x * 8 + (threadIdx.x >> 6), nw = gridDim.x * 8;
  constexpr int KMIN = (int)0x80000000;
  for (int row = gw; row < M; row += nw) {
    const float* sr = SC + (size_t)row * 2048;
    int eidx0 = 0, eidx1 = 0;
    float gate0 = 0.f, gate1 = 0.f;
#pragma unroll 1
    for (int hp = 0; hp < 2; ++hp) {
      int hd[4] = {hp * 2, hp * 2 + 1, hp * 2 + 4, hp * 2 + 5};
      int ka[4][2], kb[4][2], my[4][2];
#pragma unroll
      for (int n = 0; n < 4; ++n) {
        const float* sp = sr + hd[n] * 256;
#pragma unroll
        for (int c = 0; c < 2; ++c) {
          ka[n][c] = (fkey(sp[c * 128 + lane]) & ~127) | (127 - lane);
          kb[n][c] = (fkey(sp[c * 128 + 64 + lane]) & ~127) | (63 - lane);
          my[n][c] = KMIN;
        }
      }
#pragma unroll 1
      for (int r = 0; r < 16; ++r) {
#pragma unroll
        for (int n = 0; n < 4; ++n)
#pragma unroll
          for (int c = 0; c < 2; ++c) {
            int K = wmax_i(max(ka[n][c], kb[n][c]));
            my[n][c] = (lane == r) ? K : my[n][c];
            ka[n][c] = (ka[n][c] == K) ? KMIN : ka[n][c];
            kb[n][c] = (kb[n][c] == K) ? KMIN : kb[n][c];
          }
      }
      const int jb = (lane & 3) * 4;
      int cc[4][4], myk[4];
      int ti0[4], ti1[4];
#pragma unroll
      for (int n = 0; n < 4; ++n) {
        const float ts0 = keyf(my[n][0] & ~127), ts1 = keyf(my[n][1] & ~127);
        ti0[n] = 127 - (my[n][0] & 127);
        ti1[n] = 127 - (my[n][1] & 127);
        const float s0 = __shfl(ts0, lane >> 2, 64);
#pragma unroll
        for (int q = 0; q < 4; ++q) cc[n][q] = (fkey(s0 + __shfl(ts1, jb + q, 64)) & ~255) | (255 - (lane * 4 + q));
        myk[n] = KMIN;
      }
#pragma unroll 1
      for (int r = 0; r < 16; ++r) {
#pragma unroll
        for (int n = 0; n < 4; ++n) {
          int K = wmax_i(max(max(cc[n][0], cc[n][1]), max(cc[n][2], cc[n][3])));
          myk[n] = (lane == r) ? K : myk[n];
#pragma unroll
          for (int q = 0; q < 4; ++q) cc[n][q] = (cc[n][q] == K) ? KMIN : cc[n][q];
        }
      }
#pragma unroll
      for (int n = 0; n < 4; ++n) {
        const float bs = keyf(myk[n] & ~255);
        const int bf = 255 - (myk[n] & 255);
        const int e = __shfl(ti0[n], (bf >> 4) & 15, 64) * 128 + __shfl(ti1[n], bf & 15, 64);
        const float ev = (lane < 16) ? expf(bs - rlf(bs, 0)) : 0.f;
        const float gt = ev / wsum_u(ev);
        const int e_b = __shfl(e, lane & 15, 64);
        const float g_b = __shfl(gt, lane & 15, 64);
        const int hh = hp * 2 + (n & 1);
        if ((lane >> 4) == hh) {
          if (n < 2) { eidx0 = e_b; gate0 = g_b; }
          else { eidx1 = e_b; gate1 = g_b; }
        }
      }
    }
    float dv0 = 0.f, dv1 = 0.f;
    {
      float xf[32];
      {
        const float4* xr = (const float4*)(XF + (size_t)row * 2048);
#pragma unroll
        for (int q = 0; q < 8; ++q) {
          float4 t = xr[(q >> 2) * 256 + lane * 4 + (q & 3)];
          xf[q * 4 + 0] = t.x; xf[q * 4 + 1] = t.y; xf[q * 4 + 2] = t.z; xf[q * 4 + 3] = t.w;
        }
      }
      constexpr int R = 8;
      u32x4 w[R][2];
      float sc[R];
      auto load_row = [&](int pidx, u32x4(&wr)[2], float& scv) {
        int src = (pidx < 64) ? eidx0 : eidx1;
        int e = __builtin_amdgcn_readlane(src, pidx & 63);
        const u32x4* ur = (const u32x4*)(UB + (size_t)e * 2048);
        wr[0] = ur[lane];
        wr[1] = ur[64 + lane];
        scv = USC[e];
      };
#pragma unroll
      for (int u = 0; u < R; ++u) load_row(u, w[u], sc[u]);
#pragma unroll 1
      for (int p0 = 0; p0 < 128; p0 += R) {
#pragma unroll
        for (int u = 0; u < R; ++u) {
          float d = 0.f;
#pragma unroll
          for (int j = 0; j < 2; ++j) {
#pragma unroll
            for (int k = 0; k < 4; ++k) {
              int dw = (int)w[u][j][k];
              f32x2 lo = __builtin_amdgcn_cvt_pk_f32_fp8(dw, false);
              f32x2 hi = __builtin_amdgcn_cvt_pk_f32_fp8(dw, true);
              d += lo.x * xf[j * 16 + k * 4 + 0];
              d += lo.y * xf[j * 16 + k * 4 + 1];
              d += hi.x * xf[j * 16 + k * 4 + 2];
              d += hi.y * xf[j * 16 + k * 4 + 3];
            }
          }
          float scu = sc[u];
          if (p0 + R < 128) load_row(p0 + R + u, w[u], sc[u]);
          d = wsum_u(d) * scu;
          int pl = (p0 + u) & 63;
          if (p0 < 64) dv0 = (lane == pl) ? d : dv0;
          else dv1 = (lane == pl) ? d : dv1;
          __builtin_amdgcn_sched_barrier(0);
        }
      }
    }
    float coef0 = 0.5f * dv0 * (1.0f + erff(dv0 * 0.70710678118f)) * gate0;
    float coef1 = 0.5f * dv1 * (1.0f + erff(dv1 * 0.70710678118f)) * gate1;
    f32x2 o2[16];
#pragma unroll
    for (int i = 0; i < 16; ++i) o2[i] = f32x2{0.f, 0.f};
    {
      constexpr int R = 8;
      u32x4 w[R][2];
      float sc[R];
      auto load_row = [&](int pidx, u32x4(&wr)[2], float& scv) {
        int src = (pidx < 64) ? eidx0 : eidx1;
        int e = __builtin_amdgcn_readlane(src, pidx & 63);
        const u32x4* vr = (const u32x4*)(VB + (size_t)e * 2048);
        wr[0] = vr[lane];
        wr[1] = vr[64 + lane];
        scv = VSC[e];
      };
#pragma unroll
      for (int u = 0; u < R; ++u) load_row(u, w[u], sc[u]);
#pragma unroll 1
      for (int p0 = 0; p0 < 128; p0 += R) {
        float cfs = (p0 < 64) ? coef0 : coef1;
#pragma unroll
        for (int u = 0; u < R; ++u) {
          float c = rlf(cfs, (p0 + u) & 63) * sc[u];
          f32x2 cc = f32x2{c, c};
#pragma unroll
          for (int j = 0; j < 2; ++j) {
#pragma unroll
            for (int k = 0; k < 4; ++k) {
              int dw = (int)w[u][j][k];
              o2[j * 8 + k * 2 + 0] += cc * __builtin_amdgcn_cvt_pk_f32_fp8(dw, false);
              o2[j * 8 + k * 2 + 1] += cc * __builtin_amdgcn_cvt_pk_f32_fp8(dw, true);
            }
          }
          if (p0 + R < 128) load_row(p0 + R + u, w[u], sc[u]);
          __builtin_amdgcn_sched_barrier(0);
        }
      }
    }
    float o[32];
#pragma unroll
    for (int i = 0; i < 16; ++i) {
      o[2 * i] = o2[i].x;
      o[2 * i + 1] = o2[i].y;
    }
    float s = 0.f;
    {
      const float4* xr = (const float4*)(XF + (size_t)row * 2048);
#pragma unroll
      for (int q = 0; q < 8; ++q) {
        float4 t = xr[(q >> 2) * 256 + lane * 4 + (q & 3)];
        o[q * 4 + 0] += ALPHA * t.x; o[q * 4 + 1] += ALPHA * t.y; o[q * 4 + 2] += ALPHA * t.z; o[q * 4 + 3] += ALPHA * t.w;
      }
#pragma unroll
      for (int i = 0; i < 32; ++i) s += o[i];
    }
    float mu = wsum_u(s) * (1.0f / 2048.0f);
    float q = 0.f;
#pragma unroll
    for (int i = 0; i < 32; ++i) {
      o[i] -= mu;
      q += o[i] * o[i];
    }
    float inv = rsqrtf(wsum_u(q) * (1.0f / 2048.0f) + 1e-5f);
    float* dstf;
    if (final_out) {
      if (row < MPR) {
        int b = row / TP, t = row % TP;
        dstf = (t >= 16) ? (p.out + O_YP + ((size_t)b * 2048 + (t - 16)) * D) : nullptr;
      } else {
        dstf = p.out + O_YS + (size_t)(row - MPR) * D;
      }
    } else {
      dstf = XF + (size_t)row * 2048;
    }
#pragma unroll
    for (int j = 0; j < 2; ++j) {
      float yv[16];
#pragma unroll
      for (int k = 0; k < 4; ++k) {
        float4 gv = *(const float4*)(g + j * 1024 + lane * 16 + k * 4);
        float4 bv = *(const float4*)(bta + j * 1024 + lane * 16 + k * 4);
        float4 y;
        y.x = o[j * 16 + k * 4 + 0] * inv * gv.x + bv.x;
        y.y = o[j * 16 + k * 4 + 1] * inv * gv.y + bv.y;
        y.z = o[j * 16 + k * 4 + 2] * inv * gv.z + bv.z;
        y.w = o[j * 16 + k * 4 + 3] * inv * gv.w + bv.w;
        if (dstf) *(float4*)(dstf + j * 1024 + lane * 16 + k * 4) = y;
        yv[k * 4 + 0] = y.x; yv[k * 4 + 1] = y.y; yv[k * 4 + 2] = y.z; yv[k * 4 + 3] = y.w;
      }
      if (!final_out) {
        uint4* xb = (uint4*)(XB + (size_t)row * 2048 + j * 1024 + lane * 16);
        xb[0] = make_uint4(pack2(yv[0], yv[1]), pack2(yv[2], yv[3]), pack2(yv[4], yv[5]), pack2(yv[6], yv[7]));
        xb[1] = make_uint4(pack2(yv[8], yv[9]), pack2(yv[10], yv[11]), pack2(yv[12], yv[13]), pack2(yv[14], yv[15]));
      }
    }
  }
}

DEVI float4 f4mul(float4 a, float4 b) { return make_float4(a.x * b.x, a.y * b.y, a.z * b.z, a.w * b.w); }
DEVI void row_info(int row, bool& prompt, int& b, int& t, int& T) {
  prompt = row < MPR;
  if (prompt) { b = row / TP; t = row - b * TP; T = TP; }
  else { b = (row - MPR) >> 2; t = (row - MPR) & 3; T = 4; }
}
DEVI void phase_pre1(const Params& p) {
  char* ws = p.ws;
  const float* PROJ = (const float*)(ws + OFF_PROJ);
  float* XC = (float*)(ws + OFF_GOUT);
  float* RKV = (float*)(ws + OFF_RKV);
  u16* LRA = (u16*)(ws + OFF_LRA);
  u16* LRB = (u16*)(ws + OFF_LRB);
  u16* LRG = (u16*)(ws + OFF_LRG);
  const float* cw = p.in[I_CVW];
  const float* cbias = p.in[I_CVB];
  const float* mu = p.in[I_MU];
  const int gtid = blockIdx.x * 512 + threadIdx.x, nthr = gridDim.x * 512;
#pragma unroll 2
  for (int idx = gtid; idx < M * 384; idx += nthr) {
    int row = idx / 384, c = (idx - row * 384) * 4;
    bool prompt; int b, t, T;
    row_info(row, prompt, b, t, T);
    float4 xv[4];
#pragma unroll
    for (int jj = 0; jj < 4; ++jj) {
      int tt = t - 3 + jj;
      if (tt >= 0) xv[jj] = ld4(PROJ + (size_t)(row - 3 + jj) * N1 + 1024 + c);
      else if (prompt) xv[jj] = make_float4(0.f, 0.f, 0.f, 0.f);
      else xv[jj] = ld4(p.in[I_SCV] + (size_t)(b * 3 + (tt + 3)) * 1536 + c);
    }
    float4 acc = ld4(cbias + c);
#pragma unroll
    for (int jj = 0; jj < 4; ++jj) {
      float4 w = ld4(cw + jj * 1536 + c);
      acc.x += xv[jj].x * w.x; acc.y += xv[jj].y * w.y; acc.z += xv[jj].z * w.z; acc.w += xv[jj].w * w.w;
    }
    *(float4*)(XC + (size_t)row * 1536 + c) = make_float4(siluf_(acc.x), siluf_(acc.y), siluf_(acc.z), siluf_(acc.w));
    if (t >= T - 3) {
      float* co = prompt ? (p.out + O_CVP) : (p.out + O_CVS);
      *(float4*)(co + (size_t)(b * 3 + (t - (T - 3))) * 1536 + c) = xv[3];
    }
  }
#pragma unroll 2
  for (int idx = gtid; idx < M * 840; idx += nthr) {
    int row = idx / 840, c = (idx - row * 840) * 4;
    bool prompt; int b, t, T;
    row_info(row, prompt, b, t, T);
    float4 cur = ld4(PROJ + (size_t)row * N1 + 2560 + c);
    float4 prev;
    if (t > 0) prev = ld4(PROJ + (size_t)(row - 1) * N1 + 2560 + c);
    else if (prompt) prev = make_float4(0.f, 0.f, 0.f, 0.f);
    else prev = ld4(p.in[I_SSH] + (size_t)b * 3360 + c);
    float4 m4 = ld4(mu + c);
    float4 mx;
    mx.x = cur.x + (prev.x - cur.x) * m4.x; mx.y = cur.y + (prev.y - cur.y) * m4.y;
    mx.z = cur.z + (prev.z - cur.z) * m4.z; mx.w = cur.w + (prev.w - cur.w) * m4.w;
    if (c < 3072) *(float4*)(RKV + (size_t)row * 3072 + c) = mx;
    else if (c < 3136) st_bf4(LRA + (size_t)row * 64 + (c - 3072), tanhf(mx.x), tanhf(mx.y), tanhf(mx.z), tanhf(mx.w));
    else if (c < 3200) st_bf4(LRB + (size_t)row * 64 + (c - 3136), mx.x, mx.y, mx.z, mx.w);
    else st_bf4(LRG + (size_t)row * 192 + (c - 3200), sigmoidf_(mx.x), sigmoidf_(mx.y), sigmoidf_(mx.z), sigmoidf_(mx.w));
    if (t == T - 1) {
      float* so = prompt ? (p.out + O_SHP) : (p.out + O_SHS);
      *(float4*)(so + (size_t)b * 3360 + c) = cur;
    }
  }
  for (int idx = gtid; idx < M * 4; idx += nthr) {
    int row = idx >> 2, k = idx & 3;
    ((uint4*)(LRG + (size_t)row * 192 + 160))[k] = make_uint4(0, 0, 0, 0);
  }
}

DEVI void phase_pre1c(const Params& p) {
  char* ws = p.ws;
  float* RKV = (float*)(ws + OFF_RKV);
  const float* AA = (const float*)(ws + OFF_AA);
  float* KK = (float*)(ws + OFF_QB);
  float* KKA = (float*)(ws + OFF_MIXB);
  float* BON = (float*)(ws + OFF_BON);
  const float* k_k = p.in[I_KK];
  const float* k_a = p.in[I_KA];
  const float* r_k = p.in[I_RK];
  const int lane = threadIdx.x & 63;
  const int gw = blockIdx.x * 8 + (threadIdx.x >> 6), nw = gridDim.x * 8;
  for (int row = gw; row < M; row += nw) {
    float4 k4[4], r4[4], a4[4];
#pragma unroll
    for (int it = 0; it < 4; ++it) {
      int c = it * 256 + lane * 4;
      k4[it] = ld4(RKV + (size_t)row * 3072 + 1024 + c);
      r4[it] = ld4(RKV + (size_t)row * 3072 + c);
      a4[it] = ld4(AA + (size_t)row * 1024 + c);
    }
#pragma unroll
    for (int it = 0; it < 4; ++it) {
      int c = it * 256 + lane * 4;
      float4 kk4 = ld4(k_k + c), ka4 = ld4(k_a + c), rk4 = ld4(r_k + c);
      float4 k = k4[it], r = r4[it], a = a4[it];
      float4 kr = f4mul(k, kk4);
      float ss = red16(kr.x * kr.x + kr.y * kr.y + kr.z * kr.z + kr.w * kr.w);
      float inv = 1.0f / fmaxf(sqrtf(ss), 1e-12f);
      float4 kk = make_float4(kr.x * inv, kr.y * inv, kr.z * inv, kr.w * inv);
      float4 kp;
      kp.x = k.x * (1.0f + (a.x - 1.0f) * ka4.x); kp.y = k.y * (1.0f + (a.y - 1.0f) * ka4.y);
      kp.z = k.z * (1.0f + (a.z - 1.0f) * ka4.z); kp.w = k.w * (1.0f + (a.w - 1.0f) * ka4.w);
      float bon = red16(r.x * kp.x * rk4.x + r.y * kp.y * rk4.y + r.z * kp.z * rk4.z + r.w * kp.w * rk4.w);
      *(float4*)(KK + (size_t)row * 1024 + c) = kk;
      *(float4*)(KKA + (size_t)row * 1024 + c) = f4mul(kk, a);
      *(float4*)(RKV + (size_t)row * 3072 + 1024 + c) = kp;
      if ((lane & 15) == 0) BON[(size_t)row * 16 + it * 4 + (lane >> 4)] = bon;
    }
  }
}

DEVI void rwkv_short(const float* __restrict__ RKV, const float* __restrict__ DEC, const float* __restrict__ KK,
                     const float* __restrict__ KKA, int h, int rb, int row0, const float* __restrict__ stin,
                     float* __restrict__ stout, float* __restrict__ outp) {
  const int tid = threadIdx.x & 255, w = tid >> 6, lane = tid & 63, rl = lane >> 4, sl = lane & 15;
  const int il = w * 4 + rl;
  float4 sv = *(const float4*)(stin + il * 64 + sl * 4);
  float S[4] = {sv.x, sv.y, sv.z, sv.w};
  float4 r4[4], w4[4], k4[4], n4[4], m4[4];
  float vi[4];
#pragma unroll
  for (int t = 0; t < 4; ++t) {
    const size_t row = (size_t)(row0 + t);
    r4[t] = *(const float4*)(RKV + row * 3072 + h * 64 + sl * 4);
    w4[t] = *(const float4*)(DEC + row * 1024 + h * 64 + sl * 4);
    k4[t] = *(const float4*)(RKV + row * 3072 + 1024 + h * 64 + sl * 4);
    n4[t] = *(const float4*)(KK + row * 1024 + h * 64 + sl * 4);
    m4[t] = *(const float4*)(KKA + row * 1024 + h * 64 + sl * 4);
    vi[t] = RKV[row * 3072 + 2048 + h * 64 + rb * 16 + il];
  }
#pragma unroll
  for (int t = 0; t < 4; ++t) {
    float sa = S[0] * n4[t].x + S[1] * n4[t].y + S[2] * n4[t].z + S[3] * n4[t].w;
    sa = -red16(sa);
    S[0] = S[0] * w4[t].x + sa * m4[t].x + vi[t] * k4[t].x;
    S[1] = S[1] * w4[t].y + sa * m4[t].y + vi[t] * k4[t].y;
    S[2] = S[2] * w4[t].z + sa * m4[t].z + vi[t] * k4[t].z;
    S[3] = S[3] * w4[t].w + sa * m4[t].w + vi[t] * k4[t].w;
    float y = S[0] * r4[t].x + S[1] * r4[t].y + S[2] * r4[t].z + S[3] * r4[t].w;
    y = red16(y);
    if (sl == 0) outp[(size_t)t * 2048 + il] = y;
  }
  *(float4*)(stout + il * 64 + sl * 4) = make_float4(S[0], S[1], S[2], S[3]);
}

DEVI void phase_rec1(const Params& p, float* smem) {
  char* ws = p.ws;
  const float* XC = (const float*)(ws + OFF_GOUT);
  const float* RKV = (const float*)(ws + OFF_RKV);
  const float* DEC = (const float*)(ws + OFF_DEC);
  const float* KK = (const float*)(ws + OFF_QB);
  const float* KKA = (const float*)(ws + OFF_MIXB);
  const float* DTA = (const float*)(ws + OFF_DTA);
  float* OMIX = (float*)(ws + OFF_OMIX);
  const float* wsf = (const float*)ws;
  constexpr int XO = (int)(OFF_GOUT / 4), DO = (int)(OFF_DTA / 4), RO = (int)(OFF_RKV / 4), CO = (int)(OFF_DEC / 4),
                KO = (int)(OFF_QB / 4), AO = (int)(OFF_MIXB / 4);
  const int half = threadIdx.x >> 8;
  for (int li = blockIdx.x; li < 256; li += gridDim.x) {
    if (half == 0) {
      int b = li >> 6, h = (li >> 2) & 15, cb = li & 3;
      int g = h >> 3;
      Seg sg[4] = {{XO + 1024 + g * 128, 1536, 32}, {XO + 1280 + g * 128, 1536, 32}, {XO + h * 64 + cb * 16, 1536, 4},
                   {DO + h * 4, 64, 1}};
      int row0 = b * TP;
      colrec_long<2>(wsf, sg, row0, TP, 0.f, OMIX + (size_t)row0 * 2048 + h * 64 + cb * 16, 2048,
                     p.out + O_SSP + (size_t)(b * 16 + h) * 128 * 64 + cb * 16, 64, smem);
    } else {
      int b = li >> 6, h = (li >> 2) & 15, rb = li & 3;
      int row0 = b * TP;
      Seg sg[6] = {{RO + h * 64, 3072, 16}, {CO + h * 64, 1024, 16}, {RO + 1024 + h * 64, 3072, 16},
                   {KO + h * 64, 1024, 16}, {AO + h * 64, 1024, 16}, {RO + 2048 + h * 64 + rb * 16, 3072, 4}};
      size_t so = ((size_t)(b * 16 + h) * 64 + rb * 16) * 64;
      rwkv_item(wsf, sg, row0, TP, nullptr, p.out + O_WKP + so, OMIX + (size_t)row0 * 2048 + 1024 + h * 64 + rb * 16, 2048, smem);
    }
  }
  for (int it = blockIdx.x * 2 + half; it < 2048; it += gridDim.x * 2) {
    int b = it >> 4, h = it & 15;
    int g = h >> 3;
    long row0 = MPR + (long)b * 4;
    size_t so = (size_t)(b * 16 + h) * 128 * 64;
    colrec_short<2>(XC + 1024 + g * 128, 1536, XC + 1280 + g * 128, 1536, XC + h * 64, 1536, DTA + h * 4, row0, 0.f,
                    p.in[I_SSM] + so, p.out + O_SSS + so, 64, OMIX + h * 64, 2048, smem);
  }
  for (int it = blockIdx.x * 2 + half; it < 8192; it += gridDim.x * 2) {
    int b = it >> 6, h = (it >> 2) & 15, rb = it & 3;
    int row0 = MPR + b * 4;
    size_t so = ((size_t)(b * 16 + h) * 64 + rb * 16) * 64;
    rwkv_short(RKV, DEC, KK, KKA, h, rb, row0, p.in[I_SWK] + so, p.out + O_WKS + so,
               OMIX + (size_t)row0 * 2048 + 1024 + h * 64 + rb * 16);
  }
}

DEVI void phase_post1(const Params& p) {
  char* ws = p.ws;
  const float* PROJ = (const float*)(ws + OFF_PROJ);
  const float* OMIX = (const float*)(ws + OFF_OMIX);
  const float* XC = (const float*)(ws + OFF_GOUT);
  const float* RKV = (const float*)(ws + OFF_RKV);
  const float* GG = (const float*)(ws + OFF_GG);
  const float* BON = (const float*)(ws + OFF_BON);
  u16* MIXB = (u16*)(ws + OFF_MIXB);
  const float* dsk = p.in[I_DSK];
  const float* sng = p.in[I_SNG];
  const float* lxg = p.in[I_LXG];
  const float* lxb = p.in[I_LXB];
  const int lane = threadIdx.x & 63;
  const int gw = blockIdx.x * 8 + (threadIdx.x >> 6), nw = gridDim.x * 8;
  for (int row = gw; row < M; row += nw) {
    const float* o = OMIX + (size_t)row * 2048;
    u16* mo = MIXB + (size_t)row * 2048;
    float4 oc[4], xc[4], z[4], y[4], v[4], gg[4];
    float bn[4];
#pragma unroll
    for (int it = 0; it < 4; ++it) {
      int c = it * 256 + lane * 4;
      oc[it] = ld4(o + c);
      xc[it] = ld4(XC + (size_t)row * 1536 + c);
      z[it] = ld4(PROJ + (size_t)row * N1 + c);
      y[it] = ld4(o + 1024 + c);
      v[it] = ld4(RKV + (size_t)row * 3072 + 2048 + c);
      gg[it] = ld4(GG + (size_t)row * 1024 + c);
      bn[it] = BON[(size_t)row * 16 + it * 4 + (lane >> 4)];
    }
    float4 val[4];
    float ssq[4];
#pragma unroll
    for (int it = 0; it < 4; ++it) {
      float ds = dsk[it * 4 + (lane >> 4)];
      val[it].x = (oc[it].x + xc[it].x * ds) * z[it].x;
      val[it].y = (oc[it].y + xc[it].y * ds) * z[it].y;
      val[it].z = (oc[it].z + xc[it].z * ds) * z[it].z;
      val[it].w = (oc[it].w + xc[it].w * ds) * z[it].w;
      ssq[it] = val[it].x * val[it].x + val[it].y * val[it].y + val[it].z * val[it].z + val[it].w * val[it].w;
    }
    float inv0 = rsqrtf(wsum_u_(ssq[0] + ssq[1]) * (1.0f / 512.0f) + 1e-6f);
    float inv1 = rsqrtf(wsum_u_(ssq[2] + ssq[3]) * (1.0f / 512.0f) + 1e-6f);
#pragma unroll
    for (int it = 0; it < 4; ++it) {
      int c = it * 256 + lane * 4;
      float inv = (it < 2) ? inv0 : inv1;
      float4 sg = ld4(sng + c);
      st_bf4(mo + c, val[it].x * inv * sg.x, val[it].y * inv * sg.y, val[it].z * inv * sg.z, val[it].w * inv * sg.w);
      float mu = red16(y[it].x + y[it].y + y[it].z + y[it].w) * (1.0f / 64.0f);
      float dx = y[it].x - mu, dy = y[it].y - mu, dz = y[it].z - mu, dw = y[it].w - mu;
      float var = red16(dx * dx + dy * dy + dz * dz + dw * dw) * (1.0f / 64.0f);
      float iv = rsqrtf(var + 64e-5f);
      float4 lg = ld4(lxg + c), lb = ld4(lxb + c);
      float y0 = (dx * iv * lg.x + lb.x + bn[it] * v[it].x) * gg[it].x;
      float y1 = (dy * iv * lg.y + lb.y + bn[it] * v[it].y) * gg[it].y;
      float y2 = (dz * iv * lg.z + lb.z + bn[it] * v[it].z) * gg[it].z;
      float y3 = (dw * iv * lg.w + lb.w + bn[it] * v[it].w) * gg[it].w;
      st_bf4(mo + 1024 + c, y0, y1, y2, y3);
    }
  }
}

#define XB_TMO      128
#define XB_XCNT(j)  (256  + 64 * (j))
#define XB_XSUB(j)  (1280 + 64 * (j))
#define XB_XGEN(j)  (2304 + 64 * (j))
#define XB_TOP      3328
#define XB_TOPGEN   3392
#define XCD_BAR_WORDS 3456
#define XB_SPIN_CAP (1u << 18)
#define LAS __attribute__((address_space(3)))

__device__ __forceinline__ unsigned xb_ld(unsigned* p)              { return __hip_atomic_load(p, __ATOMIC_RELAXED, __HIP_MEMORY_SCOPE_AGENT); }
__device__ __forceinline__ unsigned xb_add(unsigned* p, unsigned v) { return __hip_atomic_fetch_add(p, v, __ATOMIC_RELAXED, __HIP_MEMORY_SCOPE_AGENT); }
__device__ __forceinline__ unsigned xb_xcc_id() { return (unsigned)__builtin_amdgcn_s_getreg((3 << 11) | 20) & 0xFu; }
#define XB_SPIN(cond, bar) do { unsigned _sp = 0; while (cond) { __builtin_amdgcn_s_sleep(1); \
    if ((++_sp & 255u) == 0u) { if (xb_ld(&(bar)[XB_TMO])) break; if (_sp > XB_SPIN_CAP) { atomicAdd(&(bar)[XB_TMO], 1u); break; } } } } while (0)

struct XcdBarrier {
    unsigned* bar; unsigned x;
    volatile LAS unsigned* st;
};

__device__ __forceinline__ XcdBarrier xcd_barrier_post(unsigned* bar, volatile LAS unsigned* st) {
    XcdBarrier b; b.bar = bar; b.x = xb_xcc_id(); b.st = st;
    if (threadIdx.x == 0) (void)xb_add(&bar[XB_XCNT(b.x)], 1u);
    return b;
}
__device__ __forceinline__ void xcd_barrier_complete(unsigned* bar, unsigned x, unsigned& nloc, unsigned& nx) {
    const unsigned G = gridDim.x * gridDim.y * gridDim.z;
    unsigned sum, cnt, mine, sp = 0u;
    for (;;) {
        sum = 0u; cnt = 0u; mine = 0u;
#pragma unroll
        for (unsigned j = 0; j < 16; ++j) { const unsigned c = xb_ld(&bar[XB_XCNT(j)]); sum += c; cnt += (c > 0u) ? 1u : 0u; mine = (j == x) ? c : mine; }
        if (sum == G) break;
        __builtin_amdgcn_s_sleep(1);
        if ((++sp & 255u) == 0u) { if (xb_ld(&bar[XB_TMO])) break; if (sp > XB_SPIN_CAP) { atomicAdd(&bar[XB_TMO], 1u); break; } }
    }
    nloc = mine > 0u ? mine : 1u; nx = cnt > 0u ? cnt : 1u;
}

__device__ __forceinline__ void xcd_barrier(const XcdBarrier& b) {
    asm volatile("s_waitcnt vmcnt(0)" ::: "memory");
    __syncthreads();
    if (threadIdx.x == 0) {
        unsigned* bar = b.bar;
        __builtin_amdgcn_s_waitcnt(0);
        unsigned nloc = b.st[0], nx = b.st[1];
        if (nloc == 0u) { xcd_barrier_complete(bar, b.x, nloc, nx); b.st[0] = nloc; b.st[1] = nx; }
        const unsigned old = xb_add(&bar[XB_XSUB(b.x)], 1u);
        const unsigned gen = old / nloc;
        if (old + 1u == (gen + 1u) * nloc) {
            __builtin_amdgcn_fence(__ATOMIC_RELEASE, "agent");
            asm volatile("s_waitcnt vmcnt(0)" ::: "memory");
            const unsigned og = xb_add(&bar[XB_TOP], 1u);
            const unsigned tg = og / nx;
            if (og + 1u == (tg + 1u) * nx) xb_add(&bar[XB_TOPGEN], 1u);
            else XB_SPIN(xb_ld(&bar[XB_TOPGEN]) == tg, bar);
            __builtin_amdgcn_fence(__ATOMIC_ACQUIRE, "agent");
            xb_add(&bar[XB_XGEN(b.x)], 1u);
            asm volatile("s_waitcnt vmcnt(0)" ::: "memory");
        } else {
            XB_SPIN(xb_ld(&bar[XB_XGEN(b.x)]) == gen, bar);
            __builtin_amdgcn_fence(__ATOMIC_ACQUIRE, "agent");
            asm volatile("s_waitcnt vmcnt(0)" ::: "memory");
        }
    }
    __syncthreads();
}


template <int ph>
DEVI void run_phase(const Params& p, char* smem_raw) {
  float* smem = (float*)smem_raw;
  char* ws = p.ws;
  {
    switch (ph) {
      case 0:
        phase0(p, smem);
        conv_fp8_rows(p.in[I_PU], (unsigned char*)(ws + OFF_UB), (float*)(ws + OFF_USC));
        conv_fp8_rows(p.in[I_PV], (unsigned char*)(ws + OFF_VB), (float*)(ws + OFF_VSC));
        break;
      case 1: {
        EpiIn0 E{(float*)(ws + OFF_PROJ), (const float*)(ws + OFF_LB), (const float*)(ws + OFF_INVREV)};
        pg8::Gemm g{(const pg8::bf16_t*)(ws + OFF_XB), (const pg8::bf16_t*)(ws + OFF_WIN0), MP, N0, 2048};
        pg8::StaticOrder S;
        S.init(MP, N0, (int)gridDim.x, (int)blockIdx.x);
        pg8::gemm_phase<EpiIn0, pg8::StaticOrder, false>((PG8_LAS unsigned char*)smem_raw, g, S, E, nullptr);
      } break;
      case 2: phase_rec0(p, smem); break;
      case 3: phase_post0(p); break;
      case 4: case 15: {
        EpiStoreF32 E{(float*)(ws + OFF_GOUT)};
        pg8::Gemm g{(const pg8::bf16_t*)(ws + OFF_MIXB), (const pg8::bf16_t*)(ws + (ph == 4 ? OFF_WOUT0 : OFF_WOUT1)), MP, 2048, 2048};
        pg8::StaticOrder S;
        S.init(MP, 2048, (int)gridDim.x, (int)blockIdx.x);
        pg8::gemm_phase<EpiStoreF32, pg8::StaticOrder, false>((PG8_LAS unsigned char*)smem_raw, g, S, E, nullptr);
      } break;
      case 5: case 16: {
        int l = (ph == 5) ? 0 : 1;
        phase_ln(p, (const float*)(ws + OFF_GOUT), p.in[I_LNG] + (size_t)(l * 2) * D, p.in[I_LNB] + (size_t)(l * 2) * D);
      } break;
      case 6: case 17: {
        EpiStoreBf16 E{(u16*)(ws + OFF_QB)};
        pg8::Gemm g{(const pg8::bf16_t*)(ws + OFF_XB), (const pg8::bf16_t*)(ws + (ph == 6 ? OFF_WQ0 : OFF_WQ1)), MP, 2048, 2048};
        pg8::StaticOrder S;
        S.init(MP, 2048, (int)gridDim.x, (int)blockIdx.x);
        pg8::gemm_phase<EpiStoreBf16, pg8::StaticOrder, false>((PG8_LAS unsigned char*)smem_raw, g, S, E, nullptr);
      } break;
      case 7: case 18: {
        float* SC = (float*)(ws + OFF_GOUT);
        gemm_phase((const u16*)(ws + OFF_QB), 2048, 128, (const u16*)(ws + (ph == 7 ? OFF_KEY0 : OFF_KEY1)), 128,
                   69, 16, smem_raw, [=](int row, int col, float v0, float v1) {
                     SC[(size_t)row * 2048 + col] = v0;
                     SC[(size_t)row * 2048 + col + 32] = v1;
                   });
      } break;
      case 8: phase_peer(p, 0, false); break;
      case 9: {
        conv_fp8_rows(p.in[I_PU] + (size_t)16384 * 2048, (unsigned char*)(ws + OFF_UB), (float*)(ws + OFF_USC));
        conv_fp8_rows(p.in[I_PV] + (size_t)16384 * 2048, (unsigned char*)(ws + OFF_VB), (float*)(ws + OFF_VSC));
        EpiIn1 E{(float*)(ws + OFF_PROJ), (float*)(ws + OFF_DTA), p.in[I_DTB], p.in[I_ALOG]};
        pg8::Gemm g{(const pg8::bf16_t*)(ws + OFF_XB), (const pg8::bf16_t*)(ws + OFF_WIN1), MP, N1, 2048};
        pg8::StaticOrder S;
        S.init(MP, N1, (int)gridDim.x, (int)blockIdx.x);
        pg8::gemm_phase<EpiIn1, pg8::StaticOrder, false>((PG8_LAS unsigned char*)smem_raw, g, S, E, nullptr);
      } break;
      case 10: phase_pre1(p); break;
      case 11: {
        float* DEC = (float*)(ws + OFF_DEC);
        float* AA = (float*)(ws + OFF_AA);
        float* GG = (float*)(ws + OFF_GG);
        const float* w0 = p.in[I_W0];
        const float* a0 = p.in[I_A0];
        gemm_phase((const u16*)(ws + OFF_LRA), 64, 0, (const u16*)(ws + OFF_W2T), 64, 69, 8, smem_raw,
                   [=](int row, int col, float v0, float v1) {
#pragma unroll
                     for (int e = 0; e < 2; ++e) {
                       int cc = col + e * 32;
                       float v = (e ? v1 : v0);
                       float wl = -softplusf_(-v) - 0.5f;
                       DEC[(size_t)row * 1024 + cc] = expf(-expf(wl));
                     }
                   }, w0);
        gemm_phase((const u16*)(ws + OFF_LRB), 64, 0, (const u16*)(ws + OFF_A2T), 64, 69, 8, smem_raw,
                   [=](int row, int col, float v0, float v1) {
                     AA[(size_t)row * 1024 + col] = sigmoidf_(v0);
                     AA[(size_t)row * 1024 + col + 32] = sigmoidf_(v1);
                   }, a0);
        gemm_phase((const u16*)(ws + OFF_LRG), 192, 0, (const u16*)(ws + OFF_G2T), 192, 69, 8, smem_raw,
                   [=](int row, int col, float v0, float v1) {
                     GG[(size_t)row * 1024 + col] = v0;
                     GG[(size_t)row * 1024 + col + 32] = v1;
                   });
      } break;
      case 12: phase_pre1c(p); break;
      case 13: phase_rec1(p, smem); break;
      case 14: phase_post1(p); break;
      case 19: phase_peer(p, 1, true); break;
      default: break;
    }
  }
}

__global__ void __launch_bounds__(512, 2) mega(Params p, int ph_lo, int ph_hi) {
  __shared__ __attribute__((aligned(16))) char smem_raw[SMEM_BYTES];
  __shared__ uint4 xb_words;
  cg::grid_group grid = cg::this_grid();
  if (threadIdx.x == 0) xb_words = make_uint4(0u, 0u, 0u, 0u);
  __syncthreads();
  XcdBarrier xb = xcd_barrier_post((unsigned*)(p.ws + OFF_BAR), (volatile LAS unsigned*)&xb_words);
  if (ph_hi > 1000) grid.sync();
#ifndef REPEAT_MASK
#define REPEAT_MASK 0
#endif
#define PHASE(K)                                          \
  if (ph_lo <= K && K < ph_hi) run_phase<K>(p, smem_raw); \
  if ((REPEAT_MASK >> K) & 1) { xcd_barrier(xb); run_phase<K>(p, smem_raw); } \
  if (ph_lo <= K && K + 1 < ph_hi) xcd_barrier(xb);
  PHASE(0) PHASE(1) PHASE(2) PHASE(3) PHASE(4) PHASE(5) PHASE(6) PHASE(7) PHASE(8) PHASE(9)
  PHASE(10) PHASE(11) PHASE(12) PHASE(13) PHASE(14) PHASE(15) PHASE(16) PHASE(17) PHASE(18) PHASE(19)
}
#ifdef PHASE_TEST
template <int PH>
__global__ void __launch_bounds__(512, 2) phk(Params p) {
  __shared__ __attribute__((aligned(16))) char smem_raw[SMEM_BYTES];
  run_phase<PH>(p, smem_raw);
}
#define INST(N) template __global__ void phk<N>(Params);
INST(0) INST(1) INST(2) INST(3) INST(4) INST(5) INST(6) INST(7) INST(8) INST(9) INST(10) INST(11) INST(12) INST(13) INST(14) INST(19)
#endif

constexpr int NPHASE = 20;

extern "C" void kernel_launch(void* const* d_in, const int* in_sizes, int n_in, void* d_out, int out_size, void* d_ws,
                              size_t ws_size, hipStream_t stream) {
  static int grid_blocks = 0;
  if (!grid_blocks) {
    int dev = 0, cus = 0, per_cu = 0;
    hipGetDevice(&dev);
    hipDeviceGetAttribute(&cus, hipDeviceAttributeMultiprocessorCount, dev);
    hipOccupancyMaxActiveBlocksPerMultiprocessor(&per_cu, mega, 512, 0);
    if (per_cu > 1) per_cu = 1;
    if (per_cu < 1) per_cu = 1;
    grid_blocks = cus * per_cu;
  }
  Params p{};
  for (int i = 0; i < 38; ++i) p.in[i] = (const float*)d_in[i];
  p.out = (float*)d_out;
  p.ws = (char*)d_ws;
  (void)hipMemsetAsync((char*)d_ws + OFF_BAR, 0, 3456 * 4, stream);
  int lo = 0, hi = NPHASE;
  void* args[] = {&p, &lo, &hi};
  hipError_t e = hipLaunchCooperativeKernel((void*)mega, dim3(grid_blocks), dim3(512), args, 0, stream);
  if (e != hipSuccess) fprintf(stderr, "cooperative launch failed: %s (grid %d)\n", hipGetErrorString(e), grid_blocks);
}
```

```cpp
#include <hip/hip_runtime.h>
#include <hip/hip_bf16.h>
#include <hip/hip_cooperative_groups.h>
#include <cstdio>
#include <cmath>
namespace cg = cooperative_groups;

#define DEVI __device__ __forceinline__
typedef unsigned short u16;
using bf16x8 = __attribute__((ext_vector_type(8))) short;
using f32x4 = __attribute__((ext_vector_type(4))) float;
using u32x4 = __attribute__((ext_vector_type(4))) unsigned int;

constexpr int D = 2048;
constexpr int TP = 2064;
constexpr int MPR = 8256;
constexpr int M = 8768;
constexpr int MP = 8960;
constexpr int N0 = 7168;
constexpr int N1 = 6144;
constexpr float ALPHA = 1.41421356237f;

constexpr size_t SZ_TAB = (size_t)16384 * 2048 * 2;
constexpr size_t OFF_UB = 0;
constexpr size_t OFF_VB = OFF_UB + SZ_TAB;
constexpr size_t OFF_WIN0 = OFF_VB + SZ_TAB;
constexpr size_t OFF_WOUT0 = OFF_WIN0 + (size_t)N0 * 2048 * 2;
constexpr size_t OFF_WQ0 = OFF_WOUT0 + (size_t)2048 * 2048 * 2;
constexpr size_t OFF_KEY0 = OFF_WQ0 + (size_t)2048 * 2048 * 2;
constexpr size_t OFF_WIN1 = OFF_KEY0 + (size_t)16 * 128 * 128 * 2;
constexpr size_t OFF_WOUT1 = OFF_WIN1 + (size_t)N1 * 2048 * 2;
constexpr size_t OFF_WQ1 = OFF_WOUT1 + (size_t)2048 * 2048 * 2;
constexpr size_t OFF_KEY1 = OFF_WQ1 + (size_t)2048 * 2048 * 2;
constexpr size_t OFF_W2T = OFF_KEY1 + (size_t)16 * 128 * 128 * 2;
constexpr size_t OFF_A2T = OFF_W2T + (size_t)1024 * 64 * 2;
constexpr size_t OFF_G2T = OFF_A2T + (size_t)1024 * 64 * 2;
constexpr size_t OFF_LB = OFF_G2T + (size_t)1024 * 192 * 2;
constexpr size_t OFF_INVREV = OFF_LB + 1024 * 4;
constexpr size_t OFF_XF = OFF_INVREV + 64 * 8;
constexpr size_t OFF_XB = OFF_XF + (size_t)MP * 2048 * 4;
constexpr size_t OFF_PROJ = OFF_XB + (size_t)MP * 2048 * 2;
constexpr size_t OFF_GOUT = OFF_PROJ + (size_t)MP * N0 * 4;
constexpr size_t OFF_OMIX = OFF_GOUT + (size_t)MP * 2048 * 4;
constexpr size_t OFF_MIXB = OFF_OMIX + (size_t)MP * 2048 * 4;
constexpr size_t OFF_QB = OFF_MIXB + (size_t)MP * 2048 * 2;
constexpr size_t OFF_RKV = OFF_QB + (size_t)MP * 2048 * 2;
constexpr size_t OFF_DEC = OFF_RKV + (size_t)MP * 3072 * 4;
constexpr size_t OFF_AA = OFF_DEC + (size_t)MP * 1024 * 4;
constexpr size_t OFF_GG = OFF_AA + (size_t)MP * 1024 * 4;
constexpr size_t OFF_LRA = OFF_GG + (size_t)MP * 1024 * 4;
constexpr size_t OFF_LRB = OFF_LRA + (size_t)MP * 64 * 2;
constexpr size_t OFF_LRG = OFF_LRB + (size_t)MP * 64 * 2;
constexpr size_t OFF_DTA = OFF_LRG + (size_t)MP * 192 * 2;
constexpr size_t OFF_BON = OFF_DTA + (size_t)MP * 64 * 4;
constexpr size_t OFF_USC = OFF_BON + (size_t)MP * 16 * 4;
constexpr size_t OFF_VSC = OFF_USC + 16384 * 4;
constexpr size_t OFF_BAR = OFF_VSC + 16384 * 4;
constexpr size_t WS_TOTAL = OFF_BAR + 3456 * 4;
static_assert(WS_TOTAL <= (size_t)1 << 30, "workspace too large");

constexpr size_t O_YP = 0;
constexpr size_t O_YS = O_YP + (size_t)4 * 2048 * 2048;
constexpr size_t O_HGP = O_YS + (size_t)128 * 4 * 2048;
constexpr size_t O_HGS = O_HGP + (size_t)4 * 8 * 128 * 128;
constexpr size_t O_RTP = O_HGS + (size_t)128 * 8 * 128 * 128;
constexpr size_t O_RTS = O_RTP + (size_t)4 * 4 * 128 * 256;
constexpr size_t O_SSP = O_RTS + (size_t)128 * 4 * 128 * 256;
constexpr size_t O_SSS = O_SSP + (size_t)4 * 16 * 128 * 64;
constexpr size_t O_CVP = O_SSS + (size_t)128 * 16 * 128 * 64;
constexpr size_t O_CVS = O_CVP + (size_t)4 * 3 * 1536;
constexpr size_t O_WKP = O_CVS + (size_t)128 * 3 * 1536;
constexpr size_t O_WKS = O_WKP + (size_t)4 * 16 * 64 * 64;
constexpr size_t O_SHP = O_WKS + (size_t)128 * 16 * 64 * 64;
constexpr size_t O_SHS = O_SHP + (size_t)4 * 3360;

struct Params {
  const float* in[38];
  float* out;
  char* ws;
};
enum { I_XP = 0, I_XS, I_SHG, I_SRT, I_SSM, I_SCV, I_SWK, I_SSH, I_META, I_LNG, I_LNB, I_EWIN, I_LBL, I_HNG, I_EWOUT,
       I_OWIN, I_CVW, I_CVB, I_DTB, I_ALOG, I_DSK, I_SNG, I_MU, I_W0, I_W2, I_A0, I_A2, I_G2, I_KK, I_KA, I_RK,
       I_LXG, I_LXB, I_OWOUT, I_WQ, I_KEYS, I_PU, I_PV };

constexpr int VB_BYTES = 2 * 2 * 128 * 72 * 2;
constexpr int SMEM_BYTES = 2 * VB_BYTES;

DEVI u16 f2bf(float f) {
  unsigned u = __float_as_uint(f);
  u += 0x7fffu + ((u >> 16) & 1u);
  return (u16)(u >> 16);
}
DEVI unsigned pack2(float a, float b) { return (unsigned)f2bf(a) | ((unsigned)f2bf(b) << 16); }
DEVI float bflo(unsigned u) { return __uint_as_float(u << 16); }
DEVI float bfhi(unsigned u) { return __uint_as_float(u & 0xffff0000u); }
DEVI float sigmoidf_(float x) { return __builtin_amdgcn_rcpf(1.0f + __builtin_amdgcn_exp2f(-1.44269504089f * x)); }
DEVI float siluf_(float x) { return x * __builtin_amdgcn_rcpf(1.0f + __builtin_amdgcn_exp2f(-1.44269504089f * x)); }
DEVI float sigmoid_acc(float x) { return 1.0f / (1.0f + expf(-x)); }
DEVI float silu_acc(float x) { return x / (1.0f + expf(-x)); }
DEVI float softplusf_(float x) { return fmaxf(x, 0.0f) + log1pf(expf(-fabsf(x))); }
DEVI float wsum(float v) {
#pragma unroll
  for (int o = 32; o > 0; o >>= 1) v += __shfl_xor(v, o, 64);
  return v;
}
DEVI float wmaxf_(float v) {
#pragma unroll
  for (int o = 32; o > 0; o >>= 1) v = fmaxf(v, __shfl_xor(v, o, 64));
  return v;
}
DEVI int wmini_(int v) {
#pragma unroll
  for (int o = 32; o > 0; o >>= 1) v = min(v, __shfl_xor(v, o, 64));
  return v;
}
template <int CTRL>
DEVI float dppf(float v) {
  return __int_as_float(__builtin_amdgcn_update_dpp(0, __float_as_int(v), CTRL, 0xF, 0xF, true));
}
DEVI float red8(float v) {
  v += dppf<0xB1>(v);
  v += dppf<0x4E>(v);
  v += dppf<0x141>(v);
  return v;
}
DEVI float red16(float v) {
  v = red8(v);
  v += dppf<0x140>(v);
  return v;
}
DEVI float rlf_(float v, int l) { return __int_as_float(__builtin_amdgcn_readlane(__float_as_int(v), l)); }
DEVI int row_pos(int row) { return row < MPR ? (row % TP) : (16384 + ((row - MPR) & 3)); }

DEVI void conv_bf16_flat(const float* __restrict__ src, u16* __restrict__ dst, size_t n4) {
  size_t stride = (size_t)gridDim.x * blockDim.x;
  for (size_t i = (size_t)blockIdx.x * blockDim.x + threadIdx.x; i < n4; i += stride) {
    float4 v = ((const float4*)src)[i];
    uint2 o;
    o.x = pack2(v.x, v.y);
    o.y = pack2(v.z, v.w);
    ((uint2*)dst)[i] = o;
  }
}

template <int MODE>
DEVI int colmap(int j) {
  if (MODE == 0) return j;
  if (MODE == 1) {
    if (j < 4096 || j >= 5120) return j;
    int hb = j & ~127, c = j & 127, wc = c >> 5, n = (c >> 4) & 1, r = c & 15;
    int d = n ? (64 + wc * 16 + r) : (wc * 16 + r);
    return hb + d;
  }
  if (j < 2560) return j;
  if (j < 5920) return j + 16;
  if (j < 5936) return 2560 + (j - 5920);
  return -1;
}

template <int MODE>
DEVI void transpose_job(const float* __restrict__ src, int ldsrc, int Ksrc, u16* __restrict__ dst, int Kdst, int ndst,
                        float* smem) {
  int ktiles = Kdst / 64, ntiles = ndst / 64;
  int tid = threadIdx.x & 255;
  const int half = threadIdx.x >> 8;
  smem += half * (64 * 65);
  for (int base = blockIdx.x * 2; base < ktiles * ntiles; base += gridDim.x * 2) {
    int tile = base + half;
    const bool valid = tile < ktiles * ntiles;
    if (!valid) tile = ktiles * ntiles - 1;
    int tn = tile / ktiles, tk = tile % ktiles;
    int j0 = tn * 64, k0 = tk * 64;
    int jj = (tid & 15) * 4;
    int sc = colmap<MODE>(j0 + jj);
#pragma unroll
    for (int i = 0; i < 4; ++i) {
      int kk = i * 16 + (tid >> 4);
      float4 v = make_float4(0.f, 0.f, 0.f, 0.f);
      if (sc >= 0 && (k0 + kk) < Ksrc) v = *(const float4*)(src + (size_t)(k0 + kk) * ldsrc + sc);
      smem[kk * 65 + jj] = v.x;
      smem[kk * 65 + jj + 1] = v.y;
      smem[kk * 65 + jj + 2] = v.z;
      smem[kk * 65 + jj + 3] = v.w;
    }
    __syncthreads();
    int jr = tid >> 2, kq = (tid & 3) * 16;
    unsigned pk[8];
#pragma unroll
    for (int e = 0; e < 8; ++e) pk[e] = pack2(smem[(kq + 2 * e) * 65 + jr], smem[(kq + 2 * e + 1) * 65 + jr]);
    uint4* dp = (uint4*)(dst + (size_t)(j0 + jr) * Kdst + k0 + kq);
    if (valid) {
      dp[0] = make_uint4(pk[0], pk[1], pk[2], pk[3]);
      dp[1] = make_uint4(pk[4], pk[5], pk[6], pk[7]);
    }
    __syncthreads();
  }
}

DEVI void phase0(const Params& p, float* smem) {
  char* ws = p.ws;
  conv_bf16_flat(p.in[I_KEYS], (u16*)(ws + OFF_KEY0), (size_t)16 * 128 * 128 / 4);
  conv_bf16_flat(p.in[I_KEYS] + (size_t)16 * 128 * 128, (u16*)(ws + OFF_KEY1), (size_t)16 * 128 * 128 / 4);
  transpose_job<1>(p.in[I_EWIN], N0, 2048, (u16*)(ws + OFF_WIN0), 2048, N0, smem);
  transpose_job<0>(p.in[I_EWOUT], 2048, 2048, (u16*)(ws + OFF_WOUT0), 2048, 2048, smem);
  transpose_job<0>(p.in[I_WQ], 2048, 2048, (u16*)(ws + OFF_WQ0), 2048, 2048, smem);
  transpose_job<0>(p.in[I_WQ] + (size_t)2048 * 2048, 2048, 2048, (u16*)(ws + OFF_WQ1), 2048, 2048, smem);
  transpose_job<2>(p.in[I_OWIN], 5936, 2048, (u16*)(ws + OFF_WIN1), 2048, N1, smem);
  transpose_job<0>(p.in[I_OWOUT], 2048, 2048, (u16*)(ws + OFF_WOUT1), 2048, 2048, smem);
  transpose_job<0>(p.in[I_W2], 1024, 64, (u16*)(ws + OFF_W2T), 64, 1024, smem);
  transpose_job<0>(p.in[I_A2], 1024, 64, (u16*)(ws + OFF_A2T), 64, 1024, smem);
  transpose_job<0>(p.in[I_G2], 1024, 160, (u16*)(ws + OFF_G2T), 192, 1024, smem);
  {
    float* XF = (float*)(ws + OFF_XF);
    u16* XB = (u16*)(ws + OFF_XB);
    size_t n4 = (size_t)MP * 512;
    size_t stride = (size_t)gridDim.x * blockDim.x;
    for (size_t i = (size_t)blockIdx.x * blockDim.x + threadIdx.x; i < n4; i += stride) {
      int row = (int)(i >> 9), c4 = (int)(i & 511);
      float4 v = make_float4(0.f, 0.f, 0.f, 0.f);
      if (row < MPR) {
        int b = row / TP, t = row % TP;
        const float* s = (t < 16) ? (p.in[I_META] + (size_t)t * D) : (p.in[I_XP] + ((size_t)b * 2048 + (t - 16)) * D);
        v = ((const float4*)s)[c4];
      } else if (row < M) {
        v = ((const float4*)(p.in[I_XS] + (size_t)(row - MPR) * D))[c4];
      }
      ((float4*)XF)[i] = v;
      uint2 o;
      o.x = pack2(v.x, v.y);
      o.y = pack2(v.z, v.w);
      ((uint2*)XB)[i] = o;
    }
  }
  if (blockIdx.x == 0) {
    float* LB = (float*)(ws + OFF_LB);
    const float* lg = p.in[I_LBL];
    for (int c = threadIdx.x; c < 1024; c += blockDim.x) {
      float a = lg[c], b = lg[1024 + c], d = lg[2048 + c];
      float m = fmaxf(a, fmaxf(b, d));
      float ea = expf(a - m), eb = expf(b - m), ed = expf(d - m);
      LB[c] = ea / (ea + eb + ed);
    }
    float* IR = (float*)(ws + OFF_INVREV);
    if (threadIdx.x < 64) {
      double d = (double)threadIdx.x;
      double v = exp(-d * (9.210340371976184 / 64.0)) * 0.15915494309189535;
      float h = (float)v;
      IR[threadIdx.x * 2] = h;
      IR[threadIdx.x * 2 + 1] = (float)(v - (double)h);
    }
  }
}

constexpr int G_LDS_STRIDE = 72;
constexpr int G_LDS_BUF = 2 * 128 * G_LDS_STRIDE;
template <class Epi>
DEVI void gemm_phase(const u16* __restrict__ A, int lda, int a_ntile_off, const u16* __restrict__ Bt, int K, int mtiles,
                     int ntiles, char* smem, Epi epi, const float* __restrict__ colc = nullptr) {
  const int half = threadIdx.x >> 8;
  u16* S0 = (u16*)(smem + half * VB_BYTES);
  const int tid = threadIdx.x & 255, wid = tid >> 6, lane = tid & 63, wr = wid >> 1, wc = wid & 1, fr = lane & 15, fq = lane >> 4;
  const int nk = K / 64;
  const int ntot = mtiles * ntiles;
  for (int base = blockIdx.x * 2; base < ntot; base += gridDim.x * 2) {
    int tile = base + half;
    const bool valid = tile < ntot;
    if (!valid) tile = ntot - 1;
    const int tm = tile / ntiles, tn = tile - tm * ntiles;
    const int brow = tm * 128, bcol = tn * 128;
    const u16* Ag = A + (size_t)brow * lda + (size_t)tn * a_ntile_off;
    const u16* Bg = Bt + (size_t)bcol * K;
    f32x4 acc[4][4];
#pragma unroll
    for (int m = 0; m < 4; ++m)
#pragma unroll
      for (int n = 0; n < 4; ++n) acc[m][n] = f32x4{0.f, 0.f, 0.f, 0.f};
    u32x4 ra0[4], rb0[4], ra1[4], rb1[4];
    auto gload = [&](int t, u32x4(&ra)[4], u32x4(&rb)[4]) {
#pragma unroll
      for (int i = 0; i < 4; ++i) {
        int c = tid + i * 256, r = c >> 3, kc = c & 7;
        ra[i] = *(const u32x4*)(Ag + (size_t)r * lda + t * 64 + kc * 8);
        rb[i] = *(const u32x4*)(Bg + (size_t)r * K + t * 64 + kc * 8);
      }
    };
    auto lwrite = [&](int buf, const u32x4(&ra)[4], const u32x4(&rb)[4]) {
      u16* SA = S0 + buf * G_LDS_BUF;
      u16* SB = SA + 128 * G_LDS_STRIDE;
#pragma unroll
      for (int i = 0; i < 4; ++i) {
        int c = tid + i * 256, r = c >> 3, kc = c & 7;
        *(u32x4*)(SA + r * G_LDS_STRIDE + kc * 8) = ra[i];
        *(u32x4*)(SB + r * G_LDS_STRIDE + kc * 8) = rb[i];
      }
    };
    auto compute = [&](int buf) {
      const u16* SA = S0 + buf * G_LDS_BUF;
      const u16* SB = SA + 128 * G_LDS_STRIDE;
#pragma unroll
      for (int kh = 0; kh < 2; ++kh) {
        bf16x8 At[4], Bl[4];
#pragma unroll
        for (int m = 0; m < 4; ++m)
          At[m] = *(const bf16x8*)(SA + (wr * 64 + m * 16 + fr) * G_LDS_STRIDE + kh * 32 + fq * 8);
#pragma unroll
        for (int n = 0; n < 4; ++n)
          Bl[n] = *(const bf16x8*)(SB + (wc * 64 + n * 16 + fr) * G_LDS_STRIDE + kh * 32 + fq * 8);
#pragma unroll
        for (int m = 0; m < 4; ++m)
#pragma unroll
          for (int n = 0; n < 4; ++n) acc[m][n] = __builtin_amdgcn_mfma_f32_16x16x32_bf16(At[m], Bl[n], acc[m][n], 0, 0, 0);
        __builtin_amdgcn_sched_barrier(0);
      }
    };
    gload(0, ra0, rb0);
    if (nk > 1) gload(1, ra1, rb1);
    lwrite(0, ra0, rb0);
    __syncthreads();
#pragma unroll 1
    for (int t = 0; t < nk; t += 2) {
      if (t + 2 < nk) gload(t + 2, ra0, rb0);
      compute(0);
      if (t + 1 < nk) lwrite(1, ra1, rb1);
      __syncthreads();
      if (t + 1 < nk) {
        if (t + 3 < nk) gload(t + 3, ra1, rb1);
        compute(1);
        if (t + 2 < nk) lwrite(0, ra0, rb0);
        __syncthreads();
      }
    }
    if (valid) {
      float cc[4] = {0.f, 0.f, 0.f, 0.f};
      if (colc) {
#pragma unroll
        for (int n = 0; n < 4; ++n) cc[n] = colc[bcol + wc * 64 + n * 16 + fr];
      }
#pragma unroll
      for (int m = 0; m < 4; ++m)
#pragma unroll
        for (int n = 0; n < 2; ++n)
#pragma unroll
          for (int j = 0; j < 4; ++j) {
            int row = brow + wr * 64 + m * 16 + fq * 4 + j;
            int col = bcol + wc * 64 + n * 16 + fr;
            epi(row, col, acc[m][n][j] + cc[n], acc[m][n + 2][j] + cc[n + 2]);
          }
    }
  }
}


namespace pg8 {
#define PG8_LAS __attribute__((address_space(3)))
typedef unsigned short bf16_t;
typedef short bf16x8 __attribute__((ext_vector_type(8)));
typedef float f32x4 __attribute__((ext_vector_type(4)));
typedef unsigned u32x4 __attribute__((ext_vector_type(4)));
constexpr int BM = 256, BK = 64, HALF = 128, HTB = HALF * BK * 2  , STAGE_BYTES = 8 * HTB, NXCD = 8, WGM = 8;

__host__ __device__ __forceinline__ int lds_byte(int r, int c) { const int st = (r >> 4) * 2 + (c >> 5), rr = r & 15, cc = c & 31, ob = rr * 64 + cc * 2; return st * 1024 + (ob ^ (((ob >> 9) & 1) << 5)); }
__host__ __device__ __forceinline__ void stage_rc(int b, int& R, int& C) { const int st = b / 1024, sb = b % 1024, swz = sb ^ (((sb >> 9) & 1) << 5); R = (st >> 1) * 16 + swz / 64; C = (st & 1) * 32 + (swz % 64) / 2; }
__host__ __device__ __forceinline__ int perm32(int rho) { const int n = rho >> 4, i = rho & 15; return 8 * (i >> 2) + 4 * n + (i & 3); }

struct Unit { int pm, pn; };
struct Gemm { const bf16_t* A; const bf16_t* Bt; int M, N, K; };

struct StaticOrder {
    int nM, nN, nwg, G, c;
    __host__ __device__ void init(int M, int N, int G_, int c_) { nM = M / BM; nN = N / BM; nwg = nM * nN; G = G_; c = c_; }
    __host__ __device__ bool next(int i, Unit& u) const {
        const long L = (long)i * G + c; if (L >= nwg) return false;
        int wgid = (int)L; { const int q = nwg / NXCD, r = nwg % NXCD, xcd = wgid % NXCD, off = wgid / NXCD; wgid = (xcd < r ? xcd * (q + 1) : r * (q + 1) + (xcd - r) * q) + off; }
        const int nig = WGM * nN, gid = wgid / nig, fm = gid * WGM, gsz = (nM - fm) < WGM ? (nM - fm) : WGM;
        u.pm = fm + ((wgid % nig) % gsz); u.pn = (wgid % nig) / gsz; return true;
    }
    __device__ __forceinline__ void a_ready(const Unit&) const {}
    __device__ __forceinline__ void done(const Unit&) const {}
};
template <class Epi, class Sched, bool STAMP = false>
__device__ __forceinline__ void gemm_phase(PG8_LAS unsigned char* lds, const Gemm g, const Sched& S, const Epi& E, unsigned long long* stamps) {
    const int tid = threadIdx.x, wid = __builtin_amdgcn_readfirstlane(tid >> 6), lane = tid & 63, wr = wid >> 2, wc = wid & 3, fr = lane & 15, fq = lane >> 4;
    const int K = g.K, nt = K / BK;
    int ts_lo = 0, ts_hi = 0, nts = 0; const unsigned long long rt_entry = STAMP ? (unsigned long long)wall_clock64() : 0ull;
#define PG8_STAMP() do { if (STAMP && wid == 0 && nts < 64) { const unsigned long long _c = (unsigned long long)clock64(); \
        ts_lo = (lane == nts) ? (int)(unsigned)_c : ts_lo; ts_hi = (lane == nts) ? (int)(unsigned)(_c >> 32) : ts_hi; ++nts; } } while (0)
    PG8_STAMP();
    unsigned voffA[2], voffB[2];
#pragma unroll
    for (int i = 0; i < 2; ++i) { int R, C; stage_rc(tid * 16 + i * 8192, R, C); const int Rb = Epi::PERM ? ((R & ~31) + perm32(R & 31)) : R;
        voffA[i] = (unsigned)(R * K + C) * 2u; voffB[i] = (unsigned)(Rb * K + C) * 2u; }
    const size_t kstep = (size_t)(BK * 2);
    const size_t hstep = (size_t)HALF * K * 2;
    const size_t tstep = 2 * hstep;
    const unsigned ldsw = (unsigned)wid * 1024u;
    const int aoff = lds_byte(wr * 64 + fr, fq * 8), boff = lds_byte(wc * 32 + fr, fq * 8);
#define PG8_SA(b, h) (((b) * 2 + (h)) * HTB)
#define PG8_SB(b, h) ((4 + (b) * 2 + (h)) * HTB)
#define PG8_STAGE(bufoff, gbase, voff) do { _Pragma("unroll") for (int _i = 0; _i < 2; ++_i) \
        __builtin_amdgcn_global_load_lds((const unsigned*)((const char*)(gbase) + (voff)[_i]), (PG8_LAS unsigned*)(lds + (bufoff) + ldsw + _i * 8192), 16, 0, 0); } while (0)
#define PG8_LDA(dst, b, h) do { _Pragma("unroll") for (int m = 0; m < 4; ++m) _Pragma("unroll") for (int k = 0; k < 2; ++k) dst[m][k] = *(const PG8_LAS bf16x8*)(lds + PG8_SA(b, h) + aoff + m * 2048 + k * 1024); } while (0)
#define PG8_LDB(dst, b, h) do { _Pragma("unroll") for (int n = 0; n < 2; ++n) _Pragma("unroll") for (int k = 0; k < 2; ++k) dst[n][k] = *(const PG8_LAS bf16x8*)(lds + PG8_SB(b, h) + boff + n * 2048 + k * 1024); } while (0)
#define PG8_MMA(ai, bj, At, Bt) do { __builtin_amdgcn_s_setprio(1); _Pragma("unroll") for (int m = 0; m < 4; ++m) _Pragma("unroll") for (int n = 0; n < 2; ++n) _Pragma("unroll") for (int k = 0; k < 2; ++k) \
        acc[ai][bj][m][n] = __builtin_amdgcn_mfma_f32_16x16x32_bf16(Bt[n][k], At[m][k], acc[ai][bj][m][n], 0, 0, 0); __builtin_amdgcn_s_setprio(0); } while (0)
#define PG8_WAIT_V(n) asm volatile("s_waitcnt vmcnt(" #n ")" ::: "memory")
#define PG8_WAIT_L(n) asm volatile("s_waitcnt lgkmcnt(" #n ")" ::: "memory")
#define PG8_BAR __builtin_amdgcn_s_barrier()
#define PG8_SCHED __builtin_amdgcn_sched_barrier(0)
    Unit cur, nxt; int ui = 0;
    if (!S.next(0, cur)) return;
    f32x4 acc[2][2][4][2];
#pragma unroll
    for (int a = 0; a < 2; ++a)
#pragma unroll
        for (int b = 0; b < 2; ++b)
#pragma unroll
            for (int m = 0; m < 4; ++m)
#pragma unroll
                for (int n = 0; n < 2; ++n) acc[a][b][m][n] = (f32x4){0.f, 0.f, 0.f, 0.f};
    bf16x8 At[4][2], B0[2][2], B1[2][2];
    const char* cA = (const char*)g.A + (size_t)cur.pm * tstep; const char* cB = (const char*)g.Bt + (size_t)cur.pn * tstep;
    S.a_ready(cur);
    PG8_STAGE(PG8_SB(0, 0), cB, voffB); PG8_STAGE(PG8_SA(0, 0), cA, voffA); PG8_STAGE(PG8_SB(0, 1), cB + hstep, voffB); PG8_STAGE(PG8_SA(0, 1), cA + hstep, voffA);
    if (wr == 1) PG8_BAR;
    PG8_WAIT_V(4); PG8_BAR;
    PG8_STAGE(PG8_SB(1, 0), cB + kstep, voffB); PG8_STAGE(PG8_SA(1, 0), cA + kstep, voffA); PG8_STAGE(PG8_SB(1, 1), cB + hstep + kstep, voffB);
    PG8_WAIT_V(6); PG8_BAR;
    PG8_STAMP();
    for (;;) {
        const bool has_next = S.next(ui + 1, nxt);
        const char* nA = has_next ? (const char*)g.A + (size_t)nxt.pm * tstep : cA; const char* nB = has_next ? (const char*)g.Bt + (size_t)nxt.pn * tstep : cB;
        for (int t = 0; t < nt; t += 2) {
            const bool last = (t == nt - 2);
            const char* a1 = cA + (size_t)(t + 1) * kstep;
            const char* a2 = last ? nA : cA + (size_t)(t + 2) * kstep; const char* b2 = last ? nB : cB + (size_t)(t + 2) * kstep;
            const char* a3 = a2 + kstep; const char* b3 = b2 + kstep;
            if (last && has_next) S.a_ready(nxt);
            PG8_LDB(B0, 0, 0); PG8_SCHED; PG8_LDA(At, 0, 0); PG8_STAGE(PG8_SA(1, 1), a1 + hstep, voffA);
            PG8_WAIT_L(8); PG8_BAR; PG8_WAIT_L(0); PG8_MMA(0, 0, At, B0); PG8_BAR; PG8_SCHED;
            PG8_LDB(B1, 0, 1); PG8_STAGE(PG8_SB(0, 0), b2, voffB);
            PG8_BAR; PG8_WAIT_L(0); PG8_MMA(0, 1, At, B1); PG8_BAR;
            PG8_LDA(At, 0, 1); PG8_STAGE(PG8_SA(0, 0), a2, voffA);
            PG8_BAR; PG8_WAIT_L(0); PG8_MMA(1, 0, At, B0); PG8_BAR; PG8_SCHED;
            PG8_STAGE(PG8_SB(0, 1), b2 + hstep, voffB);
            PG8_WAIT_V(6); PG8_BAR; PG8_MMA(1, 1, At, B1); PG8_BAR;
            PG8_LDB(B0, 1, 0); PG8_SCHED; PG8_LDA(At, 1, 0); PG8_STAGE(PG8_SA(0, 1), a2 + hstep, voffA);
            PG8_WAIT_L(8); PG8_BAR; PG8_WAIT_L(0); PG8_MMA(0, 0, At, B0); PG8_BAR; PG8_SCHED;
            PG8_LDB(B1, 1, 1); PG8_STAGE(PG8_SB(1, 0), b3, voffB);
            PG8_BAR; PG8_WAIT_L(0); PG8_MMA(0, 1, At, B1); PG8_BAR;
            PG8_LDA(At, 1, 1); PG8_STAGE(PG8_SA(1, 0), a3, voffA);
            PG8_BAR; PG8_WAIT_L(0); PG8_MMA(1, 0, At, B0); PG8_BAR; PG8_SCHED;
            PG8_STAGE(PG8_SB(1, 1), b3 + hstep, voffB);
            PG8_WAIT_V(6); PG8_BAR; PG8_MMA(1, 1, At, B1); PG8_BAR;
        }
        PG8_STAMP();
        if constexpr (!Epi::AFTER_DRAIN) { E(acc, cur, wr, wc, fr, fq); S.done(cur); }
        PG8_STAMP();
        if (!has_next) break;
#pragma unroll
        for (int a = 0; a < 2; ++a)
#pragma unroll
            for (int b = 0; b < 2; ++b)
#pragma unroll
                for (int m = 0; m < 4; ++m)
#pragma unroll
                    for (int n = 0; n < 2; ++n) acc[a][b][m][n] = (f32x4){0.f, 0.f, 0.f, 0.f};
        cur = nxt; cA = nA; cB = nB; ++ui;
    }
    PG8_WAIT_V(0);
    if (wr == 0) PG8_BAR;
    PG8_BAR;
    if constexpr (Epi::AFTER_DRAIN) { E.fused(acc, cur, wr, wc, fr, fq, lds, wid, lane); S.done(cur); }
    PG8_STAMP();
    if (STAMP && wid == 0) { stamps[lane] = lane < nts ? (((unsigned long long)(unsigned)ts_hi << 32) | (unsigned)ts_lo) : 0ull;
        if (lane == 62) stamps[62] = rt_entry; if (lane == 63) stamps[63] = (unsigned long long)wall_clock64(); }
#undef PG8_STAMP
#undef PG8_SA
#undef PG8_SB
#undef PG8_STAGE
#undef PG8_LDA
#undef PG8_LDB
#undef PG8_MMA
#undef PG8_WAIT_V
#undef PG8_WAIT_L
#undef PG8_BAR
#undef PG8_SCHED
}
}

struct EpiIn0 {
  static constexpr bool PERM = false, AFTER_DRAIN = false;
  float* PROJ;
  const float* LB;
  const float* IR;
  __device__ __forceinline__ void operator()(const pg8::f32x4 (&acc)[2][2][4][2], const pg8::Unit& u, int wr, int wc, int fr, int fq) const {
#pragma unroll
    for (int bj = 0; bj < 2; ++bj) {
      const int cb = u.pn * 256 + bj * 128;
      if (cb >= 4096 && cb < 5120) {
        const int d0 = wc * 16 + 4 * fq;
        const pg8::f32x4 irA = *(const pg8::f32x4*)(IR + 2 * d0), irB = *(const pg8::f32x4*)(IR + 2 * d0 + 4);
        const float irh[4] = {irA[0], irA[2], irB[0], irB[2]}, irl[4] = {irA[1], irA[3], irB[1], irB[3]};
        const float sc = (cb >= 4608) ? 0.08838834764831845f : 1.0f;
#pragma unroll
        for (int ai = 0; ai < 2; ++ai)
#pragma unroll
          for (int m = 0; m < 4; ++m) {
            const int row = u.pm * 256 + ai * 128 + wr * 64 + m * 16 + fr;
            float* pr = PROJ + (size_t)row * N0;
            const pg8::f32x4 v0 = acc[ai][bj][m][0], v1 = acc[ai][bj][m][1];
            const float pos = (float)row_pos(row);
            pg8::f32x4 o1, o2;
#pragma unroll
            for (int j = 0; j < 4; ++j) {
              float ph = pos * irh[j];
              float pe = __builtin_fmaf(pos, irh[j], -ph) + pos * irl[j];
              float frc = __builtin_amdgcn_fractf(ph) + pe;
              float sn = __builtin_amdgcn_sinf(frc), cs = __builtin_amdgcn_cosf(frc);
              o1[j] = (v0[j] * cs - v1[j] * sn) * sc;
              o2[j] = (v0[j] * sn + v1[j] * cs) * sc;
            }
            *(pg8::f32x4*)(pr + cb + d0) = o1;
            *(pg8::f32x4*)(pr + cb + 64 + d0) = o2;
            __builtin_amdgcn_sched_barrier(0);
          }
      } else if (cb >= 1024 && cb < 2048) {
        const int c0 = cb + 32 * wc + 4 * fq;
        const pg8::f32x4 l0 = *(const pg8::f32x4*)(LB + c0 - 1024), l1 = *(const pg8::f32x4*)(LB + c0 + 16 - 1024);
#pragma unroll
        for (int ai = 0; ai < 2; ++ai)
#pragma unroll
          for (int m = 0; m < 4; ++m) {
            const int row = u.pm * 256 + ai * 128 + wr * 64 + m * 16 + fr;
            float* pr = PROJ + (size_t)row * N0;
#pragma unroll
            for (int n = 0; n < 2; ++n) {
              const pg8::f32x4 l = n ? l1 : l0;
              pg8::f32x4 v = acc[ai][bj][m][n], o;
#pragma unroll
              for (int j = 0; j < 4; ++j) o[j] = l[j] + (1.0f - l[j]) * sigmoidf_(v[j]);
              *(pg8::f32x4*)(pr + c0 + 16 * n) = o;
            }
            __builtin_amdgcn_sched_barrier(0);
          }
      } else if (cb < 1024 || (cb >= 3072 && cb < 4096) || cb >= 6144) {
        const int c0 = cb + 32 * wc + 4 * fq;
#pragma unroll
        for (int ai = 0; ai < 2; ++ai)
#pragma unroll
          for (int m = 0; m < 4; ++m) {
            const int row = u.pm * 256 + ai * 128 + wr * 64 + m * 16 + fr;
            float* pr = PROJ + (size_t)row * N0;
#pragma unroll
            for (int n = 0; n < 2; ++n) {
              pg8::f32x4 v = acc[ai][bj][m][n], o;
#pragma unroll
              for (int j = 0; j < 4; ++j) o[j] = siluf_(v[j]);
              *(pg8::f32x4*)(pr + c0 + 16 * n) = o;
            }
            __builtin_amdgcn_sched_barrier(0);
          }
      } else {
        const int c0 = cb + 32 * wc + 4 * fq;
#pragma unroll
        for (int ai = 0; ai < 2; ++ai)
#pragma unroll
          for (int m = 0; m < 4; ++m) {
            const int row = u.pm * 256 + ai * 128 + wr * 64 + m * 16 + fr;
            float* pr = PROJ + (size_t)row * N0;
#pragma unroll
            for (int n = 0; n < 2; ++n) *(pg8::f32x4*)(pr + c0 + 16 * n) = acc[ai][bj][m][n];
          }
      }
    }
  }
};
struct EpiStoreF32 {
  static constexpr bool PERM = false, AFTER_DRAIN = false;
  float* C;
  __device__ __forceinline__ void operator()(const pg8::f32x4 (&acc)[2][2][4][2], const pg8::Unit& u, int wr, int wc, int fr, int fq) const {
#pragma unroll
    for (int ai = 0; ai < 2; ++ai)
#pragma unroll
      for (int m = 0; m < 4; ++m) {
        const int row = u.pm * 256 + ai * 128 + wr * 64 + m * 16 + fr;
        float* pr = C + (size_t)row * 2048 + u.pn * 256 + 32 * wc + 4 * fq;
#pragma unroll
        for (int bj = 0; bj < 2; ++bj)
#pragma unroll
          for (int n = 0; n < 2; ++n) *(pg8::f32x4*)(pr + bj * 128 + 16 * n) = acc[ai][bj][m][n];
      }
  }
};
struct EpiStoreBf16 {
  static constexpr bool PERM = false, AFTER_DRAIN = false;
  u16* C;
  __device__ __forceinline__ void operator()(const pg8::f32x4 (&acc)[2][2][4][2], const pg8::Unit& u, int wr, int wc, int fr, int fq) const {
#pragma unroll
    for (int ai = 0; ai < 2; ++ai)
#pragma unroll
      for (int m = 0; m < 4; ++m) {
        const int row = u.pm * 256 + ai * 128 + wr * 64 + m * 16 + fr;
        u16* pr = C + (size_t)row * 2048 + u.pn * 256 + 32 * wc + 4 * fq;
#pragma unroll
        for (int bj = 0; bj < 2; ++bj)
#pragma unroll
          for (int n = 0; n < 2; ++n) {
            const pg8::f32x4 v = acc[ai][bj][m][n];
            uint2 o;
            o.x = pack2(v[0], v[1]);
            o.y = pack2(v[2], v[3]);
            *(uint2*)(pr + bj * 128 + 16 * n) = o;
          }
      }
  }
};
struct EpiIn1 {
  static constexpr bool PERM = false, AFTER_DRAIN = false;
  float* PROJ;
  float* DTA;
  const float* dtb;
  const float* alog;
  __device__ __forceinline__ void operator()(const pg8::f32x4 (&acc)[2][2][4][2], const pg8::Unit& u, int wr, int wc, int fr, int fq) const {
    float dtbv[4] = {0.f, 0.f, 0.f, 0.f}, aev[4] = {0.f, 0.f, 0.f, 0.f};
    if (u.pn == 23) {
      const int cc = 23 * 256 + 32 * wc + 4 * fq;
      const int hb = (cc >= 5920 && cc < 5936) ? (cc - 5920) : ((cc + 16 >= 5920 && cc + 16 < 5936) ? (cc + 16 - 5920) : -1);
      if (hb >= 0) {
#pragma unroll
        for (int j = 0; j < 4; ++j) { dtbv[j] = dtb[hb + j]; aev[j] = expf(alog[hb + j]); }
      }
    }
#pragma unroll
    for (int ai = 0; ai < 2; ++ai)
#pragma unroll
      for (int m = 0; m < 4; ++m) {
        const int row = u.pm * 256 + ai * 128 + wr * 64 + m * 16 + fr;
        float* pr = PROJ + (size_t)row * N1;
#pragma unroll
        for (int bj = 0; bj < 2; ++bj)
#pragma unroll
          for (int n = 0; n < 2; ++n) {
            const int col0 = u.pn * 256 + bj * 128 + 32 * wc + 16 * n + 4 * fq;
            pg8::f32x4 v = acc[ai][bj][m][n];
            if (col0 < 1024) {
              pg8::f32x4 o;
#pragma unroll
              for (int j = 0; j < 4; ++j) o[j] = siluf_(v[j]);
              *(pg8::f32x4*)(pr + col0) = o;
            } else if (col0 < 5920) {
              *(pg8::f32x4*)(pr + col0) = v;
            } else if (col0 < 5936) {
#pragma unroll
              for (int j = 0; j < 4; ++j) {
                int h = col0 + j - 5920;
                float dt = softplusf_(v[j] + dtbv[j]);
                DTA[(size_t)row * 64 + h * 4] = dt;
                DTA[(size_t)row * 64 + h * 4 + 1] = expf(-dt * aev[j]);
              }
            }
          }
      }
  }
};

struct Seg {
  int off;
  int ld;
  int n4;
};

template <int NS, int NF4, int RG>
DEVI void stage_init(const float* wsf, const Seg (&sg)[NS], int row0, int tid, const float* (&ptr)[RG], int (&ldv)[RG]) {
  asm volatile("" : "+v"(tid));
#pragma unroll
  for (int q = 0; q < RG; ++q) {
    int flat = tid + q * 256;
    int t = flat / NF4, f = flat % NF4;
    if (flat >= 16 * NF4) { t = 0; f = 0; }
    int off = 0, ld = 0, ff = f;
    bool done = false;
#pragma unroll
    for (int s = 0; s < NS; ++s) {
      bool here = (!done) && (ff < sg[s].n4);
      off = here ? (sg[s].off + (row0 + t) * sg[s].ld + ff * 4) : off;
      ld = here ? sg[s].ld : ld;
      ff = (done || here) ? ff : (ff - sg[s].n4);
      done = done || here;
    }
    ptr[q] = wsf + off;
    ldv[q] = ld;
  }
}
template <int NF4, int RG>
DEVI void stage_issue(const float* const (&ptr)[RG], const int (&ldv)[RG], int st, int nsteps, int tid, f32x4 (&rg)[RG]) {
#pragma unroll
  for (int q = 0; q < RG; ++q) {
    int flat = tid + q * 256;
    if (flat < nsteps * NF4) rg[q] = *(const f32x4*)(ptr[q] + (st * 16) * ldv[q]);
  }
}
template <int NF4, int RG>
DEVI void stage_commit(float* buf, int nsteps, int tid, const f32x4 (&rg)[RG]) {
#pragma unroll
  for (int q = 0; q < RG; ++q) {
    int flat = tid + q * 256;
    if (flat < nsteps * NF4) ((f32x4*)buf)[flat] = rg[q];
  }
}

template <int MODE>
DEVI void colrec_long(const float* wsf, const Seg (&sg)[4], int row0, int T, float gamma, float* outp, int ldo, float* stout, int st_ld,
                      float* smem) {
  constexpr int NF4 = 69, W = 276, RG = 5;
  const int tid = threadIdx.x & 255, w = tid >> 6, lane = tid & 63, c = lane >> 4, s = lane & 15;
  smem += (threadIdx.x >> 8) * (VB_BYTES / 4);
  float S[8];
#pragma unroll
  for (int i = 0; i < 8; ++i) S[i] = 0.f;
  float* buf0 = smem;
  float* buf1 = smem + 16 * 336;
  float* obuf = smem + 2 * 16 * 336;
  const int nst = (T + 15) / 16;
  f32x4 rgA[RG], rgB[RG];
  const float* sptr[RG];
  int sld[RG];
  stage_init<4, NF4, RG>(wsf, sg, row0, tid, sptr, sld);
  auto step = [&](const float* sp, float* ob, int tt) -> float {
    float4 a0 = *(const float4*)(sp + s * 8), a1 = *(const float4*)(sp + s * 8 + 4);
    float4 q0 = *(const float4*)(sp + 128 + s * 8), q1 = *(const float4*)(sp + 128 + s * 8 + 4);
    float a[8] = {a0.x, a0.y, a0.z, a0.w, a1.x, a1.y, a1.z, a1.w};
    float q[8] = {q0.x, q0.y, q0.z, q0.w, q1.x, q1.y, q1.z, q1.w};
    float val = sp[256 + w * 4 + c];
    float dA = gamma;
    if (MODE == 2) {
      val *= sp[272];
      dA = sp[273];
    }
    float o = 0.f;
#pragma unroll
    for (int i = 0; i < 8; ++i) {
      if (MODE == 0) S[i] = val + a[i] * (S[i] - val);
      else S[i] = dA * S[i] + a[i] * val;
      o += q[i] * S[i];
    }
    return red16(o);
  };
  auto run_stage = [&](const float* b, float* ob, int nthis) {
#pragma unroll 1
    for (int tt = 0; tt < nthis; tt += 4) {
      float o0 = step(b + tt * W, ob, tt);
      float o1 = step(b + (tt + 1) * W, ob, tt + 1);
      float o2 = step(b + (tt + 2) * W, ob, tt + 2);
      float o3 = step(b + (tt + 3) * W, ob, tt + 3);
      const int base = (s == 0) ? (tt * 16 + w * 4 + c) : (1024 + (tid & 255));
      const int st16 = (s == 0) ? 16 : 0;
      ob[base] = o0;
      ob[base + st16] = o1;
      ob[base + 2 * st16] = o2;
      ob[base + 3 * st16] = o3;
    }
  };
  auto write_out = [&](const float* ob, int st, int nthis) {
    if (tid < nthis * 4) {
      int t = tid >> 2, c4 = tid & 3;
      *(float4*)(outp + (size_t)(st * 16 + t) * ldo + c4 * 4) = *(const float4*)(ob + t * 16 + c4 * 4);
    }
  };
  auto nsteps = [&](int st) { return min(16, T - st * 16); };
  stage_issue<NF4, RG>(sptr, sld, 0, nsteps(0), tid, rgA);
  stage_commit<NF4, RG>(buf0, nsteps(0), tid, rgA);
  if (nst > 1) stage_issue<NF4, RG>(sptr, sld, 1, nsteps(1), tid, rgB);
  __syncthreads();
#pragma unroll 1
  for (int st = 0; st < nst; st += 2) {
    if (st + 2 < nst) stage_issue<NF4, RG>(sptr, sld, st + 2, nsteps(st + 2), tid, rgA);
    run_stage(buf0, obuf, nsteps(st));
    if (st + 1 < nst) stage_commit<NF4, RG>(buf1, nsteps(st + 1), tid, rgB);
    __syncthreads();
    write_out(obuf, st, nsteps(st));
    if (st + 1 < nst) {
      if (st + 3 < nst) stage_issue<NF4, RG>(sptr, sld, st + 3, nsteps(st + 3), tid, rgB);
      run_stage(buf1, obuf + 512, nsteps(st + 1));
      if (st + 2 < nst) stage_commit<NF4, RG>(buf0, nsteps(st + 2), tid, rgA);
      __syncthreads();
      write_out(obuf + 512, st + 1, nsteps(st + 1));
    }
  }
#pragma unroll
  for (int i = 0; i < 8; ++i) stout[(size_t)(s * 8 + i) * st_ld + w * 4 + c] = S[i];
  __syncthreads();
}

template <int MODE>
DEVI void colrec_short(const float* pa, int lda_, const float* pq, int ldq, const float* pc, int ldc, const float* pdt,
                       long row0, float gamma, const float* stin, float* stout, int st_ld, float* outp, int ldo,
                       float* smem) {
  const int tid = threadIdx.x & 255, lane = tid & 63;
  const int wid = __builtin_amdgcn_readfirstlane(tid >> 6);
  const int k0 = wid * 32;
  smem += (threadIdx.x >> 8) * (VB_BYTES / 4);
  float S[32];
#pragma unroll
  for (int i = 0; i < 32; ++i) S[i] = stin[(size_t)(k0 + i) * st_ld + lane];
  float aq[4], vv[4], dAv[4];
#pragma unroll
  for (int t = 0; t < 4; ++t) {
    long row = row0 + t;
    aq[t] = (lane < 32) ? pa[(size_t)row * lda_ + k0 + lane] : pq[(size_t)row * ldq + k0 + (lane - 32)];
    vv[t] = pc[(size_t)row * ldc + lane];
    dAv[t] = gamma;
    if (MODE == 2) {
      vv[t] *= pdt[(size_t)row * 64];
      dAv[t] = pdt[(size_t)row * 64 + 1];
    }
  }
#pragma unroll
  for (int t = 0; t < 4; ++t) {
    const float val = vv[t], dA = dAv[t];
    float o = 0.f;
#pragma unroll
    for (int i = 0; i < 32; ++i) {
      const float a = rlf_(aq[t], i), q = rlf_(aq[t], 32 + i);
      if (MODE == 0) S[i] = val + a * (S[i] - val);
      else S[i] = dA * S[i] + a * val;
      o += q * S[i];
    }
    smem[(wid * 4 + t) * 64 + lane] = o;
  }
#pragma unroll
  for (int i = 0; i < 32; ++i) stout[(size_t)(k0 + i) * st_ld + lane] = S[i];
  __syncthreads();
  {
    int t = tid >> 6;
    float sum = smem[(0 * 4 + t) * 64 + lane] + smem[(1 * 4 + t) * 64 + lane] + smem[(2 * 4 + t) * 64 + lane] +
                smem[(3 * 4 + t) * 64 + lane];
    outp[(size_t)(row0 + t) * ldo + lane] = sum;
  }
  __syncthreads();
}

DEVI void rwkv_item(const float* wsf, const Seg (&sg)[6], int row0, int T, const float* stin, float* stout, float* outp, int ldo,
                    float* smem) {
  constexpr int NF4 = 84, W = 336, RG = 6;
  const int tid = threadIdx.x & 255, w = tid >> 6, lane = tid & 63, rl = lane >> 4, sl = lane & 15;
  smem += (threadIdx.x >> 8) * (VB_BYTES / 4);
  const int il = w * 4 + rl;
  float S[4];
  if (stin) {
    float4 v = *(const float4*)(stin + il * 64 + sl * 4);
    S[0] = v.x; S[1] = v.y; S[2] = v.z; S[3] = v.w;
  } else {
    S[0] = S[1] = S[2] = S[3] = 0.f;
  }
  float* buf0 = smem;
  float* buf1 = smem + 16 * 336;
  float* obuf = smem + 2 * 16 * 336;
  const int nst = (T + 15) / 16;
  f32x4 rgA[RG], rgB[RG];
  const float* sptr[RG];
  int sld[RG];
  stage_init<6, NF4, RG>(wsf, sg, row0, tid, sptr, sld);
  auto run_stage = [&](const float* b, float* ob, int nthis) {
#pragma unroll 4
    for (int tt = 0; tt < nthis; ++tt) {
      const float* sp = b + tt * W;
      float4 r4 = *(const float4*)(sp + sl * 4);
      float4 w4 = *(const float4*)(sp + 64 + sl * 4);
      float4 k4 = *(const float4*)(sp + 128 + sl * 4);
      float4 n4 = *(const float4*)(sp + 192 + sl * 4);
      float4 m4 = *(const float4*)(sp + 256 + sl * 4);
      float vi = sp[320 + il];
      float sa = S[0] * n4.x + S[1] * n4.y + S[2] * n4.z + S[3] * n4.w;
      sa = -red16(sa);
      S[0] = S[0] * w4.x + sa * m4.x + vi * k4.x;
      S[1] = S[1] * w4.y + sa * m4.y + vi * k4.y;
      S[2] = S[2] * w4.z + sa * m4.z + vi * k4.z;
      S[3] = S[3] * w4.w + sa * m4.w + vi * k4.w;
      float y = S[0] * r4.x + S[1] * r4.y + S[2] * r4.z + S[3] * r4.w;
      y = red16(y);
      ob[(sl == 0) ? (tt * 16 + il) : (1024 + (tid & 255))] = y;
    }
  };
  auto write_out = [&](const float* ob, int st, int nthis) {
    if (tid < nthis * 4) {
      int t = tid >> 2, c4 = tid & 3;
      *(float4*)(outp + (size_t)(st * 16 + t) * ldo + c4 * 4) = *(const float4*)(ob + t * 16 + c4 * 4);
    }
  };
  auto nsteps = [&](int st) { return min(16, T - st * 16); };
  stage_issue<NF4, RG>(sptr, sld, 0, nsteps(0), tid, rgA);
  stage_commit<NF4, RG>(buf0, nsteps(0), tid, rgA);
  if (nst > 1) stage_issue<NF4, RG>(sptr, sld, 1, nsteps(1), tid, rgB);
  __syncthreads();
  __builtin_amdgcn_s_setprio(3);
#pragma unroll 1
  for (int st = 0; st < nst; st += 2) {
    if (st + 2 < nst) stage_issue<NF4, RG>(sptr, sld, st + 2, nsteps(st + 2), tid, rgA);
    run_stage(buf0, obuf, nsteps(st));
    if (st + 1 < nst) stage_commit<NF4, RG>(buf1, nsteps(st + 1), tid, rgB);
    __syncthreads();
    write_out(obuf, st, nsteps(st));
    if (st + 1 < nst) {
      if (st + 3 < nst) stage_issue<NF4, RG>(sptr, sld, st + 3, nsteps(st + 3), tid, rgB);
      run_stage(buf1, obuf + 512, nsteps(st + 1));
      if (st + 2 < nst) stage_commit<NF4, RG>(buf0, nsteps(st + 2), tid, rgA);
      __syncthreads();
      write_out(obuf + 512, st + 1, nsteps(st + 1));
    }
  }
  __builtin_amdgcn_s_setprio(0);
  *(float4*)(stout + il * 64 + sl * 4) = make_float4(S[0], S[1], S[2], S[3]);
  __syncthreads();
}

DEVI void phase_rec0(const Params& p, float* smem) {
  char* ws = p.ws;
  const float* PROJ = (const float*)(ws + OFF_PROJ);
  float* OMIX = (float*)(ws + OFF_OMIX);
  const float* wsf = (const float*)ws;
  constexpr int PO = (int)(OFF_PROJ / 4);
  for (int item = blockIdx.x * 2 + (threadIdx.x >> 8); item < 4608; item += gridDim.x * 2) {
    if (item < 256) {
      int b = item >> 6, h = (item >> 3) & 7, cb = item & 7;
      Seg sg[4] = {{PO + 1024 + h * 128, N0, 32}, {PO + h * 128, N0, 32}, {PO + 2048 + h * 128 + cb * 16, N0, 4},
                   {PO, N0, 1}};
      int row0 = b * TP;
      colrec_long<0>(wsf, sg, row0, TP, 0.f, OMIX + (size_t)row0 * 2048 + h * 128 + cb * 16, 2048,
                     p.out + O_HGP + (size_t)(b * 8 + h) * 128 * 128 + cb * 16, 128, smem);
    } else if (item < 512) {
      int it = item - 256;
      int b = it >> 6, h = (it >> 4) & 3, cb = it & 15;
      Seg sg[4] = {{PO + 4608 + h * 128, N0, 32}, {PO + 4096 + h * 128, N0, 32},
                   {PO + 5120 + h * 256 + cb * 16, N0, 4}, {PO, N0, 1}};
      int row0 = b * TP;
      float gamma = 1.0f - exp2f(-5.0f - (float)h);
      colrec_long<1>(wsf, sg, row0, TP, gamma, OMIX + (size_t)row0 * 2048 + 1024 + h * 256 + cb * 16, 2048,
                     p.out + O_RTP + (size_t)(b * 4 + h) * 128 * 256 + cb * 16, 256, smem);
    } else if (item < 2560) {
      int it = item - 512;
      int b = it >> 4, h = (it >> 1) & 7, cb = it & 1;
      long row0 = MPR + (long)b * 4;
      size_t so = (size_t)(b * 8 + h) * 128 * 128 + cb * 64;
      colrec_short<0>(PROJ + 1024 + h * 128, N0, PROJ + h * 128, N0, PROJ + 2048 + h * 128 + cb * 64, N0, nullptr, row0,
                      0.f, p.in[I_SHG] + so, p.out + O_HGS + so, 128, OMIX + h * 128 + cb * 64, 2048, smem);
    } else {
      int it = item - 2560;
      int b = it >> 4, h = (it >> 2) & 3, cb = it & 3;
      long row0 = MPR + (long)b * 4;
      size_t so = (size_t)(b * 4 + h) * 128 * 256 + cb * 64;
      float gamma = 1.0f - exp2f(-5.0f - (float)h);
      colrec_short<1>(PROJ + 4608 + h * 128, N0, PROJ + 4096 + h * 128, N0, PROJ + 5120 + h * 256 + cb * 64, N0, nullptr,
                      row0, gamma, p.in[I_SRT] + so, p.out + O_RTS + so, 256, OMIX + 1024 + h * 256 + cb * 64, 2048,
                      smem);
    }
  }
}

DEVI float4 ld4(const float* p) { return *(const float4*)p; }
DEVI void st_bf4(u16* p, float a, float b, float c, float d) {
  uint2 o;
  o.x = pack2(a, b);
  o.y = pack2(c, d);
  *(uint2*)p = o;
}
DEVI float wsum_u_(float v) {
  v = red16(v);
  return (rlf_(v, 0) + rlf_(v, 16)) + (rlf_(v, 32) + rlf_(v, 48));
}
DEVI float red32(float v) {
  v = red16(v);
  return v + __shfl_xor(v, 16, 64);
}
DEVI void phase_post0(const Params& p) {
  char* ws = p.ws;
  const float* PROJ = (const float*)(ws + OFF_PROJ);
  const float* OMIX = (const float*)(ws + OFF_OMIX);
  u16* MIXB = (u16*)(ws + OFF_MIXB);
  const float* ng = p.in[I_HNG];
  const int lane = threadIdx.x & 63;
  const int gw = blockIdx.x * 8 + (threadIdx.x >> 6), nw = gridDim.x * 8;
  const float4 g4 = ld4(ng + (lane & 31) * 4);
  for (int row = gw; row < M; row += nw) {
    const float* o = OMIX + (size_t)row * 2048;
    const float* pr = PROJ + (size_t)row * N0;
    u16* mo = MIXB + (size_t)row * 2048;
    float4 a[4], ga[4], bq[4], gb[4];
#pragma unroll
    for (int it = 0; it < 4; ++it) {
      int c = it * 256 + lane * 4;
      a[it] = ld4(o + c);
      ga[it] = ld4(pr + 3072 + c);
      bq[it] = ld4(o + 1024 + c);
      gb[it] = ld4(pr + 6144 + c);
    }
#pragma unroll
    for (int it = 0; it < 4; ++it) {
      int c = it * 256 + lane * 4;
      float ss = red32(a[it].x * a[it].x + a[it].y * a[it].y + a[it].z * a[it].z + a[it].w * a[it].w);
      float inv = rsqrtf(ss * (1.0f / 128.0f) + 1e-6f);
      st_bf4(mo + c, a[it].x * inv * g4.x * ga[it].x, a[it].y * inv * g4.y * ga[it].y, a[it].z * inv * g4.z * ga[it].z,
             a[it].w * inv * g4.w * ga[it].w);
      float mu = wsum_u_(bq[it].x + bq[it].y + bq[it].z + bq[it].w) * (1.0f / 256.0f);
      float dx = bq[it].x - mu, dy = bq[it].y - mu, dz = bq[it].z - mu, dw = bq[it].w - mu;
      float var = wsum_u_(dx * dx + dy * dy + dz * dz + dw * dw) * (1.0f / 256.0f);
      float iv = rsqrtf(var + 1e-5f);
      st_bf4(mo + 1024 + c, dx * iv * gb[it].x, dy * iv * gb[it].y, dz * iv * gb[it].z, dw * iv * gb[it].w);
    }
  }
}

DEVI void phase_ln(const Params& p, const float* addsrc, const float* g, const float* bta) {
  char* ws = p.ws;
  float* XF = (float*)(ws + OFF_XF);
  u16* XB = (u16*)(ws + OFF_XB);
  const int lane = threadIdx.x & 63;
  const int gw = blockIdx.x * 8 + (threadIdx.x >> 6), nw = gridDim.x * 8;
  for (int row = gw; row < M; row += nw) {
    float4* xr = (float4*)(XF + (size_t)row * 2048);
    const float4* ar = (const float4*)(addsrc + (size_t)row * 2048);
    float v[32];
    float s = 0.f;
#pragma unroll
    for (int i = 0; i < 8; ++i) {
      float4 x = xr[i * 64 + lane], a = ar[i * 64 + lane];
      v[i * 4 + 0] = ALPHA * x.x + a.x;
      v[i * 4 + 1] = ALPHA * x.y + a.y;
      v[i * 4 + 2] = ALPHA * x.z + a.z;
      v[i * 4 + 3] = ALPHA * x.w + a.w;
      s += v[i * 4 + 0] + v[i * 4 + 1] + v[i * 4 + 2] + v[i * 4 + 3];
    }
    float mu = wsum(s) * (1.0f / 2048.0f);
    float q = 0.f;
#pragma unroll
    for (int i = 0; i < 32; ++i) {
      v[i] -= mu;
      q += v[i] * v[i];
    }
    float inv = rsqrtf(wsum(q) * (1.0f / 2048.0f) + 1e-5f);
#pragma unroll
    for (int i = 0; i < 8; ++i) {
      float4 gg = ((const float4*)g)[i * 64 + lane], bb = ((const float4*)bta)[i * 64 + lane];
      float4 y;
      y.x = v[i * 4 + 0] * inv * gg.x + bb.x;
      y.y = v[i * 4 + 1] * inv * gg.y + bb.y;
      y.z = v[i * 4 + 2] * inv * gg.z + bb.z;
      y.w = v[i * 4 + 3] * inv * gg.w + bb.w;
      xr[i * 64 + lane] = y;
      uint2 o;
      o.x = pack2(y.x, y.y);
      o.y = pack2(y.z, y.w);
      ((uint2*)(XB + (size_t)row * 2048))[i * 64 + lane] = o;
    }
  }
}

typedef __attribute__((ext_vector_type(2))) __bf16 bf2_t;
typedef __attribute__((ext_vector_type(2))) float f32x2;
DEVI float dot2bf(unsigned a, unsigned b, float acc) {
  return __builtin_amdgcn_fdot2_f32_bf16(__builtin_bit_cast(bf2_t, a), __builtin_bit_cast(bf2_t, b), acc, false);
}
template <int CTRL>
DEVI int dppi(int v) {
  return __builtin_amdgcn_update_dpp(v, v, CTRL, 0xF, 0xF, false);
}
DEVI int wmax_i(int v) {
  v = max(v, dppi<0xB1>(v));
  v = max(v, dppi<0x4E>(v));
  v = max(v, dppi<0x141>(v));
  v = max(v, dppi<0x140>(v));
  int a = __builtin_amdgcn_readlane(v, 0), b = __builtin_amdgcn_readlane(v, 16);
  int c = __builtin_amdgcn_readlane(v, 32), d = __builtin_amdgcn_readlane(v, 48);
  return max(max(a, b), max(c, d));
}
DEVI float rlf(float v, int l) { return __int_as_float(__builtin_amdgcn_readlane(__float_as_int(v), l)); }
DEVI float wsum_u(float v) {
  v = red16(v);
  return (rlf(v, 0) + rlf(v, 16)) + (rlf(v, 32) + rlf(v, 48));
}
DEVI int fkey(float f) {
  int u = __float_as_int(f);
  return u ^ ((u >> 31) & 0x7fffffff);
}
DEVI float keyf(int k) { return __int_as_float(k ^ ((k >> 31) & 0x7fffffff)); }

DEVI void conv_fp8_rows(const float* __restrict__ src, unsigned char* __restrict__ dst, float* __restrict__ scales) {
  const int lane = threadIdx.x & 63;
  const int gw = blockIdx.x * 8 + (threadIdx.x >> 6), nw = gridDim.x * 8;
  for (int e = gw; e < 16384; e += nw) {
    const float* r = src + (size_t)e * 2048;
    float4 v[8];
    float am = 0.f;
#pragma unroll
    for (int q = 0; q < 8; ++q) {
      v[q] = *(const float4*)(r + (q >> 2) * 1024 + lane * 16 + (q & 3) * 4);
      am = fmaxf(am, fmaxf(fmaxf(fabsf(v[q].x), fabsf(v[q].y)), fmaxf(fabsf(v[q].z), fabsf(v[q].w))));
    }
    float amax = __int_as_float(wmax_i(__float_as_int(am)));
    float inv = (amax > 0.f) ? (440.0f / amax) : 0.f;
    float scale = (amax > 0.f) ? (amax * (1.0f / 440.0f)) : 1.0f;
#pragma unroll
    for (int j = 0; j < 2; ++j) {
      u32x4 o;
#pragma unroll
      for (int k = 0; k < 4; ++k) {
        float4 t = v[j * 4 + k];
        int pk = 0;
        pk = __builtin_amdgcn_cvt_pk_fp8_f32(t.x * inv, t.y * inv, pk, false);
        pk = __builtin_amdgcn_cvt_pk_fp8_f32(t.z * inv, t.w * inv, pk, true);
        o[k] = (unsigned)pk;
      }
      *(u32x4*)(dst + (size_t)e * 2048 + j * 1024 + lane * 16) = o;
    }
    if (lane == 0) scales[e] = scale;
  }
}

DEVI void phase_peer(const Params& p, int layer, bool final_out) {
  char* ws = p.ws;
  const float* SC = (const float*)(ws + OFF_GOUT);
  float* XF = (float*)(ws + OFF_XF);
  u16* XB = (u16*)(ws + OFF_XB);
  const unsigned char* UB = (const unsigned char*)(ws + OFF_UB);
  const unsigned char* VB = (const unsigned char*)(ws + OFF_VB);
  const float* USC = (const float*)(ws + OFF_USC);
  const float* VSC = (const float*)(ws + OFF_VSC);
  const float* g = p.in[I_LNG] + (size_t)(layer * 2 + 1) * D;
  const float* bta = p.in[I_LNB] + (size_t)(layer * 2 + 1) * D;
  const int lane = threadIdx.x & 63;
  const int gw = blockIdx.x * 8 + (threadIdx.x >> 6), nw = gridDim.x * 8;
  constexpr int KMIN = (int)0x80000000;
  for (int row = gw; row < M; row += nw) {
    const float* sr = SC + (size_t)row * 2048;
    int eidx0 = 0, eidx1 = 0;
    float gate0 = 0.f, gate1 = 0.f;
#pragma unroll 1
    for (int hp = 0; hp < 2; ++hp) {
      int hd[4] = {hp * 2, hp * 2 + 1, hp * 2 + 4, hp * 2 + 5};
      int ka[4][2], kb[4][2], my[4][2];
#pragma unroll
      for (int n = 0; n < 4; ++n) {
        const float* sp = sr + hd[n] * 256;
#pragma unroll
        for (int c = 0; c < 2; ++c) {
          ka[n][c] = (fkey(sp[c * 128 + lane]) & ~127) | (127 - lane);
          kb[n][c] = (fkey(sp[c * 128 + 64 + lane]) & ~127) | (63 - lane);
          my[n][c] = KMIN;
        }
      }
#pragma unroll 1
      for (int r = 0; r < 16; ++r) {
#pragma unroll
        for (int n = 0; n < 4; ++n)
#pragma unroll
          for (int c = 0; c < 2; ++c) {
            int K = wmax_i(max(ka[n][c], kb[n][c]));
            my[n][c] = (lane == r) ? K : my[n][c];
            ka[n][c] = (ka[n][c] == K) ? KMIN : ka[n][c];
            kb[n][c] = (kb[n][c] == K) ? KMIN : kb[n][c];
          }
      }
      const int jb = (lane & 3) * 4;
      int cc[4][4], myk[4];
      int ti0[4], ti1[4];
#pragma unroll
      for (int n = 0; n < 4; ++n) {
        const float ts0 = keyf(my[n][0] & ~127), ts1 = keyf(my[n][1] & ~127);
        ti0[n] = 127 - (my[n][0] & 127);
        ti1[n] = 127 - (my[n][1] & 127);
        const float s0 = __shfl(ts0, lane >> 2, 64);
#pragma unroll
        for (int q = 0; q < 4; ++q) cc[n][q] = (fkey(s0 + __shfl(ts1, jb + q, 64)) & ~255) | (255 - (lane * 4 + q));
        myk[n] = KMIN;
      }
#pragma unroll 1
      for (int r = 0; r < 16; ++r) {
#pragma unroll
        for (int n = 0; n < 4; ++n) {
          int K = wmax_i(max(max(cc[n][0], cc[n][1]), max(cc[n][2], cc[n][3])));
          myk[n] = (lane == r) ? K : myk[n];
#pragma unroll
          for (int q = 0; q < 4; ++q) cc[n][q] = (cc[n][q] == K) ? KMIN : cc[n][q];
        }
      }
#pragma unroll
      for (int n = 0; n < 4; ++n) {
        const float bs = keyf(myk[n] & ~255);
        const int bf = 255 - (myk[n] & 255);
        const int e = __shfl(ti0[n], (bf >> 4) & 15, 64) * 128 + __shfl(ti1[n], bf & 15, 64);
        const float ev = (lane < 16) ? expf(bs - rlf(bs, 0)) : 0.f;
        const float gt = ev / wsum_u(ev);
        const int e_b = __shfl(e, lane & 15, 64);
        const float g_b = __shfl(gt, lane & 15, 64);
        const int hh = hp * 2 + (n & 1);
        if ((lane >> 4) == hh) {
          if (n < 2) { eidx0 = e_b; gate0 = g_b; }
          else { eidx1 = e_b; gate1 = g_b; }
        }
      }
    }
    float dv0 = 0.f, dv1 = 0.f;
    {
      float xf[32];
      {
        const float4* xr = (const float4*)(XF + (size_t)row * 2048);
#pragma unroll
        for (int q = 0; q < 8; ++q) {
          float4 t = xr[(q >> 2) * 256 + lane * 4 + (q & 3)];
          xf[q * 4 + 0] = t.x; xf[q * 4 + 1] = t.y; xf[q * 4 + 2] = t.z; xf[q * 4 + 3] = t.w;
        }
      }
      constexpr int R = 8;
      u32x4 w[R][2];
      float sc[R];
      auto load_row = [&](int pidx, u32x4(&wr)[2], float& scv) {
        int src = (pidx < 64) ? eidx0 : eidx1;
        int e = __builtin_amdgcn_readlane(src, pidx & 63);
        const u32x4* ur = (const u32x4*)(UB + (size_t)e * 2048);
        wr[0] = ur[lane];
        wr[1] = ur[64 + lane];
        scv = USC[e];
      };
#pragma unroll
      for (int u = 0; u < R; ++u) load_row(u, w[u], sc[u]);
#pragma unroll 1
      for (int p0 = 0; p0 < 128; p0 += R) {
#pragma unroll
        for (int u = 0; u < R; ++u) {
          float d = 0.f;
#pragma unroll
          for (int j = 0; j < 2; ++j) {
#pragma unroll
            for (int k = 0; k < 4; ++k) {
              int dw = (int)w[u][j][k];
              f32x2 lo = __builtin_amdgcn_cvt_pk_f32_fp8(dw, false);
              f32x2 hi = __builtin_amdgcn_cvt_pk_f32_fp8(dw, true);
              d += lo.x * xf[j * 16 + k * 4 + 0];
              d += lo.y * xf[j * 16 + k * 4 + 1];
              d += hi.x * xf[j * 16 + k * 4 + 2];
              d += hi.y * xf[j * 16 + k * 4 + 3];
            }
          }
          float scu = sc[u];
          if (p0 + R < 128) load_row(p0 + R + u, w[u], sc[u]);
          d = wsum_u(d) * scu;
          int pl = (p0 + u) & 63;
          if (p0 < 64) dv0 = (lane == pl) ? d : dv0;
          else dv1 = (lane == pl) ? d : dv1;
          __builtin_amdgcn_sched_barrier(0);
        }
      }
    }
    float coef0 = 0.5f * dv0 * (1.0f + erff(dv0 * 0.70710678118f)) * gate0;
    float coef1 = 0.5f * dv1 * (1.0f + erff(dv1 * 0.70710678118f)) * gate1;
    f32x2 o2[16];
#pragma unroll
    for (int i = 0; i < 16; ++i) o2[i] = f32x2{0.f, 0.f};
    {
      constexpr int R = 8;
      u32x4 w[R][2];
      float sc[R];
      auto load_row = [&](int pidx, u32x4(&wr)[2], float& scv) {
        int src = (pidx < 64) ? eidx0 : eidx1;
        int e = __builtin_amdgcn_readlane(src, pidx & 63);
        const u32x4* vr = (const u32x4*)(VB + (size_t)e * 2048);
        wr[0] = vr[lane];
        wr[1] = vr[64 + lane];
        scv = VSC[e];
      };
#pragma unroll
      for (int u = 0; u < R; ++u) load_row(u, w[u], sc[u]);
#pragma unroll 1
      for (int p0 = 0; p0 < 128; p0 += R) {
        float cfs = (p0 < 64) ? coef0 : coef1;
#pragma unroll
        for (int u = 0; u < R; ++u) {
          float c = rlf(cfs, (p0 + u) & 63) * sc[u];
          f32x2 cc = f32x2{c, c};
#pragma unroll
          for (int j = 0; j < 2; ++j) {
#pragma unroll
            for (int k = 0; k < 4; ++k) {
              int dw = (int)w[u][j][k];
              o2[j * 8 + k * 2 + 0] += cc * __builtin_amdgcn_cvt_pk_f32_fp8(dw, false);
              o2[j * 8 + k * 2 + 1] += cc * __builtin_amdgcn_cvt_pk_f32_fp8(dw, true);
            }
          }
          if (p0 + R < 128) load_row(p0 + R + u, w[u], sc[u]);
          __builtin_amdgcn_sched_barrier(0);
        }
      }
    }
    float o[32];
#pragma unroll
    for (int i = 0; i < 16; ++i) {
      o[2 * i] = o2[i].x;
      o[2 * i + 1] = o2[i].y;
    }
    float s = 0.f;
    {
      const float4* xr = (const float4*)(XF + (size_t)row * 2048);
#pragma unroll
      for (int q = 0; q < 8; ++q) {
        float4 t = xr[(q >> 2) * 256 + lane * 4 + (q & 3)];
        o[q * 4 + 0] += ALPHA * t.x; o[q * 4 + 1] += ALPHA * t.y; o[q * 4 + 2] += ALPHA * t.z; o[q * 4 + 3] += ALPHA * t.w;
      }
#pragma unroll
      for (int i = 0; i < 32; ++i) s += o[i];
    }
    float mu = wsum_u(s) * (1.0f / 2048.0f);
    float q = 0.f;
#pragma unroll
    for (int i = 0; i < 32; ++i) {
      o[i] -= mu;
      q += o[i] * o[i];
    }
    float inv = rsqrtf(wsum_u(q) * (1.0f / 2048.0f) + 1e-5f);
    float* dstf;
    if (final_out) {
      if (row < MPR) {
        int b = row / TP, t = row % TP;
        dstf = (t >= 16) ? (p.out + O_YP + ((size_t)b * 2048 + (t - 16)) * D) : nullptr;
      } else {
        dstf = p.out + O_YS + (size_t)(row - MPR) * D;
      }
    } else {
      dstf = XF + (size_t)row * 2048;
    }
#pragma unroll
    for (int j = 0; j < 2; ++j) {
      float yv[16];
#pragma unroll
      for (int k = 0; k < 4; ++k) {
        float4 gv = *(const float4*)(g + j * 1024 + lane * 16 + k * 4);
        float4 bv = *(const float4*)(bta + j * 1024 + lane * 16 + k * 4);
        float4 y;
        y.x = o[j * 16 + k * 4 + 0] * inv * gv.x + bv.x;
        y.y = o[j * 16 + k * 4 + 1] * inv * gv.y + bv.y;
        y.z = o[j * 16 + k * 4 + 2] * inv * gv.z + bv.z;
        y.w = o[j * 16 + k * 4 + 3] * inv * gv.w + bv.w;
        if (dstf) *(float4*)(dstf + j * 1024 + lane * 16 + k * 4) = y;
        yv[k * 4 + 0] = y.x; yv[k * 4 + 1] = y.y; yv[k * 4 + 2] = y.z; yv[k * 4 + 3] = y.w;
      }
      if (!final_out) {
        uint4* xb = (uint4*)(XB + (size_t)row * 2048 + j * 1024 + lane * 16);
        xb[0] = make_uint4(pack2(yv[0], yv[1]), pack2(yv[2], yv[3]), pack2(yv[4], yv[5]), pack2(yv[6], yv[7]));
        xb[1] = make_uint4(pack2(yv[8], yv[9]), pack2(yv[10], yv[11]), pack2(yv[12], yv[13]), pack2(yv[14], yv[15]));
      }
    }
  }
}

DEVI float4 f4mul(float4 a, float4 b) { return make_float4(a.x * b.x, a.y * b.y, a.z * b.z, a.w * b.w); }
DEVI void row_info(int row, bool& prompt, int& b, int& t, int& T) {
  prompt = row < MPR;
  if (prompt) { b = row / TP; t = row - b * TP; T = TP; }
  else { b = (row - MPR) >> 2; t = (row - MPR) & 3; T = 4; }
}
DEVI void phase_pre1(const Params& p) {
  char* ws = p.ws;
  const float* PROJ = (const float*)(ws + OFF_PROJ);
  float* XC = (float*)(ws + OFF_GOUT);
  float* RKV = (float*)(ws + OFF_RKV);
  u16* LRA = (u16*)(ws + OFF_LRA);
  u16* LRB = (u16*)(ws + OFF_LRB);
  u16* LRG = (u16*)(ws + OFF_LRG);
  const float* cw = p.in[I_CVW];
  const float* cbias = p.in[I_CVB];
  const float* mu = p.in[I_MU];
  const int gtid = blockIdx.x * 512 + threadIdx.x, nthr = gridDim.x * 512;
#pragma unroll 2
  for (int idx = gtid; idx < M * 384; idx += nthr) {
    int row = idx / 384, c = (idx - row * 384) * 4;
    bool prompt; int b, t, T;
    row_info(row, prompt, b, t, T);
    float4 xv[4];
#pragma unroll
    for (int jj = 0; jj < 4; ++jj) {
      int tt = t - 3 + jj;
      if (tt >= 0) xv[jj] = ld4(PROJ + (size_t)(row - 3 + jj) * N1 + 1024 + c);
      else if (prompt) xv[jj] = make_float4(0.f, 0.f, 0.f, 0.f);
      else xv[jj] = ld4(p.in[I_SCV] + (size_t)(b * 3 + (tt + 3)) * 1536 + c);
    }
    float4 acc = ld4(cbias + c);
#pragma unroll
    for (int jj = 0; jj < 4; ++jj) {
      float4 w = ld4(cw + jj * 1536 + c);
      acc.x += xv[jj].x * w.x; acc.y += xv[jj].y * w.y; acc.z += xv[jj].z * w.z; acc.w += xv[jj].w * w.w;
    }
    *(float4*)(XC + (size_t)row * 1536 + c) = make_float4(siluf_(acc.x), siluf_(acc.y), siluf_(acc.z), siluf_(acc.w));
    if (t >= T - 3) {
      float* co = prompt ? (p.out + O_CVP) : (p.out + O_CVS);
      *(float4*)(co + (size_t)(b * 3 + (t - (T - 3))) * 1536 + c) = xv[3];
    }
  }
#pragma unroll 2
  for (int idx = gtid; idx < M * 840; idx += nthr) {
    int row = idx / 840, c = (idx - row * 840) * 4;
    bool prompt; int b, t, T;
    row_info(row, prompt, b, t, T);
    float4 cur = ld4(PROJ + (size_t)row * N1 + 2560 + c);
    float4 prev;
    if (t > 0) prev = ld4(PROJ + (size_t)(row - 1) * N1 + 2560 + c);
    else if (prompt) prev = make_float4(0.f, 0.f, 0.f, 0.f);
    else prev = ld4(p.in[I_SSH] + (size_t)b * 3360 + c);
    float4 m4 = ld4(mu + c);
    float4 mx;
    mx.x = cur.x + (prev.x - cur.x) * m4.x; mx.y = cur.y + (prev.y - cur.y) * m4.y;
    mx.z = cur.z + (prev.z - cur.z) * m4.z; mx.w = cur.w + (prev.w - cur.w) * m4.w;
    if (c < 3072) *(float4*)(RKV + (size_t)row * 3072 + c) = mx;
    else if (c < 3136) st_bf4(LRA + (size_t)row * 64 + (c - 3072), tanhf(mx.x), tanhf(mx.y), tanhf(mx.z), tanhf(mx.w));
    else if (c < 3200) st_bf4(LRB + (size_t)row * 64 + (c - 3136), mx.x, mx.y, mx.z, mx.w);
    else st_bf4(LRG + (size_t)row * 192 + (c - 3200), sigmoidf_(mx.x), sigmoidf_(mx.y), sigmoidf_(mx.z), sigmoidf_(mx.w));
    if (t == T - 1) {
      float* so = prompt ? (p.out + O_SHP) : (p.out + O_SHS);
      *(float4*)(so + (size_t)b * 3360 + c) = cur;
    }
  }
  for (int idx = gtid; idx < M * 4; idx += nthr) {
    int row = idx >> 2, k = idx & 3;
    ((uint4*)(LRG + (size_t)row * 192 + 160))[k] = make_uint4(0, 0, 0, 0);
  }
}

DEVI void phase_pre1c(const Params& p) {
  char* ws = p.ws;
  float* RKV = (float*)(ws + OFF_RKV);
  const float* AA = (const float*)(ws + OFF_AA);
  float* KK = (float*)(ws + OFF_QB);
  float* KKA = (float*)(ws + OFF_MIXB);
  float* BON = (float*)(ws + OFF_BON);
  const float* k_k = p.in[I_KK];
  const float* k_a = p.in[I_KA];
  const float* r_k = p.in[I_RK];
  const int lane = threadIdx.x & 63;
  const int gw = blockIdx.x * 8 + (threadIdx.x >> 6), nw = gridDim.x * 8;
  for (int row = gw; row < M; row += nw) {
    float4 k4[4], r4[4], a4[4];
#pragma unroll
    for (int it = 0; it < 4; ++it) {
      int c = it * 256 + lane * 4;
      k4[it] = ld4(RKV + (size_t)row * 3072 + 1024 + c);
      r4[it] = ld4(RKV + (size_t)row * 3072 + c);
      a4[it] = ld4(AA + (size_t)row * 1024 + c);
    }
#pragma unroll
    for (int it = 0; it < 4; ++it) {
      int c = it * 256 + lane * 4;
      float4 kk4 = ld4(k_k + c), ka4 = ld4(k_a + c), rk4 = ld4(r_k + c);
      float4 k = k4[it], r = r4[it], a = a4[it];
      float4 kr = f4mul(k, kk4);
      float ss = red16(kr.x * kr.x + kr.y * kr.y + kr.z * kr.z + kr.w * kr.w);
      float inv = 1.0f / fmaxf(sqrtf(ss), 1e-12f);
      float4 kk = make_float4(kr.x * inv, kr.y * inv, kr.z * inv, kr.w * inv);
      float4 kp;
      kp.x = k.x * (1.0f + (a.x - 1.0f) * ka4.x); kp.y = k.y * (1.0f + (a.y - 1.0f) * ka4.y);
      kp.z = k.z * (1.0f + (a.z - 1.0f) * ka4.z); kp.w = k.w * (1.0f + (a.w - 1.0f) * ka4.w);
      float bon = red16(r.x * kp.x * rk4.x + r.y * kp.y * rk4.y + r.z * kp.z * rk4.z + r.w * kp.w * rk4.w);
      *(float4*)(KK + (size_t)row * 1024 + c) = kk;
      *(float4*)(KKA + (size_t)row * 1024 + c) = f4mul(kk, a);
      *(float4*)(RKV + (size_t)row * 3072 + 1024 + c) = kp;
      if ((lane & 15) == 0) BON[(size_t)row * 16 + it * 4 + (lane >> 4)] = bon;
    }
  }
}

DEVI void rwkv_short(const float* __restrict__ RKV, const float* __restrict__ DEC, const float* __restrict__ KK,
                     const float* __restrict__ KKA, int h, int rb, int row0, const float* __restrict__ stin,
                     float* __restrict__ stout, float* __restrict__ outp) {
  const int tid = threadIdx.x & 255, w = tid >> 6, lane = tid & 63, rl = lane >> 4, sl = lane & 15;
  const int il = w * 4 + rl;
  float4 sv = *(const float4*)(stin + il * 64 + sl * 4);
  float S[4] = {sv.x, sv.y, sv.z, sv.w};
  float4 r4[4], w4[4], k4[4], n4[4], m4[4];
  float vi[4];
#pragma unroll
  for (int t = 0; t < 4; ++t) {
    const size_t row = (size_t)(row0 + t);
    r4[t] = *(const float4*)(RKV + row * 3072 + h * 64 + sl * 4);
    w4[t] = *(const float4*)(DEC + row * 1024 + h * 64 + sl * 4);
    k4[t] = *(const float4*)(RKV + row * 3072 + 1024 + h * 64 + sl * 4);
    n4[t] = *(const float4*)(KK + row * 1024 + h * 64 + sl * 4);
    m4[t] = *(const float4*)(KKA + row * 1024 + h * 64 + sl * 4);
    vi[t] = RKV[row * 3072 + 2048 + h * 64 + rb * 16 + il];
  }
#pragma unroll
  for (int t = 0; t < 4; ++t) {
    float sa = S[0] * n4[t].x + S[1] * n4[t].y + S[2] * n4[t].z + S[3] * n4[t].w;
    sa = -red16(sa);
    S[0] = S[0] * w4[t].x + sa * m4[t].x + vi[t] * k4[t].x;
    S[1] = S[1] * w4[t].y + sa * m4[t].y + vi[t] * k4[t].y;
    S[2] = S[2] * w4[t].z + sa * m4[t].z + vi[t] * k4[t].z;
    S[3] = S[3] * w4[t].w + sa * m4[t].w + vi[t] * k4[t].w;
    float y = S[0] * r4[t].x + S[1] * r4[t].y + S[2] * r4[t].z + S[3] * r4[t].w;
    y = red16(y);
    if (sl == 0) outp[(size_t)t * 2048 + il] = y;
  }
  *(float4*)(stout + il * 64 + sl * 4) = make_float4(S[0], S[1], S[2], S[3]);
}

DEVI void phase_rec1(const Params& p, float* smem) {
  char* ws = p.ws;
  const float* XC = (const float*)(ws + OFF_GOUT);
  const float* RKV = (const float*)(ws + OFF_RKV);
  const float* DEC = (const float*)(ws + OFF_DEC);
  const float* KK = (const float*)(ws + OFF_QB);
  const float* KKA = (const float*)(ws + OFF_MIXB);
  const float* DTA = (const float*)(ws + OFF_DTA);
  float* OMIX = (float*)(ws + OFF_OMIX);
  const float* wsf = (const float*)ws;
  constexpr int XO = (int)(OFF_GOUT / 4), DO = (int)(OFF_DTA / 4), RO = (int)(OFF_RKV / 4), CO = (int)(OFF_DEC / 4),
                KO = (int)(OFF_QB / 4), AO = (int)(OFF_MIXB / 4);
  const int half = threadIdx.x >> 8;
  for (int li = blockIdx.x; li < 256; li += gridDim.x) {
    if (half == 0) {
      int b = li >> 6, h = (li >> 2) & 15, cb = li & 3;
      int g = h >> 3;
      Seg sg[4] = {{XO + 1024 + g * 128, 1536, 32}, {XO + 1280 + g * 128, 1536, 32}, {XO + h * 64 + cb * 16, 1536, 4},
                   {DO + h * 4, 64, 1}};
      int row0 = b * TP;
      colrec_long<2>(wsf, sg, row0, TP, 0.f, OMIX + (size_t)row0 * 2048 + h * 64 + cb * 16, 2048,
                     p.out + O_SSP + (size_t)(b * 16 + h) * 128 * 64 + cb * 16, 64, smem);
    } else {
      int b = li >> 6, h = (li >> 2) & 15, rb = li & 3;
      int row0 = b * TP;
      Seg sg[6] = {{RO + h * 64, 3072, 16}, {CO + h * 64, 1024, 16}, {RO + 1024 + h * 64, 3072, 16},
                   {KO + h * 64, 1024, 16}, {AO + h * 64, 1024, 16}, {RO + 2048 + h * 64 + rb * 16, 3072, 4}};
      size_t so = ((size_t)(b * 16 + h) * 64 + rb * 16) * 64;
      rwkv_item(wsf, sg, row0, TP, nullptr, p.out + O_WKP + so, OMIX + (size_t)row0 * 2048 + 1024 + h * 64 + rb * 16, 2048, smem);
    }
  }
  for (int it = blockIdx.x * 2 + half; it < 2048; it += gridDim.x * 2) {
    int b = it >> 4, h = it & 15;
    int g = h >> 3;
    long row0 = MPR + (long)b * 4;
    size_t so = (size_t)(b * 16 + h) * 128 * 64;
    colrec_short<2>(XC + 1024 + g * 128, 1536, XC + 1280 + g * 128, 1536, XC + h * 64, 1536, DTA + h * 4, row0, 0.f,
                    p.in[I_SSM] + so, p.out + O_SSS + so, 64, OMIX + h * 64, 2048, smem);
  }
  for (int it = blockIdx.x * 2 + half; it < 8192; it += gridDim.x * 2) {
    int b = it >> 6, h = (it >> 2) & 15, rb = it & 3;
    int row0 = MPR + b * 4;
    size_t so = ((size_t)(b * 16 + h) * 64 + rb * 16) * 64;
    rwkv_short(RKV, DEC, KK, KKA, h, rb, row0, p.in[I_SWK] + so, p.out + O_WKS + so,
               OMIX + (size_t)row0 * 2048 + 1024 + h * 64 + rb * 16);
  }
}

DEVI void phase_post1(const Params& p) {
  char* ws = p.ws;
  const float* PROJ = (const float*)(ws + OFF_PROJ);
  const float* OMIX = (const float*)(ws + OFF_OMIX);
  const float* XC = (const float*)(ws + OFF_GOUT);
  const float* RKV = (const float*)(ws + OFF_RKV);
  const float* GG = (const float*)(ws + OFF_GG);
  const float* BON = (const float*)(ws + OFF_BON);
  u16* MIXB = (u16*)(ws + OFF_MIXB);
  const float* dsk = p.in[I_DSK];
  const float* sng = p.in[I_SNG];
  const float* lxg = p.in[I_LXG];
  const float* lxb = p.in[I_LXB];
  const int lane = threadIdx.x & 63;
  const int gw = blockIdx.x * 8 + (threadIdx.x >> 6), nw = gridDim.x * 8;
  for (int row = gw; row < M; row += nw) {
    const float* o = OMIX + (size_t)row * 2048;
    u16* mo = MIXB + (size_t)row * 2048;
    float4 oc[4], xc[4], z[4], y[4], v[4], gg[4];
    float bn[4];
#pragma unroll
    for (int it = 0; it < 4; ++it) {
      int c = it * 256 + lane * 4;
      oc[it] = ld4(o + c);
      xc[it] = ld4(XC + (size_t)row * 1536 + c);
      z[it] = ld4(PROJ + (size_t)row * N1 + c);
      y[it] = ld4(o + 1024 + c);
      v[it] = ld4(RKV + (size_t)row * 3072 + 2048 + c);
      gg[it] = ld4(GG + (size_t)row * 1024 + c);
      bn[it] = BON[(size_t)row * 16 + it * 4 + (lane >> 4)];
    }
    float4 val[4];
    float ssq[4];
#pragma unroll
    for (int it = 0; it < 4; ++it) {
      float ds = dsk[it * 4 + (lane >> 4)];
      val[it].x = (oc[it].x + xc[it].x * ds) * z[it].x;
      val[it].y = (oc[it].y + xc[it].y * ds) * z[it].y;
      val[it].z = (oc[it].z + xc[it].z * ds) * z[it].z;
      val[it].w = (oc[it].w + xc[it].w * ds) * z[it].w;
      ssq[it] = val[it].x * val[it].x + val[it].y * val[it].y + val[it].z * val[it].z + val[it].w * val[it].w;
    }
    float inv0 = rsqrtf(wsum_u_(ssq[0] + ssq[1]) * (1.0f / 512.0f) + 1e-6f);
    float inv1 = rsqrtf(wsum_u_(ssq[2] + ssq[3]) * (1.0f / 512.0f) + 1e-6f);
#pragma unroll
    for (int it = 0; it < 4; ++it) {
      int c = it * 256 + lane * 4;
      float inv = (it < 2) ? inv0 : inv1;
      float4 sg = ld4(sng + c);
      st_bf4(mo + c, val[it].x * inv * sg.x, val[it].y * inv * sg.y, val[it].z * inv * sg.z, val[it].w * inv * sg.w);
      float mu = red16(y[it].x + y[it].y + y[it].z + y[it].w) * (1.0f / 64.0f);
      float dx = y[it].x - mu, dy = y[it].y - mu, dz = y[it].z - mu, dw = y[it].w - mu;
      float var = red16(dx * dx + dy * dy + dz * dz + dw * dw) * (1.0f / 64.0f);
      float iv = rsqrtf(var + 64e-5f);
      float4 lg = ld4(lxg + c), lb = ld4(lxb + c);
      float y0 = (dx * iv * lg.x + lb.x + bn[it] * v[it].x) * gg[it].x;
      float y1 = (dy * iv * lg.y + lb.y + bn[it] * v[it].y) * gg[it].y;
      float y2 = (dz * iv * lg.z + lb.z + bn[it] * v[it].z) * gg[it].z;
      float y3 = (dw * iv * lg.w + lb.w + bn[it] * v[it].w) * gg[it].w;
      st_bf4(mo + 1024 + c, y0, y1, y2, y3);
    }
  }
}

#define XB_TMO      128
#define XB_XCNT(j)  (256  + 64 * (j))
#define XB_XSUB(j)  (1280 + 64 * (j))
#define XB_XGEN(j)  (2304 + 64 * (j))
#define XB_TOP      3328
#define XB_TOPGEN   3392
#define XCD_BAR_WORDS 3456
#define XB_SPIN_CAP (1u << 18)
#define LAS __attribute__((address_space(3)))

__device__ __forceinline__ unsigned xb_ld(unsigned* p)              { return __hip_atomic_load(p, __ATOMIC_RELAXED, __HIP_MEMORY_SCOPE_AGENT); }
__device__ __forceinline__ unsigned xb_add(unsigned* p, unsigned v) { return __hip_atomic_fetch_add(p, v, __ATOMIC_RELAXED, __HIP_MEMORY_SCOPE_AGENT); }
__device__ __forceinline__ unsigned xb_xcc_id() { return (unsigned)__builtin_amdgcn_s_getreg((3 << 11) | 20) & 0xFu; }
#define XB_SPIN(cond, bar) do { unsigned _sp = 0; while (cond) { __builtin_amdgcn_s_sleep(1); \
    if ((++_sp & 255u) == 0u) { if (xb_ld(&(bar)[XB_TMO])) break; if (_sp > XB_SPIN_CAP) { atomicAdd(&(bar)[XB_TMO], 1u); break; } } } } while (0)

struct XcdBarrier {
    unsigned* bar; unsigned x;
    volatile LAS unsigned* st;
};

__device__ __forceinline__ XcdBarrier xcd_barrier_post(unsigned* bar, volatile LAS unsigned* st) {
    XcdBarrier b; b.bar = bar; b.x = xb_xcc_id(); b.st = st;
    if (threadIdx.x == 0) (void)xb_add(&bar[XB_XCNT(b.x)], 1u);
    return b;
}
__device__ __forceinline__ void xcd_barrier_complete(unsigned* bar, unsigned x, unsigned& nloc, unsigned& nx) {
    const unsigned G = gridDim.x * gridDim.y * gridDim.z;
    unsigned sum, cnt, mine, sp = 0u;
    for (;;) {
        sum = 0u; cnt = 0u; mine = 0u;
#pragma unroll
        for (unsigned j = 0; j < 16; ++j) { const unsigned c = xb_ld(&bar[XB_XCNT(j)]); sum += c; cnt += (c > 0u) ? 1u : 0u; mine = (j == x) ? c : mine; }
        if (sum == G) break;
        __builtin_amdgcn_s_sleep(1);
        if ((++sp & 255u) == 0u) { if (xb_ld(&bar[XB_TMO])) break; if (sp > XB_SPIN_CAP) { atomicAdd(&bar[XB_TMO], 1u); break; } }
    }
    nloc = mine > 0u ? mine : 1u; nx = cnt > 0u ? cnt : 1u;
}

__device__ __forceinline__ void xcd_barrier(const XcdBarrier& b) {
    asm volatile("s_waitcnt vmcnt(0)" ::: "memory");
    __syncthreads();
    if (threadIdx.x == 0) {
        unsigned* bar = b.bar;
        __builtin_amdgcn_s_waitcnt(0);
        unsigned nloc = b.st[0], nx = b.st[1];
        if (nloc == 0u) { xcd_barrier_complete(bar, b.x, nloc, nx); b.st[0] = nloc; b.st[1] = nx; }
        const unsigned old = xb_add(&bar[XB_XSUB(b.x)], 1u);
        const unsigned gen = old / nloc;
        if (old + 1u == (gen + 1u) * nloc) {
            __builtin_amdgcn_fence(__ATOMIC_RELEASE, "agent");
            asm volatile("s_waitcnt vmcnt(0)" ::: "memory");
            const unsigned og = xb_add(&bar[XB_TOP], 1u);
            const unsigned tg = og / nx;
            if (og + 1u == (tg + 1u) * nx) xb_add(&bar[XB_TOPGEN], 1u);
            else XB_SPIN(xb_ld(&bar[XB_TOPGEN]) == tg, bar);
            __builtin_amdgcn_fence(__ATOMIC_ACQUIRE, "agent");
            xb_add(&bar[XB_XGEN(b.x)], 1u);
            asm volatile("s_waitcnt vmcnt(0)" ::: "memory");
        } else {
            XB_SPIN(xb_ld(&bar[XB_XGEN(b.x)]) == gen, bar);
            __builtin_amdgcn_fence(__ATOMIC_ACQUIRE, "agent");
            asm volatile("s_waitcnt vmcnt(0)" ::: "memory");
        }
    }
    __syncthreads();
}


template <int ph>
DEVI void run_phase(const Params& p, char* smem_raw) {
  float* smem = (float*)smem_raw;
  char* ws = p.ws;
  {
    switch (ph) {
      case 0:
        phase0(p, smem);
        conv_fp8_rows(p.in[I_PU], (unsigned char*)(ws + OFF_UB), (float*)(ws + OFF_USC));
        conv_fp8_rows(p.in[I_PV], (unsigned char*)(ws + OFF_VB), (float*)(ws + OFF_VSC));
        break;
      case 1: {
        EpiIn0 E{(float*)(ws + OFF_PROJ), (const float*)(ws + OFF_LB), (const float*)(ws + OFF_INVREV)};
        pg8::Gemm g{(const pg8::bf16_t*)(ws + OFF_XB), (const pg8::bf16_t*)(ws + OFF_WIN0), MP, N0, 2048};
        pg8::StaticOrder S;
        S.init(MP, N0, (int)gridDim.x, (int)blockIdx.x);
        pg8::gemm_phase<EpiIn0, pg8::StaticOrder, false>((PG8_LAS unsigned char*)smem_raw, g, S, E, nullptr);
      } break;
      case 2: phase_rec0(p, smem); break;
      case 3: phase_post0(p); break;
      case 4: case 15: {
        EpiStoreF32 E{(float*)(ws + OFF_GOUT)};
        pg8::Gemm g{(const pg8::bf16_t*)(ws + OFF_MIXB), (const pg8::bf16_t*)(ws + (ph == 4 ? OFF_WOUT0 : OFF_WOUT1)), MP, 2048, 2048};
        pg8::StaticOrder S;
        S.init(MP, 2048, (int)gridDim.x, (int)blockIdx.x);
        pg8::gemm_phase<EpiStoreF32, pg8::StaticOrder, false>((PG8_LAS unsigned char*)smem_raw, g, S, E, nullptr);
      } break;
      case 5: case 16: {
        int l = (ph == 5) ? 0 : 1;
        phase_ln(p, (const float*)(ws + OFF_GOUT), p.in[I_LNG] + (size_t)(l * 2) * D, p.in[I_LNB] + (size_t)(l * 2) * D);
      } break;
      case 6: case 17: {
        EpiStoreBf16 E{(u16*)(ws + OFF_QB)};
        pg8::Gemm g{(const pg8::bf16_t*)(ws + OFF_XB), (const pg8::bf16_t*)(ws + (ph == 6 ? OFF_WQ0 : OFF_WQ1)), MP, 2048, 2048};
        pg8::StaticOrder S;
        S.init(MP, 2048, (int)gridDim.x, (int)blockIdx.x);
        pg8::gemm_phase<EpiStoreBf16, pg8::StaticOrder, false>((PG8_LAS unsigned char*)smem_raw, g, S, E, nullptr);
      } break;
      case 7: case 18: {
        float* SC = (float*)(ws + OFF_GOUT);
        gemm_phase((const u16*)(ws + OFF_QB), 2048, 128, (const u16*)(ws + (ph == 7 ? OFF_KEY0 : OFF_KEY1)), 128,
                   69, 16, smem_raw, [=](int row, int col, float v0, float v1) {
                     SC[(size_t)row * 2048 + col] = v0;
                     SC[(size_t)row * 2048 + col + 32] = v1;
                   });
      } break;
      case 8: phase_peer(p, 0, false); break;
      case 9: {
        conv_fp8_rows(p.in[I_PU] + (size_t)16384 * 2048, (unsigned char*)(ws + OFF_UB), (float*)(ws + OFF_USC));
        conv_fp8_rows(p.in[I_PV] + (size_t)16384 * 2048, (unsigned char*)(ws + OFF_VB), (float*)(ws + OFF_VSC));
        EpiIn1 E{(float*)(ws + OFF_PROJ), (float*)(ws + OFF_DTA), p.in[I_DTB], p.in[I_ALOG]};
        pg8::Gemm g{(const pg8::bf16_t*)(ws + OFF_XB), (const pg8::bf16_t*)(ws + OFF_WIN1), MP, N1, 2048};
        pg8::StaticOrder S;
        S.init(MP, N1, (int)gridDim.x, (int)blockIdx.x);
        pg8::gemm_phase<EpiIn1, pg8::StaticOrder, false>((PG8_LAS unsigned char*)smem_raw, g, S, E, nullptr);
      } break;
      case 10: phase_pre1(p); break;
      case 11: {
        float* DEC = (float*)(ws + OFF_DEC);
        float* AA = (float*)(ws + OFF_AA);
        float* GG = (float*)(ws + OFF_GG);
        const float* w0 = p.in[I_W0];
        const float* a0 = p.in[I_A0];
        gemm_phase((const u16*)(ws + OFF_LRA), 64, 0, (const u16*)(ws + OFF_W2T), 64, 69, 8, smem_raw,
                   [=](int row, int col, float v0, float v1) {
#pragma unroll
                     for (int e = 0; e < 2; ++e) {
                       int cc = col + e * 32;
                       float v = (e ? v1 : v0);
                       float ew = 0.60653065971f * sigmoidf_(v);
                       DEC[(size_t)row * 1024 + cc] = __builtin_amdgcn_exp2f(-1.44269504089f * ew);
                     }
                   }, w0);
        gemm_phase((const u16*)(ws + OFF_LRB), 64, 0, (const u16*)(ws + OFF_A2T), 64, 69, 8, smem_raw,
                   [=](int row, int col, float v0, float v1) {
                     AA[(size_t)row * 1024 + col] = sigmoidf_(v0);
                     AA[(size_t)row * 1024 + col + 32] = sigmoidf_(v1);
                   }, a0);
        gemm_phase((const u16*)(ws + OFF_LRG), 192, 0, (const u16*)(ws + OFF_G2T), 192, 69, 8, smem_raw,
                   [=](int row, int col, float v0, float v1) {
                     GG[(size_t)row * 1024 + col] = v0;
                     GG[(size_t)row * 1024 + col + 32] = v1;
                   });
      } break;
      case 12: phase_pre1c(p); break;
      case 13: phase_rec1(p, smem); break;
      case 14: phase_post1(p); break;
      case 19: phase_peer(p, 1, true); break;
      default: break;
    }
  }
}

__global__ void __launch_bounds__(512, 2) mega(Params p, int ph_lo, int ph_hi) {
  __shared__ __attribute__((aligned(16))) char smem_raw[SMEM_BYTES];
  __shared__ uint4 xb_words;
  cg::grid_group grid = cg::this_grid();
  if (threadIdx.x == 0) xb_words = make_uint4(0u, 0u, 0u, 0u);
  __syncthreads();
  XcdBarrier xb = xcd_barrier_post((unsigned*)(p.ws + OFF_BAR), (volatile LAS unsigned*)&xb_words);
  if (ph_hi > 1000) grid.sync();
#ifndef REPEAT_MASK
#define REPEAT_MASK 0
#endif
#define PHASE(K)                                          \
  if (ph_lo <= K && K < ph_hi) run_phase<K>(p, smem_raw); \
  if ((REPEAT_MASK >> K) & 1) { xcd_barrier(xb); run_phase<K>(p, smem_raw); } \
  if (ph_lo <= K && K + 1 < ph_hi) xcd_barrier(xb);
  PHASE(0) PHASE(1) PHASE(2) PHASE(3) PHASE(4) PHASE(5) PHASE(6) PHASE(7) PHASE(8) PHASE(9)
  PHASE(10) PHASE(11) PHASE(12) PHASE(13) PHASE(14) PHASE(15) PHASE(16) PHASE(17) PHASE(18) PHASE(19)
}
#ifdef PHASE_TEST
template <int PH>
__global__ void __launch_bounds__(512, 2) phk(Params p) {
  __shared__ __attribute__((aligned(16))) char smem_raw[SMEM_BYTES];
  run_phase<PH>(p, smem_raw);
}
#define INST(N) template __global__ void phk<N>(Params);
INST(0) INST(1) INST(2) INST(3) INST(4) INST(5) INST(6) INST(7) INST(8) INST(9) INST(10) INST(11) INST(12) INST(13) INST(14) INST(19)
#endif

constexpr int NPHASE = 20;

extern "C" void kernel_launch(void* const* d_in, const int* in_sizes, int n_in, void* d_out, int out_size, void* d_ws,
                              size_t ws_size, hipStream_t stream) {
  static int grid_blocks = 0;
  if (!grid_blocks) {
    int dev = 0, cus = 0, per_cu = 0;
    hipGetDevice(&dev);
    hipDeviceGetAttribute(&cus, hipDeviceAttributeMultiprocessorCount, dev);
    hipOccupancyMaxActiveBlocksPerMultiprocessor(&per_cu, mega, 512, 0);
    if (per_cu > 1) per_cu = 1;
    if (per_cu < 1) per_cu = 1;
    grid_blocks = cus * per_cu;
  }
  Params p{};
  for (int i = 0; i < 38; ++i) p.in[i] = (const float*)d_in[i];
  p.out = (float*)d_out;
  p.ws = (char*)d_ws;
  (void)hipMemsetAsync((char*)d_ws + OFF_BAR, 0, 3456 * 4, stream);
  int lo = 0, hi = NPHASE;
  void* args[] = {&p, &lo, &hi};
  hipError_t e = hipLaunchCooperativeKernel((void*)mega, dim3(grid_blocks), dim3(512), args, 0, stream);
  if (e != hipSuccess) fprintf(stderr, "cooperative launch failed: %s (grid %d)\n", hipGetErrorString(e), grid_blocks);
}
```

```cpp
#include <hip/hip_runtime.h>
#include <hip/hip_bf16.h>
#include <hip/hip_cooperative_groups.h>
#include <cstdio>
#include <cmath>
namespace cg = cooperative_groups;

#define DEVI __device__ __forceinline__
typedef unsigned short u16;
using bf16x8 = __attribute__((ext_vector_type(8))) short;
using f32x4 = __attribute__((ext_vector_type(4))) float;
using u32x4 = __attribute__((ext_vector_type(4))) unsigned int;

constexpr int D = 2048;
constexpr int TP = 2064;
constexpr int MPR = 8256;
constexpr int M = 8768;
constexpr int MP = 8960;
constexpr int N0 = 7168;
constexpr int N1 = 6144;
constexpr float ALPHA = 1.41421356237f;

constexpr size_t SZ_TAB = (size_t)16384 * 2048 * 2;
constexpr size_t OFF_UB = 0;
constexpr size_t OFF_VB = OFF_UB + SZ_TAB;
constexpr size_t OFF_WIN0 = OFF_VB + SZ_TAB;
constexpr size_t OFF_WOUT0 = OFF_WIN0 + (size_t)N0 * 2048 * 2;
constexpr size_t OFF_WQ0 = OFF_WOUT0 + (size_t)2048 * 2048 * 2;
constexpr size_t OFF_KEY0 = OFF_WQ0 + (size_t)2048 * 2048 * 2;
constexpr size_t OFF_WIN1 = OFF_KEY0 + (size_t)16 * 128 * 128 * 2;
constexpr size_t OFF_WOUT1 = OFF_WIN1 + (size_t)N1 * 2048 * 2;
constexpr size_t OFF_WQ1 = OFF_WOUT1 + (size_t)2048 * 2048 * 2;
constexpr size_t OFF_KEY1 = OFF_WQ1 + (size_t)2048 * 2048 * 2;
constexpr size_t OFF_W2T = OFF_KEY1 + (size_t)16 * 128 * 128 * 2;
constexpr size_t OFF_A2T = OFF_W2T + (size_t)1024 * 64 * 2;
constexpr size_t OFF_G2T = OFF_A2T + (size_t)1024 * 64 * 2;
constexpr size_t OFF_LB = OFF_G2T + (size_t)1024 * 192 * 2;
constexpr size_t OFF_INVREV = OFF_LB + 1024 * 4;
constexpr size_t OFF_XF = OFF_INVREV + 64 * 8;
constexpr size_t OFF_XB = OFF_XF + (size_t)MP * 2048 * 4;
constexpr size_t OFF_PROJ = OFF_XB + (size_t)MP * 2048 * 2;
constexpr size_t OFF_GOUT = OFF_PROJ + (size_t)MP * N0 * 4;
constexpr size_t OFF_OMIX = OFF_GOUT + (size_t)MP * 2048 * 4;
constexpr size_t OFF_MIXB = OFF_OMIX + (size_t)MP * 2048 * 4;
constexpr size_t OFF_QB = OFF_MIXB + (size_t)MP * 2048 * 2;
constexpr size_t OFF_RKV = OFF_QB + (size_t)MP * 2048 * 2;
constexpr size_t OFF_DEC = OFF_RKV + (size_t)MP * 3072 * 4;
constexpr size_t OFF_AA = OFF_DEC + (size_t)MP * 1024 * 4;
constexpr size_t OFF_GG = OFF_AA + (size_t)MP * 1024 * 4;
constexpr size_t OFF_LRA = OFF_GG + (size_t)MP * 1024 * 4;
constexpr size_t OFF_LRB = OFF_LRA + (size_t)MP * 64 * 2;
constexpr size_t OFF_LRG = OFF_LRB + (size_t)MP * 64 * 2;
constexpr size_t OFF_DTA = OFF_LRG + (size_t)MP * 192 * 2;
constexpr size_t OFF_BON = OFF_DTA + (size_t)MP * 64 * 4;
constexpr size_t OFF_USC = OFF_BON + (size_t)MP * 16 * 4;
constexpr size_t OFF_VSC = OFF_USC + 16384 * 4;
constexpr size_t OFF_BAR = OFF_VSC + 16384 * 4;
constexpr size_t WS_TOTAL = OFF_BAR + 3456 * 4;
static_assert(WS_TOTAL <= (size_t)1 << 30, "workspace too large");

constexpr size_t O_YP = 0;
constexpr size_t O_YS = O_YP + (size_t)4 * 2048 * 2048;
constexpr size_t O_HGP = O_YS + (size_t)128 * 4 * 2048;
constexpr size_t O_HGS = O_HGP + (size_t)4 * 8 * 128 * 128;
constexpr size_t O_RTP = O_HGS + (size_t)128 * 8 * 128 * 128;
constexpr size_t O_RTS = O_RTP + (size_t)4 * 4 * 128 * 256;
constexpr size_t O_SSP = O_RTS + (size_t)128 * 4 * 128 * 256;
constexpr size_t O_SSS = O_SSP + (size_t)4 * 16 * 128 * 64;
constexpr size_t O_CVP = O_SSS + (size_t)128 * 16 * 128 * 64;
constexpr size_t O_CVS = O_CVP + (size_t)4 * 3 * 1536;
constexpr size_t O_WKP = O_CVS + (size_t)128 * 3 * 1536;
constexpr size_t O_WKS = O_WKP + (size_t)4 * 16 * 64 * 64;
constexpr size_t O_SHP = O_WKS + (size_t)128 * 16 * 64 * 64;
constexpr size_t O_SHS = O_SHP + (size_t)4 * 3360;

struct Params {
  const float* in[38];
  float* out;
  char* ws;
};
enum { I_XP = 0, I_XS, I_SHG, I_SRT, I_SSM, I_SCV, I_SWK, I_SSH, I_META, I_LNG, I_LNB, I_EWIN, I_LBL, I_HNG, I_EWOUT,
       I_OWIN, I_CVW, I_CVB, I_DTB, I_ALOG, I_DSK, I_SNG, I_MU, I_W0, I_W2, I_A0, I_A2, I_G2, I_KK, I_KA, I_RK,
       I_LXG, I_LXB, I_OWOUT, I_WQ, I_KEYS, I_PU, I_PV };

constexpr int VB_BYTES = 2 * 2 * 128 * 72 * 2;
constexpr int SMEM_BYTES = 2 * VB_BYTES;

DEVI u16 f2bf(float f) {
  unsigned u = __float_as_uint(f);
  u += 0x7fffu + ((u >> 16) & 1u);
  return (u16)(u >> 16);
}
DEVI unsigned pack2(float a, float b) { return (unsigned)f2bf(a) | ((unsigned)f2bf(b) << 16); }
DEVI float bflo(unsigned u) { return __uint_as_float(u << 16); }
DEVI float bfhi(unsigned u) { return __uint_as_float(u & 0xffff0000u); }
DEVI float sigmoidf_(float x) { return __builtin_amdgcn_rcpf(1.0f + __builtin_amdgcn_exp2f(-1.44269504089f * x)); }
DEVI float siluf_(float x) { return x * __builtin_amdgcn_rcpf(1.0f + __builtin_amdgcn_exp2f(-1.44269504089f * x)); }
DEVI float sigmoid_acc(float x) { return 1.0f / (1.0f + expf(-x)); }
DEVI float silu_acc(float x) { return x / (1.0f + expf(-x)); }
DEVI float softplusf_(float x) { return fmaxf(x, 0.0f) + log1pf(expf(-fabsf(x))); }
DEVI float wsum(float v) {
#pragma unroll
  for (int o = 32; o > 0; o >>= 1) v += __shfl_xor(v, o, 64);
  return v;
}
DEVI float wmaxf_(float v) {
#pragma unroll
  for (int o = 32; o > 0; o >>= 1) v = fmaxf(v, __shfl_xor(v, o, 64));
  return v;
}
DEVI int wmini_(int v) {
#pragma unroll
  for (int o = 32; o > 0; o >>= 1) v = min(v, __shfl_xor(v, o, 64));
  return v;
}
template <int CTRL>
DEVI float dppf(float v) {
  return __int_as_float(__builtin_amdgcn_update_dpp(0, __float_as_int(v), CTRL, 0xF, 0xF, true));
}
DEVI float red8(float v) {
  v += dppf<0xB1>(v);
  v += dppf<0x4E>(v);
  v += dppf<0x141>(v);
  return v;
}
DEVI float red16(float v) {
  v = red8(v);
  v += dppf<0x140>(v);
  return v;
}
DEVI float rlf_(float v, int l) { return __int_as_float(__builtin_amdgcn_readlane(__float_as_int(v), l)); }
DEVI int row_pos(int row) { return row < MPR ? (row % TP) : (16384 + ((row - MPR) & 3)); }

DEVI void conv_bf16_flat(const float* __restrict__ src, u16* __restrict__ dst, size_t n4) {
  size_t stride = (size_t)gridDim.x * blockDim.x;
  for (size_t i = (size_t)blockIdx.x * blockDim.x + threadIdx.x; i < n4; i += stride) {
    float4 v = ((const float4*)src)[i];
    uint2 o;
    o.x = pack2(v.x, v.y);
    o.y = pack2(v.z, v.w);
    ((uint2*)dst)[i] = o;
  }
}

template <int MODE>
DEVI int colmap(int j) {
  if (MODE == 0) return j;
  if (MODE == 1) {
    if (j < 4096 || j >= 5120) return j;
    int hb = j & ~127, c = j & 127, wc = c >> 5, n = (c >> 4) & 1, r = c & 15;
    int d = n ? (64 + wc * 16 + r) : (wc * 16 + r);
    return hb + d;
  }
  if (j < 2560) return j;
  if (j < 5920) return j + 16;
  if (j < 5936) return 2560 + (j - 5920);
  return -1;
}

template <int MODE>
DEVI void transpose_job(const float* __restrict__ src, int ldsrc, int Ksrc, u16* __restrict__ dst, int Kdst, int ndst,
                        float* smem) {
  int ktiles = Kdst / 64, ntiles = ndst / 64;
  int tid = threadIdx.x & 255;
  const int half = threadIdx.x >> 8;
  smem += half * (64 * 65);
  for (int base = blockIdx.x * 2; base < ktiles * ntiles; base += gridDim.x * 2) {
    int tile = base + half;
    const bool valid = tile < ktiles * ntiles;
    if (!valid) tile = ktiles * ntiles - 1;
    int tn = tile / ktiles, tk = tile % ktiles;
    int j0 = tn * 64, k0 = tk * 64;
    int jj = (tid & 15) * 4;
    int sc = colmap<MODE>(j0 + jj);
#pragma unroll
    for (int i = 0; i < 4; ++i) {
      int kk = i * 16 + (tid >> 4);
      float4 v = make_float4(0.f, 0.f, 0.f, 0.f);
      if (sc >= 0 && (k0 + kk) < Ksrc) v = *(const float4*)(src + (size_t)(k0 + kk) * ldsrc + sc);
      smem[kk * 65 + jj] = v.x;
      smem[kk * 65 + jj + 1] = v.y;
      smem[kk * 65 + jj + 2] = v.z;
      smem[kk * 65 + jj + 3] = v.w;
    }
    __syncthreads();
    int jr = tid >> 2, kq = (tid & 3) * 16;
    unsigned pk[8];
#pragma unroll
    for (int e = 0; e < 8; ++e) pk[e] = pack2(smem[(kq + 2 * e) * 65 + jr], smem[(kq + 2 * e + 1) * 65 + jr]);
    uint4* dp = (uint4*)(dst + (size_t)(j0 + jr) * Kdst + k0 + kq);
    if (valid) {
      dp[0] = make_uint4(pk[0], pk[1], pk[2], pk[3]);
      dp[1] = make_uint4(pk[4], pk[5], pk[6], pk[7]);
    }
    __syncthreads();
  }
}

DEVI void phase0(const Params& p, float* smem) {
  char* ws = p.ws;
  conv_bf16_flat(p.in[I_KEYS], (u16*)(ws + OFF_KEY0), (size_t)16 * 128 * 128 / 4);
  conv_bf16_flat(p.in[I_KEYS] + (size_t)16 * 128 * 128, (u16*)(ws + OFF_KEY1), (size_t)16 * 128 * 128 / 4);
  transpose_job<1>(p.in[I_EWIN], N0, 2048, (u16*)(ws + OFF_WIN0), 2048, N0, smem);
  transpose_job<0>(p.in[I_EWOUT], 2048, 2048, (u16*)(ws + OFF_WOUT0), 2048, 2048, smem);
  transpose_job<0>(p.in[I_WQ], 2048, 2048, (u16*)(ws + OFF_WQ0), 2048, 2048, smem);
  transpose_job<0>(p.in[I_WQ] + (size_t)2048 * 2048, 2048, 2048, (u16*)(ws + OFF_WQ1), 2048, 2048, smem);
  transpose_job<2>(p.in[I_OWIN], 5936, 2048, (u16*)(ws + OFF_WIN1), 2048, N1, smem);
  transpose_job<0>(p.in[I_OWOUT], 2048, 2048, (u16*)(ws + OFF_WOUT1), 2048, 2048, smem);
  transpose_job<0>(p.in[I_W2], 1024, 64, (u16*)(ws + OFF_W2T), 64, 1024, smem);
  transpose_job<0>(p.in[I_A2], 1024, 64, (u16*)(ws + OFF_A2T), 64, 1024, smem);
  transpose_job<0>(p.in[I_G2], 1024, 160, (u16*)(ws + OFF_G2T), 192, 1024, smem);
  {
    float* XF = (float*)(ws + OFF_XF);
    u16* XB = (u16*)(ws + OFF_XB);
    size_t n4 = (size_t)MP * 512;
    size_t stride = (size_t)gridDim.x * blockDim.x;
    for (size_t i = (size_t)blockIdx.x * blockDim.x + threadIdx.x; i < n4; i += stride) {
      int row = (int)(i >> 9), c4 = (int)(i & 511);
      float4 v = make_float4(0.f, 0.f, 0.f, 0.f);
      if (row < MPR) {
        int b = row / TP, t = row % TP;
        const float* s = (t < 16) ? (p.in[I_META] + (size_t)t * D) : (p.in[I_XP] + ((size_t)b * 2048 + (t - 16)) * D);
        v = ((const float4*)s)[c4];
      } else if (row < M) {
        v = ((const float4*)(p.in[I_XS] + (size_t)(row - MPR) * D))[c4];
      }
      ((float4*)XF)[i] = v;
      uint2 o;
      o.x = pack2(v.x, v.y);
      o.y = pack2(v.z, v.w);
      ((uint2*)XB)[i] = o;
    }
  }
  if (blockIdx.x == 0) {
    float* LB = (float*)(ws + OFF_LB);
    const float* lg = p.in[I_LBL];
    for (int c = threadIdx.x; c < 1024; c += blockDim.x) {
      float a = lg[c], b = lg[1024 + c], d = lg[2048 + c];
      float m = fmaxf(a, fmaxf(b, d));
      float ea = expf(a - m), eb = expf(b - m), ed = expf(d - m);
      LB[c] = ea / (ea + eb + ed);
    }
    float* IR = (float*)(ws + OFF_INVREV);
    if (threadIdx.x < 64) {
      double d = (double)threadIdx.x;
      double v = exp(-d * (9.210340371976184 / 64.0)) * 0.15915494309189535;
      float h = (float)v;
      IR[threadIdx.x * 2] = h;
      IR[threadIdx.x * 2 + 1] = (float)(v - (double)h);
    }
  }
}

constexpr int G_LDS_STRIDE = 72;
constexpr int G_LDS_BUF = 2 * 128 * G_LDS_STRIDE;
template <class Epi>
DEVI void gemm_phase(const u16* __restrict__ A, int lda, int a_ntile_off, const u16* __restrict__ Bt, int K, int mtiles,
                     int ntiles, char* smem, Epi epi, const float* __restrict__ colc = nullptr) {
  const int half = threadIdx.x >> 8;
  u16* S0 = (u16*)(smem + half * VB_BYTES);
  const int tid = threadIdx.x & 255, wid = tid >> 6, lane = tid & 63, wr = wid >> 1, wc = wid & 1, fr = lane & 15, fq = lane >> 4;
  const int nk = K / 64;
  const int ntot = mtiles * ntiles;
  for (int base = blockIdx.x * 2; base < ntot; base += gridDim.x * 2) {
    int tile = base + half;
    const bool valid = tile < ntot;
    if (!valid) tile = ntot - 1;
    const int tm = tile / ntiles, tn = tile - tm * ntiles;
    const int brow = tm * 128, bcol = tn * 128;
    const u16* Ag = A + (size_t)brow * lda + (size_t)tn * a_ntile_off;
    const u16* Bg = Bt + (size_t)bcol * K;
    f32x4 acc[4][4];
#pragma unroll
    for (int m = 0; m < 4; ++m)
#pragma unroll
      for (int n = 0; n < 4; ++n) acc[m][n] = f32x4{0.f, 0.f, 0.f, 0.f};
    u32x4 ra0[4], rb0[4], ra1[4], rb1[4];
    auto gload = [&](int t, u32x4(&ra)[4], u32x4(&rb)[4]) {
#pragma unroll
      for (int i = 0; i < 4; ++i) {
        int c = tid + i * 256, r = c >> 3, kc = c & 7;
        ra[i] = *(const u32x4*)(Ag + (size_t)r * lda + t * 64 + kc * 8);
        rb[i] = *(const u32x4*)(Bg + (size_t)r * K + t * 64 + kc * 8);
      }
    };
    auto lwrite = [&](int buf, const u32x4(&ra)[4], const u32x4(&rb)[4]) {
      u16* SA = S0 + buf * G_LDS_BUF;
      u16* SB = SA + 128 * G_LDS_STRIDE;
#pragma unroll
      for (int i = 0; i < 4; ++i) {
        int c = tid + i * 256, r = c >> 3, kc = c & 7;
        *(u32x4*)(SA + r * G_LDS_STRIDE + kc * 8) = ra[i];
        *(u32x4*)(SB + r * G_LDS_STRIDE + kc * 8) = rb[i];
      }
    };
    auto compute = [&](int buf) {
      const u16* SA = S0 + buf * G_LDS_BUF;
      const u16* SB = SA + 128 * G_LDS_STRIDE;
#pragma unroll
      for (int kh = 0; kh < 2; ++kh) {
        bf16x8 At[4], Bl[4];
#pragma unroll
        for (int m = 0; m < 4; ++m)
          At[m] = *(const bf16x8*)(SA + (wr * 64 + m * 16 + fr) * G_LDS_STRIDE + kh * 32 + fq * 8);
#pragma unroll
        for (int n = 0; n < 4; ++n)
          Bl[n] = *(const bf16x8*)(SB + (wc * 64 + n * 16 + fr) * G_LDS_STRIDE + kh * 32 + fq * 8);
#pragma unroll
        for (int m = 0; m < 4; ++m)
#pragma unroll
          for (int n = 0; n < 4; ++n) acc[m][n] = __builtin_amdgcn_mfma_f32_16x16x32_bf16(At[m], Bl[n], acc[m][n], 0, 0, 0);
        __builtin_amdgcn_sched_barrier(0);
      }
    };
    gload(0, ra0, rb0);
    if (nk > 1) gload(1, ra1, rb1);
    lwrite(0, ra0, rb0);
    __syncthreads();
#pragma unroll 1
    for (int t = 0; t < nk; t += 2) {
      if (t + 2 < nk) gload(t + 2, ra0, rb0);
      compute(0);
      if (t + 1 < nk) lwrite(1, ra1, rb1);
      __syncthreads();
      if (t + 1 < nk) {
        if (t + 3 < nk) gload(t + 3, ra1, rb1);
        compute(1);
        if (t + 2 < nk) lwrite(0, ra0, rb0);
        __syncthreads();
      }
    }
    if (valid) {
      float cc[4] = {0.f, 0.f, 0.f, 0.f};
      if (colc) {
#pragma unroll
        for (int n = 0; n < 4; ++n) cc[n] = colc[bcol + wc * 64 + n * 16 + fr];
      }
#pragma unroll
      for (int m = 0; m < 4; ++m)
#pragma unroll
        for (int n = 0; n < 2; ++n)
#pragma unroll
          for (int j = 0; j < 4; ++j) {
            int row = brow + wr * 64 + m * 16 + fq * 4 + j;
            int col = bcol + wc * 64 + n * 16 + fr;
            epi(row, col, acc[m][n][j] + cc[n], acc[m][n + 2][j] + cc[n + 2]);
          }
    }
  }
}


namespace pg8 {
#define PG8_LAS __attribute__((address_space(3)))
typedef unsigned short bf16_t;
typedef short bf16x8 __attribute__((ext_vector_type(8)));
typedef float f32x4 __attribute__((ext_vector_type(4)));
typedef unsigned u32x4 __attribute__((ext_vector_type(4)));
constexpr int BM = 256, BK = 64, HALF = 128, HTB = HALF * BK * 2  , STAGE_BYTES = 8 * HTB, NXCD = 8, WGM = 8;

__host__ __device__ __forceinline__ int lds_byte(int r, int c) { const int st = (r >> 4) * 2 + (c >> 5), rr = r & 15, cc = c & 31, ob = rr * 64 + cc * 2; return st * 1024 + (ob ^ (((ob >> 9) & 1) << 5)); }
__host__ __device__ __forceinline__ void stage_rc(int b, int& R, int& C) { const int st = b / 1024, sb = b % 1024, swz = sb ^ (((sb >> 9) & 1) << 5); R = (st >> 1) * 16 + swz / 64; C = (st & 1) * 32 + (swz % 64) / 2; }
__host__ __device__ __forceinline__ int perm32(int rho) { const int n = rho >> 4, i = rho & 15; return 8 * (i >> 2) + 4 * n + (i & 3); }

struct Unit { int pm, pn; };
struct Gemm { const bf16_t* A; const bf16_t* Bt; int M, N, K; };

struct StaticOrder {
    int nM, nN, nwg, G, c;
    __host__ __device__ void init(int M, int N, int G_, int c_) { nM = M / BM; nN = N / BM; nwg = nM * nN; G = G_; c = c_; }
    __host__ __device__ bool next(int i, Unit& u) const {
        const long L = (long)i * G + c; if (L >= nwg) return false;
        int wgid = (int)L; { const int q = nwg / NXCD, r = nwg % NXCD, xcd = wgid % NXCD, off = wgid / NXCD; wgid = (xcd < r ? xcd * (q + 1) : r * (q + 1) + (xcd - r) * q) + off; }
        const int nig = WGM * nN, gid = wgid / nig, fm = gid * WGM, gsz = (nM - fm) < WGM ? (nM - fm) : WGM;
        u.pm = fm + ((wgid % nig) % gsz); u.pn = (wgid % nig) / gsz; return true;
    }
    __device__ __forceinline__ void a_ready(const Unit&) const {}
    __device__ __forceinline__ void done(const Unit&) const {}
};
template <class Epi, class Sched, bool STAMP = false>
__device__ __forceinline__ void gemm_phase(PG8_LAS unsigned char* lds, const Gemm g, const Sched& S, const Epi& E, unsigned long long* stamps) {
    const int tid = threadIdx.x, wid = __builtin_amdgcn_readfirstlane(tid >> 6), lane = tid & 63, wr = wid >> 2, wc = wid & 3, fr = lane & 15, fq = lane >> 4;
    const int K = g.K, nt = K / BK;
    int ts_lo = 0, ts_hi = 0, nts = 0; const unsigned long long rt_entry = STAMP ? (unsigned long long)wall_clock64() : 0ull;
#define PG8_STAMP() do { if (STAMP && wid == 0 && nts < 64) { const unsigned long long _c = (unsigned long long)clock64(); \
        ts_lo = (lane == nts) ? (int)(unsigned)_c : ts_lo; ts_hi = (lane == nts) ? (int)(unsigned)(_c >> 32) : ts_hi; ++nts; } } while (0)
    PG8_STAMP();
    unsigned voffA[2], voffB[2];
#pragma unroll
    for (int i = 0; i < 2; ++i) { int R, C; stage_rc(tid * 16 + i * 8192, R, C); const int Rb = Epi::PERM ? ((R & ~31) + perm32(R & 31)) : R;
        voffA[i] = (unsigned)(R * K + C) * 2u; voffB[i] = (unsigned)(Rb * K + C) * 2u; }
    const size_t kstep = (size_t)(BK * 2);
    const size_t hstep = (size_t)HALF * K * 2;
    const size_t tstep = 2 * hstep;
    const unsigned ldsw = (unsigned)wid * 1024u;
    const int aoff = lds_byte(wr * 64 + fr, fq * 8), boff = lds_byte(wc * 32 + fr, fq * 8);
#define PG8_SA(b, h) (((b) * 2 + (h)) * HTB)
#define PG8_SB(b, h) ((4 + (b) * 2 + (h)) * HTB)
#define PG8_STAGE(bufoff, gbase, voff) do { _Pragma("unroll") for (int _i = 0; _i < 2; ++_i) \
        __builtin_amdgcn_global_load_lds((const unsigned*)((const char*)(gbase) + (voff)[_i]), (PG8_LAS unsigned*)(lds + (bufoff) + ldsw + _i * 8192), 16, 0, 0); } while (0)
#define PG8_LDA(dst, b, h) do { _Pragma("unroll") for (int m = 0; m < 4; ++m) _Pragma("unroll") for (int k = 0; k < 2; ++k) dst[m][k] = *(const PG8_LAS bf16x8*)(lds + PG8_SA(b, h) + aoff + m * 2048 + k * 1024); } while (0)
#define PG8_LDB(dst, b, h) do { _Pragma("unroll") for (int n = 0; n < 2; ++n) _Pragma("unroll") for (int k = 0; k < 2; ++k) dst[n][k] = *(const PG8_LAS bf16x8*)(lds + PG8_SB(b, h) + boff + n * 2048 + k * 1024); } while (0)
#define PG8_MMA(ai, bj, At, Bt) do { __builtin_amdgcn_s_setprio(1); _Pragma("unroll") for (int m = 0; m < 4; ++m) _Pragma("unroll") for (int n = 0; n < 2; ++n) _Pragma("unroll") for (int k = 0; k < 2; ++k) \
        acc[ai][bj][m][n] = __builtin_amdgcn_mfma_f32_16x16x32_bf16(Bt[n][k], At[m][k], acc[ai][bj][m][n], 0, 0, 0); __builtin_amdgcn_s_setprio(0); } while (0)
#define PG8_WAIT_V(n) asm volatile("s_waitcnt vmcnt(" #n ")" ::: "memory")
#define PG8_WAIT_L(n) asm volatile("s_waitcnt lgkmcnt(" #n ")" ::: "memory")
#define PG8_BAR __builtin_amdgcn_s_barrier()
#define PG8_SCHED __builtin_amdgcn_sched_barrier(0)
    Unit cur, nxt; int ui = 0;
    if (!S.next(0, cur)) return;
    f32x4 acc[2][2][4][2];
#pragma unroll
    for (int a = 0; a < 2; ++a)
#pragma unroll
        for (int b = 0; b < 2; ++b)
#pragma unroll
            for (int m = 0; m < 4; ++m)
#pragma unroll
                for (int n = 0; n < 2; ++n) acc[a][b][m][n] = (f32x4){0.f, 0.f, 0.f, 0.f};
    bf16x8 At[4][2], B0[2][2], B1[2][2];
    const char* cA = (const char*)g.A + (size_t)cur.pm * tstep; const char* cB = (const char*)g.Bt + (size_t)cur.pn * tstep;
    S.a_ready(cur);
    PG8_STAGE(PG8_SB(0, 0), cB, voffB); PG8_STAGE(PG8_SA(0, 0), cA, voffA); PG8_STAGE(PG8_SB(0, 1), cB + hstep, voffB); PG8_STAGE(PG8_SA(0, 1), cA + hstep, voffA);
    if (wr == 1) PG8_BAR;
    PG8_WAIT_V(4); PG8_BAR;
    PG8_STAGE(PG8_SB(1, 0), cB + kstep, voffB); PG8_STAGE(PG8_SA(1, 0), cA + kstep, voffA); PG8_STAGE(PG8_SB(1, 1), cB + hstep + kstep, voffB);
    PG8_WAIT_V(6); PG8_BAR;
    PG8_STAMP();
    for (;;) {
        const bool has_next = S.next(ui + 1, nxt);
        const char* nA = has_next ? (const char*)g.A + (size_t)nxt.pm * tstep : cA; const char* nB = has_next ? (const char*)g.Bt + (size_t)nxt.pn * tstep : cB;
        for (int t = 0; t < nt; t += 2) {
            const bool last = (t == nt - 2);
            const char* a1 = cA + (size_t)(t + 1) * kstep;
            const char* a2 = last ? nA : cA + (size_t)(t + 2) * kstep; const char* b2 = last ? nB : cB + (size_t)(t + 2) * kstep;
            const char* a3 = a2 + kstep; const char* b3 = b2 + kstep;
            if (last && has_next) S.a_ready(nxt);
            PG8_LDB(B0, 0, 0); PG8_SCHED; PG8_LDA(At, 0, 0); PG8_STAGE(PG8_SA(1, 1), a1 + hstep, voffA);
            PG8_WAIT_L(8); PG8_BAR; PG8_WAIT_L(0); PG8_MMA(0, 0, At, B0); PG8_BAR; PG8_SCHED;
            PG8_LDB(B1, 0, 1); PG8_STAGE(PG8_SB(0, 0), b2, voffB);
            PG8_BAR; PG8_WAIT_L(0); PG8_MMA(0, 1, At, B1); PG8_BAR;
            PG8_LDA(At, 0, 1); PG8_STAGE(PG8_SA(0, 0), a2, voffA);
            PG8_BAR; PG8_WAIT_L(0); PG8_MMA(1, 0, At, B0); PG8_BAR; PG8_SCHED;
            PG8_STAGE(PG8_SB(0, 1), b2 + hstep, voffB);
            PG8_WAIT_V(6); PG8_BAR; PG8_MMA(1, 1, At, B1); PG8_BAR;
            PG8_LDB(B0, 1, 0); PG8_SCHED; PG8_LDA(At, 1, 0); PG8_STAGE(PG8_SA(0, 1), a2 + hstep, voffA);
            PG8_WAIT_L(8); PG8_BAR; PG8_WAIT_L(0); PG8_MMA(0, 0, At, B0); PG8_BAR; PG8_SCHED;
            PG8_LDB(B1, 1, 1); PG8_STAGE(PG8_SB(1, 0), b3, voffB);
            PG8_BAR; PG8_WAIT_L(0); PG8_MMA(0, 1, At, B1); PG8_BAR;
            PG8_LDA(At, 1, 1); PG8_STAGE(PG8_SA(1, 0), a3, voffA);
            PG8_BAR; PG8_WAIT_L(0); PG8_MMA(1, 0, At, B0); PG8_BAR; PG8_SCHED;
            PG8_STAGE(PG8_SB(1, 1), b3 + hstep, voffB);
            PG8_WAIT_V(6); PG8_BAR; PG8_MMA(1, 1, At, B1); PG8_BAR;
        }
        PG8_STAMP();
        if constexpr (!Epi::AFTER_DRAIN) { E(acc, cur, wr, wc, fr, fq); S.done(cur); }
        PG8_STAMP();
        if (!has_next) break;
#pragma unroll
        for (int a = 0; a < 2; ++a)
#pragma unroll
            for (int b = 0; b < 2; ++b)
#pragma unroll
                for (int m = 0; m < 4; ++m)
#pragma unroll
                    for (int n = 0; n < 2; ++n) acc[a][b][m][n] = (f32x4){0.f, 0.f, 0.f, 0.f};
        cur = nxt; cA = nA; cB = nB; ++ui;
    }
    PG8_WAIT_V(0);
    if (wr == 0) PG8_BAR;
    PG8_BAR;
    if constexpr (Epi::AFTER_DRAIN) { E.fused(acc, cur, wr, wc, fr, fq, lds, wid, lane); S.done(cur); }
    PG8_STAMP();
    if (STAMP && wid == 0) { stamps[lane] = lane < nts ? (((unsigned long long)(unsigned)ts_hi << 32) | (unsigned)ts_lo) : 0ull;
        if (lane == 62) stamps[62] = rt_entry; if (lane == 63) stamps[63] = (unsigned long long)wall_clock64(); }
#undef PG8_STAMP
#undef PG8_SA
#undef PG8_SB
#undef PG8_STAGE
#undef PG8_LDA
#undef PG8_LDB
#undef PG8_MMA
#undef PG8_WAIT_V
#undef PG8_WAIT_L
#undef PG8_BAR
#undef PG8_SCHED
}
}

struct EpiIn0 {
  static constexpr bool PERM = false, AFTER_DRAIN = false;
  float* PROJ;
  const float* LB;
  const float* IR;
  __device__ __forceinline__ void operator()(const pg8::f32x4 (&acc)[2][2][4][2], const pg8::Unit& u, int wr, int wc, int fr, int fq) const {
#pragma unroll
    for (int bj = 0; bj < 2; ++bj) {
      const int cb = u.pn * 256 + bj * 128;
      if (cb >= 4096 && cb < 5120) {
        const int d0 = wc * 16 + 4 * fq;
        const pg8::f32x4 irA = *(const pg8::f32x4*)(IR + 2 * d0), irB = *(const pg8::f32x4*)(IR + 2 * d0 + 4);
        const float irh[4] = {irA[0], irA[2], irB[0], irB[2]}, irl[4] = {irA[1], irA[3], irB[1], irB[3]};
        const float sc = (cb >= 4608) ? 0.08838834764831845f : 1.0f;
#pragma unroll
        for (int ai = 0; ai < 2; ++ai)
#pragma unroll
          for (int m = 0; m < 4; ++m) {
            const int row = u.pm * 256 + ai * 128 + wr * 64 + m * 16 + fr;
            float* pr = PROJ + (size_t)row * N0;
            const pg8::f32x4 v0 = acc[ai][bj][m][0], v1 = acc[ai][bj][m][1];
            const float pos = (float)row_pos(row);
            pg8::f32x4 o1, o2;
#pragma unroll
            for (int j = 0; j < 4; ++j) {
              float ph = pos * irh[j];
              float pe = __builtin_fmaf(pos, irh[j], -ph) + pos * irl[j];
              float frc = __builtin_amdgcn_fractf(ph) + pe;
              float sn = __builtin_amdgcn_sinf(frc), cs = __builtin_amdgcn_cosf(frc);
              o1[j] = (v0[j] * cs - v1[j] * sn) * sc;
              o2[j] = (v0[j] * sn + v1[j] * cs) * sc;
            }
            *(pg8::f32x4*)(pr + cb + d0) = o1;
            *(pg8::f32x4*)(pr + cb + 64 + d0) = o2;
            __builtin_amdgcn_sched_barrier(0);
          }
      } else if (cb >= 1024 && cb < 2048) {
        const int c0 = cb + 32 * wc + 4 * fq;
        const pg8::f32x4 l0 = *(const pg8::f32x4*)(LB + c0 - 1024), l1 = *(const pg8::f32x4*)(LB + c0 + 16 - 1024);
#pragma unroll
        for (int ai = 0; ai < 2; ++ai)
#pragma unroll
          for (int m = 0; m < 4; ++m) {
            const int row = u.pm * 256 + ai * 128 + wr * 64 + m * 16 + fr;
            float* pr = PROJ + (size_t)row * N0;
#pragma unroll
            for (int n = 0; n < 2; ++n) {
              const pg8::f32x4 l = n ? l1 : l0;
              pg8::f32x4 v = acc[ai][bj][m][n], o;
#pragma unroll
              for (int j = 0; j < 4; ++j) o[j] = l[j] + (1.0f - l[j]) * sigmoidf_(v[j]);
              *(pg8::f32x4*)(pr + c0 + 16 * n) = o;
            }
            __builtin_amdgcn_sched_barrier(0);
          }
      } else if (cb < 1024 || (cb >= 3072 && cb < 4096) || cb >= 6144) {
        const int c0 = cb + 32 * wc + 4 * fq;
#pragma unroll
        for (int ai = 0; ai < 2; ++ai)
#pragma unroll
          for (int m = 0; m < 4; ++m) {
            const int row = u.pm * 256 + ai * 128 + wr * 64 + m * 16 + fr;
            float* pr = PROJ + (size_t)row * N0;
#pragma unroll
            for (int n = 0; n < 2; ++n) {
              pg8::f32x4 v = acc[ai][bj][m][n], o;
#pragma unroll
              for (int j = 0; j < 4; ++j) o[j] = siluf_(v[j]);
              *(pg8::f32x4*)(pr + c0 + 16 * n) = o;
            }
            __builtin_amdgcn_sched_barrier(0);
          }
      } else {
        const int c0 = cb + 32 * wc + 4 * fq;
#pragma unroll
        for (int ai = 0; ai < 2; ++ai)
#pragma unroll
          for (int m = 0; m < 4; ++m) {
            const int row = u.pm * 256 + ai * 128 + wr * 64 + m * 16 + fr;
            float* pr = PROJ + (size_t)row * N0;
#pragma unroll
            for (int n = 0; n < 2; ++n) *(pg8::f32x4*)(pr + c0 + 16 * n) = acc[ai][bj][m][n];
          }
      }
    }
  }
};
struct EpiStoreF32 {
  static constexpr bool PERM = false, AFTER_DRAIN = false;
  float* C;
  __device__ __forceinline__ void operator()(const pg8::f32x4 (&acc)[2][2][4][2], const pg8::Unit& u, int wr, int wc, int fr, int fq) const {
#pragma unroll
    for (int ai = 0; ai < 2; ++ai)
#pragma unroll
      for (int m = 0; m < 4; ++m) {
        const int row = u.pm * 256 + ai * 128 + wr * 64 + m * 16 + fr;
        float* pr = C + (size_t)row * 2048 + u.pn * 256 + 32 * wc + 4 * fq;
#pragma unroll
        for (int bj = 0; bj < 2; ++bj)
#pragma unroll
          for (int n = 0; n < 2; ++n) *(pg8::f32x4*)(pr + bj * 128 + 16 * n) = acc[ai][bj][m][n];
      }
  }
};
struct EpiStoreBf16 {
  static constexpr bool PERM = false, AFTER_DRAIN = false;
  u16* C;
  __device__ __forceinline__ void operator()(const pg8::f32x4 (&acc)[2][2][4][2], const pg8::Unit& u, int wr, int wc, int fr, int fq) const {
#pragma unroll
    for (int ai = 0; ai < 2; ++ai)
#pragma unroll
      for (int m = 0; m < 4; ++m) {
        const int row = u.pm * 256 + ai * 128 + wr * 64 + m * 16 + fr;
        u16* pr = C + (size_t)row * 2048 + u.pn * 256 + 32 * wc + 4 * fq;
#pragma unroll
        for (int bj = 0; bj < 2; ++bj)
#pragma unroll
          for (int n = 0; n < 2; ++n) {
            const pg8::f32x4 v = acc[ai][bj][m][n];
            uint2 o;
            o.x = pack2(v[0], v[1]);
            o.y = pack2(v[2], v[3]);
            *(uint2*)(pr + bj * 128 + 16 * n) = o;
          }
      }
  }
};
struct EpiIn1 {
  static constexpr bool PERM = false, AFTER_DRAIN = false;
  float* PROJ;
  float* DTA;
  const float* dtb;
  const float* alog;
  __device__ __forceinline__ void operator()(const pg8::f32x4 (&acc)[2][2][4][2], const pg8::Unit& u, int wr, int wc, int fr, int fq) const {
    float dtbv[4] = {0.f, 0.f, 0.f, 0.f}, aev[4] = {0.f, 0.f, 0.f, 0.f};
    if (u.pn == 23) {
      const int cc = 23 * 256 + 32 * wc + 4 * fq;
      const int hb = (cc >= 5920 && cc < 5936) ? (cc - 5920) : ((cc + 16 >= 5920 && cc + 16 < 5936) ? (cc + 16 - 5920) : -1);
      if (hb >= 0) {
#pragma unroll
        for (int j = 0; j < 4; ++j) { dtbv[j] = dtb[hb + j]; aev[j] = expf(alog[hb + j]); }
      }
    }
#pragma unroll
    for (int ai = 0; ai < 2; ++ai)
#pragma unroll
      for (int m = 0; m < 4; ++m) {
        const int row = u.pm * 256 + ai * 128 + wr * 64 + m * 16 + fr;
        float* pr = PROJ + (size_t)row * N1;
#pragma unroll
        for (int bj = 0; bj < 2; ++bj)
#pragma unroll
          for (int n = 0; n < 2; ++n) {
            const int col0 = u.pn * 256 + bj * 128 + 32 * wc + 16 * n + 4 * fq;
            pg8::f32x4 v = acc[ai][bj][m][n];
            if (col0 < 1024) {
              pg8::f32x4 o;
#pragma unroll
              for (int j = 0; j < 4; ++j) o[j] = siluf_(v[j]);
              *(pg8::f32x4*)(pr + col0) = o;
            } else if (col0 < 5920) {
              *(pg8::f32x4*)(pr + col0) = v;
            } else if (col0 < 5936) {
#pragma unroll
              for (int j = 0; j < 4; ++j) {
                int h = col0 + j - 5920;
                float dt = softplusf_(v[j] + dtbv[j]);
                DTA[(size_t)row * 64 + h * 4] = dt;
                DTA[(size_t)row * 64 + h * 4 + 1] = expf(-dt * aev[j]);
              }
            }
          }
      }
  }
};

struct Seg {
  int off;
  int ld;
  int n4;
};

template <int NS, int NF4, int RG>
DEVI void stage_init(const float* wsf, const Seg (&sg)[NS], int row0, int tid, const float* (&ptr)[RG], int (&ldv)[RG]) {
  asm volatile("" : "+v"(tid));
#pragma unroll
  for (int q = 0; q < RG; ++q) {
    int flat = tid + q * 256;
    int t = flat / NF4, f = flat % NF4;
    if (flat >= 16 * NF4) { t = 0; f = 0; }
    int off = 0, ld = 0, ff = f;
    bool done = false;
#pragma unroll
    for (int s = 0; s < NS; ++s) {
      bool here = (!done) && (ff < sg[s].n4);
      off = here ? (sg[s].off + (row0 + t) * sg[s].ld + ff * 4) : off;
      ld = here ? sg[s].ld : ld;
      ff = (done || here) ? ff : (ff - sg[s].n4);
      done = done || here;
    }
    ptr[q] = wsf + off;
    ldv[q] = ld;
  }
}
template <int NF4, int RG>
DEVI void stage_issue(const float* const (&ptr)[RG], const int (&ldv)[RG], int st, int nsteps, int tid, f32x4 (&rg)[RG]) {
#pragma unroll
  for (int q = 0; q < RG; ++q) {
    int flat = tid + q * 256;
    if (flat < nsteps * NF4) rg[q] = *(const f32x4*)(ptr[q] + (st * 16) * ldv[q]);
  }
}
template <int NF4, int RG>
DEVI void stage_commit(float* buf, int nsteps, int tid, const f32x4 (&rg)[RG]) {
#pragma unroll
  for (int q = 0; q < RG; ++q) {
    int flat = tid + q * 256;
    if (flat < nsteps * NF4) ((f32x4*)buf)[flat] = rg[q];
  }
}

template <int MODE>
DEVI void colrec_long(const float* wsf, const Seg (&sg)[4], int row0, int T, float gamma, float* outp, int ldo, float* stout, int st_ld,
                      float* smem) {
  constexpr int NF4 = 69, W = 276, RG = 5;
  const int tid = threadIdx.x & 255, w = tid >> 6, lane = tid & 63, c = lane >> 4, s = lane & 15;
  smem += (threadIdx.x >> 8) * (VB_BYTES / 4);
  float S[8];
#pragma unroll
  for (int i = 0; i < 8; ++i) S[i] = 0.f;
  float* buf0 = smem;
  float* buf1 = smem + 16 * 336;
  float* obuf = smem + 2 * 16 * 336;
  const int nst = (T + 15) / 16;
  f32x4 rgA[RG], rgB[RG];
  const float* sptr[RG];
  int sld[RG];
  stage_init<4, NF4, RG>(wsf, sg, row0, tid, sptr, sld);
  auto step = [&](const float* sp, float* ob, int tt) -> float {
    float4 a0 = *(const float4*)(sp + s * 8), a1 = *(const float4*)(sp + s * 8 + 4);
    float4 q0 = *(const float4*)(sp + 128 + s * 8), q1 = *(const float4*)(sp + 128 + s * 8 + 4);
    float a[8] = {a0.x, a0.y, a0.z, a0.w, a1.x, a1.y, a1.z, a1.w};
    float q[8] = {q0.x, q0.y, q0.z, q0.w, q1.x, q1.y, q1.z, q1.w};
    float val = sp[256 + w * 4 + c];
    float dA = gamma;
    if (MODE == 2) {
      val *= sp[272];
      dA = sp[273];
    }
    float o = 0.f;
#pragma unroll
    for (int i = 0; i < 8; ++i) {
      if (MODE == 0) S[i] = val + a[i] * (S[i] - val);
      else S[i] = dA * S[i] + a[i] * val;
      o += q[i] * S[i];
    }
    return red16(o);
  };
  auto run_stage = [&](const float* b, float* ob, int nthis) {
#pragma unroll 1
    for (int tt = 0; tt < nthis; tt += 8) {
      float o0 = step(b + tt * W, ob, tt);
      float o1 = step(b + (tt + 1) * W, ob, tt + 1);
      float o2 = step(b + (tt + 2) * W, ob, tt + 2);
      float o3 = step(b + (tt + 3) * W, ob, tt + 3);
      float o4 = step(b + (tt + 4) * W, ob, tt + 4);
      float o5 = step(b + (tt + 5) * W, ob, tt + 5);
      float o6 = step(b + (tt + 6) * W, ob, tt + 6);
      float o7 = step(b + (tt + 7) * W, ob, tt + 7);
      const int base = (s == 0) ? (tt * 16 + w * 4 + c) : (1024 + (tid & 255));
      const int st16 = (s == 0) ? 16 : 0;
      ob[base] = o0;
      ob[base + st16] = o1;
      ob[base + 2 * st16] = o2;
      ob[base + 3 * st16] = o3;
      ob[base + 4 * st16] = o4;
      ob[base + 5 * st16] = o5;
      ob[base + 6 * st16] = o6;
      ob[base + 7 * st16] = o7;
    }
  };
  auto write_out = [&](const float* ob, int st, int nthis) {
    if (tid < nthis * 4) {
      int t = tid >> 2, c4 = tid & 3;
      *(float4*)(outp + (size_t)(st * 16 + t) * ldo + c4 * 4) = *(const float4*)(ob + t * 16 + c4 * 4);
    }
  };
  auto nsteps = [&](int st) { return min(16, T - st * 16); };
  stage_issue<NF4, RG>(sptr, sld, 0, nsteps(0), tid, rgA);
  stage_commit<NF4, RG>(buf0, nsteps(0), tid, rgA);
  if (nst > 1) stage_issue<NF4, RG>(sptr, sld, 1, nsteps(1), tid, rgB);
  __syncthreads();
#pragma unroll 1
  for (int st = 0; st < nst; st += 2) {
    if (st + 2 < nst) stage_issue<NF4, RG>(sptr, sld, st + 2, nsteps(st + 2), tid, rgA);
    run_stage(buf0, obuf, nsteps(st));
    if (st + 1 < nst) stage_commit<NF4, RG>(buf1, nsteps(st + 1), tid, rgB);
    __syncthreads();
    write_out(obuf, st, nsteps(st));
    if (st + 1 < nst) {
      if (st + 3 < nst) stage_issue<NF4, RG>(sptr, sld, st + 3, nsteps(st + 3), tid, rgB);
      run_stage(buf1, obuf + 512, nsteps(st + 1));
      if (st + 2 < nst) stage_commit<NF4, RG>(buf0, nsteps(st + 2), tid, rgA);
      __syncthreads();
      write_out(obuf + 512, st + 1, nsteps(st + 1));
    }
  }
#pragma unroll
  for (int i = 0; i < 8; ++i) stout[(size_t)(s * 8 + i) * st_ld + w * 4 + c] = S[i];
  __syncthreads();
}

template <int MODE>
DEVI void colrec_short(const float* pa, int lda_, const float* pq, int ldq, const float* pc, int ldc, const float* pdt,
                       long row0, float gamma, const float* stin, float* stout, int st_ld, float* outp, int ldo,
                       float* smem) {
  const int tid = threadIdx.x & 255, lane = tid & 63;
  const int wid = __builtin_amdgcn_readfirstlane(tid >> 6);
  const int k0 = wid * 32;
  smem += (threadIdx.x >> 8) * (VB_BYTES / 4);
  float S[32];
#pragma unroll
  for (int i = 0; i < 32; ++i) S[i] = stin[(size_t)(k0 + i) * st_ld + lane];
  float aq[4], vv[4], dAv[4];
#pragma unroll
  for (int t = 0; t < 4; ++t) {
    long row = row0 + t;
    aq[t] = (lane < 32) ? pa[(size_t)row * lda_ + k0 + lane] : pq[(size_t)row * ldq + k0 + (lane - 32)];
    vv[t] = pc[(size_t)row * ldc + lane];
    dAv[t] = gamma;
    if (MODE == 2) {
      vv[t] *= pdt[(size_t)row * 64];
      dAv[t] = pdt[(size_t)row * 64 + 1];
    }
  }
#pragma unroll
  for (int t = 0; t < 4; ++t) {
    const float val = vv[t], dA = dAv[t];
    float o = 0.f;
#pragma unroll
    for (int i = 0; i < 32; ++i) {
      const float a = rlf_(aq[t], i), q = rlf_(aq[t], 32 + i);
      if (MODE == 0) S[i] = val + a * (S[i] - val);
      else S[i] = dA * S[i] + a * val;
      o += q * S[i];
    }
    smem[(wid * 4 + t) * 64 + lane] = o;
  }
#pragma unroll
  for (int i = 0; i < 32; ++i) stout[(size_t)(k0 + i) * st_ld + lane] = S[i];
  __syncthreads();
  {
    int t = tid >> 6;
    float sum = smem[(0 * 4 + t) * 64 + lane] + smem[(1 * 4 + t) * 64 + lane] + smem[(2 * 4 + t) * 64 + lane] +
                smem[(3 * 4 + t) * 64 + lane];
    outp[(size_t)(row0 + t) * ldo + lane] = sum;
  }
  __syncthreads();
}

DEVI void rwkv_item(const float* wsf, const Seg (&sg)[6], int row0, int T, const float* stin, float* stout, float* outp, int ldo,
                    float* smem) {
  constexpr int NF4 = 84, W = 336, RG = 6;
  const int tid = threadIdx.x & 255, w = tid >> 6, lane = tid & 63, rl = lane >> 4, sl = lane & 15;
  smem += (threadIdx.x >> 8) * (VB_BYTES / 4);
  const int il = w * 4 + rl;
  float S[4];
  if (stin) {
    float4 v = *(const float4*)(stin + il * 64 + sl * 4);
    S[0] = v.x; S[1] = v.y; S[2] = v.z; S[3] = v.w;
  } else {
    S[0] = S[1] = S[2] = S[3] = 0.f;
  }
  float* buf0 = smem;
  float* buf1 = smem + 16 * 336;
  float* obuf = smem + 2 * 16 * 336;
  const int nst = (T + 15) / 16;
  f32x4 rgA[RG], rgB[RG];
  const float* sptr[RG];
  int sld[RG];
  stage_init<6, NF4, RG>(wsf, sg, row0, tid, sptr, sld);
  auto run_stage = [&](const float* b, float* ob, int nthis) {
#pragma unroll 4
    for (int tt = 0; tt < nthis; ++tt) {
      const float* sp = b + tt * W;
      float4 r4 = *(const float4*)(sp + sl * 4);
      float4 w4 = *(const float4*)(sp + 64 + sl * 4);
      float4 k4 = *(const float4*)(sp + 128 + sl * 4);
      float4 n4 = *(const float4*)(sp + 192 + sl * 4);
      float4 m4 = *(const float4*)(sp + 256 + sl * 4);
      float vi = sp[320 + il];
      float sa = S[0] * n4.x + S[1] * n4.y + S[2] * n4.z + S[3] * n4.w;
      sa = -red16(sa);
      S[0] = S[0] * w4.x + sa * m4.x + vi * k4.x;
      S[1] = S[1] * w4.y + sa * m4.y + vi * k4.y;
      S[2] = S[2] * w4.z + sa * m4.z + vi * k4.z;
      S[3] = S[3] * w4.w + sa * m4.w + vi * k4.w;
      float y = S[0] * r4.x + S[1] * r4.y + S[2] * r4.z + S[3] * r4.w;
      y = red16(y);
      ob[(sl == 0) ? (tt * 16 + il) : (1024 + (tid & 255))] = y;
    }
  };
  auto write_out = [&](const float* ob, int st, int nthis) {
    if (tid < nthis * 4) {
      int t = tid >> 2, c4 = tid & 3;
      *(float4*)(outp + (size_t)(st * 16 + t) * ldo + c4 * 4) = *(const float4*)(ob + t * 16 + c4 * 4);
    }
  };
  auto nsteps = [&](int st) { return min(16, T - st * 16); };
  stage_issue<NF4, RG>(sptr, sld, 0, nsteps(0), tid, rgA);
  stage_commit<NF4, RG>(buf0, nsteps(0), tid, rgA);
  if (nst > 1) stage_issue<NF4, RG>(sptr, sld, 1, nsteps(1), tid, rgB);
  __syncthreads();
  __builtin_amdgcn_s_setprio(3);
#pragma unroll 1
  for (int st = 0; st < nst; st += 2) {
    if (st + 2 < nst) stage_issue<NF4, RG>(sptr, sld, st + 2, nsteps(st + 2), tid, rgA);
    run_stage(buf0, obuf, nsteps(st));
    if (st + 1 < nst) stage_commit<NF4, RG>(buf1, nsteps(st + 1), tid, rgB);
    __syncthreads();
    write_out(obuf, st, nsteps(st));
    if (st + 1 < nst) {
      if (st + 3 < nst) stage_issue<NF4, RG>(sptr, sld, st + 3, nsteps(st + 3), tid, rgB);
      run_stage(buf1, obuf + 512, nsteps(st + 1));
      if (st + 2 < nst) stage_commit<NF4, RG>(buf0, nsteps(st + 2), tid, rgA);
      __syncthreads();
      write_out(obuf + 512, st + 1, nsteps(st + 1));
    }
  }
  __builtin_amdgcn_s_setprio(0);
  *(float4*)(stout + il * 64 + sl * 4) = make_float4(S[0], S[1], S[2], S[3]);
  __syncthreads();
}

DEVI void phase_rec0(const Params& p, float* smem) {
  char* ws = p.ws;
  const float* PROJ = (const float*)(ws + OFF_PROJ);
  float* OMIX = (float*)(ws + OFF_OMIX);
  const float* wsf = (const float*)ws;
  constexpr int PO = (int)(OFF_PROJ / 4);
  for (int item = blockIdx.x * 2 + (threadIdx.x >> 8); item < 4608; item += gridDim.x * 2) {
    if (item < 256) {
      int b = item >> 6, h = (item >> 3) & 7, cb = item & 7;
      Seg sg[4] = {{PO + 1024 + h * 128, N0, 32}, {PO + h * 128, N0, 32}, {PO + 2048 + h * 128 + cb * 16, N0, 4},
                   {PO, N0, 1}};
      int row0 = b * TP;
      colrec_long<0>(wsf, sg, row0, TP, 0.f, OMIX + (size_t)row0 * 2048 + h * 128 + cb * 16, 2048,
                     p.out + O_HGP + (size_t)(b * 8 + h) * 128 * 128 + cb * 16, 128, smem);
    } else if (item < 512) {
      int it = item - 256;
      int b = it >> 6, h = (it >> 4) & 3, cb = it & 15;
      Seg sg[4] = {{PO + 4608 + h * 128, N0, 32}, {PO + 4096 + h * 128, N0, 32},
                   {PO + 5120 + h * 256 + cb * 16, N0, 4}, {PO, N0, 1}};
      int row0 = b * TP;
      float gamma = 1.0f - exp2f(-5.0f - (float)h);
      colrec_long<1>(wsf, sg, row0, TP, gamma, OMIX + (size_t)row0 * 2048 + 1024 + h * 256 + cb * 16, 2048,
                     p.out + O_RTP + (size_t)(b * 4 + h) * 128 * 256 + cb * 16, 256, smem);
    } else if (item < 2560) {
      int it = item - 512;
      int b = it >> 4, h = (it >> 1) & 7, cb = it & 1;
      long row0 = MPR + (long)b * 4;
      size_t so = (size_t)(b * 8 + h) * 128 * 128 + cb * 64;
      colrec_short<0>(PROJ + 1024 + h * 128, N0, PROJ + h * 128, N0, PROJ + 2048 + h * 128 + cb * 64, N0, nullptr, row0,
                      0.f, p.in[I_SHG] + so, p.out + O_HGS + so, 128, OMIX + h * 128 + cb * 64, 2048, smem);
    } else {
      int it = item - 2560;
      int b = it >> 4, h = (it >> 2) & 3, cb = it & 3;
      long row0 = MPR + (long)b * 4;
      size_t so = (size_t)(b * 4 + h) * 128 * 256 + cb * 64;
      float gamma = 1.0f - exp2f(-5.0f - (float)h);
      colrec_short<1>(PROJ + 4608 + h * 128, N0, PROJ + 4096 + h * 128, N0, PROJ + 5120 + h * 256 + cb * 64, N0, nullptr,
                      row0, gamma, p.in[I_SRT] + so, p.out + O_RTS + so, 256, OMIX + 1024 + h * 256 + cb * 64, 2048,
                      smem);
    }
  }
}

DEVI float4 ld4(const float* p) { return *(const float4*)p; }
DEVI void st_bf4(u16* p, float a, float b, float c, float d) {
  uint2 o;
  o.x = pack2(a, b);
  o.y = pack2(c, d);
  *(uint2*)p = o;
}
DEVI float wsum_u_(float v) {
  v = red16(v);
  return (rlf_(v, 0) + rlf_(v, 16)) + (rlf_(v, 32) + rlf_(v, 48));
}
DEVI float red32(float v) {
  v = red16(v);
  return v + __shfl_xor(v, 16, 64);
}
DEVI void phase_post0(const Params& p) {
  char* ws = p.ws;
  const float* PROJ = (const float*)(ws + OFF_PROJ);
  const float* OMIX = (const float*)(ws + OFF_OMIX);
  u16* MIXB = (u16*)(ws + OFF_MIXB);
  const float* ng = p.in[I_HNG];
  const int lane = threadIdx.x & 63;
  const int gw = blockIdx.x * 8 + (threadIdx.x >> 6), nw = gridDim.x * 8;
  const float4 g4 = ld4(ng + (lane & 31) * 4);
  for (int row = gw; row < M; row += nw) {
    const float* o = OMIX + (size_t)row * 2048;
    const float* pr = PROJ + (size_t)row * N0;
    u16* mo = MIXB + (size_t)row * 2048;
    float4 a[4], ga[4], bq[4], gb[4];
#pragma unroll
    for (int it = 0; it < 4; ++it) {
      int c = it * 256 + lane * 4;
      a[it] = ld4(o + c);
      ga[it] = ld4(pr + 3072 + c);
      bq[it] = ld4(o + 1024 + c);
      gb[it] = ld4(pr + 6144 + c);
    }
#pragma unroll
    for (int it = 0; it < 4; ++it) {
      int c = it * 256 + lane * 4;
      float ss = red32(a[it].x * a[it].x + a[it].y * a[it].y + a[it].z * a[it].z + a[it].w * a[it].w);
      float inv = rsqrtf(ss * (1.0f / 128.0f) + 1e-6f);
      st_bf4(mo + c, a[it].x * inv * g4.x * ga[it].x, a[it].y * inv * g4.y * ga[it].y, a[it].z * inv * g4.z * ga[it].z,
             a[it].w * inv * g4.w * ga[it].w);
      float mu = wsum_u_(bq[it].x + bq[it].y + bq[it].z + bq[it].w) * (1.0f / 256.0f);
      float dx = bq[it].x - mu, dy = bq[it].y - mu, dz = bq[it].z - mu, dw = bq[it].w - mu;
      float var = wsum_u_(dx * dx + dy * dy + dz * dz + dw * dw) * (1.0f / 256.0f);
      float iv = rsqrtf(var + 1e-5f);
      st_bf4(mo + 1024 + c, dx * iv * gb[it].x, dy * iv * gb[it].y, dz * iv * gb[it].z, dw * iv * gb[it].w);
    }
  }
}

DEVI void phase_ln(const Params& p, const float* addsrc, const float* g, const float* bta) {
  char* ws = p.ws;
  float* XF = (float*)(ws + OFF_XF);
  u16* XB = (u16*)(ws + OFF_XB);
  const int lane = threadIdx.x & 63;
  const int gw = blockIdx.x * 8 + (threadIdx.x >> 6), nw = gridDim.x * 8;
  for (int row = gw; row < M; row += nw) {
    float4* xr = (float4*)(XF + (size_t)row * 2048);
    const float4* ar = (const float4*)(addsrc + (size_t)row * 2048);
    float v[32];
    float s = 0.f;
#pragma unroll
    for (int i = 0; i < 8; ++i) {
      float4 x = xr[i * 64 + lane], a = ar[i * 64 + lane];
      v[i * 4 + 0] = ALPHA * x.x + a.x;
      v[i * 4 + 1] = ALPHA * x.y + a.y;
      v[i * 4 + 2] = ALPHA * x.z + a.z;
      v[i * 4 + 3] = ALPHA * x.w + a.w;
      s += v[i * 4 + 0] + v[i * 4 + 1] + v[i * 4 + 2] + v[i * 4 + 3];
    }
    float mu = wsum(s) * (1.0f / 2048.0f);
    float q = 0.f;
#pragma unroll
    for (int i = 0; i < 32; ++i) {
      v[i] -= mu;
      q += v[i] * v[i];
    }
    float inv = rsqrtf(wsum(q) * (1.0f / 2048.0f) + 1e-5f);
#pragma unroll
    for (int i = 0; i < 8; ++i) {
      float4 gg = ((const float4*)g)[i * 64 + lane], bb = ((const float4*)bta)[i * 64 + lane];
      float4 y;
      y.x = v[i * 4 + 0] * inv * gg.x + bb.x;
      y.y = v[i * 4 + 1] * inv * gg.y + bb.y;
      y.z = v[i * 4 + 2] * inv * gg.z + bb.z;
      y.w = v[i * 4 + 3] * inv * gg.w + bb.w;
      xr[i * 64 + lane] = y;
      uint2 o;
      o.x = pack2(y.x, y.y);
      o.y = pack2(y.z, y.w);
      ((uint2*)(XB + (size_t)row * 2048))[i * 64 + lane] = o;
    }
  }
}

typedef __attribute__((ext_vector_type(2))) __bf16 bf2_t;
typedef __attribute__((ext_vector_type(2))) float f32x2;
DEVI float dot2bf(unsigned a, unsigned b, float acc) {
  return __builtin_amdgcn_fdot2_f32_bf16(__builtin_bit_cast(bf2_t, a), __builtin_bit_cast(bf2_t, b), acc, false);
}
template <int CTRL>
DEVI int dppi(int v) {
  return __builtin_amdgcn_update_dpp(v, v, CTRL, 0xF, 0xF, false);
}
DEVI int wmax_i(int v) {
  v = max(v, dppi<0xB1>(v));
  v = max(v, dppi<0x4E>(v));
  v = max(v, dppi<0x141>(v));
  v = max(v, dppi<0x140>(v));
  int a = __builtin_amdgcn_readlane(v, 0), b = __builtin_amdgcn_readlane(v, 16);
  int c = __builtin_amdgcn_readlane(v, 32), d = __builtin_amdgcn_readlane(v, 48);
  return max(max(a, b), max(c, d));
}
DEVI float rlf(float v, int l) { return __int_as_float(__builtin_amdgcn_readlane(__float_as_int(v), l)); }
DEVI float wsum_u(float v) {
  v = red16(v);
  return (rlf(v, 0) + rlf(v, 16)) + (rlf(v, 32) + rlf(v, 48));
}
DEVI int fkey(float f) {
  int u = __float_as_int(f);
  return u ^ ((u >> 31) & 0x7fffffff);
}
DEVI float keyf(int k) { return __int_as_float(k ^ ((k >> 31) & 0x7fffffff)); }

DEVI void conv_fp8_rows(const float* __restrict__ src, unsigned char* __restrict__ dst, float* __restrict__ scales) {
  const int lane = threadIdx.x & 63;
  const int gw = blockIdx.x * 8 + (threadIdx.x >> 6), nw = gridDim.x * 8;
  for (int e = gw; e < 16384; e += nw) {
    const float* r = src + (size_t)e * 2048;
    float4 v[8];
    float am = 0.f;
#pragma unroll
    for (int q = 0; q < 8; ++q) {
      v[q] = *(const float4*)(r + (q >> 2) * 1024 + lane * 16 + (q & 3) * 4);
      am = fmaxf(am, fmaxf(fmaxf(fabsf(v[q].x), fabsf(v[q].y)), fmaxf(fabsf(v[q].z), fabsf(v[q].w))));
    }
    float amax = __int_as_float(wmax_i(__float_as_int(am)));
    float inv = (amax > 0.f) ? (440.0f / amax) : 0.f;
    float scale = (amax > 0.f) ? (amax * (1.0f / 440.0f)) : 1.0f;
#pragma unroll
    for (int j = 0; j < 2; ++j) {
      u32x4 o;
#pragma unroll
      for (int k = 0; k < 4; ++k) {
        float4 t = v[j * 4 + k];
        int pk = 0;
        pk = __builtin_amdgcn_cvt_pk_fp8_f32(t.x * inv, t.y * inv, pk, false);
        pk = __builtin_amdgcn_cvt_pk_fp8_f32(t.z * inv, t.w * inv, pk, true);
        o[k] = (unsigned)pk;
      }
      *(u32x4*)(dst + (size_t)e * 2048 + j * 1024 + lane * 16) = o;
    }
    if (lane == 0) scales[e] = scale;
  }
}

DEVI void phase_peer(const Params& p, int layer, bool final_out) {
  char* ws = p.ws;
  const float* SC = (const float*)(ws + OFF_GOUT);
  float* XF = (float*)(ws + OFF_XF);
  u16* XB = (u16*)(ws + OFF_XB);
  const unsigned char* UB = (const unsigned char*)(ws + OFF_UB);
  const unsigned char* VB = (const unsigned char*)(ws + OFF_VB);
  const float* USC = (const float*)(ws + OFF_USC);
  const float* VSC = (const float*)(ws + OFF_VSC);
  const float* g = p.in[I_LNG] + (size_t)(layer * 2 + 1) * D;
  const float* bta = p.in[I_LNB] + (size_t)(layer * 2 + 1) * D;
  const int lane = threadIdx.x & 63;
  const int gw = blockIdx.x * 8 + (threadIdx.x >> 6), nw = gridDim.x * 8;
  constexpr int KMIN = (int)0x80000000;
  for (int row = gw; row < M; row += nw) {
    const float* sr = SC + (size_t)row * 2048;
    int eidx0 = 0, eidx1 = 0;
    float gate0 = 0.f, gate1 = 0.f;
#pragma unroll 1
    for (int hp = 0; hp < 2; ++hp) {
      int hd[4] = {hp * 2, hp * 2 + 1, hp * 2 + 4, hp * 2 + 5};
      int ka[4][2], kb[4][2], my[4][2];
#pragma unroll
      for (int n = 0; n < 4; ++n) {
        const float* sp = sr + hd[n] * 256;
#pragma unroll
        for (int c = 0; c < 2; ++c) {
          ka[n][c] = (fkey(sp[c * 128 + lane]) & ~127) | (127 - lane);
          kb[n][c] = (fkey(sp[c * 128 + 64 + lane]) & ~127) | (63 - lane);
          my[n][c] = KMIN;
        }
      }
#pragma unroll 1
      for (int r = 0; r < 16; ++r) {
#pragma unroll
        for (int n = 0; n < 4; ++n)
#pragma unroll
          for (int c = 0; c < 2; ++c) {
            int K = wmax_i(max(ka[n][c], kb[n][c]));
            my[n][c] = (lane == r) ? K : my[n][c];
            ka[n][c] = (ka[n][c] == K) ? KMIN : ka[n][c];
            kb[n][c] = (kb[n][c] == K) ? KMIN : kb[n][c];
          }
      }
      const int jb = (lane & 3) * 4;
      int cc[4][4], myk[4];
      int ti0[4], ti1[4];
#pragma unroll
      for (int n = 0; n < 4; ++n) {
        const float ts0 = keyf(my[n][0] & ~127), ts1 = keyf(my[n][1] & ~127);
        ti0[n] = 127 - (my[n][0] & 127);
        ti1[n] = 127 - (my[n][1] & 127);
        const float s0 = __shfl(ts0, lane >> 2, 64);
#pragma unroll
        for (int q = 0; q < 4; ++q) cc[n][q] = (fkey(s0 + __shfl(ts1, jb + q, 64)) & ~255) | (255 - (lane * 4 + q));
        myk[n] = KMIN;
      }
#pragma unroll 1
      for (int r = 0; r < 16; ++r) {
#pragma unroll
        for (int n = 0; n < 4; ++n) {
          int K = wmax_i(max(max(cc[n][0], cc[n][1]), max(cc[n][2], cc[n][3])));
          myk[n] = (lane == r) ? K : myk[n];
#pragma unroll
          for (int q = 0; q < 4; ++q) cc[n][q] = (cc[n][q] == K) ? KMIN : cc[n][q];
        }
      }
#pragma unroll
      for (int n = 0; n < 4; ++n) {
        const float bs = keyf(myk[n] & ~255);
        const int bf = 255 - (myk[n] & 255);
        const int e = __shfl(ti0[n], (bf >> 4) & 15, 64) * 128 + __shfl(ti1[n], bf & 15, 64);
        const float ev = (lane < 16) ? expf(bs - rlf(bs, 0)) : 0.f;
        const float gt = ev / wsum_u(ev);
        const int e_b = __shfl(e, lane & 15, 64);
        const float g_b = __shfl(gt, lane & 15, 64);
        const int hh = hp * 2 + (n & 1);
        if ((lane >> 4) == hh) {
          if (n < 2) { eidx0 = e_b; gate0 = g_b; }
          else { eidx1 = e_b; gate1 = g_b; }
        }
      }
    }
    float dv0 = 0.f, dv1 = 0.f;
    {
      float xf[32];
      {
        const float4* xr = (const float4*)(XF + (size_t)row * 2048);
#pragma unroll
        for (int q = 0; q < 8; ++q) {
          float4 t = xr[(q >> 2) * 256 + lane * 4 + (q & 3)];
          xf[q * 4 + 0] = t.x; xf[q * 4 + 1] = t.y; xf[q * 4 + 2] = t.z; xf[q * 4 + 3] = t.w;
        }
      }
      constexpr int R = 8;
      u32x4 w[R][2];
      float sc[R];
      auto load_row = [&](int pidx, u32x4(&wr)[2], float& scv) {
        int src = (pidx < 64) ? eidx0 : eidx1;
        int e = __builtin_amdgcn_readlane(src, pidx & 63);
        const u32x4* ur = (const u32x4*)(UB + (size_t)e * 2048);
        wr[0] = ur[lane];
        wr[1] = ur[64 + lane];
        scv = USC[e];
      };
#pragma unroll
      for (int u = 0; u < R; ++u) load_row(u, w[u], sc[u]);
#pragma unroll 1
      for (int p0 = 0; p0 < 128; p0 += R) {
#pragma unroll
        for (int u = 0; u < R; ++u) {
          float d = 0.f;
#pragma unroll
          for (int j = 0; j < 2; ++j) {
#pragma unroll
            for (int k = 0; k < 4; ++k) {
              int dw = (int)w[u][j][k];
              f32x2 lo = __builtin_amdgcn_cvt_pk_f32_fp8(dw, false);
              f32x2 hi = __builtin_amdgcn_cvt_pk_f32_fp8(dw, true);
              d += lo.x * xf[j * 16 + k * 4 + 0];
              d += lo.y * xf[j * 16 + k * 4 + 1];
              d += hi.x * xf[j * 16 + k * 4 + 2];
              d += hi.y * xf[j * 16 + k * 4 + 3];
            }
          }
          float scu = sc[u];
          if (p0 + R < 128) load_row(p0 + R + u, w[u], sc[u]);
          d = wsum_u(d) * scu;
          int pl = (p0 + u) & 63;
          if (p0 < 64) dv0 = (lane == pl) ? d : dv0;
          else dv1 = (lane == pl) ? d : dv1;
          __builtin_amdgcn_sched_barrier(0);
        }
      }
    }
    float coef0 = 0.5f * dv0 * (1.0f + erff(dv0 * 0.70710678118f)) * gate0;
    float coef1 = 0.5f * dv1 * (1.0f + erff(dv1 * 0.70710678118f)) * gate1;
    f32x2 o2[16];
#pragma unroll
    for (int i = 0; i < 16; ++i) o2[i] = f32x2{0.f, 0.f};
    {
      constexpr int R = 8;
      u32x4 w[R][2];
      float sc[R];
      auto load_row = [&](int pidx, u32x4(&wr)[2], float& scv) {
        int src = (pidx < 64) ? eidx0 : eidx1;
        int e = __builtin_amdgcn_readlane(src, pidx & 63);
        const u32x4* vr = (const u32x4*)(VB + (size_t)e * 2048);
        wr[0] = vr[lane];
        wr[1] = vr[64 + lane];
        scv = VSC[e];
      };
#pragma unroll
      for (int u = 0; u < R; ++u) load_row(u, w[u], sc[u]);
#pragma unroll 1
      for (int p0 = 0; p0 < 128; p0 += R) {
        float cfs = (p0 < 64) ? coef0 : coef1;
#pragma unroll
        for (int u = 0; u < R; ++u) {
          float c = rlf(cfs, (p0 + u) & 63) * sc[u];
          f32x2 cc = f32x2{c, c};
#pragma unroll
          for (int j = 0; j < 2; ++j) {
#pragma unroll
            for (int k = 0; k < 4; ++k) {
              int dw = (int)w[u][j][k];
              o2[j * 8 + k * 2 + 0] += cc * __builtin_amdgcn_cvt_pk_f32_fp8(dw, false);
              o2[j * 8 + k * 2 + 1] += cc * __builtin_amdgcn_cvt_pk_f32_fp8(dw, true);
            }
          }
          if (p0 + R < 128) load_row(p0 + R + u, w[u], sc[u]);
          __builtin_amdgcn_sched_barrier(0);
        }
      }
    }
    float o[32];
#pragma unroll
    for (int i = 0; i < 16; ++i) {
      o[2 * i] = o2[i].x;
      o[2 * i + 1] = o2[i].y;
    }
    float s = 0.f;
    {
      const float4* xr = (const float4*)(XF + (size_t)row * 2048);
#pragma unroll
      for (int q = 0; q < 8; ++q) {
        float4 t = xr[(q >> 2) * 256 + lane * 4 + (q & 3)];
        o[q * 4 + 0] += ALPHA * t.x; o[q * 4 + 1] += ALPHA * t.y; o[q * 4 + 2] += ALPHA * t.z; o[q * 4 + 3] += ALPHA * t.w;
      }
#pragma unroll
      for (int i = 0; i < 32; ++i) s += o[i];
    }
    float mu = wsum_u(s) * (1.0f / 2048.0f);
    float q = 0.f;
#pragma unroll
    for (int i = 0; i < 32; ++i) {
      o[i] -= mu;
      q += o[i] * o[i];
    }
    float inv = rsqrtf(wsum_u(q) * (1.0f / 2048.0f) + 1e-5f);
    float* dstf;
    if (final_out) {
      if (row < MPR) {
        int b = row / TP, t = row % TP;
        dstf = (t >= 16) ? (p.out + O_YP + ((size_t)b * 2048 + (t - 16)) * D) : nullptr;
      } else {
        dstf = p.out + O_YS + (size_t)(row - MPR) * D;
      }
    } else {
      dstf = XF + (size_t)row * 2048;
    }
#pragma unroll
    for (int j = 0; j < 2; ++j) {
      float yv[16];
#pragma unroll
      for (int k = 0; k < 4; ++k) {
        float4 gv = *(const float4*)(g + j * 1024 + lane * 16 + k * 4);
        float4 bv = *(const float4*)(bta + j * 1024 + lane * 16 + k * 4);
        float4 y;
        y.x = o[j * 16 + k * 4 + 0] * inv * gv.x + bv.x;
        y.y = o[j * 16 + k * 4 + 1] * inv * gv.y + bv.y;
        y.z = o[j * 16 + k * 4 + 2] * inv * gv.z + bv.z;
        y.w = o[j * 16 + k * 4 + 3] * inv * gv.w + bv.w;
        if (dstf) *(float4*)(dstf + j * 1024 + lane * 16 + k * 4) = y;
        yv[k * 4 + 0] = y.x; yv[k * 4 + 1] = y.y; yv[k * 4 + 2] = y.z; yv[k * 4 + 3] = y.w;
      }
      if (!final_out) {
        uint4* xb = (uint4*)(XB + (size_t)row * 2048 + j * 1024 + lane * 16);
        xb[0] = make_uint4(pack2(yv[0], yv[1]), pack2(yv[2], yv[3]), pack2(yv[4], yv[5]), pack2(yv[6], yv[7]));
        xb[1] = make_uint4(pack2(yv[8], yv[9]), pack2(yv[10], yv[11]), pack2(yv[12], yv[13]), pack2(yv[14], yv[15]));
      }
    }
  }
}

DEVI float4 f4mul(float4 a, float4 b) { return make_float4(a.x * b.x, a.y * b.y, a.z * b.z, a.w * b.w); }
DEVI void row_info(int row, bool& prompt, int& b, int& t, int& T) {
  prompt = row < MPR;
  if (prompt) { b = row / TP; t = row - b * TP; T = TP; }
  else { b = (row - MPR) >> 2; t = (row - MPR) & 3; T = 4; }
}
DEVI void phase_pre1(const Params& p) {
  char* ws = p.ws;
  const float* PROJ = (const float*)(ws + OFF_PROJ);
  float* XC = (float*)(ws + OFF_GOUT);
  float* RKV = (float*)(ws + OFF_RKV);
  u16* LRA = (u16*)(ws + OFF_LRA);
  u16* LRB = (u16*)(ws + OFF_LRB);
  u16* LRG = (u16*)(ws + OFF_LRG);
  const float* cw = p.in[I_CVW];
  const float* cbias = p.in[I_CVB];
  const float* mu = p.in[I_MU];
  const int gtid = blockIdx.x * 512 + threadIdx.x, nthr = gridDim.x * 512;
#pragma unroll 2
  for (int idx = gtid; idx < M * 384; idx += nthr) {
    int row = idx / 384, c = (idx - row * 384) * 4;
    bool prompt; int b, t, T;
    row_info(row, prompt, b, t, T);
    float4 xv[4];
#pragma unroll
    for (int jj = 0; jj < 4; ++jj) {
      int tt = t - 3 + jj;
      if (tt >= 0) xv[jj] = ld4(PROJ + (size_t)(row - 3 + jj) * N1 + 1024 + c);
      else if (prompt) xv[jj] = make_float4(0.f, 0.f, 0.f, 0.f);
      else xv[jj] = ld4(p.in[I_SCV] + (size_t)(b * 3 + (tt + 3)) * 1536 + c);
    }
    float4 acc = ld4(cbias + c);
#pragma unroll
    for (int jj = 0; jj < 4; ++jj) {
      float4 w = ld4(cw + jj * 1536 + c);
      acc.x += xv[jj].x * w.x; acc.y += xv[jj].y * w.y; acc.z += xv[jj].z * w.z; acc.w += xv[jj].w * w.w;
    }
    *(float4*)(XC + (size_t)row * 1536 + c) = make_float4(siluf_(acc.x), siluf_(acc.y), siluf_(acc.z), siluf_(acc.w));
    if (t >= T - 3) {
      float* co = prompt ? (p.out + O_CVP) : (p.out + O_CVS);
      *(float4*)(co + (size_t)(b * 3 + (t - (T - 3))) * 1536 + c) = xv[3];
    }
  }
#pragma unroll 2
  for (int idx = gtid; idx < M * 840; idx += nthr) {
    int row = idx / 840, c = (idx - row * 840) * 4;
    bool prompt; int b, t, T;
    row_info(row, prompt, b, t, T);
    float4 cur = ld4(PROJ + (size_t)row * N1 + 2560 + c);
    float4 prev;
    if (t > 0) prev = ld4(PROJ + (size_t)(row - 1) * N1 + 2560 + c);
    else if (prompt) prev = make_float4(0.f, 0.f, 0.f, 0.f);
    else prev = ld4(p.in[I_SSH] + (size_t)b * 3360 + c);
    float4 m4 = ld4(mu + c);
    float4 mx;
    mx.x = cur.x + (prev.x - cur.x) * m4.x; mx.y = cur.y + (prev.y - cur.y) * m4.y;
    mx.z = cur.z + (prev.z - cur.z) * m4.z; mx.w = cur.w + (prev.w - cur.w) * m4.w;
    if (c < 3072) *(float4*)(RKV + (size_t)row * 3072 + c) = mx;
    else if (c < 3136) st_bf4(LRA + (size_t)row * 64 + (c - 3072), tanhf(mx.x), tanhf(mx.y), tanhf(mx.z), tanhf(mx.w));
    else if (c < 3200) st_bf4(LRB + (size_t)row * 64 + (c - 3136), mx.x, mx.y, mx.z, mx.w);
    else st_bf4(LRG + (size_t)row * 192 + (c - 3200), sigmoidf_(mx.x), sigmoidf_(mx.y), sigmoidf_(mx.z), sigmoidf_(mx.w));
    if (t == T - 1) {
      float* so = prompt ? (p.out + O_SHP) : (p.out + O_SHS);
      *(float4*)(so + (size_t)b * 3360 + c) = cur;
    }
  }
  for (int idx = gtid; idx < M * 4; idx += nthr) {
    int row = idx >> 2, k = idx & 3;
    ((uint4*)(LRG + (size_t)row * 192 + 160))[k] = make_uint4(0, 0, 0, 0);
  }
}

DEVI void phase_pre1c(const Params& p) {
  char* ws = p.ws;
  float* RKV = (float*)(ws + OFF_RKV);
  const float* AA = (const float*)(ws + OFF_AA);
  float* KK = (float*)(ws + OFF_QB);
  float* KKA = (float*)(ws + OFF_MIXB);
  float* BON = (float*)(ws + OFF_BON);
  const float* k_k = p.in[I_KK];
  const float* k_a = p.in[I_KA];
  const float* r_k = p.in[I_RK];
  const int lane = threadIdx.x & 63;
  const int gw = blockIdx.x * 8 + (threadIdx.x >> 6), nw = gridDim.x * 8;
  for (int row = gw; row < M; row += nw) {
    float4 k4[4], r4[4], a4[4];
#pragma unroll
    for (int it = 0; it < 4; ++it) {
      int c = it * 256 + lane * 4;
      k4[it] = ld4(RKV + (size_t)row * 3072 + 1024 + c);
      r4[it] = ld4(RKV + (size_t)row * 3072 + c);
      a4[it] = ld4(AA + (size_t)row * 1024 + c);
    }
#pragma unroll
    for (int it = 0; it < 4; ++it) {
      int c = it * 256 + lane * 4;
      float4 kk4 = ld4(k_k + c), ka4 = ld4(k_a + c), rk4 = ld4(r_k + c);
      float4 k = k4[it], r = r4[it], a = a4[it];
      float4 kr = f4mul(k, kk4);
      float ss = red16(kr.x * kr.x + kr.y * kr.y + kr.z * kr.z + kr.w * kr.w);
      float inv = 1.0f / fmaxf(sqrtf(ss), 1e-12f);
      float4 kk = make_float4(kr.x * inv, kr.y * inv, kr.z * inv, kr.w * inv);
      float4 kp;
      kp.x = k.x * (1.0f + (a.x - 1.0f) * ka4.x); kp.y = k.y * (1.0f + (a.y - 1.0f) * ka4.y);
      kp.z = k.z * (1.0f + (a.z - 1.0f) * ka4.z); kp.w = k.w * (1.0f + (a.w - 1.0f) * ka4.w);
      float bon = red16(r.x * kp.x * rk4.x + r.y * kp.y * rk4.y + r.z * kp.z * rk4.z + r.w * kp.w * rk4.w);
      *(float4*)(KK + (size_t)row * 1024 + c) = kk;
      *(float4*)(KKA + (size_t)row * 1024 + c) = f4mul(kk, a);
      *(float4*)(RKV + (size_t)row * 3072 + 1024 + c) = kp;
      if ((lane & 15) == 0) BON[(size_t)row * 16 + it * 4 + (lane >> 4)] = bon;
    }
  }
}

DEVI void rwkv_short(const float* __restrict__ RKV, const float* __restrict__ DEC, const float* __restrict__ KK,
                     const float* __restrict__ KKA, int h, int rb, int row0, const float* __restrict__ stin,
                     float* __restrict__ stout, float* __restrict__ outp) {
  const int tid = threadIdx.x & 255, w = tid >> 6, lane = tid & 63, rl = lane >> 4, sl = lane & 15;
  const int il = w * 4 + rl;
  float4 sv = *(const float4*)(stin + il * 64 + sl * 4);
  float S[4] = {sv.x, sv.y, sv.z, sv.w};
  float4 r4[4], w4[4], k4[4], n4[4], m4[4];
  float vi[4];
#pragma unroll
  for (int t = 0; t < 4; ++t) {
    const size_t row = (size_t)(row0 + t);
    r4[t] = *(const float4*)(RKV + row * 3072 + h * 64 + sl * 4);
    w4[t] = *(const float4*)(DEC + row * 1024 + h * 64 + sl * 4);
    k4[t] = *(const float4*)(RKV + row * 3072 + 1024 + h * 64 + sl * 4);
    n4[t] = *(const float4*)(KK + row * 1024 + h * 64 + sl * 4);
    m4[t] = *(const float4*)(KKA + row * 1024 + h * 64 + sl * 4);
    vi[t] = RKV[row * 3072 + 2048 + h * 64 + rb * 16 + il];
  }
#pragma unroll
  for (int t = 0; t < 4; ++t) {
    float sa = S[0] * n4[t].x + S[1] * n4[t].y + S[2] * n4[t].z + S[3] * n4[t].w;
    sa = -red16(sa);
    S[0] = S[0] * w4[t].x + sa * m4[t].x + vi[t] * k4[t].x;
    S[1] = S[1] * w4[t].y + sa * m4[t].y + vi[t] * k4[t].y;
    S[2] = S[2] * w4[t].z + sa * m4[t].z + vi[t] * k4[t].z;
    S[3] = S[3] * w4[t].w + sa * m4[t].w + vi[t] * k4[t].w;
    float y = S[0] * r4[t].x + S[1] * r4[t].y + S[2] * r4[t].z + S[3] * r4[t].w;
    y = red16(y);
    if (sl == 0) outp[(size_t)t * 2048 + il] = y;
  }
  *(float4*)(stout + il * 64 + sl * 4) = make_float4(S[0], S[1], S[2], S[3]);
}

DEVI void phase_rec1(const Params& p, float* smem) {
  char* ws = p.ws;
  const float* XC = (const float*)(ws + OFF_GOUT);
  const float* RKV = (const float*)(ws + OFF_RKV);
  const float* DEC = (const float*)(ws + OFF_DEC);
  const float* KK = (const float*)(ws + OFF_QB);
  const float* KKA = (const float*)(ws + OFF_MIXB);
  const float* DTA = (const float*)(ws + OFF_DTA);
  float* OMIX = (float*)(ws + OFF_OMIX);
  const float* wsf = (const float*)ws;
  constexpr int XO = (int)(OFF_GOUT / 4), DO = (int)(OFF_DTA / 4), RO = (int)(OFF_RKV / 4), CO = (int)(OFF_DEC / 4),
                KO = (int)(OFF_QB / 4), AO = (int)(OFF_MIXB / 4);
  const int half = threadIdx.x >> 8;
  for (int li = blockIdx.x; li < 256; li += gridDim.x) {
    if (half == 0) {
      int b = li >> 6, h = (li >> 2) & 15, cb = li & 3;
      int g = h >> 3;
      Seg sg[4] = {{XO + 1024 + g * 128, 1536, 32}, {XO + 1280 + g * 128, 1536, 32}, {XO + h * 64 + cb * 16, 1536, 4},
                   {DO + h * 4, 64, 1}};
      int row0 = b * TP;
      colrec_long<2>(wsf, sg, row0, TP, 0.f, OMIX + (size_t)row0 * 2048 + h * 64 + cb * 16, 2048,
                     p.out + O_SSP + (size_t)(b * 16 + h) * 128 * 64 + cb * 16, 64, smem);
    } else {
      int b = li >> 6, h = (li >> 2) & 15, rb = li & 3;
      int row0 = b * TP;
      Seg sg[6] = {{RO + h * 64, 3072, 16}, {CO + h * 64, 1024, 16}, {RO + 1024 + h * 64, 3072, 16},
                   {KO + h * 64, 1024, 16}, {AO + h * 64, 1024, 16}, {RO + 2048 + h * 64 + rb * 16, 3072, 4}};
      size_t so = ((size_t)(b * 16 + h) * 64 + rb * 16) * 64;
      rwkv_item(wsf, sg, row0, TP, nullptr, p.out + O_WKP + so, OMIX + (size_t)row0 * 2048 + 1024 + h * 64 + rb * 16, 2048, smem);
    }
  }
  for (int it = blockIdx.x * 2 + half; it < 2048; it += gridDim.x * 2) {
    int b = it >> 4, h = it & 15;
    int g = h >> 3;
    long row0 = MPR + (long)b * 4;
    size_t so = (size_t)(b * 16 + h) * 128 * 64;
    colrec_short<2>(XC + 1024 + g * 128, 1536, XC + 1280 + g * 128, 1536, XC + h * 64, 1536, DTA + h * 4, row0, 0.f,
                    p.in[I_SSM] + so, p.out + O_SSS + so, 64, OMIX + h * 64, 2048, smem);
  }
  for (int it = blockIdx.x * 2 + half; it < 8192; it += gridDim.x * 2) {
    int b = it >> 6, h = (it >> 2) & 15, rb = it & 3;
    int row0 = MPR + b * 4;
    size_t so = ((size_t)(b * 16 + h) * 64 + rb * 16) * 64;
    rwkv_short(RKV, DEC, KK, KKA, h, rb, row0, p.in[I_SWK] + so, p.out + O_WKS + so,
               OMIX + (size_t)row0 * 2048 + 1024 + h * 64 + rb * 16);
  }
}

DEVI void phase_post1(const Params& p) {
  char* ws = p.ws;
  const float* PROJ = (const float*)(ws + OFF_PROJ);
  const float* OMIX = (const float*)(ws + OFF_OMIX);
  const float* XC = (const float*)(ws + OFF_GOUT);
  const float* RKV = (const float*)(ws + OFF_RKV);
  const float* GG = (const float*)(ws + OFF_GG);
  const float* BON = (const float*)(ws + OFF_BON);
  u16* MIXB = (u16*)(ws + OFF_MIXB);
  const float* dsk = p.in[I_DSK];
  const float* sng = p.in[I_SNG];
  const float* lxg = p.in[I_LXG];
  const float* lxb = p.in[I_LXB];
  const int lane = threadIdx.x & 63;
  const int gw = blockIdx.x * 8 + (threadIdx.x >> 6), nw = gridDim.x * 8;
  for (int row = gw; row < M; row += nw) {
    const float* o = OMIX + (size_t)row * 2048;
    u16* mo = MIXB + (size_t)row * 2048;
    float4 oc[4], xc[4], z[4], y[4], v[4], gg[4];
    float bn[4];
#pragma unroll
    for (int it = 0; it < 4; ++it) {
      int c = it * 256 + lane * 4;
      oc[it] = ld4(o + c);
      xc[it] = ld4(XC + (size_t)row * 1536 + c);
      z[it] = ld4(PROJ + (size_t)row * N1 + c);
      y[it] = ld4(o + 1024 + c);
      v[it] = ld4(RKV + (size_t)row * 3072 + 2048 + c);
      gg[it] = ld4(GG + (size_t)row * 1024 + c);
      bn[it] = BON[(size_t)row * 16 + it * 4 + (lane >> 4)];
    }
    float4 val[4];
    float ssq[4];
#pragma unroll
    for (int it = 0; it < 4; ++it) {
      float ds = dsk[it * 4 + (lane >> 4)];
      val[it].x = (oc[it].x + xc[it].x * ds) * z[it].x;
      val[it].y = (oc[it].y + xc[it].y * ds) * z[it].y;
      val[it].z = (oc[it].z + xc[it].z * ds) * z[it].z;
      val[it].w = (oc[it].w + xc[it].w * ds) * z[it].w;
      ssq[it] = val[it].x * val[it].x + val[it].y * val[it].y + val[it].z * val[it].z + val[it].w * val[it].w;
    }
    float inv0 = rsqrtf(wsum_u_(ssq[0] + ssq[1]) * (1.0f / 512.0f) + 1e-6f);
    float inv1 = rsqrtf(wsum_u_(ssq[2] + ssq[3]) * (1.0f / 512.0f) + 1e-6f);
#pragma unroll
    for (int it = 0; it < 4; ++it) {
      int c = it * 256 + lane * 4;
      float inv = (it < 2) ? inv0 : inv1;
      float4 sg = ld4(sng + c);
      st_bf4(mo + c, val[it].x * inv * sg.x, val[it].y * inv * sg.y, val[it].z * inv * sg.z, val[it].w * inv * sg.w);
      float mu = red16(y[it].x + y[it].y + y[it].z + y[it].w) * (1.0f / 64.0f);
      float dx = y[it].x - mu, dy = y[it].y - mu, dz = y[it].z - mu, dw = y[it].w - mu;
      float var = red16(dx * dx + dy * dy + dz * dz + dw * dw) * (1.0f / 64.0f);
      float iv = rsqrtf(var + 64e-5f);
      float4 lg = ld4(lxg + c), lb = ld4(lxb + c);
      float y0 = (dx * iv * lg.x + lb.x + bn[it] * v[it].x) * gg[it].x;
      float y1 = (dy * iv * lg.y + lb.y + bn[it] * v[it].y) * gg[it].y;
      float y2 = (dz * iv * lg.z + lb.z + bn[it] * v[it].z) * gg[it].z;
      float y3 = (dw * iv * lg.w + lb.w + bn[it] * v[it].w) * gg[it].w;
      st_bf4(mo + 1024 + c, y0, y1, y2, y3);
    }
  }
}

#define XB_TMO      128
#define XB_XCNT(j)  (256  + 64 * (j))
#define XB_XSUB(j)  (1280 + 64 * (j))
#define XB_XGEN(j)  (2304 + 64 * (j))
#define XB_TOP      3328
#define XB_TOPGEN   3392
#define XCD_BAR_WORDS 3456
#define XB_SPIN_CAP (1u << 18)
#define LAS __attribute__((address_space(3)))

__device__ __forceinline__ unsigned xb_ld(unsigned* p)              { return __hip_atomic_load(p, __ATOMIC_RELAXED, __HIP_MEMORY_SCOPE_AGENT); }
__device__ __forceinline__ unsigned xb_add(unsigned* p, unsigned v) { return __hip_atomic_fetch_add(p, v, __ATOMIC_RELAXED, __HIP_MEMORY_SCOPE_AGENT); }
__device__ __forceinline__ unsigned xb_xcc_id() { return (unsigned)__builtin_amdgcn_s_getreg((3 << 11) | 20) & 0xFu; }
#define XB_SPIN(cond, bar) do { unsigned _sp = 0; while (cond) { __builtin_amdgcn_s_sleep(1); \
    if ((++_sp & 255u) == 0u) { if (xb_ld(&(bar)[XB_TMO])) break; if (_sp > XB_SPIN_CAP) { atomicAdd(&(bar)[XB_TMO], 1u); break; } } } } while (0)

struct XcdBarrier {
    unsigned* bar; unsigned x;
    volatile LAS unsigned* st;
};

__device__ __forceinline__ XcdBarrier xcd_barrier_post(unsigned* bar, volatile LAS unsigned* st) {
    XcdBarrier b; b.bar = bar; b.x = xb_xcc_id(); b.st = st;
    if (threadIdx.x == 0) (void)xb_add(&bar[XB_XCNT(b.x)], 1u);
    return b;
}
__device__ __forceinline__ void xcd_barrier_complete(unsigned* bar, unsigned x, unsigned& nloc, unsigned& nx) {
    const unsigned G = gridDim.x * gridDim.y * gridDim.z;
    unsigned sum, cnt, mine, sp = 0u;
    for (;;) {
        sum = 0u; cnt = 0u; mine = 0u;
#pragma unroll
        for (unsigned j = 0; j < 16; ++j) { const unsigned c = xb_ld(&bar[XB_XCNT(j)]); sum += c; cnt += (c > 0u) ? 1u : 0u; mine = (j == x) ? c : mine; }
        if (sum == G) break;
        __builtin_amdgcn_s_sleep(1);
        if ((++sp & 255u) == 0u) { if (xb_ld(&bar[XB_TMO])) break; if (sp > XB_SPIN_CAP) { atomicAdd(&bar[XB_TMO], 1u); break; } }
    }
    nloc = mine > 0u ? mine : 1u; nx = cnt > 0u ? cnt : 1u;
}

__device__ __forceinline__ void xcd_barrier(const XcdBarrier& b) {
    asm volatile("s_waitcnt vmcnt(0)" ::: "memory");
    __syncthreads();
    if (threadIdx.x == 0) {
        unsigned* bar = b.bar;
        __builtin_amdgcn_s_waitcnt(0);
        unsigned nloc = b.st[0], nx = b.st[1];
        if (nloc == 0u) { xcd_barrier_complete(bar, b.x, nloc, nx); b.st[0] = nloc; b.st[1] = nx; }
        const unsigned old = xb_add(&bar[XB_XSUB(b.x)], 1u);
        const unsigned gen = old / nloc;
        if (old + 1u == (gen + 1u) * nloc) {
            __builtin_amdgcn_fence(__ATOMIC_RELEASE, "agent");
            asm volatile("s_waitcnt vmcnt(0)" ::: "memory");
            const unsigned og = xb_add(&bar[XB_TOP], 1u);
            const unsigned tg = og / nx;
            if (og + 1u == (tg + 1u) * nx) xb_add(&bar[XB_TOPGEN], 1u);
            else XB_SPIN(xb_ld(&bar[XB_TOPGEN]) == tg, bar);
            __builtin_amdgcn_fence(__ATOMIC_ACQUIRE, "agent");
            xb_add(&bar[XB_XGEN(b.x)], 1u);
            asm volatile("s_waitcnt vmcnt(0)" ::: "memory");
        } else {
            XB_SPIN(xb_ld(&bar[XB_XGEN(b.x)]) == gen, bar);
            __builtin_amdgcn_fence(__ATOMIC_ACQUIRE, "agent");
            asm volatile("s_waitcnt vmcnt(0)" ::: "memory");
        }
    }
    __syncthreads();
}


template <int ph>
DEVI void run_phase(const Params& p, char* smem_raw) {
  float* smem = (float*)smem_raw;
  char* ws = p.ws;
  {
    switch (ph) {
      case 0:
        phase0(p, smem);
        conv_fp8_rows(p.in[I_PU], (unsigned char*)(ws + OFF_UB), (float*)(ws + OFF_USC));
        conv_fp8_rows(p.in[I_PV], (unsigned char*)(ws + OFF_VB), (float*)(ws + OFF_VSC));
        break;
      case 1: {
        EpiIn0 E{(float*)(ws + OFF_PROJ), (const float*)(ws + OFF_LB), (const float*)(ws + OFF_INVREV)};
        pg8::Gemm g{(const pg8::bf16_t*)(ws + OFF_XB), (const pg8::bf16_t*)(ws + OFF_WIN0), MP, N0, 2048};
        pg8::StaticOrder S;
        S.init(MP, N0, (int)gridDim.x, (int)blockIdx.x);
        pg8::gemm_phase<EpiIn0, pg8::StaticOrder, false>((PG8_LAS unsigned char*)smem_raw, g, S, E, nullptr);
      } break;
      case 2: phase_rec0(p, smem); break;
      case 3: phase_post0(p); break;
      case 4: case 15: {
        EpiStoreF32 E{(float*)(ws + OFF_GOUT)};
        pg8::Gemm g{(const pg8::bf16_t*)(ws + OFF_MIXB), (const pg8::bf16_t*)(ws + (ph == 4 ? OFF_WOUT0 : OFF_WOUT1)), MP, 2048, 2048};
        pg8::StaticOrder S;
        S.init(MP, 2048, (int)gridDim.x, (int)blockIdx.x);
        pg8::gemm_phase<EpiStoreF32, pg8::StaticOrder, false>((PG8_LAS unsigned char*)smem_raw, g, S, E, nullptr);
      } break;
      case 5: case 16: {
        int l = (ph == 5) ? 0 : 1;
        phase_ln(p, (const float*)(ws + OFF_GOUT), p.in[I_LNG] + (size_t)(l * 2) * D, p.in[I_LNB] + (size_t)(l * 2) * D);
      } break;
      case 6: case 17: {
        EpiStoreBf16 E{(u16*)(ws + OFF_QB)};
        pg8::Gemm g{(const pg8::bf16_t*)(ws + OFF_XB), (const pg8::bf16_t*)(ws + (ph == 6 ? OFF_WQ0 : OFF_WQ1)), MP, 2048, 2048};
        pg8::StaticOrder S;
        S.init(MP, 2048, (int)gridDim.x, (int)blockIdx.x);
        pg8::gemm_phase<EpiStoreBf16, pg8::StaticOrder, false>((PG8_LAS unsigned char*)smem_raw, g, S, E, nullptr);
      } break;
      case 7: case 18: {
        float* SC = (float*)(ws + OFF_GOUT);
        gemm_phase((const u16*)(ws + OFF_QB), 2048, 128, (const u16*)(ws + (ph == 7 ? OFF_KEY0 : OFF_KEY1)), 128,
                   69, 16, smem_raw, [=](int row, int col, float v0, float v1) {
                     SC[(size_t)row * 2048 + col] = v0;
                     SC[(size_t)row * 2048 + col + 32] = v1;
                   });
      } break;
      case 8: phase_peer(p, 0, false); break;
      case 9: {
        conv_fp8_rows(p.in[I_PU] + (size_t)16384 * 2048, (unsigned char*)(ws + OFF_UB), (float*)(ws + OFF_USC));
        conv_fp8_rows(p.in[I_PV] + (size_t)16384 * 2048, (unsigned char*)(ws + OFF_VB), (float*)(ws + OFF_VSC));
        EpiIn1 E{(float*)(ws + OFF_PROJ), (float*)(ws + OFF_DTA), p.in[I_DTB], p.in[I_ALOG]};
        pg8::Gemm g{(const pg8::bf16_t*)(ws + OFF_XB), (const pg8::bf16_t*)(ws + OFF_WIN1), MP, N1, 2048};
        pg8::StaticOrder S;
        S.init(MP, N1, (int)gridDim.x, (int)blockIdx.x);
        pg8::gemm_phase<EpiIn1, pg8::StaticOrder, false>((PG8_LAS unsigned char*)smem_raw, g, S, E, nullptr);
      } break;
      case 10: phase_pre1(p); break;
      case 11: {
        float* DEC = (float*)(ws + OFF_DEC);
        float* AA = (float*)(ws + OFF_AA);
        float* GG = (float*)(ws + OFF_GG);
        const float* w0 = p.in[I_W0];
        const float* a0 = p.in[I_A0];
        gemm_phase((const u16*)(ws + OFF_LRA), 64, 0, (const u16*)(ws + OFF_W2T), 64, 69, 8, smem_raw,
                   [=](int row, int col, float v0, float v1) {
#pragma unroll
                     for (int e = 0; e < 2; ++e) {
                       int cc = col + e * 32;
                       float v = (e ? v1 : v0);
                       float ew = 0.60653065971f * sigmoidf_(v);
                       DEC[(size_t)row * 1024 + cc] = __builtin_amdgcn_exp2f(-1.44269504089f * ew);
                     }
                   }, w0);
        gemm_phase((const u16*)(ws + OFF_LRB), 64, 0, (const u16*)(ws + OFF_A2T), 64, 69, 8, smem_raw,
                   [=](int row, int col, float v0, float v1) {
                     AA[(size_t)row * 1024 + col] = sigmoidf_(v0);
                     AA[(size_t)row * 1024 + col + 32] = sigmoidf_(v1);
                   }, a0);
        gemm_phase((const u16*)(ws + OFF_LRG), 192, 0, (const u16*)(ws + OFF_G2T), 192, 69, 8, smem_raw,
                   [=](int row, int col, float v0, float v1) {
                     GG[(size_t)row * 1024 + col] = v0;
                     GG[(size_t)row * 1024 + col + 32] = v1;
                   });
      } break;
      case 12: phase_pre1c(p); break;
      case 13: phase_rec1(p, smem); break;
      case 14: phase_post1(p); break;
      case 19: phase_peer(p, 1, true); break;
      default: break;
    }
  }
}

__global__ void __launch_bounds__(512, 2) mega(Params p, int ph_lo, int ph_hi) {
  __shared__ __attribute__((aligned(16))) char smem_raw[SMEM_BYTES];
  __shared__ uint4 xb_words;
  cg::grid_group grid = cg::this_grid();
  if (threadIdx.x == 0) xb_words = make_uint4(0u, 0u, 0u, 0u);
  __syncthreads();
  XcdBarrier xb = xcd_barrier_post((unsigned*)(p.ws + OFF_BAR), (volatile LAS unsigned*)&xb_words);
  if (ph_hi > 1000) grid.sync();
#ifndef REPEAT_MASK
#define REPEAT_MASK 0
#endif
#define PHASE(K)                                          \
  if (ph_lo <= K && K < ph_hi) run_phase<K>(p, smem_raw); \
  if ((REPEAT_MASK >> K) & 1) { xcd_barrier(xb); run_phase<K>(p, smem_raw); } \
  if (ph_lo <= K && K + 1 < ph_hi) xcd_barrier(xb);
  PHASE(0) PHASE(1) PHASE(2) PHASE(3) PHASE(4) PHASE(5) PHASE(6) PHASE(7) PHASE(8) PHASE(9)
  PHASE(10) PHASE(11) PHASE(12) PHASE(13) PHASE(14) PHASE(15) PHASE(16) PHASE(17) PHASE(18) PHASE(19)
}
#ifdef PHASE_TEST
template <int PH>
__global__ void __launch_bounds__(512, 2) phk(Params p) {
  __shared__ __attribute__((aligned(16))) char smem_raw[SMEM_BYTES];
  run_phase<PH>(p, smem_raw);
}
#define INST(N) template __global__ void phk<N>(Params);
INST(0) INST(1) INST(2) INST(3) INST(4) INST(5) INST(6) INST(7) INST(8) INST(9) INST(10) INST(11) INST(12) INST(13) INST(14) INST(19)
#endif

constexpr int NPHASE = 20;

extern "C" void kernel_launch(void* const* d_in, const int* in_sizes, int n_in, void* d_out, int out_size, void* d_ws,
                              size_t ws_size, hipStream_t stream) {
  static int grid_blocks = 0;
  if (!grid_blocks) {
    int dev = 0, cus = 0, per_cu = 0;
    hipGetDevice(&dev);
    hipDeviceGetAttribute(&cus, hipDeviceAttributeMultiprocessorCount, dev);
    hipOccupancyMaxActiveBlocksPerMultiprocessor(&per_cu, mega, 512, 0);
    if (per_cu > 1) per_cu = 1;
    if (per_cu < 1) per_cu = 1;
    grid_blocks = cus * per_cu;
  }
  Params p{};
  for (int i = 0; i < 38; ++i) p.in[i] = (const float*)d_in[i];
  p.out = (float*)d_out;
  p.ws = (char*)d_ws;
  (void)hipMemsetAsync((char*)d_ws + OFF_BAR, 0, 3456 * 4, stream);
  int lo = 0, hi = NPHASE;
  void* args[] = {&p, &lo, &hi};
  hipError_t e = hipLaunchCooperativeKernel((void*)mega, dim3(grid_blocks), dim3(512), args, 0, stream);
  if (e != hipSuccess) fprintf(stderr, "cooperative launch failed: %s (grid %d)\n", hipGetErrorString(e), grid_blocks);
}
```

```cpp
#include <hip/hip_runtime.h>
#include <hip/hip_bf16.h>
#include <hip/hip_cooperative_groups.h>
#include <cstdio>
#include <cmath>
namespace cg = cooperative_groups;

#define DEVI __device__ __forceinline__
typedef unsigned short u16;
using bf16x8 = __attribute__((ext_vector_type(8))) short;
using f32x4 = __attribute__((ext_vector_type(4))) float;
using u32x4 = __attribute__((ext_vector_type(4))) unsigned int;

constexpr int D = 2048;
constexpr int TP = 2064;
constexpr int MPR = 8256;
constexpr int M = 8768;
constexpr int MP = 8960;
constexpr int N0 = 7168;
constexpr int N1 = 6144;
constexpr float ALPHA = 1.41421356237f;

constexpr size_t SZ_TAB = (size_t)16384 * 2048 * 2;
constexpr size_t OFF_UB = 0;
constexpr size_t OFF_VB = OFF_UB + SZ_TAB;
constexpr size_t OFF_WIN0 = OFF_VB + SZ_TAB;
constexpr size_t OFF_WOUT0 = OFF_WIN0 + (size_t)N0 * 2048 * 2;
constexpr size_t OFF_WQ0 = OFF_WOUT0 + (size_t)2048 * 2048 * 2;
constexpr size_t OFF_KEY0 = OFF_WQ0 + (size_t)2048 * 2048 * 2;
constexpr size_t OFF_WIN1 = OFF_KEY0 + (size_t)16 * 128 * 128 * 2;
constexpr size_t OFF_WOUT1 = OFF_WIN1 + (size_t)N1 * 2048 * 2;
constexpr size_t OFF_WQ1 = OFF_WOUT1 + (size_t)2048 * 2048 * 2;
constexpr size_t OFF_KEY1 = OFF_WQ1 + (size_t)2048 * 2048 * 2;
constexpr size_t OFF_W2T = OFF_KEY1 + (size_t)16 * 128 * 128 * 2;
constexpr size_t OFF_A2T = OFF_W2T + (size_t)1024 * 64 * 2;
constexpr size_t OFF_G2T = OFF_A2T + (size_t)1024 * 64 * 2;
constexpr size_t OFF_LB = OFF_G2T + (size_t)1024 * 192 * 2;
constexpr size_t OFF_INVREV = OFF_LB + 1024 * 4;
constexpr size_t OFF_XF = OFF_INVREV + 64 * 8;
constexpr size_t OFF_XB = OFF_XF + (size_t)MP * 2048 * 4;
constexpr size_t OFF_PROJ = OFF_XB + (size_t)MP * 2048 * 2;
constexpr size_t OFF_GOUT = OFF_PROJ + (size_t)MP * N0 * 4;
constexpr size_t OFF_OMIX = OFF_GOUT + (size_t)MP * 2048 * 4;
constexpr size_t OFF_MIXB = OFF_OMIX + (size_t)MP * 2048 * 4;
constexpr size_t OFF_QB = OFF_MIXB + (size_t)MP * 2048 * 2;
constexpr size_t OFF_RKV = OFF_QB + (size_t)MP * 2048 * 2;
constexpr size_t OFF_DEC = OFF_RKV + (size_t)MP * 3072 * 4;
constexpr size_t OFF_AA = OFF_DEC + (size_t)MP * 1024 * 4;
constexpr size_t OFF_GG = OFF_AA + (size_t)MP * 1024 * 4;
constexpr size_t OFF_LRA = OFF_GG + (size_t)MP * 1024 * 4;
constexpr size_t OFF_LRB = OFF_LRA + (size_t)MP * 64 * 2;
constexpr size_t OFF_LRG = OFF_LRB + (size_t)MP * 64 * 2;
constexpr size_t OFF_DTA = OFF_LRG + (size_t)MP * 192 * 2;
constexpr size_t OFF_BON = OFF_DTA + (size_t)MP * 64 * 4;
constexpr size_t OFF_USC = OFF_BON + (size_t)MP * 16 * 4;
constexpr size_t OFF_VSC = OFF_USC + 16384 * 4;
constexpr size_t OFF_BAR = OFF_VSC + 16384 * 4;
constexpr size_t WS_TOTAL = OFF_BAR + 3456 * 4;
static_assert(WS_TOTAL <= (size_t)1 << 30, "workspace too large");

constexpr size_t O_YP = 0;
constexpr size_t O_YS = O_YP + (size_t)4 * 2048 * 2048;
constexpr size_t O_HGP = O_YS + (size_t)128 * 4 * 2048;
constexpr size_t O_HGS = O_HGP + (size_t)4 * 8 * 128 * 128;
constexpr size_t O_RTP = O_HGS + (size_t)128 * 8 * 128 * 128;
constexpr size_t O_RTS = O_RTP + (size_t)4 * 4 * 128 * 256;
constexpr size_t O_SSP = O_RTS + (size_t)128 * 4 * 128 * 256;
constexpr size_t O_SSS = O_SSP + (size_t)4 * 16 * 128 * 64;
constexpr size_t O_CVP = O_SSS + (size_t)128 * 16 * 128 * 64;
constexpr size_t O_CVS = O_CVP + (size_t)4 * 3 * 1536;
constexpr size_t O_WKP = O_CVS + (size_t)128 * 3 * 1536;
constexpr size_t O_WKS = O_WKP + (size_t)4 * 16 * 64 * 64;
constexpr size_t O_SHP = O_WKS + (size_t)128 * 16 * 64 * 64;
constexpr size_t O_SHS = O_SHP + (size_t)4 * 3360;

struct Params {
  const float* in[38];
  float* out;
  char* ws;
};
enum { I_XP = 0, I_XS, I_SHG, I_SRT, I_SSM, I_SCV, I_SWK, I_SSH, I_META, I_LNG, I_LNB, I_EWIN, I_LBL, I_HNG, I_EWOUT,
       I_OWIN, I_CVW, I_CVB, I_DTB, I_ALOG, I_DSK, I_SNG, I_MU, I_W0, I_W2, I_A0, I_A2, I_G2, I_KK, I_KA, I_RK,
       I_LXG, I_LXB, I_OWOUT, I_WQ, I_KEYS, I_PU, I_PV };

constexpr int VB_BYTES = 2 * 2 * 128 * 72 * 2;
constexpr int SMEM_BYTES = 2 * VB_BYTES;

DEVI u16 f2bf(float f) {
  unsigned u = __float_as_uint(f);
  u += 0x7fffu + ((u >> 16) & 1u);
  return (u16)(u >> 16);
}
DEVI unsigned pack2(float a, float b) { return (unsigned)f2bf(a) | ((unsigned)f2bf(b) << 16); }
DEVI float bflo(unsigned u) { return __uint_as_float(u << 16); }
DEVI float bfhi(unsigned u) { return __uint_as_float(u & 0xffff0000u); }
DEVI float sigmoidf_(float x) { return __builtin_amdgcn_rcpf(1.0f + __builtin_amdgcn_exp2f(-1.44269504089f * x)); }
DEVI float siluf_(float x) { return x * __builtin_amdgcn_rcpf(1.0f + __builtin_amdgcn_exp2f(-1.44269504089f * x)); }
DEVI float sigmoid_acc(float x) { return 1.0f / (1.0f + expf(-x)); }
DEVI float silu_acc(float x) { return x / (1.0f + expf(-x)); }
DEVI float softplusf_(float x) { return fmaxf(x, 0.0f) + log1pf(expf(-fabsf(x))); }
DEVI float wsum(float v) {
#pragma unroll
  for (int o = 32; o > 0; o >>= 1) v += __shfl_xor(v, o, 64);
  return v;
}
DEVI float wmaxf_(float v) {
#pragma unroll
  for (int o = 32; o > 0; o >>= 1) v = fmaxf(v, __shfl_xor(v, o, 64));
  return v;
}
DEVI int wmini_(int v) {
#pragma unroll
  for (int o = 32; o > 0; o >>= 1) v = min(v, __shfl_xor(v, o, 64));
  return v;
}
template <int CTRL>
DEVI float dppf(float v) {
  return __int_as_float(__builtin_amdgcn_update_dpp(0, __float_as_int(v), CTRL, 0xF, 0xF, true));
}
DEVI float red8(float v) {
  v += dppf<0xB1>(v);
  v += dppf<0x4E>(v);
  v += dppf<0x141>(v);
  return v;
}
DEVI float red16(float v) {
  v = red8(v);
  v += dppf<0x140>(v);
  return v;
}
DEVI float rlf_(float v, int l) { return __int_as_float(__builtin_amdgcn_readlane(__float_as_int(v), l)); }
DEVI int row_pos(int row) { return row < MPR ? (row % TP) : (16384 + ((row - MPR) & 3)); }

DEVI void conv_bf16_flat(const float* __restrict__ src, u16* __restrict__ dst, size_t n4) {
  size_t stride = (size_t)gridDim.x * blockDim.x;
  for (size_t i = (size_t)blockIdx.x * blockDim.x + threadIdx.x; i < n4; i += stride) {
    float4 v = ((const float4*)src)[i];
    uint2 o;
    o.x = pack2(v.x, v.y);
    o.y = pack2(v.z, v.w);
    ((uint2*)dst)[i] = o;
  }
}

template <int MODE>
DEVI int colmap(int j) {
  if (MODE == 0) return j;
  if (MODE == 1) {
    if (j < 4096 || j >= 5120) return j;
    int hb = j & ~127, c = j & 127, wc = c >> 5, n = (c >> 4) & 1, r = c & 15;
    int d = n ? (64 + wc * 16 + r) : (wc * 16 + r);
    return hb + d;
  }
  if (j < 2560) return j;
  if (j < 5920) return j + 16;
  if (j < 5936) return 2560 + (j - 5920);
  return -1;
}

template <int MODE>
DEVI void transpose_job(const float* __restrict__ src, int ldsrc, int Ksrc, u16* __restrict__ dst, int Kdst, int ndst,
                        float* smem) {
  int ktiles = Kdst / 64, ntiles = ndst / 64;
  int tid = threadIdx.x & 255;
  const int half = threadIdx.x >> 8;
  smem += half * (64 * 65);
  for (int base = blockIdx.x * 2; base < ktiles * ntiles; base += gridDim.x * 2) {
    int tile = base + half;
    const bool valid = tile < ktiles * ntiles;
    if (!valid) tile = ktiles * ntiles - 1;
    int tn = tile / ktiles, tk = tile % ktiles;
    int j0 = tn * 64, k0 = tk * 64;
    int jj = (tid & 15) * 4;
    int sc = colmap<MODE>(j0 + jj);
#pragma unroll
    for (int i = 0; i < 4; ++i) {
      int kk = i * 16 + (tid >> 4);
      float4 v = make_float4(0.f, 0.f, 0.f, 0.f);
      if (sc >= 0 && (k0 + kk) < Ksrc) v = *(const float4*)(src + (size_t)(k0 + kk) * ldsrc + sc);
      smem[kk * 65 + jj] = v.x;
      smem[kk * 65 + jj + 1] = v.y;
      smem[kk * 65 + jj + 2] = v.z;
      smem[kk * 65 + jj + 3] = v.w;
    }
    __syncthreads();
    int jr = tid >> 2, kq = (tid & 3) * 16;
    unsigned pk[8];
#pragma unroll
    for (int e = 0; e < 8; ++e) pk[e] = pack2(smem[(kq + 2 * e) * 65 + jr], smem[(kq + 2 * e + 1) * 65 + jr]);
    uint4* dp = (uint4*)(dst + (size_t)(j0 + jr) * Kdst + k0 + kq);
    if (valid) {
      dp[0] = make_uint4(pk[0], pk[1], pk[2], pk[3]);
      dp[1] = make_uint4(pk[4], pk[5], pk[6], pk[7]);
    }
    __syncthreads();
  }
}

DEVI void phase0(const Params& p, float* smem) {
  char* ws = p.ws;
  conv_bf16_flat(p.in[I_KEYS], (u16*)(ws + OFF_KEY0), (size_t)16 * 128 * 128 / 4);
  conv_bf16_flat(p.in[I_KEYS] + (size_t)16 * 128 * 128, (u16*)(ws + OFF_KEY1), (size_t)16 * 128 * 128 / 4);
  transpose_job<1>(p.in[I_EWIN], N0, 2048, (u16*)(ws + OFF_WIN0), 2048, N0, smem);
  transpose_job<0>(p.in[I_EWOUT], 2048, 2048, (u16*)(ws + OFF_WOUT0), 2048, 2048, smem);
  transpose_job<0>(p.in[I_WQ], 2048, 2048, (u16*)(ws + OFF_WQ0), 2048, 2048, smem);
  transpose_job<0>(p.in[I_WQ] + (size_t)2048 * 2048, 2048, 2048, (u16*)(ws + OFF_WQ1), 2048, 2048, smem);
  transpose_job<2>(p.in[I_OWIN], 5936, 2048, (u16*)(ws + OFF_WIN1), 2048, N1, smem);
  transpose_job<0>(p.in[I_OWOUT], 2048, 2048, (u16*)(ws + OFF_WOUT1), 2048, 2048, smem);
  transpose_job<0>(p.in[I_W2], 1024, 64, (u16*)(ws + OFF_W2T), 64, 1024, smem);
  transpose_job<0>(p.in[I_A2], 1024, 64, (u16*)(ws + OFF_A2T), 64, 1024, smem);
  transpose_job<0>(p.in[I_G2], 1024, 160, (u16*)(ws + OFF_G2T), 192, 1024, smem);
  {
    float* XF = (float*)(ws + OFF_XF);
    u16* XB = (u16*)(ws + OFF_XB);
    size_t n4 = (size_t)MP * 512;
    size_t stride = (size_t)gridDim.x * blockDim.x;
    for (size_t i = (size_t)blockIdx.x * blockDim.x + threadIdx.x; i < n4; i += stride) {
      int row = (int)(i >> 9), c4 = (int)(i & 511);
      float4 v = make_float4(0.f, 0.f, 0.f, 0.f);
      if (row < MPR) {
        int b = row / TP, t = row % TP;
        const float* s = (t < 16) ? (p.in[I_META] + (size_t)t * D) : (p.in[I_XP] + ((size_t)b * 2048 + (t - 16)) * D);
        v = ((const float4*)s)[c4];
      } else if (row < M) {
        v = ((const float4*)(p.in[I_XS] + (size_t)(row - MPR) * D))[c4];
      }
      ((float4*)XF)[i] = v;
      uint2 o;
      o.x = pack2(v.x, v.y);
      o.y = pack2(v.z, v.w);
      ((uint2*)XB)[i] = o;
    }
  }
  if (blockIdx.x == 0) {
    float* LB = (float*)(ws + OFF_LB);
    const float* lg = p.in[I_LBL];
    for (int c = threadIdx.x; c < 1024; c += blockDim.x) {
      float a = lg[c], b = lg[1024 + c], d = lg[2048 + c];
      float m = fmaxf(a, fmaxf(b, d));
      float ea = expf(a - m), eb = expf(b - m), ed = expf(d - m);
      LB[c] = ea / (ea + eb + ed);
    }
    float* IR = (float*)(ws + OFF_INVREV);
    if (threadIdx.x < 64) {
      double d = (double)threadIdx.x;
      double v = exp(-d * (9.210340371976184 / 64.0)) * 0.15915494309189535;
      float h = (float)v;
      IR[threadIdx.x * 2] = h;
      IR[threadIdx.x * 2 + 1] = (float)(v - (double)h);
    }
  }
}

constexpr int G_LDS_STRIDE = 72;
constexpr int G_LDS_BUF = 2 * 128 * G_LDS_STRIDE;
template <class Epi>
DEVI void gemm_phase(const u16* __restrict__ A, int lda, int a_ntile_off, const u16* __restrict__ Bt, int K, int mtiles,
                     int ntiles, char* smem, Epi epi, const float* __restrict__ colc = nullptr) {
  const int half = threadIdx.x >> 8;
  u16* S0 = (u16*)(smem + half * VB_BYTES);
  const int tid = threadIdx.x & 255, wid = tid >> 6, lane = tid & 63, wr = wid >> 1, wc = wid & 1, fr = lane & 15, fq = lane >> 4;
  const int nk = K / 64;
  const int ntot = mtiles * ntiles;
  for (int base = blockIdx.x * 2; base < ntot; base += gridDim.x * 2) {
    int tile = base + half;
    const bool valid = tile < ntot;
    if (!valid) tile = ntot - 1;
    const int tm = tile / ntiles, tn = tile - tm * ntiles;
    const int brow = tm * 128, bcol = tn * 128;
    const u16* Ag = A + (size_t)brow * lda + (size_t)tn * a_ntile_off;
    const u16* Bg = Bt + (size_t)bcol * K;
    f32x4 acc[4][4];
#pragma unroll
    for (int m = 0; m < 4; ++m)
#pragma unroll
      for (int n = 0; n < 4; ++n) acc[m][n] = f32x4{0.f, 0.f, 0.f, 0.f};
    u32x4 ra0[4], rb0[4], ra1[4], rb1[4];
    auto gload = [&](int t, u32x4(&ra)[4], u32x4(&rb)[4]) {
#pragma unroll
      for (int i = 0; i < 4; ++i) {
        int c = tid + i * 256, r = c >> 3, kc = c & 7;
        ra[i] = *(const u32x4*)(Ag + (size_t)r * lda + t * 64 + kc * 8);
        rb[i] = *(const u32x4*)(Bg + (size_t)r * K + t * 64 + kc * 8);
      }
    };
    auto lwrite = [&](int buf, const u32x4(&ra)[4], const u32x4(&rb)[4]) {
      u16* SA = S0 + buf * G_LDS_BUF;
      u16* SB = SA + 128 * G_LDS_STRIDE;
#pragma unroll
      for (int i = 0; i < 4; ++i) {
        int c = tid + i * 256, r = c >> 3, kc = c & 7;
        *(u32x4*)(SA + r * G_LDS_STRIDE + kc * 8) = ra[i];
        *(u32x4*)(SB + r * G_LDS_STRIDE + kc * 8) = rb[i];
      }
    };
    auto compute = [&](int buf) {
      const u16* SA = S0 + buf * G_LDS_BUF;
      const u16* SB = SA + 128 * G_LDS_STRIDE;
#pragma unroll
      for (int kh = 0; kh < 2; ++kh) {
        bf16x8 At[4], Bl[4];
#pragma unroll
        for (int m = 0; m < 4; ++m)
          At[m] = *(const bf16x8*)(SA + (wr * 64 + m * 16 + fr) * G_LDS_STRIDE + kh * 32 + fq * 8);
#pragma unroll
        for (int n = 0; n < 4; ++n)
          Bl[n] = *(const bf16x8*)(SB + (wc * 64 + n * 16 + fr) * G_LDS_STRIDE + kh * 32 + fq * 8);
#pragma unroll
        for (int m = 0; m < 4; ++m)
#pragma unroll
          for (int n = 0; n < 4; ++n) acc[m][n] = __builtin_amdgcn_mfma_f32_16x16x32_bf16(At[m], Bl[n], acc[m][n], 0, 0, 0);
        __builtin_amdgcn_sched_barrier(0);
      }
    };
    gload(0, ra0, rb0);
    if (nk > 1) gload(1, ra1, rb1);
    lwrite(0, ra0, rb0);
    __syncthreads();
#pragma unroll 1
    for (int t = 0; t < nk; t += 2) {
      if (t + 2 < nk) gload(t + 2, ra0, rb0);
      compute(0);
      if (t + 1 < nk) lwrite(1, ra1, rb1);
      __syncthreads();
      if (t + 1 < nk) {
        if (t + 3 < nk) gload(t + 3, ra1, rb1);
        compute(1);
        if (t + 2 < nk) lwrite(0, ra0, rb0);
        __syncthreads();
      }
    }
    if (valid) {
      float cc[4] = {0.f, 0.f, 0.f, 0.f};
      if (colc) {
#pragma unroll
        for (int n = 0; n < 4; ++n) cc[n] = colc[bcol + wc * 64 + n * 16 + fr];
      }
#pragma unroll
      for (int m = 0; m < 4; ++m)
#pragma unroll
        for (int n = 0; n < 2; ++n)
#pragma unroll
          for (int j = 0; j < 4; ++j) {
            int row = brow + wr * 64 + m * 16 + fq * 4 + j;
            int col = bcol + wc * 64 + n * 16 + fr;
            epi(row, col, acc[m][n][j] + cc[n], acc[m][n + 2][j] + cc[n + 2]);
          }
    }
  }
}


namespace pg8 {
#define PG8_LAS __attribute__((address_space(3)))
typedef unsigned short bf16_t;
typedef short bf16x8 __attribute__((ext_vector_type(8)));
typedef float f32x4 __attribute__((ext_vector_type(4)));
typedef unsigned u32x4 __attribute__((ext_vector_type(4)));
constexpr int BM = 256, BK = 64, HALF = 128, HTB = HALF * BK * 2  , STAGE_BYTES = 8 * HTB, NXCD = 8, WGM = 8;

__host__ __device__ __forceinline__ int lds_byte(int r, int c) { const int st = (r >> 4) * 2 + (c >> 5), rr = r & 15, cc = c & 31, ob = rr * 64 + cc * 2; return st * 1024 + (ob ^ (((ob >> 9) & 1) << 5)); }
__host__ __device__ __forceinline__ void stage_rc(int b, int& R, int& C) { const int st = b / 1024, sb = b % 1024, swz = sb ^ (((sb >> 9) & 1) << 5); R = (st >> 1) * 16 + swz / 64; C = (st & 1) * 32 + (swz % 64) / 2; }
__host__ __device__ __forceinline__ int perm32(int rho) { const int n = rho >> 4, i = rho & 15; return 8 * (i >> 2) + 4 * n + (i & 3); }

struct Unit { int pm, pn; };
struct Gemm { const bf16_t* A; const bf16_t* Bt; int M, N, K; };

struct StaticOrder {
    int nM, nN, nwg, G, c;
    __host__ __device__ void init(int M, int N, int G_, int c_) { nM = M / BM; nN = N / BM; nwg = nM * nN; G = G_; c = c_; }
    __host__ __device__ bool next(int i, Unit& u) const {
        const long L = (long)i * G + c; if (L >= nwg) return false;
        int wgid = (int)L; { const int q = nwg / NXCD, r = nwg % NXCD, xcd = wgid % NXCD, off = wgid / NXCD; wgid = (xcd < r ? xcd * (q + 1) : r * (q + 1) + (xcd - r) * q) + off; }
        const int nig = WGM * nN, gid = wgid / nig, fm = gid * WGM, gsz = (nM - fm) < WGM ? (nM - fm) : WGM;
        u.pm = fm + ((wgid % nig) % gsz); u.pn = (wgid % nig) / gsz; return true;
    }
    __device__ __forceinline__ void a_ready(const Unit&) const {}
    __device__ __forceinline__ void done(const Unit&) const {}
};
template <class Epi, class Sched, bool STAMP = false>
__device__ __forceinline__ void gemm_phase(PG8_LAS unsigned char* lds, const Gemm g, const Sched& S, const Epi& E, unsigned long long* stamps) {
    const int tid = threadIdx.x, wid = __builtin_amdgcn_readfirstlane(tid >> 6), lane = tid & 63, wr = wid >> 2, wc = wid & 3, fr = lane & 15, fq = lane >> 4;
    const int K = g.K, nt = K / BK;
    int ts_lo = 0, ts_hi = 0, nts = 0; const unsigned long long rt_entry = STAMP ? (unsigned long long)wall_clock64() : 0ull;
#define PG8_STAMP() do { if (STAMP && wid == 0 && nts < 64) { const unsigned long long _c = (unsigned long long)clock64(); \
        ts_lo = (lane == nts) ? (int)(unsigned)_c : ts_lo; ts_hi = (lane == nts) ? (int)(unsigned)(_c >> 32) : ts_hi; ++nts; } } while (0)
    PG8_STAMP();
    unsigned voffA[2], voffB[2];
#pragma unroll
    for (int i = 0; i < 2; ++i) { int R, C; stage_rc(tid * 16 + i * 8192, R, C); const int Rb = Epi::PERM ? ((R & ~31) + perm32(R & 31)) : R;
        voffA[i] = (unsigned)(R * K + C) * 2u; voffB[i] = (unsigned)(Rb * K + C) * 2u; }
    const size_t kstep = (size_t)(BK * 2);
    const size_t hstep = (size_t)HALF * K * 2;
    const size_t tstep = 2 * hstep;
    const unsigned ldsw = (unsigned)wid * 1024u;
    const int aoff = lds_byte(wr * 64 + fr, fq * 8), boff = lds_byte(wc * 32 + fr, fq * 8);
#define PG8_SA(b, h) (((b) * 2 + (h)) * HTB)
#define PG8_SB(b, h) ((4 + (b) * 2 + (h)) * HTB)
#define PG8_STAGE(bufoff, gbase, voff) do { _Pragma("unroll") for (int _i = 0; _i < 2; ++_i) \
        __builtin_amdgcn_global_load_lds((const unsigned*)((const char*)(gbase) + (voff)[_i]), (PG8_LAS unsigned*)(lds + (bufoff) + ldsw + _i * 8192), 16, 0, 0); } while (0)
#define PG8_LDA(dst, b, h) do { _Pragma("unroll") for (int m = 0; m < 4; ++m) _Pragma("unroll") for (int k = 0; k < 2; ++k) dst[m][k] = *(const PG8_LAS bf16x8*)(lds + PG8_SA(b, h) + aoff + m * 2048 + k * 1024); } while (0)
#define PG8_LDB(dst, b, h) do { _Pragma("unroll") for (int n = 0; n < 2; ++n) _Pragma("unroll") for (int k = 0; k < 2; ++k) dst[n][k] = *(const PG8_LAS bf16x8*)(lds + PG8_SB(b, h) + boff + n * 2048 + k * 1024); } while (0)
#define PG8_MMA(ai, bj, At, Bt) do { __builtin_amdgcn_s_setprio(1); _Pragma("unroll") for (int m = 0; m < 4; ++m) _Pragma("unroll") for (int n = 0; n < 2; ++n) _Pragma("unroll") for (int k = 0; k < 2; ++k) \
        acc[ai][bj][m][n] = __builtin_amdgcn_mfma_f32_16x16x32_bf16(Bt[n][k], At[m][k], acc[ai][bj][m][n], 0, 0, 0); __builtin_amdgcn_s_setprio(0); } while (0)
#define PG8_WAIT_V(n) asm volatile("s_waitcnt vmcnt(" #n ")" ::: "memory")
#define PG8_WAIT_L(n) asm volatile("s_waitcnt lgkmcnt(" #n ")" ::: "memory")
#define PG8_BAR __builtin_amdgcn_s_barrier()
#define PG8_SCHED __builtin_amdgcn_sched_barrier(0)
    Unit cur, nxt; int ui = 0;
    if (!S.next(0, cur)) return;
    f32x4 acc[2][2][4][2];
#pragma unroll
    for (int a = 0; a < 2; ++a)
#pragma unroll
        for (int b = 0; b < 2; ++b)
#pragma unroll
            for (int m = 0; m < 4; ++m)
#pragma unroll
                for (int n = 0; n < 2; ++n) acc[a][b][m][n] = (f32x4){0.f, 0.f, 0.f, 0.f};
    bf16x8 At[4][2], B0[2][2], B1[2][2];
    const char* cA = (const char*)g.A + (size_t)cur.pm * tstep; const char* cB = (const char*)g.Bt + (size_t)cur.pn * tstep;
    S.a_ready(cur);
    PG8_STAGE(PG8_SB(0, 0), cB, voffB); PG8_STAGE(PG8_SA(0, 0), cA, voffA); PG8_STAGE(PG8_SB(0, 1), cB + hstep, voffB); PG8_STAGE(PG8_SA(0, 1), cA + hstep, voffA);
    if (wr == 1) PG8_BAR;
    PG8_WAIT_V(4); PG8_BAR;
    PG8_STAGE(PG8_SB(1, 0), cB + kstep, voffB); PG8_STAGE(PG8_SA(1, 0), cA + kstep, voffA); PG8_STAGE(PG8_SB(1, 1), cB + hstep + kstep, voffB);
    PG8_WAIT_V(6); PG8_BAR;
    PG8_STAMP();
    for (;;) {
        const bool has_next = S.next(ui + 1, nxt);
        const char* nA = has_next ? (const char*)g.A + (size_t)nxt.pm * tstep : cA; const char* nB = has_next ? (const char*)g.Bt + (size_t)nxt.pn * tstep : cB;
        for (int t = 0; t < nt; t += 2) {
            const bool last = (t == nt - 2);
            const char* a1 = cA + (size_t)(t + 1) * kstep;
            const char* a2 = last ? nA : cA + (size_t)(t + 2) * kstep; const char* b2 = last ? nB : cB + (size_t)(t + 2) * kstep;
            const char* a3 = a2 + kstep; const char* b3 = b2 + kstep;
            if (last && has_next) S.a_ready(nxt);
            PG8_LDB(B0, 0, 0); PG8_SCHED; PG8_LDA(At, 0, 0); PG8_STAGE(PG8_SA(1, 1), a1 + hstep, voffA);
            PG8_WAIT_L(8); PG8_BAR; PG8_WAIT_L(0); PG8_MMA(0, 0, At, B0); PG8_BAR; PG8_SCHED;
            PG8_LDB(B1, 0, 1); PG8_STAGE(PG8_SB(0, 0), b2, voffB);
            PG8_BAR; PG8_WAIT_L(0); PG8_MMA(0, 1, At, B1); PG8_BAR;
            PG8_LDA(At, 0, 1); PG8_STAGE(PG8_SA(0, 0), a2, voffA);
            PG8_BAR; PG8_WAIT_L(0); PG8_MMA(1, 0, At, B0); PG8_BAR; PG8_SCHED;
            PG8_STAGE(PG8_SB(0, 1), b2 + hstep, voffB);
            PG8_WAIT_V(6); PG8_BAR; PG8_MMA(1, 1, At, B1); PG8_BAR;
            PG8_LDB(B0, 1, 0); PG8_SCHED; PG8_LDA(At, 1, 0); PG8_STAGE(PG8_SA(0, 1), a2 + hstep, voffA);
            PG8_WAIT_L(8); PG8_BAR; PG8_WAIT_L(0); PG8_MMA(0, 0, At, B0); PG8_BAR; PG8_SCHED;
            PG8_LDB(B1, 1, 1); PG8_STAGE(PG8_SB(1, 0), b3, voffB);
            PG8_BAR; PG8_WAIT_L(0); PG8_MMA(0, 1, At, B1); PG8_BAR;
            PG8_LDA(At, 1, 1); PG8_STAGE(PG8_SA(1, 0), a3, voffA);
            PG8_BAR; PG8_WAIT_L(0); PG8_MMA(1, 0, At, B0); PG8_BAR; PG8_SCHED;
            PG8_STAGE(PG8_SB(1, 1), b3 + hstep, voffB);
            PG8_WAIT_V(6); PG8_BAR; PG8_MMA(1, 1, At, B1); PG8_BAR;
        }
        PG8_STAMP();
        if constexpr (!Epi::AFTER_DRAIN) { E(acc, cur, wr, wc, fr, fq); S.done(cur); }
        PG8_STAMP();
        if (!has_next) break;
#pragma unroll
        for (int a = 0; a < 2; ++a)
#pragma unroll
            for (int b = 0; b < 2; ++b)
#pragma unroll
                for (int m = 0; m < 4; ++m)
#pragma unroll
                    for (int n = 0; n < 2; ++n) acc[a][b][m][n] = (f32x4){0.f, 0.f, 0.f, 0.f};
        cur = nxt; cA = nA; cB = nB; ++ui;
    }
    PG8_WAIT_V(0);
    if (wr == 0) PG8_BAR;
    PG8_BAR;
    if constexpr (Epi::AFTER_DRAIN) { E.fused(acc, cur, wr, wc, fr, fq, lds, wid, lane); S.done(cur); }
    PG8_STAMP();
    if (STAMP && wid == 0) { stamps[lane] = lane < nts ? (((unsigned long long)(unsigned)ts_hi << 32) | (unsigned)ts_lo) : 0ull;
        if (lane == 62) stamps[62] = rt_entry; if (lane == 63) stamps[63] = (unsigned long long)wall_clock64(); }
#undef PG8_STAMP
#undef PG8_SA
#undef PG8_SB
#undef PG8_STAGE
#undef PG8_LDA
#undef PG8_LDB
#undef PG8_MMA
#undef PG8_WAIT_V
#undef PG8_WAIT_L
#undef PG8_BAR
#undef PG8_SCHED
}
}

struct EpiIn0 {
  static constexpr bool PERM = false, AFTER_DRAIN = false;
  float* PROJ;
  const float* LB;
  const float* IR;
  __device__ __forceinline__ void operator()(const pg8::f32x4 (&acc)[2][2][4][2], const pg8::Unit& u, int wr, int wc, int fr, int fq) const {
#pragma unroll
    for (int bj = 0; bj < 2; ++bj) {
      const int cb = u.pn * 256 + bj * 128;
      if (cb >= 4096 && cb < 5120) {
        const int d0 = wc * 16 + 4 * fq;
        const pg8::f32x4 irA = *(const pg8::f32x4*)(IR + 2 * d0), irB = *(const pg8::f32x4*)(IR + 2 * d0 + 4);
        const float irh[4] = {irA[0], irA[2], irB[0], irB[2]}, irl[4] = {irA[1], irA[3], irB[1], irB[3]};
        const float sc = (cb >= 4608) ? 0.08838834764831845f : 1.0f;
#pragma unroll
        for (int ai = 0; ai < 2; ++ai)
#pragma unroll
          for (int m = 0; m < 4; ++m) {
            const int row = u.pm * 256 + ai * 128 + wr * 64 + m * 16 + fr;
            float* pr = PROJ + (size_t)row * N0;
            const pg8::f32x4 v0 = acc[ai][bj][m][0], v1 = acc[ai][bj][m][1];
            const float pos = (float)row_pos(row);
            pg8::f32x4 o1, o2;
#pragma unroll
            for (int j = 0; j < 4; ++j) {
              float ph = pos * irh[j];
              float pe = __builtin_fmaf(pos, irh[j], -ph) + pos * irl[j];
              float frc = __builtin_amdgcn_fractf(ph) + pe;
              float sn = __builtin_amdgcn_sinf(frc), cs = __builtin_amdgcn_cosf(frc);
              o1[j] = (v0[j] * cs - v1[j] * sn) * sc;
              o2[j] = (v0[j] * sn + v1[j] * cs) * sc;
            }
            *(pg8::f32x4*)(pr + cb + d0) = o1;
            *(pg8::f32x4*)(pr + cb + 64 + d0) = o2;
            __builtin_amdgcn_sched_barrier(0);
          }
      } else if (cb >= 1024 && cb < 2048) {
        const int c0 = cb + 32 * wc + 4 * fq;
        const pg8::f32x4 l0 = *(const pg8::f32x4*)(LB + c0 - 1024), l1 = *(const pg8::f32x4*)(LB + c0 + 16 - 1024);
#pragma unroll
        for (int ai = 0; ai < 2; ++ai)
#pragma unroll
          for (int m = 0; m < 4; ++m) {
            const int row = u.pm * 256 + ai * 128 + wr * 64 + m * 16 + fr;
            float* pr = PROJ + (size_t)row * N0;
#pragma unroll
            for (int n = 0; n < 2; ++n) {
              const pg8::f32x4 l = n ? l1 : l0;
              pg8::f32x4 v = acc[ai][bj][m][n], o;
#pragma unroll
              for (int j = 0; j < 4; ++j) o[j] = l[j] + (1.0f - l[j]) * sigmoidf_(v[j]);
              *(pg8::f32x4*)(pr + c0 + 16 * n) = o;
            }
            __builtin_amdgcn_sched_barrier(0);
          }
      } else if (cb < 1024 || (cb >= 3072 && cb < 4096) || cb >= 6144) {
        const int c0 = cb + 32 * wc + 4 * fq;
#pragma unroll
        for (int ai = 0; ai < 2; ++ai)
#pragma unroll
          for (int m = 0; m < 4; ++m) {
            const int row = u.pm * 256 + ai * 128 + wr * 64 + m * 16 + fr;
            float* pr = PROJ + (size_t)row * N0;
#pragma unroll
            for (int n = 0; n < 2; ++n) {
              pg8::f32x4 v = acc[ai][bj][m][n], o;
#pragma unroll
              for (int j = 0; j < 4; ++j) o[j] = siluf_(v[j]);
              *(pg8::f32x4*)(pr + c0 + 16 * n) = o;
            }
            __builtin_amdgcn_sched_barrier(0);
          }
      } else {
        const int c0 = cb + 32 * wc + 4 * fq;
#pragma unroll
        for (int ai = 0; ai < 2; ++ai)
#pragma unroll
          for (int m = 0; m < 4; ++m) {
            const int row = u.pm * 256 + ai * 128 + wr * 64 + m * 16 + fr;
            float* pr = PROJ + (size_t)row * N0;
#pragma unroll
            for (int n = 0; n < 2; ++n) *(pg8::f32x4*)(pr + c0 + 16 * n) = acc[ai][bj][m][n];
          }
      }
    }
  }
};
struct EpiStoreF32 {
  static constexpr bool PERM = false, AFTER_DRAIN = false;
  float* C;
  __device__ __forceinline__ void operator()(const pg8::f32x4 (&acc)[2][2][4][2], const pg8::Unit& u, int wr, int wc, int fr, int fq) const {
#pragma unroll
    for (int ai = 0; ai < 2; ++ai)
#pragma unroll
      for (int m = 0; m < 4; ++m) {
        const int row = u.pm * 256 + ai * 128 + wr * 64 + m * 16 + fr;
        float* pr = C + (size_t)row * 2048 + u.pn * 256 + 32 * wc + 4 * fq;
#pragma unroll
        for (int bj = 0; bj < 2; ++bj)
#pragma unroll
          for (int n = 0; n < 2; ++n) *(pg8::f32x4*)(pr + bj * 128 + 16 * n) = acc[ai][bj][m][n];
      }
  }
};
struct EpiStoreBf16 {
  static constexpr bool PERM = false, AFTER_DRAIN = false;
  u16* C;
  __device__ __forceinline__ void operator()(const pg8::f32x4 (&acc)[2][2][4][2], const pg8::Unit& u, int wr, int wc, int fr, int fq) const {
#pragma unroll
    for (int ai = 0; ai < 2; ++ai)
#pragma unroll
      for (int m = 0; m < 4; ++m) {
        const int row = u.pm * 256 + ai * 128 + wr * 64 + m * 16 + fr;
        u16* pr = C + (size_t)row * 2048 + u.pn * 256 + 32 * wc + 4 * fq;
#pragma unroll
        for (int bj = 0; bj < 2; ++bj)
#pragma unroll
          for (int n = 0; n < 2; ++n) {
            const pg8::f32x4 v = acc[ai][bj][m][n];
            uint2 o;
            o.x = pack2(v[0], v[1]);
            o.y = pack2(v[2], v[3]);
            *(uint2*)(pr + bj * 128 + 16 * n) = o;
          }
      }
  }
};
struct EpiIn1 {
  static constexpr bool PERM = false, AFTER_DRAIN = false;
  float* PROJ;
  float* DTA;
  const float* dtb;
  const float* alog;
  __device__ __forceinline__ void operator()(const pg8::f32x4 (&acc)[2][2][4][2], const pg8::Unit& u, int wr, int wc, int fr, int fq) const {
    float dtbv[4] = {0.f, 0.f, 0.f, 0.f}, aev[4] = {0.f, 0.f, 0.f, 0.f};
    if (u.pn == 23) {
      const int cc = 23 * 256 + 32 * wc + 4 * fq;
      const int hb = (cc >= 5920 && cc < 5936) ? (cc - 5920) : ((cc + 16 >= 5920 && cc + 16 < 5936) ? (cc + 16 - 5920) : -1);
      if (hb >= 0) {
#pragma unroll
        for (int j = 0; j < 4; ++j) { dtbv[j] = dtb[hb + j]; aev[j] = expf(alog[hb + j]); }
      }
    }
#pragma unroll
    for (int ai = 0; ai < 2; ++ai)
#pragma unroll
      for (int m = 0; m < 4; ++m) {
        const int row = u.pm * 256 + ai * 128 + wr * 64 + m * 16 + fr;
        float* pr = PROJ + (size_t)row * N1;
#pragma unroll
        for (int bj = 0; bj < 2; ++bj)
#pragma unroll
          for (int n = 0; n < 2; ++n) {
            const int col0 = u.pn * 256 + bj * 128 + 32 * wc + 16 * n + 4 * fq;
            pg8::f32x4 v = acc[ai][bj][m][n];
            if (col0 < 1024) {
              pg8::f32x4 o;
#pragma unroll
              for (int j = 0; j < 4; ++j) o[j] = siluf_(v[j]);
              *(pg8::f32x4*)(pr + col0) = o;
            } else if (col0 < 5920) {
              *(pg8::f32x4*)(pr + col0) = v;
            } else if (col0 < 5936) {
#pragma unroll
              for (int j = 0; j < 4; ++j) {
                int h = col0 + j - 5920;
                float dt = softplusf_(v[j] + dtbv[j]);
                DTA[(size_t)row * 64 + h * 4] = dt;
                DTA[(size_t)row * 64 + h * 4 + 1] = expf(-dt * aev[j]);
              }
            }
          }
      }
  }
};

struct Seg {
  int off;
  int ld;
  int n4;
};

template <int NS, int NF4, int RG>
DEVI void stage_init(const float* wsf, const Seg (&sg)[NS], int row0, int tid, const float* (&ptr)[RG], int (&ldv)[RG]) {
  asm volatile("" : "+v"(tid));
#pragma unroll
  for (int q = 0; q < RG; ++q) {
    int flat = tid + q * 256;
    int t = flat / NF4, f = flat % NF4;
    if (flat >= 16 * NF4) { t = 0; f = 0; }
    int off = 0, ld = 0, ff = f;
    bool done = false;
#pragma unroll
    for (int s = 0; s < NS; ++s) {
      bool here = (!done) && (ff < sg[s].n4);
      off = here ? (sg[s].off + (row0 + t) * sg[s].ld + ff * 4) : off;
      ld = here ? sg[s].ld : ld;
      ff = (done || here) ? ff : (ff - sg[s].n4);
      done = done || here;
    }
    ptr[q] = wsf + off;
    ldv[q] = ld;
  }
}
template <int NF4, int RG>
DEVI void stage_issue(const float* const (&ptr)[RG], const int (&ldv)[RG], int st, int nsteps, int tid, f32x4 (&rg)[RG]) {
#pragma unroll
  for (int q = 0; q < RG; ++q) {
    int flat = tid + q * 256;
    if (flat < nsteps * NF4) rg[q] = *(const f32x4*)(ptr[q] + (st * 16) * ldv[q]);
  }
}
template <int NF4, int RG>
DEVI void stage_commit(float* buf, int nsteps, int tid, const f32x4 (&rg)[RG]) {
#pragma unroll
  for (int q = 0; q < RG; ++q) {
    int flat = tid + q * 256;
    if (flat < nsteps * NF4) ((f32x4*)buf)[flat] = rg[q];
  }
}

template <int MODE>
DEVI void colrec_long(const float* wsf, const Seg (&sg)[4], int row0, int T, float gamma, float* outp, int ldo, float* stout, int st_ld,
                      float* smem) {
  constexpr int NF4 = 69, W = 276, RG = 5;
  const int tid = threadIdx.x & 255, w = tid >> 6, lane = tid & 63, c = lane >> 4, s = lane & 15;
  smem += (threadIdx.x >> 8) * (VB_BYTES / 4);
  float S[8];
#pragma unroll
  for (int i = 0; i < 8; ++i) S[i] = 0.f;
  float* buf0 = smem;
  float* buf1 = smem + 16 * 336;
  float* obuf = smem + 2 * 16 * 336;
  const int nst = (T + 15) / 16;
  f32x4 rgA[RG], rgB[RG];
  const float* sptr[RG];
  int sld[RG];
  stage_init<4, NF4, RG>(wsf, sg, row0, tid, sptr, sld);
  auto step = [&](const float* sp, float* ob, int tt) -> float {
    float4 a0 = *(const float4*)(sp + s * 4), a1 = *(const float4*)(sp + 64 + s * 4);
    float4 q0 = *(const float4*)(sp + 128 + s * 4), q1 = *(const float4*)(sp + 192 + s * 4);
    float a[8] = {a0.x, a0.y, a0.z, a0.w, a1.x, a1.y, a1.z, a1.w};
    float q[8] = {q0.x, q0.y, q0.z, q0.w, q1.x, q1.y, q1.z, q1.w};
    float val = sp[256 + w * 4 + c];
    float dA = gamma;
    if (MODE == 2) {
      val *= sp[272];
      dA = sp[273];
    }
    float o = 0.f;
#pragma unroll
    for (int i = 0; i < 8; ++i) {
      if (MODE == 0) S[i] = val + a[i] * (S[i] - val);
      else S[i] = dA * S[i] + a[i] * val;
      o += q[i] * S[i];
    }
    return red16(o);
  };
  auto run_stage = [&](const float* b, float* ob, int nthis) {
#pragma unroll 1
    for (int tt = 0; tt < nthis; tt += 8) {
      float o0 = step(b + tt * W, ob, tt);
      float o1 = step(b + (tt + 1) * W, ob, tt + 1);
      float o2 = step(b + (tt + 2) * W, ob, tt + 2);
      float o3 = step(b + (tt + 3) * W, ob, tt + 3);
      float o4 = step(b + (tt + 4) * W, ob, tt + 4);
      float o5 = step(b + (tt + 5) * W, ob, tt + 5);
      float o6 = step(b + (tt + 6) * W, ob, tt + 6);
      float o7 = step(b + (tt + 7) * W, ob, tt + 7);
      const int base = (s == 0) ? (tt * 16 + w * 4 + c) : (1024 + (tid & 255));
      const int st16 = (s == 0) ? 16 : 0;
      ob[base] = o0;
      ob[base + st16] = o1;
      ob[base + 2 * st16] = o2;
      ob[base + 3 * st16] = o3;
      ob[base + 4 * st16] = o4;
      ob[base + 5 * st16] = o5;
      ob[base + 6 * st16] = o6;
      ob[base + 7 * st16] = o7;
    }
  };
  auto write_out = [&](const float* ob, int st, int nthis) {
    if (tid < nthis * 4) {
      int t = tid >> 2, c4 = tid & 3;
      *(float4*)(outp + (size_t)(st * 16 + t) * ldo + c4 * 4) = *(const float4*)(ob + t * 16 + c4 * 4);
    }
  };
  auto nsteps = [&](int st) { return min(16, T - st * 16); };
  stage_issue<NF4, RG>(sptr, sld, 0, nsteps(0), tid, rgA);
  stage_commit<NF4, RG>(buf0, nsteps(0), tid, rgA);
  if (nst > 1) stage_issue<NF4, RG>(sptr, sld, 1, nsteps(1), tid, rgB);
  __syncthreads();
#pragma unroll 1
  for (int st = 0; st < nst; st += 2) {
    if (st + 2 < nst) stage_issue<NF4, RG>(sptr, sld, st + 2, nsteps(st + 2), tid, rgA);
    run_stage(buf0, obuf, nsteps(st));
    if (st + 1 < nst) stage_commit<NF4, RG>(buf1, nsteps(st + 1), tid, rgB);
    __syncthreads();
    write_out(obuf, st, nsteps(st));
    if (st + 1 < nst) {
      if (st + 3 < nst) stage_issue<NF4, RG>(sptr, sld, st + 3, nsteps(st + 3), tid, rgB);
      run_stage(buf1, obuf + 512, nsteps(st + 1));
      if (st + 2 < nst) stage_commit<NF4, RG>(buf0, nsteps(st + 2), tid, rgA);
      __syncthreads();
      write_out(obuf + 512, st + 1, nsteps(st + 1));
    }
  }
#pragma unroll
  for (int i = 0; i < 8; ++i) stout[(size_t)((i < 4 ? 0 : 60) + s * 4 + i) * st_ld + w * 4 + c] = S[i];
  __syncthreads();
}

template <int MODE>
DEVI void colrec_short(const float* pa, int lda_, const float* pq, int ldq, const float* pc, int ldc, const float* pdt,
                       long row0, float gamma, const float* stin, float* stout, int st_ld, float* outp, int ldo,
                       float* smem) {
  const int tid = threadIdx.x & 255, lane = tid & 63;
  const int wid = __builtin_amdgcn_readfirstlane(tid >> 6);
  const int k0 = wid * 32;
  smem += (threadIdx.x >> 8) * (VB_BYTES / 4);
  float S[32];
#pragma unroll
  for (int i = 0; i < 32; ++i) S[i] = stin[(size_t)(k0 + i) * st_ld + lane];
  float aq[4], vv[4], dAv[4];
#pragma unroll
  for (int t = 0; t < 4; ++t) {
    long row = row0 + t;
    aq[t] = (lane < 32) ? pa[(size_t)row * lda_ + k0 + lane] : pq[(size_t)row * ldq + k0 + (lane - 32)];
    vv[t] = pc[(size_t)row * ldc + lane];
    dAv[t] = gamma;
    if (MODE == 2) {
      vv[t] *= pdt[(size_t)row * 64];
      dAv[t] = pdt[(size_t)row * 64 + 1];
    }
  }
#pragma unroll
  for (int t = 0; t < 4; ++t) {
    const float val = vv[t], dA = dAv[t];
    float o = 0.f;
#pragma unroll
    for (int i = 0; i < 32; ++i) {
      const float a = rlf_(aq[t], i), q = rlf_(aq[t], 32 + i);
      if (MODE == 0) S[i] = val + a * (S[i] - val);
      else S[i] = dA * S[i] + a * val;
      o += q * S[i];
    }
    smem[(wid * 4 + t) * 64 + lane] = o;
  }
#pragma unroll
  for (int i = 0; i < 32; ++i) stout[(size_t)(k0 + i) * st_ld + lane] = S[i];
  __syncthreads();
  {
    int t = tid >> 6;
    float sum = smem[(0 * 4 + t) * 64 + lane] + smem[(1 * 4 + t) * 64 + lane] + smem[(2 * 4 + t) * 64 + lane] +
                smem[(3 * 4 + t) * 64 + lane];
    outp[(size_t)(row0 + t) * ldo + lane] = sum;
  }
  __syncthreads();
}

DEVI void rwkv_item(const float* wsf, const Seg (&sg)[6], int row0, int T, const float* stin, float* stout, float* outp, int ldo,
                    float* smem) {
  constexpr int NF4 = 84, W = 336, RG = 6;
  const int tid = threadIdx.x & 255, w = tid >> 6, lane = tid & 63, rl = lane >> 4, sl = lane & 15;
  smem += (threadIdx.x >> 8) * (VB_BYTES / 4);
  const int il = w * 4 + rl;
  float S[4];
  if (stin) {
    float4 v = *(const float4*)(stin + il * 64 + sl * 4);
    S[0] = v.x; S[1] = v.y; S[2] = v.z; S[3] = v.w;
  } else {
    S[0] = S[1] = S[2] = S[3] = 0.f;
  }
  float* buf0 = smem;
  float* buf1 = smem + 16 * 336;
  float* obuf = smem + 2 * 16 * 336;
  const int nst = (T + 15) / 16;
  f32x4 rgA[RG], rgB[RG];
  const float* sptr[RG];
  int sld[RG];
  stage_init<6, NF4, RG>(wsf, sg, row0, tid, sptr, sld);
  auto run_stage = [&](const float* b, float* ob, int nthis) {
#pragma unroll 4
    for (int tt = 0; tt < nthis; ++tt) {
      const float* sp = b + tt * W;
      float4 r4 = *(const float4*)(sp + sl * 4);
      float4 w4 = *(const float4*)(sp + 64 + sl * 4);
      float4 k4 = *(const float4*)(sp + 128 + sl * 4);
      float4 n4 = *(const float4*)(sp + 192 + sl * 4);
      float4 m4 = *(const float4*)(sp + 256 + sl * 4);
      float vi = sp[320 + il];
      float sa = S[0] * n4.x + S[1] * n4.y + S[2] * n4.z + S[3] * n4.w;
      sa = -red16(sa);
      S[0] = S[0] * w4.x + sa * m4.x + vi * k4.x;
      S[1] = S[1] * w4.y + sa * m4.y + vi * k4.y;
      S[2] = S[2] * w4.z + sa * m4.z + vi * k4.z;
      S[3] = S[3] * w4.w + sa * m4.w + vi * k4.w;
      float y = S[0] * r4.x + S[1] * r4.y + S[2] * r4.z + S[3] * r4.w;
      y = red16(y);
      ob[(sl == 0) ? (tt * 16 + il) : (1024 + (tid & 255))] = y;
    }
  };
  auto write_out = [&](const float* ob, int st, int nthis) {
    if (tid < nthis * 4) {
      int t = tid >> 2, c4 = tid & 3;
      *(float4*)(outp + (size_t)(st * 16 + t) * ldo + c4 * 4) = *(const float4*)(ob + t * 16 + c4 * 4);
    }
  };
  auto nsteps = [&](int st) { return min(16, T - st * 16); };
  stage_issue<NF4, RG>(sptr, sld, 0, nsteps(0), tid, rgA);
  stage_commit<NF4, RG>(buf0, nsteps(0), tid, rgA);
  if (nst > 1) stage_issue<NF4, RG>(sptr, sld, 1, nsteps(1), tid, rgB);
  __syncthreads();
  __builtin_amdgcn_s_setprio(3);
#pragma unroll 1
  for (int st = 0; st < nst; st += 2) {
    if (st + 2 < nst) stage_issue<NF4, RG>(sptr, sld, st + 2, nsteps(st + 2), tid, rgA);
    run_stage(buf0, obuf, nsteps(st));
    if (st + 1 < nst) stage_commit<NF4, RG>(buf1, nsteps(st + 1), tid, rgB);
    __syncthreads();
    write_out(obuf, st, nsteps(st));
    if (st + 1 < nst) {
      if (st + 3 < nst) stage_issue<NF4, RG>(sptr, sld, st + 3, nsteps(st + 3), tid, rgB);
      run_stage(buf1, obuf + 512, nsteps(st + 1));
      if (st + 2 < nst) stage_commit<NF4, RG>(buf0, nsteps(st + 2), tid, rgA);
      __syncthreads();
      write_out(obuf + 512, st + 1, nsteps(st + 1));
    }
  }
  __builtin_amdgcn_s_setprio(0);
  *(float4*)(stout + il * 64 + sl * 4) = make_float4(S[0], S[1], S[2], S[3]);
  __syncthreads();
}

DEVI void phase_rec0(const Params& p, float* smem) {
  char* ws = p.ws;
  const float* PROJ = (const float*)(ws + OFF_PROJ);
  float* OMIX = (float*)(ws + OFF_OMIX);
  const float* wsf = (const float*)ws;
  constexpr int PO = (int)(OFF_PROJ / 4);
  for (int item = blockIdx.x * 2 + (threadIdx.x >> 8); item < 4608; item += gridDim.x * 2) {
    if (item < 256) {
      int b = item >> 6, h = (item >> 3) & 7, cb = item & 7;
      Seg sg[4] = {{PO + 1024 + h * 128, N0, 32}, {PO + h * 128, N0, 32}, {PO + 2048 + h * 128 + cb * 16, N0, 4},
                   {PO, N0, 1}};
      int row0 = b * TP;
      colrec_long<0>(wsf, sg, row0, TP, 0.f, OMIX + (size_t)row0 * 2048 + h * 128 + cb * 16, 2048,
                     p.out + O_HGP + (size_t)(b * 8 + h) * 128 * 128 + cb * 16, 128, smem);
    } else if (item < 512) {
      int it = item - 256;
      int b = it >> 6, h = (it >> 4) & 3, cb = it & 15;
      Seg sg[4] = {{PO + 4608 + h * 128, N0, 32}, {PO + 4096 + h * 128, N0, 32},
                   {PO + 5120 + h * 256 + cb * 16, N0, 4}, {PO, N0, 1}};
      int row0 = b * TP;
      float gamma = 1.0f - exp2f(-5.0f - (float)h);
      colrec_long<1>(wsf, sg, row0, TP, gamma, OMIX + (size_t)row0 * 2048 + 1024 + h * 256 + cb * 16, 2048,
                     p.out + O_RTP + (size_t)(b * 4 + h) * 128 * 256 + cb * 16, 256, smem);
    } else if (item < 2560) {
      int it = item - 512;
      int b = it >> 4, h = (it >> 1) & 7, cb = it & 1;
      long row0 = MPR + (long)b * 4;
      size_t so = (size_t)(b * 8 + h) * 128 * 128 + cb * 64;
      colrec_short<0>(PROJ + 1024 + h * 128, N0, PROJ + h * 128, N0, PROJ + 2048 + h * 128 + cb * 64, N0, nullptr, row0,
                      0.f, p.in[I_SHG] + so, p.out + O_HGS + so, 128, OMIX + h * 128 + cb * 64, 2048, smem);
    } else {
      int it = item - 2560;
      int b = it >> 4, h = (it >> 2) & 3, cb = it & 3;
      long row0 = MPR + (long)b * 4;
      size_t so = (size_t)(b * 4 + h) * 128 * 256 + cb * 64;
      float gamma = 1.0f - exp2f(-5.0f - (float)h);
      colrec_short<1>(PROJ + 4608 + h * 128, N0, PROJ + 4096 + h * 128, N0, PROJ + 5120 + h * 256 + cb * 64, N0, nullptr,
                      row0, gamma, p.in[I_SRT] + so, p.out + O_RTS + so, 256, OMIX + 1024 + h * 256 + cb * 64, 2048,
                      smem);
    }
  }
}

DEVI float4 ld4(const float* p) { return *(const float4*)p; }
DEVI void st_bf4(u16* p, float a, float b, float c, float d) {
  uint2 o;
  o.x = pack2(a, b);
  o.y = pack2(c, d);
  *(uint2*)p = o;
}
DEVI float wsum_u_(float v) {
  v = red16(v);
  return (rlf_(v, 0) + rlf_(v, 16)) + (rlf_(v, 32) + rlf_(v, 48));
}
DEVI float red32(float v) {
  v = red16(v);
  return v + __shfl_xor(v, 16, 64);
}
DEVI void phase_post0(const Params& p) {
  char* ws = p.ws;
  const float* PROJ = (const float*)(ws + OFF_PROJ);
  const float* OMIX = (const float*)(ws + OFF_OMIX);
  u16* MIXB = (u16*)(ws + OFF_MIXB);
  const float* ng = p.in[I_HNG];
  const int lane = threadIdx.x & 63;
  const int gw = blockIdx.x * 8 + (threadIdx.x >> 6), nw = gridDim.x * 8;
  const float4 g4 = ld4(ng + (lane & 31) * 4);
  for (int row = gw; row < M; row += nw) {
    const float* o = OMIX + (size_t)row * 2048;
    const float* pr = PROJ + (size_t)row * N0;
    u16* mo = MIXB + (size_t)row * 2048;
    float4 a[4], ga[4], bq[4], gb[4];
#pragma unroll
    for (int it = 0; it < 4; ++it) {
      int c = it * 256 + lane * 4;
      a[it] = ld4(o + c);
      ga[it] = ld4(pr + 3072 + c);
      bq[it] = ld4(o + 1024 + c);
      gb[it] = ld4(pr + 6144 + c);
    }
#pragma unroll
    for (int it = 0; it < 4; ++it) {
      int c = it * 256 + lane * 4;
      float ss = red32(a[it].x * a[it].x + a[it].y * a[it].y + a[it].z * a[it].z + a[it].w * a[it].w);
      float inv = rsqrtf(ss * (1.0f / 128.0f) + 1e-6f);
      st_bf4(mo + c, a[it].x * inv * g4.x * ga[it].x, a[it].y * inv * g4.y * ga[it].y, a[it].z * inv * g4.z * ga[it].z,
             a[it].w * inv * g4.w * ga[it].w);
      float mu = wsum_u_(bq[it].x + bq[it].y + bq[it].z + bq[it].w) * (1.0f / 256.0f);
      float dx = bq[it].x - mu, dy = bq[it].y - mu, dz = bq[it].z - mu, dw = bq[it].w - mu;
      float var = wsum_u_(dx * dx + dy * dy + dz * dz + dw * dw) * (1.0f / 256.0f);
      float iv = rsqrtf(var + 1e-5f);
      st_bf4(mo + 1024 + c, dx * iv * gb[it].x, dy * iv * gb[it].y, dz * iv * gb[it].z, dw * iv * gb[it].w);
    }
  }
}

DEVI void phase_ln(const Params& p, const float* addsrc, const float* g, const float* bta) {
  char* ws = p.ws;
  float* XF = (float*)(ws + OFF_XF);
  u16* XB = (u16*)(ws + OFF_XB);
  const int lane = threadIdx.x & 63;
  const int gw = blockIdx.x * 8 + (threadIdx.x >> 6), nw = gridDim.x * 8;
  for (int row = gw; row < M; row += nw) {
    float4* xr = (float4*)(XF + (size_t)row * 2048);
    const float4* ar = (const float4*)(addsrc + (size_t)row * 2048);
    float v[32];
    float s = 0.f;
#pragma unroll
    for (int i = 0; i < 8; ++i) {
      float4 x = xr[i * 64 + lane], a = ar[i * 64 + lane];
      v[i * 4 + 0] = ALPHA * x.x + a.x;
      v[i * 4 + 1] = ALPHA * x.y + a.y;
      v[i * 4 + 2] = ALPHA * x.z + a.z;
      v[i * 4 + 3] = ALPHA * x.w + a.w;
      s += v[i * 4 + 0] + v[i * 4 + 1] + v[i * 4 + 2] + v[i * 4 + 3];
    }
    float mu = wsum(s) * (1.0f / 2048.0f);
    float q = 0.f;
#pragma unroll
    for (int i = 0; i < 32; ++i) {
      v[i] -= mu;
      q += v[i] * v[i];
    }
    float inv = rsqrtf(wsum(q) * (1.0f / 2048.0f) + 1e-5f);
#pragma unroll
    for (int i = 0; i < 8; ++i) {
      float4 gg = ((const float4*)g)[i * 64 + lane], bb = ((const float4*)bta)[i * 64 + lane];
      float4 y;
      y.x = v[i * 4 + 0] * inv * gg.x + bb.x;
      y.y = v[i * 4 + 1] * inv * gg.y + bb.y;
      y.z = v[i * 4 + 2] * inv * gg.z + bb.z;
      y.w = v[i * 4 + 3] * inv * gg.w + bb.w;
      xr[i * 64 + lane] = y;
      uint2 o;
      o.x = pack2(y.x, y.y);
      o.y = pack2(y.z, y.w);
      ((uint2*)(XB + (size_t)row * 2048))[i * 64 + lane] = o;
    }
  }
}

typedef __attribute__((ext_vector_type(2))) __bf16 bf2_t;
typedef __attribute__((ext_vector_type(2))) float f32x2;
DEVI float dot2bf(unsigned a, unsigned b, float acc) {
  return __builtin_amdgcn_fdot2_f32_bf16(__builtin_bit_cast(bf2_t, a), __builtin_bit_cast(bf2_t, b), acc, false);
}
template <int CTRL>
DEVI int dppi(int v) {
  return __builtin_amdgcn_update_dpp(v, v, CTRL, 0xF, 0xF, false);
}
DEVI int wmax_i(int v) {
  v = max(v, dppi<0xB1>(v));
  v = max(v, dppi<0x4E>(v));
  v = max(v, dppi<0x141>(v));
  v = max(v, dppi<0x140>(v));
  int a = __builtin_amdgcn_readlane(v, 0), b = __builtin_amdgcn_readlane(v, 16);
  int c = __builtin_amdgcn_readlane(v, 32), d = __builtin_amdgcn_readlane(v, 48);
  return max(max(a, b), max(c, d));
}
DEVI float rlf(float v, int l) { return __int_as_float(__builtin_amdgcn_readlane(__float_as_int(v), l)); }
DEVI float wsum_u(float v) {
  v = red16(v);
  return (rlf(v, 0) + rlf(v, 16)) + (rlf(v, 32) + rlf(v, 48));
}
DEVI int fkey(float f) {
  int u = __float_as_int(f);
  return u ^ ((u >> 31) & 0x7fffffff);
}
DEVI float keyf(int k) { return __int_as_float(k ^ ((k >> 31) & 0x7fffffff)); }

DEVI void conv_fp8_rows(const float* __restrict__ src, unsigned char* __restrict__ dst, float* __restrict__ scales) {
  const int lane = threadIdx.x & 63;
  const int gw = blockIdx.x * 8 + (threadIdx.x >> 6), nw = gridDim.x * 8;
  for (int e = gw; e < 16384; e += nw) {
    const float* r = src + (size_t)e * 2048;
    float4 v[8];
    float am = 0.f;
#pragma unroll
    for (int q = 0; q < 8; ++q) {
      v[q] = *(const float4*)(r + (q >> 2) * 1024 + lane * 16 + (q & 3) * 4);
      am = fmaxf(am, fmaxf(fmaxf(fabsf(v[q].x), fabsf(v[q].y)), fmaxf(fabsf(v[q].z), fabsf(v[q].w))));
    }
    float amax = __int_as_float(wmax_i(__float_as_int(am)));
    float inv = (amax > 0.f) ? (440.0f / amax) : 0.f;
    float scale = (amax > 0.f) ? (amax * (1.0f / 440.0f)) : 1.0f;
#pragma unroll
    for (int j = 0; j < 2; ++j) {
      u32x4 o;
#pragma unroll
      for (int k = 0; k < 4; ++k) {
        float4 t = v[j * 4 + k];
        int pk = 0;
        pk = __builtin_amdgcn_cvt_pk_fp8_f32(t.x * inv, t.y * inv, pk, false);
        pk = __builtin_amdgcn_cvt_pk_fp8_f32(t.z * inv, t.w * inv, pk, true);
        o[k] = (unsigned)pk;
      }
      *(u32x4*)(dst + (size_t)e * 2048 + j * 1024 + lane * 16) = o;
    }
    if (lane == 0) scales[e] = scale;
  }
}

DEVI void phase_peer(const Params& p, int layer, bool final_out) {
  char* ws = p.ws;
  const float* SC = (const float*)(ws + OFF_GOUT);
  float* XF = (float*)(ws + OFF_XF);
  u16* XB = (u16*)(ws + OFF_XB);
  const unsigned char* UB = (const unsigned char*)(ws + OFF_UB);
  const unsigned char* VB = (const unsigned char*)(ws + OFF_VB);
  const float* USC = (const float*)(ws + OFF_USC);
  const float* VSC = (const float*)(ws + OFF_VSC);
  const float* g = p.in[I_LNG] + (size_t)(layer * 2 + 1) * D;
  const float* bta = p.in[I_LNB] + (size_t)(layer * 2 + 1) * D;
  const int lane = threadIdx.x & 63;
  const int gw = blockIdx.x * 8 + (threadIdx.x >> 6), nw = gridDim.x * 8;
  constexpr int KMIN = (int)0x80000000;
  for (int row = gw; row < M; row += nw) {
    const float* sr = SC + (size_t)row * 2048;
    int eidx0 = 0, eidx1 = 0;
    float gate0 = 0.f, gate1 = 0.f;
#pragma unroll 1
    for (int hp = 0; hp < 2; ++hp) {
      int hd[4] = {hp * 2, hp * 2 + 1, hp * 2 + 4, hp * 2 + 5};
      int ka[4][2], kb[4][2], my[4][2];
#pragma unroll
      for (int n = 0; n < 4; ++n) {
        const float* sp = sr + hd[n] * 256;
#pragma unroll
        for (int c = 0; c < 2; ++c) {
          ka[n][c] = (fkey(sp[c * 128 + lane]) & ~127) | (127 - lane);
          kb[n][c] = (fkey(sp[c * 128 + 64 + lane]) & ~127) | (63 - lane);
          my[n][c] = KMIN;
        }
      }
#pragma unroll 1
      for (int r = 0; r < 16; ++r) {
#pragma unroll
        for (int n = 0; n < 4; ++n)
#pragma unroll
          for (int c = 0; c < 2; ++c) {
            int K = wmax_i(max(ka[n][c], kb[n][c]));
            my[n][c] = (lane == r) ? K : my[n][c];
            ka[n][c] = (ka[n][c] == K) ? KMIN : ka[n][c];
            kb[n][c] = (kb[n][c] == K) ? KMIN : kb[n][c];
          }
      }
      const int jb = (lane & 3) * 4;
      int cc[4][4], myk[4];
      int ti0[4], ti1[4];
#pragma unroll
      for (int n = 0; n < 4; ++n) {
        const float ts0 = keyf(my[n][0] & ~127), ts1 = keyf(my[n][1] & ~127);
        ti0[n] = 127 - (my[n][0] & 127);
        ti1[n] = 127 - (my[n][1] & 127);
        const float s0 = __shfl(ts0, lane >> 2, 64);
#pragma unroll
        for (int q = 0; q < 4; ++q) cc[n][q] = (fkey(s0 + __shfl(ts1, jb + q, 64)) & ~255) | (255 - (lane * 4 + q));
        myk[n] = KMIN;
      }
#pragma unroll 1
      for (int r = 0; r < 16; ++r) {
#pragma unroll
        for (int n = 0; n < 4; ++n) {
          int K = wmax_i(max(max(cc[n][0], cc[n][1]), max(cc[n][2], cc[n][3])));
          myk[n] = (lane == r) ? K : myk[n];
#pragma unroll
          for (int q = 0; q < 4; ++q) cc[n][q] = (cc[n][q] == K) ? KMIN : cc[n][q];
        }
      }
#pragma unroll
      for (int n = 0; n < 4; ++n) {
        const float bs = keyf(myk[n] & ~255);
        const int bf = 255 - (myk[n] & 255);
        const int e = __shfl(ti0[n], (bf >> 4) & 15, 64) * 128 + __shfl(ti1[n], bf & 15, 64);
        const float ev = (lane < 16) ? expf(bs - rlf(bs, 0)) : 0.f;
        const float gt = ev / wsum_u(ev);
        const int e_b = __shfl(e, lane & 15, 64);
        const float g_b = __shfl(gt, lane & 15, 64);
        const int hh = hp * 2 + (n & 1);
        if ((lane >> 4) == hh) {
          if (n < 2) { eidx0 = e_b; gate0 = g_b; }
          else { eidx1 = e_b; gate1 = g_b; }
        }
      }
    }
    float dv0 = 0.f, dv1 = 0.f;
    {
      float xf[32];
      {
        const float4* xr = (const float4*)(XF + (size_t)row * 2048);
#pragma unroll
        for (int q = 0; q < 8; ++q) {
          float4 t = xr[(q >> 2) * 256 + lane * 4 + (q & 3)];
          xf[q * 4 + 0] = t.x; xf[q * 4 + 1] = t.y; xf[q * 4 + 2] = t.z; xf[q * 4 + 3] = t.w;
        }
      }
      constexpr int R = 8;
      u32x4 w[R][2];
      float sc[R];
      auto load_row = [&](int pidx, u32x4(&wr)[2], float& scv) {
        int src = (pidx < 64) ? eidx0 : eidx1;
        int e = __builtin_amdgcn_readlane(src, pidx & 63);
        const u32x4* ur = (const u32x4*)(UB + (size_t)e * 2048);
        wr[0] = ur[lane];
        wr[1] = ur[64 + lane];
        scv = USC[e];
      };
#pragma unroll
      for (int u = 0; u < R; ++u) load_row(u, w[u], sc[u]);
#pragma unroll 1
      for (int p0 = 0; p0 < 128; p0 += R) {
#pragma unroll
        for (int u = 0; u < R; ++u) {
          float d = 0.f;
#pragma unroll
          for (int j = 0; j < 2; ++j) {
#pragma unroll
            for (int k = 0; k < 4; ++k) {
              int dw = (int)w[u][j][k];
              f32x2 lo = __builtin_amdgcn_cvt_pk_f32_fp8(dw, false);
              f32x2 hi = __builtin_amdgcn_cvt_pk_f32_fp8(dw, true);
              d += lo.x * xf[j * 16 + k * 4 + 0];
              d += lo.y * xf[j * 16 + k * 4 + 1];
              d += hi.x * xf[j * 16 + k * 4 + 2];
              d += hi.y * xf[j * 16 + k * 4 + 3];
            }
          }
          float scu = sc[u];
          if (p0 + R < 128) load_row(p0 + R + u, w[u], sc[u]);
          d = wsum_u(d) * scu;
          int pl = (p0 + u) & 63;
          if (p0 < 64) dv0 = (lane == pl) ? d : dv0;
          else dv1 = (lane == pl) ? d : dv1;
          __builtin_amdgcn_sched_barrier(0);
        }
      }
    }
    float coef0 = 0.5f * dv0 * (1.0f + erff(dv0 * 0.70710678118f)) * gate0;
    float coef1 = 0.5f * dv1 * (1.0f + erff(dv1 * 0.70710678118f)) * gate1;
    f32x2 o2[16];
#pragma unroll
    for (int i = 0; i < 16; ++i) o2[i] = f32x2{0.f, 0.f};
    {
      constexpr int R = 8;
      u32x4 w[R][2];
      float sc[R];
      auto load_row = [&](int pidx, u32x4(&wr)[2], float& scv) {
        int src = (pidx < 64) ? eidx0 : eidx1;
        int e = __builtin_amdgcn_readlane(src, pidx & 63);
        const u32x4* vr = (const u32x4*)(VB + (size_t)e * 2048);
        wr[0] = vr[lane];
        wr[1] = vr[64 + lane];
        scv = VSC[e];
      };
#pragma unroll
      for (int u = 0; u < R; ++u) load_row(u, w[u], sc[u]);
#pragma unroll 1
      for (int p0 = 0; p0 < 128; p0 += R) {
        float cfs = (p0 < 64) ? coef0 : coef1;
#pragma unroll
        for (int u = 0; u < R; ++u) {
          float c = rlf(cfs, (p0 + u) & 63) * sc[u];
          f32x2 cc = f32x2{c, c};
#pragma unroll
          for (int j = 0; j < 2; ++j) {
#pragma unroll
            for (int k = 0; k < 4; ++k) {
              int dw = (int)w[u][j][k];
              o2[j * 8 + k * 2 + 0] += cc * __builtin_amdgcn_cvt_pk_f32_fp8(dw, false);
              o2[j * 8 + k * 2 + 1] += cc * __builtin_amdgcn_cvt_pk_f32_fp8(dw, true);
            }
          }
          if (p0 + R < 128) load_row(p0 + R + u, w[u], sc[u]);
          __builtin_amdgcn_sched_barrier(0);
        }
      }
    }
    float o[32];
#pragma unroll
    for (int i = 0; i < 16; ++i) {
      o[2 * i] = o2[i].x;
      o[2 * i + 1] = o2[i].y;
    }
    float s = 0.f;
    {
      const float4* xr = (const float4*)(XF + (size_t)row * 2048);
#pragma unroll
      for (int q = 0; q < 8; ++q) {
        float4 t = xr[(q >> 2) * 256 + lane * 4 + (q & 3)];
        o[q * 4 + 0] += ALPHA * t.x; o[q * 4 + 1] += ALPHA * t.y; o[q * 4 + 2] += ALPHA * t.z; o[q * 4 + 3] += ALPHA * t.w;
      }
#pragma unroll
      for (int i = 0; i < 32; ++i) s += o[i];
    }
    float mu = wsum_u(s) * (1.0f / 2048.0f);
    float q = 0.f;
#pragma unroll
    for (int i = 0; i < 32; ++i) {
      o[i] -= mu;
      q += o[i] * o[i];
    }
    float inv = rsqrtf(wsum_u(q) * (1.0f / 2048.0f) + 1e-5f);
    float* dstf;
    if (final_out) {
      if (row < MPR) {
        int b = row / TP, t = row % TP;
        dstf = (t >= 16) ? (p.out + O_YP + ((size_t)b * 2048 + (t - 16)) * D) : nullptr;
      } else {
        dstf = p.out + O_YS + (size_t)(row - MPR) * D;
      }
    } else {
      dstf = XF + (size_t)row * 2048;
    }
#pragma unroll
    for (int j = 0; j < 2; ++j) {
      float yv[16];
#pragma unroll
      for (int k = 0; k < 4; ++k) {
        float4 gv = *(const float4*)(g + j * 1024 + lane * 16 + k * 4);
        float4 bv = *(const float4*)(bta + j * 1024 + lane * 16 + k * 4);
        float4 y;
        y.x = o[j * 16 + k * 4 + 0] * inv * gv.x + bv.x;
        y.y = o[j * 16 + k * 4 + 1] * inv * gv.y + bv.y;
        y.z = o[j * 16 + k * 4 + 2] * inv * gv.z + bv.z;
        y.w = o[j * 16 + k * 4 + 3] * inv * gv.w + bv.w;
        if (dstf) *(float4*)(dstf + j * 1024 + lane * 16 + k * 4) = y;
        yv[k * 4 + 0] = y.x; yv[k * 4 + 1] = y.y; yv[k * 4 + 2] = y.z; yv[k * 4 + 3] = y.w;
      }
      if (!final_out) {
        uint4* xb = (uint4*)(XB + (size_t)row * 2048 + j * 1024 + lane * 16);
        xb[0] = make_uint4(pack2(yv[0], yv[1]), pack2(yv[2], yv[3]), pack2(yv[4], yv[5]), pack2(yv[6], yv[7]));
        xb[1] = make_uint4(pack2(yv[8], yv[9]), pack2(yv[10], yv[11]), pack2(yv[12], yv[13]), pack2(yv[14], yv[15]));
      }
    }
  }
}

DEVI float4 f4mul(float4 a, float4 b) { return make_float4(a.x * b.x, a.y * b.y, a.z * b.z, a.w * b.w); }
DEVI void row_info(int row, bool& prompt, int& b, int& t, int& T) {
  prompt = row < MPR;
  if (prompt) { b = row / TP; t = row - b * TP; T = TP; }
  else { b = (row - MPR) >> 2; t = (row - MPR) & 3; T = 4; }
}
DEVI void phase_pre1(const Params& p) {
  char* ws = p.ws;
  const float* PROJ = (const float*)(ws + OFF_PROJ);
  float* XC = (float*)(ws + OFF_GOUT);
  float* RKV = (float*)(ws + OFF_RKV);
  u16* LRA = (u16*)(ws + OFF_LRA);
  u16* LRB = (u16*)(ws + OFF_LRB);
  u16* LRG = (u16*)(ws + OFF_LRG);
  const float* cw = p.in[I_CVW];
  const float* cbias = p.in[I_CVB];
  const float* mu = p.in[I_MU];
  const int gtid = blockIdx.x * 512 + threadIdx.x, nthr = gridDim.x * 512;
#pragma unroll 2
  for (int idx = gtid; idx < M * 384; idx += nthr) {
    int row = idx / 384, c = (idx - row * 384) * 4;
    bool prompt; int b, t, T;
    row_info(row, prompt, b, t, T);
    float4 xv[4];
#pragma unroll
    for (int jj = 0; jj < 4; ++jj) {
      int tt = t - 3 + jj;
      if (tt >= 0) xv[jj] = ld4(PROJ + (size_t)(row - 3 + jj) * N1 + 1024 + c);
      else if (prompt) xv[jj] = make_float4(0.f, 0.f, 0.f, 0.f);
      else xv[jj] = ld4(p.in[I_SCV] + (size_t)(b * 3 + (tt + 3)) * 1536 + c);
    }
    float4 acc = ld4(cbias + c);
#pragma unroll
    for (int jj = 0; jj < 4; ++jj) {
      float4 w = ld4(cw + jj * 1536 + c);
      acc.x += xv[jj].x * w.x; acc.y += xv[jj].y * w.y; acc.z += xv[jj].z * w.z; acc.w += xv[jj].w * w.w;
    }
    *(float4*)(XC + (size_t)row * 1536 + c) = make_float4(siluf_(acc.x), siluf_(acc.y), siluf_(acc.z), siluf_(acc.w));
    if (t >= T - 3) {
      float* co = prompt ? (p.out + O_CVP) : (p.out + O_CVS);
      *(float4*)(co + (size_t)(b * 3 + (t - (T - 3))) * 1536 + c) = xv[3];
    }
  }
#pragma unroll 2
  for (int idx = gtid; idx < M * 840; idx += nthr) {
    int row = idx / 840, c = (idx - row * 840) * 4;
    bool prompt; int b, t, T;
    row_info(row, prompt, b, t, T);
    float4 cur = ld4(PROJ + (size_t)row * N1 + 2560 + c);
    float4 prev;
    if (t > 0) prev = ld4(PROJ + (size_t)(row - 1) * N1 + 2560 + c);
    else if (prompt) prev = make_float4(0.f, 0.f, 0.f, 0.f);
    else prev = ld4(p.in[I_SSH] + (size_t)b * 3360 + c);
    float4 m4 = ld4(mu + c);
    float4 mx;
    mx.x = cur.x + (prev.x - cur.x) * m4.x; mx.y = cur.y + (prev.y - cur.y) * m4.y;
    mx.z = cur.z + (prev.z - cur.z) * m4.z; mx.w = cur.w + (prev.w - cur.w) * m4.w;
    if (c < 3072) *(float4*)(RKV + (size_t)row * 3072 + c) = mx;
    else if (c < 3136) st_bf4(LRA + (size_t)row * 64 + (c - 3072), tanhf(mx.x), tanhf(mx.y), tanhf(mx.z), tanhf(mx.w));
    else if (c < 3200) st_bf4(LRB + (size_t)row * 64 + (c - 3136), mx.x, mx.y, mx.z, mx.w);
    else st_bf4(LRG + (size_t)row * 192 + (c - 3200), sigmoidf_(mx.x), sigmoidf_(mx.y), sigmoidf_(mx.z), sigmoidf_(mx.w));
    if (t == T - 1) {
      float* so = prompt ? (p.out + O_SHP) : (p.out + O_SHS);
      *(float4*)(so + (size_t)b * 3360 + c) = cur;
    }
  }
  for (int idx = gtid; idx < M * 4; idx += nthr) {
    int row = idx >> 2, k = idx & 3;
    ((uint4*)(LRG + (size_t)row * 192 + 160))[k] = make_uint4(0, 0, 0, 0);
  }
}

DEVI void phase_pre1c(const Params& p) {
  char* ws = p.ws;
  float* RKV = (float*)(ws + OFF_RKV);
  const float* AA = (const float*)(ws + OFF_AA);
  float* KK = (float*)(ws + OFF_QB);
  float* KKA = (float*)(ws + OFF_MIXB);
  float* BON = (float*)(ws + OFF_BON);
  const float* k_k = p.in[I_KK];
  const float* k_a = p.in[I_KA];
  const float* r_k = p.in[I_RK];
  const int lane = threadIdx.x & 63;
  const int gw = blockIdx.x * 8 + (threadIdx.x >> 6), nw = gridDim.x * 8;
  for (int row = gw; row < M; row += nw) {
    float4 k4[4], r4[4], a4[4];
#pragma unroll
    for (int it = 0; it < 4; ++it) {
      int c = it * 256 + lane * 4;
      k4[it] = ld4(RKV + (size_t)row * 3072 + 1024 + c);
      r4[it] = ld4(RKV + (size_t)row * 3072 + c);
      a4[it] = ld4(AA + (size_t)row * 1024 + c);
    }
#pragma unroll
    for (int it = 0; it < 4; ++it) {
      int c = it * 256 + lane * 4;
      float4 kk4 = ld4(k_k + c), ka4 = ld4(k_a + c), rk4 = ld4(r_k + c);
      float4 k = k4[it], r = r4[it], a = a4[it];
      float4 kr = f4mul(k, kk4);
      float ss = red16(kr.x * kr.x + kr.y * kr.y + kr.z * kr.z + kr.w * kr.w);
      float inv = 1.0f / fmaxf(sqrtf(ss), 1e-12f);
      float4 kk = make_float4(kr.x * inv, kr.y * inv, kr.z * inv, kr.w * inv);
      float4 kp;
      kp.x = k.x * (1.0f + (a.x - 1.0f) * ka4.x); kp.y = k.y * (1.0f + (a.y - 1.0f) * ka4.y);
      kp.z = k.z * (1.0f + (a.z - 1.0f) * ka4.z); kp.w = k.w * (1.0f + (a.w - 1.0f) * ka4.w);
      float bon = red16(r.x * kp.x * rk4.x + r.y * kp.y * rk4.y + r.z * kp.z * rk4.z + r.w * kp.w * rk4.w);
      *(float4*)(KK + (size_t)row * 1024 + c) = kk;
      *(float4*)(KKA + (size_t)row * 1024 + c) = f4mul(kk, a);
      *(float4*)(RKV + (size_t)row * 3072 + 1024 + c) = kp;
      if ((lane & 15) == 0) BON[(size_t)row * 16 + it * 4 + (lane >> 4)] = bon;
    }
  }
}

DEVI void rwkv_short(const float* __restrict__ RKV, const float* __restrict__ DEC, const float* __restrict__ KK,
                     const float* __restrict__ KKA, int h, int rb, int row0, const float* __restrict__ stin,
                     float* __restrict__ stout, float* __restrict__ outp) {
  const int tid = threadIdx.x & 255, w = tid >> 6, lane = tid & 63, rl = lane >> 4, sl = lane & 15;
  const int il = w * 4 + rl;
  float4 sv = *(const float4*)(stin + il * 64 + sl * 4);
  float S[4] = {sv.x, sv.y, sv.z, sv.w};
  float4 r4[4], w4[4], k4[4], n4[4], m4[4];
  float vi[4];
#pragma unroll
  for (int t = 0; t < 4; ++t) {
    const size_t row = (size_t)(row0 + t);
    r4[t] = *(const float4*)(RKV + row * 3072 + h * 64 + sl * 4);
    w4[t] = *(const float4*)(DEC + row * 1024 + h * 64 + sl * 4);
    k4[t] = *(const float4*)(RKV + row * 3072 + 1024 + h * 64 + sl * 4);
    n4[t] = *(const float4*)(KK + row * 1024 + h * 64 + sl * 4);
    m4[t] = *(const float4*)(KKA + row * 1024 + h * 64 + sl * 4);
    vi[t] = RKV[row * 3072 + 2048 + h * 64 + rb * 16 + il];
  }
#pragma unroll
  for (int t = 0; t < 4; ++t) {
    float sa = S[0] * n4[t].x + S[1] * n4[t].y + S[2] * n4[t].z + S[3] * n4[t].w;
    sa = -red16(sa);
    S[0] = S[0] * w4[t].x + sa * m4[t].x + vi[t] * k4[t].x;
    S[1] = S[1] * w4[t].y + sa * m4[t].y + vi[t] * k4[t].y;
    S[2] = S[2] * w4[t].z + sa * m4[t].z + vi[t] * k4[t].z;
    S[3] = S[3] * w4[t].w + sa * m4[t].w + vi[t] * k4[t].w;
    float y = S[0] * r4[t].x + S[1] * r4[t].y + S[2] * r4[t].z + S[3] * r4[t].w;
    y = red16(y);
    if (sl == 0) outp[(size_t)t * 2048 + il] = y;
  }
  *(float4*)(stout + il * 64 + sl * 4) = make_float4(S[0], S[1], S[2], S[3]);
}

DEVI void phase_rec1(const Params& p, float* smem) {
  char* ws = p.ws;
  const float* XC = (const float*)(ws + OFF_GOUT);
  const float* RKV = (const float*)(ws + OFF_RKV);
  const float* DEC = (const float*)(ws + OFF_DEC);
  const float* KK = (const float*)(ws + OFF_QB);
  const float* KKA = (const float*)(ws + OFF_MIXB);
  const float* DTA = (const float*)(ws + OFF_DTA);
  float* OMIX = (float*)(ws + OFF_OMIX);
  const float* wsf = (const float*)ws;
  constexpr int XO = (int)(OFF_GOUT / 4), DO = (int)(OFF_DTA / 4), RO = (int)(OFF_RKV / 4), CO = (int)(OFF_DEC / 4),
                KO = (int)(OFF_QB / 4), AO = (int)(OFF_MIXB / 4);
  const int half = threadIdx.x >> 8;
  for (int li = blockIdx.x; li < 256; li += gridDim.x) {
    if (half == 0) {
      int b = li >> 6, h = (li >> 2) & 15, cb = li & 3;
      int g = h >> 3;
      Seg sg[4] = {{XO + 1024 + g * 128, 1536, 32}, {XO + 1280 + g * 128, 1536, 32}, {XO + h * 64 + cb * 16, 1536, 4},
                   {DO + h * 4, 64, 1}};
      int row0 = b * TP;
      colrec_long<2>(wsf, sg, row0, TP, 0.f, OMIX + (size_t)row0 * 2048 + h * 64 + cb * 16, 2048,
                     p.out + O_SSP + (size_t)(b * 16 + h) * 128 * 64 + cb * 16, 64, smem);
    } else {
      int b = li >> 6, h = (li >> 2) & 15, rb = li & 3;
      int row0 = b * TP;
      Seg sg[6] = {{RO + h * 64, 3072, 16}, {CO + h * 64, 1024, 16}, {RO + 1024 + h * 64, 3072, 16},
                   {KO + h * 64, 1024, 16}, {AO + h * 64, 1024, 16}, {RO + 2048 + h * 64 + rb * 16, 3072, 4}};
      size_t so = ((size_t)(b * 16 + h) * 64 + rb * 16) * 64;
      rwkv_item(wsf, sg, row0, TP, nullptr, p.out + O_WKP + so, OMIX + (size_t)row0 * 2048 + 1024 + h * 64 + rb * 16, 2048, smem);
    }
  }
  for (int it = blockIdx.x * 2 + half; it < 2048; it += gridDim.x * 2) {
    int b = it >> 4, h = it & 15;
    int g = h >> 3;
    long row0 = MPR + (long)b * 4;
    size_t so = (size_t)(b * 16 + h) * 128 * 64;
    colrec_short<2>(XC + 1024 + g * 128, 1536, XC + 1280 + g * 128, 1536, XC + h * 64, 1536, DTA + h * 4, row0, 0.f,
                    p.in[I_SSM] + so, p.out + O_SSS + so, 64, OMIX + h * 64, 2048, smem);
  }
  for (int it = blockIdx.x * 2 + half; it < 8192; it += gridDim.x * 2) {
    int b = it >> 6, h = (it >> 2) & 15, rb = it & 3;
    int row0 = MPR + b * 4;
    size_t so = ((size_t)(b * 16 + h) * 64 + rb * 16) * 64;
    rwkv_short(RKV, DEC, KK, KKA, h, rb, row0, p.in[I_SWK] + so, p.out + O_WKS + so,
               OMIX + (size_t)row0 * 2048 + 1024 + h * 64 + rb * 16);
  }
}

DEVI void phase_post1(const Params& p) {
  char* ws = p.ws;
  const float* PROJ = (const float*)(ws + OFF_PROJ);
  const float* OMIX = (const float*)(ws + OFF_OMIX);
  const float* XC = (const float*)(ws + OFF_GOUT);
  const float* RKV = (const float*)(ws + OFF_RKV);
  const float* GG = (const float*)(ws + OFF_GG);
  const float* BON = (const float*)(ws + OFF_BON);
  u16* MIXB = (u16*)(ws + OFF_MIXB);
  const float* dsk = p.in[I_DSK];
  const float* sng = p.in[I_SNG];
  const float* lxg = p.in[I_LXG];
  const float* lxb = p.in[I_LXB];
  const int lane = threadIdx.x & 63;
  const int gw = blockIdx.x * 8 + (threadIdx.x >> 6), nw = gridDim.x * 8;
  for (int row = gw; row < M; row += nw) {
    const float* o = OMIX + (size_t)row * 2048;
    u16* mo = MIXB + (size_t)row * 2048;
    float4 oc[4], xc[4], z[4], y[4], v[4], gg[4];
    float bn[4];
#pragma unroll
    for (int it = 0; it < 4; ++it) {
      int c = it * 256 + lane * 4;
      oc[it] = ld4(o + c);
      xc[it] = ld4(XC + (size_t)row * 1536 + c);
      z[it] = ld4(PROJ + (size_t)row * N1 + c);
      y[it] = ld4(o + 1024 + c);
      v[it] = ld4(RKV + (size_t)row * 3072 + 2048 + c);
      gg[it] = ld4(GG + (size_t)row * 1024 + c);
      bn[it] = BON[(size_t)row * 16 + it * 4 + (lane >> 4)];
    }
    float4 val[4];
    float ssq[4];
#pragma unroll
    for (int it = 0; it < 4; ++it) {
      float ds = dsk[it * 4 + (lane >> 4)];
      val[it].x = (oc[it].x + xc[it].x * ds) * z[it].x;
      val[it].y = (oc[it].y + xc[it].y * ds) * z[it].y;
      val[it].z = (oc[it].z + xc[it].z * ds) * z[it].z;
      val[it].w = (oc[it].w + xc[it].w * ds) * z[it].w;
      ssq[it] = val[it].x * val[it].x + val[it].y * val[it].y + val[it].z * val[it].z + val[it].w * val[it].w;
    }
    float inv0 = rsqrtf(wsum_u_(ssq[0] + ssq[1]) * (1.0f / 512.0f) + 1e-6f);
    float inv1 = rsqrtf(wsum_u_(ssq[2] + ssq[3]) * (1.0f / 512.0f) + 1e-6f);
#pragma unroll
    for (int it = 0; it < 4; ++it) {
      int c = it * 256 + lane * 4;
      float inv = (it < 2) ? inv0 : inv1;
      float4 sg = ld4(sng + c);
      st_bf4(mo + c, val[it].x * inv * sg.x, val[it].y * inv * sg.y, val[it].z * inv * sg.z, val[it].w * inv * sg.w);
      float mu = red16(y[it].x + y[it].y + y[it].z + y[it].w) * (1.0f / 64.0f);
      float dx = y[it].x - mu, dy = y[it].y - mu, dz = y[it].z - mu, dw = y[it].w - mu;
      float var = red16(dx * dx + dy * dy + dz * dz + dw * dw) * (1.0f / 64.0f);
      float iv = rsqrtf(var + 64e-5f);
      float4 lg = ld4(lxg + c), lb = ld4(lxb + c);
      float y0 = (dx * iv * lg.x + lb.x + bn[it] * v[it].x) * gg[it].x;
      float y1 = (dy * iv * lg.y + lb.y + bn[it] * v[it].y) * gg[it].y;
      float y2 = (dz * iv * lg.z + lb.z + bn[it] * v[it].z) * gg[it].z;
      float y3 = (dw * iv * lg.w + lb.w + bn[it] * v[it].w) * gg[it].w;
      st_bf4(mo + 1024 + c, y0, y1, y2, y3);
    }
  }
}

#define XB_TMO      128
#define XB_XCNT(j)  (256  + 64 * (j))
#define XB_XSUB(j)  (1280 + 64 * (j))
#define XB_XGEN(j)  (2304 + 64 * (j))
#define XB_TOP      3328
#define XB_TOPGEN   3392
#define XCD_BAR_WORDS 3456
#define XB_SPIN_CAP (1u << 18)
#define LAS __attribute__((address_space(3)))

__device__ __forceinline__ unsigned xb_ld(unsigned* p)              { return __hip_atomic_load(p, __ATOMIC_RELAXED, __HIP_MEMORY_SCOPE_AGENT); }
__device__ __forceinline__ unsigned xb_add(unsigned* p, unsigned v) { return __hip_atomic_fetch_add(p, v, __ATOMIC_RELAXED, __HIP_MEMORY_SCOPE_AGENT); }
__device__ __forceinline__ unsigned xb_xcc_id() { return (unsigned)__builtin_amdgcn_s_getreg((3 << 11) | 20) & 0xFu; }
#define XB_SPIN(cond, bar) do { unsigned _sp = 0; while (cond) { __builtin_amdgcn_s_sleep(1); \
    if ((++_sp & 255u) == 0u) { if (xb_ld(&(bar)[XB_TMO])) break; if (_sp > XB_SPIN_CAP) { atomicAdd(&(bar)[XB_TMO], 1u); break; } } } } while (0)

struct XcdBarrier {
    unsigned* bar; unsigned x;
    volatile LAS unsigned* st;
};

__device__ __forceinline__ XcdBarrier xcd_barrier_post(unsigned* bar, volatile LAS unsigned* st) {
    XcdBarrier b; b.bar = bar; b.x = xb_xcc_id(); b.st = st;
    if (threadIdx.x == 0) (void)xb_add(&bar[XB_XCNT(b.x)], 1u);
    return b;
}
__device__ __forceinline__ void xcd_barrier_complete(unsigned* bar, unsigned x, unsigned& nloc, unsigned& nx) {
    const unsigned G = gridDim.x * gridDim.y * gridDim.z;
    unsigned sum, cnt, mine, sp = 0u;
    for (;;) {
        sum = 0u; cnt = 0u; mine = 0u;
#pragma unroll
        for (unsigned j = 0; j < 16; ++j) { const unsigned c = xb_ld(&bar[XB_XCNT(j)]); sum += c; cnt += (c > 0u) ? 1u : 0u; mine = (j == x) ? c : mine; }
        if (sum == G) break;
        __builtin_amdgcn_s_sleep(1);
        if ((++sp & 255u) == 0u) { if (xb_ld(&bar[XB_TMO])) break; if (sp > XB_SPIN_CAP) { atomicAdd(&bar[XB_TMO], 1u); break; } }
    }
    nloc = mine > 0u ? mine : 1u; nx = cnt > 0u ? cnt : 1u;
}

__device__ __forceinline__ void xcd_barrier(const XcdBarrier& b) {
    asm volatile("s_waitcnt vmcnt(0)" ::: "memory");
    __syncthreads();
    if (threadIdx.x == 0) {
        unsigned* bar = b.bar;
        __builtin_amdgcn_s_waitcnt(0);
        unsigned nloc = b.st[0], nx = b.st[1];
        if (nloc == 0u) { xcd_barrier_complete(bar, b.x, nloc, nx); b.st[0] = nloc; b.st[1] = nx; }
        const unsigned old = xb_add(&bar[XB_XSUB(b.x)], 1u);
        const unsigned gen = old / nloc;
        if (old + 1u == (gen + 1u) * nloc) {
            __builtin_amdgcn_fence(__ATOMIC_RELEASE, "agent");
            asm volatile("s_waitcnt vmcnt(0)" ::: "memory");
            const unsigned og = xb_add(&bar[XB_TOP], 1u);
            const unsigned tg = og / nx;
            if (og + 1u == (tg + 1u) * nx) xb_add(&bar[XB_TOPGEN], 1u);
            else XB_SPIN(xb_ld(&bar[XB_TOPGEN]) == tg, bar);
            __builtin_amdgcn_fence(__ATOMIC_ACQUIRE, "agent");
            xb_add(&bar[XB_XGEN(b.x)], 1u);
            asm volatile("s_waitcnt vmcnt(0)" ::: "memory");
        } else {
            XB_SPIN(xb_ld(&bar[XB_XGEN(b.x)]) == gen, bar);
            __builtin_amdgcn_fence(__ATOMIC_ACQUIRE, "agent");
            asm volatile("s_waitcnt vmcnt(0)" ::: "memory");
        }
    }
    __syncthreads();
}


template <int ph>
DEVI void run_phase(const Params& p, char* smem_raw) {
  float* smem = (float*)smem_raw;
  char* ws = p.ws;
  {
    switch (ph) {
      case 0:
        phase0(p, smem);
        conv_fp8_rows(p.in[I_PU], (unsigned char*)(ws + OFF_UB), (float*)(ws + OFF_USC));
        conv_fp8_rows(p.in[I_PV], (unsigned char*)(ws + OFF_VB), (float*)(ws + OFF_VSC));
        break;
      case 1: {
        EpiIn0 E{(float*)(ws + OFF_PROJ), (const float*)(ws + OFF_LB), (const float*)(ws + OFF_INVREV)};
        pg8::Gemm g{(const pg8::bf16_t*)(ws + OFF_XB), (const pg8::bf16_t*)(ws + OFF_WIN0), MP, N0, 2048};
        pg8::StaticOrder S;
        S.init(MP, N0, (int)gridDim.x, (int)blockIdx.x);
        pg8::gemm_phase<EpiIn0, pg8::StaticOrder, false>((PG8_LAS unsigned char*)smem_raw, g, S, E, nullptr);
      } break;
      case 2: phase_rec0(p, smem); break;
      case 3: phase_post0(p); break;
      case 4: case 15: {
        EpiStoreF32 E{(float*)(ws + OFF_GOUT)};
        pg8::Gemm g{(const pg8::bf16_t*)(ws + OFF_MIXB), (const pg8::bf16_t*)(ws + (ph == 4 ? OFF_WOUT0 : OFF_WOUT1)), MP, 2048, 2048};
        pg8::StaticOrder S;
        S.init(MP, 2048, (int)gridDim.x, (int)blockIdx.x);
        pg8::gemm_phase<EpiStoreF32, pg8::StaticOrder, false>((PG8_LAS unsigned char*)smem_raw, g, S, E, nullptr);
      } break;
      case 5: case 16: {
        int l = (ph == 5) ? 0 : 1;
        phase_ln(p, (const float*)(ws + OFF_GOUT), p.in[I_LNG] + (size_t)(l * 2) * D, p.in[I_LNB] + (size_t)(l * 2) * D);
      } break;
      case 6: case 17: {
        EpiStoreBf16 E{(u16*)(ws + OFF_QB)};
        pg8::Gemm g{(const pg8::bf16_t*)(ws + OFF_XB), (const pg8::bf16_t*)(ws + (ph == 6 ? OFF_WQ0 : OFF_WQ1)), MP, 2048, 2048};
        pg8::StaticOrder S;
        S.init(MP, 2048, (int)gridDim.x, (int)blockIdx.x);
        pg8::gemm_phase<EpiStoreBf16, pg8::StaticOrder, false>((PG8_LAS unsigned char*)smem_raw, g, S, E, nullptr);
      } break;
      case 7: case 18: {
        float* SC = (float*)(ws + OFF_GOUT);
        gemm_phase((const u16*)(ws + OFF_QB), 2048, 128, (const u16*)(ws + (ph == 7 ? OFF_KEY0 : OFF_KEY1)), 128,
                   69, 16, smem_raw, [=](int row, int col, float v0, float v1) {
                     SC[(size_t)row * 2048 + col] = v0;
                     SC[(size_t)row * 2048 + col + 32] = v1;
                   });
      } break;
      case 8: phase_peer(p, 0, false); break;
      case 9: {
        conv_fp8_rows(p.in[I_PU] + (size_t)16384 * 2048, (unsigned char*)(ws + OFF_UB), (float*)(ws + OFF_USC));
        conv_fp8_rows(p.in[I_PV] + (size_t)16384 * 2048, (unsigned char*)(ws + OFF_VB), (float*)(ws + OFF_VSC));
        EpiIn1 E{(float*)(ws + OFF_PROJ), (float*)(ws + OFF_DTA), p.in[I_DTB], p.in[I_ALOG]};
        pg8::Gemm g{(const pg8::bf16_t*)(ws + OFF_XB), (const pg8::bf16_t*)(ws + OFF_WIN1), MP, N1, 2048};
        pg8::StaticOrder S;
        S.init(MP, N1, (int)gridDim.x, (int)blockIdx.x);
        pg8::gemm_phase<EpiIn1, pg8::StaticOrder, false>((PG8_LAS unsigned char*)smem_raw, g, S, E, nullptr);
      } break;
      case 10: phase_pre1(p); break;
      case 11: {
        float* DEC = (float*)(ws + OFF_DEC);
        float* AA = (float*)(ws + OFF_AA);
        float* GG = (float*)(ws + OFF_GG);
        const float* w0 = p.in[I_W0];
        const float* a0 = p.in[I_A0];
        gemm_phase((const u16*)(ws + OFF_LRA), 64, 0, (const u16*)(ws + OFF_W2T), 64, 69, 8, smem_raw,
                   [=](int row, int col, float v0, float v1) {
#pragma unroll
                     for (int e = 0; e < 2; ++e) {
                       int cc = col + e * 32;
                       float v = (e ? v1 : v0);
                       float ew = 0.60653065971f * sigmoidf_(v);
                       DEC[(size_t)row * 1024 + cc] = __builtin_amdgcn_exp2f(-1.44269504089f * ew);
                     }
                   }, w0);
        gemm_phase((const u16*)(ws + OFF_LRB), 64, 0, (const u16*)(ws + OFF_A2T), 64, 69, 8, smem_raw,
                   [=](int row, int col, float v0, float v1) {
                     AA[(size_t)row * 1024 + col] = sigmoidf_(v0);
                     AA[(size_t)row * 1024 + col + 32] = sigmoidf_(v1);
                   }, a0);
        gemm_phase((const u16*)(ws + OFF_LRG), 192, 0, (const u16*)(ws + OFF_G2T), 192, 69, 8, smem_raw,
                   [=](int row, int col, float v0, float v1) {
                     GG[(size_t)row * 1024 + col] = v0;
                     GG[(size_t)row * 1024 + col + 32] = v1;
                   });
      } break;
      case 12: phase_pre1c(p); break;
      case 13: phase_rec1(p, smem); break;
      case 14: phase_post1(p); break;
      case 19: phase_peer(p, 1, true); break;
      default: break;
    }
  }
}

__global__ void __launch_bounds__(512, 2) mega(Params p, int ph_lo, int ph_hi) {
  __shared__ __attribute__((aligned(16))) char smem_raw[SMEM_BYTES];
  __shared__ uint4 xb_words;
  cg::grid_group grid = cg::this_grid();
  if (threadIdx.x == 0) xb_words = make_uint4(0u, 0u, 0u, 0u);
  __syncthreads();
  XcdBarrier xb = xcd_barrier_post((unsigned*)(p.ws + OFF_BAR), (volatile LAS unsigned*)&xb_words);
  if (ph_hi > 1000) grid.sync();
#ifndef REPEAT_MASK
#define REPEAT_MASK 0
#endif
#define PHASE(K)                                          \
  if (ph_lo <= K && K < ph_hi) run_phase<K>(p, smem_raw); \
  if ((REPEAT_MASK >> K) & 1) { xcd_barrier(xb); run_phase<K>(p, smem_raw); } \
  if (ph_lo <= K && K + 1 < ph_hi) xcd_barrier(xb);
  PHASE(0) PHASE(1) PHASE(2) PHASE(3) PHASE(4) PHASE(5) PHASE(6) PHASE(7) PHASE(8) PHASE(9)
  PHASE(10) PHASE(11) PHASE(12) PHASE(13) PHASE(14) PHASE(15) PHASE(16) PHASE(17) PHASE(18) PHASE(19)
}
#ifdef PHASE_TEST
template <int PH>
__global__ void __launch_bounds__(512, 2) phk(Params p) {
  __shared__ __attribute__((aligned(16))) char smem_raw[SMEM_BYTES];
  run_phase<PH>(p, smem_raw);
}
#define INST(N) template __global__ void phk<N>(Params);
INST(0) INST(1) INST(2) INST(3) INST(4) INST(5) INST(6) INST(7) INST(8) INST(9) INST(10) INST(11) INST(12) INST(13) INST(14) INST(19)
#endif

constexpr int NPHASE = 20;

extern "C" void kernel_launch(void* const* d_in, const int* in_sizes, int n_in, void* d_out, int out_size, void* d_ws,
                              size_t ws_size, hipStream_t stream) {
  static int grid_blocks = 0;
  if (!grid_blocks) {
    int dev = 0, cus = 0, per_cu = 0;
    hipGetDevice(&dev);
    hipDeviceGetAttribute(&cus, hipDeviceAttributeMultiprocessorCount, dev);
    hipOccupancyMaxActiveBlocksPerMultiprocessor(&per_cu, mega, 512, 0);
    if (per_cu > 1) per_cu = 1;
    if (per_cu < 1) per_cu = 1;
    grid_blocks = cus * per_cu;
  }
  Params p{};
  for (int i = 0; i < 38; ++i) p.in[i] = (const float*)d_in[i];
  p.out = (float*)d_out;
  p.ws = (char*)d_ws;
  (void)hipMemsetAsync((char*)d_ws + OFF_BAR, 0, 3456 * 4, stream);
  int lo = 0, hi = NPHASE;
  void* args[] = {&p, &lo, &hi};
  hipError_t e = hipLaunchCooperativeKernel((void*)mega, dim3(grid_blocks), dim3(512), args, 0, stream);
  if (e != hipSuccess) fprintf(stderr, "cooperative launch failed: %s (grid %d)\n", hipGetErrorString(e), grid_blocks);
}
```

```cpp
#include <hip/hip_runtime.h>
#include <hip/hip_bf16.h>
#include <hip/hip_cooperative_groups.h>
#include <cstdio>
#include <cmath>
namespace cg = cooperative_groups;

#define DEVI __device__ __forceinline__
typedef unsigned short u16;
using bf16x8 = __attribute__((ext_vector_type(8))) short;
using f32x4 = __attribute__((ext_vector_type(4))) float;
using u32x4 = __attribute__((ext_vector_type(4))) unsigned int;

constexpr int D = 2048;
constexpr int TP = 2064;
constexpr int MPR = 8256;
constexpr int M = 8768;
constexpr int MP = 8960;
constexpr int N0 = 7168;
constexpr int N1 = 6144;
constexpr float ALPHA = 1.41421356237f;

constexpr size_t SZ_TAB = (size_t)16384 * 2048 * 2;
constexpr size_t OFF_UB = 0;
constexpr size_t OFF_VB = OFF_UB + SZ_TAB;
constexpr size_t OFF_WIN0 = OFF_VB + SZ_TAB;
constexpr size_t OFF_WOUT0 = OFF_WIN0 + (size_t)N0 * 2048 * 2;
constexpr size_t OFF_WQ0 = OFF_WOUT0 + (size_t)2048 * 2048 * 2;
constexpr size_t OFF_KEY0 = OFF_WQ0 + (size_t)2048 * 2048 * 2;
constexpr size_t OFF_WIN1 = OFF_KEY0 + (size_t)16 * 128 * 128 * 2;
constexpr size_t OFF_WOUT1 = OFF_WIN1 + (size_t)N1 * 2048 * 2;
constexpr size_t OFF_WQ1 = OFF_WOUT1 + (size_t)2048 * 2048 * 2;
constexpr size_t OFF_KEY1 = OFF_WQ1 + (size_t)2048 * 2048 * 2;
constexpr size_t OFF_W2T = OFF_KEY1 + (size_t)16 * 128 * 128 * 2;
constexpr size_t OFF_A2T = OFF_W2T + (size_t)1024 * 64 * 2;
constexpr size_t OFF_G2T = OFF_A2T + (size_t)1024 * 64 * 2;
constexpr size_t OFF_LB = OFF_G2T + (size_t)1024 * 192 * 2;
constexpr size_t OFF_INVREV = OFF_LB + 1024 * 4;
constexpr size_t OFF_XF = OFF_INVREV + 64 * 8;
constexpr size_t OFF_XB = OFF_XF + (size_t)MP * 2048 * 4;
constexpr size_t OFF_PROJ = OFF_XB + (size_t)MP * 2048 * 2;
constexpr size_t OFF_GOUT = OFF_PROJ + (size_t)MP * N0 * 4;
constexpr size_t OFF_OMIX = OFF_GOUT + (size_t)MP * 2048 * 4;
constexpr size_t OFF_MIXB = OFF_OMIX + (size_t)MP * 2048 * 4;
constexpr size_t OFF_QB = OFF_MIXB + (size_t)MP * 2048 * 2;
constexpr size_t OFF_RKV = OFF_QB + (size_t)MP * 2048 * 2;
constexpr size_t OFF_DEC = OFF_RKV + (size_t)MP * 3072 * 4;
constexpr size_t OFF_AA = OFF_DEC + (size_t)MP * 1024 * 4;
constexpr size_t OFF_GG = OFF_AA + (size_t)MP * 1024 * 4;
constexpr size_t OFF_LRA = OFF_GG + (size_t)MP * 1024 * 4;
constexpr size_t OFF_LRB = OFF_LRA + (size_t)MP * 64 * 2;
constexpr size_t OFF_LRG = OFF_LRB + (size_t)MP * 64 * 2;
constexpr size_t OFF_DTA = OFF_LRG + (size_t)MP * 192 * 2;
constexpr size_t OFF_BON = OFF_DTA + (size_t)MP * 64 * 4;
constexpr size_t OFF_USC = OFF_BON + (size_t)MP * 16 * 4;
constexpr size_t OFF_VSC = OFF_USC + 16384 * 4;
constexpr size_t OFF_BAR = OFF_VSC + 16384 * 4;
constexpr size_t WS_TOTAL = OFF_BAR + 3456 * 4;
static_assert(WS_TOTAL <= (size_t)1 << 30, "workspace too large");

constexpr size_t O_YP = 0;
constexpr size_t O_YS = O_YP + (size_t)4 * 2048 * 2048;
constexpr size_t O_HGP = O_YS + (size_t)128 * 4 * 2048;
constexpr size_t O_HGS = O_HGP + (size_t)4 * 8 * 128 * 128;
constexpr size_t O_RTP = O_HGS + (size_t)128 * 8 * 128 * 128;
constexpr size_t O_RTS = O_RTP + (size_t)4 * 4 * 128 * 256;
constexpr size_t O_SSP = O_RTS + (size_t)128 * 4 * 128 * 256;
constexpr size_t O_SSS = O_SSP + (size_t)4 * 16 * 128 * 64;
constexpr size_t O_CVP = O_SSS + (size_t)128 * 16 * 128 * 64;
constexpr size_t O_CVS = O_CVP + (size_t)4 * 3 * 1536;
constexpr size_t O_WKP = O_CVS + (size_t)128 * 3 * 1536;
constexpr size_t O_WKS = O_WKP + (size_t)4 * 16 * 64 * 64;
constexpr size_t O_SHP = O_WKS + (size_t)128 * 16 * 64 * 64;
constexpr size_t O_SHS = O_SHP + (size_t)4 * 3360;

struct Params {
  const float* in[38];
  float* out;
  char* ws;
};
enum { I_XP = 0, I_XS, I_SHG, I_SRT, I_SSM, I_SCV, I_SWK, I_SSH, I_META, I_LNG, I_LNB, I_EWIN, I_LBL, I_HNG, I_EWOUT,
       I_OWIN, I_CVW, I_CVB, I_DTB, I_ALOG, I_DSK, I_SNG, I_MU, I_W0, I_W2, I_A0, I_A2, I_G2, I_KK, I_KA, I_RK,
       I_LXG, I_LXB, I_OWOUT, I_WQ, I_KEYS, I_PU, I_PV };

constexpr int VB_BYTES = 2 * 2 * 128 * 72 * 2;
constexpr int SMEM_BYTES = 2 * VB_BYTES;

DEVI u16 f2bf(float f) {
  unsigned u = __float_as_uint(f);
  u += 0x7fffu + ((u >> 16) & 1u);
  return (u16)(u >> 16);
}
DEVI unsigned pack2(float a, float b) { return (unsigned)f2bf(a) | ((unsigned)f2bf(b) << 16); }
DEVI float bflo(unsigned u) { return __uint_as_float(u << 16); }
DEVI float bfhi(unsigned u) { return __uint_as_float(u & 0xffff0000u); }
DEVI float sigmoidf_(float x) { return __builtin_amdgcn_rcpf(1.0f + __builtin_amdgcn_exp2f(-1.44269504089f * x)); }
DEVI float siluf_(float x) { return x * __builtin_amdgcn_rcpf(1.0f + __builtin_amdgcn_exp2f(-1.44269504089f * x)); }
DEVI float sigmoid_acc(float x) { return 1.0f / (1.0f + expf(-x)); }
DEVI float silu_acc(float x) { return x / (1.0f + expf(-x)); }
DEVI float softplusf_(float x) { return fmaxf(x, 0.0f) + log1pf(expf(-fabsf(x))); }
DEVI float wsum(float v) {
#pragma unroll
  for (int o = 32; o > 0; o >>= 1) v += __shfl_xor(v, o, 64);
  return v;
}
DEVI float wmaxf_(float v) {
#pragma unroll
  for (int o = 32; o > 0; o >>= 1) v = fmaxf(v, __shfl_xor(v, o, 64));
  return v;
}
DEVI int wmini_(int v) {
#pragma unroll
  for (int o = 32; o > 0; o >>= 1) v = min(v, __shfl_xor(v, o, 64));
  return v;
}
template <int CTRL>
DEVI float dppf(float v) {
  return __int_as_float(__builtin_amdgcn_update_dpp(0, __float_as_int(v), CTRL, 0xF, 0xF, true));
}
DEVI float red8(float v) {
  v += dppf<0xB1>(v);
  v += dppf<0x4E>(v);
  v += dppf<0x141>(v);
  return v;
}
DEVI float red16(float v) {
  v = red8(v);
  v += dppf<0x140>(v);
  return v;
}
DEVI float rlf_(float v, int l) { return __int_as_float(__builtin_amdgcn_readlane(__float_as_int(v), l)); }
DEVI int row_pos(int row) { return row < MPR ? (row % TP) : (16384 + ((row - MPR) & 3)); }

DEVI void conv_bf16_flat(const float* __restrict__ src, u16* __restrict__ dst, size_t n4) {
  size_t stride = (size_t)gridDim.x * blockDim.x;
  for (size_t i = (size_t)blockIdx.x * blockDim.x + threadIdx.x; i < n4; i += stride) {
    float4 v = ((const float4*)src)[i];
    uint2 o;
    o.x = pack2(v.x, v.y);
    o.y = pack2(v.z, v.w);
    ((uint2*)dst)[i] = o;
  }
}

template <int MODE>
DEVI int colmap(int j) {
  if (MODE == 0) return j;
  if (MODE == 1) {
    if (j < 4096 || j >= 5120) return j;
    int hb = j & ~127, c = j & 127, wc = c >> 5, n = (c >> 4) & 1, r = c & 15;
    int d = n ? (64 + wc * 16 + r) : (wc * 16 + r);
    return hb + d;
  }
  if (j < 2560) return j;
  if (j < 5920) return j + 16;
  if (j < 5936) return 2560 + (j - 5920);
  return -1;
}

template <int MODE>
DEVI void transpose_job(const float* __restrict__ src, int ldsrc, int Ksrc, u16* __restrict__ dst, int Kdst, int ndst,
                        float* smem) {
  int ktiles = Kdst / 64, ntiles = ndst / 64;
  int tid = threadIdx.x & 255;
  const int half = threadIdx.x >> 8;
  smem += half * (64 * 65);
  for (int base = blockIdx.x * 2; base < ktiles * ntiles; base += gridDim.x * 2) {
    int tile = base + half;
    const bool valid = tile < ktiles * ntiles;
    if (!valid) tile = ktiles * ntiles - 1;
    int tn = tile / ktiles, tk = tile % ktiles;
    int j0 = tn * 64, k0 = tk * 64;
    int jj = (tid & 15) * 4;
    int sc = colmap<MODE>(j0 + jj);
#pragma unroll
    for (int i = 0; i < 4; ++i) {
      int kk = i * 16 + (tid >> 4);
      float4 v = make_float4(0.f, 0.f, 0.f, 0.f);
      if (sc >= 0 && (k0 + kk) < Ksrc) v = *(const float4*)(src + (size_t)(k0 + kk) * ldsrc + sc);
      smem[kk * 65 + jj] = v.x;
      smem[kk * 65 + jj + 1] = v.y;
      smem[kk * 65 + jj + 2] = v.z;
      smem[kk * 65 + jj + 3] = v.w;
    }
    __syncthreads();
    int jr = tid >> 2, kq = (tid & 3) * 16;
    unsigned pk[8];
#pragma unroll
    for (int e = 0; e < 8; ++e) pk[e] = pack2(smem[(kq + 2 * e) * 65 + jr], smem[(kq + 2 * e + 1) * 65 + jr]);
    uint4* dp = (uint4*)(dst + (size_t)(j0 + jr) * Kdst + k0 + kq);
    if (valid) {
      dp[0] = make_uint4(pk[0], pk[1], pk[2], pk[3]);
      dp[1] = make_uint4(pk[4], pk[5], pk[6], pk[7]);
    }
    __syncthreads();
  }
}

DEVI void phase0(const Params& p, float* smem) {
  char* ws = p.ws;
  conv_bf16_flat(p.in[I_KEYS], (u16*)(ws + OFF_KEY0), (size_t)16 * 128 * 128 / 4);
  conv_bf16_flat(p.in[I_KEYS] + (size_t)16 * 128 * 128, (u16*)(ws + OFF_KEY1), (size_t)16 * 128 * 128 / 4);
  transpose_job<1>(p.in[I_EWIN], N0, 2048, (u16*)(ws + OFF_WIN0), 2048, N0, smem);
  transpose_job<0>(p.in[I_EWOUT], 2048, 2048, (u16*)(ws + OFF_WOUT0), 2048, 2048, smem);
  transpose_job<0>(p.in[I_WQ], 2048, 2048, (u16*)(ws + OFF_WQ0), 2048, 2048, smem);
  transpose_job<0>(p.in[I_WQ] + (size_t)2048 * 2048, 2048, 2048, (u16*)(ws + OFF_WQ1), 2048, 2048, smem);
  transpose_job<2>(p.in[I_OWIN], 5936, 2048, (u16*)(ws + OFF_WIN1), 2048, N1, smem);
  transpose_job<0>(p.in[I_OWOUT], 2048, 2048, (u16*)(ws + OFF_WOUT1), 2048, 2048, smem);
  transpose_job<0>(p.in[I_W2], 1024, 64, (u16*)(ws + OFF_W2T), 64, 1024, smem);
  transpose_job<0>(p.in[I_A2], 1024, 64, (u16*)(ws + OFF_A2T), 64, 1024, smem);
  transpose_job<0>(p.in[I_G2], 1024, 160, (u16*)(ws + OFF_G2T), 192, 1024, smem);
  {
    float* XF = (float*)(ws + OFF_XF);
    u16* XB = (u16*)(ws + OFF_XB);
    size_t n4 = (size_t)MP * 512;
    size_t stride = (size_t)gridDim.x * blockDim.x;
    for (size_t i = (size_t)blockIdx.x * blockDim.x + threadIdx.x; i < n4; i += stride) {
      int row = (int)(i >> 9), c4 = (int)(i & 511);
      float4 v = make_float4(0.f, 0.f, 0.f, 0.f);
      if (row < MPR) {
        int b = row / TP, t = row % TP;
        const float* s = (t < 16) ? (p.in[I_META] + (size_t)t * D) : (p.in[I_XP] + ((size_t)b * 2048 + (t - 16)) * D);
        v = ((const float4*)s)[c4];
      } else if (row < M) {
        v = ((const float4*)(p.in[I_XS] + (size_t)(row - MPR) * D))[c4];
      }
      ((float4*)XF)[i] = v;
      uint2 o;
      o.x = pack2(v.x, v.y);
      o.y = pack2(v.z, v.w);
      ((uint2*)XB)[i] = o;
    }
  }
  if (blockIdx.x == 0) {
    float* LB = (float*)(ws + OFF_LB);
    const float* lg = p.in[I_LBL];
    for (int c = threadIdx.x; c < 1024; c += blockDim.x) {
      float a = lg[c], b = lg[1024 + c], d = lg[2048 + c];
      float m = fmaxf(a, fmaxf(b, d));
      float ea = expf(a - m), eb = expf(b - m), ed = expf(d - m);
      LB[c] = ea / (ea + eb + ed);
    }
    float* IR = (float*)(ws + OFF_INVREV);
    if (threadIdx.x < 64) {
      double d = (double)threadIdx.x;
      double v = exp(-d * (9.210340371976184 / 64.0)) * 0.15915494309189535;
      float h = (float)v;
      IR[threadIdx.x * 2] = h;
      IR[threadIdx.x * 2 + 1] = (float)(v - (double)h);
    }
  }
}

constexpr int G_LDS_STRIDE = 72;
constexpr int G_LDS_BUF = 2 * 128 * G_LDS_STRIDE;
template <class Epi>
DEVI void gemm_phase(const u16* __restrict__ A, int lda, int a_ntile_off, const u16* __restrict__ Bt, int K, int mtiles,
                     int ntiles, char* smem, Epi epi, const float* __restrict__ colc = nullptr) {
  const int half = threadIdx.x >> 8;
  u16* S0 = (u16*)(smem + half * VB_BYTES);
  const int tid = threadIdx.x & 255, wid = tid >> 6, lane = tid & 63, wr = wid >> 1, wc = wid & 1, fr = lane & 15, fq = lane >> 4;
  const int nk = K / 64;
  const int ntot = mtiles * ntiles;
  for (int base = blockIdx.x * 2; base < ntot; base += gridDim.x * 2) {
    int tile = base + half;
    const bool valid = tile < ntot;
    if (!valid) tile = ntot - 1;
    const int tm = tile / ntiles, tn = tile - tm * ntiles;
    const int brow = tm * 128, bcol = tn * 128;
    const u16* Ag = A + (size_t)brow * lda + (size_t)tn * a_ntile_off;
    const u16* Bg = Bt + (size_t)bcol * K;
    f32x4 acc[4][4];
#pragma unroll
    for (int m = 0; m < 4; ++m)
#pragma unroll
      for (int n = 0; n < 4; ++n) acc[m][n] = f32x4{0.f, 0.f, 0.f, 0.f};
    u32x4 ra0[4], rb0[4], ra1[4], rb1[4];
    auto gload = [&](int t, u32x4(&ra)[4], u32x4(&rb)[4]) {
#pragma unroll
      for (int i = 0; i < 4; ++i) {
        int c = tid + i * 256, r = c >> 3, kc = c & 7;
        ra[i] = *(const u32x4*)(Ag + (size_t)r * lda + t * 64 + kc * 8);
        rb[i] = *(const u32x4*)(Bg + (size_t)r * K + t * 64 + kc * 8);
      }
    };
    auto lwrite = [&](int buf, const u32x4(&ra)[4], const u32x4(&rb)[4]) {
      u16* SA = S0 + buf * G_LDS_BUF;
      u16* SB = SA + 128 * G_LDS_STRIDE;
#pragma unroll
      for (int i = 0; i < 4; ++i) {
        int c = tid + i * 256, r = c >> 3, kc = c & 7;
        *(u32x4*)(SA + r * G_LDS_STRIDE + kc * 8) = ra[i];
        *(u32x4*)(SB + r * G_LDS_STRIDE + kc * 8) = rb[i];
      }
    };
    auto compute = [&](int buf) {
      const u16* SA = S0 + buf * G_LDS_BUF;
      const u16* SB = SA + 128 * G_LDS_STRIDE;
#pragma unroll
      for (int kh = 0; kh < 2; ++kh) {
        bf16x8 At[4], Bl[4];
#pragma unroll
        for (int m = 0; m < 4; ++m)
          At[m] = *(const bf16x8*)(SA + (wr * 64 + m * 16 + fr) * G_LDS_STRIDE + kh * 32 + fq * 8);
#pragma unroll
        for (int n = 0; n < 4; ++n)
          Bl[n] = *(const bf16x8*)(SB + (wc * 64 + n * 16 + fr) * G_LDS_STRIDE + kh * 32 + fq * 8);
#pragma unroll
        for (int m = 0; m < 4; ++m)
#pragma unroll
          for (int n = 0; n < 4; ++n) acc[m][n] = __builtin_amdgcn_mfma_f32_16x16x32_bf16(At[m], Bl[n], acc[m][n], 0, 0, 0);
        __builtin_amdgcn_sched_barrier(0);
      }
    };
    gload(0, ra0, rb0);
    if (nk > 1) gload(1, ra1, rb1);
    lwrite(0, ra0, rb0);
    __syncthreads();
#pragma unroll 1
    for (int t = 0; t < nk; t += 2) {
      if (t + 2 < nk) gload(t + 2, ra0, rb0);
      compute(0);
      if (t + 1 < nk) lwrite(1, ra1, rb1);
      __syncthreads();
      if (t + 1 < nk) {
        if (t + 3 < nk) gload(t + 3, ra1, rb1);
        compute(1);
        if (t + 2 < nk) lwrite(0, ra0, rb0);
        __syncthreads();
      }
    }
    if (valid) {
      float cc[4] = {0.f, 0.f, 0.f, 0.f};
      if (colc) {
#pragma unroll
        for (int n = 0; n < 4; ++n) cc[n] = colc[bcol + wc * 64 + n * 16 + fr];
      }
#pragma unroll
      for (int m = 0; m < 4; ++m)
#pragma unroll
        for (int n = 0; n < 2; ++n)
#pragma unroll
          for (int j = 0; j < 4; ++j) {
            int row = brow + wr * 64 + m * 16 + fq * 4 + j;
            int col = bcol + wc * 64 + n * 16 + fr;
            epi(row, col, acc[m][n][j] + cc[n], acc[m][n + 2][j] + cc[n + 2]);
          }
    }
  }
}


namespace pg8 {
#define PG8_LAS __attribute__((address_space(3)))
typedef unsigned short bf16_t;
typedef short bf16x8 __attribute__((ext_vector_type(8)));
typedef float f32x4 __attribute__((ext_vector_type(4)));
typedef unsigned u32x4 __attribute__((ext_vector_type(4)));
constexpr int BM = 256, BK = 64, HALF = 128, HTB = HALF * BK * 2  , STAGE_BYTES = 8 * HTB, NXCD = 8, WGM = 8;

__host__ __device__ __forceinline__ int lds_byte(int r, int c) { const int st = (r >> 4) * 2 + (c >> 5), rr = r & 15, cc = c & 31, ob = rr * 64 + cc * 2; return st * 1024 + (ob ^ (((ob >> 9) & 1) << 5)); }
__host__ __device__ __forceinline__ void stage_rc(int b, int& R, int& C) { const int st = b / 1024, sb = b % 1024, swz = sb ^ (((sb >> 9) & 1) << 5); R = (st >> 1) * 16 + swz / 64; C = (st & 1) * 32 + (swz % 64) / 2; }
__host__ __device__ __forceinline__ int perm32(int rho) { const int n = rho >> 4, i = rho & 15; return 8 * (i >> 2) + 4 * n + (i & 3); }

struct Unit { int pm, pn; };
struct Gemm { const bf16_t* A; const bf16_t* Bt; int M, N, K; };

struct StaticOrder {
    int nM, nN, nwg, G, c;
    __host__ __device__ void init(int M, int N, int G_, int c_) { nM = M / BM; nN = N / BM; nwg = nM * nN; G = G_; c = c_; }
    __host__ __device__ bool next(int i, Unit& u) const {
        const long L = (long)i * G + c; if (L >= nwg) return false;
        int wgid = (int)L; { const int q = nwg / NXCD, r = nwg % NXCD, xcd = wgid % NXCD, off = wgid / NXCD; wgid = (xcd < r ? xcd * (q + 1) : r * (q + 1) + (xcd - r) * q) + off; }
        const int nig = WGM * nN, gid = wgid / nig, fm = gid * WGM, gsz = (nM - fm) < WGM ? (nM - fm) : WGM;
        u.pm = fm + ((wgid % nig) % gsz); u.pn = (wgid % nig) / gsz; return true;
    }
    __device__ __forceinline__ void a_ready(const Unit&) const {}
    __device__ __forceinline__ void done(const Unit&) const {}
};
template <class Epi, class Sched, bool STAMP = false>
__device__ __forceinline__ void gemm_phase(PG8_LAS unsigned char* lds, const Gemm g, const Sched& S, const Epi& E, unsigned long long* stamps) {
    const int tid = threadIdx.x, wid = __builtin_amdgcn_readfirstlane(tid >> 6), lane = tid & 63, wr = wid >> 2, wc = wid & 3, fr = lane & 15, fq = lane >> 4;
    const int K = g.K, nt = K / BK;
    int ts_lo = 0, ts_hi = 0, nts = 0; const unsigned long long rt_entry = STAMP ? (unsigned long long)wall_clock64() : 0ull;
#define PG8_STAMP() do { if (STAMP && wid == 0 && nts < 64) { const unsigned long long _c = (unsigned long long)clock64(); \
        ts_lo = (lane == nts) ? (int)(unsigned)_c : ts_lo; ts_hi = (lane == nts) ? (int)(unsigned)(_c >> 32) : ts_hi; ++nts; } } while (0)
    PG8_STAMP();
    unsigned voffA[2], voffB[2];
#pragma unroll
    for (int i = 0; i < 2; ++i) { int R, C; stage_rc(tid * 16 + i * 8192, R, C); const int Rb = Epi::PERM ? ((R & ~31) + perm32(R & 31)) : R;
        voffA[i] = (unsigned)(R * K + C) * 2u; voffB[i] = (unsigned)(Rb * K + C) * 2u; }
    const size_t kstep = (size_t)(BK * 2);
    const size_t hstep = (size_t)HALF * K * 2;
    const size_t tstep = 2 * hstep;
    const unsigned ldsw = (unsigned)wid * 1024u;
    const int aoff = lds_byte(wr * 64 + fr, fq * 8), boff = lds_byte(wc * 32 + fr, fq * 8);
#define PG8_SA(b, h) (((b) * 2 + (h)) * HTB)
#define PG8_SB(b, h) ((4 + (b) * 2 + (h)) * HTB)
#define PG8_STAGE(bufoff, gbase, voff) do { _Pragma("unroll") for (int _i = 0; _i < 2; ++_i) \
        __builtin_amdgcn_global_load_lds((const unsigned*)((const char*)(gbase) + (voff)[_i]), (PG8_LAS unsigned*)(lds + (bufoff) + ldsw + _i * 8192), 16, 0, 0); } while (0)
#define PG8_LDA(dst, b, h) do { _Pragma("unroll") for (int m = 0; m < 4; ++m) _Pragma("unroll") for (int k = 0; k < 2; ++k) dst[m][k] = *(const PG8_LAS bf16x8*)(lds + PG8_SA(b, h) + aoff + m * 2048 + k * 1024); } while (0)
#define PG8_LDB(dst, b, h) do { _Pragma("unroll") for (int n = 0; n < 2; ++n) _Pragma("unroll") for (int k = 0; k < 2; ++k) dst[n][k] = *(const PG8_LAS bf16x8*)(lds + PG8_SB(b, h) + boff + n * 2048 + k * 1024); } while (0)
#define PG8_MMA(ai, bj, At, Bt) do { __builtin_amdgcn_s_setprio(1); _Pragma("unroll") for (int m = 0; m < 4; ++m) _Pragma("unroll") for (int n = 0; n < 2; ++n) _Pragma("unroll") for (int k = 0; k < 2; ++k) \
        acc[ai][bj][m][n] = __builtin_amdgcn_mfma_f32_16x16x32_bf16(Bt[n][k], At[m][k], acc[ai][bj][m][n], 0, 0, 0); __builtin_amdgcn_s_setprio(0); } while (0)
#define PG8_WAIT_V(n) asm volatile("s_waitcnt vmcnt(" #n ")" ::: "memory")
#define PG8_WAIT_L(n) asm volatile("s_waitcnt lgkmcnt(" #n ")" ::: "memory")
#define PG8_BAR __builtin_amdgcn_s_barrier()
#define PG8_SCHED __builtin_amdgcn_sched_barrier(0)
    Unit cur, nxt; int ui = 0;
    if (!S.next(0, cur)) return;
    f32x4 acc[2][2][4][2];
#pragma unroll
    for (int a = 0; a < 2; ++a)
#pragma unroll
        for (int b = 0; b < 2; ++b)
#pragma unroll
            for (int m = 0; m < 4; ++m)
#pragma unroll
                for (int n = 0; n < 2; ++n) acc[a][b][m][n] = (f32x4){0.f, 0.f, 0.f, 0.f};
    bf16x8 At[4][2], B0[2][2], B1[2][2];
    const char* cA = (const char*)g.A + (size_t)cur.pm * tstep; const char* cB = (const char*)g.Bt + (size_t)cur.pn * tstep;
    S.a_ready(cur);
    PG8_STAGE(PG8_SB(0, 0), cB, voffB); PG8_STAGE(PG8_SA(0, 0), cA, voffA); PG8_STAGE(PG8_SB(0, 1), cB + hstep, voffB); PG8_STAGE(PG8_SA(0, 1), cA + hstep, voffA);
    if (wr == 1) PG8_BAR;
    PG8_WAIT_V(4); PG8_BAR;
    PG8_STAGE(PG8_SB(1, 0), cB + kstep, voffB); PG8_STAGE(PG8_SA(1, 0), cA + kstep, voffA); PG8_STAGE(PG8_SB(1, 1), cB + hstep + kstep, voffB);
    PG8_WAIT_V(6); PG8_BAR;
    PG8_STAMP();
    for (;;) {
        const bool has_next = S.next(ui + 1, nxt);
        const char* nA = has_next ? (const char*)g.A + (size_t)nxt.pm * tstep : cA; const char* nB = has_next ? (const char*)g.Bt + (size_t)nxt.pn * tstep : cB;
        for (int t = 0; t < nt; t += 2) {
            const bool last = (t == nt - 2);
            const char* a1 = cA + (size_t)(t + 1) * kstep;
            const char* a2 = last ? nA : cA + (size_t)(t + 2) * kstep; const char* b2 = last ? nB : cB + (size_t)(t + 2) * kstep;
            const char* a3 = a2 + kstep; const char* b3 = b2 + kstep;
            if (last && has_next) S.a_ready(nxt);
            PG8_LDB(B0, 0, 0); PG8_SCHED; PG8_LDA(At, 0, 0); PG8_STAGE(PG8_SA(1, 1), a1 + hstep, voffA);
            PG8_WAIT_L(8); PG8_BAR; PG8_WAIT_L(0); PG8_MMA(0, 0, At, B0); PG8_BAR; PG8_SCHED;
            PG8_LDB(B1, 0, 1); PG8_STAGE(PG8_SB(0, 0), b2, voffB);
            PG8_BAR; PG8_WAIT_L(0); PG8_MMA(0, 1, At, B1); PG8_BAR;
            PG8_LDA(At, 0, 1); PG8_STAGE(PG8_SA(0, 0), a2, voffA);
            PG8_BAR; PG8_WAIT_L(0); PG8_MMA(1, 0, At, B0); PG8_BAR; PG8_SCHED;
            PG8_STAGE(PG8_SB(0, 1), b2 + hstep, voffB);
            PG8_WAIT_V(6); PG8_BAR; PG8_MMA(1, 1, At, B1); PG8_BAR;
            PG8_LDB(B0, 1, 0); PG8_SCHED; PG8_LDA(At, 1, 0); PG8_STAGE(PG8_SA(0, 1), a2 + hstep, voffA);
            PG8_WAIT_L(8); PG8_BAR; PG8_WAIT_L(0); PG8_MMA(0, 0, At, B0); PG8_BAR; PG8_SCHED;
            PG8_LDB(B1, 1, 1); PG8_STAGE(PG8_SB(1, 0), b3, voffB);
            PG8_BAR; PG8_WAIT_L(0); PG8_MMA(0, 1, At, B1); PG8_BAR;
            PG8_LDA(At, 1, 1); PG8_STAGE(PG8_SA(1, 0), a3, voffA);
            PG8_BAR; PG8_WAIT_L(0); PG8_MMA(1, 0, At, B0); PG8_BAR; PG8_SCHED;
            PG8_STAGE(PG8_SB(1, 1), b3 + hstep, voffB);
            PG8_WAIT_V(6); PG8_BAR; PG8_MMA(1, 1, At, B1); PG8_BAR;
        }
        PG8_STAMP();
        if constexpr (!Epi::AFTER_DRAIN) { E(acc, cur, wr, wc, fr, fq); S.done(cur); }
        PG8_STAMP();
        if (!has_next) break;
#pragma unroll
        for (int a = 0; a < 2; ++a)
#pragma unroll
            for (int b = 0; b < 2; ++b)
#pragma unroll
                for (int m = 0; m < 4; ++m)
#pragma unroll
                    for (int n = 0; n < 2; ++n) acc[a][b][m][n] = (f32x4){0.f, 0.f, 0.f, 0.f};
        cur = nxt; cA = nA; cB = nB; ++ui;
    }
    PG8_WAIT_V(0);
    if (wr == 0) PG8_BAR;
    PG8_BAR;
    if constexpr (Epi::AFTER_DRAIN) { E.fused(acc, cur, wr, wc, fr, fq, lds, wid, lane); S.done(cur); }
    PG8_STAMP();
    if (STAMP && wid == 0) { stamps[lane] = lane < nts ? (((unsigned long long)(unsigned)ts_hi << 32) | (unsigned)ts_lo) : 0ull;
        if (lane == 62) stamps[62] = rt_entry; if (lane == 63) stamps[63] = (unsigned long long)wall_clock64(); }
#undef PG8_STAMP
#undef PG8_SA
#undef PG8_SB
#undef PG8_STAGE
#undef PG8_LDA
#undef PG8_LDB
#undef PG8_MMA
#undef PG8_WAIT_V
#undef PG8_WAIT_L
#undef PG8_BAR
#undef PG8_SCHED
}
}

struct EpiIn0 {
  static constexpr bool PERM = false, AFTER_DRAIN = false;
  float* PROJ;
  const float* LB;
  const float* IR;
  __device__ __forceinline__ void operator()(const pg8::f32x4 (&acc)[2][2][4][2], const pg8::Unit& u, int wr, int wc, int fr, int fq) const {
#pragma unroll
    for (int bj = 0; bj < 2; ++bj) {
      const int cb = u.pn * 256 + bj * 128;
      if (cb >= 4096 && cb < 5120) {
        const int d0 = wc * 16 + 4 * fq;
        const pg8::f32x4 irA = *(const pg8::f32x4*)(IR + 2 * d0), irB = *(const pg8::f32x4*)(IR + 2 * d0 + 4);
        const float irh[4] = {irA[0], irA[2], irB[0], irB[2]}, irl[4] = {irA[1], irA[3], irB[1], irB[3]};
        const float sc = (cb >= 4608) ? 0.08838834764831845f : 1.0f;
#pragma unroll
        for (int ai = 0; ai < 2; ++ai)
#pragma unroll
          for (int m = 0; m < 4; ++m) {
            const int row = u.pm * 256 + ai * 128 + wr * 64 + m * 16 + fr;
            float* pr = PROJ + (size_t)row * N0;
            const pg8::f32x4 v0 = acc[ai][bj][m][0], v1 = acc[ai][bj][m][1];
            const float pos = (float)row_pos(row);
            pg8::f32x4 o1, o2;
#pragma unroll
            for (int j = 0; j < 4; ++j) {
              float ph = pos * irh[j];
              float pe = __builtin_fmaf(pos, irh[j], -ph) + pos * irl[j];
              float frc = __builtin_amdgcn_fractf(ph) + pe;
              float sn = __builtin_amdgcn_sinf(frc), cs = __builtin_amdgcn_cosf(frc);
              o1[j] = (v0[j] * cs - v1[j] * sn) * sc;
              o2[j] = (v0[j] * sn + v1[j] * cs) * sc;
            }
            *(pg8::f32x4*)(pr + cb + d0) = o1;
            *(pg8::f32x4*)(pr + cb + 64 + d0) = o2;
            __builtin_amdgcn_sched_barrier(0);
          }
      } else if (cb >= 1024 && cb < 2048) {
        const int c0 = cb + 32 * wc + 4 * fq;
        const pg8::f32x4 l0 = *(const pg8::f32x4*)(LB + c0 - 1024), l1 = *(const pg8::f32x4*)(LB + c0 + 16 - 1024);
#pragma unroll
        for (int ai = 0; ai < 2; ++ai)
#pragma unroll
          for (int m = 0; m < 4; ++m) {
            const int row = u.pm * 256 + ai * 128 + wr * 64 + m * 16 + fr;
            float* pr = PROJ + (size_t)row * N0;
#pragma unroll
            for (int n = 0; n < 2; ++n) {
              const pg8::f32x4 l = n ? l1 : l0;
              pg8::f32x4 v = acc[ai][bj][m][n], o;
#pragma unroll
              for (int j = 0; j < 4; ++j) o[j] = l[j] + (1.0f - l[j]) * sigmoidf_(v[j]);
              *(pg8::f32x4*)(pr + c0 + 16 * n) = o;
            }
            __builtin_amdgcn_sched_barrier(0);
          }
      } else if (cb < 1024 || (cb >= 3072 && cb < 4096) || cb >= 6144) {
        const int c0 = cb + 32 * wc + 4 * fq;
#pragma unroll
        for (int ai = 0; ai < 2; ++ai)
#pragma unroll
          for (int m = 0; m < 4; ++m) {
            const int row = u.pm * 256 + ai * 128 + wr * 64 + m * 16 + fr;
            float* pr = PROJ + (size_t)row * N0;
#pragma unroll
            for (int n = 0; n < 2; ++n) {
              pg8::f32x4 v = acc[ai][bj][m][n], o;
#pragma unroll
              for (int j = 0; j < 4; ++j) o[j] = siluf_(v[j]);
              *(pg8::f32x4*)(pr + c0 + 16 * n) = o;
            }
            __builtin_amdgcn_sched_barrier(0);
          }
      } else {
        const int c0 = cb + 32 * wc + 4 * fq;
#pragma unroll
        for (int ai = 0; ai < 2; ++ai)
#pragma unroll
          for (int m = 0; m < 4; ++m) {
            const int row = u.pm * 256 + ai * 128 + wr * 64 + m * 16 + fr;
            float* pr = PROJ + (size_t)row * N0;
#pragma unroll
            for (int n = 0; n < 2; ++n) *(pg8::f32x4*)(pr + c0 + 16 * n) = acc[ai][bj][m][n];
          }
      }
    }
  }
};
struct EpiStoreF32 {
  static constexpr bool PERM = false, AFTER_DRAIN = false;
  float* C;
  __device__ __forceinline__ void operator()(const pg8::f32x4 (&acc)[2][2][4][2], const pg8::Unit& u, int wr, int wc, int fr, int fq) const {
#pragma unroll
    for (int ai = 0; ai < 2; ++ai)
#pragma unroll
      for (int m = 0; m < 4; ++m) {
        const int row = u.pm * 256 + ai * 128 + wr * 64 + m * 16 + fr;
        float* pr = C + (size_t)row * 2048 + u.pn * 256 + 32 * wc + 4 * fq;
#pragma unroll
        for (int bj = 0; bj < 2; ++bj)
#pragma unroll
          for (int n = 0; n < 2; ++n) *(pg8::f32x4*)(pr + bj * 128 + 16 * n) = acc[ai][bj][m][n];
      }
  }
};
struct EpiStoreBf16 {
  static constexpr bool PERM = false, AFTER_DRAIN = false;
  u16* C;
  __device__ __forceinline__ void operator()(const pg8::f32x4 (&acc)[2][2][4][2], const pg8::Unit& u, int wr, int wc, int fr, int fq) const {
#pragma unroll
    for (int ai = 0; ai < 2; ++ai)
#pragma unroll
      for (int m = 0; m < 4; ++m) {
        const int row = u.pm * 256 + ai * 128 + wr * 64 + m * 16 + fr;
        u16* pr = C + (size_t)row * 2048 + u.pn * 256 + 32 * wc + 4 * fq;
#pragma unroll
        for (int bj = 0; bj < 2; ++bj)
#pragma unroll
          for (int n = 0; n < 2; ++n) {
            const pg8::f32x4 v = acc[ai][bj][m][n];
            uint2 o;
            o.x = pack2(v[0], v[1]);
            o.y = pack2(v[2], v[3]);
            *(uint2*)(pr + bj * 128 + 16 * n) = o;
          }
      }
  }
};
struct EpiIn1 {
  static constexpr bool PERM = false, AFTER_DRAIN = false;
  float* PROJ;
  float* DTA;
  const float* dtb;
  const float* alog;
  __device__ __forceinline__ void operator()(const pg8::f32x4 (&acc)[2][2][4][2], const pg8::Unit& u, int wr, int wc, int fr, int fq) const {
    float dtbv[4] = {0.f, 0.f, 0.f, 0.f}, aev[4] = {0.f, 0.f, 0.f, 0.f};
    if (u.pn == 23) {
      const int cc = 23 * 256 + 32 * wc + 4 * fq;
      const int hb = (cc >= 5920 && cc < 5936) ? (cc - 5920) : ((cc + 16 >= 5920 && cc + 16 < 5936) ? (cc + 16 - 5920) : -1);
      if (hb >= 0) {
#pragma unroll
        for (int j = 0; j < 4; ++j) { dtbv[j] = dtb[hb + j]; aev[j] = expf(alog[hb + j]); }
      }
    }
#pragma unroll
    for (int ai = 0; ai < 2; ++ai)
#pragma unroll
      for (int m = 0; m < 4; ++m) {
        const int row = u.pm * 256 + ai * 128 + wr * 64 + m * 16 + fr;
        float* pr = PROJ + (size_t)row * N1;
#pragma unroll
        for (int bj = 0; bj < 2; ++bj)
#pragma unroll
          for (int n = 0; n < 2; ++n) {
            const int col0 = u.pn * 256 + bj * 128 + 32 * wc + 16 * n + 4 * fq;
            pg8::f32x4 v = acc[ai][bj][m][n];
            if (col0 < 1024) {
              pg8::f32x4 o;
#pragma unroll
              for (int j = 0; j < 4; ++j) o[j] = siluf_(v[j]);
              *(pg8::f32x4*)(pr + col0) = o;
            } else if (col0 < 5920) {
              *(pg8::f32x4*)(pr + col0) = v;
            } else if (col0 < 5936) {
#pragma unroll
              for (int j = 0; j < 4; ++j) {
                int h = col0 + j - 5920;
                float dt = softplusf_(v[j] + dtbv[j]);
                DTA[(size_t)row * 64 + h * 4] = dt;
                DTA[(size_t)row * 64 + h * 4 + 1] = expf(-dt * aev[j]);
              }
            }
          }
      }
  }
};

struct Seg {
  int off;
  int ld;
  int n4;
};

template <int NS, int NF4, int RG>
DEVI void stage_init(const float* wsf, const Seg (&sg)[NS], int row0, int tid, const float* (&ptr)[RG], int (&ldv)[RG]) {
  asm volatile("" : "+v"(tid));
#pragma unroll
  for (int q = 0; q < RG; ++q) {
    int flat = tid + q * 256;
    int t = flat / NF4, f = flat % NF4;
    if (flat >= 16 * NF4) { t = 0; f = 0; }
    int off = 0, ld = 0, ff = f;
    bool done = false;
#pragma unroll
    for (int s = 0; s < NS; ++s) {
      bool here = (!done) && (ff < sg[s].n4);
      off = here ? (sg[s].off + (row0 + t) * sg[s].ld + ff * 4) : off;
      ld = here ? sg[s].ld : ld;
      ff = (done || here) ? ff : (ff - sg[s].n4);
      done = done || here;
    }
    ptr[q] = wsf + off;
    ldv[q] = ld;
  }
}
template <int NF4, int RG>
DEVI void stage_issue(const float* const (&ptr)[RG], const int (&ldv)[RG], int st, int nsteps, int tid, f32x4 (&rg)[RG]) {
#pragma unroll
  for (int q = 0; q < RG; ++q) {
    int flat = tid + q * 256;
    if (flat < nsteps * NF4) rg[q] = *(const f32x4*)(ptr[q] + (st * 16) * ldv[q]);
  }
}
template <int NF4, int RG>
DEVI void stage_commit(float* buf, int nsteps, int tid, const f32x4 (&rg)[RG]) {
#pragma unroll
  for (int q = 0; q < RG; ++q) {
    int flat = tid + q * 256;
    if (flat < nsteps * NF4) ((f32x4*)buf)[flat] = rg[q];
  }
}

template <int MODE>
DEVI void colrec_long(const float* wsf, const Seg (&sg)[4], int row0, int T, float gamma, float* outp, int ldo, float* stout, int st_ld,
                      float* smem) {
  constexpr int NF4 = 69, W = 276, RG = 5;
  const int tid = threadIdx.x & 255, w = tid >> 6, lane = tid & 63, c = lane >> 4, s = lane & 15;
  smem += (threadIdx.x >> 8) * (VB_BYTES / 4);
  float S[8];
#pragma unroll
  for (int i = 0; i < 8; ++i) S[i] = 0.f;
  float* buf0 = smem;
  float* buf1 = smem + 16 * 336;
  float* obuf = smem + 2 * 16 * 336;
  const int nst = (T + 15) / 16;
  f32x4 rgA[RG], rgB[RG];
  const float* sptr[RG];
  int sld[RG];
  stage_init<4, NF4, RG>(wsf, sg, row0, tid, sptr, sld);
  auto step = [&](const float* sp, float* ob, int tt) -> float {
    float4 a0 = *(const float4*)(sp + s * 4), a1 = *(const float4*)(sp + 64 + s * 4);
    float4 q0 = *(const float4*)(sp + 128 + s * 4), q1 = *(const float4*)(sp + 192 + s * 4);
    float a[8] = {a0.x, a0.y, a0.z, a0.w, a1.x, a1.y, a1.z, a1.w};
    float q[8] = {q0.x, q0.y, q0.z, q0.w, q1.x, q1.y, q1.z, q1.w};
    float val = sp[256 + w * 4 + c];
    float dA = gamma;
    if (MODE == 2) {
      val *= sp[272];
      dA = sp[273];
    }
    float o = 0.f;
#pragma unroll
    for (int i = 0; i < 8; ++i) {
      if (MODE == 0) S[i] = val + a[i] * (S[i] - val);
      else S[i] = dA * S[i] + a[i] * val;
      o += q[i] * S[i];
    }
    return red16(o);
  };
  auto run_stage = [&](const float* b, float* ob, int nthis) {
#pragma unroll 1
    for (int tt = 0; tt < nthis; tt += 8) {
      float o0 = step(b + tt * W, ob, tt);
      float o1 = step(b + (tt + 1) * W, ob, tt + 1);
      float o2 = step(b + (tt + 2) * W, ob, tt + 2);
      float o3 = step(b + (tt + 3) * W, ob, tt + 3);
      float o4 = step(b + (tt + 4) * W, ob, tt + 4);
      float o5 = step(b + (tt + 5) * W, ob, tt + 5);
      float o6 = step(b + (tt + 6) * W, ob, tt + 6);
      float o7 = step(b + (tt + 7) * W, ob, tt + 7);
      const int base = (s == 0) ? (tt * 16 + w * 4 + c) : (1024 + (tid & 255));
      const int st16 = (s == 0) ? 16 : 0;
      ob[base] = o0;
      ob[base + st16] = o1;
      ob[base + 2 * st16] = o2;
      ob[base + 3 * st16] = o3;
      ob[base + 4 * st16] = o4;
      ob[base + 5 * st16] = o5;
      ob[base + 6 * st16] = o6;
      ob[base + 7 * st16] = o7;
    }
  };
  auto write_out = [&](const float* ob, int st, int nthis) {
    if (tid < nthis * 4) {
      int t = tid >> 2, c4 = tid & 3;
      *(float4*)(outp + (size_t)(st * 16 + t) * ldo + c4 * 4) = *(const float4*)(ob + t * 16 + c4 * 4);
    }
  };
  auto nsteps = [&](int st) { return min(16, T - st * 16); };
  stage_issue<NF4, RG>(sptr, sld, 0, nsteps(0), tid, rgA);
  stage_commit<NF4, RG>(buf0, nsteps(0), tid, rgA);
  if (nst > 1) stage_issue<NF4, RG>(sptr, sld, 1, nsteps(1), tid, rgB);
  __syncthreads();
#pragma unroll 1
  for (int st = 0; st < nst; st += 2) {
    if (st + 2 < nst) stage_issue<NF4, RG>(sptr, sld, st + 2, nsteps(st + 2), tid, rgA);
    run_stage(buf0, obuf, nsteps(st));
    if (st + 1 < nst) stage_commit<NF4, RG>(buf1, nsteps(st + 1), tid, rgB);
    __syncthreads();
    write_out(obuf, st, nsteps(st));
    if (st + 1 < nst) {
      if (st + 3 < nst) stage_issue<NF4, RG>(sptr, sld, st + 3, nsteps(st + 3), tid, rgB);
      run_stage(buf1, obuf + 512, nsteps(st + 1));
      if (st + 2 < nst) stage_commit<NF4, RG>(buf0, nsteps(st + 2), tid, rgA);
      __syncthreads();
      write_out(obuf + 512, st + 1, nsteps(st + 1));
    }
  }
#pragma unroll
  for (int i = 0; i < 8; ++i) stout[(size_t)((i < 4 ? 0 : 60) + s * 4 + i) * st_ld + w * 4 + c] = S[i];
  __syncthreads();
}

template <int MODE>
DEVI void colrec_short(const float* pa, int lda_, const float* pq, int ldq, const float* pc, int ldc, const float* pdt,
                       long row0, float gamma, const float* stin, float* stout, int st_ld, float* outp, int ldo,
                       float* smem) {
  const int tid = threadIdx.x & 255, lane = tid & 63;
  const int wid = __builtin_amdgcn_readfirstlane(tid >> 6);
  const int k0 = wid * 32;
  smem += (threadIdx.x >> 8) * (VB_BYTES / 4);
  float S[32];
#pragma unroll
  for (int i = 0; i < 32; ++i) S[i] = __builtin_nontemporal_load(stin + (size_t)(k0 + i) * st_ld + lane);
  float aq[4], vv[4], dAv[4];
#pragma unroll
  for (int t = 0; t < 4; ++t) {
    long row = row0 + t;
    aq[t] = (lane < 32) ? pa[(size_t)row * lda_ + k0 + lane] : pq[(size_t)row * ldq + k0 + (lane - 32)];
    vv[t] = pc[(size_t)row * ldc + lane];
    dAv[t] = gamma;
    if (MODE == 2) {
      vv[t] *= pdt[(size_t)row * 64];
      dAv[t] = pdt[(size_t)row * 64 + 1];
    }
  }
#pragma unroll
  for (int t = 0; t < 4; ++t) {
    const float val = vv[t], dA = dAv[t];
    float o = 0.f;
#pragma unroll
    for (int i = 0; i < 32; ++i) {
      const float a = rlf_(aq[t], i), q = rlf_(aq[t], 32 + i);
      if (MODE == 0) S[i] = val + a * (S[i] - val);
      else S[i] = dA * S[i] + a * val;
      o += q * S[i];
    }
    smem[(wid * 4 + t) * 64 + lane] = o;
  }
#pragma unroll
  for (int i = 0; i < 32; ++i) __builtin_nontemporal_store(S[i], stout + (size_t)(k0 + i) * st_ld + lane);
  __syncthreads();
  {
    int t = tid >> 6;
    float sum = smem[(0 * 4 + t) * 64 + lane] + smem[(1 * 4 + t) * 64 + lane] + smem[(2 * 4 + t) * 64 + lane] +
                smem[(3 * 4 + t) * 64 + lane];
    outp[(size_t)(row0 + t) * ldo + lane] = sum;
  }
  __syncthreads();
}

DEVI void rwkv_item(const float* wsf, const Seg (&sg)[6], int row0, int T, const float* stin, float* stout, float* outp, int ldo,
                    float* smem) {
  constexpr int NF4 = 84, W = 336, RG = 6;
  const int tid = threadIdx.x & 255, w = tid >> 6, lane = tid & 63, rl = lane >> 4, sl = lane & 15;
  smem += (threadIdx.x >> 8) * (VB_BYTES / 4);
  const int il = w * 4 + rl;
  float S[4];
  if (stin) {
    float4 v = *(const float4*)(stin + il * 64 + sl * 4);
    S[0] = v.x; S[1] = v.y; S[2] = v.z; S[3] = v.w;
  } else {
    S[0] = S[1] = S[2] = S[3] = 0.f;
  }
  float* buf0 = smem;
  float* buf1 = smem + 16 * 336;
  float* obuf = smem + 2 * 16 * 336;
  const int nst = (T + 15) / 16;
  f32x4 rgA[RG], rgB[RG];
  const float* sptr[RG];
  int sld[RG];
  stage_init<6, NF4, RG>(wsf, sg, row0, tid, sptr, sld);
  auto run_stage = [&](const float* b, float* ob, int nthis) {
#pragma unroll 4
    for (int tt = 0; tt < nthis; ++tt) {
      const float* sp = b + tt * W;
      float4 r4 = *(const float4*)(sp + sl * 4);
      float4 w4 = *(const float4*)(sp + 64 + sl * 4);
      float4 k4 = *(const float4*)(sp + 128 + sl * 4);
      float4 n4 = *(const float4*)(sp + 192 + sl * 4);
      float4 m4 = *(const float4*)(sp + 256 + sl * 4);
      float vi = sp[320 + il];
      float sa = S[0] * n4.x + S[1] * n4.y + S[2] * n4.z + S[3] * n4.w;
      sa = -red16(sa);
      S[0] = S[0] * w4.x + sa * m4.x + vi * k4.x;
      S[1] = S[1] * w4.y + sa * m4.y + vi * k4.y;
      S[2] = S[2] * w4.z + sa * m4.z + vi * k4.z;
      S[3] = S[3] * w4.w + sa * m4.w + vi * k4.w;
      float y = S[0] * r4.x + S[1] * r4.y + S[2] * r4.z + S[3] * r4.w;
      y = red16(y);
      ob[(sl == 0) ? (tt * 16 + il) : (1024 + (tid & 255))] = y;
    }
  };
  auto write_out = [&](const float* ob, int st, int nthis) {
    if (tid < nthis * 4) {
      int t = tid >> 2, c4 = tid & 3;
      *(float4*)(outp + (size_t)(st * 16 + t) * ldo + c4 * 4) = *(const float4*)(ob + t * 16 + c4 * 4);
    }
  };
  auto nsteps = [&](int st) { return min(16, T - st * 16); };
  stage_issue<NF4, RG>(sptr, sld, 0, nsteps(0), tid, rgA);
  stage_commit<NF4, RG>(buf0, nsteps(0), tid, rgA);
  if (nst > 1) stage_issue<NF4, RG>(sptr, sld, 1, nsteps(1), tid, rgB);
  __syncthreads();
  __builtin_amdgcn_s_setprio(3);
#pragma unroll 1
  for (int st = 0; st < nst; st += 2) {
    if (st + 2 < nst) stage_issue<NF4, RG>(sptr, sld, st + 2, nsteps(st + 2), tid, rgA);
    run_stage(buf0, obuf, nsteps(st));
    if (st + 1 < nst) stage_commit<NF4, RG>(buf1, nsteps(st + 1), tid, rgB);
    __syncthreads();
    write_out(obuf, st, nsteps(st));
    if (st + 1 < nst) {
      if (st + 3 < nst) stage_issue<NF4, RG>(sptr, sld, st + 3, nsteps(st + 3), tid, rgB);
      run_stage(buf1, obuf + 512, nsteps(st + 1));
      if (st + 2 < nst) stage_commit<NF4, RG>(buf0, nsteps(st + 2), tid, rgA);
      __syncthreads();
      write_out(obuf + 512, st + 1, nsteps(st + 1));
    }
  }
  __builtin_amdgcn_s_setprio(0);
  *(float4*)(stout + il * 64 + sl * 4) = make_float4(S[0], S[1], S[2], S[3]);
  __syncthreads();
}

DEVI void phase_rec0(const Params& p, float* smem) {
  char* ws = p.ws;
  const float* PROJ = (const float*)(ws + OFF_PROJ);
  float* OMIX = (float*)(ws + OFF_OMIX);
  const float* wsf = (const float*)ws;
  constexpr int PO = (int)(OFF_PROJ / 4);
  for (int item = blockIdx.x * 2 + (threadIdx.x >> 8); item < 4608; item += gridDim.x * 2) {
    if (item < 256) {
      int b = item >> 6, h = (item >> 3) & 7, cb = item & 7;
      Seg sg[4] = {{PO + 1024 + h * 128, N0, 32}, {PO + h * 128, N0, 32}, {PO + 2048 + h * 128 + cb * 16, N0, 4},
                   {PO, N0, 1}};
      int row0 = b * TP;
      colrec_long<0>(wsf, sg, row0, TP, 0.f, OMIX + (size_t)row0 * 2048 + h * 128 + cb * 16, 2048,
                     p.out + O_HGP + (size_t)(b * 8 + h) * 128 * 128 + cb * 16, 128, smem);
    } else if (item < 512) {
      int it = item - 256;
      int b = it >> 6, h = (it >> 4) & 3, cb = it & 15;
      Seg sg[4] = {{PO + 4608 + h * 128, N0, 32}, {PO + 4096 + h * 128, N0, 32},
                   {PO + 5120 + h * 256 + cb * 16, N0, 4}, {PO, N0, 1}};
      int row0 = b * TP;
      float gamma = 1.0f - exp2f(-5.0f - (float)h);
      colrec_long<1>(wsf, sg, row0, TP, gamma, OMIX + (size_t)row0 * 2048 + 1024 + h * 256 + cb * 16, 2048,
                     p.out + O_RTP + (size_t)(b * 4 + h) * 128 * 256 + cb * 16, 256, smem);
    } else if (item < 2560) {
      int it = item - 512;
      int b = it >> 4, h = (it >> 1) & 7, cb = it & 1;
      long row0 = MPR + (long)b * 4;
      size_t so = (size_t)(b * 8 + h) * 128 * 128 + cb * 64;
      colrec_short<0>(PROJ + 1024 + h * 128, N0, PROJ + h * 128, N0, PROJ + 2048 + h * 128 + cb * 64, N0, nullptr, row0,
                      0.f, p.in[I_SHG] + so, p.out + O_HGS + so, 128, OMIX + h * 128 + cb * 64, 2048, smem);
    } else {
      int it = item - 2560;
      int b = it >> 4, h = (it >> 2) & 3, cb = it & 3;
      long row0 = MPR + (long)b * 4;
      size_t so = (size_t)(b * 4 + h) * 128 * 256 + cb * 64;
      float gamma = 1.0f - exp2f(-5.0f - (float)h);
      colrec_short<1>(PROJ + 4608 + h * 128, N0, PROJ + 4096 + h * 128, N0, PROJ + 5120 + h * 256 + cb * 64, N0, nullptr,
                      row0, gamma, p.in[I_SRT] + so, p.out + O_RTS + so, 256, OMIX + 1024 + h * 256 + cb * 64, 2048,
                      smem);
    }
  }
}

DEVI float4 ld4(const float* p) { return *(const float4*)p; }
DEVI void st_bf4(u16* p, float a, float b, float c, float d) {
  uint2 o;
  o.x = pack2(a, b);
  o.y = pack2(c, d);
  *(uint2*)p = o;
}
DEVI float wsum_u_(float v) {
  v = red16(v);
  return (rlf_(v, 0) + rlf_(v, 16)) + (rlf_(v, 32) + rlf_(v, 48));
}
DEVI float red32(float v) {
  v = red16(v);
  return v + __shfl_xor(v, 16, 64);
}
DEVI void phase_post0(const Params& p) {
  char* ws = p.ws;
  const float* PROJ = (const float*)(ws + OFF_PROJ);
  const float* OMIX = (const float*)(ws + OFF_OMIX);
  u16* MIXB = (u16*)(ws + OFF_MIXB);
  const float* ng = p.in[I_HNG];
  const int lane = threadIdx.x & 63;
  const int gw = blockIdx.x * 8 + (threadIdx.x >> 6), nw = gridDim.x * 8;
  const float4 g4 = ld4(ng + (lane & 31) * 4);
  for (int row = gw; row < M; row += nw) {
    const float* o = OMIX + (size_t)row * 2048;
    const float* pr = PROJ + (size_t)row * N0;
    u16* mo = MIXB + (size_t)row * 2048;
    float4 a[4], ga[4], bq[4], gb[4];
#pragma unroll
    for (int it = 0; it < 4; ++it) {
      int c = it * 256 + lane * 4;
      a[it] = ld4(o + c);
      ga[it] = ld4(pr + 3072 + c);
      bq[it] = ld4(o + 1024 + c);
      gb[it] = ld4(pr + 6144 + c);
    }
#pragma unroll
    for (int it = 0; it < 4; ++it) {
      int c = it * 256 + lane * 4;
      float ss = red32(a[it].x * a[it].x + a[it].y * a[it].y + a[it].z * a[it].z + a[it].w * a[it].w);
      float inv = rsqrtf(ss * (1.0f / 128.0f) + 1e-6f);
      st_bf4(mo + c, a[it].x * inv * g4.x * ga[it].x, a[it].y * inv * g4.y * ga[it].y, a[it].z * inv * g4.z * ga[it].z,
             a[it].w * inv * g4.w * ga[it].w);
      float mu = wsum_u_(bq[it].x + bq[it].y + bq[it].z + bq[it].w) * (1.0f / 256.0f);
      float dx = bq[it].x - mu, dy = bq[it].y - mu, dz = bq[it].z - mu, dw = bq[it].w - mu;
      float var = wsum_u_(dx * dx + dy * dy + dz * dz + dw * dw) * (1.0f / 256.0f);
      float iv = rsqrtf(var + 1e-5f);
      st_bf4(mo + 1024 + c, dx * iv * gb[it].x, dy * iv * gb[it].y, dz * iv * gb[it].z, dw * iv * gb[it].w);
    }
  }
}

DEVI void phase_ln(const Params& p, const float* addsrc, const float* g, const float* bta) {
  char* ws = p.ws;
  float* XF = (float*)(ws + OFF_XF);
  u16* XB = (u16*)(ws + OFF_XB);
  const int lane = threadIdx.x & 63;
  const int gw = blockIdx.x * 8 + (threadIdx.x >> 6), nw = gridDim.x * 8;
  for (int row = gw; row < M; row += nw) {
    float4* xr = (float4*)(XF + (size_t)row * 2048);
    const float4* ar = (const float4*)(addsrc + (size_t)row * 2048);
    float v[32];
    float s = 0.f;
#pragma unroll
    for (int i = 0; i < 8; ++i) {
      float4 x = xr[i * 64 + lane], a = ar[i * 64 + lane];
      v[i * 4 + 0] = ALPHA * x.x + a.x;
      v[i * 4 + 1] = ALPHA * x.y + a.y;
      v[i * 4 + 2] = ALPHA * x.z + a.z;
      v[i * 4 + 3] = ALPHA * x.w + a.w;
      s += v[i * 4 + 0] + v[i * 4 + 1] + v[i * 4 + 2] + v[i * 4 + 3];
    }
    float mu = wsum(s) * (1.0f / 2048.0f);
    float q = 0.f;
#pragma unroll
    for (int i = 0; i < 32; ++i) {
      v[i] -= mu;
      q += v[i] * v[i];
    }
    float inv = rsqrtf(wsum(q) * (1.0f / 2048.0f) + 1e-5f);
#pragma unroll
    for (int i = 0; i < 8; ++i) {
      float4 gg = ((const float4*)g)[i * 64 + lane], bb = ((const float4*)bta)[i * 64 + lane];
      float4 y;
      y.x = v[i * 4 + 0] * inv * gg.x + bb.x;
      y.y = v[i * 4 + 1] * inv * gg.y + bb.y;
      y.z = v[i * 4 + 2] * inv * gg.z + bb.z;
      y.w = v[i * 4 + 3] * inv * gg.w + bb.w;
      xr[i * 64 + lane] = y;
      uint2 o;
      o.x = pack2(y.x, y.y);
      o.y = pack2(y.z, y.w);
      ((uint2*)(XB + (size_t)row * 2048))[i * 64 + lane] = o;
    }
  }
}

typedef __attribute__((ext_vector_type(2))) __bf16 bf2_t;
typedef __attribute__((ext_vector_type(2))) float f32x2;
DEVI float dot2bf(unsigned a, unsigned b, float acc) {
  return __builtin_amdgcn_fdot2_f32_bf16(__builtin_bit_cast(bf2_t, a), __builtin_bit_cast(bf2_t, b), acc, false);
}
template <int CTRL>
DEVI int dppi(int v) {
  return __builtin_amdgcn_update_dpp(v, v, CTRL, 0xF, 0xF, false);
}
DEVI int wmax_i(int v) {
  v = max(v, dppi<0xB1>(v));
  v = max(v, dppi<0x4E>(v));
  v = max(v, dppi<0x141>(v));
  v = max(v, dppi<0x140>(v));
  int a = __builtin_amdgcn_readlane(v, 0), b = __builtin_amdgcn_readlane(v, 16);
  int c = __builtin_amdgcn_readlane(v, 32), d = __builtin_amdgcn_readlane(v, 48);
  return max(max(a, b), max(c, d));
}
DEVI float rlf(float v, int l) { return __int_as_float(__builtin_amdgcn_readlane(__float_as_int(v), l)); }
DEVI float wsum_u(float v) {
  v = red16(v);
  return (rlf(v, 0) + rlf(v, 16)) + (rlf(v, 32) + rlf(v, 48));
}
DEVI int fkey(float f) {
  int u = __float_as_int(f);
  return u ^ ((u >> 31) & 0x7fffffff);
}
DEVI float keyf(int k) { return __int_as_float(k ^ ((k >> 31) & 0x7fffffff)); }

DEVI void conv_fp8_rows(const float* __restrict__ src, unsigned char* __restrict__ dst, float* __restrict__ scales) {
  const int lane = threadIdx.x & 63;
  const int gw = blockIdx.x * 8 + (threadIdx.x >> 6), nw = gridDim.x * 8;
  for (int e = gw; e < 16384; e += nw) {
    const float* r = src + (size_t)e * 2048;
    float4 v[8];
    float am = 0.f;
#pragma unroll
    for (int q = 0; q < 8; ++q) {
      v[q] = *(const float4*)(r + (q >> 2) * 1024 + lane * 16 + (q & 3) * 4);
      am = fmaxf(am, fmaxf(fmaxf(fabsf(v[q].x), fabsf(v[q].y)), fmaxf(fabsf(v[q].z), fabsf(v[q].w))));
    }
    float amax = __int_as_float(wmax_i(__float_as_int(am)));
    float inv = (amax > 0.f) ? (440.0f / amax) : 0.f;
    float scale = (amax > 0.f) ? (amax * (1.0f / 440.0f)) : 1.0f;
#pragma unroll
    for (int j = 0; j < 2; ++j) {
      u32x4 o;
#pragma unroll
      for (int k = 0; k < 4; ++k) {
        float4 t = v[j * 4 + k];
        int pk = 0;
        pk = __builtin_amdgcn_cvt_pk_fp8_f32(t.x * inv, t.y * inv, pk, false);
        pk = __builtin_amdgcn_cvt_pk_fp8_f32(t.z * inv, t.w * inv, pk, true);
        o[k] = (unsigned)pk;
      }
      *(u32x4*)(dst + (size_t)e * 2048 + j * 1024 + lane * 16) = o;
    }
    if (lane == 0) scales[e] = scale;
  }
}

DEVI void phase_peer(const Params& p, int layer, bool final_out) {
  char* ws = p.ws;
  const float* SC = (const float*)(ws + OFF_GOUT);
  float* XF = (float*)(ws + OFF_XF);
  u16* XB = (u16*)(ws + OFF_XB);
  const unsigned char* UB = (const unsigned char*)(ws + OFF_UB);
  const unsigned char* VB = (const unsigned char*)(ws + OFF_VB);
  const float* USC = (const float*)(ws + OFF_USC);
  const float* VSC = (const float*)(ws + OFF_VSC);
  const float* g = p.in[I_LNG] + (size_t)(layer * 2 + 1) * D;
  const float* bta = p.in[I_LNB] + (size_t)(layer * 2 + 1) * D;
  const int lane = threadIdx.x & 63;
  const int gw = blockIdx.x * 8 + (threadIdx.x >> 6), nw = gridDim.x * 8;
  constexpr int KMIN = (int)0x80000000;
  for (int row = gw; row < M; row += nw) {
    const float* sr = SC + (size_t)row * 2048;
    int eidx0 = 0, eidx1 = 0;
    float gate0 = 0.f, gate1 = 0.f;
#pragma unroll 1
    for (int hp = 0; hp < 2; ++hp) {
      int hd[4] = {hp * 2, hp * 2 + 1, hp * 2 + 4, hp * 2 + 5};
      int ka[4][2], kb[4][2], my[4][2];
#pragma unroll
      for (int n = 0; n < 4; ++n) {
        const float* sp = sr + hd[n] * 256;
#pragma unroll
        for (int c = 0; c < 2; ++c) {
          ka[n][c] = (fkey(sp[c * 128 + lane]) & ~127) | (127 - lane);
          kb[n][c] = (fkey(sp[c * 128 + 64 + lane]) & ~127) | (63 - lane);
          my[n][c] = KMIN;
        }
      }
#pragma unroll 1
      for (int r = 0; r < 16; ++r) {
#pragma unroll
        for (int n = 0; n < 4; ++n)
#pragma unroll
          for (int c = 0; c < 2; ++c) {
            int K = wmax_i(max(ka[n][c], kb[n][c]));
            my[n][c] = (lane == r) ? K : my[n][c];
            ka[n][c] = (ka[n][c] == K) ? KMIN : ka[n][c];
            kb[n][c] = (kb[n][c] == K) ? KMIN : kb[n][c];
          }
      }
      const int jb = (lane & 3) * 4;
      int cc[4][4], myk[4];
      int ti0[4], ti1[4];
#pragma unroll
      for (int n = 0; n < 4; ++n) {
        const float ts0 = keyf(my[n][0] & ~127), ts1 = keyf(my[n][1] & ~127);
        ti0[n] = 127 - (my[n][0] & 127);
        ti1[n] = 127 - (my[n][1] & 127);
        const float s0 = __shfl(ts0, lane >> 2, 64);
#pragma unroll
        for (int q = 0; q < 4; ++q) cc[n][q] = (fkey(s0 + __shfl(ts1, jb + q, 64)) & ~255) | (255 - (lane * 4 + q));
        myk[n] = KMIN;
      }
#pragma unroll 1
      for (int r = 0; r < 16; ++r) {
#pragma unroll
        for (int n = 0; n < 4; ++n) {
          int K = wmax_i(max(max(cc[n][0], cc[n][1]), max(cc[n][2], cc[n][3])));
          myk[n] = (lane == r) ? K : myk[n];
#pragma unroll
          for (int q = 0; q < 4; ++q) cc[n][q] = (cc[n][q] == K) ? KMIN : cc[n][q];
        }
      }
#pragma unroll
      for (int n = 0; n < 4; ++n) {
        const float bs = keyf(myk[n] & ~255);
        const int bf = 255 - (myk[n] & 255);
        const int e = __shfl(ti0[n], (bf >> 4) & 15, 64) * 128 + __shfl(ti1[n], bf & 15, 64);
        const float ev = (lane < 16) ? expf(bs - rlf(bs, 0)) : 0.f;
        const float gt = ev / wsum_u(ev);
        const int e_b = __shfl(e, lane & 15, 64);
        const float g_b = __shfl(gt, lane & 15, 64);
        const int hh = hp * 2 + (n & 1);
        if ((lane >> 4) == hh) {
          if (n < 2) { eidx0 = e_b; gate0 = g_b; }
          else { eidx1 = e_b; gate1 = g_b; }
        }
      }
    }
    float dv0 = 0.f, dv1 = 0.f;
    {
      float xf[32];
      {
        const float4* xr = (const float4*)(XF + (size_t)row * 2048);
#pragma unroll
        for (int q = 0; q < 8; ++q) {
          float4 t = xr[(q >> 2) * 256 + lane * 4 + (q & 3)];
          xf[q * 4 + 0] = t.x; xf[q * 4 + 1] = t.y; xf[q * 4 + 2] = t.z; xf[q * 4 + 3] = t.w;
        }
      }
      constexpr int R = 8;
      u32x4 w[R][2];
      float sc[R];
      auto load_row = [&](int pidx, u32x4(&wr)[2], float& scv) {
        int src = (pidx < 64) ? eidx0 : eidx1;
        int e = __builtin_amdgcn_readlane(src, pidx & 63);
        const u32x4* ur = (const u32x4*)(UB + (size_t)e * 2048);
        wr[0] = ur[lane];
        wr[1] = ur[64 + lane];
        scv = USC[e];
      };
#pragma unroll
      for (int u = 0; u < R; ++u) load_row(u, w[u], sc[u]);
#pragma unroll 1
      for (int p0 = 0; p0 < 128; p0 += R) {
#pragma unroll
        for (int u = 0; u < R; ++u) {
          float d = 0.f;
#pragma unroll
          for (int j = 0; j < 2; ++j) {
#pragma unroll
            for (int k = 0; k < 4; ++k) {
              int dw = (int)w[u][j][k];
              f32x2 lo = __builtin_amdgcn_cvt_pk_f32_fp8(dw, false);
              f32x2 hi = __builtin_amdgcn_cvt_pk_f32_fp8(dw, true);
              d += lo.x * xf[j * 16 + k * 4 + 0];
              d += lo.y * xf[j * 16 + k * 4 + 1];
              d += hi.x * xf[j * 16 + k * 4 + 2];
              d += hi.y * xf[j * 16 + k * 4 + 3];
            }
          }
          float scu = sc[u];
          if (p0 + R < 128) load_row(p0 + R + u, w[u], sc[u]);
          d = wsum_u(d) * scu;
          int pl = (p0 + u) & 63;
          if (p0 < 64) dv0 = (lane == pl) ? d : dv0;
          else dv1 = (lane == pl) ? d : dv1;
          __builtin_amdgcn_sched_barrier(0);
        }
      }
    }
    float coef0 = 0.5f * dv0 * (1.0f + erff(dv0 * 0.70710678118f)) * gate0;
    float coef1 = 0.5f * dv1 * (1.0f + erff(dv1 * 0.70710678118f)) * gate1;
    f32x2 o2[16];
#pragma unroll
    for (int i = 0; i < 16; ++i) o2[i] = f32x2{0.f, 0.f};
    {
      constexpr int R = 8;
      u32x4 w[R][2];
      float sc[R];
      auto load_row = [&](int pidx, u32x4(&wr)[2], float& scv) {
        int src = (pidx < 64) ? eidx0 : eidx1;
        int e = __builtin_amdgcn_readlane(src, pidx & 63);
        const u32x4* vr = (const u32x4*)(VB + (size_t)e * 2048);
        wr[0] = vr[lane];
        wr[1] = vr[64 + lane];
        scv = VSC[e];
      };
#pragma unroll
      for (int u = 0; u < R; ++u) load_row(u, w[u], sc[u]);
#pragma unroll 1
      for (int p0 = 0; p0 < 128; p0 += R) {
        float cfs = (p0 < 64) ? coef0 : coef1;
#pragma unroll
        for (int u = 0; u < R; ++u) {
          float c = rlf(cfs, (p0 + u) & 63) * sc[u];
          f32x2 cc = f32x2{c, c};
#pragma unroll
          for (int j = 0; j < 2; ++j) {
#pragma unroll
            for (int k = 0; k < 4; ++k) {
              int dw = (int)w[u][j][k];
              o2[j * 8 + k * 2 + 0] += cc * __builtin_amdgcn_cvt_pk_f32_fp8(dw, false);
              o2[j * 8 + k * 2 + 1] += cc * __builtin_amdgcn_cvt_pk_f32_fp8(dw, true);
            }
          }
          if (p0 + R < 128) load_row(p0 + R + u, w[u], sc[u]);
          __builtin_amdgcn_sched_barrier(0);
        }
      }
    }
    float o[32];
#pragma unroll
    for (int i = 0; i < 16; ++i) {
      o[2 * i] = o2[i].x;
      o[2 * i + 1] = o2[i].y;
    }
    float s = 0.f;
    {
      const float4* xr = (const float4*)(XF + (size_t)row * 2048);
#pragma unroll
      for (int q = 0; q < 8; ++q) {
        float4 t = xr[(q >> 2) * 256 + lane * 4 + (q & 3)];
        o[q * 4 + 0] += ALPHA * t.x; o[q * 4 + 1] += ALPHA * t.y; o[q * 4 + 2] += ALPHA * t.z; o[q * 4 + 3] += ALPHA * t.w;
      }
#pragma unroll
      for (int i = 0; i < 32; ++i) s += o[i];
    }
    float mu = wsum_u(s) * (1.0f / 2048.0f);
    float q = 0.f;
#pragma unroll
    for (int i = 0; i < 32; ++i) {
      o[i] -= mu;
      q += o[i] * o[i];
    }
    float inv = rsqrtf(wsum_u(q) * (1.0f / 2048.0f) + 1e-5f);
    float* dstf;
    if (final_out) {
      if (row < MPR) {
        int b = row / TP, t = row % TP;
        dstf = (t >= 16) ? (p.out + O_YP + ((size_t)b * 2048 + (t - 16)) * D) : nullptr;
      } else {
        dstf = p.out + O_YS + (size_t)(row - MPR) * D;
      }
    } else {
      dstf = XF + (size_t)row * 2048;
    }
#pragma unroll
    for (int j = 0; j < 2; ++j) {
      float yv[16];
#pragma unroll
      for (int k = 0; k < 4; ++k) {
        float4 gv = *(const float4*)(g + j * 1024 + lane * 16 + k * 4);
        float4 bv = *(const float4*)(bta + j * 1024 + lane * 16 + k * 4);
        float4 y;
        y.x = o[j * 16 + k * 4 + 0] * inv * gv.x + bv.x;
        y.y = o[j * 16 + k * 4 + 1] * inv * gv.y + bv.y;
        y.z = o[j * 16 + k * 4 + 2] * inv * gv.z + bv.z;
        y.w = o[j * 16 + k * 4 + 3] * inv * gv.w + bv.w;
        if (dstf) *(float4*)(dstf + j * 1024 + lane * 16 + k * 4) = y;
        yv[k * 4 + 0] = y.x; yv[k * 4 + 1] = y.y; yv[k * 4 + 2] = y.z; yv[k * 4 + 3] = y.w;
      }
      if (!final_out) {
        uint4* xb = (uint4*)(XB + (size_t)row * 2048 + j * 1024 + lane * 16);
        xb[0] = make_uint4(pack2(yv[0], yv[1]), pack2(yv[2], yv[3]), pack2(yv[4], yv[5]), pack2(yv[6], yv[7]));
        xb[1] = make_uint4(pack2(yv[8], yv[9]), pack2(yv[10], yv[11]), pack2(yv[12], yv[13]), pack2(yv[14], yv[15]));
      }
    }
  }
}

DEVI float4 f4mul(float4 a, float4 b) { return make_float4(a.x * b.x, a.y * b.y, a.z * b.z, a.w * b.w); }
DEVI void row_info(int row, bool& prompt, int& b, int& t, int& T) {
  prompt = row < MPR;
  if (prompt) { b = row / TP; t = row - b * TP; T = TP; }
  else { b = (row - MPR) >> 2; t = (row - MPR) & 3; T = 4; }
}
DEVI void phase_pre1(const Params& p) {
  char* ws = p.ws;
  const float* PROJ = (const float*)(ws + OFF_PROJ);
  float* XC = (float*)(ws + OFF_GOUT);
  float* RKV = (float*)(ws + OFF_RKV);
  u16* LRA = (u16*)(ws + OFF_LRA);
  u16* LRB = (u16*)(ws + OFF_LRB);
  u16* LRG = (u16*)(ws + OFF_LRG);
  const float* cw = p.in[I_CVW];
  const float* cbias = p.in[I_CVB];
  const float* mu = p.in[I_MU];
  const int gtid = blockIdx.x * 512 + threadIdx.x, nthr = gridDim.x * 512;
#pragma unroll 2
  for (int idx = gtid; idx < M * 384; idx += nthr) {
    int row = idx / 384, c = (idx - row * 384) * 4;
    bool prompt; int b, t, T;
    row_info(row, prompt, b, t, T);
    float4 xv[4];
#pragma unroll
    for (int jj = 0; jj < 4; ++jj) {
      int tt = t - 3 + jj;
      if (tt >= 0) xv[jj] = ld4(PROJ + (size_t)(row - 3 + jj) * N1 + 1024 + c);
      else if (prompt) xv[jj] = make_float4(0.f, 0.f, 0.f, 0.f);
      else xv[jj] = ld4(p.in[I_SCV] + (size_t)(b * 3 + (tt + 3)) * 1536 + c);
    }
    float4 acc = ld4(cbias + c);
#pragma unroll
    for (int jj = 0; jj < 4; ++jj) {
      float4 w = ld4(cw + jj * 1536 + c);
      acc.x += xv[jj].x * w.x; acc.y += xv[jj].y * w.y; acc.z += xv[jj].z * w.z; acc.w += xv[jj].w * w.w;
    }
    *(float4*)(XC + (size_t)row * 1536 + c) = make_float4(siluf_(acc.x), siluf_(acc.y), siluf_(acc.z), siluf_(acc.w));
    if (t >= T - 3) {
      float* co = prompt ? (p.out + O_CVP) : (p.out + O_CVS);
      *(float4*)(co + (size_t)(b * 3 + (t - (T - 3))) * 1536 + c) = xv[3];
    }
  }
#pragma unroll 2
  for (int idx = gtid; idx < M * 840; idx += nthr) {
    int row = idx / 840, c = (idx - row * 840) * 4;
    bool prompt; int b, t, T;
    row_info(row, prompt, b, t, T);
    float4 cur = ld4(PROJ + (size_t)row * N1 + 2560 + c);
    float4 prev;
    if (t > 0) prev = ld4(PROJ + (size_t)(row - 1) * N1 + 2560 + c);
    else if (prompt) prev = make_float4(0.f, 0.f, 0.f, 0.f);
    else prev = ld4(p.in[I_SSH] + (size_t)b * 3360 + c);
    float4 m4 = ld4(mu + c);
    float4 mx;
    mx.x = cur.x + (prev.x - cur.x) * m4.x; mx.y = cur.y + (prev.y - cur.y) * m4.y;
    mx.z = cur.z + (prev.z - cur.z) * m4.z; mx.w = cur.w + (prev.w - cur.w) * m4.w;
    if (c < 3072) *(float4*)(RKV + (size_t)row * 3072 + c) = mx;
    else if (c < 3136) st_bf4(LRA + (size_t)row * 64 + (c - 3072), tanhf(mx.x), tanhf(mx.y), tanhf(mx.z), tanhf(mx.w));
    else if (c < 3200) st_bf4(LRB + (size_t)row * 64 + (c - 3136), mx.x, mx.y, mx.z, mx.w);
    else st_bf4(LRG + (size_t)row * 192 + (c - 3200), sigmoidf_(mx.x), sigmoidf_(mx.y), sigmoidf_(mx.z), sigmoidf_(mx.w));
    if (t == T - 1) {
      float* so = prompt ? (p.out + O_SHP) : (p.out + O_SHS);
      *(float4*)(so + (size_t)b * 3360 + c) = cur;
    }
  }
  for (int idx = gtid; idx < M * 4; idx += nthr) {
    int row = idx >> 2, k = idx & 3;
    ((uint4*)(LRG + (size_t)row * 192 + 160))[k] = make_uint4(0, 0, 0, 0);
  }
}

DEVI void phase_pre1c(const Params& p) {
  char* ws = p.ws;
  float* RKV = (float*)(ws + OFF_RKV);
  const float* AA = (const float*)(ws + OFF_AA);
  float* KK = (float*)(ws + OFF_QB);
  float* KKA = (float*)(ws + OFF_MIXB);
  float* BON = (float*)(ws + OFF_BON);
  const float* k_k = p.in[I_KK];
  const float* k_a = p.in[I_KA];
  const float* r_k = p.in[I_RK];
  const int lane = threadIdx.x & 63;
  const int gw = blockIdx.x * 8 + (threadIdx.x >> 6), nw = gridDim.x * 8;
  for (int row = gw; row < M; row += nw) {
    float4 k4[4], r4[4], a4[4];
#pragma unroll
    for (int it = 0; it < 4; ++it) {
      int c = it * 256 + lane * 4;
      k4[it] = ld4(RKV + (size_t)row * 3072 + 1024 + c);
      r4[it] = ld4(RKV + (size_t)row * 3072 + c);
      a4[it] = ld4(AA + (size_t)row * 1024 + c);
    }
#pragma unroll
    for (int it = 0; it < 4; ++it) {
      int c = it * 256 + lane * 4;
      float4 kk4 = ld4(k_k + c), ka4 = ld4(k_a + c), rk4 = ld4(r_k + c);
      float4 k = k4[it], r = r4[it], a = a4[it];
      float4 kr = f4mul(k, kk4);
      float ss = red16(kr.x * kr.x + kr.y * kr.y + kr.z * kr.z + kr.w * kr.w);
      float inv = 1.0f / fmaxf(sqrtf(ss), 1e-12f);
      float4 kk = make_float4(kr.x * inv, kr.y * inv, kr.z * inv, kr.w * inv);
      float4 kp;
      kp.x = k.x * (1.0f + (a.x - 1.0f) * ka4.x); kp.y = k.y * (1.0f + (a.y - 1.0f) * ka4.y);
      kp.z = k.z * (1.0f + (a.z - 1.0f) * ka4.z); kp.w = k.w * (1.0f + (a.w - 1.0f) * ka4.w);
      float bon = red16(r.x * kp.x * rk4.x + r.y * kp.y * rk4.y + r.z * kp.z * rk4.z + r.w * kp.w * rk4.w);
      *(float4*)(KK + (size_t)row * 1024 + c) = kk;
      *(float4*)(KKA + (size_t)row * 1024 + c) = f4mul(kk, a);
      *(float4*)(RKV + (size_t)row * 3072 + 1024 + c) = kp;
      if ((lane & 15) == 0) BON[(size_t)row * 16 + it * 4 + (lane >> 4)] = bon;
    }
  }
}

DEVI void rwkv_short(const float* __restrict__ RKV, const float* __restrict__ DEC, const float* __restrict__ KK,
                     const float* __restrict__ KKA, int h, int rb, int row0, const float* __restrict__ stin,
                     float* __restrict__ stout, float* __restrict__ outp) {
  const int tid = threadIdx.x & 255, w = tid >> 6, lane = tid & 63, rl = lane >> 4, sl = lane & 15;
  const int il = w * 4 + rl;
  float4 sv = *(const float4*)(stin + il * 64 + sl * 4);
  float S[4] = {sv.x, sv.y, sv.z, sv.w};
  float4 r4[4], w4[4], k4[4], n4[4], m4[4];
  float vi[4];
#pragma unroll
  for (int t = 0; t < 4; ++t) {
    const size_t row = (size_t)(row0 + t);
    r4[t] = *(const float4*)(RKV + row * 3072 + h * 64 + sl * 4);
    w4[t] = *(const float4*)(DEC + row * 1024 + h * 64 + sl * 4);
    k4[t] = *(const float4*)(RKV + row * 3072 + 1024 + h * 64 + sl * 4);
    n4[t] = *(const float4*)(KK + row * 1024 + h * 64 + sl * 4);
    m4[t] = *(const float4*)(KKA + row * 1024 + h * 64 + sl * 4);
    vi[t] = RKV[row * 3072 + 2048 + h * 64 + rb * 16 + il];
  }
#pragma unroll
  for (int t = 0; t < 4; ++t) {
    float sa = S[0] * n4[t].x + S[1] * n4[t].y + S[2] * n4[t].z + S[3] * n4[t].w;
    sa = -red16(sa);
    S[0] = S[0] * w4[t].x + sa * m4[t].x + vi[t] * k4[t].x;
    S[1] = S[1] * w4[t].y + sa * m4[t].y + vi[t] * k4[t].y;
    S[2] = S[2] * w4[t].z + sa * m4[t].z + vi[t] * k4[t].z;
    S[3] = S[3] * w4[t].w + sa * m4[t].w + vi[t] * k4[t].w;
    float y = S[0] * r4[t].x + S[1] * r4[t].y + S[2] * r4[t].z + S[3] * r4[t].w;
    y = red16(y);
    if (sl == 0) outp[(size_t)t * 2048 + il] = y;
  }
  *(float4*)(stout + il * 64 + sl * 4) = make_float4(S[0], S[1], S[2], S[3]);
}

DEVI void phase_rec1(const Params& p, float* smem) {
  char* ws = p.ws;
  const float* XC = (const float*)(ws + OFF_GOUT);
  const float* RKV = (const float*)(ws + OFF_RKV);
  const float* DEC = (const float*)(ws + OFF_DEC);
  const float* KK = (const float*)(ws + OFF_QB);
  const float* KKA = (const float*)(ws + OFF_MIXB);
  const float* DTA = (const float*)(ws + OFF_DTA);
  float* OMIX = (float*)(ws + OFF_OMIX);
  const float* wsf = (const float*)ws;
  constexpr int XO = (int)(OFF_GOUT / 4), DO = (int)(OFF_DTA / 4), RO = (int)(OFF_RKV / 4), CO = (int)(OFF_DEC / 4),
                KO = (int)(OFF_QB / 4), AO = (int)(OFF_MIXB / 4);
  const int half = threadIdx.x >> 8;
  for (int li = blockIdx.x; li < 256; li += gridDim.x) {
    if (half == 0) {
      int b = li >> 6, h = (li >> 2) & 15, cb = li & 3;
      int g = h >> 3;
      Seg sg[4] = {{XO + 1024 + g * 128, 1536, 32}, {XO + 1280 + g * 128, 1536, 32}, {XO + h * 64 + cb * 16, 1536, 4},
                   {DO + h * 4, 64, 1}};
      int row0 = b * TP;
      colrec_long<2>(wsf, sg, row0, TP, 0.f, OMIX + (size_t)row0 * 2048 + h * 64 + cb * 16, 2048,
                     p.out + O_SSP + (size_t)(b * 16 + h) * 128 * 64 + cb * 16, 64, smem);
    } else {
      int b = li >> 6, h = (li >> 2) & 15, rb = li & 3;
      int row0 = b * TP;
      Seg sg[6] = {{RO + h * 64, 3072, 16}, {CO + h * 64, 1024, 16}, {RO + 1024 + h * 64, 3072, 16},
                   {KO + h * 64, 1024, 16}, {AO + h * 64, 1024, 16}, {RO + 2048 + h * 64 + rb * 16, 3072, 4}};
      size_t so = ((size_t)(b * 16 + h) * 64 + rb * 16) * 64;
      rwkv_item(wsf, sg, row0, TP, nullptr, p.out + O_WKP + so, OMIX + (size_t)row0 * 2048 + 1024 + h * 64 + rb * 16, 2048, smem);
    }
  }
  for (int it = blockIdx.x * 2 + half; it < 2048; it += gridDim.x * 2) {
    int b = it >> 4, h = it & 15;
    int g = h >> 3;
    long row0 = MPR + (long)b * 4;
    size_t so = (size_t)(b * 16 + h) * 128 * 64;
    colrec_short<2>(XC + 1024 + g * 128, 1536, XC + 1280 + g * 128, 1536, XC + h * 64, 1536, DTA + h * 4, row0, 0.f,
                    p.in[I_SSM] + so, p.out + O_SSS + so, 64, OMIX + h * 64, 2048, smem);
  }
  for (int it = blockIdx.x * 2 + half; it < 8192; it += gridDim.x * 2) {
    int b = it >> 6, h = (it >> 2) & 15, rb = it & 3;
    int row0 = MPR + b * 4;
    size_t so = ((size_t)(b * 16 + h) * 64 + rb * 16) * 64;
    rwkv_short(RKV, DEC, KK, KKA, h, rb, row0, p.in[I_SWK] + so, p.out + O_WKS + so,
               OMIX + (size_t)row0 * 2048 + 1024 + h * 64 + rb * 16);
  }
}

DEVI void phase_post1(const Params& p) {
  char* ws = p.ws;
  const float* PROJ = (const float*)(ws + OFF_PROJ);
  const float* OMIX = (const float*)(ws + OFF_OMIX);
  const float* XC = (const float*)(ws + OFF_GOUT);
  const float* RKV = (const float*)(ws + OFF_RKV);
  const float* GG = (const float*)(ws + OFF_GG);
  const float* BON = (const float*)(ws + OFF_BON);
  u16* MIXB = (u16*)(ws + OFF_MIXB);
  const float* dsk = p.in[I_DSK];
  const float* sng = p.in[I_SNG];
  const float* lxg = p.in[I_LXG];
  const float* lxb = p.in[I_LXB];
  const int lane = threadIdx.x & 63;
  const int gw = blockIdx.x * 8 + (threadIdx.x >> 6), nw = gridDim.x * 8;
  for (int row = gw; row < M; row += nw) {
    const float* o = OMIX + (size_t)row * 2048;
    u16* mo = MIXB + (size_t)row * 2048;
    float4 oc[4], xc[4], z[4], y[4], v[4], gg[4];
    float bn[4];
#pragma unroll
    for (int it = 0; it < 4; ++it) {
      int c = it * 256 + lane * 4;
      oc[it] = ld4(o + c);
      xc[it] = ld4(XC + (size_t)row * 1536 + c);
      z[it] = ld4(PROJ + (size_t)row * N1 + c);
      y[it] = ld4(o + 1024 + c);
      v[it] = ld4(RKV + (size_t)row * 3072 + 2048 + c);
      gg[it] = ld4(GG + (size_t)row * 1024 + c);
      bn[it] = BON[(size_t)row * 16 + it * 4 + (lane >> 4)];
    }
    float4 val[4];
    float ssq[4];
#pragma unroll
    for (int it = 0; it < 4; ++it) {
      float ds = dsk[it * 4 + (lane >> 4)];
      val[it].x = (oc[it].x + xc[it].x * ds) * z[it].x;
      val[it].y = (oc[it].y + xc[it].y * ds) * z[it].y;
      val[it].z = (oc[it].z + xc[it].z * ds) * z[it].z;
      val[it].w = (oc[it].w + xc[it].w * ds) * z[it].w;
      ssq[it] = val[it].x * val[it].x + val[it].y * val[it].y + val[it].z * val[it].z + val[it].w * val[it].w;
    }
    float inv0 = rsqrtf(wsum_u_(ssq[0] + ssq[1]) * (1.0f / 512.0f) + 1e-6f);
    float inv1 = rsqrtf(wsum_u_(ssq[2] + ssq[3]) * (1.0f / 512.0f) + 1e-6f);
#pragma unroll
    for (int it = 0; it < 4; ++it) {
      int c = it * 256 + lane * 4;
      float inv = (it < 2) ? inv0 : inv1;
      float4 sg = ld4(sng + c);
      st_bf4(mo + c, val[it].x * inv * sg.x, val[it].y * inv * sg.y, val[it].z * inv * sg.z, val[it].w * inv * sg.w);
      float mu = red16(y[it].x + y[it].y + y[it].z + y[it].w) * (1.0f / 64.0f);
      float dx = y[it].x - mu, dy = y[it].y - mu, dz = y[it].z - mu, dw = y[it].w - mu;
      float var = red16(dx * dx + dy * dy + dz * dz + dw * dw) * (1.0f / 64.0f);
      float iv = rsqrtf(var + 64e-5f);
      float4 lg = ld4(lxg + c), lb = ld4(lxb + c);
      float y0 = (dx * iv * lg.x + lb.x + bn[it] * v[it].x) * gg[it].x;
      float y1 = (dy * iv * lg.y + lb.y + bn[it] * v[it].y) * gg[it].y;
      float y2 = (dz * iv * lg.z + lb.z + bn[it] * v[it].z) * gg[it].z;
      float y3 = (dw * iv * lg.w + lb.w + bn[it] * v[it].w) * gg[it].w;
      st_bf4(mo + 1024 + c, y0, y1, y2, y3);
    }
  }
}

#define XB_TMO      128
#define XB_XCNT(j)  (256  + 64 * (j))
#define XB_XSUB(j)  (1280 + 64 * (j))
#define XB_XGEN(j)  (2304 + 64 * (j))
#define XB_TOP      3328
#define XB_TOPGEN   3392
#define XCD_BAR_WORDS 3456
#define XB_SPIN_CAP (1u << 18)
#define LAS __attribute__((address_space(3)))

__device__ __forceinline__ unsigned xb_ld(unsigned* p)              { return __hip_atomic_load(p, __ATOMIC_RELAXED, __HIP_MEMORY_SCOPE_AGENT); }
__device__ __forceinline__ unsigned xb_add(unsigned* p, unsigned v) { return __hip_atomic_fetch_add(p, v, __ATOMIC_RELAXED, __HIP_MEMORY_SCOPE_AGENT); }
__device__ __forceinline__ unsigned xb_xcc_id() { return (unsigned)__builtin_amdgcn_s_getreg((3 << 11) | 20) & 0xFu; }
#define XB_SPIN(cond, bar) do { unsigned _sp = 0; while (cond) { __builtin_amdgcn_s_sleep(1); \
    if ((++_sp & 255u) == 0u) { if (xb_ld(&(bar)[XB_TMO])) break; if (_sp > XB_SPIN_CAP) { atomicAdd(&(bar)[XB_TMO], 1u); break; } } } } while (0)

struct XcdBarrier {
    unsigned* bar; unsigned x;
    volatile LAS unsigned* st;
};

__device__ __forceinline__ XcdBarrier xcd_barrier_post(unsigned* bar, volatile LAS unsigned* st) {
    XcdBarrier b; b.bar = bar; b.x = xb_xcc_id(); b.st = st;
    if (threadIdx.x == 0) (void)xb_add(&bar[XB_XCNT(b.x)], 1u);
    return b;
}
__device__ __forceinline__ void xcd_barrier_complete(unsigned* bar, unsigned x, unsigned& nloc, unsigned& nx) {
    const unsigned G = gridDim.x * gridDim.y * gridDim.z;
    unsigned sum, cnt, mine, sp = 0u;
    for (;;) {
        sum = 0u; cnt = 0u; mine = 0u;
#pragma unroll
        for (unsigned j = 0; j < 16; ++j) { const unsigned c = xb_ld(&bar[XB_XCNT(j)]); sum += c; cnt += (c > 0u) ? 1u : 0u; mine = (j == x) ? c : mine; }
        if (sum == G) break;
        __builtin_amdgcn_s_sleep(1);
        if ((++sp & 255u) == 0u) { if (xb_ld(&bar[XB_TMO])) break; if (sp > XB_SPIN_CAP) { atomicAdd(&bar[XB_TMO], 1u); break; } }
    }
    nloc = mine > 0u ? mine : 1u; nx = cnt > 0u ? cnt : 1u;
}

__device__ __forceinline__ void xcd_barrier(const XcdBarrier& b) {
    asm volatile("s_waitcnt vmcnt(0)" ::: "memory");
    __syncthreads();
    if (threadIdx.x == 0) {
        unsigned* bar = b.bar;
        __builtin_amdgcn_s_waitcnt(0);
        unsigned nloc = b.st[0], nx = b.st[1];
        if (nloc == 0u) { xcd_barrier_complete(bar, b.x, nloc, nx); b.st[0] = nloc; b.st[1] = nx; }
        const unsigned old = xb_add(&bar[XB_XSUB(b.x)], 1u);
        const unsigned gen = old / nloc;
        if (old + 1u == (gen + 1u) * nloc) {
            __builtin_amdgcn_fence(__ATOMIC_RELEASE, "agent");
            asm volatile("s_waitcnt vmcnt(0)" ::: "memory");
            const unsigned og = xb_add(&bar[XB_TOP], 1u);
            const unsigned tg = og / nx;
            if (og + 1u == (tg + 1u) * nx) xb_add(&bar[XB_TOPGEN], 1u);
            else XB_SPIN(xb_ld(&bar[XB_TOPGEN]) == tg, bar);
            __builtin_amdgcn_fence(__ATOMIC_ACQUIRE, "agent");
            xb_add(&bar[XB_XGEN(b.x)], 1u);
            asm volatile("s_waitcnt vmcnt(0)" ::: "memory");
        } else {
            XB_SPIN(xb_ld(&bar[XB_XGEN(b.x)]) == gen, bar);
            __builtin_amdgcn_fence(__ATOMIC_ACQUIRE, "agent");
            asm volatile("s_waitcnt vmcnt(0)" ::: "memory");
        }
    }
    __syncthreads();
}


template <int ph>
DEVI void run_phase(const Params& p, char* smem_raw) {
  float* smem = (float*)smem_raw;
  char* ws = p.ws;
  {
    switch (ph) {
      case 0:
        phase0(p, smem);
        conv_fp8_rows(p.in[I_PU], (unsigned char*)(ws + OFF_UB), (float*)(ws + OFF_USC));
        conv_fp8_rows(p.in[I_PV], (unsigned char*)(ws + OFF_VB), (float*)(ws + OFF_VSC));
        break;
      case 1: {
        EpiIn0 E{(float*)(ws + OFF_PROJ), (const float*)(ws + OFF_LB), (const float*)(ws + OFF_INVREV)};
        pg8::Gemm g{(const pg8::bf16_t*)(ws + OFF_XB), (const pg8::bf16_t*)(ws + OFF_WIN0), MP, N0, 2048};
        pg8::StaticOrder S;
        S.init(MP, N0, (int)gridDim.x, (int)blockIdx.x);
        pg8::gemm_phase<EpiIn0, pg8::StaticOrder, false>((PG8_LAS unsigned char*)smem_raw, g, S, E, nullptr);
      } break;
      case 2: phase_rec0(p, smem); break;
      case 3: phase_post0(p); break;
      case 4: case 15: {
        EpiStoreF32 E{(float*)(ws + OFF_GOUT)};
        pg8::Gemm g{(const pg8::bf16_t*)(ws + OFF_MIXB), (const pg8::bf16_t*)(ws + (ph == 4 ? OFF_WOUT0 : OFF_WOUT1)), MP, 2048, 2048};
        pg8::StaticOrder S;
        S.init(MP, 2048, (int)gridDim.x, (int)blockIdx.x);
        pg8::gemm_phase<EpiStoreF32, pg8::StaticOrder, false>((PG8_LAS unsigned char*)smem_raw, g, S, E, nullptr);
      } break;
      case 5: case 16: {
        int l = (ph == 5) ? 0 : 1;
        phase_ln(p, (const float*)(ws + OFF_GOUT), p.in[I_LNG] + (size_t)(l * 2) * D, p.in[I_LNB] + (size_t)(l * 2) * D);
      } break;
      case 6: case 17: {
        EpiStoreBf16 E{(u16*)(ws + OFF_QB)};
        pg8::Gemm g{(const pg8::bf16_t*)(ws + OFF_XB), (const pg8::bf16_t*)(ws + (ph == 6 ? OFF_WQ0 : OFF_WQ1)), MP, 2048, 2048};
        pg8::StaticOrder S;
        S.init(MP, 2048, (int)gridDim.x, (int)blockIdx.x);
        pg8::gemm_phase<EpiStoreBf16, pg8::StaticOrder, false>((PG8_LAS unsigned char*)smem_raw, g, S, E, nullptr);
      } break;
      case 7: case 18: {
        float* SC = (float*)(ws + OFF_GOUT);
        gemm_phase((const u16*)(ws + OFF_QB), 2048, 128, (const u16*)(ws + (ph == 7 ? OFF_KEY0 : OFF_KEY1)), 128,
                   69, 16, smem_raw, [=](int row, int col, float v0, float v1) {
                     SC[(size_t)row * 2048 + col] = v0;
                     SC[(size_t)row * 2048 + col + 32] = v1;
                   });
      } break;
      case 8: phase_peer(p, 0, false); break;
      case 9: {
        conv_fp8_rows(p.in[I_PU] + (size_t)16384 * 2048, (unsigned char*)(ws + OFF_UB), (float*)(ws + OFF_USC));
        conv_fp8_rows(p.in[I_PV] + (size_t)16384 * 2048, (unsigned char*)(ws + OFF_VB), (float*)(ws + OFF_VSC));
        EpiIn1 E{(float*)(ws + OFF_PROJ), (float*)(ws + OFF_DTA), p.in[I_DTB], p.in[I_ALOG]};
        pg8::Gemm g{(const pg8::bf16_t*)(ws + OFF_XB), (const pg8::bf16_t*)(ws + OFF_WIN1), MP, N1, 2048};
        pg8::StaticOrder S;
        S.init(MP, N1, (int)gridDim.x, (int)blockIdx.x);
        pg8::gemm_phase<EpiIn1, pg8::StaticOrder, false>((PG8_LAS unsigned char*)smem_raw, g, S, E, nullptr);
      } break;
      case 10: phase_pre1(p); break;
      case 11: {
        float* DEC = (float*)(ws + OFF_DEC);
        float* AA = (float*)(ws + OFF_AA);
        float* GG = (float*)(ws + OFF_GG);
        const float* w0 = p.in[I_W0];
        const float* a0 = p.in[I_A0];
        gemm_phase((const u16*)(ws + OFF_LRA), 64, 0, (const u16*)(ws + OFF_W2T), 64, 69, 8, smem_raw,
                   [=](int row, int col, float v0, float v1) {
#pragma unroll
                     for (int e = 0; e < 2; ++e) {
                       int cc = col + e * 32;
                       float v = (e ? v1 : v0);
                       float ew = 0.60653065971f * sigmoidf_(v);
                       DEC[(size_t)row * 1024 + cc] = __builtin_amdgcn_exp2f(-1.44269504089f * ew);
                     }
                   }, w0);
        gemm_phase((const u16*)(ws + OFF_LRB), 64, 0, (const u16*)(ws + OFF_A2T), 64, 69, 8, smem_raw,
                   [=](int row, int col, float v0, float v1) {
                     AA[(size_t)row * 1024 + col] = sigmoidf_(v0);
                     AA[(size_t)row * 1024 + col + 32] = sigmoidf_(v1);
                   }, a0);
        gemm_phase((const u16*)(ws + OFF_LRG), 192, 0, (const u16*)(ws + OFF_G2T), 192, 69, 8, smem_raw,
                   [=](int row, int col, float v0, float v1) {
                     GG[(size_t)row * 1024 + col] = v0;
                     GG[(size_t)row * 1024 + col + 32] = v1;
                   });
      } break;
      case 12: phase_pre1c(p); break;
      case 13: phase_rec1(p, smem); break;
      case 14: phase_post1(p); break;
      case 19: phase_peer(p, 1, true); break;
      default: break;
    }
  }
}

__global__ void __launch_bounds__(512, 2) mega(Params p, int ph_lo, int ph_hi) {
  __shared__ __attribute__((aligned(16))) char smem_raw[SMEM_BYTES];
  __shared__ uint4 xb_words;
  cg::grid_group grid = cg::this_grid();
  if (threadIdx.x == 0) xb_words = make_uint4(0u, 0u, 0u, 0u);
  __syncthreads();
  XcdBarrier xb = xcd_barrier_post((unsigned*)(p.ws + OFF_BAR), (volatile LAS unsigned*)&xb_words);
  if (ph_hi > 1000) grid.sync();
#ifndef REPEAT_MASK
#define REPEAT_MASK 0
#endif
#define PHASE(K)                                          \
  if (ph_lo <= K && K < ph_hi) run_phase<K>(p, smem_raw); \
  if ((REPEAT_MASK >> K) & 1) { xcd_barrier(xb); run_phase<K>(p, smem_raw); } \
  if (ph_lo <= K && K + 1 < ph_hi) xcd_barrier(xb);
  PHASE(0) PHASE(1) PHASE(2) PHASE(3) PHASE(4) PHASE(5) PHASE(6) PHASE(7) PHASE(8) PHASE(9)
  PHASE(10) PHASE(11) PHASE(12) PHASE(13) PHASE(14) PHASE(15) PHASE(16) PHASE(17) PHASE(18) PHASE(19)
}
#ifdef PHASE_TEST
template <int PH>
__global__ void __launch_bounds__(512, 2) phk(Params p) {
  __shared__ __attribute__((aligned(16))) char smem_raw[SMEM_BYTES];
  run_phase<PH>(p, smem_raw);
}
#define INST(N) template __global__ void phk<N>(Params);
INST(0) INST(1) INST(2) INST(3) INST(4) INST(5) INST(6) INST(7) INST(8) INST(9) INST(10) INST(11) INST(12) INST(13) INST(14) INST(19)
#endif

constexpr int NPHASE = 20;

extern "C" void kernel_launch(void* const* d_in, const int* in_sizes, int n_in, void* d_out, int out_size, void* d_ws,
                              size_t ws_size, hipStream_t stream) {
  static int grid_blocks = 0;
  if (!grid_blocks) {
    int dev = 0, cus = 0, per_cu = 0;
    hipGetDevice(&dev);
    hipDeviceGetAttribute(&cus, hipDeviceAttributeMultiprocessorCount, dev);
    hipOccupancyMaxActiveBlocksPerMultiprocessor(&per_cu, mega, 512, 0);
    if (per_cu > 1) per_cu = 1;
    if (per_cu < 1) per_cu = 1;
    grid_blocks = cus * per_cu;
  }
  Params p{};
  for (int i = 0; i < 38; ++i) p.in[i] = (const float*)d_in[i];
  p.out = (float*)d_out;
  p.ws = (char*)d_ws;
  (void)hipMemsetAsync((char*)d_ws + OFF_BAR, 0, 3456 * 4, stream);
  int lo = 0, hi = NPHASE;
  void* args[] = {&p, &lo, &hi};
  hipError_t e = hipLaunchCooperativeKernel((void*)mega, dim3(grid_blocks), dim3(512), args, 0, stream);
  if (e != hipSuccess) fprintf(stderr, "cooperative launch failed: %s (grid %d)\n", hipGetErrorString(e), grid_blocks);
}
```
